# Optimizing an MI355X kernel written in HIP

```python
import math
import jax
import jax.numpy as jnp
from jax import lax
import numpy as np

D_MODEL = 1024
BATCH = 32
SEQ = 2048
DEPTH = 4

N_MIXERS = 4
N_HEADS = 16
HEAD_DIM = 64
ATTN_WIDTH = N_HEADS * HEAD_DIM
NUM_BUCKETS = 32
MAX_DISTANCE = 2048
DIL_GROUPS = ((128, 1), (512, 4), (2048, 16))
CONV_WIDTH = 3
MOBA_BLOCK = 256
MOBA_TOPK = 3
MOBA_QGROUP = 128
MOBA_UNITS_PER_STEP = 256
GMLP_CHUNK = 128
GMLP_GROUPS = 8
GMLP_WIDTH = D_MODEL
D_FF = 2816
N_EXPERTS = 8
TOP_K = 2
D_FF_EXPERT = 3584
MOE_UNIT = 512
ALPHA = (2 * DEPTH) ** 0.25
BETA = (8 * DEPTH) ** -0.25
LN_EPS = 1e-5
NEG_INF = -1e30
N_A = len(range(0, DEPTH, N_MIXERS))
N_B = len(range(1, DEPTH, N_MIXERS))
N_C = len(range(2, DEPTH, N_MIXERS))
N_D = len(range(3, DEPTH, N_MIXERS))
N_DENSE = len(range(0, DEPTH, 2))
N_MOE = len(range(1, DEPTH, 2))

kernel_name = 'hybrid_dilated_conv_moba_gmlp_moe'

F32 = jnp.float32


def _layernorm(x, g, b):
    xf = x.astype(F32)
    mu = xf.mean(-1, keepdims=True)
    var = jnp.square(xf - mu).mean(-1, keepdims=True)
    return ((xf - mu) * lax.rsqrt(var + LN_EPS) * g + b).astype(x.dtype)


def _t5_bucket(dist):
    max_exact = NUM_BUCKETS // 2
    d = jnp.maximum(dist, 0)
    log_ratio = jnp.log(jnp.maximum(d, 1).astype(F32) / max_exact) / math.log(MAX_DISTANCE / max_exact)
    large = max_exact + (log_ratio * (NUM_BUCKETS - max_exact)).astype(jnp.int32)
    large = jnp.clip(large, max_exact, NUM_BUCKETS - 1)
    return jnp.where(d < max_exact, d, large)


def _rel_bias(rel_bias, dist):
    return jnp.moveaxis(rel_bias[_t5_bucket(dist)], -1, 0).astype(F32)


def _partial_softmax(s, v, mask=None):
    if mask is not None:
        s = jnp.where(mask, s, NEG_INF)
    m = s.max(-1)
    p = jnp.exp(s - m[..., None])
    l = p.sum(-1)
    o = jnp.einsum('...qk,...ke->...qe', p.astype(v.dtype), v)
    return m, l, o


def _merge_partials(ms, ls, os_):
    m = ms[0]
    for mi in ms[1:]:
        m = jnp.maximum(m, mi)
    w = jnp.exp(ms[0] - m)
    num = w[..., None] * os_[0].astype(F32)
    den = w * ls[0]
    for mi, li, oi in zip(ms[1:], ls[1:], os_[1:]):
        w = jnp.exp(mi - m)
        num = num + w[..., None] * oi.astype(F32)
        den = den + w * li
    return num / den[..., None]


def _group_slots(gid, n_groups, unit, round_units):
    n_items = gid.shape[0]
    n_units = -(-n_items // unit) + n_groups
    n_units = -(-n_units // round_units) * round_units
    counts = jnp.bincount(gid, length=n_groups + 1)[:n_groups]
    padded = (counts + unit - 1) // unit * unit
    pad_end = jnp.cumsum(padded)
    pad_start = pad_end - padded
    start = jnp.cumsum(counts) - counts
    order = jnp.argsort(gid).astype(jnp.int32)
    g_sorted = gid[order]
    g_clip = jnp.minimum(g_sorted, n_groups - 1)
    rank = jnp.arange(n_items, dtype=jnp.int32) - start[g_clip]
    dest = jnp.where(g_sorted < n_groups, pad_start[g_clip] + rank, n_units * unit)
    slot_item = jnp.full((n_units * unit,), n_items, jnp.int32).at[dest].set(order, mode='drop')
    unit_group = jnp.searchsorted(pad_end, jnp.arange(n_units, dtype=jnp.int32) * unit, side='right')
    unit_group = jnp.minimum(unit_group, n_groups - 1).astype(jnp.int32)
    return slot_item.reshape(n_units, unit), unit_group


def _dilated_group_attention(q, k, v, rel_bias, window, dil):
    bsz, seq, heads, hd = q.shape
    n_back = window // dil
    sub_len = seq // dil
    n_blk = -(-sub_len // n_back)
    pad_len = n_blk * n_back - sub_len

    def to_sub(t):
        t = t.reshape(bsz, sub_len, dil, heads, hd).transpose(0, 2, 3, 1, 4)
        t = jnp.pad(t, ((0, 0), (0, 0), (0, 0), (0, pad_len), (0, 0)))
        return t.reshape(bsz, dil, heads, n_blk, n_back, hd)

    def with_prev(t):
        prev = jnp.pad(t, ((0, 0), (0, 0), (0, 0), (1, 0), (0, 0), (0, 0)))[:, :, :, :-1]
        return jnp.concatenate([prev, t], axis=4)

    def from_sub(t):
        t = t.reshape((bsz, dil, heads, n_blk * n_back) + t.shape[5:])[:, :, :, :sub_len]
        t = jnp.moveaxis(t, 3, 1)
        return t.reshape((bsz, seq, heads) + t.shape[4:])

    qb, kw, vw = to_sub(q), with_prev(to_sub(k)), with_prev(to_sub(v))
    qi = jnp.arange(n_back)[:, None]
    kj = jnp.arange(2 * n_back)[None, :]
    delta = qi + n_back - kj
    band = (delta >= 0) & (delta <= n_back)
    not_front = (jnp.arange(n_blk)[:, None, None] > 0) | (kj >= n_back)[None]
    mask = band[None] & not_front
    bias = _rel_bias(rel_bias, delta * dil)
    s = jnp.einsum('bchnqe,bchnke->bchnqk', qb * (hd ** -0.5), kw).astype(F32) + bias[None, None, :, None]
    m, l, o = _partial_softmax(s, vw, mask)
    return from_sub(m), from_sub(l), from_sub(o)


def _dilated_mixer(x, w_in, w_out, rel_bias):
    bsz, seq, dm = x.shape
    group_cols = 3 * ATTN_WIDTH
    ms, ls, os_ = [], [], []
    for g, (window, dil) in enumerate(DIL_GROUPS):
        w_g = w_in[:, g * group_cols:(g + 1) * group_cols].reshape(dm, 3, N_HEADS, HEAD_DIM)
        qkv = jnp.einsum('bsd,dthe->tbshe', x, w_g)
        m, l, o = _dilated_group_attention(qkv[0], qkv[1], qkv[2], rel_bias, window, dil)
        ms.append(m)
        ls.append(l)
        os_.append(o)
    out = _merge_partials(ms, ls, os_)
    return out.reshape(bsz, seq, ATTN_WIDTH).astype(x.dtype) @ w_out


def _short_conv_mixer(x, w_in, conv_w, w_out):
    dm = x.shape[-1]
    gate_b, gate_c, x_in = jnp.split(x @ w_in, 3, axis=-1)
    z = lax.conv_general_dilated(gate_c * x_in, conv_w[:, None, :], window_strides=(1,),
                                 padding=((CONV_WIDTH - 1, 0),),
                                 dimension_numbers=('NWC', 'WIO', 'NWC'), feature_group_count=dm)
    return (gate_b * z) @ w_out


def _moba_mixer(x, w_in, w_out, rel_bias):
    bsz, seq, dm = x.shape
    H, hd, blk = N_HEADS, HEAD_DIM, MOBA_BLOCK
    n_blk = -(-seq // blk)
    seq_p = n_blk * blk
    qkv = jnp.einsum('bsd,dthe->tbhse', x, w_in.reshape(dm, 3, H, hd))
    qkv = jnp.pad(qkv, ((0, 0), (0, 0), (0, 0), (0, seq_p - seq), (0, 0))).reshape(3, bsz, H, n_blk, blk, hd)
    q, k, v = qkv[0] * (hd ** -0.5), qkv[1], qkv[2]
    pos = jnp.arange(blk)
    own_bias = _rel_bias(rel_bias, pos[:, None] - pos[None, :])
    s_own = jnp.einsum('bhnqe,bhnke->bhnqk', q, k).astype(F32) + own_bias[None, :, None]
    m_own, l_own, o_own = _partial_softmax(s_own, v, pos[:, None] >= pos[None, :])
    ms, ls, os_ = [m_own], [l_own], [o_own]
    n_sel = min(MOBA_TOPK, n_blk - 1)
    if n_sel > 0:
        k_mean = k.mean(axis=3)
        gate = jnp.einsum('bhnqe,bhme->bhnqm', q, k_mean).astype(F32)
        blk_id = jnp.arange(n_blk)
        gate = jnp.where((blk_id[None, :] < blk_id[:, None])[:, None, :], gate, NEG_INF)
        _, sel = lax.top_k(gate, n_sel)
        t_pos = blk_id[:, None] * blk + pos[None, :]
        valid = (jnp.arange(n_sel)[None, None, :] < blk_id[:, None, None]) & (t_pos < seq)[:, :, None]
        n_groups = bsz * H * n_blk
        bh = jnp.arange(bsz * H, dtype=jnp.int32).reshape(bsz, H, 1, 1, 1)
        gid = jnp.where(valid, bh * n_blk + sel.astype(jnp.int32), n_groups).reshape(-1)
        n_items = gid.shape[0]
        slot_item, unit_group = _group_slots(gid, n_groups, MOBA_QGROUP, MOBA_UNITS_PER_STEP)
        q_rows = q.reshape(-1, hd)
        k_blocks = k.reshape(n_groups, blk, hd)
        v_blocks = v.reshape(n_groups, blk, hd)

        def unit_step(args):
            items, groups = args
            row = jnp.minimum(items, n_items - 1) // n_sel
            t = row % seq_p
            head = (row // seq_p) % H
            key_pos = (groups % n_blk)[:, None] * blk + pos[None, :]
            bias = rel_bias[_t5_bucket(t[:, :, None] - key_pos[:, None, :]), head[:, :, None]]
            s = jnp.einsum('cqe,cke->cqk', q_rows[row], k_blocks[groups]).astype(F32) + bias.astype(F32)
            return _partial_softmax(s, v_blocks[groups])

        n_steps = slot_item.shape[0] // MOBA_UNITS_PER_STEP
        m_u, l_u, o_u = lax.map(unit_step, (slot_item.reshape(n_steps, MOBA_UNITS_PER_STEP, MOBA_QGROUP),
                                            unit_group.reshape(n_steps, MOBA_UNITS_PER_STEP)))
        flat = slot_item.reshape(-1)
        m_it = jnp.full((n_items,), NEG_INF, F32).at[flat].set(m_u.reshape(-1), mode='drop')
        l_it = jnp.zeros((n_items,), F32).at[flat].set(l_u.reshape(-1), mode='drop')
        o_it = jnp.zeros((n_items, hd), F32).at[flat].set(o_u.reshape(-1, hd).astype(F32), mode='drop')
        shp = (bsz, H, n_blk, blk, n_sel)
        m_it, l_it, o_it = m_it.reshape(shp), l_it.reshape(shp), o_it.reshape(shp + (hd,))
        for j in range(n_sel):
            ms.append(m_it[..., j])
            ls.append(l_it[..., j])
            os_.append(o_it[..., j, :])
    out = _merge_partials(ms, ls, os_)
    out = out.reshape(bsz, H, seq_p, hd)[:, :, :seq].transpose(0, 2, 1, 3).reshape(bsz, seq, ATTN_WIDTH)
    return out.astype(x.dtype) @ w_out


def _gmlp_mixer(x, w_in, ln_g, ln_b, w_s, b_s, w_out):
    bsz, seq, _ = x.shape
    u, v = jnp.split(jax.nn.gelu(x @ w_in, approximate=False), 2, axis=-1)
    v = _layernorm(v, ln_g, ln_b)
    n_chunk = seq // GMLP_CHUNK
    vc = v.reshape(bsz, n_chunk, GMLP_CHUNK, GMLP_GROUPS, GMLP_WIDTH // GMLP_GROUPS)
    causal = jnp.tril(jnp.ones((GMLP_CHUNK, GMLP_CHUNK), dtype=bool))
    ws = jnp.where(causal[None], w_s, 0)
    mixed = jnp.einsum('gts,bnsgc->bntgc', ws, vc) + b_s.T[None, None, :, :, None]
    return (u * mixed.reshape(bsz, seq, GMLP_WIDTH)) @ w_out


def _swiglu(x, w_gate, w_up, w_down):
    return (jax.nn.silu(x @ w_gate) * (x @ w_up)) @ w_down


def _moe_swiglu(x, w_router, w_gate, w_up, w_down):
    bsz, seq, dm = x.shape
    xt = x.reshape(-1, dm)
    logits = (xt @ w_router).astype(F32)
    top_val, top_idx = lax.top_k(logits, TOP_K)
    gates = jax.nn.softmax(top_val, axis=-1)
    n_items = xt.shape[0] * TOP_K
    slot_item, unit_expert = _group_slots(top_idx.reshape(-1).astype(jnp.int32), N_EXPERTS, MOE_UNIT, 1)
    it = jnp.minimum(slot_item, n_items - 1)
    tok = it // TOP_K
    g = jnp.where(slot_item < n_items, gates.reshape(-1)[it], 0.0)

    def expert_step(args):
        xb, e = args
        return _swiglu(xb, w_gate[e], w_up[e], w_down[e])

    ys = lax.map(expert_step, (xt[tok], unit_expert))
    contrib = (ys.astype(F32) * g[..., None]).reshape(-1, dm)
    out = jnp.zeros(xt.shape, F32).at[tok.reshape(-1)].add(contrib)
    return out.astype(x.dtype).reshape(bsz, seq, dm)


def setup_inputs(seed: int = 0) -> dict:
    key = jax.random.key(seed)
    keys = iter(jax.random.split(key, 32))

    def nrm(shape, scale):
        return jax.random.normal(next(keys), shape, F32) * scale

    D = D_MODEL
    n_dil = len(DIL_GROUPS)
    return {
        'x': nrm((BATCH, SEQ, D), 1.0),
        'rel_bias': nrm((NUM_BUCKETS, N_HEADS), 0.3),
        'ln_gain': 1.0 + nrm((DEPTH, 2, D), 0.02),
        'ln_bias': nrm((DEPTH, 2, D), 0.02),
        'a_w_in': nrm((N_A, D, n_dil * 3 * ATTN_WIDTH), D ** -0.5),
        'a_w_out': nrm((N_A, ATTN_WIDTH, D), BETA * ATTN_WIDTH ** -0.5),
        'b_w_in': nrm((N_B, D, 3 * D), D ** -0.5),
        'b_conv': nrm((N_B, CONV_WIDTH, D), CONV_WIDTH ** -0.5),
        'b_w_out': nrm((N_B, D, D), BETA * D ** -0.5),
        'c_w_in': nrm((N_C, D, 3 * ATTN_WIDTH), D ** -0.5),
        'c_w_out': nrm((N_C, ATTN_WIDTH, D), BETA * ATTN_WIDTH ** -0.5),
        'd_w_in': nrm((N_D, D, 2 * GMLP_WIDTH), D ** -0.5),
        'd_ln_gain': 1.0 + nrm((N_D, GMLP_WIDTH), 0.02),
        'd_ln_bias': nrm((N_D, GMLP_WIDTH), 0.02),
        'd_w_s': nrm((N_D, GMLP_GROUPS, GMLP_CHUNK, GMLP_CHUNK), GMLP_CHUNK ** -0.5),
        'd_b_s': 1.0 + nrm((N_D, GMLP_GROUPS, GMLP_CHUNK), 0.02),
        'd_w_out': nrm((N_D, GMLP_WIDTH, D), BETA * GMLP_WIDTH ** -0.5),
        'f_w_gate': nrm((N_DENSE, D, D_FF), D ** -0.5),
        'f_w_up': nrm((N_DENSE, D, D_FF), D ** -0.5),
        'f_w_down': nrm((N_DENSE, D_FF, D), BETA * D_FF ** -0.5),
        'e_w_router': nrm((N_MOE, D, N_EXPERTS), D ** -0.5),
        'e_w_gate': nrm((N_MOE, N_EXPERTS, D, D_FF_EXPERT), D ** -0.5),
        'e_w_up': nrm((N_MOE, N_EXPERTS, D, D_FF_EXPERT), D ** -0.5),
        'e_w_down': nrm((N_MOE, N_EXPERTS, D_FF_EXPERT, D), BETA * D_FF_EXPERT ** -0.5),
    }


def reference(x, rel_bias, ln_gain, ln_bias, a_w_in, a_w_out, b_w_in, b_conv, b_w_out,
              c_w_in, c_w_out, d_w_in, d_ln_gain, d_ln_bias, d_w_s, d_b_s, d_w_out,
              f_w_gate, f_w_up, f_w_down, e_w_router, e_w_gate, e_w_up, e_w_down):
    h = x
    for i in range(DEPTH):
        kind, j = i % N_MIXERS, i // N_MIXERS
        if kind == 0:
            y = _dilated_mixer(h, a_w_in[j], a_w_out[j], rel_bias)
        elif kind == 1:
            y = _short_conv_mixer(h, b_w_in[j], b_conv[j], b_w_out[j])
        elif kind == 2:
            y = _moba_mixer(h, c_w_in[j], c_w_out[j], rel_bias)
        else:
            y = _gmlp_mixer(h, d_w_in[j], d_ln_gain[j], d_ln_bias[j], d_w_s[j], d_b_s[j], d_w_out[j])
        h = _layernorm(ALPHA * h + y.astype(h.dtype), ln_gain[i, 0], ln_bias[i, 0])
        f = i // 2
        if i % 2 == 0:
            y = _swiglu(h, f_w_gate[f], f_w_up[f], f_w_down[f])
        else:
            y = _moe_swiglu(h, e_w_router[f], e_w_gate[f], e_w_up[f], e_w_down[f])
        h = _layernorm(ALPHA * h + y.astype(h.dtype), ln_gain[i, 1], ln_bias[i, 1])
    return h
```

```cpp
#include <hip/hip_runtime.h>
#include <cstdio>
#include <cstdint>

#ifndef MK_MULTI
#define MK_MULTI 0
#endif
#ifndef MK_PROBE
#define MK_PROBE 0
#endif
#ifndef MK_ENABLE
#define MK_ENABLE 0xFF
#endif

#define GAS __attribute__((address_space(1)))
#define LAS __attribute__((address_space(3)))
typedef unsigned short bf16;
typedef short bf16x8 __attribute__((ext_vector_type(8)));
typedef float f32x4 __attribute__((ext_vector_type(4)));
typedef float f32x2 __attribute__((ext_vector_type(2)));
typedef float f32x16 __attribute__((ext_vector_type(16)));
typedef unsigned u32x4 __attribute__((ext_vector_type(4)));
typedef unsigned u32x2 __attribute__((ext_vector_type(2)));
typedef GAS unsigned gu32;
typedef int v8i_t __attribute__((ext_vector_type(8)));
typedef int v4i_t __attribute__((ext_vector_type(4)));
typedef short s16x16_t __attribute__((ext_vector_type(16)));

constexpr int D = 1024, NB = 32, SEQ = 2048, T = NB * SEQ, NH = 16, HD = 64;
constexpr int DFF = 2816, NE = 8, DFE = 3584;
constexpr float ALPHA = 1.6817928305074290f;
constexpr float LN_EPS = 1e-5f;
constexpr float LOG2E = 1.4426950408889634f;
constexpr float QSCALE = 0.125f * LOG2E;
constexpr float NEGB = -1e30f;
constexpr int TC = 16384;
constexpr int MOE_CH_TILES = 256;
constexpr int MOE_MAX_TILES = 520;
constexpr int FFN_GU8 = 1;

constexpr size_t MiB = 1u << 20;
constexpr size_t WS_CTL = 0, CTL_ZERO_BYTES = 1 * MiB;
constexpr size_t WS_BUCKET = 1 * MiB;
constexpr size_t WS_BTABA = WS_BUCKET + 8192;
constexpr size_t WS_BTABC = WS_BTABA + 32768;
constexpr size_t WS_WST = WS_BTABC + 131072;
constexpr size_t WS_KMEAN = 2 * MiB;
constexpr size_t WS_ROUTE = 4 * MiB;
constexpr size_t WS_GATES = 5 * MiB;
constexpr size_t WS_SLOTS = 6 * MiB;
constexpr size_t WS_WCNT = 7 * MiB;
constexpr size_t WS_W = 8 * MiB;
constexpr size_t W_A_QK = WS_W;
constexpr size_t W_A_V = W_A_QK + 12 * MiB;
constexpr size_t W_A_O = W_A_V + 6 * MiB;
constexpr size_t W_B_IN = W_A_O + 2 * MiB;
constexpr size_t W_B_O = W_B_IN + 6 * MiB;
constexpr size_t W_C_QK = W_B_O + 2 * MiB;
constexpr size_t W_C_V = W_C_QK + 4 * MiB;
constexpr size_t W_C_O = W_C_V + 2 * MiB;
constexpr size_t W_D_IN = W_C_O + 2 * MiB;
constexpr size_t W_D_O = W_D_IN + 4 * MiB;
constexpr size_t W_F_GU = W_D_O + 2 * MiB;
constexpr size_t W_F_D = W_F_GU + 22 * MiB;
constexpr size_t W_E_GU = W_F_D + 11 * MiB;
constexpr size_t W_E_D = W_E_GU + 224 * MiB;
constexpr size_t WS_HB = W_E_D + 112 * MiB;
constexpr size_t WS_SCR = WS_HB + 128 * MiB;
constexpr size_t WS_NEED = WS_SCR + 512 * MiB;
static_assert(WS_HB == 419 * MiB, "map");
constexpr size_t S_QK = 0;
constexpr size_t S_VT = 192 * MiB;
constexpr size_t S_HB8 = 416 * MiB;
constexpr size_t S_ATT = 288 * MiB;
constexpr size_t S_HID = 0;
constexpr size_t S_BCX = 0;
constexpr size_t S_P = 384 * MiB;
constexpr size_t S_XG = 0;
constexpr size_t S_MHID = 260 * MiB;
constexpr size_t S_Y = 256 * MiB;
constexpr size_t S_CQK = 0;
constexpr size_t S_CVT = 256 * MiB;
constexpr size_t S_CATT = 384 * MiB;
constexpr size_t S_UV = 0;
constexpr size_t O_OG = 0;
constexpr size_t O_LSE = 96 * MiB;
constexpr int CW_TMO = 0;
constexpr int CW_ECNT = 64;
constexpr int CW_BAR = 4096;

constexpr float ASCALE8 = 8.f;
constexpr float WSCALE8 = 64.f, WSCALE8D = 256.f;
__device__ __forceinline__ unsigned pk4_fp8(float a, float b, float c, float d) { int p = 0; p = __builtin_amdgcn_cvt_pk_fp8_f32(a, b, p, false); p = __builtin_amdgcn_cvt_pk_fp8_f32(c, d, p, true); return (unsigned)p; }
namespace pg8 {
constexpr int BM = 256, BK = 64, HALF = 128, HTB = HALF * BK * 2, STAGE_BYTES = 8 * HTB, NXCD = 8, WGM = 8;
__host__ __device__ __forceinline__ int lds_byte(int r, int c) { const int st = (r >> 4) * 2 + (c >> 5), rr = r & 15, cc = c & 31, ob = rr * 64 + cc * 2; return st * 1024 + (ob ^ (((ob >> 9) & 1) << 5)); }
__host__ __device__ __forceinline__ void stage_rc(int b, int& R, int& C) { const int st = b / 1024, sb = b % 1024, swz = sb ^ (((sb >> 9) & 1) << 5); R = (st >> 1) * 16 + swz / 64; C = (st & 1) * 32 + (swz % 64) / 2; }
__host__ __device__ __forceinline__ int perm32(int rho) { const int n = rho >> 4, i = rho & 15; return 8 * (i >> 2) + 4 * n + (i & 3); }

struct Unit { int pm, pn; unsigned a, b; };
struct Gemm { int K; int rsA, rsB; size_t hstepA, hstepB; };

__device__ __forceinline__ bool tile_of(long L, int nM, int nN, int& pm, int& pn) {
    const int nwg = nM * nN; if (L >= nwg) return false;
    int wgid = (int)L; { const int q = nwg / NXCD, r = nwg % NXCD, xcd = wgid % NXCD, off = wgid / NXCD; wgid = (xcd < r ? xcd * (q + 1) : r * (q + 1) + (xcd - r) * q) + off; }
    const int nig = WGM * nN, gid = wgid / nig, fm = gid * WGM, gsz = (nM - fm) < WGM ? (nM - fm) : WGM;
    pm = fm + ((wgid % nig) % gsz); pn = (wgid % nig) / gsz; return true;
}
struct LinOrder {
    int nM, nN, G, c; const char* A0; const char* B0; size_t aT, bT;
    __device__ __forceinline__ bool next(int i, Unit& u) const { if (!tile_of((long)i * G + c, nM, nN, u.pm, u.pn)) return false; u.a = (unsigned)((size_t)u.pm * aT); u.b = (unsigned)((size_t)u.pn * bT); return true; }
};

typedef __bf16 bf16x2_t __attribute__((ext_vector_type(2)));
__device__ __forceinline__ unsigned cvt_pk_bf16(float lo, float hi) { f32x2 v = {lo, hi}; bf16x2_t b = __builtin_convertvector(v, bf16x2_t); return __builtin_bit_cast(unsigned, b); }
__device__ __forceinline__ f32x2 gelu_pk(f32x2 v) {
    const f32x2 av = __builtin_elementwise_abs(v), d = av * 0.2316418882f + 1.0f;
    f32x2 t; t.x = __builtin_amdgcn_rcpf(d.x); t.y = __builtin_amdgcn_rcpf(d.y);
    f32x2 q = t * 0.5307027145f + (-0.7265760135f); q = q * t + 0.7107068705f; q = q * t + (-0.142248368f); q = q * t + 0.127414796f; q = q * t;
    const f32x2 s = (v * v) * (-0.72134752044f);
    f32x2 e; e.x = __builtin_amdgcn_exp2f(s.x); e.y = __builtin_amdgcn_exp2f(s.y);
    const f32x2 m = v * (q * e), r = v - m;
    f32x2 o; o.x = v.x < 0.f ? m.x : r.x; o.y = v.y < 0.f ? m.y : r.y; return o;
}
__device__ __forceinline__ float silu_f(float g) { return g * __builtin_amdgcn_rcpf(1.0f + __builtin_amdgcn_exp2f(-LOG2E * g)); }

template <int ACT  > struct EpiBf16 {
    static constexpr bool PERM = true;
    bf16* O; int ldc; float sc = 1.f;
    __device__ __forceinline__ void operator()(const f32x4 (&acc)[2][2][4][2], const Unit& u, int wr, int wc, int fr, int fq) const {
        const int row0 = u.pm * BM + wr * 64 + fr, col0 = u.pn * BM + wc * 32 + 8 * fq;
#pragma unroll
        for (int ai = 0; ai < 2; ++ai)
#pragma unroll
            for (int m = 0; m < 4; ++m) { bf16* rowp = O + (size_t)(row0 + ai * HALF + m * 16) * ldc + col0;
#pragma unroll
                for (int bj = 0; bj < 2; ++bj) { f32x4 v0 = acc[ai][bj][m][0] * sc, v1 = acc[ai][bj][m][1] * sc;
                    if (ACT == 1) { f32x2 a = gelu_pk((f32x2){v0[0], v0[1]}), b = gelu_pk((f32x2){v0[2], v0[3]}), c = gelu_pk((f32x2){v1[0], v1[1]}), d = gelu_pk((f32x2){v1[2], v1[3]});
                        v0 = (f32x4){a.x, a.y, b.x, b.y}; v1 = (f32x4){c.x, c.y, d.x, d.y}; }
                    u32x4 w; w.x = cvt_pk_bf16(v0[0], v0[1]); w.y = cvt_pk_bf16(v0[2], v0[3]); w.z = cvt_pk_bf16(v1[0], v1[1]); w.w = cvt_pk_bf16(v1[2], v1[3]);
                    *(u32x4*)(rowp + bj * HALF) = w; } }
    }
};
template <int ACT  > struct EpiGlu {
    static constexpr bool PERM = true;
    bf16* O; int ldc;
    __device__ __forceinline__ void operator()(const f32x4 (&acc)[2][2][4][2], const Unit& u, int wr, int wc, int fr, int fq) const {
        const int row0 = u.pm * BM + wr * 64 + fr, col0 = u.pn * HALF + wc * 32 + 8 * fq;
#pragma unroll
        for (int ai = 0; ai < 2; ++ai)
#pragma unroll
            for (int m = 0; m < 4; ++m) { bf16* rowp = O + (size_t)(row0 + ai * HALF + m * 16) * ldc + col0;
                f32x4 g0 = acc[ai][0][m][0], g1 = acc[ai][0][m][1]; const f32x4 u0 = acc[ai][1][m][0], u1 = acc[ai][1][m][1];
                if (ACT == 1) { g0 = (f32x4){silu_f(g0[0]), silu_f(g0[1]), silu_f(g0[2]), silu_f(g0[3])}; g1 = (f32x4){silu_f(g1[0]), silu_f(g1[1]), silu_f(g1[2]), silu_f(g1[3])}; }
                const f32x4 p0 = g0 * u0, p1 = g1 * u1;
                u32x4 w; w.x = cvt_pk_bf16(p0[0], p0[1]); w.y = cvt_pk_bf16(p0[2], p0[3]); w.z = cvt_pk_bf16(p1[0], p1[1]); w.w = cvt_pk_bf16(p1[2], p1[3]);
                *(u32x4*)rowp = w; }
    }
};
struct EpiSwiglu8 {
    static constexpr bool PERM = true;
    unsigned char* O; int ldc; float s = 1.f;
    __device__ __forceinline__ void operator()(const f32x4 (&acc)[2][2][4][2], const Unit& u, int wr, int wc, int fr, int fq) const {
        const int row0 = u.pm * BM + wr * 64 + fr, col0 = u.pn * HALF + wc * 32 + 8 * fq;
#pragma unroll
        for (int ai = 0; ai < 2; ++ai)
#pragma unroll
            for (int m = 0; m < 4; ++m) { unsigned char* rowp = O + (size_t)(row0 + ai * HALF + m * 16) * ldc + col0;
                const f32x4 g0 = acc[ai][0][m][0], g1 = acc[ai][0][m][1], u0 = acc[ai][1][m][0], u1 = acc[ai][1][m][1];
                const f32x4 gg0 = g0 * s, gg1 = g1 * s, uu0 = u0 * s, uu1 = u1 * s;
                u32x2 w; w.x = pk4_fp8(silu_f(gg0[0]) * uu0[0], silu_f(gg0[1]) * uu0[1], silu_f(gg0[2]) * uu0[2], silu_f(gg0[3]) * uu0[3]);
                w.y = pk4_fp8(silu_f(gg1[0]) * uu1[0], silu_f(gg1[1]) * uu1[1], silu_f(gg1[2]) * uu1[2], silu_f(gg1[3]) * uu1[3]);
                *(u32x2*)rowp = w; }
    }
};
struct EpiResBf16 {
    static constexpr bool PERM = true;
    const bf16* base; bf16* out; int ldc; float alpha; float sc = 1.f;
    __device__ __forceinline__ void operator()(const f32x4 (&acc)[2][2][4][2], const Unit& u, int wr, int wc, int fr, int fq) const {
        const int row0 = u.pm * BM + wr * 64 + fr, col0 = u.pn * BM + wc * 32 + 8 * fq;
#pragma unroll
        for (int ai = 0; ai < 2; ++ai)
#pragma unroll
            for (int m = 0; m < 4; ++m) { const size_t off = (size_t)(row0 + ai * HALF + m * 16) * ldc + col0;
#pragma unroll
                for (int bj = 0; bj < 2; ++bj) { const u32x4 b = *(const u32x4*)(base + off + bj * HALF); const f32x4 a0 = acc[ai][bj][m][0] * sc, a1 = acc[ai][bj][m][1] * sc;
                    u32x4 w; w.x = cvt_pk_bf16(__builtin_bit_cast(float, b.x << 16) * alpha + a0[0], __builtin_bit_cast(float, b.x & 0xffff0000u) * alpha + a0[1]);
                    w.y = cvt_pk_bf16(__builtin_bit_cast(float, b.y << 16) * alpha + a0[2], __builtin_bit_cast(float, b.y & 0xffff0000u) * alpha + a0[3]);
                    w.z = cvt_pk_bf16(__builtin_bit_cast(float, b.z << 16) * alpha + a1[0], __builtin_bit_cast(float, b.z & 0xffff0000u) * alpha + a1[1]);
                    w.w = cvt_pk_bf16(__builtin_bit_cast(float, b.w << 16) * alpha + a1[2], __builtin_bit_cast(float, b.w & 0xffff0000u) * alpha + a1[3]);
                    *(u32x4*)(out + off + bj * HALF) = w; }
                asm volatile("" ::: "memory"); }
    }
};

template <class Epi, class Sched, bool ALIGN_EPI = true, int FP8 = 0>
__device__ __forceinline__ void gemm_phase(LAS unsigned char* lds, const int wave_s, const Gemm g, const Sched& S, const Epi& E) {
    int tid = wave_s * 64 + (int)__builtin_amdgcn_mbcnt_hi(~0u, __builtin_amdgcn_mbcnt_lo(~0u, 0u)); asm volatile("" : "+v"(tid));
    const int wid = __builtin_amdgcn_readfirstlane(tid >> 6), lane = tid & 63, wr = wid >> 2, wc = wid & 3, fr = lane & 15, fq = lane >> 4;
    const int K = g.K, nt = K / BK;
    unsigned voffA[2], voffB[2];
#pragma unroll
    for (int i = 0; i < 2; ++i) { int R, C; stage_rc(tid * 16 + i * 8192, R, C); const int Rb = Epi::PERM ? ((R & ~31) + perm32(R & 31)) : R;
        voffA[i] = (unsigned)(R * g.rsA * K + C) * 2u; voffB[i] = (unsigned)(Rb * g.rsB * K + C) * 2u; }
    const unsigned kstep = (unsigned)(BK * 2);
    const unsigned hstepA = (unsigned)g.hstepA, hstepB = (unsigned)g.hstepB;
    const __amdgpu_buffer_rsrc_t rsrcA = __builtin_amdgcn_make_buffer_rsrc((void*)S.A0, 0, 0x7fffffff, 0x00020000), rsrcB = __builtin_amdgcn_make_buffer_rsrc((void*)S.B0, 0, 0x7fffffff, 0x00020000);
    const unsigned ldsw = (unsigned)wid * 1024u;
    const int aoff = lds_byte(wr * 64 + fr, fq * 8), boff = lds_byte(wc * 32 + fr, fq * 8);
    const int aoff8 = lds_byte(wr * 64 + fr, fq * 16), boff8 = lds_byte(wc * 32 + fr, fq * 16);
    unsigned bbase8_ = (unsigned)(4 * HTB + boff); asm volatile("" : "+v"(bbase8_));
    LAS unsigned char* const ldsB8 = lds + bbase8_;
#define PG8_SA(b, h) (((b) * 2 + (h)) * HTB)
#define PG8_SB(b, h) ((4 + (b) * 2 + (h)) * HTB)
#define PG8_STAGE(bufoff, gbase, voff) do { _Pragma("unroll") for (int _i = 0; _i < 2; ++_i) \
        __builtin_amdgcn_raw_ptr_buffer_load_lds(PG8_RS_##voff, (LAS unsigned*)(lds + (bufoff) + ldsw + _i * 8192), 16, (int)(voff)[_i], (int)(gbase), 0, 0); } while (0)
#define PG8_RS_voffA rsrcA
#define PG8_RS_voffB rsrcB
#define PG8_LD16(off) (*(const LAS bf16x8*)(lds + (off)))
#define PG8_CAT8(lo, hi) __builtin_shufflevector(__builtin_bit_cast(v4i_t, lo), __builtin_bit_cast(v4i_t, hi), 0, 1, 2, 3, 4, 5, 6, 7)
#define PG8_LDA(dst, b, h) do { if constexpr (FP8) { _Pragma("unroll") for (int m = 0; m < 4; ++m) dst##8[m] = PG8_CAT8(PG8_LD16(PG8_SA(b, h) + aoff + m * 2048), PG8_LD16(PG8_SA(b, h) + aoff + m * 2048 + 1024)); } \
        else { _Pragma("unroll") for (int m = 0; m < 4; ++m) _Pragma("unroll") for (int k = 0; k < 2; ++k) dst[m][k] = PG8_LD16(PG8_SA(b, h) + aoff + m * 2048 + k * 1024); } } while (0)
#define PG8_LDB(dst, b, h) do { if constexpr (FP8) { _Pragma("unroll") for (int n = 0; n < 2; ++n) dst##8[n] = PG8_CAT8(*(const LAS bf16x8*)(ldsB8 + ((b) * 2 + (h)) * HTB + n * 2048), *(const LAS bf16x8*)(ldsB8 + ((b) * 2 + (h)) * HTB + n * 2048 + 1024)); } \
        else { _Pragma("unroll") for (int n = 0; n < 2; ++n) _Pragma("unroll") for (int k = 0; k < 2; ++k) dst[n][k] = PG8_LD16(PG8_SB(b, h) + boff + n * 2048 + k * 1024); } } while (0)
#define PG8_MMA(ai, bj, At, Bt) do { __builtin_amdgcn_s_setprio(1); \
        if constexpr (FP8) { _Pragma("unroll") for (int m = 0; m < 4; ++m) _Pragma("unroll") for (int n = 0; n < 2; ++n) \
            acc[ai][bj][m][n] = __builtin_amdgcn_mfma_scale_f32_16x16x128_f8f6f4(Bt##8[n], At##8[m], acc[ai][bj][m][n], 0, 0, 0, 0, 0, 0); } \
        else { _Pragma("unroll") for (int m = 0; m < 4; ++m) _Pragma("unroll") for (int n = 0; n < 2; ++n) _Pragma("unroll") for (int k = 0; k < 2; ++k) \
            acc[ai][bj][m][n] = __builtin_amdgcn_mfma_f32_16x16x32_bf16(Bt[n][k], At[m][k], acc[ai][bj][m][n], 0, 0, 0); } \
        __builtin_amdgcn_s_setprio(0); } while (0)
#define PG8_WAIT_V(n) asm volatile("s_waitcnt vmcnt(" #n ")" ::: "memory")
#define PG8_WAIT_L(n) asm volatile("s_waitcnt lgkmcnt(" #n ")" ::: "memory")
#define PG8_BAR __builtin_amdgcn_s_barrier()
#define PG8_SCHED __builtin_amdgcn_sched_barrier(0)
    Unit cur, nxt; int ui = 0;
    if (!S.next(0, cur)) return;
    f32x4 acc[2][2][4][2];
#pragma unroll
    for (int a = 0; a < 2; ++a)
#pragma unroll
        for (int b = 0; b < 2; ++b)
#pragma unroll
            for (int m = 0; m < 4; ++m)
#pragma unroll
                for (int n = 0; n < 2; ++n) acc[a][b][m][n] = (f32x4){0.f, 0.f, 0.f, 0.f};
    bf16x8 At[4][2], B0[2][2], B1[2][2]; v8i_t At8[4], B08[2], B18[2];
    unsigned cA = cur.a, cB = cur.b;
    PG8_STAGE(PG8_SB(0, 0), cB, voffB); PG8_STAGE(PG8_SB(0, 1), cB + hstepB, voffB); PG8_STAGE(PG8_SA(0, 0), cA, voffA); PG8_STAGE(PG8_SA(0, 1), cA + hstepA, voffA);
    if (wr == 1) PG8_BAR;
    PG8_WAIT_V(2); PG8_BAR;
    PG8_STAGE(PG8_SB(1, 0), cB + kstep, voffB); PG8_STAGE(PG8_SA(1, 0), cA + kstep, voffA); PG8_STAGE(PG8_SB(1, 1), cB + hstepB + kstep, voffB);
    PG8_WAIT_V(6); PG8_BAR;
    for (;;) {
        const bool has_next = S.next(ui + 1, nxt);
        const unsigned nA = has_next ? nxt.a : cA, nB = has_next ? nxt.b : cB;
#pragma clang loop unroll(disable)
        for (int t = 0; t < nt; t += 2) {
            const bool last = (t == nt - 2);
            const unsigned a1 = cA + (unsigned)(t + 1) * kstep;
            const unsigned a2 = last ? nA : cA + (unsigned)(t + 2) * kstep, b2 = last ? nB : cB + (unsigned)(t + 2) * kstep;
            const unsigned a3 = a2 + kstep, b3 = b2 + kstep;
            PG8_LDB(B0, 0, 0); PG8_LDB(B1, 0, 1); PG8_SCHED; PG8_LDA(At, 0, 0); PG8_STAGE(PG8_SA(1, 1), a1 + hstepA, voffA);
            PG8_WAIT_V(8); PG8_WAIT_L(0); PG8_BAR; PG8_MMA(0, 0, At, B0); PG8_MMA(0, 1, At, B1); PG8_BAR; PG8_SCHED;
            PG8_LDA(At, 0, 1); PG8_STAGE(PG8_SB(0, 0), b2, voffB); PG8_STAGE(PG8_SB(0, 1), b2 + hstepB, voffB); PG8_STAGE(PG8_SA(0, 0), a2, voffA);
            PG8_WAIT_V(8); PG8_WAIT_L(0); PG8_BAR; PG8_MMA(1, 0, At, B0); PG8_MMA(1, 1, At, B1); PG8_BAR; PG8_SCHED;
            PG8_LDB(B0, 1, 0); PG8_LDB(B1, 1, 1); PG8_SCHED; PG8_LDA(At, 1, 0); PG8_STAGE(PG8_SA(0, 1), a2 + hstepA, voffA);
            PG8_WAIT_V(8); PG8_WAIT_L(0); PG8_BAR; PG8_MMA(0, 0, At, B0); PG8_MMA(0, 1, At, B1); PG8_BAR; PG8_SCHED;
            PG8_LDA(At, 1, 1); PG8_STAGE(PG8_SB(1, 0), b3, voffB); PG8_STAGE(PG8_SB(1, 1), b3 + hstepB, voffB); PG8_STAGE(PG8_SA(1, 0), a3, voffA);
            PG8_WAIT_V(8); PG8_WAIT_L(0); PG8_BAR; PG8_MMA(1, 0, At, B0); PG8_MMA(1, 1, At, B1); PG8_BAR; PG8_SCHED;
        }
        if constexpr (ALIGN_EPI) { if (wr == 0) PG8_BAR; }
        E(acc, cur, wr, wc, fr, fq);
        if (!has_next) break;
#pragma unroll
        for (int a = 0; a < 2; ++a)
#pragma unroll
            for (int b = 0; b < 2; ++b)
#pragma unroll
                for (int m = 0; m < 4; ++m)
#pragma unroll
                    for (int n = 0; n < 2; ++n) acc[a][b][m][n] = (f32x4){0.f, 0.f, 0.f, 0.f};
        cur = nxt; cA = nA; cB = nB; ++ui;
        if constexpr (ALIGN_EPI) { if (wr == 1) PG8_BAR; }
    }
    PG8_WAIT_V(0);
    if constexpr (!ALIGN_EPI) { if (wr == 0) PG8_BAR; }
    PG8_BAR;
#undef PG8_SA
#undef PG8_SB
#undef PG8_STAGE
#undef PG8_RS_voffA
#undef PG8_RS_voffB
#undef PG8_LDA
#undef PG8_LD16
#undef PG8_CAT8
#undef PG8_LDB
#undef PG8_MMA
#undef PG8_WAIT_V
#undef PG8_WAIT_L
#undef PG8_BAR
#undef PG8_SCHED
}
}

#define RLX_AGENT __ATOMIC_RELAXED, __HIP_MEMORY_SCOPE_AGENT
#define LDS_WAIT() asm volatile("s_waitcnt lgkmcnt(0)" ::: "memory")
#define VM_WAIT() asm volatile("s_waitcnt vmcnt(0)" ::: "memory")
__device__ __forceinline__ unsigned f2bf(float f) { unsigned u = __builtin_bit_cast(unsigned, f); return (u + 0x7fffu + ((u >> 16) & 1u)) >> 16; }
__device__ __forceinline__ unsigned pk2(float lo, float hi) { return pg8::cvt_pk_bf16(lo, hi); }
__device__ __forceinline__ float bflo(unsigned w) { return __builtin_bit_cast(float, w << 16); }
__device__ __forceinline__ float bfhi(unsigned w) { return __builtin_bit_cast(float, w & 0xffff0000u); }
__device__ __forceinline__ float wave_sum(float v) {
#pragma unroll
    for (int o = 1; o < 64; o <<= 1) v += __shfl_xor(v, o);
    return v;
}

#define XB_TMO      128
#define XB_XCNT(j)  (256  + 64 * (j))
#define XB_XSUB(j)  (1280 + 64 * (j))
#define XB_XGEN(j)  (2304 + 64 * (j))
#define XB_TOP      3328
#define XB_TOPGEN   3392
#define XCD_BAR_WORDS 3456
#define XB_SPIN_CAP (1u << 22)
__device__ __forceinline__ unsigned xb_ld(unsigned* p)              { return __hip_atomic_load(p, __ATOMIC_RELAXED, __HIP_MEMORY_SCOPE_AGENT); }
__device__ __forceinline__ unsigned xb_add(unsigned* p, unsigned v) { return __hip_atomic_fetch_add(p, v, __ATOMIC_RELAXED, __HIP_MEMORY_SCOPE_AGENT); }
__device__ __forceinline__ unsigned xb_xcc_id() { return (unsigned)__builtin_amdgcn_s_getreg((3 << 11) | 20) & 0xFu; }
#define XB_SPIN(cond, bar) do { unsigned _sp = 0; while (cond) { __builtin_amdgcn_s_sleep(1); \
    if ((++_sp & 255u) == 0u) { if (xb_ld(&(bar)[XB_TMO])) break; if (_sp > XB_SPIN_CAP) { atomicAdd(&(bar)[XB_TMO], 1u); break; } } } } while (0)
struct XcdBarrier { unsigned* bar; unsigned x; volatile LAS unsigned* st; };
__device__ __forceinline__ XcdBarrier xcd_barrier_post(unsigned* bar, volatile LAS unsigned* st) {
    XcdBarrier b; b.bar = bar; b.x = xb_xcc_id(); b.st = st;
    if (threadIdx.x == 0) (void)xb_add(&bar[XB_XCNT(b.x)], 1u);
    return b;
}
__device__ __forceinline__ void xcd_barrier_complete(unsigned* bar, unsigned x, unsigned& nloc, unsigned& nx) {
    const unsigned G = gridDim.x * gridDim.y * gridDim.z;
    unsigned sum, cnt, mine, sp = 0u;
    for (;;) {
        sum = 0u; cnt = 0u; mine = 0u;
#pragma unroll
        for (unsigned j = 0; j < 16; ++j) { const unsigned c = xb_ld(&bar[XB_XCNT(j)]); sum += c; cnt += (c > 0u) ? 1u : 0u; mine = (j == x) ? c : mine; }
        if (sum == G) break;
        __builtin_amdgcn_s_sleep(1);
        if ((++sp & 255u) == 0u) { if (xb_ld(&bar[XB_TMO])) break; if (sp > XB_SPIN_CAP) { atomicAdd(&bar[XB_TMO], 1u); break; } }
    }
    nloc = mine > 0u ? mine : 1u; nx = cnt > 0u ? cnt : 1u;
}
__device__ __forceinline__ void xcd_barrier(const XcdBarrier& b, const int tid) {
    asm volatile("s_waitcnt vmcnt(0)" ::: "memory");
    __syncthreads();
    if (tid == 0) {
        unsigned* bar = b.bar;
        __builtin_amdgcn_s_waitcnt(0);
        unsigned nloc = b.st[0], nx = b.st[1];
        if (nloc == 0u) { xcd_barrier_complete(bar, b.x, nloc, nx); b.st[0] = nloc; b.st[1] = nx; }
        const unsigned old = xb_add(&bar[XB_XSUB(b.x)], 1u);
        const unsigned gen = old / nloc;
        if (old + 1u == (gen + 1u) * nloc) {
            __builtin_amdgcn_fence(__ATOMIC_RELEASE, "agent");
            asm volatile("s_waitcnt vmcnt(0)" ::: "memory");
            const unsigned og = xb_add(&bar[XB_TOP], 1u);
            const unsigned tg = og / nx;
            if (og + 1u == (tg + 1u) * nx) xb_add(&bar[XB_TOPGEN], 1u);
            else XB_SPIN(xb_ld(&bar[XB_TOPGEN]) == tg, bar);
            __builtin_amdgcn_fence(__ATOMIC_ACQUIRE, "agent");
            xb_add(&bar[XB_XGEN(b.x)], 1u);
            asm volatile("s_waitcnt vmcnt(0)" ::: "memory");
        } else {
            XB_SPIN(xb_ld(&bar[XB_XGEN(b.x)]) == gen, bar);
            __builtin_amdgcn_fence(__ATOMIC_ACQUIRE, "agent");
            asm volatile("s_waitcnt vmcnt(0)" ::: "memory");
        }
    }
    __syncthreads();
}

constexpr int NWAVES = 8;
constexpr int RING_BYTES = 131072, MISC_OFF = RING_BYTES + 320, LDS_BYTES = 147456;
struct Args { const float* in[24]; float* out; unsigned char* ws; int ph_lo, ph_hi; int chk, pad; };
struct Frame {
    LAS unsigned char* lds;
    gu32* ctl; unsigned char* ws; float* out;
    int tid, lane, wave, vcu, G;
    int chk, stage;
};

struct Job { const float* src; bf16* dst; int ld, K, N, mode, start; float scale; int fp8, pad; };
constexpr int NJOBS = 74;
__device__ __forceinline__ void make_job(const Args& a, int j, Job& J) {
    unsigned char* ws = a.ws; J.scale = 1.f; J.mode = 0; J.start = 0; J.fp8 = 0; J.pad = 0;
    if (j < 9) { const int g = j / 3, t = j % 3; J.src = a.in[4] + g * 3072 + t * 1024; J.ld = 9216; J.K = 1024; J.N = 1024;
        if (t == 2) J.dst = (bf16*)(ws + W_A_V + (size_t)g * 1024 * 1024); else J.dst = (bf16*)(ws + W_A_QK + (size_t)g * 2048 * 1024 + (size_t)t * 1024 * 1024);
        J.fp8 = 1; J.scale = (t == 0 ? QSCALE : 1.f) * WSCALE8; return; }
    j -= 9;
    if (j == 0) { J.src = a.in[5]; J.ld = 1024; J.K = 1024; J.N = 1024; J.dst = (bf16*)(ws + W_A_O); J.fp8 = 1; J.scale = WSCALE8; return; }
    if (j == 1) { J.src = a.in[6]; J.ld = 3072; J.K = 1024; J.N = 1024; J.dst = (bf16*)(ws + W_B_IN); return; }
    if (j == 9 || j == 10) { J.src = a.in[6] + 1024 * (j - 8); J.ld = 3072; J.K = 1024; J.N = 1024; J.dst = (bf16*)(ws + W_B_IN) + (size_t)1024 * 1024; J.mode = j - 8; return; }
    if (j == 2) { J.src = a.in[8]; J.ld = 1024; J.K = 1024; J.N = 1024; J.dst = (bf16*)(ws + W_B_O); return; }
    if (j == 3) { J.src = a.in[9]; J.ld = 3072; J.K = 1024; J.N = 1024; J.dst = (bf16*)(ws + W_C_QK); J.scale = QSCALE; return; }
    if (j == 4) { J.src = a.in[9] + 1024; J.ld = 3072; J.K = 1024; J.N = 1024; J.dst = (bf16*)(ws + W_C_QK) + (size_t)1024 * 1024; return; }
    if (j == 5) { J.src = a.in[9] + 2048; J.ld = 3072; J.K = 1024; J.N = 1024; J.dst = (bf16*)(ws + W_C_V); return; }
    if (j == 6) { J.src = a.in[10]; J.ld = 1024; J.K = 1024; J.N = 1024; J.dst = (bf16*)(ws + W_C_O); J.fp8 = 1; J.scale = WSCALE8; return; }
    if (j == 7) { J.src = a.in[11]; J.ld = 2048; J.K = 1024; J.N = 2048; J.dst = (bf16*)(ws + W_D_IN); return; }
    if (j == 8) { J.src = a.in[16]; J.ld = 1024; J.K = 1024; J.N = 1024; J.dst = (bf16*)(ws + W_D_O); return; }
    j -= 11;
    if (j < 6) { const int f = j / 3, t = j % 3;
        if (t < 2) { J.src = a.in[17 + t] + (size_t)f * 1024 * DFF; J.ld = DFF; J.K = 1024; J.N = DFF; J.dst = (bf16*)(ws + W_F_GU) + (size_t)f * 2 * DFF * 1024; J.mode = 1 + t;
            if (f == FFN_GU8) { J.fp8 = 1; J.scale = WSCALE8; } }
        else { J.src = a.in[19] + (size_t)f * DFF * 1024; J.ld = 1024; J.K = DFF; J.N = 1024; J.dst = (bf16*)(ws + W_F_D) + (size_t)f * 1024 * DFF; J.fp8 = 1; J.scale = WSCALE8D; }
        return; }
    j -= 6;
    { const int fe = j / 3, t = j % 3;
        if (t < 2) { J.src = a.in[21 + t] + (size_t)fe * 1024 * DFE; J.ld = DFE; J.K = 1024; J.N = DFE; J.dst = (bf16*)(ws + W_E_GU) + (size_t)fe * 2 * DFE * 1024; J.mode = 1 + t; J.fp8 = 1; J.scale = WSCALE8; }
        else { J.src = a.in[23] + (size_t)fe * DFE * 1024; J.ld = 1024; J.K = DFE; J.N = 1024; J.dst = (bf16*)(ws + W_E_D) + (size_t)fe * 1024 * DFE; J.fp8 = 1; J.scale = WSCALE8D; } }
}
__device__ __forceinline__ void transpose_item(const Job& J, int item, int lane) {
    const int nblk = J.N >> 6, kb = item / nblk, nb = item - kb * nblk, k0 = 64 * kb, n = 64 * nb + lane;
    const float* W = J.src + (size_t)k0 * J.ld + n;
    int r = n; if (J.mode) r = (n >> 7) * 256 + (n & 127) + (J.mode == 2 ? 128 : 0);
    const float sc = J.scale; const size_t ld = (size_t)J.ld;
    if (J.fp8) {
        unsigned char* dst8 = (unsigned char*)J.dst + (size_t)r * J.K + k0;
#pragma unroll
        for (int hf = 0; hf < 2; ++hf) {
            float v[32];
#pragma unroll
            for (int j = 0; j < 32; ++j) v[j] = W[(size_t)(32 * hf + j) * ld];
#pragma unroll
            for (int c = 0; c < 2; ++c) { u32x4 o; o.x = pk4_fp8(v[16 * c] * sc, v[16 * c + 1] * sc, v[16 * c + 2] * sc, v[16 * c + 3] * sc); o.y = pk4_fp8(v[16 * c + 4] * sc, v[16 * c + 5] * sc, v[16 * c + 6] * sc, v[16 * c + 7] * sc);
                o.z = pk4_fp8(v[16 * c + 8] * sc, v[16 * c + 9] * sc, v[16 * c + 10] * sc, v[16 * c + 11] * sc); o.w = pk4_fp8(v[16 * c + 12] * sc, v[16 * c + 13] * sc, v[16 * c + 14] * sc, v[16 * c + 15] * sc);
                *(u32x4*)(dst8 + 32 * hf + 16 * c) = o; }
        }
        return;
    }
    bf16* dst = J.dst + (size_t)r * J.K + k0;
#pragma unroll
    for (int hf = 0; hf < 2; ++hf) {
        float v[32];
#pragma unroll
        for (int j = 0; j < 32; ++j) v[j] = W[(size_t)(32 * hf + j) * ld];
#pragma unroll
        for (int c = 0; c < 4; ++c) { u32x4 o; o.x = pk2(v[8 * c] * sc, v[8 * c + 1] * sc); o.y = pk2(v[8 * c + 2] * sc, v[8 * c + 3] * sc); o.z = pk2(v[8 * c + 4] * sc, v[8 * c + 5] * sc); o.w = pk2(v[8 * c + 6] * sc, v[8 * c + 7] * sc);
            *(u32x4*)(dst + 32 * hf + 8 * c) = o; }
    }
}
__device__ __forceinline__ int t5_bucket(int d) {
    if (d < 16) return d;
    int b = 16 + (int)(log((double)d / 16.0) / log(128.0) * 16.0);
    return b < 16 ? 16 : (b > 31 ? 31 : b);
}
__device__ __forceinline__ void p_prologue(Frame& F, const Args& a) {
    unsigned char* gl_ = (unsigned char*)F.lds;
    Job* jobs = (Job*)(gl_ + 7 * 16384 + 8704);
    int* tot = (int*)(gl_ + 7 * 16384 + 8704 + NJOBS * sizeof(Job));
    static_assert(8704 + NJOBS * sizeof(Job) + 16 <= 16384, "job table fits");
    if (F.tid < NJOBS) { Job J; make_job(a, F.tid, J); jobs[F.tid] = J; }
    __syncthreads();
    if (F.tid == 0) { int s = 0; for (int j = 0; j < NJOBS; ++j) { jobs[j].start = s; s += (jobs[j].K / 64) * (jobs[j].N / 64); } tot[0] = s; }
    __syncthreads();
    const int total = tot[0];
    const int gw = F.vcu * NWAVES + F.wave, NGW = F.G * NWAVES;
    int jc = 0;
    for (int it = gw; it < total; it += NGW) {
        while (jc + 1 < NJOBS && jobs[jc + 1].start <= it) ++jc;
        const Job J = jobs[jc];
        transpose_item(J, it - J.start, F.lane);
    }
    { bf16* hb = (bf16*)(F.ws + WS_HB); const float* x = a.in[0]; unsigned char* hb8 = F.ws + WS_SCR + S_HB8;
      for (int m0 = 4 * gw; m0 < T; m0 += 4 * NGW) { f32x4 v[4][4];
#pragma unroll
          for (int k = 0; k < 4; ++k) { const f32x4* xr = (const f32x4*)(x + (size_t)(m0 + k) * D) + F.lane;
#pragma unroll
              for (int j = 0; j < 4; ++j) v[k][j] = xr[64 * j]; }
#pragma unroll
          for (int k = 0; k < 4; ++k) { unsigned long long* o8 = (unsigned long long*)(hb + (size_t)(m0 + k) * D) + F.lane;
#pragma unroll
              for (int j = 0; j < 4; ++j) o8[64 * j] = (unsigned long long)pk2(v[k][j].x, v[k][j].y) | ((unsigned long long)pk2(v[k][j].z, v[k][j].w) << 32);
              unsigned* o4 = (unsigned*)(hb8 + (size_t)(m0 + k) * D) + F.lane;
#pragma unroll
              for (int j = 0; j < 4; ++j) o4[64 * j] = pk4_fp8(v[k][j].x, v[k][j].y, v[k][j].z, v[k][j].w); } } }
    const int gt = blockIdx.x * 512 + F.tid, NGT = F.G * 512;
    const float* rel = a.in[1];
    float* btA = (float*)(F.ws + WS_BTABA); float* btC = (float*)(F.ws + WS_BTABC);
    for (int i = gt; i < 48 * 132; i += NGT) { const int gh = i / 132, dl = i % 132, g = gh >> 4, hh = gh & 15; const int dil = g == 0 ? 1 : (g == 1 ? 4 : 16);
        btA[i] = dl <= 128 ? rel[t5_bucket(dl * dil) * NH + hh] * LOG2E : 0.f; }
    for (int i = gt; i < 16 * 2048; i += NGT) { const int hh = i >> 11, dd = i & 2047; btC[i] = rel[t5_bucket(dd) * NH + hh] * LOG2E; }
    { bf16* wst = (bf16*)(F.ws + WS_WST); const float* wsrc = a.in[14];
      for (int i = gt; i < 8 * 128 * 128; i += NGT) { const int tt = (i >> 7) & 127, ss = i & 127; wst[i] = (bf16)f2bf(ss <= tt ? wsrc[i] : 0.f); } }
}

__device__ __forceinline__ void unpack8(const u32x4 a, float* x) { x[0] = bflo(a.x); x[1] = bfhi(a.x); x[2] = bflo(a.y); x[3] = bfhi(a.y); x[4] = bflo(a.z); x[5] = bfhi(a.z); x[6] = bflo(a.w); x[7] = bfhi(a.w); }
template <int MODE, bool ROUTE, bool FINAL, bool HB8 = false>
__device__ __forceinline__ void ln_phase(Frame& F, const float* gain, const float* bias, const float* wr) {
    constexpr int NBT = 2;
    const int gw = F.vcu * NWAVES + F.wave, NGW = F.G * NWAVES, lane = F.lane;
    bf16* hb = (bf16*)(F.ws + WS_HB); const bf16* zb = (const bf16*)F.out;
    float gv[16], bv[16];
#pragma unroll
    for (int k = 0; k < 2; ++k)
#pragma unroll
        for (int j = 0; j < 2; ++j) { const f32x4 g4 = *(const f32x4*)(gain + 512 * k + 8 * lane + 4 * j), b4 = *(const f32x4*)(bias + 512 * k + 8 * lane + 4 * j);
            gv[8 * k + 4 * j] = g4.x; gv[8 * k + 4 * j + 1] = g4.y; gv[8 * k + 4 * j + 2] = g4.z; gv[8 * k + 4 * j + 3] = g4.w;
            bv[8 * k + 4 * j] = b4.x; bv[8 * k + 4 * j + 1] = b4.y; bv[8 * k + 4 * j + 2] = b4.z; bv[8 * k + 4 * j + 3] = b4.w; }
    LAS float* wrT = (LAS float*)F.lds;
    if (ROUTE) { for (int i = F.tid; i < 8 * 1024; i += 512) { const int e = i >> 10, c = i & 1023; wrT[i] = wr[c * 8 + e]; } __syncthreads(); }
    const bf16* ys = (const bf16*)(F.ws + WS_SCR + S_XG);
    const int* slots = (const int*)(F.ws + WS_SLOTS); const float* gates = (const float*)(F.ws + WS_GATES);
    int* route = (int*)(F.ws + WS_ROUTE); float* gout = (float*)(F.ws + WS_GATES);
    for (int grp = gw; grp < T / 32; grp += NGW) {
        int cnt_e = 0;
        int my_e1 = 0, my_e2 = 0, my_r1 = 0, my_r2 = 0; float my_g1 = 0.f, my_g2 = 0.f;
        int sl0 = 0, sl1 = 0; float gg0 = 0.f, gg1 = 0.f;
        if (MODE == 2) { const int mm = grp * 32 + (lane & 31); sl0 = slots[2 * mm]; sl1 = slots[2 * mm + 1]; gg0 = gates[2 * mm]; gg1 = gates[2 * mm + 1]; }
        for (int i0 = 0; i0 < 32; i0 += NBT) {
            float v[NBT][16]; float st[NBT][2];
#pragma unroll
            for (int k = 0; k < NBT; ++k) { const int m = grp * 32 + i0 + k;
                if (MODE == 0) { const u32x4* zr = (const u32x4*)(zb + (size_t)m * D) + lane; unpack8(zr[0], v[k]); unpack8(zr[64], v[k] + 8); }
                else { const u32x4* hr = (const u32x4*)(hb + (size_t)m * D) + lane; unpack8(hr[0], v[k]); unpack8(hr[64], v[k] + 8);
#pragma unroll
                    for (int j = 0; j < 16; ++j) v[k][j] *= ALPHA;
                    if (MODE == 3) { const u32x4* yr = (const u32x4*)((const bf16*)(F.ws + WS_SCR + S_Y) + (size_t)m * D) + lane; float a[16]; unpack8(yr[0], a); unpack8(yr[64], a + 8);
#pragma unroll
                        for (int j = 0; j < 16; ++j) v[k][j] += a[j]; }
                    if (MODE == 2) { const int s0 = __builtin_amdgcn_readlane(sl0, i0 + k), s1 = __builtin_amdgcn_readlane(sl1, i0 + k);
                        const float g0 = __builtin_bit_cast(float, __builtin_amdgcn_readlane(__builtin_bit_cast(int, gg0), i0 + k)), g1 = __builtin_bit_cast(float, __builtin_amdgcn_readlane(__builtin_bit_cast(int, gg1), i0 + k));
                        const u32x4* y0 = (const u32x4*)(ys + (size_t)s0 * D) + lane; const u32x4* y1 = (const u32x4*)(ys + (size_t)s1 * D) + lane;
                        float a[16], b[16]; unpack8(y0[0], a); unpack8(y0[64], a + 8); unpack8(y1[0], b); unpack8(y1[64], b + 8);
#pragma unroll
                        for (int j = 0; j < 16; ++j) v[k][j] += g0 * a[j] + g1 * b[j]; } }
                float s = 0.f, q2 = 0.f;
#pragma unroll
                for (int j = 0; j < 16; ++j) { s += v[k][j]; q2 += v[k][j] * v[k][j]; }
                st[k][0] = s; st[k][1] = q2; }
#pragma unroll
            for (int o = 1; o < 64; o <<= 1) {
#pragma unroll
                for (int k = 0; k < NBT; ++k) { st[k][0] += __shfl_xor(st[k][0], o); st[k][1] += __shfl_xor(st[k][1], o); } }
#pragma unroll
            for (int k = 0; k < NBT; ++k) { const int m = grp * 32 + i0 + k;
                const float mean = st[k][0] * (1.f / D), var = fmaxf(st[k][1] * (1.f / D) - mean * mean, 0.f), rstd = 1.f / sqrtf(var + LN_EPS);
#pragma unroll
                for (int j = 0; j < 16; ++j) v[k][j] = (v[k][j] - mean) * rstd * gv[j] + bv[j];
                if (FINAL) { f32x4* orow = (f32x4*)(F.out + (size_t)m * D) + 2 * lane;
                    orow[0] = (f32x4){v[k][0], v[k][1], v[k][2], v[k][3]}; orow[1] = (f32x4){v[k][4], v[k][5], v[k][6], v[k][7]}; orow[128] = (f32x4){v[k][8], v[k][9], v[k][10], v[k][11]}; orow[129] = (f32x4){v[k][12], v[k][13], v[k][14], v[k][15]}; }
                else { u32x4* o = (u32x4*)(hb + (size_t)m * D) + lane; u32x4 a, b;
                    a.x = pk2(v[k][0], v[k][1]); a.y = pk2(v[k][2], v[k][3]); a.z = pk2(v[k][4], v[k][5]); a.w = pk2(v[k][6], v[k][7]); b.x = pk2(v[k][8], v[k][9]); b.y = pk2(v[k][10], v[k][11]); b.z = pk2(v[k][12], v[k][13]); b.w = pk2(v[k][14], v[k][15]);
                    o[0] = a; o[64] = b;
                    if (HB8) { u32x2* o8 = (u32x2*)(F.ws + WS_SCR + S_HB8 + (size_t)m * D) + lane; u32x2 c, d;
                        c.x = pk4_fp8(v[k][0], v[k][1], v[k][2], v[k][3]); c.y = pk4_fp8(v[k][4], v[k][5], v[k][6], v[k][7]); d.x = pk4_fp8(v[k][8], v[k][9], v[k][10], v[k][11]); d.y = pk4_fp8(v[k][12], v[k][13], v[k][14], v[k][15]);
                        o8[0] = c; o8[64] = d; } }
                if (ROUTE) {
                    float lg[8];
#pragma unroll
                    for (int e = 0; e < 8; ++e) { float p = 0.f;
#pragma unroll
                        for (int kk = 0; kk < 2; ++kk)
#pragma unroll
                            for (int j = 0; j < 2; ++j) { const f32x4 w4 = *(const LAS f32x4*)(wrT + e * 1024 + 512 * kk + 8 * lane + 4 * j); p += (v[k][8 * kk + 4 * j] * w4.x + v[k][8 * kk + 4 * j + 1] * w4.y) + (v[k][8 * kk + 4 * j + 2] * w4.z + v[k][8 * kk + 4 * j + 3] * w4.w); }
                        lg[e] = p; }
#pragma unroll
                    for (int o = 1; o < 64; o <<= 1) {
#pragma unroll
                        for (int e = 0; e < 8; ++e) lg[e] += __shfl_xor(lg[e], o); }
                    int e1 = 0; float v1 = lg[0];
#pragma unroll
                    for (int e = 1; e < 8; ++e) if (lg[e] > v1) { v1 = lg[e]; e1 = e; }
                    int e2 = -1; float v2 = -3.4e38f;
#pragma unroll
                    for (int e = 0; e < 8; ++e) if (e != e1 && lg[e] > v2) { v2 = lg[e]; e2 = e; }
                    const float g2 = 1.f / (1.f + __expf(v1 - v2)), g1 = 1.f - g2;
                    const int r1 = __shfl(cnt_e, e1); if (lane == e1) ++cnt_e;
                    const int r2 = __shfl(cnt_e, e2); if (lane == e2) ++cnt_e;
                    if (lane == i0 + k) { my_e1 = e1; my_e2 = e2; my_r1 = r1; my_r2 = r2; my_g1 = g1; my_g2 = g2; }
                }
            }
        }
        if (ROUTE) {
            if (lane < 8) ((int*)(F.ws + WS_WCNT))[grp * 8 + lane] = cnt_e;
            if (lane < 32) { const int m = grp * 32 + lane; int* r = route + 4 * m; r[0] = my_e1; r[1] = my_r1; r[2] = my_e2; r[3] = my_r2; gout[2 * m] = my_g1; gout[2 * m + 1] = my_g2; }
        }
    }
}

__device__ __forceinline__ f32x16 mfma32(bf16x8 a, bf16x8 b, f32x16 c) { return __builtin_amdgcn_mfma_f32_32x32x16_bf16(a, b, c, 0, 0, 0); }
__device__ __forceinline__ bf16x8 pack8(const f32x16& s, int b0) {
    u32x4 w; w.x = pg8::cvt_pk_bf16(s[b0], s[b0 + 1]); w.y = pg8::cvt_pk_bf16(s[b0 + 2], s[b0 + 3]); w.z = pg8::cvt_pk_bf16(s[b0 + 4], s[b0 + 5]); w.w = pg8::cvt_pk_bf16(s[b0 + 6], s[b0 + 7]);
    return __builtin_bit_cast(bf16x8, w);
}
__device__ __forceinline__ float max16(const f32x16& s) {
    float a = fmaxf(fmaxf(s[0], s[1]), fmaxf(s[2], s[3])), b = fmaxf(fmaxf(s[4], s[5]), fmaxf(s[6], s[7]));
    float c = fmaxf(fmaxf(s[8], s[9]), fmaxf(s[10], s[11])), d = fmaxf(fmaxf(s[12], s[13]), fmaxf(s[14], s[15]));
    return fmaxf(fmaxf(a, b), fmaxf(c, d));
}
__device__ __forceinline__ void softmax_pv(f32x16& s, float& m_run, float& l_run, f32x16& o0, f32x16& o1, const bf16* vt0, const bf16* vt1, int h) {
    float mx = max16(s); mx = fmaxf(mx, __shfl_xor(mx, 32));
    const float mn = fmaxf(m_run, mx), alpha = __builtin_amdgcn_exp2f(m_run - mn); m_run = mn;
    float ps = 0.f;
#pragma unroll
    for (int r = 0; r < 16; ++r) { const float p = __builtin_amdgcn_exp2f(s[r] - mn); s[r] = p; ps += p; }
    l_run = l_run * alpha + ps;
#pragma unroll
    for (int r = 0; r < 16; ++r) { o0[r] *= alpha; o1[r] *= alpha; }
    const bf16x8 p0 = pack8(s, 0), p1 = pack8(s, 8);
    const bf16x8 v00 = *(const bf16x8*)(vt0 + 8 * h), v01 = *(const bf16x8*)(vt0 + 16 + 8 * h), v10 = *(const bf16x8*)(vt1 + 8 * h), v11 = *(const bf16x8*)(vt1 + 16 + 8 * h);
    o0 = mfma32(v00, p0, o0); o0 = mfma32(v01, p1, o0);
    o1 = mfma32(v10, p0, o1); o1 = mfma32(v11, p1, o1);
}
__device__ __forceinline__ int kperm(int i) { return (i & 19) | ((i & 8) >> 1) | ((i & 4) << 1); }

__device__ __forceinline__ void dil_attn_phase(Frame& F) {
    LAS float* bt = (LAS float*)F.lds;
    { const float* btA = (const float*)(F.ws + WS_BTABA); for (int i = F.tid; i < 48 * 192; i += 512) { const int gh = i / 192, dl = i % 192 - 32; bt[i] = (dl >= 0 && dl <= 128) ? btA[gh * 132 + dl] : NEGB; } }
    __syncthreads();
    const int gw = F.vcu * NWAVES + F.wave, NGW = F.G * NWAVES, lane = F.lane, q = lane & 31, h = lane >> 5;
    const bf16* QK = (const bf16*)(F.ws + WS_SCR + S_QK); const bf16* VT = (const bf16*)(F.ws + WS_SCR + S_VT);
    bf16* OG = (bf16*)((unsigned char*)F.out + O_OG); float* LSE = (float*)((unsigned char*)F.out + O_LSE);
    constexpr int NTASK = 3 * 16 * 8 * 64;
    const int per = (NTASK + NGW - 1) / NGW;
    const int t_lo = gw * per, t_hi = (t_lo + per) < NTASK ? (t_lo + per) : NTASK;
    for (int task = t_lo; task < t_hi; ++task) {
        const int qt = task & 3, rn = (task >> 2) & 15, bl = (task >> 6) & 7, gh = task >> 9, g = gh >> 4, hh = gh & 15;
        const int nblk = 16 >> (2 * g); const bool has_prev = (rn & (nblk - 1)) != 0;
        const int n0 = bl * 2048 + rn * 128;
        const bf16* qrow = QK + ((size_t)g * TC + n0 + 32 * qt + q) * 2048 + hh * 64;
        bf16x8 qf[4];
#pragma unroll
        for (int d0 = 0; d0 < 4; ++d0) qf[d0] = *(const bf16x8*)(qrow + d0 * 16 + 8 * h);
        float m_run = NEGB, l_run = 0.f; f32x16 o0 = {}, o1 = {};
        const bf16* vbase0 = VT + ((size_t)g * 1024 + hh * 64 + q) * TC; const bf16* vbase1 = vbase0 + (size_t)32 * TC;
        const LAS float* btl = bt + gh * 192 + (q - 8 * h + 137);
#pragma unroll
        for (int t = 0; t < 5; ++t) {
            if (has_prev || qt + t > 3) {
                const int kr0 = n0 - 128 + 32 * qt + 32 * t;
                const bf16* krow = QK + ((size_t)g * TC + kr0 + kperm(q)) * 2048 + 1024 + hh * 64;
                f32x16 s;
#pragma unroll
                for (int r = 0; r < 16; ++r) s[r] = btl[-32 * t + 23 - 16 * (r >> 3) - (r & 7)];
#pragma unroll
                for (int d0 = 0; d0 < 4; ++d0) { const bf16x8 kf = *(const bf16x8*)(krow + d0 * 16 + 8 * h); s = mfma32(kf, qf[d0], s); }
                softmax_pv(s, m_run, l_run, o0, o1, vbase0 + kr0, vbase1 + kr0, h);
            }
        }
        const float l_tot = l_run + __shfl_xor(l_run, 32), inv = 1.f / l_tot;
        const size_t orow = (size_t)g * TC + n0 + 32 * qt + q;
        bf16* op = OG + orow * 1024 + hh * 64 + 4 * h;
#pragma unroll
        for (int gq = 0; gq < 4; ++gq) {
            u32x2 w0, w1; w0.x = pg8::cvt_pk_bf16(o0[4 * gq] * inv, o0[4 * gq + 1] * inv); w0.y = pg8::cvt_pk_bf16(o0[4 * gq + 2] * inv, o0[4 * gq + 3] * inv);
            w1.x = pg8::cvt_pk_bf16(o1[4 * gq] * inv, o1[4 * gq + 1] * inv); w1.y = pg8::cvt_pk_bf16(o1[4 * gq + 2] * inv, o1[4 * gq + 3] * inv);
            *(u32x2*)(op + 8 * gq) = w0; *(u32x2*)(op + 32 + 8 * gq) = w1; }
        if (h == 0) LSE[orow * 16 + hh] = m_run + __log2f(l_tot);
    }
}
__device__ __forceinline__ void dil_merge_phase(Frame& F, int ck) {
    const int gw = F.vcu * NWAVES + F.wave, NGW = F.G * NWAVES, lane = F.lane;
    const bf16* OG = (const bf16*)((unsigned char*)F.out + O_OG); const float* LSE = (const float*)((unsigned char*)F.out + O_LSE);
    unsigned char* att = F.ws + WS_SCR + S_ATT + (size_t)ck * TC * 1024;
    const int hh = lane >> 2;
    for (int tl0 = 2 * gw; tl0 < TC; tl0 += 2 * NGW) {
        size_t n[2][3]; float ls[2][3]; u32x4 x[2][3][2];
#pragma unroll
        for (int k = 0; k < 2; ++k) { const int tl = tl0 + k, bl = tl >> 11, tt = tl & 2047;
            n[k][0] = tl; n[k][1] = bl * 2048 + (tt & 3) * 512 + (tt >> 2); n[k][2] = bl * 2048 + (tt & 15) * 128 + (tt >> 4);
#pragma unroll
            for (int g = 0; g < 3; ++g) { ls[k][g] = LSE[((size_t)g * TC + n[k][g]) * 16 + hh]; const u32x4* p = (const u32x4*)(OG + ((size_t)g * TC + n[k][g]) * 1024 + 16 * lane); x[k][g][0] = p[0]; x[k][g][1] = p[1]; } }
#pragma unroll
        for (int k = 0; k < 2; ++k) {
            const float M = fmaxf(fmaxf(ls[k][0], ls[k][1]), ls[k][2]);
            float w[3]; float W = 0.f;
#pragma unroll
            for (int g = 0; g < 3; ++g) { w[g] = __builtin_amdgcn_exp2f(ls[k][g] - M); W += w[g]; }
            const float iw = 1.f / W;
            float acc[16];
#pragma unroll
            for (int j = 0; j < 16; ++j) acc[j] = 0.f;
#pragma unroll
            for (int g = 0; g < 3; ++g) { const float wg = w[g] * iw; float a[16]; unpack8(x[k][g][0], a); unpack8(x[k][g][1], a + 8);
#pragma unroll
                for (int j = 0; j < 16; ++j) acc[j] += wg * a[j]; }
#pragma unroll
            for (int j = 0; j < 16; ++j) acc[j] *= ASCALE8;
            u32x4 y; y.x = pk4_fp8(acc[0], acc[1], acc[2], acc[3]); y.y = pk4_fp8(acc[4], acc[5], acc[6], acc[7]); y.z = pk4_fp8(acc[8], acc[9], acc[10], acc[11]); y.w = pk4_fp8(acc[12], acc[13], acc[14], acc[15]);
            *(u32x4*)(att + (size_t)(tl0 + k) * 1024 + 16 * lane) = y;
        }
    }
}

__device__ __forceinline__ void conv_phase(Frame& F, const float* cw) {
    const int gw = F.vcu * NWAVES + F.wave, NGW = F.G * NWAVES, lane = F.lane;
    const bf16* gbp = (const bf16*)(F.ws + WS_SCR + S_BCX); const bf16* up = (const bf16*)(F.ws + WS_SCR + S_BCX + (size_t)128 * MiB); bf16* p = (bf16*)(F.ws + WS_SCR + S_P);
    for (int item = gw; item < (T / 32) * 2; item += NGW) {
        const int half = item & 1, tb = item >> 1, t0 = tb * 32, c0 = half * 512 + lane * 8;
        float w0[8], w1[8], w2[8];
#pragma unroll
        for (int j = 0; j < 8; ++j) { w0[j] = cw[c0 + j]; w1[j] = cw[1024 + c0 + j]; w2[j] = cw[2048 + c0 + j]; }
        float u1[8], u2[8];
        const bool first = (t0 & 2047) == 0;
#pragma unroll
        for (int j = 0; j < 8; ++j) { u1[j] = 0.f; u2[j] = 0.f; }
        if (!first) { unpack8(*(const u32x4*)(up + (size_t)(t0 - 2) * 1024 + c0), u2); unpack8(*(const u32x4*)(up + (size_t)(t0 - 1) * 1024 + c0), u1); }
        for (int i = 0; i < 32; ++i) { const size_t r = (size_t)(t0 + i) * 1024;
            const u32x4 gb = *(const u32x4*)(gbp + r + c0), uu = *(const u32x4*)(up + r + c0);
            float u0[8], b[8]; unpack8(uu, u0); unpack8(gb, b);
            float o[8];
#pragma unroll
            for (int j = 0; j < 8; ++j) { o[j] = b[j] * (w0[j] * u2[j] + w1[j] * u1[j] + w2[j] * u0[j]); u2[j] = u1[j]; u1[j] = u0[j]; }
            u32x4 x; x.x = pk2(o[0], o[1]); x.y = pk2(o[2], o[3]); x.z = pk2(o[4], o[5]); x.w = pk2(o[6], o[7]);
            *(u32x4*)(p + (size_t)(t0 + i) * 1024 + c0) = x; }
    }
}

__device__ __forceinline__ void kmean_phase(Frame& F) {
    const int gw = F.vcu * NWAVES + F.wave, NGW = F.G * NWAVES, lane = F.lane;
    const bf16* QK = (const bf16*)(F.ws + WS_SCR + S_CQK); float* km = (float*)(F.ws + WS_KMEAN);
    const int kq = lane >> 3, dc = lane & 7;
    for (int u = gw; u < NB * NH * 8; u += NGW) { const int blk = u & 7, hh = (u >> 3) & 15, b = u >> 7;
        float a[8];
#pragma unroll
        for (int j = 0; j < 8; ++j) a[j] = 0.f;
        const bf16* kp = QK + ((size_t)b * SEQ + blk * 256 + kq) * 2048 + 1024 + hh * 64 + dc * 8;
#pragma unroll 8
        for (int i = 0; i < 32; ++i) { const u32x4 x = *(const u32x4*)(kp + (size_t)i * 8 * 2048);
            a[0] += bflo(x.x); a[1] += bfhi(x.x); a[2] += bflo(x.y); a[3] += bfhi(x.y); a[4] += bflo(x.z); a[5] += bfhi(x.z); a[6] += bflo(x.w); a[7] += bfhi(x.w); }
#pragma unroll
        for (int j = 0; j < 8; ++j) { a[j] += __shfl_xor(a[j], 8); a[j] += __shfl_xor(a[j], 16); a[j] += __shfl_xor(a[j], 32); }
        if (lane < 8) { float* o = km + (size_t)u * 64 + lane * 8;
#pragma unroll
            for (int j = 0; j < 8; ++j) o[j] = a[j] * (1.f / 256.f); }
    }
}
__device__ __forceinline__ void moba_unit(Frame& F, int b, int hh, int nb, LAS float* bt, int& cur_h) {
    const int lane = F.lane, q = lane & 31, h = lane >> 5, w = F.wave;
    const bf16* QK = (const bf16*)(F.ws + WS_SCR + S_CQK); const bf16* VT = (const bf16*)(F.ws + WS_SCR + S_CVT);
    bf16* att = (bf16*)(F.ws + WS_SCR + S_CATT); const float* km = (const float*)(F.ws + WS_KMEAN);
    if (hh != cur_h) { __syncthreads(); const float* btC = (const float*)(F.ws + WS_BTABC) + hh * 2048; for (int i = F.tid; i < 2048; i += 512) bt[i] = btC[i]; cur_h = hh; __syncthreads(); }
    const size_t tq = (size_t)b * SEQ + nb * 256 + 32 * w + q;
    const bf16* qrow = QK + tq * 2048 + hh * 64;
    bf16x8 qf[4];
#pragma unroll
    for (int d0 = 0; d0 < 4; ++d0) qf[d0] = *(const bf16x8*)(qrow + d0 * 16 + 8 * h);
    unsigned sel = 0;
    if (nb > 0) {
        float gsc[7];
#pragma unroll
        for (int m = 0; m < 7; ++m) { float s = 0.f;
            if (m < nb) { const float* kmp = km + (((size_t)b * NH + hh) * 8 + m) * 64;
#pragma unroll
                for (int d0 = 0; d0 < 4; ++d0) { const f32x4 k0 = *(const f32x4*)(kmp + d0 * 16 + 8 * h), k1 = *(const f32x4*)(kmp + d0 * 16 + 8 * h + 4); const u32x4 qq = __builtin_bit_cast(u32x4, qf[d0]);
                    s += bflo(qq.x) * k0.x + bfhi(qq.x) * k0.y + bflo(qq.y) * k0.z + bfhi(qq.y) * k0.w + bflo(qq.z) * k1.x + bfhi(qq.z) * k1.y + bflo(qq.w) * k1.z + bfhi(qq.w) * k1.w; }
                s += __shfl_xor(s, 32); }
            gsc[m] = m < nb ? s : -3.0e38f; }
        const int nsel = nb < 3 ? nb : 3;
#pragma unroll
        for (int r = 0; r < 3; ++r) { if (r < nsel) { int bi = -1; float bv = -3.4e38f;
#pragma unroll
                for (int m = 0; m < 7; ++m) if (!((sel >> m) & 1u) && gsc[m] > bv) { bv = gsc[m]; bi = m; }
                sel |= 1u << bi; } }
    }
#ifdef MK_SELFCHECK
    if (h == 0) ((unsigned*)(F.ws + WS_NEED + 3 * MiB))[tq * 16 + hh] = sel;
#endif
    float m_run = NEGB, l_run = 0.f; f32x16 o0 = {}, o1 = {};
    const bf16* vbase0 = VT + ((size_t)hh * 64 + q) * T + (size_t)b * SEQ; const bf16* vbase1 = vbase0 + (size_t)32 * T;
    const int qpos = nb * 256 + 32 * w + q;
    for (int m = 0; m < nb; ++m) {
        const bool mine = (sel >> m) & 1u;
        if (__ballot(mine) == 0ull) continue;
        for (int kt = 0; kt < 8; ++kt) {
            const int kr0 = m * 256 + 32 * kt;
            const bf16* krow = QK + ((size_t)b * SEQ + kr0 + kperm(q)) * 2048 + 1024 + hh * 64;
            f32x16 s = {};
#pragma unroll
            for (int d0 = 0; d0 < 4; ++d0) { const bf16x8 kf = *(const bf16x8*)(krow + d0 * 16 + 8 * h); s = mfma32(kf, qf[d0], s); }
#pragma unroll
            for (int r = 0; r < 16; ++r) { const int kap = 16 * (r >> 3) + 8 * h + (r & 7); const float bb = bt[qpos - kr0 - kap]; s[r] = mine ? s[r] + bb : NEGB; }
            softmax_pv(s, m_run, l_run, o0, o1, vbase0 + kr0, vbase1 + kr0, h);
        }
    }
    for (int kt = 0; kt <= w; ++kt) {
        const int kr0 = nb * 256 + 32 * kt;
        const bf16* krow = QK + ((size_t)b * SEQ + kr0 + kperm(q)) * 2048 + 1024 + hh * 64;
        f32x16 s = {};
#pragma unroll
        for (int d0 = 0; d0 < 4; ++d0) { const bf16x8 kf = *(const bf16x8*)(krow + d0 * 16 + 8 * h); s = mfma32(kf, qf[d0], s); }
#pragma unroll
        for (int r = 0; r < 16; ++r) { const int kap = 16 * (r >> 3) + 8 * h + (r & 7); const int dd = qpos - kr0 - kap; const float bb = bt[dd < 0 ? 0 : dd]; s[r] = dd >= 0 ? s[r] + bb : NEGB; }
        softmax_pv(s, m_run, l_run, o0, o1, vbase0 + kr0, vbase1 + kr0, h);
    }
    const float l_tot = l_run + __shfl_xor(l_run, 32), inv = 1.f / l_tot;
#ifdef MK_SELFCHECK
    if (h == 0) ((float*)(F.ws + WS_NEED + 7 * MiB))[tq * 16 + hh] = m_run + __log2f(l_tot);
#endif
    bf16* op = att + tq * 1024 + hh * 64 + 4 * h;
#pragma unroll
    for (int gq = 0; gq < 4; ++gq) {
        u32x2 w0, w1; w0.x = pg8::cvt_pk_bf16(o0[4 * gq] * inv, o0[4 * gq + 1] * inv); w0.y = pg8::cvt_pk_bf16(o0[4 * gq + 2] * inv, o0[4 * gq + 3] * inv);
        w1.x = pg8::cvt_pk_bf16(o1[4 * gq] * inv, o1[4 * gq + 1] * inv); w1.y = pg8::cvt_pk_bf16(o1[4 * gq + 2] * inv, o1[4 * gq + 3] * inv);
        *(u32x2*)(op + 8 * gq) = w0; *(u32x2*)(op + 32 + 8 * gq) = w1; }
}
__device__ __forceinline__ void moba_phase(Frame& F) {
    LAS float* bt = (LAS float*)F.lds; int cur_h = -1;
    const int NP = NB * NH * 4, per = (NP + F.G - 1) / F.G;
    const int lo = F.vcu * per, hi = (lo + per) < NP ? (lo + per) : NP;
    for (int pu = lo; pu < hi; ++pu) { const int j = pu & 3, hh = (pu >> 2) & 15, b = pu >> 6;
        moba_unit(F, b, hh, 7 - j, bt, cur_h); moba_unit(F, b, hh, j, bt, cur_h); }
}


constexpr int AKP = 72;
constexpr int ATILE = 64 * AKP * 2;
struct AttnSt { float m, l; f32x16 o0, o1; };
template <bool MASKED>
__device__ __forceinline__ void attn_tile(const LAS bf16* Kt, const LAS bf16* Vt, const LAS float* bl, const bf16x8 (&qf)[4], AttnSt& st, int q, int h, bool mine) {
    f32x16 s;
#pragma unroll
    for (int r = 0; r < 16; ++r) s[r] = bl[23 - 16 * (r >> 3) - (r & 7)];
    const LAS bf16* kr = Kt + kperm(q) * AKP + 8 * h;
#pragma unroll
    for (int d0 = 0; d0 < 4; ++d0) s = mfma32(*(const LAS bf16x8*)(kr + d0 * 16), qf[d0], s);
    float mx = max16(s); mx = fmaxf(mx, __shfl_xor(mx, 32));
    float mn = fmaxf(st.m, mx); if (MASKED) mn = mine ? mn : st.m;
    const float alpha = __builtin_amdgcn_exp2f(st.m - mn);
    float ps = 0.f;
#pragma unroll
    for (int r = 0; r < 16; ++r) { const float p = __builtin_amdgcn_exp2f(s[r] - mn); s[r] = p; ps += p; }
    bf16x8 p0 = pack8(s, 0), p1 = pack8(s, 8);
    if (MASKED) { if (!mine) { p0 = (bf16x8){0, 0, 0, 0, 0, 0, 0, 0}; p1 = p0; ps = 0.f; } }
    st.l = st.l * alpha + ps; st.m = mn;
    if (__ballot(alpha != 1.0f) != 0ull) {
#pragma unroll
        for (int r = 0; r < 16; ++r) { st.o0[r] *= alpha; st.o1[r] *= alpha; } }
    const LAS bf16* v0 = Vt + q * AKP + 8 * h; const LAS bf16* v1 = v0 + 32 * AKP;
    st.o0 = mfma32(*(const LAS bf16x8*)v0, p0, st.o0); st.o0 = mfma32(*(const LAS bf16x8*)(v0 + 16), p1, st.o0);
    st.o1 = mfma32(*(const LAS bf16x8*)v1, p0, st.o1); st.o1 = mfma32(*(const LAS bf16x8*)(v1 + 16), p1, st.o1);
}
__device__ __forceinline__ void attn_store(const AttnSt& st, bf16* op  , float inv) {
#pragma unroll
    for (int gq = 0; gq < 4; ++gq) {
        u32x2 w0, w1; w0.x = pg8::cvt_pk_bf16(st.o0[4 * gq] * inv, st.o0[4 * gq + 1] * inv); w0.y = pg8::cvt_pk_bf16(st.o0[4 * gq + 2] * inv, st.o0[4 * gq + 3] * inv);
        w1.x = pg8::cvt_pk_bf16(st.o1[4 * gq] * inv, st.o1[4 * gq + 1] * inv); w1.y = pg8::cvt_pk_bf16(st.o1[4 * gq + 2] * inv, st.o1[4 * gq + 3] * inv);
        *(u32x2*)(op + 8 * gq) = w0; *(u32x2*)(op + 32 + 8 * gq) = w1; }
}

__device__ __forceinline__ void attn_store8(const AttnSt& st, unsigned char* op  , float inv) {
#pragma unroll
    for (int gq = 0; gq < 4; ++gq) {
        *(unsigned*)(op + 8 * gq) = pk4_fp8(st.o0[4 * gq] * inv, st.o0[4 * gq + 1] * inv, st.o0[4 * gq + 2] * inv, st.o0[4 * gq + 3] * inv);
        *(unsigned*)(op + 32 + 8 * gq) = pk4_fp8(st.o1[4 * gq] * inv, st.o1[4 * gq + 1] * inv, st.o1[4 * gq + 2] * inv, st.o1[4 * gq + 3] * inv); }
}

__device__ __forceinline__ void dil_attn_phase2(Frame& F) {
    LAS float* bt = (LAS float*)F.lds;
    { const float* btA = (const float*)(F.ws + WS_BTABA); for (int i = F.tid; i < 48 * 192; i += 512) { const int gh = i / 192, dl = i % 192 - 32; bt[i] = (dl >= 0 && dl <= 128) ? btA[gh * 132 + dl] : NEGB; } }
    __syncthreads();
    constexpr int TBL = 48 * 192 * 4;
    const int lane = F.lane, q = lane & 31, h = lane >> 5, w = F.wave, uw = w >> 2, qt = w & 3, t = F.tid, tu = t >> 8, tt = t & 255, srow = tt >> 3, sch = tt & 7;
    const bf16* QK = (const bf16*)(F.ws + WS_SCR + S_QK); const bf16* VT = (const bf16*)(F.ws + WS_SCR + S_VT);
    bf16* OG = (bf16*)((unsigned char*)F.out + O_OG); float* LSE = (float*)((unsigned char*)F.out + O_LSE);
    for (int du = F.vcu; du < 3072; du += F.G) {
        const int g = du >> 10, rem = du & 1023, hh = rem >> 6, blp = (rem >> 4) & 3, rn = rem & 15, gh = g * 16 + hh;
        const int nblk = 16 >> (2 * g); const bool has_prev = (rn & (nblk - 1)) != 0;
        const int j0 = has_prev ? 0 : 2;
        const int n0s = (2 * blp + tu) * 2048 + rn * 128;
        const bf16* ksrc = QK + ((size_t)g * TC + n0s - 128 + srow) * 2048 + 1024 + hh * 64 + sch * 8;
        const bf16* vsrc = VT + ((size_t)g * 1024 + hh * 64 + srow) * TC + (n0s - 128) + sch * 8;
        const int sdst = srow * AKP + sch * 8;
        const int n0 = (2 * blp + uw) * 2048 + rn * 128;
        const bf16* qrow = QK + ((size_t)g * TC + n0 + 32 * qt + q) * 2048 + hh * 64;
        bf16x8 qf[4];
#pragma unroll
        for (int d0 = 0; d0 < 4; ++d0) qf[d0] = *(const bf16x8*)(qrow + d0 * 16 + 8 * h);
        AttnSt st; st.m = NEGB; st.l = 0.f; st.o0 = (f32x16){}; st.o1 = (f32x16){};
        u32x4 k0, k1, v0, v1;
        k0 = *(const u32x4*)(ksrc + (size_t)(64 * j0) * 2048); k1 = *(const u32x4*)(ksrc + (size_t)(64 * j0 + 32) * 2048);
        v0 = *(const u32x4*)(vsrc + 64 * j0); v1 = *(const u32x4*)(vsrc + (size_t)32 * TC + 64 * j0);
        { LAS bf16* kb = (LAS bf16*)(F.lds + TBL + (0 * 2 + tu) * 2 * ATILE); LAS bf16* vb = kb + 64 * AKP;
          *(LAS u32x4*)(kb + sdst) = k0; *(LAS u32x4*)(kb + 32 * AKP + sdst) = k1; *(LAS u32x4*)(vb + sdst) = v0; *(LAS u32x4*)(vb + 32 * AKP + sdst) = v1; }
        __syncthreads();
        int pb = 0;
        for (int j = j0; j < 4; ++j) {
            const bool more = j + 1 < 4;
            if (more) { k0 = *(const u32x4*)(ksrc + (size_t)(64 * (j + 1)) * 2048); k1 = *(const u32x4*)(ksrc + (size_t)(64 * (j + 1) + 32) * 2048);
                        v0 = *(const u32x4*)(vsrc + 64 * (j + 1)); v1 = *(const u32x4*)(vsrc + (size_t)32 * TC + 64 * (j + 1)); }
            const LAS bf16* kb = (const LAS bf16*)(F.lds + TBL + (pb * 2 + uw) * 2 * ATILE); const LAS bf16* vb = kb + 64 * AKP;
#pragma unroll
            for (int t2 = 0; t2 < 2; ++t2) { const int t32 = 2 * j + t2;
                if (t32 >= qt && t32 <= qt + 4) {
                    const LAS float* bl = bt + gh * 192 + 32 + (32 * qt + q + 128 - 32 * t32 - 8 * h - 23);
                    attn_tile<false>(kb + 32 * t2 * AKP, vb + 32 * t2, bl, qf, st, q, h, true); } }
            if (more) { LAS bf16* kn = (LAS bf16*)(F.lds + TBL + ((pb ^ 1) * 2 + tu) * 2 * ATILE); LAS bf16* vn = kn + 64 * AKP;
                *(LAS u32x4*)(kn + sdst) = k0; *(LAS u32x4*)(kn + 32 * AKP + sdst) = k1; *(LAS u32x4*)(vn + sdst) = v0; *(LAS u32x4*)(vn + 32 * AKP + sdst) = v1; }
            __syncthreads();
            pb ^= 1;
        }
        const float l_tot = st.l + __shfl_xor(st.l, 32), inv = 1.f / l_tot;
        const size_t orow = (size_t)g * TC + n0 + 32 * qt + q;
        attn_store(st, OG + orow * 1024 + hh * 64 + 4 * h, inv);
        if (h == 0) LSE[orow * 16 + hh] = st.m + __log2f(l_tot);
    }
}

__device__ __forceinline__ void moba_unit2(Frame& F, int b, int hh, int nb, LAS float* bt, int& cur_h) {
    constexpr int TBL = 8448;
    const int lane = F.lane, q = lane & 31, h = lane >> 5, w = F.wave, t = F.tid, srow = t >> 3, sch = t & 7;
    const bf16* QK = (const bf16*)(F.ws + WS_SCR + S_CQK); const bf16* VT = (const bf16*)(F.ws + WS_SCR + S_CVT);
    bf16* att = (bf16*)(F.ws + WS_SCR + S_CATT); const float* km = (const float*)(F.ws + WS_KMEAN);
    if (hh != cur_h) { __syncthreads(); const float* btC = (const float*)(F.ws + WS_BTABC) + hh * 2048; for (int i = t; i < 2048 + 32; i += 512) bt[i] = i < 32 ? NEGB : btC[i - 32]; cur_h = hh; __syncthreads(); }
    const size_t tq = (size_t)b * SEQ + nb * 256 + 32 * w + q;
    const bf16* qrow = QK + tq * 2048 + hh * 64;
    bf16x8 qf[4];
#pragma unroll
    for (int d0 = 0; d0 < 4; ++d0) qf[d0] = *(const bf16x8*)(qrow + d0 * 16 + 8 * h);
    unsigned sel = 0;
    if (nb > 0) {
        float gsc[7];
#pragma unroll
        for (int m = 0; m < 7; ++m) { float s = 0.f;
            if (m < nb) { const float* kmp = km + (((size_t)b * NH + hh) * 8 + m) * 64;
#pragma unroll
                for (int d0 = 0; d0 < 4; ++d0) { const f32x4 k0 = *(const f32x4*)(kmp + d0 * 16 + 8 * h), k1 = *(const f32x4*)(kmp + d0 * 16 + 8 * h + 4); const u32x4 qq = __builtin_bit_cast(u32x4, qf[d0]);
                    s += bflo(qq.x) * k0.x + bfhi(qq.x) * k0.y + bflo(qq.y) * k0.z + bfhi(qq.y) * k0.w + bflo(qq.z) * k1.x + bfhi(qq.z) * k1.y + bflo(qq.w) * k1.z + bfhi(qq.w) * k1.w; }
                s += __shfl_xor(s, 32); }
            gsc[m] = m < nb ? s : -3.0e38f; }
        const int nsel = nb < 3 ? nb : 3;
#pragma unroll
        for (int r = 0; r < 3; ++r) { if (r < nsel) { int bi = 0; float bv = -3.4e38f;
#pragma unroll
                for (int m = 0; m < 7; ++m) if (!((sel >> m) & 1u) && gsc[m] > bv) { bv = gsc[m]; bi = m; }
                sel |= 1u << bi; } }
    }
    AttnSt st; st.m = NEGB; st.l = 0.f; st.o0 = (f32x16){}; st.o1 = (f32x16){};
    const int qpos = nb * 256 + 32 * w + q, nsteps = 4 * nb + 4;
    const bf16* ksrc = QK + ((size_t)b * SEQ + srow) * 2048 + 1024 + hh * 64 + sch * 8;
    const bf16* vsrc = VT + ((size_t)hh * 64 + srow) * T + (size_t)b * SEQ + sch * 8;
    const int sdst = srow * AKP + sch * 8;
    u32x4 kreg = *(const u32x4*)ksrc, vreg = *(const u32x4*)vsrc;
    { LAS bf16* kb = (LAS bf16*)(F.lds + TBL); *(LAS u32x4*)(kb + sdst) = kreg; *(LAS u32x4*)(kb + 64 * AKP + sdst) = vreg; }
    __syncthreads();
    int pb = 0;
    for (int s = 0; s < nsteps; ++s) {
        const bool more = s + 1 < nsteps;
        if (more) { kreg = *(const u32x4*)(ksrc + (size_t)(64 * (s + 1)) * 2048); vreg = *(const u32x4*)(vsrc + 64 * (s + 1)); }
        const LAS bf16* kb = (const LAS bf16*)(F.lds + TBL + pb * 2 * ATILE); const LAS bf16* vb = kb + 64 * AKP;
        if (s < 4 * nb) {
            const bool mine = (sel >> (s >> 2)) & 1u;
            if (__ballot(mine) != 0ull) {
#pragma unroll
                for (int t2 = 0; t2 < 2; ++t2) { const LAS float* bl = bt + 32 + (qpos - 8 * h - (64 * s + 32 * t2) - 23);
                    attn_tile<true>(kb + 32 * t2 * AKP, vb + 32 * t2, bl, qf, st, q, h, mine); } }
        } else {
#pragma unroll
            for (int t2 = 0; t2 < 2; ++t2) { const int t32 = (s - 4 * nb) * 2 + t2;
                if (t32 <= w) { const LAS float* bl = bt + 32 + (qpos - 8 * h - (64 * s + 32 * t2) - 23);
                    attn_tile<false>(kb + 32 * t2 * AKP, vb + 32 * t2, bl, qf, st, q, h, true); } }
        }
        if (more) { LAS bf16* kn = (LAS bf16*)(F.lds + TBL + (pb ^ 1) * 2 * ATILE); *(LAS u32x4*)(kn + sdst) = kreg; *(LAS u32x4*)(kn + 64 * AKP + sdst) = vreg; }
        __syncthreads();
        pb ^= 1;
    }
    const float l_tot = st.l + __shfl_xor(st.l, 32), inv = 1.f / l_tot;
    attn_store(st, att + tq * 1024 + hh * 64 + 4 * h, inv);
}
__device__ __forceinline__ void moba_phase2(Frame& F) {
    LAS float* bt = (LAS float*)F.lds; int cur_h = -1;
    const int NP = NB * NH * 4, per = (NP + F.G - 1) / F.G;
    const int lo = F.vcu * per, hi = (lo + per) < NP ? (lo + per) : NP;
    for (int pu = lo; pu < hi; ++pu) { const int j = pu & 3, hh = (pu >> 2) & 15, b = pu >> 6;
        moba_unit2(F, b, hh, 7 - j, bt, cur_h); moba_unit2(F, b, hh, j, bt, cur_h); }
}


__device__ __forceinline__ float xhalf_max(float m) { auto rr = __builtin_amdgcn_permlane32_swap(__float_as_uint(m), __float_as_uint(m), false, false); return fmaxf(__uint_as_float(rr[0]), __uint_as_float(rr[1])); }
__device__ __forceinline__ float xhalf_sum(float m) { auto rr = __builtin_amdgcn_permlane32_swap(__float_as_uint(m), __float_as_uint(m), false, false); return __uint_as_float(rr[0]) + __uint_as_float(rr[1]); }
template <bool MASKED>
__device__ __forceinline__ void attn_tile2(const LAS bf16* Kt, const LAS bf16* Vt, const LAS float* bl0, const bf16x8 (&qf)[4], AttnSt& st, int q, int h, bool mine) {
    f32x16 s0, s1;
#pragma unroll
    for (int r = 0; r < 16; ++r) { s0[r] = bl0[23 - 16 * (r >> 3) - (r & 7)]; s1[r] = bl0[-32 + 23 - 16 * (r >> 3) - (r & 7)]; }
    const LAS bf16* kr = Kt + kperm(q) * AKP + 8 * h;
#pragma unroll
    for (int d0 = 0; d0 < 4; ++d0) { s0 = mfma32(*(const LAS bf16x8*)(kr + d0 * 16), qf[d0], s0); s1 = mfma32(*(const LAS bf16x8*)(kr + 32 * AKP + d0 * 16), qf[d0], s1); }
    const float mx = xhalf_max(fmaxf(max16(s0), max16(s1)));
    float mn = fmaxf(st.m, mx); if (MASKED) mn = mine ? mn : st.m;
    const float alpha = __builtin_amdgcn_exp2f(st.m - mn);
    float ps0 = 0.f, ps1 = 0.f;
#pragma unroll
    for (int r = 0; r < 16; ++r) { const float p = __builtin_amdgcn_exp2f(s0[r] - mn); s0[r] = p; ps0 += p; const float p2 = __builtin_amdgcn_exp2f(s1[r] - mn); s1[r] = p2; ps1 += p2; }
    bf16x8 p00 = pack8(s0, 0), p01 = pack8(s0, 8), p10 = pack8(s1, 0), p11 = pack8(s1, 8);
    float ps = ps0 + ps1;
    if (MASKED) { if (!mine) { p00 = (bf16x8){0, 0, 0, 0, 0, 0, 0, 0}; p01 = p00; p10 = p00; p11 = p00; ps = 0.f; } }
    st.l = st.l * alpha + ps; st.m = mn;
    if (__ballot(alpha != 1.0f) != 0ull) {
#pragma unroll
        for (int r = 0; r < 16; ++r) { st.o0[r] *= alpha; st.o1[r] *= alpha; } }
    const LAS bf16* v0 = Vt + q * AKP + 8 * h; const LAS bf16* v1 = v0 + 32 * AKP;
    st.o0 = mfma32(*(const LAS bf16x8*)v0, p00, st.o0); st.o1 = mfma32(*(const LAS bf16x8*)v1, p00, st.o1);
    st.o0 = mfma32(*(const LAS bf16x8*)(v0 + 16), p01, st.o0); st.o1 = mfma32(*(const LAS bf16x8*)(v1 + 16), p01, st.o1);
    st.o0 = mfma32(*(const LAS bf16x8*)(v0 + 32), p10, st.o0); st.o1 = mfma32(*(const LAS bf16x8*)(v1 + 32), p10, st.o1);
    st.o0 = mfma32(*(const LAS bf16x8*)(v0 + 48), p11, st.o0); st.o1 = mfma32(*(const LAS bf16x8*)(v1 + 48), p11, st.o1);
}

__device__ __forceinline__ void dil_attn_phase3(Frame& F) {
    LAS float* bt = (LAS float*)F.lds;
    { const float* btA = (const float*)(F.ws + WS_BTABA); for (int i = F.tid; i < 48 * 192; i += 512) { const int gh = i / 192, dl = i % 192 - 32; bt[i] = (dl >= 0 && dl <= 128) ? btA[gh * 132 + dl] : NEGB; } }
    constexpr int TBL = 48 * 192 * 4;
    const int lane = F.lane, q = lane & 31, h = lane >> 5, w = F.wave, uw = w >> 2, qt = w & 3, t = F.tid, tu = t >> 8, tt = t & 255, srow = tt >> 3, sch = tt & 7;
    const bf16* QK = (const bf16*)(F.ws + WS_SCR + S_QK); const bf16* VT = (const bf16*)(F.ws + WS_SCR + S_VT);
    bf16* OG = (bf16*)((unsigned char*)F.out + O_OG); float* LSE = (float*)((unsigned char*)F.out + O_LSE);
    const int sdst = srow * AKP + sch * 8;
    int du = F.vcu;
    if (du >= 3072) { __syncthreads(); return; }
    int g = du >> 10, hh = (du >> 6) & 15, blp = (du >> 4) & 3, rn = du & 15;
    int j = ((rn & ((16 >> (2 * g)) - 1)) != 0) ? 0 : 2;
    u32x4 k0, k1, v0, v1; bf16x8 qn[4], qf[4];
#define DIL_LOADS(G_, HH_, BLP_, RN_, J_) do { const int n0s_ = (2 * (BLP_) + tu) * 2048 + (RN_) * 128 - 128 + 64 * (J_); \
        const bf16* ks_ = QK + ((size_t)(G_) * TC + n0s_ + srow) * 2048 + 1024 + (HH_) * 64 + sch * 8; \
        const bf16* vs_ = VT + ((size_t)(G_) * 1024 + (HH_) * 64 + srow) * TC + n0s_ + sch * 8; \
        k0 = *(const u32x4*)ks_; k1 = *(const u32x4*)(ks_ + (size_t)32 * 2048); v0 = *(const u32x4*)vs_; v1 = *(const u32x4*)(vs_ + (size_t)32 * TC); } while (0)
#define DIL_QLOADS(G_, HH_, BLP_, RN_) do { const bf16* qr_ = QK + ((size_t)(G_) * TC + (2 * (BLP_) + uw) * 2048 + (RN_) * 128 + 32 * qt + q) * 2048 + (HH_) * 64; \
        _Pragma("unroll") for (int d0 = 0; d0 < 4; ++d0) qn[d0] = *(const bf16x8*)(qr_ + d0 * 16 + 8 * h); } while (0)
#define DIL_WRITE(PB_) do { LAS bf16* kb_ = (LAS bf16*)(F.lds + TBL + ((PB_) * 2 + tu) * 2 * ATILE); LAS bf16* vb_ = kb_ + 64 * AKP; \
        *(LAS u32x4*)(kb_ + sdst) = k0; *(LAS u32x4*)(kb_ + 32 * AKP + sdst) = k1; *(LAS u32x4*)(vb_ + sdst) = v0; *(LAS u32x4*)(vb_ + 32 * AKP + sdst) = v1; } while (0)
    DIL_LOADS(g, hh, blp, rn, j); DIL_QLOADS(g, hh, blp, rn);
    DIL_WRITE(0);
#pragma unroll
    for (int d0 = 0; d0 < 4; ++d0) qf[d0] = qn[d0];
    __syncthreads();
    AttnSt st; st.m = NEGB; st.l = 0.f; st.o0 = (f32x16){}; st.o1 = (f32x16){};
    int pb = 0;
    for (;;) {
        const bool last = (j == 3);
        int ng = g, nhh = hh, nblp = blp, nrn = rn, nj = j + 1; bool more = true;
        if (last) { const int nd = du + F.G; more = nd < 3072; ng = nd >> 10; nhh = (nd >> 6) & 15; nblp = (nd >> 4) & 3; nrn = nd & 15; nj = ((nrn & ((16 >> (2 * ng)) - 1)) != 0) ? 0 : 2; }
        if (more) { DIL_LOADS(ng, nhh, nblp, nrn, nj); if (last) DIL_QLOADS(ng, nhh, nblp, nrn); }
        { const LAS bf16* kb = (const LAS bf16*)(F.lds + TBL + (pb * 2 + uw) * 2 * ATILE); const LAS bf16* vb = kb + 64 * AKP;
          const int gh = g * 16 + hh, ta = 2 * j, tb = 2 * j + 1;
          const bool a_on = ta >= qt && ta <= qt + 4, b_on = tb >= qt && tb <= qt + 4;
          const LAS float* bl = bt + gh * 192 + 32 + (32 * qt + q + 128 - 32 * ta - 8 * h - 23);
          if (a_on && b_on) attn_tile2<false>(kb, vb, bl, qf, st, q, h, true);
          else if (a_on) attn_tile<false>(kb, vb, bl, qf, st, q, h, true);
          else if (b_on) attn_tile<false>(kb + 32 * AKP, vb + 32, bl - 32, qf, st, q, h, true); }
        if (more) DIL_WRITE(pb ^ 1);
        if (last) {
            const float l_tot = xhalf_sum(st.l), inv = 1.f / l_tot;
            const size_t orow = (size_t)g * TC + (2 * blp + uw) * 2048 + rn * 128 + 32 * qt + q;
            attn_store(st, OG + orow * 1024 + hh * 64 + 4 * h, inv);
            if (h == 0) LSE[orow * 16 + hh] = st.m + __log2f(l_tot);
            st.m = NEGB; st.l = 0.f; st.o0 = (f32x16){}; st.o1 = (f32x16){};
#pragma unroll
            for (int d0 = 0; d0 < 4; ++d0) qf[d0] = qn[d0];
        }
        __syncthreads();
        pb ^= 1;
        if (!more) break;
        if (last) du += F.G;
        g = ng; hh = nhh; blp = nblp; rn = nrn; j = nj;
    }
#undef DIL_LOADS
#undef DIL_QLOADS
#undef DIL_WRITE
}

__device__ __forceinline__ void moba_phase3(Frame& F) {
    constexpr int TBL = 8448, KMO = TBL + 4 * ATILE;
    LAS float* bt = (LAS float*)F.lds; LAS float* kml = (LAS float*)(F.lds + KMO);
    const int lane = F.lane, q = lane & 31, h = lane >> 5, w = F.wave, t = F.tid, srow = t >> 3, sch = t & 7;
    const bf16* QK = (const bf16*)(F.ws + WS_SCR + S_CQK); const bf16* VT = (const bf16*)(F.ws + WS_SCR + S_CVT);
    bf16* att = (bf16*)(F.ws + WS_SCR + S_CATT); const float* km = (const float*)(F.ws + WS_KMEAN);
    const int NP = NB * NH * 4, per = (NP + F.G - 1) / F.G;
    const int lo = F.vcu * per, hi = (lo + per) < NP ? (lo + per) : NP;
    const int nunits = 2 * (hi - lo);
    if (nunits <= 0) return;
    const int sdst = srow * AKP + sch * 8;
    int u = 0, cur_bh = -1;
    u32x4 kreg, vreg; bf16x8 qn[4], qf[4];
#define MB_LOADS(B_, HH_, S_) do { const bf16* ks_ = QK + ((size_t)(B_) * SEQ + 64 * (S_) + srow) * 2048 + 1024 + (HH_) * 64 + sch * 8; \
        const bf16* vs_ = VT + ((size_t)(HH_) * 64 + srow) * T + (size_t)(B_) * SEQ + 64 * (S_) + sch * 8; kreg = *(const u32x4*)ks_; vreg = *(const u32x4*)vs_; } while (0)
#define MB_QLOADS(B_, HH_, NB_) do { const bf16* qr_ = QK + ((size_t)(B_) * SEQ + (NB_) * 256 + 32 * w + q) * 2048 + (HH_) * 64; \
        _Pragma("unroll") for (int d0 = 0; d0 < 4; ++d0) qn[d0] = *(const bf16x8*)(qr_ + d0 * 16 + 8 * h); } while (0)
#define MB_WRITE(PB_) do { LAS bf16* kb_ = (LAS bf16*)(F.lds + TBL + (PB_) * 2 * ATILE); *(LAS u32x4*)(kb_ + sdst) = kreg; *(LAS u32x4*)(kb_ + 64 * AKP + sdst) = vreg; } while (0)
    int pu = lo, jj = pu & 3, hh = (pu >> 2) & 15, b = pu >> 6, nb = 7 - jj, s = 0, pb = 0;
    MB_LOADS(b, hh, 0); MB_QLOADS(b, hh, nb); MB_WRITE(0);
    unsigned sel = 0; bool fresh = true;
    AttnSt st; st.m = NEGB; st.l = 0.f; st.o0 = (f32x16){}; st.o1 = (f32x16){};
    for (;;) {
        if (fresh) {
            if (b * 16 + hh != cur_bh) { __syncthreads(); const float* btC = (const float*)(F.ws + WS_BTABC) + hh * 2048;
                for (int i = t; i < 2048 + 32; i += 512) bt[i] = i < 32 ? NEGB : btC[i - 32];
                { const float* kmp = km + ((size_t)b * NH + hh) * 512; kml[t] = kmp[t]; }
                cur_bh = b * 16 + hh; }
#pragma unroll
            for (int d0 = 0; d0 < 4; ++d0) qf[d0] = qn[d0];
            __syncthreads();
            sel = 0;
            if (nb > 0) {
                float gsc[7];
#pragma unroll
                for (int m = 0; m < 7; ++m) { float sc = 0.f;
                    if (m < nb) {
#pragma unroll
                        for (int d0 = 0; d0 < 4; ++d0) { const f32x4 c0 = *(const LAS f32x4*)(kml + m * 64 + d0 * 16 + 8 * h), c1 = *(const LAS f32x4*)(kml + m * 64 + d0 * 16 + 8 * h + 4); const u32x4 qq = __builtin_bit_cast(u32x4, qf[d0]);
                            sc += bflo(qq.x) * c0.x + bfhi(qq.x) * c0.y + bflo(qq.y) * c0.z + bfhi(qq.y) * c0.w + bflo(qq.z) * c1.x + bfhi(qq.z) * c1.y + bflo(qq.w) * c1.z + bfhi(qq.w) * c1.w; }
                        sc = xhalf_sum(sc); }
                    gsc[m] = m < nb ? sc : -3.0e38f; }
                const int nsel = nb < 3 ? nb : 3;
#pragma unroll
                for (int r = 0; r < 3; ++r) { if (r < nsel) { int bi = 0; float bv = -3.4e38f;
#pragma unroll
                        for (int m = 0; m < 7; ++m) if (!((sel >> m) & 1u) && gsc[m] > bv) { bv = gsc[m]; bi = m; }
                        sel |= 1u << bi; } }
            }
            fresh = false;
        }
        const int nsteps = 4 * nb + 4;
        const bool last = (s + 1 == nsteps);
        int nb2 = nb, b2 = b, hh2 = hh, s2 = s + 1; bool more = true;
        if (last) { const int u2 = u + 1; more = u2 < nunits; const int pu2 = lo + (u2 >> 1), j2 = pu2 & 3; hh2 = (pu2 >> 2) & 15; b2 = pu2 >> 6; nb2 = (u2 & 1) ? j2 : 7 - j2; s2 = 0; }
        if (more) { MB_LOADS(b2, hh2, s2); if (last) MB_QLOADS(b2, hh2, nb2); }
        { const LAS bf16* kb = (const LAS bf16*)(F.lds + TBL + pb * 2 * ATILE); const LAS bf16* vb = kb + 64 * AKP;
          const int qpos = nb * 256 + 32 * w + q;
          const LAS float* bl = bt + 32 + (qpos - 8 * h - 64 * s - 23);
          if (s < 4 * nb) { const bool mine = (sel >> (s >> 2)) & 1u;
              if (__ballot(mine) != 0ull) attn_tile2<true>(kb, vb, bl, qf, st, q, h, mine); }
          else { const int ta = (s - 4 * nb) * 2;
              if (ta + 1 <= w) attn_tile2<false>(kb, vb, bl, qf, st, q, h, true);
              else if (ta <= w) attn_tile<false>(kb, vb, bl, qf, st, q, h, true); } }
        if (more) MB_WRITE(pb ^ 1);
        if (last) {
            const float l_tot = xhalf_sum(st.l), inv = 1.f / l_tot;
            const size_t tq = (size_t)b * SEQ + nb * 256 + 32 * w + q;
            attn_store8(st, (unsigned char*)att + tq * 1024 + hh * 64 + 4 * h, inv * ASCALE8);
            st.m = NEGB; st.l = 0.f; st.o0 = (f32x16){}; st.o1 = (f32x16){};
        }
        if (!last) __syncthreads();
        pb ^= 1;
        if (!more) break;
        if (last) { ++u; fresh = true; }
        nb = nb2; b = b2; hh = hh2; s = s2;
    }
#undef MB_LOADS
#undef MB_QLOADS
#undef MB_WRITE
}

__device__ __forceinline__ void gmlp_phase(Frame& F, const float* lng, const float* lnb, const float* bs) {
    const int lane = F.lane, w = F.wave, q = lane & 31, h = lane >> 5;
    const bf16* uv = (const bf16*)(F.ws + WS_SCR + S_UV); bf16* p = (bf16*)(F.ws + WS_SCR + S_P); const bf16* wst = (const bf16*)(F.ws + WS_WST);
    LAS float* stat = (LAS float*)F.lds;
    LAS bf16* vnT = (LAS bf16*)(F.lds + 1024);
    constexpr int VP = 136;
    for (int unit = F.vcu; unit < T / 128; unit += F.G) {
        const size_t t0 = (size_t)unit * 128;
        __syncthreads();
        for (int i = 0; i < 16; ++i) { const int r = w * 16 + i; const u32x4* vr = (const u32x4*)(uv + (t0 + r) * 2048 + 1024) + lane;
            const u32x4 a = vr[0], b = vr[64]; float x[16];
            x[0] = bflo(a.x); x[1] = bfhi(a.x); x[2] = bflo(a.y); x[3] = bfhi(a.y); x[4] = bflo(a.z); x[5] = bfhi(a.z); x[6] = bflo(a.w); x[7] = bfhi(a.w);
            x[8] = bflo(b.x); x[9] = bfhi(b.x); x[10] = bflo(b.y); x[11] = bfhi(b.y); x[12] = bflo(b.z); x[13] = bfhi(b.z); x[14] = bflo(b.w); x[15] = bfhi(b.w);
            float s = 0.f;
#pragma unroll
            for (int j = 0; j < 16; ++j) s += x[j];
            const float mean = wave_sum(s) * (1.f / 1024.f); float s2 = 0.f;
#pragma unroll
            for (int j = 0; j < 16; ++j) { const float d = x[j] - mean; s2 += d * d; }
            const float rstd = 1.f / sqrtf(wave_sum(s2) * (1.f / 1024.f) + LN_EPS);
            if (lane == 0) { stat[2 * r] = mean; stat[2 * r + 1] = rstd; } }
        __syncthreads();
        for (int gg = 0; gg < 8; ++gg) {
#pragma unroll
            for (int k = 0; k < 4; ++k) { const int id = F.tid + 512 * k, s = id >> 4, cc = (id & 15) * 8;
                const u32x4 a = *(const u32x4*)(uv + (t0 + s) * 2048 + 1024 + gg * 128 + cc); const float mean = stat[2 * s], rstd = stat[2 * s + 1];
                float x[8]; x[0] = bflo(a.x); x[1] = bfhi(a.x); x[2] = bflo(a.y); x[3] = bfhi(a.y); x[4] = bflo(a.z); x[5] = bfhi(a.z); x[6] = bflo(a.w); x[7] = bfhi(a.w);
#pragma unroll
                for (int j = 0; j < 8; ++j) { const int c = gg * 128 + cc + j; const float y = (x[j] - mean) * rstd * lng[c] + lnb[c]; vnT[(cc + j) * VP + s] = (bf16)f2bf(y); } }
            __syncthreads();
            const int cr = 32 * (w & 3), tc0 = 64 * (w >> 2);
            f32x16 acc0 = {}, acc1 = {};
#pragma unroll
            for (int ks = 0; ks < 8; ++ks) {
                const bf16x8 af = *(const LAS bf16x8*)(vnT + (cr + q) * VP + ks * 16 + 8 * h);
                const bf16x8 b0 = *(const bf16x8*)(wst + ((size_t)gg * 128 + tc0 + q) * 128 + ks * 16 + 8 * h);
                const bf16x8 b1 = *(const bf16x8*)(wst + ((size_t)gg * 128 + tc0 + 32 + q) * 128 + ks * 16 + 8 * h);
                acc0 = mfma32(af, b0, acc0); acc1 = mfma32(af, b1, acc1);
            }
#pragma unroll
            for (int tt = 0; tt < 2; ++tt) { const f32x16& ac = tt == 0 ? acc0 : acc1; const int tl = tc0 + 32 * tt + q; const float bsv = bs[gg * 128 + tl];
                const size_t rowu = (t0 + tl) * 2048, rowp = (t0 + tl) * 1024;
#pragma unroll
                for (int gq = 0; gq < 4; ++gq) { const int c = gg * 128 + cr + 8 * gq + 4 * h; const u32x2 uu = *(const u32x2*)(uv + rowu + c);
                    u32x2 o; o.x = pk2(bflo(uu.x) * (ac[4 * gq] + bsv), bfhi(uu.x) * (ac[4 * gq + 1] + bsv)); o.y = pk2(bflo(uu.y) * (ac[4 * gq + 2] + bsv), bfhi(uu.y) * (ac[4 * gq + 3] + bsv));
                    *(u32x2*)(p + rowp + c) = o; } }
            __syncthreads();
        }
    }
}

struct MoeSeg { int ts[9]; };
__device__ __forceinline__ MoeSeg moe_seg(Frame& F, int moe_l) {
    MoeSeg s; int acc = 0;
#pragma unroll
    for (int e = 0; e < 8; ++e) { s.ts[e] = acc; const unsigned c = __hip_atomic_load((unsigned*)(F.ctl + CW_ECNT + 64 * moe_l + e), RLX_AGENT); acc += (int)((c + 255u) >> 8); }
    s.ts[8] = acc; return s;
}
__device__ __forceinline__ void moe_gather_phase(Frame& F, int moe_l) {
    LAS int* P = (LAS int*)F.lds;
    LAS int* wtot = (LAS int*)(F.lds + 65536);
    LAS int* tot = wtot + 64;
    const int* wcnt = (const int*)(F.ws + WS_WCNT);
    int t = F.tid; asm volatile("" : "+v"(t));
    const int lane = F.lane;
    int loc[4][8], sum[8], inc[8];
#pragma unroll
    for (int k = 0; k < 4; ++k) { const u32x4 a = *(const u32x4*)(wcnt + (4 * t + k) * 8), b = *(const u32x4*)(wcnt + (4 * t + k) * 8 + 4);
        loc[k][0] = (int)a.x; loc[k][1] = (int)a.y; loc[k][2] = (int)a.z; loc[k][3] = (int)a.w; loc[k][4] = (int)b.x; loc[k][5] = (int)b.y; loc[k][6] = (int)b.z; loc[k][7] = (int)b.w; }
#pragma unroll
    for (int e = 0; e < 8; ++e) { sum[e] = (loc[0][e] + loc[1][e]) + (loc[2][e] + loc[3][e]); inc[e] = sum[e]; }
#pragma unroll
    for (int off = 1; off < 64; off <<= 1) {
#pragma unroll
        for (int e = 0; e < 8; ++e) { const int v = __shfl_up(inc[e], off); if (lane >= off) inc[e] += v; } }
    if (lane == 63) {
#pragma unroll
        for (int e = 0; e < 8; ++e) wtot[F.wave * 8 + e] = inc[e]; }
    __syncthreads();
    int run[8];
#pragma unroll
    for (int e = 0; e < 8; ++e) { int wb = 0; for (int w = 0; w < F.wave; ++w) wb += wtot[w * 8 + e]; run[e] = wb + inc[e] - sum[e]; }
#pragma unroll
    for (int k = 0; k < 4; ++k) {
#pragma unroll
        for (int e = 0; e < 8; ++e) { P[(4 * t + k) * 8 + e] = run[e]; run[e] += loc[k][e]; } }
    if (t == 511) {
#pragma unroll
        for (int e = 0; e < 8; ++e) tot[e] = run[e]; }
    __syncthreads();
    MoeSeg sg; { int acc = 0;
#pragma unroll
        for (int e = 0; e < 8; ++e) { sg.ts[e] = acc; acc += (tot[e] + 255) >> 8; } sg.ts[8] = acc; }
    if (blockIdx.x == 0 && t < 8) __hip_atomic_store((unsigned*)(F.ctl + CW_ECNT + 64 * moe_l + t), (unsigned)tot[t], RLX_AGENT);
    const int gw = F.vcu * NWAVES + F.wave, NGW = F.G * NWAVES;
    const bf16* hb = (const bf16*)(F.ws + WS_HB); unsigned char* xg8 = (unsigned char*)F.out;
    const int* route = (const int*)(F.ws + WS_ROUTE); int* slots = (int*)(F.ws + WS_SLOTS);
    for (int m0 = 4 * gw; m0 < T; m0 += 4 * NGW) {
        int s1[4], s2[4]; u32x4 a[4], b[4];
#pragma unroll
        for (int k = 0; k < 4; ++k) { const int m = m0 + k, grp = m >> 5;
            const int e1 = route[4 * m], p1 = route[4 * m + 1], e2 = route[4 * m + 2], p2 = route[4 * m + 3];
            int ts1 = 0, ts2 = 0;
#pragma unroll
            for (int e = 0; e < 8; ++e) { ts1 = e == e1 ? sg.ts[e] : ts1; ts2 = e == e2 ? sg.ts[e] : ts2; }
            s1[k] = ts1 * 256 + P[grp * 8 + e1] + p1; s2[k] = ts2 * 256 + P[grp * 8 + e2] + p2;
            const u32x4* src = (const u32x4*)(hb + (size_t)m * D) + lane; a[k] = src[0]; b[k] = src[64]; }
#pragma unroll
        for (int k = 0; k < 4; ++k) { const int m = m0 + k;
            float x[16]; unpack8(a[k], x); unpack8(b[k], x + 8);
            u32x2 lo, hi; lo.x = pk4_fp8(x[0], x[1], x[2], x[3]); lo.y = pk4_fp8(x[4], x[5], x[6], x[7]); hi.x = pk4_fp8(x[8], x[9], x[10], x[11]); hi.y = pk4_fp8(x[12], x[13], x[14], x[15]);
            unsigned char* d1 = xg8 + (size_t)s1[k] * D + 8 * lane; unsigned char* d2 = xg8 + (size_t)s2[k] * D + 8 * lane;
            *(u32x2*)d1 = lo; *(u32x2*)(d1 + 512) = hi; *(u32x2*)d2 = lo; *(u32x2*)(d2 + 512) = hi;
            if (lane == 0) { slots[2 * m] = s1[k]; slots[2 * m + 1] = s2[k]; } }
    }
}
struct MoeOrder {
    int nM, nN, G, c, tile0; MoeSeg sg; const char* A0; const char* B0; size_t aT, bE, bT; bool a_local;
    bool out_local;
    __device__ __forceinline__ bool next(int i, pg8::Unit& u) const {
        int pm, pn; if (!pg8::tile_of((long)i * G + c, nM, nN, pm, pn)) return false;
        const int tile = tile0 + pm; int e = 0;
#pragma unroll
        for (int k = 1; k < 8; ++k) e += (tile >= sg.ts[k]) ? 1 : 0;
        u.pm = out_local ? pm : tile; u.pn = pn; u.a = (unsigned)((size_t)(a_local ? pm : tile) * aT); u.b = (unsigned)((size_t)e * bE + (size_t)pn * bT); return true;
    }
};


template <int GI> struct L0QKOrder { int G, c; const char* A0; const char* B0;
    __device__ __forceinline__ bool next(int i, pg8::Unit& u) const { if (!pg8::tile_of((long)i * G + c, 64, 8, u.pm, u.pn)) return false; const int pm = u.pm;
        const int tok = GI == 0 ? pm * 256 : (GI == 1 ? (pm >> 3) * 2048 + (pm & 1) * 1024 + ((pm >> 1) & 3) : (pm >> 3) * 2048 + (pm & 7) * 2);
        u.a = (unsigned)tok * 1024u; u.b = (unsigned)u.pn * 256u * 1024u; return true; } };
template <int GI> struct L0VtOrder { int G, c; const char* A0; const char* B0;
    __device__ __forceinline__ bool next(int i, pg8::Unit& u) const { if (!pg8::tile_of((long)i * G + c, 4, 64, u.pm, u.pn)) return false; const int pn = u.pn;
        const int tok = GI == 0 ? pn * 256 : (GI == 1 ? (pn >> 3) * 2048 + (pn & 1) * 1024 + ((pn >> 1) & 3) : (pn >> 3) * 2048 + (pn & 7) * 2);
        u.a = (unsigned)u.pm * 256u * 1024u; u.b = (unsigned)tok * 1024u; return true; } };
template <int GI> __device__ __forceinline__ void l0_gemms(Frame& F, int ck, int bx) {
    constexpr int rs = GI == 0 ? 1 : (GI == 1 ? 4 : 16);
    constexpr size_t hst = (GI == 0 ? (size_t)128 : (GI == 1 ? (size_t)512 : (size_t)1)) * 1024;
    const char* hbc = (const char*)(F.ws + WS_SCR + S_HB8) + (size_t)ck * TC * 1024;
    unsigned char* scr = F.ws + WS_SCR;
    { L0QKOrder<GI> S{F.G, bx, hbc, (const char*)(F.ws + W_A_QK) + (size_t)GI * 2048 * 1024};
      pg8::Gemm gm{512, rs, 1, hst, (size_t)128 * 1024};
      pg8::EpiBf16<0> E{(bf16*)(scr + S_QK) + (size_t)GI * TC * 2048, 2048, 1.f / WSCALE8};
      pg8::gemm_phase<pg8::EpiBf16<0>, L0QKOrder<GI>, false, 1>(F.lds, F.wave, gm, S, E); }
    { L0VtOrder<GI> S{F.G, bx, (const char*)(F.ws + W_A_V) + (size_t)GI * 1024 * 1024, hbc};
      pg8::Gemm gm{512, 1, rs, (size_t)128 * 1024, hst};
      pg8::EpiBf16<0> E{(bf16*)(scr + S_VT) + (size_t)GI * 1024 * TC, TC, 1.f / WSCALE8};
      pg8::gemm_phase<pg8::EpiBf16<0>, L0VtOrder<GI>, false, 1>(F.lds, F.wave, gm, S, E); }
}


#ifdef MK_SELFCHECK
__device__ __forceinline__ void selfcheck_buf(Frame& F, const void* ptr, size_t nbytes, int stage, int slot0) {
    if (!F.chk) return;
    const int gw = F.vcu * NWAVES + F.wave, NGW = F.G * NWAVES; unsigned* cks = (unsigned*)(F.ws + WS_NEED + 2 * MiB) + slot0;
    const int nch = (int)(nbytes >> 12);
    for (int c = gw; c < nch; c += NGW) { const u32x4* r = (const u32x4*)((const char*)ptr + ((size_t)c << 12)) + F.lane; unsigned x = 0;
#pragma unroll
        for (int j = 0; j < 4; ++j) { const u32x4 v = r[64 * j]; x ^= v.x * 3u + v.y * 5u + v.z * 7u + v.w * 11u + (unsigned)j; }
        x *= (unsigned)(2 * F.lane + 1);
#pragma unroll
        for (int o = 1; o < 64; o <<= 1) x ^= __shfl_xor(x, o);
        if (F.lane == 0) { if (F.chk == 1) cks[c] = x; else if (cks[c] != x) atomicMax((unsigned*)(F.ctl + 32), (unsigned)(1000 - stage)); } }
}
#endif

__global__ void __launch_bounds__(NWAVES * 64, 2) mk_fwd(Args args) {
    extern __shared__ __attribute__((aligned(16))) unsigned char lds[];
    Frame F;
    F.lds = (LAS unsigned char*)lds;
    F.tid = threadIdx.x; F.lane = F.tid & 63; F.wave = __builtin_amdgcn_readfirstlane(F.tid >> 6);
    F.G = gridDim.x; { const int bx = blockIdx.x; F.vcu = (F.G % 8 == 0) ? (bx % 8) * (F.G / 8) + bx / 8 : bx; }
    F.ws = args.ws; F.ctl = (gu32*)(args.ws + WS_CTL); F.out = args.out; F.chk = args.chk; F.stage = 0;
    volatile LAS unsigned* MISC = (volatile LAS unsigned*)(F.lds + MISC_OFF);
    for (int u = F.tid; u < (LDS_BYTES - RING_BYTES) / 4; u += NWAVES * 64) ((LAS unsigned*)(F.lds + RING_BYTES))[u] = 0u;
    __syncthreads();
    XcdBarrier bar; bar.bar = (unsigned*)(F.ctl + CW_BAR); bar.x = 0; bar.st = nullptr;
    if (!MK_MULTI) bar = xcd_barrier_post((unsigned*)(F.ctl + CW_BAR), MISC + 8);
    const int lo = args.ph_lo, hi = args.ph_hi;
    int ph = 0;
#define PHASE_BEGIN if (ph >= lo && ph < hi) { F.lane = (int)__builtin_amdgcn_mbcnt_hi(~0u, __builtin_amdgcn_mbcnt_lo(~0u, 0u)); asm volatile("" : "+v"(F.lane)); F.tid = F.wave * 64 + F.lane;
#define PHASE_END   if (!MK_MULTI && ph + 1 < hi) xcd_barrier(bar, F.tid); } ++ph;
    const int bx = (int)blockIdx.x;
#define scr (args.ws + WS_SCR)
#define hb ((const bf16*)(args.ws + WS_HB))
#define ln_g (args.in[2])
#define ln_b (args.in[3])

    PHASE_BEGIN p_prologue(F, args); if (MK_PROBE & 8) p_prologue(F, args); PHASE_END

    if (MK_ENABLE & 1) {
#define L0_CHUNK(ck) \
        PHASE_BEGIN \
        if ((ck) > 0) dil_merge_phase(F, (ck) - 1); \
        l0_gemms<0>(F, (ck), bx); l0_gemms<1>(F, (ck), bx); l0_gemms<2>(F, (ck), bx); \
        PHASE_END \
        PHASE_BEGIN dil_attn_phase3(F); if (MK_PROBE & 1) dil_attn_phase3(F); PHASE_END
        L0_CHUNK(0) L0_CHUNK(1) L0_CHUNK(2) L0_CHUNK(3)
#undef L0_CHUNK
        PHASE_BEGIN dil_merge_phase(F, 3); if (MK_PROBE & 4) { dil_merge_phase(F, 3); dil_merge_phase(F, 3); dil_merge_phase(F, 3); dil_merge_phase(F, 3); } PHASE_END
        PHASE_BEGIN
        { pg8::LinOrder S{T / 256, 4, F.G, bx, (const char*)(scr + S_ATT), (const char*)(F.ws + W_A_O), (size_t)256 * 1024, (size_t)256 * 1024};
          pg8::Gemm gm{512, 1, 1, (size_t)128 * 1024, (size_t)128 * 1024};
          pg8::EpiResBf16 E{hb, (bf16*)F.out, 1024, ALPHA, 1.f / (WSCALE8 * ASCALE8)};
          pg8::gemm_phase<pg8::EpiResBf16, pg8::LinOrder, true, 1>(F.lds, F.wave, gm, S, E); }
        PHASE_END
        PHASE_BEGIN ln_phase<0, false, false, FFN_GU8 == 0>(F, ln_g + 0 * 2048, ln_b + 0 * 2048, nullptr); PHASE_END
    } else {
        PHASE_BEGIN ln_phase<1, false, false>(F, ln_g + 0 * 2048, ln_b + 0 * 2048, nullptr); PHASE_END
    }
#define DENSE_FFN(f, lnidx, enbit) \
    if (MK_ENABLE & (enbit)) { \
        PHASE_BEGIN \
        if ((f) == FFN_GU8) { \
          pg8::LinOrder S{T / 256, 2 * DFF / 256, F.G, bx, (const char*)(scr + S_HB8), (const char*)(F.ws + W_F_GU) + (size_t)(f) * 2 * DFF * 2048, (size_t)256 * 1024, (size_t)256 * 1024}; \
          pg8::Gemm gm{512, 1, 1, (size_t)128 * 1024, (size_t)128 * 1024};     \
          pg8::EpiSwiglu8 E{(unsigned char*)(scr + S_HID), DFF, 1.f / WSCALE8}; \
          pg8::gemm_phase<pg8::EpiSwiglu8, pg8::LinOrder, true, 1>(F.lds, F.wave, gm, S, E); \
        } else { pg8::LinOrder S{T / 256, 2 * DFF / 256, F.G, bx, (const char*)hb, (const char*)(F.ws + W_F_GU) + (size_t)(f) * 2 * DFF * 2048, (size_t)256 * 2048, (size_t)256 * 2048}; \
          pg8::Gemm gm{1024, 1, 1, (size_t)128 * 2048, (size_t)128 * 2048}; \
          pg8::EpiSwiglu8 E{(unsigned char*)(scr + S_HID), DFF}; \
          pg8::gemm_phase(F.lds, F.wave, gm, S, E); } \
        PHASE_END \
        PHASE_BEGIN \
        { pg8::LinOrder S{T / 256, 4, F.G, bx, (const char*)(scr + S_HID), (const char*)(F.ws + W_F_D) + (size_t)(f) * 1024 * DFF * 2, (size_t)256 * DFF, (size_t)256 * DFF}; \
          pg8::Gemm gm{DFF / 2, 1, 1, (size_t)128 * DFF, (size_t)128 * DFF};     \
          pg8::EpiBf16<0> E{(bf16*)(scr + S_Y), 1024, 1.f / WSCALE8D}; \
          pg8::gemm_phase<pg8::EpiBf16<0>, pg8::LinOrder, false, 0x7B>(F.lds, F.wave, gm, S, E); } \
        PHASE_END \
        PHASE_BEGIN ln_phase<3, false, false>(F, ln_g + (lnidx) * 1024, ln_b + (lnidx) * 1024, nullptr); PHASE_END \
    } else { \
        PHASE_BEGIN ln_phase<1, false, false>(F, ln_g + (lnidx) * 1024, ln_b + (lnidx) * 1024, nullptr); PHASE_END \
    }
    DENSE_FFN(0, 1, 2)

    if (MK_ENABLE & 4) {
        PHASE_BEGIN
        { pg8::LinOrder S{T / 256, 4, F.G, bx, (const char*)hb, (const char*)(F.ws + W_B_IN), (size_t)256 * 2048, (size_t)256 * 2048};
          pg8::Gemm gm{1024, 1, 1, (size_t)128 * 2048, (size_t)128 * 2048};
          pg8::EpiBf16<0> E{(bf16*)(scr + S_BCX), 1024};
          pg8::gemm_phase(F.lds, F.wave, gm, S, E); }
        { pg8::LinOrder S{T / 256, 8, F.G, bx, (const char*)hb, (const char*)(F.ws + W_B_IN) + (size_t)1024 * 2048, (size_t)256 * 2048, (size_t)256 * 2048};
          pg8::Gemm gm{1024, 1, 1, (size_t)128 * 2048, (size_t)128 * 2048};
          pg8::EpiGlu<0> E{(bf16*)(scr + S_BCX + (size_t)128 * MiB), 1024};
          pg8::gemm_phase(F.lds, F.wave, gm, S, E); }
        PHASE_END
        PHASE_BEGIN conv_phase(F, args.in[7]); if (MK_PROBE & 4) conv_phase(F, args.in[7]); PHASE_END
        PHASE_BEGIN
        { pg8::LinOrder S{T / 256, 4, F.G, bx, (const char*)(scr + S_P), (const char*)(F.ws + W_B_O), (size_t)256 * 2048, (size_t)256 * 2048};
          pg8::Gemm gm{1024, 1, 1, (size_t)128 * 2048, (size_t)128 * 2048};
          pg8::EpiResBf16 E{hb, (bf16*)F.out, 1024, ALPHA};
          pg8::gemm_phase(F.lds, F.wave, gm, S, E); }
        PHASE_END
        PHASE_BEGIN ln_phase<0, true, false>(F, ln_g + 2 * 1024, ln_b + 2 * 1024, args.in[20]); PHASE_END
    } else {
        PHASE_BEGIN ln_phase<1, true, false>(F, ln_g + 2 * 1024, ln_b + 2 * 1024, args.in[20]); PHASE_END
    }
#define MOE_CHUNK(f, ck) \
        PHASE_BEGIN \
        { const MoeSeg sg = moe_seg(F, (f)); int nM = sg.ts[8] - (ck) * MOE_CH_TILES; nM = nM > MOE_CH_TILES ? MOE_CH_TILES : (nM < 0 ? 0 : nM); \
          MoeOrder S{nM, 2 * DFE / 256, F.G, bx, (ck) * MOE_CH_TILES, sg, (const char*)F.out, (const char*)(F.ws + W_E_GU) + (size_t)(f) * 8 * 2 * DFE * 2048, (size_t)256 * 1024, (size_t)2 * DFE * 2048, (size_t)256 * 1024, false, true}; \
          pg8::Gemm gm{512, 1, 1, (size_t)128 * 1024, (size_t)128 * 1024};     \
          pg8::EpiSwiglu8 E{(unsigned char*)(scr + S_MHID), DFE, 1.f / WSCALE8}; \
          pg8::gemm_phase<pg8::EpiSwiglu8, MoeOrder, true, 0x7C>(F.lds, F.wave, gm, S, E);     if ((ck) == 0 && (MK_PROBE & 32)) pg8::gemm_phase(F.lds, F.wave, gm, S, E); } \
        PHASE_END \
        PHASE_BEGIN \
        { const MoeSeg sg = moe_seg(F, (f)); int nM = sg.ts[8] - (ck) * MOE_CH_TILES; nM = nM > MOE_CH_TILES ? MOE_CH_TILES : (nM < 0 ? 0 : nM); \
          MoeOrder S{nM, 4, F.G, bx, (ck) * MOE_CH_TILES, sg, (const char*)(scr + S_MHID), (const char*)(F.ws + W_E_D) + (size_t)(f) * 8 * 1024 * DFE * 2, (size_t)256 * DFE, (size_t)1024 * DFE * 2, (size_t)256 * DFE, true, false}; \
          pg8::Gemm gm{DFE / 2, 1, 1, (size_t)128 * DFE, (size_t)128 * DFE};     \
          pg8::EpiBf16<0> E{(bf16*)(scr + S_XG), 1024, 1.f / WSCALE8D}; \
          pg8::gemm_phase<pg8::EpiBf16<0>, MoeOrder, true, 0x7B>(F.lds, F.wave, gm, S, E);     if ((ck) == 0 && (MK_PROBE & 64)) pg8::gemm_phase(F.lds, F.wave, gm, S, E); } \
        PHASE_END
#define MOE_FFN(f, lnidx, enbit, fin) \
    if (MK_ENABLE & (enbit)) { \
        PHASE_BEGIN moe_gather_phase(F, (f)); if (MK_PROBE & 4) moe_gather_phase(F, (f)); PHASE_END \
        MOE_CHUNK(f, 0) MOE_CHUNK(f, 1) MOE_CHUNK(f, 2) \
        PHASE_BEGIN ln_phase<2, false, fin>(F, ln_g + (lnidx) * 1024, ln_b + (lnidx) * 1024, nullptr); PHASE_END \
    } else { \
        PHASE_BEGIN ln_phase<1, false, fin>(F, ln_g + (lnidx) * 1024, ln_b + (lnidx) * 1024, nullptr); PHASE_END \
    }
    MOE_FFN(0, 3, 8, false)

    if (MK_ENABLE & 16) {
        PHASE_BEGIN
        { pg8::LinOrder S{T / 256, 8, F.G, bx, (const char*)hb, (const char*)(F.ws + W_C_QK), (size_t)256 * 2048, (size_t)256 * 2048};
          pg8::Gemm gm{1024, 1, 1, (size_t)128 * 2048, (size_t)128 * 2048};
          pg8::EpiBf16<0> E{(bf16*)(scr + S_CQK), 2048};
          pg8::gemm_phase(F.lds, F.wave, gm, S, E); }
        { pg8::LinOrder S{4, T / 256, F.G, bx, (const char*)(F.ws + W_C_V), (const char*)hb, (size_t)256 * 2048, (size_t)256 * 2048};
          pg8::Gemm gm{1024, 1, 1, (size_t)128 * 2048, (size_t)128 * 2048};
          pg8::EpiBf16<0> E{(bf16*)(scr + S_CVT), T};
          pg8::gemm_phase(F.lds, F.wave, gm, S, E); }
        PHASE_END
#ifdef MK_SELFCHECK
        PHASE_BEGIN selfcheck_buf(F, scr + S_CQK, (size_t)256 * MiB, 40, 0); selfcheck_buf(F, scr + S_CVT, (size_t)128 * MiB, 41, 65536); PHASE_END
#endif
        PHASE_BEGIN kmean_phase(F); if (MK_PROBE & 4) kmean_phase(F); PHASE_END
#ifdef MK_SELFCHECK
        PHASE_BEGIN selfcheck_buf(F, F.ws + WS_KMEAN, (size_t)1 * MiB, 42, 65536 + 32768); PHASE_END
#endif
        PHASE_BEGIN moba_phase3(F); if (MK_PROBE & 2) moba_phase3(F); PHASE_END
#ifdef MK_SELFCHECK
        PHASE_BEGIN selfcheck_buf(F, F.ws + WS_NEED + 3 * MiB, (size_t)4 * MiB, 43, 65536 + 32768 + 256); selfcheck_buf(F, F.ws + WS_NEED + 7 * MiB, (size_t)4 * MiB, 44, 65536 + 32768 + 256 + 1024);
                    selfcheck_buf(F, scr + S_CATT, (size_t)128 * MiB, 45, 65536 + 32768 + 256 + 2048); PHASE_END
#endif
        PHASE_BEGIN
        { pg8::LinOrder S{T / 256, 4, F.G, bx, (const char*)(scr + S_CATT), (const char*)(F.ws + W_C_O), (size_t)256 * 1024, (size_t)256 * 1024};
          pg8::Gemm gm{512, 1, 1, (size_t)128 * 1024, (size_t)128 * 1024};
          pg8::EpiResBf16 E{hb, (bf16*)F.out, 1024, ALPHA, 1.f / (WSCALE8 * ASCALE8)};
          pg8::gemm_phase<pg8::EpiResBf16, pg8::LinOrder, true, 1>(F.lds, F.wave, gm, S, E); }
        PHASE_END
        PHASE_BEGIN ln_phase<0, false, false, FFN_GU8 == 1>(F, ln_g + 4 * 1024, ln_b + 4 * 1024, nullptr); PHASE_END
    } else {
        PHASE_BEGIN ln_phase<1, false, false>(F, ln_g + 4 * 1024, ln_b + 4 * 1024, nullptr); PHASE_END
    }
    DENSE_FFN(1, 5, 32)

    if (MK_ENABLE & 64) {
        PHASE_BEGIN
        { pg8::LinOrder S{T / 256, 8, F.G, bx, (const char*)hb, (const char*)(F.ws + W_D_IN), (size_t)256 * 2048, (size_t)256 * 2048};
          pg8::Gemm gm{1024, 1, 1, (size_t)128 * 2048, (size_t)128 * 2048};
          pg8::EpiBf16<1> E{(bf16*)(scr + S_UV), 2048};
          pg8::gemm_phase(F.lds, F.wave, gm, S, E); }
        PHASE_END
        PHASE_BEGIN gmlp_phase(F, args.in[12], args.in[13], args.in[15]); if (MK_PROBE & 4) gmlp_phase(F, args.in[12], args.in[13], args.in[15]); PHASE_END
        PHASE_BEGIN
        { pg8::LinOrder S{T / 256, 4, F.G, bx, (const char*)(scr + S_P), (const char*)(F.ws + W_D_O), (size_t)256 * 2048, (size_t)256 * 2048};
          pg8::Gemm gm{1024, 1, 1, (size_t)128 * 2048, (size_t)128 * 2048};
          pg8::EpiResBf16 E{hb, (bf16*)F.out, 1024, ALPHA};
          pg8::gemm_phase(F.lds, F.wave, gm, S, E); }
        PHASE_END
        PHASE_BEGIN ln_phase<0, true, false>(F, ln_g + 6 * 1024, ln_b + 6 * 1024, args.in[20] + 8192); PHASE_END
    } else {
        PHASE_BEGIN ln_phase<1, true, false>(F, ln_g + 6 * 1024, ln_b + 6 * 1024, args.in[20] + 8192); PHASE_END
    }
    MOE_FFN(1, 7, 128, true)
#ifdef MK_SELFCHECK
    PHASE_BEGIN
    { const unsigned fl = __hip_atomic_load((unsigned*)(F.ctl + 32), RLX_AGENT);
      if (fl != 0u) { const int code = 1000 - (int)fl; const float cval = (code >= 40 && code <= 45) ? (float)(20 + 2 * (code - 40)) : (float)(1u << (code / 10 + 1)); const int gw = F.vcu * NWAVES + F.wave, NGW = F.G * NWAVES;
          for (int m = gw; m < T; m += NGW) { f32x4* w = (f32x4*)(F.out + (size_t)m * D) + F.lane;
#pragma unroll
              for (int j = 0; j < 4; ++j) w[64 * j] = (f32x4){cval, cval, cval, cval}; } } }
    PHASE_END
#endif
#undef PHASE_BEGIN
#undef PHASE_END
#undef scr
#undef hb
#undef ln_g
#undef ln_b
}

static int count_phases() {
    int n = 1;
    n += (MK_ENABLE & 1) ? (8 + 1 + 1 + 1) : 1;
    n += (MK_ENABLE & 2) ? 3 : 1;
    n += (MK_ENABLE & 4) ? 4 : 1;
    n += (MK_ENABLE & 8) ? 8 : 1;
    n += (MK_ENABLE & 16) ? 5 : 1;
    n += (MK_ENABLE & 32) ? 3 : 1;
    n += (MK_ENABLE & 64) ? 4 : 1;
    n += (MK_ENABLE & 128) ? 8 : 1;
#ifdef MK_SELFCHECK
    n += 1 + 3;
#endif
    return n;
}
extern "C" void kernel_launch(void* const* d_in, const int* in_sizes, int n_in, void* d_out, int out_size, void* d_ws, size_t ws_size, hipStream_t stream) {
    static int grid = 0;
    if (grid == 0) {
        if (n_in != 24 || in_sizes[0] != T * D || out_size != T * D || ws_size < WS_NEED) { fprintf(stderr, "kernel_launch: unexpected shapes (n_in %d, in0 %d, out %d, ws %zu < %zu); nothing launched\n", n_in, n_in > 0 ? in_sizes[0] : -1, out_size, ws_size, (size_t)WS_NEED); grid = -1; return; }
        int dev = 0, cus = 0, per_cu = 0;
        if (hipGetDevice(&dev) != hipSuccess || hipDeviceGetAttribute(&cus, hipDeviceAttributeMultiprocessorCount, dev) != hipSuccess) { grid = -1; return; }
        if (hipFuncSetAttribute((const void*)mk_fwd, hipFuncAttributeMaxDynamicSharedMemorySize, LDS_BYTES) != hipSuccess) { fprintf(stderr, "kernel_launch: hipFuncSetAttribute failed\n"); grid = -1; return; }
        if (hipOccupancyMaxActiveBlocksPerMultiprocessor(&per_cu, (const void*)mk_fwd, NWAVES * 64, LDS_BYTES) != hipSuccess || per_cu < 1) fprintf(stderr, "kernel_launch: occupancy query reports %d\n", per_cu);
        (void)hipGetLastError();
        grid = cus;
    }
    if (grid < 0) return;
    (void)hipMemsetAsync((char*)d_ws + WS_CTL, 0, CTL_ZERO_BYTES, stream);
#ifdef SELF_POISON
    (void)hipMemsetAsync((char*)d_ws + CTL_ZERO_BYTES, 0xAA, WS_NEED - CTL_ZERO_BYTES, stream);
    (void)hipMemsetAsync(d_out, 0xAA, (size_t)T * D * 4, stream);
#endif
    Args a{};
    for (int i = 0; i < 24; ++i) a.in[i] = (const float*)d_in[i];
    a.out = (float*)d_out; a.ws = (unsigned char*)d_ws;
    const int nph = count_phases();
#if MK_MULTI
    for (int p = 0; p < nph; ++p) { a.ph_lo = p; a.ph_hi = p + 1; hipLaunchKernelGGL(mk_fwd, dim3(grid), dim3(NWAVES * 64), LDS_BYTES, stream, a); }
#else
    a.ph_lo = 0; a.ph_hi = nph;
#ifdef MK_SELFCHECK
    a.chk = 1;
    hipLaunchKernelGGL(mk_fwd, dim3(grid), dim3(NWAVES * 64), LDS_BYTES, stream, a);
    (void)hipMemsetAsync((char*)d_ws + WS_CTL, 0, CTL_ZERO_BYTES, stream);
    a.chk = 2;
#endif
    hipLaunchKernelGGL(mk_fwd, dim3(grid), dim3(NWAVES * 64), LDS_BYTES, stream, a);
#endif
    const hipError_t le = hipPeekAtLastError();
    if (le != hipSuccess) fprintf(stderr, "kernel_launch: launch failed: %s\n", hipGetErrorName(le));
}
```

```cpp
#include <hip/hip_runtime.h>
#include <cstdio>
#include <cstdint>

#ifndef MK_MULTI
#define MK_MULTI 0
#endif
#ifndef MK_PROBE
#define MK_PROBE 0
#endif
#ifndef MK_ENABLE
#define MK_ENABLE 0xFF
#endif

#define GAS __attribute__((address_space(1)))
#define LAS __attribute__((address_space(3)))
typedef unsigned short bf16;
typedef short bf16x8 __attribute__((ext_vector_type(8)));
typedef float f32x4 __attribute__((ext_vector_type(4)));
typedef float f32x2 __attribute__((ext_vector_type(2)));
typedef float f32x16 __attribute__((ext_vector_type(16)));
typedef unsigned u32x4 __attribute__((ext_vector_type(4)));
typedef unsigned u32x2 __attribute__((ext_vector_type(2)));
typedef GAS unsigned gu32;
typedef int v8i_t __attribute__((ext_vector_type(8)));
typedef int v4i_t __attribute__((ext_vector_type(4)));
typedef short s16x16_t __attribute__((ext_vector_type(16)));

constexpr int D = 1024, NB = 32, SEQ = 2048, T = NB * SEQ, NH = 16, HD = 64;
constexpr int DFF = 2816, NE = 8, DFE = 3584;
constexpr float ALPHA = 1.6817928305074290f;
constexpr float LN_EPS = 1e-5f;
constexpr float LOG2E = 1.4426950408889634f;
constexpr float QSCALE = 0.125f * LOG2E;
constexpr float NEGB = -1e30f;
constexpr int TC = 16384;
constexpr int MOE_CH_TILES = 256;
constexpr int MOE_MAX_TILES = 520;
constexpr int FFN_GU8 = 1;

constexpr size_t MiB = 1u << 20;
constexpr size_t WS_CTL = 0, CTL_ZERO_BYTES = 1 * MiB;
constexpr size_t WS_BUCKET = 1 * MiB;
constexpr size_t WS_BTABA = WS_BUCKET + 8192;
constexpr size_t WS_BTABC = WS_BTABA + 32768;
constexpr size_t WS_WST = WS_BTABC + 131072;
constexpr size_t WS_KMEAN = 2 * MiB;
constexpr size_t WS_ROUTE = 4 * MiB;
constexpr size_t WS_GATES = 5 * MiB;
constexpr size_t WS_SLOTS = 6 * MiB;
constexpr size_t WS_WCNT = 7 * MiB;
constexpr size_t WS_W = 8 * MiB;
constexpr size_t W_A_QK = WS_W;
constexpr size_t W_A_V = W_A_QK + 12 * MiB;
constexpr size_t W_A_O = W_A_V + 6 * MiB;
constexpr size_t W_B_IN = W_A_O + 2 * MiB;
constexpr size_t W_B_O = W_B_IN + 6 * MiB;
constexpr size_t W_C_QK = W_B_O + 2 * MiB;
constexpr size_t W_C_V = W_C_QK + 4 * MiB;
constexpr size_t W_C_O = W_C_V + 2 * MiB;
constexpr size_t W_D_IN = W_C_O + 2 * MiB;
constexpr size_t W_D_O = W_D_IN + 4 * MiB;
constexpr size_t W_F_GU = W_D_O + 2 * MiB;
constexpr size_t W_F_D = W_F_GU + 22 * MiB;
constexpr size_t W_E_GU = W_F_D + 11 * MiB;
constexpr size_t W_E_D = W_E_GU + 224 * MiB;
constexpr size_t WS_HB = W_E_D + 112 * MiB;
constexpr size_t WS_SCR = WS_HB + 128 * MiB;
constexpr size_t WS_NEED = WS_SCR + 512 * MiB;
static_assert(WS_HB == 419 * MiB, "map");
constexpr size_t S_QK = 0;
constexpr size_t S_VT = 192 * MiB;
constexpr size_t S_HB8 = 416 * MiB;
constexpr size_t S_ATT = 288 * MiB;
constexpr size_t S_HID = 0;
constexpr size_t S_BCX = 0;
constexpr size_t S_P = 384 * MiB;
constexpr size_t S_XG = 0;
constexpr size_t S_MHID = 260 * MiB;
constexpr size_t S_Y = 256 * MiB;
constexpr size_t S_CQK = 0;
constexpr size_t S_CVT = 256 * MiB;
constexpr size_t S_CATT = 384 * MiB;
constexpr size_t S_UV = 0;
constexpr size_t O_OG = 0;
constexpr size_t O_LSE = 96 * MiB;
constexpr int CW_TMO = 0;
constexpr int CW_ECNT = 64;
constexpr int CW_BAR = 4096;
constexpr int CW_LNC = 16384;

constexpr float ASCALE8 = 8.f;
constexpr float WSCALE8 = 64.f, WSCALE8D = 256.f;
__device__ __forceinline__ unsigned pk4_fp8(float a, float b, float c, float d) { int p = 0; p = __builtin_amdgcn_cvt_pk_fp8_f32(a, b, p, false); p = __builtin_amdgcn_cvt_pk_fp8_f32(c, d, p, true); return (unsigned)p; }
namespace pg8 {
constexpr int BM = 256, BK = 64, HALF = 128, HTB = HALF * BK * 2, STAGE_BYTES = 8 * HTB, NXCD = 8, WGM = 8;
__host__ __device__ __forceinline__ int lds_byte(int r, int c) { const int st = (r >> 4) * 2 + (c >> 5), rr = r & 15, cc = c & 31, ob = rr * 64 + cc * 2; return st * 1024 + (ob ^ (((ob >> 9) & 1) << 5)); }
__host__ __device__ __forceinline__ void stage_rc(int b, int& R, int& C) { const int st = b / 1024, sb = b % 1024, swz = sb ^ (((sb >> 9) & 1) << 5); R = (st >> 1) * 16 + swz / 64; C = (st & 1) * 32 + (swz % 64) / 2; }
__host__ __device__ __forceinline__ int perm32(int rho) { const int n = rho >> 4, i = rho & 15; return 8 * (i >> 2) + 4 * n + (i & 3); }

struct Unit { int pm, pn; unsigned a, b; };
struct Gemm { int K; int rsA, rsB; size_t hstepA, hstepB; };

__device__ __forceinline__ bool tile_of(long L, int nM, int nN, int& pm, int& pn) {
    const int nwg = nM * nN; if (L >= nwg) return false;
    int wgid = (int)L; { const int q = nwg / NXCD, r = nwg % NXCD, xcd = wgid % NXCD, off = wgid / NXCD; wgid = (xcd < r ? xcd * (q + 1) : r * (q + 1) + (xcd - r) * q) + off; }
    const int nig = WGM * nN, gid = wgid / nig, fm = gid * WGM, gsz = (nM - fm) < WGM ? (nM - fm) : WGM;
    pm = fm + ((wgid % nig) % gsz); pn = (wgid % nig) / gsz; return true;
}
struct LinOrder {
    int nM, nN, G, c; const char* A0; const char* B0; size_t aT, bT;
    __device__ __forceinline__ bool next(int i, Unit& u) const { if (!tile_of((long)i * G + c, nM, nN, u.pm, u.pn)) return false; u.a = (unsigned)((size_t)u.pm * aT); u.b = (unsigned)((size_t)u.pn * bT); return true; }
};

typedef __bf16 bf16x2_t __attribute__((ext_vector_type(2)));
__device__ __forceinline__ unsigned cvt_pk_bf16(float lo, float hi) { f32x2 v = {lo, hi}; bf16x2_t b = __builtin_convertvector(v, bf16x2_t); return __builtin_bit_cast(unsigned, b); }
__device__ __forceinline__ f32x2 gelu_pk(f32x2 v) {
    const f32x2 av = __builtin_elementwise_abs(v), d = av * 0.2316418882f + 1.0f;
    f32x2 t; t.x = __builtin_amdgcn_rcpf(d.x); t.y = __builtin_amdgcn_rcpf(d.y);
    f32x2 q = t * 0.5307027145f + (-0.7265760135f); q = q * t + 0.7107068705f; q = q * t + (-0.142248368f); q = q * t + 0.127414796f; q = q * t;
    const f32x2 s = (v * v) * (-0.72134752044f);
    f32x2 e; e.x = __builtin_amdgcn_exp2f(s.x); e.y = __builtin_amdgcn_exp2f(s.y);
    const f32x2 m = v * (q * e), r = v - m;
    f32x2 o; o.x = v.x < 0.f ? m.x : r.x; o.y = v.y < 0.f ? m.y : r.y; return o;
}
__device__ __forceinline__ float silu_f(float g) { return g * __builtin_amdgcn_rcpf(1.0f + __builtin_amdgcn_exp2f(-LOG2E * g)); }

template <int ACT  > struct EpiBf16 {
    static constexpr bool PERM = true;
    bf16* O; int ldc; float sc = 1.f;
    __device__ __forceinline__ void operator()(const f32x4 (&acc)[2][2][4][2], const Unit& u, int wr, int wc, int fr, int fq) const {
        const int row0 = u.pm * BM + wr * 64 + fr, col0 = u.pn * BM + wc * 32 + 8 * fq;
#pragma unroll
        for (int ai = 0; ai < 2; ++ai)
#pragma unroll
            for (int m = 0; m < 4; ++m) { bf16* rowp = O + (size_t)(row0 + ai * HALF + m * 16) * ldc + col0;
#pragma unroll
                for (int bj = 0; bj < 2; ++bj) { f32x4 v0 = acc[ai][bj][m][0] * sc, v1 = acc[ai][bj][m][1] * sc;
                    if (ACT == 1) { f32x2 a = gelu_pk((f32x2){v0[0], v0[1]}), b = gelu_pk((f32x2){v0[2], v0[3]}), c = gelu_pk((f32x2){v1[0], v1[1]}), d = gelu_pk((f32x2){v1[2], v1[3]});
                        v0 = (f32x4){a.x, a.y, b.x, b.y}; v1 = (f32x4){c.x, c.y, d.x, d.y}; }
                    u32x4 w; w.x = cvt_pk_bf16(v0[0], v0[1]); w.y = cvt_pk_bf16(v0[2], v0[3]); w.z = cvt_pk_bf16(v1[0], v1[1]); w.w = cvt_pk_bf16(v1[2], v1[3]);
                    *(u32x4*)(rowp + bj * HALF) = w; } }
    }
};
template <int ACT  > struct EpiGlu {
    static constexpr bool PERM = true;
    bf16* O; int ldc;
    __device__ __forceinline__ void operator()(const f32x4 (&acc)[2][2][4][2], const Unit& u, int wr, int wc, int fr, int fq) const {
        const int row0 = u.pm * BM + wr * 64 + fr, col0 = u.pn * HALF + wc * 32 + 8 * fq;
#pragma unroll
        for (int ai = 0; ai < 2; ++ai)
#pragma unroll
            for (int m = 0; m < 4; ++m) { bf16* rowp = O + (size_t)(row0 + ai * HALF + m * 16) * ldc + col0;
                f32x4 g0 = acc[ai][0][m][0], g1 = acc[ai][0][m][1]; const f32x4 u0 = acc[ai][1][m][0], u1 = acc[ai][1][m][1];
                if (ACT == 1) { g0 = (f32x4){silu_f(g0[0]), silu_f(g0[1]), silu_f(g0[2]), silu_f(g0[3])}; g1 = (f32x4){silu_f(g1[0]), silu_f(g1[1]), silu_f(g1[2]), silu_f(g1[3])}; }
                const f32x4 p0 = g0 * u0, p1 = g1 * u1;
                u32x4 w; w.x = cvt_pk_bf16(p0[0], p0[1]); w.y = cvt_pk_bf16(p0[2], p0[3]); w.z = cvt_pk_bf16(p1[0], p1[1]); w.w = cvt_pk_bf16(p1[2], p1[3]);
                *(u32x4*)rowp = w; }
    }
};
struct EpiSwiglu8 {
    static constexpr bool PERM = true;
    unsigned char* O; int ldc; float s = 1.f;
    __device__ __forceinline__ void operator()(const f32x4 (&acc)[2][2][4][2], const Unit& u, int wr, int wc, int fr, int fq) const {
        const int row0 = u.pm * BM + wr * 64 + fr, col0 = u.pn * HALF + wc * 32 + 8 * fq;
#pragma unroll
        for (int ai = 0; ai < 2; ++ai)
#pragma unroll
            for (int m = 0; m < 4; ++m) { unsigned char* rowp = O + (size_t)(row0 + ai * HALF + m * 16) * ldc + col0;
                const f32x4 g0 = acc[ai][0][m][0], g1 = acc[ai][0][m][1], u0 = acc[ai][1][m][0], u1 = acc[ai][1][m][1];
                const f32x4 gg0 = g0 * s, gg1 = g1 * s, uu0 = u0 * s, uu1 = u1 * s;
                u32x2 w; w.x = pk4_fp8(silu_f(gg0[0]) * uu0[0], silu_f(gg0[1]) * uu0[1], silu_f(gg0[2]) * uu0[2], silu_f(gg0[3]) * uu0[3]);
                w.y = pk4_fp8(silu_f(gg1[0]) * uu1[0], silu_f(gg1[1]) * uu1[1], silu_f(gg1[2]) * uu1[2], silu_f(gg1[3]) * uu1[3]);
                *(u32x2*)rowp = w; }
    }
};
struct EpiResBf16 {
    static constexpr bool PERM = true;
    const bf16* base; bf16* out; int ldc; float alpha; float sc = 1.f;
    __device__ __forceinline__ void operator()(const f32x4 (&acc)[2][2][4][2], const Unit& u, int wr, int wc, int fr, int fq) const {
        const int row0 = u.pm * BM + wr * 64 + fr, col0 = u.pn * BM + wc * 32 + 8 * fq;
#pragma unroll
        for (int ai = 0; ai < 2; ++ai)
#pragma unroll
            for (int m = 0; m < 4; ++m) { const size_t off = (size_t)(row0 + ai * HALF + m * 16) * ldc + col0;
#pragma unroll
                for (int bj = 0; bj < 2; ++bj) { const u32x4 b = *(const u32x4*)(base + off + bj * HALF); const f32x4 a0 = acc[ai][bj][m][0] * sc, a1 = acc[ai][bj][m][1] * sc;
                    u32x4 w; w.x = cvt_pk_bf16(__builtin_bit_cast(float, b.x << 16) * alpha + a0[0], __builtin_bit_cast(float, b.x & 0xffff0000u) * alpha + a0[1]);
                    w.y = cvt_pk_bf16(__builtin_bit_cast(float, b.y << 16) * alpha + a0[2], __builtin_bit_cast(float, b.y & 0xffff0000u) * alpha + a0[3]);
                    w.z = cvt_pk_bf16(__builtin_bit_cast(float, b.z << 16) * alpha + a1[0], __builtin_bit_cast(float, b.z & 0xffff0000u) * alpha + a1[1]);
                    w.w = cvt_pk_bf16(__builtin_bit_cast(float, b.w << 16) * alpha + a1[2], __builtin_bit_cast(float, b.w & 0xffff0000u) * alpha + a1[3]);
                    *(u32x4*)(out + off + bj * HALF) = w; }
                asm volatile("" ::: "memory"); }
    }
};

template <bool HB8> struct EpiResLn {
    static constexpr bool PERM = true;
    bf16* h; const float* gain; const float* bias; float alpha, sc;
    float* xbuf;
    unsigned* cnt;
    unsigned* tmo;
    unsigned char* h8;
    LAS unsigned char* tb;
    __device__ __forceinline__ void operator()(f32x4 (&acc)[2][2][4][2], const Unit& u, int wr, int wc, int fr, int fq) const {
        asm volatile("" : "+v"(fr), "+v"(fq));
        const int row0 = u.pm * BM + wr * 64 + fr, col0 = u.pn * BM + wc * 32 + 8 * fq;
        LAS f32x2* P = (LAS f32x2*)tb; LAS f32x2* S = (LAS f32x2*)(tb + 8192);
#pragma unroll
        for (int ai = 0; ai < 2; ++ai)
#pragma unroll
            for (int m = 0; m < 4; ++m) { const size_t off = (size_t)(row0 + ai * HALF + m * 16) * 1024 + col0; float sm = 0.f, sq = 0.f;
#pragma unroll
                for (int bj = 0; bj < 2; ++bj) { const u32x4 b = *(const u32x4*)(h + off + bj * HALF); const f32x4 a0 = acc[ai][bj][m][0] * sc, a1 = acc[ai][bj][m][1] * sc;
                    f32x4 z0, z1;
                    z0[0] = __builtin_bit_cast(float, b.x << 16) * alpha + a0[0]; z0[1] = __builtin_bit_cast(float, b.x & 0xffff0000u) * alpha + a0[1];
                    z0[2] = __builtin_bit_cast(float, b.y << 16) * alpha + a0[2]; z0[3] = __builtin_bit_cast(float, b.y & 0xffff0000u) * alpha + a0[3];
                    z1[0] = __builtin_bit_cast(float, b.z << 16) * alpha + a1[0]; z1[1] = __builtin_bit_cast(float, b.z & 0xffff0000u) * alpha + a1[1];
                    z1[2] = __builtin_bit_cast(float, b.w << 16) * alpha + a1[2]; z1[3] = __builtin_bit_cast(float, b.w & 0xffff0000u) * alpha + a1[3];
                    acc[ai][bj][m][0] = z0; acc[ai][bj][m][1] = z1;
                    sm += ((z0[0] + z0[1]) + (z0[2] + z0[3])) + ((z1[0] + z1[1]) + (z1[2] + z1[3]));
                    sq += ((z0[0] * z0[0] + z0[1] * z0[1]) + (z0[2] * z0[2] + z0[3] * z0[3])) + ((z1[0] * z1[0] + z1[1] * z1[1]) + (z1[2] * z1[2] + z1[3] * z1[3])); }
                sm += __shfl_xor(sm, 16); sm += __shfl_xor(sm, 32); sq += __shfl_xor(sq, 16); sq += __shfl_xor(sq, 32);
                if (fq == 0) P[(ai * HALF + wr * 64 + m * 16 + fr) * 4 + wc] = (f32x2){sm, sq};
                asm volatile("" ::: "memory"); }
        asm volatile("s_waitcnt lgkmcnt(0)" ::: "memory"); __builtin_amdgcn_s_barrier(); asm volatile("" ::: "memory");
        const int wid = wr * 4 + wc, lane = fq * 16 + fr, row = wid * 32 + (lane & 31);
        unsigned long long* slots = (unsigned long long*)xbuf + (size_t)(u.pm * BM + row) * 4;
        if (lane < 32) { const f32x2 a = P[row * 4 + 0], b = P[row * 4 + 1], c = P[row * 4 + 2], d = P[row * 4 + 3];
            const float ts = (a.x + b.x) + (c.x + d.x), tq = (a.y + b.y) + (c.y + d.y);
            __hip_atomic_store(slots + u.pn, ((unsigned long long)__builtin_bit_cast(unsigned, tq) << 32) | (unsigned long long)__builtin_bit_cast(unsigned, ts), __ATOMIC_RELAXED, __HIP_MEMORY_SCOPE_AGENT); }
        asm volatile("s_waitcnt vmcnt(0)" ::: "memory");
        if (lane == 0) (void)__hip_atomic_fetch_add(cnt + 16 * u.pm, 1u, __ATOMIC_RELAXED, __HIP_MEMORY_SCOPE_AGENT);
        if (wid == 0) { unsigned sp = 0u;
            while ((unsigned)__builtin_amdgcn_readfirstlane(__hip_atomic_load(cnt + 16 * u.pm, __ATOMIC_RELAXED, __HIP_MEMORY_SCOPE_AGENT)) < 32u) { __builtin_amdgcn_s_sleep(1);
                if ((++sp & 255u) == 0u) { if (__hip_atomic_load(tmo, __ATOMIC_RELAXED, __HIP_MEMORY_SCOPE_AGENT)) break; if (sp > (1u << 22)) { if (lane == 0) (void)__hip_atomic_fetch_add(tmo, 1u, __ATOMIC_RELAXED, __HIP_MEMORY_SCOPE_AGENT); break; } } }
            __builtin_amdgcn_fence(__ATOMIC_ACQUIRE, "agent"); }
        asm volatile("s_waitcnt vmcnt(0) lgkmcnt(0)" ::: "memory"); __builtin_amdgcn_s_barrier(); asm volatile("" ::: "memory");
        if (lane < 32) { float ts = 0.f, tq = 0.f;
#pragma unroll
            for (int t = 0; t < 4; ++t) { const unsigned long long w = __hip_atomic_load(slots + t, __ATOMIC_RELAXED, __HIP_MEMORY_SCOPE_AGENT); ts += __builtin_bit_cast(float, (unsigned)w); tq += __builtin_bit_cast(float, (unsigned)(w >> 32)); }
            const float mean = ts * (1.f / 1024.f), var = fmaxf(tq * (1.f / 1024.f) - mean * mean, 0.f);
            S[row] = (f32x2){mean, 1.f / sqrtf(var + LN_EPS)}; }
        asm volatile("s_waitcnt vmcnt(0) lgkmcnt(0)" ::: "memory"); __builtin_amdgcn_s_barrier(); asm volatile("" ::: "memory");
#pragma unroll
        for (int bj = 0; bj < 2; ++bj) { const f32x4 g0 = *(const f32x4*)(gain + col0 + bj * HALF), g1 = *(const f32x4*)(gain + col0 + bj * HALF + 4), b0 = *(const f32x4*)(bias + col0 + bj * HALF), b1 = *(const f32x4*)(bias + col0 + bj * HALF + 4);
#pragma unroll
            for (int ai = 0; ai < 2; ++ai)
#pragma unroll
                for (int m = 0; m < 4; ++m) { const int r = ai * HALF + wr * 64 + m * 16 + fr; const f32x2 sr = S[r]; const size_t off = (size_t)(u.pm * BM + r) * 1024 + col0 + bj * HALF;
                    const f32x4 y0 = (acc[ai][bj][m][0] - sr.x) * sr.y * g0 + b0, y1 = (acc[ai][bj][m][1] - sr.x) * sr.y * g1 + b1;
                    u32x4 w; w.x = cvt_pk_bf16(y0[0], y0[1]); w.y = cvt_pk_bf16(y0[2], y0[3]); w.z = cvt_pk_bf16(y1[0], y1[1]); w.w = cvt_pk_bf16(y1[2], y1[3]);
                    *(u32x4*)(h + off) = w;
                    if (HB8) { u32x2 w8; w8.x = pk4_fp8(y0[0], y0[1], y0[2], y0[3]); w8.y = pk4_fp8(y1[0], y1[1], y1[2], y1[3]); *(u32x2*)(h8 + off) = w8; }
                    asm volatile("" ::: "memory"); } }
    }
};

template <class Epi, class Sched, bool ALIGN_EPI = true, int FP8 = 0>
__device__ __forceinline__ void gemm_phase(LAS unsigned char* lds, const int wave_s, const Gemm g, const Sched& S, const Epi& E) {
    int tid = wave_s * 64 + (int)__builtin_amdgcn_mbcnt_hi(~0u, __builtin_amdgcn_mbcnt_lo(~0u, 0u)); asm volatile("" : "+v"(tid));
    const int wid = __builtin_amdgcn_readfirstlane(tid >> 6), lane = tid & 63, wr = wid >> 2, wc = wid & 3, fr = lane & 15, fq = lane >> 4;
    const int K = g.K, nt = K / BK;
    unsigned voffA[2], voffB[2];
#pragma unroll
    for (int i = 0; i < 2; ++i) { int R, C; stage_rc(tid * 16 + i * 8192, R, C); const int Rb = Epi::PERM ? ((R & ~31) + perm32(R & 31)) : R;
        voffA[i] = (unsigned)(R * g.rsA * K + C) * 2u; voffB[i] = (unsigned)(Rb * g.rsB * K + C) * 2u; }
    const unsigned kstep = (unsigned)(BK * 2);
    const unsigned hstepA = (unsigned)g.hstepA, hstepB = (unsigned)g.hstepB;
    const __amdgpu_buffer_rsrc_t rsrcA = __builtin_amdgcn_make_buffer_rsrc((void*)S.A0, 0, 0x7fffffff, 0x00020000), rsrcB = __builtin_amdgcn_make_buffer_rsrc((void*)S.B0, 0, 0x7fffffff, 0x00020000);
    const unsigned ldsw = (unsigned)wid * 1024u;
    const int aoff = lds_byte(wr * 64 + fr, fq * 8), boff = lds_byte(wc * 32 + fr, fq * 8);
    const int aoff8 = lds_byte(wr * 64 + fr, fq * 16), boff8 = lds_byte(wc * 32 + fr, fq * 16);
    unsigned bbase8_ = (unsigned)(4 * HTB + boff); asm volatile("" : "+v"(bbase8_));
    LAS unsigned char* const ldsB8 = lds + bbase8_;
#define PG8_SA(b, h) (((b) * 2 + (h)) * HTB)
#define PG8_SB(b, h) ((4 + (b) * 2 + (h)) * HTB)
#define PG8_STAGE(bufoff, gbase, voff) do { _Pragma("unroll") for (int _i = 0; _i < 2; ++_i) \
        __builtin_amdgcn_raw_ptr_buffer_load_lds(PG8_RS_##voff, (LAS unsigned*)(lds + (bufoff) + ldsw + _i * 8192), 16, (int)(voff)[_i], (int)(gbase), 0, 0); } while (0)
#define PG8_RS_voffA rsrcA
#define PG8_RS_voffB rsrcB
#define PG8_LD16(off) (*(const LAS bf16x8*)(lds + (off)))
#define PG8_CAT8(lo, hi) __builtin_shufflevector(__builtin_bit_cast(v4i_t, lo), __builtin_bit_cast(v4i_t, hi), 0, 1, 2, 3, 4, 5, 6, 7)
#define PG8_LDA(dst, b, h) do { if constexpr (FP8) { _Pragma("unroll") for (int m = 0; m < 4; ++m) dst##8[m] = PG8_CAT8(PG8_LD16(PG8_SA(b, h) + aoff + m * 2048), PG8_LD16(PG8_SA(b, h) + aoff + m * 2048 + 1024)); } \
        else { _Pragma("unroll") for (int m = 0; m < 4; ++m) _Pragma("unroll") for (int k = 0; k < 2; ++k) dst[m][k] = PG8_LD16(PG8_SA(b, h) + aoff + m * 2048 + k * 1024); } } while (0)
#define PG8_LDB(dst, b, h) do { if constexpr (FP8) { _Pragma("unroll") for (int n = 0; n < 2; ++n) dst##8[n] = PG8_CAT8(*(const LAS bf16x8*)(ldsB8 + ((b) * 2 + (h)) * HTB + n * 2048), *(const LAS bf16x8*)(ldsB8 + ((b) * 2 + (h)) * HTB + n * 2048 + 1024)); } \
        else { _Pragma("unroll") for (int n = 0; n < 2; ++n) _Pragma("unroll") for (int k = 0; k < 2; ++k) dst[n][k] = PG8_LD16(PG8_SB(b, h) + boff + n * 2048 + k * 1024); } } while (0)
#define PG8_MMA(ai, bj, At, Bt) do { __builtin_amdgcn_s_setprio(1); \
        if constexpr (FP8) { _Pragma("unroll") for (int m = 0; m < 4; ++m) _Pragma("unroll") for (int n = 0; n < 2; ++n) \
            acc[ai][bj][m][n] = __builtin_amdgcn_mfma_scale_f32_16x16x128_f8f6f4(Bt##8[n], At##8[m], acc[ai][bj][m][n], 0, 0, 0, 0, 0, 0); } \
        else { _Pragma("unroll") for (int m = 0; m < 4; ++m) _Pragma("unroll") for (int n = 0; n < 2; ++n) _Pragma("unroll") for (int k = 0; k < 2; ++k) \
            acc[ai][bj][m][n] = __builtin_amdgcn_mfma_f32_16x16x32_bf16(Bt[n][k], At[m][k], acc[ai][bj][m][n], 0, 0, 0); } \
        __builtin_amdgcn_s_setprio(0); } while (0)
#define PG8_WAIT_V(n) asm volatile("s_waitcnt vmcnt(" #n ")" ::: "memory")
#define PG8_WAIT_L(n) asm volatile("s_waitcnt lgkmcnt(" #n ")" ::: "memory")
#define PG8_BAR __builtin_amdgcn_s_barrier()
#define PG8_SCHED __builtin_amdgcn_sched_barrier(0)
    Unit cur, nxt; int ui = 0;
    if (!S.next(0, cur)) return;
    f32x4 acc[2][2][4][2];
#pragma unroll
    for (int a = 0; a < 2; ++a)
#pragma unroll
        for (int b = 0; b < 2; ++b)
#pragma unroll
            for (int m = 0; m < 4; ++m)
#pragma unroll
                for (int n = 0; n < 2; ++n) acc[a][b][m][n] = (f32x4){0.f, 0.f, 0.f, 0.f};
    bf16x8 At[4][2], B0[2][2], B1[2][2]; v8i_t At8[4], B08[2], B18[2];
    unsigned cA = cur.a, cB = cur.b;
    PG8_STAGE(PG8_SB(0, 0), cB, voffB); PG8_STAGE(PG8_SB(0, 1), cB + hstepB, voffB); PG8_STAGE(PG8_SA(0, 0), cA, voffA); PG8_STAGE(PG8_SA(0, 1), cA + hstepA, voffA);
    if (wr == 1) PG8_BAR;
    PG8_WAIT_V(2); PG8_BAR;
    PG8_STAGE(PG8_SB(1, 0), cB + kstep, voffB); PG8_STAGE(PG8_SA(1, 0), cA + kstep, voffA); PG8_STAGE(PG8_SB(1, 1), cB + hstepB + kstep, voffB);
    PG8_WAIT_V(6); PG8_BAR;
    for (;;) {
        const bool has_next = S.next(ui + 1, nxt);
        const unsigned nA = has_next ? nxt.a : cA, nB = has_next ? nxt.b : cB;
#pragma clang loop unroll(disable)
        for (int t = 0; t < nt; t += 2) {
            const bool last = (t == nt - 2);
            const unsigned a1 = cA + (unsigned)(t + 1) * kstep;
            const unsigned a2 = last ? nA : cA + (unsigned)(t + 2) * kstep, b2 = last ? nB : cB + (unsigned)(t + 2) * kstep;
            const unsigned a3 = a2 + kstep, b3 = b2 + kstep;
            PG8_LDB(B0, 0, 0); PG8_LDB(B1, 0, 1); PG8_SCHED; PG8_LDA(At, 0, 0); PG8_STAGE(PG8_SA(1, 1), a1 + hstepA, voffA);
            PG8_WAIT_V(8); PG8_WAIT_L(0); PG8_BAR; PG8_MMA(0, 0, At, B0); PG8_MMA(0, 1, At, B1); PG8_BAR; PG8_SCHED;
            PG8_LDA(At, 0, 1); PG8_STAGE(PG8_SB(0, 0), b2, voffB); PG8_STAGE(PG8_SB(0, 1), b2 + hstepB, voffB); PG8_STAGE(PG8_SA(0, 0), a2, voffA);
            PG8_WAIT_V(8); PG8_WAIT_L(0); PG8_BAR; PG8_MMA(1, 0, At, B0); PG8_MMA(1, 1, At, B1); PG8_BAR; PG8_SCHED;
            PG8_LDB(B0, 1, 0); PG8_LDB(B1, 1, 1); PG8_SCHED; PG8_LDA(At, 1, 0); PG8_STAGE(PG8_SA(0, 1), a2 + hstepA, voffA);
            PG8_WAIT_V(8); PG8_WAIT_L(0); PG8_BAR; PG8_MMA(0, 0, At, B0); PG8_MMA(0, 1, At, B1); PG8_BAR; PG8_SCHED;
            PG8_LDA(At, 1, 1); PG8_STAGE(PG8_SB(1, 0), b3, voffB); PG8_STAGE(PG8_SB(1, 1), b3 + hstepB, voffB); PG8_STAGE(PG8_SA(1, 0), a3, voffA);
            PG8_WAIT_V(8); PG8_WAIT_L(0); PG8_BAR; PG8_MMA(1, 0, At, B0); PG8_MMA(1, 1, At, B1); PG8_BAR; PG8_SCHED;
        }
        if constexpr (ALIGN_EPI) { if (wr == 0) PG8_BAR; }
        E(acc, cur, wr, wc, fr, fq);
        if (!has_next) break;
#pragma unroll
        for (int a = 0; a < 2; ++a)
#pragma unroll
            for (int b = 0; b < 2; ++b)
#pragma unroll
                for (int m = 0; m < 4; ++m)
#pragma unroll
                    for (int n = 0; n < 2; ++n) acc[a][b][m][n] = (f32x4){0.f, 0.f, 0.f, 0.f};
        cur = nxt; cA = nA; cB = nB; ++ui;
        if constexpr (ALIGN_EPI) { if (wr == 1) PG8_BAR; }
    }
    PG8_WAIT_V(0);
    if constexpr (!ALIGN_EPI) { if (wr == 0) PG8_BAR; }
    PG8_BAR;
#undef PG8_SA
#undef PG8_SB
#undef PG8_STAGE
#undef PG8_RS_voffA
#undef PG8_RS_voffB
#undef PG8_LDA
#undef PG8_LD16
#undef PG8_CAT8
#undef PG8_LDB
#undef PG8_MMA
#undef PG8_WAIT_V
#undef PG8_WAIT_L
#undef PG8_BAR
#undef PG8_SCHED
}
}

#define RLX_AGENT __ATOMIC_RELAXED, __HIP_MEMORY_SCOPE_AGENT
#define LDS_WAIT() asm volatile("s_waitcnt lgkmcnt(0)" ::: "memory")
#define VM_WAIT() asm volatile("s_waitcnt vmcnt(0)" ::: "memory")
__device__ __forceinline__ unsigned f2bf(float f) { unsigned u = __builtin_bit_cast(unsigned, f); return (u + 0x7fffu + ((u >> 16) & 1u)) >> 16; }
__device__ __forceinline__ unsigned pk2(float lo, float hi) { return pg8::cvt_pk_bf16(lo, hi); }
__device__ __forceinline__ float bflo(unsigned w) { return __builtin_bit_cast(float, w << 16); }
__device__ __forceinline__ float bfhi(unsigned w) { return __builtin_bit_cast(float, w & 0xffff0000u); }
__device__ __forceinline__ float wave_sum(float v) {
#pragma unroll
    for (int o = 1; o < 64; o <<= 1) v += __shfl_xor(v, o);
    return v;
}

#define XB_TMO      128
#define XB_XCNT(j)  (256  + 64 * (j))
#define XB_XSUB(j)  (1280 + 64 * (j))
#define XB_XGEN(j)  (2304 + 64 * (j))
#define XB_TOP      3328
#define XB_TOPGEN   3392
#define XCD_BAR_WORDS 3456
#define XB_SPIN_CAP (1u << 22)
__device__ __forceinline__ unsigned xb_ld(unsigned* p)              { return __hip_atomic_load(p, __ATOMIC_RELAXED, __HIP_MEMORY_SCOPE_AGENT); }
__device__ __forceinline__ unsigned xb_add(unsigned* p, unsigned v) { return __hip_atomic_fetch_add(p, v, __ATOMIC_RELAXED, __HIP_MEMORY_SCOPE_AGENT); }
__device__ __forceinline__ unsigned xb_xcc_id() { return (unsigned)__builtin_amdgcn_s_getreg((3 << 11) | 20) & 0xFu; }
#define XB_SPIN(cond, bar) do { unsigned _sp = 0; while (cond) { __builtin_amdgcn_s_sleep(1); \
    if ((++_sp & 255u) == 0u) { if (xb_ld(&(bar)[XB_TMO])) break; if (_sp > XB_SPIN_CAP) { atomicAdd(&(bar)[XB_TMO], 1u); break; } } } } while (0)
struct XcdBarrier { unsigned* bar; unsigned x; volatile LAS unsigned* st; };
__device__ __forceinline__ XcdBarrier xcd_barrier_post(unsigned* bar, volatile LAS unsigned* st) {
    XcdBarrier b; b.bar = bar; b.x = xb_xcc_id(); b.st = st;
    if (threadIdx.x == 0) (void)xb_add(&bar[XB_XCNT(b.x)], 1u);
    return b;
}
__device__ __forceinline__ void xcd_barrier_complete(unsigned* bar, unsigned x, unsigned& nloc, unsigned& nx) {
    const unsigned G = gridDim.x * gridDim.y * gridDim.z;
    unsigned sum, cnt, mine, sp = 0u;
    for (;;) {
        sum = 0u; cnt = 0u; mine = 0u;
#pragma unroll
        for (unsigned j = 0; j < 16; ++j) { const unsigned c = xb_ld(&bar[XB_XCNT(j)]); sum += c; cnt += (c > 0u) ? 1u : 0u; mine = (j == x) ? c : mine; }
        if (sum == G) break;
        __builtin_amdgcn_s_sleep(1);
        if ((++sp & 255u) == 0u) { if (xb_ld(&bar[XB_TMO])) break; if (sp > XB_SPIN_CAP) { atomicAdd(&bar[XB_TMO], 1u); break; } }
    }
    nloc = mine > 0u ? mine : 1u; nx = cnt > 0u ? cnt : 1u;
}
__device__ __forceinline__ void xcd_barrier(const XcdBarrier& b, const int tid) {
    asm volatile("s_waitcnt vmcnt(0)" ::: "memory");
    __syncthreads();
    if (tid == 0) {
        unsigned* bar = b.bar;
        __builtin_amdgcn_s_waitcnt(0);
        unsigned nloc = b.st[0], nx = b.st[1];
        if (nloc == 0u) { xcd_barrier_complete(bar, b.x, nloc, nx); b.st[0] = nloc; b.st[1] = nx; }
        const unsigned old = xb_add(&bar[XB_XSUB(b.x)], 1u);
        const unsigned gen = old / nloc;
        if (old + 1u == (gen + 1u) * nloc) {
            __builtin_amdgcn_fence(__ATOMIC_RELEASE, "agent");
            asm volatile("s_waitcnt vmcnt(0)" ::: "memory");
            const unsigned og = xb_add(&bar[XB_TOP], 1u);
            const unsigned tg = og / nx;
            if (og + 1u == (tg + 1u) * nx) xb_add(&bar[XB_TOPGEN], 1u);
            else XB_SPIN(xb_ld(&bar[XB_TOPGEN]) == tg, bar);
            __builtin_amdgcn_fence(__ATOMIC_ACQUIRE, "agent");
            xb_add(&bar[XB_XGEN(b.x)], 1u);
            asm volatile("s_waitcnt vmcnt(0)" ::: "memory");
        } else {
            XB_SPIN(xb_ld(&bar[XB_XGEN(b.x)]) == gen, bar);
            __builtin_amdgcn_fence(__ATOMIC_ACQUIRE, "agent");
            asm volatile("s_waitcnt vmcnt(0)" ::: "memory");
        }
    }
    __syncthreads();
}

constexpr int NWAVES = 8;
constexpr int RING_BYTES = 131072, MISC_OFF = RING_BYTES + 320, LNT_OFF = RING_BYTES + 2048  , LDS_BYTES = 147456;
struct Args { const float* in[24]; float* out; unsigned char* ws; int ph_lo, ph_hi; int chk, pad; };
struct Frame {
    LAS unsigned char* lds;
    gu32* ctl; unsigned char* ws; float* out;
    int tid, lane, wave, vcu, G;
    int chk, stage;
};

struct Job { const float* src; bf16* dst; int ld, K, N, mode, start; float scale; int fp8, pad; };
constexpr int NJOBS = 74;
__device__ __forceinline__ void make_job(const Args& a, int j, Job& J) {
    unsigned char* ws = a.ws; J.scale = 1.f; J.mode = 0; J.start = 0; J.fp8 = 0; J.pad = 0;
    if (j < 9) { const int g = j / 3, t = j % 3; J.src = a.in[4] + g * 3072 + t * 1024; J.ld = 9216; J.K = 1024; J.N = 1024;
        if (t == 2) J.dst = (bf16*)(ws + W_A_V + (size_t)g * 1024 * 1024); else J.dst = (bf16*)(ws + W_A_QK + (size_t)g * 2048 * 1024 + (size_t)t * 1024 * 1024);
        J.fp8 = 1; J.scale = (t == 0 ? QSCALE : 1.f) * WSCALE8; return; }
    j -= 9;
    if (j == 0) { J.src = a.in[5]; J.ld = 1024; J.K = 1024; J.N = 1024; J.dst = (bf16*)(ws + W_A_O); J.fp8 = 1; J.scale = WSCALE8; return; }
    if (j == 1) { J.src = a.in[6]; J.ld = 3072; J.K = 1024; J.N = 1024; J.dst = (bf16*)(ws + W_B_IN); return; }
    if (j == 9 || j == 10) { J.src = a.in[6] + 1024 * (j - 8); J.ld = 3072; J.K = 1024; J.N = 1024; J.dst = (bf16*)(ws + W_B_IN) + (size_t)1024 * 1024; J.mode = j - 8; return; }
    if (j == 2) { J.src = a.in[8]; J.ld = 1024; J.K = 1024; J.N = 1024; J.dst = (bf16*)(ws + W_B_O); return; }
    if (j == 3) { J.src = a.in[9]; J.ld = 3072; J.K = 1024; J.N = 1024; J.dst = (bf16*)(ws + W_C_QK); J.scale = QSCALE; return; }
    if (j == 4) { J.src = a.in[9] + 1024; J.ld = 3072; J.K = 1024; J.N = 1024; J.dst = (bf16*)(ws + W_C_QK) + (size_t)1024 * 1024; return; }
    if (j == 5) { J.src = a.in[9] + 2048; J.ld = 3072; J.K = 1024; J.N = 1024; J.dst = (bf16*)(ws + W_C_V); return; }
    if (j == 6) { J.src = a.in[10]; J.ld = 1024; J.K = 1024; J.N = 1024; J.dst = (bf16*)(ws + W_C_O); J.fp8 = 1; J.scale = WSCALE8; return; }
    if (j == 7) { J.src = a.in[11]; J.ld = 2048; J.K = 1024; J.N = 2048; J.dst = (bf16*)(ws + W_D_IN); return; }
    if (j == 8) { J.src = a.in[16]; J.ld = 1024; J.K = 1024; J.N = 1024; J.dst = (bf16*)(ws + W_D_O); return; }
    j -= 11;
    if (j < 6) { const int f = j / 3, t = j % 3;
        if (t < 2) { J.src = a.in[17 + t] + (size_t)f * 1024 * DFF; J.ld = DFF; J.K = 1024; J.N = DFF; J.dst = (bf16*)(ws + W_F_GU) + (size_t)f * 2 * DFF * 1024; J.mode = 1 + t;
            if (f == FFN_GU8) { J.fp8 = 1; J.scale = WSCALE8; } }
        else { J.src = a.in[19] + (size_t)f * DFF * 1024; J.ld = 1024; J.K = DFF; J.N = 1024; J.dst = (bf16*)(ws + W_F_D) + (size_t)f * 1024 * DFF; J.fp8 = 1; J.scale = WSCALE8D; }
        return; }
    j -= 6;
    { const int fe = j / 3, t = j % 3;
        if (t < 2) { J.src = a.in[21 + t] + (size_t)fe * 1024 * DFE; J.ld = DFE; J.K = 1024; J.N = DFE; J.dst = (bf16*)(ws + W_E_GU) + (size_t)fe * 2 * DFE * 1024; J.mode = 1 + t; J.fp8 = 1; J.scale = WSCALE8; }
        else { J.src = a.in[23] + (size_t)fe * DFE * 1024; J.ld = 1024; J.K = DFE; J.N = 1024; J.dst = (bf16*)(ws + W_E_D) + (size_t)fe * 1024 * DFE; J.fp8 = 1; J.scale = WSCALE8D; } }
}
__device__ __forceinline__ void transpose_item(const Job& J, int item, int lane) {
    const int nblk = J.N >> 6, kb = item / nblk, nb = item - kb * nblk, k0 = 64 * kb, n = 64 * nb + lane;
    const float* W = J.src + (size_t)k0 * J.ld + n;
    int r = n; if (J.mode) r = (n >> 7) * 256 + (n & 127) + (J.mode == 2 ? 128 : 0);
    const float sc = J.scale; const size_t ld = (size_t)J.ld;
    if (J.fp8) {
        unsigned char* dst8 = (unsigned char*)J.dst + (size_t)r * J.K + k0;
#pragma unroll
        for (int hf = 0; hf < 2; ++hf) {
            float v[32];
#pragma unroll
            for (int j = 0; j < 32; ++j) v[j] = W[(size_t)(32 * hf + j) * ld];
#pragma unroll
            for (int c = 0; c < 2; ++c) { u32x4 o; o.x = pk4_fp8(v[16 * c] * sc, v[16 * c + 1] * sc, v[16 * c + 2] * sc, v[16 * c + 3] * sc); o.y = pk4_fp8(v[16 * c + 4] * sc, v[16 * c + 5] * sc, v[16 * c + 6] * sc, v[16 * c + 7] * sc);
                o.z = pk4_fp8(v[16 * c + 8] * sc, v[16 * c + 9] * sc, v[16 * c + 10] * sc, v[16 * c + 11] * sc); o.w = pk4_fp8(v[16 * c + 12] * sc, v[16 * c + 13] * sc, v[16 * c + 14] * sc, v[16 * c + 15] * sc);
                *(u32x4*)(dst8 + 32 * hf + 16 * c) = o; }
        }
        return;
    }
    bf16* dst = J.dst + (size_t)r * J.K + k0;
#pragma unroll
    for (int hf = 0; hf < 2; ++hf) {
        float v[32];
#pragma unroll
        for (int j = 0; j < 32; ++j) v[j] = W[(size_t)(32 * hf + j) * ld];
#pragma unroll
        for (int c = 0; c < 4; ++c) { u32x4 o; o.x = pk2(v[8 * c] * sc, v[8 * c + 1] * sc); o.y = pk2(v[8 * c + 2] * sc, v[8 * c + 3] * sc); o.z = pk2(v[8 * c + 4] * sc, v[8 * c + 5] * sc); o.w = pk2(v[8 * c + 6] * sc, v[8 * c + 7] * sc);
            *(u32x4*)(dst + 32 * hf + 8 * c) = o; }
    }
}
__device__ __forceinline__ int t5_bucket(int d) {
    if (d < 16) return d;
    int b = 16 + (int)(log((double)d / 16.0) / log(128.0) * 16.0);
    return b < 16 ? 16 : (b > 31 ? 31 : b);
}
__device__ __forceinline__ void p_prologue(Frame& F, const Args& a) {
    unsigned char* gl_ = (unsigned char*)F.lds;
    Job* jobs = (Job*)(gl_ + 7 * 16384 + 8704);
    int* tot = (int*)(gl_ + 7 * 16384 + 8704 + NJOBS * sizeof(Job));
    static_assert(8704 + NJOBS * sizeof(Job) + 16 <= 16384, "job table fits");
    if (F.tid < NJOBS) { Job J; make_job(a, F.tid, J); jobs[F.tid] = J; }
    __syncthreads();
    if (F.tid == 0) { int s = 0; for (int j = 0; j < NJOBS; ++j) { jobs[j].start = s; s += (jobs[j].K / 64) * (jobs[j].N / 64); } tot[0] = s; }
    __syncthreads();
    const int total = tot[0];
    const int gw = F.vcu * NWAVES + F.wave, NGW = F.G * NWAVES;
    int jc = 0;
    for (int it = gw; it < total; it += NGW) {
        while (jc + 1 < NJOBS && jobs[jc + 1].start <= it) ++jc;
        const Job J = jobs[jc];
        transpose_item(J, it - J.start, F.lane);
    }
    { bf16* hb = (bf16*)(F.ws + WS_HB); const float* x = a.in[0]; unsigned char* hb8 = F.ws + WS_SCR + S_HB8;
      for (int m0 = 4 * gw; m0 < T; m0 += 4 * NGW) { f32x4 v[4][4];
#pragma unroll
          for (int k = 0; k < 4; ++k) { const f32x4* xr = (const f32x4*)(x + (size_t)(m0 + k) * D) + F.lane;
#pragma unroll
              for (int j = 0; j < 4; ++j) v[k][j] = xr[64 * j]; }
#pragma unroll
          for (int k = 0; k < 4; ++k) { unsigned long long* o8 = (unsigned long long*)(hb + (size_t)(m0 + k) * D) + F.lane;
#pragma unroll
              for (int j = 0; j < 4; ++j) o8[64 * j] = (unsigned long long)pk2(v[k][j].x, v[k][j].y) | ((unsigned long long)pk2(v[k][j].z, v[k][j].w) << 32);
              unsigned* o4 = (unsigned*)(hb8 + (size_t)(m0 + k) * D) + F.lane;
#pragma unroll
              for (int j = 0; j < 4; ++j) o4[64 * j] = pk4_fp8(v[k][j].x, v[k][j].y, v[k][j].z, v[k][j].w); } } }
    const int gt = blockIdx.x * 512 + F.tid, NGT = F.G * 512;
    const float* rel = a.in[1];
    float* btA = (float*)(F.ws + WS_BTABA); float* btC = (float*)(F.ws + WS_BTABC);
    for (int i = gt; i < 48 * 132; i += NGT) { const int gh = i / 132, dl = i % 132, g = gh >> 4, hh = gh & 15; const int dil = g == 0 ? 1 : (g == 1 ? 4 : 16);
        btA[i] = dl <= 128 ? rel[t5_bucket(dl * dil) * NH + hh] * LOG2E : 0.f; }
    for (int i = gt; i < 16 * 2048; i += NGT) { const int hh = i >> 11, dd = i & 2047; btC[i] = rel[t5_bucket(dd) * NH + hh] * LOG2E; }
    { bf16* wst = (bf16*)(F.ws + WS_WST); const float* wsrc = a.in[14];
      for (int i = gt; i < 8 * 128 * 128; i += NGT) { const int tt = (i >> 7) & 127, ss = i & 127; wst[i] = (bf16)f2bf(ss <= tt ? wsrc[i] : 0.f); } }
}

__device__ __forceinline__ void unpack8(const u32x4 a, float* x) { x[0] = bflo(a.x); x[1] = bfhi(a.x); x[2] = bflo(a.y); x[3] = bfhi(a.y); x[4] = bflo(a.z); x[5] = bfhi(a.z); x[6] = bflo(a.w); x[7] = bfhi(a.w); }
template <int MODE, bool ROUTE, bool FINAL, bool HB8 = false>
__device__ __forceinline__ void ln_phase(Frame& F, const float* gain, const float* bias, const float* wr) {
    constexpr int NBT = 2;
    const int gw = F.vcu * NWAVES + F.wave, NGW = F.G * NWAVES, lane = F.lane;
    bf16* hb = (bf16*)(F.ws + WS_HB); const bf16* zb = (const bf16*)F.out;
    float gv[16], bv[16];
#pragma unroll
    for (int k = 0; k < 2; ++k)
#pragma unroll
        for (int j = 0; j < 2; ++j) { const f32x4 g4 = *(const f32x4*)(gain + 512 * k + 8 * lane + 4 * j), b4 = *(const f32x4*)(bias + 512 * k + 8 * lane + 4 * j);
            gv[8 * k + 4 * j] = g4.x; gv[8 * k + 4 * j + 1] = g4.y; gv[8 * k + 4 * j + 2] = g4.z; gv[8 * k + 4 * j + 3] = g4.w;
            bv[8 * k + 4 * j] = b4.x; bv[8 * k + 4 * j + 1] = b4.y; bv[8 * k + 4 * j + 2] = b4.z; bv[8 * k + 4 * j + 3] = b4.w; }
    LAS float* wrT = (LAS float*)F.lds;
    if (ROUTE) { for (int i = F.tid; i < 8 * 1024; i += 512) { const int e = i >> 10, c = i & 1023; wrT[i] = wr[c * 8 + e]; } __syncthreads(); }
    const bf16* ys = (const bf16*)(F.ws + WS_SCR + S_XG);
    const int* slots = (const int*)(F.ws + WS_SLOTS); const float* gates = (const float*)(F.ws + WS_GATES);
    int* route = (int*)(F.ws + WS_ROUTE); float* gout = (float*)(F.ws + WS_GATES);
    for (int grp = gw; grp < T / 32; grp += NGW) {
        int cnt_e = 0;
        int my_e1 = 0, my_e2 = 0, my_r1 = 0, my_r2 = 0; float my_g1 = 0.f, my_g2 = 0.f;
        int sl0 = 0, sl1 = 0; float gg0 = 0.f, gg1 = 0.f;
        if (MODE == 2) { const int mm = grp * 32 + (lane & 31); sl0 = slots[2 * mm]; sl1 = slots[2 * mm + 1]; gg0 = gates[2 * mm]; gg1 = gates[2 * mm + 1]; }
        for (int i0 = 0; i0 < 32; i0 += NBT) {
            float v[NBT][16]; float st[NBT][2];
#pragma unroll
            for (int k = 0; k < NBT; ++k) { const int m = grp * 32 + i0 + k;
                if (MODE == 0) { const u32x4* zr = (const u32x4*)(zb + (size_t)m * D) + lane; unpack8(zr[0], v[k]); unpack8(zr[64], v[k] + 8); }
                else { const u32x4* hr = (const u32x4*)(hb + (size_t)m * D) + lane; unpack8(hr[0], v[k]); unpack8(hr[64], v[k] + 8);
#pragma unroll
                    for (int j = 0; j < 16; ++j) v[k][j] *= ALPHA;
                    if (MODE == 3) { const u32x4* yr = (const u32x4*)((const bf16*)(F.ws + WS_SCR + S_Y) + (size_t)m * D) + lane; float a[16]; unpack8(yr[0], a); unpack8(yr[64], a + 8);
#pragma unroll
                        for (int j = 0; j < 16; ++j) v[k][j] += a[j]; }
                    if (MODE == 2) { const int s0 = __builtin_amdgcn_readlane(sl0, i0 + k), s1 = __builtin_amdgcn_readlane(sl1, i0 + k);
                        const float g0 = __builtin_bit_cast(float, __builtin_amdgcn_readlane(__builtin_bit_cast(int, gg0), i0 + k)), g1 = __builtin_bit_cast(float, __builtin_amdgcn_readlane(__builtin_bit_cast(int, gg1), i0 + k));
                        const u32x4* y0 = (const u32x4*)(ys + (size_t)s0 * D) + lane; const u32x4* y1 = (const u32x4*)(ys + (size_t)s1 * D) + lane;
                        float a[16], b[16]; unpack8(y0[0], a); unpack8(y0[64], a + 8); unpack8(y1[0], b); unpack8(y1[64], b + 8);
#pragma unroll
                        for (int j = 0; j < 16; ++j) v[k][j] += g0 * a[j] + g1 * b[j]; } }
                float s = 0.f, q2 = 0.f;
#pragma unroll
                for (int j = 0; j < 16; ++j) { s += v[k][j]; q2 += v[k][j] * v[k][j]; }
                st[k][0] = s; st[k][1] = q2; }
#pragma unroll
            for (int o = 1; o < 64; o <<= 1) {
#pragma unroll
                for (int k = 0; k < NBT; ++k) { st[k][0] += __shfl_xor(st[k][0], o); st[k][1] += __shfl_xor(st[k][1], o); } }
#pragma unroll
            for (int k = 0; k < NBT; ++k) { const int m = grp * 32 + i0 + k;
                const float mean = st[k][0] * (1.f / D), var = fmaxf(st[k][1] * (1.f / D) - mean * mean, 0.f), rstd = 1.f / sqrtf(var + LN_EPS);
#pragma unroll
                for (int j = 0; j < 16; ++j) v[k][j] = (v[k][j] - mean) * rstd * gv[j] + bv[j];
                if (FINAL) { f32x4* orow = (f32x4*)(F.out + (size_t)m * D) + 2 * lane;
                    orow[0] = (f32x4){v[k][0], v[k][1], v[k][2], v[k][3]}; orow[1] = (f32x4){v[k][4], v[k][5], v[k][6], v[k][7]}; orow[128] = (f32x4){v[k][8], v[k][9], v[k][10], v[k][11]}; orow[129] = (f32x4){v[k][12], v[k][13], v[k][14], v[k][15]}; }
                else { u32x4* o = (u32x4*)(hb + (size_t)m * D) + lane; u32x4 a, b;
                    a.x = pk2(v[k][0], v[k][1]); a.y = pk2(v[k][2], v[k][3]); a.z = pk2(v[k][4], v[k][5]); a.w = pk2(v[k][6], v[k][7]); b.x = pk2(v[k][8], v[k][9]); b.y = pk2(v[k][10], v[k][11]); b.z = pk2(v[k][12], v[k][13]); b.w = pk2(v[k][14], v[k][15]);
                    o[0] = a; o[64] = b;
                    if (HB8) { u32x2* o8 = (u32x2*)(F.ws + WS_SCR + S_HB8 + (size_t)m * D) + lane; u32x2 c, d;
                        c.x = pk4_fp8(v[k][0], v[k][1], v[k][2], v[k][3]); c.y = pk4_fp8(v[k][4], v[k][5], v[k][6], v[k][7]); d.x = pk4_fp8(v[k][8], v[k][9], v[k][10], v[k][11]); d.y = pk4_fp8(v[k][12], v[k][13], v[k][14], v[k][15]);
                        o8[0] = c; o8[64] = d; } }
                if (ROUTE) {
                    float lg[8];
#pragma unroll
                    for (int e = 0; e < 8; ++e) { float p = 0.f;
#pragma unroll
                        for (int kk = 0; kk < 2; ++kk)
#pragma unroll
                            for (int j = 0; j < 2; ++j) { const f32x4 w4 = *(const LAS f32x4*)(wrT + e * 1024 + 512 * kk + 8 * lane + 4 * j); p += (v[k][8 * kk + 4 * j] * w4.x + v[k][8 * kk + 4 * j + 1] * w4.y) + (v[k][8 * kk + 4 * j + 2] * w4.z + v[k][8 * kk + 4 * j + 3] * w4.w); }
                        lg[e] = p; }
#pragma unroll
                    for (int o = 1; o < 64; o <<= 1) {
#pragma unroll
                        for (int e = 0; e < 8; ++e) lg[e] += __shfl_xor(lg[e], o); }
                    int e1 = 0; float v1 = lg[0];
#pragma unroll
                    for (int e = 1; e < 8; ++e) if (lg[e] > v1) { v1 = lg[e]; e1 = e; }
                    int e2 = -1; float v2 = -3.4e38f;
#pragma unroll
                    for (int e = 0; e < 8; ++e) if (e != e1 && lg[e] > v2) { v2 = lg[e]; e2 = e; }
                    const float g2 = 1.f / (1.f + __expf(v1 - v2)), g1 = 1.f - g2;
                    const int r1 = __shfl(cnt_e, e1); if (lane == e1) ++cnt_e;
                    const int r2 = __shfl(cnt_e, e2); if (lane == e2) ++cnt_e;
                    if (lane == i0 + k) { my_e1 = e1; my_e2 = e2; my_r1 = r1; my_r2 = r2; my_g1 = g1; my_g2 = g2; }
                }
            }
        }
        if (ROUTE) {
            if (lane < 8) ((int*)(F.ws + WS_WCNT))[grp * 8 + lane] = cnt_e;
            if (lane < 32) { const int m = grp * 32 + lane; int* r = route + 4 * m; r[0] = my_e1; r[1] = my_r1; r[2] = my_e2; r[3] = my_r2; gout[2 * m] = my_g1; gout[2 * m + 1] = my_g2; }
        }
    }
}

__device__ __forceinline__ f32x16 mfma32(bf16x8 a, bf16x8 b, f32x16 c) { return __builtin_amdgcn_mfma_f32_32x32x16_bf16(a, b, c, 0, 0, 0); }
__device__ __forceinline__ bf16x8 pack8(const f32x16& s, int b0) {
    u32x4 w; w.x = pg8::cvt_pk_bf16(s[b0], s[b0 + 1]); w.y = pg8::cvt_pk_bf16(s[b0 + 2], s[b0 + 3]); w.z = pg8::cvt_pk_bf16(s[b0 + 4], s[b0 + 5]); w.w = pg8::cvt_pk_bf16(s[b0 + 6], s[b0 + 7]);
    return __builtin_bit_cast(bf16x8, w);
}
__device__ __forceinline__ float max16(const f32x16& s) {
    float a = fmaxf(fmaxf(s[0], s[1]), fmaxf(s[2], s[3])), b = fmaxf(fmaxf(s[4], s[5]), fmaxf(s[6], s[7]));
    float c = fmaxf(fmaxf(s[8], s[9]), fmaxf(s[10], s[11])), d = fmaxf(fmaxf(s[12], s[13]), fmaxf(s[14], s[15]));
    return fmaxf(fmaxf(a, b), fmaxf(c, d));
}
__device__ __forceinline__ void softmax_pv(f32x16& s, float& m_run, float& l_run, f32x16& o0, f32x16& o1, const bf16* vt0, const bf16* vt1, int h) {
    float mx = max16(s); mx = fmaxf(mx, __shfl_xor(mx, 32));
    const float mn = fmaxf(m_run, mx), alpha = __builtin_amdgcn_exp2f(m_run - mn); m_run = mn;
    float ps = 0.f;
#pragma unroll
    for (int r = 0; r < 16; ++r) { const float p = __builtin_amdgcn_exp2f(s[r] - mn); s[r] = p; ps += p; }
    l_run = l_run * alpha + ps;
#pragma unroll
    for (int r = 0; r < 16; ++r) { o0[r] *= alpha; o1[r] *= alpha; }
    const bf16x8 p0 = pack8(s, 0), p1 = pack8(s, 8);
    const bf16x8 v00 = *(const bf16x8*)(vt0 + 8 * h), v01 = *(const bf16x8*)(vt0 + 16 + 8 * h), v10 = *(const bf16x8*)(vt1 + 8 * h), v11 = *(const bf16x8*)(vt1 + 16 + 8 * h);
    o0 = mfma32(v00, p0, o0); o0 = mfma32(v01, p1, o0);
    o1 = mfma32(v10, p0, o1); o1 = mfma32(v11, p1, o1);
}
__device__ __forceinline__ int kperm(int i) { return (i & 19) | ((i & 8) >> 1) | ((i & 4) << 1); }

__device__ __forceinline__ void dil_attn_phase(Frame& F) {
    LAS float* bt = (LAS float*)F.lds;
    { const float* btA = (const float*)(F.ws + WS_BTABA); for (int i = F.tid; i < 48 * 192; i += 512) { const int gh = i / 192, dl = i % 192 - 32; bt[i] = (dl >= 0 && dl <= 128) ? btA[gh * 132 + dl] : NEGB; } }
    __syncthreads();
    const int gw = F.vcu * NWAVES + F.wave, NGW = F.G * NWAVES, lane = F.lane, q = lane & 31, h = lane >> 5;
    const bf16* QK = (const bf16*)(F.ws + WS_SCR + S_QK); const bf16* VT = (const bf16*)(F.ws + WS_SCR + S_VT);
    bf16* OG = (bf16*)((unsigned char*)F.out + O_OG); float* LSE = (float*)((unsigned char*)F.out + O_LSE);
    constexpr int NTASK = 3 * 16 * 8 * 64;
    const int per = (NTASK + NGW - 1) / NGW;
    const int t_lo = gw * per, t_hi = (t_lo + per) < NTASK ? (t_lo + per) : NTASK;
    for (int task = t_lo; task < t_hi; ++task) {
        const int qt = task & 3, rn = (task >> 2) & 15, bl = (task >> 6) & 7, gh = task >> 9, g = gh >> 4, hh = gh & 15;
        const int nblk = 16 >> (2 * g); const bool has_prev = (rn & (nblk - 1)) != 0;
        const int n0 = bl * 2048 + rn * 128;
        const bf16* qrow = QK + ((size_t)g * TC + n0 + 32 * qt + q) * 2048 + hh * 64;
        bf16x8 qf[4];
#pragma unroll
        for (int d0 = 0; d0 < 4; ++d0) qf[d0] = *(const bf16x8*)(qrow + d0 * 16 + 8 * h);
        float m_run = NEGB, l_run = 0.f; f32x16 o0 = {}, o1 = {};
        const bf16* vbase0 = VT + ((size_t)g * 1024 + hh * 64 + q) * TC; const bf16* vbase1 = vbase0 + (size_t)32 * TC;
        const LAS float* btl = bt + gh * 192 + (q - 8 * h + 137);
#pragma unroll
        for (int t = 0; t < 5; ++t) {
            if (has_prev || qt + t > 3) {
                const int kr0 = n0 - 128 + 32 * qt + 32 * t;
                const bf16* krow = QK + ((size_t)g * TC + kr0 + kperm(q)) * 2048 + 1024 + hh * 64;
                f32x16 s;
#pragma unroll
                for (int r = 0; r < 16; ++r) s[r] = btl[-32 * t + 23 - 16 * (r >> 3) - (r & 7)];
#pragma unroll
                for (int d0 = 0; d0 < 4; ++d0) { const bf16x8 kf = *(const bf16x8*)(krow + d0 * 16 + 8 * h); s = mfma32(kf, qf[d0], s); }
                softmax_pv(s, m_run, l_run, o0, o1, vbase0 + kr0, vbase1 + kr0, h);
            }
        }
        const float l_tot = l_run + __shfl_xor(l_run, 32), inv = 1.f / l_tot;
        const size_t orow = (size_t)g * TC + n0 + 32 * qt + q;
        bf16* op = OG + orow * 1024 + hh * 64 + 4 * h;
#pragma unroll
        for (int gq = 0; gq < 4; ++gq) {
            u32x2 w0, w1; w0.x = pg8::cvt_pk_bf16(o0[4 * gq] * inv, o0[4 * gq + 1] * inv); w0.y = pg8::cvt_pk_bf16(o0[4 * gq + 2] * inv, o0[4 * gq + 3] * inv);
            w1.x = pg8::cvt_pk_bf16(o1[4 * gq] * inv, o1[4 * gq + 1] * inv); w1.y = pg8::cvt_pk_bf16(o1[4 * gq + 2] * inv, o1[4 * gq + 3] * inv);
            *(u32x2*)(op + 8 * gq) = w0; *(u32x2*)(op + 32 + 8 * gq) = w1; }
        if (h == 0) LSE[orow * 16 + hh] = m_run + __log2f(l_tot);
    }
}
__device__ __forceinline__ void dil_merge_phase(Frame& F, int ck) {
    const int gw = F.vcu * NWAVES + F.wave, NGW = F.G * NWAVES, lane = F.lane;
    const bf16* OG = (const bf16*)((unsigned char*)F.out + O_OG); const float* LSE = (const float*)((unsigned char*)F.out + O_LSE);
    unsigned char* att = F.ws + WS_SCR + S_ATT + (size_t)ck * TC * 1024;
    const int hh = lane >> 2;
    for (int tl0 = 2 * gw; tl0 < TC; tl0 += 2 * NGW) {
        size_t n[2][3]; float ls[2][3]; u32x4 x[2][3][2];
#pragma unroll
        for (int k = 0; k < 2; ++k) { const int tl = tl0 + k, bl = tl >> 11, tt = tl & 2047;
            n[k][0] = tl; n[k][1] = bl * 2048 + (tt & 3) * 512 + (tt >> 2); n[k][2] = bl * 2048 + (tt & 15) * 128 + (tt >> 4);
#pragma unroll
            for (int g = 0; g < 3; ++g) { ls[k][g] = LSE[((size_t)g * TC + n[k][g]) * 16 + hh]; const u32x4* p = (const u32x4*)(OG + ((size_t)g * TC + n[k][g]) * 1024 + 16 * lane); x[k][g][0] = p[0]; x[k][g][1] = p[1]; } }
#pragma unroll
        for (int k = 0; k < 2; ++k) {
            const float M = fmaxf(fmaxf(ls[k][0], ls[k][1]), ls[k][2]);
            float w[3]; float W = 0.f;
#pragma unroll
            for (int g = 0; g < 3; ++g) { w[g] = __builtin_amdgcn_exp2f(ls[k][g] - M); W += w[g]; }
            const float iw = 1.f / W;
            float acc[16];
#pragma unroll
            for (int j = 0; j < 16; ++j) acc[j] = 0.f;
#pragma unroll
            for (int g = 0; g < 3; ++g) { const float wg = w[g] * iw; float a[16]; unpack8(x[k][g][0], a); unpack8(x[k][g][1], a + 8);
#pragma unroll
                for (int j = 0; j < 16; ++j) acc[j] += wg * a[j]; }
#pragma unroll
            for (int j = 0; j < 16; ++j) acc[j] *= ASCALE8;
            u32x4 y; y.x = pk4_fp8(acc[0], acc[1], acc[2], acc[3]); y.y = pk4_fp8(acc[4], acc[5], acc[6], acc[7]); y.z = pk4_fp8(acc[8], acc[9], acc[10], acc[11]); y.w = pk4_fp8(acc[12], acc[13], acc[14], acc[15]);
            *(u32x4*)(att + (size_t)(tl0 + k) * 1024 + 16 * lane) = y;
        }
    }
}

__device__ __forceinline__ void conv_phase(Frame& F, const float* cw) {
    const int gw = F.vcu * NWAVES + F.wave, NGW = F.G * NWAVES, lane = F.lane;
    const bf16* gbp = (const bf16*)(F.ws + WS_SCR + S_BCX); const bf16* up = (const bf16*)(F.ws + WS_SCR + S_BCX + (size_t)128 * MiB); bf16* p = (bf16*)(F.ws + WS_SCR + S_P);
    for (int item = gw; item < (T / 32) * 2; item += NGW) {
        const int half = item & 1, tb = item >> 1, t0 = tb * 32, c0 = half * 512 + lane * 8;
        float w0[8], w1[8], w2[8];
#pragma unroll
        for (int j = 0; j < 8; ++j) { w0[j] = cw[c0 + j]; w1[j] = cw[1024 + c0 + j]; w2[j] = cw[2048 + c0 + j]; }
        float u1[8], u2[8];
        const bool first = (t0 & 2047) == 0;
#pragma unroll
        for (int j = 0; j < 8; ++j) { u1[j] = 0.f; u2[j] = 0.f; }
        if (!first) { unpack8(*(const u32x4*)(up + (size_t)(t0 - 2) * 1024 + c0), u2); unpack8(*(const u32x4*)(up + (size_t)(t0 - 1) * 1024 + c0), u1); }
        for (int i = 0; i < 32; ++i) { const size_t r = (size_t)(t0 + i) * 1024;
            const u32x4 gb = *(const u32x4*)(gbp + r + c0), uu = *(const u32x4*)(up + r + c0);
            float u0[8], b[8]; unpack8(uu, u0); unpack8(gb, b);
            float o[8];
#pragma unroll
            for (int j = 0; j < 8; ++j) { o[j] = b[j] * (w0[j] * u2[j] + w1[j] * u1[j] + w2[j] * u0[j]); u2[j] = u1[j]; u1[j] = u0[j]; }
            u32x4 x; x.x = pk2(o[0], o[1]); x.y = pk2(o[2], o[3]); x.z = pk2(o[4], o[5]); x.w = pk2(o[6], o[7]);
            *(u32x4*)(p + (size_t)(t0 + i) * 1024 + c0) = x; }
    }
}

__device__ __forceinline__ void kmean_phase(Frame& F) {
    const int gw = F.vcu * NWAVES + F.wave, NGW = F.G * NWAVES, lane = F.lane;
    const bf16* QK = (const bf16*)(F.ws + WS_SCR + S_CQK); float* km = (float*)(F.ws + WS_KMEAN);
    const int kq = lane >> 3, dc = lane & 7;
    for (int u = gw; u < NB * NH * 8; u += NGW) { const int blk = u & 7, hh = (u >> 3) & 15, b = u >> 7;
        float a[8];
#pragma unroll
        for (int j = 0; j < 8; ++j) a[j] = 0.f;
        const bf16* kp = QK + ((size_t)b * SEQ + blk * 256 + kq) * 2048 + 1024 + hh * 64 + dc * 8;
#pragma unroll 8
        for (int i = 0; i < 32; ++i) { const u32x4 x = *(const u32x4*)(kp + (size_t)i * 8 * 2048);
            a[0] += bflo(x.x); a[1] += bfhi(x.x); a[2] += bflo(x.y); a[3] += bfhi(x.y); a[4] += bflo(x.z); a[5] += bfhi(x.z); a[6] += bflo(x.w); a[7] += bfhi(x.w); }
#pragma unroll
        for (int j = 0; j < 8; ++j) { a[j] += __shfl_xor(a[j], 8); a[j] += __shfl_xor(a[j], 16); a[j] += __shfl_xor(a[j], 32); }
        if (lane < 8) { float* o = km + (size_t)u * 64 + lane * 8;
#pragma unroll
            for (int j = 0; j < 8; ++j) o[j] = a[j] * (1.f / 256.f); }
    }
}
__device__ __forceinline__ void moba_unit(Frame& F, int b, int hh, int nb, LAS float* bt, int& cur_h) {
    const int lane = F.lane, q = lane & 31, h = lane >> 5, w = F.wave;
    const bf16* QK = (const bf16*)(F.ws + WS_SCR + S_CQK); const bf16* VT = (const bf16*)(F.ws + WS_SCR + S_CVT);
    bf16* att = (bf16*)(F.ws + WS_SCR + S_CATT); const float* km = (const float*)(F.ws + WS_KMEAN);
    if (hh != cur_h) { __syncthreads(); const float* btC = (const float*)(F.ws + WS_BTABC) + hh * 2048; for (int i = F.tid; i < 2048; i += 512) bt[i] = btC[i]; cur_h = hh; __syncthreads(); }
    const size_t tq = (size_t)b * SEQ + nb * 256 + 32 * w + q;
    const bf16* qrow = QK + tq * 2048 + hh * 64;
    bf16x8 qf[4];
#pragma unroll
    for (int d0 = 0; d0 < 4; ++d0) qf[d0] = *(const bf16x8*)(qrow + d0 * 16 + 8 * h);
    unsigned sel = 0;
    if (nb > 0) {
        float gsc[7];
#pragma unroll
        for (int m = 0; m < 7; ++m) { float s = 0.f;
            if (m < nb) { const float* kmp = km + (((size_t)b * NH + hh) * 8 + m) * 64;
#pragma unroll
                for (int d0 = 0; d0 < 4; ++d0) { const f32x4 k0 = *(const f32x4*)(kmp + d0 * 16 + 8 * h), k1 = *(const f32x4*)(kmp + d0 * 16 + 8 * h + 4); const u32x4 qq = __builtin_bit_cast(u32x4, qf[d0]);
                    s += bflo(qq.x) * k0.x + bfhi(qq.x) * k0.y + bflo(qq.y) * k0.z + bfhi(qq.y) * k0.w + bflo(qq.z) * k1.x + bfhi(qq.z) * k1.y + bflo(qq.w) * k1.z + bfhi(qq.w) * k1.w; }
                s += __shfl_xor(s, 32); }
            gsc[m] = m < nb ? s : -3.0e38f; }
        const int nsel = nb < 3 ? nb : 3;
#pragma unroll
        for (int r = 0; r < 3; ++r) { if (r < nsel) { int bi = -1; float bv = -3.4e38f;
#pragma unroll
                for (int m = 0; m < 7; ++m) if (!((sel >> m) & 1u) && gsc[m] > bv) { bv = gsc[m]; bi = m; }
                sel |= 1u << bi; } }
    }
#ifdef MK_SELFCHECK
    if (h == 0) ((unsigned*)(F.ws + WS_NEED + 3 * MiB))[tq * 16 + hh] = sel;
#endif
    float m_run = NEGB, l_run = 0.f; f32x16 o0 = {}, o1 = {};
    const bf16* vbase0 = VT + ((size_t)hh * 64 + q) * T + (size_t)b * SEQ; const bf16* vbase1 = vbase0 + (size_t)32 * T;
    const int qpos = nb * 256 + 32 * w + q;
    for (int m = 0; m < nb; ++m) {
        const bool mine = (sel >> m) & 1u;
        if (__ballot(mine) == 0ull) continue;
        for (int kt = 0; kt < 8; ++kt) {
            const int kr0 = m * 256 + 32 * kt;
            const bf16* krow = QK + ((size_t)b * SEQ + kr0 + kperm(q)) * 2048 + 1024 + hh * 64;
            f32x16 s = {};
#pragma unroll
            for (int d0 = 0; d0 < 4; ++d0) { const bf16x8 kf = *(const bf16x8*)(krow + d0 * 16 + 8 * h); s = mfma32(kf, qf[d0], s); }
#pragma unroll
            for (int r = 0; r < 16; ++r) { const int kap = 16 * (r >> 3) + 8 * h + (r & 7); const float bb = bt[qpos - kr0 - kap]; s[r] = mine ? s[r] + bb : NEGB; }
            softmax_pv(s, m_run, l_run, o0, o1, vbase0 + kr0, vbase1 + kr0, h);
        }
    }
    for (int kt = 0; kt <= w; ++kt) {
        const int kr0 = nb * 256 + 32 * kt;
        const bf16* krow = QK + ((size_t)b * SEQ + kr0 + kperm(q)) * 2048 + 1024 + hh * 64;
        f32x16 s = {};
#pragma unroll
        for (int d0 = 0; d0 < 4; ++d0) { const bf16x8 kf = *(const bf16x8*)(krow + d0 * 16 + 8 * h); s = mfma32(kf, qf[d0], s); }
#pragma unroll
        for (int r = 0; r < 16; ++r) { const int kap = 16 * (r >> 3) + 8 * h + (r & 7); const int dd = qpos - kr0 - kap; const float bb = bt[dd < 0 ? 0 : dd]; s[r] = dd >= 0 ? s[r] + bb : NEGB; }
        softmax_pv(s, m_run, l_run, o0, o1, vbase0 + kr0, vbase1 + kr0, h);
    }
    const float l_tot = l_run + __shfl_xor(l_run, 32), inv = 1.f / l_tot;
#ifdef MK_SELFCHECK
    if (h == 0) ((float*)(F.ws + WS_NEED + 7 * MiB))[tq * 16 + hh] = m_run + __log2f(l_tot);
#endif
    bf16* op = att + tq * 1024 + hh * 64 + 4 * h;
#pragma unroll
    for (int gq = 0; gq < 4; ++gq) {
        u32x2 w0, w1; w0.x = pg8::cvt_pk_bf16(o0[4 * gq] * inv, o0[4 * gq + 1] * inv); w0.y = pg8::cvt_pk_bf16(o0[4 * gq + 2] * inv, o0[4 * gq + 3] * inv);
        w1.x = pg8::cvt_pk_bf16(o1[4 * gq] * inv, o1[4 * gq + 1] * inv); w1.y = pg8::cvt_pk_bf16(o1[4 * gq + 2] * inv, o1[4 * gq + 3] * inv);
        *(u32x2*)(op + 8 * gq) = w0; *(u32x2*)(op + 32 + 8 * gq) = w1; }
}
__device__ __forceinline__ void moba_phase(Frame& F) {
    LAS float* bt = (LAS float*)F.lds; int cur_h = -1;
    const int NP = NB * NH * 4, per = (NP + F.G - 1) / F.G;
    const int lo = F.vcu * per, hi = (lo + per) < NP ? (lo + per) : NP;
    for (int pu = lo; pu < hi; ++pu) { const int j = pu & 3, hh = (pu >> 2) & 15, b = pu >> 6;
        moba_unit(F, b, hh, 7 - j, bt, cur_h); moba_unit(F, b, hh, j, bt, cur_h); }
}


constexpr int AKP = 72;
constexpr int ATILE = 64 * AKP * 2;
struct AttnSt { float m, l; f32x16 o0, o1; };
template <bool MASKED>
__device__ __forceinline__ void attn_tile(const LAS bf16* Kt, const LAS bf16* Vt, const LAS float* bl, const bf16x8 (&qf)[4], AttnSt& st, int q, int h, bool mine) {
    f32x16 s;
#pragma unroll
    for (int r = 0; r < 16; ++r) s[r] = bl[23 - 16 * (r >> 3) - (r & 7)];
    const LAS bf16* kr = Kt + kperm(q) * AKP + 8 * h;
#pragma unroll
    for (int d0 = 0; d0 < 4; ++d0) s = mfma32(*(const LAS bf16x8*)(kr + d0 * 16), qf[d0], s);
    float mx = max16(s); mx = fmaxf(mx, __shfl_xor(mx, 32));
    float mn = fmaxf(st.m, mx); if (MASKED) mn = mine ? mn : st.m;
    const float alpha = __builtin_amdgcn_exp2f(st.m - mn);
    float ps = 0.f;
#pragma unroll
    for (int r = 0; r < 16; ++r) { const float p = __builtin_amdgcn_exp2f(s[r] - mn); s[r] = p; ps += p; }
    bf16x8 p0 = pack8(s, 0), p1 = pack8(s, 8);
    if (MASKED) { if (!mine) { p0 = (bf16x8){0, 0, 0, 0, 0, 0, 0, 0}; p1 = p0; ps = 0.f; } }
    st.l = st.l * alpha + ps; st.m = mn;
    if (__ballot(alpha != 1.0f) != 0ull) {
#pragma unroll
        for (int r = 0; r < 16; ++r) { st.o0[r] *= alpha; st.o1[r] *= alpha; } }
    const LAS bf16* v0 = Vt + q * AKP + 8 * h; const LAS bf16* v1 = v0 + 32 * AKP;
    st.o0 = mfma32(*(const LAS bf16x8*)v0, p0, st.o0); st.o0 = mfma32(*(const LAS bf16x8*)(v0 + 16), p1, st.o0);
    st.o1 = mfma32(*(const LAS bf16x8*)v1, p0, st.o1); st.o1 = mfma32(*(const LAS bf16x8*)(v1 + 16), p1, st.o1);
}
__device__ __forceinline__ void attn_store(const AttnSt& st, bf16* op  , float inv) {
#pragma unroll
    for (int gq = 0; gq < 4; ++gq) {
        u32x2 w0, w1; w0.x = pg8::cvt_pk_bf16(st.o0[4 * gq] * inv, st.o0[4 * gq + 1] * inv); w0.y = pg8::cvt_pk_bf16(st.o0[4 * gq + 2] * inv, st.o0[4 * gq + 3] * inv);
        w1.x = pg8::cvt_pk_bf16(st.o1[4 * gq] * inv, st.o1[4 * gq + 1] * inv); w1.y = pg8::cvt_pk_bf16(st.o1[4 * gq + 2] * inv, st.o1[4 * gq + 3] * inv);
        *(u32x2*)(op + 8 * gq) = w0; *(u32x2*)(op + 32 + 8 * gq) = w1; }
}

__device__ __forceinline__ void attn_store8(const AttnSt& st, unsigned char* op  , float inv) {
#pragma unroll
    for (int gq = 0; gq < 4; ++gq) {
        *(unsigned*)(op + 8 * gq) = pk4_fp8(st.o0[4 * gq] * inv, st.o0[4 * gq + 1] * inv, st.o0[4 * gq + 2] * inv, st.o0[4 * gq + 3] * inv);
        *(unsigned*)(op + 32 + 8 * gq) = pk4_fp8(st.o1[4 * gq] * inv, st.o1[4 * gq + 1] * inv, st.o1[4 * gq + 2] * inv, st.o1[4 * gq + 3] * inv); }
}

__device__ __forceinline__ void dil_attn_phase2(Frame& F) {
    LAS float* bt = (LAS float*)F.lds;
    { const float* btA = (const float*)(F.ws + WS_BTABA); for (int i = F.tid; i < 48 * 192; i += 512) { const int gh = i / 192, dl = i % 192 - 32; bt[i] = (dl >= 0 && dl <= 128) ? btA[gh * 132 + dl] : NEGB; } }
    __syncthreads();
    constexpr int TBL = 48 * 192 * 4;
    const int lane = F.lane, q = lane & 31, h = lane >> 5, w = F.wave, uw = w >> 2, qt = w & 3, t = F.tid, tu = t >> 8, tt = t & 255, srow = tt >> 3, sch = tt & 7;
    const bf16* QK = (const bf16*)(F.ws + WS_SCR + S_QK); const bf16* VT = (const bf16*)(F.ws + WS_SCR + S_VT);
    bf16* OG = (bf16*)((unsigned char*)F.out + O_OG); float* LSE = (float*)((unsigned char*)F.out + O_LSE);
    for (int du = F.vcu; du < 3072; du += F.G) {
        const int g = du >> 10, rem = du & 1023, hh = rem >> 6, blp = (rem >> 4) & 3, rn = rem & 15, gh = g * 16 + hh;
        const int nblk = 16 >> (2 * g); const bool has_prev = (rn & (nblk - 1)) != 0;
        const int j0 = has_prev ? 0 : 2;
        const int n0s = (2 * blp + tu) * 2048 + rn * 128;
        const bf16* ksrc = QK + ((size_t)g * TC + n0s - 128 + srow) * 2048 + 1024 + hh * 64 + sch * 8;
        const bf16* vsrc = VT + ((size_t)g * 1024 + hh * 64 + srow) * TC + (n0s - 128) + sch * 8;
        const int sdst = srow * AKP + sch * 8;
        const int n0 = (2 * blp + uw) * 2048 + rn * 128;
        const bf16* qrow = QK + ((size_t)g * TC + n0 + 32 * qt + q) * 2048 + hh * 64;
        bf16x8 qf[4];
#pragma unroll
        for (int d0 = 0; d0 < 4; ++d0) qf[d0] = *(const bf16x8*)(qrow + d0 * 16 + 8 * h);
        AttnSt st; st.m = NEGB; st.l = 0.f; st.o0 = (f32x16){}; st.o1 = (f32x16){};
        u32x4 k0, k1, v0, v1;
        k0 = *(const u32x4*)(ksrc + (size_t)(64 * j0) * 2048); k1 = *(const u32x4*)(ksrc + (size_t)(64 * j0 + 32) * 2048);
        v0 = *(const u32x4*)(vsrc + 64 * j0); v1 = *(const u32x4*)(vsrc + (size_t)32 * TC + 64 * j0);
        { LAS bf16* kb = (LAS bf16*)(F.lds + TBL + (0 * 2 + tu) * 2 * ATILE); LAS bf16* vb = kb + 64 * AKP;
          *(LAS u32x4*)(kb + sdst) = k0; *(LAS u32x4*)(kb + 32 * AKP + sdst) = k1; *(LAS u32x4*)(vb + sdst) = v0; *(LAS u32x4*)(vb + 32 * AKP + sdst) = v1; }
        __syncthreads();
        int pb = 0;
        for (int j = j0; j < 4; ++j) {
            const bool more = j + 1 < 4;
            if (more) { k0 = *(const u32x4*)(ksrc + (size_t)(64 * (j + 1)) * 2048); k1 = *(const u32x4*)(ksrc + (size_t)(64 * (j + 1) + 32) * 2048);
                        v0 = *(const u32x4*)(vsrc + 64 * (j + 1)); v1 = *(const u32x4*)(vsrc + (size_t)32 * TC + 64 * (j + 1)); }
            const LAS bf16* kb = (const LAS bf16*)(F.lds + TBL + (pb * 2 + uw) * 2 * ATILE); const LAS bf16* vb = kb + 64 * AKP;
#pragma unroll
            for (int t2 = 0; t2 < 2; ++t2) { const int t32 = 2 * j + t2;
                if (t32 >= qt && t32 <= qt + 4) {
                    const LAS float* bl = bt + gh * 192 + 32 + (32 * qt + q + 128 - 32 * t32 - 8 * h - 23);
                    attn_tile<false>(kb + 32 * t2 * AKP, vb + 32 * t2, bl, qf, st, q, h, true); } }
            if (more) { LAS bf16* kn = (LAS bf16*)(F.lds + TBL + ((pb ^ 1) * 2 + tu) * 2 * ATILE); LAS bf16* vn = kn + 64 * AKP;
                *(LAS u32x4*)(kn + sdst) = k0; *(LAS u32x4*)(kn + 32 * AKP + sdst) = k1; *(LAS u32x4*)(vn + sdst) = v0; *(LAS u32x4*)(vn + 32 * AKP + sdst) = v1; }
            __syncthreads();
            pb ^= 1;
        }
        const float l_tot = st.l + __shfl_xor(st.l, 32), inv = 1.f / l_tot;
        const size_t orow = (size_t)g * TC + n0 + 32 * qt + q;
        attn_store(st, OG + orow * 1024 + hh * 64 + 4 * h, inv);
        if (h == 0) LSE[orow * 16 + hh] = st.m + __log2f(l_tot);
    }
}

__device__ __forceinline__ void moba_unit2(Frame& F, int b, int hh, int nb, LAS float* bt, int& cur_h) {
    constexpr int TBL = 8448;
    const int lane = F.lane, q = lane & 31, h = lane >> 5, w = F.wave, t = F.tid, srow = t >> 3, sch = t & 7;
    const bf16* QK = (const bf16*)(F.ws + WS_SCR + S_CQK); const bf16* VT = (const bf16*)(F.ws + WS_SCR + S_CVT);
    bf16* att = (bf16*)(F.ws + WS_SCR + S_CATT); const float* km = (const float*)(F.ws + WS_KMEAN);
    if (hh != cur_h) { __syncthreads(); const float* btC = (const float*)(F.ws + WS_BTABC) + hh * 2048; for (int i = t; i < 2048 + 32; i += 512) bt[i] = i < 32 ? NEGB : btC[i - 32]; cur_h = hh; __syncthreads(); }
    const size_t tq = (size_t)b * SEQ + nb * 256 + 32 * w + q;
    const bf16* qrow = QK + tq * 2048 + hh * 64;
    bf16x8 qf[4];
#pragma unroll
    for (int d0 = 0; d0 < 4; ++d0) qf[d0] = *(const bf16x8*)(qrow + d0 * 16 + 8 * h);
    unsigned sel = 0;
    if (nb > 0) {
        float gsc[7];
#pragma unroll
        for (int m = 0; m < 7; ++m) { float s = 0.f;
            if (m < nb) { const float* kmp = km + (((size_t)b * NH + hh) * 8 + m) * 64;
#pragma unroll
                for (int d0 = 0; d0 < 4; ++d0) { const f32x4 k0 = *(const f32x4*)(kmp + d0 * 16 + 8 * h), k1 = *(const f32x4*)(kmp + d0 * 16 + 8 * h + 4); const u32x4 qq = __builtin_bit_cast(u32x4, qf[d0]);
                    s += bflo(qq.x) * k0.x + bfhi(qq.x) * k0.y + bflo(qq.y) * k0.z + bfhi(qq.y) * k0.w + bflo(qq.z) * k1.x + bfhi(qq.z) * k1.y + bflo(qq.w) * k1.z + bfhi(qq.w) * k1.w; }
                s += __shfl_xor(s, 32); }
            gsc[m] = m < nb ? s : -3.0e38f; }
        const int nsel = nb < 3 ? nb : 3;
#pragma unroll
        for (int r = 0; r < 3; ++r) { if (r < nsel) { int bi = 0; float bv = -3.4e38f;
#pragma unroll
                for (int m = 0; m < 7; ++m) if (!((sel >> m) & 1u) && gsc[m] > bv) { bv = gsc[m]; bi = m; }
                sel |= 1u << bi; } }
    }
    AttnSt st; st.m = NEGB; st.l = 0.f; st.o0 = (f32x16){}; st.o1 = (f32x16){};
    const int qpos = nb * 256 + 32 * w + q, nsteps = 4 * nb + 4;
    const bf16* ksrc = QK + ((size_t)b * SEQ + srow) * 2048 + 1024 + hh * 64 + sch * 8;
    const bf16* vsrc = VT + ((size_t)hh * 64 + srow) * T + (size_t)b * SEQ + sch * 8;
    const int sdst = srow * AKP + sch * 8;
    u32x4 kreg = *(const u32x4*)ksrc, vreg = *(const u32x4*)vsrc;
    { LAS bf16* kb = (LAS bf16*)(F.lds + TBL); *(LAS u32x4*)(kb + sdst) = kreg; *(LAS u32x4*)(kb + 64 * AKP + sdst) = vreg; }
    __syncthreads();
    int pb = 0;
    for (int s = 0; s < nsteps; ++s) {
        const bool more = s + 1 < nsteps;
        if (more) { kreg = *(const u32x4*)(ksrc + (size_t)(64 * (s + 1)) * 2048); vreg = *(const u32x4*)(vsrc + 64 * (s + 1)); }
        const LAS bf16* kb = (const LAS bf16*)(F.lds + TBL + pb * 2 * ATILE); const LAS bf16* vb = kb + 64 * AKP;
        if (s < 4 * nb) {
            const bool mine = (sel >> (s >> 2)) & 1u;
            if (__ballot(mine) != 0ull) {
#pragma unroll
                for (int t2 = 0; t2 < 2; ++t2) { const LAS float* bl = bt + 32 + (qpos - 8 * h - (64 * s + 32 * t2) - 23);
                    attn_tile<true>(kb + 32 * t2 * AKP, vb + 32 * t2, bl, qf, st, q, h, mine); } }
        } else {
#pragma unroll
            for (int t2 = 0; t2 < 2; ++t2) { const int t32 = (s - 4 * nb) * 2 + t2;
                if (t32 <= w) { const LAS float* bl = bt + 32 + (qpos - 8 * h - (64 * s + 32 * t2) - 23);
                    attn_tile<false>(kb + 32 * t2 * AKP, vb + 32 * t2, bl, qf, st, q, h, true); } }
        }
        if (more) { LAS bf16* kn = (LAS bf16*)(F.lds + TBL + (pb ^ 1) * 2 * ATILE); *(LAS u32x4*)(kn + sdst) = kreg; *(LAS u32x4*)(kn + 64 * AKP + sdst) = vreg; }
        __syncthreads();
        pb ^= 1;
    }
    const float l_tot = st.l + __shfl_xor(st.l, 32), inv = 1.f / l_tot;
    attn_store(st, att + tq * 1024 + hh * 64 + 4 * h, inv);
}
__device__ __forceinline__ void moba_phase2(Frame& F) {
    LAS float* bt = (LAS float*)F.lds; int cur_h = -1;
    const int NP = NB * NH * 4, per = (NP + F.G - 1) / F.G;
    const int lo = F.vcu * per, hi = (lo + per) < NP ? (lo + per) : NP;
    for (int pu = lo; pu < hi; ++pu) { const int j = pu & 3, hh = (pu >> 2) & 15, b = pu >> 6;
        moba_unit2(F, b, hh, 7 - j, bt, cur_h); moba_unit2(F, b, hh, j, bt, cur_h); }
}


__device__ __forceinline__ float xhalf_max(float m) { auto rr = __builtin_amdgcn_permlane32_swap(__float_as_uint(m), __float_as_uint(m), false, false); return fmaxf(__uint_as_float(rr[0]), __uint_as_float(rr[1])); }
__device__ __forceinline__ float xhalf_sum(float m) { auto rr = __builtin_amdgcn_permlane32_swap(__float_as_uint(m), __float_as_uint(m), false, false); return __uint_as_float(rr[0]) + __uint_as_float(rr[1]); }
template <bool MASKED>
__device__ __forceinline__ void attn_tile2(const LAS bf16* Kt, const LAS bf16* Vt, const LAS float* bl0, const bf16x8 (&qf)[4], AttnSt& st, int q, int h, bool mine) {
    f32x16 s0, s1;
#pragma unroll
    for (int r = 0; r < 16; ++r) { s0[r] = bl0[23 - 16 * (r >> 3) - (r & 7)]; s1[r] = bl0[-32 + 23 - 16 * (r >> 3) - (r & 7)]; }
    const LAS bf16* kr = Kt + kperm(q) * AKP + 8 * h;
#pragma unroll
    for (int d0 = 0; d0 < 4; ++d0) { s0 = mfma32(*(const LAS bf16x8*)(kr + d0 * 16), qf[d0], s0); s1 = mfma32(*(const LAS bf16x8*)(kr + 32 * AKP + d0 * 16), qf[d0], s1); }
    const float mx = xhalf_max(fmaxf(max16(s0), max16(s1)));
    float mn = fmaxf(st.m, mx); if (MASKED) mn = mine ? mn : st.m;
    const float alpha = __builtin_amdgcn_exp2f(st.m - mn);
    float ps0 = 0.f, ps1 = 0.f;
#pragma unroll
    for (int r = 0; r < 16; ++r) { const float p = __builtin_amdgcn_exp2f(s0[r] - mn); s0[r] = p; ps0 += p; const float p2 = __builtin_amdgcn_exp2f(s1[r] - mn); s1[r] = p2; ps1 += p2; }
    bf16x8 p00 = pack8(s0, 0), p01 = pack8(s0, 8), p10 = pack8(s1, 0), p11 = pack8(s1, 8);
    float ps = ps0 + ps1;
    if (MASKED) { if (!mine) { p00 = (bf16x8){0, 0, 0, 0, 0, 0, 0, 0}; p01 = p00; p10 = p00; p11 = p00; ps = 0.f; } }
    st.l = st.l * alpha + ps; st.m = mn;
    if (__ballot(alpha != 1.0f) != 0ull) {
#pragma unroll
        for (int r = 0; r < 16; ++r) { st.o0[r] *= alpha; st.o1[r] *= alpha; } }
    const LAS bf16* v0 = Vt + q * AKP + 8 * h; const LAS bf16* v1 = v0 + 32 * AKP;
    st.o0 = mfma32(*(const LAS bf16x8*)v0, p00, st.o0); st.o1 = mfma32(*(const LAS bf16x8*)v1, p00, st.o1);
    st.o0 = mfma32(*(const LAS bf16x8*)(v0 + 16), p01, st.o0); st.o1 = mfma32(*(const LAS bf16x8*)(v1 + 16), p01, st.o1);
    st.o0 = mfma32(*(const LAS bf16x8*)(v0 + 32), p10, st.o0); st.o1 = mfma32(*(const LAS bf16x8*)(v1 + 32), p10, st.o1);
    st.o0 = mfma32(*(const LAS bf16x8*)(v0 + 48), p11, st.o0); st.o1 = mfma32(*(const LAS bf16x8*)(v1 + 48), p11, st.o1);
}

__device__ __forceinline__ void dil_attn_phase3(Frame& F) {
    LAS float* bt = (LAS float*)F.lds;
    { const float* btA = (const float*)(F.ws + WS_BTABA); for (int i = F.tid; i < 48 * 192; i += 512) { const int gh = i / 192, dl = i % 192 - 32; bt[i] = (dl >= 0 && dl <= 128) ? btA[gh * 132 + dl] : NEGB; } }
    constexpr int TBL = 48 * 192 * 4;
    const int lane = F.lane, q = lane & 31, h = lane >> 5, w = F.wave, uw = w >> 2, qt = w & 3, t = F.tid, tu = t >> 8, tt = t & 255, srow = tt >> 3, sch = tt & 7;
    const bf16* QK = (const bf16*)(F.ws + WS_SCR + S_QK); const bf16* VT = (const bf16*)(F.ws + WS_SCR + S_VT);
    bf16* OG = (bf16*)((unsigned char*)F.out + O_OG); float* LSE = (float*)((unsigned char*)F.out + O_LSE);
    const int sdst = srow * AKP + sch * 8;
    int du = F.vcu;
    if (du >= 3072) { __syncthreads(); return; }
    int g = du >> 10, hh = (du >> 6) & 15, blp = (du >> 4) & 3, rn = du & 15;
    int j = ((rn & ((16 >> (2 * g)) - 1)) != 0) ? 0 : 2;
    u32x4 k0, k1, v0, v1; bf16x8 qn[4], qf[4];
#define DIL_LOADS(G_, HH_, BLP_, RN_, J_) do { const int n0s_ = (2 * (BLP_) + tu) * 2048 + (RN_) * 128 - 128 + 64 * (J_); \
        const bf16* ks_ = QK + ((size_t)(G_) * TC + n0s_ + srow) * 2048 + 1024 + (HH_) * 64 + sch * 8; \
        const bf16* vs_ = VT + ((size_t)(G_) * 1024 + (HH_) * 64 + srow) * TC + n0s_ + sch * 8; \
        k0 = *(const u32x4*)ks_; k1 = *(const u32x4*)(ks_ + (size_t)32 * 2048); v0 = *(const u32x4*)vs_; v1 = *(const u32x4*)(vs_ + (size_t)32 * TC); } while (0)
#define DIL_QLOADS(G_, HH_, BLP_, RN_) do { const bf16* qr_ = QK + ((size_t)(G_) * TC + (2 * (BLP_) + uw) * 2048 + (RN_) * 128 + 32 * qt + q) * 2048 + (HH_) * 64; \
        _Pragma("unroll") for (int d0 = 0; d0 < 4; ++d0) qn[d0] = *(const bf16x8*)(qr_ + d0 * 16 + 8 * h); } while (0)
#define DIL_WRITE(PB_) do { LAS bf16* kb_ = (LAS bf16*)(F.lds + TBL + ((PB_) * 2 + tu) * 2 * ATILE); LAS bf16* vb_ = kb_ + 64 * AKP; \
        *(LAS u32x4*)(kb_ + sdst) = k0; *(LAS u32x4*)(kb_ + 32 * AKP + sdst) = k1; *(LAS u32x4*)(vb_ + sdst) = v0; *(LAS u32x4*)(vb_ + 32 * AKP + sdst) = v1; } while (0)
    DIL_LOADS(g, hh, blp, rn, j); DIL_QLOADS(g, hh, blp, rn);
    DIL_WRITE(0);
#pragma unroll
    for (int d0 = 0; d0 < 4; ++d0) qf[d0] = qn[d0];
    __syncthreads();
    AttnSt st; st.m = NEGB; st.l = 0.f; st.o0 = (f32x16){}; st.o1 = (f32x16){};
    int pb = 0;
    for (;;) {
        const bool last = (j == 3);
        int ng = g, nhh = hh, nblp = blp, nrn = rn, nj = j + 1; bool more = true;
        if (last) { const int nd = du + F.G; more = nd < 3072; ng = nd >> 10; nhh = (nd >> 6) & 15; nblp = (nd >> 4) & 3; nrn = nd & 15; nj = ((nrn & ((16 >> (2 * ng)) - 1)) != 0) ? 0 : 2; }
        if (more) { DIL_LOADS(ng, nhh, nblp, nrn, nj); if (last) DIL_QLOADS(ng, nhh, nblp, nrn); }
        { const LAS bf16* kb = (const LAS bf16*)(F.lds + TBL + (pb * 2 + uw) * 2 * ATILE); const LAS bf16* vb = kb + 64 * AKP;
          const int gh = g * 16 + hh, ta = 2 * j, tb = 2 * j + 1;
          const bool a_on = ta >= qt && ta <= qt + 4, b_on = tb >= qt && tb <= qt + 4;
          const LAS float* bl = bt + gh * 192 + 32 + (32 * qt + q + 128 - 32 * ta - 8 * h - 23);
          if (a_on && b_on) attn_tile2<false>(kb, vb, bl, qf, st, q, h, true);
          else if (a_on) attn_tile<false>(kb, vb, bl, qf, st, q, h, true);
          else if (b_on) attn_tile<false>(kb + 32 * AKP, vb + 32, bl - 32, qf, st, q, h, true); }
        if (more) DIL_WRITE(pb ^ 1);
        if (last) {
            const float l_tot = xhalf_sum(st.l), inv = 1.f / l_tot;
            const size_t orow = (size_t)g * TC + (2 * blp + uw) * 2048 + rn * 128 + 32 * qt + q;
            attn_store(st, OG + orow * 1024 + hh * 64 + 4 * h, inv);
            if (h == 0) LSE[orow * 16 + hh] = st.m + __log2f(l_tot);
            st.m = NEGB; st.l = 0.f; st.o0 = (f32x16){}; st.o1 = (f32x16){};
#pragma unroll
            for (int d0 = 0; d0 < 4; ++d0) qf[d0] = qn[d0];
        }
        __syncthreads();
        pb ^= 1;
        if (!more) break;
        if (last) du += F.G;
        g = ng; hh = nhh; blp = nblp; rn = nrn; j = nj;
    }
#undef DIL_LOADS
#undef DIL_QLOADS
#undef DIL_WRITE
}

__device__ __forceinline__ void moba_phase3(Frame& F) {
    constexpr int TBL = 8448, KMO = TBL + 4 * ATILE;
    LAS float* bt = (LAS float*)F.lds; LAS float* kml = (LAS float*)(F.lds + KMO);
    const int lane = F.lane, q = lane & 31, h = lane >> 5, w = F.wave, t = F.tid, srow = t >> 3, sch = t & 7;
    const bf16* QK = (const bf16*)(F.ws + WS_SCR + S_CQK); const bf16* VT = (const bf16*)(F.ws + WS_SCR + S_CVT);
    bf16* att = (bf16*)(F.ws + WS_SCR + S_CATT); const float* km = (const float*)(F.ws + WS_KMEAN);
    const int NP = NB * NH * 4, per = (NP + F.G - 1) / F.G;
    const int lo = F.vcu * per, hi = (lo + per) < NP ? (lo + per) : NP;
    const int nunits = 2 * (hi - lo);
    if (nunits <= 0) return;
    const int sdst = srow * AKP + sch * 8;
    int u = 0, cur_bh = -1;
    u32x4 kreg, vreg; bf16x8 qn[4], qf[4];
#define MB_LOADS(B_, HH_, S_) do { const bf16* ks_ = QK + ((size_t)(B_) * SEQ + 64 * (S_) + srow) * 2048 + 1024 + (HH_) * 64 + sch * 8; \
        const bf16* vs_ = VT + ((size_t)(HH_) * 64 + srow) * T + (size_t)(B_) * SEQ + 64 * (S_) + sch * 8; kreg = *(const u32x4*)ks_; vreg = *(const u32x4*)vs_; } while (0)
#define MB_QLOADS(B_, HH_, NB_) do { const bf16* qr_ = QK + ((size_t)(B_) * SEQ + (NB_) * 256 + 32 * w + q) * 2048 + (HH_) * 64; \
        _Pragma("unroll") for (int d0 = 0; d0 < 4; ++d0) qn[d0] = *(const bf16x8*)(qr_ + d0 * 16 + 8 * h); } while (0)
#define MB_WRITE(PB_) do { LAS bf16* kb_ = (LAS bf16*)(F.lds + TBL + (PB_) * 2 * ATILE); *(LAS u32x4*)(kb_ + sdst) = kreg; *(LAS u32x4*)(kb_ + 64 * AKP + sdst) = vreg; } while (0)
    int pu = lo, jj = pu & 3, hh = (pu >> 2) & 15, b = pu >> 6, nb = 7 - jj, s = 0, pb = 0;
    MB_LOADS(b, hh, 0); MB_QLOADS(b, hh, nb); MB_WRITE(0);
    unsigned sel = 0; bool fresh = true;
    AttnSt st; st.m = NEGB; st.l = 0.f; st.o0 = (f32x16){}; st.o1 = (f32x16){};
    for (;;) {
        if (fresh) {
            if (b * 16 + hh != cur_bh) { __syncthreads(); const float* btC = (const float*)(F.ws + WS_BTABC) + hh * 2048;
                for (int i = t; i < 2048 + 32; i += 512) bt[i] = i < 32 ? NEGB : btC[i - 32];
                { const float* kmp = km + ((size_t)b * NH + hh) * 512; kml[t] = kmp[t]; }
                cur_bh = b * 16 + hh; }
#pragma unroll
            for (int d0 = 0; d0 < 4; ++d0) qf[d0] = qn[d0];
            __syncthreads();
            sel = 0;
            if (nb > 0) {
                float gsc[7];
#pragma unroll
                for (int m = 0; m < 7; ++m) { float sc = 0.f;
                    if (m < nb) {
#pragma unroll
                        for (int d0 = 0; d0 < 4; ++d0) { const f32x4 c0 = *(const LAS f32x4*)(kml + m * 64 + d0 * 16 + 8 * h), c1 = *(const LAS f32x4*)(kml + m * 64 + d0 * 16 + 8 * h + 4); const u32x4 qq = __builtin_bit_cast(u32x4, qf[d0]);
                            sc += bflo(qq.x) * c0.x + bfhi(qq.x) * c0.y + bflo(qq.y) * c0.z + bfhi(qq.y) * c0.w + bflo(qq.z) * c1.x + bfhi(qq.z) * c1.y + bflo(qq.w) * c1.z + bfhi(qq.w) * c1.w; }
                        sc = xhalf_sum(sc); }
                    gsc[m] = m < nb ? sc : -3.0e38f; }
                const int nsel = nb < 3 ? nb : 3;
#pragma unroll
                for (int r = 0; r < 3; ++r) { if (r < nsel) { int bi = 0; float bv = -3.4e38f;
#pragma unroll
                        for (int m = 0; m < 7; ++m) if (!((sel >> m) & 1u) && gsc[m] > bv) { bv = gsc[m]; bi = m; }
                        sel |= 1u << bi; } }
            }
            fresh = false;
        }
        const int nsteps = 4 * nb + 4;
        const bool last = (s + 1 == nsteps);
        int nb2 = nb, b2 = b, hh2 = hh, s2 = s + 1; bool more = true;
        if (last) { const int u2 = u + 1; more = u2 < nunits; const int pu2 = lo + (u2 >> 1), j2 = pu2 & 3; hh2 = (pu2 >> 2) & 15; b2 = pu2 >> 6; nb2 = (u2 & 1) ? j2 : 7 - j2; s2 = 0; }
        if (more) { MB_LOADS(b2, hh2, s2); if (last) MB_QLOADS(b2, hh2, nb2); }
        { const LAS bf16* kb = (const LAS bf16*)(F.lds + TBL + pb * 2 * ATILE); const LAS bf16* vb = kb + 64 * AKP;
          const int qpos = nb * 256 + 32 * w + q;
          const LAS float* bl = bt + 32 + (qpos - 8 * h - 64 * s - 23);
          if (s < 4 * nb) { const bool mine = (sel >> (s >> 2)) & 1u;
              if (__ballot(mine) != 0ull) attn_tile2<true>(kb, vb, bl, qf, st, q, h, mine); }
          else { const int ta = (s - 4 * nb) * 2;
              if (ta + 1 <= w) attn_tile2<false>(kb, vb, bl, qf, st, q, h, true);
              else if (ta <= w) attn_tile<false>(kb, vb, bl, qf, st, q, h, true); } }
        if (more) MB_WRITE(pb ^ 1);
        if (last) {
            const float l_tot = xhalf_sum(st.l), inv = 1.f / l_tot;
            const size_t tq = (size_t)b * SEQ + nb * 256 + 32 * w + q;
            attn_store8(st, (unsigned char*)att + tq * 1024 + hh * 64 + 4 * h, inv * ASCALE8);
            st.m = NEGB; st.l = 0.f; st.o0 = (f32x16){}; st.o1 = (f32x16){};
        }
        if (!last) __syncthreads();
        pb ^= 1;
        if (!more) break;
        if (last) { ++u; fresh = true; }
        nb = nb2; b = b2; hh = hh2; s = s2;
    }
#undef MB_LOADS
#undef MB_QLOADS
#undef MB_WRITE
}

__device__ __forceinline__ void gmlp_phase(Frame& F, const float* lng, const float* lnb, const float* bs) {
    const int lane = F.lane, w = F.wave, q = lane & 31, h = lane >> 5;
    const bf16* uv = (const bf16*)(F.ws + WS_SCR + S_UV); bf16* p = (bf16*)(F.ws + WS_SCR + S_P); const bf16* wst = (const bf16*)(F.ws + WS_WST);
    LAS float* stat = (LAS float*)F.lds;
    LAS bf16* vnT = (LAS bf16*)(F.lds + 1024);
    constexpr int VP = 136;
    for (int unit = F.vcu; unit < T / 128; unit += F.G) {
        const size_t t0 = (size_t)unit * 128;
        __syncthreads();
        for (int i = 0; i < 16; ++i) { const int r = w * 16 + i; const u32x4* vr = (const u32x4*)(uv + (t0 + r) * 2048 + 1024) + lane;
            const u32x4 a = vr[0], b = vr[64]; float x[16];
            x[0] = bflo(a.x); x[1] = bfhi(a.x); x[2] = bflo(a.y); x[3] = bfhi(a.y); x[4] = bflo(a.z); x[5] = bfhi(a.z); x[6] = bflo(a.w); x[7] = bfhi(a.w);
            x[8] = bflo(b.x); x[9] = bfhi(b.x); x[10] = bflo(b.y); x[11] = bfhi(b.y); x[12] = bflo(b.z); x[13] = bfhi(b.z); x[14] = bflo(b.w); x[15] = bfhi(b.w);
            float s = 0.f;
#pragma unroll
            for (int j = 0; j < 16; ++j) s += x[j];
            const float mean = wave_sum(s) * (1.f / 1024.f); float s2 = 0.f;
#pragma unroll
            for (int j = 0; j < 16; ++j) { const float d = x[j] - mean; s2 += d * d; }
            const float rstd = 1.f / sqrtf(wave_sum(s2) * (1.f / 1024.f) + LN_EPS);
            if (lane == 0) { stat[2 * r] = mean; stat[2 * r + 1] = rstd; } }
        __syncthreads();
        for (int gg = 0; gg < 8; ++gg) {
#pragma unroll
            for (int k = 0; k < 4; ++k) { const int id = F.tid + 512 * k, s = id >> 4, cc = (id & 15) * 8;
                const u32x4 a = *(const u32x4*)(uv + (t0 + s) * 2048 + 1024 + gg * 128 + cc); const float mean = stat[2 * s], rstd = stat[2 * s + 1];
                float x[8]; x[0] = bflo(a.x); x[1] = bfhi(a.x); x[2] = bflo(a.y); x[3] = bfhi(a.y); x[4] = bflo(a.z); x[5] = bfhi(a.z); x[6] = bflo(a.w); x[7] = bfhi(a.w);
#pragma unroll
                for (int j = 0; j < 8; ++j) { const int c = gg * 128 + cc + j; const float y = (x[j] - mean) * rstd * lng[c] + lnb[c]; vnT[(cc + j) * VP + s] = (bf16)f2bf(y); } }
            __syncthreads();
            const int cr = 32 * (w & 3), tc0 = 64 * (w >> 2);
            f32x16 acc0 = {}, acc1 = {};
#pragma unroll
            for (int ks = 0; ks < 8; ++ks) {
                const bf16x8 af = *(const LAS bf16x8*)(vnT + (cr + q) * VP + ks * 16 + 8 * h);
                const bf16x8 b0 = *(const bf16x8*)(wst + ((size_t)gg * 128 + tc0 + q) * 128 + ks * 16 + 8 * h);
                const bf16x8 b1 = *(const bf16x8*)(wst + ((size_t)gg * 128 + tc0 + 32 + q) * 128 + ks * 16 + 8 * h);
                acc0 = mfma32(af, b0, acc0); acc1 = mfma32(af, b1, acc1);
            }
#pragma unroll
            for (int tt = 0; tt < 2; ++tt) { const f32x16& ac = tt == 0 ? acc0 : acc1; const int tl = tc0 + 32 * tt + q; const float bsv = bs[gg * 128 + tl];
                const size_t rowu = (t0 + tl) * 2048, rowp = (t0 + tl) * 1024;
#pragma unroll
                for (int gq = 0; gq < 4; ++gq) { const int c = gg * 128 + cr + 8 * gq + 4 * h; const u32x2 uu = *(const u32x2*)(uv + rowu + c);
                    u32x2 o; o.x = pk2(bflo(uu.x) * (ac[4 * gq] + bsv), bfhi(uu.x) * (ac[4 * gq + 1] + bsv)); o.y = pk2(bflo(uu.y) * (ac[4 * gq + 2] + bsv), bfhi(uu.y) * (ac[4 * gq + 3] + bsv));
                    *(u32x2*)(p + rowp + c) = o; } }
            __syncthreads();
        }
    }
}

struct MoeSeg { int ts[9]; };
__device__ __forceinline__ MoeSeg moe_seg(Frame& F, int moe_l) {
    MoeSeg s; int acc = 0;
#pragma unroll
    for (int e = 0; e < 8; ++e) { s.ts[e] = acc; const unsigned c = __hip_atomic_load((unsigned*)(F.ctl + CW_ECNT + 64 * moe_l + e), RLX_AGENT); acc += (int)((c + 255u) >> 8); }
    s.ts[8] = acc; return s;
}
__device__ __forceinline__ void moe_gather_phase(Frame& F, int moe_l) {
    LAS int* P = (LAS int*)F.lds;
    LAS int* wtot = (LAS int*)(F.lds + 65536);
    LAS int* tot = wtot + 64;
    const int* wcnt = (const int*)(F.ws + WS_WCNT);
    int t = F.tid; asm volatile("" : "+v"(t));
    const int lane = F.lane;
    int loc[4][8], sum[8], inc[8];
#pragma unroll
    for (int k = 0; k < 4; ++k) { const u32x4 a = *(const u32x4*)(wcnt + (4 * t + k) * 8), b = *(const u32x4*)(wcnt + (4 * t + k) * 8 + 4);
        loc[k][0] = (int)a.x; loc[k][1] = (int)a.y; loc[k][2] = (int)a.z; loc[k][3] = (int)a.w; loc[k][4] = (int)b.x; loc[k][5] = (int)b.y; loc[k][6] = (int)b.z; loc[k][7] = (int)b.w; }
#pragma unroll
    for (int e = 0; e < 8; ++e) { sum[e] = (loc[0][e] + loc[1][e]) + (loc[2][e] + loc[3][e]); inc[e] = sum[e]; }
#pragma unroll
    for (int off = 1; off < 64; off <<= 1) {
#pragma unroll
        for (int e = 0; e < 8; ++e) { const int v = __shfl_up(inc[e], off); if (lane >= off) inc[e] += v; } }
    if (lane == 63) {
#pragma unroll
        for (int e = 0; e < 8; ++e) wtot[F.wave * 8 + e] = inc[e]; }
    __syncthreads();
    int run[8];
#pragma unroll
    for (int e = 0; e < 8; ++e) { int wb = 0; for (int w = 0; w < F.wave; ++w) wb += wtot[w * 8 + e]; run[e] = wb + inc[e] - sum[e]; }
#pragma unroll
    for (int k = 0; k < 4; ++k) {
#pragma unroll
        for (int e = 0; e < 8; ++e) { P[(4 * t + k) * 8 + e] = run[e]; run[e] += loc[k][e]; } }
    if (t == 511) {
#pragma unroll
        for (int e = 0; e < 8; ++e) tot[e] = run[e]; }
    __syncthreads();
    MoeSeg sg; { int acc = 0;
#pragma unroll
        for (int e = 0; e < 8; ++e) { sg.ts[e] = acc; acc += (tot[e] + 255) >> 8; } sg.ts[8] = acc; }
    if (blockIdx.x == 0 && t < 8) __hip_atomic_store((unsigned*)(F.ctl + CW_ECNT + 64 * moe_l + t), (unsigned)tot[t], RLX_AGENT);
    const int gw = F.vcu * NWAVES + F.wave, NGW = F.G * NWAVES;
    const bf16* hb = (const bf16*)(F.ws + WS_HB); unsigned char* xg8 = (unsigned char*)F.out;
    const int* route = (const int*)(F.ws + WS_ROUTE); int* slots = (int*)(F.ws + WS_SLOTS);
    for (int m0 = 4 * gw; m0 < T; m0 += 4 * NGW) {
        int s1[4], s2[4]; u32x4 a[4], b[4];
#pragma unroll
        for (int k = 0; k < 4; ++k) { const int m = m0 + k, grp = m >> 5;
            const int e1 = route[4 * m], p1 = route[4 * m + 1], e2 = route[4 * m + 2], p2 = route[4 * m + 3];
            int ts1 = 0, ts2 = 0;
#pragma unroll
            for (int e = 0; e < 8; ++e) { ts1 = e == e1 ? sg.ts[e] : ts1; ts2 = e == e2 ? sg.ts[e] : ts2; }
            s1[k] = ts1 * 256 + P[grp * 8 + e1] + p1; s2[k] = ts2 * 256 + P[grp * 8 + e2] + p2;
            const u32x4* src = (const u32x4*)(hb + (size_t)m * D) + lane; a[k] = src[0]; b[k] = src[64]; }
#pragma unroll
        for (int k = 0; k < 4; ++k) { const int m = m0 + k;
            float x[16]; unpack8(a[k], x); unpack8(b[k], x + 8);
            u32x2 lo, hi; lo.x = pk4_fp8(x[0], x[1], x[2], x[3]); lo.y = pk4_fp8(x[4], x[5], x[6], x[7]); hi.x = pk4_fp8(x[8], x[9], x[10], x[11]); hi.y = pk4_fp8(x[12], x[13], x[14], x[15]);
            unsigned char* d1 = xg8 + (size_t)s1[k] * D + 8 * lane; unsigned char* d2 = xg8 + (size_t)s2[k] * D + 8 * lane;
            *(u32x2*)d1 = lo; *(u32x2*)(d1 + 512) = hi; *(u32x2*)d2 = lo; *(u32x2*)(d2 + 512) = hi;
            if (lane == 0) { slots[2 * m] = s1[k]; slots[2 * m + 1] = s2[k]; } }
    }
}
struct MoeOrder {
    int nM, nN, G, c, tile0; MoeSeg sg; const char* A0; const char* B0; size_t aT, bE, bT; bool a_local;
    bool out_local;
    __device__ __forceinline__ bool next(int i, pg8::Unit& u) const {
        int pm, pn; if (!pg8::tile_of((long)i * G + c, nM, nN, pm, pn)) return false;
        const int tile = tile0 + pm; int e = 0;
#pragma unroll
        for (int k = 1; k < 8; ++k) e += (tile >= sg.ts[k]) ? 1 : 0;
        u.pm = out_local ? pm : tile; u.pn = pn; u.a = (unsigned)((size_t)(a_local ? pm : tile) * aT); u.b = (unsigned)((size_t)e * bE + (size_t)pn * bT); return true;
    }
};


template <int GI> struct L0QKOrder { int G, c; const char* A0; const char* B0;
    __device__ __forceinline__ bool next(int i, pg8::Unit& u) const { if (!pg8::tile_of((long)i * G + c, 64, 8, u.pm, u.pn)) return false; const int pm = u.pm;
        const int tok = GI == 0 ? pm * 256 : (GI == 1 ? (pm >> 3) * 2048 + (pm & 1) * 1024 + ((pm >> 1) & 3) : (pm >> 3) * 2048 + (pm & 7) * 2);
        u.a = (unsigned)tok * 1024u; u.b = (unsigned)u.pn * 256u * 1024u; return true; } };
template <int GI> struct L0VtOrder { int G, c; const char* A0; const char* B0;
    __device__ __forceinline__ bool next(int i, pg8::Unit& u) const { if (!pg8::tile_of((long)i * G + c, 4, 64, u.pm, u.pn)) return false; const int pn = u.pn;
        const int tok = GI == 0 ? pn * 256 : (GI == 1 ? (pn >> 3) * 2048 + (pn & 1) * 1024 + ((pn >> 1) & 3) : (pn >> 3) * 2048 + (pn & 7) * 2);
        u.a = (unsigned)u.pm * 256u * 1024u; u.b = (unsigned)tok * 1024u; return true; } };
template <int GI> __device__ __forceinline__ void l0_gemms(Frame& F, int ck, int bx) {
    constexpr int rs = GI == 0 ? 1 : (GI == 1 ? 4 : 16);
    constexpr size_t hst = (GI == 0 ? (size_t)128 : (GI == 1 ? (size_t)512 : (size_t)1)) * 1024;
    const char* hbc = (const char*)(F.ws + WS_SCR + S_HB8) + (size_t)ck * TC * 1024;
    unsigned char* scr = F.ws + WS_SCR;
    { L0QKOrder<GI> S{F.G, bx, hbc, (const char*)(F.ws + W_A_QK) + (size_t)GI * 2048 * 1024};
      pg8::Gemm gm{512, rs, 1, hst, (size_t)128 * 1024};
      pg8::EpiBf16<0> E{(bf16*)(scr + S_QK) + (size_t)GI * TC * 2048, 2048, 1.f / WSCALE8};
      pg8::gemm_phase<pg8::EpiBf16<0>, L0QKOrder<GI>, false, 1>(F.lds, F.wave, gm, S, E); }
    { L0VtOrder<GI> S{F.G, bx, (const char*)(F.ws + W_A_V) + (size_t)GI * 1024 * 1024, hbc};
      pg8::Gemm gm{512, 1, rs, (size_t)128 * 1024, hst};
      pg8::EpiBf16<0> E{(bf16*)(scr + S_VT) + (size_t)GI * 1024 * TC, TC, 1.f / WSCALE8};
      pg8::gemm_phase<pg8::EpiBf16<0>, L0VtOrder<GI>, false, 1>(F.lds, F.wave, gm, S, E); }
}


#ifdef MK_SELFCHECK
__device__ __forceinline__ void selfcheck_buf(Frame& F, const void* ptr, size_t nbytes, int stage, int slot0) {
    if (!F.chk) return;
    const int gw = F.vcu * NWAVES + F.wave, NGW = F.G * NWAVES; unsigned* cks = (unsigned*)(F.ws + WS_NEED + 2 * MiB) + slot0;
    const int nch = (int)(nbytes >> 12);
    for (int c = gw; c < nch; c += NGW) { const u32x4* r = (const u32x4*)((const char*)ptr + ((size_t)c << 12)) + F.lane; unsigned x = 0;
#pragma unroll
        for (int j = 0; j < 4; ++j) { const u32x4 v = r[64 * j]; x ^= v.x * 3u + v.y * 5u + v.z * 7u + v.w * 11u + (unsigned)j; }
        x *= (unsigned)(2 * F.lane + 1);
#pragma unroll
        for (int o = 1; o < 64; o <<= 1) x ^= __shfl_xor(x, o);
        if (F.lane == 0) { if (F.chk == 1) cks[c] = x; else if (cks[c] != x) atomicMax((unsigned*)(F.ctl + 32), (unsigned)(1000 - stage)); } }
}
#endif

__global__ void __launch_bounds__(NWAVES * 64, 2) mk_fwd(Args args) {
    extern __shared__ __attribute__((aligned(16))) unsigned char lds[];
    Frame F;
    F.lds = (LAS unsigned char*)lds;
    F.tid = threadIdx.x; F.lane = F.tid & 63; F.wave = __builtin_amdgcn_readfirstlane(F.tid >> 6);
    F.G = gridDim.x; { const int bx = blockIdx.x; F.vcu = (F.G % 8 == 0) ? (bx % 8) * (F.G / 8) + bx / 8 : bx; }
    F.ws = args.ws; F.ctl = (gu32*)(args.ws + WS_CTL); F.out = args.out; F.chk = args.chk; F.stage = 0;
    volatile LAS unsigned* MISC = (volatile LAS unsigned*)(F.lds + MISC_OFF);
    for (int u = F.tid; u < (LDS_BYTES - RING_BYTES) / 4; u += NWAVES * 64) ((LAS unsigned*)(F.lds + RING_BYTES))[u] = 0u;
    __syncthreads();
    XcdBarrier bar; bar.bar = (unsigned*)(F.ctl + CW_BAR); bar.x = 0; bar.st = nullptr;
    if (!MK_MULTI) bar = xcd_barrier_post((unsigned*)(F.ctl + CW_BAR), MISC + 8);
    const int lo = args.ph_lo, hi = args.ph_hi;
    int ph = 0;
#define PHASE_BEGIN if (ph >= lo && ph < hi) { F.lane = (int)__builtin_amdgcn_mbcnt_hi(~0u, __builtin_amdgcn_mbcnt_lo(~0u, 0u)); asm volatile("" : "+v"(F.lane)); F.tid = F.wave * 64 + F.lane;
#define PHASE_END   if (!MK_MULTI && ph + 1 < hi) xcd_barrier(bar, F.tid); } ++ph;
    const int bx = (int)blockIdx.x;
#define scr (args.ws + WS_SCR)
#define hb ((const bf16*)(args.ws + WS_HB))
#define ln_g (args.in[2])
#define ln_b (args.in[3])

    PHASE_BEGIN p_prologue(F, args); if (MK_PROBE & 8) p_prologue(F, args); PHASE_END

    if (MK_ENABLE & 1) {
#define L0_CHUNK(ck) \
        PHASE_BEGIN \
        if ((ck) > 0) dil_merge_phase(F, (ck) - 1); \
        l0_gemms<0>(F, (ck), bx); l0_gemms<1>(F, (ck), bx); l0_gemms<2>(F, (ck), bx); \
        PHASE_END \
        PHASE_BEGIN dil_attn_phase3(F); if (MK_PROBE & 1) dil_attn_phase3(F); PHASE_END
        L0_CHUNK(0) L0_CHUNK(1) L0_CHUNK(2) L0_CHUNK(3)
#undef L0_CHUNK
        PHASE_BEGIN dil_merge_phase(F, 3); if (MK_PROBE & 4) { dil_merge_phase(F, 3); dil_merge_phase(F, 3); dil_merge_phase(F, 3); dil_merge_phase(F, 3); } PHASE_END
        PHASE_BEGIN
        { pg8::LinOrder S{T / 256, 4, F.G, bx, (const char*)(scr + S_ATT), (const char*)(F.ws + W_A_O), (size_t)256 * 1024, (size_t)256 * 1024};
          pg8::Gemm gm{512, 1, 1, (size_t)128 * 1024, (size_t)128 * 1024};
          pg8::EpiResLn<FFN_GU8 == 0> E{(bf16*)(F.ws + WS_HB), ln_g + 0 * 2048, ln_b + 0 * 2048, ALPHA, 1.f / (WSCALE8 * ASCALE8), (float*)scr, (unsigned*)(F.ctl + CW_LNC + 0 * 4096), (unsigned*)(F.ctl + CW_BAR) + XB_TMO, scr + S_HB8, F.lds + LNT_OFF};
          pg8::gemm_phase<pg8::EpiResLn<FFN_GU8 == 0>, pg8::LinOrder, true, 1>(F.lds, F.wave, gm, S, E); }
        PHASE_END
    } else {
        PHASE_BEGIN ln_phase<1, false, false>(F, ln_g + 0 * 2048, ln_b + 0 * 2048, nullptr); PHASE_END
    }
#define DENSE_FFN(f, lnidx, enbit) \
    if (MK_ENABLE & (enbit)) { \
        PHASE_BEGIN \
        if ((f) == FFN_GU8) { \
          pg8::LinOrder S{T / 256, 2 * DFF / 256, F.G, bx, (const char*)(scr + S_HB8), (const char*)(F.ws + W_F_GU) + (size_t)(f) * 2 * DFF * 2048, (size_t)256 * 1024, (size_t)256 * 1024}; \
          pg8::Gemm gm{512, 1, 1, (size_t)128 * 1024, (size_t)128 * 1024};     \
          pg8::EpiSwiglu8 E{(unsigned char*)(scr + S_HID), DFF, 1.f / WSCALE8}; \
          pg8::gemm_phase<pg8::EpiSwiglu8, pg8::LinOrder, true, 1>(F.lds, F.wave, gm, S, E); \
        } else { pg8::LinOrder S{T / 256, 2 * DFF / 256, F.G, bx, (const char*)hb, (const char*)(F.ws + W_F_GU) + (size_t)(f) * 2 * DFF * 2048, (size_t)256 * 2048, (size_t)256 * 2048}; \
          pg8::Gemm gm{1024, 1, 1, (size_t)128 * 2048, (size_t)128 * 2048}; \
          pg8::EpiSwiglu8 E{(unsigned char*)(scr + S_HID), DFF}; \
          pg8::gemm_phase(F.lds, F.wave, gm, S, E); } \
        PHASE_END \
        PHASE_BEGIN \
        { pg8::LinOrder S{T / 256, 4, F.G, bx, (const char*)(scr + S_HID), (const char*)(F.ws + W_F_D) + (size_t)(f) * 1024 * DFF * 2, (size_t)256 * DFF, (size_t)256 * DFF}; \
          pg8::Gemm gm{DFF / 2, 1, 1, (size_t)128 * DFF, (size_t)128 * DFF};     \
          pg8::EpiResLn<false> E{(bf16*)(F.ws + WS_HB), ln_g + (lnidx) * 1024, ln_b + (lnidx) * 1024, ALPHA, 1.f / WSCALE8D, (float*)(scr + S_Y), (unsigned*)(F.ctl + CW_LNC + (2 + (f)) * 4096), (unsigned*)(F.ctl + CW_BAR) + XB_TMO, nullptr, F.lds + LNT_OFF}; \
          pg8::gemm_phase<pg8::EpiResLn<false>, pg8::LinOrder, true, 1>(F.lds, F.wave, gm, S, E); }     \
        PHASE_END \
    } else { \
        PHASE_BEGIN ln_phase<1, false, false>(F, ln_g + (lnidx) * 1024, ln_b + (lnidx) * 1024, nullptr); PHASE_END \
    }
    DENSE_FFN(0, 1, 2)

    if (MK_ENABLE & 4) {
        PHASE_BEGIN
        { pg8::LinOrder S{T / 256, 4, F.G, bx, (const char*)hb, (const char*)(F.ws + W_B_IN), (size_t)256 * 2048, (size_t)256 * 2048};
          pg8::Gemm gm{1024, 1, 1, (size_t)128 * 2048, (size_t)128 * 2048};
          pg8::EpiBf16<0> E{(bf16*)(scr + S_BCX), 1024};
          pg8::gemm_phase(F.lds, F.wave, gm, S, E); }
        { pg8::LinOrder S{T / 256, 8, F.G, bx, (const char*)hb, (const char*)(F.ws + W_B_IN) + (size_t)1024 * 2048, (size_t)256 * 2048, (size_t)256 * 2048};
          pg8::Gemm gm{1024, 1, 1, (size_t)128 * 2048, (size_t)128 * 2048};
          pg8::EpiGlu<0> E{(bf16*)(scr + S_BCX + (size_t)128 * MiB), 1024};
          pg8::gemm_phase(F.lds, F.wave, gm, S, E); }
        PHASE_END
        PHASE_BEGIN conv_phase(F, args.in[7]); if (MK_PROBE & 4) conv_phase(F, args.in[7]); PHASE_END
        PHASE_BEGIN
        { pg8::LinOrder S{T / 256, 4, F.G, bx, (const char*)(scr + S_P), (const char*)(F.ws + W_B_O), (size_t)256 * 2048, (size_t)256 * 2048};
          pg8::Gemm gm{1024, 1, 1, (size_t)128 * 2048, (size_t)128 * 2048};
          pg8::EpiResBf16 E{hb, (bf16*)F.out, 1024, ALPHA};
          pg8::gemm_phase(F.lds, F.wave, gm, S, E); }
        PHASE_END
        PHASE_BEGIN ln_phase<0, true, false>(F, ln_g + 2 * 1024, ln_b + 2 * 1024, args.in[20]); PHASE_END
    } else {
        PHASE_BEGIN ln_phase<1, true, false>(F, ln_g + 2 * 1024, ln_b + 2 * 1024, args.in[20]); PHASE_END
    }
#define MOE_CHUNK(f, ck) \
        PHASE_BEGIN \
        { const MoeSeg sg = moe_seg(F, (f)); int nM = sg.ts[8] - (ck) * MOE_CH_TILES; nM = nM > MOE_CH_TILES ? MOE_CH_TILES : (nM < 0 ? 0 : nM); \
          MoeOrder S{nM, 2 * DFE / 256, F.G, bx, (ck) * MOE_CH_TILES, sg, (const char*)F.out, (const char*)(F.ws + W_E_GU) + (size_t)(f) * 8 * 2 * DFE * 2048, (size_t)256 * 1024, (size_t)2 * DFE * 2048, (size_t)256 * 1024, false, true}; \
          pg8::Gemm gm{512, 1, 1, (size_t)128 * 1024, (size_t)128 * 1024};     \
          pg8::EpiSwiglu8 E{(unsigned char*)(scr + S_MHID), DFE, 1.f / WSCALE8}; \
          pg8::gemm_phase<pg8::EpiSwiglu8, MoeOrder, true, 0x7C>(F.lds, F.wave, gm, S, E);     if ((ck) == 0 && (MK_PROBE & 32)) pg8::gemm_phase(F.lds, F.wave, gm, S, E); } \
        PHASE_END \
        PHASE_BEGIN \
        { const MoeSeg sg = moe_seg(F, (f)); int nM = sg.ts[8] - (ck) * MOE_CH_TILES; nM = nM > MOE_CH_TILES ? MOE_CH_TILES : (nM < 0 ? 0 : nM); \
          MoeOrder S{nM, 4, F.G, bx, (ck) * MOE_CH_TILES, sg, (const char*)(scr + S_MHID), (const char*)(F.ws + W_E_D) + (size_t)(f) * 8 * 1024 * DFE * 2, (size_t)256 * DFE, (size_t)1024 * DFE * 2, (size_t)256 * DFE, true, false}; \
          pg8::Gemm gm{DFE / 2, 1, 1, (size_t)128 * DFE, (size_t)128 * DFE};     \
          pg8::EpiBf16<0> E{(bf16*)(scr + S_XG), 1024, 1.f / WSCALE8D}; \
          pg8::gemm_phase<pg8::EpiBf16<0>, MoeOrder, true, 0x7B>(F.lds, F.wave, gm, S, E);     if ((ck) == 0 && (MK_PROBE & 64)) pg8::gemm_phase(F.lds, F.wave, gm, S, E); } \
        PHASE_END
#define MOE_FFN(f, lnidx, enbit, fin) \
    if (MK_ENABLE & (enbit)) { \
        PHASE_BEGIN moe_gather_phase(F, (f)); if (MK_PROBE & 4) moe_gather_phase(F, (f)); PHASE_END \
        MOE_CHUNK(f, 0) MOE_CHUNK(f, 1) MOE_CHUNK(f, 2) \
        PHASE_BEGIN ln_phase<2, false, fin>(F, ln_g + (lnidx) * 1024, ln_b + (lnidx) * 1024, nullptr); PHASE_END \
    } else { \
        PHASE_BEGIN ln_phase<1, false, fin>(F, ln_g + (lnidx) * 1024, ln_b + (lnidx) * 1024, nullptr); PHASE_END \
    }
    MOE_FFN(0, 3, 8, false)

    if (MK_ENABLE & 16) {
        PHASE_BEGIN
        { pg8::LinOrder S{T / 256, 8, F.G, bx, (const char*)hb, (const char*)(F.ws + W_C_QK), (size_t)256 * 2048, (size_t)256 * 2048};
          pg8::Gemm gm{1024, 1, 1, (size_t)128 * 2048, (size_t)128 * 2048};
          pg8::EpiBf16<0> E{(bf16*)(scr + S_CQK), 2048};
          pg8::gemm_phase(F.lds, F.wave, gm, S, E); }
        { pg8::LinOrder S{4, T / 256, F.G, bx, (const char*)(F.ws + W_C_V), (const char*)hb, (size_t)256 * 2048, (size_t)256 * 2048};
          pg8::Gemm gm{1024, 1, 1, (size_t)128 * 2048, (size_t)128 * 2048};
          pg8::EpiBf16<0> E{(bf16*)(scr + S_CVT), T};
          pg8::gemm_phase(F.lds, F.wave, gm, S, E); }
        PHASE_END
#ifdef MK_SELFCHECK
        PHASE_BEGIN selfcheck_buf(F, scr + S_CQK, (size_t)256 * MiB, 40, 0); selfcheck_buf(F, scr + S_CVT, (size_t)128 * MiB, 41, 65536); PHASE_END
#endif
        PHASE_BEGIN kmean_phase(F); if (MK_PROBE & 4) kmean_phase(F); PHASE_END
#ifdef MK_SELFCHECK
        PHASE_BEGIN selfcheck_buf(F, F.ws + WS_KMEAN, (size_t)1 * MiB, 42, 65536 + 32768); PHASE_END
#endif
        PHASE_BEGIN moba_phase3(F); if (MK_PROBE & 2) moba_phase3(F); PHASE_END
#ifdef MK_SELFCHECK
        PHASE_BEGIN selfcheck_buf(F, F.ws + WS_NEED + 3 * MiB, (size_t)4 * MiB, 43, 65536 + 32768 + 256); selfcheck_buf(F, F.ws + WS_NEED + 7 * MiB, (size_t)4 * MiB, 44, 65536 + 32768 + 256 + 1024);
                    selfcheck_buf(F, scr + S_CATT, (size_t)128 * MiB, 45, 65536 + 32768 + 256 + 2048); PHASE_END
#endif
        PHASE_BEGIN
        { pg8::LinOrder S{T / 256, 4, F.G, bx, (const char*)(scr + S_CATT), (const char*)(F.ws + W_C_O), (size_t)256 * 1024, (size_t)256 * 1024};
          pg8::Gemm gm{512, 1, 1, (size_t)128 * 1024, (size_t)128 * 1024};
          pg8::EpiResLn<FFN_GU8 == 1> E{(bf16*)(F.ws + WS_HB), ln_g + 4 * 1024, ln_b + 4 * 1024, ALPHA, 1.f / (WSCALE8 * ASCALE8), (float*)scr, (unsigned*)(F.ctl + CW_LNC + 1 * 4096), (unsigned*)(F.ctl + CW_BAR) + XB_TMO, scr + S_HB8, F.lds + LNT_OFF};
          pg8::gemm_phase<pg8::EpiResLn<FFN_GU8 == 1>, pg8::LinOrder, true, 1>(F.lds, F.wave, gm, S, E); }
        PHASE_END
    } else {
        PHASE_BEGIN ln_phase<1, false, false>(F, ln_g + 4 * 1024, ln_b + 4 * 1024, nullptr); PHASE_END
    }
    DENSE_FFN(1, 5, 32)

    if (MK_ENABLE & 64) {
        PHASE_BEGIN
        { pg8::LinOrder S{T / 256, 8, F.G, bx, (const char*)hb, (const char*)(F.ws + W_D_IN), (size_t)256 * 2048, (size_t)256 * 2048};
          pg8::Gemm gm{1024, 1, 1, (size_t)128 * 2048, (size_t)128 * 2048};
          pg8::EpiBf16<1> E{(bf16*)(scr + S_UV), 2048};
          pg8::gemm_phase(F.lds, F.wave, gm, S, E); }
        PHASE_END
        PHASE_BEGIN gmlp_phase(F, args.in[12], args.in[13], args.in[15]); if (MK_PROBE & 4) gmlp_phase(F, args.in[12], args.in[13], args.in[15]); PHASE_END
        PHASE_BEGIN
        { pg8::LinOrder S{T / 256, 4, F.G, bx, (const char*)(scr + S_P), (const char*)(F.ws + W_D_O), (size_t)256 * 2048, (size_t)256 * 2048};
          pg8::Gemm gm{1024, 1, 1, (size_t)128 * 2048, (size_t)128 * 2048};
          pg8::EpiResBf16 E{hb, (bf16*)F.out, 1024, ALPHA};
          pg8::gemm_phase(F.lds, F.wave, gm, S, E); }
        PHASE_END
        PHASE_BEGIN ln_phase<0, true, false>(F, ln_g + 6 * 1024, ln_b + 6 * 1024, args.in[20] + 8192); PHASE_END
    } else {
        PHASE_BEGIN ln_phase<1, true, false>(F, ln_g + 6 * 1024, ln_b + 6 * 1024, args.in[20] + 8192); PHASE_END
    }
    MOE_FFN(1, 7, 128, true)
#ifdef MK_SELFCHECK
    PHASE_BEGIN
    { const unsigned fl = __hip_atomic_load((unsigned*)(F.ctl + 32), RLX_AGENT);
      if (fl != 0u) { const int code = 1000 - (int)fl; const float cval = (code >= 40 && code <= 45) ? (float)(20 + 2 * (code - 40)) : (float)(1u << (code / 10 + 1)); const int gw = F.vcu * NWAVES + F.wave, NGW = F.G * NWAVES;
          for (int m = gw; m < T; m += NGW) { f32x4* w = (f32x4*)(F.out + (size_t)m * D) + F.lane;
#pragma unroll
              for (int j = 0; j < 4; ++j) w[64 * j] = (f32x4){cval, cval, cval, cval}; } } }
    PHASE_END
#endif
#undef PHASE_BEGIN
#undef PHASE_END
#undef scr
#undef hb
#undef ln_g
#undef ln_b
}

static int count_phases() {
    int n = 1;
    n += (MK_ENABLE & 1) ? (8 + 1 + 1) : 1;
    n += (MK_ENABLE & 2) ? 2 : 1;
    n += (MK_ENABLE & 4) ? 4 : 1;
    n += (MK_ENABLE & 8) ? 8 : 1;
    n += (MK_ENABLE & 16) ? 4 : 1;
    n += (MK_ENABLE & 32) ? 2 : 1;
    n += (MK_ENABLE & 64) ? 4 : 1;
    n += (MK_ENABLE & 128) ? 8 : 1;
#ifdef MK_SELFCHECK
    n += 1 + 3;
#endif
    return n;
}
extern "C" void kernel_launch(void* const* d_in, const int* in_sizes, int n_in, void* d_out, int out_size, void* d_ws, size_t ws_size, hipStream_t stream) {
    static int grid = 0;
    if (grid == 0) {
        if (n_in != 24 || in_sizes[0] != T * D || out_size != T * D || ws_size < WS_NEED) { fprintf(stderr, "kernel_launch: unexpected shapes (n_in %d, in0 %d, out %d, ws %zu < %zu); nothing launched\n", n_in, n_in > 0 ? in_sizes[0] : -1, out_size, ws_size, (size_t)WS_NEED); grid = -1; return; }
        int dev = 0, cus = 0, per_cu = 0;
        if (hipGetDevice(&dev) != hipSuccess || hipDeviceGetAttribute(&cus, hipDeviceAttributeMultiprocessorCount, dev) != hipSuccess) { grid = -1; return; }
        if (hipFuncSetAttribute((const void*)mk_fwd, hipFuncAttributeMaxDynamicSharedMemorySize, LDS_BYTES) != hipSuccess) { fprintf(stderr, "kernel_launch: hipFuncSetAttribute failed\n"); grid = -1; return; }
        if (hipOccupancyMaxActiveBlocksPerMultiprocessor(&per_cu, (const void*)mk_fwd, NWAVES * 64, LDS_BYTES) != hipSuccess || per_cu < 1) fprintf(stderr, "kernel_launch: occupancy query reports %d\n", per_cu);
        (void)hipGetLastError();
        grid = cus;
    }
    if (grid < 0) return;
    (void)hipMemsetAsync((char*)d_ws + WS_CTL, 0, CTL_ZERO_BYTES, stream);
#ifdef SELF_POISON
    (void)hipMemsetAsync((char*)d_ws + CTL_ZERO_BYTES, 0xAA, WS_NEED - CTL_ZERO_BYTES, stream);
    (void)hipMemsetAsync(d_out, 0xAA, (size_t)T * D * 4, stream);
#endif
    Args a{};
    for (int i = 0; i < 24; ++i) a.in[i] = (const float*)d_in[i];
    a.out = (float*)d_out; a.ws = (unsigned char*)d_ws;
    const int nph = count_phases();
#if MK_MULTI
    for (int p = 0; p < nph; ++p) { a.ph_lo = p; a.ph_hi = p + 1; hipLaunchKernelGGL(mk_fwd, dim3(grid), dim3(NWAVES * 64), LDS_BYTES, stream, a); }
#else
    a.ph_lo = 0; a.ph_hi = nph;
#ifdef MK_SELFCHECK
    a.chk = 1;
    hipLaunchKernelGGL(mk_fwd, dim3(grid), dim3(NWAVES * 64), LDS_BYTES, stream, a);
    (void)hipMemsetAsync((char*)d_ws + WS_CTL, 0, CTL_ZERO_BYTES, stream);
    a.chk = 2;
#endif
    hipLaunchKernelGGL(mk_fwd, dim3(grid), dim3(NWAVES * 64), LDS_BYTES, stream, a);
#endif
    const hipError_t le = hipPeekAtLastError();
    if (le != hipSuccess) fprintf(stderr, "kernel_launch: launch failed: %s\n", hipGetErrorName(le));
}
```

```cpp
#include <hip/hip_runtime.h>
#include <cstdio>
#include <cstdint>

#ifndef MK_MULTI
#define MK_MULTI 0
#endif
#ifndef MK_PROBE
#define MK_PROBE 0
#endif
#ifndef MK_ENABLE
#define MK_ENABLE 0xFF
#endif

#define GAS __attribute__((address_space(1)))
#define LAS __attribute__((address_space(3)))
typedef unsigned short bf16;
typedef short bf16x8 __attribute__((ext_vector_type(8)));
typedef float f32x4 __attribute__((ext_vector_type(4)));
typedef float f32x2 __attribute__((ext_vector_type(2)));
typedef float f32x16 __attribute__((ext_vector_type(16)));
typedef unsigned u32x4 __attribute__((ext_vector_type(4)));
typedef unsigned u32x2 __attribute__((ext_vector_type(2)));
typedef GAS unsigned gu32;
typedef int v8i_t __attribute__((ext_vector_type(8)));
typedef int v4i_t __attribute__((ext_vector_type(4)));
typedef short s16x16_t __attribute__((ext_vector_type(16)));

constexpr int D = 1024, NB = 32, SEQ = 2048, T = NB * SEQ, NH = 16, HD = 64;
constexpr int DFF = 2816, NE = 8, DFE = 3584;
constexpr float ALPHA = 1.6817928305074290f;
constexpr float LN_EPS = 1e-5f;
constexpr float LOG2E = 1.4426950408889634f;
constexpr float QSCALE = 0.125f * LOG2E;
constexpr float NEGB = -1e30f;
constexpr int TC = 16384;
constexpr int MOE_CH_TILES = 256;
constexpr int MOE_MAX_TILES = 520;
constexpr int FFN_GU8 = 1;

constexpr size_t MiB = 1u << 20;
constexpr size_t WS_CTL = 0, CTL_ZERO_BYTES = 1 * MiB;
constexpr size_t WS_BUCKET = 1 * MiB;
constexpr size_t WS_BTABA = WS_BUCKET + 8192;
constexpr size_t WS_BTABC = WS_BTABA + 32768;
constexpr size_t WS_WST = WS_BTABC + 131072;
constexpr size_t WS_KMEAN = 2 * MiB;
constexpr size_t WS_ROUTE = 4 * MiB;
constexpr size_t WS_GATES = 5 * MiB;
constexpr size_t WS_SLOTS = 6 * MiB;
constexpr size_t WS_WCNT = 7 * MiB;
constexpr size_t WS_W = 8 * MiB;
constexpr size_t W_A_QK = WS_W;
constexpr size_t W_A_V = W_A_QK + 12 * MiB;
constexpr size_t W_A_O = W_A_V + 6 * MiB;
constexpr size_t W_B_IN = W_A_O + 2 * MiB;
constexpr size_t W_B_O = W_B_IN + 6 * MiB;
constexpr size_t W_C_QK = W_B_O + 2 * MiB;
constexpr size_t W_C_V = W_C_QK + 4 * MiB;
constexpr size_t W_C_O = W_C_V + 2 * MiB;
constexpr size_t W_D_IN = W_C_O + 2 * MiB;
constexpr size_t W_D_O = W_D_IN + 4 * MiB;
constexpr size_t W_F_GU = W_D_O + 2 * MiB;
constexpr size_t W_F_D = W_F_GU + 22 * MiB;
constexpr size_t W_E_GU = W_F_D + 11 * MiB;
constexpr size_t W_E_D = W_E_GU + 224 * MiB;
constexpr size_t WS_HB = W_E_D + 112 * MiB;
constexpr size_t WS_SCR = WS_HB + 128 * MiB;
constexpr size_t WS_NEED = WS_SCR + 512 * MiB;
static_assert(WS_HB == 419 * MiB, "map");
constexpr size_t S_QK = 0;
constexpr size_t S_VT = 192 * MiB;
constexpr size_t S_HB8 = 416 * MiB;
constexpr size_t S_ATT = 288 * MiB;
constexpr size_t S_HID = 0;
constexpr size_t S_BCX = 0;
constexpr size_t S_P = 384 * MiB;
constexpr size_t S_XG = 0;
constexpr size_t S_MHID = 260 * MiB;
constexpr size_t S_Y = 256 * MiB;
constexpr size_t S_CQK = 0;
constexpr size_t S_CVT = 256 * MiB;
constexpr size_t S_CATT = 384 * MiB;
constexpr size_t S_UV = 0;
constexpr size_t O_OG = 0;
constexpr size_t O_LSE = 96 * MiB;
constexpr int CW_TMO = 0;
constexpr int CW_ECNT = 64;
constexpr int CW_BAR = 4096;
constexpr int CW_LNC = 16384;

constexpr float ASCALE8 = 8.f;
constexpr float WSCALE8 = 64.f, WSCALE8D = 256.f;
__device__ __forceinline__ unsigned pk4_fp8(float a, float b, float c, float d) { int p = 0; p = __builtin_amdgcn_cvt_pk_fp8_f32(a, b, p, false); p = __builtin_amdgcn_cvt_pk_fp8_f32(c, d, p, true); return (unsigned)p; }
namespace pg8 {
constexpr int BM = 256, BK = 64, HALF = 128, HTB = HALF * BK * 2, STAGE_BYTES = 8 * HTB, NXCD = 8, WGM = 8;
__host__ __device__ __forceinline__ int lds_byte(int r, int c) { const int st = (r >> 4) * 2 + (c >> 5), rr = r & 15, cc = c & 31, ob = rr * 64 + cc * 2; return st * 1024 + (ob ^ (((ob >> 9) & 1) << 5)); }
__host__ __device__ __forceinline__ void stage_rc(int b, int& R, int& C) { const int st = b / 1024, sb = b % 1024, swz = sb ^ (((sb >> 9) & 1) << 5); R = (st >> 1) * 16 + swz / 64; C = (st & 1) * 32 + (swz % 64) / 2; }
__host__ __device__ __forceinline__ int perm32(int rho) { const int n = rho >> 4, i = rho & 15; return 8 * (i >> 2) + 4 * n + (i & 3); }

struct Unit { int pm, pn; unsigned a, b; };
struct Gemm { int K; int rsA, rsB; size_t hstepA, hstepB; };

__device__ __forceinline__ bool tile_of(long L, int nM, int nN, int& pm, int& pn) {
    const int nwg = nM * nN; if (L >= nwg) return false;
    int wgid = (int)L; { const int q = nwg / NXCD, r = nwg % NXCD, xcd = wgid % NXCD, off = wgid / NXCD; wgid = (xcd < r ? xcd * (q + 1) : r * (q + 1) + (xcd - r) * q) + off; }
    const int nig = WGM * nN, gid = wgid / nig, fm = gid * WGM, gsz = (nM - fm) < WGM ? (nM - fm) : WGM;
    pm = fm + ((wgid % nig) % gsz); pn = (wgid % nig) / gsz; return true;
}
struct LinOrder {
    int nM, nN, G, c; const char* A0; const char* B0; size_t aT, bT;
    __device__ __forceinline__ bool next(int i, Unit& u) const { if (!tile_of((long)i * G + c, nM, nN, u.pm, u.pn)) return false; u.a = (unsigned)((size_t)u.pm * aT); u.b = (unsigned)((size_t)u.pn * bT); return true; }
};

typedef __bf16 bf16x2_t __attribute__((ext_vector_type(2)));
__device__ __forceinline__ unsigned cvt_pk_bf16(float lo, float hi) { f32x2 v = {lo, hi}; bf16x2_t b = __builtin_convertvector(v, bf16x2_t); return __builtin_bit_cast(unsigned, b); }
__device__ __forceinline__ f32x2 gelu_pk(f32x2 v) {
    const f32x2 av = __builtin_elementwise_abs(v), d = av * 0.2316418882f + 1.0f;
    f32x2 t; t.x = __builtin_amdgcn_rcpf(d.x); t.y = __builtin_amdgcn_rcpf(d.y);
    f32x2 q = t * 0.5307027145f + (-0.7265760135f); q = q * t + 0.7107068705f; q = q * t + (-0.142248368f); q = q * t + 0.127414796f; q = q * t;
    const f32x2 s = (v * v) * (-0.72134752044f);
    f32x2 e; e.x = __builtin_amdgcn_exp2f(s.x); e.y = __builtin_amdgcn_exp2f(s.y);
    const f32x2 m = v * (q * e), r = v - m;
    f32x2 o; o.x = v.x < 0.f ? m.x : r.x; o.y = v.y < 0.f ? m.y : r.y; return o;
}
__device__ __forceinline__ float silu_f(float g) { return g * __builtin_amdgcn_rcpf(1.0f + __builtin_amdgcn_exp2f(-LOG2E * g)); }

template <int ACT  > struct EpiBf16 {
    static constexpr bool PERM = true;
    bf16* O; int ldc; float sc = 1.f;
    __device__ __forceinline__ void operator()(const f32x4 (&acc)[2][2][4][2], const Unit& u, int wr, int wc, int fr, int fq) const {
        const int row0 = u.pm * BM + wr * 64 + fr, col0 = u.pn * BM + wc * 32 + 8 * fq;
#pragma unroll
        for (int ai = 0; ai < 2; ++ai)
#pragma unroll
            for (int m = 0; m < 4; ++m) { bf16* rowp = O + (size_t)(row0 + ai * HALF + m * 16) * ldc + col0;
#pragma unroll
                for (int bj = 0; bj < 2; ++bj) { f32x4 v0 = acc[ai][bj][m][0] * sc, v1 = acc[ai][bj][m][1] * sc;
                    if (ACT == 1) { f32x2 a = gelu_pk((f32x2){v0[0], v0[1]}), b = gelu_pk((f32x2){v0[2], v0[3]}), c = gelu_pk((f32x2){v1[0], v1[1]}), d = gelu_pk((f32x2){v1[2], v1[3]});
                        v0 = (f32x4){a.x, a.y, b.x, b.y}; v1 = (f32x4){c.x, c.y, d.x, d.y}; }
                    u32x4 w; w.x = cvt_pk_bf16(v0[0], v0[1]); w.y = cvt_pk_bf16(v0[2], v0[3]); w.z = cvt_pk_bf16(v1[0], v1[1]); w.w = cvt_pk_bf16(v1[2], v1[3]);
                    *(u32x4*)(rowp + bj * HALF) = w; } }
    }
};
template <int ACT  > struct EpiGlu {
    static constexpr bool PERM = true;
    bf16* O; int ldc;
    __device__ __forceinline__ void operator()(const f32x4 (&acc)[2][2][4][2], const Unit& u, int wr, int wc, int fr, int fq) const {
        const int row0 = u.pm * BM + wr * 64 + fr, col0 = u.pn * HALF + wc * 32 + 8 * fq;
#pragma unroll
        for (int ai = 0; ai < 2; ++ai)
#pragma unroll
            for (int m = 0; m < 4; ++m) { bf16* rowp = O + (size_t)(row0 + ai * HALF + m * 16) * ldc + col0;
                f32x4 g0 = acc[ai][0][m][0], g1 = acc[ai][0][m][1]; const f32x4 u0 = acc[ai][1][m][0], u1 = acc[ai][1][m][1];
                if (ACT == 1) { g0 = (f32x4){silu_f(g0[0]), silu_f(g0[1]), silu_f(g0[2]), silu_f(g0[3])}; g1 = (f32x4){silu_f(g1[0]), silu_f(g1[1]), silu_f(g1[2]), silu_f(g1[3])}; }
                const f32x4 p0 = g0 * u0, p1 = g1 * u1;
                u32x4 w; w.x = cvt_pk_bf16(p0[0], p0[1]); w.y = cvt_pk_bf16(p0[2], p0[3]); w.z = cvt_pk_bf16(p1[0], p1[1]); w.w = cvt_pk_bf16(p1[2], p1[3]);
                *(u32x4*)rowp = w; }
    }
};
struct EpiSwiglu8 {
    static constexpr bool PERM = true;
    unsigned char* O; int ldc; float s = 1.f;
    __device__ __forceinline__ void operator()(const f32x4 (&acc)[2][2][4][2], const Unit& u, int wr, int wc, int fr, int fq) const {
        const int row0 = u.pm * BM + wr * 64 + fr, col0 = u.pn * HALF + wc * 32 + 8 * fq;
#pragma unroll
        for (int ai = 0; ai < 2; ++ai)
#pragma unroll
            for (int m = 0; m < 4; ++m) { unsigned char* rowp = O + (size_t)(row0 + ai * HALF + m * 16) * ldc + col0;
                const f32x4 g0 = acc[ai][0][m][0], g1 = acc[ai][0][m][1], u0 = acc[ai][1][m][0], u1 = acc[ai][1][m][1];
                const float c1 = -LOG2E * s, s2 = s * s;
                const f32x4 p0 = (g0 * u0) * s2, p1 = (g1 * u1) * s2;
                f32x4 r0, r1;
#pragma unroll
                for (int j = 0; j < 4; ++j) { r0[j] = __builtin_amdgcn_rcpf(1.0f + __builtin_amdgcn_exp2f(g0[j] * c1)); r1[j] = __builtin_amdgcn_rcpf(1.0f + __builtin_amdgcn_exp2f(g1[j] * c1)); }
                const f32x4 o0 = p0 * r0, o1 = p1 * r1;
                u32x2 w; w.x = pk4_fp8(o0[0], o0[1], o0[2], o0[3]); w.y = pk4_fp8(o1[0], o1[1], o1[2], o1[3]);
                *(u32x2*)rowp = w; }
    }
};
struct EpiResBf16 {
    static constexpr bool PERM = true;
    const bf16* base; bf16* out; int ldc; float alpha; float sc = 1.f;
    __device__ __forceinline__ void operator()(const f32x4 (&acc)[2][2][4][2], const Unit& u, int wr, int wc, int fr, int fq) const {
        const int row0 = u.pm * BM + wr * 64 + fr, col0 = u.pn * BM + wc * 32 + 8 * fq;
#pragma unroll
        for (int ai = 0; ai < 2; ++ai)
#pragma unroll
            for (int m = 0; m < 4; ++m) { const size_t off = (size_t)(row0 + ai * HALF + m * 16) * ldc + col0;
#pragma unroll
                for (int bj = 0; bj < 2; ++bj) { const u32x4 b = *(const u32x4*)(base + off + bj * HALF); const f32x4 a0 = acc[ai][bj][m][0] * sc, a1 = acc[ai][bj][m][1] * sc;
                    u32x4 w; w.x = cvt_pk_bf16(__builtin_bit_cast(float, b.x << 16) * alpha + a0[0], __builtin_bit_cast(float, b.x & 0xffff0000u) * alpha + a0[1]);
                    w.y = cvt_pk_bf16(__builtin_bit_cast(float, b.y << 16) * alpha + a0[2], __builtin_bit_cast(float, b.y & 0xffff0000u) * alpha + a0[3]);
                    w.z = cvt_pk_bf16(__builtin_bit_cast(float, b.z << 16) * alpha + a1[0], __builtin_bit_cast(float, b.z & 0xffff0000u) * alpha + a1[1]);
                    w.w = cvt_pk_bf16(__builtin_bit_cast(float, b.w << 16) * alpha + a1[2], __builtin_bit_cast(float, b.w & 0xffff0000u) * alpha + a1[3]);
                    *(u32x4*)(out + off + bj * HALF) = w; }
                asm volatile("" ::: "memory"); }
    }
};

template <bool HB8> struct EpiResLn {
    static constexpr bool PERM = true;
    bf16* h; const float* gain; const float* bias; float alpha, sc;
    float* xbuf;
    unsigned* cnt;
    unsigned* tmo;
    unsigned char* h8;
    LAS unsigned char* tb;
    __device__ __forceinline__ void operator()(f32x4 (&acc)[2][2][4][2], const Unit& u, int wr, int wc, int fr, int fq) const {
        asm volatile("" : "+v"(fr), "+v"(fq));
        const int row0 = u.pm * BM + wr * 64 + fr, col0 = u.pn * BM + wc * 32 + 8 * fq;
        LAS f32x2* P = (LAS f32x2*)tb; LAS f32x2* S = (LAS f32x2*)(tb + 8192);
#pragma unroll
        for (int ai = 0; ai < 2; ++ai)
#pragma unroll
            for (int m = 0; m < 4; ++m) { const size_t off = (size_t)(row0 + ai * HALF + m * 16) * 1024 + col0; float sm = 0.f, sq = 0.f;
#pragma unroll
                for (int bj = 0; bj < 2; ++bj) { const u32x4 b = *(const u32x4*)(h + off + bj * HALF); const f32x4 a0 = acc[ai][bj][m][0] * sc, a1 = acc[ai][bj][m][1] * sc;
                    f32x4 z0, z1;
                    z0[0] = __builtin_bit_cast(float, b.x << 16) * alpha + a0[0]; z0[1] = __builtin_bit_cast(float, b.x & 0xffff0000u) * alpha + a0[1];
                    z0[2] = __builtin_bit_cast(float, b.y << 16) * alpha + a0[2]; z0[3] = __builtin_bit_cast(float, b.y & 0xffff0000u) * alpha + a0[3];
                    z1[0] = __builtin_bit_cast(float, b.z << 16) * alpha + a1[0]; z1[1] = __builtin_bit_cast(float, b.z & 0xffff0000u) * alpha + a1[1];
                    z1[2] = __builtin_bit_cast(float, b.w << 16) * alpha + a1[2]; z1[3] = __builtin_bit_cast(float, b.w & 0xffff0000u) * alpha + a1[3];
                    acc[ai][bj][m][0] = z0; acc[ai][bj][m][1] = z1;
                    sm += ((z0[0] + z0[1]) + (z0[2] + z0[3])) + ((z1[0] + z1[1]) + (z1[2] + z1[3]));
                    sq += ((z0[0] * z0[0] + z0[1] * z0[1]) + (z0[2] * z0[2] + z0[3] * z0[3])) + ((z1[0] * z1[0] + z1[1] * z1[1]) + (z1[2] * z1[2] + z1[3] * z1[3])); }
                sm += __shfl_xor(sm, 16); sm += __shfl_xor(sm, 32); sq += __shfl_xor(sq, 16); sq += __shfl_xor(sq, 32);
                if (fq == 0) P[(ai * HALF + wr * 64 + m * 16 + fr) * 4 + wc] = (f32x2){sm, sq};
                asm volatile("" ::: "memory"); }
        asm volatile("s_waitcnt lgkmcnt(0)" ::: "memory"); __builtin_amdgcn_s_barrier(); asm volatile("" ::: "memory");
        const int wid = wr * 4 + wc, lane = fq * 16 + fr, row = wid * 32 + (lane & 31);
        unsigned long long* slots = (unsigned long long*)xbuf + (size_t)(u.pm * BM + row) * 4;
        if (lane < 32) { const f32x2 a = P[row * 4 + 0], b = P[row * 4 + 1], c = P[row * 4 + 2], d = P[row * 4 + 3];
            const float ts = (a.x + b.x) + (c.x + d.x), tq = (a.y + b.y) + (c.y + d.y);
            __hip_atomic_store(slots + u.pn, ((unsigned long long)__builtin_bit_cast(unsigned, tq) << 32) | (unsigned long long)__builtin_bit_cast(unsigned, ts), __ATOMIC_RELAXED, __HIP_MEMORY_SCOPE_AGENT); }
        asm volatile("s_waitcnt vmcnt(0)" ::: "memory");
        if (lane == 0) (void)__hip_atomic_fetch_add(cnt + 16 * u.pm, 1u, __ATOMIC_RELAXED, __HIP_MEMORY_SCOPE_AGENT);
        if (wid == 0) { unsigned sp = 0u;
            while ((unsigned)__builtin_amdgcn_readfirstlane(__hip_atomic_load(cnt + 16 * u.pm, __ATOMIC_RELAXED, __HIP_MEMORY_SCOPE_AGENT)) < 32u) { __builtin_amdgcn_s_sleep(1);
                if ((++sp & 255u) == 0u) { if (__hip_atomic_load(tmo, __ATOMIC_RELAXED, __HIP_MEMORY_SCOPE_AGENT)) break; if (sp > (1u << 22)) { if (lane == 0) (void)__hip_atomic_fetch_add(tmo, 1u, __ATOMIC_RELAXED, __HIP_MEMORY_SCOPE_AGENT); break; } } }
            __builtin_amdgcn_fence(__ATOMIC_ACQUIRE, "agent"); }
        asm volatile("s_waitcnt vmcnt(0) lgkmcnt(0)" ::: "memory"); __builtin_amdgcn_s_barrier(); asm volatile("" ::: "memory");
        if (lane < 32) { float ts = 0.f, tq = 0.f;
#pragma unroll
            for (int t = 0; t < 4; ++t) { const unsigned long long w = __hip_atomic_load(slots + t, __ATOMIC_RELAXED, __HIP_MEMORY_SCOPE_AGENT); ts += __builtin_bit_cast(float, (unsigned)w); tq += __builtin_bit_cast(float, (unsigned)(w >> 32)); }
            const float mean = ts * (1.f / 1024.f), var = fmaxf(tq * (1.f / 1024.f) - mean * mean, 0.f);
            S[row] = (f32x2){mean, 1.f / sqrtf(var + LN_EPS)}; }
        asm volatile("s_waitcnt vmcnt(0) lgkmcnt(0)" ::: "memory"); __builtin_amdgcn_s_barrier(); asm volatile("" ::: "memory");
#pragma unroll
        for (int bj = 0; bj < 2; ++bj) { const f32x4 g0 = *(const f32x4*)(gain + col0 + bj * HALF), g1 = *(const f32x4*)(gain + col0 + bj * HALF + 4), b0 = *(const f32x4*)(bias + col0 + bj * HALF), b1 = *(const f32x4*)(bias + col0 + bj * HALF + 4);
#pragma unroll
            for (int ai = 0; ai < 2; ++ai)
#pragma unroll
                for (int m = 0; m < 4; ++m) { const int r = ai * HALF + wr * 64 + m * 16 + fr; const f32x2 sr = S[r]; const size_t off = (size_t)(u.pm * BM + r) * 1024 + col0 + bj * HALF;
                    const f32x4 y0 = (acc[ai][bj][m][0] - sr.x) * sr.y * g0 + b0, y1 = (acc[ai][bj][m][1] - sr.x) * sr.y * g1 + b1;
                    u32x4 w; w.x = cvt_pk_bf16(y0[0], y0[1]); w.y = cvt_pk_bf16(y0[2], y0[3]); w.z = cvt_pk_bf16(y1[0], y1[1]); w.w = cvt_pk_bf16(y1[2], y1[3]);
                    *(u32x4*)(h + off) = w;
                    if (HB8) { u32x2 w8; w8.x = pk4_fp8(y0[0], y0[1], y0[2], y0[3]); w8.y = pk4_fp8(y1[0], y1[1], y1[2], y1[3]); *(u32x2*)(h8 + off) = w8; }
                    asm volatile("" ::: "memory"); } }
    }
};

template <class Epi, class Sched, bool ALIGN_EPI = true, int FP8 = 0>
__device__ __forceinline__ void gemm_phase(LAS unsigned char* lds, const int wave_s, const Gemm g, const Sched& S, const Epi& E) {
    int tid = wave_s * 64 + (int)__builtin_amdgcn_mbcnt_hi(~0u, __builtin_amdgcn_mbcnt_lo(~0u, 0u)); asm volatile("" : "+v"(tid));
    const int wid = __builtin_amdgcn_readfirstlane(tid >> 6), lane = tid & 63, wr = wid >> 2, wc = wid & 3, fr = lane & 15, fq = lane >> 4;
    const int K = g.K, nt = K / BK;
    unsigned voffA[2], voffB[2];
#pragma unroll
    for (int i = 0; i < 2; ++i) { int R, C; stage_rc(tid * 16 + i * 8192, R, C); const int Rb = Epi::PERM ? ((R & ~31) + perm32(R & 31)) : R;
        voffA[i] = (unsigned)(R * g.rsA * K + C) * 2u; voffB[i] = (unsigned)(Rb * g.rsB * K + C) * 2u; }
    const unsigned kstep = (unsigned)(BK * 2);
    const unsigned hstepA = (unsigned)g.hstepA, hstepB = (unsigned)g.hstepB;
    const __amdgpu_buffer_rsrc_t rsrcA = __builtin_amdgcn_make_buffer_rsrc((void*)S.A0, 0, 0x7fffffff, 0x00020000), rsrcB = __builtin_amdgcn_make_buffer_rsrc((void*)S.B0, 0, 0x7fffffff, 0x00020000);
    const unsigned ldsw = (unsigned)wid * 1024u;
    const int aoff = lds_byte(wr * 64 + fr, fq * 8), boff = lds_byte(wc * 32 + fr, fq * 8);
    const int aoff8 = lds_byte(wr * 64 + fr, fq * 16), boff8 = lds_byte(wc * 32 + fr, fq * 16);
    unsigned bbase8_ = (unsigned)(4 * HTB + boff); asm volatile("" : "+v"(bbase8_));
    LAS unsigned char* const ldsB8 = lds + bbase8_;
#define PG8_SA(b, h) (((b) * 2 + (h)) * HTB)
#define PG8_SB(b, h) ((4 + (b) * 2 + (h)) * HTB)
#define PG8_STAGE(bufoff, gbase, voff) do { _Pragma("unroll") for (int _i = 0; _i < 2; ++_i) \
        __builtin_amdgcn_raw_ptr_buffer_load_lds(PG8_RS_##voff, (LAS unsigned*)(lds + (bufoff) + ldsw + _i * 8192), 16, (int)(voff)[_i], (int)(gbase), 0, 0); } while (0)
#define PG8_RS_voffA rsrcA
#define PG8_RS_voffB rsrcB
#define PG8_LD16(off) (*(const LAS bf16x8*)(lds + (off)))
#define PG8_CAT8(lo, hi) __builtin_shufflevector(__builtin_bit_cast(v4i_t, lo), __builtin_bit_cast(v4i_t, hi), 0, 1, 2, 3, 4, 5, 6, 7)
#define PG8_LDA(dst, b, h) do { if constexpr (FP8) { _Pragma("unroll") for (int m = 0; m < 4; ++m) dst##8[m] = PG8_CAT8(PG8_LD16(PG8_SA(b, h) + aoff + m * 2048), PG8_LD16(PG8_SA(b, h) + aoff + m * 2048 + 1024)); } \
        else { _Pragma("unroll") for (int m = 0; m < 4; ++m) _Pragma("unroll") for (int k = 0; k < 2; ++k) dst[m][k] = PG8_LD16(PG8_SA(b, h) + aoff + m * 2048 + k * 1024); } } while (0)
#define PG8_LDB(dst, b, h) do { if constexpr (FP8) { _Pragma("unroll") for (int n = 0; n < 2; ++n) dst##8[n] = PG8_CAT8(*(const LAS bf16x8*)(ldsB8 + ((b) * 2 + (h)) * HTB + n * 2048), *(const LAS bf16x8*)(ldsB8 + ((b) * 2 + (h)) * HTB + n * 2048 + 1024)); } \
        else { _Pragma("unroll") for (int n = 0; n < 2; ++n) _Pragma("unroll") for (int k = 0; k < 2; ++k) dst[n][k] = PG8_LD16(PG8_SB(b, h) + boff + n * 2048 + k * 1024); } } while (0)
#define PG8_MMA(ai, bj, At, Bt) do { __builtin_amdgcn_s_setprio(1); \
        if constexpr (FP8) { _Pragma("unroll") for (int m = 0; m < 4; ++m) _Pragma("unroll") for (int n = 0; n < 2; ++n) \
            acc[ai][bj][m][n] = __builtin_amdgcn_mfma_scale_f32_16x16x128_f8f6f4(Bt##8[n], At##8[m], acc[ai][bj][m][n], 0, 0, 0, 0, 0, 0); } \
        else { _Pragma("unroll") for (int m = 0; m < 4; ++m) _Pragma("unroll") for (int n = 0; n < 2; ++n) _Pragma("unroll") for (int k = 0; k < 2; ++k) \
            acc[ai][bj][m][n] = __builtin_amdgcn_mfma_f32_16x16x32_bf16(Bt[n][k], At[m][k], acc[ai][bj][m][n], 0, 0, 0); } \
        __builtin_amdgcn_s_setprio(0); } while (0)
#define PG8_WAIT_V(n) asm volatile("s_waitcnt vmcnt(" #n ")" ::: "memory")
#define PG8_WAIT_L(n) asm volatile("s_waitcnt lgkmcnt(" #n ")" ::: "memory")
#define PG8_BAR __builtin_amdgcn_s_barrier()
#define PG8_SCHED __builtin_amdgcn_sched_barrier(0)
    Unit cur, nxt; int ui = 0;
    if (!S.next(0, cur)) return;
    f32x4 acc[2][2][4][2];
#pragma unroll
    for (int a = 0; a < 2; ++a)
#pragma unroll
        for (int b = 0; b < 2; ++b)
#pragma unroll
            for (int m = 0; m < 4; ++m)
#pragma unroll
                for (int n = 0; n < 2; ++n) acc[a][b][m][n] = (f32x4){0.f, 0.f, 0.f, 0.f};
    bf16x8 At[4][2], B0[2][2], B1[2][2]; v8i_t At8[4], B08[2], B18[2];
    unsigned cA = cur.a, cB = cur.b;
    PG8_STAGE(PG8_SB(0, 0), cB, voffB); PG8_STAGE(PG8_SB(0, 1), cB + hstepB, voffB); PG8_STAGE(PG8_SA(0, 0), cA, voffA); PG8_STAGE(PG8_SA(0, 1), cA + hstepA, voffA);
    if (wr == 1) PG8_BAR;
    PG8_WAIT_V(2); PG8_BAR;
    PG8_STAGE(PG8_SB(1, 0), cB + kstep, voffB); PG8_STAGE(PG8_SA(1, 0), cA + kstep, voffA); PG8_STAGE(PG8_SB(1, 1), cB + hstepB + kstep, voffB);
    PG8_WAIT_V(6); PG8_BAR;
    for (;;) {
        const bool has_next = S.next(ui + 1, nxt);
        const unsigned nA = has_next ? nxt.a : cA, nB = has_next ? nxt.b : cB;
#pragma clang loop unroll(disable)
        for (int t = 0; t < nt; t += 2) {
            const bool last = (t == nt - 2);
            const unsigned a1 = cA + (unsigned)(t + 1) * kstep;
            const unsigned a2 = last ? nA : cA + (unsigned)(t + 2) * kstep, b2 = last ? nB : cB + (unsigned)(t + 2) * kstep;
            const unsigned a3 = a2 + kstep, b3 = b2 + kstep;
            PG8_LDB(B0, 0, 0); PG8_LDB(B1, 0, 1); PG8_SCHED; PG8_LDA(At, 0, 0); PG8_STAGE(PG8_SA(1, 1), a1 + hstepA, voffA);
            PG8_WAIT_V(8); PG8_WAIT_L(0); PG8_BAR; PG8_MMA(0, 0, At, B0); PG8_MMA(0, 1, At, B1); PG8_BAR; PG8_SCHED;
            PG8_LDA(At, 0, 1); PG8_STAGE(PG8_SB(0, 0), b2, voffB); PG8_STAGE(PG8_SB(0, 1), b2 + hstepB, voffB); PG8_STAGE(PG8_SA(0, 0), a2, voffA);
            PG8_WAIT_V(8); PG8_WAIT_L(0); PG8_BAR; PG8_MMA(1, 0, At, B0); PG8_MMA(1, 1, At, B1); PG8_BAR; PG8_SCHED;
            PG8_LDB(B0, 1, 0); PG8_LDB(B1, 1, 1); PG8_SCHED; PG8_LDA(At, 1, 0); PG8_STAGE(PG8_SA(0, 1), a2 + hstepA, voffA);
            PG8_WAIT_V(8); PG8_WAIT_L(0); PG8_BAR; PG8_MMA(0, 0, At, B0); PG8_MMA(0, 1, At, B1); PG8_BAR; PG8_SCHED;
            PG8_LDA(At, 1, 1); PG8_STAGE(PG8_SB(1, 0), b3, voffB); PG8_STAGE(PG8_SB(1, 1), b3 + hstepB, voffB); PG8_STAGE(PG8_SA(1, 0), a3, voffA);
            PG8_WAIT_V(8); PG8_WAIT_L(0); PG8_BAR; PG8_MMA(1, 0, At, B0); PG8_MMA(1, 1, At, B1); PG8_BAR; PG8_SCHED;
        }
        if constexpr (ALIGN_EPI) { if (wr == 0) PG8_BAR; }
        E(acc, cur, wr, wc, fr, fq);
        if (!has_next) break;
#pragma unroll
        for (int a = 0; a < 2; ++a)
#pragma unroll
            for (int b = 0; b < 2; ++b)
#pragma unroll
                for (int m = 0; m < 4; ++m)
#pragma unroll
                    for (int n = 0; n < 2; ++n) acc[a][b][m][n] = (f32x4){0.f, 0.f, 0.f, 0.f};
        cur = nxt; cA = nA; cB = nB; ++ui;
        if constexpr (ALIGN_EPI) { if (wr == 1) PG8_BAR; }
    }
    PG8_WAIT_V(0);
    if constexpr (!ALIGN_EPI) { if (wr == 0) PG8_BAR; }
    PG8_BAR;
#undef PG8_SA
#undef PG8_SB
#undef PG8_STAGE
#undef PG8_RS_voffA
#undef PG8_RS_voffB
#undef PG8_LDA
#undef PG8_LD16
#undef PG8_CAT8
#undef PG8_LDB
#undef PG8_MMA
#undef PG8_WAIT_V
#undef PG8_WAIT_L
#undef PG8_BAR
#undef PG8_SCHED
}
}

#define RLX_AGENT __ATOMIC_RELAXED, __HIP_MEMORY_SCOPE_AGENT
#define LDS_WAIT() asm volatile("s_waitcnt lgkmcnt(0)" ::: "memory")
#define VM_WAIT() asm volatile("s_waitcnt vmcnt(0)" ::: "memory")
__device__ __forceinline__ unsigned f2bf(float f) { unsigned u = __builtin_bit_cast(unsigned, f); return (u + 0x7fffu + ((u >> 16) & 1u)) >> 16; }
__device__ __forceinline__ unsigned pk2(float lo, float hi) { return pg8::cvt_pk_bf16(lo, hi); }
__device__ __forceinline__ float bflo(unsigned w) { return __builtin_bit_cast(float, w << 16); }
__device__ __forceinline__ float bfhi(unsigned w) { return __builtin_bit_cast(float, w & 0xffff0000u); }
__device__ __forceinline__ float wave_sum(float v) {
#pragma unroll
    for (int o = 1; o < 64; o <<= 1) v += __shfl_xor(v, o);
    return v;
}

#define XB_TMO      128
#define XB_XCNT(j)  (256  + 64 * (j))
#define XB_XSUB(j)  (1280 + 64 * (j))
#define XB_XGEN(j)  (2304 + 64 * (j))
#define XB_TOP      3328
#define XB_TOPGEN   3392
#define XCD_BAR_WORDS 3456
#define XB_SPIN_CAP (1u << 22)
__device__ __forceinline__ unsigned xb_ld(unsigned* p)              { return __hip_atomic_load(p, __ATOMIC_RELAXED, __HIP_MEMORY_SCOPE_AGENT); }
__device__ __forceinline__ unsigned xb_add(unsigned* p, unsigned v) { return __hip_atomic_fetch_add(p, v, __ATOMIC_RELAXED, __HIP_MEMORY_SCOPE_AGENT); }
__device__ __forceinline__ unsigned xb_xcc_id() { return (unsigned)__builtin_amdgcn_s_getreg((3 << 11) | 20) & 0xFu; }
#define XB_SPIN(cond, bar) do { unsigned _sp = 0; while (cond) { __builtin_amdgcn_s_sleep(1); \
    if ((++_sp & 255u) == 0u) { if (xb_ld(&(bar)[XB_TMO])) break; if (_sp > XB_SPIN_CAP) { atomicAdd(&(bar)[XB_TMO], 1u); break; } } } } while (0)
struct XcdBarrier { unsigned* bar; unsigned x; volatile LAS unsigned* st; };
__device__ __forceinline__ XcdBarrier xcd_barrier_post(unsigned* bar, volatile LAS unsigned* st) {
    XcdBarrier b; b.bar = bar; b.x = xb_xcc_id(); b.st = st;
    if (threadIdx.x == 0) (void)xb_add(&bar[XB_XCNT(b.x)], 1u);
    return b;
}
__device__ __forceinline__ void xcd_barrier_complete(unsigned* bar, unsigned x, unsigned& nloc, unsigned& nx) {
    const unsigned G = gridDim.x * gridDim.y * gridDim.z;
    unsigned sum, cnt, mine, sp = 0u;
    for (;;) {
        sum = 0u; cnt = 0u; mine = 0u;
#pragma unroll
        for (unsigned j = 0; j < 16; ++j) { const unsigned c = xb_ld(&bar[XB_XCNT(j)]); sum += c; cnt += (c > 0u) ? 1u : 0u; mine = (j == x) ? c : mine; }
        if (sum == G) break;
        __builtin_amdgcn_s_sleep(1);
        if ((++sp & 255u) == 0u) { if (xb_ld(&bar[XB_TMO])) break; if (sp > XB_SPIN_CAP) { atomicAdd(&bar[XB_TMO], 1u); break; } }
    }
    nloc = mine > 0u ? mine : 1u; nx = cnt > 0u ? cnt : 1u;
}
__device__ __forceinline__ void xcd_barrier(const XcdBarrier& b, const int tid) {
    asm volatile("s_waitcnt vmcnt(0)" ::: "memory");
    __syncthreads();
    if (tid == 0) {
        unsigned* bar = b.bar;
        __builtin_amdgcn_s_waitcnt(0);
        unsigned nloc = b.st[0], nx = b.st[1];
        if (nloc == 0u) { xcd_barrier_complete(bar, b.x, nloc, nx); b.st[0] = nloc; b.st[1] = nx; }
        const unsigned old = xb_add(&bar[XB_XSUB(b.x)], 1u);
        const unsigned gen = old / nloc;
        if (old + 1u == (gen + 1u) * nloc) {
            __builtin_amdgcn_fence(__ATOMIC_RELEASE, "agent");
            asm volatile("s_waitcnt vmcnt(0)" ::: "memory");
            const unsigned og = xb_add(&bar[XB_TOP], 1u);
            const unsigned tg = og / nx;
            if (og + 1u == (tg + 1u) * nx) xb_add(&bar[XB_TOPGEN], 1u);
            else XB_SPIN(xb_ld(&bar[XB_TOPGEN]) == tg, bar);
            __builtin_amdgcn_fence(__ATOMIC_ACQUIRE, "agent");
            xb_add(&bar[XB_XGEN(b.x)], 1u);
            asm volatile("s_waitcnt vmcnt(0)" ::: "memory");
        } else {
            XB_SPIN(xb_ld(&bar[XB_XGEN(b.x)]) == gen, bar);
            __builtin_amdgcn_fence(__ATOMIC_ACQUIRE, "agent");
            asm volatile("s_waitcnt vmcnt(0)" ::: "memory");
        }
    }
    __syncthreads();
}

constexpr int NWAVES = 8;
constexpr int RING_BYTES = 131072, MISC_OFF = RING_BYTES + 320, LNT_OFF = RING_BYTES + 2048  , LDS_BYTES = 147456;
struct Args { const float* in[24]; float* out; unsigned char* ws; int ph_lo, ph_hi; int chk, pad; };
struct Frame {
    LAS unsigned char* lds;
    gu32* ctl; unsigned char* ws; float* out;
    int tid, lane, wave, vcu, G;
    int chk, stage;
};

struct Job { const float* src; bf16* dst; int ld, K, N, mode, start; float scale; int fp8, pad; };
constexpr int NJOBS = 74;
__device__ __forceinline__ void make_job(const Args& a, int j, Job& J) {
    unsigned char* ws = a.ws; J.scale = 1.f; J.mode = 0; J.start = 0; J.fp8 = 0; J.pad = 0;
    if (j < 9) { const int g = j / 3, t = j % 3; J.src = a.in[4] + g * 3072 + t * 1024; J.ld = 9216; J.K = 1024; J.N = 1024;
        if (t == 2) J.dst = (bf16*)(ws + W_A_V + (size_t)g * 1024 * 1024); else J.dst = (bf16*)(ws + W_A_QK + (size_t)g * 2048 * 1024 + (size_t)t * 1024 * 1024);
        J.fp8 = 1; J.scale = (t == 0 ? QSCALE : 1.f) * WSCALE8; return; }
    j -= 9;
    if (j == 0) { J.src = a.in[5]; J.ld = 1024; J.K = 1024; J.N = 1024; J.dst = (bf16*)(ws + W_A_O); J.fp8 = 1; J.scale = WSCALE8; return; }
    if (j == 1) { J.src = a.in[6]; J.ld = 3072; J.K = 1024; J.N = 1024; J.dst = (bf16*)(ws + W_B_IN); return; }
    if (j == 9 || j == 10) { J.src = a.in[6] + 1024 * (j - 8); J.ld = 3072; J.K = 1024; J.N = 1024; J.dst = (bf16*)(ws + W_B_IN) + (size_t)1024 * 1024; J.mode = j - 8; return; }
    if (j == 2) { J.src = a.in[8]; J.ld = 1024; J.K = 1024; J.N = 1024; J.dst = (bf16*)(ws + W_B_O); return; }
    if (j == 3) { J.src = a.in[9]; J.ld = 3072; J.K = 1024; J.N = 1024; J.dst = (bf16*)(ws + W_C_QK); J.scale = QSCALE; return; }
    if (j == 4) { J.src = a.in[9] + 1024; J.ld = 3072; J.K = 1024; J.N = 1024; J.dst = (bf16*)(ws + W_C_QK) + (size_t)1024 * 1024; return; }
    if (j == 5) { J.src = a.in[9] + 2048; J.ld = 3072; J.K = 1024; J.N = 1024; J.dst = (bf16*)(ws + W_C_V); return; }
    if (j == 6) { J.src = a.in[10]; J.ld = 1024; J.K = 1024; J.N = 1024; J.dst = (bf16*)(ws + W_C_O); J.fp8 = 1; J.scale = WSCALE8; return; }
    if (j == 7) { J.src = a.in[11]; J.ld = 2048; J.K = 1024; J.N = 2048; J.dst = (bf16*)(ws + W_D_IN); return; }
    if (j == 8) { J.src = a.in[16]; J.ld = 1024; J.K = 1024; J.N = 1024; J.dst = (bf16*)(ws + W_D_O); return; }
    j -= 11;
    if (j < 6) { const int f = j / 3, t = j % 3;
        if (t < 2) { J.src = a.in[17 + t] + (size_t)f * 1024 * DFF; J.ld = DFF; J.K = 1024; J.N = DFF; J.dst = (bf16*)(ws + W_F_GU) + (size_t)f * 2 * DFF * 1024; J.mode = 1 + t;
            if (f == FFN_GU8) { J.fp8 = 1; J.scale = WSCALE8; } }
        else { J.src = a.in[19] + (size_t)f * DFF * 1024; J.ld = 1024; J.K = DFF; J.N = 1024; J.dst = (bf16*)(ws + W_F_D) + (size_t)f * 1024 * DFF; J.fp8 = 1; J.scale = WSCALE8D; }
        return; }
    j -= 6;
    { const int fe = j / 3, t = j % 3;
        if (t < 2) { J.src = a.in[21 + t] + (size_t)fe * 1024 * DFE; J.ld = DFE; J.K = 1024; J.N = DFE; J.dst = (bf16*)(ws + W_E_GU) + (size_t)fe * 2 * DFE * 1024; J.mode = 1 + t; J.fp8 = 1; J.scale = WSCALE8; }
        else { J.src = a.in[23] + (size_t)fe * DFE * 1024; J.ld = 1024; J.K = DFE; J.N = 1024; J.dst = (bf16*)(ws + W_E_D) + (size_t)fe * 1024 * DFE; J.fp8 = 1; J.scale = WSCALE8D; } }
}
__device__ __forceinline__ void transpose_item(const Job& J, int item, int lane) {
    const int nblk = J.N >> 6, kb = item / nblk, nb = item - kb * nblk, k0 = 64 * kb, n = 64 * nb + lane;
    const float* W = J.src + (size_t)k0 * J.ld + n;
    int r = n; if (J.mode) r = (n >> 7) * 256 + (n & 127) + (J.mode == 2 ? 128 : 0);
    const float sc = J.scale; const size_t ld = (size_t)J.ld;
    if (J.fp8) {
        unsigned char* dst8 = (unsigned char*)J.dst + (size_t)r * J.K + k0;
#pragma unroll
        for (int hf = 0; hf < 2; ++hf) {
            float v[32];
#pragma unroll
            for (int j = 0; j < 32; ++j) v[j] = W[(size_t)(32 * hf + j) * ld];
#pragma unroll
            for (int c = 0; c < 2; ++c) { u32x4 o; o.x = pk4_fp8(v[16 * c] * sc, v[16 * c + 1] * sc, v[16 * c + 2] * sc, v[16 * c + 3] * sc); o.y = pk4_fp8(v[16 * c + 4] * sc, v[16 * c + 5] * sc, v[16 * c + 6] * sc, v[16 * c + 7] * sc);
                o.z = pk4_fp8(v[16 * c + 8] * sc, v[16 * c + 9] * sc, v[16 * c + 10] * sc, v[16 * c + 11] * sc); o.w = pk4_fp8(v[16 * c + 12] * sc, v[16 * c + 13] * sc, v[16 * c + 14] * sc, v[16 * c + 15] * sc);
                *(u32x4*)(dst8 + 32 * hf + 16 * c) = o; }
        }
        return;
    }
    bf16* dst = J.dst + (size_t)r * J.K + k0;
#pragma unroll
    for (int hf = 0; hf < 2; ++hf) {
        float v[32];
#pragma unroll
        for (int j = 0; j < 32; ++j) v[j] = W[(size_t)(32 * hf + j) * ld];
#pragma unroll
        for (int c = 0; c < 4; ++c) { u32x4 o; o.x = pk2(v[8 * c] * sc, v[8 * c + 1] * sc); o.y = pk2(v[8 * c + 2] * sc, v[8 * c + 3] * sc); o.z = pk2(v[8 * c + 4] * sc, v[8 * c + 5] * sc); o.w = pk2(v[8 * c + 6] * sc, v[8 * c + 7] * sc);
            *(u32x4*)(dst + 32 * hf + 8 * c) = o; }
    }
}
__device__ __forceinline__ int t5_bucket(int d) {
    if (d < 16) return d;
    int b = 16 + (int)(log((double)d / 16.0) / log(128.0) * 16.0);
    return b < 16 ? 16 : (b > 31 ? 31 : b);
}
__device__ __forceinline__ void p_prologue(Frame& F, const Args& a) {
    unsigned char* gl_ = (unsigned char*)F.lds;
    Job* jobs = (Job*)(gl_ + 7 * 16384 + 8704);
    int* tot = (int*)(gl_ + 7 * 16384 + 8704 + NJOBS * sizeof(Job));
    static_assert(8704 + NJOBS * sizeof(Job) + 16 <= 16384, "job table fits");
    if (F.tid < NJOBS) { Job J; make_job(a, F.tid, J); jobs[F.tid] = J; }
    __syncthreads();
    if (F.tid == 0) { int s = 0; for (int j = 0; j < NJOBS; ++j) { jobs[j].start = s; s += (jobs[j].K / 64) * (jobs[j].N / 64); } tot[0] = s; }
    __syncthreads();
    const int total = tot[0];
    const int gw = F.vcu * NWAVES + F.wave, NGW = F.G * NWAVES;
    int jc = 0;
    for (int it = gw; it < total; it += NGW) {
        while (jc + 1 < NJOBS && jobs[jc + 1].start <= it) ++jc;
        const Job J = jobs[jc];
        transpose_item(J, it - J.start, F.lane);
    }
    { bf16* hb = (bf16*)(F.ws + WS_HB); const float* x = a.in[0]; unsigned char* hb8 = F.ws + WS_SCR + S_HB8;
      for (int m0 = 4 * gw; m0 < T; m0 += 4 * NGW) { f32x4 v[4][4];
#pragma unroll
          for (int k = 0; k < 4; ++k) { const f32x4* xr = (const f32x4*)(x + (size_t)(m0 + k) * D) + F.lane;
#pragma unroll
              for (int j = 0; j < 4; ++j) v[k][j] = xr[64 * j]; }
#pragma unroll
          for (int k = 0; k < 4; ++k) { unsigned long long* o8 = (unsigned long long*)(hb + (size_t)(m0 + k) * D) + F.lane;
#pragma unroll
              for (int j = 0; j < 4; ++j) o8[64 * j] = (unsigned long long)pk2(v[k][j].x, v[k][j].y) | ((unsigned long long)pk2(v[k][j].z, v[k][j].w) << 32);
              unsigned* o4 = (unsigned*)(hb8 + (size_t)(m0 + k) * D) + F.lane;
#pragma unroll
              for (int j = 0; j < 4; ++j) o4[64 * j] = pk4_fp8(v[k][j].x, v[k][j].y, v[k][j].z, v[k][j].w); } } }
    const int gt = blockIdx.x * 512 + F.tid, NGT = F.G * 512;
    const float* rel = a.in[1];
    float* btA = (float*)(F.ws + WS_BTABA); float* btC = (float*)(F.ws + WS_BTABC);
    for (int i = gt; i < 48 * 132; i += NGT) { const int gh = i / 132, dl = i % 132, g = gh >> 4, hh = gh & 15; const int dil = g == 0 ? 1 : (g == 1 ? 4 : 16);
        btA[i] = dl <= 128 ? rel[t5_bucket(dl * dil) * NH + hh] * LOG2E : 0.f; }
    for (int i = gt; i < 16 * 2048; i += NGT) { const int hh = i >> 11, dd = i & 2047; btC[i] = rel[t5_bucket(dd) * NH + hh] * LOG2E; }
    { bf16* wst = (bf16*)(F.ws + WS_WST); const float* wsrc = a.in[14];
      for (int i = gt; i < 8 * 128 * 128; i += NGT) { const int tt = (i >> 7) & 127, ss = i & 127; wst[i] = (bf16)f2bf(ss <= tt ? wsrc[i] : 0.f); } }
}

__device__ __forceinline__ void unpack8(const u32x4 a, float* x) { x[0] = bflo(a.x); x[1] = bfhi(a.x); x[2] = bflo(a.y); x[3] = bfhi(a.y); x[4] = bflo(a.z); x[5] = bfhi(a.z); x[6] = bflo(a.w); x[7] = bfhi(a.w); }
template <int MODE, bool ROUTE, bool FINAL, bool HB8 = false>
__device__ __forceinline__ void ln_phase(Frame& F, const float* gain, const float* bias, const float* wr) {
    constexpr int NBT = 2;
    const int gw = F.vcu * NWAVES + F.wave, NGW = F.G * NWAVES, lane = F.lane;
    bf16* hb = (bf16*)(F.ws + WS_HB); const bf16* zb = (const bf16*)F.out;
    float gv[16], bv[16];
#pragma unroll
    for (int k = 0; k < 2; ++k)
#pragma unroll
        for (int j = 0; j < 2; ++j) { const f32x4 g4 = *(const f32x4*)(gain + 512 * k + 8 * lane + 4 * j), b4 = *(const f32x4*)(bias + 512 * k + 8 * lane + 4 * j);
            gv[8 * k + 4 * j] = g4.x; gv[8 * k + 4 * j + 1] = g4.y; gv[8 * k + 4 * j + 2] = g4.z; gv[8 * k + 4 * j + 3] = g4.w;
            bv[8 * k + 4 * j] = b4.x; bv[8 * k + 4 * j + 1] = b4.y; bv[8 * k + 4 * j + 2] = b4.z; bv[8 * k + 4 * j + 3] = b4.w; }
    LAS float* wrT = (LAS float*)F.lds;
    if (ROUTE) { for (int i = F.tid; i < 8 * 1024; i += 512) { const int e = i >> 10, c = i & 1023; wrT[i] = wr[c * 8 + e]; } __syncthreads(); }
    const bf16* ys = (const bf16*)(F.ws + WS_SCR + S_XG);
    const int* slots = (const int*)(F.ws + WS_SLOTS); const float* gates = (const float*)(F.ws + WS_GATES);
    int* route = (int*)(F.ws + WS_ROUTE); float* gout = (float*)(F.ws + WS_GATES);
    for (int grp = gw; grp < T / 32; grp += NGW) {
        int cnt_e = 0;
        int my_e1 = 0, my_e2 = 0, my_r1 = 0, my_r2 = 0; float my_g1 = 0.f, my_g2 = 0.f;
        int sl0 = 0, sl1 = 0; float gg0 = 0.f, gg1 = 0.f;
        if (MODE == 2) { const int mm = grp * 32 + (lane & 31); sl0 = slots[2 * mm]; sl1 = slots[2 * mm + 1]; gg0 = gates[2 * mm]; gg1 = gates[2 * mm + 1]; }
        for (int i0 = 0; i0 < 32; i0 += NBT) {
            float v[NBT][16]; float st[NBT][2];
#pragma unroll
            for (int k = 0; k < NBT; ++k) { const int m = grp * 32 + i0 + k;
                if (MODE == 0) { const u32x4* zr = (const u32x4*)(zb + (size_t)m * D) + lane; unpack8(zr[0], v[k]); unpack8(zr[64], v[k] + 8); }
                else { const u32x4* hr = (const u32x4*)(hb + (size_t)m * D) + lane; unpack8(hr[0], v[k]); unpack8(hr[64], v[k] + 8);
#pragma unroll
                    for (int j = 0; j < 16; ++j) v[k][j] *= ALPHA;
                    if (MODE == 3) { const u32x4* yr = (const u32x4*)((const bf16*)(F.ws + WS_SCR + S_Y) + (size_t)m * D) + lane; float a[16]; unpack8(yr[0], a); unpack8(yr[64], a + 8);
#pragma unroll
                        for (int j = 0; j < 16; ++j) v[k][j] += a[j]; }
                    if (MODE == 2) { const int s0 = __builtin_amdgcn_readlane(sl0, i0 + k), s1 = __builtin_amdgcn_readlane(sl1, i0 + k);
                        const float g0 = __builtin_bit_cast(float, __builtin_amdgcn_readlane(__builtin_bit_cast(int, gg0), i0 + k)), g1 = __builtin_bit_cast(float, __builtin_amdgcn_readlane(__builtin_bit_cast(int, gg1), i0 + k));
                        const u32x4* y0 = (const u32x4*)(ys + (size_t)s0 * D) + lane; const u32x4* y1 = (const u32x4*)(ys + (size_t)s1 * D) + lane;
                        float a[16], b[16]; unpack8(y0[0], a); unpack8(y0[64], a + 8); unpack8(y1[0], b); unpack8(y1[64], b + 8);
#pragma unroll
                        for (int j = 0; j < 16; ++j) v[k][j] += g0 * a[j] + g1 * b[j]; } }
                float s = 0.f, q2 = 0.f;
#pragma unroll
                for (int j = 0; j < 16; ++j) { s += v[k][j]; q2 += v[k][j] * v[k][j]; }
                st[k][0] = s; st[k][1] = q2; }
#pragma unroll
            for (int o = 1; o < 64; o <<= 1) {
#pragma unroll
                for (int k = 0; k < NBT; ++k) { st[k][0] += __shfl_xor(st[k][0], o); st[k][1] += __shfl_xor(st[k][1], o); } }
#pragma unroll
            for (int k = 0; k < NBT; ++k) { const int m = grp * 32 + i0 + k;
                const float mean = st[k][0] * (1.f / D), var = fmaxf(st[k][1] * (1.f / D) - mean * mean, 0.f), rstd = 1.f / sqrtf(var + LN_EPS);
#pragma unroll
                for (int j = 0; j < 16; ++j) v[k][j] = (v[k][j] - mean) * rstd * gv[j] + bv[j];
                if (FINAL) { f32x4* orow = (f32x4*)(F.out + (size_t)m * D) + 2 * lane;
                    orow[0] = (f32x4){v[k][0], v[k][1], v[k][2], v[k][3]}; orow[1] = (f32x4){v[k][4], v[k][5], v[k][6], v[k][7]}; orow[128] = (f32x4){v[k][8], v[k][9], v[k][10], v[k][11]}; orow[129] = (f32x4){v[k][12], v[k][13], v[k][14], v[k][15]}; }
                else { u32x4* o = (u32x4*)(hb + (size_t)m * D) + lane; u32x4 a, b;
                    a.x = pk2(v[k][0], v[k][1]); a.y = pk2(v[k][2], v[k][3]); a.z = pk2(v[k][4], v[k][5]); a.w = pk2(v[k][6], v[k][7]); b.x = pk2(v[k][8], v[k][9]); b.y = pk2(v[k][10], v[k][11]); b.z = pk2(v[k][12], v[k][13]); b.w = pk2(v[k][14], v[k][15]);
                    o[0] = a; o[64] = b;
                    if (HB8) { u32x2* o8 = (u32x2*)(F.ws + WS_SCR + S_HB8 + (size_t)m * D) + lane; u32x2 c, d;
                        c.x = pk4_fp8(v[k][0], v[k][1], v[k][2], v[k][3]); c.y = pk4_fp8(v[k][4], v[k][5], v[k][6], v[k][7]); d.x = pk4_fp8(v[k][8], v[k][9], v[k][10], v[k][11]); d.y = pk4_fp8(v[k][12], v[k][13], v[k][14], v[k][15]);
                        o8[0] = c; o8[64] = d; } }
                if (ROUTE) {
                    float lg[8];
#pragma unroll
                    for (int e = 0; e < 8; ++e) { float p = 0.f;
#pragma unroll
                        for (int kk = 0; kk < 2; ++kk)
#pragma unroll
                            for (int j = 0; j < 2; ++j) { const f32x4 w4 = *(const LAS f32x4*)(wrT + e * 1024 + 512 * kk + 8 * lane + 4 * j); p += (v[k][8 * kk + 4 * j] * w4.x + v[k][8 * kk + 4 * j + 1] * w4.y) + (v[k][8 * kk + 4 * j + 2] * w4.z + v[k][8 * kk + 4 * j + 3] * w4.w); }
                        lg[e] = p; }
#pragma unroll
                    for (int o = 1; o < 64; o <<= 1) {
#pragma unroll
                        for (int e = 0; e < 8; ++e) lg[e] += __shfl_xor(lg[e], o); }
                    int e1 = 0; float v1 = lg[0];
#pragma unroll
                    for (int e = 1; e < 8; ++e) if (lg[e] > v1) { v1 = lg[e]; e1 = e; }
                    int e2 = -1; float v2 = -3.4e38f;
#pragma unroll
                    for (int e = 0; e < 8; ++e) if (e != e1 && lg[e] > v2) { v2 = lg[e]; e2 = e; }
                    const float g2 = 1.f / (1.f + __expf(v1 - v2)), g1 = 1.f - g2;
                    const int r1 = __shfl(cnt_e, e1); if (lane == e1) ++cnt_e;
                    const int r2 = __shfl(cnt_e, e2); if (lane == e2) ++cnt_e;
                    if (lane == i0 + k) { my_e1 = e1; my_e2 = e2; my_r1 = r1; my_r2 = r2; my_g1 = g1; my_g2 = g2; }
                }
            }
        }
        if (ROUTE) {
            if (lane < 8) ((int*)(F.ws + WS_WCNT))[grp * 8 + lane] = cnt_e;
            if (lane < 32) { const int m = grp * 32 + lane; int* r = route + 4 * m; r[0] = my_e1; r[1] = my_r1; r[2] = my_e2; r[3] = my_r2; gout[2 * m] = my_g1; gout[2 * m + 1] = my_g2; }
        }
    }
}

__device__ __forceinline__ f32x16 mfma32(bf16x8 a, bf16x8 b, f32x16 c) { return __builtin_amdgcn_mfma_f32_32x32x16_bf16(a, b, c, 0, 0, 0); }
__device__ __forceinline__ bf16x8 pack8(const f32x16& s, int b0) {
    u32x4 w; w.x = pg8::cvt_pk_bf16(s[b0], s[b0 + 1]); w.y = pg8::cvt_pk_bf16(s[b0 + 2], s[b0 + 3]); w.z = pg8::cvt_pk_bf16(s[b0 + 4], s[b0 + 5]); w.w = pg8::cvt_pk_bf16(s[b0 + 6], s[b0 + 7]);
    return __builtin_bit_cast(bf16x8, w);
}
__device__ __forceinline__ float max16(const f32x16& s) {
    float a = fmaxf(fmaxf(s[0], s[1]), fmaxf(s[2], s[3])), b = fmaxf(fmaxf(s[4], s[5]), fmaxf(s[6], s[7]));
    float c = fmaxf(fmaxf(s[8], s[9]), fmaxf(s[10], s[11])), d = fmaxf(fmaxf(s[12], s[13]), fmaxf(s[14], s[15]));
    return fmaxf(fmaxf(a, b), fmaxf(c, d));
}
__device__ __forceinline__ void softmax_pv(f32x16& s, float& m_run, float& l_run, f32x16& o0, f32x16& o1, const bf16* vt0, const bf16* vt1, int h) {
    float mx = max16(s); mx = fmaxf(mx, __shfl_xor(mx, 32));
    const float mn = fmaxf(m_run, mx), alpha = __builtin_amdgcn_exp2f(m_run - mn); m_run = mn;
    float ps = 0.f;
#pragma unroll
    for (int r = 0; r < 16; ++r) { const float p = __builtin_amdgcn_exp2f(s[r] - mn); s[r] = p; ps += p; }
    l_run = l_run * alpha + ps;
#pragma unroll
    for (int r = 0; r < 16; ++r) { o0[r] *= alpha; o1[r] *= alpha; }
    const bf16x8 p0 = pack8(s, 0), p1 = pack8(s, 8);
    const bf16x8 v00 = *(const bf16x8*)(vt0 + 8 * h), v01 = *(const bf16x8*)(vt0 + 16 + 8 * h), v10 = *(const bf16x8*)(vt1 + 8 * h), v11 = *(const bf16x8*)(vt1 + 16 + 8 * h);
    o0 = mfma32(v00, p0, o0); o0 = mfma32(v01, p1, o0);
    o1 = mfma32(v10, p0, o1); o1 = mfma32(v11, p1, o1);
}
__device__ __forceinline__ int kperm(int i) { return (i & 19) | ((i & 8) >> 1) | ((i & 4) << 1); }

__device__ __forceinline__ void dil_attn_phase(Frame& F) {
    LAS float* bt = (LAS float*)F.lds;
    { const float* btA = (const float*)(F.ws + WS_BTABA); for (int i = F.tid; i < 48 * 192; i += 512) { const int gh = i / 192, dl = i % 192 - 32; bt[i] = (dl >= 0 && dl <= 128) ? btA[gh * 132 + dl] : NEGB; } }
    __syncthreads();
    const int gw = F.vcu * NWAVES + F.wave, NGW = F.G * NWAVES, lane = F.lane, q = lane & 31, h = lane >> 5;
    const bf16* QK = (const bf16*)(F.ws + WS_SCR + S_QK); const bf16* VT = (const bf16*)(F.ws + WS_SCR + S_VT);
    bf16* OG = (bf16*)((unsigned char*)F.out + O_OG); float* LSE = (float*)((unsigned char*)F.out + O_LSE);
    constexpr int NTASK = 3 * 16 * 8 * 64;
    const int per = (NTASK + NGW - 1) / NGW;
    const int t_lo = gw * per, t_hi = (t_lo + per) < NTASK ? (t_lo + per) : NTASK;
    for (int task = t_lo; task < t_hi; ++task) {
        const int qt = task & 3, rn = (task >> 2) & 15, bl = (task >> 6) & 7, gh = task >> 9, g = gh >> 4, hh = gh & 15;
        const int nblk = 16 >> (2 * g); const bool has_prev = (rn & (nblk - 1)) != 0;
        const int n0 = bl * 2048 + rn * 128;
        const bf16* qrow = QK + ((size_t)g * TC + n0 + 32 * qt + q) * 2048 + hh * 64;
        bf16x8 qf[4];
#pragma unroll
        for (int d0 = 0; d0 < 4; ++d0) qf[d0] = *(const bf16x8*)(qrow + d0 * 16 + 8 * h);
        float m_run = NEGB, l_run = 0.f; f32x16 o0 = {}, o1 = {};
        const bf16* vbase0 = VT + ((size_t)g * 1024 + hh * 64 + q) * TC; const bf16* vbase1 = vbase0 + (size_t)32 * TC;
        const LAS float* btl = bt + gh * 192 + (q - 8 * h + 137);
#pragma unroll
        for (int t = 0; t < 5; ++t) {
            if (has_prev || qt + t > 3) {
                const int kr0 = n0 - 128 + 32 * qt + 32 * t;
                const bf16* krow = QK + ((size_t)g * TC + kr0 + kperm(q)) * 2048 + 1024 + hh * 64;
                f32x16 s;
#pragma unroll
                for (int r = 0; r < 16; ++r) s[r] = btl[-32 * t + 23 - 16 * (r >> 3) - (r & 7)];
#pragma unroll
                for (int d0 = 0; d0 < 4; ++d0) { const bf16x8 kf = *(const bf16x8*)(krow + d0 * 16 + 8 * h); s = mfma32(kf, qf[d0], s); }
                softmax_pv(s, m_run, l_run, o0, o1, vbase0 + kr0, vbase1 + kr0, h);
            }
        }
        const float l_tot = l_run + __shfl_xor(l_run, 32), inv = 1.f / l_tot;
        const size_t orow = (size_t)g * TC + n0 + 32 * qt + q;
        bf16* op = OG + orow * 1024 + hh * 64 + 4 * h;
#pragma unroll
        for (int gq = 0; gq < 4; ++gq) {
            u32x2 w0, w1; w0.x = pg8::cvt_pk_bf16(o0[4 * gq] * inv, o0[4 * gq + 1] * inv); w0.y = pg8::cvt_pk_bf16(o0[4 * gq + 2] * inv, o0[4 * gq + 3] * inv);
            w1.x = pg8::cvt_pk_bf16(o1[4 * gq] * inv, o1[4 * gq + 1] * inv); w1.y = pg8::cvt_pk_bf16(o1[4 * gq + 2] * inv, o1[4 * gq + 3] * inv);
            *(u32x2*)(op + 8 * gq) = w0; *(u32x2*)(op + 32 + 8 * gq) = w1; }
        if (h == 0) LSE[orow * 16 + hh] = m_run + __log2f(l_tot);
    }
}
__device__ __forceinline__ void dil_merge_phase(Frame& F, int ck) {
    const int gw = F.vcu * NWAVES + F.wave, NGW = F.G * NWAVES, lane = F.lane;
    const bf16* OG = (const bf16*)((unsigned char*)F.out + O_OG); const float* LSE = (const float*)((unsigned char*)F.out + O_LSE);
    unsigned char* att = F.ws + WS_SCR + S_ATT + (size_t)ck * TC * 1024;
    const int hh = lane >> 2;
    for (int tl0 = 2 * gw; tl0 < TC; tl0 += 2 * NGW) {
        size_t n[2][3]; float ls[2][3]; u32x4 x[2][3][2];
#pragma unroll
        for (int k = 0; k < 2; ++k) { const int tl = tl0 + k, bl = tl >> 11, tt = tl & 2047;
            n[k][0] = tl; n[k][1] = bl * 2048 + (tt & 3) * 512 + (tt >> 2); n[k][2] = bl * 2048 + (tt & 15) * 128 + (tt >> 4);
#pragma unroll
            for (int g = 0; g < 3; ++g) { ls[k][g] = LSE[((size_t)g * TC + n[k][g]) * 16 + hh]; const u32x4* p = (const u32x4*)(OG + ((size_t)g * TC + n[k][g]) * 1024 + 16 * lane); x[k][g][0] = p[0]; x[k][g][1] = p[1]; } }
#pragma unroll
        for (int k = 0; k < 2; ++k) {
            const float M = fmaxf(fmaxf(ls[k][0], ls[k][1]), ls[k][2]);
            float w[3]; float W = 0.f;
#pragma unroll
            for (int g = 0; g < 3; ++g) { w[g] = __builtin_amdgcn_exp2f(ls[k][g] - M); W += w[g]; }
            const float iw = 1.f / W;
            float acc[16];
#pragma unroll
            for (int j = 0; j < 16; ++j) acc[j] = 0.f;
#pragma unroll
            for (int g = 0; g < 3; ++g) { const float wg = w[g] * iw; float a[16]; unpack8(x[k][g][0], a); unpack8(x[k][g][1], a + 8);
#pragma unroll
                for (int j = 0; j < 16; ++j) acc[j] += wg * a[j]; }
#pragma unroll
            for (int j = 0; j < 16; ++j) acc[j] *= ASCALE8;
            u32x4 y; y.x = pk4_fp8(acc[0], acc[1], acc[2], acc[3]); y.y = pk4_fp8(acc[4], acc[5], acc[6], acc[7]); y.z = pk4_fp8(acc[8], acc[9], acc[10], acc[11]); y.w = pk4_fp8(acc[12], acc[13], acc[14], acc[15]);
            *(u32x4*)(att + (size_t)(tl0 + k) * 1024 + 16 * lane) = y;
        }
    }
}

__device__ __forceinline__ void conv_phase(Frame& F, const float* cw) {
    const int gw = F.vcu * NWAVES + F.wave, NGW = F.G * NWAVES, lane = F.lane;
    const bf16* gbp = (const bf16*)(F.ws + WS_SCR + S_BCX); const bf16* up = (const bf16*)(F.ws + WS_SCR + S_BCX + (size_t)128 * MiB); bf16* p = (bf16*)(F.ws + WS_SCR + S_P);
    for (int item = gw; item < (T / 32) * 2; item += NGW) {
        const int half = item & 1, tb = item >> 1, t0 = tb * 32, c0 = half * 512 + lane * 8;
        float w0[8], w1[8], w2[8];
#pragma unroll
        for (int j = 0; j < 8; ++j) { w0[j] = cw[c0 + j]; w1[j] = cw[1024 + c0 + j]; w2[j] = cw[2048 + c0 + j]; }
        float u1[8], u2[8];
        const bool first = (t0 & 2047) == 0;
#pragma unroll
        for (int j = 0; j < 8; ++j) { u1[j] = 0.f; u2[j] = 0.f; }
        if (!first) { unpack8(*(const u32x4*)(up + (size_t)(t0 - 2) * 1024 + c0), u2); unpack8(*(const u32x4*)(up + (size_t)(t0 - 1) * 1024 + c0), u1); }
        for (int i = 0; i < 32; ++i) { const size_t r = (size_t)(t0 + i) * 1024;
            const u32x4 gb = *(const u32x4*)(gbp + r + c0), uu = *(const u32x4*)(up + r + c0);
            float u0[8], b[8]; unpack8(uu, u0); unpack8(gb, b);
            float o[8];
#pragma unroll
            for (int j = 0; j < 8; ++j) { o[j] = b[j] * (w0[j] * u2[j] + w1[j] * u1[j] + w2[j] * u0[j]); u2[j] = u1[j]; u1[j] = u0[j]; }
            u32x4 x; x.x = pk2(o[0], o[1]); x.y = pk2(o[2], o[3]); x.z = pk2(o[4], o[5]); x.w = pk2(o[6], o[7]);
            *(u32x4*)(p + (size_t)(t0 + i) * 1024 + c0) = x; }
    }
}

__device__ __forceinline__ void kmean_phase(Frame& F) {
    const int gw = F.vcu * NWAVES + F.wave, NGW = F.G * NWAVES, lane = F.lane;
    const bf16* QK = (const bf16*)(F.ws + WS_SCR + S_CQK); float* km = (float*)(F.ws + WS_KMEAN);
    const int kq = lane >> 3, dc = lane & 7;
    for (int u = gw; u < NB * NH * 8; u += NGW) { const int blk = u & 7, hh = (u >> 3) & 15, b = u >> 7;
        float a[8];
#pragma unroll
        for (int j = 0; j < 8; ++j) a[j] = 0.f;
        const bf16* kp = QK + ((size_t)b * SEQ + blk * 256 + kq) * 2048 + 1024 + hh * 64 + dc * 8;
#pragma unroll 8
        for (int i = 0; i < 32; ++i) { const u32x4 x = *(const u32x4*)(kp + (size_t)i * 8 * 2048);
            a[0] += bflo(x.x); a[1] += bfhi(x.x); a[2] += bflo(x.y); a[3] += bfhi(x.y); a[4] += bflo(x.z); a[5] += bfhi(x.z); a[6] += bflo(x.w); a[7] += bfhi(x.w); }
#pragma unroll
        for (int j = 0; j < 8; ++j) { a[j] += __shfl_xor(a[j], 8); a[j] += __shfl_xor(a[j], 16); a[j] += __shfl_xor(a[j], 32); }
        if (lane < 8) { float* o = km + (size_t)u * 64 + lane * 8;
#pragma unroll
            for (int j = 0; j < 8; ++j) o[j] = a[j] * (1.f / 256.f); }
    }
}
__device__ __forceinline__ void moba_unit(Frame& F, int b, int hh, int nb, LAS float* bt, int& cur_h) {
    const int lane = F.lane, q = lane & 31, h = lane >> 5, w = F.wave;
    const bf16* QK = (const bf16*)(F.ws + WS_SCR + S_CQK); const bf16* VT = (const bf16*)(F.ws + WS_SCR + S_CVT);
    bf16* att = (bf16*)(F.ws + WS_SCR + S_CATT); const float* km = (const float*)(F.ws + WS_KMEAN);
    if (hh != cur_h) { __syncthreads(); const float* btC = (const float*)(F.ws + WS_BTABC) + hh * 2048; for (int i = F.tid; i < 2048; i += 512) bt[i] = btC[i]; cur_h = hh; __syncthreads(); }
    const size_t tq = (size_t)b * SEQ + nb * 256 + 32 * w + q;
    const bf16* qrow = QK + tq * 2048 + hh * 64;
    bf16x8 qf[4];
#pragma unroll
    for (int d0 = 0; d0 < 4; ++d0) qf[d0] = *(const bf16x8*)(qrow + d0 * 16 + 8 * h);
    unsigned sel = 0;
    if (nb > 0) {
        float gsc[7];
#pragma unroll
        for (int m = 0; m < 7; ++m) { float s = 0.f;
            if (m < nb) { const float* kmp = km + (((size_t)b * NH + hh) * 8 + m) * 64;
#pragma unroll
                for (int d0 = 0; d0 < 4; ++d0) { const f32x4 k0 = *(const f32x4*)(kmp + d0 * 16 + 8 * h), k1 = *(const f32x4*)(kmp + d0 * 16 + 8 * h + 4); const u32x4 qq = __builtin_bit_cast(u32x4, qf[d0]);
                    s += bflo(qq.x) * k0.x + bfhi(qq.x) * k0.y + bflo(qq.y) * k0.z + bfhi(qq.y) * k0.w + bflo(qq.z) * k1.x + bfhi(qq.z) * k1.y + bflo(qq.w) * k1.z + bfhi(qq.w) * k1.w; }
                s += __shfl_xor(s, 32); }
            gsc[m] = m < nb ? s : -3.0e38f; }
        const int nsel = nb < 3 ? nb : 3;
#pragma unroll
        for (int r = 0; r < 3; ++r) { if (r < nsel) { int bi = -1; float bv = -3.4e38f;
#pragma unroll
                for (int m = 0; m < 7; ++m) if (!((sel >> m) & 1u) && gsc[m] > bv) { bv = gsc[m]; bi = m; }
                sel |= 1u << bi; } }
    }
#ifdef MK_SELFCHECK
    if (h == 0) ((unsigned*)(F.ws + WS_NEED + 3 * MiB))[tq * 16 + hh] = sel;
#endif
    float m_run = NEGB, l_run = 0.f; f32x16 o0 = {}, o1 = {};
    const bf16* vbase0 = VT + ((size_t)hh * 64 + q) * T + (size_t)b * SEQ; const bf16* vbase1 = vbase0 + (size_t)32 * T;
    const int qpos = nb * 256 + 32 * w + q;
    for (int m = 0; m < nb; ++m) {
        const bool mine = (sel >> m) & 1u;
        if (__ballot(mine) == 0ull) continue;
        for (int kt = 0; kt < 8; ++kt) {
            const int kr0 = m * 256 + 32 * kt;
            const bf16* krow = QK + ((size_t)b * SEQ + kr0 + kperm(q)) * 2048 + 1024 + hh * 64;
            f32x16 s = {};
#pragma unroll
            for (int d0 = 0; d0 < 4; ++d0) { const bf16x8 kf = *(const bf16x8*)(krow + d0 * 16 + 8 * h); s = mfma32(kf, qf[d0], s); }
#pragma unroll
            for (int r = 0; r < 16; ++r) { const int kap = 16 * (r >> 3) + 8 * h + (r & 7); const float bb = bt[qpos - kr0 - kap]; s[r] = mine ? s[r] + bb : NEGB; }
            softmax_pv(s, m_run, l_run, o0, o1, vbase0 + kr0, vbase1 + kr0, h);
        }
    }
    for (int kt = 0; kt <= w; ++kt) {
        const int kr0 = nb * 256 + 32 * kt;
        const bf16* krow = QK + ((size_t)b * SEQ + kr0 + kperm(q)) * 2048 + 1024 + hh * 64;
        f32x16 s = {};
#pragma unroll
        for (int d0 = 0; d0 < 4; ++d0) { const bf16x8 kf = *(const bf16x8*)(krow + d0 * 16 + 8 * h); s = mfma32(kf, qf[d0], s); }
#pragma unroll
        for (int r = 0; r < 16; ++r) { const int kap = 16 * (r >> 3) + 8 * h + (r & 7); const int dd = qpos - kr0 - kap; const float bb = bt[dd < 0 ? 0 : dd]; s[r] = dd >= 0 ? s[r] + bb : NEGB; }
        softmax_pv(s, m_run, l_run, o0, o1, vbase0 + kr0, vbase1 + kr0, h);
    }
    const float l_tot = l_run + __shfl_xor(l_run, 32), inv = 1.f / l_tot;
#ifdef MK_SELFCHECK
    if (h == 0) ((float*)(F.ws + WS_NEED + 7 * MiB))[tq * 16 + hh] = m_run + __log2f(l_tot);
#endif
    bf16* op = att + tq * 1024 + hh * 64 + 4 * h;
#pragma unroll
    for (int gq = 0; gq < 4; ++gq) {
        u32x2 w0, w1; w0.x = pg8::cvt_pk_bf16(o0[4 * gq] * inv, o0[4 * gq + 1] * inv); w0.y = pg8::cvt_pk_bf16(o0[4 * gq + 2] * inv, o0[4 * gq + 3] * inv);
        w1.x = pg8::cvt_pk_bf16(o1[4 * gq] * inv, o1[4 * gq + 1] * inv); w1.y = pg8::cvt_pk_bf16(o1[4 * gq + 2] * inv, o1[4 * gq + 3] * inv);
        *(u32x2*)(op + 8 * gq) = w0; *(u32x2*)(op + 32 + 8 * gq) = w1; }
}
__device__ __forceinline__ void moba_phase(Frame& F) {
    LAS float* bt = (LAS float*)F.lds; int cur_h = -1;
    const int NP = NB * NH * 4, per = (NP + F.G - 1) / F.G;
    const int lo = F.vcu * per, hi = (lo + per) < NP ? (lo + per) : NP;
    for (int pu = lo; pu < hi; ++pu) { const int j = pu & 3, hh = (pu >> 2) & 15, b = pu >> 6;
        moba_unit(F, b, hh, 7 - j, bt, cur_h); moba_unit(F, b, hh, j, bt, cur_h); }
}


constexpr int AKP = 72;
constexpr int ATILE = 64 * AKP * 2;
struct AttnSt { float m, l; f32x16 o0, o1; };
template <bool MASKED>
__device__ __forceinline__ void attn_tile(const LAS bf16* Kt, const LAS bf16* Vt, const LAS float* bl, const bf16x8 (&qf)[4], AttnSt& st, int q, int h, bool mine) {
    f32x16 s;
#pragma unroll
    for (int r = 0; r < 16; ++r) s[r] = bl[23 - 16 * (r >> 3) - (r & 7)];
    const LAS bf16* kr = Kt + kperm(q) * AKP + 8 * h;
#pragma unroll
    for (int d0 = 0; d0 < 4; ++d0) s = mfma32(*(const LAS bf16x8*)(kr + d0 * 16), qf[d0], s);
    float mx = max16(s); mx = fmaxf(mx, __shfl_xor(mx, 32));
    float mn = fmaxf(st.m, mx); if (MASKED) mn = mine ? mn : st.m;
    const float alpha = __builtin_amdgcn_exp2f(st.m - mn);
    float ps = 0.f;
#pragma unroll
    for (int r = 0; r < 16; ++r) { const float p = __builtin_amdgcn_exp2f(s[r] - mn); s[r] = p; ps += p; }
    bf16x8 p0 = pack8(s, 0), p1 = pack8(s, 8);
    if (MASKED) { if (!mine) { p0 = (bf16x8){0, 0, 0, 0, 0, 0, 0, 0}; p1 = p0; ps = 0.f; } }
    st.l = st.l * alpha + ps; st.m = mn;
    if (__ballot(alpha != 1.0f) != 0ull) {
#pragma unroll
        for (int r = 0; r < 16; ++r) { st.o0[r] *= alpha; st.o1[r] *= alpha; } }
    const LAS bf16* v0 = Vt + q * AKP + 8 * h; const LAS bf16* v1 = v0 + 32 * AKP;
    st.o0 = mfma32(*(const LAS bf16x8*)v0, p0, st.o0); st.o0 = mfma32(*(const LAS bf16x8*)(v0 + 16), p1, st.o0);
    st.o1 = mfma32(*(const LAS bf16x8*)v1, p0, st.o1); st.o1 = mfma32(*(const LAS bf16x8*)(v1 + 16), p1, st.o1);
}
__device__ __forceinline__ void attn_store(const AttnSt& st, bf16* op  , float inv) {
#pragma unroll
    for (int gq = 0; gq < 4; ++gq) {
        u32x2 w0, w1; w0.x = pg8::cvt_pk_bf16(st.o0[4 * gq] * inv, st.o0[4 * gq + 1] * inv); w0.y = pg8::cvt_pk_bf16(st.o0[4 * gq + 2] * inv, st.o0[4 * gq + 3] * inv);
        w1.x = pg8::cvt_pk_bf16(st.o1[4 * gq] * inv, st.o1[4 * gq + 1] * inv); w1.y = pg8::cvt_pk_bf16(st.o1[4 * gq + 2] * inv, st.o1[4 * gq + 3] * inv);
        *(u32x2*)(op + 8 * gq) = w0; *(u32x2*)(op + 32 + 8 * gq) = w1; }
}

__device__ __forceinline__ void attn_store8(const AttnSt& st, unsigned char* op  , float inv) {
#pragma unroll
    for (int gq = 0; gq < 4; ++gq) {
        *(unsigned*)(op + 8 * gq) = pk4_fp8(st.o0[4 * gq] * inv, st.o0[4 * gq + 1] * inv, st.o0[4 * gq + 2] * inv, st.o0[4 * gq + 3] * inv);
        *(unsigned*)(op + 32 + 8 * gq) = pk4_fp8(st.o1[4 * gq] * inv, st.o1[4 * gq + 1] * inv, st.o1[4 * gq + 2] * inv, st.o1[4 * gq + 3] * inv); }
}

__device__ __forceinline__ void dil_attn_phase2(Frame& F) {
    LAS float* bt = (LAS float*)F.lds;
    { const float* btA = (const float*)(F.ws + WS_BTABA); for (int i = F.tid; i < 48 * 192; i += 512) { const int gh = i / 192, dl = i % 192 - 32; bt[i] = (dl >= 0 && dl <= 128) ? btA[gh * 132 + dl] : NEGB; } }
    __syncthreads();
    constexpr int TBL = 48 * 192 * 4;
    const int lane = F.lane, q = lane & 31, h = lane >> 5, w = F.wave, uw = w >> 2, qt = w & 3, t = F.tid, tu = t >> 8, tt = t & 255, srow = tt >> 3, sch = tt & 7;
    const bf16* QK = (const bf16*)(F.ws + WS_SCR + S_QK); const bf16* VT = (const bf16*)(F.ws + WS_SCR + S_VT);
    bf16* OG = (bf16*)((unsigned char*)F.out + O_OG); float* LSE = (float*)((unsigned char*)F.out + O_LSE);
    for (int du = F.vcu; du < 3072; du += F.G) {
        const int g = du >> 10, rem = du & 1023, hh = rem >> 6, blp = (rem >> 4) & 3, rn = rem & 15, gh = g * 16 + hh;
        const int nblk = 16 >> (2 * g); const bool has_prev = (rn & (nblk - 1)) != 0;
        const int j0 = has_prev ? 0 : 2;
        const int n0s = (2 * blp + tu) * 2048 + rn * 128;
        const bf16* ksrc = QK + ((size_t)g * TC + n0s - 128 + srow) * 2048 + 1024 + hh * 64 + sch * 8;
        const bf16* vsrc = VT + ((size_t)g * 1024 + hh * 64 + srow) * TC + (n0s - 128) + sch * 8;
        const int sdst = srow * AKP + sch * 8;
        const int n0 = (2 * blp + uw) * 2048 + rn * 128;
        const bf16* qrow = QK + ((size_t)g * TC + n0 + 32 * qt + q) * 2048 + hh * 64;
        bf16x8 qf[4];
#pragma unroll
        for (int d0 = 0; d0 < 4; ++d0) qf[d0] = *(const bf16x8*)(qrow + d0 * 16 + 8 * h);
        AttnSt st; st.m = NEGB; st.l = 0.f; st.o0 = (f32x16){}; st.o1 = (f32x16){};
        u32x4 k0, k1, v0, v1;
        k0 = *(const u32x4*)(ksrc + (size_t)(64 * j0) * 2048); k1 = *(const u32x4*)(ksrc + (size_t)(64 * j0 + 32) * 2048);
        v0 = *(const u32x4*)(vsrc + 64 * j0); v1 = *(const u32x4*)(vsrc + (size_t)32 * TC + 64 * j0);
        { LAS bf16* kb = (LAS bf16*)(F.lds + TBL + (0 * 2 + tu) * 2 * ATILE); LAS bf16* vb = kb + 64 * AKP;
          *(LAS u32x4*)(kb + sdst) = k0; *(LAS u32x4*)(kb + 32 * AKP + sdst) = k1; *(LAS u32x4*)(vb + sdst) = v0; *(LAS u32x4*)(vb + 32 * AKP + sdst) = v1; }
        __syncthreads();
        int pb = 0;
        for (int j = j0; j < 4; ++j) {
            const bool more = j + 1 < 4;
            if (more) { k0 = *(const u32x4*)(ksrc + (size_t)(64 * (j + 1)) * 2048); k1 = *(const u32x4*)(ksrc + (size_t)(64 * (j + 1) + 32) * 2048);
                        v0 = *(const u32x4*)(vsrc + 64 * (j + 1)); v1 = *(const u32x4*)(vsrc + (size_t)32 * TC + 64 * (j + 1)); }
            const LAS bf16* kb = (const LAS bf16*)(F.lds + TBL + (pb * 2 + uw) * 2 * ATILE); const LAS bf16* vb = kb + 64 * AKP;
#pragma unroll
            for (int t2 = 0; t2 < 2; ++t2) { const int t32 = 2 * j + t2;
                if (t32 >= qt && t32 <= qt + 4) {
                    const LAS float* bl = bt + gh * 192 + 32 + (32 * qt + q + 128 - 32 * t32 - 8 * h - 23);
                    attn_tile<false>(kb + 32 * t2 * AKP, vb + 32 * t2, bl, qf, st, q, h, true); } }
            if (more) { LAS bf16* kn = (LAS bf16*)(F.lds + TBL + ((pb ^ 1) * 2 + tu) * 2 * ATILE); LAS bf16* vn = kn + 64 * AKP;
                *(LAS u32x4*)(kn + sdst) = k0; *(LAS u32x4*)(kn + 32 * AKP + sdst) = k1; *(LAS u32x4*)(vn + sdst) = v0; *(LAS u32x4*)(vn + 32 * AKP + sdst) = v1; }
            __syncthreads();
            pb ^= 1;
        }
        const float l_tot = st.l + __shfl_xor(st.l, 32), inv = 1.f / l_tot;
        const size_t orow = (size_t)g * TC + n0 + 32 * qt + q;
        attn_store(st, OG + orow * 1024 + hh * 64 + 4 * h, inv);
        if (h == 0) LSE[orow * 16 + hh] = st.m + __log2f(l_tot);
    }
}

__device__ __forceinline__ void moba_unit2(Frame& F, int b, int hh, int nb, LAS float* bt, int& cur_h) {
    constexpr int TBL = 8448;
    const int lane = F.lane, q = lane & 31, h = lane >> 5, w = F.wave, t = F.tid, srow = t >> 3, sch = t & 7;
    const bf16* QK = (const bf16*)(F.ws + WS_SCR + S_CQK); const bf16* VT = (const bf16*)(F.ws + WS_SCR + S_CVT);
    bf16* att = (bf16*)(F.ws + WS_SCR + S_CATT); const float* km = (const float*)(F.ws + WS_KMEAN);
    if (hh != cur_h) { __syncthreads(); const float* btC = (const float*)(F.ws + WS_BTABC) + hh * 2048; for (int i = t; i < 2048 + 32; i += 512) bt[i] = i < 32 ? NEGB : btC[i - 32]; cur_h = hh; __syncthreads(); }
    const size_t tq = (size_t)b * SEQ + nb * 256 + 32 * w + q;
    const bf16* qrow = QK + tq * 2048 + hh * 64;
    bf16x8 qf[4];
#pragma unroll
    for (int d0 = 0; d0 < 4; ++d0) qf[d0] = *(const bf16x8*)(qrow + d0 * 16 + 8 * h);
    unsigned sel = 0;
    if (nb > 0) {
        float gsc[7];
#pragma unroll
        for (int m = 0; m < 7; ++m) { float s = 0.f;
            if (m < nb) { const float* kmp = km + (((size_t)b * NH + hh) * 8 + m) * 64;
#pragma unroll
                for (int d0 = 0; d0 < 4; ++d0) { const f32x4 k0 = *(const f32x4*)(kmp + d0 * 16 + 8 * h), k1 = *(const f32x4*)(kmp + d0 * 16 + 8 * h + 4); const u32x4 qq = __builtin_bit_cast(u32x4, qf[d0]);
                    s += bflo(qq.x) * k0.x + bfhi(qq.x) * k0.y + bflo(qq.y) * k0.z + bfhi(qq.y) * k0.w + bflo(qq.z) * k1.x + bfhi(qq.z) * k1.y + bflo(qq.w) * k1.z + bfhi(qq.w) * k1.w; }
                s += __shfl_xor(s, 32); }
            gsc[m] = m < nb ? s : -3.0e38f; }
        const int nsel = nb < 3 ? nb : 3;
#pragma unroll
        for (int r = 0; r < 3; ++r) { if (r < nsel) { int bi = 0; float bv = -3.4e38f;
#pragma unroll
                for (int m = 0; m < 7; ++m) if (!((sel >> m) & 1u) && gsc[m] > bv) { bv = gsc[m]; bi = m; }
                sel |= 1u << bi; } }
    }
    AttnSt st; st.m = NEGB; st.l = 0.f; st.o0 = (f32x16){}; st.o1 = (f32x16){};
    const int qpos = nb * 256 + 32 * w + q, nsteps = 4 * nb + 4;
    const bf16* ksrc = QK + ((size_t)b * SEQ + srow) * 2048 + 1024 + hh * 64 + sch * 8;
    const bf16* vsrc = VT + ((size_t)hh * 64 + srow) * T + (size_t)b * SEQ + sch * 8;
    const int sdst = srow * AKP + sch * 8;
    u32x4 kreg = *(const u32x4*)ksrc, vreg = *(const u32x4*)vsrc;
    { LAS bf16* kb = (LAS bf16*)(F.lds + TBL); *(LAS u32x4*)(kb + sdst) = kreg; *(LAS u32x4*)(kb + 64 * AKP + sdst) = vreg; }
    __syncthreads();
    int pb = 0;
    for (int s = 0; s < nsteps; ++s) {
        const bool more = s + 1 < nsteps;
        if (more) { kreg = *(const u32x4*)(ksrc + (size_t)(64 * (s + 1)) * 2048); vreg = *(const u32x4*)(vsrc + 64 * (s + 1)); }
        const LAS bf16* kb = (const LAS bf16*)(F.lds + TBL + pb * 2 * ATILE); const LAS bf16* vb = kb + 64 * AKP;
        if (s < 4 * nb) {
            const bool mine = (sel >> (s >> 2)) & 1u;
            if (__ballot(mine) != 0ull) {
#pragma unroll
                for (int t2 = 0; t2 < 2; ++t2) { const LAS float* bl = bt + 32 + (qpos - 8 * h - (64 * s + 32 * t2) - 23);
                    attn_tile<true>(kb + 32 * t2 * AKP, vb + 32 * t2, bl, qf, st, q, h, mine); } }
        } else {
#pragma unroll
            for (int t2 = 0; t2 < 2; ++t2) { const int t32 = (s - 4 * nb) * 2 + t2;
                if (t32 <= w) { const LAS float* bl = bt + 32 + (qpos - 8 * h - (64 * s + 32 * t2) - 23);
                    attn_tile<false>(kb + 32 * t2 * AKP, vb + 32 * t2, bl, qf, st, q, h, true); } }
        }
        if (more) { LAS bf16* kn = (LAS bf16*)(F.lds + TBL + (pb ^ 1) * 2 * ATILE); *(LAS u32x4*)(kn + sdst) = kreg; *(LAS u32x4*)(kn + 64 * AKP + sdst) = vreg; }
        __syncthreads();
        pb ^= 1;
    }
    const float l_tot = st.l + __shfl_xor(st.l, 32), inv = 1.f / l_tot;
    attn_store(st, att + tq * 1024 + hh * 64 + 4 * h, inv);
}
__device__ __forceinline__ void moba_phase2(Frame& F) {
    LAS float* bt = (LAS float*)F.lds; int cur_h = -1;
    const int NP = NB * NH * 4, per = (NP + F.G - 1) / F.G;
    const int lo = F.vcu * per, hi = (lo + per) < NP ? (lo + per) : NP;
    for (int pu = lo; pu < hi; ++pu) { const int j = pu & 3, hh = (pu >> 2) & 15, b = pu >> 6;
        moba_unit2(F, b, hh, 7 - j, bt, cur_h); moba_unit2(F, b, hh, j, bt, cur_h); }
}


__device__ __forceinline__ float xhalf_max(float m) { auto rr = __builtin_amdgcn_permlane32_swap(__float_as_uint(m), __float_as_uint(m), false, false); return fmaxf(__uint_as_float(rr[0]), __uint_as_float(rr[1])); }
__device__ __forceinline__ float xhalf_sum(float m) { auto rr = __builtin_amdgcn_permlane32_swap(__float_as_uint(m), __float_as_uint(m), false, false); return __uint_as_float(rr[0]) + __uint_as_float(rr[1]); }
template <bool MASKED>
__device__ __forceinline__ void attn_tile2(const LAS bf16* Kt, const LAS bf16* Vt, const LAS float* bl0, const bf16x8 (&qf)[4], AttnSt& st, int q, int h, bool mine) {
    f32x16 s0, s1;
#pragma unroll
    for (int r = 0; r < 16; ++r) { s0[r] = bl0[23 - 16 * (r >> 3) - (r & 7)]; s1[r] = bl0[-32 + 23 - 16 * (r >> 3) - (r & 7)]; }
    const LAS bf16* kr = Kt + kperm(q) * AKP + 8 * h;
#pragma unroll
    for (int d0 = 0; d0 < 4; ++d0) { s0 = mfma32(*(const LAS bf16x8*)(kr + d0 * 16), qf[d0], s0); s1 = mfma32(*(const LAS bf16x8*)(kr + 32 * AKP + d0 * 16), qf[d0], s1); }
    const float mx = xhalf_max(fmaxf(max16(s0), max16(s1)));
    float mn = fmaxf(st.m, mx); if (MASKED) mn = mine ? mn : st.m;
    const float alpha = __builtin_amdgcn_exp2f(st.m - mn);
    float ps0 = 0.f, ps1 = 0.f;
#pragma unroll
    for (int r = 0; r < 16; ++r) { const float p = __builtin_amdgcn_exp2f(s0[r] - mn); s0[r] = p; ps0 += p; const float p2 = __builtin_amdgcn_exp2f(s1[r] - mn); s1[r] = p2; ps1 += p2; }
    bf16x8 p00 = pack8(s0, 0), p01 = pack8(s0, 8), p10 = pack8(s1, 0), p11 = pack8(s1, 8);
    float ps = ps0 + ps1;
    if (MASKED) { if (!mine) { p00 = (bf16x8){0, 0, 0, 0, 0, 0, 0, 0}; p01 = p00; p10 = p00; p11 = p00; ps = 0.f; } }
    st.l = st.l * alpha + ps; st.m = mn;
    if (__ballot(alpha != 1.0f) != 0ull) {
#pragma unroll
        for (int r = 0; r < 16; ++r) { st.o0[r] *= alpha; st.o1[r] *= alpha; } }
    const LAS bf16* v0 = Vt + q * AKP + 8 * h; const LAS bf16* v1 = v0 + 32 * AKP;
    st.o0 = mfma32(*(const LAS bf16x8*)v0, p00, st.o0); st.o1 = mfma32(*(const LAS bf16x8*)v1, p00, st.o1);
    st.o0 = mfma32(*(const LAS bf16x8*)(v0 + 16), p01, st.o0); st.o1 = mfma32(*(const LAS bf16x8*)(v1 + 16), p01, st.o1);
    st.o0 = mfma32(*(const LAS bf16x8*)(v0 + 32), p10, st.o0); st.o1 = mfma32(*(const LAS bf16x8*)(v1 + 32), p10, st.o1);
    st.o0 = mfma32(*(const LAS bf16x8*)(v0 + 48), p11, st.o0); st.o1 = mfma32(*(const LAS bf16x8*)(v1 + 48), p11, st.o1);
}

__device__ __forceinline__ void dil_attn_phase3(Frame& F) {
    LAS float* bt = (LAS float*)F.lds;
    { const float* btA = (const float*)(F.ws + WS_BTABA); for (int i = F.tid; i < 48 * 192; i += 512) { const int gh = i / 192, dl = i % 192 - 32; bt[i] = (dl >= 0 && dl <= 128) ? btA[gh * 132 + dl] : NEGB; } }
    constexpr int TBL = 48 * 192 * 4;
    const int lane = F.lane, q = lane & 31, h = lane >> 5, w = F.wave, uw = w >> 2, qt = w & 3, t = F.tid, tu = t >> 8, tt = t & 255, srow = tt >> 3, sch = tt & 7;
    const bf16* QK = (const bf16*)(F.ws + WS_SCR + S_QK); const bf16* VT = (const bf16*)(F.ws + WS_SCR + S_VT);
    bf16* OG = (bf16*)((unsigned char*)F.out + O_OG); float* LSE = (float*)((unsigned char*)F.out + O_LSE);
    const int sdst = srow * AKP + sch * 8;
    int du = F.vcu;
    if (du >= 3072) { __syncthreads(); return; }
    int g = du >> 10, hh = (du >> 6) & 15, blp = (du >> 4) & 3, rn = du & 15;
    int j = ((rn & ((16 >> (2 * g)) - 1)) != 0) ? 0 : 2;
    u32x4 k0, k1, v0, v1; bf16x8 qn[4], qf[4];
#define DIL_LOADS(G_, HH_, BLP_, RN_, J_) do { const int n0s_ = (2 * (BLP_) + tu) * 2048 + (RN_) * 128 - 128 + 64 * (J_); \
        const bf16* ks_ = QK + ((size_t)(G_) * TC + n0s_ + srow) * 2048 + 1024 + (HH_) * 64 + sch * 8; \
        const bf16* vs_ = VT + ((size_t)(G_) * 1024 + (HH_) * 64 + srow) * TC + n0s_ + sch * 8; \
        k0 = *(const u32x4*)ks_; k1 = *(const u32x4*)(ks_ + (size_t)32 * 2048); v0 = *(const u32x4*)vs_; v1 = *(const u32x4*)(vs_ + (size_t)32 * TC); } while (0)
#define DIL_QLOADS(G_, HH_, BLP_, RN_) do { const bf16* qr_ = QK + ((size_t)(G_) * TC + (2 * (BLP_) + uw) * 2048 + (RN_) * 128 + 32 * qt + q) * 2048 + (HH_) * 64; \
        _Pragma("unroll") for (int d0 = 0; d0 < 4; ++d0) qn[d0] = *(const bf16x8*)(qr_ + d0 * 16 + 8 * h); } while (0)
#define DIL_WRITE(PB_) do { LAS bf16* kb_ = (LAS bf16*)(F.lds + TBL + ((PB_) * 2 + tu) * 2 * ATILE); LAS bf16* vb_ = kb_ + 64 * AKP; \
        *(LAS u32x4*)(kb_ + sdst) = k0; *(LAS u32x4*)(kb_ + 32 * AKP + sdst) = k1; *(LAS u32x4*)(vb_ + sdst) = v0; *(LAS u32x4*)(vb_ + 32 * AKP + sdst) = v1; } while (0)
    DIL_LOADS(g, hh, blp, rn, j); DIL_QLOADS(g, hh, blp, rn);
    DIL_WRITE(0);
#pragma unroll
    for (int d0 = 0; d0 < 4; ++d0) qf[d0] = qn[d0];
    __syncthreads();
    AttnSt st; st.m = NEGB; st.l = 0.f; st.o0 = (f32x16){}; st.o1 = (f32x16){};
    int pb = 0;
    for (;;) {
        const bool last = (j == 3);
        int ng = g, nhh = hh, nblp = blp, nrn = rn, nj = j + 1; bool more = true;
        if (last) { const int nd = du + F.G; more = nd < 3072; ng = nd >> 10; nhh = (nd >> 6) & 15; nblp = (nd >> 4) & 3; nrn = nd & 15; nj = ((nrn & ((16 >> (2 * ng)) - 1)) != 0) ? 0 : 2; }
        if (more) { DIL_LOADS(ng, nhh, nblp, nrn, nj); if (last) DIL_QLOADS(ng, nhh, nblp, nrn); }
        { const LAS bf16* kb = (const LAS bf16*)(F.lds + TBL + (pb * 2 + uw) * 2 * ATILE); const LAS bf16* vb = kb + 64 * AKP;
          const int gh = g * 16 + hh, ta = 2 * j, tb = 2 * j + 1;
          const bool a_on = ta >= qt && ta <= qt + 4, b_on = tb >= qt && tb <= qt + 4;
          const LAS float* bl = bt + gh * 192 + 32 + (32 * qt + q + 128 - 32 * ta - 8 * h - 23);
          if (a_on && b_on) attn_tile2<false>(kb, vb, bl, qf, st, q, h, true);
          else if (a_on) attn_tile<false>(kb, vb, bl, qf, st, q, h, true);
          else if (b_on) attn_tile<false>(kb + 32 * AKP, vb + 32, bl - 32, qf, st, q, h, true); }
        if (more) DIL_WRITE(pb ^ 1);
        if (last) {
            const float l_tot = xhalf_sum(st.l), inv = 1.f / l_tot;
            const size_t orow = (size_t)g * TC + (2 * blp + uw) * 2048 + rn * 128 + 32 * qt + q;
            attn_store(st, OG + orow * 1024 + hh * 64 + 4 * h, inv);
            if (h == 0) LSE[orow * 16 + hh] = st.m + __log2f(l_tot);
            st.m = NEGB; st.l = 0.f; st.o0 = (f32x16){}; st.o1 = (f32x16){};
#pragma unroll
            for (int d0 = 0; d0 < 4; ++d0) qf[d0] = qn[d0];
        }
        __syncthreads();
        pb ^= 1;
        if (!more) break;
        if (last) du += F.G;
        g = ng; hh = nhh; blp = nblp; rn = nrn; j = nj;
    }
#undef DIL_LOADS
#undef DIL_QLOADS
#undef DIL_WRITE
}

__device__ __forceinline__ void moba_phase3(Frame& F) {
    constexpr int TBL = 8448, KMO = TBL + 4 * ATILE;
    LAS float* bt = (LAS float*)F.lds; LAS float* kml = (LAS float*)(F.lds + KMO);
    const int lane = F.lane, q = lane & 31, h = lane >> 5, w = F.wave, t = F.tid, srow = t >> 3, sch = t & 7;
    const bf16* QK = (const bf16*)(F.ws + WS_SCR + S_CQK); const bf16* VT = (const bf16*)(F.ws + WS_SCR + S_CVT);
    bf16* att = (bf16*)(F.ws + WS_SCR + S_CATT); const float* km = (const float*)(F.ws + WS_KMEAN);
    const int NP = NB * NH * 4, per = (NP + F.G - 1) / F.G;
    const int lo = F.vcu * per, hi = (lo + per) < NP ? (lo + per) : NP;
    const int nunits = 2 * (hi - lo);
    if (nunits <= 0) return;
    const int sdst = srow * AKP + sch * 8;
    int u = 0, cur_bh = -1;
    u32x4 kreg, vreg; bf16x8 qn[4], qf[4];
#define MB_LOADS(B_, HH_, S_) do { const bf16* ks_ = QK + ((size_t)(B_) * SEQ + 64 * (S_) + srow) * 2048 + 1024 + (HH_) * 64 + sch * 8; \
        const bf16* vs_ = VT + ((size_t)(HH_) * 64 + srow) * T + (size_t)(B_) * SEQ + 64 * (S_) + sch * 8; kreg = *(const u32x4*)ks_; vreg = *(const u32x4*)vs_; } while (0)
#define MB_QLOADS(B_, HH_, NB_) do { const bf16* qr_ = QK + ((size_t)(B_) * SEQ + (NB_) * 256 + 32 * w + q) * 2048 + (HH_) * 64; \
        _Pragma("unroll") for (int d0 = 0; d0 < 4; ++d0) qn[d0] = *(const bf16x8*)(qr_ + d0 * 16 + 8 * h); } while (0)
#define MB_WRITE(PB_) do { LAS bf16* kb_ = (LAS bf16*)(F.lds + TBL + (PB_) * 2 * ATILE); *(LAS u32x4*)(kb_ + sdst) = kreg; *(LAS u32x4*)(kb_ + 64 * AKP + sdst) = vreg; } while (0)
    int pu = lo, jj = pu & 3, hh = (pu >> 2) & 15, b = pu >> 6, nb = 7 - jj, s = 0, pb = 0;
    MB_LOADS(b, hh, 0); MB_QLOADS(b, hh, nb); MB_WRITE(0);
    unsigned sel = 0; bool fresh = true;
    AttnSt st; st.m = NEGB; st.l = 0.f; st.o0 = (f32x16){}; st.o1 = (f32x16){};
    for (;;) {
        if (fresh) {
            if (b * 16 + hh != cur_bh) { __syncthreads(); const float* btC = (const float*)(F.ws + WS_BTABC) + hh * 2048;
                for (int i = t; i < 2048 + 32; i += 512) bt[i] = i < 32 ? NEGB : btC[i - 32];
                { const float* kmp = km + ((size_t)b * NH + hh) * 512; kml[t] = kmp[t]; }
                cur_bh = b * 16 + hh; }
#pragma unroll
            for (int d0 = 0; d0 < 4; ++d0) qf[d0] = qn[d0];
            __syncthreads();
            sel = 0;
            if (nb > 0) {
                float gsc[7];
#pragma unroll
                for (int m = 0; m < 7; ++m) { float sc = 0.f;
                    if (m < nb) {
#pragma unroll
                        for (int d0 = 0; d0 < 4; ++d0) { const f32x4 c0 = *(const LAS f32x4*)(kml + m * 64 + d0 * 16 + 8 * h), c1 = *(const LAS f32x4*)(kml + m * 64 + d0 * 16 + 8 * h + 4); const u32x4 qq = __builtin_bit_cast(u32x4, qf[d0]);
                            sc += bflo(qq.x) * c0.x + bfhi(qq.x) * c0.y + bflo(qq.y) * c0.z + bfhi(qq.y) * c0.w + bflo(qq.z) * c1.x + bfhi(qq.z) * c1.y + bflo(qq.w) * c1.z + bfhi(qq.w) * c1.w; }
                        sc = xhalf_sum(sc); }
                    gsc[m] = m < nb ? sc : -3.0e38f; }
                const int nsel = nb < 3 ? nb : 3;
#pragma unroll
                for (int r = 0; r < 3; ++r) { if (r < nsel) { int bi = 0; float bv = -3.4e38f;
#pragma unroll
                        for (int m = 0; m < 7; ++m) if (!((sel >> m) & 1u) && gsc[m] > bv) { bv = gsc[m]; bi = m; }
                        sel |= 1u << bi; } }
            }
            fresh = false;
        }
        const int nsteps = 4 * nb + 4;
        const bool last = (s + 1 == nsteps);
        int nb2 = nb, b2 = b, hh2 = hh, s2 = s + 1; bool more = true;
        if (last) { const int u2 = u + 1; more = u2 < nunits; const int pu2 = lo + (u2 >> 1), j2 = pu2 & 3; hh2 = (pu2 >> 2) & 15; b2 = pu2 >> 6; nb2 = (u2 & 1) ? j2 : 7 - j2; s2 = 0; }
        if (more) { MB_LOADS(b2, hh2, s2); if (last) MB_QLOADS(b2, hh2, nb2); }
        { const LAS bf16* kb = (const LAS bf16*)(F.lds + TBL + pb * 2 * ATILE); const LAS bf16* vb = kb + 64 * AKP;
          const int qpos = nb * 256 + 32 * w + q;
          const LAS float* bl = bt + 32 + (qpos - 8 * h - 64 * s - 23);
          if (s < 4 * nb) { const bool mine = (sel >> (s >> 2)) & 1u;
              if (__ballot(mine) != 0ull) attn_tile2<true>(kb, vb, bl, qf, st, q, h, mine); }
          else { const int ta = (s - 4 * nb) * 2;
              if (ta + 1 <= w) attn_tile2<false>(kb, vb, bl, qf, st, q, h, true);
              else if (ta <= w) attn_tile<false>(kb, vb, bl, qf, st, q, h, true); } }
        if (more) MB_WRITE(pb ^ 1);
        if (last) {
            const float l_tot = xhalf_sum(st.l), inv = 1.f / l_tot;
            const size_t tq = (size_t)b * SEQ + nb * 256 + 32 * w + q;
            attn_store8(st, (unsigned char*)att + tq * 1024 + hh * 64 + 4 * h, inv * ASCALE8);
            st.m = NEGB; st.l = 0.f; st.o0 = (f32x16){}; st.o1 = (f32x16){};
        }
        if (!last) __syncthreads();
        pb ^= 1;
        if (!more) break;
        if (last) { ++u; fresh = true; }
        nb = nb2; b = b2; hh = hh2; s = s2;
    }
#undef MB_LOADS
#undef MB_QLOADS
#undef MB_WRITE
}

__device__ __forceinline__ void gmlp_phase(Frame& F, const float* lng, const float* lnb, const float* bs) {
    const int lane = F.lane, w = F.wave, q = lane & 31, h = lane >> 5;
    const bf16* uv = (const bf16*)(F.ws + WS_SCR + S_UV); bf16* p = (bf16*)(F.ws + WS_SCR + S_P); const bf16* wst = (const bf16*)(F.ws + WS_WST);
    LAS float* stat = (LAS float*)F.lds;
    LAS bf16* vnT = (LAS bf16*)(F.lds + 1024);
    constexpr int VP = 136;
    for (int unit = F.vcu; unit < T / 128; unit += F.G) {
        const size_t t0 = (size_t)unit * 128;
        __syncthreads();
        for (int i = 0; i < 16; ++i) { const int r = w * 16 + i; const u32x4* vr = (const u32x4*)(uv + (t0 + r) * 2048 + 1024) + lane;
            const u32x4 a = vr[0], b = vr[64]; float x[16];
            x[0] = bflo(a.x); x[1] = bfhi(a.x); x[2] = bflo(a.y); x[3] = bfhi(a.y); x[4] = bflo(a.z); x[5] = bfhi(a.z); x[6] = bflo(a.w); x[7] = bfhi(a.w);
            x[8] = bflo(b.x); x[9] = bfhi(b.x); x[10] = bflo(b.y); x[11] = bfhi(b.y); x[12] = bflo(b.z); x[13] = bfhi(b.z); x[14] = bflo(b.w); x[15] = bfhi(b.w);
            float s = 0.f;
#pragma unroll
            for (int j = 0; j < 16; ++j) s += x[j];
            const float mean = wave_sum(s) * (1.f / 1024.f); float s2 = 0.f;
#pragma unroll
            for (int j = 0; j < 16; ++j) { const float d = x[j] - mean; s2 += d * d; }
            const float rstd = 1.f / sqrtf(wave_sum(s2) * (1.f / 1024.f) + LN_EPS);
            if (lane == 0) { stat[2 * r] = mean; stat[2 * r + 1] = rstd; } }
        __syncthreads();
        for (int gg = 0; gg < 8; ++gg) {
#pragma unroll
            for (int k = 0; k < 4; ++k) { const int id = F.tid + 512 * k, s = id >> 4, cc = (id & 15) * 8;
                const u32x4 a = *(const u32x4*)(uv + (t0 + s) * 2048 + 1024 + gg * 128 + cc); const float mean = stat[2 * s], rstd = stat[2 * s + 1];
                float x[8]; x[0] = bflo(a.x); x[1] = bfhi(a.x); x[2] = bflo(a.y); x[3] = bfhi(a.y); x[4] = bflo(a.z); x[5] = bfhi(a.z); x[6] = bflo(a.w); x[7] = bfhi(a.w);
#pragma unroll
                for (int j = 0; j < 8; ++j) { const int c = gg * 128 + cc + j; const float y = (x[j] - mean) * rstd * lng[c] + lnb[c]; vnT[(cc + j) * VP + s] = (bf16)f2bf(y); } }
            __syncthreads();
            const int cr = 32 * (w & 3), tc0 = 64 * (w >> 2);
            f32x16 acc0 = {}, acc1 = {};
#pragma unroll
            for (int ks = 0; ks < 8; ++ks) {
                const bf16x8 af = *(const LAS bf16x8*)(vnT + (cr + q) * VP + ks * 16 + 8 * h);
                const bf16x8 b0 = *(const bf16x8*)(wst + ((size_t)gg * 128 + tc0 + q) * 128 + ks * 16 + 8 * h);
                const bf16x8 b1 = *(const bf16x8*)(wst + ((size_t)gg * 128 + tc0 + 32 + q) * 128 + ks * 16 + 8 * h);
                acc0 = mfma32(af, b0, acc0); acc1 = mfma32(af, b1, acc1);
            }
#pragma unroll
            for (int tt = 0; tt < 2; ++tt) { const f32x16& ac = tt == 0 ? acc0 : acc1; const int tl = tc0 + 32 * tt + q; const float bsv = bs[gg * 128 + tl];
                const size_t rowu = (t0 + tl) * 2048, rowp = (t0 + tl) * 1024;
#pragma unroll
                for (int gq = 0; gq < 4; ++gq) { const int c = gg * 128 + cr + 8 * gq + 4 * h; const u32x2 uu = *(const u32x2*)(uv + rowu + c);
                    u32x2 o; o.x = pk2(bflo(uu.x) * (ac[4 * gq] + bsv), bfhi(uu.x) * (ac[4 * gq + 1] + bsv)); o.y = pk2(bflo(uu.y) * (ac[4 * gq + 2] + bsv), bfhi(uu.y) * (ac[4 * gq + 3] + bsv));
                    *(u32x2*)(p + rowp + c) = o; } }
            __syncthreads();
        }
    }
}

struct MoeSeg { int ts[9]; };
__device__ __forceinline__ MoeSeg moe_seg(Frame& F, int moe_l) {
    MoeSeg s; int acc = 0;
#pragma unroll
    for (int e = 0; e < 8; ++e) { s.ts[e] = acc; const unsigned c = __hip_atomic_load((unsigned*)(F.ctl + CW_ECNT + 64 * moe_l + e), RLX_AGENT); acc += (int)((c + 255u) >> 8); }
    s.ts[8] = acc; return s;
}
__device__ __forceinline__ void moe_gather_phase(Frame& F, int moe_l) {
    LAS int* P = (LAS int*)F.lds;
    LAS int* wtot = (LAS int*)(F.lds + 65536);
    LAS int* tot = wtot + 64;
    const int* wcnt = (const int*)(F.ws + WS_WCNT);
    int t = F.tid; asm volatile("" : "+v"(t));
    const int lane = F.lane;
    int loc[4][8], sum[8], inc[8];
#pragma unroll
    for (int k = 0; k < 4; ++k) { const u32x4 a = *(const u32x4*)(wcnt + (4 * t + k) * 8), b = *(const u32x4*)(wcnt + (4 * t + k) * 8 + 4);
        loc[k][0] = (int)a.x; loc[k][1] = (int)a.y; loc[k][2] = (int)a.z; loc[k][3] = (int)a.w; loc[k][4] = (int)b.x; loc[k][5] = (int)b.y; loc[k][6] = (int)b.z; loc[k][7] = (int)b.w; }
#pragma unroll
    for (int e = 0; e < 8; ++e) { sum[e] = (loc[0][e] + loc[1][e]) + (loc[2][e] + loc[3][e]); inc[e] = sum[e]; }
#pragma unroll
    for (int off = 1; off < 64; off <<= 1) {
#pragma unroll
        for (int e = 0; e < 8; ++e) { const int v = __shfl_up(inc[e], off); if (lane >= off) inc[e] += v; } }
    if (lane == 63) {
#pragma unroll
        for (int e = 0; e < 8; ++e) wtot[F.wave * 8 + e] = inc[e]; }
    __syncthreads();
    int run[8];
#pragma unroll
    for (int e = 0; e < 8; ++e) { int wb = 0; for (int w = 0; w < F.wave; ++w) wb += wtot[w * 8 + e]; run[e] = wb + inc[e] - sum[e]; }
#pragma unroll
    for (int k = 0; k < 4; ++k) {
#pragma unroll
        for (int e = 0; e < 8; ++e) { P[(4 * t + k) * 8 + e] = run[e]; run[e] += loc[k][e]; } }
    if (t == 511) {
#pragma unroll
        for (int e = 0; e < 8; ++e) tot[e] = run[e]; }
    __syncthreads();
    MoeSeg sg; { int acc = 0;
#pragma unroll
        for (int e = 0; e < 8; ++e) { sg.ts[e] = acc; acc += (tot[e] + 255) >> 8; } sg.ts[8] = acc; }
    if (blockIdx.x == 0 && t < 8) __hip_atomic_store((unsigned*)(F.ctl + CW_ECNT + 64 * moe_l + t), (unsigned)tot[t], RLX_AGENT);
    const int gw = F.vcu * NWAVES + F.wave, NGW = F.G * NWAVES;
    const bf16* hb = (const bf16*)(F.ws + WS_HB); unsigned char* xg8 = (unsigned char*)F.out;
    const int* route = (const int*)(F.ws + WS_ROUTE); int* slots = (int*)(F.ws + WS_SLOTS);
    for (int m0 = 4 * gw; m0 < T; m0 += 4 * NGW) {
        int s1[4], s2[4]; u32x4 a[4], b[4];
#pragma unroll
        for (int k = 0; k < 4; ++k) { const int m = m0 + k, grp = m >> 5;
            const int e1 = route[4 * m], p1 = route[4 * m + 1], e2 = route[4 * m + 2], p2 = route[4 * m + 3];
            int ts1 = 0, ts2 = 0;
#pragma unroll
            for (int e = 0; e < 8; ++e) { ts1 = e == e1 ? sg.ts[e] : ts1; ts2 = e == e2 ? sg.ts[e] : ts2; }
            s1[k] = ts1 * 256 + P[grp * 8 + e1] + p1; s2[k] = ts2 * 256 + P[grp * 8 + e2] + p2;
            const u32x4* src = (const u32x4*)(hb + (size_t)m * D) + lane; a[k] = src[0]; b[k] = src[64]; }
#pragma unroll
        for (int k = 0; k < 4; ++k) { const int m = m0 + k;
            float x[16]; unpack8(a[k], x); unpack8(b[k], x + 8);
            u32x2 lo, hi; lo.x = pk4_fp8(x[0], x[1], x[2], x[3]); lo.y = pk4_fp8(x[4], x[5], x[6], x[7]); hi.x = pk4_fp8(x[8], x[9], x[10], x[11]); hi.y = pk4_fp8(x[12], x[13], x[14], x[15]);
            unsigned char* d1 = xg8 + (size_t)s1[k] * D + 8 * lane; unsigned char* d2 = xg8 + (size_t)s2[k] * D + 8 * lane;
            *(u32x2*)d1 = lo; *(u32x2*)(d1 + 512) = hi; *(u32x2*)d2 = lo; *(u32x2*)(d2 + 512) = hi;
            if (lane == 0) { slots[2 * m] = s1[k]; slots[2 * m + 1] = s2[k]; } }
    }
}
struct MoeOrder {
    int nM, nN, G, c, tile0; MoeSeg sg; const char* A0; const char* B0; size_t aT, bE, bT; bool a_local;
    bool out_local;
    __device__ __forceinline__ bool next(int i, pg8::Unit& u) const {
        int pm, pn; if (!pg8::tile_of((long)i * G + c, nM, nN, pm, pn)) return false;
        const int tile = tile0 + pm; int e = 0;
#pragma unroll
        for (int k = 1; k < 8; ++k) e += (tile >= sg.ts[k]) ? 1 : 0;
        u.pm = out_local ? pm : tile; u.pn = pn; u.a = (unsigned)((size_t)(a_local ? pm : tile) * aT); u.b = (unsigned)((size_t)e * bE + (size_t)pn * bT); return true;
    }
};


template <int GI> struct L0QKOrder { int G, c; const char* A0; const char* B0;
    __device__ __forceinline__ bool next(int i, pg8::Unit& u) const { if (!pg8::tile_of((long)i * G + c, 64, 8, u.pm, u.pn)) return false; const int pm = u.pm;
        const int tok = GI == 0 ? pm * 256 : (GI == 1 ? (pm >> 3) * 2048 + (pm & 1) * 1024 + ((pm >> 1) & 3) : (pm >> 3) * 2048 + (pm & 7) * 2);
        u.a = (unsigned)tok * 1024u; u.b = (unsigned)u.pn * 256u * 1024u; return true; } };
template <int GI> struct L0VtOrder { int G, c; const char* A0; const char* B0;
    __device__ __forceinline__ bool next(int i, pg8::Unit& u) const { if (!pg8::tile_of((long)i * G + c, 4, 64, u.pm, u.pn)) return false; const int pn = u.pn;
        const int tok = GI == 0 ? pn * 256 : (GI == 1 ? (pn >> 3) * 2048 + (pn & 1) * 1024 + ((pn >> 1) & 3) : (pn >> 3) * 2048 + (pn & 7) * 2);
        u.a = (unsigned)u.pm * 256u * 1024u; u.b = (unsigned)tok * 1024u; return true; } };
template <int GI> __device__ __forceinline__ void l0_gemms(Frame& F, int ck, int bx) {
    constexpr int rs = GI == 0 ? 1 : (GI == 1 ? 4 : 16);
    constexpr size_t hst = (GI == 0 ? (size_t)128 : (GI == 1 ? (size_t)512 : (size_t)1)) * 1024;
    const char* hbc = (const char*)(F.ws + WS_SCR + S_HB8) + (size_t)ck * TC * 1024;
    unsigned char* scr = F.ws + WS_SCR;
    { L0QKOrder<GI> S{F.G, bx, hbc, (const char*)(F.ws + W_A_QK) + (size_t)GI * 2048 * 1024};
      pg8::Gemm gm{512, rs, 1, hst, (size_t)128 * 1024};
      pg8::EpiBf16<0> E{(bf16*)(scr + S_QK) + (size_t)GI * TC * 2048, 2048, 1.f / WSCALE8};
      pg8::gemm_phase<pg8::EpiBf16<0>, L0QKOrder<GI>, false, 1>(F.lds, F.wave, gm, S, E); }
    { L0VtOrder<GI> S{F.G, bx, (const char*)(F.ws + W_A_V) + (size_t)GI * 1024 * 1024, hbc};
      pg8::Gemm gm{512, 1, rs, (size_t)128 * 1024, hst};
      pg8::EpiBf16<0> E{(bf16*)(scr + S_VT) + (size_t)GI * 1024 * TC, TC, 1.f / WSCALE8};
      pg8::gemm_phase<pg8::EpiBf16<0>, L0VtOrder<GI>, false, 1>(F.lds, F.wave, gm, S, E); }
}


#ifdef MK_SELFCHECK
__device__ __forceinline__ void selfcheck_buf(Frame& F, const void* ptr, size_t nbytes, int stage, int slot0) {
    if (!F.chk) return;
    const int gw = F.vcu * NWAVES + F.wave, NGW = F.G * NWAVES; unsigned* cks = (unsigned*)(F.ws + WS_NEED + 2 * MiB) + slot0;
    const int nch = (int)(nbytes >> 12);
    for (int c = gw; c < nch; c += NGW) { const u32x4* r = (const u32x4*)((const char*)ptr + ((size_t)c << 12)) + F.lane; unsigned x = 0;
#pragma unroll
        for (int j = 0; j < 4; ++j) { const u32x4 v = r[64 * j]; x ^= v.x * 3u + v.y * 5u + v.z * 7u + v.w * 11u + (unsigned)j; }
        x *= (unsigned)(2 * F.lane + 1);
#pragma unroll
        for (int o = 1; o < 64; o <<= 1) x ^= __shfl_xor(x, o);
        if (F.lane == 0) { if (F.chk == 1) cks[c] = x; else if (cks[c] != x) atomicMax((unsigned*)(F.ctl + 32), (unsigned)(1000 - stage)); } }
}
#endif

__global__ void __launch_bounds__(NWAVES * 64, 2) mk_fwd(Args args) {
    extern __shared__ __attribute__((aligned(16))) unsigned char lds[];
    Frame F;
    F.lds = (LAS unsigned char*)lds;
    F.tid = threadIdx.x; F.lane = F.tid & 63; F.wave = __builtin_amdgcn_readfirstlane(F.tid >> 6);
    F.G = gridDim.x; { const int bx = blockIdx.x; F.vcu = (F.G % 8 == 0) ? (bx % 8) * (F.G / 8) + bx / 8 : bx; }
    F.ws = args.ws; F.ctl = (gu32*)(args.ws + WS_CTL); F.out = args.out; F.chk = args.chk; F.stage = 0;
    volatile LAS unsigned* MISC = (volatile LAS unsigned*)(F.lds + MISC_OFF);
    for (int u = F.tid; u < (LDS_BYTES - RING_BYTES) / 4; u += NWAVES * 64) ((LAS unsigned*)(F.lds + RING_BYTES))[u] = 0u;
    __syncthreads();
    XcdBarrier bar; bar.bar = (unsigned*)(F.ctl + CW_BAR); bar.x = 0; bar.st = nullptr;
    if (!MK_MULTI) bar = xcd_barrier_post((unsigned*)(F.ctl + CW_BAR), MISC + 8);
    const int lo = args.ph_lo, hi = args.ph_hi;
    int ph = 0;
#define PHASE_BEGIN if (ph >= lo && ph < hi) { F.lane = (int)__builtin_amdgcn_mbcnt_hi(~0u, __builtin_amdgcn_mbcnt_lo(~0u, 0u)); asm volatile("" : "+v"(F.lane)); F.tid = F.wave * 64 + F.lane;
#define PHASE_END   if (!MK_MULTI && ph + 1 < hi) xcd_barrier(bar, F.tid); } ++ph;
    const int bx = (int)blockIdx.x;
#define scr (args.ws + WS_SCR)
#define hb ((const bf16*)(args.ws + WS_HB))
#define ln_g (args.in[2])
#define ln_b (args.in[3])

    PHASE_BEGIN p_prologue(F, args); if (MK_PROBE & 8) p_prologue(F, args); PHASE_END

    if (MK_ENABLE & 1) {
#define L0_CHUNK(ck) \
        PHASE_BEGIN \
        if ((ck) > 0) dil_merge_phase(F, (ck) - 1); \
        l0_gemms<0>(F, (ck), bx); l0_gemms<1>(F, (ck), bx); l0_gemms<2>(F, (ck), bx); \
        PHASE_END \
        PHASE_BEGIN dil_attn_phase3(F); if (MK_PROBE & 1) dil_attn_phase3(F); PHASE_END
        L0_CHUNK(0) L0_CHUNK(1) L0_CHUNK(2) L0_CHUNK(3)
#undef L0_CHUNK
        PHASE_BEGIN dil_merge_phase(F, 3); if (MK_PROBE & 4) { dil_merge_phase(F, 3); dil_merge_phase(F, 3); dil_merge_phase(F, 3); dil_merge_phase(F, 3); } PHASE_END
        PHASE_BEGIN
        { pg8::LinOrder S{T / 256, 4, F.G, bx, (const char*)(scr + S_ATT), (const char*)(F.ws + W_A_O), (size_t)256 * 1024, (size_t)256 * 1024};
          pg8::Gemm gm{512, 1, 1, (size_t)128 * 1024, (size_t)128 * 1024};
          pg8::EpiResLn<FFN_GU8 == 0> E{(bf16*)(F.ws + WS_HB), ln_g + 0 * 2048, ln_b + 0 * 2048, ALPHA, 1.f / (WSCALE8 * ASCALE8), (float*)scr, (unsigned*)(F.ctl + CW_LNC + 0 * 4096), (unsigned*)(F.ctl + CW_BAR) + XB_TMO, scr + S_HB8, F.lds + LNT_OFF};
          pg8::gemm_phase<pg8::EpiResLn<FFN_GU8 == 0>, pg8::LinOrder, true, 1>(F.lds, F.wave, gm, S, E); }
        PHASE_END
    } else {
        PHASE_BEGIN ln_phase<1, false, false>(F, ln_g + 0 * 2048, ln_b + 0 * 2048, nullptr); PHASE_END
    }
#define DENSE_FFN(f, lnidx, enbit) \
    if (MK_ENABLE & (enbit)) { \
        PHASE_BEGIN \
        if ((f) == FFN_GU8) { \
          pg8::LinOrder S{T / 256, 2 * DFF / 256, F.G, bx, (const char*)(scr + S_HB8), (const char*)(F.ws + W_F_GU) + (size_t)(f) * 2 * DFF * 2048, (size_t)256 * 1024, (size_t)256 * 1024}; \
          pg8::Gemm gm{512, 1, 1, (size_t)128 * 1024, (size_t)128 * 1024};     \
          pg8::EpiSwiglu8 E{(unsigned char*)(scr + S_HID), DFF, 1.f / WSCALE8}; \
          pg8::gemm_phase<pg8::EpiSwiglu8, pg8::LinOrder, true, 1>(F.lds, F.wave, gm, S, E); \
        } else { pg8::LinOrder S{T / 256, 2 * DFF / 256, F.G, bx, (const char*)hb, (const char*)(F.ws + W_F_GU) + (size_t)(f) * 2 * DFF * 2048, (size_t)256 * 2048, (size_t)256 * 2048}; \
          pg8::Gemm gm{1024, 1, 1, (size_t)128 * 2048, (size_t)128 * 2048}; \
          pg8::EpiSwiglu8 E{(unsigned char*)(scr + S_HID), DFF}; \
          pg8::gemm_phase(F.lds, F.wave, gm, S, E); } \
        PHASE_END \
        PHASE_BEGIN \
        { pg8::LinOrder S{T / 256, 4, F.G, bx, (const char*)(scr + S_HID), (const char*)(F.ws + W_F_D) + (size_t)(f) * 1024 * DFF * 2, (size_t)256 * DFF, (size_t)256 * DFF}; \
          pg8::Gemm gm{DFF / 2, 1, 1, (size_t)128 * DFF, (size_t)128 * DFF};     \
          pg8::EpiResLn<false> E{(bf16*)(F.ws + WS_HB), ln_g + (lnidx) * 1024, ln_b + (lnidx) * 1024, ALPHA, 1.f / WSCALE8D, (float*)(scr + S_Y), (unsigned*)(F.ctl + CW_LNC + (2 + (f)) * 4096), (unsigned*)(F.ctl + CW_BAR) + XB_TMO, nullptr, F.lds + LNT_OFF}; \
          pg8::gemm_phase<pg8::EpiResLn<false>, pg8::LinOrder, true, 1>(F.lds, F.wave, gm, S, E); }     \
        PHASE_END \
    } else { \
        PHASE_BEGIN ln_phase<1, false, false>(F, ln_g + (lnidx) * 1024, ln_b + (lnidx) * 1024, nullptr); PHASE_END \
    }
    DENSE_FFN(0, 1, 2)

    if (MK_ENABLE & 4) {
        PHASE_BEGIN
        { pg8::LinOrder S{T / 256, 4, F.G, bx, (const char*)hb, (const char*)(F.ws + W_B_IN), (size_t)256 * 2048, (size_t)256 * 2048};
          pg8::Gemm gm{1024, 1, 1, (size_t)128 * 2048, (size_t)128 * 2048};
          pg8::EpiBf16<0> E{(bf16*)(scr + S_BCX), 1024};
          pg8::gemm_phase(F.lds, F.wave, gm, S, E); }
        { pg8::LinOrder S{T / 256, 8, F.G, bx, (const char*)hb, (const char*)(F.ws + W_B_IN) + (size_t)1024 * 2048, (size_t)256 * 2048, (size_t)256 * 2048};
          pg8::Gemm gm{1024, 1, 1, (size_t)128 * 2048, (size_t)128 * 2048};
          pg8::EpiGlu<0> E{(bf16*)(scr + S_BCX + (size_t)128 * MiB), 1024};
          pg8::gemm_phase(F.lds, F.wave, gm, S, E); }
        PHASE_END
        PHASE_BEGIN conv_phase(F, args.in[7]); if (MK_PROBE & 4) conv_phase(F, args.in[7]); PHASE_END
        PHASE_BEGIN
        { pg8::LinOrder S{T / 256, 4, F.G, bx, (const char*)(scr + S_P), (const char*)(F.ws + W_B_O), (size_t)256 * 2048, (size_t)256 * 2048};
          pg8::Gemm gm{1024, 1, 1, (size_t)128 * 2048, (size_t)128 * 2048};
          pg8::EpiResBf16 E{hb, (bf16*)F.out, 1024, ALPHA};
          pg8::gemm_phase(F.lds, F.wave, gm, S, E); }
        PHASE_END
        PHASE_BEGIN ln_phase<0, true, false>(F, ln_g + 2 * 1024, ln_b + 2 * 1024, args.in[20]); PHASE_END
    } else {
        PHASE_BEGIN ln_phase<1, true, false>(F, ln_g + 2 * 1024, ln_b + 2 * 1024, args.in[20]); PHASE_END
    }
#define MOE_CHUNK(f, ck) \
        PHASE_BEGIN \
        { const MoeSeg sg = moe_seg(F, (f)); int nM = sg.ts[8] - (ck) * MOE_CH_TILES; nM = nM > MOE_CH_TILES ? MOE_CH_TILES : (nM < 0 ? 0 : nM); \
          MoeOrder S{nM, 2 * DFE / 256, F.G, bx, (ck) * MOE_CH_TILES, sg, (const char*)F.out, (const char*)(F.ws + W_E_GU) + (size_t)(f) * 8 * 2 * DFE * 2048, (size_t)256 * 1024, (size_t)2 * DFE * 2048, (size_t)256 * 1024, false, true}; \
          pg8::Gemm gm{512, 1, 1, (size_t)128 * 1024, (size_t)128 * 1024};     \
          pg8::EpiSwiglu8 E{(unsigned char*)(scr + S_MHID), DFE, 1.f / WSCALE8}; \
          pg8::gemm_phase<pg8::EpiSwiglu8, MoeOrder, true, 0x7C>(F.lds, F.wave, gm, S, E);     if ((ck) == 0 && (MK_PROBE & 32)) pg8::gemm_phase(F.lds, F.wave, gm, S, E); } \
        PHASE_END \
        PHASE_BEGIN \
        { const MoeSeg sg = moe_seg(F, (f)); int nM = sg.ts[8] - (ck) * MOE_CH_TILES; nM = nM > MOE_CH_TILES ? MOE_CH_TILES : (nM < 0 ? 0 : nM); \
          MoeOrder S{nM, 4, F.G, bx, (ck) * MOE_CH_TILES, sg, (const char*)(scr + S_MHID), (const char*)(F.ws + W_E_D) + (size_t)(f) * 8 * 1024 * DFE * 2, (size_t)256 * DFE, (size_t)1024 * DFE * 2, (size_t)256 * DFE, true, false}; \
          pg8::Gemm gm{DFE / 2, 1, 1, (size_t)128 * DFE, (size_t)128 * DFE};     \
          pg8::EpiBf16<0> E{(bf16*)(scr + S_XG), 1024, 1.f / WSCALE8D}; \
          pg8::gemm_phase<pg8::EpiBf16<0>, MoeOrder, true, 0x7B>(F.lds, F.wave, gm, S, E);     if ((ck) == 0 && (MK_PROBE & 64)) pg8::gemm_phase(F.lds, F.wave, gm, S, E); } \
        PHASE_END
#define MOE_FFN(f, lnidx, enbit, fin) \
    if (MK_ENABLE & (enbit)) { \
        PHASE_BEGIN moe_gather_phase(F, (f)); if (MK_PROBE & 4) moe_gather_phase(F, (f)); PHASE_END \
        MOE_CHUNK(f, 0) MOE_CHUNK(f, 1) MOE_CHUNK(f, 2) \
        PHASE_BEGIN ln_phase<2, false, fin>(F, ln_g + (lnidx) * 1024, ln_b + (lnidx) * 1024, nullptr); PHASE_END \
    } else { \
        PHASE_BEGIN ln_phase<1, false, fin>(F, ln_g + (lnidx) * 1024, ln_b + (lnidx) * 1024, nullptr); PHASE_END \
    }
    MOE_FFN(0, 3, 8, false)

    if (MK_ENABLE & 16) {
        PHASE_BEGIN
        { pg8::LinOrder S{T / 256, 8, F.G, bx, (const char*)hb, (const char*)(F.ws + W_C_QK), (size_t)256 * 2048, (size_t)256 * 2048};
          pg8::Gemm gm{1024, 1, 1, (size_t)128 * 2048, (size_t)128 * 2048};
          pg8::EpiBf16<0> E{(bf16*)(scr + S_CQK), 2048};
          pg8::gemm_phase(F.lds, F.wave, gm, S, E); }
        { pg8::LinOrder S{4, T / 256, F.G, bx, (const char*)(F.ws + W_C_V), (const char*)hb, (size_t)256 * 2048, (size_t)256 * 2048};
          pg8::Gemm gm{1024, 1, 1, (size_t)128 * 2048, (size_t)128 * 2048};
          pg8::EpiBf16<0> E{(bf16*)(scr + S_CVT), T};
          pg8::gemm_phase(F.lds, F.wave, gm, S, E); }
        PHASE_END
#ifdef MK_SELFCHECK
        PHASE_BEGIN selfcheck_buf(F, scr + S_CQK, (size_t)256 * MiB, 40, 0); selfcheck_buf(F, scr + S_CVT, (size_t)128 * MiB, 41, 65536); PHASE_END
#endif
        PHASE_BEGIN kmean_phase(F); if (MK_PROBE & 4) kmean_phase(F); PHASE_END
#ifdef MK_SELFCHECK
        PHASE_BEGIN selfcheck_buf(F, F.ws + WS_KMEAN, (size_t)1 * MiB, 42, 65536 + 32768); PHASE_END
#endif
        PHASE_BEGIN moba_phase3(F); if (MK_PROBE & 2) moba_phase3(F); PHASE_END
#ifdef MK_SELFCHECK
        PHASE_BEGIN selfcheck_buf(F, F.ws + WS_NEED + 3 * MiB, (size_t)4 * MiB, 43, 65536 + 32768 + 256); selfcheck_buf(F, F.ws + WS_NEED + 7 * MiB, (size_t)4 * MiB, 44, 65536 + 32768 + 256 + 1024);
                    selfcheck_buf(F, scr + S_CATT, (size_t)128 * MiB, 45, 65536 + 32768 + 256 + 2048); PHASE_END
#endif
        PHASE_BEGIN
        { pg8::LinOrder S{T / 256, 4, F.G, bx, (const char*)(scr + S_CATT), (const char*)(F.ws + W_C_O), (size_t)256 * 1024, (size_t)256 * 1024};
          pg8::Gemm gm{512, 1, 1, (size_t)128 * 1024, (size_t)128 * 1024};
          pg8::EpiResLn<FFN_GU8 == 1> E{(bf16*)(F.ws + WS_HB), ln_g + 4 * 1024, ln_b + 4 * 1024, ALPHA, 1.f / (WSCALE8 * ASCALE8), (float*)scr, (unsigned*)(F.ctl + CW_LNC + 1 * 4096), (unsigned*)(F.ctl + CW_BAR) + XB_TMO, scr + S_HB8, F.lds + LNT_OFF};
          pg8::gemm_phase<pg8::EpiResLn<FFN_GU8 == 1>, pg8::LinOrder, true, 1>(F.lds, F.wave, gm, S, E); }
        PHASE_END
    } else {
        PHASE_BEGIN ln_phase<1, false, false>(F, ln_g + 4 * 1024, ln_b + 4 * 1024, nullptr); PHASE_END
    }
    DENSE_FFN(1, 5, 32)

    if (MK_ENABLE & 64) {
        PHASE_BEGIN
        { pg8::LinOrder S{T / 256, 8, F.G, bx, (const char*)hb, (const char*)(F.ws + W_D_IN), (size_t)256 * 2048, (size_t)256 * 2048};
          pg8::Gemm gm{1024, 1, 1, (size_t)128 * 2048, (size_t)128 * 2048};
          pg8::EpiBf16<1> E{(bf16*)(scr + S_UV), 2048};
          pg8::gemm_phase(F.lds, F.wave, gm, S, E); }
        PHASE_END
        PHASE_BEGIN gmlp_phase(F, args.in[12], args.in[13], args.in[15]); if (MK_PROBE & 4) gmlp_phase(F, args.in[12], args.in[13], args.in[15]); PHASE_END
        PHASE_BEGIN
        { pg8::LinOrder S{T / 256, 4, F.G, bx, (const char*)(scr + S_P), (const char*)(F.ws + W_D_O), (size_t)256 * 2048, (size_t)256 * 2048};
          pg8::Gemm gm{1024, 1, 1, (size_t)128 * 2048, (size_t)128 * 2048};
          pg8::EpiResBf16 E{hb, (bf16*)F.out, 1024, ALPHA};
          pg8::gemm_phase(F.lds, F.wave, gm, S, E); }
        PHASE_END
        PHASE_BEGIN ln_phase<0, true, false>(F, ln_g + 6 * 1024, ln_b + 6 * 1024, args.in[20] + 8192); PHASE_END
    } else {
        PHASE_BEGIN ln_phase<1, true, false>(F, ln_g + 6 * 1024, ln_b + 6 * 1024, args.in[20] + 8192); PHASE_END
    }
    MOE_FFN(1, 7, 128, true)
#ifdef MK_SELFCHECK
    PHASE_BEGIN
    { const unsigned fl = __hip_atomic_load((unsigned*)(F.ctl + 32), RLX_AGENT);
      if (fl != 0u) { const int code = 1000 - (int)fl; const float cval = (code >= 40 && code <= 45) ? (float)(20 + 2 * (code - 40)) : (float)(1u << (code / 10 + 1)); const int gw = F.vcu * NWAVES + F.wave, NGW = F.G * NWAVES;
          for (int m = gw; m < T; m += NGW) { f32x4* w = (f32x4*)(F.out + (size_t)m * D) + F.lane;
#pragma unroll
              for (int j = 0; j < 4; ++j) w[64 * j] = (f32x4){cval, cval, cval, cval}; } } }
    PHASE_END
#endif
#undef PHASE_BEGIN
#undef PHASE_END
#undef scr
#undef hb
#undef ln_g
#undef ln_b
}

static int count_phases() {
    int n = 1;
    n += (MK_ENABLE & 1) ? (8 + 1 + 1) : 1;
    n += (MK_ENABLE & 2) ? 2 : 1;
    n += (MK_ENABLE & 4) ? 4 : 1;
    n += (MK_ENABLE & 8) ? 8 : 1;
    n += (MK_ENABLE & 16) ? 4 : 1;
    n += (MK_ENABLE & 32) ? 2 : 1;
    n += (MK_ENABLE & 64) ? 4 : 1;
    n += (MK_ENABLE & 128) ? 8 : 1;
#ifdef MK_SELFCHECK
    n += 1 + 3;
#endif
    return n;
}
extern "C" void kernel_launch(void* const* d_in, const int* in_sizes, int n_in, void* d_out, int out_size, void* d_ws, size_t ws_size, hipStream_t stream) {
    static int grid = 0;
    if (grid == 0) {
        if (n_in != 24 || in_sizes[0] != T * D || out_size != T * D || ws_size < WS_NEED) { fprintf(stderr, "kernel_launch: unexpected shapes (n_in %d, in0 %d, out %d, ws %zu < %zu); nothing launched\n", n_in, n_in > 0 ? in_sizes[0] : -1, out_size, ws_size, (size_t)WS_NEED); grid = -1; return; }
        int dev = 0, cus = 0, per_cu = 0;
        if (hipGetDevice(&dev) != hipSuccess || hipDeviceGetAttribute(&cus, hipDeviceAttributeMultiprocessorCount, dev) != hipSuccess) { grid = -1; return; }
        if (hipFuncSetAttribute((const void*)mk_fwd, hipFuncAttributeMaxDynamicSharedMemorySize, LDS_BYTES) != hipSuccess) { fprintf(stderr, "kernel_launch: hipFuncSetAttribute failed\n"); grid = -1; return; }
        if (hipOccupancyMaxActiveBlocksPerMultiprocessor(&per_cu, (const void*)mk_fwd, NWAVES * 64, LDS_BYTES) != hipSuccess || per_cu < 1) fprintf(stderr, "kernel_launch: occupancy query reports %d\n", per_cu);
        (void)hipGetLastError();
        grid = cus;
    }
    if (grid < 0) return;
    (void)hipMemsetAsync((char*)d_ws + WS_CTL, 0, CTL_ZERO_BYTES, stream);
#ifdef SELF_POISON
    (void)hipMemsetAsync((char*)d_ws + CTL_ZERO_BYTES, 0xAA, WS_NEED - CTL_ZERO_BYTES, stream);
    (void)hipMemsetAsync(d_out, 0xAA, (size_t)T * D * 4, stream);
#endif
    Args a{};
    for (int i = 0; i < 24; ++i) a.in[i] = (const float*)d_in[i];
    a.out = (float*)d_out; a.ws = (unsigned char*)d_ws;
    const int nph = count_phases();
#if MK_MULTI
    for (int p = 0; p < nph; ++p) { a.ph_lo = p; a.ph_hi = p + 1; hipLaunchKernelGGL(mk_fwd, dim3(grid), dim3(NWAVES * 64), LDS_BYTES, stream, a); }
#else
    a.ph_lo = 0; a.ph_hi = nph;
#ifdef MK_SELFCHECK
    a.chk = 1;
    hipLaunchKernelGGL(mk_fwd, dim3(grid), dim3(NWAVES * 64), LDS_BYTES, stream, a);
    (void)hipMemsetAsync((char*)d_ws + WS_CTL, 0, CTL_ZERO_BYTES, stream);
    a.chk = 2;
#endif
    hipLaunchKernelGGL(mk_fwd, dim3(grid), dim3(NWAVES * 64), LDS_BYTES, stream, a);
#endif
    const hipError_t le = hipPeekAtLastError();
    if (le != hipSuccess) fprintf(stderr, "kernel_launch: launch failed: %s\n", hipGetErrorName(le));
}
```

```cpp
#include <hip/hip_runtime.h>
#include <cstdio>
#include <cstdint>

#ifndef MK_MULTI
#define MK_MULTI 0
#endif
#ifndef MK_PROBE
#define MK_PROBE 0
#endif
#ifndef MK_ENABLE
#define MK_ENABLE 0xFF
#endif

#define GAS __attribute__((address_space(1)))
#define LAS __attribute__((address_space(3)))
typedef unsigned short bf16;
typedef short bf16x8 __attribute__((ext_vector_type(8)));
typedef float f32x4 __attribute__((ext_vector_type(4)));
typedef float f32x2 __attribute__((ext_vector_type(2)));
typedef float f32x16 __attribute__((ext_vector_type(16)));
typedef unsigned u32x4 __attribute__((ext_vector_type(4)));
typedef unsigned u32x2 __attribute__((ext_vector_type(2)));
typedef GAS unsigned gu32;
typedef int v8i_t __attribute__((ext_vector_type(8)));
typedef int v4i_t __attribute__((ext_vector_type(4)));
typedef short s16x16_t __attribute__((ext_vector_type(16)));

constexpr int D = 1024, NB = 32, SEQ = 2048, T = NB * SEQ, NH = 16, HD = 64;
constexpr int DFF = 2816, NE = 8, DFE = 3584;
constexpr float ALPHA = 1.6817928305074290f;
constexpr float LN_EPS = 1e-5f;
constexpr float LOG2E = 1.4426950408889634f;
constexpr float QSCALE = 0.125f * LOG2E;
constexpr float NEGB = -1e30f;
constexpr int TC = 16384;
constexpr int MOE_CH_TILES = 256;
constexpr int MOE_MAX_TILES = 520;
constexpr int FFN_GU8 = 1;

constexpr size_t MiB = 1u << 20;
constexpr size_t WS_CTL = 0, CTL_ZERO_BYTES = 1 * MiB;
constexpr size_t WS_BUCKET = 1 * MiB;
constexpr size_t WS_BTABA = WS_BUCKET + 8192;
constexpr size_t WS_BTABC = WS_BTABA + 32768;
constexpr size_t WS_WST = WS_BTABC + 131072;
constexpr size_t WS_KMEAN = 2 * MiB;
constexpr size_t WS_ROUTE = 4 * MiB;
constexpr size_t WS_GATES = 5 * MiB;
constexpr size_t WS_SLOTS = 6 * MiB;
constexpr size_t WS_WCNT = 7 * MiB;
constexpr size_t WS_W = 8 * MiB;
constexpr size_t W_A_QK = WS_W;
constexpr size_t W_A_V = W_A_QK + 12 * MiB;
constexpr size_t W_A_O = W_A_V + 6 * MiB;
constexpr size_t W_B_IN = W_A_O + 2 * MiB;
constexpr size_t W_B_O = W_B_IN + 6 * MiB;
constexpr size_t W_C_QK = W_B_O + 2 * MiB;
constexpr size_t W_C_V = W_C_QK + 4 * MiB;
constexpr size_t W_C_O = W_C_V + 2 * MiB;
constexpr size_t W_D_IN = W_C_O + 2 * MiB;
constexpr size_t W_D_O = W_D_IN + 4 * MiB;
constexpr size_t W_F_GU = W_D_O + 2 * MiB;
constexpr size_t W_F_D = W_F_GU + 22 * MiB;
constexpr size_t W_E_GU = W_F_D + 11 * MiB;
constexpr size_t W_E_D = W_E_GU + 224 * MiB;
constexpr size_t WS_HB = W_E_D + 112 * MiB;
constexpr size_t WS_SCR = WS_HB + 128 * MiB;
constexpr size_t WS_NEED = WS_SCR + 512 * MiB;
static_assert(WS_HB == 419 * MiB, "map");
constexpr size_t S_QK = 0;
constexpr size_t S_VT = 192 * MiB;
constexpr size_t S_HB8 = 416 * MiB;
constexpr size_t S_ATT = 288 * MiB;
constexpr size_t S_HID = 0;
constexpr size_t S_BCX = 0;
constexpr size_t S_P = 384 * MiB;
constexpr size_t S_XG = 0;
constexpr size_t S_MHID = 260 * MiB;
constexpr size_t S_Y = 256 * MiB;
constexpr size_t S_CQK = 0;
constexpr size_t S_CVT = 256 * MiB;
constexpr size_t S_CATT = 384 * MiB;
constexpr size_t S_UV = 0;
constexpr size_t O_OG = 0;
constexpr size_t O_LSE = 96 * MiB;
constexpr int CW_TMO = 0;
constexpr int CW_ECNT = 64;
constexpr int CW_BAR = 4096;
constexpr int CW_LNC = 16384;

constexpr float ASCALE8 = 8.f;
constexpr float WSCALE8 = 64.f, WSCALE8D = 256.f;
__device__ __forceinline__ unsigned pk4_fp8(float a, float b, float c, float d) { int p = 0; p = __builtin_amdgcn_cvt_pk_fp8_f32(a, b, p, false); p = __builtin_amdgcn_cvt_pk_fp8_f32(c, d, p, true); return (unsigned)p; }
namespace pg8 {
constexpr int BM = 256, BK = 64, HALF = 128, HTB = HALF * BK * 2, STAGE_BYTES = 8 * HTB, NXCD = 8, WGM = 8;
__host__ __device__ __forceinline__ int lds_byte(int r, int c) { const int st = (r >> 4) * 2 + (c >> 5), rr = r & 15, cc = c & 31, ob = rr * 64 + cc * 2; return st * 1024 + (ob ^ (((ob >> 9) & 1) << 5)); }
__host__ __device__ __forceinline__ void stage_rc(int b, int& R, int& C) { const int st = b / 1024, sb = b % 1024, swz = sb ^ (((sb >> 9) & 1) << 5); R = (st >> 1) * 16 + swz / 64; C = (st & 1) * 32 + (swz % 64) / 2; }
__host__ __device__ __forceinline__ int perm32(int rho) { const int n = rho >> 4, i = rho & 15; return 8 * (i >> 2) + 4 * n + (i & 3); }

struct Unit { int pm, pn; unsigned a, b; };
struct Gemm { int K; int rsA, rsB; size_t hstepA, hstepB; };

__device__ __forceinline__ bool tile_of(long L, int nM, int nN, int& pm, int& pn) {
    const int nwg = nM * nN; if (L >= nwg) return false;
    int wgid = (int)L; { const int q = nwg / NXCD, r = nwg % NXCD, xcd = wgid % NXCD, off = wgid / NXCD; wgid = (xcd < r ? xcd * (q + 1) : r * (q + 1) + (xcd - r) * q) + off; }
    const int nig = WGM * nN, gid = wgid / nig, fm = gid * WGM, gsz = (nM - fm) < WGM ? (nM - fm) : WGM;
    pm = fm + ((wgid % nig) % gsz); pn = (wgid % nig) / gsz; return true;
}
struct LinOrder {
    int nM, nN, G, c; const char* A0; const char* B0; size_t aT, bT;
    __device__ __forceinline__ bool next(int i, Unit& u) const { if (!tile_of((long)i * G + c, nM, nN, u.pm, u.pn)) return false; u.a = (unsigned)((size_t)u.pm * aT); u.b = (unsigned)((size_t)u.pn * bT); return true; }
};

typedef __bf16 bf16x2_t __attribute__((ext_vector_type(2)));
__device__ __forceinline__ unsigned cvt_pk_bf16(float lo, float hi) { f32x2 v = {lo, hi}; bf16x2_t b = __builtin_convertvector(v, bf16x2_t); return __builtin_bit_cast(unsigned, b); }
__device__ __forceinline__ f32x2 gelu_pk(f32x2 v) {
    const f32x2 av = __builtin_elementwise_abs(v), d = av * 0.2316418882f + 1.0f;
    f32x2 t; t.x = __builtin_amdgcn_rcpf(d.x); t.y = __builtin_amdgcn_rcpf(d.y);
    f32x2 q = t * 0.5307027145f + (-0.7265760135f); q = q * t + 0.7107068705f; q = q * t + (-0.142248368f); q = q * t + 0.127414796f; q = q * t;
    const f32x2 s = (v * v) * (-0.72134752044f);
    f32x2 e; e.x = __builtin_amdgcn_exp2f(s.x); e.y = __builtin_amdgcn_exp2f(s.y);
    const f32x2 m = v * (q * e), r = v - m;
    f32x2 o; o.x = v.x < 0.f ? m.x : r.x; o.y = v.y < 0.f ? m.y : r.y; return o;
}
__device__ __forceinline__ float silu_f(float g) { return g * __builtin_amdgcn_rcpf(1.0f + __builtin_amdgcn_exp2f(-LOG2E * g)); }

template <int ACT  > struct EpiBf16 {
    static constexpr bool PERM = true;
    bf16* O; int ldc; float sc = 1.f;
    __device__ __forceinline__ void operator()(const f32x4 (&acc)[2][2][4][2], const Unit& u, int wr, int wc, int fr, int fq) const {
        const int row0 = u.pm * BM + wr * 64 + fr, col0 = u.pn * BM + wc * 32 + 8 * fq;
#pragma unroll
        for (int ai = 0; ai < 2; ++ai)
#pragma unroll
            for (int m = 0; m < 4; ++m) { bf16* rowp = O + (size_t)(row0 + ai * HALF + m * 16) * ldc + col0;
#pragma unroll
                for (int bj = 0; bj < 2; ++bj) { f32x4 v0 = acc[ai][bj][m][0] * sc, v1 = acc[ai][bj][m][1] * sc;
                    if (ACT == 1) { f32x2 a = gelu_pk((f32x2){v0[0], v0[1]}), b = gelu_pk((f32x2){v0[2], v0[3]}), c = gelu_pk((f32x2){v1[0], v1[1]}), d = gelu_pk((f32x2){v1[2], v1[3]});
                        v0 = (f32x4){a.x, a.y, b.x, b.y}; v1 = (f32x4){c.x, c.y, d.x, d.y}; }
                    u32x4 w; w.x = cvt_pk_bf16(v0[0], v0[1]); w.y = cvt_pk_bf16(v0[2], v0[3]); w.z = cvt_pk_bf16(v1[0], v1[1]); w.w = cvt_pk_bf16(v1[2], v1[3]);
                    *(u32x4*)(rowp + bj * HALF) = w; } }
    }
};
template <int ACT  > struct EpiGlu {
    static constexpr bool PERM = true;
    bf16* O; int ldc;
    __device__ __forceinline__ void operator()(const f32x4 (&acc)[2][2][4][2], const Unit& u, int wr, int wc, int fr, int fq) const {
        const int row0 = u.pm * BM + wr * 64 + fr, col0 = u.pn * HALF + wc * 32 + 8 * fq;
#pragma unroll
        for (int ai = 0; ai < 2; ++ai)
#pragma unroll
            for (int m = 0; m < 4; ++m) { bf16* rowp = O + (size_t)(row0 + ai * HALF + m * 16) * ldc + col0;
                f32x4 g0 = acc[ai][0][m][0], g1 = acc[ai][0][m][1]; const f32x4 u0 = acc[ai][1][m][0], u1 = acc[ai][1][m][1];
                if (ACT == 1) { g0 = (f32x4){silu_f(g0[0]), silu_f(g0[1]), silu_f(g0[2]), silu_f(g0[3])}; g1 = (f32x4){silu_f(g1[0]), silu_f(g1[1]), silu_f(g1[2]), silu_f(g1[3])}; }
                const f32x4 p0 = g0 * u0, p1 = g1 * u1;
                u32x4 w; w.x = cvt_pk_bf16(p0[0], p0[1]); w.y = cvt_pk_bf16(p0[2], p0[3]); w.z = cvt_pk_bf16(p1[0], p1[1]); w.w = cvt_pk_bf16(p1[2], p1[3]);
                *(u32x4*)rowp = w; }
    }
};
struct EpiSwiglu8 {
    static constexpr bool PERM = true;
    unsigned char* O; int ldc; float s = 1.f;
    __device__ __forceinline__ void operator()(const f32x4 (&acc)[2][2][4][2], const Unit& u, int wr, int wc, int fr, int fq) const {
        const int row0 = u.pm * BM + wr * 64 + fr, col0 = u.pn * HALF + wc * 32 + 8 * fq;
#pragma unroll
        for (int ai = 0; ai < 2; ++ai)
#pragma unroll
            for (int m = 0; m < 4; ++m) { unsigned char* rowp = O + (size_t)(row0 + ai * HALF + m * 16) * ldc + col0;
                const f32x4 g0 = acc[ai][0][m][0], g1 = acc[ai][0][m][1], u0 = acc[ai][1][m][0], u1 = acc[ai][1][m][1];
                const float c1 = -LOG2E * s, s2 = s * s;
                const f32x4 p0 = (g0 * u0) * s2, p1 = (g1 * u1) * s2;
                f32x4 r0, r1;
#pragma unroll
                for (int j = 0; j < 4; ++j) { r0[j] = __builtin_amdgcn_rcpf(1.0f + __builtin_amdgcn_exp2f(g0[j] * c1)); r1[j] = __builtin_amdgcn_rcpf(1.0f + __builtin_amdgcn_exp2f(g1[j] * c1)); }
                const f32x4 o0 = p0 * r0, o1 = p1 * r1;
                u32x2 w; w.x = pk4_fp8(o0[0], o0[1], o0[2], o0[3]); w.y = pk4_fp8(o1[0], o1[1], o1[2], o1[3]);
                *(u32x2*)rowp = w; }
    }
};
struct EpiResBf16 {
    static constexpr bool PERM = true;
    const bf16* base; bf16* out; int ldc; float alpha; float sc = 1.f;
    __device__ __forceinline__ void operator()(const f32x4 (&acc)[2][2][4][2], const Unit& u, int wr, int wc, int fr, int fq) const {
        const int row0 = u.pm * BM + wr * 64 + fr, col0 = u.pn * BM + wc * 32 + 8 * fq;
#pragma unroll
        for (int ai = 0; ai < 2; ++ai)
#pragma unroll
            for (int m = 0; m < 4; ++m) { const size_t off = (size_t)(row0 + ai * HALF + m * 16) * ldc + col0;
#pragma unroll
                for (int bj = 0; bj < 2; ++bj) { const u32x4 b = *(const u32x4*)(base + off + bj * HALF); const f32x4 a0 = acc[ai][bj][m][0] * sc, a1 = acc[ai][bj][m][1] * sc;
                    u32x4 w; w.x = cvt_pk_bf16(__builtin_bit_cast(float, b.x << 16) * alpha + a0[0], __builtin_bit_cast(float, b.x & 0xffff0000u) * alpha + a0[1]);
                    w.y = cvt_pk_bf16(__builtin_bit_cast(float, b.y << 16) * alpha + a0[2], __builtin_bit_cast(float, b.y & 0xffff0000u) * alpha + a0[3]);
                    w.z = cvt_pk_bf16(__builtin_bit_cast(float, b.z << 16) * alpha + a1[0], __builtin_bit_cast(float, b.z & 0xffff0000u) * alpha + a1[1]);
                    w.w = cvt_pk_bf16(__builtin_bit_cast(float, b.w << 16) * alpha + a1[2], __builtin_bit_cast(float, b.w & 0xffff0000u) * alpha + a1[3]);
                    *(u32x4*)(out + off + bj * HALF) = w; }
                asm volatile("" ::: "memory"); }
    }
};

template <bool HB8> struct EpiResLn {
    static constexpr bool PERM = true;
    bf16* h; const float* gain; const float* bias; float alpha, sc;
    float* xbuf;
    unsigned* cnt;
    unsigned* tmo;
    unsigned char* h8;
    LAS unsigned char* tb;
    __device__ __forceinline__ void operator()(f32x4 (&acc)[2][2][4][2], const Unit& u, int wr, int wc, int fr, int fq) const {
        asm volatile("" : "+v"(fr), "+v"(fq));
        const int row0 = u.pm * BM + wr * 64 + fr, col0 = u.pn * BM + wc * 32 + 8 * fq;
        LAS f32x2* P = (LAS f32x2*)tb; LAS f32x2* S = (LAS f32x2*)(tb + 8192);
#pragma unroll
        for (int ai = 0; ai < 2; ++ai)
#pragma unroll
            for (int m = 0; m < 4; ++m) { const size_t off = (size_t)(row0 + ai * HALF + m * 16) * 1024 + col0; float sm = 0.f, sq = 0.f;
#pragma unroll
                for (int bj = 0; bj < 2; ++bj) { const u32x4 b = *(const u32x4*)(h + off + bj * HALF); const f32x4 a0 = acc[ai][bj][m][0] * sc, a1 = acc[ai][bj][m][1] * sc;
                    f32x4 z0, z1;
                    z0[0] = __builtin_bit_cast(float, b.x << 16) * alpha + a0[0]; z0[1] = __builtin_bit_cast(float, b.x & 0xffff0000u) * alpha + a0[1];
                    z0[2] = __builtin_bit_cast(float, b.y << 16) * alpha + a0[2]; z0[3] = __builtin_bit_cast(float, b.y & 0xffff0000u) * alpha + a0[3];
                    z1[0] = __builtin_bit_cast(float, b.z << 16) * alpha + a1[0]; z1[1] = __builtin_bit_cast(float, b.z & 0xffff0000u) * alpha + a1[1];
                    z1[2] = __builtin_bit_cast(float, b.w << 16) * alpha + a1[2]; z1[3] = __builtin_bit_cast(float, b.w & 0xffff0000u) * alpha + a1[3];
                    acc[ai][bj][m][0] = z0; acc[ai][bj][m][1] = z1;
                    sm += ((z0[0] + z0[1]) + (z0[2] + z0[3])) + ((z1[0] + z1[1]) + (z1[2] + z1[3]));
                    sq += ((z0[0] * z0[0] + z0[1] * z0[1]) + (z0[2] * z0[2] + z0[3] * z0[3])) + ((z1[0] * z1[0] + z1[1] * z1[1]) + (z1[2] * z1[2] + z1[3] * z1[3])); }
                sm += __shfl_xor(sm, 16); sm += __shfl_xor(sm, 32); sq += __shfl_xor(sq, 16); sq += __shfl_xor(sq, 32);
                if (fq == 0) P[(ai * HALF + wr * 64 + m * 16 + fr) * 4 + wc] = (f32x2){sm, sq};
                asm volatile("" ::: "memory"); }
        asm volatile("s_waitcnt lgkmcnt(0)" ::: "memory"); __builtin_amdgcn_s_barrier(); asm volatile("" ::: "memory");
        const int wid = wr * 4 + wc, lane = fq * 16 + fr, row = wid * 32 + (lane & 31);
        unsigned long long* slots = (unsigned long long*)xbuf + (size_t)(u.pm * BM + row) * 4;
        if (lane < 32) { const f32x2 a = P[row * 4 + 0], b = P[row * 4 + 1], c = P[row * 4 + 2], d = P[row * 4 + 3];
            const float ts = (a.x + b.x) + (c.x + d.x), tq = (a.y + b.y) + (c.y + d.y);
            __hip_atomic_store(slots + u.pn, ((unsigned long long)__builtin_bit_cast(unsigned, tq) << 32) | (unsigned long long)__builtin_bit_cast(unsigned, ts), __ATOMIC_RELAXED, __HIP_MEMORY_SCOPE_AGENT); }
        asm volatile("s_waitcnt vmcnt(0)" ::: "memory");
        if (lane == 0) (void)__hip_atomic_fetch_add(cnt + 16 * u.pm, 1u, __ATOMIC_RELAXED, __HIP_MEMORY_SCOPE_AGENT);
        if (wid == 0) { unsigned sp = 0u;
            while ((unsigned)__builtin_amdgcn_readfirstlane(__hip_atomic_load(cnt + 16 * u.pm, __ATOMIC_RELAXED, __HIP_MEMORY_SCOPE_AGENT)) < 32u) { __builtin_amdgcn_s_sleep(1);
                if ((++sp & 255u) == 0u) { if (__hip_atomic_load(tmo, __ATOMIC_RELAXED, __HIP_MEMORY_SCOPE_AGENT)) break; if (sp > (1u << 22)) { if (lane == 0) (void)__hip_atomic_fetch_add(tmo, 1u, __ATOMIC_RELAXED, __HIP_MEMORY_SCOPE_AGENT); break; } } }
            __builtin_amdgcn_fence(__ATOMIC_ACQUIRE, "agent"); }
        asm volatile("s_waitcnt vmcnt(0) lgkmcnt(0)" ::: "memory"); __builtin_amdgcn_s_barrier(); asm volatile("" ::: "memory");
        if (lane < 32) { float ts = 0.f, tq = 0.f;
#pragma unroll
            for (int t = 0; t < 4; ++t) { const unsigned long long w = __hip_atomic_load(slots + t, __ATOMIC_RELAXED, __HIP_MEMORY_SCOPE_AGENT); ts += __builtin_bit_cast(float, (unsigned)w); tq += __builtin_bit_cast(float, (unsigned)(w >> 32)); }
            const float mean = ts * (1.f / 1024.f), var = fmaxf(tq * (1.f / 1024.f) - mean * mean, 0.f);
            S[row] = (f32x2){mean, 1.f / sqrtf(var + LN_EPS)}; }
        asm volatile("s_waitcnt vmcnt(0) lgkmcnt(0)" ::: "memory"); __builtin_amdgcn_s_barrier(); asm volatile("" ::: "memory");
#pragma unroll
        for (int bj = 0; bj < 2; ++bj) { const f32x4 g0 = *(const f32x4*)(gain + col0 + bj * HALF), g1 = *(const f32x4*)(gain + col0 + bj * HALF + 4), b0 = *(const f32x4*)(bias + col0 + bj * HALF), b1 = *(const f32x4*)(bias + col0 + bj * HALF + 4);
#pragma unroll
            for (int ai = 0; ai < 2; ++ai)
#pragma unroll
                for (int m = 0; m < 4; ++m) { const int r = ai * HALF + wr * 64 + m * 16 + fr; const f32x2 sr = S[r]; const size_t off = (size_t)(u.pm * BM + r) * 1024 + col0 + bj * HALF;
                    const f32x4 y0 = (acc[ai][bj][m][0] - sr.x) * sr.y * g0 + b0, y1 = (acc[ai][bj][m][1] - sr.x) * sr.y * g1 + b1;
                    u32x4 w; w.x = cvt_pk_bf16(y0[0], y0[1]); w.y = cvt_pk_bf16(y0[2], y0[3]); w.z = cvt_pk_bf16(y1[0], y1[1]); w.w = cvt_pk_bf16(y1[2], y1[3]);
                    *(u32x4*)(h + off) = w;
                    if (HB8) { u32x2 w8; w8.x = pk4_fp8(y0[0], y0[1], y0[2], y0[3]); w8.y = pk4_fp8(y1[0], y1[1], y1[2], y1[3]); *(u32x2*)(h8 + off) = w8; }
                    asm volatile("" ::: "memory"); } }
    }
};

template <class Epi, class Sched, bool ALIGN_EPI = true, int FP8 = 0>
__device__ __forceinline__ void gemm_phase(LAS unsigned char* lds, const int wave_s, const Gemm g, const Sched& S, const Epi& E) {
    int tid = wave_s * 64 + (int)__builtin_amdgcn_mbcnt_hi(~0u, __builtin_amdgcn_mbcnt_lo(~0u, 0u)); asm volatile("" : "+v"(tid));
    const int wid = __builtin_amdgcn_readfirstlane(tid >> 6), lane = tid & 63, wr = wid >> 2, wc = wid & 3, fr = lane & 15, fq = lane >> 4;
    const int K = g.K, nt = K / BK;
    unsigned voffA[2], voffB[2];
#pragma unroll
    for (int i = 0; i < 2; ++i) { int R, C; stage_rc(tid * 16 + i * 8192, R, C); const int Rb = Epi::PERM ? ((R & ~31) + perm32(R & 31)) : R;
        voffA[i] = (unsigned)(R * g.rsA * K + C) * 2u; voffB[i] = (unsigned)(Rb * g.rsB * K + C) * 2u; }
    const unsigned kstep = (unsigned)(BK * 2);
    const unsigned hstepA = (unsigned)g.hstepA, hstepB = (unsigned)g.hstepB;
    const __amdgpu_buffer_rsrc_t rsrcA = __builtin_amdgcn_make_buffer_rsrc((void*)S.A0, 0, 0x7fffffff, 0x00020000), rsrcB = __builtin_amdgcn_make_buffer_rsrc((void*)S.B0, 0, 0x7fffffff, 0x00020000);
    const unsigned ldsw = (unsigned)wid * 1024u;
    const int aoff = lds_byte(wr * 64 + fr, fq * 8), boff = lds_byte(wc * 32 + fr, fq * 8);
    const int aoff8 = lds_byte(wr * 64 + fr, fq * 16), boff8 = lds_byte(wc * 32 + fr, fq * 16);
    unsigned bbase8_ = (unsigned)(4 * HTB + boff); asm volatile("" : "+v"(bbase8_));
    LAS unsigned char* const ldsB8 = lds + bbase8_;
#define PG8_SA(b, h) (((b) * 2 + (h)) * HTB)
#define PG8_SB(b, h) ((4 + (b) * 2 + (h)) * HTB)
#define PG8_STAGE(bufoff, gbase, voff) do { _Pragma("unroll") for (int _i = 0; _i < 2; ++_i) \
        __builtin_amdgcn_raw_ptr_buffer_load_lds(PG8_RS_##voff, (LAS unsigned*)(lds + (bufoff) + ldsw + _i * 8192), 16, (int)(voff)[_i], (int)(gbase), 0, 0); } while (0)
#define PG8_RS_voffA rsrcA
#define PG8_RS_voffB rsrcB
#define PG8_LD16(off) (*(const LAS bf16x8*)(lds + (off)))
#define PG8_CAT8(lo, hi) __builtin_shufflevector(__builtin_bit_cast(v4i_t, lo), __builtin_bit_cast(v4i_t, hi), 0, 1, 2, 3, 4, 5, 6, 7)
#define PG8_LDA(dst, b, h) do { if constexpr (FP8) { _Pragma("unroll") for (int m = 0; m < 4; ++m) dst##8[m] = PG8_CAT8(PG8_LD16(PG8_SA(b, h) + aoff + m * 2048), PG8_LD16(PG8_SA(b, h) + aoff + m * 2048 + 1024)); } \
        else { _Pragma("unroll") for (int m = 0; m < 4; ++m) _Pragma("unroll") for (int k = 0; k < 2; ++k) dst[m][k] = PG8_LD16(PG8_SA(b, h) + aoff + m * 2048 + k * 1024); } } while (0)
#define PG8_LDB(dst, b, h) do { if constexpr (FP8) { _Pragma("unroll") for (int n = 0; n < 2; ++n) dst##8[n] = PG8_CAT8(*(const LAS bf16x8*)(ldsB8 + ((b) * 2 + (h)) * HTB + n * 2048), *(const LAS bf16x8*)(ldsB8 + ((b) * 2 + (h)) * HTB + n * 2048 + 1024)); } \
        else { _Pragma("unroll") for (int n = 0; n < 2; ++n) _Pragma("unroll") for (int k = 0; k < 2; ++k) dst[n][k] = PG8_LD16(PG8_SB(b, h) + boff + n * 2048 + k * 1024); } } while (0)
#define PG8_MMA(ai, bj, At, Bt) do { __builtin_amdgcn_s_setprio(1); \
        if constexpr (FP8) { _Pragma("unroll") for (int m = 0; m < 4; ++m) _Pragma("unroll") for (int n = 0; n < 2; ++n) \
            acc[ai][bj][m][n] = __builtin_amdgcn_mfma_scale_f32_16x16x128_f8f6f4(Bt##8[n], At##8[m], acc[ai][bj][m][n], 0, 0, 0, 0, 0, 0); } \
        else { _Pragma("unroll") for (int m = 0; m < 4; ++m) _Pragma("unroll") for (int n = 0; n < 2; ++n) _Pragma("unroll") for (int k = 0; k < 2; ++k) \
            acc[ai][bj][m][n] = __builtin_amdgcn_mfma_f32_16x16x32_bf16(Bt[n][k], At[m][k], acc[ai][bj][m][n], 0, 0, 0); } \
        __builtin_amdgcn_s_setprio(0); } while (0)
#define PG8_WAIT_V(n) asm volatile("s_waitcnt vmcnt(" #n ")" ::: "memory")
#define PG8_WAIT_L(n) asm volatile("s_waitcnt lgkmcnt(" #n ")" ::: "memory")
#define PG8_BAR __builtin_amdgcn_s_barrier()
#define PG8_SCHED __builtin_amdgcn_sched_barrier(0)
    Unit cur, nxt; int ui = 0;
    if (!S.next(0, cur)) return;
    f32x4 acc[2][2][4][2];
#pragma unroll
    for (int a = 0; a < 2; ++a)
#pragma unroll
        for (int b = 0; b < 2; ++b)
#pragma unroll
            for (int m = 0; m < 4; ++m)
#pragma unroll
                for (int n = 0; n < 2; ++n) acc[a][b][m][n] = (f32x4){0.f, 0.f, 0.f, 0.f};
    bf16x8 At[4][2], B0[2][2], B1[2][2]; v8i_t At8[4], B08[2], B18[2];
    unsigned cA = cur.a, cB = cur.b;
    PG8_STAGE(PG8_SB(0, 0), cB, voffB); PG8_STAGE(PG8_SB(0, 1), cB + hstepB, voffB); PG8_STAGE(PG8_SA(0, 0), cA, voffA); PG8_STAGE(PG8_SA(0, 1), cA + hstepA, voffA);
    if (wr == 1) PG8_BAR;
    PG8_WAIT_V(2); PG8_BAR;
    PG8_STAGE(PG8_SB(1, 0), cB + kstep, voffB); PG8_STAGE(PG8_SA(1, 0), cA + kstep, voffA); PG8_STAGE(PG8_SB(1, 1), cB + hstepB + kstep, voffB);
    PG8_WAIT_V(6); PG8_BAR;
    for (;;) {
        const bool has_next = S.next(ui + 1, nxt);
        const unsigned nA = has_next ? nxt.a : cA, nB = has_next ? nxt.b : cB;
#pragma clang loop unroll(disable)
        for (int t = 0; t < nt; t += 2) {
            const bool last = (t == nt - 2);
            const unsigned a1 = cA + (unsigned)(t + 1) * kstep;
            const unsigned a2 = last ? nA : cA + (unsigned)(t + 2) * kstep, b2 = last ? nB : cB + (unsigned)(t + 2) * kstep;
            const unsigned a3 = a2 + kstep, b3 = b2 + kstep;
            PG8_LDB(B0, 0, 0); PG8_LDB(B1, 0, 1); PG8_SCHED; PG8_LDA(At, 0, 0); PG8_STAGE(PG8_SA(1, 1), a1 + hstepA, voffA);
            PG8_WAIT_V(8); PG8_WAIT_L(0); PG8_BAR; PG8_MMA(0, 0, At, B0); PG8_MMA(0, 1, At, B1); PG8_BAR; PG8_SCHED;
            PG8_LDA(At, 0, 1); PG8_STAGE(PG8_SB(0, 0), b2, voffB); PG8_STAGE(PG8_SB(0, 1), b2 + hstepB, voffB); PG8_STAGE(PG8_SA(0, 0), a2, voffA);
            PG8_WAIT_V(8); PG8_WAIT_L(0); PG8_BAR; PG8_MMA(1, 0, At, B0); PG8_MMA(1, 1, At, B1); PG8_BAR; PG8_SCHED;
            PG8_LDB(B0, 1, 0); PG8_LDB(B1, 1, 1); PG8_SCHED; PG8_LDA(At, 1, 0); PG8_STAGE(PG8_SA(0, 1), a2 + hstepA, voffA);
            PG8_WAIT_V(8); PG8_WAIT_L(0); PG8_BAR; PG8_MMA(0, 0, At, B0); PG8_MMA(0, 1, At, B1); PG8_BAR; PG8_SCHED;
            PG8_LDA(At, 1, 1); PG8_STAGE(PG8_SB(1, 0), b3, voffB); PG8_STAGE(PG8_SB(1, 1), b3 + hstepB, voffB); PG8_STAGE(PG8_SA(1, 0), a3, voffA);
            PG8_WAIT_V(8); PG8_WAIT_L(0); PG8_BAR; PG8_MMA(1, 0, At, B0); PG8_MMA(1, 1, At, B1); PG8_BAR; PG8_SCHED;
        }
        if constexpr (ALIGN_EPI) { if (wr == 0) PG8_BAR; }
        E(acc, cur, wr, wc, fr, fq);
        if (!has_next) break;
#pragma unroll
        for (int a = 0; a < 2; ++a)
#pragma unroll
            for (int b = 0; b < 2; ++b)
#pragma unroll
                for (int m = 0; m < 4; ++m)
#pragma unroll
                    for (int n = 0; n < 2; ++n) acc[a][b][m][n] = (f32x4){0.f, 0.f, 0.f, 0.f};
        cur = nxt; cA = nA; cB = nB; ++ui;
        if constexpr (ALIGN_EPI) { if (wr == 1) PG8_BAR; }
    }
    PG8_WAIT_V(0);
    if constexpr (!ALIGN_EPI) { if (wr == 0) PG8_BAR; }
    PG8_BAR;
#undef PG8_SA
#undef PG8_SB
#undef PG8_STAGE
#undef PG8_RS_voffA
#undef PG8_RS_voffB
#undef PG8_LDA
#undef PG8_LD16
#undef PG8_CAT8
#undef PG8_LDB
#undef PG8_MMA
#undef PG8_WAIT_V
#undef PG8_WAIT_L
#undef PG8_BAR
#undef PG8_SCHED
}
}

#define RLX_AGENT __ATOMIC_RELAXED, __HIP_MEMORY_SCOPE_AGENT
#define LDS_WAIT() asm volatile("s_waitcnt lgkmcnt(0)" ::: "memory")
#define VM_WAIT() asm volatile("s_waitcnt vmcnt(0)" ::: "memory")
__device__ __forceinline__ unsigned f2bf(float f) { unsigned u = __builtin_bit_cast(unsigned, f); return (u + 0x7fffu + ((u >> 16) & 1u)) >> 16; }
__device__ __forceinline__ unsigned pk2(float lo, float hi) { return pg8::cvt_pk_bf16(lo, hi); }
__device__ __forceinline__ float bflo(unsigned w) { return __builtin_bit_cast(float, w << 16); }
__device__ __forceinline__ float bfhi(unsigned w) { return __builtin_bit_cast(float, w & 0xffff0000u); }
__device__ __forceinline__ float wave_sum(float v) {
#pragma unroll
    for (int o = 1; o < 64; o <<= 1) v += __shfl_xor(v, o);
    return v;
}

#define XB_TMO      128
#define XB_XCNT(j)  (256  + 64 * (j))
#define XB_XSUB(j)  (1280 + 64 * (j))
#define XB_XGEN(j)  (2304 + 64 * (j))
#define XB_TOP      3328
#define XB_TOPGEN   3392
#define XCD_BAR_WORDS 3456
#define XB_SPIN_CAP (1u << 22)
__device__ __forceinline__ unsigned xb_ld(unsigned* p)              { return __hip_atomic_load(p, __ATOMIC_RELAXED, __HIP_MEMORY_SCOPE_AGENT); }
__device__ __forceinline__ unsigned xb_add(unsigned* p, unsigned v) { return __hip_atomic_fetch_add(p, v, __ATOMIC_RELAXED, __HIP_MEMORY_SCOPE_AGENT); }
__device__ __forceinline__ unsigned xb_xcc_id() { return (unsigned)__builtin_amdgcn_s_getreg((3 << 11) | 20) & 0xFu; }
#define XB_SPIN(cond, bar) do { unsigned _sp = 0; while (cond) { __builtin_amdgcn_s_sleep(1); \
    if ((++_sp & 255u) == 0u) { if (xb_ld(&(bar)[XB_TMO])) break; if (_sp > XB_SPIN_CAP) { atomicAdd(&(bar)[XB_TMO], 1u); break; } } } } while (0)
struct XcdBarrier { unsigned* bar; unsigned x; volatile LAS unsigned* st; };
__device__ __forceinline__ XcdBarrier xcd_barrier_post(unsigned* bar, volatile LAS unsigned* st) {
    XcdBarrier b; b.bar = bar; b.x = xb_xcc_id(); b.st = st;
    if (threadIdx.x == 0) (void)xb_add(&bar[XB_XCNT(b.x)], 1u);
    return b;
}
__device__ __forceinline__ void xcd_barrier_complete(unsigned* bar, unsigned x, unsigned& nloc, unsigned& nx) {
    const unsigned G = gridDim.x * gridDim.y * gridDim.z;
    unsigned sum, cnt, mine, sp = 0u;
    for (;;) {
        sum = 0u; cnt = 0u; mine = 0u;
#pragma unroll
        for (unsigned j = 0; j < 16; ++j) { const unsigned c = xb_ld(&bar[XB_XCNT(j)]); sum += c; cnt += (c > 0u) ? 1u : 0u; mine = (j == x) ? c : mine; }
        if (sum == G) break;
        __builtin_amdgcn_s_sleep(1);
        if ((++sp & 255u) == 0u) { if (xb_ld(&bar[XB_TMO])) break; if (sp > XB_SPIN_CAP) { atomicAdd(&bar[XB_TMO], 1u); break; } }
    }
    nloc = mine > 0u ? mine : 1u; nx = cnt > 0u ? cnt : 1u;
}
__device__ __forceinline__ void xcd_barrier(const XcdBarrier& b, const int tid) {
    asm volatile("s_waitcnt vmcnt(0)" ::: "memory");
    __syncthreads();
    if (tid == 0) {
        unsigned* bar = b.bar;
        __builtin_amdgcn_s_waitcnt(0);
        unsigned nloc = b.st[0], nx = b.st[1];
        if (nloc == 0u) { xcd_barrier_complete(bar, b.x, nloc, nx); b.st[0] = nloc; b.st[1] = nx; }
        const unsigned old = xb_add(&bar[XB_XSUB(b.x)], 1u);
        const unsigned gen = old / nloc;
        if (old + 1u == (gen + 1u) * nloc) {
            __builtin_amdgcn_fence(__ATOMIC_RELEASE, "agent");
            asm volatile("s_waitcnt vmcnt(0)" ::: "memory");
            const unsigned og = xb_add(&bar[XB_TOP], 1u);
            const unsigned tg = og / nx;
            if (og + 1u == (tg + 1u) * nx) xb_add(&bar[XB_TOPGEN], 1u);
            else XB_SPIN(xb_ld(&bar[XB_TOPGEN]) == tg, bar);
            __builtin_amdgcn_fence(__ATOMIC_ACQUIRE, "agent");
            xb_add(&bar[XB_XGEN(b.x)], 1u);
            asm volatile("s_waitcnt vmcnt(0)" ::: "memory");
        } else {
            XB_SPIN(xb_ld(&bar[XB_XGEN(b.x)]) == gen, bar);
            __builtin_amdgcn_fence(__ATOMIC_ACQUIRE, "agent");
            asm volatile("s_waitcnt vmcnt(0)" ::: "memory");
        }
    }
    __syncthreads();
}

constexpr int NWAVES = 8;
constexpr int RING_BYTES = 131072, MISC_OFF = RING_BYTES + 320, LNT_OFF = RING_BYTES + 2048  , LDS_BYTES = 147456;
struct Args { const float* in[24]; float* out; unsigned char* ws; int ph_lo, ph_hi; int chk, pad; };
struct Frame {
    LAS unsigned char* lds;
    gu32* ctl; unsigned char* ws; float* out;
    int tid, lane, wave, vcu, G;
    int chk, stage;
};

struct Job { const float* src; bf16* dst; int ld, K, N, mode, start; float scale; int fp8, pad; };
constexpr int NJOBS = 74;
__device__ __forceinline__ void make_job(const Args& a, int j, Job& J) {
    unsigned char* ws = a.ws; J.scale = 1.f; J.mode = 0; J.start = 0; J.fp8 = 0; J.pad = 0;
    if (j < 9) { const int g = j / 3, t = j % 3; J.src = a.in[4] + g * 3072 + t * 1024; J.ld = 9216; J.K = 1024; J.N = 1024;
        if (t == 2) J.dst = (bf16*)(ws + W_A_V + (size_t)g * 1024 * 1024); else J.dst = (bf16*)(ws + W_A_QK + (size_t)g * 2048 * 1024 + (size_t)t * 1024 * 1024);
        J.fp8 = 1; J.scale = (t == 0 ? QSCALE : 1.f) * WSCALE8; return; }
    j -= 9;
    if (j == 0) { J.src = a.in[5]; J.ld = 1024; J.K = 1024; J.N = 1024; J.dst = (bf16*)(ws + W_A_O); J.fp8 = 1; J.scale = WSCALE8; return; }
    if (j == 1) { J.src = a.in[6]; J.ld = 3072; J.K = 1024; J.N = 1024; J.dst = (bf16*)(ws + W_B_IN); return; }
    if (j == 9 || j == 10) { J.src = a.in[6] + 1024 * (j - 8); J.ld = 3072; J.K = 1024; J.N = 1024; J.dst = (bf16*)(ws + W_B_IN) + (size_t)1024 * 1024; J.mode = j - 8; return; }
    if (j == 2) { J.src = a.in[8]; J.ld = 1024; J.K = 1024; J.N = 1024; J.dst = (bf16*)(ws + W_B_O); return; }
    if (j == 3) { J.src = a.in[9]; J.ld = 3072; J.K = 1024; J.N = 1024; J.dst = (bf16*)(ws + W_C_QK); J.scale = QSCALE; return; }
    if (j == 4) { J.src = a.in[9] + 1024; J.ld = 3072; J.K = 1024; J.N = 1024; J.dst = (bf16*)(ws + W_C_QK) + (size_t)1024 * 1024; return; }
    if (j == 5) { J.src = a.in[9] + 2048; J.ld = 3072; J.K = 1024; J.N = 1024; J.dst = (bf16*)(ws + W_C_V); return; }
    if (j == 6) { J.src = a.in[10]; J.ld = 1024; J.K = 1024; J.N = 1024; J.dst = (bf16*)(ws + W_C_O); J.fp8 = 1; J.scale = WSCALE8; return; }
    if (j == 7) { J.src = a.in[11]; J.ld = 2048; J.K = 1024; J.N = 2048; J.dst = (bf16*)(ws + W_D_IN); return; }
    if (j == 8) { J.src = a.in[16]; J.ld = 1024; J.K = 1024; J.N = 1024; J.dst = (bf16*)(ws + W_D_O); return; }
    j -= 11;
    if (j < 6) { const int f = j / 3, t = j % 3;
        if (t < 2) { J.src = a.in[17 + t] + (size_t)f * 1024 * DFF; J.ld = DFF; J.K = 1024; J.N = DFF; J.dst = (bf16*)(ws + W_F_GU) + (size_t)f * 2 * DFF * 1024; J.mode = 1 + t;
            if (f == FFN_GU8) { J.fp8 = 1; J.scale = WSCALE8; } }
        else { J.src = a.in[19] + (size_t)f * DFF * 1024; J.ld = 1024; J.K = DFF; J.N = 1024; J.dst = (bf16*)(ws + W_F_D) + (size_t)f * 1024 * DFF; J.fp8 = 1; J.scale = WSCALE8D; }
        return; }
    j -= 6;
    { const int fe = j / 3, t = j % 3;
        if (t < 2) { J.src = a.in[21 + t] + (size_t)fe * 1024 * DFE; J.ld = DFE; J.K = 1024; J.N = DFE; J.dst = (bf16*)(ws + W_E_GU) + (size_t)fe * 2 * DFE * 1024; J.mode = 1 + t; J.fp8 = 1; J.scale = WSCALE8; }
        else { J.src = a.in[23] + (size_t)fe * DFE * 1024; J.ld = 1024; J.K = DFE; J.N = 1024; J.dst = (bf16*)(ws + W_E_D) + (size_t)fe * 1024 * DFE; J.fp8 = 1; J.scale = WSCALE8D; } }
}
__device__ __forceinline__ void transpose_item(const Job& J, int item, int lane) {
    const int nblk = J.N >> 6, kb = item / nblk, nb = item - kb * nblk, k0 = 64 * kb, n = 64 * nb + lane;
    const float* W = J.src + (size_t)k0 * J.ld + n;
    int r = n; if (J.mode) r = (n >> 7) * 256 + (n & 127) + (J.mode == 2 ? 128 : 0);
    const float sc = J.scale; const size_t ld = (size_t)J.ld;
    if (J.fp8) {
        unsigned char* dst8 = (unsigned char*)J.dst + (size_t)r * J.K + k0;
#pragma unroll
        for (int hf = 0; hf < 2; ++hf) {
            float v[32];
#pragma unroll
            for (int j = 0; j < 32; ++j) v[j] = W[(size_t)(32 * hf + j) * ld];
#pragma unroll
            for (int c = 0; c < 2; ++c) { u32x4 o; o.x = pk4_fp8(v[16 * c] * sc, v[16 * c + 1] * sc, v[16 * c + 2] * sc, v[16 * c + 3] * sc); o.y = pk4_fp8(v[16 * c + 4] * sc, v[16 * c + 5] * sc, v[16 * c + 6] * sc, v[16 * c + 7] * sc);
                o.z = pk4_fp8(v[16 * c + 8] * sc, v[16 * c + 9] * sc, v[16 * c + 10] * sc, v[16 * c + 11] * sc); o.w = pk4_fp8(v[16 * c + 12] * sc, v[16 * c + 13] * sc, v[16 * c + 14] * sc, v[16 * c + 15] * sc);
                *(u32x4*)(dst8 + 32 * hf + 16 * c) = o; }
        }
        return;
    }
    bf16* dst = J.dst + (size_t)r * J.K + k0;
#pragma unroll
    for (int hf = 0; hf < 2; ++hf) {
        float v[32];
#pragma unroll
        for (int j = 0; j < 32; ++j) v[j] = W[(size_t)(32 * hf + j) * ld];
#pragma unroll
        for (int c = 0; c < 4; ++c) { u32x4 o; o.x = pk2(v[8 * c] * sc, v[8 * c + 1] * sc); o.y = pk2(v[8 * c + 2] * sc, v[8 * c + 3] * sc); o.z = pk2(v[8 * c + 4] * sc, v[8 * c + 5] * sc); o.w = pk2(v[8 * c + 6] * sc, v[8 * c + 7] * sc);
            *(u32x4*)(dst + 32 * hf + 8 * c) = o; }
    }
}
__device__ __forceinline__ int t5_bucket(int d) {
    if (d < 16) return d;
    int b = 16 + (int)(log((double)d / 16.0) / log(128.0) * 16.0);
    return b < 16 ? 16 : (b > 31 ? 31 : b);
}
__device__ __forceinline__ void p_prologue(Frame& F, const Args& a) {
    unsigned char* gl_ = (unsigned char*)F.lds;
    Job* jobs = (Job*)(gl_ + 7 * 16384 + 8704);
    int* tot = (int*)(gl_ + 7 * 16384 + 8704 + NJOBS * sizeof(Job));
    static_assert(8704 + NJOBS * sizeof(Job) + 16 <= 16384, "job table fits");
    if (F.tid < NJOBS) { Job J; make_job(a, F.tid, J); jobs[F.tid] = J; }
    __syncthreads();
    if (F.tid == 0) { int s = 0; for (int j = 0; j < NJOBS; ++j) { jobs[j].start = s; s += (jobs[j].K / 64) * (jobs[j].N / 64); } tot[0] = s; }
    __syncthreads();
    const int total = tot[0];
    const int gw = F.vcu * NWAVES + F.wave, NGW = F.G * NWAVES;
    int jc = 0;
    for (int it = gw; it < total; it += NGW) {
        while (jc + 1 < NJOBS && jobs[jc + 1].start <= it) ++jc;
        const Job J = jobs[jc];
        transpose_item(J, it - J.start, F.lane);
    }
    { bf16* hb = (bf16*)(F.ws + WS_HB); const float* x = a.in[0]; unsigned char* hb8 = F.ws + WS_SCR + S_HB8;
      for (int m0 = 4 * gw; m0 < T; m0 += 4 * NGW) { f32x4 v[4][4];
#pragma unroll
          for (int k = 0; k < 4; ++k) { const f32x4* xr = (const f32x4*)(x + (size_t)(m0 + k) * D) + F.lane;
#pragma unroll
              for (int j = 0; j < 4; ++j) v[k][j] = xr[64 * j]; }
#pragma unroll
          for (int k = 0; k < 4; ++k) { unsigned long long* o8 = (unsigned long long*)(hb + (size_t)(m0 + k) * D) + F.lane;
#pragma unroll
              for (int j = 0; j < 4; ++j) o8[64 * j] = (unsigned long long)pk2(v[k][j].x, v[k][j].y) | ((unsigned long long)pk2(v[k][j].z, v[k][j].w) << 32);
              unsigned* o4 = (unsigned*)(hb8 + (size_t)(m0 + k) * D) + F.lane;
#pragma unroll
              for (int j = 0; j < 4; ++j) o4[64 * j] = pk4_fp8(v[k][j].x, v[k][j].y, v[k][j].z, v[k][j].w); } } }
    const int gt = blockIdx.x * 512 + F.tid, NGT = F.G * 512;
    const float* rel = a.in[1];
    float* btA = (float*)(F.ws + WS_BTABA); float* btC = (float*)(F.ws + WS_BTABC);
    for (int i = gt; i < 48 * 132; i += NGT) { const int gh = i / 132, dl = i % 132, g = gh >> 4, hh = gh & 15; const int dil = g == 0 ? 1 : (g == 1 ? 4 : 16);
        btA[i] = dl <= 128 ? rel[t5_bucket(dl * dil) * NH + hh] * LOG2E : 0.f; }
    for (int i = gt; i < 16 * 2048; i += NGT) { const int hh = i >> 11, dd = i & 2047; btC[i] = rel[t5_bucket(dd) * NH + hh] * LOG2E; }
    { bf16* wst = (bf16*)(F.ws + WS_WST); const float* wsrc = a.in[14];
      for (int i = gt; i < 8 * 128 * 128; i += NGT) { const int tt = (i >> 7) & 127, ss = i & 127; wst[i] = (bf16)f2bf(ss <= tt ? wsrc[i] : 0.f); } }
}

__device__ __forceinline__ void unpack8(const u32x4 a, float* x) { x[0] = bflo(a.x); x[1] = bfhi(a.x); x[2] = bflo(a.y); x[3] = bfhi(a.y); x[4] = bflo(a.z); x[5] = bfhi(a.z); x[6] = bflo(a.w); x[7] = bfhi(a.w); }
template <int MODE, bool ROUTE, bool FINAL, bool HB8 = false>
__device__ __forceinline__ void ln_phase(Frame& F, const float* gain, const float* bias, const float* wr) {
    constexpr int NBT = 2;
    const int gw = F.vcu * NWAVES + F.wave, NGW = F.G * NWAVES, lane = F.lane;
    bf16* hb = (bf16*)(F.ws + WS_HB); const bf16* zb = (const bf16*)F.out;
    float gv[16], bv[16];
#pragma unroll
    for (int k = 0; k < 2; ++k)
#pragma unroll
        for (int j = 0; j < 2; ++j) { const f32x4 g4 = *(const f32x4*)(gain + 512 * k + 8 * lane + 4 * j), b4 = *(const f32x4*)(bias + 512 * k + 8 * lane + 4 * j);
            gv[8 * k + 4 * j] = g4.x; gv[8 * k + 4 * j + 1] = g4.y; gv[8 * k + 4 * j + 2] = g4.z; gv[8 * k + 4 * j + 3] = g4.w;
            bv[8 * k + 4 * j] = b4.x; bv[8 * k + 4 * j + 1] = b4.y; bv[8 * k + 4 * j + 2] = b4.z; bv[8 * k + 4 * j + 3] = b4.w; }
    LAS float* wrT = (LAS float*)F.lds;
    if (ROUTE) { for (int i = F.tid; i < 8 * 1024; i += 512) { const int e = i >> 10, c = i & 1023; wrT[i] = wr[c * 8 + e]; } __syncthreads(); }
    const bf16* ys = (const bf16*)(F.ws + WS_SCR + S_XG);
    const int* slots = (const int*)(F.ws + WS_SLOTS); const float* gates = (const float*)(F.ws + WS_GATES);
    int* route = (int*)(F.ws + WS_ROUTE); float* gout = (float*)(F.ws + WS_GATES);
    for (int grp = gw; grp < T / 32; grp += NGW) {
        int cnt_e = 0;
        int my_e1 = 0, my_e2 = 0, my_r1 = 0, my_r2 = 0; float my_g1 = 0.f, my_g2 = 0.f;
        int sl0 = 0, sl1 = 0; float gg0 = 0.f, gg1 = 0.f;
        if (MODE == 2) { const int mm = grp * 32 + (lane & 31); sl0 = slots[2 * mm]; sl1 = slots[2 * mm + 1]; gg0 = gates[2 * mm]; gg1 = gates[2 * mm + 1]; }
        for (int i0 = 0; i0 < 32; i0 += NBT) {
            float v[NBT][16]; float st[NBT][2];
#pragma unroll
            for (int k = 0; k < NBT; ++k) { const int m = grp * 32 + i0 + k;
                if (MODE == 0) { const u32x4* zr = (const u32x4*)(zb + (size_t)m * D) + lane; unpack8(zr[0], v[k]); unpack8(zr[64], v[k] + 8); }
                else { const u32x4* hr = (const u32x4*)(hb + (size_t)m * D) + lane; unpack8(hr[0], v[k]); unpack8(hr[64], v[k] + 8);
#pragma unroll
                    for (int j = 0; j < 16; ++j) v[k][j] *= ALPHA;
                    if (MODE == 3) { const u32x4* yr = (const u32x4*)((const bf16*)(F.ws + WS_SCR + S_Y) + (size_t)m * D) + lane; float a[16]; unpack8(yr[0], a); unpack8(yr[64], a + 8);
#pragma unroll
                        for (int j = 0; j < 16; ++j) v[k][j] += a[j]; }
                    if (MODE == 2) { const int s0 = __builtin_amdgcn_readlane(sl0, i0 + k), s1 = __builtin_amdgcn_readlane(sl1, i0 + k);
                        const float g0 = __builtin_bit_cast(float, __builtin_amdgcn_readlane(__builtin_bit_cast(int, gg0), i0 + k)), g1 = __builtin_bit_cast(float, __builtin_amdgcn_readlane(__builtin_bit_cast(int, gg1), i0 + k));
                        const u32x4* y0 = (const u32x4*)(ys + (size_t)s0 * D) + lane; const u32x4* y1 = (const u32x4*)(ys + (size_t)s1 * D) + lane;
                        float a[16], b[16]; unpack8(y0[0], a); unpack8(y0[64], a + 8); unpack8(y1[0], b); unpack8(y1[64], b + 8);
#pragma unroll
                        for (int j = 0; j < 16; ++j) v[k][j] += g0 * a[j] + g1 * b[j]; } }
                float s = 0.f, q2 = 0.f;
#pragma unroll
                for (int j = 0; j < 16; ++j) { s += v[k][j]; q2 += v[k][j] * v[k][j]; }
                st[k][0] = s; st[k][1] = q2; }
#pragma unroll
            for (int o = 1; o < 64; o <<= 1) {
#pragma unroll
                for (int k = 0; k < NBT; ++k) { st[k][0] += __shfl_xor(st[k][0], o); st[k][1] += __shfl_xor(st[k][1], o); } }
#pragma unroll
            for (int k = 0; k < NBT; ++k) { const int m = grp * 32 + i0 + k;
                const float mean = st[k][0] * (1.f / D), var = fmaxf(st[k][1] * (1.f / D) - mean * mean, 0.f), rstd = 1.f / sqrtf(var + LN_EPS);
#pragma unroll
                for (int j = 0; j < 16; ++j) v[k][j] = (v[k][j] - mean) * rstd * gv[j] + bv[j];
                if (FINAL) { f32x4* orow = (f32x4*)(F.out + (size_t)m * D) + 2 * lane;
                    orow[0] = (f32x4){v[k][0], v[k][1], v[k][2], v[k][3]}; orow[1] = (f32x4){v[k][4], v[k][5], v[k][6], v[k][7]}; orow[128] = (f32x4){v[k][8], v[k][9], v[k][10], v[k][11]}; orow[129] = (f32x4){v[k][12], v[k][13], v[k][14], v[k][15]}; }
                else { u32x4* o = (u32x4*)(hb + (size_t)m * D) + lane; u32x4 a, b;
                    a.x = pk2(v[k][0], v[k][1]); a.y = pk2(v[k][2], v[k][3]); a.z = pk2(v[k][4], v[k][5]); a.w = pk2(v[k][6], v[k][7]); b.x = pk2(v[k][8], v[k][9]); b.y = pk2(v[k][10], v[k][11]); b.z = pk2(v[k][12], v[k][13]); b.w = pk2(v[k][14], v[k][15]);
                    o[0] = a; o[64] = b;
                    if (HB8) { u32x2* o8 = (u32x2*)(F.ws + WS_SCR + S_HB8 + (size_t)m * D) + lane; u32x2 c, d;
                        c.x = pk4_fp8(v[k][0], v[k][1], v[k][2], v[k][3]); c.y = pk4_fp8(v[k][4], v[k][5], v[k][6], v[k][7]); d.x = pk4_fp8(v[k][8], v[k][9], v[k][10], v[k][11]); d.y = pk4_fp8(v[k][12], v[k][13], v[k][14], v[k][15]);
                        o8[0] = c; o8[64] = d; } }
                if (ROUTE) {
                    float lg[8];
#pragma unroll
                    for (int e = 0; e < 8; ++e) { float p = 0.f;
#pragma unroll
                        for (int kk = 0; kk < 2; ++kk)
#pragma unroll
                            for (int j = 0; j < 2; ++j) { const f32x4 w4 = *(const LAS f32x4*)(wrT + e * 1024 + 512 * kk + 8 * lane + 4 * j); p += (v[k][8 * kk + 4 * j] * w4.x + v[k][8 * kk + 4 * j + 1] * w4.y) + (v[k][8 * kk + 4 * j + 2] * w4.z + v[k][8 * kk + 4 * j + 3] * w4.w); }
                        lg[e] = p; }
#pragma unroll
                    for (int o = 1; o < 64; o <<= 1) {
#pragma unroll
                        for (int e = 0; e < 8; ++e) lg[e] += __shfl_xor(lg[e], o); }
                    int e1 = 0; float v1 = lg[0];
#pragma unroll
                    for (int e = 1; e < 8; ++e) if (lg[e] > v1) { v1 = lg[e]; e1 = e; }
                    int e2 = -1; float v2 = -3.4e38f;
#pragma unroll
                    for (int e = 0; e < 8; ++e) if (e != e1 && lg[e] > v2) { v2 = lg[e]; e2 = e; }
                    const float g2 = 1.f / (1.f + __expf(v1 - v2)), g1 = 1.f - g2;
                    const int r1 = __shfl(cnt_e, e1); if (lane == e1) ++cnt_e;
                    const int r2 = __shfl(cnt_e, e2); if (lane == e2) ++cnt_e;
                    if (lane == i0 + k) { my_e1 = e1; my_e2 = e2; my_r1 = r1; my_r2 = r2; my_g1 = g1; my_g2 = g2; }
                }
            }
        }
        if (ROUTE) {
            if (lane < 8) ((int*)(F.ws + WS_WCNT))[grp * 8 + lane] = cnt_e;
            if (lane < 32) { const int m = grp * 32 + lane; int* r = route + 4 * m; r[0] = my_e1; r[1] = my_r1; r[2] = my_e2; r[3] = my_r2; gout[2 * m] = my_g1; gout[2 * m + 1] = my_g2; }
        }
    }
}

__device__ __forceinline__ f32x16 mfma32(bf16x8 a, bf16x8 b, f32x16 c) { return __builtin_amdgcn_mfma_f32_32x32x16_bf16(a, b, c, 0, 0, 0); }
__device__ __forceinline__ bf16x8 pack8(const f32x16& s, int b0) {
    u32x4 w; w.x = pg8::cvt_pk_bf16(s[b0], s[b0 + 1]); w.y = pg8::cvt_pk_bf16(s[b0 + 2], s[b0 + 3]); w.z = pg8::cvt_pk_bf16(s[b0 + 4], s[b0 + 5]); w.w = pg8::cvt_pk_bf16(s[b0 + 6], s[b0 + 7]);
    return __builtin_bit_cast(bf16x8, w);
}
__device__ __forceinline__ float max16(const f32x16& s) {
    float a = fmaxf(fmaxf(s[0], s[1]), fmaxf(s[2], s[3])), b = fmaxf(fmaxf(s[4], s[5]), fmaxf(s[6], s[7]));
    float c = fmaxf(fmaxf(s[8], s[9]), fmaxf(s[10], s[11])), d = fmaxf(fmaxf(s[12], s[13]), fmaxf(s[14], s[15]));
    return fmaxf(fmaxf(a, b), fmaxf(c, d));
}
__device__ __forceinline__ void softmax_pv(f32x16& s, float& m_run, float& l_run, f32x16& o0, f32x16& o1, const bf16* vt0, const bf16* vt1, int h) {
    float mx = max16(s); mx = fmaxf(mx, __shfl_xor(mx, 32));
    const float mn = fmaxf(m_run, mx), alpha = __builtin_amdgcn_exp2f(m_run - mn); m_run = mn;
    float ps = 0.f;
#pragma unroll
    for (int r = 0; r < 16; ++r) { const float p = __builtin_amdgcn_exp2f(s[r] - mn); s[r] = p; ps += p; }
    l_run = l_run * alpha + ps;
#pragma unroll
    for (int r = 0; r < 16; ++r) { o0[r] *= alpha; o1[r] *= alpha; }
    const bf16x8 p0 = pack8(s, 0), p1 = pack8(s, 8);
    const bf16x8 v00 = *(const bf16x8*)(vt0 + 8 * h), v01 = *(const bf16x8*)(vt0 + 16 + 8 * h), v10 = *(const bf16x8*)(vt1 + 8 * h), v11 = *(const bf16x8*)(vt1 + 16 + 8 * h);
    o0 = mfma32(v00, p0, o0); o0 = mfma32(v01, p1, o0);
    o1 = mfma32(v10, p0, o1); o1 = mfma32(v11, p1, o1);
}
__device__ __forceinline__ int kperm(int i) { return (i & 19) | ((i & 8) >> 1) | ((i & 4) << 1); }

__device__ __forceinline__ void dil_attn_phase(Frame& F) {
    LAS float* bt = (LAS float*)F.lds;
    { const float* btA = (const float*)(F.ws + WS_BTABA); for (int i = F.tid; i < 48 * 192; i += 512) { const int gh = i / 192, dl = i % 192 - 32; bt[i] = (dl >= 0 && dl <= 128) ? btA[gh * 132 + dl] : NEGB; } }
    __syncthreads();
    const int gw = F.vcu * NWAVES + F.wave, NGW = F.G * NWAVES, lane = F.lane, q = lane & 31, h = lane >> 5;
    const bf16* QK = (const bf16*)(F.ws + WS_SCR + S_QK); const bf16* VT = (const bf16*)(F.ws + WS_SCR + S_VT);
    bf16* OG = (bf16*)((unsigned char*)F.out + O_OG); float* LSE = (float*)((unsigned char*)F.out + O_LSE);
    constexpr int NTASK = 3 * 16 * 8 * 64;
    const int per = (NTASK + NGW - 1) / NGW;
    const int t_lo = gw * per, t_hi = (t_lo + per) < NTASK ? (t_lo + per) : NTASK;
    for (int task = t_lo; task < t_hi; ++task) {
        const int qt = task & 3, rn = (task >> 2) & 15, bl = (task >> 6) & 7, gh = task >> 9, g = gh >> 4, hh = gh & 15;
        const int nblk = 16 >> (2 * g); const bool has_prev = (rn & (nblk - 1)) != 0;
        const int n0 = bl * 2048 + rn * 128;
        const bf16* qrow = QK + ((size_t)g * TC + n0 + 32 * qt + q) * 2048 + hh * 64;
        bf16x8 qf[4];
#pragma unroll
        for (int d0 = 0; d0 < 4; ++d0) qf[d0] = *(const bf16x8*)(qrow + d0 * 16 + 8 * h);
        float m_run = NEGB, l_run = 0.f; f32x16 o0 = {}, o1 = {};
        const bf16* vbase0 = VT + ((size_t)g * 1024 + hh * 64 + q) * TC; const bf16* vbase1 = vbase0 + (size_t)32 * TC;
        const LAS float* btl = bt + gh * 192 + (q - 8 * h + 137);
#pragma unroll
        for (int t = 0; t < 5; ++t) {
            if (has_prev || qt + t > 3) {
                const int kr0 = n0 - 128 + 32 * qt + 32 * t;
                const bf16* krow = QK + ((size_t)g * TC + kr0 + kperm(q)) * 2048 + 1024 + hh * 64;
                f32x16 s;
#pragma unroll
                for (int r = 0; r < 16; ++r) s[r] = btl[-32 * t + 23 - 16 * (r >> 3) - (r & 7)];
#pragma unroll
                for (int d0 = 0; d0 < 4; ++d0) { const bf16x8 kf = *(const bf16x8*)(krow + d0 * 16 + 8 * h); s = mfma32(kf, qf[d0], s); }
                softmax_pv(s, m_run, l_run, o0, o1, vbase0 + kr0, vbase1 + kr0, h);
            }
        }
        const float l_tot = l_run + __shfl_xor(l_run, 32), inv = 1.f / l_tot;
        const size_t orow = (size_t)g * TC + n0 + 32 * qt + q;
        bf16* op = OG + orow * 1024 + hh * 64 + 4 * h;
#pragma unroll
        for (int gq = 0; gq < 4; ++gq) {
            u32x2 w0, w1; w0.x = pg8::cvt_pk_bf16(o0[4 * gq] * inv, o0[4 * gq + 1] * inv); w0.y = pg8::cvt_pk_bf16(o0[4 * gq + 2] * inv, o0[4 * gq + 3] * inv);
            w1.x = pg8::cvt_pk_bf16(o1[4 * gq] * inv, o1[4 * gq + 1] * inv); w1.y = pg8::cvt_pk_bf16(o1[4 * gq + 2] * inv, o1[4 * gq + 3] * inv);
            *(u32x2*)(op + 8 * gq) = w0; *(u32x2*)(op + 32 + 8 * gq) = w1; }
        if (h == 0) LSE[orow * 16 + hh] = m_run + __log2f(l_tot);
    }
}
__device__ __forceinline__ void dil_merge_phase(Frame& F, int ck) {
    const int gw = F.vcu * NWAVES + F.wave, NGW = F.G * NWAVES, lane = F.lane;
    const bf16* OG = (const bf16*)((unsigned char*)F.out + O_OG); const float* LSE = (const float*)((unsigned char*)F.out + O_LSE);
    unsigned char* att = F.ws + WS_SCR + S_ATT + (size_t)ck * TC * 1024;
    const int hh = lane >> 2;
    for (int tl0 = 2 * gw; tl0 < TC; tl0 += 2 * NGW) {
        size_t n[2][3]; float ls[2][3]; u32x4 x[2][3];
#pragma unroll
        for (int k = 0; k < 2; ++k) { const int tl = tl0 + k, bl = tl >> 11, tt = tl & 2047;
            n[k][0] = tl; n[k][1] = bl * 2048 + (tt & 3) * 512 + (tt >> 2); n[k][2] = bl * 2048 + (tt & 15) * 128 + (tt >> 4);
#pragma unroll
            for (int g = 0; g < 3; ++g) { ls[k][g] = LSE[((size_t)g * TC + n[k][g]) * 16 + hh]; x[k][g] = *(const u32x4*)((const unsigned char*)OG + ((size_t)g * TC + n[k][g]) * 1024 + 16 * lane); } }
#pragma unroll
        for (int k = 0; k < 2; ++k) {
            const float M = fmaxf(fmaxf(ls[k][0], ls[k][1]), ls[k][2]);
            float w[3]; float W = 0.f;
#pragma unroll
            for (int g = 0; g < 3; ++g) { w[g] = __builtin_amdgcn_exp2f(ls[k][g] - M); W += w[g]; }
            const float iw = 1.f / W;
            float acc[16];
#pragma unroll
            for (int j = 0; j < 16; ++j) acc[j] = 0.f;
#pragma unroll
            for (int g = 0; g < 3; ++g) { const float wg = w[g] * iw; float a[16];
#pragma unroll
                for (int c = 0; c < 4; ++c) { const f32x2 lo = __builtin_amdgcn_cvt_pk_f32_fp8((int)x[k][g][c], false), hi = __builtin_amdgcn_cvt_pk_f32_fp8((int)x[k][g][c], true); a[4 * c] = lo.x; a[4 * c + 1] = lo.y; a[4 * c + 2] = hi.x; a[4 * c + 3] = hi.y; }
#pragma unroll
                for (int j = 0; j < 16; ++j) acc[j] += wg * a[j]; }
            u32x4 y; y.x = pk4_fp8(acc[0], acc[1], acc[2], acc[3]); y.y = pk4_fp8(acc[4], acc[5], acc[6], acc[7]); y.z = pk4_fp8(acc[8], acc[9], acc[10], acc[11]); y.w = pk4_fp8(acc[12], acc[13], acc[14], acc[15]);
            *(u32x4*)(att + (size_t)(tl0 + k) * 1024 + 16 * lane) = y;
        }
    }
}

__device__ __forceinline__ void conv_phase(Frame& F, const float* cw) {
    const int gw = F.vcu * NWAVES + F.wave, NGW = F.G * NWAVES, lane = F.lane;
    const bf16* gbp = (const bf16*)(F.ws + WS_SCR + S_BCX); const bf16* up = (const bf16*)(F.ws + WS_SCR + S_BCX + (size_t)128 * MiB); bf16* p = (bf16*)(F.ws + WS_SCR + S_P);
    for (int item = gw; item < (T / 32) * 2; item += NGW) {
        const int half = item & 1, tb = item >> 1, t0 = tb * 32, c0 = half * 512 + lane * 8;
        float w0[8], w1[8], w2[8];
#pragma unroll
        for (int j = 0; j < 8; ++j) { w0[j] = cw[c0 + j]; w1[j] = cw[1024 + c0 + j]; w2[j] = cw[2048 + c0 + j]; }
        float u1[8], u2[8];
        const bool first = (t0 & 2047) == 0;
#pragma unroll
        for (int j = 0; j < 8; ++j) { u1[j] = 0.f; u2[j] = 0.f; }
        if (!first) { unpack8(*(const u32x4*)(up + (size_t)(t0 - 2) * 1024 + c0), u2); unpack8(*(const u32x4*)(up + (size_t)(t0 - 1) * 1024 + c0), u1); }
        for (int i = 0; i < 32; ++i) { const size_t r = (size_t)(t0 + i) * 1024;
            const u32x4 gb = *(const u32x4*)(gbp + r + c0), uu = *(const u32x4*)(up + r + c0);
            float u0[8], b[8]; unpack8(uu, u0); unpack8(gb, b);
            float o[8];
#pragma unroll
            for (int j = 0; j < 8; ++j) { o[j] = b[j] * (w0[j] * u2[j] + w1[j] * u1[j] + w2[j] * u0[j]); u2[j] = u1[j]; u1[j] = u0[j]; }
            u32x4 x; x.x = pk2(o[0], o[1]); x.y = pk2(o[2], o[3]); x.z = pk2(o[4], o[5]); x.w = pk2(o[6], o[7]);
            *(u32x4*)(p + (size_t)(t0 + i) * 1024 + c0) = x; }
    }
}

__device__ __forceinline__ void kmean_phase(Frame& F) {
    const int gw = F.vcu * NWAVES + F.wave, NGW = F.G * NWAVES, lane = F.lane;
    const bf16* QK = (const bf16*)(F.ws + WS_SCR + S_CQK); float* km = (float*)(F.ws + WS_KMEAN);
    const int kq = lane >> 3, dc = lane & 7;
    for (int u = gw; u < NB * NH * 8; u += NGW) { const int blk = u & 7, hh = (u >> 3) & 15, b = u >> 7;
        float a[8];
#pragma unroll
        for (int j = 0; j < 8; ++j) a[j] = 0.f;
        const bf16* kp = QK + ((size_t)b * SEQ + blk * 256 + kq) * 2048 + 1024 + hh * 64 + dc * 8;
#pragma unroll 8
        for (int i = 0; i < 32; ++i) { const u32x4 x = *(const u32x4*)(kp + (size_t)i * 8 * 2048);
            a[0] += bflo(x.x); a[1] += bfhi(x.x); a[2] += bflo(x.y); a[3] += bfhi(x.y); a[4] += bflo(x.z); a[5] += bfhi(x.z); a[6] += bflo(x.w); a[7] += bfhi(x.w); }
#pragma unroll
        for (int j = 0; j < 8; ++j) { a[j] += __shfl_xor(a[j], 8); a[j] += __shfl_xor(a[j], 16); a[j] += __shfl_xor(a[j], 32); }
        if (lane < 8) { float* o = km + (size_t)u * 64 + lane * 8;
#pragma unroll
            for (int j = 0; j < 8; ++j) o[j] = a[j] * (1.f / 256.f); }
    }
}
__device__ __forceinline__ void moba_unit(Frame& F, int b, int hh, int nb, LAS float* bt, int& cur_h) {
    const int lane = F.lane, q = lane & 31, h = lane >> 5, w = F.wave;
    const bf16* QK = (const bf16*)(F.ws + WS_SCR + S_CQK); const bf16* VT = (const bf16*)(F.ws + WS_SCR + S_CVT);
    bf16* att = (bf16*)(F.ws + WS_SCR + S_CATT); const float* km = (const float*)(F.ws + WS_KMEAN);
    if (hh != cur_h) { __syncthreads(); const float* btC = (const float*)(F.ws + WS_BTABC) + hh * 2048; for (int i = F.tid; i < 2048; i += 512) bt[i] = btC[i]; cur_h = hh; __syncthreads(); }
    const size_t tq = (size_t)b * SEQ + nb * 256 + 32 * w + q;
    const bf16* qrow = QK + tq * 2048 + hh * 64;
    bf16x8 qf[4];
#pragma unroll
    for (int d0 = 0; d0 < 4; ++d0) qf[d0] = *(const bf16x8*)(qrow + d0 * 16 + 8 * h);
    unsigned sel = 0;
    if (nb > 0) {
        float gsc[7];
#pragma unroll
        for (int m = 0; m < 7; ++m) { float s = 0.f;
            if (m < nb) { const float* kmp = km + (((size_t)b * NH + hh) * 8 + m) * 64;
#pragma unroll
                for (int d0 = 0; d0 < 4; ++d0) { const f32x4 k0 = *(const f32x4*)(kmp + d0 * 16 + 8 * h), k1 = *(const f32x4*)(kmp + d0 * 16 + 8 * h + 4); const u32x4 qq = __builtin_bit_cast(u32x4, qf[d0]);
                    s += bflo(qq.x) * k0.x + bfhi(qq.x) * k0.y + bflo(qq.y) * k0.z + bfhi(qq.y) * k0.w + bflo(qq.z) * k1.x + bfhi(qq.z) * k1.y + bflo(qq.w) * k1.z + bfhi(qq.w) * k1.w; }
                s += __shfl_xor(s, 32); }
            gsc[m] = m < nb ? s : -3.0e38f; }
        const int nsel = nb < 3 ? nb : 3;
#pragma unroll
        for (int r = 0; r < 3; ++r) { if (r < nsel) { int bi = -1; float bv = -3.4e38f;
#pragma unroll
                for (int m = 0; m < 7; ++m) if (!((sel >> m) & 1u) && gsc[m] > bv) { bv = gsc[m]; bi = m; }
                sel |= 1u << bi; } }
    }
#ifdef MK_SELFCHECK
    if (h == 0) ((unsigned*)(F.ws + WS_NEED + 3 * MiB))[tq * 16 + hh] = sel;
#endif
    float m_run = NEGB, l_run = 0.f; f32x16 o0 = {}, o1 = {};
    const bf16* vbase0 = VT + ((size_t)hh * 64 + q) * T + (size_t)b * SEQ; const bf16* vbase1 = vbase0 + (size_t)32 * T;
    const int qpos = nb * 256 + 32 * w + q;
    for (int m = 0; m < nb; ++m) {
        const bool mine = (sel >> m) & 1u;
        if (__ballot(mine) == 0ull) continue;
        for (int kt = 0; kt < 8; ++kt) {
            const int kr0 = m * 256 + 32 * kt;
            const bf16* krow = QK + ((size_t)b * SEQ + kr0 + kperm(q)) * 2048 + 1024 + hh * 64;
            f32x16 s = {};
#pragma unroll
            for (int d0 = 0; d0 < 4; ++d0) { const bf16x8 kf = *(const bf16x8*)(krow + d0 * 16 + 8 * h); s = mfma32(kf, qf[d0], s); }
#pragma unroll
            for (int r = 0; r < 16; ++r) { const int kap = 16 * (r >> 3) + 8 * h + (r & 7); const float bb = bt[qpos - kr0 - kap]; s[r] = mine ? s[r] + bb : NEGB; }
            softmax_pv(s, m_run, l_run, o0, o1, vbase0 + kr0, vbase1 + kr0, h);
        }
    }
    for (int kt = 0; kt <= w; ++kt) {
        const int kr0 = nb * 256 + 32 * kt;
        const bf16* krow = QK + ((size_t)b * SEQ + kr0 + kperm(q)) * 2048 + 1024 + hh * 64;
        f32x16 s = {};
#pragma unroll
        for (int d0 = 0; d0 < 4; ++d0) { const bf16x8 kf = *(const bf16x8*)(krow + d0 * 16 + 8 * h); s = mfma32(kf, qf[d0], s); }
#pragma unroll
        for (int r = 0; r < 16; ++r) { const int kap = 16 * (r >> 3) + 8 * h + (r & 7); const int dd = qpos - kr0 - kap; const float bb = bt[dd < 0 ? 0 : dd]; s[r] = dd >= 0 ? s[r] + bb : NEGB; }
        softmax_pv(s, m_run, l_run, o0, o1, vbase0 + kr0, vbase1 + kr0, h);
    }
    const float l_tot = l_run + __shfl_xor(l_run, 32), inv = 1.f / l_tot;
#ifdef MK_SELFCHECK
    if (h == 0) ((float*)(F.ws + WS_NEED + 7 * MiB))[tq * 16 + hh] = m_run + __log2f(l_tot);
#endif
    bf16* op = att + tq * 1024 + hh * 64 + 4 * h;
#pragma unroll
    for (int gq = 0; gq < 4; ++gq) {
        u32x2 w0, w1; w0.x = pg8::cvt_pk_bf16(o0[4 * gq] * inv, o0[4 * gq + 1] * inv); w0.y = pg8::cvt_pk_bf16(o0[4 * gq + 2] * inv, o0[4 * gq + 3] * inv);
        w1.x = pg8::cvt_pk_bf16(o1[4 * gq] * inv, o1[4 * gq + 1] * inv); w1.y = pg8::cvt_pk_bf16(o1[4 * gq + 2] * inv, o1[4 * gq + 3] * inv);
        *(u32x2*)(op + 8 * gq) = w0; *(u32x2*)(op + 32 + 8 * gq) = w1; }
}
__device__ __forceinline__ void moba_phase(Frame& F) {
    LAS float* bt = (LAS float*)F.lds; int cur_h = -1;
    const int NP = NB * NH * 4, per = (NP + F.G - 1) / F.G;
    const int lo = F.vcu * per, hi = (lo + per) < NP ? (lo + per) : NP;
    for (int pu = lo; pu < hi; ++pu) { const int j = pu & 3, hh = (pu >> 2) & 15, b = pu >> 6;
        moba_unit(F, b, hh, 7 - j, bt, cur_h); moba_unit(F, b, hh, j, bt, cur_h); }
}


constexpr int AKP = 72;
constexpr int ATILE = 64 * AKP * 2;
struct AttnSt { float m, l; f32x16 o0, o1; };
template <bool MASKED>
__device__ __forceinline__ void attn_tile(const LAS bf16* Kt, const LAS bf16* Vt, const LAS float* bl, const bf16x8 (&qf)[4], AttnSt& st, int q, int h, bool mine) {
    f32x16 s;
#pragma unroll
    for (int r = 0; r < 16; ++r) s[r] = bl[23 - 16 * (r >> 3) - (r & 7)];
    const LAS bf16* kr = Kt + kperm(q) * AKP + 8 * h;
#pragma unroll
    for (int d0 = 0; d0 < 4; ++d0) s = mfma32(*(const LAS bf16x8*)(kr + d0 * 16), qf[d0], s);
    float mx = max16(s); mx = fmaxf(mx, __shfl_xor(mx, 32));
    float mn = fmaxf(st.m, mx); if (MASKED) mn = mine ? mn : st.m;
    const float alpha = __builtin_amdgcn_exp2f(st.m - mn);
    float ps = 0.f;
#pragma unroll
    for (int r = 0; r < 16; ++r) { const float p = __builtin_amdgcn_exp2f(s[r] - mn); s[r] = p; ps += p; }
    bf16x8 p0 = pack8(s, 0), p1 = pack8(s, 8);
    if (MASKED) { if (!mine) { p0 = (bf16x8){0, 0, 0, 0, 0, 0, 0, 0}; p1 = p0; ps = 0.f; } }
    st.l = st.l * alpha + ps; st.m = mn;
    if (__ballot(alpha != 1.0f) != 0ull) {
#pragma unroll
        for (int r = 0; r < 16; ++r) { st.o0[r] *= alpha; st.o1[r] *= alpha; } }
    const LAS bf16* v0 = Vt + q * AKP + 8 * h; const LAS bf16* v1 = v0 + 32 * AKP;
    st.o0 = mfma32(*(const LAS bf16x8*)v0, p0, st.o0); st.o0 = mfma32(*(const LAS bf16x8*)(v0 + 16), p1, st.o0);
    st.o1 = mfma32(*(const LAS bf16x8*)v1, p0, st.o1); st.o1 = mfma32(*(const LAS bf16x8*)(v1 + 16), p1, st.o1);
}
__device__ __forceinline__ void attn_store(const AttnSt& st, bf16* op  , float inv) {
#pragma unroll
    for (int gq = 0; gq < 4; ++gq) {
        u32x2 w0, w1; w0.x = pg8::cvt_pk_bf16(st.o0[4 * gq] * inv, st.o0[4 * gq + 1] * inv); w0.y = pg8::cvt_pk_bf16(st.o0[4 * gq + 2] * inv, st.o0[4 * gq + 3] * inv);
        w1.x = pg8::cvt_pk_bf16(st.o1[4 * gq] * inv, st.o1[4 * gq + 1] * inv); w1.y = pg8::cvt_pk_bf16(st.o1[4 * gq + 2] * inv, st.o1[4 * gq + 3] * inv);
        *(u32x2*)(op + 8 * gq) = w0; *(u32x2*)(op + 32 + 8 * gq) = w1; }
}

__device__ __forceinline__ void attn_store8(const AttnSt& st, unsigned char* op  , float inv) {
#pragma unroll
    for (int gq = 0; gq < 4; ++gq) {
        *(unsigned*)(op + 8 * gq) = pk4_fp8(st.o0[4 * gq] * inv, st.o0[4 * gq + 1] * inv, st.o0[4 * gq + 2] * inv, st.o0[4 * gq + 3] * inv);
        *(unsigned*)(op + 32 + 8 * gq) = pk4_fp8(st.o1[4 * gq] * inv, st.o1[4 * gq + 1] * inv, st.o1[4 * gq + 2] * inv, st.o1[4 * gq + 3] * inv); }
}

__device__ __forceinline__ void dil_attn_phase2(Frame& F) {
    LAS float* bt = (LAS float*)F.lds;
    { const float* btA = (const float*)(F.ws + WS_BTABA); for (int i = F.tid; i < 48 * 192; i += 512) { const int gh = i / 192, dl = i % 192 - 32; bt[i] = (dl >= 0 && dl <= 128) ? btA[gh * 132 + dl] : NEGB; } }
    __syncthreads();
    constexpr int TBL = 48 * 192 * 4;
    const int lane = F.lane, q = lane & 31, h = lane >> 5, w = F.wave, uw = w >> 2, qt = w & 3, t = F.tid, tu = t >> 8, tt = t & 255, srow = tt >> 3, sch = tt & 7;
    const bf16* QK = (const bf16*)(F.ws + WS_SCR + S_QK); const bf16* VT = (const bf16*)(F.ws + WS_SCR + S_VT);
    bf16* OG = (bf16*)((unsigned char*)F.out + O_OG); float* LSE = (float*)((unsigned char*)F.out + O_LSE);
    for (int du = F.vcu; du < 3072; du += F.G) {
        const int g = du >> 10, rem = du & 1023, hh = rem >> 6, blp = (rem >> 4) & 3, rn = rem & 15, gh = g * 16 + hh;
        const int nblk = 16 >> (2 * g); const bool has_prev = (rn & (nblk - 1)) != 0;
        const int j0 = has_prev ? 0 : 2;
        const int n0s = (2 * blp + tu) * 2048 + rn * 128;
        const bf16* ksrc = QK + ((size_t)g * TC + n0s - 128 + srow) * 2048 + 1024 + hh * 64 + sch * 8;
        const bf16* vsrc = VT + ((size_t)g * 1024 + hh * 64 + srow) * TC + (n0s - 128) + sch * 8;
        const int sdst = srow * AKP + sch * 8;
        const int n0 = (2 * blp + uw) * 2048 + rn * 128;
        const bf16* qrow = QK + ((size_t)g * TC + n0 + 32 * qt + q) * 2048 + hh * 64;
        bf16x8 qf[4];
#pragma unroll
        for (int d0 = 0; d0 < 4; ++d0) qf[d0] = *(const bf16x8*)(qrow + d0 * 16 + 8 * h);
        AttnSt st; st.m = NEGB; st.l = 0.f; st.o0 = (f32x16){}; st.o1 = (f32x16){};
        u32x4 k0, k1, v0, v1;
        k0 = *(const u32x4*)(ksrc + (size_t)(64 * j0) * 2048); k1 = *(const u32x4*)(ksrc + (size_t)(64 * j0 + 32) * 2048);
        v0 = *(const u32x4*)(vsrc + 64 * j0); v1 = *(const u32x4*)(vsrc + (size_t)32 * TC + 64 * j0);
        { LAS bf16* kb = (LAS bf16*)(F.lds + TBL + (0 * 2 + tu) * 2 * ATILE); LAS bf16* vb = kb + 64 * AKP;
          *(LAS u32x4*)(kb + sdst) = k0; *(LAS u32x4*)(kb + 32 * AKP + sdst) = k1; *(LAS u32x4*)(vb + sdst) = v0; *(LAS u32x4*)(vb + 32 * AKP + sdst) = v1; }
        __syncthreads();
        int pb = 0;
        for (int j = j0; j < 4; ++j) {
            const bool more = j + 1 < 4;
            if (more) { k0 = *(const u32x4*)(ksrc + (size_t)(64 * (j + 1)) * 2048); k1 = *(const u32x4*)(ksrc + (size_t)(64 * (j + 1) + 32) * 2048);
                        v0 = *(const u32x4*)(vsrc + 64 * (j + 1)); v1 = *(const u32x4*)(vsrc + (size_t)32 * TC + 64 * (j + 1)); }
            const LAS bf16* kb = (const LAS bf16*)(F.lds + TBL + (pb * 2 + uw) * 2 * ATILE); const LAS bf16* vb = kb + 64 * AKP;
#pragma unroll
            for (int t2 = 0; t2 < 2; ++t2) { const int t32 = 2 * j + t2;
                if (t32 >= qt && t32 <= qt + 4) {
                    const LAS float* bl = bt + gh * 192 + 32 + (32 * qt + q + 128 - 32 * t32 - 8 * h - 23);
                    attn_tile<false>(kb + 32 * t2 * AKP, vb + 32 * t2, bl, qf, st, q, h, true); } }
            if (more) { LAS bf16* kn = (LAS bf16*)(F.lds + TBL + ((pb ^ 1) * 2 + tu) * 2 * ATILE); LAS bf16* vn = kn + 64 * AKP;
                *(LAS u32x4*)(kn + sdst) = k0; *(LAS u32x4*)(kn + 32 * AKP + sdst) = k1; *(LAS u32x4*)(vn + sdst) = v0; *(LAS u32x4*)(vn + 32 * AKP + sdst) = v1; }
            __syncthreads();
            pb ^= 1;
        }
        const float l_tot = st.l + __shfl_xor(st.l, 32), inv = 1.f / l_tot;
        const size_t orow = (size_t)g * TC + n0 + 32 * qt + q;
        attn_store(st, OG + orow * 1024 + hh * 64 + 4 * h, inv);
        if (h == 0) LSE[orow * 16 + hh] = st.m + __log2f(l_tot);
    }
}

__device__ __forceinline__ void moba_unit2(Frame& F, int b, int hh, int nb, LAS float* bt, int& cur_h) {
    constexpr int TBL = 8448;
    const int lane = F.lane, q = lane & 31, h = lane >> 5, w = F.wave, t = F.tid, srow = t >> 3, sch = t & 7;
    const bf16* QK = (const bf16*)(F.ws + WS_SCR + S_CQK); const bf16* VT = (const bf16*)(F.ws + WS_SCR + S_CVT);
    bf16* att = (bf16*)(F.ws + WS_SCR + S_CATT); const float* km = (const float*)(F.ws + WS_KMEAN);
    if (hh != cur_h) { __syncthreads(); const float* btC = (const float*)(F.ws + WS_BTABC) + hh * 2048; for (int i = t; i < 2048 + 32; i += 512) bt[i] = i < 32 ? NEGB : btC[i - 32]; cur_h = hh; __syncthreads(); }
    const size_t tq = (size_t)b * SEQ + nb * 256 + 32 * w + q;
    const bf16* qrow = QK + tq * 2048 + hh * 64;
    bf16x8 qf[4];
#pragma unroll
    for (int d0 = 0; d0 < 4; ++d0) qf[d0] = *(const bf16x8*)(qrow + d0 * 16 + 8 * h);
    unsigned sel = 0;
    if (nb > 0) {
        float gsc[7];
#pragma unroll
        for (int m = 0; m < 7; ++m) { float s = 0.f;
            if (m < nb) { const float* kmp = km + (((size_t)b * NH + hh) * 8 + m) * 64;
#pragma unroll
                for (int d0 = 0; d0 < 4; ++d0) { const f32x4 k0 = *(const f32x4*)(kmp + d0 * 16 + 8 * h), k1 = *(const f32x4*)(kmp + d0 * 16 + 8 * h + 4); const u32x4 qq = __builtin_bit_cast(u32x4, qf[d0]);
                    s += bflo(qq.x) * k0.x + bfhi(qq.x) * k0.y + bflo(qq.y) * k0.z + bfhi(qq.y) * k0.w + bflo(qq.z) * k1.x + bfhi(qq.z) * k1.y + bflo(qq.w) * k1.z + bfhi(qq.w) * k1.w; }
                s += __shfl_xor(s, 32); }
            gsc[m] = m < nb ? s : -3.0e38f; }
        const int nsel = nb < 3 ? nb : 3;
#pragma unroll
        for (int r = 0; r < 3; ++r) { if (r < nsel) { int bi = 0; float bv = -3.4e38f;
#pragma unroll
                for (int m = 0; m < 7; ++m) if (!((sel >> m) & 1u) && gsc[m] > bv) { bv = gsc[m]; bi = m; }
                sel |= 1u << bi; } }
    }
    AttnSt st; st.m = NEGB; st.l = 0.f; st.o0 = (f32x16){}; st.o1 = (f32x16){};
    const int qpos = nb * 256 + 32 * w + q, nsteps = 4 * nb + 4;
    const bf16* ksrc = QK + ((size_t)b * SEQ + srow) * 2048 + 1024 + hh * 64 + sch * 8;
    const bf16* vsrc = VT + ((size_t)hh * 64 + srow) * T + (size_t)b * SEQ + sch * 8;
    const int sdst = srow * AKP + sch * 8;
    u32x4 kreg = *(const u32x4*)ksrc, vreg = *(const u32x4*)vsrc;
    { LAS bf16* kb = (LAS bf16*)(F.lds + TBL); *(LAS u32x4*)(kb + sdst) = kreg; *(LAS u32x4*)(kb + 64 * AKP + sdst) = vreg; }
    __syncthreads();
    int pb = 0;
    for (int s = 0; s < nsteps; ++s) {
        const bool more = s + 1 < nsteps;
        if (more) { kreg = *(const u32x4*)(ksrc + (size_t)(64 * (s + 1)) * 2048); vreg = *(const u32x4*)(vsrc + 64 * (s + 1)); }
        const LAS bf16* kb = (const LAS bf16*)(F.lds + TBL + pb * 2 * ATILE); const LAS bf16* vb = kb + 64 * AKP;
        if (s < 4 * nb) {
            const bool mine = (sel >> (s >> 2)) & 1u;
            if (__ballot(mine) != 0ull) {
#pragma unroll
                for (int t2 = 0; t2 < 2; ++t2) { const LAS float* bl = bt + 32 + (qpos - 8 * h - (64 * s + 32 * t2) - 23);
                    attn_tile<true>(kb + 32 * t2 * AKP, vb + 32 * t2, bl, qf, st, q, h, mine); } }
        } else {
#pragma unroll
            for (int t2 = 0; t2 < 2; ++t2) { const int t32 = (s - 4 * nb) * 2 + t2;
                if (t32 <= w) { const LAS float* bl = bt + 32 + (qpos - 8 * h - (64 * s + 32 * t2) - 23);
                    attn_tile<false>(kb + 32 * t2 * AKP, vb + 32 * t2, bl, qf, st, q, h, true); } }
        }
        if (more) { LAS bf16* kn = (LAS bf16*)(F.lds + TBL + (pb ^ 1) * 2 * ATILE); *(LAS u32x4*)(kn + sdst) = kreg; *(LAS u32x4*)(kn + 64 * AKP + sdst) = vreg; }
        __syncthreads();
        pb ^= 1;
    }
    const float l_tot = st.l + __shfl_xor(st.l, 32), inv = 1.f / l_tot;
    attn_store(st, att + tq * 1024 + hh * 64 + 4 * h, inv);
}
__device__ __forceinline__ void moba_phase2(Frame& F) {
    LAS float* bt = (LAS float*)F.lds; int cur_h = -1;
    const int NP = NB * NH * 4, per = (NP + F.G - 1) / F.G;
    const int lo = F.vcu * per, hi = (lo + per) < NP ? (lo + per) : NP;
    for (int pu = lo; pu < hi; ++pu) { const int j = pu & 3, hh = (pu >> 2) & 15, b = pu >> 6;
        moba_unit2(F, b, hh, 7 - j, bt, cur_h); moba_unit2(F, b, hh, j, bt, cur_h); }
}


__device__ __forceinline__ float xhalf_max(float m) { auto rr = __builtin_amdgcn_permlane32_swap(__float_as_uint(m), __float_as_uint(m), false, false); return fmaxf(__uint_as_float(rr[0]), __uint_as_float(rr[1])); }
__device__ __forceinline__ float xhalf_sum(float m) { auto rr = __builtin_amdgcn_permlane32_swap(__float_as_uint(m), __float_as_uint(m), false, false); return __uint_as_float(rr[0]) + __uint_as_float(rr[1]); }
template <bool MASKED>
__device__ __forceinline__ void attn_tile2(const LAS bf16* Kt, const LAS bf16* Vt, const LAS float* bl0, const bf16x8 (&qf)[4], AttnSt& st, int q, int h, bool mine) {
    f32x16 s0, s1;
#pragma unroll
    for (int r = 0; r < 16; ++r) { s0[r] = bl0[23 - 16 * (r >> 3) - (r & 7)]; s1[r] = bl0[-32 + 23 - 16 * (r >> 3) - (r & 7)]; }
    const LAS bf16* kr = Kt + kperm(q) * AKP + 8 * h;
#pragma unroll
    for (int d0 = 0; d0 < 4; ++d0) { s0 = mfma32(*(const LAS bf16x8*)(kr + d0 * 16), qf[d0], s0); s1 = mfma32(*(const LAS bf16x8*)(kr + 32 * AKP + d0 * 16), qf[d0], s1); }
    const float mx = xhalf_max(fmaxf(max16(s0), max16(s1)));
    float mn = fmaxf(st.m, mx); if (MASKED) mn = mine ? mn : st.m;
    const float alpha = __builtin_amdgcn_exp2f(st.m - mn);
    float ps0 = 0.f, ps1 = 0.f;
#pragma unroll
    for (int r = 0; r < 16; ++r) { const float p = __builtin_amdgcn_exp2f(s0[r] - mn); s0[r] = p; ps0 += p; const float p2 = __builtin_amdgcn_exp2f(s1[r] - mn); s1[r] = p2; ps1 += p2; }
    bf16x8 p00 = pack8(s0, 0), p01 = pack8(s0, 8), p10 = pack8(s1, 0), p11 = pack8(s1, 8);
    float ps = ps0 + ps1;
    if (MASKED) { if (!mine) { p00 = (bf16x8){0, 0, 0, 0, 0, 0, 0, 0}; p01 = p00; p10 = p00; p11 = p00; ps = 0.f; } }
    st.l = st.l * alpha + ps; st.m = mn;
    if (__ballot(alpha != 1.0f) != 0ull) {
#pragma unroll
        for (int r = 0; r < 16; ++r) { st.o0[r] *= alpha; st.o1[r] *= alpha; } }
    const LAS bf16* v0 = Vt + q * AKP + 8 * h; const LAS bf16* v1 = v0 + 32 * AKP;
    st.o0 = mfma32(*(const LAS bf16x8*)v0, p00, st.o0); st.o1 = mfma32(*(const LAS bf16x8*)v1, p00, st.o1);
    st.o0 = mfma32(*(const LAS bf16x8*)(v0 + 16), p01, st.o0); st.o1 = mfma32(*(const LAS bf16x8*)(v1 + 16), p01, st.o1);
    st.o0 = mfma32(*(const LAS bf16x8*)(v0 + 32), p10, st.o0); st.o1 = mfma32(*(const LAS bf16x8*)(v1 + 32), p10, st.o1);
    st.o0 = mfma32(*(const LAS bf16x8*)(v0 + 48), p11, st.o0); st.o1 = mfma32(*(const LAS bf16x8*)(v1 + 48), p11, st.o1);
}

__device__ __forceinline__ void dil_attn_phase3(Frame& F) {
    LAS float* bt = (LAS float*)F.lds;
    { const float* btA = (const float*)(F.ws + WS_BTABA); for (int i = F.tid; i < 48 * 192; i += 512) { const int gh = i / 192, dl = i % 192 - 32; bt[i] = (dl >= 0 && dl <= 128) ? btA[gh * 132 + dl] : NEGB; } }
    constexpr int TBL = 48 * 192 * 4;
    const int lane = F.lane, q = lane & 31, h = lane >> 5, w = F.wave, uw = w >> 2, qt = w & 3, t = F.tid, tu = t >> 8, tt = t & 255, srow = tt >> 3, sch = tt & 7;
    const bf16* QK = (const bf16*)(F.ws + WS_SCR + S_QK); const bf16* VT = (const bf16*)(F.ws + WS_SCR + S_VT);
    bf16* OG = (bf16*)((unsigned char*)F.out + O_OG); float* LSE = (float*)((unsigned char*)F.out + O_LSE);
    const int sdst = srow * AKP + sch * 8;
    int du = F.vcu;
    if (du >= 3072) { __syncthreads(); return; }
    int g = du >> 10, hh = (du >> 6) & 15, blp = (du >> 4) & 3, rn = du & 15;
    int j = ((rn & ((16 >> (2 * g)) - 1)) != 0) ? 0 : 2;
    u32x4 k0, k1, v0, v1; bf16x8 qn[4], qf[4];
#define DIL_LOADS(G_, HH_, BLP_, RN_, J_) do { const int n0s_ = (2 * (BLP_) + tu) * 2048 + (RN_) * 128 - 128 + 64 * (J_); \
        const bf16* ks_ = QK + ((size_t)(G_) * TC + n0s_ + srow) * 2048 + 1024 + (HH_) * 64 + sch * 8; \
        const bf16* vs_ = VT + ((size_t)(G_) * 1024 + (HH_) * 64 + srow) * TC + n0s_ + sch * 8; \
        k0 = *(const u32x4*)ks_; k1 = *(const u32x4*)(ks_ + (size_t)32 * 2048); v0 = *(const u32x4*)vs_; v1 = *(const u32x4*)(vs_ + (size_t)32 * TC); } while (0)
#define DIL_QLOADS(G_, HH_, BLP_, RN_) do { const bf16* qr_ = QK + ((size_t)(G_) * TC + (2 * (BLP_) + uw) * 2048 + (RN_) * 128 + 32 * qt + q) * 2048 + (HH_) * 64; \
        _Pragma("unroll") for (int d0 = 0; d0 < 4; ++d0) qn[d0] = *(const bf16x8*)(qr_ + d0 * 16 + 8 * h); } while (0)
#define DIL_WRITE(PB_) do { LAS bf16* kb_ = (LAS bf16*)(F.lds + TBL + ((PB_) * 2 + tu) * 2 * ATILE); LAS bf16* vb_ = kb_ + 64 * AKP; \
        *(LAS u32x4*)(kb_ + sdst) = k0; *(LAS u32x4*)(kb_ + 32 * AKP + sdst) = k1; *(LAS u32x4*)(vb_ + sdst) = v0; *(LAS u32x4*)(vb_ + 32 * AKP + sdst) = v1; } while (0)
    DIL_LOADS(g, hh, blp, rn, j); DIL_QLOADS(g, hh, blp, rn);
    DIL_WRITE(0);
#pragma unroll
    for (int d0 = 0; d0 < 4; ++d0) qf[d0] = qn[d0];
    __syncthreads();
    AttnSt st; st.m = NEGB; st.l = 0.f; st.o0 = (f32x16){}; st.o1 = (f32x16){};
    int pb = 0;
    for (;;) {
        const bool last = (j == 3);
        int ng = g, nhh = hh, nblp = blp, nrn = rn, nj = j + 1; bool more = true;
        if (last) { const int nd = du + F.G; more = nd < 3072; ng = nd >> 10; nhh = (nd >> 6) & 15; nblp = (nd >> 4) & 3; nrn = nd & 15; nj = ((nrn & ((16 >> (2 * ng)) - 1)) != 0) ? 0 : 2; }
        if (more) { DIL_LOADS(ng, nhh, nblp, nrn, nj); if (last) DIL_QLOADS(ng, nhh, nblp, nrn); }
        { const LAS bf16* kb = (const LAS bf16*)(F.lds + TBL + (pb * 2 + uw) * 2 * ATILE); const LAS bf16* vb = kb + 64 * AKP;
          const int gh = g * 16 + hh, ta = 2 * j, tb = 2 * j + 1;
          const bool a_on = ta >= qt && ta <= qt + 4, b_on = tb >= qt && tb <= qt + 4;
          const LAS float* bl = bt + gh * 192 + 32 + (32 * qt + q + 128 - 32 * ta - 8 * h - 23);
          if (a_on && b_on) attn_tile2<false>(kb, vb, bl, qf, st, q, h, true);
          else if (a_on) attn_tile<false>(kb, vb, bl, qf, st, q, h, true);
          else if (b_on) attn_tile<false>(kb + 32 * AKP, vb + 32, bl - 32, qf, st, q, h, true); }
        if (more) DIL_WRITE(pb ^ 1);
        if (last) {
            const float l_tot = xhalf_sum(st.l), inv = 1.f / l_tot;
            const size_t orow = (size_t)g * TC + (2 * blp + uw) * 2048 + rn * 128 + 32 * qt + q;
            attn_store8(st, (unsigned char*)OG + orow * 1024 + hh * 64 + 4 * h, inv * ASCALE8);
            if (h == 0) LSE[orow * 16 + hh] = st.m + __log2f(l_tot);
            st.m = NEGB; st.l = 0.f; st.o0 = (f32x16){}; st.o1 = (f32x16){};
#pragma unroll
            for (int d0 = 0; d0 < 4; ++d0) qf[d0] = qn[d0];
        }
        __syncthreads();
        pb ^= 1;
        if (!more) break;
        if (last) du += F.G;
        g = ng; hh = nhh; blp = nblp; rn = nrn; j = nj;
    }
#undef DIL_LOADS
#undef DIL_QLOADS
#undef DIL_WRITE
}

__device__ __forceinline__ void moba_phase3(Frame& F) {
    constexpr int TBL = 8448, KMO = TBL + 4 * ATILE;
    LAS float* bt = (LAS float*)F.lds; LAS float* kml = (LAS float*)(F.lds + KMO);
    const int lane = F.lane, q = lane & 31, h = lane >> 5, w = F.wave, t = F.tid, srow = t >> 3, sch = t & 7;
    const bf16* QK = (const bf16*)(F.ws + WS_SCR + S_CQK); const bf16* VT = (const bf16*)(F.ws + WS_SCR + S_CVT);
    bf16* att = (bf16*)(F.ws + WS_SCR + S_CATT); const float* km = (const float*)(F.ws + WS_KMEAN);
    const int NP = NB * NH * 4, per = (NP + F.G - 1) / F.G;
    const int lo = F.vcu * per, hi = (lo + per) < NP ? (lo + per) : NP;
    const int nunits = 2 * (hi - lo);
    if (nunits <= 0) return;
    const int sdst = srow * AKP + sch * 8;
    int u = 0, cur_bh = -1;
    u32x4 kreg, vreg; bf16x8 qn[4], qf[4];
#define MB_LOADS(B_, HH_, S_) do { const bf16* ks_ = QK + ((size_t)(B_) * SEQ + 64 * (S_) + srow) * 2048 + 1024 + (HH_) * 64 + sch * 8; \
        const bf16* vs_ = VT + ((size_t)(HH_) * 64 + srow) * T + (size_t)(B_) * SEQ + 64 * (S_) + sch * 8; kreg = *(const u32x4*)ks_; vreg = *(const u32x4*)vs_; } while (0)
#define MB_QLOADS(B_, HH_, NB_) do { const bf16* qr_ = QK + ((size_t)(B_) * SEQ + (NB_) * 256 + 32 * w + q) * 2048 + (HH_) * 64; \
        _Pragma("unroll") for (int d0 = 0; d0 < 4; ++d0) qn[d0] = *(const bf16x8*)(qr_ + d0 * 16 + 8 * h); } while (0)
#define MB_WRITE(PB_) do { LAS bf16* kb_ = (LAS bf16*)(F.lds + TBL + (PB_) * 2 * ATILE); *(LAS u32x4*)(kb_ + sdst) = kreg; *(LAS u32x4*)(kb_ + 64 * AKP + sdst) = vreg; } while (0)
    int pu = lo, jj = pu & 3, hh = (pu >> 2) & 15, b = pu >> 6, nb = 7 - jj, s = 0, pb = 0;
    MB_LOADS(b, hh, 0); MB_QLOADS(b, hh, nb); MB_WRITE(0);
    unsigned sel = 0; bool fresh = true;
    AttnSt st; st.m = NEGB; st.l = 0.f; st.o0 = (f32x16){}; st.o1 = (f32x16){};
    for (;;) {
        if (fresh) {
            if (b * 16 + hh != cur_bh) { __syncthreads(); const float* btC = (const float*)(F.ws + WS_BTABC) + hh * 2048;
                for (int i = t; i < 2048 + 32; i += 512) bt[i] = i < 32 ? NEGB : btC[i - 32];
                { const float* kmp = km + ((size_t)b * NH + hh) * 512; kml[t] = kmp[t]; }
                cur_bh = b * 16 + hh; }
#pragma unroll
            for (int d0 = 0; d0 < 4; ++d0) qf[d0] = qn[d0];
            __syncthreads();
            sel = 0;
            if (nb > 0) {
                float gsc[7];
#pragma unroll
                for (int m = 0; m < 7; ++m) { float sc = 0.f;
                    if (m < nb) {
#pragma unroll
                        for (int d0 = 0; d0 < 4; ++d0) { const f32x4 c0 = *(const LAS f32x4*)(kml + m * 64 + d0 * 16 + 8 * h), c1 = *(const LAS f32x4*)(kml + m * 64 + d0 * 16 + 8 * h + 4); const u32x4 qq = __builtin_bit_cast(u32x4, qf[d0]);
                            sc += bflo(qq.x) * c0.x + bfhi(qq.x) * c0.y + bflo(qq.y) * c0.z + bfhi(qq.y) * c0.w + bflo(qq.z) * c1.x + bfhi(qq.z) * c1.y + bflo(qq.w) * c1.z + bfhi(qq.w) * c1.w; }
                        sc = xhalf_sum(sc); }
                    gsc[m] = m < nb ? sc : -3.0e38f; }
                const int nsel = nb < 3 ? nb : 3;
#pragma unroll
                for (int r = 0; r < 3; ++r) { if (r < nsel) { int bi = 0; float bv = -3.4e38f;
#pragma unroll
                        for (int m = 0; m < 7; ++m) if (!((sel >> m) & 1u) && gsc[m] > bv) { bv = gsc[m]; bi = m; }
                        sel |= 1u << bi; } }
            }
            fresh = false;
        }
        const int nsteps = 4 * nb + 4;
        const bool last = (s + 1 == nsteps);
        int nb2 = nb, b2 = b, hh2 = hh, s2 = s + 1; bool more = true;
        if (last) { const int u2 = u + 1; more = u2 < nunits; const int pu2 = lo + (u2 >> 1), j2 = pu2 & 3; hh2 = (pu2 >> 2) & 15; b2 = pu2 >> 6; nb2 = (u2 & 1) ? j2 : 7 - j2; s2 = 0; }
        if (more) { MB_LOADS(b2, hh2, s2); if (last) MB_QLOADS(b2, hh2, nb2); }
        { const LAS bf16* kb = (const LAS bf16*)(F.lds + TBL + pb * 2 * ATILE); const LAS bf16* vb = kb + 64 * AKP;
          const int qpos = nb * 256 + 32 * w + q;
          const LAS float* bl = bt + 32 + (qpos - 8 * h - 64 * s - 23);
          if (s < 4 * nb) { const bool mine = (sel >> (s >> 2)) & 1u;
              if (__ballot(mine) != 0ull) attn_tile2<true>(kb, vb, bl, qf, st, q, h, mine); }
          else { const int ta = (s - 4 * nb) * 2;
              if (ta + 1 <= w) attn_tile2<false>(kb, vb, bl, qf, st, q, h, true);
              else if (ta <= w) attn_tile<false>(kb, vb, bl, qf, st, q, h, true); } }
        if (more) MB_WRITE(pb ^ 1);
        if (last) {
            const float l_tot = xhalf_sum(st.l), inv = 1.f / l_tot;
            const size_t tq = (size_t)b * SEQ + nb * 256 + 32 * w + q;
            attn_store8(st, (unsigned char*)att + tq * 1024 + hh * 64 + 4 * h, inv * ASCALE8);
            st.m = NEGB; st.l = 0.f; st.o0 = (f32x16){}; st.o1 = (f32x16){};
        }
        if (!last) __syncthreads();
        pb ^= 1;
        if (!more) break;
        if (last) { ++u; fresh = true; }
        nb = nb2; b = b2; hh = hh2; s = s2;
    }
#undef MB_LOADS
#undef MB_QLOADS
#undef MB_WRITE
}

__device__ __forceinline__ void gmlp_phase(Frame& F, const float* lng, const float* lnb, const float* bs) {
    const int lane = F.lane, w = F.wave, q = lane & 31, h = lane >> 5;
    const bf16* uv = (const bf16*)(F.ws + WS_SCR + S_UV); bf16* p = (bf16*)(F.ws + WS_SCR + S_P); const bf16* wst = (const bf16*)(F.ws + WS_WST);
    LAS float* stat = (LAS float*)F.lds;
    LAS bf16* vnT = (LAS bf16*)(F.lds + 1024);
    constexpr int VP = 136;
    for (int unit = F.vcu; unit < T / 128; unit += F.G) {
        const size_t t0 = (size_t)unit * 128;
        __syncthreads();
        for (int i = 0; i < 16; ++i) { const int r = w * 16 + i; const u32x4* vr = (const u32x4*)(uv + (t0 + r) * 2048 + 1024) + lane;
            const u32x4 a = vr[0], b = vr[64]; float x[16];
            x[0] = bflo(a.x); x[1] = bfhi(a.x); x[2] = bflo(a.y); x[3] = bfhi(a.y); x[4] = bflo(a.z); x[5] = bfhi(a.z); x[6] = bflo(a.w); x[7] = bfhi(a.w);
            x[8] = bflo(b.x); x[9] = bfhi(b.x); x[10] = bflo(b.y); x[11] = bfhi(b.y); x[12] = bflo(b.z); x[13] = bfhi(b.z); x[14] = bflo(b.w); x[15] = bfhi(b.w);
            float s = 0.f;
#pragma unroll
            for (int j = 0; j < 16; ++j) s += x[j];
            const float mean = wave_sum(s) * (1.f / 1024.f); float s2 = 0.f;
#pragma unroll
            for (int j = 0; j < 16; ++j) { const float d = x[j] - mean; s2 += d * d; }
            const float rstd = 1.f / sqrtf(wave_sum(s2) * (1.f / 1024.f) + LN_EPS);
            if (lane == 0) { stat[2 * r] = mean; stat[2 * r + 1] = rstd; } }
        __syncthreads();
        for (int gg = 0; gg < 8; ++gg) {
#pragma unroll
            for (int k = 0; k < 4; ++k) { const int id = F.tid + 512 * k, s = id >> 4, cc = (id & 15) * 8;
                const u32x4 a = *(const u32x4*)(uv + (t0 + s) * 2048 + 1024 + gg * 128 + cc); const float mean = stat[2 * s], rstd = stat[2 * s + 1];
                float x[8]; x[0] = bflo(a.x); x[1] = bfhi(a.x); x[2] = bflo(a.y); x[3] = bfhi(a.y); x[4] = bflo(a.z); x[5] = bfhi(a.z); x[6] = bflo(a.w); x[7] = bfhi(a.w);
#pragma unroll
                for (int j = 0; j < 8; ++j) { const int c = gg * 128 + cc + j; const float y = (x[j] - mean) * rstd * lng[c] + lnb[c]; vnT[(cc + j) * VP + s] = (bf16)f2bf(y); } }
            __syncthreads();
            const int cr = 32 * (w & 3), tc0 = 64 * (w >> 2);
            f32x16 acc0 = {}, acc1 = {};
#pragma unroll
            for (int ks = 0; ks < 8; ++ks) {
                const bf16x8 af = *(const LAS bf16x8*)(vnT + (cr + q) * VP + ks * 16 + 8 * h);
                const bf16x8 b0 = *(const bf16x8*)(wst + ((size_t)gg * 128 + tc0 + q) * 128 + ks * 16 + 8 * h);
                const bf16x8 b1 = *(const bf16x8*)(wst + ((size_t)gg * 128 + tc0 + 32 + q) * 128 + ks * 16 + 8 * h);
                acc0 = mfma32(af, b0, acc0); acc1 = mfma32(af, b1, acc1);
            }
#pragma unroll
            for (int tt = 0; tt < 2; ++tt) { const f32x16& ac = tt == 0 ? acc0 : acc1; const int tl = tc0 + 32 * tt + q; const float bsv = bs[gg * 128 + tl];
                const size_t rowu = (t0 + tl) * 2048, rowp = (t0 + tl) * 1024;
#pragma unroll
                for (int gq = 0; gq < 4; ++gq) { const int c = gg * 128 + cr + 8 * gq + 4 * h; const u32x2 uu = *(const u32x2*)(uv + rowu + c);
                    u32x2 o; o.x = pk2(bflo(uu.x) * (ac[4 * gq] + bsv), bfhi(uu.x) * (ac[4 * gq + 1] + bsv)); o.y = pk2(bflo(uu.y) * (ac[4 * gq + 2] + bsv), bfhi(uu.y) * (ac[4 * gq + 3] + bsv));
                    *(u32x2*)(p + rowp + c) = o; } }
            __syncthreads();
        }
    }
}

struct MoeSeg { int ts[9]; };
__device__ __forceinline__ MoeSeg moe_seg(Frame& F, int moe_l) {
    MoeSeg s; int acc = 0;
#pragma unroll
    for (int e = 0; e < 8; ++e) { s.ts[e] = acc; const unsigned c = __hip_atomic_load((unsigned*)(F.ctl + CW_ECNT + 64 * moe_l + e), RLX_AGENT); acc += (int)((c + 255u) >> 8); }
    s.ts[8] = acc; return s;
}
__device__ __forceinline__ void moe_gather_phase(Frame& F, int moe_l) {
    LAS int* P = (LAS int*)F.lds;
    LAS int* wtot = (LAS int*)(F.lds + 65536);
    LAS int* tot = wtot + 64;
    const int* wcnt = (const int*)(F.ws + WS_WCNT);
    int t = F.tid; asm volatile("" : "+v"(t));
    const int lane = F.lane;
    int loc[4][8], sum[8], inc[8];
#pragma unroll
    for (int k = 0; k < 4; ++k) { const u32x4 a = *(const u32x4*)(wcnt + (4 * t + k) * 8), b = *(const u32x4*)(wcnt + (4 * t + k) * 8 + 4);
        loc[k][0] = (int)a.x; loc[k][1] = (int)a.y; loc[k][2] = (int)a.z; loc[k][3] = (int)a.w; loc[k][4] = (int)b.x; loc[k][5] = (int)b.y; loc[k][6] = (int)b.z; loc[k][7] = (int)b.w; }
#pragma unroll
    for (int e = 0; e < 8; ++e) { sum[e] = (loc[0][e] + loc[1][e]) + (loc[2][e] + loc[3][e]); inc[e] = sum[e]; }
#pragma unroll
    for (int off = 1; off < 64; off <<= 1) {
#pragma unroll
        for (int e = 0; e < 8; ++e) { const int v = __shfl_up(inc[e], off); if (lane >= off) inc[e] += v; } }
    if (lane == 63) {
#pragma unroll
        for (int e = 0; e < 8; ++e) wtot[F.wave * 8 + e] = inc[e]; }
    __syncthreads();
    int run[8];
#pragma unroll
    for (int e = 0; e < 8; ++e) { int wb = 0; for (int w = 0; w < F.wave; ++w) wb += wtot[w * 8 + e]; run[e] = wb + inc[e] - sum[e]; }
#pragma unroll
    for (int k = 0; k < 4; ++k) {
#pragma unroll
        for (int e = 0; e < 8; ++e) { P[(4 * t + k) * 8 + e] = run[e]; run[e] += loc[k][e]; } }
    if (t == 511) {
#pragma unroll
        for (int e = 0; e < 8; ++e) tot[e] = run[e]; }
    __syncthreads();
    MoeSeg sg; { int acc = 0;
#pragma unroll
        for (int e = 0; e < 8; ++e) { sg.ts[e] = acc; acc += (tot[e] + 255) >> 8; } sg.ts[8] = acc; }
    if (blockIdx.x == 0 && t < 8) __hip_atomic_store((unsigned*)(F.ctl + CW_ECNT + 64 * moe_l + t), (unsigned)tot[t], RLX_AGENT);
    const int gw = F.vcu * NWAVES + F.wave, NGW = F.G * NWAVES;
    const bf16* hb = (const bf16*)(F.ws + WS_HB); unsigned char* xg8 = (unsigned char*)F.out;
    const int* route = (const int*)(F.ws + WS_ROUTE); int* slots = (int*)(F.ws + WS_SLOTS);
    for (int m0 = 4 * gw; m0 < T; m0 += 4 * NGW) {
        int s1[4], s2[4]; u32x4 a[4], b[4];
#pragma unroll
        for (int k = 0; k < 4; ++k) { const int m = m0 + k, grp = m >> 5;
            const int e1 = route[4 * m], p1 = route[4 * m + 1], e2 = route[4 * m + 2], p2 = route[4 * m + 3];
            int ts1 = 0, ts2 = 0;
#pragma unroll
            for (int e = 0; e < 8; ++e) { ts1 = e == e1 ? sg.ts[e] : ts1; ts2 = e == e2 ? sg.ts[e] : ts2; }
            s1[k] = ts1 * 256 + P[grp * 8 + e1] + p1; s2[k] = ts2 * 256 + P[grp * 8 + e2] + p2;
            const u32x4* src = (const u32x4*)(hb + (size_t)m * D) + lane; a[k] = src[0]; b[k] = src[64]; }
#pragma unroll
        for (int k = 0; k < 4; ++k) { const int m = m0 + k;
            float x[16]; unpack8(a[k], x); unpack8(b[k], x + 8);
            u32x2 lo, hi; lo.x = pk4_fp8(x[0], x[1], x[2], x[3]); lo.y = pk4_fp8(x[4], x[5], x[6], x[7]); hi.x = pk4_fp8(x[8], x[9], x[10], x[11]); hi.y = pk4_fp8(x[12], x[13], x[14], x[15]);
            unsigned char* d1 = xg8 + (size_t)s1[k] * D + 8 * lane; unsigned char* d2 = xg8 + (size_t)s2[k] * D + 8 * lane;
            *(u32x2*)d1 = lo; *(u32x2*)(d1 + 512) = hi; *(u32x2*)d2 = lo; *(u32x2*)(d2 + 512) = hi;
            if (lane == 0) { slots[2 * m] = s1[k]; slots[2 * m + 1] = s2[k]; } }
    }
}
struct MoeOrder {
    int nM, nN, G, c, tile0; MoeSeg sg; const char* A0; const char* B0; size_t aT, bE, bT; bool a_local;
    bool out_local;
    __device__ __forceinline__ bool next(int i, pg8::Unit& u) const {
        int pm, pn; if (!pg8::tile_of((long)i * G + c, nM, nN, pm, pn)) return false;
        const int tile = tile0 + pm; int e = 0;
#pragma unroll
        for (int k = 1; k < 8; ++k) e += (tile >= sg.ts[k]) ? 1 : 0;
        u.pm = out_local ? pm : tile; u.pn = pn; u.a = (unsigned)((size_t)(a_local ? pm : tile) * aT); u.b = (unsigned)((size_t)e * bE + (size_t)pn * bT); return true;
    }
};


template <int GI> struct L0QKOrder { int G, c; const char* A0; const char* B0;
    __device__ __forceinline__ bool next(int i, pg8::Unit& u) const { if (!pg8::tile_of((long)i * G + c, 64, 8, u.pm, u.pn)) return false; const int pm = u.pm;
        const int tok = GI == 0 ? pm * 256 : (GI == 1 ? (pm >> 3) * 2048 + (pm & 1) * 1024 + ((pm >> 1) & 3) : (pm >> 3) * 2048 + (pm & 7) * 2);
        u.a = (unsigned)tok * 1024u; u.b = (unsigned)u.pn * 256u * 1024u; return true; } };
template <int GI> struct L0VtOrder { int G, c; const char* A0; const char* B0;
    __device__ __forceinline__ bool next(int i, pg8::Unit& u) const { if (!pg8::tile_of((long)i * G + c, 4, 64, u.pm, u.pn)) return false; const int pn = u.pn;
        const int tok = GI == 0 ? pn * 256 : (GI == 1 ? (pn >> 3) * 2048 + (pn & 1) * 1024 + ((pn >> 1) & 3) : (pn >> 3) * 2048 + (pn & 7) * 2);
        u.a = (unsigned)u.pm * 256u * 1024u; u.b = (unsigned)tok * 1024u; return true; } };
template <int GI> __device__ __forceinline__ void l0_gemms(Frame& F, int ck, int bx) {
    constexpr int rs = GI == 0 ? 1 : (GI == 1 ? 4 : 16);
    constexpr size_t hst = (GI == 0 ? (size_t)128 : (GI == 1 ? (size_t)512 : (size_t)1)) * 1024;
    const char* hbc = (const char*)(F.ws + WS_SCR + S_HB8) + (size_t)ck * TC * 1024;
    unsigned char* scr = F.ws + WS_SCR;
    { L0QKOrder<GI> S{F.G, bx, hbc, (const char*)(F.ws + W_A_QK) + (size_t)GI * 2048 * 1024};
      pg8::Gemm gm{512, rs, 1, hst, (size_t)128 * 1024};
      pg8::EpiBf16<0> E{(bf16*)(scr + S_QK) + (size_t)GI * TC * 2048, 2048, 1.f / WSCALE8};
      pg8::gemm_phase<pg8::EpiBf16<0>, L0QKOrder<GI>, false, 1>(F.lds, F.wave, gm, S, E); }
    { L0VtOrder<GI> S{F.G, bx, (const char*)(F.ws + W_A_V) + (size_t)GI * 1024 * 1024, hbc};
      pg8::Gemm gm{512, 1, rs, (size_t)128 * 1024, hst};
      pg8::EpiBf16<0> E{(bf16*)(scr + S_VT) + (size_t)GI * 1024 * TC, TC, 1.f / WSCALE8};
      pg8::gemm_phase<pg8::EpiBf16<0>, L0VtOrder<GI>, false, 1>(F.lds, F.wave, gm, S, E); }
}


#ifdef MK_SELFCHECK
__device__ __forceinline__ void selfcheck_buf(Frame& F, const void* ptr, size_t nbytes, int stage, int slot0) {
    if (!F.chk) return;
    const int gw = F.vcu * NWAVES + F.wave, NGW = F.G * NWAVES; unsigned* cks = (unsigned*)(F.ws + WS_NEED + 2 * MiB) + slot0;
    const int nch = (int)(nbytes >> 12);
    for (int c = gw; c < nch; c += NGW) { const u32x4* r = (const u32x4*)((const char*)ptr + ((size_t)c << 12)) + F.lane; unsigned x = 0;
#pragma unroll
        for (int j = 0; j < 4; ++j) { const u32x4 v = r[64 * j]; x ^= v.x * 3u + v.y * 5u + v.z * 7u + v.w * 11u + (unsigned)j; }
        x *= (unsigned)(2 * F.lane + 1);
#pragma unroll
        for (int o = 1; o < 64; o <<= 1) x ^= __shfl_xor(x, o);
        if (F.lane == 0) { if (F.chk == 1) cks[c] = x; else if (cks[c] != x) atomicMax((unsigned*)(F.ctl + 32), (unsigned)(1000 - stage)); } }
}
#endif

__global__ void __launch_bounds__(NWAVES * 64, 2) mk_fwd(Args args) {
    extern __shared__ __attribute__((aligned(16))) unsigned char lds[];
    Frame F;
    F.lds = (LAS unsigned char*)lds;
    F.tid = threadIdx.x; F.lane = F.tid & 63; F.wave = __builtin_amdgcn_readfirstlane(F.tid >> 6);
    F.G = gridDim.x; { const int bx = blockIdx.x; F.vcu = (F.G % 8 == 0) ? (bx % 8) * (F.G / 8) + bx / 8 : bx; }
    F.ws = args.ws; F.ctl = (gu32*)(args.ws + WS_CTL); F.out = args.out; F.chk = args.chk; F.stage = 0;
    volatile LAS unsigned* MISC = (volatile LAS unsigned*)(F.lds + MISC_OFF);
    for (int u = F.tid; u < (LDS_BYTES - RING_BYTES) / 4; u += NWAVES * 64) ((LAS unsigned*)(F.lds + RING_BYTES))[u] = 0u;
    __syncthreads();
    XcdBarrier bar; bar.bar = (unsigned*)(F.ctl + CW_BAR); bar.x = 0; bar.st = nullptr;
    if (!MK_MULTI) bar = xcd_barrier_post((unsigned*)(F.ctl + CW_BAR), MISC + 8);
    const int lo = args.ph_lo, hi = args.ph_hi;
    int ph = 0;
#define PHASE_BEGIN if (ph >= lo && ph < hi) { F.lane = (int)__builtin_amdgcn_mbcnt_hi(~0u, __builtin_amdgcn_mbcnt_lo(~0u, 0u)); asm volatile("" : "+v"(F.lane)); F.tid = F.wave * 64 + F.lane;
#define PHASE_END   if (!MK_MULTI && ph + 1 < hi) xcd_barrier(bar, F.tid); } ++ph;
    const int bx = (int)blockIdx.x;
#define scr (args.ws + WS_SCR)
#define hb ((const bf16*)(args.ws + WS_HB))
#define ln_g (args.in[2])
#define ln_b (args.in[3])

    PHASE_BEGIN p_prologue(F, args); if (MK_PROBE & 8) p_prologue(F, args); PHASE_END

    if (MK_ENABLE & 1) {
#define L0_CHUNK(ck) \
        PHASE_BEGIN \
        if ((ck) > 0) dil_merge_phase(F, (ck) - 1); \
        l0_gemms<0>(F, (ck), bx); l0_gemms<1>(F, (ck), bx); l0_gemms<2>(F, (ck), bx); \
        PHASE_END \
        PHASE_BEGIN dil_attn_phase3(F); if (MK_PROBE & 1) dil_attn_phase3(F); PHASE_END
        L0_CHUNK(0) L0_CHUNK(1) L0_CHUNK(2) L0_CHUNK(3)
#undef L0_CHUNK
        PHASE_BEGIN dil_merge_phase(F, 3); if (MK_PROBE & 4) { dil_merge_phase(F, 3); dil_merge_phase(F, 3); dil_merge_phase(F, 3); dil_merge_phase(F, 3); } PHASE_END
        PHASE_BEGIN
        { pg8::LinOrder S{T / 256, 4, F.G, bx, (const char*)(scr + S_ATT), (const char*)(F.ws + W_A_O), (size_t)256 * 1024, (size_t)256 * 1024};
          pg8::Gemm gm{512, 1, 1, (size_t)128 * 1024, (size_t)128 * 1024};
          pg8::EpiResLn<FFN_GU8 == 0> E{(bf16*)(F.ws + WS_HB), ln_g + 0 * 2048, ln_b + 0 * 2048, ALPHA, 1.f / (WSCALE8 * ASCALE8), (float*)scr, (unsigned*)(F.ctl + CW_LNC + 0 * 4096), (unsigned*)(F.ctl + CW_BAR) + XB_TMO, scr + S_HB8, F.lds + LNT_OFF};
          pg8::gemm_phase<pg8::EpiResLn<FFN_GU8 == 0>, pg8::LinOrder, true, 1>(F.lds, F.wave, gm, S, E); }
        PHASE_END
    } else {
        PHASE_BEGIN ln_phase<1, false, false>(F, ln_g + 0 * 2048, ln_b + 0 * 2048, nullptr); PHASE_END
    }
#define DENSE_FFN(f, lnidx, enbit) \
    if (MK_ENABLE & (enbit)) { \
        PHASE_BEGIN \
        if ((f) == FFN_GU8) { \
          pg8::LinOrder S{T / 256, 2 * DFF / 256, F.G, bx, (const char*)(scr + S_HB8), (const char*)(F.ws + W_F_GU) + (size_t)(f) * 2 * DFF * 2048, (size_t)256 * 1024, (size_t)256 * 1024}; \
          pg8::Gemm gm{512, 1, 1, (size_t)128 * 1024, (size_t)128 * 1024};     \
          pg8::EpiSwiglu8 E{(unsigned char*)(scr + S_HID), DFF, 1.f / WSCALE8}; \
          pg8::gemm_phase<pg8::EpiSwiglu8, pg8::LinOrder, true, 1>(F.lds, F.wave, gm, S, E); \
        } else { pg8::LinOrder S{T / 256, 2 * DFF / 256, F.G, bx, (const char*)hb, (const char*)(F.ws + W_F_GU) + (size_t)(f) * 2 * DFF * 2048, (size_t)256 * 2048, (size_t)256 * 2048}; \
          pg8::Gemm gm{1024, 1, 1, (size_t)128 * 2048, (size_t)128 * 2048}; \
          pg8::EpiSwiglu8 E{(unsigned char*)(scr + S_HID), DFF}; \
          pg8::gemm_phase(F.lds, F.wave, gm, S, E); } \
        PHASE_END \
        PHASE_BEGIN \
        { pg8::LinOrder S{T / 256, 4, F.G, bx, (const char*)(scr + S_HID), (const char*)(F.ws + W_F_D) + (size_t)(f) * 1024 * DFF * 2, (size_t)256 * DFF, (size_t)256 * DFF}; \
          pg8::Gemm gm{DFF / 2, 1, 1, (size_t)128 * DFF, (size_t)128 * DFF};     \
          pg8::EpiResLn<false> E{(bf16*)(F.ws + WS_HB), ln_g + (lnidx) * 1024, ln_b + (lnidx) * 1024, ALPHA, 1.f / WSCALE8D, (float*)(scr + S_Y), (unsigned*)(F.ctl + CW_LNC + (2 + (f)) * 4096), (unsigned*)(F.ctl + CW_BAR) + XB_TMO, nullptr, F.lds + LNT_OFF}; \
          pg8::gemm_phase<pg8::EpiResLn<false>, pg8::LinOrder, true, 1>(F.lds, F.wave, gm, S, E); }     \
        PHASE_END \
    } else { \
        PHASE_BEGIN ln_phase<1, false, false>(F, ln_g + (lnidx) * 1024, ln_b + (lnidx) * 1024, nullptr); PHASE_END \
    }
    DENSE_FFN(0, 1, 2)

    if (MK_ENABLE & 4) {
        PHASE_BEGIN
        { pg8::LinOrder S{T / 256, 4, F.G, bx, (const char*)hb, (const char*)(F.ws + W_B_IN), (size_t)256 * 2048, (size_t)256 * 2048};
          pg8::Gemm gm{1024, 1, 1, (size_t)128 * 2048, (size_t)128 * 2048};
          pg8::EpiBf16<0> E{(bf16*)(scr + S_BCX), 1024};
          pg8::gemm_phase(F.lds, F.wave, gm, S, E); }
        { pg8::LinOrder S{T / 256, 8, F.G, bx, (const char*)hb, (const char*)(F.ws + W_B_IN) + (size_t)1024 * 2048, (size_t)256 * 2048, (size_t)256 * 2048};
          pg8::Gemm gm{1024, 1, 1, (size_t)128 * 2048, (size_t)128 * 2048};
          pg8::EpiGlu<0> E{(bf16*)(scr + S_BCX + (size_t)128 * MiB), 1024};
          pg8::gemm_phase(F.lds, F.wave, gm, S, E); }
        PHASE_END
        PHASE_BEGIN conv_phase(F, args.in[7]); if (MK_PROBE & 4) conv_phase(F, args.in[7]); PHASE_END
        PHASE_BEGIN
        { pg8::LinOrder S{T / 256, 4, F.G, bx, (const char*)(scr + S_P), (const char*)(F.ws + W_B_O), (size_t)256 * 2048, (size_t)256 * 2048};
          pg8::Gemm gm{1024, 1, 1, (size_t)128 * 2048, (size_t)128 * 2048};
          pg8::EpiResBf16 E{hb, (bf16*)F.out, 1024, ALPHA};
          pg8::gemm_phase(F.lds, F.wave, gm, S, E); }
        PHASE_END
        PHASE_BEGIN ln_phase<0, true, false>(F, ln_g + 2 * 1024, ln_b + 2 * 1024, args.in[20]); PHASE_END
    } else {
        PHASE_BEGIN ln_phase<1, true, false>(F, ln_g + 2 * 1024, ln_b + 2 * 1024, args.in[20]); PHASE_END
    }
#define MOE_CHUNK(f, ck) \
        PHASE_BEGIN \
        { const MoeSeg sg = moe_seg(F, (f)); int nM = sg.ts[8] - (ck) * MOE_CH_TILES; nM = nM > MOE_CH_TILES ? MOE_CH_TILES : (nM < 0 ? 0 : nM); \
          MoeOrder S{nM, 2 * DFE / 256, F.G, bx, (ck) * MOE_CH_TILES, sg, (const char*)F.out, (const char*)(F.ws + W_E_GU) + (size_t)(f) * 8 * 2 * DFE * 2048, (size_t)256 * 1024, (size_t)2 * DFE * 2048, (size_t)256 * 1024, false, true}; \
          pg8::Gemm gm{512, 1, 1, (size_t)128 * 1024, (size_t)128 * 1024};     \
          pg8::EpiSwiglu8 E{(unsigned char*)(scr + S_MHID), DFE, 1.f / WSCALE8}; \
          pg8::gemm_phase<pg8::EpiSwiglu8, MoeOrder, true, 0x7C>(F.lds, F.wave, gm, S, E);     if ((ck) == 0 && (MK_PROBE & 32)) pg8::gemm_phase(F.lds, F.wave, gm, S, E); } \
        PHASE_END \
        PHASE_BEGIN \
        { const MoeSeg sg = moe_seg(F, (f)); int nM = sg.ts[8] - (ck) * MOE_CH_TILES; nM = nM > MOE_CH_TILES ? MOE_CH_TILES : (nM < 0 ? 0 : nM); \
          MoeOrder S{nM, 4, F.G, bx, (ck) * MOE_CH_TILES, sg, (const char*)(scr + S_MHID), (const char*)(F.ws + W_E_D) + (size_t)(f) * 8 * 1024 * DFE * 2, (size_t)256 * DFE, (size_t)1024 * DFE * 2, (size_t)256 * DFE, true, false}; \
          pg8::Gemm gm{DFE / 2, 1, 1, (size_t)128 * DFE, (size_t)128 * DFE};     \
          pg8::EpiBf16<0> E{(bf16*)(scr + S_XG), 1024, 1.f / WSCALE8D}; \
          pg8::gemm_phase<pg8::EpiBf16<0>, MoeOrder, true, 0x7B>(F.lds, F.wave, gm, S, E);     if ((ck) == 0 && (MK_PROBE & 64)) pg8::gemm_phase(F.lds, F.wave, gm, S, E); } \
        PHASE_END
#define MOE_FFN(f, lnidx, enbit, fin) \
    if (MK_ENABLE & (enbit)) { \
        PHASE_BEGIN moe_gather_phase(F, (f)); if (MK_PROBE & 4) moe_gather_phase(F, (f)); PHASE_END \
        MOE_CHUNK(f, 0) MOE_CHUNK(f, 1) MOE_CHUNK(f, 2) \
        PHASE_BEGIN ln_phase<2, false, fin>(F, ln_g + (lnidx) * 1024, ln_b + (lnidx) * 1024, nullptr); PHASE_END \
    } else { \
        PHASE_BEGIN ln_phase<1, false, fin>(F, ln_g + (lnidx) * 1024, ln_b + (lnidx) * 1024, nullptr); PHASE_END \
    }
    MOE_FFN(0, 3, 8, false)

    if (MK_ENABLE & 16) {
        PHASE_BEGIN
        { pg8::LinOrder S{T / 256, 8, F.G, bx, (const char*)hb, (const char*)(F.ws + W_C_QK), (size_t)256 * 2048, (size_t)256 * 2048};
          pg8::Gemm gm{1024, 1, 1, (size_t)128 * 2048, (size_t)128 * 2048};
          pg8::EpiBf16<0> E{(bf16*)(scr + S_CQK), 2048};
          pg8::gemm_phase(F.lds, F.wave, gm, S, E); }
        { pg8::LinOrder S{4, T / 256, F.G, bx, (const char*)(F.ws + W_C_V), (const char*)hb, (size_t)256 * 2048, (size_t)256 * 2048};
          pg8::Gemm gm{1024, 1, 1, (size_t)128 * 2048, (size_t)128 * 2048};
          pg8::EpiBf16<0> E{(bf16*)(scr + S_CVT), T};
          pg8::gemm_phase(F.lds, F.wave, gm, S, E); }
        PHASE_END
#ifdef MK_SELFCHECK
        PHASE_BEGIN selfcheck_buf(F, scr + S_CQK, (size_t)256 * MiB, 40, 0); selfcheck_buf(F, scr + S_CVT, (size_t)128 * MiB, 41, 65536); PHASE_END
#endif
        PHASE_BEGIN kmean_phase(F); if (MK_PROBE & 4) kmean_phase(F); PHASE_END
#ifdef MK_SELFCHECK
        PHASE_BEGIN selfcheck_buf(F, F.ws + WS_KMEAN, (size_t)1 * MiB, 42, 65536 + 32768); PHASE_END
#endif
        PHASE_BEGIN moba_phase3(F); if (MK_PROBE & 2) moba_phase3(F); PHASE_END
#ifdef MK_SELFCHECK
        PHASE_BEGIN selfcheck_buf(F, F.ws + WS_NEED + 3 * MiB, (size_t)4 * MiB, 43, 65536 + 32768 + 256); selfcheck_buf(F, F.ws + WS_NEED + 7 * MiB, (size_t)4 * MiB, 44, 65536 + 32768 + 256 + 1024);
                    selfcheck_buf(F, scr + S_CATT, (size_t)128 * MiB, 45, 65536 + 32768 + 256 + 2048); PHASE_END
#endif
        PHASE_BEGIN
        { pg8::LinOrder S{T / 256, 4, F.G, bx, (const char*)(scr + S_CATT), (const char*)(F.ws + W_C_O), (size_t)256 * 1024, (size_t)256 * 1024};
          pg8::Gemm gm{512, 1, 1, (size_t)128 * 1024, (size_t)128 * 1024};
          pg8::EpiResLn<FFN_GU8 == 1> E{(bf16*)(F.ws + WS_HB), ln_g + 4 * 1024, ln_b + 4 * 1024, ALPHA, 1.f / (WSCALE8 * ASCALE8), (float*)scr, (unsigned*)(F.ctl + CW_LNC + 1 * 4096), (unsigned*)(F.ctl + CW_BAR) + XB_TMO, scr + S_HB8, F.lds + LNT_OFF};
          pg8::gemm_phase<pg8::EpiResLn<FFN_GU8 == 1>, pg8::LinOrder, true, 1>(F.lds, F.wave, gm, S, E); }
        PHASE_END
    } else {
        PHASE_BEGIN ln_phase<1, false, false>(F, ln_g + 4 * 1024, ln_b + 4 * 1024, nullptr); PHASE_END
    }
    DENSE_FFN(1, 5, 32)

    if (MK_ENABLE & 64) {
        PHASE_BEGIN
        { pg8::LinOrder S{T / 256, 8, F.G, bx, (const char*)hb, (const char*)(F.ws + W_D_IN), (size_t)256 * 2048, (size_t)256 * 2048};
          pg8::Gemm gm{1024, 1, 1, (size_t)128 * 2048, (size_t)128 * 2048};
          pg8::EpiBf16<1> E{(bf16*)(scr + S_UV), 2048};
          pg8::gemm_phase(F.lds, F.wave, gm, S, E); }
        PHASE_END
        PHASE_BEGIN gmlp_phase(F, args.in[12], args.in[13], args.in[15]); if (MK_PROBE & 4) gmlp_phase(F, args.in[12], args.in[13], args.in[15]); PHASE_END
        PHASE_BEGIN
        { pg8::LinOrder S{T / 256, 4, F.G, bx, (const char*)(scr + S_P), (const char*)(F.ws + W_D_O), (size_t)256 * 2048, (size_t)256 * 2048};
          pg8::Gemm gm{1024, 1, 1, (size_t)128 * 2048, (size_t)128 * 2048};
          pg8::EpiResBf16 E{hb, (bf16*)F.out, 1024, ALPHA};
          pg8::gemm_phase(F.lds, F.wave, gm, S, E); }
        PHASE_END
        PHASE_BEGIN ln_phase<0, true, false>(F, ln_g + 6 * 1024, ln_b + 6 * 1024, args.in[20] + 8192); PHASE_END
    } else {
        PHASE_BEGIN ln_phase<1, true, false>(F, ln_g + 6 * 1024, ln_b + 6 * 1024, args.in[20] + 8192); PHASE_END
    }
    MOE_FFN(1, 7, 128, true)
#ifdef MK_SELFCHECK
    PHASE_BEGIN
    { const unsigned fl = __hip_atomic_load((unsigned*)(F.ctl + 32), RLX_AGENT);
      if (fl != 0u) { const int code = 1000 - (int)fl; const float cval = (code >= 40 && code <= 45) ? (float)(20 + 2 * (code - 40)) : (float)(1u << (code / 10 + 1)); const int gw = F.vcu * NWAVES + F.wave, NGW = F.G * NWAVES;
          for (int m = gw; m < T; m += NGW) { f32x4* w = (f32x4*)(F.out + (size_t)m * D) + F.lane;
#pragma unroll
              for (int j = 0; j < 4; ++j) w[64 * j] = (f32x4){cval, cval, cval, cval}; } } }
    PHASE_END
#endif
#undef PHASE_BEGIN
#undef PHASE_END
#undef scr
#undef hb
#undef ln_g
#undef ln_b
}

static int count_phases() {
    int n = 1;
    n += (MK_ENABLE & 1) ? (8 + 1 + 1) : 1;
    n += (MK_ENABLE & 2) ? 2 : 1;
    n += (MK_ENABLE & 4) ? 4 : 1;
    n += (MK_ENABLE & 8) ? 8 : 1;
    n += (MK_ENABLE & 16) ? 4 : 1;
    n += (MK_ENABLE & 32) ? 2 : 1;
    n += (MK_ENABLE & 64) ? 4 : 1;
    n += (MK_ENABLE & 128) ? 8 : 1;
#ifdef MK_SELFCHECK
    n += 1 + 3;
#endif
    return n;
}
extern "C" void kernel_launch(void* const* d_in, const int* in_sizes, int n_in, void* d_out, int out_size, void* d_ws, size_t ws_size, hipStream_t stream) {
    static int grid = 0;
    if (grid == 0) {
        if (n_in != 24 || in_sizes[0] != T * D || out_size != T * D || ws_size < WS_NEED) { fprintf(stderr, "kernel_launch: unexpected shapes (n_in %d, in0 %d, out %d, ws %zu < %zu); nothing launched\n", n_in, n_in > 0 ? in_sizes[0] : -1, out_size, ws_size, (size_t)WS_NEED); grid = -1; return; }
        int dev = 0, cus = 0, per_cu = 0;
        if (hipGetDevice(&dev) != hipSuccess || hipDeviceGetAttribute(&cus, hipDeviceAttributeMultiprocessorCount, dev) != hipSuccess) { grid = -1; return; }
        if (hipFuncSetAttribute((const void*)mk_fwd, hipFuncAttributeMaxDynamicSharedMemorySize, LDS_BYTES) != hipSuccess) { fprintf(stderr, "kernel_launch: hipFuncSetAttribute failed\n"); grid = -1; return; }
        if (hipOccupancyMaxActiveBlocksPerMultiprocessor(&per_cu, (const void*)mk_fwd, NWAVES * 64, LDS_BYTES) != hipSuccess || per_cu < 1) fprintf(stderr, "kernel_launch: occupancy query reports %d\n", per_cu);
        (void)hipGetLastError();
        grid = cus;
    }
    if (grid < 0) return;
    (void)hipMemsetAsync((char*)d_ws + WS_CTL, 0, CTL_ZERO_BYTES, stream);
#ifdef SELF_POISON
    (void)hipMemsetAsync((char*)d_ws + CTL_ZERO_BYTES, 0xAA, WS_NEED - CTL_ZERO_BYTES, stream);
    (void)hipMemsetAsync(d_out, 0xAA, (size_t)T * D * 4, stream);
#endif
    Args a{};
    for (int i = 0; i < 24; ++i) a.in[i] = (const float*)d_in[i];
    a.out = (float*)d_out; a.ws = (unsigned char*)d_ws;
    const int nph = count_phases();
#if MK_MULTI
    for (int p = 0; p < nph; ++p) { a.ph_lo = p; a.ph_hi = p + 1; hipLaunchKernelGGL(mk_fwd, dim3(grid), dim3(NWAVES * 64), LDS_BYTES, stream, a); }
#else
    a.ph_lo = 0; a.ph_hi = nph;
#ifdef MK_SELFCHECK
    a.chk = 1;
    hipLaunchKernelGGL(mk_fwd, dim3(grid), dim3(NWAVES * 64), LDS_BYTES, stream, a);
    (void)hipMemsetAsync((char*)d_ws + WS_CTL, 0, CTL_ZERO_BYTES, stream);
    a.chk = 2;
#endif
    hipLaunchKernelGGL(mk_fwd, dim3(grid), dim3(NWAVES * 64), LDS_BYTES, stream, a);
#endif
    const hipError_t le = hipPeekAtLastError();
    if (le != hipSuccess) fprintf(stderr, "kernel_launch: launch failed: %s\n", hipGetErrorName(le));
}
```

```cpp
#include <hip/hip_runtime.h>
#include <cstdio>
#include <cstdint>

#ifndef MK_MULTI
#define MK_MULTI 0
#endif
#ifndef MK_PROBE
#define MK_PROBE 0
#endif
#ifndef MK_ENABLE
#define MK_ENABLE 0xFF
#endif

#define GAS __attribute__((address_space(1)))
#define LAS __attribute__((address_space(3)))
typedef unsigned short bf16;
typedef short bf16x8 __attribute__((ext_vector_type(8)));
typedef float f32x4 __attribute__((ext_vector_type(4)));
typedef float f32x2 __attribute__((ext_vector_type(2)));
typedef float f32x16 __attribute__((ext_vector_type(16)));
typedef unsigned u32x4 __attribute__((ext_vector_type(4)));
typedef unsigned u32x2 __attribute__((ext_vector_type(2)));
typedef GAS unsigned gu32;
typedef int v8i_t __attribute__((ext_vector_type(8)));
typedef int v4i_t __attribute__((ext_vector_type(4)));
typedef short s16x16_t __attribute__((ext_vector_type(16)));

constexpr int D = 1024, NB = 32, SEQ = 2048, T = NB * SEQ, NH = 16, HD = 64;
constexpr int DFF = 2816, NE = 8, DFE = 3584;
constexpr float ALPHA = 1.6817928305074290f;
constexpr float LN_EPS = 1e-5f;
constexpr float LOG2E = 1.4426950408889634f;
constexpr float QSCALE = 0.125f * LOG2E;
constexpr float NEGB = -1e30f;
constexpr int TC = 16384;
constexpr int MOE_CH_TILES = 256;
constexpr int MOE_MAX_TILES = 520;
constexpr int FFN_GU8 = 1;

constexpr size_t MiB = 1u << 20;
constexpr size_t WS_CTL = 0, CTL_ZERO_BYTES = 1 * MiB;
constexpr size_t WS_BUCKET = 1 * MiB;
constexpr size_t WS_BTABA = WS_BUCKET + 8192;
constexpr size_t WS_BTABC = WS_BTABA + 32768;
constexpr size_t WS_WST = WS_BTABC + 131072;
constexpr size_t WS_KMEAN = 2 * MiB;
constexpr size_t WS_ROUTE = 4 * MiB;
constexpr size_t WS_GATES = 5 * MiB;
constexpr size_t WS_SLOTS = 6 * MiB;
constexpr size_t WS_WCNT = 7 * MiB;
constexpr size_t WS_W = 8 * MiB;
constexpr size_t W_A_QK = WS_W;
constexpr size_t W_A_V = W_A_QK + 12 * MiB;
constexpr size_t W_A_O = W_A_V + 6 * MiB;
constexpr size_t W_B_IN = W_A_O + 2 * MiB;
constexpr size_t W_B_O = W_B_IN + 6 * MiB;
constexpr size_t W_C_QK = W_B_O + 2 * MiB;
constexpr size_t W_C_V = W_C_QK + 4 * MiB;
constexpr size_t W_C_O = W_C_V + 2 * MiB;
constexpr size_t W_D_IN = W_C_O + 2 * MiB;
constexpr size_t W_D_O = W_D_IN + 4 * MiB;
constexpr size_t W_F_GU = W_D_O + 2 * MiB;
constexpr size_t W_F_D = W_F_GU + 22 * MiB;
constexpr size_t W_E_GU = W_F_D + 11 * MiB;
constexpr size_t W_E_D = W_E_GU + 224 * MiB;
constexpr size_t WS_HB = W_E_D + 112 * MiB;
constexpr size_t WS_SCR = WS_HB + 128 * MiB;
constexpr size_t WS_NEED = WS_SCR + 512 * MiB;
static_assert(WS_HB == 419 * MiB, "map");
constexpr size_t S_QK = 0;
constexpr size_t S_VT = 192 * MiB;
constexpr size_t S_HB8 = 416 * MiB;
constexpr size_t S_ATT = 288 * MiB;
constexpr size_t S_HID = 0;
constexpr size_t S_BCX = 0;
constexpr size_t S_P = 384 * MiB;
constexpr size_t S_XG = 0;
constexpr size_t S_MHID = 260 * MiB;
constexpr size_t S_Y = 256 * MiB;
constexpr size_t S_CQK = 0;
constexpr size_t S_CVT = 256 * MiB;
constexpr size_t S_CATT = 384 * MiB;
constexpr size_t S_UV = 0;
constexpr size_t O_OG = 0;
constexpr size_t O_LSE = 96 * MiB;
constexpr int CW_TMO = 0;
constexpr int CW_ECNT = 64;
constexpr int CW_BAR = 4096;
constexpr int CW_LNC = 16384;

constexpr float ASCALE8 = 8.f;
constexpr float WSCALE8 = 64.f, WSCALE8D = 256.f;
__device__ __forceinline__ unsigned pk4_fp8(float a, float b, float c, float d) { int p = 0; p = __builtin_amdgcn_cvt_pk_fp8_f32(a, b, p, false); p = __builtin_amdgcn_cvt_pk_fp8_f32(c, d, p, true); return (unsigned)p; }
namespace pg8 {
constexpr int BM = 256, BK = 64, HALF = 128, HTB = HALF * BK * 2, STAGE_BYTES = 8 * HTB, NXCD = 8, WGM = 8;
__host__ __device__ __forceinline__ int lds_byte(int r, int c) { const int st = (r >> 4) * 2 + (c >> 5), rr = r & 15, cc = c & 31, ob = rr * 64 + cc * 2; return st * 1024 + (ob ^ (((ob >> 9) & 1) << 5)); }
__host__ __device__ __forceinline__ void stage_rc(int b, int& R, int& C) { const int st = b / 1024, sb = b % 1024, swz = sb ^ (((sb >> 9) & 1) << 5); R = (st >> 1) * 16 + swz / 64; C = (st & 1) * 32 + (swz % 64) / 2; }
__host__ __device__ __forceinline__ int perm32(int rho) { const int n = rho >> 4, i = rho & 15; return 8 * (i >> 2) + 4 * n + (i & 3); }

struct Unit { int pm, pn; unsigned a, b; };
struct Gemm { int K; int rsA, rsB; size_t hstepA, hstepB; };

__device__ __forceinline__ bool tile_of(long L, int nM, int nN, int& pm, int& pn) {
    const int nwg = nM * nN; if (L >= nwg) return false;
    int wgid = (int)L; { const int q = nwg / NXCD, r = nwg % NXCD, xcd = wgid % NXCD, off = wgid / NXCD; wgid = (xcd < r ? xcd * (q + 1) : r * (q + 1) + (xcd - r) * q) + off; }
    const int nig = WGM * nN, gid = wgid / nig, fm = gid * WGM, gsz = (nM - fm) < WGM ? (nM - fm) : WGM;
    pm = fm + ((wgid % nig) % gsz); pn = (wgid % nig) / gsz; return true;
}
struct LinOrder {
    int nM, nN, G, c; const char* A0; const char* B0; size_t aT, bT;
    __device__ __forceinline__ bool next(int i, Unit& u) const { if (!tile_of((long)i * G + c, nM, nN, u.pm, u.pn)) return false; u.a = (unsigned)((size_t)u.pm * aT); u.b = (unsigned)((size_t)u.pn * bT); return true; }
};

typedef __bf16 bf16x2_t __attribute__((ext_vector_type(2)));
__device__ __forceinline__ unsigned cvt_pk_bf16(float lo, float hi) { f32x2 v = {lo, hi}; bf16x2_t b = __builtin_convertvector(v, bf16x2_t); return __builtin_bit_cast(unsigned, b); }
__device__ __forceinline__ f32x2 gelu_pk(f32x2 v) {
    const f32x2 av = __builtin_elementwise_abs(v), d = av * 0.2316418882f + 1.0f;
    f32x2 t; t.x = __builtin_amdgcn_rcpf(d.x); t.y = __builtin_amdgcn_rcpf(d.y);
    f32x2 q = t * 0.5307027145f + (-0.7265760135f); q = q * t + 0.7107068705f; q = q * t + (-0.142248368f); q = q * t + 0.127414796f; q = q * t;
    const f32x2 s = (v * v) * (-0.72134752044f);
    f32x2 e; e.x = __builtin_amdgcn_exp2f(s.x); e.y = __builtin_amdgcn_exp2f(s.y);
    const f32x2 m = v * (q * e), r = v - m;
    f32x2 o; o.x = v.x < 0.f ? m.x : r.x; o.y = v.y < 0.f ? m.y : r.y; return o;
}
__device__ __forceinline__ float silu_f(float g) { return g * __builtin_amdgcn_rcpf(1.0f + __builtin_amdgcn_exp2f(-LOG2E * g)); }

template <int ACT  > struct EpiBf16 {
    static constexpr bool PERM = true;
    bf16* O; int ldc; float sc = 1.f;
    __device__ __forceinline__ void operator()(const f32x4 (&acc)[2][2][4][2], const Unit& u, int wr, int wc, int fr, int fq) const {
        const int row0 = u.pm * BM + wr * 64 + fr, col0 = u.pn * BM + wc * 32 + 8 * fq;
#pragma unroll
        for (int ai = 0; ai < 2; ++ai)
#pragma unroll
            for (int m = 0; m < 4; ++m) { bf16* rowp = O + (size_t)(row0 + ai * HALF + m * 16) * ldc + col0;
#pragma unroll
                for (int bj = 0; bj < 2; ++bj) { f32x4 v0 = acc[ai][bj][m][0] * sc, v1 = acc[ai][bj][m][1] * sc;
                    if (ACT == 1) { f32x2 a = gelu_pk((f32x2){v0[0], v0[1]}), b = gelu_pk((f32x2){v0[2], v0[3]}), c = gelu_pk((f32x2){v1[0], v1[1]}), d = gelu_pk((f32x2){v1[2], v1[3]});
                        v0 = (f32x4){a.x, a.y, b.x, b.y}; v1 = (f32x4){c.x, c.y, d.x, d.y}; }
                    u32x4 w; w.x = cvt_pk_bf16(v0[0], v0[1]); w.y = cvt_pk_bf16(v0[2], v0[3]); w.z = cvt_pk_bf16(v1[0], v1[1]); w.w = cvt_pk_bf16(v1[2], v1[3]);
                    *(u32x4*)(rowp + bj * HALF) = w; } }
    }
};
struct EpiF8 {
    static constexpr bool PERM = true;
    unsigned char* O; int ldc; float sc = 1.f;
    __device__ __forceinline__ void operator()(const f32x4 (&acc)[2][2][4][2], const Unit& u, int wr, int wc, int fr, int fq) const {
        const int row0 = u.pm * BM + wr * 64 + fr, col0 = u.pn * BM + wc * 32 + 8 * fq;
#pragma unroll
        for (int ai = 0; ai < 2; ++ai)
#pragma unroll
            for (int m = 0; m < 4; ++m) { unsigned char* rowp = O + (size_t)(row0 + ai * HALF + m * 16) * ldc + col0;
#pragma unroll
                for (int bj = 0; bj < 2; ++bj) { const f32x4 v0 = acc[ai][bj][m][0] * sc, v1 = acc[ai][bj][m][1] * sc;
                    u32x2 w; w.x = pk4_fp8(v0[0], v0[1], v0[2], v0[3]); w.y = pk4_fp8(v1[0], v1[1], v1[2], v1[3]);
                    *(u32x2*)(rowp + bj * HALF) = w; } }
    }
};
template <int ACT  > struct EpiGlu {
    static constexpr bool PERM = true;
    bf16* O; int ldc;
    __device__ __forceinline__ void operator()(const f32x4 (&acc)[2][2][4][2], const Unit& u, int wr, int wc, int fr, int fq) const {
        const int row0 = u.pm * BM + wr * 64 + fr, col0 = u.pn * HALF + wc * 32 + 8 * fq;
#pragma unroll
        for (int ai = 0; ai < 2; ++ai)
#pragma unroll
            for (int m = 0; m < 4; ++m) { bf16* rowp = O + (size_t)(row0 + ai * HALF + m * 16) * ldc + col0;
                f32x4 g0 = acc[ai][0][m][0], g1 = acc[ai][0][m][1]; const f32x4 u0 = acc[ai][1][m][0], u1 = acc[ai][1][m][1];
                if (ACT == 1) { g0 = (f32x4){silu_f(g0[0]), silu_f(g0[1]), silu_f(g0[2]), silu_f(g0[3])}; g1 = (f32x4){silu_f(g1[0]), silu_f(g1[1]), silu_f(g1[2]), silu_f(g1[3])}; }
                const f32x4 p0 = g0 * u0, p1 = g1 * u1;
                u32x4 w; w.x = cvt_pk_bf16(p0[0], p0[1]); w.y = cvt_pk_bf16(p0[2], p0[3]); w.z = cvt_pk_bf16(p1[0], p1[1]); w.w = cvt_pk_bf16(p1[2], p1[3]);
                *(u32x4*)rowp = w; }
    }
};
struct EpiSwiglu8 {
    static constexpr bool PERM = true;
    unsigned char* O; int ldc; float s = 1.f;
    __device__ __forceinline__ void operator()(const f32x4 (&acc)[2][2][4][2], const Unit& u, int wr, int wc, int fr, int fq) const {
        const int row0 = u.pm * BM + wr * 64 + fr, col0 = u.pn * HALF + wc * 32 + 8 * fq;
#pragma unroll
        for (int ai = 0; ai < 2; ++ai)
#pragma unroll
            for (int m = 0; m < 4; ++m) { unsigned char* rowp = O + (size_t)(row0 + ai * HALF + m * 16) * ldc + col0;
                const f32x4 g0 = acc[ai][0][m][0], g1 = acc[ai][0][m][1], u0 = acc[ai][1][m][0], u1 = acc[ai][1][m][1];
                const float c1 = -LOG2E * s, s2 = s * s;
                const f32x4 p0 = (g0 * u0) * s2, p1 = (g1 * u1) * s2;
                f32x4 r0, r1;
#pragma unroll
                for (int j = 0; j < 4; ++j) { r0[j] = __builtin_amdgcn_rcpf(1.0f + __builtin_amdgcn_exp2f(g0[j] * c1)); r1[j] = __builtin_amdgcn_rcpf(1.0f + __builtin_amdgcn_exp2f(g1[j] * c1)); }
                const f32x4 o0 = p0 * r0, o1 = p1 * r1;
                u32x2 w; w.x = pk4_fp8(o0[0], o0[1], o0[2], o0[3]); w.y = pk4_fp8(o1[0], o1[1], o1[2], o1[3]);
                *(u32x2*)rowp = w; }
    }
};
struct EpiResBf16 {
    static constexpr bool PERM = true;
    const bf16* base; bf16* out; int ldc; float alpha; float sc = 1.f;
    __device__ __forceinline__ void operator()(const f32x4 (&acc)[2][2][4][2], const Unit& u, int wr, int wc, int fr, int fq) const {
        const int row0 = u.pm * BM + wr * 64 + fr, col0 = u.pn * BM + wc * 32 + 8 * fq;
#pragma unroll
        for (int ai = 0; ai < 2; ++ai)
#pragma unroll
            for (int m = 0; m < 4; ++m) { const size_t off = (size_t)(row0 + ai * HALF + m * 16) * ldc + col0;
#pragma unroll
                for (int bj = 0; bj < 2; ++bj) { const u32x4 b = *(const u32x4*)(base + off + bj * HALF); const f32x4 a0 = acc[ai][bj][m][0] * sc, a1 = acc[ai][bj][m][1] * sc;
                    u32x4 w; w.x = cvt_pk_bf16(__builtin_bit_cast(float, b.x << 16) * alpha + a0[0], __builtin_bit_cast(float, b.x & 0xffff0000u) * alpha + a0[1]);
                    w.y = cvt_pk_bf16(__builtin_bit_cast(float, b.y << 16) * alpha + a0[2], __builtin_bit_cast(float, b.y & 0xffff0000u) * alpha + a0[3]);
                    w.z = cvt_pk_bf16(__builtin_bit_cast(float, b.z << 16) * alpha + a1[0], __builtin_bit_cast(float, b.z & 0xffff0000u) * alpha + a1[1]);
                    w.w = cvt_pk_bf16(__builtin_bit_cast(float, b.w << 16) * alpha + a1[2], __builtin_bit_cast(float, b.w & 0xffff0000u) * alpha + a1[3]);
                    *(u32x4*)(out + off + bj * HALF) = w; }
                asm volatile("" ::: "memory"); }
    }
};

template <bool HB8> struct EpiResLn {
    static constexpr bool PERM = true;
    bf16* h; const float* gain; const float* bias; float alpha, sc;
    float* xbuf;
    unsigned* cnt;
    unsigned* tmo;
    unsigned char* h8;
    LAS unsigned char* tb;
    __device__ __forceinline__ void operator()(f32x4 (&acc)[2][2][4][2], const Unit& u, int wr, int wc, int fr, int fq) const {
        asm volatile("" : "+v"(fr), "+v"(fq));
        const int row0 = u.pm * BM + wr * 64 + fr, col0 = u.pn * BM + wc * 32 + 8 * fq;
        LAS f32x2* P = (LAS f32x2*)tb; LAS f32x2* S = (LAS f32x2*)(tb + 8192);
#pragma unroll
        for (int ai = 0; ai < 2; ++ai)
#pragma unroll
            for (int m = 0; m < 4; ++m) { const size_t off = (size_t)(row0 + ai * HALF + m * 16) * 1024 + col0; float sm = 0.f, sq = 0.f;
#pragma unroll
                for (int bj = 0; bj < 2; ++bj) { const u32x4 b = *(const u32x4*)(h + off + bj * HALF); const f32x4 a0 = acc[ai][bj][m][0] * sc, a1 = acc[ai][bj][m][1] * sc;
                    f32x4 z0, z1;
                    z0[0] = __builtin_bit_cast(float, b.x << 16) * alpha + a0[0]; z0[1] = __builtin_bit_cast(float, b.x & 0xffff0000u) * alpha + a0[1];
                    z0[2] = __builtin_bit_cast(float, b.y << 16) * alpha + a0[2]; z0[3] = __builtin_bit_cast(float, b.y & 0xffff0000u) * alpha + a0[3];
                    z1[0] = __builtin_bit_cast(float, b.z << 16) * alpha + a1[0]; z1[1] = __builtin_bit_cast(float, b.z & 0xffff0000u) * alpha + a1[1];
                    z1[2] = __builtin_bit_cast(float, b.w << 16) * alpha + a1[2]; z1[3] = __builtin_bit_cast(float, b.w & 0xffff0000u) * alpha + a1[3];
                    acc[ai][bj][m][0] = z0; acc[ai][bj][m][1] = z1;
                    sm += ((z0[0] + z0[1]) + (z0[2] + z0[3])) + ((z1[0] + z1[1]) + (z1[2] + z1[3]));
                    sq += ((z0[0] * z0[0] + z0[1] * z0[1]) + (z0[2] * z0[2] + z0[3] * z0[3])) + ((z1[0] * z1[0] + z1[1] * z1[1]) + (z1[2] * z1[2] + z1[3] * z1[3])); }
                sm += __shfl_xor(sm, 16); sm += __shfl_xor(sm, 32); sq += __shfl_xor(sq, 16); sq += __shfl_xor(sq, 32);
                if (fq == 0) P[(ai * HALF + wr * 64 + m * 16 + fr) * 4 + wc] = (f32x2){sm, sq};
                asm volatile("" ::: "memory"); }
        asm volatile("s_waitcnt lgkmcnt(0)" ::: "memory"); __builtin_amdgcn_s_barrier(); asm volatile("" ::: "memory");
        const int wid = wr * 4 + wc, lane = fq * 16 + fr, row = wid * 32 + (lane & 31);
        unsigned long long* slots = (unsigned long long*)xbuf + (size_t)(u.pm * BM + row) * 4;
        if (lane < 32) { const f32x2 a = P[row * 4 + 0], b = P[row * 4 + 1], c = P[row * 4 + 2], d = P[row * 4 + 3];
            const float ts = (a.x + b.x) + (c.x + d.x), tq = (a.y + b.y) + (c.y + d.y);
            __hip_atomic_store(slots + u.pn, ((unsigned long long)__builtin_bit_cast(unsigned, tq) << 32) | (unsigned long long)__builtin_bit_cast(unsigned, ts), __ATOMIC_RELAXED, __HIP_MEMORY_SCOPE_AGENT); }
        asm volatile("s_waitcnt vmcnt(0)" ::: "memory");
        if (lane == 0) (void)__hip_atomic_fetch_add(cnt + 16 * u.pm, 1u, __ATOMIC_RELAXED, __HIP_MEMORY_SCOPE_AGENT);
        if (wid == 0) { unsigned sp = 0u;
            while ((unsigned)__builtin_amdgcn_readfirstlane(__hip_atomic_load(cnt + 16 * u.pm, __ATOMIC_RELAXED, __HIP_MEMORY_SCOPE_AGENT)) < 32u) { __builtin_amdgcn_s_sleep(1);
                if ((++sp & 255u) == 0u) { if (__hip_atomic_load(tmo, __ATOMIC_RELAXED, __HIP_MEMORY_SCOPE_AGENT)) break; if (sp > (1u << 22)) { if (lane == 0) (void)__hip_atomic_fetch_add(tmo, 1u, __ATOMIC_RELAXED, __HIP_MEMORY_SCOPE_AGENT); break; } } }
            __builtin_amdgcn_fence(__ATOMIC_ACQUIRE, "agent"); }
        asm volatile("s_waitcnt vmcnt(0) lgkmcnt(0)" ::: "memory"); __builtin_amdgcn_s_barrier(); asm volatile("" ::: "memory");
        if (lane < 32) { float ts = 0.f, tq = 0.f;
#pragma unroll
            for (int t = 0; t < 4; ++t) { const unsigned long long w = __hip_atomic_load(slots + t, __ATOMIC_RELAXED, __HIP_MEMORY_SCOPE_AGENT); ts += __builtin_bit_cast(float, (unsigned)w); tq += __builtin_bit_cast(float, (unsigned)(w >> 32)); }
            const float mean = ts * (1.f / 1024.f), var = fmaxf(tq * (1.f / 1024.f) - mean * mean, 0.f);
            S[row] = (f32x2){mean, 1.f / sqrtf(var + LN_EPS)}; }
        asm volatile("s_waitcnt vmcnt(0) lgkmcnt(0)" ::: "memory"); __builtin_amdgcn_s_barrier(); asm volatile("" ::: "memory");
#pragma unroll
        for (int bj = 0; bj < 2; ++bj) { const f32x4 g0 = *(const f32x4*)(gain + col0 + bj * HALF), g1 = *(const f32x4*)(gain + col0 + bj * HALF + 4), b0 = *(const f32x4*)(bias + col0 + bj * HALF), b1 = *(const f32x4*)(bias + col0 + bj * HALF + 4);
#pragma unroll
            for (int ai = 0; ai < 2; ++ai)
#pragma unroll
                for (int m = 0; m < 4; ++m) { const int r = ai * HALF + wr * 64 + m * 16 + fr; const f32x2 sr = S[r]; const size_t off = (size_t)(u.pm * BM + r) * 1024 + col0 + bj * HALF;
                    const f32x4 y0 = (acc[ai][bj][m][0] - sr.x) * sr.y * g0 + b0, y1 = (acc[ai][bj][m][1] - sr.x) * sr.y * g1 + b1;
                    u32x4 w; w.x = cvt_pk_bf16(y0[0], y0[1]); w.y = cvt_pk_bf16(y0[2], y0[3]); w.z = cvt_pk_bf16(y1[0], y1[1]); w.w = cvt_pk_bf16(y1[2], y1[3]);
                    *(u32x4*)(h + off) = w;
                    if (HB8) { u32x2 w8; w8.x = pk4_fp8(y0[0], y0[1], y0[2], y0[3]); w8.y = pk4_fp8(y1[0], y1[1], y1[2], y1[3]); *(u32x2*)(h8 + off) = w8; }
                    asm volatile("" ::: "memory"); } }
    }
};

template <class Epi, class Sched, bool ALIGN_EPI = true, int FP8 = 0>
__device__ __forceinline__ void gemm_phase(LAS unsigned char* lds, const int wave_s, const Gemm g, const Sched& S, const Epi& E) {
    int tid = wave_s * 64 + (int)__builtin_amdgcn_mbcnt_hi(~0u, __builtin_amdgcn_mbcnt_lo(~0u, 0u)); asm volatile("" : "+v"(tid));
    const int wid = __builtin_amdgcn_readfirstlane(tid >> 6), lane = tid & 63, wr = wid >> 2, wc = wid & 3, fr = lane & 15, fq = lane >> 4;
    const int K = g.K, nt = K / BK;
    unsigned voffA[2], voffB[2];
#pragma unroll
    for (int i = 0; i < 2; ++i) { int R, C; stage_rc(tid * 16 + i * 8192, R, C); const int Rb = Epi::PERM ? ((R & ~31) + perm32(R & 31)) : R;
        voffA[i] = (unsigned)(R * g.rsA * K + C) * 2u; voffB[i] = (unsigned)(Rb * g.rsB * K + C) * 2u; }
    const unsigned kstep = (unsigned)(BK * 2);
    const unsigned hstepA = (unsigned)g.hstepA, hstepB = (unsigned)g.hstepB;
    const __amdgpu_buffer_rsrc_t rsrcA = __builtin_amdgcn_make_buffer_rsrc((void*)S.A0, 0, 0x7fffffff, 0x00020000), rsrcB = __builtin_amdgcn_make_buffer_rsrc((void*)S.B0, 0, 0x7fffffff, 0x00020000);
    const unsigned ldsw = (unsigned)wid * 1024u;
    const int aoff = lds_byte(wr * 64 + fr, fq * 8), boff = lds_byte(wc * 32 + fr, fq * 8);
    const int aoff8 = lds_byte(wr * 64 + fr, fq * 16), boff8 = lds_byte(wc * 32 + fr, fq * 16);
    unsigned bbase8_ = (unsigned)(4 * HTB + boff); asm volatile("" : "+v"(bbase8_));
    LAS unsigned char* const ldsB8 = lds + bbase8_;
#define PG8_SA(b, h) (((b) * 2 + (h)) * HTB)
#define PG8_SB(b, h) ((4 + (b) * 2 + (h)) * HTB)
#define PG8_STAGE(bufoff, gbase, voff) do { _Pragma("unroll") for (int _i = 0; _i < 2; ++_i) \
        __builtin_amdgcn_raw_ptr_buffer_load_lds(PG8_RS_##voff, (LAS unsigned*)(lds + (bufoff) + ldsw + _i * 8192), 16, (int)(voff)[_i], (int)(gbase), 0, 0); } while (0)
#define PG8_RS_voffA rsrcA
#define PG8_RS_voffB rsrcB
#define PG8_LD16(off) (*(const LAS bf16x8*)(lds + (off)))
#define PG8_CAT8(lo, hi) __builtin_shufflevector(__builtin_bit_cast(v4i_t, lo), __builtin_bit_cast(v4i_t, hi), 0, 1, 2, 3, 4, 5, 6, 7)
#define PG8_LDA(dst, b, h) do { if constexpr (FP8) { _Pragma("unroll") for (int m = 0; m < 4; ++m) dst##8[m] = PG8_CAT8(PG8_LD16(PG8_SA(b, h) + aoff + m * 2048), PG8_LD16(PG8_SA(b, h) + aoff + m * 2048 + 1024)); } \
        else { _Pragma("unroll") for (int m = 0; m < 4; ++m) _Pragma("unroll") for (int k = 0; k < 2; ++k) dst[m][k] = PG8_LD16(PG8_SA(b, h) + aoff + m * 2048 + k * 1024); } } while (0)
#define PG8_LDB(dst, b, h) do { if constexpr (FP8) { _Pragma("unroll") for (int n = 0; n < 2; ++n) dst##8[n] = PG8_CAT8(*(const LAS bf16x8*)(ldsB8 + ((b) * 2 + (h)) * HTB + n * 2048), *(const LAS bf16x8*)(ldsB8 + ((b) * 2 + (h)) * HTB + n * 2048 + 1024)); } \
        else { _Pragma("unroll") for (int n = 0; n < 2; ++n) _Pragma("unroll") for (int k = 0; k < 2; ++k) dst[n][k] = PG8_LD16(PG8_SB(b, h) + boff + n * 2048 + k * 1024); } } while (0)
#define PG8_MMA(ai, bj, At, Bt) do { __builtin_amdgcn_s_setprio(1); \
        if constexpr (FP8) { _Pragma("unroll") for (int m = 0; m < 4; ++m) _Pragma("unroll") for (int n = 0; n < 2; ++n) \
            acc[ai][bj][m][n] = __builtin_amdgcn_mfma_scale_f32_16x16x128_f8f6f4(Bt##8[n], At##8[m], acc[ai][bj][m][n], 0, 0, 0, 0, 0, 0); } \
        else { _Pragma("unroll") for (int m = 0; m < 4; ++m) _Pragma("unroll") for (int n = 0; n < 2; ++n) _Pragma("unroll") for (int k = 0; k < 2; ++k) \
            acc[ai][bj][m][n] = __builtin_amdgcn_mfma_f32_16x16x32_bf16(Bt[n][k], At[m][k], acc[ai][bj][m][n], 0, 0, 0); } \
        __builtin_amdgcn_s_setprio(0); } while (0)
#define PG8_WAIT_V(n) asm volatile("s_waitcnt vmcnt(" #n ")" ::: "memory")
#define PG8_WAIT_L(n) asm volatile("s_waitcnt lgkmcnt(" #n ")" ::: "memory")
#define PG8_BAR __builtin_amdgcn_s_barrier()
#define PG8_SCHED __builtin_amdgcn_sched_barrier(0)
    Unit cur, nxt; int ui = 0;
    if (!S.next(0, cur)) return;
    f32x4 acc[2][2][4][2];
#pragma unroll
    for (int a = 0; a < 2; ++a)
#pragma unroll
        for (int b = 0; b < 2; ++b)
#pragma unroll
            for (int m = 0; m < 4; ++m)
#pragma unroll
                for (int n = 0; n < 2; ++n) acc[a][b][m][n] = (f32x4){0.f, 0.f, 0.f, 0.f};
    bf16x8 At[4][2], B0[2][2], B1[2][2]; v8i_t At8[4], B08[2], B18[2];
    unsigned cA = cur.a, cB = cur.b;
    PG8_STAGE(PG8_SB(0, 0), cB, voffB); PG8_STAGE(PG8_SB(0, 1), cB + hstepB, voffB); PG8_STAGE(PG8_SA(0, 0), cA, voffA); PG8_STAGE(PG8_SA(0, 1), cA + hstepA, voffA);
    if (wr == 1) PG8_BAR;
    PG8_WAIT_V(2); PG8_BAR;
    PG8_STAGE(PG8_SB(1, 0), cB + kstep, voffB); PG8_STAGE(PG8_SA(1, 0), cA + kstep, voffA); PG8_STAGE(PG8_SB(1, 1), cB + hstepB + kstep, voffB);
    PG8_WAIT_V(6); PG8_BAR;
    for (;;) {
        const bool has_next = S.next(ui + 1, nxt);
        const unsigned nA = has_next ? nxt.a : cA, nB = has_next ? nxt.b : cB;
#pragma clang loop unroll(disable)
        for (int t = 0; t < nt; t += 2) {
            const bool last = (t == nt - 2);
            const unsigned a1 = cA + (unsigned)(t + 1) * kstep;
            const unsigned a2 = last ? nA : cA + (unsigned)(t + 2) * kstep, b2 = last ? nB : cB + (unsigned)(t + 2) * kstep;
            const unsigned a3 = a2 + kstep, b3 = b2 + kstep;
            PG8_LDB(B0, 0, 0); PG8_LDB(B1, 0, 1); PG8_SCHED; PG8_LDA(At, 0, 0); PG8_STAGE(PG8_SA(1, 1), a1 + hstepA, voffA);
            PG8_WAIT_V(8); PG8_WAIT_L(0); PG8_BAR; PG8_MMA(0, 0, At, B0); PG8_MMA(0, 1, At, B1); PG8_BAR; PG8_SCHED;
            PG8_LDA(At, 0, 1); PG8_STAGE(PG8_SB(0, 0), b2, voffB); PG8_STAGE(PG8_SB(0, 1), b2 + hstepB, voffB); PG8_STAGE(PG8_SA(0, 0), a2, voffA);
            PG8_WAIT_V(8); PG8_WAIT_L(0); PG8_BAR; PG8_MMA(1, 0, At, B0); PG8_MMA(1, 1, At, B1); PG8_BAR; PG8_SCHED;
            PG8_LDB(B0, 1, 0); PG8_LDB(B1, 1, 1); PG8_SCHED; PG8_LDA(At, 1, 0); PG8_STAGE(PG8_SA(0, 1), a2 + hstepA, voffA);
            PG8_WAIT_V(8); PG8_WAIT_L(0); PG8_BAR; PG8_MMA(0, 0, At, B0); PG8_MMA(0, 1, At, B1); PG8_BAR; PG8_SCHED;
            PG8_LDA(At, 1, 1); PG8_STAGE(PG8_SB(1, 0), b3, voffB); PG8_STAGE(PG8_SB(1, 1), b3 + hstepB, voffB); PG8_STAGE(PG8_SA(1, 0), a3, voffA);
            PG8_WAIT_V(8); PG8_WAIT_L(0); PG8_BAR; PG8_MMA(1, 0, At, B0); PG8_MMA(1, 1, At, B1); PG8_BAR; PG8_SCHED;
        }
        if constexpr (ALIGN_EPI) { if (wr == 0) PG8_BAR; }
        E(acc, cur, wr, wc, fr, fq);
        if (!has_next) break;
#pragma unroll
        for (int a = 0; a < 2; ++a)
#pragma unroll
            for (int b = 0; b < 2; ++b)
#pragma unroll
                for (int m = 0; m < 4; ++m)
#pragma unroll
                    for (int n = 0; n < 2; ++n) acc[a][b][m][n] = (f32x4){0.f, 0.f, 0.f, 0.f};
        cur = nxt; cA = nA; cB = nB; ++ui;
        if constexpr (ALIGN_EPI) { if (wr == 1) PG8_BAR; }
    }
    PG8_WAIT_V(0);
    if constexpr (!ALIGN_EPI) { if (wr == 0) PG8_BAR; }
    PG8_BAR;
#undef PG8_SA
#undef PG8_SB
#undef PG8_STAGE
#undef PG8_RS_voffA
#undef PG8_RS_voffB
#undef PG8_LDA
#undef PG8_LD16
#undef PG8_CAT8
#undef PG8_LDB
#undef PG8_MMA
#undef PG8_WAIT_V
#undef PG8_WAIT_L
#undef PG8_BAR
#undef PG8_SCHED
}
}

#define RLX_AGENT __ATOMIC_RELAXED, __HIP_MEMORY_SCOPE_AGENT
#define LDS_WAIT() asm volatile("s_waitcnt lgkmcnt(0)" ::: "memory")
#define VM_WAIT() asm volatile("s_waitcnt vmcnt(0)" ::: "memory")
__device__ __forceinline__ unsigned f2bf(float f) { unsigned u = __builtin_bit_cast(unsigned, f); return (u + 0x7fffu + ((u >> 16) & 1u)) >> 16; }
__device__ __forceinline__ unsigned pk2(float lo, float hi) { return pg8::cvt_pk_bf16(lo, hi); }
__device__ __forceinline__ float bflo(unsigned w) { return __builtin_bit_cast(float, w << 16); }
__device__ __forceinline__ float bfhi(unsigned w) { return __builtin_bit_cast(float, w & 0xffff0000u); }
__device__ __forceinline__ float wave_sum(float v) {
#pragma unroll
    for (int o = 1; o < 64; o <<= 1) v += __shfl_xor(v, o);
    return v;
}

#define XB_TMO      128
#define XB_XCNT(j)  (256  + 64 * (j))
#define XB_XSUB(j)  (1280 + 64 * (j))
#define XB_XGEN(j)  (2304 + 64 * (j))
#define XB_TOP      3328
#define XB_TOPGEN   3392
#define XCD_BAR_WORDS 3456
#define XB_SPIN_CAP (1u << 22)
__device__ __forceinline__ unsigned xb_ld(unsigned* p)              { return __hip_atomic_load(p, __ATOMIC_RELAXED, __HIP_MEMORY_SCOPE_AGENT); }
__device__ __forceinline__ unsigned xb_add(unsigned* p, unsigned v) { return __hip_atomic_fetch_add(p, v, __ATOMIC_RELAXED, __HIP_MEMORY_SCOPE_AGENT); }
__device__ __forceinline__ unsigned xb_xcc_id() { return (unsigned)__builtin_amdgcn_s_getreg((3 << 11) | 20) & 0xFu; }
#define XB_SPIN(cond, bar) do { unsigned _sp = 0; while (cond) { __builtin_amdgcn_s_sleep(1); \
    if ((++_sp & 255u) == 0u) { if (xb_ld(&(bar)[XB_TMO])) break; if (_sp > XB_SPIN_CAP) { atomicAdd(&(bar)[XB_TMO], 1u); break; } } } } while (0)
struct XcdBarrier { unsigned* bar; unsigned x; volatile LAS unsigned* st; };
__device__ __forceinline__ XcdBarrier xcd_barrier_post(unsigned* bar, volatile LAS unsigned* st) {
    XcdBarrier b; b.bar = bar; b.x = xb_xcc_id(); b.st = st;
    if (threadIdx.x == 0) (void)xb_add(&bar[XB_XCNT(b.x)], 1u);
    return b;
}
__device__ __forceinline__ void xcd_barrier_complete(unsigned* bar, unsigned x, unsigned& nloc, unsigned& nx) {
    const unsigned G = gridDim.x * gridDim.y * gridDim.z;
    unsigned sum, cnt, mine, sp = 0u;
    for (;;) {
        sum = 0u; cnt = 0u; mine = 0u;
#pragma unroll
        for (unsigned j = 0; j < 16; ++j) { const unsigned c = xb_ld(&bar[XB_XCNT(j)]); sum += c; cnt += (c > 0u) ? 1u : 0u; mine = (j == x) ? c : mine; }
        if (sum == G) break;
        __builtin_amdgcn_s_sleep(1);
        if ((++sp & 255u) == 0u) { if (xb_ld(&bar[XB_TMO])) break; if (sp > XB_SPIN_CAP) { atomicAdd(&bar[XB_TMO], 1u); break; } }
    }
    nloc = mine > 0u ? mine : 1u; nx = cnt > 0u ? cnt : 1u;
}
__device__ __forceinline__ void xcd_barrier(const XcdBarrier& b, const int tid) {
    asm volatile("s_waitcnt vmcnt(0)" ::: "memory");
    __syncthreads();
    if (tid == 0) {
        unsigned* bar = b.bar;
        __builtin_amdgcn_s_waitcnt(0);
        unsigned nloc = b.st[0], nx = b.st[1];
        if (nloc == 0u) { xcd_barrier_complete(bar, b.x, nloc, nx); b.st[0] = nloc; b.st[1] = nx; }
        const unsigned old = xb_add(&bar[XB_XSUB(b.x)], 1u);
        const unsigned gen = old / nloc;
        if (old + 1u == (gen + 1u) * nloc) {
            __builtin_amdgcn_fence(__ATOMIC_RELEASE, "agent");
            asm volatile("s_waitcnt vmcnt(0)" ::: "memory");
            const unsigned og = xb_add(&bar[XB_TOP], 1u);
            const unsigned tg = og / nx;
            if (og + 1u == (tg + 1u) * nx) xb_add(&bar[XB_TOPGEN], 1u);
            else XB_SPIN(xb_ld(&bar[XB_TOPGEN]) == tg, bar);
            __builtin_amdgcn_fence(__ATOMIC_ACQUIRE, "agent");
            xb_add(&bar[XB_XGEN(b.x)], 1u);
            asm volatile("s_waitcnt vmcnt(0)" ::: "memory");
        } else {
            XB_SPIN(xb_ld(&bar[XB_XGEN(b.x)]) == gen, bar);
            __builtin_amdgcn_fence(__ATOMIC_ACQUIRE, "agent");
            asm volatile("s_waitcnt vmcnt(0)" ::: "memory");
        }
    }
    __syncthreads();
}

constexpr int NWAVES = 8;
constexpr int RING_BYTES = 131072, MISC_OFF = RING_BYTES + 320, LNT_OFF = RING_BYTES + 2048  , LDS_BYTES = 147456;
struct Args { const float* in[24]; float* out; unsigned char* ws; int ph_lo, ph_hi; int chk, pad; };
struct Frame {
    LAS unsigned char* lds;
    gu32* ctl; unsigned char* ws; float* out;
    int tid, lane, wave, vcu, G;
    int chk, stage;
};

struct Job { const float* src; bf16* dst; int ld, K, N, mode, start; float scale; int fp8, pad; };
constexpr int NJOBS = 74;
__device__ __forceinline__ void make_job(const Args& a, int j, Job& J) {
    unsigned char* ws = a.ws; J.scale = 1.f; J.mode = 0; J.start = 0; J.fp8 = 0; J.pad = 0;
    if (j < 9) { const int g = j / 3, t = j % 3; J.src = a.in[4] + g * 3072 + t * 1024; J.ld = 9216; J.K = 1024; J.N = 1024;
        if (t == 2) J.dst = (bf16*)(ws + W_A_V + (size_t)g * 1024 * 1024); else J.dst = (bf16*)(ws + W_A_QK + (size_t)g * 2048 * 1024 + (size_t)t * 1024 * 1024);
        J.fp8 = 1; J.scale = (t == 0 ? QSCALE : 1.f) * WSCALE8; return; }
    j -= 9;
    if (j == 0) { J.src = a.in[5]; J.ld = 1024; J.K = 1024; J.N = 1024; J.dst = (bf16*)(ws + W_A_O); J.fp8 = 1; J.scale = WSCALE8; return; }
    if (j == 1) { J.src = a.in[6]; J.ld = 3072; J.K = 1024; J.N = 1024; J.dst = (bf16*)(ws + W_B_IN); return; }
    if (j == 9 || j == 10) { J.src = a.in[6] + 1024 * (j - 8); J.ld = 3072; J.K = 1024; J.N = 1024; J.dst = (bf16*)(ws + W_B_IN) + (size_t)1024 * 1024; J.mode = j - 8; return; }
    if (j == 2) { J.src = a.in[8]; J.ld = 1024; J.K = 1024; J.N = 1024; J.dst = (bf16*)(ws + W_B_O); return; }
    if (j == 3) { J.src = a.in[9]; J.ld = 3072; J.K = 1024; J.N = 1024; J.dst = (bf16*)(ws + W_C_QK); J.scale = QSCALE; return; }
    if (j == 4) { J.src = a.in[9] + 1024; J.ld = 3072; J.K = 1024; J.N = 1024; J.dst = (bf16*)(ws + W_C_QK) + (size_t)1024 * 1024; return; }
    if (j == 5) { J.src = a.in[9] + 2048; J.ld = 3072; J.K = 1024; J.N = 1024; J.dst = (bf16*)(ws + W_C_V); return; }
    if (j == 6) { J.src = a.in[10]; J.ld = 1024; J.K = 1024; J.N = 1024; J.dst = (bf16*)(ws + W_C_O); J.fp8 = 1; J.scale = WSCALE8; return; }
    if (j == 7) { J.src = a.in[11]; J.ld = 2048; J.K = 1024; J.N = 2048; J.dst = (bf16*)(ws + W_D_IN); return; }
    if (j == 8) { J.src = a.in[16]; J.ld = 1024; J.K = 1024; J.N = 1024; J.dst = (bf16*)(ws + W_D_O); return; }
    j -= 11;
    if (j < 6) { const int f = j / 3, t = j % 3;
        if (t < 2) { J.src = a.in[17 + t] + (size_t)f * 1024 * DFF; J.ld = DFF; J.K = 1024; J.N = DFF; J.dst = (bf16*)(ws + W_F_GU) + (size_t)f * 2 * DFF * 1024; J.mode = 1 + t;
            if (f == FFN_GU8) { J.fp8 = 1; J.scale = WSCALE8; } }
        else { J.src = a.in[19] + (size_t)f * DFF * 1024; J.ld = 1024; J.K = DFF; J.N = 1024; J.dst = (bf16*)(ws + W_F_D) + (size_t)f * 1024 * DFF; J.fp8 = 1; J.scale = WSCALE8D; }
        return; }
    j -= 6;
    { const int fe = j / 3, t = j % 3;
        if (t < 2) { J.src = a.in[21 + t] + (size_t)fe * 1024 * DFE; J.ld = DFE; J.K = 1024; J.N = DFE; J.dst = (bf16*)(ws + W_E_GU) + (size_t)fe * 2 * DFE * 1024; J.mode = 1 + t; J.fp8 = 1; J.scale = WSCALE8; }
        else { J.src = a.in[23] + (size_t)fe * DFE * 1024; J.ld = 1024; J.K = DFE; J.N = 1024; J.dst = (bf16*)(ws + W_E_D) + (size_t)fe * 1024 * DFE; J.fp8 = 1; J.scale = WSCALE8D; } }
}
__device__ __forceinline__ void transpose_item(const Job& J, int item, int lane) {
    const int nblk = J.N >> 6, kb = item / nblk, nb = item - kb * nblk, k0 = 64 * kb, n = 64 * nb + lane;
    const float* W = J.src + (size_t)k0 * J.ld + n;
    int r = n; if (J.mode) r = (n >> 7) * 256 + (n & 127) + (J.mode == 2 ? 128 : 0);
    const float sc = J.scale; const size_t ld = (size_t)J.ld;
    if (J.fp8) {
        unsigned char* dst8 = (unsigned char*)J.dst + (size_t)r * J.K + k0;
#pragma unroll
        for (int hf = 0; hf < 2; ++hf) {
            float v[32];
#pragma unroll
            for (int j = 0; j < 32; ++j) v[j] = W[(size_t)(32 * hf + j) * ld];
#pragma unroll
            for (int c = 0; c < 2; ++c) { u32x4 o; o.x = pk4_fp8(v[16 * c] * sc, v[16 * c + 1] * sc, v[16 * c + 2] * sc, v[16 * c + 3] * sc); o.y = pk4_fp8(v[16 * c + 4] * sc, v[16 * c + 5] * sc, v[16 * c + 6] * sc, v[16 * c + 7] * sc);
                o.z = pk4_fp8(v[16 * c + 8] * sc, v[16 * c + 9] * sc, v[16 * c + 10] * sc, v[16 * c + 11] * sc); o.w = pk4_fp8(v[16 * c + 12] * sc, v[16 * c + 13] * sc, v[16 * c + 14] * sc, v[16 * c + 15] * sc);
                *(u32x4*)(dst8 + 32 * hf + 16 * c) = o; }
        }
        return;
    }
    bf16* dst = J.dst + (size_t)r * J.K + k0;
#pragma unroll
    for (int hf = 0; hf < 2; ++hf) {
        float v[32];
#pragma unroll
        for (int j = 0; j < 32; ++j) v[j] = W[(size_t)(32 * hf + j) * ld];
#pragma unroll
        for (int c = 0; c < 4; ++c) { u32x4 o; o.x = pk2(v[8 * c] * sc, v[8 * c + 1] * sc); o.y = pk2(v[8 * c + 2] * sc, v[8 * c + 3] * sc); o.z = pk2(v[8 * c + 4] * sc, v[8 * c + 5] * sc); o.w = pk2(v[8 * c + 6] * sc, v[8 * c + 7] * sc);
            *(u32x4*)(dst + 32 * hf + 8 * c) = o; }
    }
}
__device__ __forceinline__ int t5_bucket(int d) {
    if (d < 16) return d;
    int b = 16 + (int)(log((double)d / 16.0) / log(128.0) * 16.0);
    return b < 16 ? 16 : (b > 31 ? 31 : b);
}
__device__ __forceinline__ void p_prologue(Frame& F, const Args& a) {
    unsigned char* gl_ = (unsigned char*)F.lds;
    Job* jobs = (Job*)(gl_ + 7 * 16384 + 8704);
    int* tot = (int*)(gl_ + 7 * 16384 + 8704 + NJOBS * sizeof(Job));
    static_assert(8704 + NJOBS * sizeof(Job) + 16 <= 16384, "job table fits");
    if (F.tid < NJOBS) { Job J; make_job(a, F.tid, J); jobs[F.tid] = J; }
    __syncthreads();
    if (F.tid == 0) { int s = 0; for (int j = 0; j < NJOBS; ++j) { jobs[j].start = s; s += (jobs[j].K / 64) * (jobs[j].N / 64); } tot[0] = s; }
    __syncthreads();
    const int total = tot[0];
    const int gw = F.vcu * NWAVES + F.wave, NGW = F.G * NWAVES;
    int jc = 0;
    for (int it = gw; it < total; it += NGW) {
        while (jc + 1 < NJOBS && jobs[jc + 1].start <= it) ++jc;
        const Job J = jobs[jc];
        transpose_item(J, it - J.start, F.lane);
    }
    { bf16* hb = (bf16*)(F.ws + WS_HB); const float* x = a.in[0]; unsigned char* hb8 = F.ws + WS_SCR + S_HB8;
      for (int m0 = 4 * gw; m0 < T; m0 += 4 * NGW) { f32x4 v[4][4];
#pragma unroll
          for (int k = 0; k < 4; ++k) { const f32x4* xr = (const f32x4*)(x + (size_t)(m0 + k) * D) + F.lane;
#pragma unroll
              for (int j = 0; j < 4; ++j) v[k][j] = xr[64 * j]; }
#pragma unroll
          for (int k = 0; k < 4; ++k) { unsigned long long* o8 = (unsigned long long*)(hb + (size_t)(m0 + k) * D) + F.lane;
#pragma unroll
              for (int j = 0; j < 4; ++j) o8[64 * j] = (unsigned long long)pk2(v[k][j].x, v[k][j].y) | ((unsigned long long)pk2(v[k][j].z, v[k][j].w) << 32);
              unsigned* o4 = (unsigned*)(hb8 + (size_t)(m0 + k) * D) + F.lane;
#pragma unroll
              for (int j = 0; j < 4; ++j) o4[64 * j] = pk4_fp8(v[k][j].x, v[k][j].y, v[k][j].z, v[k][j].w); } } }
    const int gt = blockIdx.x * 512 + F.tid, NGT = F.G * 512;
    const float* rel = a.in[1];
    float* btA = (float*)(F.ws + WS_BTABA); float* btC = (float*)(F.ws + WS_BTABC);
    for (int i = gt; i < 48 * 132; i += NGT) { const int gh = i / 132, dl = i % 132, g = gh >> 4, hh = gh & 15; const int dil = g == 0 ? 1 : (g == 1 ? 4 : 16);
        btA[i] = dl <= 128 ? rel[t5_bucket(dl * dil) * NH + hh] * LOG2E : 0.f; }
    for (int i = gt; i < 16 * 2048; i += NGT) { const int hh = i >> 11, dd = i & 2047; btC[i] = rel[t5_bucket(dd) * NH + hh] * LOG2E; }
    { bf16* wst = (bf16*)(F.ws + WS_WST); const float* wsrc = a.in[14];
      for (int i = gt; i < 8 * 128 * 128; i += NGT) { const int tt = (i >> 7) & 127, ss = i & 127; wst[i] = (bf16)f2bf(ss <= tt ? wsrc[i] : 0.f); } }
}

__device__ __forceinline__ void unpack8(const u32x4 a, float* x) { x[0] = bflo(a.x); x[1] = bfhi(a.x); x[2] = bflo(a.y); x[3] = bfhi(a.y); x[4] = bflo(a.z); x[5] = bfhi(a.z); x[6] = bflo(a.w); x[7] = bfhi(a.w); }
template <int MODE, bool ROUTE, bool FINAL, bool HB8 = false>
__device__ __forceinline__ void ln_phase(Frame& F, const float* gain, const float* bias, const float* wr) {
    constexpr int NBT = 2;
    const int gw = F.vcu * NWAVES + F.wave, NGW = F.G * NWAVES, lane = F.lane;
    bf16* hb = (bf16*)(F.ws + WS_HB); const bf16* zb = (const bf16*)F.out;
    float gv[16], bv[16];
#pragma unroll
    for (int k = 0; k < 2; ++k)
#pragma unroll
        for (int j = 0; j < 2; ++j) { const f32x4 g4 = *(const f32x4*)(gain + 512 * k + 8 * lane + 4 * j), b4 = *(const f32x4*)(bias + 512 * k + 8 * lane + 4 * j);
            gv[8 * k + 4 * j] = g4.x; gv[8 * k + 4 * j + 1] = g4.y; gv[8 * k + 4 * j + 2] = g4.z; gv[8 * k + 4 * j + 3] = g4.w;
            bv[8 * k + 4 * j] = b4.x; bv[8 * k + 4 * j + 1] = b4.y; bv[8 * k + 4 * j + 2] = b4.z; bv[8 * k + 4 * j + 3] = b4.w; }
    LAS float* wrT = (LAS float*)F.lds;
    if (ROUTE) { for (int i = F.tid; i < 8 * 1024; i += 512) { const int e = i >> 10, c = i & 1023; wrT[i] = wr[c * 8 + e]; } __syncthreads(); }
    const bf16* ys = (const bf16*)(F.ws + WS_SCR + S_XG);
    const int* slots = (const int*)(F.ws + WS_SLOTS); const float* gates = (const float*)(F.ws + WS_GATES);
    int* route = (int*)(F.ws + WS_ROUTE); float* gout = (float*)(F.ws + WS_GATES);
    for (int grp = gw; grp < T / 32; grp += NGW) {
        int cnt_e = 0;
        int my_e1 = 0, my_e2 = 0, my_r1 = 0, my_r2 = 0; float my_g1 = 0.f, my_g2 = 0.f;
        int sl0 = 0, sl1 = 0; float gg0 = 0.f, gg1 = 0.f;
        if (MODE == 2) { const int mm = grp * 32 + (lane & 31); sl0 = slots[2 * mm]; sl1 = slots[2 * mm + 1]; gg0 = gates[2 * mm]; gg1 = gates[2 * mm + 1]; }
        for (int i0 = 0; i0 < 32; i0 += NBT) {
            float v[NBT][16]; float st[NBT][2];
#pragma unroll
            for (int k = 0; k < NBT; ++k) { const int m = grp * 32 + i0 + k;
                if (MODE == 0) { const u32x4* zr = (const u32x4*)(zb + (size_t)m * D) + lane; unpack8(zr[0], v[k]); unpack8(zr[64], v[k] + 8); }
                else { const u32x4* hr = (const u32x4*)(hb + (size_t)m * D) + lane; unpack8(hr[0], v[k]); unpack8(hr[64], v[k] + 8);
#pragma unroll
                    for (int j = 0; j < 16; ++j) v[k][j] *= ALPHA;
                    if (MODE == 3) { const u32x4* yr = (const u32x4*)((const bf16*)(F.ws + WS_SCR + S_Y) + (size_t)m * D) + lane; float a[16]; unpack8(yr[0], a); unpack8(yr[64], a + 8);
#pragma unroll
                        for (int j = 0; j < 16; ++j) v[k][j] += a[j]; }
                    if (MODE == 2) { const int s0 = __builtin_amdgcn_readlane(sl0, i0 + k), s1 = __builtin_amdgcn_readlane(sl1, i0 + k);
                        const float g0 = __builtin_bit_cast(float, __builtin_amdgcn_readlane(__builtin_bit_cast(int, gg0), i0 + k)), g1 = __builtin_bit_cast(float, __builtin_amdgcn_readlane(__builtin_bit_cast(int, gg1), i0 + k));
                        const u32x4* y0 = (const u32x4*)(ys + (size_t)s0 * D) + lane; const u32x4* y1 = (const u32x4*)(ys + (size_t)s1 * D) + lane;
                        float a[16], b[16]; unpack8(y0[0], a); unpack8(y0[64], a + 8); unpack8(y1[0], b); unpack8(y1[64], b + 8);
#pragma unroll
                        for (int j = 0; j < 16; ++j) v[k][j] += g0 * a[j] + g1 * b[j]; } }
                float s = 0.f, q2 = 0.f;
#pragma unroll
                for (int j = 0; j < 16; ++j) { s += v[k][j]; q2 += v[k][j] * v[k][j]; }
                st[k][0] = s; st[k][1] = q2; }
#pragma unroll
            for (int o = 1; o < 64; o <<= 1) {
#pragma unroll
                for (int k = 0; k < NBT; ++k) { st[k][0] += __shfl_xor(st[k][0], o); st[k][1] += __shfl_xor(st[k][1], o); } }
#pragma unroll
            for (int k = 0; k < NBT; ++k) { const int m = grp * 32 + i0 + k;
                const float mean = st[k][0] * (1.f / D), var = fmaxf(st[k][1] * (1.f / D) - mean * mean, 0.f), rstd = 1.f / sqrtf(var + LN_EPS);
#pragma unroll
                for (int j = 0; j < 16; ++j) v[k][j] = (v[k][j] - mean) * rstd * gv[j] + bv[j];
                if (FINAL) { f32x4* orow = (f32x4*)(F.out + (size_t)m * D) + 2 * lane;
                    orow[0] = (f32x4){v[k][0], v[k][1], v[k][2], v[k][3]}; orow[1] = (f32x4){v[k][4], v[k][5], v[k][6], v[k][7]}; orow[128] = (f32x4){v[k][8], v[k][9], v[k][10], v[k][11]}; orow[129] = (f32x4){v[k][12], v[k][13], v[k][14], v[k][15]}; }
                else { u32x4* o = (u32x4*)(hb + (size_t)m * D) + lane; u32x4 a, b;
                    a.x = pk2(v[k][0], v[k][1]); a.y = pk2(v[k][2], v[k][3]); a.z = pk2(v[k][4], v[k][5]); a.w = pk2(v[k][6], v[k][7]); b.x = pk2(v[k][8], v[k][9]); b.y = pk2(v[k][10], v[k][11]); b.z = pk2(v[k][12], v[k][13]); b.w = pk2(v[k][14], v[k][15]);
                    o[0] = a; o[64] = b;
                    if (HB8) { u32x2* o8 = (u32x2*)(F.ws + WS_SCR + S_HB8 + (size_t)m * D) + lane; u32x2 c, d;
                        c.x = pk4_fp8(v[k][0], v[k][1], v[k][2], v[k][3]); c.y = pk4_fp8(v[k][4], v[k][5], v[k][6], v[k][7]); d.x = pk4_fp8(v[k][8], v[k][9], v[k][10], v[k][11]); d.y = pk4_fp8(v[k][12], v[k][13], v[k][14], v[k][15]);
                        o8[0] = c; o8[64] = d; } }
                if (ROUTE) {
                    float lg[8];
#pragma unroll
                    for (int e = 0; e < 8; ++e) { float p = 0.f;
#pragma unroll
                        for (int kk = 0; kk < 2; ++kk)
#pragma unroll
                            for (int j = 0; j < 2; ++j) { const f32x4 w4 = *(const LAS f32x4*)(wrT + e * 1024 + 512 * kk + 8 * lane + 4 * j); p += (v[k][8 * kk + 4 * j] * w4.x + v[k][8 * kk + 4 * j + 1] * w4.y) + (v[k][8 * kk + 4 * j + 2] * w4.z + v[k][8 * kk + 4 * j + 3] * w4.w); }
                        lg[e] = p; }
#pragma unroll
                    for (int o = 1; o < 64; o <<= 1) {
#pragma unroll
                        for (int e = 0; e < 8; ++e) lg[e] += __shfl_xor(lg[e], o); }
                    int e1 = 0; float v1 = lg[0];
#pragma unroll
                    for (int e = 1; e < 8; ++e) if (lg[e] > v1) { v1 = lg[e]; e1 = e; }
                    int e2 = -1; float v2 = -3.4e38f;
#pragma unroll
                    for (int e = 0; e < 8; ++e) if (e != e1 && lg[e] > v2) { v2 = lg[e]; e2 = e; }
                    const float g2 = 1.f / (1.f + __expf(v1 - v2)), g1 = 1.f - g2;
                    const int r1 = __shfl(cnt_e, e1); if (lane == e1) ++cnt_e;
                    const int r2 = __shfl(cnt_e, e2); if (lane == e2) ++cnt_e;
                    if (lane == i0 + k) { my_e1 = e1; my_e2 = e2; my_r1 = r1; my_r2 = r2; my_g1 = g1; my_g2 = g2; }
                }
            }
        }
        if (ROUTE) {
            if (lane < 8) ((int*)(F.ws + WS_WCNT))[grp * 8 + lane] = cnt_e;
            if (lane < 32) { const int m = grp * 32 + lane; int* r = route + 4 * m; r[0] = my_e1; r[1] = my_r1; r[2] = my_e2; r[3] = my_r2; gout[2 * m] = my_g1; gout[2 * m + 1] = my_g2; }
        }
    }
}

__device__ __forceinline__ f32x16 mfma32(bf16x8 a, bf16x8 b, f32x16 c) { return __builtin_amdgcn_mfma_f32_32x32x16_bf16(a, b, c, 0, 0, 0); }
__device__ __forceinline__ bf16x8 pack8(const f32x16& s, int b0) {
    u32x4 w; w.x = pg8::cvt_pk_bf16(s[b0], s[b0 + 1]); w.y = pg8::cvt_pk_bf16(s[b0 + 2], s[b0 + 3]); w.z = pg8::cvt_pk_bf16(s[b0 + 4], s[b0 + 5]); w.w = pg8::cvt_pk_bf16(s[b0 + 6], s[b0 + 7]);
    return __builtin_bit_cast(bf16x8, w);
}
__device__ __forceinline__ float max16(const f32x16& s) {
    float a = fmaxf(fmaxf(s[0], s[1]), fmaxf(s[2], s[3])), b = fmaxf(fmaxf(s[4], s[5]), fmaxf(s[6], s[7]));
    float c = fmaxf(fmaxf(s[8], s[9]), fmaxf(s[10], s[11])), d = fmaxf(fmaxf(s[12], s[13]), fmaxf(s[14], s[15]));
    return fmaxf(fmaxf(a, b), fmaxf(c, d));
}
__device__ __forceinline__ void softmax_pv(f32x16& s, float& m_run, float& l_run, f32x16& o0, f32x16& o1, const bf16* vt0, const bf16* vt1, int h) {
    float mx = max16(s); mx = fmaxf(mx, __shfl_xor(mx, 32));
    const float mn = fmaxf(m_run, mx), alpha = __builtin_amdgcn_exp2f(m_run - mn); m_run = mn;
    float ps = 0.f;
#pragma unroll
    for (int r = 0; r < 16; ++r) { const float p = __builtin_amdgcn_exp2f(s[r] - mn); s[r] = p; ps += p; }
    l_run = l_run * alpha + ps;
#pragma unroll
    for (int r = 0; r < 16; ++r) { o0[r] *= alpha; o1[r] *= alpha; }
    const bf16x8 p0 = pack8(s, 0), p1 = pack8(s, 8);
    const bf16x8 v00 = *(const bf16x8*)(vt0 + 8 * h), v01 = *(const bf16x8*)(vt0 + 16 + 8 * h), v10 = *(const bf16x8*)(vt1 + 8 * h), v11 = *(const bf16x8*)(vt1 + 16 + 8 * h);
    o0 = mfma32(v00, p0, o0); o0 = mfma32(v01, p1, o0);
    o1 = mfma32(v10, p0, o1); o1 = mfma32(v11, p1, o1);
}
__device__ __forceinline__ int kperm(int i) { return (i & 19) | ((i & 8) >> 1) | ((i & 4) << 1); }

__device__ __forceinline__ void dil_attn_phase(Frame& F) {
    LAS float* bt = (LAS float*)F.lds;
    { const float* btA = (const float*)(F.ws + WS_BTABA); for (int i = F.tid; i < 48 * 192; i += 512) { const int gh = i / 192, dl = i % 192 - 32; bt[i] = (dl >= 0 && dl <= 128) ? btA[gh * 132 + dl] : NEGB; } }
    __syncthreads();
    const int gw = F.vcu * NWAVES + F.wave, NGW = F.G * NWAVES, lane = F.lane, q = lane & 31, h = lane >> 5;
    const bf16* QK = (const bf16*)(F.ws + WS_SCR + S_QK); const bf16* VT = (const bf16*)(F.ws + WS_SCR + S_VT);
    bf16* OG = (bf16*)((unsigned char*)F.out + O_OG); float* LSE = (float*)((unsigned char*)F.out + O_LSE);
    constexpr int NTASK = 3 * 16 * 8 * 64;
    const int per = (NTASK + NGW - 1) / NGW;
    const int t_lo = gw * per, t_hi = (t_lo + per) < NTASK ? (t_lo + per) : NTASK;
    for (int task = t_lo; task < t_hi; ++task) {
        const int qt = task & 3, rn = (task >> 2) & 15, bl = (task >> 6) & 7, gh = task >> 9, g = gh >> 4, hh = gh & 15;
        const int nblk = 16 >> (2 * g); const bool has_prev = (rn & (nblk - 1)) != 0;
        const int n0 = bl * 2048 + rn * 128;
        const bf16* qrow = QK + ((size_t)g * TC + n0 + 32 * qt + q) * 2048 + hh * 64;
        bf16x8 qf[4];
#pragma unroll
        for (int d0 = 0; d0 < 4; ++d0) qf[d0] = *(const bf16x8*)(qrow + d0 * 16 + 8 * h);
        float m_run = NEGB, l_run = 0.f; f32x16 o0 = {}, o1 = {};
        const bf16* vbase0 = VT + ((size_t)g * 1024 + hh * 64 + q) * TC; const bf16* vbase1 = vbase0 + (size_t)32 * TC;
        const LAS float* btl = bt + gh * 192 + (q - 8 * h + 137);
#pragma unroll
        for (int t = 0; t < 5; ++t) {
            if (has_prev || qt + t > 3) {
                const int kr0 = n0 - 128 + 32 * qt + 32 * t;
                const bf16* krow = QK + ((size_t)g * TC + kr0 + kperm(q)) * 2048 + 1024 + hh * 64;
                f32x16 s;
#pragma unroll
                for (int r = 0; r < 16; ++r) s[r] = btl[-32 * t + 23 - 16 * (r >> 3) - (r & 7)];
#pragma unroll
                for (int d0 = 0; d0 < 4; ++d0) { const bf16x8 kf = *(const bf16x8*)(krow + d0 * 16 + 8 * h); s = mfma32(kf, qf[d0], s); }
                softmax_pv(s, m_run, l_run, o0, o1, vbase0 + kr0, vbase1 + kr0, h);
            }
        }
        const float l_tot = l_run + __shfl_xor(l_run, 32), inv = 1.f / l_tot;
        const size_t orow = (size_t)g * TC + n0 + 32 * qt + q;
        bf16* op = OG + orow * 1024 + hh * 64 + 4 * h;
#pragma unroll
        for (int gq = 0; gq < 4; ++gq) {
            u32x2 w0, w1; w0.x = pg8::cvt_pk_bf16(o0[4 * gq] * inv, o0[4 * gq + 1] * inv); w0.y = pg8::cvt_pk_bf16(o0[4 * gq + 2] * inv, o0[4 * gq + 3] * inv);
            w1.x = pg8::cvt_pk_bf16(o1[4 * gq] * inv, o1[4 * gq + 1] * inv); w1.y = pg8::cvt_pk_bf16(o1[4 * gq + 2] * inv, o1[4 * gq + 3] * inv);
            *(u32x2*)(op + 8 * gq) = w0; *(u32x2*)(op + 32 + 8 * gq) = w1; }
        if (h == 0) LSE[orow * 16 + hh] = m_run + __log2f(l_tot);
    }
}
__device__ __forceinline__ void dil_merge_phase(Frame& F, int ck) {
    const int gw = F.vcu * NWAVES + F.wave, NGW = F.G * NWAVES, lane = F.lane;
    const bf16* OG = (const bf16*)((unsigned char*)F.out + O_OG); const float* LSE = (const float*)((unsigned char*)F.out + O_LSE);
    unsigned char* att = F.ws + WS_SCR + S_ATT + (size_t)ck * TC * 1024;
    const int hh = lane >> 2;
    for (int tl0 = 2 * gw; tl0 < TC; tl0 += 2 * NGW) {
        size_t n[2][3]; float ls[2][3]; u32x4 x[2][3];
#pragma unroll
        for (int k = 0; k < 2; ++k) { const int tl = tl0 + k, bl = tl >> 11, tt = tl & 2047;
            n[k][0] = tl; n[k][1] = bl * 2048 + (tt & 3) * 512 + (tt >> 2); n[k][2] = bl * 2048 + (tt & 15) * 128 + (tt >> 4);
#pragma unroll
            for (int g = 0; g < 3; ++g) { ls[k][g] = LSE[((size_t)g * TC + n[k][g]) * 16 + hh]; x[k][g] = *(const u32x4*)((const unsigned char*)OG + ((size_t)g * TC + n[k][g]) * 1024 + 16 * lane); } }
#pragma unroll
        for (int k = 0; k < 2; ++k) {
            const float M = fmaxf(fmaxf(ls[k][0], ls[k][1]), ls[k][2]);
            float w[3]; float W = 0.f;
#pragma unroll
            for (int g = 0; g < 3; ++g) { w[g] = __builtin_amdgcn_exp2f(ls[k][g] - M); W += w[g]; }
            const float iw = 1.f / W;
            float acc[16];
#pragma unroll
            for (int j = 0; j < 16; ++j) acc[j] = 0.f;
#pragma unroll
            for (int g = 0; g < 3; ++g) { const float wg = w[g] * iw; float a[16];
#pragma unroll
                for (int c = 0; c < 4; ++c) { const f32x2 lo = __builtin_amdgcn_cvt_pk_f32_fp8((int)x[k][g][c], false), hi = __builtin_amdgcn_cvt_pk_f32_fp8((int)x[k][g][c], true); a[4 * c] = lo.x; a[4 * c + 1] = lo.y; a[4 * c + 2] = hi.x; a[4 * c + 3] = hi.y; }
#pragma unroll
                for (int j = 0; j < 16; ++j) acc[j] += wg * a[j]; }
            u32x4 y; y.x = pk4_fp8(acc[0], acc[1], acc[2], acc[3]); y.y = pk4_fp8(acc[4], acc[5], acc[6], acc[7]); y.z = pk4_fp8(acc[8], acc[9], acc[10], acc[11]); y.w = pk4_fp8(acc[12], acc[13], acc[14], acc[15]);
            *(u32x4*)(att + (size_t)(tl0 + k) * 1024 + 16 * lane) = y;
        }
    }
}

__device__ __forceinline__ void conv_phase(Frame& F, const float* cw) {
    const int gw = F.vcu * NWAVES + F.wave, NGW = F.G * NWAVES, lane = F.lane;
    const bf16* gbp = (const bf16*)(F.ws + WS_SCR + S_BCX); const bf16* up = (const bf16*)(F.ws + WS_SCR + S_BCX + (size_t)128 * MiB); bf16* p = (bf16*)(F.ws + WS_SCR + S_P);
    for (int item = gw; item < (T / 32) * 2; item += NGW) {
        const int half = item & 1, tb = item >> 1, t0 = tb * 32, c0 = half * 512 + lane * 8;
        float w0[8], w1[8], w2[8];
#pragma unroll
        for (int j = 0; j < 8; ++j) { w0[j] = cw[c0 + j]; w1[j] = cw[1024 + c0 + j]; w2[j] = cw[2048 + c0 + j]; }
        float u1[8], u2[8];
        const bool first = (t0 & 2047) == 0;
#pragma unroll
        for (int j = 0; j < 8; ++j) { u1[j] = 0.f; u2[j] = 0.f; }
        if (!first) { unpack8(*(const u32x4*)(up + (size_t)(t0 - 2) * 1024 + c0), u2); unpack8(*(const u32x4*)(up + (size_t)(t0 - 1) * 1024 + c0), u1); }
        for (int i = 0; i < 32; ++i) { const size_t r = (size_t)(t0 + i) * 1024;
            const u32x4 gb = *(const u32x4*)(gbp + r + c0), uu = *(const u32x4*)(up + r + c0);
            float u0[8], b[8]; unpack8(uu, u0); unpack8(gb, b);
            float o[8];
#pragma unroll
            for (int j = 0; j < 8; ++j) { o[j] = b[j] * (w0[j] * u2[j] + w1[j] * u1[j] + w2[j] * u0[j]); u2[j] = u1[j]; u1[j] = u0[j]; }
            u32x4 x; x.x = pk2(o[0], o[1]); x.y = pk2(o[2], o[3]); x.z = pk2(o[4], o[5]); x.w = pk2(o[6], o[7]);
            *(u32x4*)(p + (size_t)(t0 + i) * 1024 + c0) = x; }
    }
}

__device__ __forceinline__ void kmean_phase(Frame& F) {
    const int gw = F.vcu * NWAVES + F.wave, NGW = F.G * NWAVES, lane = F.lane;
    const bf16* QK = (const bf16*)(F.ws + WS_SCR + S_CQK); float* km = (float*)(F.ws + WS_KMEAN);
    const int kq = lane >> 3, dc = lane & 7;
    for (int u = gw; u < NB * NH * 8; u += NGW) { const int blk = u & 7, hh = (u >> 3) & 15, b = u >> 7;
        float a[8];
#pragma unroll
        for (int j = 0; j < 8; ++j) a[j] = 0.f;
        const bf16* kp = QK + ((size_t)b * SEQ + blk * 256 + kq) * 2048 + 1024 + hh * 64 + dc * 8;
#pragma unroll 8
        for (int i = 0; i < 32; ++i) { const u32x4 x = *(const u32x4*)(kp + (size_t)i * 8 * 2048);
            a[0] += bflo(x.x); a[1] += bfhi(x.x); a[2] += bflo(x.y); a[3] += bfhi(x.y); a[4] += bflo(x.z); a[5] += bfhi(x.z); a[6] += bflo(x.w); a[7] += bfhi(x.w); }
#pragma unroll
        for (int j = 0; j < 8; ++j) { a[j] += __shfl_xor(a[j], 8); a[j] += __shfl_xor(a[j], 16); a[j] += __shfl_xor(a[j], 32); }
        if (lane < 8) { float* o = km + (size_t)u * 64 + lane * 8;
#pragma unroll
            for (int j = 0; j < 8; ++j) o[j] = a[j] * (1.f / 256.f); }
    }
}
__device__ __forceinline__ void moba_unit(Frame& F, int b, int hh, int nb, LAS float* bt, int& cur_h) {
    const int lane = F.lane, q = lane & 31, h = lane >> 5, w = F.wave;
    const bf16* QK = (const bf16*)(F.ws + WS_SCR + S_CQK); const bf16* VT = (const bf16*)(F.ws + WS_SCR + S_CVT);
    bf16* att = (bf16*)(F.ws + WS_SCR + S_CATT); const float* km = (const float*)(F.ws + WS_KMEAN);
    if (hh != cur_h) { __syncthreads(); const float* btC = (const float*)(F.ws + WS_BTABC) + hh * 2048; for (int i = F.tid; i < 2048; i += 512) bt[i] = btC[i]; cur_h = hh; __syncthreads(); }
    const size_t tq = (size_t)b * SEQ + nb * 256 + 32 * w + q;
    const bf16* qrow = QK + tq * 2048 + hh * 64;
    bf16x8 qf[4];
#pragma unroll
    for (int d0 = 0; d0 < 4; ++d0) qf[d0] = *(const bf16x8*)(qrow + d0 * 16 + 8 * h);
    unsigned sel = 0;
    if (nb > 0) {
        float gsc[7];
#pragma unroll
        for (int m = 0; m < 7; ++m) { float s = 0.f;
            if (m < nb) { const float* kmp = km + (((size_t)b * NH + hh) * 8 + m) * 64;
#pragma unroll
                for (int d0 = 0; d0 < 4; ++d0) { const f32x4 k0 = *(const f32x4*)(kmp + d0 * 16 + 8 * h), k1 = *(const f32x4*)(kmp + d0 * 16 + 8 * h + 4); const u32x4 qq = __builtin_bit_cast(u32x4, qf[d0]);
                    s += bflo(qq.x) * k0.x + bfhi(qq.x) * k0.y + bflo(qq.y) * k0.z + bfhi(qq.y) * k0.w + bflo(qq.z) * k1.x + bfhi(qq.z) * k1.y + bflo(qq.w) * k1.z + bfhi(qq.w) * k1.w; }
                s += __shfl_xor(s, 32); }
            gsc[m] = m < nb ? s : -3.0e38f; }
        const int nsel = nb < 3 ? nb : 3;
#pragma unroll
        for (int r = 0; r < 3; ++r) { if (r < nsel) { int bi = -1; float bv = -3.4e38f;
#pragma unroll
                for (int m = 0; m < 7; ++m) if (!((sel >> m) & 1u) && gsc[m] > bv) { bv = gsc[m]; bi = m; }
                sel |= 1u << bi; } }
    }
#ifdef MK_SELFCHECK
    if (h == 0) ((unsigned*)(F.ws + WS_NEED + 3 * MiB))[tq * 16 + hh] = sel;
#endif
    float m_run = NEGB, l_run = 0.f; f32x16 o0 = {}, o1 = {};
    const bf16* vbase0 = VT + ((size_t)hh * 64 + q) * T + (size_t)b * SEQ; const bf16* vbase1 = vbase0 + (size_t)32 * T;
    const int qpos = nb * 256 + 32 * w + q;
    for (int m = 0; m < nb; ++m) {
        const bool mine = (sel >> m) & 1u;
        if (__ballot(mine) == 0ull) continue;
        for (int kt = 0; kt < 8; ++kt) {
            const int kr0 = m * 256 + 32 * kt;
            const bf16* krow = QK + ((size_t)b * SEQ + kr0 + kperm(q)) * 2048 + 1024 + hh * 64;
            f32x16 s = {};
#pragma unroll
            for (int d0 = 0; d0 < 4; ++d0) { const bf16x8 kf = *(const bf16x8*)(krow + d0 * 16 + 8 * h); s = mfma32(kf, qf[d0], s); }
#pragma unroll
            for (int r = 0; r < 16; ++r) { const int kap = 16 * (r >> 3) + 8 * h + (r & 7); const float bb = bt[qpos - kr0 - kap]; s[r] = mine ? s[r] + bb : NEGB; }
            softmax_pv(s, m_run, l_run, o0, o1, vbase0 + kr0, vbase1 + kr0, h);
        }
    }
    for (int kt = 0; kt <= w; ++kt) {
        const int kr0 = nb * 256 + 32 * kt;
        const bf16* krow = QK + ((size_t)b * SEQ + kr0 + kperm(q)) * 2048 + 1024 + hh * 64;
        f32x16 s = {};
#pragma unroll
        for (int d0 = 0; d0 < 4; ++d0) { const bf16x8 kf = *(const bf16x8*)(krow + d0 * 16 + 8 * h); s = mfma32(kf, qf[d0], s); }
#pragma unroll
        for (int r = 0; r < 16; ++r) { const int kap = 16 * (r >> 3) + 8 * h + (r & 7); const int dd = qpos - kr0 - kap; const float bb = bt[dd < 0 ? 0 : dd]; s[r] = dd >= 0 ? s[r] + bb : NEGB; }
        softmax_pv(s, m_run, l_run, o0, o1, vbase0 + kr0, vbase1 + kr0, h);
    }
    const float l_tot = l_run + __shfl_xor(l_run, 32), inv = 1.f / l_tot;
#ifdef MK_SELFCHECK
    if (h == 0) ((float*)(F.ws + WS_NEED + 7 * MiB))[tq * 16 + hh] = m_run + __log2f(l_tot);
#endif
    bf16* op = att + tq * 1024 + hh * 64 + 4 * h;
#pragma unroll
    for (int gq = 0; gq < 4; ++gq) {
        u32x2 w0, w1; w0.x = pg8::cvt_pk_bf16(o0[4 * gq] * inv, o0[4 * gq + 1] * inv); w0.y = pg8::cvt_pk_bf16(o0[4 * gq + 2] * inv, o0[4 * gq + 3] * inv);
        w1.x = pg8::cvt_pk_bf16(o1[4 * gq] * inv, o1[4 * gq + 1] * inv); w1.y = pg8::cvt_pk_bf16(o1[4 * gq + 2] * inv, o1[4 * gq + 3] * inv);
        *(u32x2*)(op + 8 * gq) = w0; *(u32x2*)(op + 32 + 8 * gq) = w1; }
}
__device__ __forceinline__ void moba_phase(Frame& F) {
    LAS float* bt = (LAS float*)F.lds; int cur_h = -1;
    const int NP = NB * NH * 4, per = (NP + F.G - 1) / F.G;
    const int lo = F.vcu * per, hi = (lo + per) < NP ? (lo + per) : NP;
    for (int pu = lo; pu < hi; ++pu) { const int j = pu & 3, hh = (pu >> 2) & 15, b = pu >> 6;
        moba_unit(F, b, hh, 7 - j, bt, cur_h); moba_unit(F, b, hh, j, bt, cur_h); }
}


constexpr int AKP = 72;
constexpr int ATILE = 64 * AKP * 2;
struct AttnSt { float m, l; f32x16 o0, o1; };
template <bool MASKED>
__device__ __forceinline__ void attn_tile(const LAS bf16* Kt, const LAS bf16* Vt, const LAS float* bl, const bf16x8 (&qf)[4], AttnSt& st, int q, int h, bool mine) {
    f32x16 s;
#pragma unroll
    for (int r = 0; r < 16; ++r) s[r] = bl[23 - 16 * (r >> 3) - (r & 7)];
    const LAS bf16* kr = Kt + kperm(q) * AKP + 8 * h;
#pragma unroll
    for (int d0 = 0; d0 < 4; ++d0) s = mfma32(*(const LAS bf16x8*)(kr + d0 * 16), qf[d0], s);
    float mx = max16(s); mx = fmaxf(mx, __shfl_xor(mx, 32));
    float mn = fmaxf(st.m, mx); if (MASKED) mn = mine ? mn : st.m;
    const float alpha = __builtin_amdgcn_exp2f(st.m - mn);
    float ps = 0.f;
#pragma unroll
    for (int r = 0; r < 16; ++r) { const float p = __builtin_amdgcn_exp2f(s[r] - mn); s[r] = p; ps += p; }
    bf16x8 p0 = pack8(s, 0), p1 = pack8(s, 8);
    if (MASKED) { if (!mine) { p0 = (bf16x8){0, 0, 0, 0, 0, 0, 0, 0}; p1 = p0; ps = 0.f; } }
    st.l = st.l * alpha + ps; st.m = mn;
    if (__ballot(alpha != 1.0f) != 0ull) {
#pragma unroll
        for (int r = 0; r < 16; ++r) { st.o0[r] *= alpha; st.o1[r] *= alpha; } }
    const LAS bf16* v0 = Vt + q * AKP + 8 * h; const LAS bf16* v1 = v0 + 32 * AKP;
    st.o0 = mfma32(*(const LAS bf16x8*)v0, p0, st.o0); st.o0 = mfma32(*(const LAS bf16x8*)(v0 + 16), p1, st.o0);
    st.o1 = mfma32(*(const LAS bf16x8*)v1, p0, st.o1); st.o1 = mfma32(*(const LAS bf16x8*)(v1 + 16), p1, st.o1);
}
__device__ __forceinline__ void attn_store(const AttnSt& st, bf16* op  , float inv) {
#pragma unroll
    for (int gq = 0; gq < 4; ++gq) {
        u32x2 w0, w1; w0.x = pg8::cvt_pk_bf16(st.o0[4 * gq] * inv, st.o0[4 * gq + 1] * inv); w0.y = pg8::cvt_pk_bf16(st.o0[4 * gq + 2] * inv, st.o0[4 * gq + 3] * inv);
        w1.x = pg8::cvt_pk_bf16(st.o1[4 * gq] * inv, st.o1[4 * gq + 1] * inv); w1.y = pg8::cvt_pk_bf16(st.o1[4 * gq + 2] * inv, st.o1[4 * gq + 3] * inv);
        *(u32x2*)(op + 8 * gq) = w0; *(u32x2*)(op + 32 + 8 * gq) = w1; }
}

__device__ __forceinline__ void attn_store8(const AttnSt& st, unsigned char* op  , float inv) {
#pragma unroll
    for (int gq = 0; gq < 4; ++gq) {
        *(unsigned*)(op + 8 * gq) = pk4_fp8(st.o0[4 * gq] * inv, st.o0[4 * gq + 1] * inv, st.o0[4 * gq + 2] * inv, st.o0[4 * gq + 3] * inv);
        *(unsigned*)(op + 32 + 8 * gq) = pk4_fp8(st.o1[4 * gq] * inv, st.o1[4 * gq + 1] * inv, st.o1[4 * gq + 2] * inv, st.o1[4 * gq + 3] * inv); }
}

__device__ __forceinline__ void dil_attn_phase2(Frame& F) {
    LAS float* bt = (LAS float*)F.lds;
    { const float* btA = (const float*)(F.ws + WS_BTABA); for (int i = F.tid; i < 48 * 192; i += 512) { const int gh = i / 192, dl = i % 192 - 32; bt[i] = (dl >= 0 && dl <= 128) ? btA[gh * 132 + dl] : NEGB; } }
    __syncthreads();
    constexpr int TBL = 48 * 192 * 4;
    const int lane = F.lane, q = lane & 31, h = lane >> 5, w = F.wave, uw = w >> 2, qt = w & 3, t = F.tid, tu = t >> 8, tt = t & 255, srow = tt >> 3, sch = tt & 7;
    const bf16* QK = (const bf16*)(F.ws + WS_SCR + S_QK); const bf16* VT = (const bf16*)(F.ws + WS_SCR + S_VT);
    bf16* OG = (bf16*)((unsigned char*)F.out + O_OG); float* LSE = (float*)((unsigned char*)F.out + O_LSE);
    for (int du = F.vcu; du < 3072; du += F.G) {
        const int g = du >> 10, rem = du & 1023, hh = rem >> 6, blp = (rem >> 4) & 3, rn = rem & 15, gh = g * 16 + hh;
        const int nblk = 16 >> (2 * g); const bool has_prev = (rn & (nblk - 1)) != 0;
        const int j0 = has_prev ? 0 : 2;
        const int n0s = (2 * blp + tu) * 2048 + rn * 128;
        const bf16* ksrc = QK + ((size_t)g * TC + n0s - 128 + srow) * 2048 + 1024 + hh * 64 + sch * 8;
        const bf16* vsrc = VT + ((size_t)g * 1024 + hh * 64 + srow) * TC + (n0s - 128) + sch * 8;
        const int sdst = srow * AKP + sch * 8;
        const int n0 = (2 * blp + uw) * 2048 + rn * 128;
        const bf16* qrow = QK + ((size_t)g * TC + n0 + 32 * qt + q) * 2048 + hh * 64;
        bf16x8 qf[4];
#pragma unroll
        for (int d0 = 0; d0 < 4; ++d0) qf[d0] = *(const bf16x8*)(qrow + d0 * 16 + 8 * h);
        AttnSt st; st.m = NEGB; st.l = 0.f; st.o0 = (f32x16){}; st.o1 = (f32x16){};
        u32x4 k0, k1, v0, v1;
        k0 = *(const u32x4*)(ksrc + (size_t)(64 * j0) * 2048); k1 = *(const u32x4*)(ksrc + (size_t)(64 * j0 + 32) * 2048);
        v0 = *(const u32x4*)(vsrc + 64 * j0); v1 = *(const u32x4*)(vsrc + (size_t)32 * TC + 64 * j0);
        { LAS bf16* kb = (LAS bf16*)(F.lds + TBL + (0 * 2 + tu) * 2 * ATILE); LAS bf16* vb = kb + 64 * AKP;
          *(LAS u32x4*)(kb + sdst) = k0; *(LAS u32x4*)(kb + 32 * AKP + sdst) = k1; *(LAS u32x4*)(vb + sdst) = v0; *(LAS u32x4*)(vb + 32 * AKP + sdst) = v1; }
        __syncthreads();
        int pb = 0;
        for (int j = j0; j < 4; ++j) {
            const bool more = j + 1 < 4;
            if (more) { k0 = *(const u32x4*)(ksrc + (size_t)(64 * (j + 1)) * 2048); k1 = *(const u32x4*)(ksrc + (size_t)(64 * (j + 1) + 32) * 2048);
                        v0 = *(const u32x4*)(vsrc + 64 * (j + 1)); v1 = *(const u32x4*)(vsrc + (size_t)32 * TC + 64 * (j + 1)); }
            const LAS bf16* kb = (const LAS bf16*)(F.lds + TBL + (pb * 2 + uw) * 2 * ATILE); const LAS bf16* vb = kb + 64 * AKP;
#pragma unroll
            for (int t2 = 0; t2 < 2; ++t2) { const int t32 = 2 * j + t2;
                if (t32 >= qt && t32 <= qt + 4) {
                    const LAS float* bl = bt + gh * 192 + 32 + (32 * qt + q + 128 - 32 * t32 - 8 * h - 23);
                    attn_tile<false>(kb + 32 * t2 * AKP, vb + 32 * t2, bl, qf, st, q, h, true); } }
            if (more) { LAS bf16* kn = (LAS bf16*)(F.lds + TBL + ((pb ^ 1) * 2 + tu) * 2 * ATILE); LAS bf16* vn = kn + 64 * AKP;
                *(LAS u32x4*)(kn + sdst) = k0; *(LAS u32x4*)(kn + 32 * AKP + sdst) = k1; *(LAS u32x4*)(vn + sdst) = v0; *(LAS u32x4*)(vn + 32 * AKP + sdst) = v1; }
            __syncthreads();
            pb ^= 1;
        }
        const float l_tot = st.l + __shfl_xor(st.l, 32), inv = 1.f / l_tot;
        const size_t orow = (size_t)g * TC + n0 + 32 * qt + q;
        attn_store(st, OG + orow * 1024 + hh * 64 + 4 * h, inv);
        if (h == 0) LSE[orow * 16 + hh] = st.m + __log2f(l_tot);
    }
}

__device__ __forceinline__ void moba_unit2(Frame& F, int b, int hh, int nb, LAS float* bt, int& cur_h) {
    constexpr int TBL = 8448;
    const int lane = F.lane, q = lane & 31, h = lane >> 5, w = F.wave, t = F.tid, srow = t >> 3, sch = t & 7;
    const bf16* QK = (const bf16*)(F.ws + WS_SCR + S_CQK); const bf16* VT = (const bf16*)(F.ws + WS_SCR + S_CVT);
    bf16* att = (bf16*)(F.ws + WS_SCR + S_CATT); const float* km = (const float*)(F.ws + WS_KMEAN);
    if (hh != cur_h) { __syncthreads(); const float* btC = (const float*)(F.ws + WS_BTABC) + hh * 2048; for (int i = t; i < 2048 + 32; i += 512) bt[i] = i < 32 ? NEGB : btC[i - 32]; cur_h = hh; __syncthreads(); }
    const size_t tq = (size_t)b * SEQ + nb * 256 + 32 * w + q;
    const bf16* qrow = QK + tq * 2048 + hh * 64;
    bf16x8 qf[4];
#pragma unroll
    for (int d0 = 0; d0 < 4; ++d0) qf[d0] = *(const bf16x8*)(qrow + d0 * 16 + 8 * h);
    unsigned sel = 0;
    if (nb > 0) {
        float gsc[7];
#pragma unroll
        for (int m = 0; m < 7; ++m) { float s = 0.f;
            if (m < nb) { const float* kmp = km + (((size_t)b * NH + hh) * 8 + m) * 64;
#pragma unroll
                for (int d0 = 0; d0 < 4; ++d0) { const f32x4 k0 = *(const f32x4*)(kmp + d0 * 16 + 8 * h), k1 = *(const f32x4*)(kmp + d0 * 16 + 8 * h + 4); const u32x4 qq = __builtin_bit_cast(u32x4, qf[d0]);
                    s += bflo(qq.x) * k0.x + bfhi(qq.x) * k0.y + bflo(qq.y) * k0.z + bfhi(qq.y) * k0.w + bflo(qq.z) * k1.x + bfhi(qq.z) * k1.y + bflo(qq.w) * k1.z + bfhi(qq.w) * k1.w; }
                s += __shfl_xor(s, 32); }
            gsc[m] = m < nb ? s : -3.0e38f; }
        const int nsel = nb < 3 ? nb : 3;
#pragma unroll
        for (int r = 0; r < 3; ++r) { if (r < nsel) { int bi = 0; float bv = -3.4e38f;
#pragma unroll
                for (int m = 0; m < 7; ++m) if (!((sel >> m) & 1u) && gsc[m] > bv) { bv = gsc[m]; bi = m; }
                sel |= 1u << bi; } }
    }
    AttnSt st; st.m = NEGB; st.l = 0.f; st.o0 = (f32x16){}; st.o1 = (f32x16){};
    const int qpos = nb * 256 + 32 * w + q, nsteps = 4 * nb + 4;
    const bf16* ksrc = QK + ((size_t)b * SEQ + srow) * 2048 + 1024 + hh * 64 + sch * 8;
    const bf16* vsrc = VT + ((size_t)hh * 64 + srow) * T + (size_t)b * SEQ + sch * 8;
    const int sdst = srow * AKP + sch * 8;
    u32x4 kreg = *(const u32x4*)ksrc, vreg = *(const u32x4*)vsrc;
    { LAS bf16* kb = (LAS bf16*)(F.lds + TBL); *(LAS u32x4*)(kb + sdst) = kreg; *(LAS u32x4*)(kb + 64 * AKP + sdst) = vreg; }
    __syncthreads();
    int pb = 0;
    for (int s = 0; s < nsteps; ++s) {
        const bool more = s + 1 < nsteps;
        if (more) { kreg = *(const u32x4*)(ksrc + (size_t)(64 * (s + 1)) * 2048); vreg = *(const u32x4*)(vsrc + 64 * (s + 1)); }
        const LAS bf16* kb = (const LAS bf16*)(F.lds + TBL + pb * 2 * ATILE); const LAS bf16* vb = kb + 64 * AKP;
        if (s < 4 * nb) {
            const bool mine = (sel >> (s >> 2)) & 1u;
            if (__ballot(mine) != 0ull) {
#pragma unroll
                for (int t2 = 0; t2 < 2; ++t2) { const LAS float* bl = bt + 32 + (qpos - 8 * h - (64 * s + 32 * t2) - 23);
                    attn_tile<true>(kb + 32 * t2 * AKP, vb + 32 * t2, bl, qf, st, q, h, mine); } }
        } else {
#pragma unroll
            for (int t2 = 0; t2 < 2; ++t2) { const int t32 = (s - 4 * nb) * 2 + t2;
                if (t32 <= w) { const LAS float* bl = bt + 32 + (qpos - 8 * h - (64 * s + 32 * t2) - 23);
                    attn_tile<false>(kb + 32 * t2 * AKP, vb + 32 * t2, bl, qf, st, q, h, true); } }
        }
        if (more) { LAS bf16* kn = (LAS bf16*)(F.lds + TBL + (pb ^ 1) * 2 * ATILE); *(LAS u32x4*)(kn + sdst) = kreg; *(LAS u32x4*)(kn + 64 * AKP + sdst) = vreg; }
        __syncthreads();
        pb ^= 1;
    }
    const float l_tot = st.l + __shfl_xor(st.l, 32), inv = 1.f / l_tot;
    attn_store(st, att + tq * 1024 + hh * 64 + 4 * h, inv);
}
__device__ __forceinline__ void moba_phase2(Frame& F) {
    LAS float* bt = (LAS float*)F.lds; int cur_h = -1;
    const int NP = NB * NH * 4, per = (NP + F.G - 1) / F.G;
    const int lo = F.vcu * per, hi = (lo + per) < NP ? (lo + per) : NP;
    for (int pu = lo; pu < hi; ++pu) { const int j = pu & 3, hh = (pu >> 2) & 15, b = pu >> 6;
        moba_unit2(F, b, hh, 7 - j, bt, cur_h); moba_unit2(F, b, hh, j, bt, cur_h); }
}


__device__ __forceinline__ float xhalf_max(float m) { auto rr = __builtin_amdgcn_permlane32_swap(__float_as_uint(m), __float_as_uint(m), false, false); return fmaxf(__uint_as_float(rr[0]), __uint_as_float(rr[1])); }
__device__ __forceinline__ float xhalf_sum(float m) { auto rr = __builtin_amdgcn_permlane32_swap(__float_as_uint(m), __float_as_uint(m), false, false); return __uint_as_float(rr[0]) + __uint_as_float(rr[1]); }
template <bool MASKED>
__device__ __forceinline__ void attn_tile2(const LAS bf16* Kt, const LAS bf16* Vt, const LAS float* bl0, const bf16x8 (&qf)[4], AttnSt& st, int q, int h, bool mine) {
    f32x16 s0, s1;
#pragma unroll
    for (int r = 0; r < 16; ++r) { s0[r] = bl0[23 - 16 * (r >> 3) - (r & 7)]; s1[r] = bl0[-32 + 23 - 16 * (r >> 3) - (r & 7)]; }
    const LAS bf16* kr = Kt + kperm(q) * AKP + 8 * h;
#pragma unroll
    for (int d0 = 0; d0 < 4; ++d0) { s0 = mfma32(*(const LAS bf16x8*)(kr + d0 * 16), qf[d0], s0); s1 = mfma32(*(const LAS bf16x8*)(kr + 32 * AKP + d0 * 16), qf[d0], s1); }
    const float mx = xhalf_max(fmaxf(max16(s0), max16(s1)));
    float mn = fmaxf(st.m, mx); if (MASKED) mn = mine ? mn : st.m;
    const float alpha = __builtin_amdgcn_exp2f(st.m - mn);
    float ps0 = 0.f, ps1 = 0.f;
#pragma unroll
    for (int r = 0; r < 16; ++r) { const float p = __builtin_amdgcn_exp2f(s0[r] - mn); s0[r] = p; ps0 += p; const float p2 = __builtin_amdgcn_exp2f(s1[r] - mn); s1[r] = p2; ps1 += p2; }
    bf16x8 p00 = pack8(s0, 0), p01 = pack8(s0, 8), p10 = pack8(s1, 0), p11 = pack8(s1, 8);
    float ps = ps0 + ps1;
    if (MASKED) { if (!mine) { p00 = (bf16x8){0, 0, 0, 0, 0, 0, 0, 0}; p01 = p00; p10 = p00; p11 = p00; ps = 0.f; } }
    st.l = st.l * alpha + ps; st.m = mn;
    if (__ballot(alpha != 1.0f) != 0ull) {
#pragma unroll
        for (int r = 0; r < 16; ++r) { st.o0[r] *= alpha; st.o1[r] *= alpha; } }
    const LAS bf16* v0 = Vt + q * AKP + 8 * h; const LAS bf16* v1 = v0 + 32 * AKP;
    st.o0 = mfma32(*(const LAS bf16x8*)v0, p00, st.o0); st.o1 = mfma32(*(const LAS bf16x8*)v1, p00, st.o1);
    st.o0 = mfma32(*(const LAS bf16x8*)(v0 + 16), p01, st.o0); st.o1 = mfma32(*(const LAS bf16x8*)(v1 + 16), p01, st.o1);
    st.o0 = mfma32(*(const LAS bf16x8*)(v0 + 32), p10, st.o0); st.o1 = mfma32(*(const LAS bf16x8*)(v1 + 32), p10, st.o1);
    st.o0 = mfma32(*(const LAS bf16x8*)(v0 + 48), p11, st.o0); st.o1 = mfma32(*(const LAS bf16x8*)(v1 + 48), p11, st.o1);
}

__device__ __forceinline__ u32x4 f8x8_bf16(u32x2 v) {
    const f32x2 a = __builtin_amdgcn_cvt_pk_f32_fp8((int)v.x, false), b = __builtin_amdgcn_cvt_pk_f32_fp8((int)v.x, true), c = __builtin_amdgcn_cvt_pk_f32_fp8((int)v.y, false), d = __builtin_amdgcn_cvt_pk_f32_fp8((int)v.y, true);
    u32x4 r; r.x = pg8::cvt_pk_bf16(a.x, a.y); r.y = pg8::cvt_pk_bf16(b.x, b.y); r.z = pg8::cvt_pk_bf16(c.x, c.y); r.w = pg8::cvt_pk_bf16(d.x, d.y); return r;
}
__device__ __forceinline__ void dil_attn_phase3(Frame& F) {
    LAS float* bt = (LAS float*)F.lds;
    { const float* btA = (const float*)(F.ws + WS_BTABA); for (int i = F.tid; i < 48 * 192; i += 512) { const int gh = i / 192, dl = i % 192 - 32; bt[i] = (dl >= 0 && dl <= 128) ? btA[gh * 132 + dl] : NEGB; } }
    constexpr int TBL = 48 * 192 * 4;
    const int lane = F.lane, q = lane & 31, h = lane >> 5, w = F.wave, uw = w >> 2, qt = w & 3, t = F.tid, tu = t >> 8, tt = t & 255, srow = tt >> 3, sch = tt & 7;
    const unsigned char* QK = F.ws + WS_SCR + S_QK; const unsigned char* VT = F.ws + WS_SCR + S_VT;
    bf16* OG = (bf16*)((unsigned char*)F.out + O_OG); float* LSE = (float*)((unsigned char*)F.out + O_LSE);
    const int sdst = srow * AKP + sch * 8;
    int du = F.vcu;
    if (du >= 3072) { __syncthreads(); return; }
    int g = du >> 10, hh = (du >> 6) & 15, blp = (du >> 4) & 3, rn = du & 15;
    int j = ((rn & ((16 >> (2 * g)) - 1)) != 0) ? 0 : 2;
    u32x2 k0, k1, v0, v1; u32x2 qn[4]; bf16x8 qf[4];
#define DIL_LOADS(G_, HH_, BLP_, RN_, J_) do { const int n0s_ = (2 * (BLP_) + tu) * 2048 + (RN_) * 128 - 128 + 64 * (J_); \
        const unsigned char* ks_ = QK + ((size_t)(G_) * TC + n0s_ + srow) * 2048 + 1024 + (HH_) * 64 + sch * 8; \
        const unsigned char* vs_ = VT + ((size_t)(G_) * 1024 + (HH_) * 64 + srow) * TC + n0s_ + sch * 8; \
        k0 = *(const u32x2*)ks_; k1 = *(const u32x2*)(ks_ + (size_t)32 * 2048); v0 = *(const u32x2*)vs_; v1 = *(const u32x2*)(vs_ + (size_t)32 * TC); } while (0)
#define DIL_QLOADS(G_, HH_, BLP_, RN_) do { const unsigned char* qr_ = QK + ((size_t)(G_) * TC + (2 * (BLP_) + uw) * 2048 + (RN_) * 128 + 32 * qt + q) * 2048 + (HH_) * 64; \
        _Pragma("unroll") for (int d0 = 0; d0 < 4; ++d0) qn[d0] = *(const u32x2*)(qr_ + d0 * 16 + 8 * h); } while (0)
#define DIL_WRITE(PB_) do { LAS bf16* kb_ = (LAS bf16*)(F.lds + TBL + ((PB_) * 2 + tu) * 2 * ATILE); LAS bf16* vb_ = kb_ + 64 * AKP; \
        *(LAS u32x4*)(kb_ + sdst) = f8x8_bf16(k0); *(LAS u32x4*)(kb_ + 32 * AKP + sdst) = f8x8_bf16(k1); *(LAS u32x4*)(vb_ + sdst) = f8x8_bf16(v0); *(LAS u32x4*)(vb_ + 32 * AKP + sdst) = f8x8_bf16(v1); } while (0)
    DIL_LOADS(g, hh, blp, rn, j); DIL_QLOADS(g, hh, blp, rn);
    DIL_WRITE(0);
#pragma unroll
    for (int d0 = 0; d0 < 4; ++d0) qf[d0] = __builtin_bit_cast(bf16x8, f8x8_bf16(qn[d0]));
    __syncthreads();
    AttnSt st; st.m = NEGB; st.l = 0.f; st.o0 = (f32x16){}; st.o1 = (f32x16){};
    int pb = 0;
    for (;;) {
        const bool last = (j == 3);
        int ng = g, nhh = hh, nblp = blp, nrn = rn, nj = j + 1; bool more = true;
        if (last) { const int nd = du + F.G; more = nd < 3072; ng = nd >> 10; nhh = (nd >> 6) & 15; nblp = (nd >> 4) & 3; nrn = nd & 15; nj = ((nrn & ((16 >> (2 * ng)) - 1)) != 0) ? 0 : 2; }
        if (more) { DIL_LOADS(ng, nhh, nblp, nrn, nj); if (last) DIL_QLOADS(ng, nhh, nblp, nrn); }
        { const LAS bf16* kb = (const LAS bf16*)(F.lds + TBL + (pb * 2 + uw) * 2 * ATILE); const LAS bf16* vb = kb + 64 * AKP;
          const int gh = g * 16 + hh, ta = 2 * j, tb = 2 * j + 1;
          const bool a_on = ta >= qt && ta <= qt + 4, b_on = tb >= qt && tb <= qt + 4;
          const LAS float* bl = bt + gh * 192 + 32 + (32 * qt + q + 128 - 32 * ta - 8 * h - 23);
          if (a_on && b_on) attn_tile2<false>(kb, vb, bl, qf, st, q, h, true);
          else if (a_on) attn_tile<false>(kb, vb, bl, qf, st, q, h, true);
          else if (b_on) attn_tile<false>(kb + 32 * AKP, vb + 32, bl - 32, qf, st, q, h, true); }
        if (more) DIL_WRITE(pb ^ 1);
        if (last) {
            const float l_tot = xhalf_sum(st.l), inv = 1.f / l_tot;
            const size_t orow = (size_t)g * TC + (2 * blp + uw) * 2048 + rn * 128 + 32 * qt + q;
            attn_store8(st, (unsigned char*)OG + orow * 1024 + hh * 64 + 4 * h, inv * ASCALE8);
            if (h == 0) LSE[orow * 16 + hh] = st.m + __log2f(l_tot);
            st.m = NEGB; st.l = 0.f; st.o0 = (f32x16){}; st.o1 = (f32x16){};
#pragma unroll
            for (int d0 = 0; d0 < 4; ++d0) qf[d0] = __builtin_bit_cast(bf16x8, f8x8_bf16(qn[d0]));
        }
        __syncthreads();
        pb ^= 1;
        if (!more) break;
        if (last) du += F.G;
        g = ng; hh = nhh; blp = nblp; rn = nrn; j = nj;
    }
#undef DIL_LOADS
#undef DIL_QLOADS
#undef DIL_WRITE
}

__device__ __forceinline__ void moba_phase3(Frame& F) {
    constexpr int TBL = 8448, KMO = TBL + 4 * ATILE;
    LAS float* bt = (LAS float*)F.lds; LAS float* kml = (LAS float*)(F.lds + KMO);
    const int lane = F.lane, q = lane & 31, h = lane >> 5, w = F.wave, t = F.tid, srow = t >> 3, sch = t & 7;
    const bf16* QK = (const bf16*)(F.ws + WS_SCR + S_CQK); const bf16* VT = (const bf16*)(F.ws + WS_SCR + S_CVT);
    bf16* att = (bf16*)(F.ws + WS_SCR + S_CATT); const float* km = (const float*)(F.ws + WS_KMEAN);
    const int NP = NB * NH * 4, per = (NP + F.G - 1) / F.G;
    const int lo = F.vcu * per, hi = (lo + per) < NP ? (lo + per) : NP;
    const int nunits = 2 * (hi - lo);
    if (nunits <= 0) return;
    const int sdst = srow * AKP + sch * 8;
    int u = 0, cur_bh = -1;
    u32x4 kreg, vreg; bf16x8 qn[4], qf[4];
#define MB_LOADS(B_, HH_, S_) do { const bf16* ks_ = QK + ((size_t)(B_) * SEQ + 64 * (S_) + srow) * 2048 + 1024 + (HH_) * 64 + sch * 8; \
        const bf16* vs_ = VT + ((size_t)(HH_) * 64 + srow) * T + (size_t)(B_) * SEQ + 64 * (S_) + sch * 8; kreg = *(const u32x4*)ks_; vreg = *(const u32x4*)vs_; } while (0)
#define MB_QLOADS(B_, HH_, NB_) do { const bf16* qr_ = QK + ((size_t)(B_) * SEQ + (NB_) * 256 + 32 * w + q) * 2048 + (HH_) * 64; \
        _Pragma("unroll") for (int d0 = 0; d0 < 4; ++d0) qn[d0] = *(const bf16x8*)(qr_ + d0 * 16 + 8 * h); } while (0)
#define MB_WRITE(PB_) do { LAS bf16* kb_ = (LAS bf16*)(F.lds + TBL + (PB_) * 2 * ATILE); *(LAS u32x4*)(kb_ + sdst) = kreg; *(LAS u32x4*)(kb_ + 64 * AKP + sdst) = vreg; } while (0)
    int pu = lo, jj = pu & 3, hh = (pu >> 2) & 15, b = pu >> 6, nb = 7 - jj, s = 0, pb = 0;
    MB_LOADS(b, hh, 0); MB_QLOADS(b, hh, nb); MB_WRITE(0);
    unsigned sel = 0; bool fresh = true;
    AttnSt st; st.m = NEGB; st.l = 0.f; st.o0 = (f32x16){}; st.o1 = (f32x16){};
    for (;;) {
        if (fresh) {
            if (b * 16 + hh != cur_bh) { __syncthreads(); const float* btC = (const float*)(F.ws + WS_BTABC) + hh * 2048;
                for (int i = t; i < 2048 + 32; i += 512) bt[i] = i < 32 ? NEGB : btC[i - 32];
                { const float* kmp = km + ((size_t)b * NH + hh) * 512; kml[t] = kmp[t]; }
                cur_bh = b * 16 + hh; }
#pragma unroll
            for (int d0 = 0; d0 < 4; ++d0) qf[d0] = qn[d0];
            __syncthreads();
            sel = 0;
            if (nb > 0) {
                float gsc[7];
#pragma unroll
                for (int m = 0; m < 7; ++m) { float sc = 0.f;
                    if (m < nb) {
#pragma unroll
                        for (int d0 = 0; d0 < 4; ++d0) { const f32x4 c0 = *(const LAS f32x4*)(kml + m * 64 + d0 * 16 + 8 * h), c1 = *(const LAS f32x4*)(kml + m * 64 + d0 * 16 + 8 * h + 4); const u32x4 qq = __builtin_bit_cast(u32x4, qf[d0]);
                            sc += bflo(qq.x) * c0.x + bfhi(qq.x) * c0.y + bflo(qq.y) * c0.z + bfhi(qq.y) * c0.w + bflo(qq.z) * c1.x + bfhi(qq.z) * c1.y + bflo(qq.w) * c1.z + bfhi(qq.w) * c1.w; }
                        sc = xhalf_sum(sc); }
                    gsc[m] = m < nb ? sc : -3.0e38f; }
                const int nsel = nb < 3 ? nb : 3;
#pragma unroll
                for (int r = 0; r < 3; ++r) { if (r < nsel) { int bi = 0; float bv = -3.4e38f;
#pragma unroll
                        for (int m = 0; m < 7; ++m) if (!((sel >> m) & 1u) && gsc[m] > bv) { bv = gsc[m]; bi = m; }
                        sel |= 1u << bi; } }
            }
            fresh = false;
        }
        const int nsteps = 4 * nb + 4;
        const bool last = (s + 1 == nsteps);
        int nb2 = nb, b2 = b, hh2 = hh, s2 = s + 1; bool more = true;
        if (last) { const int u2 = u + 1; more = u2 < nunits; const int pu2 = lo + (u2 >> 1), j2 = pu2 & 3; hh2 = (pu2 >> 2) & 15; b2 = pu2 >> 6; nb2 = (u2 & 1) ? j2 : 7 - j2; s2 = 0; }
        if (more) { MB_LOADS(b2, hh2, s2); if (last) MB_QLOADS(b2, hh2, nb2); }
        { const LAS bf16* kb = (const LAS bf16*)(F.lds + TBL + pb * 2 * ATILE); const LAS bf16* vb = kb + 64 * AKP;
          const int qpos = nb * 256 + 32 * w + q;
          const LAS float* bl = bt + 32 + (qpos - 8 * h - 64 * s - 23);
          if (s < 4 * nb) { const bool mine = (sel >> (s >> 2)) & 1u;
              if (__ballot(mine) != 0ull) attn_tile2<true>(kb, vb, bl, qf, st, q, h, mine); }
          else { const int ta = (s - 4 * nb) * 2;
              if (ta + 1 <= w) attn_tile2<false>(kb, vb, bl, qf, st, q, h, true);
              else if (ta <= w) attn_tile<false>(kb, vb, bl, qf, st, q, h, true); } }
        if (more) MB_WRITE(pb ^ 1);
        if (last) {
            const float l_tot = xhalf_sum(st.l), inv = 1.f / l_tot;
            const size_t tq = (size_t)b * SEQ + nb * 256 + 32 * w + q;
            attn_store8(st, (unsigned char*)att + tq * 1024 + hh * 64 + 4 * h, inv * ASCALE8);
            st.m = NEGB; st.l = 0.f; st.o0 = (f32x16){}; st.o1 = (f32x16){};
        }
        if (!last) __syncthreads();
        pb ^= 1;
        if (!more) break;
        if (last) { ++u; fresh = true; }
        nb = nb2; b = b2; hh = hh2; s = s2;
    }
#undef MB_LOADS
#undef MB_QLOADS
#undef MB_WRITE
}

__device__ __forceinline__ void gmlp_phase(Frame& F, const float* lng, const float* lnb, const float* bs) {
    const int lane = F.lane, w = F.wave, q = lane & 31, h = lane >> 5;
    const bf16* uv = (const bf16*)(F.ws + WS_SCR + S_UV); bf16* p = (bf16*)(F.ws + WS_SCR + S_P); const bf16* wst = (const bf16*)(F.ws + WS_WST);
    LAS float* stat = (LAS float*)F.lds;
    LAS bf16* vnT = (LAS bf16*)(F.lds + 1024);
    constexpr int VP = 136;
    for (int unit = F.vcu; unit < T / 128; unit += F.G) {
        const size_t t0 = (size_t)unit * 128;
        __syncthreads();
        for (int i = 0; i < 16; ++i) { const int r = w * 16 + i; const u32x4* vr = (const u32x4*)(uv + (t0 + r) * 2048 + 1024) + lane;
            const u32x4 a = vr[0], b = vr[64]; float x[16];
            x[0] = bflo(a.x); x[1] = bfhi(a.x); x[2] = bflo(a.y); x[3] = bfhi(a.y); x[4] = bflo(a.z); x[5] = bfhi(a.z); x[6] = bflo(a.w); x[7] = bfhi(a.w);
            x[8] = bflo(b.x); x[9] = bfhi(b.x); x[10] = bflo(b.y); x[11] = bfhi(b.y); x[12] = bflo(b.z); x[13] = bfhi(b.z); x[14] = bflo(b.w); x[15] = bfhi(b.w);
            float s = 0.f;
#pragma unroll
            for (int j = 0; j < 16; ++j) s += x[j];
            const float mean = wave_sum(s) * (1.f / 1024.f); float s2 = 0.f;
#pragma unroll
            for (int j = 0; j < 16; ++j) { const float d = x[j] - mean; s2 += d * d; }
            const float rstd = 1.f / sqrtf(wave_sum(s2) * (1.f / 1024.f) + LN_EPS);
            if (lane == 0) { stat[2 * r] = mean; stat[2 * r + 1] = rstd; } }
        __syncthreads();
        for (int gg = 0; gg < 8; ++gg) {
#pragma unroll
            for (int k = 0; k < 4; ++k) { const int id = F.tid + 512 * k, s = id >> 4, cc = (id & 15) * 8;
                const u32x4 a = *(const u32x4*)(uv + (t0 + s) * 2048 + 1024 + gg * 128 + cc); const float mean = stat[2 * s], rstd = stat[2 * s + 1];
                float x[8]; x[0] = bflo(a.x); x[1] = bfhi(a.x); x[2] = bflo(a.y); x[3] = bfhi(a.y); x[4] = bflo(a.z); x[5] = bfhi(a.z); x[6] = bflo(a.w); x[7] = bfhi(a.w);
#pragma unroll
                for (int j = 0; j < 8; ++j) { const int c = gg * 128 + cc + j; const float y = (x[j] - mean) * rstd * lng[c] + lnb[c]; vnT[(cc + j) * VP + s] = (bf16)f2bf(y); } }
            __syncthreads();
            const int cr = 32 * (w & 3), tc0 = 64 * (w >> 2);
            f32x16 acc0 = {}, acc1 = {};
#pragma unroll
            for (int ks = 0; ks < 8; ++ks) {
                const bf16x8 af = *(const LAS bf16x8*)(vnT + (cr + q) * VP + ks * 16 + 8 * h);
                const bf16x8 b0 = *(const bf16x8*)(wst + ((size_t)gg * 128 + tc0 + q) * 128 + ks * 16 + 8 * h);
                const bf16x8 b1 = *(const bf16x8*)(wst + ((size_t)gg * 128 + tc0 + 32 + q) * 128 + ks * 16 + 8 * h);
                acc0 = mfma32(af, b0, acc0); acc1 = mfma32(af, b1, acc1);
            }
#pragma unroll
            for (int tt = 0; tt < 2; ++tt) { const f32x16& ac = tt == 0 ? acc0 : acc1; const int tl = tc0 + 32 * tt + q; const float bsv = bs[gg * 128 + tl];
                const size_t rowu = (t0 + tl) * 2048, rowp = (t0 + tl) * 1024;
#pragma unroll
                for (int gq = 0; gq < 4; ++gq) { const int c = gg * 128 + cr + 8 * gq + 4 * h; const u32x2 uu = *(const u32x2*)(uv + rowu + c);
                    u32x2 o; o.x = pk2(bflo(uu.x) * (ac[4 * gq] + bsv), bfhi(uu.x) * (ac[4 * gq + 1] + bsv)); o.y = pk2(bflo(uu.y) * (ac[4 * gq + 2] + bsv), bfhi(uu.y) * (ac[4 * gq + 3] + bsv));
                    *(u32x2*)(p + rowp + c) = o; } }
            __syncthreads();
        }
    }
}

struct MoeSeg { int ts[9]; };
__device__ __forceinline__ MoeSeg moe_seg(Frame& F, int moe_l) {
    MoeSeg s; int acc = 0;
#pragma unroll
    for (int e = 0; e < 8; ++e) { s.ts[e] = acc; const unsigned c = __hip_atomic_load((unsigned*)(F.ctl + CW_ECNT + 64 * moe_l + e), RLX_AGENT); acc += (int)((c + 255u) >> 8); }
    s.ts[8] = acc; return s;
}
__device__ __forceinline__ void moe_gather_phase(Frame& F, int moe_l) {
    LAS int* P = (LAS int*)F.lds;
    LAS int* wtot = (LAS int*)(F.lds + 65536);
    LAS int* tot = wtot + 64;
    const int* wcnt = (const int*)(F.ws + WS_WCNT);
    int t = F.tid; asm volatile("" : "+v"(t));
    const int lane = F.lane;
    int loc[4][8], sum[8], inc[8];
#pragma unroll
    for (int k = 0; k < 4; ++k) { const u32x4 a = *(const u32x4*)(wcnt + (4 * t + k) * 8), b = *(const u32x4*)(wcnt + (4 * t + k) * 8 + 4);
        loc[k][0] = (int)a.x; loc[k][1] = (int)a.y; loc[k][2] = (int)a.z; loc[k][3] = (int)a.w; loc[k][4] = (int)b.x; loc[k][5] = (int)b.y; loc[k][6] = (int)b.z; loc[k][7] = (int)b.w; }
#pragma unroll
    for (int e = 0; e < 8; ++e) { sum[e] = (loc[0][e] + loc[1][e]) + (loc[2][e] + loc[3][e]); inc[e] = sum[e]; }
#pragma unroll
    for (int off = 1; off < 64; off <<= 1) {
#pragma unroll
        for (int e = 0; e < 8; ++e) { const int v = __shfl_up(inc[e], off); if (lane >= off) inc[e] += v; } }
    if (lane == 63) {
#pragma unroll
        for (int e = 0; e < 8; ++e) wtot[F.wave * 8 + e] = inc[e]; }
    __syncthreads();
    int run[8];
#pragma unroll
    for (int e = 0; e < 8; ++e) { int wb = 0; for (int w = 0; w < F.wave; ++w) wb += wtot[w * 8 + e]; run[e] = wb + inc[e] - sum[e]; }
#pragma unroll
    for (int k = 0; k < 4; ++k) {
#pragma unroll
        for (int e = 0; e < 8; ++e) { P[(4 * t + k) * 8 + e] = run[e]; run[e] += loc[k][e]; } }
    if (t == 511) {
#pragma unroll
        for (int e = 0; e < 8; ++e) tot[e] = run[e]; }
    __syncthreads();
    MoeSeg sg; { int acc = 0;
#pragma unroll
        for (int e = 0; e < 8; ++e) { sg.ts[e] = acc; acc += (tot[e] + 255) >> 8; } sg.ts[8] = acc; }
    if (blockIdx.x == 0 && t < 8) __hip_atomic_store((unsigned*)(F.ctl + CW_ECNT + 64 * moe_l + t), (unsigned)tot[t], RLX_AGENT);
    const int gw = F.vcu * NWAVES + F.wave, NGW = F.G * NWAVES;
    const bf16* hb = (const bf16*)(F.ws + WS_HB); unsigned char* xg8 = (unsigned char*)F.out;
    const int* route = (const int*)(F.ws + WS_ROUTE); int* slots = (int*)(F.ws + WS_SLOTS);
    for (int m0 = 4 * gw; m0 < T; m0 += 4 * NGW) {
        int s1[4], s2[4]; u32x4 a[4], b[4];
#pragma unroll
        for (int k = 0; k < 4; ++k) { const int m = m0 + k, grp = m >> 5;
            const int e1 = route[4 * m], p1 = route[4 * m + 1], e2 = route[4 * m + 2], p2 = route[4 * m + 3];
            int ts1 = 0, ts2 = 0;
#pragma unroll
            for (int e = 0; e < 8; ++e) { ts1 = e == e1 ? sg.ts[e] : ts1; ts2 = e == e2 ? sg.ts[e] : ts2; }
            s1[k] = ts1 * 256 + P[grp * 8 + e1] + p1; s2[k] = ts2 * 256 + P[grp * 8 + e2] + p2;
            const u32x4* src = (const u32x4*)(hb + (size_t)m * D) + lane; a[k] = src[0]; b[k] = src[64]; }
#pragma unroll
        for (int k = 0; k < 4; ++k) { const int m = m0 + k;
            float x[16]; unpack8(a[k], x); unpack8(b[k], x + 8);
            u32x2 lo, hi; lo.x = pk4_fp8(x[0], x[1], x[2], x[3]); lo.y = pk4_fp8(x[4], x[5], x[6], x[7]); hi.x = pk4_fp8(x[8], x[9], x[10], x[11]); hi.y = pk4_fp8(x[12], x[13], x[14], x[15]);
            unsigned char* d1 = xg8 + (size_t)s1[k] * D + 8 * lane; unsigned char* d2 = xg8 + (size_t)s2[k] * D + 8 * lane;
            *(u32x2*)d1 = lo; *(u32x2*)(d1 + 512) = hi; *(u32x2*)d2 = lo; *(u32x2*)(d2 + 512) = hi;
            if (lane == 0) { slots[2 * m] = s1[k]; slots[2 * m + 1] = s2[k]; } }
    }
}
struct MoeOrder {
    int nM, nN, G, c, tile0; MoeSeg sg; const char* A0; const char* B0; size_t aT, bE, bT; bool a_local;
    bool out_local;
    __device__ __forceinline__ bool next(int i, pg8::Unit& u) const {
        int pm, pn; if (!pg8::tile_of((long)i * G + c, nM, nN, pm, pn)) return false;
        const int tile = tile0 + pm; int e = 0;
#pragma unroll
        for (int k = 1; k < 8; ++k) e += (tile >= sg.ts[k]) ? 1 : 0;
        u.pm = out_local ? pm : tile; u.pn = pn; u.a = (unsigned)((size_t)(a_local ? pm : tile) * aT); u.b = (unsigned)((size_t)e * bE + (size_t)pn * bT); return true;
    }
};


template <int GI> struct L0QKOrder { int G, c; const char* A0; const char* B0;
    __device__ __forceinline__ bool next(int i, pg8::Unit& u) const { if (!pg8::tile_of((long)i * G + c, 64, 8, u.pm, u.pn)) return false; const int pm = u.pm;
        const int tok = GI == 0 ? pm * 256 : (GI == 1 ? (pm >> 3) * 2048 + (pm & 1) * 1024 + ((pm >> 1) & 3) : (pm >> 3) * 2048 + (pm & 7) * 2);
        u.a = (unsigned)tok * 1024u; u.b = (unsigned)u.pn * 256u * 1024u; return true; } };
template <int GI> struct L0VtOrder { int G, c; const char* A0; const char* B0;
    __device__ __forceinline__ bool next(int i, pg8::Unit& u) const { if (!pg8::tile_of((long)i * G + c, 4, 64, u.pm, u.pn)) return false; const int pn = u.pn;
        const int tok = GI == 0 ? pn * 256 : (GI == 1 ? (pn >> 3) * 2048 + (pn & 1) * 1024 + ((pn >> 1) & 3) : (pn >> 3) * 2048 + (pn & 7) * 2);
        u.a = (unsigned)u.pm * 256u * 1024u; u.b = (unsigned)tok * 1024u; return true; } };
template <int GI> __device__ __forceinline__ void l0_gemms(Frame& F, int ck, int bx) {
    constexpr int rs = GI == 0 ? 1 : (GI == 1 ? 4 : 16);
    constexpr size_t hst = (GI == 0 ? (size_t)128 : (GI == 1 ? (size_t)512 : (size_t)1)) * 1024;
    const char* hbc = (const char*)(F.ws + WS_SCR + S_HB8) + (size_t)ck * TC * 1024;
    unsigned char* scr = F.ws + WS_SCR;
    { L0QKOrder<GI> S{F.G, bx, hbc, (const char*)(F.ws + W_A_QK) + (size_t)GI * 2048 * 1024};
      pg8::Gemm gm{512, rs, 1, hst, (size_t)128 * 1024};
      pg8::EpiF8 E{scr + S_QK + (size_t)GI * TC * 2048, 2048, 1.f / WSCALE8};
      pg8::gemm_phase<pg8::EpiF8, L0QKOrder<GI>, false, 1>(F.lds, F.wave, gm, S, E); }
    { L0VtOrder<GI> S{F.G, bx, (const char*)(F.ws + W_A_V) + (size_t)GI * 1024 * 1024, hbc};
      pg8::Gemm gm{512, 1, rs, (size_t)128 * 1024, hst};
      pg8::EpiF8 E{scr + S_VT + (size_t)GI * 1024 * TC, TC, 1.f / WSCALE8};
      pg8::gemm_phase<pg8::EpiF8, L0VtOrder<GI>, false, 1>(F.lds, F.wave, gm, S, E); }
}


#ifdef MK_SELFCHECK
__device__ __forceinline__ void selfcheck_buf(Frame& F, const void* ptr, size_t nbytes, int stage, int slot0) {
    if (!F.chk) return;
    const int gw = F.vcu * NWAVES + F.wave, NGW = F.G * NWAVES; unsigned* cks = (unsigned*)(F.ws + WS_NEED + 2 * MiB) + slot0;
    const int nch = (int)(nbytes >> 12);
    for (int c = gw; c < nch; c += NGW) { const u32x4* r = (const u32x4*)((const char*)ptr + ((size_t)c << 12)) + F.lane; unsigned x = 0;
#pragma unroll
        for (int j = 0; j < 4; ++j) { const u32x4 v = r[64 * j]; x ^= v.x * 3u + v.y * 5u + v.z * 7u + v.w * 11u + (unsigned)j; }
        x *= (unsigned)(2 * F.lane + 1);
#pragma unroll
        for (int o = 1; o < 64; o <<= 1) x ^= __shfl_xor(x, o);
        if (F.lane == 0) { if (F.chk == 1) cks[c] = x; else if (cks[c] != x) atomicMax((unsigned*)(F.ctl + 32), (unsigned)(1000 - stage)); } }
}
#endif

__global__ void __launch_bounds__(NWAVES * 64, 2) mk_fwd(Args args) {
    extern __shared__ __attribute__((aligned(16))) unsigned char lds[];
    Frame F;
    F.lds = (LAS unsigned char*)lds;
    F.tid = threadIdx.x; F.lane = F.tid & 63; F.wave = __builtin_amdgcn_readfirstlane(F.tid >> 6);
    F.G = gridDim.x; { const int bx = blockIdx.x; F.vcu = (F.G % 8 == 0) ? (bx % 8) * (F.G / 8) + bx / 8 : bx; }
    F.ws = args.ws; F.ctl = (gu32*)(args.ws + WS_CTL); F.out = args.out; F.chk = args.chk; F.stage = 0;
    volatile LAS unsigned* MISC = (volatile LAS unsigned*)(F.lds + MISC_OFF);
    for (int u = F.tid; u < (LDS_BYTES - RING_BYTES) / 4; u += NWAVES * 64) ((LAS unsigned*)(F.lds + RING_BYTES))[u] = 0u;
    __syncthreads();
    XcdBarrier bar; bar.bar = (unsigned*)(F.ctl + CW_BAR); bar.x = 0; bar.st = nullptr;
    if (!MK_MULTI) bar = xcd_barrier_post((unsigned*)(F.ctl + CW_BAR), MISC + 8);
    const int lo = args.ph_lo, hi = args.ph_hi;
    int ph = 0;
#define PHASE_BEGIN if (ph >= lo && ph < hi) { F.lane = (int)__builtin_amdgcn_mbcnt_hi(~0u, __builtin_amdgcn_mbcnt_lo(~0u, 0u)); asm volatile("" : "+v"(F.lane)); F.tid = F.wave * 64 + F.lane;
#define PHASE_END   if (!MK_MULTI && ph + 1 < hi) xcd_barrier(bar, F.tid); } ++ph;
    const int bx = (int)blockIdx.x;
#define scr (args.ws + WS_SCR)
#define hb ((const bf16*)(args.ws + WS_HB))
#define ln_g (args.in[2])
#define ln_b (args.in[3])

    PHASE_BEGIN p_prologue(F, args); if (MK_PROBE & 8) p_prologue(F, args); PHASE_END

    if (MK_ENABLE & 1) {
#define L0_CHUNK(ck) \
        PHASE_BEGIN \
        if ((ck) > 0) dil_merge_phase(F, (ck) - 1); \
        l0_gemms<0>(F, (ck), bx); l0_gemms<1>(F, (ck), bx); l0_gemms<2>(F, (ck), bx); \
        PHASE_END \
        PHASE_BEGIN dil_attn_phase3(F); if (MK_PROBE & 1) dil_attn_phase3(F); PHASE_END
        L0_CHUNK(0) L0_CHUNK(1) L0_CHUNK(2) L0_CHUNK(3)
#undef L0_CHUNK
        PHASE_BEGIN dil_merge_phase(F, 3); if (MK_PROBE & 4) { dil_merge_phase(F, 3); dil_merge_phase(F, 3); dil_merge_phase(F, 3); dil_merge_phase(F, 3); } PHASE_END
        PHASE_BEGIN
        { pg8::LinOrder S{T / 256, 4, F.G, bx, (const char*)(scr + S_ATT), (const char*)(F.ws + W_A_O), (size_t)256 * 1024, (size_t)256 * 1024};
          pg8::Gemm gm{512, 1, 1, (size_t)128 * 1024, (size_t)128 * 1024};
          pg8::EpiResLn<FFN_GU8 == 0> E{(bf16*)(F.ws + WS_HB), ln_g + 0 * 2048, ln_b + 0 * 2048, ALPHA, 1.f / (WSCALE8 * ASCALE8), (float*)scr, (unsigned*)(F.ctl + CW_LNC + 0 * 4096), (unsigned*)(F.ctl + CW_BAR) + XB_TMO, scr + S_HB8, F.lds + LNT_OFF};
          pg8::gemm_phase<pg8::EpiResLn<FFN_GU8 == 0>, pg8::LinOrder, true, 1>(F.lds, F.wave, gm, S, E); }
        PHASE_END
    } else {
        PHASE_BEGIN ln_phase<1, false, false>(F, ln_g + 0 * 2048, ln_b + 0 * 2048, nullptr); PHASE_END
    }
#define DENSE_FFN(f, lnidx, enbit) \
    if (MK_ENABLE & (enbit)) { \
        PHASE_BEGIN \
        if ((f) == FFN_GU8) { \
          pg8::LinOrder S{T / 256, 2 * DFF / 256, F.G, bx, (const char*)(scr + S_HB8), (const char*)(F.ws + W_F_GU) + (size_t)(f) * 2 * DFF * 2048, (size_t)256 * 1024, (size_t)256 * 1024}; \
          pg8::Gemm gm{512, 1, 1, (size_t)128 * 1024, (size_t)128 * 1024};     \
          pg8::EpiSwiglu8 E{(unsigned char*)(scr + S_HID), DFF, 1.f / WSCALE8}; \
          pg8::gemm_phase<pg8::EpiSwiglu8, pg8::LinOrder, true, 1>(F.lds, F.wave, gm, S, E); \
        } else { pg8::LinOrder S{T / 256, 2 * DFF / 256, F.G, bx, (const char*)hb, (const char*)(F.ws + W_F_GU) + (size_t)(f) * 2 * DFF * 2048, (size_t)256 * 2048, (size_t)256 * 2048}; \
          pg8::Gemm gm{1024, 1, 1, (size_t)128 * 2048, (size_t)128 * 2048}; \
          pg8::EpiSwiglu8 E{(unsigned char*)(scr + S_HID), DFF}; \
          pg8::gemm_phase(F.lds, F.wave, gm, S, E); } \
        PHASE_END \
        PHASE_BEGIN \
        { pg8::LinOrder S{T / 256, 4, F.G, bx, (const char*)(scr + S_HID), (const char*)(F.ws + W_F_D) + (size_t)(f) * 1024 * DFF * 2, (size_t)256 * DFF, (size_t)256 * DFF}; \
          pg8::Gemm gm{DFF / 2, 1, 1, (size_t)128 * DFF, (size_t)128 * DFF};     \
          pg8::EpiResLn<false> E{(bf16*)(F.ws + WS_HB), ln_g + (lnidx) * 1024, ln_b + (lnidx) * 1024, ALPHA, 1.f / WSCALE8D, (float*)(scr + S_Y), (unsigned*)(F.ctl + CW_LNC + (2 + (f)) * 4096), (unsigned*)(F.ctl + CW_BAR) + XB_TMO, nullptr, F.lds + LNT_OFF}; \
          pg8::gemm_phase<pg8::EpiResLn<false>, pg8::LinOrder, true, 1>(F.lds, F.wave, gm, S, E); }     \
        PHASE_END \
    } else { \
        PHASE_BEGIN ln_phase<1, false, false>(F, ln_g + (lnidx) * 1024, ln_b + (lnidx) * 1024, nullptr); PHASE_END \
    }
    DENSE_FFN(0, 1, 2)

    if (MK_ENABLE & 4) {
        PHASE_BEGIN
        { pg8::LinOrder S{T / 256, 4, F.G, bx, (const char*)hb, (const char*)(F.ws + W_B_IN), (size_t)256 * 2048, (size_t)256 * 2048};
          pg8::Gemm gm{1024, 1, 1, (size_t)128 * 2048, (size_t)128 * 2048};
          pg8::EpiBf16<0> E{(bf16*)(scr + S_BCX), 1024};
          pg8::gemm_phase(F.lds, F.wave, gm, S, E); }
        { pg8::LinOrder S{T / 256, 8, F.G, bx, (const char*)hb, (const char*)(F.ws + W_B_IN) + (size_t)1024 * 2048, (size_t)256 * 2048, (size_t)256 * 2048};
          pg8::Gemm gm{1024, 1, 1, (size_t)128 * 2048, (size_t)128 * 2048};
          pg8::EpiGlu<0> E{(bf16*)(scr + S_BCX + (size_t)128 * MiB), 1024};
          pg8::gemm_phase(F.lds, F.wave, gm, S, E); }
        PHASE_END
        PHASE_BEGIN conv_phase(F, args.in[7]); if (MK_PROBE & 4) conv_phase(F, args.in[7]); PHASE_END
        PHASE_BEGIN
        { pg8::LinOrder S{T / 256, 4, F.G, bx, (const char*)(scr + S_P), (const char*)(F.ws + W_B_O), (size_t)256 * 2048, (size_t)256 * 2048};
          pg8::Gemm gm{1024, 1, 1, (size_t)128 * 2048, (size_t)128 * 2048};
          pg8::EpiResBf16 E{hb, (bf16*)F.out, 1024, ALPHA};
          pg8::gemm_phase(F.lds, F.wave, gm, S, E); }
        PHASE_END
        PHASE_BEGIN ln_phase<0, true, false>(F, ln_g + 2 * 1024, ln_b + 2 * 1024, args.in[20]); PHASE_END
    } else {
        PHASE_BEGIN ln_phase<1, true, false>(F, ln_g + 2 * 1024, ln_b + 2 * 1024, args.in[20]); PHASE_END
    }
#define MOE_CHUNK(f, ck) \
        PHASE_BEGIN \
        { const MoeSeg sg = moe_seg(F, (f)); int nM = sg.ts[8] - (ck) * MOE_CH_TILES; nM = nM > MOE_CH_TILES ? MOE_CH_TILES : (nM < 0 ? 0 : nM); \
          MoeOrder S{nM, 2 * DFE / 256, F.G, bx, (ck) * MOE_CH_TILES, sg, (const char*)F.out, (const char*)(F.ws + W_E_GU) + (size_t)(f) * 8 * 2 * DFE * 2048, (size_t)256 * 1024, (size_t)2 * DFE * 2048, (size_t)256 * 1024, false, true}; \
          pg8::Gemm gm{512, 1, 1, (size_t)128 * 1024, (size_t)128 * 1024};     \
          pg8::EpiSwiglu8 E{(unsigned char*)(scr + S_MHID), DFE, 1.f / WSCALE8}; \
          pg8::gemm_phase<pg8::EpiSwiglu8, MoeOrder, true, 0x7C>(F.lds, F.wave, gm, S, E);     if ((ck) == 0 && (MK_PROBE & 32)) pg8::gemm_phase(F.lds, F.wave, gm, S, E); } \
        PHASE_END \
        PHASE_BEGIN \
        { const MoeSeg sg = moe_seg(F, (f)); int nM = sg.ts[8] - (ck) * MOE_CH_TILES; nM = nM > MOE_CH_TILES ? MOE_CH_TILES : (nM < 0 ? 0 : nM); \
          MoeOrder S{nM, 4, F.G, bx, (ck) * MOE_CH_TILES, sg, (const char*)(scr + S_MHID), (const char*)(F.ws + W_E_D) + (size_t)(f) * 8 * 1024 * DFE * 2, (size_t)256 * DFE, (size_t)1024 * DFE * 2, (size_t)256 * DFE, true, false}; \
          pg8::Gemm gm{DFE / 2, 1, 1, (size_t)128 * DFE, (size_t)128 * DFE};     \
          pg8::EpiBf16<0> E{(bf16*)(scr + S_XG), 1024, 1.f / WSCALE8D}; \
          pg8::gemm_phase<pg8::EpiBf16<0>, MoeOrder, true, 0x7B>(F.lds, F.wave, gm, S, E);     if ((ck) == 0 && (MK_PROBE & 64)) pg8::gemm_phase(F.lds, F.wave, gm, S, E); } \
        PHASE_END
#define MOE_FFN(f, lnidx, enbit, fin) \
    if (MK_ENABLE & (enbit)) { \
        PHASE_BEGIN moe_gather_phase(F, (f)); if (MK_PROBE & 4) moe_gather_phase(F, (f)); PHASE_END \
        MOE_CHUNK(f, 0) MOE_CHUNK(f, 1) MOE_CHUNK(f, 2) \
        PHASE_BEGIN ln_phase<2, false, fin>(F, ln_g + (lnidx) * 1024, ln_b + (lnidx) * 1024, nullptr); PHASE_END \
    } else { \
        PHASE_BEGIN ln_phase<1, false, fin>(F, ln_g + (lnidx) * 1024, ln_b + (lnidx) * 1024, nullptr); PHASE_END \
    }
    MOE_FFN(0, 3, 8, false)

    if (MK_ENABLE & 16) {
        PHASE_BEGIN
        { pg8::LinOrder S{T / 256, 8, F.G, bx, (const char*)hb, (const char*)(F.ws + W_C_QK), (size_t)256 * 2048, (size_t)256 * 2048};
          pg8::Gemm gm{1024, 1, 1, (size_t)128 * 2048, (size_t)128 * 2048};
          pg8::EpiBf16<0> E{(bf16*)(scr + S_CQK), 2048};
          pg8::gemm_phase(F.lds, F.wave, gm, S, E); }
        { pg8::LinOrder S{4, T / 256, F.G, bx, (const char*)(F.ws + W_C_V), (const char*)hb, (size_t)256 * 2048, (size_t)256 * 2048};
          pg8::Gemm gm{1024, 1, 1, (size_t)128 * 2048, (size_t)128 * 2048};
          pg8::EpiBf16<0> E{(bf16*)(scr + S_CVT), T};
          pg8::gemm_phase(F.lds, F.wave, gm, S, E); }
        PHASE_END
#ifdef MK_SELFCHECK
        PHASE_BEGIN selfcheck_buf(F, scr + S_CQK, (size_t)256 * MiB, 40, 0); selfcheck_buf(F, scr + S_CVT, (size_t)128 * MiB, 41, 65536); PHASE_END
#endif
        PHASE_BEGIN kmean_phase(F); if (MK_PROBE & 4) kmean_phase(F); PHASE_END
#ifdef MK_SELFCHECK
        PHASE_BEGIN selfcheck_buf(F, F.ws + WS_KMEAN, (size_t)1 * MiB, 42, 65536 + 32768); PHASE_END
#endif
        PHASE_BEGIN moba_phase3(F); if (MK_PROBE & 2) moba_phase3(F); PHASE_END
#ifdef MK_SELFCHECK
        PHASE_BEGIN selfcheck_buf(F, F.ws + WS_NEED + 3 * MiB, (size_t)4 * MiB, 43, 65536 + 32768 + 256); selfcheck_buf(F, F.ws + WS_NEED + 7 * MiB, (size_t)4 * MiB, 44, 65536 + 32768 + 256 + 1024);
                    selfcheck_buf(F, scr + S_CATT, (size_t)128 * MiB, 45, 65536 + 32768 + 256 + 2048); PHASE_END
#endif
        PHASE_BEGIN
        { pg8::LinOrder S{T / 256, 4, F.G, bx, (const char*)(scr + S_CATT), (const char*)(F.ws + W_C_O), (size_t)256 * 1024, (size_t)256 * 1024};
          pg8::Gemm gm{512, 1, 1, (size_t)128 * 1024, (size_t)128 * 1024};
          pg8::EpiResLn<FFN_GU8 == 1> E{(bf16*)(F.ws + WS_HB), ln_g + 4 * 1024, ln_b + 4 * 1024, ALPHA, 1.f / (WSCALE8 * ASCALE8), (float*)scr, (unsigned*)(F.ctl + CW_LNC + 1 * 4096), (unsigned*)(F.ctl + CW_BAR) + XB_TMO, scr + S_HB8, F.lds + LNT_OFF};
          pg8::gemm_phase<pg8::EpiResLn<FFN_GU8 == 1>, pg8::LinOrder, true, 1>(F.lds, F.wave, gm, S, E); }
        PHASE_END
    } else {
        PHASE_BEGIN ln_phase<1, false, false>(F, ln_g + 4 * 1024, ln_b + 4 * 1024, nullptr); PHASE_END
    }
    DENSE_FFN(1, 5, 32)

    if (MK_ENABLE & 64) {
        PHASE_BEGIN
        { pg8::LinOrder S{T / 256, 8, F.G, bx, (const char*)hb, (const char*)(F.ws + W_D_IN), (size_t)256 * 2048, (size_t)256 * 2048};
          pg8::Gemm gm{1024, 1, 1, (size_t)128 * 2048, (size_t)128 * 2048};
          pg8::EpiBf16<1> E{(bf16*)(scr + S_UV), 2048};
          pg8::gemm_phase(F.lds, F.wave, gm, S, E); }
        PHASE_END
        PHASE_BEGIN gmlp_phase(F, args.in[12], args.in[13], args.in[15]); if (MK_PROBE & 4) gmlp_phase(F, args.in[12], args.in[13], args.in[15]); PHASE_END
        PHASE_BEGIN
        { pg8::LinOrder S{T / 256, 4, F.G, bx, (const char*)(scr + S_P), (const char*)(F.ws + W_D_O), (size_t)256 * 2048, (size_t)256 * 2048};
          pg8::Gemm gm{1024, 1, 1, (size_t)128 * 2048, (size_t)128 * 2048};
          pg8::EpiResBf16 E{hb, (bf16*)F.out, 1024, ALPHA};
          pg8::gemm_phase(F.lds, F.wave, gm, S, E); }
        PHASE_END
        PHASE_BEGIN ln_phase<0, true, false>(F, ln_g + 6 * 1024, ln_b + 6 * 1024, args.in[20] + 8192); PHASE_END
    } else {
        PHASE_BEGIN ln_phase<1, true, false>(F, ln_g + 6 * 1024, ln_b + 6 * 1024, args.in[20] + 8192); PHASE_END
    }
    MOE_FFN(1, 7, 128, true)
#ifdef MK_SELFCHECK
    PHASE_BEGIN
    { const unsigned fl = __hip_atomic_load((unsigned*)(F.ctl + 32), RLX_AGENT);
      if (fl != 0u) { const int code = 1000 - (int)fl; const float cval = (code >= 40 && code <= 45) ? (float)(20 + 2 * (code - 40)) : (float)(1u << (code / 10 + 1)); const int gw = F.vcu * NWAVES + F.wave, NGW = F.G * NWAVES;
          for (int m = gw; m < T; m += NGW) { f32x4* w = (f32x4*)(F.out + (size_t)m * D) + F.lane;
#pragma unroll
              for (int j = 0; j < 4; ++j) w[64 * j] = (f32x4){cval, cval, cval, cval}; } } }
    PHASE_END
#endif
#undef PHASE_BEGIN
#undef PHASE_END
#undef scr
#undef hb
#undef ln_g
#undef ln_b
}

static int count_phases() {
    int n = 1;
    n += (MK_ENABLE & 1) ? (8 + 1 + 1) : 1;
    n += (MK_ENABLE & 2) ? 2 : 1;
    n += (MK_ENABLE & 4) ? 4 : 1;
    n += (MK_ENABLE & 8) ? 8 : 1;
    n += (MK_ENABLE & 16) ? 4 : 1;
    n += (MK_ENABLE & 32) ? 2 : 1;
    n += (MK_ENABLE & 64) ? 4 : 1;
    n += (MK_ENABLE & 128) ? 8 : 1;
#ifdef MK_SELFCHECK
    n += 1 + 3;
#endif
    return n;
}
extern "C" void kernel_launch(void* const* d_in, const int* in_sizes, int n_in, void* d_out, int out_size, void* d_ws, size_t ws_size, hipStream_t stream) {
    static int grid = 0;
    if (grid == 0) {
        if (n_in != 24 || in_sizes[0] != T * D || out_size != T * D || ws_size < WS_NEED) { fprintf(stderr, "kernel_launch: unexpected shapes (n_in %d, in0 %d, out %d, ws %zu < %zu); nothing launched\n", n_in, n_in > 0 ? in_sizes[0] : -1, out_size, ws_size, (size_t)WS_NEED); grid = -1; return; }
        int dev = 0, cus = 0, per_cu = 0;
        if (hipGetDevice(&dev) != hipSuccess || hipDeviceGetAttribute(&cus, hipDeviceAttributeMultiprocessorCount, dev) != hipSuccess) { grid = -1; return; }
        if (hipFuncSetAttribute((const void*)mk_fwd, hipFuncAttributeMaxDynamicSharedMemorySize, LDS_BYTES) != hipSuccess) { fprintf(stderr, "kernel_launch: hipFuncSetAttribute failed\n"); grid = -1; return; }
        if (hipOccupancyMaxActiveBlocksPerMultiprocessor(&per_cu, (const void*)mk_fwd, NWAVES * 64, LDS_BYTES) != hipSuccess || per_cu < 1) fprintf(stderr, "kernel_launch: occupancy query reports %d\n", per_cu);
        (void)hipGetLastError();
        grid = cus;
    }
    if (grid < 0) return;
    (void)hipMemsetAsync((char*)d_ws + WS_CTL, 0, CTL_ZERO_BYTES, stream);
#ifdef SELF_POISON
    (void)hipMemsetAsync((char*)d_ws + CTL_ZERO_BYTES, 0xAA, WS_NEED - CTL_ZERO_BYTES, stream);
    (void)hipMemsetAsync(d_out, 0xAA, (size_t)T * D * 4, stream);
#endif
    Args a{};
    for (int i = 0; i < 24; ++i) a.in[i] = (const float*)d_in[i];
    a.out = (float*)d_out; a.ws = (unsigned char*)d_ws;
    const int nph = count_phases();
#if MK_MULTI
    for (int p = 0; p < nph; ++p) { a.ph_lo = p; a.ph_hi = p + 1; hipLaunchKernelGGL(mk_fwd, dim3(grid), dim3(NWAVES * 64), LDS_BYTES, stream, a); }
#else
    a.ph_lo = 0; a.ph_hi = nph;
#ifdef MK_SELFCHECK
    a.chk = 1;
    hipLaunchKernelGGL(mk_fwd, dim3(grid), dim3(NWAVES * 64), LDS_BYTES, stream, a);
    (void)hipMemsetAsync((char*)d_ws + WS_CTL, 0, CTL_ZERO_BYTES, stream);
    a.chk = 2;
#endif
    hipLaunchKernelGGL(mk_fwd, dim3(grid), dim3(NWAVES * 64), LDS_BYTES, stream, a);
#endif
    const hipError_t le = hipPeekAtLastError();
    if (le != hipSuccess) fprintf(stderr, "kernel_launch: launch failed: %s\n", hipGetErrorName(le));
}
```

```cpp
#include <hip/hip_runtime.h>
#include <cstdio>
#include <cstdint>

#ifndef MK_MULTI
#define MK_MULTI 0
#endif
#ifndef MK_PROBE
#define MK_PROBE 0
#endif
#ifndef MK_ENABLE
#define MK_ENABLE 0xFF
#endif

#define GAS __attribute__((address_space(1)))
#define LAS __attribute__((address_space(3)))
typedef unsigned short bf16;
typedef short bf16x8 __attribute__((ext_vector_type(8)));
typedef float f32x4 __attribute__((ext_vector_type(4)));
typedef float f32x2 __attribute__((ext_vector_type(2)));
typedef float f32x16 __attribute__((ext_vector_type(16)));
typedef unsigned u32x4 __attribute__((ext_vector_type(4)));
typedef unsigned u32x2 __attribute__((ext_vector_type(2)));
typedef GAS unsigned gu32;
typedef int v8i_t __attribute__((ext_vector_type(8)));
typedef int v4i_t __attribute__((ext_vector_type(4)));
typedef short s16x16_t __attribute__((ext_vector_type(16)));

constexpr int D = 1024, NB = 32, SEQ = 2048, T = NB * SEQ, NH = 16, HD = 64;
constexpr int DFF = 2816, NE = 8, DFE = 3584;
constexpr float ALPHA = 1.6817928305074290f;
constexpr float LN_EPS = 1e-5f;
constexpr float LOG2E = 1.4426950408889634f;
constexpr float QSCALE = 0.125f * LOG2E;
constexpr float NEGB = -1e30f;
constexpr int TC = 16384;
constexpr int MOE_CH_TILES = 256;
constexpr int MOE_MAX_TILES = 520;
constexpr int FFN_GU8 = 1;

constexpr size_t MiB = 1u << 20;
constexpr size_t WS_CTL = 0, CTL_ZERO_BYTES = 1 * MiB;
constexpr size_t WS_BUCKET = 1 * MiB;
constexpr size_t WS_BTABA = WS_BUCKET + 8192;
constexpr size_t WS_BTABC = WS_BTABA + 32768;
constexpr size_t WS_WST = WS_BTABC + 131072;
constexpr size_t WS_KMEAN = 2 * MiB;
constexpr size_t WS_ROUTE = 4 * MiB;
constexpr size_t WS_GATES = 5 * MiB;
constexpr size_t WS_SLOTS = 6 * MiB;
constexpr size_t WS_WCNT = 7 * MiB;
constexpr size_t WS_W = 8 * MiB;
constexpr size_t W_A_QK = WS_W;
constexpr size_t W_A_V = W_A_QK + 12 * MiB;
constexpr size_t W_A_O = W_A_V + 6 * MiB;
constexpr size_t W_B_IN = W_A_O + 2 * MiB;
constexpr size_t W_B_O = W_B_IN + 6 * MiB;
constexpr size_t W_C_QK = W_B_O + 2 * MiB;
constexpr size_t W_C_V = W_C_QK + 4 * MiB;
constexpr size_t W_C_O = W_C_V + 2 * MiB;
constexpr size_t W_D_IN = W_C_O + 2 * MiB;
constexpr size_t W_D_O = W_D_IN + 4 * MiB;
constexpr size_t W_F_GU = W_D_O + 2 * MiB;
constexpr size_t W_F_D = W_F_GU + 22 * MiB;
constexpr size_t W_E_GU = W_F_D + 11 * MiB;
constexpr size_t W_E_D = W_E_GU + 224 * MiB;
constexpr size_t WS_HB = W_E_D + 112 * MiB;
constexpr size_t WS_SCR = WS_HB + 128 * MiB;
constexpr size_t WS_NEED = WS_SCR + 512 * MiB;
static_assert(WS_HB == 419 * MiB, "map");
constexpr size_t S_QK = 0;
constexpr size_t S_VT = 192 * MiB;
constexpr size_t S_HB8 = 416 * MiB;
constexpr size_t S_ATT = 288 * MiB;
constexpr size_t S_HID = 0;
constexpr size_t S_BCX = 0;
constexpr size_t S_P = 384 * MiB;
constexpr size_t S_XG = 0;
constexpr size_t S_MHID = 260 * MiB;
constexpr size_t S_Y = 256 * MiB;
constexpr size_t S_CQK = 0;
constexpr size_t S_CVT = 256 * MiB;
constexpr size_t S_CATT = 384 * MiB;
constexpr size_t S_UV = 0;
constexpr size_t O_OG = 0;
constexpr size_t O_LSE = 96 * MiB;
constexpr int CW_TMO = 0;
constexpr int CW_ECNT = 64;
constexpr int CW_BAR = 4096;
constexpr int CW_LNC = 16384;

constexpr float ASCALE8 = 8.f;
constexpr float WSCALE8 = 64.f, WSCALE8D = 256.f;
__device__ __forceinline__ unsigned pk4_fp8(float a, float b, float c, float d) { int p = 0; p = __builtin_amdgcn_cvt_pk_fp8_f32(a, b, p, false); p = __builtin_amdgcn_cvt_pk_fp8_f32(c, d, p, true); return (unsigned)p; }
namespace pg8 {
constexpr int BM = 256, BK = 64, HALF = 128, HTB = HALF * BK * 2, STAGE_BYTES = 8 * HTB, NXCD = 8, WGM = 8;
__host__ __device__ __forceinline__ int lds_byte(int r, int c) { const int st = (r >> 4) * 2 + (c >> 5), rr = r & 15, cc = c & 31, ob = rr * 64 + cc * 2; return st * 1024 + (ob ^ (((ob >> 9) & 1) << 5)); }
__host__ __device__ __forceinline__ void stage_rc(int b, int& R, int& C) { const int st = b / 1024, sb = b % 1024, swz = sb ^ (((sb >> 9) & 1) << 5); R = (st >> 1) * 16 + swz / 64; C = (st & 1) * 32 + (swz % 64) / 2; }
__host__ __device__ __forceinline__ int perm32(int rho) { const int n = rho >> 4, i = rho & 15; return 8 * (i >> 2) + 4 * n + (i & 3); }

struct Unit { int pm, pn; unsigned a, b; };
struct Gemm { int K; int rsA, rsB; size_t hstepA, hstepB; };

__device__ __forceinline__ bool tile_of(long L, int nM, int nN, int& pm, int& pn) {
    const int nwg = nM * nN; if (L >= nwg) return false;
    int wgid = (int)L; { const int q = nwg / NXCD, r = nwg % NXCD, xcd = wgid % NXCD, off = wgid / NXCD; wgid = (xcd < r ? xcd * (q + 1) : r * (q + 1) + (xcd - r) * q) + off; }
    const int nig = WGM * nN, gid = wgid / nig, fm = gid * WGM, gsz = (nM - fm) < WGM ? (nM - fm) : WGM;
    pm = fm + ((wgid % nig) % gsz); pn = (wgid % nig) / gsz; return true;
}
struct LinOrder {
    int nM, nN, G, c; const char* A0; const char* B0; size_t aT, bT;
    __device__ __forceinline__ bool next(int i, Unit& u) const { if (!tile_of((long)i * G + c, nM, nN, u.pm, u.pn)) return false; u.a = (unsigned)((size_t)u.pm * aT); u.b = (unsigned)((size_t)u.pn * bT); return true; }
};

typedef __bf16 bf16x2_t __attribute__((ext_vector_type(2)));
__device__ __forceinline__ unsigned cvt_pk_bf16(float lo, float hi) { f32x2 v = {lo, hi}; bf16x2_t b = __builtin_convertvector(v, bf16x2_t); return __builtin_bit_cast(unsigned, b); }
__device__ __forceinline__ f32x2 gelu_pk(f32x2 v) {
    const f32x2 av = __builtin_elementwise_abs(v), d = av * 0.2316418882f + 1.0f;
    f32x2 t; t.x = __builtin_amdgcn_rcpf(d.x); t.y = __builtin_amdgcn_rcpf(d.y);
    f32x2 q = t * 0.5307027145f + (-0.7265760135f); q = q * t + 0.7107068705f; q = q * t + (-0.142248368f); q = q * t + 0.127414796f; q = q * t;
    const f32x2 s = (v * v) * (-0.72134752044f);
    f32x2 e; e.x = __builtin_amdgcn_exp2f(s.x); e.y = __builtin_amdgcn_exp2f(s.y);
    const f32x2 m = v * (q * e), r = v - m;
    f32x2 o; o.x = v.x < 0.f ? m.x : r.x; o.y = v.y < 0.f ? m.y : r.y; return o;
}
__device__ __forceinline__ float silu_f(float g) { return g * __builtin_amdgcn_rcpf(1.0f + __builtin_amdgcn_exp2f(-LOG2E * g)); }

template <int ACT  > struct EpiBf16 {
    static constexpr bool PERM = true;
    bf16* O; int ldc; float sc = 1.f;
    __device__ __forceinline__ void operator()(const f32x4 (&acc)[2][2][4][2], const Unit& u, int wr, int wc, int fr, int fq) const {
        const int row0 = u.pm * BM + wr * 64 + fr, col0 = u.pn * BM + wc * 32 + 8 * fq;
#pragma unroll
        for (int ai = 0; ai < 2; ++ai)
#pragma unroll
            for (int m = 0; m < 4; ++m) { bf16* rowp = O + (size_t)(row0 + ai * HALF + m * 16) * ldc + col0;
#pragma unroll
                for (int bj = 0; bj < 2; ++bj) { f32x4 v0 = acc[ai][bj][m][0] * sc, v1 = acc[ai][bj][m][1] * sc;
                    if (ACT == 1) { f32x2 a = gelu_pk((f32x2){v0[0], v0[1]}), b = gelu_pk((f32x2){v0[2], v0[3]}), c = gelu_pk((f32x2){v1[0], v1[1]}), d = gelu_pk((f32x2){v1[2], v1[3]});
                        v0 = (f32x4){a.x, a.y, b.x, b.y}; v1 = (f32x4){c.x, c.y, d.x, d.y}; }
                    u32x4 w; w.x = cvt_pk_bf16(v0[0], v0[1]); w.y = cvt_pk_bf16(v0[2], v0[3]); w.z = cvt_pk_bf16(v1[0], v1[1]); w.w = cvt_pk_bf16(v1[2], v1[3]);
                    *(u32x4*)(rowp + bj * HALF) = w; } }
    }
};
struct EpiF8 {
    static constexpr bool PERM = true;
    unsigned char* O; int ldc; float sc = 1.f;
    __device__ __forceinline__ void operator()(const f32x4 (&acc)[2][2][4][2], const Unit& u, int wr, int wc, int fr, int fq) const {
        const int row0 = u.pm * BM + wr * 64 + fr, col0 = u.pn * BM + wc * 32 + 8 * fq;
#pragma unroll
        for (int ai = 0; ai < 2; ++ai)
#pragma unroll
            for (int m = 0; m < 4; ++m) { unsigned char* rowp = O + (size_t)(row0 + ai * HALF + m * 16) * ldc + col0;
#pragma unroll
                for (int bj = 0; bj < 2; ++bj) { const f32x4 v0 = acc[ai][bj][m][0] * sc, v1 = acc[ai][bj][m][1] * sc;
                    u32x2 w; w.x = pk4_fp8(v0[0], v0[1], v0[2], v0[3]); w.y = pk4_fp8(v1[0], v1[1], v1[2], v1[3]);
                    *(u32x2*)(rowp + bj * HALF) = w; } }
    }
};
template <int ACT  > struct EpiGlu {
    static constexpr bool PERM = true;
    bf16* O; int ldc;
    __device__ __forceinline__ void operator()(const f32x4 (&acc)[2][2][4][2], const Unit& u, int wr, int wc, int fr, int fq) const {
        const int row0 = u.pm * BM + wr * 64 + fr, col0 = u.pn * HALF + wc * 32 + 8 * fq;
#pragma unroll
        for (int ai = 0; ai < 2; ++ai)
#pragma unroll
            for (int m = 0; m < 4; ++m) { bf16* rowp = O + (size_t)(row0 + ai * HALF + m * 16) * ldc + col0;
                f32x4 g0 = acc[ai][0][m][0], g1 = acc[ai][0][m][1]; const f32x4 u0 = acc[ai][1][m][0], u1 = acc[ai][1][m][1];
                if (ACT == 1) { g0 = (f32x4){silu_f(g0[0]), silu_f(g0[1]), silu_f(g0[2]), silu_f(g0[3])}; g1 = (f32x4){silu_f(g1[0]), silu_f(g1[1]), silu_f(g1[2]), silu_f(g1[3])}; }
                const f32x4 p0 = g0 * u0, p1 = g1 * u1;
                u32x4 w; w.x = cvt_pk_bf16(p0[0], p0[1]); w.y = cvt_pk_bf16(p0[2], p0[3]); w.z = cvt_pk_bf16(p1[0], p1[1]); w.w = cvt_pk_bf16(p1[2], p1[3]);
                *(u32x4*)rowp = w; }
    }
};
struct EpiSwiglu8 {
    static constexpr bool PERM = true;
    unsigned char* O; int ldc; float s = 1.f;
    __device__ __forceinline__ void operator()(const f32x4 (&acc)[2][2][4][2], const Unit& u, int wr, int wc, int fr, int fq) const {
        const int row0 = u.pm * BM + wr * 64 + fr, col0 = u.pn * HALF + wc * 32 + 8 * fq;
#pragma unroll
        for (int ai = 0; ai < 2; ++ai)
#pragma unroll
            for (int m = 0; m < 4; ++m) { unsigned char* rowp = O + (size_t)(row0 + ai * HALF + m * 16) * ldc + col0;
                const f32x4 g0 = acc[ai][0][m][0], g1 = acc[ai][0][m][1], u0 = acc[ai][1][m][0], u1 = acc[ai][1][m][1];
                const float c1 = -LOG2E * s, s2 = s * s;
                const f32x4 p0 = (g0 * u0) * s2, p1 = (g1 * u1) * s2;
                f32x4 r0, r1;
#pragma unroll
                for (int j = 0; j < 4; ++j) { r0[j] = __builtin_amdgcn_rcpf(1.0f + __builtin_amdgcn_exp2f(g0[j] * c1)); r1[j] = __builtin_amdgcn_rcpf(1.0f + __builtin_amdgcn_exp2f(g1[j] * c1)); }
                const f32x4 o0 = p0 * r0, o1 = p1 * r1;
                u32x2 w; w.x = pk4_fp8(o0[0], o0[1], o0[2], o0[3]); w.y = pk4_fp8(o1[0], o1[1], o1[2], o1[3]);
                *(u32x2*)rowp = w; }
    }
};
struct EpiResBf16 {
    static constexpr bool PERM = true;
    const bf16* base; bf16* out; int ldc; float alpha; float sc = 1.f;
    __device__ __forceinline__ void operator()(const f32x4 (&acc)[2][2][4][2], const Unit& u, int wr, int wc, int fr, int fq) const {
        const int row0 = u.pm * BM + wr * 64 + fr, col0 = u.pn * BM + wc * 32 + 8 * fq;
#pragma unroll
        for (int ai = 0; ai < 2; ++ai)
#pragma unroll
            for (int m = 0; m < 4; ++m) { const size_t off = (size_t)(row0 + ai * HALF + m * 16) * ldc + col0;
#pragma unroll
                for (int bj = 0; bj < 2; ++bj) { const u32x4 b = *(const u32x4*)(base + off + bj * HALF); const f32x4 a0 = acc[ai][bj][m][0] * sc, a1 = acc[ai][bj][m][1] * sc;
                    u32x4 w; w.x = cvt_pk_bf16(__builtin_bit_cast(float, b.x << 16) * alpha + a0[0], __builtin_bit_cast(float, b.x & 0xffff0000u) * alpha + a0[1]);
                    w.y = cvt_pk_bf16(__builtin_bit_cast(float, b.y << 16) * alpha + a0[2], __builtin_bit_cast(float, b.y & 0xffff0000u) * alpha + a0[3]);
                    w.z = cvt_pk_bf16(__builtin_bit_cast(float, b.z << 16) * alpha + a1[0], __builtin_bit_cast(float, b.z & 0xffff0000u) * alpha + a1[1]);
                    w.w = cvt_pk_bf16(__builtin_bit_cast(float, b.w << 16) * alpha + a1[2], __builtin_bit_cast(float, b.w & 0xffff0000u) * alpha + a1[3]);
                    *(u32x4*)(out + off + bj * HALF) = w; }
                asm volatile("" ::: "memory"); }
    }
};

template <bool HB8> struct EpiResLn {
    static constexpr bool PERM = true;
    bf16* h; const float* gain; const float* bias; float alpha, sc;
    float* xbuf;
    unsigned* cnt;
    unsigned* tmo;
    unsigned char* h8;
    LAS unsigned char* tb;
    __device__ __forceinline__ void operator()(f32x4 (&acc)[2][2][4][2], const Unit& u, int wr, int wc, int fr, int fq) const {
        asm volatile("" : "+v"(fr), "+v"(fq));
        const int row0 = u.pm * BM + wr * 64 + fr, col0 = u.pn * BM + wc * 32 + 8 * fq;
        LAS f32x2* P = (LAS f32x2*)tb; LAS f32x2* S = (LAS f32x2*)(tb + 8192);
#pragma unroll
        for (int ai = 0; ai < 2; ++ai)
#pragma unroll
            for (int m = 0; m < 4; ++m) { const size_t off = (size_t)(row0 + ai * HALF + m * 16) * 1024 + col0; float sm = 0.f, sq = 0.f;
#pragma unroll
                for (int bj = 0; bj < 2; ++bj) { const u32x4 b = *(const u32x4*)(h + off + bj * HALF); const f32x4 a0 = acc[ai][bj][m][0] * sc, a1 = acc[ai][bj][m][1] * sc;
                    f32x4 z0, z1;
                    z0[0] = __builtin_bit_cast(float, b.x << 16) * alpha + a0[0]; z0[1] = __builtin_bit_cast(float, b.x & 0xffff0000u) * alpha + a0[1];
                    z0[2] = __builtin_bit_cast(float, b.y << 16) * alpha + a0[2]; z0[3] = __builtin_bit_cast(float, b.y & 0xffff0000u) * alpha + a0[3];
                    z1[0] = __builtin_bit_cast(float, b.z << 16) * alpha + a1[0]; z1[1] = __builtin_bit_cast(float, b.z & 0xffff0000u) * alpha + a1[1];
                    z1[2] = __builtin_bit_cast(float, b.w << 16) * alpha + a1[2]; z1[3] = __builtin_bit_cast(float, b.w & 0xffff0000u) * alpha + a1[3];
                    acc[ai][bj][m][0] = z0; acc[ai][bj][m][1] = z1;
                    sm += ((z0[0] + z0[1]) + (z0[2] + z0[3])) + ((z1[0] + z1[1]) + (z1[2] + z1[3]));
                    sq += ((z0[0] * z0[0] + z0[1] * z0[1]) + (z0[2] * z0[2] + z0[3] * z0[3])) + ((z1[0] * z1[0] + z1[1] * z1[1]) + (z1[2] * z1[2] + z1[3] * z1[3])); }
                sm += __shfl_xor(sm, 16); sm += __shfl_xor(sm, 32); sq += __shfl_xor(sq, 16); sq += __shfl_xor(sq, 32);
                if (fq == 0) P[(ai * HALF + wr * 64 + m * 16 + fr) * 4 + wc] = (f32x2){sm, sq};
                asm volatile("" ::: "memory"); }
        asm volatile("s_waitcnt lgkmcnt(0)" ::: "memory"); __builtin_amdgcn_s_barrier(); asm volatile("" ::: "memory");
        const int wid = wr * 4 + wc, lane = fq * 16 + fr, row = wid * 32 + (lane & 31);
        unsigned long long* slots = (unsigned long long*)xbuf + (size_t)(u.pm * BM + row) * 4;
        if (lane < 32) { const f32x2 a = P[row * 4 + 0], b = P[row * 4 + 1], c = P[row * 4 + 2], d = P[row * 4 + 3];
            const float ts = (a.x + b.x) + (c.x + d.x), tq = (a.y + b.y) + (c.y + d.y);
            __hip_atomic_store(slots + u.pn, ((unsigned long long)__builtin_bit_cast(unsigned, tq) << 32) | (unsigned long long)__builtin_bit_cast(unsigned, ts), __ATOMIC_RELAXED, __HIP_MEMORY_SCOPE_AGENT); }
        asm volatile("s_waitcnt vmcnt(0)" ::: "memory");
        if (lane == 0) (void)__hip_atomic_fetch_add(cnt + 16 * u.pm, 1u, __ATOMIC_RELAXED, __HIP_MEMORY_SCOPE_AGENT);
        if (wid == 0) { unsigned sp = 0u;
            while ((unsigned)__builtin_amdgcn_readfirstlane(__hip_atomic_load(cnt + 16 * u.pm, __ATOMIC_RELAXED, __HIP_MEMORY_SCOPE_AGENT)) < 32u) { __builtin_amdgcn_s_sleep(1);
                if ((++sp & 255u) == 0u) { if (__hip_atomic_load(tmo, __ATOMIC_RELAXED, __HIP_MEMORY_SCOPE_AGENT)) break; if (sp > (1u << 22)) { if (lane == 0) (void)__hip_atomic_fetch_add(tmo, 1u, __ATOMIC_RELAXED, __HIP_MEMORY_SCOPE_AGENT); break; } } }
            __builtin_amdgcn_fence(__ATOMIC_ACQUIRE, "agent"); }
        asm volatile("s_waitcnt vmcnt(0) lgkmcnt(0)" ::: "memory"); __builtin_amdgcn_s_barrier(); asm volatile("" ::: "memory");
        if (lane < 32) { float ts = 0.f, tq = 0.f;
#pragma unroll
            for (int t = 0; t < 4; ++t) { const unsigned long long w = __hip_atomic_load(slots + t, __ATOMIC_RELAXED, __HIP_MEMORY_SCOPE_AGENT); ts += __builtin_bit_cast(float, (unsigned)w); tq += __builtin_bit_cast(float, (unsigned)(w >> 32)); }
            const float mean = ts * (1.f / 1024.f), var = fmaxf(tq * (1.f / 1024.f) - mean * mean, 0.f);
            S[row] = (f32x2){mean, 1.f / sqrtf(var + LN_EPS)}; }
        asm volatile("s_waitcnt vmcnt(0) lgkmcnt(0)" ::: "memory"); __builtin_amdgcn_s_barrier(); asm volatile("" ::: "memory");
#pragma unroll
        for (int bj = 0; bj < 2; ++bj) { const f32x4 g0 = *(const f32x4*)(gain + col0 + bj * HALF), g1 = *(const f32x4*)(gain + col0 + bj * HALF + 4), b0 = *(const f32x4*)(bias + col0 + bj * HALF), b1 = *(const f32x4*)(bias + col0 + bj * HALF + 4);
#pragma unroll
            for (int ai = 0; ai < 2; ++ai)
#pragma unroll
                for (int m = 0; m < 4; ++m) { const int r = ai * HALF + wr * 64 + m * 16 + fr; const f32x2 sr = S[r]; const size_t off = (size_t)(u.pm * BM + r) * 1024 + col0 + bj * HALF;
                    const f32x4 y0 = (acc[ai][bj][m][0] - sr.x) * sr.y * g0 + b0, y1 = (acc[ai][bj][m][1] - sr.x) * sr.y * g1 + b1;
                    u32x4 w; w.x = cvt_pk_bf16(y0[0], y0[1]); w.y = cvt_pk_bf16(y0[2], y0[3]); w.z = cvt_pk_bf16(y1[0], y1[1]); w.w = cvt_pk_bf16(y1[2], y1[3]);
                    *(u32x4*)(h + off) = w;
                    if (HB8) { u32x2 w8; w8.x = pk4_fp8(y0[0], y0[1], y0[2], y0[3]); w8.y = pk4_fp8(y1[0], y1[1], y1[2], y1[3]); *(u32x2*)(h8 + off) = w8; }
                    asm volatile("" ::: "memory"); } }
    }
};

template <class Epi, class Sched, bool ALIGN_EPI = true, int FP8 = 0>
__device__ __forceinline__ void gemm_phase(LAS unsigned char* lds, const int wave_s, const Gemm g, const Sched& S, const Epi& E) {
    int tid = wave_s * 64 + (int)__builtin_amdgcn_mbcnt_hi(~0u, __builtin_amdgcn_mbcnt_lo(~0u, 0u)); asm volatile("" : "+v"(tid));
    const int wid = __builtin_amdgcn_readfirstlane(tid >> 6), lane = tid & 63, wr = wid >> 2, wc = wid & 3, fr = lane & 15, fq = lane >> 4;
    const int K = g.K, nt = K / BK;
    unsigned voffA[2], voffB[2];
#pragma unroll
    for (int i = 0; i < 2; ++i) { int R, C; stage_rc(tid * 16 + i * 8192, R, C); const int Rb = Epi::PERM ? ((R & ~31) + perm32(R & 31)) : R;
        voffA[i] = (unsigned)(R * g.rsA * K + C) * 2u; voffB[i] = (unsigned)(Rb * g.rsB * K + C) * 2u; }
    const unsigned kstep = (unsigned)(BK * 2);
    const unsigned hstepA = (unsigned)g.hstepA, hstepB = (unsigned)g.hstepB;
    const __amdgpu_buffer_rsrc_t rsrcA = __builtin_amdgcn_make_buffer_rsrc((void*)S.A0, 0, 0x7fffffff, 0x00020000), rsrcB = __builtin_amdgcn_make_buffer_rsrc((void*)S.B0, 0, 0x7fffffff, 0x00020000);
    const unsigned ldsw = (unsigned)wid * 1024u;
    const int aoff = lds_byte(wr * 64 + fr, fq * 8), boff = lds_byte(wc * 32 + fr, fq * 8);
    const int aoff8 = lds_byte(wr * 64 + fr, fq * 16), boff8 = lds_byte(wc * 32 + fr, fq * 16);
    unsigned bbase8_ = (unsigned)(4 * HTB + boff); asm volatile("" : "+v"(bbase8_));
    LAS unsigned char* const ldsB8 = lds + bbase8_;
#define PG8_SA(b, h) (((b) * 2 + (h)) * HTB)
#define PG8_SB(b, h) ((4 + (b) * 2 + (h)) * HTB)
#define PG8_STAGE(bufoff, gbase, voff) do { _Pragma("unroll") for (int _i = 0; _i < 2; ++_i) \
        __builtin_amdgcn_raw_ptr_buffer_load_lds(PG8_RS_##voff, (LAS unsigned*)(lds + (bufoff) + ldsw + _i * 8192), 16, (int)(voff)[_i], (int)(gbase), 0, 0); } while (0)
#define PG8_RS_voffA rsrcA
#define PG8_RS_voffB rsrcB
#define PG8_LD16(off) (*(const LAS bf16x8*)(lds + (off)))
#define PG8_CAT8(lo, hi) __builtin_shufflevector(__builtin_bit_cast(v4i_t, lo), __builtin_bit_cast(v4i_t, hi), 0, 1, 2, 3, 4, 5, 6, 7)
#define PG8_LDA(dst, b, h) do { if constexpr (FP8) { _Pragma("unroll") for (int m = 0; m < 4; ++m) dst##8[m] = PG8_CAT8(PG8_LD16(PG8_SA(b, h) + aoff + m * 2048), PG8_LD16(PG8_SA(b, h) + aoff + m * 2048 + 1024)); } \
        else { _Pragma("unroll") for (int m = 0; m < 4; ++m) _Pragma("unroll") for (int k = 0; k < 2; ++k) dst[m][k] = PG8_LD16(PG8_SA(b, h) + aoff + m * 2048 + k * 1024); } } while (0)
#define PG8_LDB(dst, b, h) do { if constexpr (FP8) { _Pragma("unroll") for (int n = 0; n < 2; ++n) dst##8[n] = PG8_CAT8(*(const LAS bf16x8*)(ldsB8 + ((b) * 2 + (h)) * HTB + n * 2048), *(const LAS bf16x8*)(ldsB8 + ((b) * 2 + (h)) * HTB + n * 2048 + 1024)); } \
        else { _Pragma("unroll") for (int n = 0; n < 2; ++n) _Pragma("unroll") for (int k = 0; k < 2; ++k) dst[n][k] = PG8_LD16(PG8_SB(b, h) + boff + n * 2048 + k * 1024); } } while (0)
#define PG8_MMA(ai, bj, At, Bt) do { __builtin_amdgcn_s_setprio(1); \
        if constexpr (FP8) { _Pragma("unroll") for (int m = 0; m < 4; ++m) _Pragma("unroll") for (int n = 0; n < 2; ++n) \
            acc[ai][bj][m][n] = __builtin_amdgcn_mfma_scale_f32_16x16x128_f8f6f4(Bt##8[n], At##8[m], acc[ai][bj][m][n], 0, 0, 0, 0, 0, 0); } \
        else { _Pragma("unroll") for (int m = 0; m < 4; ++m) _Pragma("unroll") for (int n = 0; n < 2; ++n) _Pragma("unroll") for (int k = 0; k < 2; ++k) \
            acc[ai][bj][m][n] = __builtin_amdgcn_mfma_f32_16x16x32_bf16(Bt[n][k], At[m][k], acc[ai][bj][m][n], 0, 0, 0); } \
        __builtin_amdgcn_s_setprio(0); } while (0)
#define PG8_WAIT_V(n) asm volatile("s_waitcnt vmcnt(" #n ")" ::: "memory")
#define PG8_WAIT_L(n) asm volatile("s_waitcnt lgkmcnt(" #n ")" ::: "memory")
#define PG8_BAR __builtin_amdgcn_s_barrier()
#define PG8_SCHED __builtin_amdgcn_sched_barrier(0)
    Unit cur, nxt; int ui = 0;
    if (!S.next(0, cur)) return;
    f32x4 acc[2][2][4][2];
#pragma unroll
    for (int a = 0; a < 2; ++a)
#pragma unroll
        for (int b = 0; b < 2; ++b)
#pragma unroll
            for (int m = 0; m < 4; ++m)
#pragma unroll
                for (int n = 0; n < 2; ++n) acc[a][b][m][n] = (f32x4){0.f, 0.f, 0.f, 0.f};
    bf16x8 At[4][2], B0[2][2], B1[2][2]; v8i_t At8[4], B08[2], B18[2];
    unsigned cA = cur.a, cB = cur.b;
    PG8_STAGE(PG8_SB(0, 0), cB, voffB); PG8_STAGE(PG8_SB(0, 1), cB + hstepB, voffB); PG8_STAGE(PG8_SA(0, 0), cA, voffA); PG8_STAGE(PG8_SA(0, 1), cA + hstepA, voffA);
    if (wr == 1) PG8_BAR;
    PG8_WAIT_V(2); PG8_BAR;
    PG8_STAGE(PG8_SB(1, 0), cB + kstep, voffB); PG8_STAGE(PG8_SA(1, 0), cA + kstep, voffA); PG8_STAGE(PG8_SB(1, 1), cB + hstepB + kstep, voffB);
    PG8_WAIT_V(6); PG8_BAR;
    for (;;) {
        const bool has_next = S.next(ui + 1, nxt);
        const unsigned nA = has_next ? nxt.a : cA, nB = has_next ? nxt.b : cB;
#pragma clang loop unroll(disable)
        for (int t = 0; t < nt; t += 2) {
            const bool last = (t == nt - 2);
            const unsigned a1 = cA + (unsigned)(t + 1) * kstep;
            const unsigned a2 = last ? nA : cA + (unsigned)(t + 2) * kstep, b2 = last ? nB : cB + (unsigned)(t + 2) * kstep;
            const unsigned a3 = a2 + kstep, b3 = b2 + kstep;
            PG8_LDB(B0, 0, 0); PG8_LDB(B1, 0, 1); PG8_SCHED; PG8_LDA(At, 0, 0); PG8_STAGE(PG8_SA(1, 1), a1 + hstepA, voffA);
            PG8_WAIT_V(8); PG8_WAIT_L(0); PG8_BAR; PG8_MMA(0, 0, At, B0); PG8_MMA(0, 1, At, B1); PG8_BAR; PG8_SCHED;
            PG8_LDA(At, 0, 1); PG8_STAGE(PG8_SB(0, 0), b2, voffB); PG8_STAGE(PG8_SB(0, 1), b2 + hstepB, voffB); PG8_STAGE(PG8_SA(0, 0), a2, voffA);
            PG8_WAIT_V(8); PG8_WAIT_L(0); PG8_BAR; PG8_MMA(1, 0, At, B0); PG8_MMA(1, 1, At, B1); PG8_BAR; PG8_SCHED;
            PG8_LDB(B0, 1, 0); PG8_LDB(B1, 1, 1); PG8_SCHED; PG8_LDA(At, 1, 0); PG8_STAGE(PG8_SA(0, 1), a2 + hstepA, voffA);
            PG8_WAIT_V(8); PG8_WAIT_L(0); PG8_BAR; PG8_MMA(0, 0, At, B0); PG8_MMA(0, 1, At, B1); PG8_BAR; PG8_SCHED;
            PG8_LDA(At, 1, 1); PG8_STAGE(PG8_SB(1, 0), b3, voffB); PG8_STAGE(PG8_SB(1, 1), b3 + hstepB, voffB); PG8_STAGE(PG8_SA(1, 0), a3, voffA);
            PG8_WAIT_V(8); PG8_WAIT_L(0); PG8_BAR; PG8_MMA(1, 0, At, B0); PG8_MMA(1, 1, At, B1); PG8_BAR; PG8_SCHED;
        }
        if constexpr (ALIGN_EPI) { if (wr == 0) PG8_BAR; }
        E(acc, cur, wr, wc, fr, fq);
        if (!has_next) break;
#pragma unroll
        for (int a = 0; a < 2; ++a)
#pragma unroll
            for (int b = 0; b < 2; ++b)
#pragma unroll
                for (int m = 0; m < 4; ++m)
#pragma unroll
                    for (int n = 0; n < 2; ++n) acc[a][b][m][n] = (f32x4){0.f, 0.f, 0.f, 0.f};
        cur = nxt; cA = nA; cB = nB; ++ui;
        if constexpr (ALIGN_EPI) { if (wr == 1) PG8_BAR; }
    }
    PG8_WAIT_V(0);
    if constexpr (!ALIGN_EPI) { if (wr == 0) PG8_BAR; }
    PG8_BAR;
#undef PG8_SA
#undef PG8_SB
#undef PG8_STAGE
#undef PG8_RS_voffA
#undef PG8_RS_voffB
#undef PG8_LDA
#undef PG8_LD16
#undef PG8_CAT8
#undef PG8_LDB
#undef PG8_MMA
#undef PG8_WAIT_V
#undef PG8_WAIT_L
#undef PG8_BAR
#undef PG8_SCHED
}
}

#define RLX_AGENT __ATOMIC_RELAXED, __HIP_MEMORY_SCOPE_AGENT
#define LDS_WAIT() asm volatile("s_waitcnt lgkmcnt(0)" ::: "memory")
#define VM_WAIT() asm volatile("s_waitcnt vmcnt(0)" ::: "memory")
__device__ __forceinline__ unsigned f2bf(float f) { unsigned u = __builtin_bit_cast(unsigned, f); return (u + 0x7fffu + ((u >> 16) & 1u)) >> 16; }
__device__ __forceinline__ unsigned pk2(float lo, float hi) { return pg8::cvt_pk_bf16(lo, hi); }
__device__ __forceinline__ float bflo(unsigned w) { return __builtin_bit_cast(float, w << 16); }
__device__ __forceinline__ float bfhi(unsigned w) { return __builtin_bit_cast(float, w & 0xffff0000u); }
__device__ __forceinline__ float wave_sum(float v) {
#pragma unroll
    for (int o = 1; o < 64; o <<= 1) v += __shfl_xor(v, o);
    return v;
}

#define XB_TMO      128
#define XB_XCNT(j)  (256  + 64 * (j))
#define XB_XSUB(j)  (1280 + 64 * (j))
#define XB_XGEN(j)  (2304 + 64 * (j))
#define XB_TOP      3328
#define XB_TOPGEN   3392
#define XCD_BAR_WORDS 3456
#define XB_SPIN_CAP (1u << 22)
__device__ __forceinline__ unsigned xb_ld(unsigned* p)              { return __hip_atomic_load(p, __ATOMIC_RELAXED, __HIP_MEMORY_SCOPE_AGENT); }
__device__ __forceinline__ unsigned xb_add(unsigned* p, unsigned v) { return __hip_atomic_fetch_add(p, v, __ATOMIC_RELAXED, __HIP_MEMORY_SCOPE_AGENT); }
__device__ __forceinline__ unsigned xb_xcc_id() { return (unsigned)__builtin_amdgcn_s_getreg((3 << 11) | 20) & 0xFu; }
#define XB_SPIN(cond, bar) do { unsigned _sp = 0; while (cond) { __builtin_amdgcn_s_sleep(1); \
    if ((++_sp & 255u) == 0u) { if (xb_ld(&(bar)[XB_TMO])) break; if (_sp > XB_SPIN_CAP) { atomicAdd(&(bar)[XB_TMO], 1u); break; } } } } while (0)
struct XcdBarrier { unsigned* bar; unsigned x; volatile LAS unsigned* st; };
__device__ __forceinline__ XcdBarrier xcd_barrier_post(unsigned* bar, volatile LAS unsigned* st) {
    XcdBarrier b; b.bar = bar; b.x = xb_xcc_id(); b.st = st;
    if (threadIdx.x == 0) (void)xb_add(&bar[XB_XCNT(b.x)], 1u);
    return b;
}
__device__ __forceinline__ void xcd_barrier_complete(unsigned* bar, unsigned x, unsigned& nloc, unsigned& nx) {
    const unsigned G = gridDim.x * gridDim.y * gridDim.z;
    unsigned sum, cnt, mine, sp = 0u;
    for (;;) {
        sum = 0u; cnt = 0u; mine = 0u;
#pragma unroll
        for (unsigned j = 0; j < 16; ++j) { const unsigned c = xb_ld(&bar[XB_XCNT(j)]); sum += c; cnt += (c > 0u) ? 1u : 0u; mine = (j == x) ? c : mine; }
        if (sum == G) break;
        __builtin_amdgcn_s_sleep(1);
        if ((++sp & 255u) == 0u) { if (xb_ld(&bar[XB_TMO])) break; if (sp > XB_SPIN_CAP) { atomicAdd(&bar[XB_TMO], 1u); break; } }
    }
    nloc = mine > 0u ? mine : 1u; nx = cnt > 0u ? cnt : 1u;
}
__device__ __forceinline__ void xcd_barrier(const XcdBarrier& b, const int tid) {
    asm volatile("s_waitcnt vmcnt(0)" ::: "memory");
    __syncthreads();
    if (tid == 0) {
        unsigned* bar = b.bar;
        __builtin_amdgcn_s_waitcnt(0);
        unsigned nloc = b.st[0], nx = b.st[1];
        if (nloc == 0u) { xcd_barrier_complete(bar, b.x, nloc, nx); b.st[0] = nloc; b.st[1] = nx; }
        const unsigned old = xb_add(&bar[XB_XSUB(b.x)], 1u);
        const unsigned gen = old / nloc;
        if (old + 1u == (gen + 1u) * nloc) {
            __builtin_amdgcn_fence(__ATOMIC_RELEASE, "agent");
            asm volatile("s_waitcnt vmcnt(0)" ::: "memory");
            const unsigned og = xb_add(&bar[XB_TOP], 1u);
            const unsigned tg = og / nx;
            if (og + 1u == (tg + 1u) * nx) xb_add(&bar[XB_TOPGEN], 1u);
            else XB_SPIN(xb_ld(&bar[XB_TOPGEN]) == tg, bar);
            __builtin_amdgcn_fence(__ATOMIC_ACQUIRE, "agent");
            xb_add(&bar[XB_XGEN(b.x)], 1u);
            asm volatile("s_waitcnt vmcnt(0)" ::: "memory");
        } else {
            XB_SPIN(xb_ld(&bar[XB_XGEN(b.x)]) == gen, bar);
            __builtin_amdgcn_fence(__ATOMIC_ACQUIRE, "agent");
            asm volatile("s_waitcnt vmcnt(0)" ::: "memory");
        }
    }
    __syncthreads();
}

constexpr int NWAVES = 8;
constexpr int RING_BYTES = 131072, MISC_OFF = RING_BYTES + 320, LNT_OFF = RING_BYTES + 2048  , LDS_BYTES = 147456;
struct Args { const float* in[24]; float* out; unsigned char* ws; int ph_lo, ph_hi; int chk, pad; };
struct Frame {
    LAS unsigned char* lds;
    gu32* ctl; unsigned char* ws; float* out;
    int tid, lane, wave, vcu, G;
    int chk, stage;
};

struct Job { const float* src; bf16* dst; int ld, K, N, mode, start; float scale; int fp8, pad; };
constexpr int NJOBS = 74;
__device__ __forceinline__ void make_job(const Args& a, int j, Job& J) {
    unsigned char* ws = a.ws; J.scale = 1.f; J.mode = 0; J.start = 0; J.fp8 = 0; J.pad = 0;
    if (j < 9) { const int g = j / 3, t = j % 3; J.src = a.in[4] + g * 3072 + t * 1024; J.ld = 9216; J.K = 1024; J.N = 1024;
        if (t == 2) J.dst = (bf16*)(ws + W_A_V + (size_t)g * 1024 * 1024); else J.dst = (bf16*)(ws + W_A_QK + (size_t)g * 2048 * 1024 + (size_t)t * 1024 * 1024);
        J.fp8 = 1; J.scale = (t == 0 ? QSCALE : 1.f) * WSCALE8; return; }
    j -= 9;
    if (j == 0) { J.src = a.in[5]; J.ld = 1024; J.K = 1024; J.N = 1024; J.dst = (bf16*)(ws + W_A_O); J.fp8 = 1; J.scale = WSCALE8; return; }
    if (j == 1) { J.src = a.in[6]; J.ld = 3072; J.K = 1024; J.N = 1024; J.dst = (bf16*)(ws + W_B_IN); return; }
    if (j == 9 || j == 10) { J.src = a.in[6] + 1024 * (j - 8); J.ld = 3072; J.K = 1024; J.N = 1024; J.dst = (bf16*)(ws + W_B_IN) + (size_t)1024 * 1024; J.mode = j - 8; return; }
    if (j == 2) { J.src = a.in[8]; J.ld = 1024; J.K = 1024; J.N = 1024; J.dst = (bf16*)(ws + W_B_O); return; }
    if (j == 3) { J.src = a.in[9]; J.ld = 3072; J.K = 1024; J.N = 1024; J.dst = (bf16*)(ws + W_C_QK); J.scale = QSCALE; return; }
    if (j == 4) { J.src = a.in[9] + 1024; J.ld = 3072; J.K = 1024; J.N = 1024; J.dst = (bf16*)(ws + W_C_QK) + (size_t)1024 * 1024; return; }
    if (j == 5) { J.src = a.in[9] + 2048; J.ld = 3072; J.K = 1024; J.N = 1024; J.dst = (bf16*)(ws + W_C_V); return; }
    if (j == 6) { J.src = a.in[10]; J.ld = 1024; J.K = 1024; J.N = 1024; J.dst = (bf16*)(ws + W_C_O); J.fp8 = 1; J.scale = WSCALE8; return; }
    if (j == 7) { J.src = a.in[11]; J.ld = 2048; J.K = 1024; J.N = 2048; J.dst = (bf16*)(ws + W_D_IN); return; }
    if (j == 8) { J.src = a.in[16]; J.ld = 1024; J.K = 1024; J.N = 1024; J.dst = (bf16*)(ws + W_D_O); return; }
    j -= 11;
    if (j < 6) { const int f = j / 3, t = j % 3;
        if (t < 2) { J.src = a.in[17 + t] + (size_t)f * 1024 * DFF; J.ld = DFF; J.K = 1024; J.N = DFF; J.dst = (bf16*)(ws + W_F_GU) + (size_t)f * 2 * DFF * 1024; J.mode = 1 + t;
            if (f == FFN_GU8) { J.fp8 = 1; J.scale = WSCALE8; } }
        else { J.src = a.in[19] + (size_t)f * DFF * 1024; J.ld = 1024; J.K = DFF; J.N = 1024; J.dst = (bf16*)(ws + W_F_D) + (size_t)f * 1024 * DFF; J.fp8 = 1; J.scale = WSCALE8D; }
        return; }
    j -= 6;
    { const int fe = j / 3, t = j % 3;
        if (t < 2) { J.src = a.in[21 + t] + (size_t)fe * 1024 * DFE; J.ld = DFE; J.K = 1024; J.N = DFE; J.dst = (bf16*)(ws + W_E_GU) + (size_t)fe * 2 * DFE * 1024; J.mode = 1 + t; J.fp8 = 1; J.scale = WSCALE8; }
        else { J.src = a.in[23] + (size_t)fe * DFE * 1024; J.ld = 1024; J.K = DFE; J.N = 1024; J.dst = (bf16*)(ws + W_E_D) + (size_t)fe * 1024 * DFE; J.fp8 = 1; J.scale = WSCALE8D; } }
}
__device__ __forceinline__ void transpose_item(const Job& J, int item, int lane) {
    const int nblk = J.N >> 6, kb = item / nblk, nb = item - kb * nblk, k0 = 64 * kb, n = 64 * nb + lane;
    const float* W = J.src + (size_t)k0 * J.ld + n;
    int r = n; if (J.mode) r = (n >> 7) * 256 + (n & 127) + (J.mode == 2 ? 128 : 0);
    const float sc = J.scale; const size_t ld = (size_t)J.ld;
    if (J.fp8) {
        unsigned char* dst8 = (unsigned char*)J.dst + (size_t)r * J.K + k0;
#pragma unroll
        for (int hf = 0; hf < 2; ++hf) {
            float v[32];
#pragma unroll
            for (int j = 0; j < 32; ++j) v[j] = W[(size_t)(32 * hf + j) * ld];
#pragma unroll
            for (int c = 0; c < 2; ++c) { u32x4 o; o.x = pk4_fp8(v[16 * c] * sc, v[16 * c + 1] * sc, v[16 * c + 2] * sc, v[16 * c + 3] * sc); o.y = pk4_fp8(v[16 * c + 4] * sc, v[16 * c + 5] * sc, v[16 * c + 6] * sc, v[16 * c + 7] * sc);
                o.z = pk4_fp8(v[16 * c + 8] * sc, v[16 * c + 9] * sc, v[16 * c + 10] * sc, v[16 * c + 11] * sc); o.w = pk4_fp8(v[16 * c + 12] * sc, v[16 * c + 13] * sc, v[16 * c + 14] * sc, v[16 * c + 15] * sc);
                *(u32x4*)(dst8 + 32 * hf + 16 * c) = o; }
        }
        return;
    }
    bf16* dst = J.dst + (size_t)r * J.K + k0;
#pragma unroll
    for (int hf = 0; hf < 2; ++hf) {
        float v[32];
#pragma unroll
        for (int j = 0; j < 32; ++j) v[j] = W[(size_t)(32 * hf + j) * ld];
#pragma unroll
        for (int c = 0; c < 4; ++c) { u32x4 o; o.x = pk2(v[8 * c] * sc, v[8 * c + 1] * sc); o.y = pk2(v[8 * c + 2] * sc, v[8 * c + 3] * sc); o.z = pk2(v[8 * c + 4] * sc, v[8 * c + 5] * sc); o.w = pk2(v[8 * c + 6] * sc, v[8 * c + 7] * sc);
            *(u32x4*)(dst + 32 * hf + 8 * c) = o; }
    }
}
__device__ __forceinline__ int t5_bucket(int d) {
    if (d < 16) return d;
    int b = 16 + (int)(log((double)d / 16.0) / log(128.0) * 16.0);
    return b < 16 ? 16 : (b > 31 ? 31 : b);
}
__device__ __forceinline__ void p_prologue(Frame& F, const Args& a) {
    unsigned char* gl_ = (unsigned char*)F.lds;
    Job* jobs = (Job*)(gl_ + 7 * 16384 + 8704);
    int* tot = (int*)(gl_ + 7 * 16384 + 8704 + NJOBS * sizeof(Job));
    static_assert(8704 + NJOBS * sizeof(Job) + 16 <= 16384, "job table fits");
    if (F.tid < NJOBS) { Job J; make_job(a, F.tid, J); jobs[F.tid] = J; }
    __syncthreads();
    if (F.tid == 0) { int s = 0; for (int j = 0; j < NJOBS; ++j) { jobs[j].start = s; s += (jobs[j].K / 64) * (jobs[j].N / 64); } tot[0] = s; }
    __syncthreads();
    const int total = tot[0];
    const int gw = F.vcu * NWAVES + F.wave, NGW = F.G * NWAVES;
    int jc = 0;
    for (int it = gw; it < total; it += NGW) {
        while (jc + 1 < NJOBS && jobs[jc + 1].start <= it) ++jc;
        const Job J = jobs[jc];
        transpose_item(J, it - J.start, F.lane);
    }
    { bf16* hb = (bf16*)(F.ws + WS_HB); const float* x = a.in[0]; unsigned char* hb8 = F.ws + WS_SCR + S_HB8;
      for (int m0 = 4 * gw; m0 < T; m0 += 4 * NGW) { f32x4 v[4][4];
#pragma unroll
          for (int k = 0; k < 4; ++k) { const f32x4* xr = (const f32x4*)(x + (size_t)(m0 + k) * D) + F.lane;
#pragma unroll
              for (int j = 0; j < 4; ++j) v[k][j] = xr[64 * j]; }
#pragma unroll
          for (int k = 0; k < 4; ++k) { unsigned long long* o8 = (unsigned long long*)(hb + (size_t)(m0 + k) * D) + F.lane;
#pragma unroll
              for (int j = 0; j < 4; ++j) o8[64 * j] = (unsigned long long)pk2(v[k][j].x, v[k][j].y) | ((unsigned long long)pk2(v[k][j].z, v[k][j].w) << 32);
              unsigned* o4 = (unsigned*)(hb8 + (size_t)(m0 + k) * D) + F.lane;
#pragma unroll
              for (int j = 0; j < 4; ++j) o4[64 * j] = pk4_fp8(v[k][j].x, v[k][j].y, v[k][j].z, v[k][j].w); } } }
    const int gt = blockIdx.x * 512 + F.tid, NGT = F.G * 512;
    const float* rel = a.in[1];
    float* btA = (float*)(F.ws + WS_BTABA); float* btC = (float*)(F.ws + WS_BTABC);
    for (int i = gt; i < 48 * 132; i += NGT) { const int gh = i / 132, dl = i % 132, g = gh >> 4, hh = gh & 15; const int dil = g == 0 ? 1 : (g == 1 ? 4 : 16);
        btA[i] = dl <= 128 ? rel[t5_bucket(dl * dil) * NH + hh] * LOG2E : 0.f; }
    for (int i = gt; i < 16 * 2048; i += NGT) { const int hh = i >> 11, dd = i & 2047; btC[i] = rel[t5_bucket(dd) * NH + hh] * LOG2E; }
    { bf16* wst = (bf16*)(F.ws + WS_WST); const float* wsrc = a.in[14];
      for (int i = gt; i < 8 * 128 * 128; i += NGT) { const int tt = (i >> 7) & 127, ss = i & 127; wst[i] = (bf16)f2bf(ss <= tt ? wsrc[i] : 0.f); } }
}

__device__ __forceinline__ void unpack8(const u32x4 a, float* x) { x[0] = bflo(a.x); x[1] = bfhi(a.x); x[2] = bflo(a.y); x[3] = bfhi(a.y); x[4] = bflo(a.z); x[5] = bfhi(a.z); x[6] = bflo(a.w); x[7] = bfhi(a.w); }
template <int MODE, bool ROUTE, bool FINAL, bool HB8 = false>
__device__ __forceinline__ void ln_phase(Frame& F, const float* gain, const float* bias, const float* wr) {
    constexpr int NBT = 2;
    const int gw = F.vcu * NWAVES + F.wave, NGW = F.G * NWAVES, lane = F.lane;
    bf16* hb = (bf16*)(F.ws + WS_HB); const bf16* zb = (const bf16*)F.out;
    float gv[16], bv[16];
#pragma unroll
    for (int k = 0; k < 2; ++k)
#pragma unroll
        for (int j = 0; j < 2; ++j) { const f32x4 g4 = *(const f32x4*)(gain + 512 * k + 8 * lane + 4 * j), b4 = *(const f32x4*)(bias + 512 * k + 8 * lane + 4 * j);
            gv[8 * k + 4 * j] = g4.x; gv[8 * k + 4 * j + 1] = g4.y; gv[8 * k + 4 * j + 2] = g4.z; gv[8 * k + 4 * j + 3] = g4.w;
            bv[8 * k + 4 * j] = b4.x; bv[8 * k + 4 * j + 1] = b4.y; bv[8 * k + 4 * j + 2] = b4.z; bv[8 * k + 4 * j + 3] = b4.w; }
    LAS float* wrT = (LAS float*)F.lds;
    if (ROUTE) { for (int i = F.tid; i < 8 * 1024; i += 512) { const int e = i >> 10, c = i & 1023; wrT[i] = wr[c * 8 + e]; } __syncthreads(); }
    const bf16* ys = (const bf16*)(F.ws + WS_SCR + S_XG);
    const int* slots = (const int*)(F.ws + WS_SLOTS); const float* gates = (const float*)(F.ws + WS_GATES);
    int* route = (int*)(F.ws + WS_ROUTE); float* gout = (float*)(F.ws + WS_GATES);
    for (int grp = gw; grp < T / 32; grp += NGW) {
        int cnt_e = 0;
        int my_e1 = 0, my_e2 = 0, my_r1 = 0, my_r2 = 0; float my_g1 = 0.f, my_g2 = 0.f;
        int sl0 = 0, sl1 = 0; float gg0 = 0.f, gg1 = 0.f;
        if (MODE == 2) { const int mm = grp * 32 + (lane & 31); sl0 = slots[2 * mm]; sl1 = slots[2 * mm + 1]; gg0 = gates[2 * mm]; gg1 = gates[2 * mm + 1]; }
        for (int i0 = 0; i0 < 32; i0 += NBT) {
            float v[NBT][16]; float st[NBT][2];
#pragma unroll
            for (int k = 0; k < NBT; ++k) { const int m = grp * 32 + i0 + k;
                if (MODE == 0) { const u32x4* zr = (const u32x4*)(zb + (size_t)m * D) + lane; unpack8(zr[0], v[k]); unpack8(zr[64], v[k] + 8); }
                else { const u32x4* hr = (const u32x4*)(hb + (size_t)m * D) + lane; unpack8(hr[0], v[k]); unpack8(hr[64], v[k] + 8);
#pragma unroll
                    for (int j = 0; j < 16; ++j) v[k][j] *= ALPHA;
                    if (MODE == 3) { const u32x4* yr = (const u32x4*)((const bf16*)(F.ws + WS_SCR + S_Y) + (size_t)m * D) + lane; float a[16]; unpack8(yr[0], a); unpack8(yr[64], a + 8);
#pragma unroll
                        for (int j = 0; j < 16; ++j) v[k][j] += a[j]; }
                    if (MODE == 2) { const int s0 = __builtin_amdgcn_readlane(sl0, i0 + k), s1 = __builtin_amdgcn_readlane(sl1, i0 + k);
                        const float g0 = __builtin_bit_cast(float, __builtin_amdgcn_readlane(__builtin_bit_cast(int, gg0), i0 + k)), g1 = __builtin_bit_cast(float, __builtin_amdgcn_readlane(__builtin_bit_cast(int, gg1), i0 + k));
                        const u32x4* y0 = (const u32x4*)(ys + (size_t)s0 * D) + lane; const u32x4* y1 = (const u32x4*)(ys + (size_t)s1 * D) + lane;
                        float a[16], b[16]; unpack8(y0[0], a); unpack8(y0[64], a + 8); unpack8(y1[0], b); unpack8(y1[64], b + 8);
#pragma unroll
                        for (int j = 0; j < 16; ++j) v[k][j] += g0 * a[j] + g1 * b[j]; } }
                float s = 0.f, q2 = 0.f;
#pragma unroll
                for (int j = 0; j < 16; ++j) { s += v[k][j]; q2 += v[k][j] * v[k][j]; }
                st[k][0] = s; st[k][1] = q2; }
#pragma unroll
            for (int o = 1; o < 64; o <<= 1) {
#pragma unroll
                for (int k = 0; k < NBT; ++k) { st[k][0] += __shfl_xor(st[k][0], o); st[k][1] += __shfl_xor(st[k][1], o); } }
#pragma unroll
            for (int k = 0; k < NBT; ++k) { const int m = grp * 32 + i0 + k;
                const float mean = st[k][0] * (1.f / D), var = fmaxf(st[k][1] * (1.f / D) - mean * mean, 0.f), rstd = 1.f / sqrtf(var + LN_EPS);
#pragma unroll
                for (int j = 0; j < 16; ++j) v[k][j] = (v[k][j] - mean) * rstd * gv[j] + bv[j];
                if (FINAL) { f32x4* orow = (f32x4*)(F.out + (size_t)m * D) + 2 * lane;
                    orow[0] = (f32x4){v[k][0], v[k][1], v[k][2], v[k][3]}; orow[1] = (f32x4){v[k][4], v[k][5], v[k][6], v[k][7]}; orow[128] = (f32x4){v[k][8], v[k][9], v[k][10], v[k][11]}; orow[129] = (f32x4){v[k][12], v[k][13], v[k][14], v[k][15]}; }
                else { u32x4* o = (u32x4*)(hb + (size_t)m * D) + lane; u32x4 a, b;
                    a.x = pk2(v[k][0], v[k][1]); a.y = pk2(v[k][2], v[k][3]); a.z = pk2(v[k][4], v[k][5]); a.w = pk2(v[k][6], v[k][7]); b.x = pk2(v[k][8], v[k][9]); b.y = pk2(v[k][10], v[k][11]); b.z = pk2(v[k][12], v[k][13]); b.w = pk2(v[k][14], v[k][15]);
                    o[0] = a; o[64] = b;
                    if (HB8) { u32x2* o8 = (u32x2*)(F.ws + WS_SCR + S_HB8 + (size_t)m * D) + lane; u32x2 c, d;
                        c.x = pk4_fp8(v[k][0], v[k][1], v[k][2], v[k][3]); c.y = pk4_fp8(v[k][4], v[k][5], v[k][6], v[k][7]); d.x = pk4_fp8(v[k][8], v[k][9], v[k][10], v[k][11]); d.y = pk4_fp8(v[k][12], v[k][13], v[k][14], v[k][15]);
                        o8[0] = c; o8[64] = d; } }
                if (ROUTE) {
                    float lg[8];
#pragma unroll
                    for (int e = 0; e < 8; ++e) { float p = 0.f;
#pragma unroll
                        for (int kk = 0; kk < 2; ++kk)
#pragma unroll
                            for (int j = 0; j < 2; ++j) { const f32x4 w4 = *(const LAS f32x4*)(wrT + e * 1024 + 512 * kk + 8 * lane + 4 * j); p += (v[k][8 * kk + 4 * j] * w4.x + v[k][8 * kk + 4 * j + 1] * w4.y) + (v[k][8 * kk + 4 * j + 2] * w4.z + v[k][8 * kk + 4 * j + 3] * w4.w); }
                        lg[e] = p; }
#pragma unroll
                    for (int o = 1; o < 64; o <<= 1) {
#pragma unroll
                        for (int e = 0; e < 8; ++e) lg[e] += __shfl_xor(lg[e], o); }
                    int e1 = 0; float v1 = lg[0];
#pragma unroll
                    for (int e = 1; e < 8; ++e) if (lg[e] > v1) { v1 = lg[e]; e1 = e; }
                    int e2 = -1; float v2 = -3.4e38f;
#pragma unroll
                    for (int e = 0; e < 8; ++e) if (e != e1 && lg[e] > v2) { v2 = lg[e]; e2 = e; }
                    const float g2 = 1.f / (1.f + __expf(v1 - v2)), g1 = 1.f - g2;
                    const int r1 = __shfl(cnt_e, e1); if (lane == e1) ++cnt_e;
                    const int r2 = __shfl(cnt_e, e2); if (lane == e2) ++cnt_e;
                    if (lane == i0 + k) { my_e1 = e1; my_e2 = e2; my_r1 = r1; my_r2 = r2; my_g1 = g1; my_g2 = g2; }
                }
            }
        }
        if (ROUTE) {
            if (lane < 8) ((int*)(F.ws + WS_WCNT))[grp * 8 + lane] = cnt_e;
            if (lane < 32) { const int m = grp * 32 + lane; int* r = route + 4 * m; r[0] = my_e1; r[1] = my_r1; r[2] = my_e2; r[3] = my_r2; gout[2 * m] = my_g1; gout[2 * m + 1] = my_g2; }
        }
    }
}

__device__ __forceinline__ f32x16 mfma32(bf16x8 a, bf16x8 b, f32x16 c) { return __builtin_amdgcn_mfma_f32_32x32x16_bf16(a, b, c, 0, 0, 0); }
__device__ __forceinline__ bf16x8 pack8(const f32x16& s, int b0) {
    u32x4 w; w.x = pg8::cvt_pk_bf16(s[b0], s[b0 + 1]); w.y = pg8::cvt_pk_bf16(s[b0 + 2], s[b0 + 3]); w.z = pg8::cvt_pk_bf16(s[b0 + 4], s[b0 + 5]); w.w = pg8::cvt_pk_bf16(s[b0 + 6], s[b0 + 7]);
    return __builtin_bit_cast(bf16x8, w);
}
__device__ __forceinline__ float max16(const f32x16& s) {
    float a = fmaxf(fmaxf(s[0], s[1]), fmaxf(s[2], s[3])), b = fmaxf(fmaxf(s[4], s[5]), fmaxf(s[6], s[7]));
    float c = fmaxf(fmaxf(s[8], s[9]), fmaxf(s[10], s[11])), d = fmaxf(fmaxf(s[12], s[13]), fmaxf(s[14], s[15]));
    return fmaxf(fmaxf(a, b), fmaxf(c, d));
}
__device__ __forceinline__ void softmax_pv(f32x16& s, float& m_run, float& l_run, f32x16& o0, f32x16& o1, const bf16* vt0, const bf16* vt1, int h) {
    float mx = max16(s); mx = fmaxf(mx, __shfl_xor(mx, 32));
    const float mn = fmaxf(m_run, mx), alpha = __builtin_amdgcn_exp2f(m_run - mn); m_run = mn;
    float ps = 0.f;
#pragma unroll
    for (int r = 0; r < 16; ++r) { const float p = __builtin_amdgcn_exp2f(s[r] - mn); s[r] = p; ps += p; }
    l_run = l_run * alpha + ps;
#pragma unroll
    for (int r = 0; r < 16; ++r) { o0[r] *= alpha; o1[r] *= alpha; }
    const bf16x8 p0 = pack8(s, 0), p1 = pack8(s, 8);
    const bf16x8 v00 = *(const bf16x8*)(vt0 + 8 * h), v01 = *(const bf16x8*)(vt0 + 16 + 8 * h), v10 = *(const bf16x8*)(vt1 + 8 * h), v11 = *(const bf16x8*)(vt1 + 16 + 8 * h);
    o0 = mfma32(v00, p0, o0); o0 = mfma32(v01, p1, o0);
    o1 = mfma32(v10, p0, o1); o1 = mfma32(v11, p1, o1);
}
__device__ __forceinline__ int kperm(int i) { return (i & 19) | ((i & 8) >> 1) | ((i & 4) << 1); }

__device__ __forceinline__ void dil_attn_phase(Frame& F) {
    LAS float* bt = (LAS float*)F.lds;
    { const float* btA = (const float*)(F.ws + WS_BTABA); for (int i = F.tid; i < 48 * 192; i += 512) { const int gh = i / 192, dl = i % 192 - 32; bt[i] = (dl >= 0 && dl <= 128) ? btA[gh * 132 + dl] : NEGB; } }
    __syncthreads();
    const int gw = F.vcu * NWAVES + F.wave, NGW = F.G * NWAVES, lane = F.lane, q = lane & 31, h = lane >> 5;
    const bf16* QK = (const bf16*)(F.ws + WS_SCR + S_QK); const bf16* VT = (const bf16*)(F.ws + WS_SCR + S_VT);
    bf16* OG = (bf16*)((unsigned char*)F.out + O_OG); float* LSE = (float*)((unsigned char*)F.out + O_LSE);
    constexpr int NTASK = 3 * 16 * 8 * 64;
    const int per = (NTASK + NGW - 1) / NGW;
    const int t_lo = gw * per, t_hi = (t_lo + per) < NTASK ? (t_lo + per) : NTASK;
    for (int task = t_lo; task < t_hi; ++task) {
        const int qt = task & 3, rn = (task >> 2) & 15, bl = (task >> 6) & 7, gh = task >> 9, g = gh >> 4, hh = gh & 15;
        const int nblk = 16 >> (2 * g); const bool has_prev = (rn & (nblk - 1)) != 0;
        const int n0 = bl * 2048 + rn * 128;
        const bf16* qrow = QK + ((size_t)g * TC + n0 + 32 * qt + q) * 2048 + hh * 64;
        bf16x8 qf[4];
#pragma unroll
        for (int d0 = 0; d0 < 4; ++d0) qf[d0] = *(const bf16x8*)(qrow + d0 * 16 + 8 * h);
        float m_run = NEGB, l_run = 0.f; f32x16 o0 = {}, o1 = {};
        const bf16* vbase0 = VT + ((size_t)g * 1024 + hh * 64 + q) * TC; const bf16* vbase1 = vbase0 + (size_t)32 * TC;
        const LAS float* btl = bt + gh * 192 + (q - 8 * h + 137);
#pragma unroll
        for (int t = 0; t < 5; ++t) {
            if (has_prev || qt + t > 3) {
                const int kr0 = n0 - 128 + 32 * qt + 32 * t;
                const bf16* krow = QK + ((size_t)g * TC + kr0 + kperm(q)) * 2048 + 1024 + hh * 64;
                f32x16 s;
#pragma unroll
                for (int r = 0; r < 16; ++r) s[r] = btl[-32 * t + 23 - 16 * (r >> 3) - (r & 7)];
#pragma unroll
                for (int d0 = 0; d0 < 4; ++d0) { const bf16x8 kf = *(const bf16x8*)(krow + d0 * 16 + 8 * h); s = mfma32(kf, qf[d0], s); }
                softmax_pv(s, m_run, l_run, o0, o1, vbase0 + kr0, vbase1 + kr0, h);
            }
        }
        const float l_tot = l_run + __shfl_xor(l_run, 32), inv = 1.f / l_tot;
        const size_t orow = (size_t)g * TC + n0 + 32 * qt + q;
        bf16* op = OG + orow * 1024 + hh * 64 + 4 * h;
#pragma unroll
        for (int gq = 0; gq < 4; ++gq) {
            u32x2 w0, w1; w0.x = pg8::cvt_pk_bf16(o0[4 * gq] * inv, o0[4 * gq + 1] * inv); w0.y = pg8::cvt_pk_bf16(o0[4 * gq + 2] * inv, o0[4 * gq + 3] * inv);
            w1.x = pg8::cvt_pk_bf16(o1[4 * gq] * inv, o1[4 * gq + 1] * inv); w1.y = pg8::cvt_pk_bf16(o1[4 * gq + 2] * inv, o1[4 * gq + 3] * inv);
            *(u32x2*)(op + 8 * gq) = w0; *(u32x2*)(op + 32 + 8 * gq) = w1; }
        if (h == 0) LSE[orow * 16 + hh] = m_run + __log2f(l_tot);
    }
}
__device__ __forceinline__ void dil_merge_phase(Frame& F, int ck) {
    const int gw = F.vcu * NWAVES + F.wave, NGW = F.G * NWAVES, lane = F.lane;
    const bf16* OG = (const bf16*)((unsigned char*)F.out + O_OG); const float* LSE = (const float*)((unsigned char*)F.out + O_LSE);
    unsigned char* att = F.ws + WS_SCR + S_ATT + (size_t)ck * TC * 1024;
    const int hh = lane >> 2;
    for (int tl0 = 2 * gw; tl0 < TC; tl0 += 2 * NGW) {
        size_t n[2][3]; float ls[2][3]; u32x4 x[2][3];
#pragma unroll
        for (int k = 0; k < 2; ++k) { const int tl = tl0 + k, bl = tl >> 11, tt = tl & 2047;
            n[k][0] = tl; n[k][1] = bl * 2048 + (tt & 3) * 512 + (tt >> 2); n[k][2] = bl * 2048 + (tt & 15) * 128 + (tt >> 4);
#pragma unroll
            for (int g = 0; g < 3; ++g) { ls[k][g] = LSE[((size_t)g * TC + n[k][g]) * 16 + hh]; x[k][g] = *(const u32x4*)((const unsigned char*)OG + ((size_t)g * TC + n[k][g]) * 1024 + 16 * lane); } }
#pragma unroll
        for (int k = 0; k < 2; ++k) {
            const float M = fmaxf(fmaxf(ls[k][0], ls[k][1]), ls[k][2]);
            float w[3]; float W = 0.f;
#pragma unroll
            for (int g = 0; g < 3; ++g) { w[g] = __builtin_amdgcn_exp2f(ls[k][g] - M); W += w[g]; }
            const float iw = 1.f / W;
            float acc[16];
#pragma unroll
            for (int j = 0; j < 16; ++j) acc[j] = 0.f;
#pragma unroll
            for (int g = 0; g < 3; ++g) { const float wg = w[g] * iw; float a[16];
#pragma unroll
                for (int c = 0; c < 4; ++c) { const f32x2 lo = __builtin_amdgcn_cvt_pk_f32_fp8((int)x[k][g][c], false), hi = __builtin_amdgcn_cvt_pk_f32_fp8((int)x[k][g][c], true); a[4 * c] = lo.x; a[4 * c + 1] = lo.y; a[4 * c + 2] = hi.x; a[4 * c + 3] = hi.y; }
#pragma unroll
                for (int j = 0; j < 16; ++j) acc[j] += wg * a[j]; }
            u32x4 y; y.x = pk4_fp8(acc[0], acc[1], acc[2], acc[3]); y.y = pk4_fp8(acc[4], acc[5], acc[6], acc[7]); y.z = pk4_fp8(acc[8], acc[9], acc[10], acc[11]); y.w = pk4_fp8(acc[12], acc[13], acc[14], acc[15]);
            *(u32x4*)(att + (size_t)(tl0 + k) * 1024 + 16 * lane) = y;
        }
    }
}

__device__ __forceinline__ void conv_phase(Frame& F, const float* cw) {
    const int gw = F.vcu * NWAVES + F.wave, NGW = F.G * NWAVES, lane = F.lane;
    const bf16* gbp = (const bf16*)(F.ws + WS_SCR + S_BCX); const bf16* up = (const bf16*)(F.ws + WS_SCR + S_BCX + (size_t)128 * MiB); bf16* p = (bf16*)(F.ws + WS_SCR + S_P);
    for (int item = gw; item < (T / 32) * 2; item += NGW) {
        const int half = item & 1, tb = item >> 1, t0 = tb * 32, c0 = half * 512 + lane * 8;
        float w0[8], w1[8], w2[8];
#pragma unroll
        for (int j = 0; j < 8; ++j) { w0[j] = cw[c0 + j]; w1[j] = cw[1024 + c0 + j]; w2[j] = cw[2048 + c0 + j]; }
        float u1[8], u2[8];
        const bool first = (t0 & 2047) == 0;
#pragma unroll
        for (int j = 0; j < 8; ++j) { u1[j] = 0.f; u2[j] = 0.f; }
        if (!first) { unpack8(*(const u32x4*)(up + (size_t)(t0 - 2) * 1024 + c0), u2); unpack8(*(const u32x4*)(up + (size_t)(t0 - 1) * 1024 + c0), u1); }
        for (int i = 0; i < 32; ++i) { const size_t r = (size_t)(t0 + i) * 1024;
            const u32x4 gb = *(const u32x4*)(gbp + r + c0), uu = *(const u32x4*)(up + r + c0);
            float u0[8], b[8]; unpack8(uu, u0); unpack8(gb, b);
            float o[8];
#pragma unroll
            for (int j = 0; j < 8; ++j) { o[j] = b[j] * (w0[j] * u2[j] + w1[j] * u1[j] + w2[j] * u0[j]); u2[j] = u1[j]; u1[j] = u0[j]; }
            u32x4 x; x.x = pk2(o[0], o[1]); x.y = pk2(o[2], o[3]); x.z = pk2(o[4], o[5]); x.w = pk2(o[6], o[7]);
            *(u32x4*)(p + (size_t)(t0 + i) * 1024 + c0) = x; }
    }
}

__device__ __forceinline__ void kmean_phase(Frame& F) {
    const int gw = F.vcu * NWAVES + F.wave, NGW = F.G * NWAVES, lane = F.lane;
    const bf16* QK = (const bf16*)(F.ws + WS_SCR + S_CQK); float* km = (float*)(F.ws + WS_KMEAN);
    const int kq = lane >> 3, dc = lane & 7;
    for (int u = gw; u < NB * NH * 8; u += NGW) { const int blk = u & 7, hh = (u >> 3) & 15, b = u >> 7;
        float a[8];
#pragma unroll
        for (int j = 0; j < 8; ++j) a[j] = 0.f;
        const bf16* kp = QK + ((size_t)b * SEQ + blk * 256 + kq) * 2048 + 1024 + hh * 64 + dc * 8;
#pragma unroll 8
        for (int i = 0; i < 32; ++i) { const u32x4 x = *(const u32x4*)(kp + (size_t)i * 8 * 2048);
            a[0] += bflo(x.x); a[1] += bfhi(x.x); a[2] += bflo(x.y); a[3] += bfhi(x.y); a[4] += bflo(x.z); a[5] += bfhi(x.z); a[6] += bflo(x.w); a[7] += bfhi(x.w); }
#pragma unroll
        for (int j = 0; j < 8; ++j) { a[j] += __shfl_xor(a[j], 8); a[j] += __shfl_xor(a[j], 16); a[j] += __shfl_xor(a[j], 32); }
        if (lane < 8) { float* o = km + (size_t)u * 64 + lane * 8;
#pragma unroll
            for (int j = 0; j < 8; ++j) o[j] = a[j] * (1.f / 256.f); }
    }
}
__device__ __forceinline__ void moba_unit(Frame& F, int b, int hh, int nb, LAS float* bt, int& cur_h) {
    const int lane = F.lane, q = lane & 31, h = lane >> 5, w = F.wave;
    const bf16* QK = (const bf16*)(F.ws + WS_SCR + S_CQK); const bf16* VT = (const bf16*)(F.ws + WS_SCR + S_CVT);
    bf16* att = (bf16*)(F.ws + WS_SCR + S_CATT); const float* km = (const float*)(F.ws + WS_KMEAN);
    if (hh != cur_h) { __syncthreads(); const float* btC = (const float*)(F.ws + WS_BTABC) + hh * 2048; for (int i = F.tid; i < 2048; i += 512) bt[i] = btC[i]; cur_h = hh; __syncthreads(); }
    const size_t tq = (size_t)b * SEQ + nb * 256 + 32 * w + q;
    const bf16* qrow = QK + tq * 2048 + hh * 64;
    bf16x8 qf[4];
#pragma unroll
    for (int d0 = 0; d0 < 4; ++d0) qf[d0] = *(const bf16x8*)(qrow + d0 * 16 + 8 * h);
    unsigned sel = 0;
    if (nb > 0) {
        float gsc[7];
#pragma unroll
        for (int m = 0; m < 7; ++m) { float s = 0.f;
            if (m < nb) { const float* kmp = km + (((size_t)b * NH + hh) * 8 + m) * 64;
#pragma unroll
                for (int d0 = 0; d0 < 4; ++d0) { const f32x4 k0 = *(const f32x4*)(kmp + d0 * 16 + 8 * h), k1 = *(const f32x4*)(kmp + d0 * 16 + 8 * h + 4); const u32x4 qq = __builtin_bit_cast(u32x4, qf[d0]);
                    s += bflo(qq.x) * k0.x + bfhi(qq.x) * k0.y + bflo(qq.y) * k0.z + bfhi(qq.y) * k0.w + bflo(qq.z) * k1.x + bfhi(qq.z) * k1.y + bflo(qq.w) * k1.z + bfhi(qq.w) * k1.w; }
                s += __shfl_xor(s, 32); }
            gsc[m] = m < nb ? s : -3.0e38f; }
        const int nsel = nb < 3 ? nb : 3;
#pragma unroll
        for (int r = 0; r < 3; ++r) { if (r < nsel) { int bi = -1; float bv = -3.4e38f;
#pragma unroll
                for (int m = 0; m < 7; ++m) if (!((sel >> m) & 1u) && gsc[m] > bv) { bv = gsc[m]; bi = m; }
                sel |= 1u << bi; } }
    }
#ifdef MK_SELFCHECK
    if (h == 0) ((unsigned*)(F.ws + WS_NEED + 3 * MiB))[tq * 16 + hh] = sel;
#endif
    float m_run = NEGB, l_run = 0.f; f32x16 o0 = {}, o1 = {};
    const bf16* vbase0 = VT + ((size_t)hh * 64 + q) * T + (size_t)b * SEQ; const bf16* vbase1 = vbase0 + (size_t)32 * T;
    const int qpos = nb * 256 + 32 * w + q;
    for (int m = 0; m < nb; ++m) {
        const bool mine = (sel >> m) & 1u;
        if (__ballot(mine) == 0ull) continue;
        for (int kt = 0; kt < 8; ++kt) {
            const int kr0 = m * 256 + 32 * kt;
            const bf16* krow = QK + ((size_t)b * SEQ + kr0 + kperm(q)) * 2048 + 1024 + hh * 64;
            f32x16 s = {};
#pragma unroll
            for (int d0 = 0; d0 < 4; ++d0) { const bf16x8 kf = *(const bf16x8*)(krow + d0 * 16 + 8 * h); s = mfma32(kf, qf[d0], s); }
#pragma unroll
            for (int r = 0; r < 16; ++r) { const int kap = 16 * (r >> 3) + 8 * h + (r & 7); const float bb = bt[qpos - kr0 - kap]; s[r] = mine ? s[r] + bb : NEGB; }
            softmax_pv(s, m_run, l_run, o0, o1, vbase0 + kr0, vbase1 + kr0, h);
        }
    }
    for (int kt = 0; kt <= w; ++kt) {
        const int kr0 = nb * 256 + 32 * kt;
        const bf16* krow = QK + ((size_t)b * SEQ + kr0 + kperm(q)) * 2048 + 1024 + hh * 64;
        f32x16 s = {};
#pragma unroll
        for (int d0 = 0; d0 < 4; ++d0) { const bf16x8 kf = *(const bf16x8*)(krow + d0 * 16 + 8 * h); s = mfma32(kf, qf[d0], s); }
#pragma unroll
        for (int r = 0; r < 16; ++r) { const int kap = 16 * (r >> 3) + 8 * h + (r & 7); const int dd = qpos - kr0 - kap; const float bb = bt[dd < 0 ? 0 : dd]; s[r] = dd >= 0 ? s[r] + bb : NEGB; }
        softmax_pv(s, m_run, l_run, o0, o1, vbase0 + kr0, vbase1 + kr0, h);
    }
    const float l_tot = l_run + __shfl_xor(l_run, 32), inv = 1.f / l_tot;
#ifdef MK_SELFCHECK
    if (h == 0) ((float*)(F.ws + WS_NEED + 7 * MiB))[tq * 16 + hh] = m_run + __log2f(l_tot);
#endif
    bf16* op = att + tq * 1024 + hh * 64 + 4 * h;
#pragma unroll
    for (int gq = 0; gq < 4; ++gq) {
        u32x2 w0, w1; w0.x = pg8::cvt_pk_bf16(o0[4 * gq] * inv, o0[4 * gq + 1] * inv); w0.y = pg8::cvt_pk_bf16(o0[4 * gq + 2] * inv, o0[4 * gq + 3] * inv);
        w1.x = pg8::cvt_pk_bf16(o1[4 * gq] * inv, o1[4 * gq + 1] * inv); w1.y = pg8::cvt_pk_bf16(o1[4 * gq + 2] * inv, o1[4 * gq + 3] * inv);
        *(u32x2*)(op + 8 * gq) = w0; *(u32x2*)(op + 32 + 8 * gq) = w1; }
}
__device__ __forceinline__ void moba_phase(Frame& F) {
    LAS float* bt = (LAS float*)F.lds; int cur_h = -1;
    const int NP = NB * NH * 4, per = (NP + F.G - 1) / F.G;
    const int lo = F.vcu * per, hi = (lo + per) < NP ? (lo + per) : NP;
    for (int pu = lo; pu < hi; ++pu) { const int j = pu & 3, hh = (pu >> 2) & 15, b = pu >> 6;
        moba_unit(F, b, hh, 7 - j, bt, cur_h); moba_unit(F, b, hh, j, bt, cur_h); }
}


constexpr int AKP = 72;
constexpr int ATILE = 64 * AKP * 2;
struct AttnSt { float m, l; f32x16 o0, o1; };
template <bool MASKED>
__device__ __forceinline__ void attn_tile(const LAS bf16* Kt, const LAS bf16* Vt, const LAS float* bl, const bf16x8 (&qf)[4], AttnSt& st, int q, int h, bool mine) {
    f32x16 s;
#pragma unroll
    for (int r = 0; r < 16; ++r) s[r] = bl[23 - 16 * (r >> 3) - (r & 7)];
    const LAS bf16* kr = Kt + kperm(q) * AKP + 8 * h;
#pragma unroll
    for (int d0 = 0; d0 < 4; ++d0) s = mfma32(*(const LAS bf16x8*)(kr + d0 * 16), qf[d0], s);
    float mx = max16(s); mx = fmaxf(mx, __shfl_xor(mx, 32));
    float mn = fmaxf(st.m, mx); if (MASKED) mn = mine ? mn : st.m;
    const float alpha = __builtin_amdgcn_exp2f(st.m - mn);
    float ps = 0.f;
#pragma unroll
    for (int r = 0; r < 16; ++r) { const float p = __builtin_amdgcn_exp2f(s[r] - mn); s[r] = p; ps += p; }
    bf16x8 p0 = pack8(s, 0), p1 = pack8(s, 8);
    if (MASKED) { if (!mine) { p0 = (bf16x8){0, 0, 0, 0, 0, 0, 0, 0}; p1 = p0; ps = 0.f; } }
    st.l = st.l * alpha + ps; st.m = mn;
    if (__ballot(alpha != 1.0f) != 0ull) {
#pragma unroll
        for (int r = 0; r < 16; ++r) { st.o0[r] *= alpha; st.o1[r] *= alpha; } }
    const LAS bf16* v0 = Vt + q * AKP + 8 * h; const LAS bf16* v1 = v0 + 32 * AKP;
    st.o0 = mfma32(*(const LAS bf16x8*)v0, p0, st.o0); st.o0 = mfma32(*(const LAS bf16x8*)(v0 + 16), p1, st.o0);
    st.o1 = mfma32(*(const LAS bf16x8*)v1, p0, st.o1); st.o1 = mfma32(*(const LAS bf16x8*)(v1 + 16), p1, st.o1);
}
__device__ __forceinline__ void attn_store(const AttnSt& st, bf16* op  , float inv) {
#pragma unroll
    for (int gq = 0; gq < 4; ++gq) {
        u32x2 w0, w1; w0.x = pg8::cvt_pk_bf16(st.o0[4 * gq] * inv, st.o0[4 * gq + 1] * inv); w0.y = pg8::cvt_pk_bf16(st.o0[4 * gq + 2] * inv, st.o0[4 * gq + 3] * inv);
        w1.x = pg8::cvt_pk_bf16(st.o1[4 * gq] * inv, st.o1[4 * gq + 1] * inv); w1.y = pg8::cvt_pk_bf16(st.o1[4 * gq + 2] * inv, st.o1[4 * gq + 3] * inv);
        *(u32x2*)(op + 8 * gq) = w0; *(u32x2*)(op + 32 + 8 * gq) = w1; }
}

__device__ __forceinline__ void attn_store8(const AttnSt& st, unsigned char* op  , float inv) {
#pragma unroll
    for (int gq = 0; gq < 4; ++gq) {
        *(unsigned*)(op + 8 * gq) = pk4_fp8(st.o0[4 * gq] * inv, st.o0[4 * gq + 1] * inv, st.o0[4 * gq + 2] * inv, st.o0[4 * gq + 3] * inv);
        *(unsigned*)(op + 32 + 8 * gq) = pk4_fp8(st.o1[4 * gq] * inv, st.o1[4 * gq + 1] * inv, st.o1[4 * gq + 2] * inv, st.o1[4 * gq + 3] * inv); }
}

__device__ __forceinline__ void dil_attn_phase2(Frame& F) {
    LAS float* bt = (LAS float*)F.lds;
    { const float* btA = (const float*)(F.ws + WS_BTABA); for (int i = F.tid; i < 48 * 192; i += 512) { const int gh = i / 192, dl = i % 192 - 32; bt[i] = (dl >= 0 && dl <= 128) ? btA[gh * 132 + dl] : NEGB; } }
    __syncthreads();
    constexpr int TBL = 48 * 192 * 4;
    const int lane = F.lane, q = lane & 31, h = lane >> 5, w = F.wave, uw = w >> 2, qt = w & 3, t = F.tid, tu = t >> 8, tt = t & 255, srow = tt >> 3, sch = tt & 7;
    const bf16* QK = (const bf16*)(F.ws + WS_SCR + S_QK); const bf16* VT = (const bf16*)(F.ws + WS_SCR + S_VT);
    bf16* OG = (bf16*)((unsigned char*)F.out + O_OG); float* LSE = (float*)((unsigned char*)F.out + O_LSE);
    for (int du = F.vcu; du < 3072; du += F.G) {
        const int g = du >> 10, rem = du & 1023, hh = rem >> 6, blp = (rem >> 4) & 3, rn = rem & 15, gh = g * 16 + hh;
        const int nblk = 16 >> (2 * g); const bool has_prev = (rn & (nblk - 1)) != 0;
        const int j0 = has_prev ? 0 : 2;
        const int n0s = (2 * blp + tu) * 2048 + rn * 128;
        const bf16* ksrc = QK + ((size_t)g * TC + n0s - 128 + srow) * 2048 + 1024 + hh * 64 + sch * 8;
        const bf16* vsrc = VT + ((size_t)g * 1024 + hh * 64 + srow) * TC + (n0s - 128) + sch * 8;
        const int sdst = srow * AKP + sch * 8;
        const int n0 = (2 * blp + uw) * 2048 + rn * 128;
        const bf16* qrow = QK + ((size_t)g * TC + n0 + 32 * qt + q) * 2048 + hh * 64;
        bf16x8 qf[4];
#pragma unroll
        for (int d0 = 0; d0 < 4; ++d0) qf[d0] = *(const bf16x8*)(qrow + d0 * 16 + 8 * h);
        AttnSt st; st.m = NEGB; st.l = 0.f; st.o0 = (f32x16){}; st.o1 = (f32x16){};
        u32x4 k0, k1, v0, v1;
        k0 = *(const u32x4*)(ksrc + (size_t)(64 * j0) * 2048); k1 = *(const u32x4*)(ksrc + (size_t)(64 * j0 + 32) * 2048);
        v0 = *(const u32x4*)(vsrc + 64 * j0); v1 = *(const u32x4*)(vsrc + (size_t)32 * TC + 64 * j0);
        { LAS bf16* kb = (LAS bf16*)(F.lds + TBL + (0 * 2 + tu) * 2 * ATILE); LAS bf16* vb = kb + 64 * AKP;
          *(LAS u32x4*)(kb + sdst) = k0; *(LAS u32x4*)(kb + 32 * AKP + sdst) = k1; *(LAS u32x4*)(vb + sdst) = v0; *(LAS u32x4*)(vb + 32 * AKP + sdst) = v1; }
        __syncthreads();
        int pb = 0;
        for (int j = j0; j < 4; ++j) {
            const bool more = j + 1 < 4;
            if (more) { k0 = *(const u32x4*)(ksrc + (size_t)(64 * (j + 1)) * 2048); k1 = *(const u32x4*)(ksrc + (size_t)(64 * (j + 1) + 32) * 2048);
                        v0 = *(const u32x4*)(vsrc + 64 * (j + 1)); v1 = *(const u32x4*)(vsrc + (size_t)32 * TC + 64 * (j + 1)); }
            const LAS bf16* kb = (const LAS bf16*)(F.lds + TBL + (pb * 2 + uw) * 2 * ATILE); const LAS bf16* vb = kb + 64 * AKP;
#pragma unroll
            for (int t2 = 0; t2 < 2; ++t2) { const int t32 = 2 * j + t2;
                if (t32 >= qt && t32 <= qt + 4) {
                    const LAS float* bl = bt + gh * 192 + 32 + (32 * qt + q + 128 - 32 * t32 - 8 * h - 23);
                    attn_tile<false>(kb + 32 * t2 * AKP, vb + 32 * t2, bl, qf, st, q, h, true); } }
            if (more) { LAS bf16* kn = (LAS bf16*)(F.lds + TBL + ((pb ^ 1) * 2 + tu) * 2 * ATILE); LAS bf16* vn = kn + 64 * AKP;
                *(LAS u32x4*)(kn + sdst) = k0; *(LAS u32x4*)(kn + 32 * AKP + sdst) = k1; *(LAS u32x4*)(vn + sdst) = v0; *(LAS u32x4*)(vn + 32 * AKP + sdst) = v1; }
            __syncthreads();
            pb ^= 1;
        }
        const float l_tot = st.l + __shfl_xor(st.l, 32), inv = 1.f / l_tot;
        const size_t orow = (size_t)g * TC + n0 + 32 * qt + q;
        attn_store(st, OG + orow * 1024 + hh * 64 + 4 * h, inv);
        if (h == 0) LSE[orow * 16 + hh] = st.m + __log2f(l_tot);
    }
}

__device__ __forceinline__ void moba_unit2(Frame& F, int b, int hh, int nb, LAS float* bt, int& cur_h) {
    constexpr int TBL = 8448;
    const int lane = F.lane, q = lane & 31, h = lane >> 5, w = F.wave, t = F.tid, srow = t >> 3, sch = t & 7;
    const bf16* QK = (const bf16*)(F.ws + WS_SCR + S_CQK); const bf16* VT = (const bf16*)(F.ws + WS_SCR + S_CVT);
    bf16* att = (bf16*)(F.ws + WS_SCR + S_CATT); const float* km = (const float*)(F.ws + WS_KMEAN);
    if (hh != cur_h) { __syncthreads(); const float* btC = (const float*)(F.ws + WS_BTABC) + hh * 2048; for (int i = t; i < 2048 + 32; i += 512) bt[i] = i < 32 ? NEGB : btC[i - 32]; cur_h = hh; __syncthreads(); }
    const size_t tq = (size_t)b * SEQ + nb * 256 + 32 * w + q;
    const bf16* qrow = QK + tq * 2048 + hh * 64;
    bf16x8 qf[4];
#pragma unroll
    for (int d0 = 0; d0 < 4; ++d0) qf[d0] = *(const bf16x8*)(qrow + d0 * 16 + 8 * h);
    unsigned sel = 0;
    if (nb > 0) {
        float gsc[7];
#pragma unroll
        for (int m = 0; m < 7; ++m) { float s = 0.f;
            if (m < nb) { const float* kmp = km + (((size_t)b * NH + hh) * 8 + m) * 64;
#pragma unroll
                for (int d0 = 0; d0 < 4; ++d0) { const f32x4 k0 = *(const f32x4*)(kmp + d0 * 16 + 8 * h), k1 = *(const f32x4*)(kmp + d0 * 16 + 8 * h + 4); const u32x4 qq = __builtin_bit_cast(u32x4, qf[d0]);
                    s += bflo(qq.x) * k0.x + bfhi(qq.x) * k0.y + bflo(qq.y) * k0.z + bfhi(qq.y) * k0.w + bflo(qq.z) * k1.x + bfhi(qq.z) * k1.y + bflo(qq.w) * k1.z + bfhi(qq.w) * k1.w; }
                s += __shfl_xor(s, 32); }
            gsc[m] = m < nb ? s : -3.0e38f; }
        const int nsel = nb < 3 ? nb : 3;
#pragma unroll
        for (int r = 0; r < 3; ++r) { if (r < nsel) { int bi = 0; float bv = -3.4e38f;
#pragma unroll
                for (int m = 0; m < 7; ++m) if (!((sel >> m) & 1u) && gsc[m] > bv) { bv = gsc[m]; bi = m; }
                sel |= 1u << bi; } }
    }
    AttnSt st; st.m = NEGB; st.l = 0.f; st.o0 = (f32x16){}; st.o1 = (f32x16){};
    const int qpos = nb * 256 + 32 * w + q, nsteps = 4 * nb + 4;
    const bf16* ksrc = QK + ((size_t)b * SEQ + srow) * 2048 + 1024 + hh * 64 + sch * 8;
    const bf16* vsrc = VT + ((size_t)hh * 64 + srow) * T + (size_t)b * SEQ + sch * 8;
    const int sdst = srow * AKP + sch * 8;
    u32x4 kreg = *(const u32x4*)ksrc, vreg = *(const u32x4*)vsrc;
    { LAS bf16* kb = (LAS bf16*)(F.lds + TBL); *(LAS u32x4*)(kb + sdst) = kreg; *(LAS u32x4*)(kb + 64 * AKP + sdst) = vreg; }
    __syncthreads();
    int pb = 0;
    for (int s = 0; s < nsteps; ++s) {
        const bool more = s + 1 < nsteps;
        if (more) { kreg = *(const u32x4*)(ksrc + (size_t)(64 * (s + 1)) * 2048); vreg = *(const u32x4*)(vsrc + 64 * (s + 1)); }
        const LAS bf16* kb = (const LAS bf16*)(F.lds + TBL + pb * 2 * ATILE); const LAS bf16* vb = kb + 64 * AKP;
        if (s < 4 * nb) {
            const bool mine = (sel >> (s >> 2)) & 1u;
            if (__ballot(mine) != 0ull) {
#pragma unroll
                for (int t2 = 0; t2 < 2; ++t2) { const LAS float* bl = bt + 32 + (qpos - 8 * h - (64 * s + 32 * t2) - 23);
                    attn_tile<true>(kb + 32 * t2 * AKP, vb + 32 * t2, bl, qf, st, q, h, mine); } }
        } else {
#pragma unroll
            for (int t2 = 0; t2 < 2; ++t2) { const int t32 = (s - 4 * nb) * 2 + t2;
                if (t32 <= w) { const LAS float* bl = bt + 32 + (qpos - 8 * h - (64 * s + 32 * t2) - 23);
                    attn_tile<false>(kb + 32 * t2 * AKP, vb + 32 * t2, bl, qf, st, q, h, true); } }
        }
        if (more) { LAS bf16* kn = (LAS bf16*)(F.lds + TBL + (pb ^ 1) * 2 * ATILE); *(LAS u32x4*)(kn + sdst) = kreg; *(LAS u32x4*)(kn + 64 * AKP + sdst) = vreg; }
        __syncthreads();
        pb ^= 1;
    }
    const float l_tot = st.l + __shfl_xor(st.l, 32), inv = 1.f / l_tot;
    attn_store(st, att + tq * 1024 + hh * 64 + 4 * h, inv);
}
__device__ __forceinline__ void moba_phase2(Frame& F) {
    LAS float* bt = (LAS float*)F.lds; int cur_h = -1;
    const int NP = NB * NH * 4, per = (NP + F.G - 1) / F.G;
    const int lo = F.vcu * per, hi = (lo + per) < NP ? (lo + per) : NP;
    for (int pu = lo; pu < hi; ++pu) { const int j = pu & 3, hh = (pu >> 2) & 15, b = pu >> 6;
        moba_unit2(F, b, hh, 7 - j, bt, cur_h); moba_unit2(F, b, hh, j, bt, cur_h); }
}


__device__ __forceinline__ float xhalf_max(float m) { auto rr = __builtin_amdgcn_permlane32_swap(__float_as_uint(m), __float_as_uint(m), false, false); return fmaxf(__uint_as_float(rr[0]), __uint_as_float(rr[1])); }
__device__ __forceinline__ float xhalf_sum(float m) { auto rr = __builtin_amdgcn_permlane32_swap(__float_as_uint(m), __float_as_uint(m), false, false); return __uint_as_float(rr[0]) + __uint_as_float(rr[1]); }
template <bool MASKED>
__device__ __forceinline__ void attn_tile2(const LAS bf16* Kt, const LAS bf16* Vt, const LAS float* bl0, const bf16x8 (&qf)[4], AttnSt& st, int q, int h, bool mine) {
    f32x16 s0, s1;
#pragma unroll
    for (int r = 0; r < 16; ++r) { s0[r] = bl0[23 - 16 * (r >> 3) - (r & 7)]; s1[r] = bl0[-32 + 23 - 16 * (r >> 3) - (r & 7)]; }
    const LAS bf16* kr = Kt + kperm(q) * AKP + 8 * h;
#pragma unroll
    for (int d0 = 0; d0 < 4; ++d0) { s0 = mfma32(*(const LAS bf16x8*)(kr + d0 * 16), qf[d0], s0); s1 = mfma32(*(const LAS bf16x8*)(kr + 32 * AKP + d0 * 16), qf[d0], s1); }
    const float mx = xhalf_max(fmaxf(max16(s0), max16(s1)));
    float mn = fmaxf(st.m, mx); if (MASKED) mn = mine ? mn : st.m;
    const float alpha = __builtin_amdgcn_exp2f(st.m - mn);
    float ps0 = 0.f, ps1 = 0.f;
#pragma unroll
    for (int r = 0; r < 16; ++r) { const float p = __builtin_amdgcn_exp2f(s0[r] - mn); s0[r] = p; ps0 += p; const float p2 = __builtin_amdgcn_exp2f(s1[r] - mn); s1[r] = p2; ps1 += p2; }
    bf16x8 p00 = pack8(s0, 0), p01 = pack8(s0, 8), p10 = pack8(s1, 0), p11 = pack8(s1, 8);
    float ps = ps0 + ps1;
    if (MASKED) { if (!mine) { p00 = (bf16x8){0, 0, 0, 0, 0, 0, 0, 0}; p01 = p00; p10 = p00; p11 = p00; ps = 0.f; } }
    st.l = st.l * alpha + ps; st.m = mn;
    if (__ballot(alpha != 1.0f) != 0ull) {
#pragma unroll
        for (int r = 0; r < 16; ++r) { st.o0[r] *= alpha; st.o1[r] *= alpha; } }
    const LAS bf16* v0 = Vt + q * AKP + 8 * h; const LAS bf16* v1 = v0 + 32 * AKP;
    st.o0 = mfma32(*(const LAS bf16x8*)v0, p00, st.o0); st.o1 = mfma32(*(const LAS bf16x8*)v1, p00, st.o1);
    st.o0 = mfma32(*(const LAS bf16x8*)(v0 + 16), p01, st.o0); st.o1 = mfma32(*(const LAS bf16x8*)(v1 + 16), p01, st.o1);
    st.o0 = mfma32(*(const LAS bf16x8*)(v0 + 32), p10, st.o0); st.o1 = mfma32(*(const LAS bf16x8*)(v1 + 32), p10, st.o1);
    st.o0 = mfma32(*(const LAS bf16x8*)(v0 + 48), p11, st.o0); st.o1 = mfma32(*(const LAS bf16x8*)(v1 + 48), p11, st.o1);
}

__device__ __forceinline__ u32x4 f8x8_bf16(u32x2 v) {
    const f32x2 a = __builtin_amdgcn_cvt_pk_f32_fp8((int)v.x, false), b = __builtin_amdgcn_cvt_pk_f32_fp8((int)v.x, true), c = __builtin_amdgcn_cvt_pk_f32_fp8((int)v.y, false), d = __builtin_amdgcn_cvt_pk_f32_fp8((int)v.y, true);
    u32x4 r; r.x = pg8::cvt_pk_bf16(a.x, a.y); r.y = pg8::cvt_pk_bf16(b.x, b.y); r.z = pg8::cvt_pk_bf16(c.x, c.y); r.w = pg8::cvt_pk_bf16(d.x, d.y); return r;
}
__device__ __forceinline__ void dil_attn_phase3(Frame& F) {
    LAS float* bt = (LAS float*)F.lds;
    { const float* btA = (const float*)(F.ws + WS_BTABA); for (int i = F.tid; i < 48 * 192; i += 512) { const int gh = i / 192, dl = i % 192 - 32; bt[i] = (dl >= 0 && dl <= 128) ? btA[gh * 132 + dl] : NEGB; } }
    constexpr int TBL = 48 * 192 * 4;
    const int lane = F.lane, q = lane & 31, h = lane >> 5, w = F.wave, uw = w >> 2, qt = w & 3, t = F.tid, tu = t >> 8, tt = t & 255, srow = tt >> 3, sch = tt & 7;
    const unsigned char* QK = F.ws + WS_SCR + S_QK; const unsigned char* VT = F.ws + WS_SCR + S_VT;
    bf16* OG = (bf16*)((unsigned char*)F.out + O_OG); float* LSE = (float*)((unsigned char*)F.out + O_LSE);
    const int sdst = srow * AKP + sch * 8;
    int du = F.vcu;
    if (du >= 3072) { __syncthreads(); return; }
    int g = du >> 10, hh = (du >> 6) & 15, blp = (du >> 4) & 3, rn = du & 15;
    int j = ((rn & ((16 >> (2 * g)) - 1)) != 0) ? 0 : 2;
    u32x2 k0, k1, v0, v1; u32x2 qn[4]; bf16x8 qf[4];
#define DIL_LOADS(G_, HH_, BLP_, RN_, J_) do { const int n0s_ = (2 * (BLP_) + tu) * 2048 + (RN_) * 128 - 128 + 64 * (J_); \
        const unsigned char* ks_ = QK + ((size_t)(G_) * TC + n0s_ + srow) * 2048 + 1024 + (HH_) * 64 + sch * 8; \
        const unsigned char* vs_ = VT + ((size_t)(G_) * 1024 + (HH_) * 64 + srow) * TC + n0s_ + sch * 8; \
        k0 = *(const u32x2*)ks_; k1 = *(const u32x2*)(ks_ + (size_t)32 * 2048); v0 = *(const u32x2*)vs_; v1 = *(const u32x2*)(vs_ + (size_t)32 * TC); } while (0)
#define DIL_QLOADS(G_, HH_, BLP_, RN_) do { const unsigned char* qr_ = QK + ((size_t)(G_) * TC + (2 * (BLP_) + uw) * 2048 + (RN_) * 128 + 32 * qt + q) * 2048 + (HH_) * 64; \
        _Pragma("unroll") for (int d0 = 0; d0 < 4; ++d0) qn[d0] = *(const u32x2*)(qr_ + d0 * 16 + 8 * h); } while (0)
#define DIL_WRITE(PB_) do { LAS bf16* kb_ = (LAS bf16*)(F.lds + TBL + ((PB_) * 2 + tu) * 2 * ATILE); LAS bf16* vb_ = kb_ + 64 * AKP; \
        *(LAS u32x4*)(kb_ + sdst) = f8x8_bf16(k0); *(LAS u32x4*)(kb_ + 32 * AKP + sdst) = f8x8_bf16(k1); *(LAS u32x4*)(vb_ + sdst) = f8x8_bf16(v0); *(LAS u32x4*)(vb_ + 32 * AKP + sdst) = f8x8_bf16(v1); } while (0)
    DIL_LOADS(g, hh, blp, rn, j); DIL_QLOADS(g, hh, blp, rn);
    DIL_WRITE(0);
#pragma unroll
    for (int d0 = 0; d0 < 4; ++d0) qf[d0] = __builtin_bit_cast(bf16x8, f8x8_bf16(qn[d0]));
    __syncthreads();
    AttnSt st; st.m = NEGB; st.l = 0.f; st.o0 = (f32x16){}; st.o1 = (f32x16){};
    int pb = 0;
    for (;;) {
        const bool last = (j == 3);
        int ng = g, nhh = hh, nblp = blp, nrn = rn, nj = j + 1; bool more = true;
        if (last) { const int nd = du + F.G; more = nd < 3072; ng = nd >> 10; nhh = (nd >> 6) & 15; nblp = (nd >> 4) & 3; nrn = nd & 15; nj = ((nrn & ((16 >> (2 * ng)) - 1)) != 0) ? 0 : 2; }
        if (more) { DIL_LOADS(ng, nhh, nblp, nrn, nj); if (last) DIL_QLOADS(ng, nhh, nblp, nrn); }
        { const LAS bf16* kb = (const LAS bf16*)(F.lds + TBL + (pb * 2 + uw) * 2 * ATILE); const LAS bf16* vb = kb + 64 * AKP;
          const int gh = g * 16 + hh, ta = 2 * j, tb = 2 * j + 1;
          const bool a_on = ta >= qt && ta <= qt + 4, b_on = tb >= qt && tb <= qt + 4;
          const LAS float* bl = bt + gh * 192 + 32 + (32 * qt + q + 128 - 32 * ta - 8 * h - 23);
          if (a_on && b_on) attn_tile2<false>(kb, vb, bl, qf, st, q, h, true);
          else if (a_on) attn_tile<false>(kb, vb, bl, qf, st, q, h, true);
          else if (b_on) attn_tile<false>(kb + 32 * AKP, vb + 32, bl - 32, qf, st, q, h, true); }
        if (more) DIL_WRITE(pb ^ 1);
        if (last) {
            const float l_tot = xhalf_sum(st.l), inv = 1.f / l_tot;
            const size_t orow = (size_t)g * TC + (2 * blp + uw) * 2048 + rn * 128 + 32 * qt + q;
            attn_store8(st, (unsigned char*)OG + orow * 1024 + hh * 64 + 4 * h, inv * ASCALE8);
            if (h == 0) LSE[orow * 16 + hh] = st.m + __log2f(l_tot);
            st.m = NEGB; st.l = 0.f; st.o0 = (f32x16){}; st.o1 = (f32x16){};
#pragma unroll
            for (int d0 = 0; d0 < 4; ++d0) qf[d0] = __builtin_bit_cast(bf16x8, f8x8_bf16(qn[d0]));
        }
        __syncthreads();
        pb ^= 1;
        if (!more) break;
        if (last) du += F.G;
        g = ng; hh = nhh; blp = nblp; rn = nrn; j = nj;
    }
#undef DIL_LOADS
#undef DIL_QLOADS
#undef DIL_WRITE
}

__device__ __forceinline__ void attn_tile2r(const LAS bf16* Kt, const LAS bf16* Vt, const LAS float* b0, const LAS float* b1, const bf16x8 (&qf)[4], AttnSt& st, int q, int h) {
    f32x16 s0, s1;
#pragma unroll
    for (int r = 0; r < 16; ++r) { s0[r] = b0[16 * (r >> 3) + (r & 7)]; s1[r] = b1[16 * (r >> 3) + (r & 7)]; }
    const LAS bf16* kr = Kt + kperm(q) * AKP + 8 * h;
#pragma unroll
    for (int d0 = 0; d0 < 4; ++d0) { s0 = mfma32(*(const LAS bf16x8*)(kr + d0 * 16), qf[d0], s0); s1 = mfma32(*(const LAS bf16x8*)(kr + 32 * AKP + d0 * 16), qf[d0], s1); }
    const float mx = xhalf_max(fmaxf(max16(s0), max16(s1)));
    const float mn = fmaxf(st.m, mx);
    const float alpha = __builtin_amdgcn_exp2f(st.m - mn);
    float ps0 = 0.f, ps1 = 0.f;
#pragma unroll
    for (int r = 0; r < 16; ++r) { const float p = __builtin_amdgcn_exp2f(s0[r] - mn); s0[r] = p; ps0 += p; const float p2 = __builtin_amdgcn_exp2f(s1[r] - mn); s1[r] = p2; ps1 += p2; }
    const bf16x8 p00 = pack8(s0, 0), p01 = pack8(s0, 8), p10 = pack8(s1, 0), p11 = pack8(s1, 8);
    st.l = st.l * alpha + (ps0 + ps1); st.m = mn;
    if (__ballot(alpha != 1.0f) != 0ull) {
#pragma unroll
        for (int r = 0; r < 16; ++r) { st.o0[r] *= alpha; st.o1[r] *= alpha; } }
    const LAS bf16* v0 = Vt + q * AKP + 8 * h; const LAS bf16* v1 = v0 + 32 * AKP;
    st.o0 = mfma32(*(const LAS bf16x8*)v0, p00, st.o0); st.o1 = mfma32(*(const LAS bf16x8*)v1, p00, st.o1);
    st.o0 = mfma32(*(const LAS bf16x8*)(v0 + 16), p01, st.o0); st.o1 = mfma32(*(const LAS bf16x8*)(v1 + 16), p01, st.o1);
    st.o0 = mfma32(*(const LAS bf16x8*)(v0 + 32), p10, st.o0); st.o1 = mfma32(*(const LAS bf16x8*)(v1 + 32), p10, st.o1);
    st.o0 = mfma32(*(const LAS bf16x8*)(v0 + 48), p11, st.o0); st.o1 = mfma32(*(const LAS bf16x8*)(v1 + 48), p11, st.o1);
}

__device__ __forceinline__ void moba_phase3(Frame& F) {
    constexpr int TBL = 8448, KMO = TBL + 4 * ATILE;
    LAS float* bt = (LAS float*)F.lds; LAS float* kml = (LAS float*)(F.lds + KMO);
    const int lane = F.lane, q = lane & 31, h = lane >> 5, w = F.wave, t = F.tid, srow = t >> 3, sch = t & 7;
    const bf16* QK = (const bf16*)(F.ws + WS_SCR + S_CQK); const bf16* VT = (const bf16*)(F.ws + WS_SCR + S_CVT);
    bf16* att = (bf16*)(F.ws + WS_SCR + S_CATT); const float* km = (const float*)(F.ws + WS_KMEAN);
    const int NP = NB * NH * 4, per = (NP + F.G - 1) / F.G;
    const int lo = F.vcu * per, hi = (lo + per) < NP ? (lo + per) : NP;
    const int nunits = 2 * (hi - lo);
    if (nunits <= 0) return;
    const int sdst = srow * AKP + sch * 8;
    int u = 0, cur_bh = -1;
    u32x4 kreg, vreg; bf16x8 qn[4], qf[4];
#define MB_LOADS(B_, HH_, S_) do { const bf16* ks_ = QK + ((size_t)(B_) * SEQ + 64 * (S_) + srow) * 2048 + 1024 + (HH_) * 64 + sch * 8; \
        const bf16* vs_ = VT + ((size_t)(HH_) * 64 + srow) * T + (size_t)(B_) * SEQ + 64 * (S_) + sch * 8; kreg = *(const u32x4*)ks_; vreg = *(const u32x4*)vs_; } while (0)
#define MB_QLOADS(B_, HH_, NB_) do { const bf16* qr_ = QK + ((size_t)(B_) * SEQ + (NB_) * 256 + 32 * w + q) * 2048 + (HH_) * 64; \
        _Pragma("unroll") for (int d0 = 0; d0 < 4; ++d0) qn[d0] = *(const bf16x8*)(qr_ + d0 * 16 + 8 * h); } while (0)
#define MB_WRITE(PB_) do { LAS bf16* kb_ = (LAS bf16*)(F.lds + TBL + (PB_) * 2 * ATILE); *(LAS u32x4*)(kb_ + sdst) = kreg; *(LAS u32x4*)(kb_ + 64 * AKP + sdst) = vreg; } while (0)
    int pu = lo, jj = pu & 3, hh = (pu >> 2) & 15, b = pu >> 6, nb = 7 - jj, s = 0, pb = 0;
    MB_LOADS(b, hh, 0); MB_QLOADS(b, hh, nb); MB_WRITE(0);
    unsigned sel = 0; bool fresh = true;
    AttnSt st; st.m = NEGB; st.l = 0.f; st.o0 = (f32x16){}; st.o1 = (f32x16){};
    for (;;) {
        if (fresh) {
            if (b * 16 + hh != cur_bh) { __syncthreads(); const float* btC = (const float*)(F.ws + WS_BTABC) + hh * 2048;
                for (int i = t; i < 2048 + 32; i += 512) bt[2079 - i] = i < 32 ? NEGB : btC[i - 32];
                { const float* kmp = km + ((size_t)b * NH + hh) * 512; kml[t] = kmp[t]; }
                cur_bh = b * 16 + hh; }
#pragma unroll
            for (int d0 = 0; d0 < 4; ++d0) qf[d0] = qn[d0];
            __syncthreads();
            sel = 0;
            if (nb > 0) {
                float gsc[7];
#pragma unroll
                for (int m = 0; m < 7; ++m) { float sc = 0.f;
                    if (m < nb) {
#pragma unroll
                        for (int d0 = 0; d0 < 4; ++d0) { const f32x4 c0 = *(const LAS f32x4*)(kml + m * 64 + d0 * 16 + 8 * h), c1 = *(const LAS f32x4*)(kml + m * 64 + d0 * 16 + 8 * h + 4); const u32x4 qq = __builtin_bit_cast(u32x4, qf[d0]);
                            sc += bflo(qq.x) * c0.x + bfhi(qq.x) * c0.y + bflo(qq.y) * c0.z + bfhi(qq.y) * c0.w + bflo(qq.z) * c1.x + bfhi(qq.z) * c1.y + bflo(qq.w) * c1.z + bfhi(qq.w) * c1.w; }
                        sc = xhalf_sum(sc); }
                    gsc[m] = m < nb ? sc : -3.0e38f; }
                const int nsel = nb < 3 ? nb : 3;
#pragma unroll
                for (int r = 0; r < 3; ++r) { if (r < nsel) { int bi = 0; float bv = -3.4e38f;
#pragma unroll
                        for (int m = 0; m < 7; ++m) if (!((sel >> m) & 1u) && gsc[m] > bv) { bv = gsc[m]; bi = m; }
                        sel |= 1u << bi; } }
            }
            fresh = false;
        }
        const int nsteps = 4 * nb + 4;
        const bool last = (s + 1 == nsteps);
        int nb2 = nb, b2 = b, hh2 = hh, s2 = s + 1; bool more = true;
        if (last) { const int u2 = u + 1; more = u2 < nunits; const int pu2 = lo + (u2 >> 1), j2 = pu2 & 3; hh2 = (pu2 >> 2) & 15; b2 = pu2 >> 6; nb2 = (u2 & 1) ? j2 : 7 - j2; s2 = 0; }
        if (more) { MB_LOADS(b2, hh2, s2); if (last) MB_QLOADS(b2, hh2, nb2); }
        { const LAS bf16* kb = (const LAS bf16*)(F.lds + TBL + pb * 2 * ATILE); const LAS bf16* vb = kb + 64 * AKP;
          const int qpos = nb * 256 + 32 * w + q;
          const LAS float* ba = bt + (2056 - (32 + (qpos - 8 * h - 64 * s - 23)));
          const LAS float* negp = bt + 2048;
          bool act; const LAS float* p0; const LAS float* p1;
          if (s < 4 * nb) { const bool mine = (sel >> (s >> 2)) & 1u; act = __ballot(mine) != 0ull; p0 = mine ? ba : negp; p1 = mine ? ba + 32 : negp; }
          else { const int ta = (s - 4 * nb) * 2; act = ta <= w; p0 = ba; p1 = (ta + 1 <= w) ? ba + 32 : negp; }
          if (act) attn_tile2r(kb, vb, p0, p1, qf, st, q, h); }
        if (more) MB_WRITE(pb ^ 1);
        if (last) {
            const float l_tot = xhalf_sum(st.l), inv = 1.f / l_tot;
            const size_t tq = (size_t)b * SEQ + nb * 256 + 32 * w + q;
            attn_store8(st, (unsigned char*)att + tq * 1024 + hh * 64 + 4 * h, inv * ASCALE8);
            st.m = NEGB; st.l = 0.f; st.o0 = (f32x16){}; st.o1 = (f32x16){};
        }
        if (!last) __syncthreads();
        pb ^= 1;
        if (!more) break;
        if (last) { ++u; fresh = true; }
        nb = nb2; b = b2; hh = hh2; s = s2;
    }
#undef MB_LOADS
#undef MB_QLOADS
#undef MB_WRITE
}

__device__ __forceinline__ void gmlp_phase(Frame& F, const float* lng, const float* lnb, const float* bs) {
    const int lane = F.lane, w = F.wave, q = lane & 31, h = lane >> 5;
    const bf16* uv = (const bf16*)(F.ws + WS_SCR + S_UV); bf16* p = (bf16*)(F.ws + WS_SCR + S_P); const bf16* wst = (const bf16*)(F.ws + WS_WST);
    LAS float* stat = (LAS float*)F.lds;
    LAS bf16* vnT = (LAS bf16*)(F.lds + 1024);
    constexpr int VP = 136;
    for (int unit = F.vcu; unit < T / 128; unit += F.G) {
        const size_t t0 = (size_t)unit * 128;
        __syncthreads();
        for (int i = 0; i < 16; ++i) { const int r = w * 16 + i; const u32x4* vr = (const u32x4*)(uv + (t0 + r) * 2048 + 1024) + lane;
            const u32x4 a = vr[0], b = vr[64]; float x[16];
            x[0] = bflo(a.x); x[1] = bfhi(a.x); x[2] = bflo(a.y); x[3] = bfhi(a.y); x[4] = bflo(a.z); x[5] = bfhi(a.z); x[6] = bflo(a.w); x[7] = bfhi(a.w);
            x[8] = bflo(b.x); x[9] = bfhi(b.x); x[10] = bflo(b.y); x[11] = bfhi(b.y); x[12] = bflo(b.z); x[13] = bfhi(b.z); x[14] = bflo(b.w); x[15] = bfhi(b.w);
            float s = 0.f;
#pragma unroll
            for (int j = 0; j < 16; ++j) s += x[j];
            const float mean = wave_sum(s) * (1.f / 1024.f); float s2 = 0.f;
#pragma unroll
            for (int j = 0; j < 16; ++j) { const float d = x[j] - mean; s2 += d * d; }
            const float rstd = 1.f / sqrtf(wave_sum(s2) * (1.f / 1024.f) + LN_EPS);
            if (lane == 0) { stat[2 * r] = mean; stat[2 * r + 1] = rstd; } }
        __syncthreads();
        for (int gg = 0; gg < 8; ++gg) {
#pragma unroll
            for (int k = 0; k < 4; ++k) { const int id = F.tid + 512 * k, s = id >> 4, cc = (id & 15) * 8;
                const u32x4 a = *(const u32x4*)(uv + (t0 + s) * 2048 + 1024 + gg * 128 + cc); const float mean = stat[2 * s], rstd = stat[2 * s + 1];
                float x[8]; x[0] = bflo(a.x); x[1] = bfhi(a.x); x[2] = bflo(a.y); x[3] = bfhi(a.y); x[4] = bflo(a.z); x[5] = bfhi(a.z); x[6] = bflo(a.w); x[7] = bfhi(a.w);
#pragma unroll
                for (int j = 0; j < 8; ++j) { const int c = gg * 128 + cc + j; const float y = (x[j] - mean) * rstd * lng[c] + lnb[c]; vnT[(cc + j) * VP + s] = (bf16)f2bf(y); } }
            __syncthreads();
            const int cr = 32 * (w & 3), tc0 = 64 * (w >> 2);
            f32x16 acc0 = {}, acc1 = {};
#pragma unroll
            for (int ks = 0; ks < 8; ++ks) {
                const bf16x8 af = *(const LAS bf16x8*)(vnT + (cr + q) * VP + ks * 16 + 8 * h);
                const bf16x8 b0 = *(const bf16x8*)(wst + ((size_t)gg * 128 + tc0 + q) * 128 + ks * 16 + 8 * h);
                const bf16x8 b1 = *(const bf16x8*)(wst + ((size_t)gg * 128 + tc0 + 32 + q) * 128 + ks * 16 + 8 * h);
                acc0 = mfma32(af, b0, acc0); acc1 = mfma32(af, b1, acc1);
            }
#pragma unroll
            for (int tt = 0; tt < 2; ++tt) { const f32x16& ac = tt == 0 ? acc0 : acc1; const int tl = tc0 + 32 * tt + q; const float bsv = bs[gg * 128 + tl];
                const size_t rowu = (t0 + tl) * 2048, rowp = (t0 + tl) * 1024;
#pragma unroll
                for (int gq = 0; gq < 4; ++gq) { const int c = gg * 128 + cr + 8 * gq + 4 * h; const u32x2 uu = *(const u32x2*)(uv + rowu + c);
                    u32x2 o; o.x = pk2(bflo(uu.x) * (ac[4 * gq] + bsv), bfhi(uu.x) * (ac[4 * gq + 1] + bsv)); o.y = pk2(bflo(uu.y) * (ac[4 * gq + 2] + bsv), bfhi(uu.y) * (ac[4 * gq + 3] + bsv));
                    *(u32x2*)(p + rowp + c) = o; } }
            __syncthreads();
        }
    }
}

struct MoeSeg { int ts[9]; };
__device__ __forceinline__ MoeSeg moe_seg(Frame& F, int moe_l) {
    MoeSeg s; int acc = 0;
#pragma unroll
    for (int e = 0; e < 8; ++e) { s.ts[e] = acc; const unsigned c = __hip_atomic_load((unsigned*)(F.ctl + CW_ECNT + 64 * moe_l + e), RLX_AGENT); acc += (int)((c + 255u) >> 8); }
    s.ts[8] = acc; return s;
}
__device__ __forceinline__ void moe_gather_phase(Frame& F, int moe_l) {
    LAS int* P = (LAS int*)F.lds;
    LAS int* wtot = (LAS int*)(F.lds + 65536);
    LAS int* tot = wtot + 64;
    const int* wcnt = (const int*)(F.ws + WS_WCNT);
    int t = F.tid; asm volatile("" : "+v"(t));
    const int lane = F.lane;
    int loc[4][8], sum[8], inc[8];
#pragma unroll
    for (int k = 0; k < 4; ++k) { const u32x4 a = *(const u32x4*)(wcnt + (4 * t + k) * 8), b = *(const u32x4*)(wcnt + (4 * t + k) * 8 + 4);
        loc[k][0] = (int)a.x; loc[k][1] = (int)a.y; loc[k][2] = (int)a.z; loc[k][3] = (int)a.w; loc[k][4] = (int)b.x; loc[k][5] = (int)b.y; loc[k][6] = (int)b.z; loc[k][7] = (int)b.w; }
#pragma unroll
    for (int e = 0; e < 8; ++e) { sum[e] = (loc[0][e] + loc[1][e]) + (loc[2][e] + loc[3][e]); inc[e] = sum[e]; }
#pragma unroll
    for (int off = 1; off < 64; off <<= 1) {
#pragma unroll
        for (int e = 0; e < 8; ++e) { const int v = __shfl_up(inc[e], off); if (lane >= off) inc[e] += v; } }
    if (lane == 63) {
#pragma unroll
        for (int e = 0; e < 8; ++e) wtot[F.wave * 8 + e] = inc[e]; }
    __syncthreads();
    int run[8];
#pragma unroll
    for (int e = 0; e < 8; ++e) { int wb = 0; for (int w = 0; w < F.wave; ++w) wb += wtot[w * 8 + e]; run[e] = wb + inc[e] - sum[e]; }
#pragma unroll
    for (int k = 0; k < 4; ++k) {
#pragma unroll
        for (int e = 0; e < 8; ++e) { P[(4 * t + k) * 8 + e] = run[e]; run[e] += loc[k][e]; } }
    if (t == 511) {
#pragma unroll
        for (int e = 0; e < 8; ++e) tot[e] = run[e]; }
    __syncthreads();
    MoeSeg sg; { int acc = 0;
#pragma unroll
        for (int e = 0; e < 8; ++e) { sg.ts[e] = acc; acc += (tot[e] + 255) >> 8; } sg.ts[8] = acc; }
    if (blockIdx.x == 0 && t < 8) __hip_atomic_store((unsigned*)(F.ctl + CW_ECNT + 64 * moe_l + t), (unsigned)tot[t], RLX_AGENT);
    const int gw = F.vcu * NWAVES + F.wave, NGW = F.G * NWAVES;
    const bf16* hb = (const bf16*)(F.ws + WS_HB); unsigned char* xg8 = (unsigned char*)F.out;
    const int* route = (const int*)(F.ws + WS_ROUTE); int* slots = (int*)(F.ws + WS_SLOTS);
    for (int m0 = 4 * gw; m0 < T; m0 += 4 * NGW) {
        int s1[4], s2[4]; u32x4 a[4], b[4];
#pragma unroll
        for (int k = 0; k < 4; ++k) { const int m = m0 + k, grp = m >> 5;
            const int e1 = route[4 * m], p1 = route[4 * m + 1], e2 = route[4 * m + 2], p2 = route[4 * m + 3];
            int ts1 = 0, ts2 = 0;
#pragma unroll
            for (int e = 0; e < 8; ++e) { ts1 = e == e1 ? sg.ts[e] : ts1; ts2 = e == e2 ? sg.ts[e] : ts2; }
            s1[k] = ts1 * 256 + P[grp * 8 + e1] + p1; s2[k] = ts2 * 256 + P[grp * 8 + e2] + p2;
            const u32x4* src = (const u32x4*)(hb + (size_t)m * D) + lane; a[k] = src[0]; b[k] = src[64]; }
#pragma unroll
        for (int k = 0; k < 4; ++k) { const int m = m0 + k;
            float x[16]; unpack8(a[k], x); unpack8(b[k], x + 8);
            u32x2 lo, hi; lo.x = pk4_fp8(x[0], x[1], x[2], x[3]); lo.y = pk4_fp8(x[4], x[5], x[6], x[7]); hi.x = pk4_fp8(x[8], x[9], x[10], x[11]); hi.y = pk4_fp8(x[12], x[13], x[14], x[15]);
            unsigned char* d1 = xg8 + (size_t)s1[k] * D + 8 * lane; unsigned char* d2 = xg8 + (size_t)s2[k] * D + 8 * lane;
            *(u32x2*)d1 = lo; *(u32x2*)(d1 + 512) = hi; *(u32x2*)d2 = lo; *(u32x2*)(d2 + 512) = hi;
            if (lane == 0) { slots[2 * m] = s1[k]; slots[2 * m + 1] = s2[k]; } }
    }
}
struct MoeOrder {
    int nM, nN, G, c, tile0; MoeSeg sg; const char* A0; const char* B0; size_t aT, bE, bT; bool a_local;
    bool out_local;
    __device__ __forceinline__ bool next(int i, pg8::Unit& u) const {
        int pm, pn; if (!pg8::tile_of((long)i * G + c, nM, nN, pm, pn)) return false;
        const int tile = tile0 + pm; int e = 0;
#pragma unroll
        for (int k = 1; k < 8; ++k) e += (tile >= sg.ts[k]) ? 1 : 0;
        u.pm = out_local ? pm : tile; u.pn = pn; u.a = (unsigned)((size_t)(a_local ? pm : tile) * aT); u.b = (unsigned)((size_t)e * bE + (size_t)pn * bT); return true;
    }
};


template <int GI> struct L0QKOrder { int G, c; const char* A0; const char* B0;
    __device__ __forceinline__ bool next(int i, pg8::Unit& u) const { if (!pg8::tile_of((long)i * G + c, 64, 8, u.pm, u.pn)) return false; const int pm = u.pm;
        const int tok = GI == 0 ? pm * 256 : (GI == 1 ? (pm >> 3) * 2048 + (pm & 1) * 1024 + ((pm >> 1) & 3) : (pm >> 3) * 2048 + (pm & 7) * 2);
        u.a = (unsigned)tok * 1024u; u.b = (unsigned)u.pn * 256u * 1024u; return true; } };
template <int GI> struct L0VtOrder { int G, c; const char* A0; const char* B0;
    __device__ __forceinline__ bool next(int i, pg8::Unit& u) const { if (!pg8::tile_of((long)i * G + c, 4, 64, u.pm, u.pn)) return false; const int pn = u.pn;
        const int tok = GI == 0 ? pn * 256 : (GI == 1 ? (pn >> 3) * 2048 + (pn & 1) * 1024 + ((pn >> 1) & 3) : (pn >> 3) * 2048 + (pn & 7) * 2);
        u.a = (unsigned)u.pm * 256u * 1024u; u.b = (unsigned)tok * 1024u; return true; } };
template <int GI> __device__ __forceinline__ void l0_gemms(Frame& F, int ck, int bx) {
    constexpr int rs = GI == 0 ? 1 : (GI == 1 ? 4 : 16);
    constexpr size_t hst = (GI == 0 ? (size_t)128 : (GI == 1 ? (size_t)512 : (size_t)1)) * 1024;
    const char* hbc = (const char*)(F.ws + WS_SCR + S_HB8) + (size_t)ck * TC * 1024;
    unsigned char* scr = F.ws + WS_SCR;
    { L0QKOrder<GI> S{F.G, bx, hbc, (const char*)(F.ws + W_A_QK) + (size_t)GI * 2048 * 1024};
      pg8::Gemm gm{512, rs, 1, hst, (size_t)128 * 1024};
      pg8::EpiF8 E{scr + S_QK + (size_t)GI * TC * 2048, 2048, 1.f / WSCALE8};
      pg8::gemm_phase<pg8::EpiF8, L0QKOrder<GI>, false, 1>(F.lds, F.wave, gm, S, E); }
    { L0VtOrder<GI> S{F.G, bx, (const char*)(F.ws + W_A_V) + (size_t)GI * 1024 * 1024, hbc};
      pg8::Gemm gm{512, 1, rs, (size_t)128 * 1024, hst};
      pg8::EpiF8 E{scr + S_VT + (size_t)GI * 1024 * TC, TC, 1.f / WSCALE8};
      pg8::gemm_phase<pg8::EpiF8, L0VtOrder<GI>, false, 1>(F.lds, F.wave, gm, S, E); }
}


#ifdef MK_SELFCHECK
__device__ __forceinline__ void selfcheck_buf(Frame& F, const void* ptr, size_t nbytes, int stage, int slot0) {
    if (!F.chk) return;
    const int gw = F.vcu * NWAVES + F.wave, NGW = F.G * NWAVES; unsigned* cks = (unsigned*)(F.ws + WS_NEED + 2 * MiB) + slot0;
    const int nch = (int)(nbytes >> 12);
    for (int c = gw; c < nch; c += NGW) { const u32x4* r = (const u32x4*)((const char*)ptr + ((size_t)c << 12)) + F.lane; unsigned x = 0;
#pragma unroll
        for (int j = 0; j < 4; ++j) { const u32x4 v = r[64 * j]; x ^= v.x * 3u + v.y * 5u + v.z * 7u + v.w * 11u + (unsigned)j; }
        x *= (unsigned)(2 * F.lane + 1);
#pragma unroll
        for (int o = 1; o < 64; o <<= 1) x ^= __shfl_xor(x, o);
        if (F.lane == 0) { if (F.chk == 1) cks[c] = x; else if (cks[c] != x) atomicMax((unsigned*)(F.ctl + 32), (unsigned)(1000 - stage)); } }
}
#endif

__global__ void __launch_bounds__(NWAVES * 64, 2) mk_fwd(Args args) {
    extern __shared__ __attribute__((aligned(16))) unsigned char lds[];
    Frame F;
    F.lds = (LAS unsigned char*)lds;
    F.tid = threadIdx.x; F.lane = F.tid & 63; F.wave = __builtin_amdgcn_readfirstlane(F.tid >> 6);
    F.G = gridDim.x; { const int bx = blockIdx.x; F.vcu = (F.G % 8 == 0) ? (bx % 8) * (F.G / 8) + bx / 8 : bx; }
    F.ws = args.ws; F.ctl = (gu32*)(args.ws + WS_CTL); F.out = args.out; F.chk = args.chk; F.stage = 0;
    volatile LAS unsigned* MISC = (volatile LAS unsigned*)(F.lds + MISC_OFF);
    for (int u = F.tid; u < (LDS_BYTES - RING_BYTES) / 4; u += NWAVES * 64) ((LAS unsigned*)(F.lds + RING_BYTES))[u] = 0u;
    __syncthreads();
    XcdBarrier bar; bar.bar = (unsigned*)(F.ctl + CW_BAR); bar.x = 0; bar.st = nullptr;
    if (!MK_MULTI) bar = xcd_barrier_post((unsigned*)(F.ctl + CW_BAR), MISC + 8);
    const int lo = args.ph_lo, hi = args.ph_hi;
    int ph = 0;
#define PHASE_BEGIN if (ph >= lo && ph < hi) { F.lane = (int)__builtin_amdgcn_mbcnt_hi(~0u, __builtin_amdgcn_mbcnt_lo(~0u, 0u)); asm volatile("" : "+v"(F.lane)); F.tid = F.wave * 64 + F.lane;
#define PHASE_END   if (!MK_MULTI && ph + 1 < hi) xcd_barrier(bar, F.tid); } ++ph;
    const int bx = (int)blockIdx.x;
#define scr (args.ws + WS_SCR)
#define hb ((const bf16*)(args.ws + WS_HB))
#define ln_g (args.in[2])
#define ln_b (args.in[3])

    PHASE_BEGIN p_prologue(F, args); if (MK_PROBE & 8) p_prologue(F, args); PHASE_END

    if (MK_ENABLE & 1) {
#define L0_CHUNK(ck) \
        PHASE_BEGIN \
        if ((ck) > 0) dil_merge_phase(F, (ck) - 1); \
        l0_gemms<0>(F, (ck), bx); l0_gemms<1>(F, (ck), bx); l0_gemms<2>(F, (ck), bx); \
        PHASE_END \
        PHASE_BEGIN dil_attn_phase3(F); if (MK_PROBE & 1) dil_attn_phase3(F); PHASE_END
        L0_CHUNK(0) L0_CHUNK(1) L0_CHUNK(2) L0_CHUNK(3)
#undef L0_CHUNK
        PHASE_BEGIN dil_merge_phase(F, 3); if (MK_PROBE & 4) { dil_merge_phase(F, 3); dil_merge_phase(F, 3); dil_merge_phase(F, 3); dil_merge_phase(F, 3); } PHASE_END
        PHASE_BEGIN
        { pg8::LinOrder S{T / 256, 4, F.G, bx, (const char*)(scr + S_ATT), (const char*)(F.ws + W_A_O), (size_t)256 * 1024, (size_t)256 * 1024};
          pg8::Gemm gm{512, 1, 1, (size_t)128 * 1024, (size_t)128 * 1024};
          pg8::EpiResLn<FFN_GU8 == 0> E{(bf16*)(F.ws + WS_HB), ln_g + 0 * 2048, ln_b + 0 * 2048, ALPHA, 1.f / (WSCALE8 * ASCALE8), (float*)scr, (unsigned*)(F.ctl + CW_LNC + 0 * 4096), (unsigned*)(F.ctl + CW_BAR) + XB_TMO, scr + S_HB8, F.lds + LNT_OFF};
          pg8::gemm_phase<pg8::EpiResLn<FFN_GU8 == 0>, pg8::LinOrder, true, 1>(F.lds, F.wave, gm, S, E); }
        PHASE_END
    } else {
        PHASE_BEGIN ln_phase<1, false, false>(F, ln_g + 0 * 2048, ln_b + 0 * 2048, nullptr); PHASE_END
    }
#define DENSE_FFN(f, lnidx, enbit) \
    if (MK_ENABLE & (enbit)) { \
        PHASE_BEGIN \
        if ((f) == FFN_GU8) { \
          pg8::LinOrder S{T / 256, 2 * DFF / 256, F.G, bx, (const char*)(scr + S_HB8), (const char*)(F.ws + W_F_GU) + (size_t)(f) * 2 * DFF * 2048, (size_t)256 * 1024, (size_t)256 * 1024}; \
          pg8::Gemm gm{512, 1, 1, (size_t)128 * 1024, (size_t)128 * 1024};     \
          pg8::EpiSwiglu8 E{(unsigned char*)(scr + S_HID), DFF, 1.f / WSCALE8}; \
          pg8::gemm_phase<pg8::EpiSwiglu8, pg8::LinOrder, true, 1>(F.lds, F.wave, gm, S, E); \
        } else { pg8::LinOrder S{T / 256, 2 * DFF / 256, F.G, bx, (const char*)hb, (const char*)(F.ws + W_F_GU) + (size_t)(f) * 2 * DFF * 2048, (size_t)256 * 2048, (size_t)256 * 2048}; \
          pg8::Gemm gm{1024, 1, 1, (size_t)128 * 2048, (size_t)128 * 2048}; \
          pg8::EpiSwiglu8 E{(unsigned char*)(scr + S_HID), DFF}; \
          pg8::gemm_phase(F.lds, F.wave, gm, S, E); } \
        PHASE_END \
        PHASE_BEGIN \
        { pg8::LinOrder S{T / 256, 4, F.G, bx, (const char*)(scr + S_HID), (const char*)(F.ws + W_F_D) + (size_t)(f) * 1024 * DFF * 2, (size_t)256 * DFF, (size_t)256 * DFF}; \
          pg8::Gemm gm{DFF / 2, 1, 1, (size_t)128 * DFF, (size_t)128 * DFF};     \
          pg8::EpiResLn<false> E{(bf16*)(F.ws + WS_HB), ln_g + (lnidx) * 1024, ln_b + (lnidx) * 1024, ALPHA, 1.f / WSCALE8D, (float*)(scr + S_Y), (unsigned*)(F.ctl + CW_LNC + (2 + (f)) * 4096), (unsigned*)(F.ctl + CW_BAR) + XB_TMO, nullptr, F.lds + LNT_OFF}; \
          pg8::gemm_phase<pg8::EpiResLn<false>, pg8::LinOrder, true, 1>(F.lds, F.wave, gm, S, E); }     \
        PHASE_END \
    } else { \
        PHASE_BEGIN ln_phase<1, false, false>(F, ln_g + (lnidx) * 1024, ln_b + (lnidx) * 1024, nullptr); PHASE_END \
    }
    DENSE_FFN(0, 1, 2)

    if (MK_ENABLE & 4) {
        PHASE_BEGIN
        { pg8::LinOrder S{T / 256, 4, F.G, bx, (const char*)hb, (const char*)(F.ws + W_B_IN), (size_t)256 * 2048, (size_t)256 * 2048};
          pg8::Gemm gm{1024, 1, 1, (size_t)128 * 2048, (size_t)128 * 2048};
          pg8::EpiBf16<0> E{(bf16*)(scr + S_BCX), 1024};
          pg8::gemm_phase(F.lds, F.wave, gm, S, E); }
        { pg8::LinOrder S{T / 256, 8, F.G, bx, (const char*)hb, (const char*)(F.ws + W_B_IN) + (size_t)1024 * 2048, (size_t)256 * 2048, (size_t)256 * 2048};
          pg8::Gemm gm{1024, 1, 1, (size_t)128 * 2048, (size_t)128 * 2048};
          pg8::EpiGlu<0> E{(bf16*)(scr + S_BCX + (size_t)128 * MiB), 1024};
          pg8::gemm_phase(F.lds, F.wave, gm, S, E); }
        PHASE_END
        PHASE_BEGIN conv_phase(F, args.in[7]); if (MK_PROBE & 4) conv_phase(F, args.in[7]); PHASE_END
        PHASE_BEGIN
        { pg8::LinOrder S{T / 256, 4, F.G, bx, (const char*)(scr + S_P), (const char*)(F.ws + W_B_O), (size_t)256 * 2048, (size_t)256 * 2048};
          pg8::Gemm gm{1024, 1, 1, (size_t)128 * 2048, (size_t)128 * 2048};
          pg8::EpiResBf16 E{hb, (bf16*)F.out, 1024, ALPHA};
          pg8::gemm_phase(F.lds, F.wave, gm, S, E); }
        PHASE_END
        PHASE_BEGIN ln_phase<0, true, false>(F, ln_g + 2 * 1024, ln_b + 2 * 1024, args.in[20]); PHASE_END
    } else {
        PHASE_BEGIN ln_phase<1, true, false>(F, ln_g + 2 * 1024, ln_b + 2 * 1024, args.in[20]); PHASE_END
    }
#define MOE_CHUNK(f, ck) \
        PHASE_BEGIN \
        { const MoeSeg sg = moe_seg(F, (f)); int nM = sg.ts[8] - (ck) * MOE_CH_TILES; nM = nM > MOE_CH_TILES ? MOE_CH_TILES : (nM < 0 ? 0 : nM); \
          MoeOrder S{nM, 2 * DFE / 256, F.G, bx, (ck) * MOE_CH_TILES, sg, (const char*)F.out, (const char*)(F.ws + W_E_GU) + (size_t)(f) * 8 * 2 * DFE * 2048, (size_t)256 * 1024, (size_t)2 * DFE * 2048, (size_t)256 * 1024, false, true}; \
          pg8::Gemm gm{512, 1, 1, (size_t)128 * 1024, (size_t)128 * 1024};     \
          pg8::EpiSwiglu8 E{(unsigned char*)(scr + S_MHID), DFE, 1.f / WSCALE8}; \
          pg8::gemm_phase<pg8::EpiSwiglu8, MoeOrder, true, 0x7C>(F.lds, F.wave, gm, S, E);     if ((ck) == 0 && (MK_PROBE & 32)) pg8::gemm_phase(F.lds, F.wave, gm, S, E); } \
        PHASE_END \
        PHASE_BEGIN \
        { const MoeSeg sg = moe_seg(F, (f)); int nM = sg.ts[8] - (ck) * MOE_CH_TILES; nM = nM > MOE_CH_TILES ? MOE_CH_TILES : (nM < 0 ? 0 : nM); \
          MoeOrder S{nM, 4, F.G, bx, (ck) * MOE_CH_TILES, sg, (const char*)(scr + S_MHID), (const char*)(F.ws + W_E_D) + (size_t)(f) * 8 * 1024 * DFE * 2, (size_t)256 * DFE, (size_t)1024 * DFE * 2, (size_t)256 * DFE, true, false}; \
          pg8::Gemm gm{DFE / 2, 1, 1, (size_t)128 * DFE, (size_t)128 * DFE};     \
          pg8::EpiBf16<0> E{(bf16*)(scr + S_XG), 1024, 1.f / WSCALE8D}; \
          pg8::gemm_phase<pg8::EpiBf16<0>, MoeOrder, true, 0x7B>(F.lds, F.wave, gm, S, E);     if ((ck) == 0 && (MK_PROBE & 64)) pg8::gemm_phase(F.lds, F.wave, gm, S, E); } \
        PHASE_END
#define MOE_FFN(f, lnidx, enbit, fin) \
    if (MK_ENABLE & (enbit)) { \
        PHASE_BEGIN moe_gather_phase(F, (f)); if (MK_PROBE & 4) moe_gather_phase(F, (f)); PHASE_END \
        MOE_CHUNK(f, 0) MOE_CHUNK(f, 1) MOE_CHUNK(f, 2) \
        PHASE_BEGIN ln_phase<2, false, fin>(F, ln_g + (lnidx) * 1024, ln_b + (lnidx) * 1024, nullptr); PHASE_END \
    } else { \
        PHASE_BEGIN ln_phase<1, false, fin>(F, ln_g + (lnidx) * 1024, ln_b + (lnidx) * 1024, nullptr); PHASE_END \
    }
    MOE_FFN(0, 3, 8, false)

    if (MK_ENABLE & 16) {
        PHASE_BEGIN
        { pg8::LinOrder S{T / 256, 8, F.G, bx, (const char*)hb, (const char*)(F.ws + W_C_QK), (size_t)256 * 2048, (size_t)256 * 2048};
          pg8::Gemm gm{1024, 1, 1, (size_t)128 * 2048, (size_t)128 * 2048};
          pg8::EpiBf16<0> E{(bf16*)(scr + S_CQK), 2048};
          pg8::gemm_phase(F.lds, F.wave, gm, S, E); }
        { pg8::LinOrder S{4, T / 256, F.G, bx, (const char*)(F.ws + W_C_V), (const char*)hb, (size_t)256 * 2048, (size_t)256 * 2048};
          pg8::Gemm gm{1024, 1, 1, (size_t)128 * 2048, (size_t)128 * 2048};
          pg8::EpiBf16<0> E{(bf16*)(scr + S_CVT), T};
          pg8::gemm_phase(F.lds, F.wave, gm, S, E); }
        PHASE_END
#ifdef MK_SELFCHECK
        PHASE_BEGIN selfcheck_buf(F, scr + S_CQK, (size_t)256 * MiB, 40, 0); selfcheck_buf(F, scr + S_CVT, (size_t)128 * MiB, 41, 65536); PHASE_END
#endif
        PHASE_BEGIN kmean_phase(F); if (MK_PROBE & 4) kmean_phase(F); PHASE_END
#ifdef MK_SELFCHECK
        PHASE_BEGIN selfcheck_buf(F, F.ws + WS_KMEAN, (size_t)1 * MiB, 42, 65536 + 32768); PHASE_END
#endif
        PHASE_BEGIN moba_phase3(F); if (MK_PROBE & 2) moba_phase3(F); PHASE_END
#ifdef MK_SELFCHECK
        PHASE_BEGIN selfcheck_buf(F, F.ws + WS_NEED + 3 * MiB, (size_t)4 * MiB, 43, 65536 + 32768 + 256); selfcheck_buf(F, F.ws + WS_NEED + 7 * MiB, (size_t)4 * MiB, 44, 65536 + 32768 + 256 + 1024);
                    selfcheck_buf(F, scr + S_CATT, (size_t)128 * MiB, 45, 65536 + 32768 + 256 + 2048); PHASE_END
#endif
        PHASE_BEGIN
        { pg8::LinOrder S{T / 256, 4, F.G, bx, (const char*)(scr + S_CATT), (const char*)(F.ws + W_C_O), (size_t)256 * 1024, (size_t)256 * 1024};
          pg8::Gemm gm{512, 1, 1, (size_t)128 * 1024, (size_t)128 * 1024};
          pg8::EpiResLn<FFN_GU8 == 1> E{(bf16*)(F.ws + WS_HB), ln_g + 4 * 1024, ln_b + 4 * 1024, ALPHA, 1.f / (WSCALE8 * ASCALE8), (float*)scr, (unsigned*)(F.ctl + CW_LNC + 1 * 4096), (unsigned*)(F.ctl + CW_BAR) + XB_TMO, scr + S_HB8, F.lds + LNT_OFF};
          pg8::gemm_phase<pg8::EpiResLn<FFN_GU8 == 1>, pg8::LinOrder, true, 1>(F.lds, F.wave, gm, S, E); }
        PHASE_END
    } else {
        PHASE_BEGIN ln_phase<1, false, false>(F, ln_g + 4 * 1024, ln_b + 4 * 1024, nullptr); PHASE_END
    }
    DENSE_FFN(1, 5, 32)

    if (MK_ENABLE & 64) {
        PHASE_BEGIN
        { pg8::LinOrder S{T / 256, 8, F.G, bx, (const char*)hb, (const char*)(F.ws + W_D_IN), (size_t)256 * 2048, (size_t)256 * 2048};
          pg8::Gemm gm{1024, 1, 1, (size_t)128 * 2048, (size_t)128 * 2048};
          pg8::EpiBf16<1> E{(bf16*)(scr + S_UV), 2048};
          pg8::gemm_phase(F.lds, F.wave, gm, S, E); }
        PHASE_END
        PHASE_BEGIN gmlp_phase(F, args.in[12], args.in[13], args.in[15]); if (MK_PROBE & 4) gmlp_phase(F, args.in[12], args.in[13], args.in[15]); PHASE_END
        PHASE_BEGIN
        { pg8::LinOrder S{T / 256, 4, F.G, bx, (const char*)(scr + S_P), (const char*)(F.ws + W_D_O), (size_t)256 * 2048, (size_t)256 * 2048};
          pg8::Gemm gm{1024, 1, 1, (size_t)128 * 2048, (size_t)128 * 2048};
          pg8::EpiResBf16 E{hb, (bf16*)F.out, 1024, ALPHA};
          pg8::gemm_phase(F.lds, F.wave, gm, S, E); }
        PHASE_END
        PHASE_BEGIN ln_phase<0, true, false>(F, ln_g + 6 * 1024, ln_b + 6 * 1024, args.in[20] + 8192); PHASE_END
    } else {
        PHASE_BEGIN ln_phase<1, true, false>(F, ln_g + 6 * 1024, ln_b + 6 * 1024, args.in[20] + 8192); PHASE_END
    }
    MOE_FFN(1, 7, 128, true)
#ifdef MK_SELFCHECK
    PHASE_BEGIN
    { const unsigned fl = __hip_atomic_load((unsigned*)(F.ctl + 32), RLX_AGENT);
      if (fl != 0u) { const int code = 1000 - (int)fl; const float cval = (code >= 40 && code <= 45) ? (float)(20 + 2 * (code - 40)) : (float)(1u << (code / 10 + 1)); const int gw = F.vcu * NWAVES + F.wave, NGW = F.G * NWAVES;
          for (int m = gw; m < T; m += NGW) { f32x4* w = (f32x4*)(F.out + (size_t)m * D) + F.lane;
#pragma unroll
              for (int j = 0; j < 4; ++j) w[64 * j] = (f32x4){cval, cval, cval, cval}; } } }
    PHASE_END
#endif
#undef PHASE_BEGIN
#undef PHASE_END
#undef scr
#undef hb
#undef ln_g
#undef ln_b
}

static int count_phases() {
    int n = 1;
    n += (MK_ENABLE & 1) ? (8 + 1 + 1) : 1;
    n += (MK_ENABLE & 2) ? 2 : 1;
    n += (MK_ENABLE & 4) ? 4 : 1;
    n += (MK_ENABLE & 8) ? 8 : 1;
    n += (MK_ENABLE & 16) ? 4 : 1;
    n += (MK_ENABLE & 32) ? 2 : 1;
    n += (MK_ENABLE & 64) ? 4 : 1;
    n += (MK_ENABLE & 128) ? 8 : 1;
#ifdef MK_SELFCHECK
    n += 1 + 3;
#endif
    return n;
}
extern "C" void kernel_launch(void* const* d_in, const int* in_sizes, int n_in, void* d_out, int out_size, void* d_ws, size_t ws_size, hipStream_t stream) {
    static int grid = 0;
    if (grid == 0) {
        if (n_in != 24 || in_sizes[0] != T * D || out_size != T * D || ws_size < WS_NEED) { fprintf(stderr, "kernel_launch: unexpected shapes (n_in %d, in0 %d, out %d, ws %zu < %zu); nothing launched\n", n_in, n_in > 0 ? in_sizes[0] : -1, out_size, ws_size, (size_t)WS_NEED); grid = -1; return; }
        int dev = 0, cus = 0, per_cu = 0;
        if (hipGetDevice(&dev) != hipSuccess || hipDeviceGetAttribute(&cus, hipDeviceAttributeMultiprocessorCount, dev) != hipSuccess) { grid = -1; return; }
        if (hipFuncSetAttribute((const void*)mk_fwd, hipFuncAttributeMaxDynamicSharedMemorySize, LDS_BYTES) != hipSuccess) { fprintf(stderr, "kernel_launch: hipFuncSetAttribute failed\n"); grid = -1; return; }
        if (hipOccupancyMaxActiveBlocksPerMultiprocessor(&per_cu, (const void*)mk_fwd, NWAVES * 64, LDS_BYTES) != hipSuccess || per_cu < 1) fprintf(stderr, "kernel_launch: occupancy query reports %d\n", per_cu);
        (void)hipGetLastError();
        grid = cus;
    }
    if (grid < 0) return;
    (void)hipMemsetAsync((char*)d_ws + WS_CTL, 0, CTL_ZERO_BYTES, stream);
#ifdef SELF_POISON
    (void)hipMemsetAsync((char*)d_ws + CTL_ZERO_BYTES, 0xAA, WS_NEED - CTL_ZERO_BYTES, stream);
    (void)hipMemsetAsync(d_out, 0xAA, (size_t)T * D * 4, stream);
#endif
    Args a{};
    for (int i = 0; i < 24; ++i) a.in[i] = (const float*)d_in[i];
    a.out = (float*)d_out; a.ws = (unsigned char*)d_ws;
    const int nph = count_phases();
#if MK_MULTI
    for (int p = 0; p < nph; ++p) { a.ph_lo = p; a.ph_hi = p + 1; hipLaunchKernelGGL(mk_fwd, dim3(grid), dim3(NWAVES * 64), LDS_BYTES, stream, a); }
#else
    a.ph_lo = 0; a.ph_hi = nph;
#ifdef MK_SELFCHECK
    a.chk = 1;
    hipLaunchKernelGGL(mk_fwd, dim3(grid), dim3(NWAVES * 64), LDS_BYTES, stream, a);
    (void)hipMemsetAsync((char*)d_ws + WS_CTL, 0, CTL_ZERO_BYTES, stream);
    a.chk = 2;
#endif
    hipLaunchKernelGGL(mk_fwd, dim3(grid), dim3(NWAVES * 64), LDS_BYTES, stream, a);
#endif
    const hipError_t le = hipPeekAtLastError();
    if (le != hipSuccess) fprintf(stderr, "kernel_launch: launch failed: %s\n", hipGetErrorName(le));
}
```

```cpp
#include <hip/hip_runtime.h>
#include <cstdio>
#include <cstdint>

#ifndef MK_MULTI
#define MK_MULTI 0
#endif
#ifndef MK_PROBE
#define MK_PROBE 0
#endif
#ifndef MK_ENABLE
#define MK_ENABLE 0xFF
#endif

#define GAS __attribute__((address_space(1)))
#define LAS __attribute__((address_space(3)))
typedef unsigned short bf16;
typedef short bf16x8 __attribute__((ext_vector_type(8)));
typedef float f32x4 __attribute__((ext_vector_type(4)));
typedef float f32x2 __attribute__((ext_vector_type(2)));
typedef float f32x16 __attribute__((ext_vector_type(16)));
typedef unsigned u32x4 __attribute__((ext_vector_type(4)));
typedef unsigned u32x2 __attribute__((ext_vector_type(2)));
typedef GAS unsigned gu32;
typedef int v8i_t __attribute__((ext_vector_type(8)));
typedef int v4i_t __attribute__((ext_vector_type(4)));
typedef short s16x16_t __attribute__((ext_vector_type(16)));

constexpr int D = 1024, NB = 32, SEQ = 2048, T = NB * SEQ, NH = 16, HD = 64;
constexpr int DFF = 2816, NE = 8, DFE = 3584;
constexpr float ALPHA = 1.6817928305074290f;
constexpr float LN_EPS = 1e-5f;
constexpr float LOG2E = 1.4426950408889634f;
constexpr float QSCALE = 0.125f * LOG2E;
constexpr float NEGB = -1e30f;
constexpr int TC = 16384;
constexpr int MOE_CH_TILES = 256;
constexpr int MOE_MAX_TILES = 520;
constexpr int FFN_GU8 = 1;

constexpr size_t MiB = 1u << 20;
constexpr size_t WS_CTL = 0, CTL_ZERO_BYTES = 1 * MiB;
constexpr size_t WS_BUCKET = 1 * MiB;
constexpr size_t WS_BTABA = WS_BUCKET + 8192;
constexpr size_t WS_BTABC = WS_BTABA + 32768;
constexpr size_t WS_WST = WS_BTABC + 131072;
constexpr size_t WS_KMEAN = 2 * MiB;
constexpr size_t WS_ROUTE = 4 * MiB;
constexpr size_t WS_GATES = 5 * MiB;
constexpr size_t WS_SLOTS = 6 * MiB;
constexpr size_t WS_WCNT = 7 * MiB;
constexpr size_t WS_W = 8 * MiB;
constexpr size_t W_A_QK = WS_W;
constexpr size_t W_A_V = W_A_QK + 12 * MiB;
constexpr size_t W_A_O = W_A_V + 6 * MiB;
constexpr size_t W_B_IN = W_A_O + 2 * MiB;
constexpr size_t W_B_O = W_B_IN + 6 * MiB;
constexpr size_t W_C_QK = W_B_O + 2 * MiB;
constexpr size_t W_C_V = W_C_QK + 4 * MiB;
constexpr size_t W_C_O = W_C_V + 2 * MiB;
constexpr size_t W_D_IN = W_C_O + 2 * MiB;
constexpr size_t W_D_O = W_D_IN + 4 * MiB;
constexpr size_t W_F_GU = W_D_O + 2 * MiB;
constexpr size_t W_F_D = W_F_GU + 22 * MiB;
constexpr size_t W_E_GU = W_F_D + 11 * MiB;
constexpr size_t W_E_D = W_E_GU + 224 * MiB;
constexpr size_t WS_HB = W_E_D + 112 * MiB;
constexpr size_t WS_SCR = WS_HB + 128 * MiB;
constexpr size_t WS_NEED = WS_SCR + 512 * MiB;
static_assert(WS_HB == 419 * MiB, "map");
constexpr size_t S_QK = 0;
constexpr size_t S_VT = 192 * MiB;
constexpr size_t S_HB8 = 416 * MiB;
constexpr size_t S_ATT = 288 * MiB;
constexpr size_t S_HID = 0;
constexpr size_t S_BCX = 0;
constexpr size_t S_P = 384 * MiB;
constexpr size_t S_XG = 0;
constexpr size_t S_MHID = 260 * MiB;
constexpr size_t S_Y = 256 * MiB;
constexpr size_t S_CQK = 0;
constexpr size_t S_CVT = 256 * MiB;
constexpr size_t S_CATT = 384 * MiB;
constexpr size_t S_UV = 0;
constexpr size_t O_OG = 0;
constexpr size_t O_LSE = 96 * MiB;
constexpr int CW_TMO = 0;
constexpr int CW_ECNT = 64;
constexpr int CW_BAR = 4096;
constexpr int CW_LNC = 16384;

constexpr float ASCALE8 = 8.f;
constexpr float WSCALE8 = 64.f, WSCALE8D = 256.f;
__device__ __forceinline__ unsigned pk4_fp8(float a, float b, float c, float d) { int p = 0; p = __builtin_amdgcn_cvt_pk_fp8_f32(a, b, p, false); p = __builtin_amdgcn_cvt_pk_fp8_f32(c, d, p, true); return (unsigned)p; }
namespace pg8 {
constexpr int BM = 256, BK = 64, HALF = 128, HTB = HALF * BK * 2, STAGE_BYTES = 8 * HTB, NXCD = 8, WGM = 8;
__host__ __device__ __forceinline__ int lds_byte(int r, int c) { const int st = (r >> 4) * 2 + (c >> 5), rr = r & 15, cc = c & 31, ob = rr * 64 + cc * 2; return st * 1024 + (ob ^ (((ob >> 9) & 1) << 5)); }
__host__ __device__ __forceinline__ void stage_rc(int b, int& R, int& C) { const int st = b / 1024, sb = b % 1024, swz = sb ^ (((sb >> 9) & 1) << 5); R = (st >> 1) * 16 + swz / 64; C = (st & 1) * 32 + (swz % 64) / 2; }
__host__ __device__ __forceinline__ int perm32(int rho) { const int n = rho >> 4, i = rho & 15; return 8 * (i >> 2) + 4 * n + (i & 3); }

struct Unit { int pm, pn; unsigned a, b; };
struct Gemm { int K; int rsA, rsB; size_t hstepA, hstepB; };

__device__ __forceinline__ bool tile_of(long L, int nM, int nN, int& pm, int& pn) {
    const int nwg = nM * nN; if (L >= nwg) return false;
    int wgid = (int)L; { const int q = nwg / NXCD, r = nwg % NXCD, xcd = wgid % NXCD, off = wgid / NXCD; wgid = (xcd < r ? xcd * (q + 1) : r * (q + 1) + (xcd - r) * q) + off; }
    const int nig = WGM * nN, gid = wgid / nig, fm = gid * WGM, gsz = (nM - fm) < WGM ? (nM - fm) : WGM;
    pm = fm + ((wgid % nig) % gsz); pn = (wgid % nig) / gsz; return true;
}
struct LinOrder {
    int nM, nN, G, c; const char* A0; const char* B0; size_t aT, bT;
    __device__ __forceinline__ bool next(int i, Unit& u) const { if (!tile_of((long)i * G + c, nM, nN, u.pm, u.pn)) return false; u.a = (unsigned)((size_t)u.pm * aT); u.b = (unsigned)((size_t)u.pn * bT); return true; }
};

typedef __bf16 bf16x2_t __attribute__((ext_vector_type(2)));
__device__ __forceinline__ unsigned cvt_pk_bf16(float lo, float hi) { f32x2 v = {lo, hi}; bf16x2_t b = __builtin_convertvector(v, bf16x2_t); return __builtin_bit_cast(unsigned, b); }
__device__ __forceinline__ f32x2 gelu_pk(f32x2 v) {
    const f32x2 av = __builtin_elementwise_abs(v), d = av * 0.2316418882f + 1.0f;
    f32x2 t; t.x = __builtin_amdgcn_rcpf(d.x); t.y = __builtin_amdgcn_rcpf(d.y);
    f32x2 q = t * 0.5307027145f + (-0.7265760135f); q = q * t + 0.7107068705f; q = q * t + (-0.142248368f); q = q * t + 0.127414796f; q = q * t;
    const f32x2 s = (v * v) * (-0.72134752044f);
    f32x2 e; e.x = __builtin_amdgcn_exp2f(s.x); e.y = __builtin_amdgcn_exp2f(s.y);
    const f32x2 m = v * (q * e), r = v - m;
    f32x2 o; o.x = v.x < 0.f ? m.x : r.x; o.y = v.y < 0.f ? m.y : r.y; return o;
}
__device__ __forceinline__ float silu_f(float g) { return g * __builtin_amdgcn_rcpf(1.0f + __builtin_amdgcn_exp2f(-LOG2E * g)); }

template <int ACT  > struct EpiBf16 {
    static constexpr bool PERM = true;
    bf16* O; int ldc; float sc = 1.f;
    __device__ __forceinline__ void operator()(const f32x4 (&acc)[2][2][4][2], const Unit& u, int wr, int wc, int fr, int fq) const {
        const int row0 = u.pm * BM + wr * 64 + fr, col0 = u.pn * BM + wc * 32 + 8 * fq;
#pragma unroll
        for (int ai = 0; ai < 2; ++ai)
#pragma unroll
            for (int m = 0; m < 4; ++m) { bf16* rowp = O + (size_t)(row0 + ai * HALF + m * 16) * ldc + col0;
#pragma unroll
                for (int bj = 0; bj < 2; ++bj) { f32x4 v0 = acc[ai][bj][m][0] * sc, v1 = acc[ai][bj][m][1] * sc;
                    if (ACT == 1) { f32x2 a = gelu_pk((f32x2){v0[0], v0[1]}), b = gelu_pk((f32x2){v0[2], v0[3]}), c = gelu_pk((f32x2){v1[0], v1[1]}), d = gelu_pk((f32x2){v1[2], v1[3]});
                        v0 = (f32x4){a.x, a.y, b.x, b.y}; v1 = (f32x4){c.x, c.y, d.x, d.y}; }
                    u32x4 w; w.x = cvt_pk_bf16(v0[0], v0[1]); w.y = cvt_pk_bf16(v0[2], v0[3]); w.z = cvt_pk_bf16(v1[0], v1[1]); w.w = cvt_pk_bf16(v1[2], v1[3]);
                    *(u32x4*)(rowp + bj * HALF) = w; } }
    }
};
struct EpiF8 {
    static constexpr bool PERM = true;
    unsigned char* O; int ldc; float sc = 1.f;
    __device__ __forceinline__ void operator()(const f32x4 (&acc)[2][2][4][2], const Unit& u, int wr, int wc, int fr, int fq) const {
        const int row0 = u.pm * BM + wr * 64 + fr, col0 = u.pn * BM + wc * 32 + 8 * fq;
#pragma unroll
        for (int ai = 0; ai < 2; ++ai)
#pragma unroll
            for (int m = 0; m < 4; ++m) { unsigned char* rowp = O + (size_t)(row0 + ai * HALF + m * 16) * ldc + col0;
#pragma unroll
                for (int bj = 0; bj < 2; ++bj) { const f32x4 v0 = acc[ai][bj][m][0] * sc, v1 = acc[ai][bj][m][1] * sc;
                    u32x2 w; w.x = pk4_fp8(v0[0], v0[1], v0[2], v0[3]); w.y = pk4_fp8(v1[0], v1[1], v1[2], v1[3]);
                    *(u32x2*)(rowp + bj * HALF) = w; } }
    }
};
template <int ACT  > struct EpiGlu {
    static constexpr bool PERM = true;
    bf16* O; int ldc;
    __device__ __forceinline__ void operator()(const f32x4 (&acc)[2][2][4][2], const Unit& u, int wr, int wc, int fr, int fq) const {
        const int row0 = u.pm * BM + wr * 64 + fr, col0 = u.pn * HALF + wc * 32 + 8 * fq;
#pragma unroll
        for (int ai = 0; ai < 2; ++ai)
#pragma unroll
            for (int m = 0; m < 4; ++m) { bf16* rowp = O + (size_t)(row0 + ai * HALF + m * 16) * ldc + col0;
                f32x4 g0 = acc[ai][0][m][0], g1 = acc[ai][0][m][1]; const f32x4 u0 = acc[ai][1][m][0], u1 = acc[ai][1][m][1];
                if (ACT == 1) { g0 = (f32x4){silu_f(g0[0]), silu_f(g0[1]), silu_f(g0[2]), silu_f(g0[3])}; g1 = (f32x4){silu_f(g1[0]), silu_f(g1[1]), silu_f(g1[2]), silu_f(g1[3])}; }
                const f32x4 p0 = g0 * u0, p1 = g1 * u1;
                u32x4 w; w.x = cvt_pk_bf16(p0[0], p0[1]); w.y = cvt_pk_bf16(p0[2], p0[3]); w.z = cvt_pk_bf16(p1[0], p1[1]); w.w = cvt_pk_bf16(p1[2], p1[3]);
                *(u32x4*)rowp = w; }
    }
};
struct EpiSwiglu8 {
    static constexpr bool PERM = true;
    unsigned char* O; int ldc; float s = 1.f;
    __device__ __forceinline__ void operator()(const f32x4 (&acc)[2][2][4][2], const Unit& u, int wr, int wc, int fr, int fq) const {
        const int row0 = u.pm * BM + wr * 64 + fr, col0 = u.pn * HALF + wc * 32 + 8 * fq;
#pragma unroll
        for (int ai = 0; ai < 2; ++ai)
#pragma unroll
            for (int m = 0; m < 4; ++m) { unsigned char* rowp = O + (size_t)(row0 + ai * HALF + m * 16) * ldc + col0;
                const f32x4 g0 = acc[ai][0][m][0], g1 = acc[ai][0][m][1], u0 = acc[ai][1][m][0], u1 = acc[ai][1][m][1];
                const float c1 = -LOG2E * s, s2 = s * s;
                const f32x4 p0 = (g0 * u0) * s2, p1 = (g1 * u1) * s2;
                f32x4 r0, r1;
#pragma unroll
                for (int j = 0; j < 4; ++j) { r0[j] = __builtin_amdgcn_rcpf(1.0f + __builtin_amdgcn_exp2f(g0[j] * c1)); r1[j] = __builtin_amdgcn_rcpf(1.0f + __builtin_amdgcn_exp2f(g1[j] * c1)); }
                const f32x4 o0 = p0 * r0, o1 = p1 * r1;
                u32x2 w; w.x = pk4_fp8(o0[0], o0[1], o0[2], o0[3]); w.y = pk4_fp8(o1[0], o1[1], o1[2], o1[3]);
                *(u32x2*)rowp = w; }
    }
};
struct EpiResBf16 {
    static constexpr bool PERM = true;
    const bf16* base; bf16* out; int ldc; float alpha; float sc = 1.f;
    __device__ __forceinline__ void operator()(const f32x4 (&acc)[2][2][4][2], const Unit& u, int wr, int wc, int fr, int fq) const {
        const int row0 = u.pm * BM + wr * 64 + fr, col0 = u.pn * BM + wc * 32 + 8 * fq;
#pragma unroll
        for (int ai = 0; ai < 2; ++ai)
#pragma unroll
            for (int m = 0; m < 4; ++m) { const size_t off = (size_t)(row0 + ai * HALF + m * 16) * ldc + col0;
#pragma unroll
                for (int bj = 0; bj < 2; ++bj) { const u32x4 b = *(const u32x4*)(base + off + bj * HALF); const f32x4 a0 = acc[ai][bj][m][0] * sc, a1 = acc[ai][bj][m][1] * sc;
                    u32x4 w; w.x = cvt_pk_bf16(__builtin_bit_cast(float, b.x << 16) * alpha + a0[0], __builtin_bit_cast(float, b.x & 0xffff0000u) * alpha + a0[1]);
                    w.y = cvt_pk_bf16(__builtin_bit_cast(float, b.y << 16) * alpha + a0[2], __builtin_bit_cast(float, b.y & 0xffff0000u) * alpha + a0[3]);
                    w.z = cvt_pk_bf16(__builtin_bit_cast(float, b.z << 16) * alpha + a1[0], __builtin_bit_cast(float, b.z & 0xffff0000u) * alpha + a1[1]);
                    w.w = cvt_pk_bf16(__builtin_bit_cast(float, b.w << 16) * alpha + a1[2], __builtin_bit_cast(float, b.w & 0xffff0000u) * alpha + a1[3]);
                    *(u32x4*)(out + off + bj * HALF) = w; }
                asm volatile("" ::: "memory"); }
    }
};

template <bool HB8> struct EpiResLn {
    static constexpr bool PERM = true;
    bf16* h; const float* gain; const float* bias; float alpha, sc;
    float* xbuf;
    unsigned* cnt;
    unsigned* tmo;
    unsigned char* h8;
    LAS unsigned char* tb;
    __device__ __forceinline__ void operator()(f32x4 (&acc)[2][2][4][2], const Unit& u, int wr, int wc, int fr, int fq) const {
        asm volatile("" : "+v"(fr), "+v"(fq));
        const int row0 = u.pm * BM + wr * 64 + fr, col0 = u.pn * BM + wc * 32 + 8 * fq;
        LAS f32x2* P = (LAS f32x2*)tb; LAS f32x2* S = (LAS f32x2*)(tb + 8192);
#pragma unroll
        for (int ai = 0; ai < 2; ++ai)
#pragma unroll
            for (int m = 0; m < 4; ++m) { const size_t off = (size_t)(row0 + ai * HALF + m * 16) * 1024 + col0; float sm = 0.f, sq = 0.f;
#pragma unroll
                for (int bj = 0; bj < 2; ++bj) { const u32x4 b = *(const u32x4*)(h + off + bj * HALF); const f32x4 a0 = acc[ai][bj][m][0] * sc, a1 = acc[ai][bj][m][1] * sc;
                    f32x4 z0, z1;
                    z0[0] = __builtin_bit_cast(float, b.x << 16) * alpha + a0[0]; z0[1] = __builtin_bit_cast(float, b.x & 0xffff0000u) * alpha + a0[1];
                    z0[2] = __builtin_bit_cast(float, b.y << 16) * alpha + a0[2]; z0[3] = __builtin_bit_cast(float, b.y & 0xffff0000u) * alpha + a0[3];
                    z1[0] = __builtin_bit_cast(float, b.z << 16) * alpha + a1[0]; z1[1] = __builtin_bit_cast(float, b.z & 0xffff0000u) * alpha + a1[1];
                    z1[2] = __builtin_bit_cast(float, b.w << 16) * alpha + a1[2]; z1[3] = __builtin_bit_cast(float, b.w & 0xffff0000u) * alpha + a1[3];
                    acc[ai][bj][m][0] = z0; acc[ai][bj][m][1] = z1;
                    sm += ((z0[0] + z0[1]) + (z0[2] + z0[3])) + ((z1[0] + z1[1]) + (z1[2] + z1[3]));
                    sq += ((z0[0] * z0[0] + z0[1] * z0[1]) + (z0[2] * z0[2] + z0[3] * z0[3])) + ((z1[0] * z1[0] + z1[1] * z1[1]) + (z1[2] * z1[2] + z1[3] * z1[3])); }
                sm += __shfl_xor(sm, 16); sm += __shfl_xor(sm, 32); sq += __shfl_xor(sq, 16); sq += __shfl_xor(sq, 32);
                if (fq == 0) P[(ai * HALF + wr * 64 + m * 16 + fr) * 4 + wc] = (f32x2){sm, sq};
                asm volatile("" ::: "memory"); }
        asm volatile("s_waitcnt lgkmcnt(0)" ::: "memory"); __builtin_amdgcn_s_barrier(); asm volatile("" ::: "memory");
        const int wid = wr * 4 + wc, lane = fq * 16 + fr, row = wid * 32 + (lane & 31);
        unsigned long long* slots = (unsigned long long*)xbuf + (size_t)(u.pm * BM + row) * 4;
        if (lane < 32) { const f32x2 a = P[row * 4 + 0], b = P[row * 4 + 1], c = P[row * 4 + 2], d = P[row * 4 + 3];
            const float ts = (a.x + b.x) + (c.x + d.x), tq = (a.y + b.y) + (c.y + d.y);
            __hip_atomic_store(slots + u.pn, ((unsigned long long)__builtin_bit_cast(unsigned, tq) << 32) | (unsigned long long)__builtin_bit_cast(unsigned, ts), __ATOMIC_RELAXED, __HIP_MEMORY_SCOPE_AGENT); }
        asm volatile("s_waitcnt vmcnt(0)" ::: "memory");
        if (lane == 0) (void)__hip_atomic_fetch_add(cnt + 16 * u.pm, 1u, __ATOMIC_RELAXED, __HIP_MEMORY_SCOPE_AGENT);
        if (wid == 0) { unsigned sp = 0u;
            while ((unsigned)__builtin_amdgcn_readfirstlane(__hip_atomic_load(cnt + 16 * u.pm, __ATOMIC_RELAXED, __HIP_MEMORY_SCOPE_AGENT)) < 32u) { __builtin_amdgcn_s_sleep(1);
                if ((++sp & 255u) == 0u) { if (__hip_atomic_load(tmo, __ATOMIC_RELAXED, __HIP_MEMORY_SCOPE_AGENT)) break; if (sp > (1u << 22)) { if (lane == 0) (void)__hip_atomic_fetch_add(tmo, 1u, __ATOMIC_RELAXED, __HIP_MEMORY_SCOPE_AGENT); break; } } }
            __builtin_amdgcn_fence(__ATOMIC_ACQUIRE, "agent"); }
        asm volatile("s_waitcnt vmcnt(0) lgkmcnt(0)" ::: "memory"); __builtin_amdgcn_s_barrier(); asm volatile("" ::: "memory");
        if (lane < 32) { float ts = 0.f, tq = 0.f;
#pragma unroll
            for (int t = 0; t < 4; ++t) { const unsigned long long w = __hip_atomic_load(slots + t, __ATOMIC_RELAXED, __HIP_MEMORY_SCOPE_AGENT); ts += __builtin_bit_cast(float, (unsigned)w); tq += __builtin_bit_cast(float, (unsigned)(w >> 32)); }
            const float mean = ts * (1.f / 1024.f), var = fmaxf(tq * (1.f / 1024.f) - mean * mean, 0.f);
            S[row] = (f32x2){mean, 1.f / sqrtf(var + LN_EPS)}; }
        asm volatile("s_waitcnt vmcnt(0) lgkmcnt(0)" ::: "memory"); __builtin_amdgcn_s_barrier(); asm volatile("" ::: "memory");
#pragma unroll
        for (int bj = 0; bj < 2; ++bj) { const f32x4 g0 = *(const f32x4*)(gain + col0 + bj * HALF), g1 = *(const f32x4*)(gain + col0 + bj * HALF + 4), b0 = *(const f32x4*)(bias + col0 + bj * HALF), b1 = *(const f32x4*)(bias + col0 + bj * HALF + 4);
#pragma unroll
            for (int ai = 0; ai < 2; ++ai)
#pragma unroll
                for (int m = 0; m < 4; ++m) { const int r = ai * HALF + wr * 64 + m * 16 + fr; const f32x2 sr = S[r]; const size_t off = (size_t)(u.pm * BM + r) * 1024 + col0 + bj * HALF;
                    const f32x4 y0 = (acc[ai][bj][m][0] - sr.x) * sr.y * g0 + b0, y1 = (acc[ai][bj][m][1] - sr.x) * sr.y * g1 + b1;
                    u32x4 w; w.x = cvt_pk_bf16(y0[0], y0[1]); w.y = cvt_pk_bf16(y0[2], y0[3]); w.z = cvt_pk_bf16(y1[0], y1[1]); w.w = cvt_pk_bf16(y1[2], y1[3]);
                    *(u32x4*)(h + off) = w;
                    if (HB8) { u32x2 w8; w8.x = pk4_fp8(y0[0], y0[1], y0[2], y0[3]); w8.y = pk4_fp8(y1[0], y1[1], y1[2], y1[3]); *(u32x2*)(h8 + off) = w8; }
                    asm volatile("" ::: "memory"); } }
    }
};

template <class Epi, class Sched, bool ALIGN_EPI = true, int FP8 = 0>
__device__ __forceinline__ void gemm_phase(LAS unsigned char* lds, const int wave_s, const Gemm g, const Sched& S, const Epi& E) {
    int tid = wave_s * 64 + (int)__builtin_amdgcn_mbcnt_hi(~0u, __builtin_amdgcn_mbcnt_lo(~0u, 0u)); asm volatile("" : "+v"(tid));
    const int wid = __builtin_amdgcn_readfirstlane(tid >> 6), lane = tid & 63, wr = wid >> 2, wc = wid & 3, fr = lane & 15, fq = lane >> 4;
    const int K = g.K, nt = K / BK;
    unsigned voffA[2], voffB[2];
#pragma unroll
    for (int i = 0; i < 2; ++i) { int R, C; stage_rc(tid * 16 + i * 8192, R, C); const int Rb = Epi::PERM ? ((R & ~31) + perm32(R & 31)) : R;
        voffA[i] = (unsigned)(R * g.rsA * K + C) * 2u; voffB[i] = (unsigned)(Rb * g.rsB * K + C) * 2u; }
    const unsigned kstep = (unsigned)(BK * 2);
    const unsigned hstepA = (unsigned)g.hstepA, hstepB = (unsigned)g.hstepB;
    const __amdgpu_buffer_rsrc_t rsrcA = __builtin_amdgcn_make_buffer_rsrc((void*)S.A0, 0, 0x7fffffff, 0x00020000), rsrcB = __builtin_amdgcn_make_buffer_rsrc((void*)S.B0, 0, 0x7fffffff, 0x00020000);
    const unsigned ldsw = (unsigned)wid * 1024u;
    const int aoff = lds_byte(wr * 64 + fr, fq * 8), boff = lds_byte(wc * 32 + fr, fq * 8);
    const int aoff8 = lds_byte(wr * 64 + fr, fq * 16), boff8 = lds_byte(wc * 32 + fr, fq * 16);
    unsigned bbase8_ = (unsigned)(4 * HTB + boff); asm volatile("" : "+v"(bbase8_));
    LAS unsigned char* const ldsB8 = lds + bbase8_;
#define PG8_SA(b, h) (((b) * 2 + (h)) * HTB)
#define PG8_SB(b, h) ((4 + (b) * 2 + (h)) * HTB)
#define PG8_STAGE(bufoff, gbase, voff) do { _Pragma("unroll") for (int _i = 0; _i < 2; ++_i) \
        __builtin_amdgcn_raw_ptr_buffer_load_lds(PG8_RS_##voff, (LAS unsigned*)(lds + (bufoff) + ldsw + _i * 8192), 16, (int)(voff)[_i], (int)(gbase), 0, 0); } while (0)
#define PG8_RS_voffA rsrcA
#define PG8_RS_voffB rsrcB
#define PG8_LD16(off) (*(const LAS bf16x8*)(lds + (off)))
#define PG8_CAT8(lo, hi) __builtin_shufflevector(__builtin_bit_cast(v4i_t, lo), __builtin_bit_cast(v4i_t, hi), 0, 1, 2, 3, 4, 5, 6, 7)
#define PG8_LDA(dst, b, h) do { if constexpr (FP8) { _Pragma("unroll") for (int m = 0; m < 4; ++m) dst##8[m] = PG8_CAT8(PG8_LD16(PG8_SA(b, h) + aoff + m * 2048), PG8_LD16(PG8_SA(b, h) + aoff + m * 2048 + 1024)); } \
        else { _Pragma("unroll") for (int m = 0; m < 4; ++m) _Pragma("unroll") for (int k = 0; k < 2; ++k) dst[m][k] = PG8_LD16(PG8_SA(b, h) + aoff + m * 2048 + k * 1024); } } while (0)
#define PG8_LDB(dst, b, h) do { if constexpr (FP8) { _Pragma("unroll") for (int n = 0; n < 2; ++n) dst##8[n] = PG8_CAT8(*(const LAS bf16x8*)(ldsB8 + ((b) * 2 + (h)) * HTB + n * 2048), *(const LAS bf16x8*)(ldsB8 + ((b) * 2 + (h)) * HTB + n * 2048 + 1024)); } \
        else { _Pragma("unroll") for (int n = 0; n < 2; ++n) _Pragma("unroll") for (int k = 0; k < 2; ++k) dst[n][k] = PG8_LD16(PG8_SB(b, h) + boff + n * 2048 + k * 1024); } } while (0)
#define PG8_MMA(ai, bj, At, Bt) do { __builtin_amdgcn_s_setprio(1); \
        if constexpr (FP8) { _Pragma("unroll") for (int m = 0; m < 4; ++m) _Pragma("unroll") for (int n = 0; n < 2; ++n) \
            acc[ai][bj][m][n] = __builtin_amdgcn_mfma_scale_f32_16x16x128_f8f6f4(Bt##8[n], At##8[m], acc[ai][bj][m][n], 0, 0, 0, 0, 0, 0); } \
        else { _Pragma("unroll") for (int m = 0; m < 4; ++m) _Pragma("unroll") for (int n = 0; n < 2; ++n) _Pragma("unroll") for (int k = 0; k < 2; ++k) \
            acc[ai][bj][m][n] = __builtin_amdgcn_mfma_f32_16x16x32_bf16(Bt[n][k], At[m][k], acc[ai][bj][m][n], 0, 0, 0); } \
        __builtin_amdgcn_s_setprio(0); } while (0)
#define PG8_WAIT_V(n) asm volatile("s_waitcnt vmcnt(" #n ")" ::: "memory")
#define PG8_WAIT_L(n) asm volatile("s_waitcnt lgkmcnt(" #n ")" ::: "memory")
#define PG8_BAR __builtin_amdgcn_s_barrier()
#define PG8_SCHED __builtin_amdgcn_sched_barrier(0)
    Unit cur, nxt; int ui = 0;
    if (!S.next(0, cur)) return;
    f32x4 acc[2][2][4][2];
#pragma unroll
    for (int a = 0; a < 2; ++a)
#pragma unroll
        for (int b = 0; b < 2; ++b)
#pragma unroll
            for (int m = 0; m < 4; ++m)
#pragma unroll
                for (int n = 0; n < 2; ++n) acc[a][b][m][n] = (f32x4){0.f, 0.f, 0.f, 0.f};
    bf16x8 At[4][2], B0[2][2], B1[2][2]; v8i_t At8[4], B08[2], B18[2];
    unsigned cA = cur.a, cB = cur.b;
    PG8_STAGE(PG8_SB(0, 0), cB, voffB); PG8_STAGE(PG8_SB(0, 1), cB + hstepB, voffB); PG8_STAGE(PG8_SA(0, 0), cA, voffA); PG8_STAGE(PG8_SA(0, 1), cA + hstepA, voffA);
    if (wr == 1) PG8_BAR;
    PG8_WAIT_V(2); PG8_BAR;
    PG8_STAGE(PG8_SB(1, 0), cB + kstep, voffB); PG8_STAGE(PG8_SA(1, 0), cA + kstep, voffA); PG8_STAGE(PG8_SB(1, 1), cB + hstepB + kstep, voffB);
    PG8_WAIT_V(6); PG8_BAR;
    for (;;) {
        const bool has_next = S.next(ui + 1, nxt);
        const unsigned nA = has_next ? nxt.a : cA, nB = has_next ? nxt.b : cB;
#pragma clang loop unroll(disable)
        for (int t = 0; t < nt; t += 2) {
            const bool last = (t == nt - 2);
            const unsigned a1 = cA + (unsigned)(t + 1) * kstep;
            const unsigned a2 = last ? nA : cA + (unsigned)(t + 2) * kstep, b2 = last ? nB : cB + (unsigned)(t + 2) * kstep;
            const unsigned a3 = a2 + kstep, b3 = b2 + kstep;
            PG8_LDB(B0, 0, 0); PG8_LDB(B1, 0, 1); PG8_SCHED; PG8_LDA(At, 0, 0); PG8_STAGE(PG8_SA(1, 1), a1 + hstepA, voffA);
            PG8_WAIT_V(8); PG8_WAIT_L(0); PG8_BAR; PG8_MMA(0, 0, At, B0); PG8_MMA(0, 1, At, B1); PG8_BAR; PG8_SCHED;
            PG8_LDA(At, 0, 1); PG8_STAGE(PG8_SB(0, 0), b2, voffB); PG8_STAGE(PG8_SB(0, 1), b2 + hstepB, voffB); PG8_STAGE(PG8_SA(0, 0), a2, voffA);
            PG8_WAIT_V(8); PG8_WAIT_L(0); PG8_BAR; PG8_MMA(1, 0, At, B0); PG8_MMA(1, 1, At, B1); PG8_BAR; PG8_SCHED;
            PG8_LDB(B0, 1, 0); PG8_LDB(B1, 1, 1); PG8_SCHED; PG8_LDA(At, 1, 0); PG8_STAGE(PG8_SA(0, 1), a2 + hstepA, voffA);
            PG8_WAIT_V(8); PG8_WAIT_L(0); PG8_BAR; PG8_MMA(0, 0, At, B0); PG8_MMA(0, 1, At, B1); PG8_BAR; PG8_SCHED;
            PG8_LDA(At, 1, 1); PG8_STAGE(PG8_SB(1, 0), b3, voffB); PG8_STAGE(PG8_SB(1, 1), b3 + hstepB, voffB); PG8_STAGE(PG8_SA(1, 0), a3, voffA);
            PG8_WAIT_V(8); PG8_WAIT_L(0); PG8_BAR; PG8_MMA(1, 0, At, B0); PG8_MMA(1, 1, At, B1); PG8_BAR; PG8_SCHED;
        }
        if constexpr (ALIGN_EPI) { if (wr == 0) PG8_BAR; }
        E(acc, cur, wr, wc, fr, fq);
        if (!has_next) break;
#pragma unroll
        for (int a = 0; a < 2; ++a)
#pragma unroll
            for (int b = 0; b < 2; ++b)
#pragma unroll
                for (int m = 0; m < 4; ++m)
#pragma unroll
                    for (int n = 0; n < 2; ++n) acc[a][b][m][n] = (f32x4){0.f, 0.f, 0.f, 0.f};
        cur = nxt; cA = nA; cB = nB; ++ui;
        if constexpr (ALIGN_EPI) { if (wr == 1) PG8_BAR; }
    }
    PG8_WAIT_V(0);
    if constexpr (!ALIGN_EPI) { if (wr == 0) PG8_BAR; }
    PG8_BAR;
#undef PG8_SA
#undef PG8_SB
#undef PG8_STAGE
#undef PG8_RS_voffA
#undef PG8_RS_voffB
#undef PG8_LDA
#undef PG8_LD16
#undef PG8_CAT8
#undef PG8_LDB
#undef PG8_MMA
#undef PG8_WAIT_V
#undef PG8_WAIT_L
#undef PG8_BAR
#undef PG8_SCHED
}
}

#define RLX_AGENT __ATOMIC_RELAXED, __HIP_MEMORY_SCOPE_AGENT
#define LDS_WAIT() asm volatile("s_waitcnt lgkmcnt(0)" ::: "memory")
#define VM_WAIT() asm volatile("s_waitcnt vmcnt(0)" ::: "memory")
__device__ __forceinline__ unsigned f2bf(float f) { unsigned u = __builtin_bit_cast(unsigned, f); return (u + 0x7fffu + ((u >> 16) & 1u)) >> 16; }
__device__ __forceinline__ unsigned pk2(float lo, float hi) { return pg8::cvt_pk_bf16(lo, hi); }
__device__ __forceinline__ float bflo(unsigned w) { return __builtin_bit_cast(float, w << 16); }
__device__ __forceinline__ float bfhi(unsigned w) { return __builtin_bit_cast(float, w & 0xffff0000u); }
__device__ __forceinline__ float wave_sum(float v) {
#pragma unroll
    for (int o = 1; o < 64; o <<= 1) v += __shfl_xor(v, o);
    return v;
}

#define XB_TMO      128
#define XB_XCNT(j)  (256  + 64 * (j))
#define XB_XSUB(j)  (1280 + 64 * (j))
#define XB_XGEN(j)  (2304 + 64 * (j))
#define XB_TOP      3328
#define XB_TOPGEN   3392
#define XCD_BAR_WORDS 3456
#define XB_SPIN_CAP (1u << 22)
__device__ __forceinline__ unsigned xb_ld(unsigned* p)              { return __hip_atomic_load(p, __ATOMIC_RELAXED, __HIP_MEMORY_SCOPE_AGENT); }
__device__ __forceinline__ unsigned xb_add(unsigned* p, unsigned v) { return __hip_atomic_fetch_add(p, v, __ATOMIC_RELAXED, __HIP_MEMORY_SCOPE_AGENT); }
__device__ __forceinline__ unsigned xb_xcc_id() { return (unsigned)__builtin_amdgcn_s_getreg((3 << 11) | 20) & 0xFu; }
#define XB_SPIN(cond, bar) do { unsigned _sp = 0; while (cond) { __builtin_amdgcn_s_sleep(1); \
    if ((++_sp & 255u) == 0u) { if (xb_ld(&(bar)[XB_TMO])) break; if (_sp > XB_SPIN_CAP) { atomicAdd(&(bar)[XB_TMO], 1u); break; } } } } while (0)
struct XcdBarrier { unsigned* bar; unsigned x; volatile LAS unsigned* st; };
__device__ __forceinline__ XcdBarrier xcd_barrier_post(unsigned* bar, volatile LAS unsigned* st) {
    XcdBarrier b; b.bar = bar; b.x = xb_xcc_id(); b.st = st;
    if (threadIdx.x == 0) (void)xb_add(&bar[XB_XCNT(b.x)], 1u);
    return b;
}
__device__ __forceinline__ void xcd_barrier_complete(unsigned* bar, unsigned x, unsigned& nloc, unsigned& nx) {
    const unsigned G = gridDim.x * gridDim.y * gridDim.z;
    unsigned sum, cnt, mine, sp = 0u;
    for (;;) {
        sum = 0u; cnt = 0u; mine = 0u;
#pragma unroll
        for (unsigned j = 0; j < 16; ++j) { const unsigned c = xb_ld(&bar[XB_XCNT(j)]); sum += c; cnt += (c > 0u) ? 1u : 0u; mine = (j == x) ? c : mine; }
        if (sum == G) break;
        __builtin_amdgcn_s_sleep(1);
        if ((++sp & 255u) == 0u) { if (xb_ld(&bar[XB_TMO])) break; if (sp > XB_SPIN_CAP) { atomicAdd(&bar[XB_TMO], 1u); break; } }
    }
    nloc = mine > 0u ? mine : 1u; nx = cnt > 0u ? cnt : 1u;
}
__device__ __forceinline__ void xcd_barrier(const XcdBarrier& b, const int tid) {
    asm volatile("s_waitcnt vmcnt(0)" ::: "memory");
    __syncthreads();
    if (tid == 0) {
        unsigned* bar = b.bar;
        __builtin_amdgcn_s_waitcnt(0);
        unsigned nloc = b.st[0], nx = b.st[1];
        if (nloc == 0u) { xcd_barrier_complete(bar, b.x, nloc, nx); b.st[0] = nloc; b.st[1] = nx; }
        const unsigned old = xb_add(&bar[XB_XSUB(b.x)], 1u);
        const unsigned gen = old / nloc;
        if (old + 1u == (gen + 1u) * nloc) {
            __builtin_amdgcn_fence(__ATOMIC_RELEASE, "agent");
            asm volatile("s_waitcnt vmcnt(0)" ::: "memory");
            const unsigned og = xb_add(&bar[XB_TOP], 1u);
            const unsigned tg = og / nx;
            if (og + 1u == (tg + 1u) * nx) xb_add(&bar[XB_TOPGEN], 1u);
            else XB_SPIN(xb_ld(&bar[XB_TOPGEN]) == tg, bar);
            __builtin_amdgcn_fence(__ATOMIC_ACQUIRE, "agent");
            xb_add(&bar[XB_XGEN(b.x)], 1u);
            asm volatile("s_waitcnt vmcnt(0)" ::: "memory");
        } else {
            XB_SPIN(xb_ld(&bar[XB_XGEN(b.x)]) == gen, bar);
            __builtin_amdgcn_fence(__ATOMIC_ACQUIRE, "agent");
            asm volatile("s_waitcnt vmcnt(0)" ::: "memory");
        }
    }
    __syncthreads();
}

constexpr int NWAVES = 8;
constexpr int RING_BYTES = 131072, MISC_OFF = RING_BYTES + 320, LNT_OFF = RING_BYTES + 2048  , LDS_BYTES = 147456;
struct Args { const float* in[24]; float* out; unsigned char* ws; int ph_lo, ph_hi; int chk, pad; };
struct Frame {
    LAS unsigned char* lds;
    gu32* ctl; unsigned char* ws; float* out;
    int tid, lane, wave, vcu, G;
    int chk, stage;
};

struct Job { const float* src; bf16* dst; int ld, K, N, mode, start; float scale; int fp8, pad; };
constexpr int NJOBS = 74;
__device__ __forceinline__ void make_job(const Args& a, int j, Job& J) {
    unsigned char* ws = a.ws; J.scale = 1.f; J.mode = 0; J.start = 0; J.fp8 = 0; J.pad = 0;
    if (j < 9) { const int g = j / 3, t = j % 3; J.src = a.in[4] + g * 3072 + t * 1024; J.ld = 9216; J.K = 1024; J.N = 1024;
        if (t == 2) J.dst = (bf16*)(ws + W_A_V + (size_t)g * 1024 * 1024); else J.dst = (bf16*)(ws + W_A_QK + (size_t)g * 2048 * 1024 + (size_t)t * 1024 * 1024);
        J.fp8 = 1; J.scale = (t == 0 ? QSCALE : 1.f) * WSCALE8; return; }
    j -= 9;
    if (j == 0) { J.src = a.in[5]; J.ld = 1024; J.K = 1024; J.N = 1024; J.dst = (bf16*)(ws + W_A_O); J.fp8 = 1; J.scale = WSCALE8; return; }
    if (j == 1) { J.src = a.in[6]; J.ld = 3072; J.K = 1024; J.N = 1024; J.dst = (bf16*)(ws + W_B_IN); return; }
    if (j == 9 || j == 10) { J.src = a.in[6] + 1024 * (j - 8); J.ld = 3072; J.K = 1024; J.N = 1024; J.dst = (bf16*)(ws + W_B_IN) + (size_t)1024 * 1024; J.mode = j - 8; return; }
    if (j == 2) { J.src = a.in[8]; J.ld = 1024; J.K = 1024; J.N = 1024; J.dst = (bf16*)(ws + W_B_O); return; }
    if (j == 3) { J.src = a.in[9]; J.ld = 3072; J.K = 1024; J.N = 1024; J.dst = (bf16*)(ws + W_C_QK); J.scale = QSCALE; return; }
    if (j == 4) { J.src = a.in[9] + 1024; J.ld = 3072; J.K = 1024; J.N = 1024; J.dst = (bf16*)(ws + W_C_QK) + (size_t)1024 * 1024; return; }
    if (j == 5) { J.src = a.in[9] + 2048; J.ld = 3072; J.K = 1024; J.N = 1024; J.dst = (bf16*)(ws + W_C_V); return; }
    if (j == 6) { J.src = a.in[10]; J.ld = 1024; J.K = 1024; J.N = 1024; J.dst = (bf16*)(ws + W_C_O); J.fp8 = 1; J.scale = WSCALE8; return; }
    if (j == 7) { J.src = a.in[11]; J.ld = 2048; J.K = 1024; J.N = 2048; J.dst = (bf16*)(ws + W_D_IN); return; }
    if (j == 8) { J.src = a.in[16]; J.ld = 1024; J.K = 1024; J.N = 1024; J.dst = (bf16*)(ws + W_D_O); return; }
    j -= 11;
    if (j < 6) { const int f = j / 3, t = j % 3;
        if (t < 2) { J.src = a.in[17 + t] + (size_t)f * 1024 * DFF; J.ld = DFF; J.K = 1024; J.N = DFF; J.dst = (bf16*)(ws + W_F_GU) + (size_t)f * 2 * DFF * 1024; J.mode = 1 + t;
            if (f == FFN_GU8) { J.fp8 = 1; J.scale = WSCALE8; } }
        else { J.src = a.in[19] + (size_t)f * DFF * 1024; J.ld = 1024; J.K = DFF; J.N = 1024; J.dst = (bf16*)(ws + W_F_D) + (size_t)f * 1024 * DFF; J.fp8 = 1; J.scale = WSCALE8D; }
        return; }
    j -= 6;
    { const int fe = j / 3, t = j % 3;
        if (t < 2) { J.src = a.in[21 + t] + (size_t)fe * 1024 * DFE; J.ld = DFE; J.K = 1024; J.N = DFE; J.dst = (bf16*)(ws + W_E_GU) + (size_t)fe * 2 * DFE * 1024; J.mode = 1 + t; J.fp8 = 1; J.scale = WSCALE8; }
        else { J.src = a.in[23] + (size_t)fe * DFE * 1024; J.ld = 1024; J.K = DFE; J.N = 1024; J.dst = (bf16*)(ws + W_E_D) + (size_t)fe * 1024 * DFE; J.fp8 = 1; J.scale = WSCALE8D; } }
}
__device__ __forceinline__ void transpose_item(const Job& J, int item, int lane) {
    const int nblk = J.N >> 6, kb = item / nblk, nb = item - kb * nblk, k0 = 64 * kb, n = 64 * nb + lane;
    const float* W = J.src + (size_t)k0 * J.ld + n;
    int r = n; if (J.mode) r = (n >> 7) * 256 + (n & 127) + (J.mode == 2 ? 128 : 0);
    const float sc = J.scale; const size_t ld = (size_t)J.ld;
    if (J.fp8) {
        unsigned char* dst8 = (unsigned char*)J.dst + (size_t)r * J.K + k0;
#pragma unroll
        for (int hf = 0; hf < 2; ++hf) {
            float v[32];
#pragma unroll
            for (int j = 0; j < 32; ++j) v[j] = W[(size_t)(32 * hf + j) * ld];
#pragma unroll
            for (int c = 0; c < 2; ++c) { u32x4 o; o.x = pk4_fp8(v[16 * c] * sc, v[16 * c + 1] * sc, v[16 * c + 2] * sc, v[16 * c + 3] * sc); o.y = pk4_fp8(v[16 * c + 4] * sc, v[16 * c + 5] * sc, v[16 * c + 6] * sc, v[16 * c + 7] * sc);
                o.z = pk4_fp8(v[16 * c + 8] * sc, v[16 * c + 9] * sc, v[16 * c + 10] * sc, v[16 * c + 11] * sc); o.w = pk4_fp8(v[16 * c + 12] * sc, v[16 * c + 13] * sc, v[16 * c + 14] * sc, v[16 * c + 15] * sc);
                *(u32x4*)(dst8 + 32 * hf + 16 * c) = o; }
        }
        return;
    }
    bf16* dst = J.dst + (size_t)r * J.K + k0;
#pragma unroll
    for (int hf = 0; hf < 2; ++hf) {
        float v[32];
#pragma unroll
        for (int j = 0; j < 32; ++j) v[j] = W[(size_t)(32 * hf + j) * ld];
#pragma unroll
        for (int c = 0; c < 4; ++c) { u32x4 o; o.x = pk2(v[8 * c] * sc, v[8 * c + 1] * sc); o.y = pk2(v[8 * c + 2] * sc, v[8 * c + 3] * sc); o.z = pk2(v[8 * c + 4] * sc, v[8 * c + 5] * sc); o.w = pk2(v[8 * c + 6] * sc, v[8 * c + 7] * sc);
            *(u32x4*)(dst + 32 * hf + 8 * c) = o; }
    }
}
__device__ __forceinline__ int t5_bucket(int d) {
    if (d < 16) return d;
    int b = 16 + (int)(log((double)d / 16.0) / log(128.0) * 16.0);
    return b < 16 ? 16 : (b > 31 ? 31 : b);
}
__device__ __forceinline__ void p_prologue(Frame& F, const Args& a) {
    unsigned char* gl_ = (unsigned char*)F.lds;
    Job* jobs = (Job*)(gl_ + 7 * 16384 + 8704);
    int* tot = (int*)(gl_ + 7 * 16384 + 8704 + NJOBS * sizeof(Job));
    static_assert(8704 + NJOBS * sizeof(Job) + 16 <= 16384, "job table fits");
    if (F.tid < NJOBS) { Job J; make_job(a, F.tid, J); jobs[F.tid] = J; }
    __syncthreads();
    if (F.tid == 0) { int s = 0; for (int j = 0; j < NJOBS; ++j) { jobs[j].start = s; s += (jobs[j].K / 64) * (jobs[j].N / 64); } tot[0] = s; }
    __syncthreads();
    const int total = tot[0];
    const int gw = F.vcu * NWAVES + F.wave, NGW = F.G * NWAVES;
    int jc = 0;
    for (int it = gw; it < total; it += NGW) {
        while (jc + 1 < NJOBS && jobs[jc + 1].start <= it) ++jc;
        const Job J = jobs[jc];
        transpose_item(J, it - J.start, F.lane);
    }
    { bf16* hb = (bf16*)(F.ws + WS_HB); const float* x = a.in[0]; unsigned char* hb8 = F.ws + WS_SCR + S_HB8;
      for (int m0 = 4 * gw; m0 < T; m0 += 4 * NGW) { f32x4 v[4][4];
#pragma unroll
          for (int k = 0; k < 4; ++k) { const f32x4* xr = (const f32x4*)(x + (size_t)(m0 + k) * D) + F.lane;
#pragma unroll
              for (int j = 0; j < 4; ++j) v[k][j] = xr[64 * j]; }
#pragma unroll
          for (int k = 0; k < 4; ++k) { unsigned long long* o8 = (unsigned long long*)(hb + (size_t)(m0 + k) * D) + F.lane;
#pragma unroll
              for (int j = 0; j < 4; ++j) o8[64 * j] = (unsigned long long)pk2(v[k][j].x, v[k][j].y) | ((unsigned long long)pk2(v[k][j].z, v[k][j].w) << 32);
              unsigned* o4 = (unsigned*)(hb8 + (size_t)(m0 + k) * D) + F.lane;
#pragma unroll
              for (int j = 0; j < 4; ++j) o4[64 * j] = pk4_fp8(v[k][j].x, v[k][j].y, v[k][j].z, v[k][j].w); } } }
    const int gt = blockIdx.x * 512 + F.tid, NGT = F.G * 512;
    const float* rel = a.in[1];
    float* btA = (float*)(F.ws + WS_BTABA); float* btC = (float*)(F.ws + WS_BTABC);
    for (int i = gt; i < 48 * 132; i += NGT) { const int gh = i / 132, dl = i % 132, g = gh >> 4, hh = gh & 15; const int dil = g == 0 ? 1 : (g == 1 ? 4 : 16);
        btA[i] = dl <= 128 ? rel[t5_bucket(dl * dil) * NH + hh] * LOG2E : 0.f; }
    for (int i = gt; i < 16 * 2048; i += NGT) { const int hh = i >> 11, dd = i & 2047; btC[i] = rel[t5_bucket(dd) * NH + hh] * LOG2E; }
    { bf16* wst = (bf16*)(F.ws + WS_WST); const float* wsrc = a.in[14];
      for (int i = gt; i < 8 * 128 * 128; i += NGT) { const int tt = (i >> 7) & 127, ss = i & 127; wst[i] = (bf16)f2bf(ss <= tt ? wsrc[i] : 0.f); } }
}

__device__ __forceinline__ void unpack8(const u32x4 a, float* x) { x[0] = bflo(a.x); x[1] = bfhi(a.x); x[2] = bflo(a.y); x[3] = bfhi(a.y); x[4] = bflo(a.z); x[5] = bfhi(a.z); x[6] = bflo(a.w); x[7] = bfhi(a.w); }
template <int MODE, bool ROUTE, bool FINAL, bool HB8 = false>
__device__ __forceinline__ void ln_phase(Frame& F, const float* gain, const float* bias, const float* wr) {
    constexpr int NBT = 2;
    const int gw = F.vcu * NWAVES + F.wave, NGW = F.G * NWAVES, lane = F.lane;
    bf16* hb = (bf16*)(F.ws + WS_HB); const bf16* zb = (const bf16*)F.out;
    float gv[16], bv[16];
#pragma unroll
    for (int k = 0; k < 2; ++k)
#pragma unroll
        for (int j = 0; j < 2; ++j) { const f32x4 g4 = *(const f32x4*)(gain + 512 * k + 8 * lane + 4 * j), b4 = *(const f32x4*)(bias + 512 * k + 8 * lane + 4 * j);
            gv[8 * k + 4 * j] = g4.x; gv[8 * k + 4 * j + 1] = g4.y; gv[8 * k + 4 * j + 2] = g4.z; gv[8 * k + 4 * j + 3] = g4.w;
            bv[8 * k + 4 * j] = b4.x; bv[8 * k + 4 * j + 1] = b4.y; bv[8 * k + 4 * j + 2] = b4.z; bv[8 * k + 4 * j + 3] = b4.w; }
    LAS float* wrT = (LAS float*)F.lds;
    if (ROUTE) { for (int i = F.tid; i < 8 * 1024; i += 512) { const int e = i >> 10, c = i & 1023; wrT[i] = wr[c * 8 + e]; } __syncthreads(); }
    const bf16* ys = (const bf16*)(F.ws + WS_SCR + S_XG);
    const int* slots = (const int*)(F.ws + WS_SLOTS); const float* gates = (const float*)(F.ws + WS_GATES);
    int* route = (int*)(F.ws + WS_ROUTE); float* gout = (float*)(F.ws + WS_GATES);
    for (int grp = gw; grp < T / 32; grp += NGW) {
        int cnt_e = 0;
        int my_e1 = 0, my_e2 = 0, my_r1 = 0, my_r2 = 0; float my_g1 = 0.f, my_g2 = 0.f;
        int sl0 = 0, sl1 = 0; float gg0 = 0.f, gg1 = 0.f;
        if (MODE == 2) { const int mm = grp * 32 + (lane & 31); sl0 = slots[2 * mm]; sl1 = slots[2 * mm + 1]; gg0 = gates[2 * mm]; gg1 = gates[2 * mm + 1]; }
        for (int i0 = 0; i0 < 32; i0 += NBT) {
            float v[NBT][16]; float st[NBT][2];
#pragma unroll
            for (int k = 0; k < NBT; ++k) { const int m = grp * 32 + i0 + k;
                if (MODE == 0) { const u32x4* zr = (const u32x4*)(zb + (size_t)m * D) + lane; unpack8(zr[0], v[k]); unpack8(zr[64], v[k] + 8); }
                else { const u32x4* hr = (const u32x4*)(hb + (size_t)m * D) + lane; unpack8(hr[0], v[k]); unpack8(hr[64], v[k] + 8);
#pragma unroll
                    for (int j = 0; j < 16; ++j) v[k][j] *= ALPHA;
                    if (MODE == 3) { const u32x4* yr = (const u32x4*)((const bf16*)(F.ws + WS_SCR + S_Y) + (size_t)m * D) + lane; float a[16]; unpack8(yr[0], a); unpack8(yr[64], a + 8);
#pragma unroll
                        for (int j = 0; j < 16; ++j) v[k][j] += a[j]; }
                    if (MODE == 2) { const int s0 = __builtin_amdgcn_readlane(sl0, i0 + k), s1 = __builtin_amdgcn_readlane(sl1, i0 + k);
                        const float g0 = __builtin_bit_cast(float, __builtin_amdgcn_readlane(__builtin_bit_cast(int, gg0), i0 + k)), g1 = __builtin_bit_cast(float, __builtin_amdgcn_readlane(__builtin_bit_cast(int, gg1), i0 + k));
                        const u32x4* y0 = (const u32x4*)(ys + (size_t)s0 * D) + lane; const u32x4* y1 = (const u32x4*)(ys + (size_t)s1 * D) + lane;
                        float a[16], b[16]; unpack8(y0[0], a); unpack8(y0[64], a + 8); unpack8(y1[0], b); unpack8(y1[64], b + 8);
#pragma unroll
                        for (int j = 0; j < 16; ++j) v[k][j] += g0 * a[j] + g1 * b[j]; } }
                float s = 0.f, q2 = 0.f;
#pragma unroll
                for (int j = 0; j < 16; ++j) { s += v[k][j]; q2 += v[k][j] * v[k][j]; }
                st[k][0] = s; st[k][1] = q2; }
#pragma unroll
            for (int o = 1; o < 64; o <<= 1) {
#pragma unroll
                for (int k = 0; k < NBT; ++k) { st[k][0] += __shfl_xor(st[k][0], o); st[k][1] += __shfl_xor(st[k][1], o); } }
#pragma unroll
            for (int k = 0; k < NBT; ++k) { const int m = grp * 32 + i0 + k;
                const float mean = st[k][0] * (1.f / D), var = fmaxf(st[k][1] * (1.f / D) - mean * mean, 0.f), rstd = 1.f / sqrtf(var + LN_EPS);
#pragma unroll
                for (int j = 0; j < 16; ++j) v[k][j] = (v[k][j] - mean) * rstd * gv[j] + bv[j];
                if (FINAL) { f32x4* orow = (f32x4*)(F.out + (size_t)m * D) + 2 * lane;
                    orow[0] = (f32x4){v[k][0], v[k][1], v[k][2], v[k][3]}; orow[1] = (f32x4){v[k][4], v[k][5], v[k][6], v[k][7]}; orow[128] = (f32x4){v[k][8], v[k][9], v[k][10], v[k][11]}; orow[129] = (f32x4){v[k][12], v[k][13], v[k][14], v[k][15]}; }
                else { u32x4* o = (u32x4*)(hb + (size_t)m * D) + lane; u32x4 a, b;
                    a.x = pk2(v[k][0], v[k][1]); a.y = pk2(v[k][2], v[k][3]); a.z = pk2(v[k][4], v[k][5]); a.w = pk2(v[k][6], v[k][7]); b.x = pk2(v[k][8], v[k][9]); b.y = pk2(v[k][10], v[k][11]); b.z = pk2(v[k][12], v[k][13]); b.w = pk2(v[k][14], v[k][15]);
                    o[0] = a; o[64] = b;
                    if (HB8) { u32x2* o8 = (u32x2*)(F.ws + WS_SCR + S_HB8 + (size_t)m * D) + lane; u32x2 c, d;
                        c.x = pk4_fp8(v[k][0], v[k][1], v[k][2], v[k][3]); c.y = pk4_fp8(v[k][4], v[k][5], v[k][6], v[k][7]); d.x = pk4_fp8(v[k][8], v[k][9], v[k][10], v[k][11]); d.y = pk4_fp8(v[k][12], v[k][13], v[k][14], v[k][15]);
                        o8[0] = c; o8[64] = d; } }
                if (ROUTE) {
                    float lg[8];
#pragma unroll
                    for (int e = 0; e < 8; ++e) { float p = 0.f;
#pragma unroll
                        for (int kk = 0; kk < 2; ++kk)
#pragma unroll
                            for (int j = 0; j < 2; ++j) { const f32x4 w4 = *(const LAS f32x4*)(wrT + e * 1024 + 512 * kk + 8 * lane + 4 * j); p += (v[k][8 * kk + 4 * j] * w4.x + v[k][8 * kk + 4 * j + 1] * w4.y) + (v[k][8 * kk + 4 * j + 2] * w4.z + v[k][8 * kk + 4 * j + 3] * w4.w); }
                        lg[e] = p; }
#pragma unroll
                    for (int o = 1; o < 64; o <<= 1) {
#pragma unroll
                        for (int e = 0; e < 8; ++e) lg[e] += __shfl_xor(lg[e], o); }
                    int e1 = 0; float v1 = lg[0];
#pragma unroll
                    for (int e = 1; e < 8; ++e) if (lg[e] > v1) { v1 = lg[e]; e1 = e; }
                    int e2 = -1; float v2 = -3.4e38f;
#pragma unroll
                    for (int e = 0; e < 8; ++e) if (e != e1 && lg[e] > v2) { v2 = lg[e]; e2 = e; }
                    const float g2 = 1.f / (1.f + __expf(v1 - v2)), g1 = 1.f - g2;
                    const int r1 = __shfl(cnt_e, e1); if (lane == e1) ++cnt_e;
                    const int r2 = __shfl(cnt_e, e2); if (lane == e2) ++cnt_e;
                    if (lane == i0 + k) { my_e1 = e1; my_e2 = e2; my_r1 = r1; my_r2 = r2; my_g1 = g1; my_g2 = g2; }
                }
            }
        }
        if (ROUTE) {
            if (lane < 8) ((int*)(F.ws + WS_WCNT))[grp * 8 + lane] = cnt_e;
            if (lane < 32) { const int m = grp * 32 + lane; int* r = route + 4 * m; r[0] = my_e1; r[1] = my_r1; r[2] = my_e2; r[3] = my_r2; gout[2 * m] = my_g1; gout[2 * m + 1] = my_g2; }
        }
    }
}

__device__ __forceinline__ f32x16 mfma32(bf16x8 a, bf16x8 b, f32x16 c) { return __builtin_amdgcn_mfma_f32_32x32x16_bf16(a, b, c, 0, 0, 0); }
__device__ __forceinline__ bf16x8 pack8(const f32x16& s, int b0) {
    u32x4 w; w.x = pg8::cvt_pk_bf16(s[b0], s[b0 + 1]); w.y = pg8::cvt_pk_bf16(s[b0 + 2], s[b0 + 3]); w.z = pg8::cvt_pk_bf16(s[b0 + 4], s[b0 + 5]); w.w = pg8::cvt_pk_bf16(s[b0 + 6], s[b0 + 7]);
    return __builtin_bit_cast(bf16x8, w);
}
__device__ __forceinline__ float max16(const f32x16& s) {
    float a = fmaxf(fmaxf(s[0], s[1]), fmaxf(s[2], s[3])), b = fmaxf(fmaxf(s[4], s[5]), fmaxf(s[6], s[7]));
    float c = fmaxf(fmaxf(s[8], s[9]), fmaxf(s[10], s[11])), d = fmaxf(fmaxf(s[12], s[13]), fmaxf(s[14], s[15]));
    return fmaxf(fmaxf(a, b), fmaxf(c, d));
}
__device__ __forceinline__ void softmax_pv(f32x16& s, float& m_run, float& l_run, f32x16& o0, f32x16& o1, const bf16* vt0, const bf16* vt1, int h) {
    float mx = max16(s); mx = fmaxf(mx, __shfl_xor(mx, 32));
    const float mn = fmaxf(m_run, mx), alpha = __builtin_amdgcn_exp2f(m_run - mn); m_run = mn;
    float ps = 0.f;
#pragma unroll
    for (int r = 0; r < 16; ++r) { const float p = __builtin_amdgcn_exp2f(s[r] - mn); s[r] = p; ps += p; }
    l_run = l_run * alpha + ps;
#pragma unroll
    for (int r = 0; r < 16; ++r) { o0[r] *= alpha; o1[r] *= alpha; }
    const bf16x8 p0 = pack8(s, 0), p1 = pack8(s, 8);
    const bf16x8 v00 = *(const bf16x8*)(vt0 + 8 * h), v01 = *(const bf16x8*)(vt0 + 16 + 8 * h), v10 = *(const bf16x8*)(vt1 + 8 * h), v11 = *(const bf16x8*)(vt1 + 16 + 8 * h);
    o0 = mfma32(v00, p0, o0); o0 = mfma32(v01, p1, o0);
    o1 = mfma32(v10, p0, o1); o1 = mfma32(v11, p1, o1);
}
__device__ __forceinline__ int kperm(int i) { return (i & 19) | ((i & 8) >> 1) | ((i & 4) << 1); }

__device__ __forceinline__ void dil_attn_phase(Frame& F) {
    LAS float* bt = (LAS float*)F.lds;
    { const float* btA = (const float*)(F.ws + WS_BTABA); for (int i = F.tid; i < 48 * 192; i += 512) { const int gh = i / 192, dl = i % 192 - 32; bt[i] = (dl >= 0 && dl <= 128) ? btA[gh * 132 + dl] : NEGB; } }
    __syncthreads();
    const int gw = F.vcu * NWAVES + F.wave, NGW = F.G * NWAVES, lane = F.lane, q = lane & 31, h = lane >> 5;
    const bf16* QK = (const bf16*)(F.ws + WS_SCR + S_QK); const bf16* VT = (const bf16*)(F.ws + WS_SCR + S_VT);
    bf16* OG = (bf16*)((unsigned char*)F.out + O_OG); float* LSE = (float*)((unsigned char*)F.out + O_LSE);
    constexpr int NTASK = 3 * 16 * 8 * 64;
    const int per = (NTASK + NGW - 1) / NGW;
    const int t_lo = gw * per, t_hi = (t_lo + per) < NTASK ? (t_lo + per) : NTASK;
    for (int task = t_lo; task < t_hi; ++task) {
        const int qt = task & 3, rn = (task >> 2) & 15, bl = (task >> 6) & 7, gh = task >> 9, g = gh >> 4, hh = gh & 15;
        const int nblk = 16 >> (2 * g); const bool has_prev = (rn & (nblk - 1)) != 0;
        const int n0 = bl * 2048 + rn * 128;
        const bf16* qrow = QK + ((size_t)g * TC + n0 + 32 * qt + q) * 2048 + hh * 64;
        bf16x8 qf[4];
#pragma unroll
        for (int d0 = 0; d0 < 4; ++d0) qf[d0] = *(const bf16x8*)(qrow + d0 * 16 + 8 * h);
        float m_run = NEGB, l_run = 0.f; f32x16 o0 = {}, o1 = {};
        const bf16* vbase0 = VT + ((size_t)g * 1024 + hh * 64 + q) * TC; const bf16* vbase1 = vbase0 + (size_t)32 * TC;
        const LAS float* btl = bt + gh * 192 + (q - 8 * h + 137);
#pragma unroll
        for (int t = 0; t < 5; ++t) {
            if (has_prev || qt + t > 3) {
                const int kr0 = n0 - 128 + 32 * qt + 32 * t;
                const bf16* krow = QK + ((size_t)g * TC + kr0 + kperm(q)) * 2048 + 1024 + hh * 64;
                f32x16 s;
#pragma unroll
                for (int r = 0; r < 16; ++r) s[r] = btl[-32 * t + 23 - 16 * (r >> 3) - (r & 7)];
#pragma unroll
                for (int d0 = 0; d0 < 4; ++d0) { const bf16x8 kf = *(const bf16x8*)(krow + d0 * 16 + 8 * h); s = mfma32(kf, qf[d0], s); }
                softmax_pv(s, m_run, l_run, o0, o1, vbase0 + kr0, vbase1 + kr0, h);
            }
        }
        const float l_tot = l_run + __shfl_xor(l_run, 32), inv = 1.f / l_tot;
        const size_t orow = (size_t)g * TC + n0 + 32 * qt + q;
        bf16* op = OG + orow * 1024 + hh * 64 + 4 * h;
#pragma unroll
        for (int gq = 0; gq < 4; ++gq) {
            u32x2 w0, w1; w0.x = pg8::cvt_pk_bf16(o0[4 * gq] * inv, o0[4 * gq + 1] * inv); w0.y = pg8::cvt_pk_bf16(o0[4 * gq + 2] * inv, o0[4 * gq + 3] * inv);
            w1.x = pg8::cvt_pk_bf16(o1[4 * gq] * inv, o1[4 * gq + 1] * inv); w1.y = pg8::cvt_pk_bf16(o1[4 * gq + 2] * inv, o1[4 * gq + 3] * inv);
            *(u32x2*)(op + 8 * gq) = w0; *(u32x2*)(op + 32 + 8 * gq) = w1; }
        if (h == 0) LSE[orow * 16 + hh] = m_run + __log2f(l_tot);
    }
}
__device__ __forceinline__ void dil_merge_phase(Frame& F, int ck) {
    const int gw = F.vcu * NWAVES + F.wave, NGW = F.G * NWAVES, lane = F.lane;
    const bf16* OG = (const bf16*)((unsigned char*)F.out + O_OG); const float* LSE = (const float*)((unsigned char*)F.out + O_LSE);
    unsigned char* att = F.ws + WS_SCR + S_ATT + (size_t)ck * TC * 1024;
    const int hh = lane >> 2;
    for (int tl0 = 2 * gw; tl0 < TC; tl0 += 2 * NGW) {
        size_t n[2][3]; float ls[2][3]; u32x4 x[2][3];
#pragma unroll
        for (int k = 0; k < 2; ++k) { const int tl = tl0 + k, bl = tl >> 11, tt = tl & 2047;
            n[k][0] = tl; n[k][1] = bl * 2048 + (tt & 3) * 512 + (tt >> 2); n[k][2] = bl * 2048 + (tt & 15) * 128 + (tt >> 4);
#pragma unroll
            for (int g = 0; g < 3; ++g) { ls[k][g] = LSE[((size_t)g * TC + n[k][g]) * 16 + hh]; x[k][g] = *(const u32x4*)((const unsigned char*)OG + ((size_t)g * TC + n[k][g]) * 1024 + 16 * lane); } }
#pragma unroll
        for (int k = 0; k < 2; ++k) {
            const float M = fmaxf(fmaxf(ls[k][0], ls[k][1]), ls[k][2]);
            float w[3]; float W = 0.f;
#pragma unroll
            for (int g = 0; g < 3; ++g) { w[g] = __builtin_amdgcn_exp2f(ls[k][g] - M); W += w[g]; }
            const float iw = 1.f / W;
            float acc[16];
#pragma unroll
            for (int j = 0; j < 16; ++j) acc[j] = 0.f;
#pragma unroll
            for (int g = 0; g < 3; ++g) { const float wg = w[g] * iw; float a[16];
#pragma unroll
                for (int c = 0; c < 4; ++c) { const f32x2 lo = __builtin_amdgcn_cvt_pk_f32_fp8((int)x[k][g][c], false), hi = __builtin_amdgcn_cvt_pk_f32_fp8((int)x[k][g][c], true); a[4 * c] = lo.x; a[4 * c + 1] = lo.y; a[4 * c + 2] = hi.x; a[4 * c + 3] = hi.y; }
#pragma unroll
                for (int j = 0; j < 16; ++j) acc[j] += wg * a[j]; }
            u32x4 y; y.x = pk4_fp8(acc[0], acc[1], acc[2], acc[3]); y.y = pk4_fp8(acc[4], acc[5], acc[6], acc[7]); y.z = pk4_fp8(acc[8], acc[9], acc[10], acc[11]); y.w = pk4_fp8(acc[12], acc[13], acc[14], acc[15]);
            *(u32x4*)(att + (size_t)(tl0 + k) * 1024 + 16 * lane) = y;
        }
    }
}

__device__ __forceinline__ void conv_phase(Frame& F, const float* cw) {
    const int gw = F.vcu * NWAVES + F.wave, NGW = F.G * NWAVES, lane = F.lane;
    const bf16* gbp = (const bf16*)(F.ws + WS_SCR + S_BCX); const bf16* up = (const bf16*)(F.ws + WS_SCR + S_BCX + (size_t)128 * MiB); bf16* p = (bf16*)(F.ws + WS_SCR + S_P);
    for (int item = gw; item < (T / 32) * 2; item += NGW) {
        const int half = item & 1, tb = item >> 1, t0 = tb * 32, c0 = half * 512 + lane * 8;
        float w0[8], w1[8], w2[8];
#pragma unroll
        for (int j = 0; j < 8; ++j) { w0[j] = cw[c0 + j]; w1[j] = cw[1024 + c0 + j]; w2[j] = cw[2048 + c0 + j]; }
        float u1[8], u2[8];
        const bool first = (t0 & 2047) == 0;
#pragma unroll
        for (int j = 0; j < 8; ++j) { u1[j] = 0.f; u2[j] = 0.f; }
        if (!first) { unpack8(*(const u32x4*)(up + (size_t)(t0 - 2) * 1024 + c0), u2); unpack8(*(const u32x4*)(up + (size_t)(t0 - 1) * 1024 + c0), u1); }
        for (int i = 0; i < 32; ++i) { const size_t r = (size_t)(t0 + i) * 1024;
            const u32x4 gb = *(const u32x4*)(gbp + r + c0), uu = *(const u32x4*)(up + r + c0);
            float u0[8], b[8]; unpack8(uu, u0); unpack8(gb, b);
            float o[8];
#pragma unroll
            for (int j = 0; j < 8; ++j) { o[j] = b[j] * (w0[j] * u2[j] + w1[j] * u1[j] + w2[j] * u0[j]); u2[j] = u1[j]; u1[j] = u0[j]; }
            u32x4 x; x.x = pk2(o[0], o[1]); x.y = pk2(o[2], o[3]); x.z = pk2(o[4], o[5]); x.w = pk2(o[6], o[7]);
            *(u32x4*)(p + (size_t)(t0 + i) * 1024 + c0) = x; }
    }
}

__device__ __forceinline__ void kmean_phase(Frame& F) {
    const int gw = F.vcu * NWAVES + F.wave, NGW = F.G * NWAVES, lane = F.lane;
    const bf16* QK = (const bf16*)(F.ws + WS_SCR + S_CQK); float* km = (float*)(F.ws + WS_KMEAN);
    const int kq = lane >> 3, dc = lane & 7;
    for (int u = gw; u < NB * NH * 8; u += NGW) { const int blk = u & 7, hh = (u >> 3) & 15, b = u >> 7;
        float a[8];
#pragma unroll
        for (int j = 0; j < 8; ++j) a[j] = 0.f;
        const bf16* kp = QK + ((size_t)b * SEQ + blk * 256 + kq) * 2048 + 1024 + hh * 64 + dc * 8;
#pragma unroll 8
        for (int i = 0; i < 32; ++i) { const u32x4 x = *(const u32x4*)(kp + (size_t)i * 8 * 2048);
            a[0] += bflo(x.x); a[1] += bfhi(x.x); a[2] += bflo(x.y); a[3] += bfhi(x.y); a[4] += bflo(x.z); a[5] += bfhi(x.z); a[6] += bflo(x.w); a[7] += bfhi(x.w); }
#pragma unroll
        for (int j = 0; j < 8; ++j) { a[j] += __shfl_xor(a[j], 8); a[j] += __shfl_xor(a[j], 16); a[j] += __shfl_xor(a[j], 32); }
        if (lane < 8) { float* o = km + (size_t)u * 64 + lane * 8;
#pragma unroll
            for (int j = 0; j < 8; ++j) o[j] = a[j] * (1.f / 256.f); }
    }
}
__device__ __forceinline__ void moba_unit(Frame& F, int b, int hh, int nb, LAS float* bt, int& cur_h) {
    const int lane = F.lane, q = lane & 31, h = lane >> 5, w = F.wave;
    const bf16* QK = (const bf16*)(F.ws + WS_SCR + S_CQK); const bf16* VT = (const bf16*)(F.ws + WS_SCR + S_CVT);
    bf16* att = (bf16*)(F.ws + WS_SCR + S_CATT); const float* km = (const float*)(F.ws + WS_KMEAN);
    if (hh != cur_h) { __syncthreads(); const float* btC = (const float*)(F.ws + WS_BTABC) + hh * 2048; for (int i = F.tid; i < 2048; i += 512) bt[i] = btC[i]; cur_h = hh; __syncthreads(); }
    const size_t tq = (size_t)b * SEQ + nb * 256 + 32 * w + q;
    const bf16* qrow = QK + tq * 2048 + hh * 64;
    bf16x8 qf[4];
#pragma unroll
    for (int d0 = 0; d0 < 4; ++d0) qf[d0] = *(const bf16x8*)(qrow + d0 * 16 + 8 * h);
    unsigned sel = 0;
    if (nb > 0) {
        float gsc[7];
#pragma unroll
        for (int m = 0; m < 7; ++m) { float s = 0.f;
            if (m < nb) { const float* kmp = km + (((size_t)b * NH + hh) * 8 + m) * 64;
#pragma unroll
                for (int d0 = 0; d0 < 4; ++d0) { const f32x4 k0 = *(const f32x4*)(kmp + d0 * 16 + 8 * h), k1 = *(const f32x4*)(kmp + d0 * 16 + 8 * h + 4); const u32x4 qq = __builtin_bit_cast(u32x4, qf[d0]);
                    s += bflo(qq.x) * k0.x + bfhi(qq.x) * k0.y + bflo(qq.y) * k0.z + bfhi(qq.y) * k0.w + bflo(qq.z) * k1.x + bfhi(qq.z) * k1.y + bflo(qq.w) * k1.z + bfhi(qq.w) * k1.w; }
                s += __shfl_xor(s, 32); }
            gsc[m] = m < nb ? s : -3.0e38f; }
        const int nsel = nb < 3 ? nb : 3;
#pragma unroll
        for (int r = 0; r < 3; ++r) { if (r < nsel) { int bi = -1; float bv = -3.4e38f;
#pragma unroll
                for (int m = 0; m < 7; ++m) if (!((sel >> m) & 1u) && gsc[m] > bv) { bv = gsc[m]; bi = m; }
                sel |= 1u << bi; } }
    }
#ifdef MK_SELFCHECK
    if (h == 0) ((unsigned*)(F.ws + WS_NEED + 3 * MiB))[tq * 16 + hh] = sel;
#endif
    float m_run = NEGB, l_run = 0.f; f32x16 o0 = {}, o1 = {};
    const bf16* vbase0 = VT + ((size_t)hh * 64 + q) * T + (size_t)b * SEQ; const bf16* vbase1 = vbase0 + (size_t)32 * T;
    const int qpos = nb * 256 + 32 * w + q;
    for (int m = 0; m < nb; ++m) {
        const bool mine = (sel >> m) & 1u;
        if (__ballot(mine) == 0ull) continue;
        for (int kt = 0; kt < 8; ++kt) {
            const int kr0 = m * 256 + 32 * kt;
            const bf16* krow = QK + ((size_t)b * SEQ + kr0 + kperm(q)) * 2048 + 1024 + hh * 64;
            f32x16 s = {};
#pragma unroll
            for (int d0 = 0; d0 < 4; ++d0) { const bf16x8 kf = *(const bf16x8*)(krow + d0 * 16 + 8 * h); s = mfma32(kf, qf[d0], s); }
#pragma unroll
            for (int r = 0; r < 16; ++r) { const int kap = 16 * (r >> 3) + 8 * h + (r & 7); const float bb = bt[qpos - kr0 - kap]; s[r] = mine ? s[r] + bb : NEGB; }
            softmax_pv(s, m_run, l_run, o0, o1, vbase0 + kr0, vbase1 + kr0, h);
        }
    }
    for (int kt = 0; kt <= w; ++kt) {
        const int kr0 = nb * 256 + 32 * kt;
        const bf16* krow = QK + ((size_t)b * SEQ + kr0 + kperm(q)) * 2048 + 1024 + hh * 64;
        f32x16 s = {};
#pragma unroll
        for (int d0 = 0; d0 < 4; ++d0) { const bf16x8 kf = *(const bf16x8*)(krow + d0 * 16 + 8 * h); s = mfma32(kf, qf[d0], s); }
#pragma unroll
        for (int r = 0; r < 16; ++r) { const int kap = 16 * (r >> 3) + 8 * h + (r & 7); const int dd = qpos - kr0 - kap; const float bb = bt[dd < 0 ? 0 : dd]; s[r] = dd >= 0 ? s[r] + bb : NEGB; }
        softmax_pv(s, m_run, l_run, o0, o1, vbase0 + kr0, vbase1 + kr0, h);
    }
    const float l_tot = l_run + __shfl_xor(l_run, 32), inv = 1.f / l_tot;
#ifdef MK_SELFCHECK
    if (h == 0) ((float*)(F.ws + WS_NEED + 7 * MiB))[tq * 16 + hh] = m_run + __log2f(l_tot);
#endif
    bf16* op = att + tq * 1024 + hh * 64 + 4 * h;
#pragma unroll
    for (int gq = 0; gq < 4; ++gq) {
        u32x2 w0, w1; w0.x = pg8::cvt_pk_bf16(o0[4 * gq] * inv, o0[4 * gq + 1] * inv); w0.y = pg8::cvt_pk_bf16(o0[4 * gq + 2] * inv, o0[4 * gq + 3] * inv);
        w1.x = pg8::cvt_pk_bf16(o1[4 * gq] * inv, o1[4 * gq + 1] * inv); w1.y = pg8::cvt_pk_bf16(o1[4 * gq + 2] * inv, o1[4 * gq + 3] * inv);
        *(u32x2*)(op + 8 * gq) = w0; *(u32x2*)(op + 32 + 8 * gq) = w1; }
}
__device__ __forceinline__ void moba_phase(Frame& F) {
    LAS float* bt = (LAS float*)F.lds; int cur_h = -1;
    const int NP = NB * NH * 4, per = (NP + F.G - 1) / F.G;
    const int lo = F.vcu * per, hi = (lo + per) < NP ? (lo + per) : NP;
    for (int pu = lo; pu < hi; ++pu) { const int j = pu & 3, hh = (pu >> 2) & 15, b = pu >> 6;
        moba_unit(F, b, hh, 7 - j, bt, cur_h); moba_unit(F, b, hh, j, bt, cur_h); }
}


constexpr int AKP = 72;
constexpr int ATILE = 64 * AKP * 2;
struct AttnSt { float m, l; f32x16 o0, o1; };
template <bool MASKED>
__device__ __forceinline__ void attn_tile(const LAS bf16* Kt, const LAS bf16* Vt, const LAS float* bl, const bf16x8 (&qf)[4], AttnSt& st, int q, int h, bool mine) {
    f32x16 s;
#pragma unroll
    for (int r = 0; r < 16; ++r) s[r] = bl[23 - 16 * (r >> 3) - (r & 7)];
    const LAS bf16* kr = Kt + kperm(q) * AKP + 8 * h;
#pragma unroll
    for (int d0 = 0; d0 < 4; ++d0) s = mfma32(*(const LAS bf16x8*)(kr + d0 * 16), qf[d0], s);
    float mx = max16(s); mx = fmaxf(mx, __shfl_xor(mx, 32));
    float mn = fmaxf(st.m, mx); if (MASKED) mn = mine ? mn : st.m;
    const float alpha = __builtin_amdgcn_exp2f(st.m - mn);
    float ps = 0.f;
#pragma unroll
    for (int r = 0; r < 16; ++r) { const float p = __builtin_amdgcn_exp2f(s[r] - mn); s[r] = p; ps += p; }
    bf16x8 p0 = pack8(s, 0), p1 = pack8(s, 8);
    if (MASKED) { if (!mine) { p0 = (bf16x8){0, 0, 0, 0, 0, 0, 0, 0}; p1 = p0; ps = 0.f; } }
    st.l = st.l * alpha + ps; st.m = mn;
    if (__ballot(alpha != 1.0f) != 0ull) {
#pragma unroll
        for (int r = 0; r < 16; ++r) { st.o0[r] *= alpha; st.o1[r] *= alpha; } }
    const LAS bf16* v0 = Vt + q * AKP + 8 * h; const LAS bf16* v1 = v0 + 32 * AKP;
    st.o0 = mfma32(*(const LAS bf16x8*)v0, p0, st.o0); st.o0 = mfma32(*(const LAS bf16x8*)(v0 + 16), p1, st.o0);
    st.o1 = mfma32(*(const LAS bf16x8*)v1, p0, st.o1); st.o1 = mfma32(*(const LAS bf16x8*)(v1 + 16), p1, st.o1);
}
__device__ __forceinline__ void attn_store(const AttnSt& st, bf16* op  , float inv) {
#pragma unroll
    for (int gq = 0; gq < 4; ++gq) {
        u32x2 w0, w1; w0.x = pg8::cvt_pk_bf16(st.o0[4 * gq] * inv, st.o0[4 * gq + 1] * inv); w0.y = pg8::cvt_pk_bf16(st.o0[4 * gq + 2] * inv, st.o0[4 * gq + 3] * inv);
        w1.x = pg8::cvt_pk_bf16(st.o1[4 * gq] * inv, st.o1[4 * gq + 1] * inv); w1.y = pg8::cvt_pk_bf16(st.o1[4 * gq + 2] * inv, st.o1[4 * gq + 3] * inv);
        *(u32x2*)(op + 8 * gq) = w0; *(u32x2*)(op + 32 + 8 * gq) = w1; }
}

__device__ __forceinline__ void attn_store8(const AttnSt& st, unsigned char* op  , float inv) {
#pragma unroll
    for (int gq = 0; gq < 4; ++gq) {
        *(unsigned*)(op + 8 * gq) = pk4_fp8(st.o0[4 * gq] * inv, st.o0[4 * gq + 1] * inv, st.o0[4 * gq + 2] * inv, st.o0[4 * gq + 3] * inv);
        *(unsigned*)(op + 32 + 8 * gq) = pk4_fp8(st.o1[4 * gq] * inv, st.o1[4 * gq + 1] * inv, st.o1[4 * gq + 2] * inv, st.o1[4 * gq + 3] * inv); }
}

__device__ __forceinline__ void dil_attn_phase2(Frame& F) {
    LAS float* bt = (LAS float*)F.lds;
    { const float* btA = (const float*)(F.ws + WS_BTABA); for (int i = F.tid; i < 48 * 192; i += 512) { const int gh = i / 192, dl = i % 192 - 32; bt[i] = (dl >= 0 && dl <= 128) ? btA[gh * 132 + dl] : NEGB; } }
    __syncthreads();
    constexpr int TBL = 48 * 192 * 4;
    const int lane = F.lane, q = lane & 31, h = lane >> 5, w = F.wave, uw = w >> 2, qt = w & 3, t = F.tid, tu = t >> 8, tt = t & 255, srow = tt >> 3, sch = tt & 7;
    const bf16* QK = (const bf16*)(F.ws + WS_SCR + S_QK); const bf16* VT = (const bf16*)(F.ws + WS_SCR + S_VT);
    bf16* OG = (bf16*)((unsigned char*)F.out + O_OG); float* LSE = (float*)((unsigned char*)F.out + O_LSE);
    for (int du = F.vcu; du < 3072; du += F.G) {
        const int g = du >> 10, rem = du & 1023, hh = rem >> 6, blp = (rem >> 4) & 3, rn = rem & 15, gh = g * 16 + hh;
        const int nblk = 16 >> (2 * g); const bool has_prev = (rn & (nblk - 1)) != 0;
        const int j0 = has_prev ? 0 : 2;
        const int n0s = (2 * blp + tu) * 2048 + rn * 128;
        const bf16* ksrc = QK + ((size_t)g * TC + n0s - 128 + srow) * 2048 + 1024 + hh * 64 + sch * 8;
        const bf16* vsrc = VT + ((size_t)g * 1024 + hh * 64 + srow) * TC + (n0s - 128) + sch * 8;
        const int sdst = srow * AKP + sch * 8;
        const int n0 = (2 * blp + uw) * 2048 + rn * 128;
        const bf16* qrow = QK + ((size_t)g * TC + n0 + 32 * qt + q) * 2048 + hh * 64;
        bf16x8 qf[4];
#pragma unroll
        for (int d0 = 0; d0 < 4; ++d0) qf[d0] = *(const bf16x8*)(qrow + d0 * 16 + 8 * h);
        AttnSt st; st.m = NEGB; st.l = 0.f; st.o0 = (f32x16){}; st.o1 = (f32x16){};
        u32x4 k0, k1, v0, v1;
        k0 = *(const u32x4*)(ksrc + (size_t)(64 * j0) * 2048); k1 = *(const u32x4*)(ksrc + (size_t)(64 * j0 + 32) * 2048);
        v0 = *(const u32x4*)(vsrc + 64 * j0); v1 = *(const u32x4*)(vsrc + (size_t)32 * TC + 64 * j0);
        { LAS bf16* kb = (LAS bf16*)(F.lds + TBL + (0 * 2 + tu) * 2 * ATILE); LAS bf16* vb = kb + 64 * AKP;
          *(LAS u32x4*)(kb + sdst) = k0; *(LAS u32x4*)(kb + 32 * AKP + sdst) = k1; *(LAS u32x4*)(vb + sdst) = v0; *(LAS u32x4*)(vb + 32 * AKP + sdst) = v1; }
        __syncthreads();
        int pb = 0;
        for (int j = j0; j < 4; ++j) {
            const bool more = j + 1 < 4;
            if (more) { k0 = *(const u32x4*)(ksrc + (size_t)(64 * (j + 1)) * 2048); k1 = *(const u32x4*)(ksrc + (size_t)(64 * (j + 1) + 32) * 2048);
                        v0 = *(const u32x4*)(vsrc + 64 * (j + 1)); v1 = *(const u32x4*)(vsrc + (size_t)32 * TC + 64 * (j + 1)); }
            const LAS bf16* kb = (const LAS bf16*)(F.lds + TBL + (pb * 2 + uw) * 2 * ATILE); const LAS bf16* vb = kb + 64 * AKP;
#pragma unroll
            for (int t2 = 0; t2 < 2; ++t2) { const int t32 = 2 * j + t2;
                if (t32 >= qt && t32 <= qt + 4) {
                    const LAS float* bl = bt + gh * 192 + 32 + (32 * qt + q + 128 - 32 * t32 - 8 * h - 23);
                    attn_tile<false>(kb + 32 * t2 * AKP, vb + 32 * t2, bl, qf, st, q, h, true); } }
            if (more) { LAS bf16* kn = (LAS bf16*)(F.lds + TBL + ((pb ^ 1) * 2 + tu) * 2 * ATILE); LAS bf16* vn = kn + 64 * AKP;
                *(LAS u32x4*)(kn + sdst) = k0; *(LAS u32x4*)(kn + 32 * AKP + sdst) = k1; *(LAS u32x4*)(vn + sdst) = v0; *(LAS u32x4*)(vn + 32 * AKP + sdst) = v1; }
            __syncthreads();
            pb ^= 1;
        }
        const float l_tot = st.l + __shfl_xor(st.l, 32), inv = 1.f / l_tot;
        const size_t orow = (size_t)g * TC + n0 + 32 * qt + q;
        attn_store(st, OG + orow * 1024 + hh * 64 + 4 * h, inv);
        if (h == 0) LSE[orow * 16 + hh] = st.m + __log2f(l_tot);
    }
}

__device__ __forceinline__ void moba_unit2(Frame& F, int b, int hh, int nb, LAS float* bt, int& cur_h) {
    constexpr int TBL = 8448;
    const int lane = F.lane, q = lane & 31, h = lane >> 5, w = F.wave, t = F.tid, srow = t >> 3, sch = t & 7;
    const bf16* QK = (const bf16*)(F.ws + WS_SCR + S_CQK); const bf16* VT = (const bf16*)(F.ws + WS_SCR + S_CVT);
    bf16* att = (bf16*)(F.ws + WS_SCR + S_CATT); const float* km = (const float*)(F.ws + WS_KMEAN);
    if (hh != cur_h) { __syncthreads(); const float* btC = (const float*)(F.ws + WS_BTABC) + hh * 2048; for (int i = t; i < 2048 + 32; i += 512) bt[i] = i < 32 ? NEGB : btC[i - 32]; cur_h = hh; __syncthreads(); }
    const size_t tq = (size_t)b * SEQ + nb * 256 + 32 * w + q;
    const bf16* qrow = QK + tq * 2048 + hh * 64;
    bf16x8 qf[4];
#pragma unroll
    for (int d0 = 0; d0 < 4; ++d0) qf[d0] = *(const bf16x8*)(qrow + d0 * 16 + 8 * h);
    unsigned sel = 0;
    if (nb > 0) {
        float gsc[7];
#pragma unroll
        for (int m = 0; m < 7; ++m) { float s = 0.f;
            if (m < nb) { const float* kmp = km + (((size_t)b * NH + hh) * 8 + m) * 64;
#pragma unroll
                for (int d0 = 0; d0 < 4; ++d0) { const f32x4 k0 = *(const f32x4*)(kmp + d0 * 16 + 8 * h), k1 = *(const f32x4*)(kmp + d0 * 16 + 8 * h + 4); const u32x4 qq = __builtin_bit_cast(u32x4, qf[d0]);
                    s += bflo(qq.x) * k0.x + bfhi(qq.x) * k0.y + bflo(qq.y) * k0.z + bfhi(qq.y) * k0.w + bflo(qq.z) * k1.x + bfhi(qq.z) * k1.y + bflo(qq.w) * k1.z + bfhi(qq.w) * k1.w; }
                s += __shfl_xor(s, 32); }
            gsc[m] = m < nb ? s : -3.0e38f; }
        const int nsel = nb < 3 ? nb : 3;
#pragma unroll
        for (int r = 0; r < 3; ++r) { if (r < nsel) { int bi = 0; float bv = -3.4e38f;
#pragma unroll
                for (int m = 0; m < 7; ++m) if (!((sel >> m) & 1u) && gsc[m] > bv) { bv = gsc[m]; bi = m; }
                sel |= 1u << bi; } }
    }
    AttnSt st; st.m = NEGB; st.l = 0.f; st.o0 = (f32x16){}; st.o1 = (f32x16){};
    const int qpos = nb * 256 + 32 * w + q, nsteps = 4 * nb + 4;
    const bf16* ksrc = QK + ((size_t)b * SEQ + srow) * 2048 + 1024 + hh * 64 + sch * 8;
    const bf16* vsrc = VT + ((size_t)hh * 64 + srow) * T + (size_t)b * SEQ + sch * 8;
    const int sdst = srow * AKP + sch * 8;
    u32x4 kreg = *(const u32x4*)ksrc, vreg = *(const u32x4*)vsrc;
    { LAS bf16* kb = (LAS bf16*)(F.lds + TBL); *(LAS u32x4*)(kb + sdst) = kreg; *(LAS u32x4*)(kb + 64 * AKP + sdst) = vreg; }
    __syncthreads();
    int pb = 0;
    for (int s = 0; s < nsteps; ++s) {
        const bool more = s + 1 < nsteps;
        if (more) { kreg = *(const u32x4*)(ksrc + (size_t)(64 * (s + 1)) * 2048); vreg = *(const u32x4*)(vsrc + 64 * (s + 1)); }
        const LAS bf16* kb = (const LAS bf16*)(F.lds + TBL + pb * 2 * ATILE); const LAS bf16* vb = kb + 64 * AKP;
        if (s < 4 * nb) {
            const bool mine = (sel >> (s >> 2)) & 1u;
            if (__ballot(mine) != 0ull) {
#pragma unroll
                for (int t2 = 0; t2 < 2; ++t2) { const LAS float* bl = bt + 32 + (qpos - 8 * h - (64 * s + 32 * t2) - 23);
                    attn_tile<true>(kb + 32 * t2 * AKP, vb + 32 * t2, bl, qf, st, q, h, mine); } }
        } else {
#pragma unroll
            for (int t2 = 0; t2 < 2; ++t2) { const int t32 = (s - 4 * nb) * 2 + t2;
                if (t32 <= w) { const LAS float* bl = bt + 32 + (qpos - 8 * h - (64 * s + 32 * t2) - 23);
                    attn_tile<false>(kb + 32 * t2 * AKP, vb + 32 * t2, bl, qf, st, q, h, true); } }
        }
        if (more) { LAS bf16* kn = (LAS bf16*)(F.lds + TBL + (pb ^ 1) * 2 * ATILE); *(LAS u32x4*)(kn + sdst) = kreg; *(LAS u32x4*)(kn + 64 * AKP + sdst) = vreg; }
        __syncthreads();
        pb ^= 1;
    }
    const float l_tot = st.l + __shfl_xor(st.l, 32), inv = 1.f / l_tot;
    attn_store(st, att + tq * 1024 + hh * 64 + 4 * h, inv);
}
__device__ __forceinline__ void moba_phase2(Frame& F) {
    LAS float* bt = (LAS float*)F.lds; int cur_h = -1;
    const int NP = NB * NH * 4, per = (NP + F.G - 1) / F.G;
    const int lo = F.vcu * per, hi = (lo + per) < NP ? (lo + per) : NP;
    for (int pu = lo; pu < hi; ++pu) { const int j = pu & 3, hh = (pu >> 2) & 15, b = pu >> 6;
        moba_unit2(F, b, hh, 7 - j, bt, cur_h); moba_unit2(F, b, hh, j, bt, cur_h); }
}


__device__ __forceinline__ float xhalf_max(float m) { auto rr = __builtin_amdgcn_permlane32_swap(__float_as_uint(m), __float_as_uint(m), false, false); return fmaxf(__uint_as_float(rr[0]), __uint_as_float(rr[1])); }
__device__ __forceinline__ float xhalf_sum(float m) { auto rr = __builtin_amdgcn_permlane32_swap(__float_as_uint(m), __float_as_uint(m), false, false); return __uint_as_float(rr[0]) + __uint_as_float(rr[1]); }
template <bool MASKED>
__device__ __forceinline__ void attn_tile2(const LAS bf16* Kt, const LAS bf16* Vt, const LAS float* bl0, const bf16x8 (&qf)[4], AttnSt& st, int q, int h, bool mine) {
    f32x16 s0, s1;
#pragma unroll
    for (int r = 0; r < 16; ++r) { s0[r] = bl0[23 - 16 * (r >> 3) - (r & 7)]; s1[r] = bl0[-32 + 23 - 16 * (r >> 3) - (r & 7)]; }
    const LAS bf16* kr = Kt + kperm(q) * AKP + 8 * h;
#pragma unroll
    for (int d0 = 0; d0 < 4; ++d0) { s0 = mfma32(*(const LAS bf16x8*)(kr + d0 * 16), qf[d0], s0); s1 = mfma32(*(const LAS bf16x8*)(kr + 32 * AKP + d0 * 16), qf[d0], s1); }
    const float mx = xhalf_max(fmaxf(max16(s0), max16(s1)));
    float mn = fmaxf(st.m, mx); if (MASKED) mn = mine ? mn : st.m;
    const float alpha = __builtin_amdgcn_exp2f(st.m - mn);
    float ps0 = 0.f, ps1 = 0.f;
#pragma unroll
    for (int r = 0; r < 16; ++r) { const float p = __builtin_amdgcn_exp2f(s0[r] - mn); s0[r] = p; ps0 += p; const float p2 = __builtin_amdgcn_exp2f(s1[r] - mn); s1[r] = p2; ps1 += p2; }
    bf16x8 p00 = pack8(s0, 0), p01 = pack8(s0, 8), p10 = pack8(s1, 0), p11 = pack8(s1, 8);
    float ps = ps0 + ps1;
    if (MASKED) { if (!mine) { p00 = (bf16x8){0, 0, 0, 0, 0, 0, 0, 0}; p01 = p00; p10 = p00; p11 = p00; ps = 0.f; } }
    st.l = st.l * alpha + ps; st.m = mn;
    if (__ballot(alpha != 1.0f) != 0ull) {
#pragma unroll
        for (int r = 0; r < 16; ++r) { st.o0[r] *= alpha; st.o1[r] *= alpha; } }
    const LAS bf16* v0 = Vt + q * AKP + 8 * h; const LAS bf16* v1 = v0 + 32 * AKP;
    st.o0 = mfma32(*(const LAS bf16x8*)v0, p00, st.o0); st.o1 = mfma32(*(const LAS bf16x8*)v1, p00, st.o1);
    st.o0 = mfma32(*(const LAS bf16x8*)(v0 + 16), p01, st.o0); st.o1 = mfma32(*(const LAS bf16x8*)(v1 + 16), p01, st.o1);
    st.o0 = mfma32(*(const LAS bf16x8*)(v0 + 32), p10, st.o0); st.o1 = mfma32(*(const LAS bf16x8*)(v1 + 32), p10, st.o1);
    st.o0 = mfma32(*(const LAS bf16x8*)(v0 + 48), p11, st.o0); st.o1 = mfma32(*(const LAS bf16x8*)(v1 + 48), p11, st.o1);
}

__device__ __forceinline__ void attn_tile2r(const LAS bf16* Kt, const LAS bf16* Vt, const LAS float* b0, const LAS float* b1, const bf16x8 (&qf)[4], AttnSt& st, int q, int h) {
    f32x16 s0, s1;
#pragma unroll
    for (int r = 0; r < 16; ++r) { s0[r] = b0[16 * (r >> 3) + (r & 7)]; s1[r] = b1[16 * (r >> 3) + (r & 7)]; }
    const LAS bf16* kr = Kt + kperm(q) * AKP + 8 * h;
#pragma unroll
    for (int d0 = 0; d0 < 4; ++d0) { s0 = mfma32(*(const LAS bf16x8*)(kr + d0 * 16), qf[d0], s0); s1 = mfma32(*(const LAS bf16x8*)(kr + 32 * AKP + d0 * 16), qf[d0], s1); }
    const float mx = xhalf_max(fmaxf(max16(s0), max16(s1)));
    const float mn = fmaxf(st.m, mx);
    const float alpha = __builtin_amdgcn_exp2f(st.m - mn);
    float ps0 = 0.f, ps1 = 0.f;
#pragma unroll
    for (int r = 0; r < 16; ++r) { const float p = __builtin_amdgcn_exp2f(s0[r] - mn); s0[r] = p; ps0 += p; const float p2 = __builtin_amdgcn_exp2f(s1[r] - mn); s1[r] = p2; ps1 += p2; }
    const bf16x8 p00 = pack8(s0, 0), p01 = pack8(s0, 8), p10 = pack8(s1, 0), p11 = pack8(s1, 8);
    st.l = st.l * alpha + (ps0 + ps1); st.m = mn;
    if (__ballot(alpha != 1.0f) != 0ull) {
#pragma unroll
        for (int r = 0; r < 16; ++r) { st.o0[r] *= alpha; st.o1[r] *= alpha; } }
    const LAS bf16* v0 = Vt + q * AKP + 8 * h; const LAS bf16* v1 = v0 + 32 * AKP;
    st.o0 = mfma32(*(const LAS bf16x8*)v0, p00, st.o0); st.o1 = mfma32(*(const LAS bf16x8*)v1, p00, st.o1);
    st.o0 = mfma32(*(const LAS bf16x8*)(v0 + 16), p01, st.o0); st.o1 = mfma32(*(const LAS bf16x8*)(v1 + 16), p01, st.o1);
    st.o0 = mfma32(*(const LAS bf16x8*)(v0 + 32), p10, st.o0); st.o1 = mfma32(*(const LAS bf16x8*)(v1 + 32), p10, st.o1);
    st.o0 = mfma32(*(const LAS bf16x8*)(v0 + 48), p11, st.o0); st.o1 = mfma32(*(const LAS bf16x8*)(v1 + 48), p11, st.o1);
}

__device__ __forceinline__ u32x4 f8x8_bf16(u32x2 v) {
    const f32x2 a = __builtin_amdgcn_cvt_pk_f32_fp8((int)v.x, false), b = __builtin_amdgcn_cvt_pk_f32_fp8((int)v.x, true), c = __builtin_amdgcn_cvt_pk_f32_fp8((int)v.y, false), d = __builtin_amdgcn_cvt_pk_f32_fp8((int)v.y, true);
    u32x4 r; r.x = pg8::cvt_pk_bf16(a.x, a.y); r.y = pg8::cvt_pk_bf16(b.x, b.y); r.z = pg8::cvt_pk_bf16(c.x, c.y); r.w = pg8::cvt_pk_bf16(d.x, d.y); return r;
}
__device__ __forceinline__ void dil_attn_phase3(Frame& F) {
    LAS float* bt = (LAS float*)F.lds;
    { const float* btA = (const float*)(F.ws + WS_BTABA); for (int i = F.tid; i < 48 * 192; i += 512) { const int gh = i / 192, dl = 159 - i % 192; bt[i] = (dl >= 0 && dl <= 128) ? btA[gh * 132 + dl] : NEGB; } }
    constexpr int TBL = 48 * 192 * 4;
    const int lane = F.lane, q = lane & 31, h = lane >> 5, w = F.wave, uw = w >> 2, qt = w & 3, t = F.tid, tu = t >> 8, tt = t & 255, srow = tt >> 3, sch = tt & 7;
    const unsigned char* QK = F.ws + WS_SCR + S_QK; const unsigned char* VT = F.ws + WS_SCR + S_VT;
    bf16* OG = (bf16*)((unsigned char*)F.out + O_OG); float* LSE = (float*)((unsigned char*)F.out + O_LSE);
    const int sdst = srow * AKP + sch * 8;
    int du = F.vcu;
    if (du >= 3072) { __syncthreads(); return; }
    int g = du >> 10, hh = (du >> 6) & 15, blp = (du >> 4) & 3, rn = du & 15;
    int j = ((rn & ((16 >> (2 * g)) - 1)) != 0) ? 0 : 2;
    u32x2 k0, k1, v0, v1; u32x2 qn[4]; bf16x8 qf[4];
#define DIL_LOADS(G_, HH_, BLP_, RN_, J_) do { const int n0s_ = (2 * (BLP_) + tu) * 2048 + (RN_) * 128 - 128 + 64 * (J_); \
        const unsigned char* ks_ = QK + ((size_t)(G_) * TC + n0s_ + srow) * 2048 + 1024 + (HH_) * 64 + sch * 8; \
        const unsigned char* vs_ = VT + ((size_t)(G_) * 1024 + (HH_) * 64 + srow) * TC + n0s_ + sch * 8; \
        k0 = *(const u32x2*)ks_; k1 = *(const u32x2*)(ks_ + (size_t)32 * 2048); v0 = *(const u32x2*)vs_; v1 = *(const u32x2*)(vs_ + (size_t)32 * TC); } while (0)
#define DIL_QLOADS(G_, HH_, BLP_, RN_) do { const unsigned char* qr_ = QK + ((size_t)(G_) * TC + (2 * (BLP_) + uw) * 2048 + (RN_) * 128 + 32 * qt + q) * 2048 + (HH_) * 64; \
        _Pragma("unroll") for (int d0 = 0; d0 < 4; ++d0) qn[d0] = *(const u32x2*)(qr_ + d0 * 16 + 8 * h); } while (0)
#define DIL_WRITE(PB_) do { LAS bf16* kb_ = (LAS bf16*)(F.lds + TBL + ((PB_) * 2 + tu) * 2 * ATILE); LAS bf16* vb_ = kb_ + 64 * AKP; \
        *(LAS u32x4*)(kb_ + sdst) = f8x8_bf16(k0); *(LAS u32x4*)(kb_ + 32 * AKP + sdst) = f8x8_bf16(k1); *(LAS u32x4*)(vb_ + sdst) = f8x8_bf16(v0); *(LAS u32x4*)(vb_ + 32 * AKP + sdst) = f8x8_bf16(v1); } while (0)
    DIL_LOADS(g, hh, blp, rn, j); DIL_QLOADS(g, hh, blp, rn);
    DIL_WRITE(0);
#pragma unroll
    for (int d0 = 0; d0 < 4; ++d0) qf[d0] = __builtin_bit_cast(bf16x8, f8x8_bf16(qn[d0]));
    __syncthreads();
    AttnSt st; st.m = NEGB; st.l = 0.f; st.o0 = (f32x16){}; st.o1 = (f32x16){};
    int pb = 0;
    for (;;) {
        const bool last = (j == 3);
        int ng = g, nhh = hh, nblp = blp, nrn = rn, nj = j + 1; bool more = true;
        if (last) { const int nd = du + F.G; more = nd < 3072; ng = nd >> 10; nhh = (nd >> 6) & 15; nblp = (nd >> 4) & 3; nrn = nd & 15; nj = ((nrn & ((16 >> (2 * ng)) - 1)) != 0) ? 0 : 2; }
        if (more) { DIL_LOADS(ng, nhh, nblp, nrn, nj); if (last) DIL_QLOADS(ng, nhh, nblp, nrn); }
        { const LAS bf16* kb = (const LAS bf16*)(F.lds + TBL + (pb * 2 + uw) * 2 * ATILE); const LAS bf16* vb = kb + 64 * AKP;
          const int gh = g * 16 + hh, ta = 2 * j, tb = 2 * j + 1;
          const bool a_on = ta >= qt && ta <= qt + 4, b_on = tb >= qt && tb <= qt + 4;
          const LAS float* row = bt + gh * 192;
          const LAS float* ba = row + (168 - (32 + (32 * qt + q + 128 - 32 * ta - 8 * h - 23)));
          if (a_on || b_on) attn_tile2r(kb, vb, a_on ? ba : row + 160, b_on ? ba + 32 : row + 160, qf, st, q, h); }
        if (more) DIL_WRITE(pb ^ 1);
        if (last) {
            const float l_tot = xhalf_sum(st.l), inv = 1.f / l_tot;
            const size_t orow = (size_t)g * TC + (2 * blp + uw) * 2048 + rn * 128 + 32 * qt + q;
            attn_store8(st, (unsigned char*)OG + orow * 1024 + hh * 64 + 4 * h, inv * ASCALE8);
            if (h == 0) LSE[orow * 16 + hh] = st.m + __log2f(l_tot);
            st.m = NEGB; st.l = 0.f; st.o0 = (f32x16){}; st.o1 = (f32x16){};
#pragma unroll
            for (int d0 = 0; d0 < 4; ++d0) qf[d0] = __builtin_bit_cast(bf16x8, f8x8_bf16(qn[d0]));
        }
        __syncthreads();
        pb ^= 1;
        if (!more) break;
        if (last) du += F.G;
        g = ng; hh = nhh; blp = nblp; rn = nrn; j = nj;
    }
#undef DIL_LOADS
#undef DIL_QLOADS
#undef DIL_WRITE
}

__device__ __forceinline__ void moba_phase3(Frame& F) {
    constexpr int TBL = 8448, KMO = TBL + 4 * ATILE;
    LAS float* bt = (LAS float*)F.lds; LAS float* kml = (LAS float*)(F.lds + KMO);
    const int lane = F.lane, q = lane & 31, h = lane >> 5, w = F.wave, t = F.tid, srow = t >> 3, sch = t & 7;
    const bf16* QK = (const bf16*)(F.ws + WS_SCR + S_CQK); const bf16* VT = (const bf16*)(F.ws + WS_SCR + S_CVT);
    bf16* att = (bf16*)(F.ws + WS_SCR + S_CATT); const float* km = (const float*)(F.ws + WS_KMEAN);
    const int NP = NB * NH * 4, per = (NP + F.G - 1) / F.G;
    const int lo = F.vcu * per, hi = (lo + per) < NP ? (lo + per) : NP;
    const int nunits = 2 * (hi - lo);
    if (nunits <= 0) return;
    const int sdst = srow * AKP + sch * 8;
    int u = 0, cur_bh = -1;
    u32x4 kreg, vreg; bf16x8 qn[4], qf[4];
#define MB_LOADS(B_, HH_, S_) do { const bf16* ks_ = QK + ((size_t)(B_) * SEQ + 64 * (S_) + srow) * 2048 + 1024 + (HH_) * 64 + sch * 8; \
        const bf16* vs_ = VT + ((size_t)(HH_) * 64 + srow) * T + (size_t)(B_) * SEQ + 64 * (S_) + sch * 8; kreg = *(const u32x4*)ks_; vreg = *(const u32x4*)vs_; } while (0)
#define MB_QLOADS(B_, HH_, NB_) do { const bf16* qr_ = QK + ((size_t)(B_) * SEQ + (NB_) * 256 + 32 * w + q) * 2048 + (HH_) * 64; \
        _Pragma("unroll") for (int d0 = 0; d0 < 4; ++d0) qn[d0] = *(const bf16x8*)(qr_ + d0 * 16 + 8 * h); } while (0)
#define MB_WRITE(PB_) do { LAS bf16* kb_ = (LAS bf16*)(F.lds + TBL + (PB_) * 2 * ATILE); *(LAS u32x4*)(kb_ + sdst) = kreg; *(LAS u32x4*)(kb_ + 64 * AKP + sdst) = vreg; } while (0)
    int pu = lo, jj = pu & 3, hh = (pu >> 2) & 15, b = pu >> 6, nb = 7 - jj, s = 0, pb = 0;
    MB_LOADS(b, hh, 0); MB_QLOADS(b, hh, nb); MB_WRITE(0);
    unsigned sel = 0; bool fresh = true;
    AttnSt st; st.m = NEGB; st.l = 0.f; st.o0 = (f32x16){}; st.o1 = (f32x16){};
    for (;;) {
        if (fresh) {
            if (b * 16 + hh != cur_bh) { __syncthreads(); const float* btC = (const float*)(F.ws + WS_BTABC) + hh * 2048;
                for (int i = t; i < 2048 + 32; i += 512) bt[2079 - i] = i < 32 ? NEGB : btC[i - 32];
                { const float* kmp = km + ((size_t)b * NH + hh) * 512; kml[t] = kmp[t]; }
                cur_bh = b * 16 + hh; }
#pragma unroll
            for (int d0 = 0; d0 < 4; ++d0) qf[d0] = qn[d0];
            __syncthreads();
            sel = 0;
            if (nb > 0) {
                float gsc[7];
#pragma unroll
                for (int m = 0; m < 7; ++m) { float sc = 0.f;
                    if (m < nb) {
#pragma unroll
                        for (int d0 = 0; d0 < 4; ++d0) { const f32x4 c0 = *(const LAS f32x4*)(kml + m * 64 + d0 * 16 + 8 * h), c1 = *(const LAS f32x4*)(kml + m * 64 + d0 * 16 + 8 * h + 4); const u32x4 qq = __builtin_bit_cast(u32x4, qf[d0]);
                            sc += bflo(qq.x) * c0.x + bfhi(qq.x) * c0.y + bflo(qq.y) * c0.z + bfhi(qq.y) * c0.w + bflo(qq.z) * c1.x + bfhi(qq.z) * c1.y + bflo(qq.w) * c1.z + bfhi(qq.w) * c1.w; }
                        sc = xhalf_sum(sc); }
                    gsc[m] = m < nb ? sc : -3.0e38f; }
                const int nsel = nb < 3 ? nb : 3;
#pragma unroll
                for (int r = 0; r < 3; ++r) { if (r < nsel) { int bi = 0; float bv = -3.4e38f;
#pragma unroll
                        for (int m = 0; m < 7; ++m) if (!((sel >> m) & 1u) && gsc[m] > bv) { bv = gsc[m]; bi = m; }
                        sel |= 1u << bi; } }
            }
            fresh = false;
        }
        const int nsteps = 4 * nb + 4;
        const bool last = (s + 1 == nsteps);
        int nb2 = nb, b2 = b, hh2 = hh, s2 = s + 1; bool more = true;
        if (last) { const int u2 = u + 1; more = u2 < nunits; const int pu2 = lo + (u2 >> 1), j2 = pu2 & 3; hh2 = (pu2 >> 2) & 15; b2 = pu2 >> 6; nb2 = (u2 & 1) ? j2 : 7 - j2; s2 = 0; }
        if (more) { MB_LOADS(b2, hh2, s2); if (last) MB_QLOADS(b2, hh2, nb2); }
        { const LAS bf16* kb = (const LAS bf16*)(F.lds + TBL + pb * 2 * ATILE); const LAS bf16* vb = kb + 64 * AKP;
          const int qpos = nb * 256 + 32 * w + q;
          const LAS float* ba = bt + (2056 - (32 + (qpos - 8 * h - 64 * s - 23)));
          const LAS float* negp = bt + 2048;
          bool act; const LAS float* p0; const LAS float* p1;
          if (s < 4 * nb) { const bool mine = (sel >> (s >> 2)) & 1u; act = __ballot(mine) != 0ull; p0 = mine ? ba : negp; p1 = mine ? ba + 32 : negp; }
          else { const int ta = (s - 4 * nb) * 2; act = ta <= w; p0 = ba; p1 = (ta + 1 <= w) ? ba + 32 : negp; }
          if (act) attn_tile2r(kb, vb, p0, p1, qf, st, q, h); }
        if (more) MB_WRITE(pb ^ 1);
        if (last) {
            const float l_tot = xhalf_sum(st.l), inv = 1.f / l_tot;
            const size_t tq = (size_t)b * SEQ + nb * 256 + 32 * w + q;
            attn_store8(st, (unsigned char*)att + tq * 1024 + hh * 64 + 4 * h, inv * ASCALE8);
            st.m = NEGB; st.l = 0.f; st.o0 = (f32x16){}; st.o1 = (f32x16){};
        }
        if (!last) __syncthreads();
        pb ^= 1;
        if (!more) break;
        if (last) { ++u; fresh = true; }
        nb = nb2; b = b2; hh = hh2; s = s2;
    }
#undef MB_LOADS
#undef MB_QLOADS
#undef MB_WRITE
}

__device__ __forceinline__ void gmlp_phase(Frame& F, const float* lng, const float* lnb, const float* bs) {
    const int lane = F.lane, w = F.wave, q = lane & 31, h = lane >> 5;
    const bf16* uv = (const bf16*)(F.ws + WS_SCR + S_UV); bf16* p = (bf16*)(F.ws + WS_SCR + S_P); const bf16* wst = (const bf16*)(F.ws + WS_WST);
    LAS float* stat = (LAS float*)F.lds;
    LAS bf16* vnT = (LAS bf16*)(F.lds + 1024);
    constexpr int VP = 136;
    for (int unit = F.vcu; unit < T / 128; unit += F.G) {
        const size_t t0 = (size_t)unit * 128;
        __syncthreads();
        for (int i = 0; i < 16; ++i) { const int r = w * 16 + i; const u32x4* vr = (const u32x4*)(uv + (t0 + r) * 2048 + 1024) + lane;
            const u32x4 a = vr[0], b = vr[64]; float x[16];
            x[0] = bflo(a.x); x[1] = bfhi(a.x); x[2] = bflo(a.y); x[3] = bfhi(a.y); x[4] = bflo(a.z); x[5] = bfhi(a.z); x[6] = bflo(a.w); x[7] = bfhi(a.w);
            x[8] = bflo(b.x); x[9] = bfhi(b.x); x[10] = bflo(b.y); x[11] = bfhi(b.y); x[12] = bflo(b.z); x[13] = bfhi(b.z); x[14] = bflo(b.w); x[15] = bfhi(b.w);
            float s = 0.f;
#pragma unroll
            for (int j = 0; j < 16; ++j) s += x[j];
            const float mean = wave_sum(s) * (1.f / 1024.f); float s2 = 0.f;
#pragma unroll
            for (int j = 0; j < 16; ++j) { const float d = x[j] - mean; s2 += d * d; }
            const float rstd = 1.f / sqrtf(wave_sum(s2) * (1.f / 1024.f) + LN_EPS);
            if (lane == 0) { stat[2 * r] = mean; stat[2 * r + 1] = rstd; } }
        __syncthreads();
        for (int gg = 0; gg < 8; ++gg) {
#pragma unroll
            for (int k = 0; k < 4; ++k) { const int id = F.tid + 512 * k, s = id >> 4, cc = (id & 15) * 8;
                const u32x4 a = *(const u32x4*)(uv + (t0 + s) * 2048 + 1024 + gg * 128 + cc); const float mean = stat[2 * s], rstd = stat[2 * s + 1];
                float x[8]; x[0] = bflo(a.x); x[1] = bfhi(a.x); x[2] = bflo(a.y); x[3] = bfhi(a.y); x[4] = bflo(a.z); x[5] = bfhi(a.z); x[6] = bflo(a.w); x[7] = bfhi(a.w);
#pragma unroll
                for (int j = 0; j < 8; ++j) { const int c = gg * 128 + cc + j; const float y = (x[j] - mean) * rstd * lng[c] + lnb[c]; vnT[(cc + j) * VP + s] = (bf16)f2bf(y); } }
            __syncthreads();
            const int cr = 32 * (w & 3), tc0 = 64 * (w >> 2);
            f32x16 acc0 = {}, acc1 = {};
#pragma unroll
            for (int ks = 0; ks < 8; ++ks) {
                const bf16x8 af = *(const LAS bf16x8*)(vnT + (cr + q) * VP + ks * 16 + 8 * h);
                const bf16x8 b0 = *(const bf16x8*)(wst + ((size_t)gg * 128 + tc0 + q) * 128 + ks * 16 + 8 * h);
                const bf16x8 b1 = *(const bf16x8*)(wst + ((size_t)gg * 128 + tc0 + 32 + q) * 128 + ks * 16 + 8 * h);
                acc0 = mfma32(af, b0, acc0); acc1 = mfma32(af, b1, acc1);
            }
#pragma unroll
            for (int tt = 0; tt < 2; ++tt) { const f32x16& ac = tt == 0 ? acc0 : acc1; const int tl = tc0 + 32 * tt + q; const float bsv = bs[gg * 128 + tl];
                const size_t rowu = (t0 + tl) * 2048, rowp = (t0 + tl) * 1024;
#pragma unroll
                for (int gq = 0; gq < 4; ++gq) { const int c = gg * 128 + cr + 8 * gq + 4 * h; const u32x2 uu = *(const u32x2*)(uv + rowu + c);
                    u32x2 o; o.x = pk2(bflo(uu.x) * (ac[4 * gq] + bsv), bfhi(uu.x) * (ac[4 * gq + 1] + bsv)); o.y = pk2(bflo(uu.y) * (ac[4 * gq + 2] + bsv), bfhi(uu.y) * (ac[4 * gq + 3] + bsv));
                    *(u32x2*)(p + rowp + c) = o; } }
            __syncthreads();
        }
    }
}

struct MoeSeg { int ts[9]; };
__device__ __forceinline__ MoeSeg moe_seg(Frame& F, int moe_l) {
    MoeSeg s; int acc = 0;
#pragma unroll
    for (int e = 0; e < 8; ++e) { s.ts[e] = acc; const unsigned c = __hip_atomic_load((unsigned*)(F.ctl + CW_ECNT + 64 * moe_l + e), RLX_AGENT); acc += (int)((c + 255u) >> 8); }
    s.ts[8] = acc; return s;
}
__device__ __forceinline__ void moe_gather_phase(Frame& F, int moe_l) {
    LAS int* P = (LAS int*)F.lds;
    LAS int* wtot = (LAS int*)(F.lds + 65536);
    LAS int* tot = wtot + 64;
    const int* wcnt = (const int*)(F.ws + WS_WCNT);
    int t = F.tid; asm volatile("" : "+v"(t));
    const int lane = F.lane;
    int loc[4][8], sum[8], inc[8];
#pragma unroll
    for (int k = 0; k < 4; ++k) { const u32x4 a = *(const u32x4*)(wcnt + (4 * t + k) * 8), b = *(const u32x4*)(wcnt + (4 * t + k) * 8 + 4);
        loc[k][0] = (int)a.x; loc[k][1] = (int)a.y; loc[k][2] = (int)a.z; loc[k][3] = (int)a.w; loc[k][4] = (int)b.x; loc[k][5] = (int)b.y; loc[k][6] = (int)b.z; loc[k][7] = (int)b.w; }
#pragma unroll
    for (int e = 0; e < 8; ++e) { sum[e] = (loc[0][e] + loc[1][e]) + (loc[2][e] + loc[3][e]); inc[e] = sum[e]; }
#pragma unroll
    for (int off = 1; off < 64; off <<= 1) {
#pragma unroll
        for (int e = 0; e < 8; ++e) { const int v = __shfl_up(inc[e], off); if (lane >= off) inc[e] += v; } }
    if (lane == 63) {
#pragma unroll
        for (int e = 0; e < 8; ++e) wtot[F.wave * 8 + e] = inc[e]; }
    __syncthreads();
    int run[8];
#pragma unroll
    for (int e = 0; e < 8; ++e) { int wb = 0; for (int w = 0; w < F.wave; ++w) wb += wtot[w * 8 + e]; run[e] = wb + inc[e] - sum[e]; }
#pragma unroll
    for (int k = 0; k < 4; ++k) {
#pragma unroll
        for (int e = 0; e < 8; ++e) { P[(4 * t + k) * 8 + e] = run[e]; run[e] += loc[k][e]; } }
    if (t == 511) {
#pragma unroll
        for (int e = 0; e < 8; ++e) tot[e] = run[e]; }
    __syncthreads();
    MoeSeg sg; { int acc = 0;
#pragma unroll
        for (int e = 0; e < 8; ++e) { sg.ts[e] = acc; acc += (tot[e] + 255) >> 8; } sg.ts[8] = acc; }
    if (blockIdx.x == 0 && t < 8) __hip_atomic_store((unsigned*)(F.ctl + CW_ECNT + 64 * moe_l + t), (unsigned)tot[t], RLX_AGENT);
    const int gw = F.vcu * NWAVES + F.wave, NGW = F.G * NWAVES;
    const bf16* hb = (const bf16*)(F.ws + WS_HB); unsigned char* xg8 = (unsigned char*)F.out;
    const int* route = (const int*)(F.ws + WS_ROUTE); int* slots = (int*)(F.ws + WS_SLOTS);
    for (int m0 = 4 * gw; m0 < T; m0 += 4 * NGW) {
        int s1[4], s2[4]; u32x4 a[4], b[4];
#pragma unroll
        for (int k = 0; k < 4; ++k) { const int m = m0 + k, grp = m >> 5;
            const int e1 = route[4 * m], p1 = route[4 * m + 1], e2 = route[4 * m + 2], p2 = route[4 * m + 3];
            int ts1 = 0, ts2 = 0;
#pragma unroll
            for (int e = 0; e < 8; ++e) { ts1 = e == e1 ? sg.ts[e] : ts1; ts2 = e == e2 ? sg.ts[e] : ts2; }
            s1[k] = ts1 * 256 + P[grp * 8 + e1] + p1; s2[k] = ts2 * 256 + P[grp * 8 + e2] + p2;
            const u32x4* src = (const u32x4*)(hb + (size_t)m * D) + lane; a[k] = src[0]; b[k] = src[64]; }
#pragma unroll
        for (int k = 0; k < 4; ++k) { const int m = m0 + k;
            float x[16]; unpack8(a[k], x); unpack8(b[k], x + 8);
            u32x2 lo, hi; lo.x = pk4_fp8(x[0], x[1], x[2], x[3]); lo.y = pk4_fp8(x[4], x[5], x[6], x[7]); hi.x = pk4_fp8(x[8], x[9], x[10], x[11]); hi.y = pk4_fp8(x[12], x[13], x[14], x[15]);
            unsigned char* d1 = xg8 + (size_t)s1[k] * D + 8 * lane; unsigned char* d2 = xg8 + (size_t)s2[k] * D + 8 * lane;
            *(u32x2*)d1 = lo; *(u32x2*)(d1 + 512) = hi; *(u32x2*)d2 = lo; *(u32x2*)(d2 + 512) = hi;
            if (lane == 0) { slots[2 * m] = s1[k]; slots[2 * m + 1] = s2[k]; } }
    }
}
struct MoeOrder {
    int nM, nN, G, c, tile0; MoeSeg sg; const char* A0; const char* B0; size_t aT, bE, bT; bool a_local;
    bool out_local;
    __device__ __forceinline__ bool next(int i, pg8::Unit& u) const {
        int pm, pn; if (!pg8::tile_of((long)i * G + c, nM, nN, pm, pn)) return false;
        const int tile = tile0 + pm; int e = 0;
#pragma unroll
        for (int k = 1; k < 8; ++k) e += (tile >= sg.ts[k]) ? 1 : 0;
        u.pm = out_local ? pm : tile; u.pn = pn; u.a = (unsigned)((size_t)(a_local ? pm : tile) * aT); u.b = (unsigned)((size_t)e * bE + (size_t)pn * bT); return true;
    }
};


template <int GI> struct L0QKOrder { int G, c; const char* A0; const char* B0;
    __device__ __forceinline__ bool next(int i, pg8::Unit& u) const { if (!pg8::tile_of((long)i * G + c, 64, 8, u.pm, u.pn)) return false; const int pm = u.pm;
        const int tok = GI == 0 ? pm * 256 : (GI == 1 ? (pm >> 3) * 2048 + (pm & 1) * 1024 + ((pm >> 1) & 3) : (pm >> 3) * 2048 + (pm & 7) * 2);
        u.a = (unsigned)tok * 1024u; u.b = (unsigned)u.pn * 256u * 1024u; return true; } };
template <int GI> struct L0VtOrder { int G, c; const char* A0; const char* B0;
    __device__ __forceinline__ bool next(int i, pg8::Unit& u) const { if (!pg8::tile_of((long)i * G + c, 4, 64, u.pm, u.pn)) return false; const int pn = u.pn;
        const int tok = GI == 0 ? pn * 256 : (GI == 1 ? (pn >> 3) * 2048 + (pn & 1) * 1024 + ((pn >> 1) & 3) : (pn >> 3) * 2048 + (pn & 7) * 2);
        u.a = (unsigned)u.pm * 256u * 1024u; u.b = (unsigned)tok * 1024u; return true; } };
template <int GI> __device__ __forceinline__ void l0_gemms(Frame& F, int ck, int bx) {
    constexpr int rs = GI == 0 ? 1 : (GI == 1 ? 4 : 16);
    constexpr size_t hst = (GI == 0 ? (size_t)128 : (GI == 1 ? (size_t)512 : (size_t)1)) * 1024;
    const char* hbc = (const char*)(F.ws + WS_SCR + S_HB8) + (size_t)ck * TC * 1024;
    unsigned char* scr = F.ws + WS_SCR;
    { L0QKOrder<GI> S{F.G, bx, hbc, (const char*)(F.ws + W_A_QK) + (size_t)GI * 2048 * 1024};
      pg8::Gemm gm{512, rs, 1, hst, (size_t)128 * 1024};
      pg8::EpiF8 E{scr + S_QK + (size_t)GI * TC * 2048, 2048, 1.f / WSCALE8};
      pg8::gemm_phase<pg8::EpiF8, L0QKOrder<GI>, false, 1>(F.lds, F.wave, gm, S, E); }
    { L0VtOrder<GI> S{F.G, bx, (const char*)(F.ws + W_A_V) + (size_t)GI * 1024 * 1024, hbc};
      pg8::Gemm gm{512, 1, rs, (size_t)128 * 1024, hst};
      pg8::EpiF8 E{scr + S_VT + (size_t)GI * 1024 * TC, TC, 1.f / WSCALE8};
      pg8::gemm_phase<pg8::EpiF8, L0VtOrder<GI>, false, 1>(F.lds, F.wave, gm, S, E); }
}


#ifdef MK_SELFCHECK
__device__ __forceinline__ void selfcheck_buf(Frame& F, const void* ptr, size_t nbytes, int stage, int slot0) {
    if (!F.chk) return;
    const int gw = F.vcu * NWAVES + F.wave, NGW = F.G * NWAVES; unsigned* cks = (unsigned*)(F.ws + WS_NEED + 2 * MiB) + slot0;
    const int nch = (int)(nbytes >> 12);
    for (int c = gw; c < nch; c += NGW) { const u32x4* r = (const u32x4*)((const char*)ptr + ((size_t)c << 12)) + F.lane; unsigned x = 0;
#pragma unroll
        for (int j = 0; j < 4; ++j) { const u32x4 v = r[64 * j]; x ^= v.x * 3u + v.y * 5u + v.z * 7u + v.w * 11u + (unsigned)j; }
        x *= (unsigned)(2 * F.lane + 1);
#pragma unroll
        for (int o = 1; o < 64; o <<= 1) x ^= __shfl_xor(x, o);
        if (F.lane == 0) { if (F.chk == 1) cks[c] = x; else if (cks[c] != x) atomicMax((unsigned*)(F.ctl + 32), (unsigned)(1000 - stage)); } }
}
#endif

__global__ void __launch_bounds__(NWAVES * 64, 2) mk_fwd(Args args) {
    extern __shared__ __attribute__((aligned(16))) unsigned char lds[];
    Frame F;
    F.lds = (LAS unsigned char*)lds;
    F.tid = threadIdx.x; F.lane = F.tid & 63; F.wave = __builtin_amdgcn_readfirstlane(F.tid >> 6);
    F.G = gridDim.x; { const int bx = blockIdx.x; F.vcu = (F.G % 8 == 0) ? (bx % 8) * (F.G / 8) + bx / 8 : bx; }
    F.ws = args.ws; F.ctl = (gu32*)(args.ws + WS_CTL); F.out = args.out; F.chk = args.chk; F.stage = 0;
    volatile LAS unsigned* MISC = (volatile LAS unsigned*)(F.lds + MISC_OFF);
    for (int u = F.tid; u < (LDS_BYTES - RING_BYTES) / 4; u += NWAVES * 64) ((LAS unsigned*)(F.lds + RING_BYTES))[u] = 0u;
    __syncthreads();
    XcdBarrier bar; bar.bar = (unsigned*)(F.ctl + CW_BAR); bar.x = 0; bar.st = nullptr;
    if (!MK_MULTI) bar = xcd_barrier_post((unsigned*)(F.ctl + CW_BAR), MISC + 8);
    const int lo = args.ph_lo, hi = args.ph_hi;
    int ph = 0;
#define PHASE_BEGIN if (ph >= lo && ph < hi) { F.lane = (int)__builtin_amdgcn_mbcnt_hi(~0u, __builtin_amdgcn_mbcnt_lo(~0u, 0u)); asm volatile("" : "+v"(F.lane)); F.tid = F.wave * 64 + F.lane;
#define PHASE_END   if (!MK_MULTI && ph + 1 < hi) xcd_barrier(bar, F.tid); } ++ph;
    const int bx = (int)blockIdx.x;
#define scr (args.ws + WS_SCR)
#define hb ((const bf16*)(args.ws + WS_HB))
#define ln_g (args.in[2])
#define ln_b (args.in[3])

    PHASE_BEGIN p_prologue(F, args); if (MK_PROBE & 8) p_prologue(F, args); PHASE_END

    if (MK_ENABLE & 1) {
#define L0_CHUNK(ck) \
        PHASE_BEGIN \
        if ((ck) > 0) dil_merge_phase(F, (ck) - 1); \
        l0_gemms<0>(F, (ck), bx); l0_gemms<1>(F, (ck), bx); l0_gemms<2>(F, (ck), bx); \
        PHASE_END \
        PHASE_BEGIN dil_attn_phase3(F); if (MK_PROBE & 1) dil_attn_phase3(F); PHASE_END
        L0_CHUNK(0) L0_CHUNK(1) L0_CHUNK(2) L0_CHUNK(3)
#undef L0_CHUNK
        PHASE_BEGIN dil_merge_phase(F, 3); if (MK_PROBE & 4) { dil_merge_phase(F, 3); dil_merge_phase(F, 3); dil_merge_phase(F, 3); dil_merge_phase(F, 3); } PHASE_END
        PHASE_BEGIN
        { pg8::LinOrder S{T / 256, 4, F.G, bx, (const char*)(scr + S_ATT), (const char*)(F.ws + W_A_O), (size_t)256 * 1024, (size_t)256 * 1024};
          pg8::Gemm gm{512, 1, 1, (size_t)128 * 1024, (size_t)128 * 1024};
          pg8::EpiResLn<FFN_GU8 == 0> E{(bf16*)(F.ws + WS_HB), ln_g + 0 * 2048, ln_b + 0 * 2048, ALPHA, 1.f / (WSCALE8 * ASCALE8), (float*)scr, (unsigned*)(F.ctl + CW_LNC + 0 * 4096), (unsigned*)(F.ctl + CW_BAR) + XB_TMO, scr + S_HB8, F.lds + LNT_OFF};
          pg8::gemm_phase<pg8::EpiResLn<FFN_GU8 == 0>, pg8::LinOrder, true, 1>(F.lds, F.wave, gm, S, E); }
        PHASE_END
    } else {
        PHASE_BEGIN ln_phase<1, false, false>(F, ln_g + 0 * 2048, ln_b + 0 * 2048, nullptr); PHASE_END
    }
#define DENSE_FFN(f, lnidx, enbit) \
    if (MK_ENABLE & (enbit)) { \
        PHASE_BEGIN \
        if ((f) == FFN_GU8) { \
          pg8::LinOrder S{T / 256, 2 * DFF / 256, F.G, bx, (const char*)(scr + S_HB8), (const char*)(F.ws + W_F_GU) + (size_t)(f) * 2 * DFF * 2048, (size_t)256 * 1024, (size_t)256 * 1024}; \
          pg8::Gemm gm{512, 1, 1, (size_t)128 * 1024, (size_t)128 * 1024};     \
          pg8::EpiSwiglu8 E{(unsigned char*)(scr + S_HID), DFF, 1.f / WSCALE8}; \
          pg8::gemm_phase<pg8::EpiSwiglu8, pg8::LinOrder, true, 1>(F.lds, F.wave, gm, S, E); \
        } else { pg8::LinOrder S{T / 256, 2 * DFF / 256, F.G, bx, (const char*)hb, (const char*)(F.ws + W_F_GU) + (size_t)(f) * 2 * DFF * 2048, (size_t)256 * 2048, (size_t)256 * 2048}; \
          pg8::Gemm gm{1024, 1, 1, (size_t)128 * 2048, (size_t)128 * 2048}; \
          pg8::EpiSwiglu8 E{(unsigned char*)(scr + S_HID), DFF}; \
          pg8::gemm_phase(F.lds, F.wave, gm, S, E); } \
        PHASE_END \
        PHASE_BEGIN \
        { pg8::LinOrder S{T / 256, 4, F.G, bx, (const char*)(scr + S_HID), (const char*)(F.ws + W_F_D) + (size_t)(f) * 1024 * DFF * 2, (size_t)256 * DFF, (size_t)256 * DFF}; \
          pg8::Gemm gm{DFF / 2, 1, 1, (size_t)128 * DFF, (size_t)128 * DFF};     \
          pg8::EpiResLn<false> E{(bf16*)(F.ws + WS_HB), ln_g + (lnidx) * 1024, ln_b + (lnidx) * 1024, ALPHA, 1.f / WSCALE8D, (float*)(scr + S_Y), (unsigned*)(F.ctl + CW_LNC + (2 + (f)) * 4096), (unsigned*)(F.ctl + CW_BAR) + XB_TMO, nullptr, F.lds + LNT_OFF}; \
          pg8::gemm_phase<pg8::EpiResLn<false>, pg8::LinOrder, true, 1>(F.lds, F.wave, gm, S, E); }     \
        PHASE_END \
    } else { \
        PHASE_BEGIN ln_phase<1, false, false>(F, ln_g + (lnidx) * 1024, ln_b + (lnidx) * 1024, nullptr); PHASE_END \
    }
    DENSE_FFN(0, 1, 2)

    if (MK_ENABLE & 4) {
        PHASE_BEGIN
        { pg8::LinOrder S{T / 256, 4, F.G, bx, (const char*)hb, (const char*)(F.ws + W_B_IN), (size_t)256 * 2048, (size_t)256 * 2048};
          pg8::Gemm gm{1024, 1, 1, (size_t)128 * 2048, (size_t)128 * 2048};
          pg8::EpiBf16<0> E{(bf16*)(scr + S_BCX), 1024};
          pg8::gemm_phase(F.lds, F.wave, gm, S, E); }
        { pg8::LinOrder S{T / 256, 8, F.G, bx, (const char*)hb, (const char*)(F.ws + W_B_IN) + (size_t)1024 * 2048, (size_t)256 * 2048, (size_t)256 * 2048};
          pg8::Gemm gm{1024, 1, 1, (size_t)128 * 2048, (size_t)128 * 2048};
          pg8::EpiGlu<0> E{(bf16*)(scr + S_BCX + (size_t)128 * MiB), 1024};
          pg8::gemm_phase(F.lds, F.wave, gm, S, E); }
        PHASE_END
        PHASE_BEGIN conv_phase(F, args.in[7]); if (MK_PROBE & 4) conv_phase(F, args.in[7]); PHASE_END
        PHASE_BEGIN
        { pg8::LinOrder S{T / 256, 4, F.G, bx, (const char*)(scr + S_P), (const char*)(F.ws + W_B_O), (size_t)256 * 2048, (size_t)256 * 2048};
          pg8::Gemm gm{1024, 1, 1, (size_t)128 * 2048, (size_t)128 * 2048};
          pg8::EpiResBf16 E{hb, (bf16*)F.out, 1024, ALPHA};
          pg8::gemm_phase(F.lds, F.wave, gm, S, E); }
        PHASE_END
        PHASE_BEGIN ln_phase<0, true, false>(F, ln_g + 2 * 1024, ln_b + 2 * 1024, args.in[20]); PHASE_END
    } else {
        PHASE_BEGIN ln_phase<1, true, false>(F, ln_g + 2 * 1024, ln_b + 2 * 1024, args.in[20]); PHASE_END
    }
#define MOE_CHUNK(f, ck) \
        PHASE_BEGIN \
        { const MoeSeg sg = moe_seg(F, (f)); int nM = sg.ts[8] - (ck) * MOE_CH_TILES; nM = nM > MOE_CH_TILES ? MOE_CH_TILES : (nM < 0 ? 0 : nM); \
          MoeOrder S{nM, 2 * DFE / 256, F.G, bx, (ck) * MOE_CH_TILES, sg, (const char*)F.out, (const char*)(F.ws + W_E_GU) + (size_t)(f) * 8 * 2 * DFE * 2048, (size_t)256 * 1024, (size_t)2 * DFE * 2048, (size_t)256 * 1024, false, true}; \
          pg8::Gemm gm{512, 1, 1, (size_t)128 * 1024, (size_t)128 * 1024};     \
          pg8::EpiSwiglu8 E{(unsigned char*)(scr + S_MHID), DFE, 1.f / WSCALE8}; \
          pg8::gemm_phase<pg8::EpiSwiglu8, MoeOrder, true, 0x7C>(F.lds, F.wave, gm, S, E);     if ((ck) == 0 && (MK_PROBE & 32)) pg8::gemm_phase(F.lds, F.wave, gm, S, E); } \
        PHASE_END \
        PHASE_BEGIN \
        { const MoeSeg sg = moe_seg(F, (f)); int nM = sg.ts[8] - (ck) * MOE_CH_TILES; nM = nM > MOE_CH_TILES ? MOE_CH_TILES : (nM < 0 ? 0 : nM); \
          MoeOrder S{nM, 4, F.G, bx, (ck) * MOE_CH_TILES, sg, (const char*)(scr + S_MHID), (const char*)(F.ws + W_E_D) + (size_t)(f) * 8 * 1024 * DFE * 2, (size_t)256 * DFE, (size_t)1024 * DFE * 2, (size_t)256 * DFE, true, false}; \
          pg8::Gemm gm{DFE / 2, 1, 1, (size_t)128 * DFE, (size_t)128 * DFE};     \
          pg8::EpiBf16<0> E{(bf16*)(scr + S_XG), 1024, 1.f / WSCALE8D}; \
          pg8::gemm_phase<pg8::EpiBf16<0>, MoeOrder, true, 0x7B>(F.lds, F.wave, gm, S, E);     if ((ck) == 0 && (MK_PROBE & 64)) pg8::gemm_phase(F.lds, F.wave, gm, S, E); } \
        PHASE_END
#define MOE_FFN(f, lnidx, enbit, fin) \
    if (MK_ENABLE & (enbit)) { \
        PHASE_BEGIN moe_gather_phase(F, (f)); if (MK_PROBE & 4) moe_gather_phase(F, (f)); PHASE_END \
        MOE_CHUNK(f, 0) MOE_CHUNK(f, 1) MOE_CHUNK(f, 2) \
        PHASE_BEGIN ln_phase<2, false, fin>(F, ln_g + (lnidx) * 1024, ln_b + (lnidx) * 1024, nullptr); PHASE_END \
    } else { \
        PHASE_BEGIN ln_phase<1, false, fin>(F, ln_g + (lnidx) * 1024, ln_b + (lnidx) * 1024, nullptr); PHASE_END \
    }
    MOE_FFN(0, 3, 8, false)

    if (MK_ENABLE & 16) {
        PHASE_BEGIN
        { pg8::LinOrder S{T / 256, 8, F.G, bx, (const char*)hb, (const char*)(F.ws + W_C_QK), (size_t)256 * 2048, (size_t)256 * 2048};
          pg8::Gemm gm{1024, 1, 1, (size_t)128 * 2048, (size_t)128 * 2048};
          pg8::EpiBf16<0> E{(bf16*)(scr + S_CQK), 2048};
          pg8::gemm_phase(F.lds, F.wave, gm, S, E); }
        { pg8::LinOrder S{4, T / 256, F.G, bx, (const char*)(F.ws + W_C_V), (const char*)hb, (size_t)256 * 2048, (size_t)256 * 2048};
          pg8::Gemm gm{1024, 1, 1, (size_t)128 * 2048, (size_t)128 * 2048};
          pg8::EpiBf16<0> E{(bf16*)(scr + S_CVT), T};
          pg8::gemm_phase(F.lds, F.wave, gm, S, E); }
        PHASE_END
#ifdef MK_SELFCHECK
        PHASE_BEGIN selfcheck_buf(F, scr + S_CQK, (size_t)256 * MiB, 40, 0); selfcheck_buf(F, scr + S_CVT, (size_t)128 * MiB, 41, 65536); PHASE_END
#endif
        PHASE_BEGIN kmean_phase(F); if (MK_PROBE & 4) kmean_phase(F); PHASE_END
#ifdef MK_SELFCHECK
        PHASE_BEGIN selfcheck_buf(F, F.ws + WS_KMEAN, (size_t)1 * MiB, 42, 65536 + 32768); PHASE_END
#endif
        PHASE_BEGIN moba_phase3(F); if (MK_PROBE & 2) moba_phase3(F); PHASE_END
#ifdef MK_SELFCHECK
        PHASE_BEGIN selfcheck_buf(F, F.ws + WS_NEED + 3 * MiB, (size_t)4 * MiB, 43, 65536 + 32768 + 256); selfcheck_buf(F, F.ws + WS_NEED + 7 * MiB, (size_t)4 * MiB, 44, 65536 + 32768 + 256 + 1024);
                    selfcheck_buf(F, scr + S_CATT, (size_t)128 * MiB, 45, 65536 + 32768 + 256 + 2048); PHASE_END
#endif
        PHASE_BEGIN
        { pg8::LinOrder S{T / 256, 4, F.G, bx, (const char*)(scr + S_CATT), (const char*)(F.ws + W_C_O), (size_t)256 * 1024, (size_t)256 * 1024};
          pg8::Gemm gm{512, 1, 1, (size_t)128 * 1024, (size_t)128 * 1024};
          pg8::EpiResLn<FFN_GU8 == 1> E{(bf16*)(F.ws + WS_HB), ln_g + 4 * 1024, ln_b + 4 * 1024, ALPHA, 1.f / (WSCALE8 * ASCALE8), (float*)scr, (unsigned*)(F.ctl + CW_LNC + 1 * 4096), (unsigned*)(F.ctl + CW_BAR) + XB_TMO, scr + S_HB8, F.lds + LNT_OFF};
          pg8::gemm_phase<pg8::EpiResLn<FFN_GU8 == 1>, pg8::LinOrder, true, 1>(F.lds, F.wave, gm, S, E); }
        PHASE_END
    } else {
        PHASE_BEGIN ln_phase<1, false, false>(F, ln_g + 4 * 1024, ln_b + 4 * 1024, nullptr); PHASE_END
    }
    DENSE_FFN(1, 5, 32)

    if (MK_ENABLE & 64) {
        PHASE_BEGIN
        { pg8::LinOrder S{T / 256, 8, F.G, bx, (const char*)hb, (const char*)(F.ws + W_D_IN), (size_t)256 * 2048, (size_t)256 * 2048};
          pg8::Gemm gm{1024, 1, 1, (size_t)128 * 2048, (size_t)128 * 2048};
          pg8::EpiBf16<1> E{(bf16*)(scr + S_UV), 2048};
          pg8::gemm_phase(F.lds, F.wave, gm, S, E); }
        PHASE_END
        PHASE_BEGIN gmlp_phase(F, args.in[12], args.in[13], args.in[15]); if (MK_PROBE & 4) gmlp_phase(F, args.in[12], args.in[13], args.in[15]); PHASE_END
        PHASE_BEGIN
        { pg8::LinOrder S{T / 256, 4, F.G, bx, (const char*)(scr + S_P), (const char*)(F.ws + W_D_O), (size_t)256 * 2048, (size_t)256 * 2048};
          pg8::Gemm gm{1024, 1, 1, (size_t)128 * 2048, (size_t)128 * 2048};
          pg8::EpiResBf16 E{hb, (bf16*)F.out, 1024, ALPHA};
          pg8::gemm_phase(F.lds, F.wave, gm, S, E); }
        PHASE_END
        PHASE_BEGIN ln_phase<0, true, false>(F, ln_g + 6 * 1024, ln_b + 6 * 1024, args.in[20] + 8192); PHASE_END
    } else {
        PHASE_BEGIN ln_phase<1, true, false>(F, ln_g + 6 * 1024, ln_b + 6 * 1024, args.in[20] + 8192); PHASE_END
    }
    MOE_FFN(1, 7, 128, true)
#ifdef MK_SELFCHECK
    PHASE_BEGIN
    { const unsigned fl = __hip_atomic_load((unsigned*)(F.ctl + 32), RLX_AGENT);
      if (fl != 0u) { const int code = 1000 - (int)fl; const float cval = (code >= 40 && code <= 45) ? (float)(20 + 2 * (code - 40)) : (float)(1u << (code / 10 + 1)); const int gw = F.vcu * NWAVES + F.wave, NGW = F.G * NWAVES;
          for (int m = gw; m < T; m += NGW) { f32x4* w = (f32x4*)(F.out + (size_t)m * D) + F.lane;
#pragma unroll
              for (int j = 0; j < 4; ++j) w[64 * j] = (f32x4){cval, cval, cval, cval}; } } }
    PHASE_END
#endif
#undef PHASE_BEGIN
#undef PHASE_END
#undef scr
#undef hb
#undef ln_g
#undef ln_b
}

static int count_phases() {
    int n = 1;
    n += (MK_ENABLE & 1) ? (8 + 1 + 1) : 1;
    n += (MK_ENABLE & 2) ? 2 : 1;
    n += (MK_ENABLE & 4) ? 4 : 1;
    n += (MK_ENABLE & 8) ? 8 : 1;
    n += (MK_ENABLE & 16) ? 4 : 1;
    n += (MK_ENABLE & 32) ? 2 : 1;
    n += (MK_ENABLE & 64) ? 4 : 1;
    n += (MK_ENABLE & 128) ? 8 : 1;
#ifdef MK_SELFCHECK
    n += 1 + 3;
#endif
    return n;
}
extern "C" void kernel_launch(void* const* d_in, const int* in_sizes, int n_in, void* d_out, int out_size, void* d_ws, size_t ws_size, hipStream_t stream) {
    static int grid = 0;
    if (grid == 0) {
        if (n_in != 24 || in_sizes[0] != T * D || out_size != T * D || ws_size < WS_NEED) { fprintf(stderr, "kernel_launch: unexpected shapes (n_in %d, in0 %d, out %d, ws %zu < %zu); nothing launched\n", n_in, n_in > 0 ? in_sizes[0] : -1, out_size, ws_size, (size_t)WS_NEED); grid = -1; return; }
        int dev = 0, cus = 0, per_cu = 0;
        if (hipGetDevice(&dev) != hipSuccess || hipDeviceGetAttribute(&cus, hipDeviceAttributeMultiprocessorCount, dev) != hipSuccess) { grid = -1; return; }
        if (hipFuncSetAttribute((const void*)mk_fwd, hipFuncAttributeMaxDynamicSharedMemorySize, LDS_BYTES) != hipSuccess) { fprintf(stderr, "kernel_launch: hipFuncSetAttribute failed\n"); grid = -1; return; }
        if (hipOccupancyMaxActiveBlocksPerMultiprocessor(&per_cu, (const void*)mk_fwd, NWAVES * 64, LDS_BYTES) != hipSuccess || per_cu < 1) fprintf(stderr, "kernel_launch: occupancy query reports %d\n", per_cu);
        (void)hipGetLastError();
        grid = cus;
    }
    if (grid < 0) return;
    (void)hipMemsetAsync((char*)d_ws + WS_CTL, 0, CTL_ZERO_BYTES, stream);
#ifdef SELF_POISON
    (void)hipMemsetAsync((char*)d_ws + CTL_ZERO_BYTES, 0xAA, WS_NEED - CTL_ZERO_BYTES, stream);
    (void)hipMemsetAsync(d_out, 0xAA, (size_t)T * D * 4, stream);
#endif
    Args a{};
    for (int i = 0; i < 24; ++i) a.in[i] = (const float*)d_in[i];
    a.out = (float*)d_out; a.ws = (unsigned char*)d_ws;
    const int nph = count_phases();
#if MK_MULTI
    for (int p = 0; p < nph; ++p) { a.ph_lo = p; a.ph_hi = p + 1; hipLaunchKernelGGL(mk_fwd, dim3(grid), dim3(NWAVES * 64), LDS_BYTES, stream, a); }
#else
    a.ph_lo = 0; a.ph_hi = nph;
#ifdef MK_SELFCHECK
    a.chk = 1;
    hipLaunchKernelGGL(mk_fwd, dim3(grid), dim3(NWAVES * 64), LDS_BYTES, stream, a);
    (void)hipMemsetAsync((char*)d_ws + WS_CTL, 0, CTL_ZERO_BYTES, stream);
    a.chk = 2;
#endif
    hipLaunchKernelGGL(mk_fwd, dim3(grid), dim3(NWAVES * 64), LDS_BYTES, stream, a);
#endif
    const hipError_t le = hipPeekAtLastError();
    if (le != hipSuccess) fprintf(stderr, "kernel_launch: launch failed: %s\n", hipGetErrorName(le));
}
```

```cpp
#include <hip/hip_runtime.h>
#include <cstdio>
#include <cstdint>

#ifndef MK_MULTI
#define MK_MULTI 0
#endif
#ifndef MK_PROBE
#define MK_PROBE 0
#endif
#ifndef MK_ENABLE
#define MK_ENABLE 0xFF
#endif

#define GAS __attribute__((address_space(1)))
#define LAS __attribute__((address_space(3)))
typedef unsigned short bf16;
typedef short bf16x8 __attribute__((ext_vector_type(8)));
typedef float f32x4 __attribute__((ext_vector_type(4)));
typedef float f32x2 __attribute__((ext_vector_type(2)));
typedef float f32x16 __attribute__((ext_vector_type(16)));
typedef unsigned u32x4 __attribute__((ext_vector_type(4)));
typedef unsigned u32x2 __attribute__((ext_vector_type(2)));
typedef GAS unsigned gu32;
typedef int v8i_t __attribute__((ext_vector_type(8)));
typedef int v4i_t __attribute__((ext_vector_type(4)));
typedef short s16x16_t __attribute__((ext_vector_type(16)));

constexpr int D = 1024, NB = 32, SEQ = 2048, T = NB * SEQ, NH = 16, HD = 64;
constexpr int DFF = 2816, NE = 8, DFE = 3584;
constexpr float ALPHA = 1.6817928305074290f;
constexpr float LN_EPS = 1e-5f;
constexpr float LOG2E = 1.4426950408889634f;
constexpr float QSCALE = 0.125f * LOG2E;
constexpr float NEGB = -1e30f;
constexpr int TC = 16384;
constexpr int MOE_CH_TILES = 256;
constexpr int MOE_MAX_TILES = 520;
constexpr int FFN_GU8 = 1;

constexpr size_t MiB = 1u << 20;
constexpr size_t WS_CTL = 0, CTL_ZERO_BYTES = 1 * MiB;
constexpr size_t WS_BUCKET = 1 * MiB;
constexpr size_t WS_BTABA = WS_BUCKET + 8192;
constexpr size_t WS_BTABC = WS_BTABA + 32768;
constexpr size_t WS_WST = WS_BTABC + 131072;
constexpr size_t WS_KMEAN = 2 * MiB;
constexpr size_t WS_ROUTE = 4 * MiB;
constexpr size_t WS_GATES = 5 * MiB;
constexpr size_t WS_SLOTS = 6 * MiB;
constexpr size_t WS_WCNT = 7 * MiB;
constexpr size_t WS_W = 8 * MiB;
constexpr size_t W_A_QK = WS_W;
constexpr size_t W_A_V = W_A_QK + 12 * MiB;
constexpr size_t W_A_O = W_A_V + 6 * MiB;
constexpr size_t W_B_IN = W_A_O + 2 * MiB;
constexpr size_t W_B_O = W_B_IN + 6 * MiB;
constexpr size_t W_C_QK = W_B_O + 2 * MiB;
constexpr size_t W_C_V = W_C_QK + 4 * MiB;
constexpr size_t W_C_O = W_C_V + 2 * MiB;
constexpr size_t W_D_IN = W_C_O + 2 * MiB;
constexpr size_t W_D_O = W_D_IN + 4 * MiB;
constexpr size_t W_F_GU = W_D_O + 2 * MiB;
constexpr size_t W_F_D = W_F_GU + 22 * MiB;
constexpr size_t W_E_GU = W_F_D + 11 * MiB;
constexpr size_t W_E_D = W_E_GU + 224 * MiB;
constexpr size_t WS_HB = W_E_D + 112 * MiB;
constexpr size_t WS_SCR = WS_HB + 128 * MiB;
constexpr size_t WS_NEED = WS_SCR + 512 * MiB;
static_assert(WS_HB == 419 * MiB, "map");
constexpr size_t S_QK = 0;
constexpr size_t S_VT = 192 * MiB;
constexpr size_t S_HB8 = 416 * MiB;
constexpr size_t S_ATT = 288 * MiB;
constexpr size_t S_HID = 0;
constexpr size_t S_BCX = 0;
constexpr size_t S_P = 384 * MiB;
constexpr size_t S_XG = 0;
constexpr size_t S_MHID = 260 * MiB;
constexpr size_t S_Y = 256 * MiB;
constexpr size_t S_CQK = 0;
constexpr size_t S_CVT = 256 * MiB;
constexpr size_t S_CATT = 384 * MiB;
constexpr size_t S_UV = 0;
constexpr size_t O_OG = 0;
constexpr size_t O_LSE = 96 * MiB;
constexpr int CW_TMO = 0;
constexpr int CW_ECNT = 64;
constexpr int CW_BAR = 4096;
constexpr int CW_LNC = 16384;

constexpr float YSCALE8 = 16.f;
constexpr float ASCALE8 = 8.f;
constexpr float WSCALE8 = 64.f, WSCALE8D = 256.f;
__device__ __forceinline__ unsigned pk4_fp8(float a, float b, float c, float d) { int p = 0; p = __builtin_amdgcn_cvt_pk_fp8_f32(a, b, p, false); p = __builtin_amdgcn_cvt_pk_fp8_f32(c, d, p, true); return (unsigned)p; }
namespace pg8 {
constexpr int BM = 256, BK = 64, HALF = 128, HTB = HALF * BK * 2, STAGE_BYTES = 8 * HTB, NXCD = 8, WGM = 8;
__host__ __device__ __forceinline__ int lds_byte(int r, int c) { const int st = (r >> 4) * 2 + (c >> 5), rr = r & 15, cc = c & 31, ob = rr * 64 + cc * 2; return st * 1024 + (ob ^ (((ob >> 9) & 1) << 5)); }
__host__ __device__ __forceinline__ void stage_rc(int b, int& R, int& C) { const int st = b / 1024, sb = b % 1024, swz = sb ^ (((sb >> 9) & 1) << 5); R = (st >> 1) * 16 + swz / 64; C = (st & 1) * 32 + (swz % 64) / 2; }
__host__ __device__ __forceinline__ int perm32(int rho) { const int n = rho >> 4, i = rho & 15; return 8 * (i >> 2) + 4 * n + (i & 3); }

struct Unit { int pm, pn; unsigned a, b; };
struct Gemm { int K; int rsA, rsB; size_t hstepA, hstepB; };

__device__ __forceinline__ bool tile_of(long L, int nM, int nN, int& pm, int& pn) {
    const int nwg = nM * nN; if (L >= nwg) return false;
    int wgid = (int)L; { const int q = nwg / NXCD, r = nwg % NXCD, xcd = wgid % NXCD, off = wgid / NXCD; wgid = (xcd < r ? xcd * (q + 1) : r * (q + 1) + (xcd - r) * q) + off; }
    const int nig = WGM * nN, gid = wgid / nig, fm = gid * WGM, gsz = (nM - fm) < WGM ? (nM - fm) : WGM;
    pm = fm + ((wgid % nig) % gsz); pn = (wgid % nig) / gsz; return true;
}
struct LinOrder {
    int nM, nN, G, c; const char* A0; const char* B0; size_t aT, bT;
    __device__ __forceinline__ bool next(int i, Unit& u) const { if (!tile_of((long)i * G + c, nM, nN, u.pm, u.pn)) return false; u.a = (unsigned)((size_t)u.pm * aT); u.b = (unsigned)((size_t)u.pn * bT); return true; }
};

typedef __bf16 bf16x2_t __attribute__((ext_vector_type(2)));
__device__ __forceinline__ unsigned cvt_pk_bf16(float lo, float hi) { f32x2 v = {lo, hi}; bf16x2_t b = __builtin_convertvector(v, bf16x2_t); return __builtin_bit_cast(unsigned, b); }
__device__ __forceinline__ f32x2 gelu_pk(f32x2 v) {
    const f32x2 av = __builtin_elementwise_abs(v), d = av * 0.2316418882f + 1.0f;
    f32x2 t; t.x = __builtin_amdgcn_rcpf(d.x); t.y = __builtin_amdgcn_rcpf(d.y);
    f32x2 q = t * 0.5307027145f + (-0.7265760135f); q = q * t + 0.7107068705f; q = q * t + (-0.142248368f); q = q * t + 0.127414796f; q = q * t;
    const f32x2 s = (v * v) * (-0.72134752044f);
    f32x2 e; e.x = __builtin_amdgcn_exp2f(s.x); e.y = __builtin_amdgcn_exp2f(s.y);
    const f32x2 m = v * (q * e), r = v - m;
    f32x2 o; o.x = v.x < 0.f ? m.x : r.x; o.y = v.y < 0.f ? m.y : r.y; return o;
}
__device__ __forceinline__ float silu_f(float g) { return g * __builtin_amdgcn_rcpf(1.0f + __builtin_amdgcn_exp2f(-LOG2E * g)); }

template <int ACT  > struct EpiBf16 {
    static constexpr bool PERM = true;
    bf16* O; int ldc; float sc = 1.f;
    __device__ __forceinline__ void operator()(const f32x4 (&acc)[2][2][4][2], const Unit& u, int wr, int wc, int fr, int fq) const {
        const int row0 = u.pm * BM + wr * 64 + fr, col0 = u.pn * BM + wc * 32 + 8 * fq;
#pragma unroll
        for (int ai = 0; ai < 2; ++ai)
#pragma unroll
            for (int m = 0; m < 4; ++m) { bf16* rowp = O + (size_t)(row0 + ai * HALF + m * 16) * ldc + col0;
#pragma unroll
                for (int bj = 0; bj < 2; ++bj) { f32x4 v0 = acc[ai][bj][m][0] * sc, v1 = acc[ai][bj][m][1] * sc;
                    if (ACT == 1) { f32x2 a = gelu_pk((f32x2){v0[0], v0[1]}), b = gelu_pk((f32x2){v0[2], v0[3]}), c = gelu_pk((f32x2){v1[0], v1[1]}), d = gelu_pk((f32x2){v1[2], v1[3]});
                        v0 = (f32x4){a.x, a.y, b.x, b.y}; v1 = (f32x4){c.x, c.y, d.x, d.y}; }
                    u32x4 w; w.x = cvt_pk_bf16(v0[0], v0[1]); w.y = cvt_pk_bf16(v0[2], v0[3]); w.z = cvt_pk_bf16(v1[0], v1[1]); w.w = cvt_pk_bf16(v1[2], v1[3]);
                    *(u32x4*)(rowp + bj * HALF) = w; } }
    }
};
struct EpiF8 {
    static constexpr bool PERM = true;
    unsigned char* O; int ldc; float sc = 1.f;
    __device__ __forceinline__ void operator()(const f32x4 (&acc)[2][2][4][2], const Unit& u, int wr, int wc, int fr, int fq) const {
        const int row0 = u.pm * BM + wr * 64 + fr, col0 = u.pn * BM + wc * 32 + 8 * fq;
#pragma unroll
        for (int ai = 0; ai < 2; ++ai)
#pragma unroll
            for (int m = 0; m < 4; ++m) { unsigned char* rowp = O + (size_t)(row0 + ai * HALF + m * 16) * ldc + col0;
#pragma unroll
                for (int bj = 0; bj < 2; ++bj) { const f32x4 v0 = acc[ai][bj][m][0] * sc, v1 = acc[ai][bj][m][1] * sc;
                    u32x2 w; w.x = pk4_fp8(v0[0], v0[1], v0[2], v0[3]); w.y = pk4_fp8(v1[0], v1[1], v1[2], v1[3]);
                    *(u32x2*)(rowp + bj * HALF) = w; } }
    }
};
template <int ACT  > struct EpiGlu {
    static constexpr bool PERM = true;
    bf16* O; int ldc;
    __device__ __forceinline__ void operator()(const f32x4 (&acc)[2][2][4][2], const Unit& u, int wr, int wc, int fr, int fq) const {
        const int row0 = u.pm * BM + wr * 64 + fr, col0 = u.pn * HALF + wc * 32 + 8 * fq;
#pragma unroll
        for (int ai = 0; ai < 2; ++ai)
#pragma unroll
            for (int m = 0; m < 4; ++m) { bf16* rowp = O + (size_t)(row0 + ai * HALF + m * 16) * ldc + col0;
                f32x4 g0 = acc[ai][0][m][0], g1 = acc[ai][0][m][1]; const f32x4 u0 = acc[ai][1][m][0], u1 = acc[ai][1][m][1];
                if (ACT == 1) { g0 = (f32x4){silu_f(g0[0]), silu_f(g0[1]), silu_f(g0[2]), silu_f(g0[3])}; g1 = (f32x4){silu_f(g1[0]), silu_f(g1[1]), silu_f(g1[2]), silu_f(g1[3])}; }
                const f32x4 p0 = g0 * u0, p1 = g1 * u1;
                u32x4 w; w.x = cvt_pk_bf16(p0[0], p0[1]); w.y = cvt_pk_bf16(p0[2], p0[3]); w.z = cvt_pk_bf16(p1[0], p1[1]); w.w = cvt_pk_bf16(p1[2], p1[3]);
                *(u32x4*)rowp = w; }
    }
};
struct EpiSwiglu8 {
    static constexpr bool PERM = true;
    unsigned char* O; int ldc; float s = 1.f;
    __device__ __forceinline__ void operator()(const f32x4 (&acc)[2][2][4][2], const Unit& u, int wr, int wc, int fr, int fq) const {
        const int row0 = u.pm * BM + wr * 64 + fr, col0 = u.pn * HALF + wc * 32 + 8 * fq;
#pragma unroll
        for (int ai = 0; ai < 2; ++ai)
#pragma unroll
            for (int m = 0; m < 4; ++m) { unsigned char* rowp = O + (size_t)(row0 + ai * HALF + m * 16) * ldc + col0;
                const f32x4 g0 = acc[ai][0][m][0], g1 = acc[ai][0][m][1], u0 = acc[ai][1][m][0], u1 = acc[ai][1][m][1];
                const float c1 = -LOG2E * s, s2 = s * s;
                const f32x4 p0 = (g0 * u0) * s2, p1 = (g1 * u1) * s2;
                f32x4 r0, r1;
#pragma unroll
                for (int j = 0; j < 4; ++j) { r0[j] = __builtin_amdgcn_rcpf(1.0f + __builtin_amdgcn_exp2f(g0[j] * c1)); r1[j] = __builtin_amdgcn_rcpf(1.0f + __builtin_amdgcn_exp2f(g1[j] * c1)); }
                const f32x4 o0 = p0 * r0, o1 = p1 * r1;
                u32x2 w; w.x = pk4_fp8(o0[0], o0[1], o0[2], o0[3]); w.y = pk4_fp8(o1[0], o1[1], o1[2], o1[3]);
                *(u32x2*)rowp = w; }
    }
};
struct EpiResBf16 {
    static constexpr bool PERM = true;
    const bf16* base; bf16* out; int ldc; float alpha; float sc = 1.f;
    __device__ __forceinline__ void operator()(const f32x4 (&acc)[2][2][4][2], const Unit& u, int wr, int wc, int fr, int fq) const {
        const int row0 = u.pm * BM + wr * 64 + fr, col0 = u.pn * BM + wc * 32 + 8 * fq;
#pragma unroll
        for (int ai = 0; ai < 2; ++ai)
#pragma unroll
            for (int m = 0; m < 4; ++m) { const size_t off = (size_t)(row0 + ai * HALF + m * 16) * ldc + col0;
#pragma unroll
                for (int bj = 0; bj < 2; ++bj) { const u32x4 b = *(const u32x4*)(base + off + bj * HALF); const f32x4 a0 = acc[ai][bj][m][0] * sc, a1 = acc[ai][bj][m][1] * sc;
                    u32x4 w; w.x = cvt_pk_bf16(__builtin_bit_cast(float, b.x << 16) * alpha + a0[0], __builtin_bit_cast(float, b.x & 0xffff0000u) * alpha + a0[1]);
                    w.y = cvt_pk_bf16(__builtin_bit_cast(float, b.y << 16) * alpha + a0[2], __builtin_bit_cast(float, b.y & 0xffff0000u) * alpha + a0[3]);
                    w.z = cvt_pk_bf16(__builtin_bit_cast(float, b.z << 16) * alpha + a1[0], __builtin_bit_cast(float, b.z & 0xffff0000u) * alpha + a1[1]);
                    w.w = cvt_pk_bf16(__builtin_bit_cast(float, b.w << 16) * alpha + a1[2], __builtin_bit_cast(float, b.w & 0xffff0000u) * alpha + a1[3]);
                    *(u32x4*)(out + off + bj * HALF) = w; }
                asm volatile("" ::: "memory"); }
    }
};

template <bool HB8> struct EpiResLn {
    static constexpr bool PERM = true;
    bf16* h; const float* gain; const float* bias; float alpha, sc;
    float* xbuf;
    unsigned* cnt;
    unsigned* tmo;
    unsigned char* h8;
    LAS unsigned char* tb;
    __device__ __forceinline__ void operator()(f32x4 (&acc)[2][2][4][2], const Unit& u, int wr, int wc, int fr, int fq) const {
        asm volatile("" : "+v"(fr), "+v"(fq));
        const int row0 = u.pm * BM + wr * 64 + fr, col0 = u.pn * BM + wc * 32 + 8 * fq;
        LAS f32x2* P = (LAS f32x2*)tb; LAS f32x2* S = (LAS f32x2*)(tb + 8192);
#pragma unroll
        for (int ai = 0; ai < 2; ++ai)
#pragma unroll
            for (int m = 0; m < 4; ++m) { const size_t off = (size_t)(row0 + ai * HALF + m * 16) * 1024 + col0; float sm = 0.f, sq = 0.f;
#pragma unroll
                for (int bj = 0; bj < 2; ++bj) { const u32x4 b = *(const u32x4*)(h + off + bj * HALF); const f32x4 a0 = acc[ai][bj][m][0] * sc, a1 = acc[ai][bj][m][1] * sc;
                    f32x4 z0, z1;
                    z0[0] = __builtin_bit_cast(float, b.x << 16) * alpha + a0[0]; z0[1] = __builtin_bit_cast(float, b.x & 0xffff0000u) * alpha + a0[1];
                    z0[2] = __builtin_bit_cast(float, b.y << 16) * alpha + a0[2]; z0[3] = __builtin_bit_cast(float, b.y & 0xffff0000u) * alpha + a0[3];
                    z1[0] = __builtin_bit_cast(float, b.z << 16) * alpha + a1[0]; z1[1] = __builtin_bit_cast(float, b.z & 0xffff0000u) * alpha + a1[1];
                    z1[2] = __builtin_bit_cast(float, b.w << 16) * alpha + a1[2]; z1[3] = __builtin_bit_cast(float, b.w & 0xffff0000u) * alpha + a1[3];
                    acc[ai][bj][m][0] = z0; acc[ai][bj][m][1] = z1;
                    sm += ((z0[0] + z0[1]) + (z0[2] + z0[3])) + ((z1[0] + z1[1]) + (z1[2] + z1[3]));
                    sq += ((z0[0] * z0[0] + z0[1] * z0[1]) + (z0[2] * z0[2] + z0[3] * z0[3])) + ((z1[0] * z1[0] + z1[1] * z1[1]) + (z1[2] * z1[2] + z1[3] * z1[3])); }
                sm += __shfl_xor(sm, 16); sm += __shfl_xor(sm, 32); sq += __shfl_xor(sq, 16); sq += __shfl_xor(sq, 32);
                if (fq == 0) P[(ai * HALF + wr * 64 + m * 16 + fr) * 4 + wc] = (f32x2){sm, sq};
                asm volatile("" ::: "memory"); }
        asm volatile("s_waitcnt lgkmcnt(0)" ::: "memory"); __builtin_amdgcn_s_barrier(); asm volatile("" ::: "memory");
        const int wid = wr * 4 + wc, lane = fq * 16 + fr, row = wid * 32 + (lane & 31);
        unsigned long long* slots = (unsigned long long*)xbuf + (size_t)(u.pm * BM + row) * 4;
        if (lane < 32) { const f32x2 a = P[row * 4 + 0], b = P[row * 4 + 1], c = P[row * 4 + 2], d = P[row * 4 + 3];
            const float ts = (a.x + b.x) + (c.x + d.x), tq = (a.y + b.y) + (c.y + d.y);
            __hip_atomic_store(slots + u.pn, ((unsigned long long)__builtin_bit_cast(unsigned, tq) << 32) | (unsigned long long)__builtin_bit_cast(unsigned, ts), __ATOMIC_RELAXED, __HIP_MEMORY_SCOPE_AGENT); }
        asm volatile("s_waitcnt vmcnt(0)" ::: "memory");
        if (lane == 0) (void)__hip_atomic_fetch_add(cnt + 16 * u.pm, 1u, __ATOMIC_RELAXED, __HIP_MEMORY_SCOPE_AGENT);
        if (wid == 0) { unsigned sp = 0u;
            while ((unsigned)__builtin_amdgcn_readfirstlane(__hip_atomic_load(cnt + 16 * u.pm, __ATOMIC_RELAXED, __HIP_MEMORY_SCOPE_AGENT)) < 32u) { __builtin_amdgcn_s_sleep(1);
                if ((++sp & 255u) == 0u) { if (__hip_atomic_load(tmo, __ATOMIC_RELAXED, __HIP_MEMORY_SCOPE_AGENT)) break; if (sp > (1u << 22)) { if (lane == 0) (void)__hip_atomic_fetch_add(tmo, 1u, __ATOMIC_RELAXED, __HIP_MEMORY_SCOPE_AGENT); break; } } }
            __builtin_amdgcn_fence(__ATOMIC_ACQUIRE, "agent"); }
        asm volatile("s_waitcnt vmcnt(0) lgkmcnt(0)" ::: "memory"); __builtin_amdgcn_s_barrier(); asm volatile("" ::: "memory");
        if (lane < 32) { float ts = 0.f, tq = 0.f;
#pragma unroll
            for (int t = 0; t < 4; ++t) { const unsigned long long w = __hip_atomic_load(slots + t, __ATOMIC_RELAXED, __HIP_MEMORY_SCOPE_AGENT); ts += __builtin_bit_cast(float, (unsigned)w); tq += __builtin_bit_cast(float, (unsigned)(w >> 32)); }
            const float mean = ts * (1.f / 1024.f), var = fmaxf(tq * (1.f / 1024.f) - mean * mean, 0.f);
            S[row] = (f32x2){mean, 1.f / sqrtf(var + LN_EPS)}; }
        asm volatile("s_waitcnt vmcnt(0) lgkmcnt(0)" ::: "memory"); __builtin_amdgcn_s_barrier(); asm volatile("" ::: "memory");
#pragma unroll
        for (int bj = 0; bj < 2; ++bj) { const f32x4 g0 = *(const f32x4*)(gain + col0 + bj * HALF), g1 = *(const f32x4*)(gain + col0 + bj * HALF + 4), b0 = *(const f32x4*)(bias + col0 + bj * HALF), b1 = *(const f32x4*)(bias + col0 + bj * HALF + 4);
#pragma unroll
            for (int ai = 0; ai < 2; ++ai)
#pragma unroll
                for (int m = 0; m < 4; ++m) { const int r = ai * HALF + wr * 64 + m * 16 + fr; const f32x2 sr = S[r]; const size_t off = (size_t)(u.pm * BM + r) * 1024 + col0 + bj * HALF;
                    const f32x4 y0 = (acc[ai][bj][m][0] - sr.x) * sr.y * g0 + b0, y1 = (acc[ai][bj][m][1] - sr.x) * sr.y * g1 + b1;
                    u32x4 w; w.x = cvt_pk_bf16(y0[0], y0[1]); w.y = cvt_pk_bf16(y0[2], y0[3]); w.z = cvt_pk_bf16(y1[0], y1[1]); w.w = cvt_pk_bf16(y1[2], y1[3]);
                    *(u32x4*)(h + off) = w;
                    if (HB8) { u32x2 w8; w8.x = pk4_fp8(y0[0], y0[1], y0[2], y0[3]); w8.y = pk4_fp8(y1[0], y1[1], y1[2], y1[3]); *(u32x2*)(h8 + off) = w8; }
                    asm volatile("" ::: "memory"); } }
    }
};

template <class Epi, class Sched, bool ALIGN_EPI = true, int FP8 = 0>
__device__ __forceinline__ void gemm_phase(LAS unsigned char* lds, const int wave_s, const Gemm g, const Sched& S, const Epi& E) {
    int tid = wave_s * 64 + (int)__builtin_amdgcn_mbcnt_hi(~0u, __builtin_amdgcn_mbcnt_lo(~0u, 0u)); asm volatile("" : "+v"(tid));
    const int wid = __builtin_amdgcn_readfirstlane(tid >> 6), lane = tid & 63, wr = wid >> 2, wc = wid & 3, fr = lane & 15, fq = lane >> 4;
    const int K = g.K, nt = K / BK;
    unsigned voffA[2], voffB[2];
#pragma unroll
    for (int i = 0; i < 2; ++i) { int R, C; stage_rc(tid * 16 + i * 8192, R, C); const int Rb = Epi::PERM ? ((R & ~31) + perm32(R & 31)) : R;
        voffA[i] = (unsigned)(R * g.rsA * K + C) * 2u; voffB[i] = (unsigned)(Rb * g.rsB * K + C) * 2u; }
    const unsigned kstep = (unsigned)(BK * 2);
    const unsigned hstepA = (unsigned)g.hstepA, hstepB = (unsigned)g.hstepB;
    const __amdgpu_buffer_rsrc_t rsrcA = __builtin_amdgcn_make_buffer_rsrc((void*)S.A0, 0, 0x7fffffff, 0x00020000), rsrcB = __builtin_amdgcn_make_buffer_rsrc((void*)S.B0, 0, 0x7fffffff, 0x00020000);
    const unsigned ldsw = (unsigned)wid * 1024u;
    const int aoff = lds_byte(wr * 64 + fr, fq * 8), boff = lds_byte(wc * 32 + fr, fq * 8);
    const int aoff8 = lds_byte(wr * 64 + fr, fq * 16), boff8 = lds_byte(wc * 32 + fr, fq * 16);
    unsigned bbase8_ = (unsigned)(4 * HTB + boff); asm volatile("" : "+v"(bbase8_));
    LAS unsigned char* const ldsB8 = lds + bbase8_;
#define PG8_SA(b, h) (((b) * 2 + (h)) * HTB)
#define PG8_SB(b, h) ((4 + (b) * 2 + (h)) * HTB)
#define PG8_STAGE(bufoff, gbase, voff) do { _Pragma("unroll") for (int _i = 0; _i < 2; ++_i) \
        __builtin_amdgcn_raw_ptr_buffer_load_lds(PG8_RS_##voff, (LAS unsigned*)(lds + (bufoff) + ldsw + _i * 8192), 16, (int)(voff)[_i], (int)(gbase), 0, 0); } while (0)
#define PG8_RS_voffA rsrcA
#define PG8_RS_voffB rsrcB
#define PG8_LD16(off) (*(const LAS bf16x8*)(lds + (off)))
#define PG8_CAT8(lo, hi) __builtin_shufflevector(__builtin_bit_cast(v4i_t, lo), __builtin_bit_cast(v4i_t, hi), 0, 1, 2, 3, 4, 5, 6, 7)
#define PG8_LDA(dst, b, h) do { if constexpr (FP8) { _Pragma("unroll") for (int m = 0; m < 4; ++m) dst##8[m] = PG8_CAT8(PG8_LD16(PG8_SA(b, h) + aoff + m * 2048), PG8_LD16(PG8_SA(b, h) + aoff + m * 2048 + 1024)); } \
        else { _Pragma("unroll") for (int m = 0; m < 4; ++m) _Pragma("unroll") for (int k = 0; k < 2; ++k) dst[m][k] = PG8_LD16(PG8_SA(b, h) + aoff + m * 2048 + k * 1024); } } while (0)
#define PG8_LDB(dst, b, h) do { if constexpr (FP8) { _Pragma("unroll") for (int n = 0; n < 2; ++n) dst##8[n] = PG8_CAT8(*(const LAS bf16x8*)(ldsB8 + ((b) * 2 + (h)) * HTB + n * 2048), *(const LAS bf16x8*)(ldsB8 + ((b) * 2 + (h)) * HTB + n * 2048 + 1024)); } \
        else { _Pragma("unroll") for (int n = 0; n < 2; ++n) _Pragma("unroll") for (int k = 0; k < 2; ++k) dst[n][k] = PG8_LD16(PG8_SB(b, h) + boff + n * 2048 + k * 1024); } } while (0)
#define PG8_MMA(ai, bj, At, Bt) do { __builtin_amdgcn_s_setprio(1); \
        if constexpr (FP8) { _Pragma("unroll") for (int m = 0; m < 4; ++m) _Pragma("unroll") for (int n = 0; n < 2; ++n) \
            acc[ai][bj][m][n] = __builtin_amdgcn_mfma_scale_f32_16x16x128_f8f6f4(Bt##8[n], At##8[m], acc[ai][bj][m][n], 0, 0, 0, 0, 0, 0); } \
        else { _Pragma("unroll") for (int m = 0; m < 4; ++m) _Pragma("unroll") for (int n = 0; n < 2; ++n) _Pragma("unroll") for (int k = 0; k < 2; ++k) \
            acc[ai][bj][m][n] = __builtin_amdgcn_mfma_f32_16x16x32_bf16(Bt[n][k], At[m][k], acc[ai][bj][m][n], 0, 0, 0); } \
        __builtin_amdgcn_s_setprio(0); } while (0)
#define PG8_WAIT_V(n) asm volatile("s_waitcnt vmcnt(" #n ")" ::: "memory")
#define PG8_WAIT_L(n) asm volatile("s_waitcnt lgkmcnt(" #n ")" ::: "memory")
#define PG8_BAR __builtin_amdgcn_s_barrier()
#define PG8_SCHED __builtin_amdgcn_sched_barrier(0)
    Unit cur, nxt; int ui = 0;
    if (!S.next(0, cur)) return;
    f32x4 acc[2][2][4][2];
#pragma unroll
    for (int a = 0; a < 2; ++a)
#pragma unroll
        for (int b = 0; b < 2; ++b)
#pragma unroll
            for (int m = 0; m < 4; ++m)
#pragma unroll
                for (int n = 0; n < 2; ++n) acc[a][b][m][n] = (f32x4){0.f, 0.f, 0.f, 0.f};
    bf16x8 At[4][2], B0[2][2], B1[2][2]; v8i_t At8[4], B08[2], B18[2];
    unsigned cA = cur.a, cB = cur.b;
    PG8_STAGE(PG8_SB(0, 0), cB, voffB); PG8_STAGE(PG8_SB(0, 1), cB + hstepB, voffB); PG8_STAGE(PG8_SA(0, 0), cA, voffA); PG8_STAGE(PG8_SA(0, 1), cA + hstepA, voffA);
    if (wr == 1) PG8_BAR;
    PG8_WAIT_V(2); PG8_BAR;
    PG8_STAGE(PG8_SB(1, 0), cB + kstep, voffB); PG8_STAGE(PG8_SA(1, 0), cA + kstep, voffA); PG8_STAGE(PG8_SB(1, 1), cB + hstepB + kstep, voffB);
    PG8_WAIT_V(6); PG8_BAR;
    for (;;) {
        const bool has_next = S.next(ui + 1, nxt);
        const unsigned nA = has_next ? nxt.a : cA, nB = has_next ? nxt.b : cB;
#pragma clang loop unroll(disable)
        for (int t = 0; t < nt; t += 2) {
            const bool last = (t == nt - 2);
            const unsigned a1 = cA + (unsigned)(t + 1) * kstep;
            const unsigned a2 = last ? nA : cA + (unsigned)(t + 2) * kstep, b2 = last ? nB : cB + (unsigned)(t + 2) * kstep;
            const unsigned a3 = a2 + kstep, b3 = b2 + kstep;
            PG8_LDB(B0, 0, 0); PG8_LDB(B1, 0, 1); PG8_SCHED; PG8_LDA(At, 0, 0); PG8_STAGE(PG8_SA(1, 1), a1 + hstepA, voffA);
            PG8_WAIT_V(8); PG8_WAIT_L(0); PG8_BAR; PG8_MMA(0, 0, At, B0); PG8_MMA(0, 1, At, B1); PG8_BAR; PG8_SCHED;
            PG8_LDA(At, 0, 1); PG8_STAGE(PG8_SB(0, 0), b2, voffB); PG8_STAGE(PG8_SB(0, 1), b2 + hstepB, voffB); PG8_STAGE(PG8_SA(0, 0), a2, voffA);
            PG8_WAIT_V(8); PG8_WAIT_L(0); PG8_BAR; PG8_MMA(1, 0, At, B0); PG8_MMA(1, 1, At, B1); PG8_BAR; PG8_SCHED;
            PG8_LDB(B0, 1, 0); PG8_LDB(B1, 1, 1); PG8_SCHED; PG8_LDA(At, 1, 0); PG8_STAGE(PG8_SA(0, 1), a2 + hstepA, voffA);
            PG8_WAIT_V(8); PG8_WAIT_L(0); PG8_BAR; PG8_MMA(0, 0, At, B0); PG8_MMA(0, 1, At, B1); PG8_BAR; PG8_SCHED;
            PG8_LDA(At, 1, 1); PG8_STAGE(PG8_SB(1, 0), b3, voffB); PG8_STAGE(PG8_SB(1, 1), b3 + hstepB, voffB); PG8_STAGE(PG8_SA(1, 0), a3, voffA);
            PG8_WAIT_V(8); PG8_WAIT_L(0); PG8_BAR; PG8_MMA(1, 0, At, B0); PG8_MMA(1, 1, At, B1); PG8_BAR; PG8_SCHED;
        }
        if constexpr (ALIGN_EPI) { if (wr == 0) PG8_BAR; }
        E(acc, cur, wr, wc, fr, fq);
        if (!has_next) break;
#pragma unroll
        for (int a = 0; a < 2; ++a)
#pragma unroll
            for (int b = 0; b < 2; ++b)
#pragma unroll
                for (int m = 0; m < 4; ++m)
#pragma unroll
                    for (int n = 0; n < 2; ++n) acc[a][b][m][n] = (f32x4){0.f, 0.f, 0.f, 0.f};
        cur = nxt; cA = nA; cB = nB; ++ui;
        if constexpr (ALIGN_EPI) { if (wr == 1) PG8_BAR; }
    }
    PG8_WAIT_V(0);
    if constexpr (!ALIGN_EPI) { if (wr == 0) PG8_BAR; }
    PG8_BAR;
#undef PG8_SA
#undef PG8_SB
#undef PG8_STAGE
#undef PG8_RS_voffA
#undef PG8_RS_voffB
#undef PG8_LDA
#undef PG8_LD16
#undef PG8_CAT8
#undef PG8_LDB
#undef PG8_MMA
#undef PG8_WAIT_V
#undef PG8_WAIT_L
#undef PG8_BAR
#undef PG8_SCHED
}
}

#define RLX_AGENT __ATOMIC_RELAXED, __HIP_MEMORY_SCOPE_AGENT
#define LDS_WAIT() asm volatile("s_waitcnt lgkmcnt(0)" ::: "memory")
#define VM_WAIT() asm volatile("s_waitcnt vmcnt(0)" ::: "memory")
__device__ __forceinline__ unsigned f2bf(float f) { unsigned u = __builtin_bit_cast(unsigned, f); return (u + 0x7fffu + ((u >> 16) & 1u)) >> 16; }
__device__ __forceinline__ unsigned pk2(float lo, float hi) { return pg8::cvt_pk_bf16(lo, hi); }
__device__ __forceinline__ float bflo(unsigned w) { return __builtin_bit_cast(float, w << 16); }
__device__ __forceinline__ float bfhi(unsigned w) { return __builtin_bit_cast(float, w & 0xffff0000u); }
__device__ __forceinline__ float wave_sum(float v) {
#pragma unroll
    for (int o = 1; o < 64; o <<= 1) v += __shfl_xor(v, o);
    return v;
}

#define XB_TMO      128
#define XB_XCNT(j)  (256  + 64 * (j))
#define XB_XSUB(j)  (1280 + 64 * (j))
#define XB_XGEN(j)  (2304 + 64 * (j))
#define XB_TOP      3328
#define XB_TOPGEN   3392
#define XCD_BAR_WORDS 3456
#define XB_SPIN_CAP (1u << 22)
__device__ __forceinline__ unsigned xb_ld(unsigned* p)              { return __hip_atomic_load(p, __ATOMIC_RELAXED, __HIP_MEMORY_SCOPE_AGENT); }
__device__ __forceinline__ unsigned xb_add(unsigned* p, unsigned v) { return __hip_atomic_fetch_add(p, v, __ATOMIC_RELAXED, __HIP_MEMORY_SCOPE_AGENT); }
__device__ __forceinline__ unsigned xb_xcc_id() { return (unsigned)__builtin_amdgcn_s_getreg((3 << 11) | 20) & 0xFu; }
#define XB_SPIN(cond, bar) do { unsigned _sp = 0; while (cond) { __builtin_amdgcn_s_sleep(1); \
    if ((++_sp & 255u) == 0u) { if (xb_ld(&(bar)[XB_TMO])) break; if (_sp > XB_SPIN_CAP) { atomicAdd(&(bar)[XB_TMO], 1u); break; } } } } while (0)
struct XcdBarrier { unsigned* bar; unsigned x; volatile LAS unsigned* st; };
__device__ __forceinline__ XcdBarrier xcd_barrier_post(unsigned* bar, volatile LAS unsigned* st) {
    XcdBarrier b; b.bar = bar; b.x = xb_xcc_id(); b.st = st;
    if (threadIdx.x == 0) (void)xb_add(&bar[XB_XCNT(b.x)], 1u);
    return b;
}
__device__ __forceinline__ void xcd_barrier_complete(unsigned* bar, unsigned x, unsigned& nloc, unsigned& nx) {
    const unsigned G = gridDim.x * gridDim.y * gridDim.z;
    unsigned sum, cnt, mine, sp = 0u;
    for (;;) {
        sum = 0u; cnt = 0u; mine = 0u;
#pragma unroll
        for (unsigned j = 0; j < 16; ++j) { const unsigned c = xb_ld(&bar[XB_XCNT(j)]); sum += c; cnt += (c > 0u) ? 1u : 0u; mine = (j == x) ? c : mine; }
        if (sum == G) break;
        __builtin_amdgcn_s_sleep(1);
        if ((++sp & 255u) == 0u) { if (xb_ld(&bar[XB_TMO])) break; if (sp > XB_SPIN_CAP) { atomicAdd(&bar[XB_TMO], 1u); break; } }
    }
    nloc = mine > 0u ? mine : 1u; nx = cnt > 0u ? cnt : 1u;
}
__device__ __forceinline__ void xcd_barrier(const XcdBarrier& b, const int tid) {
    asm volatile("s_waitcnt vmcnt(0)" ::: "memory");
    __syncthreads();
    if (tid == 0) {
        unsigned* bar = b.bar;
        __builtin_amdgcn_s_waitcnt(0);
        unsigned nloc = b.st[0], nx = b.st[1];
        if (nloc == 0u) { xcd_barrier_complete(bar, b.x, nloc, nx); b.st[0] = nloc; b.st[1] = nx; }
        const unsigned old = xb_add(&bar[XB_XSUB(b.x)], 1u);
        const unsigned gen = old / nloc;
        if (old + 1u == (gen + 1u) * nloc) {
            __builtin_amdgcn_fence(__ATOMIC_RELEASE, "agent");
            asm volatile("s_waitcnt vmcnt(0)" ::: "memory");
            const unsigned og = xb_add(&bar[XB_TOP], 1u);
            const unsigned tg = og / nx;
            if (og + 1u == (tg + 1u) * nx) xb_add(&bar[XB_TOPGEN], 1u);
            else XB_SPIN(xb_ld(&bar[XB_TOPGEN]) == tg, bar);
            __builtin_amdgcn_fence(__ATOMIC_ACQUIRE, "agent");
            xb_add(&bar[XB_XGEN(b.x)], 1u);
            asm volatile("s_waitcnt vmcnt(0)" ::: "memory");
        } else {
            XB_SPIN(xb_ld(&bar[XB_XGEN(b.x)]) == gen, bar);
            __builtin_amdgcn_fence(__ATOMIC_ACQUIRE, "agent");
            asm volatile("s_waitcnt vmcnt(0)" ::: "memory");
        }
    }
    __syncthreads();
}

constexpr int NWAVES = 8;
constexpr int RING_BYTES = 131072, MISC_OFF = RING_BYTES + 320, LNT_OFF = RING_BYTES + 2048  , LDS_BYTES = 147456;
struct Args { const float* in[24]; float* out; unsigned char* ws; int ph_lo, ph_hi; int chk, pad; };
struct Frame {
    LAS unsigned char* lds;
    gu32* ctl; unsigned char* ws; float* out;
    int tid, lane, wave, vcu, G;
    int chk, stage;
};

struct Job { const float* src; bf16* dst; int ld, K, N, mode, start; float scale; int fp8, pad; };
constexpr int NJOBS = 74;
__device__ __forceinline__ void make_job(const Args& a, int j, Job& J) {
    unsigned char* ws = a.ws; J.scale = 1.f; J.mode = 0; J.start = 0; J.fp8 = 0; J.pad = 0;
    if (j < 9) { const int g = j / 3, t = j % 3; J.src = a.in[4] + g * 3072 + t * 1024; J.ld = 9216; J.K = 1024; J.N = 1024;
        if (t == 2) J.dst = (bf16*)(ws + W_A_V + (size_t)g * 1024 * 1024); else J.dst = (bf16*)(ws + W_A_QK + (size_t)g * 2048 * 1024 + (size_t)t * 1024 * 1024);
        J.fp8 = 1; J.scale = (t == 0 ? QSCALE : 1.f) * WSCALE8; return; }
    j -= 9;
    if (j == 0) { J.src = a.in[5]; J.ld = 1024; J.K = 1024; J.N = 1024; J.dst = (bf16*)(ws + W_A_O); J.fp8 = 1; J.scale = WSCALE8; return; }
    if (j == 1) { J.src = a.in[6]; J.ld = 3072; J.K = 1024; J.N = 1024; J.dst = (bf16*)(ws + W_B_IN); return; }
    if (j == 9 || j == 10) { J.src = a.in[6] + 1024 * (j - 8); J.ld = 3072; J.K = 1024; J.N = 1024; J.dst = (bf16*)(ws + W_B_IN) + (size_t)1024 * 1024; J.mode = j - 8; return; }
    if (j == 2) { J.src = a.in[8]; J.ld = 1024; J.K = 1024; J.N = 1024; J.dst = (bf16*)(ws + W_B_O); return; }
    if (j == 3) { J.src = a.in[9]; J.ld = 3072; J.K = 1024; J.N = 1024; J.dst = (bf16*)(ws + W_C_QK); J.scale = QSCALE; return; }
    if (j == 4) { J.src = a.in[9] + 1024; J.ld = 3072; J.K = 1024; J.N = 1024; J.dst = (bf16*)(ws + W_C_QK) + (size_t)1024 * 1024; return; }
    if (j == 5) { J.src = a.in[9] + 2048; J.ld = 3072; J.K = 1024; J.N = 1024; J.dst = (bf16*)(ws + W_C_V); return; }
    if (j == 6) { J.src = a.in[10]; J.ld = 1024; J.K = 1024; J.N = 1024; J.dst = (bf16*)(ws + W_C_O); J.fp8 = 1; J.scale = WSCALE8; return; }
    if (j == 7) { J.src = a.in[11]; J.ld = 2048; J.K = 1024; J.N = 2048; J.dst = (bf16*)(ws + W_D_IN); return; }
    if (j == 8) { J.src = a.in[16]; J.ld = 1024; J.K = 1024; J.N = 1024; J.dst = (bf16*)(ws + W_D_O); return; }
    j -= 11;
    if (j < 6) { const int f = j / 3, t = j % 3;
        if (t < 2) { J.src = a.in[17 + t] + (size_t)f * 1024 * DFF; J.ld = DFF; J.K = 1024; J.N = DFF; J.dst = (bf16*)(ws + W_F_GU) + (size_t)f * 2 * DFF * 1024; J.mode = 1 + t;
            if (f == FFN_GU8) { J.fp8 = 1; J.scale = WSCALE8; } }
        else { J.src = a.in[19] + (size_t)f * DFF * 1024; J.ld = 1024; J.K = DFF; J.N = 1024; J.dst = (bf16*)(ws + W_F_D) + (size_t)f * 1024 * DFF; J.fp8 = 1; J.scale = WSCALE8D; }
        return; }
    j -= 6;
    { const int fe = j / 3, t = j % 3;
        if (t < 2) { J.src = a.in[21 + t] + (size_t)fe * 1024 * DFE; J.ld = DFE; J.K = 1024; J.N = DFE; J.dst = (bf16*)(ws + W_E_GU) + (size_t)fe * 2 * DFE * 1024; J.mode = 1 + t; J.fp8 = 1; J.scale = WSCALE8; }
        else { J.src = a.in[23] + (size_t)fe * DFE * 1024; J.ld = 1024; J.K = DFE; J.N = 1024; J.dst = (bf16*)(ws + W_E_D) + (size_t)fe * 1024 * DFE; J.fp8 = 1; J.scale = WSCALE8D; } }
}
__device__ __forceinline__ void transpose_item(const Job& J, int item, int lane) {
    const int nblk = J.N >> 6, kb = item / nblk, nb = item - kb * nblk, k0 = 64 * kb, n = 64 * nb + lane;
    const float* W = J.src + (size_t)k0 * J.ld + n;
    int r = n; if (J.mode) r = (n >> 7) * 256 + (n & 127) + (J.mode == 2 ? 128 : 0);
    const float sc = J.scale; const size_t ld = (size_t)J.ld;
    if (J.fp8) {
        unsigned char* dst8 = (unsigned char*)J.dst + (size_t)r * J.K + k0;
#pragma unroll
        for (int hf = 0; hf < 2; ++hf) {
            float v[32];
#pragma unroll
            for (int j = 0; j < 32; ++j) v[j] = W[(size_t)(32 * hf + j) * ld];
#pragma unroll
            for (int c = 0; c < 2; ++c) { u32x4 o; o.x = pk4_fp8(v[16 * c] * sc, v[16 * c + 1] * sc, v[16 * c + 2] * sc, v[16 * c + 3] * sc); o.y = pk4_fp8(v[16 * c + 4] * sc, v[16 * c + 5] * sc, v[16 * c + 6] * sc, v[16 * c + 7] * sc);
                o.z = pk4_fp8(v[16 * c + 8] * sc, v[16 * c + 9] * sc, v[16 * c + 10] * sc, v[16 * c + 11] * sc); o.w = pk4_fp8(v[16 * c + 12] * sc, v[16 * c + 13] * sc, v[16 * c + 14] * sc, v[16 * c + 15] * sc);
                *(u32x4*)(dst8 + 32 * hf + 16 * c) = o; }
        }
        return;
    }
    bf16* dst = J.dst + (size_t)r * J.K + k0;
#pragma unroll
    for (int hf = 0; hf < 2; ++hf) {
        float v[32];
#pragma unroll
        for (int j = 0; j < 32; ++j) v[j] = W[(size_t)(32 * hf + j) * ld];
#pragma unroll
        for (int c = 0; c < 4; ++c) { u32x4 o; o.x = pk2(v[8 * c] * sc, v[8 * c + 1] * sc); o.y = pk2(v[8 * c + 2] * sc, v[8 * c + 3] * sc); o.z = pk2(v[8 * c + 4] * sc, v[8 * c + 5] * sc); o.w = pk2(v[8 * c + 6] * sc, v[8 * c + 7] * sc);
            *(u32x4*)(dst + 32 * hf + 8 * c) = o; }
    }
}
__device__ __forceinline__ int t5_bucket(int d) {
    if (d < 16) return d;
    int b = 16 + (int)(log((double)d / 16.0) / log(128.0) * 16.0);
    return b < 16 ? 16 : (b > 31 ? 31 : b);
}
__device__ __forceinline__ void p_prologue(Frame& F, const Args& a) {
    unsigned char* gl_ = (unsigned char*)F.lds;
    Job* jobs = (Job*)(gl_ + 7 * 16384 + 8704);
    int* tot = (int*)(gl_ + 7 * 16384 + 8704 + NJOBS * sizeof(Job));
    static_assert(8704 + NJOBS * sizeof(Job) + 16 <= 16384, "job table fits");
    if (F.tid < NJOBS) { Job J; make_job(a, F.tid, J); jobs[F.tid] = J; }
    __syncthreads();
    if (F.tid == 0) { int s = 0; for (int j = 0; j < NJOBS; ++j) { jobs[j].start = s; s += (jobs[j].K / 64) * (jobs[j].N / 64); } tot[0] = s; }
    __syncthreads();
    const int total = tot[0];
    const int gw = F.vcu * NWAVES + F.wave, NGW = F.G * NWAVES;
    int jc = 0;
    for (int it = gw; it < total; it += NGW) {
        while (jc + 1 < NJOBS && jobs[jc + 1].start <= it) ++jc;
        const Job J = jobs[jc];
        transpose_item(J, it - J.start, F.lane);
    }
    { bf16* hb = (bf16*)(F.ws + WS_HB); const float* x = a.in[0]; unsigned char* hb8 = F.ws + WS_SCR + S_HB8;
      for (int m0 = 4 * gw; m0 < T; m0 += 4 * NGW) { f32x4 v[4][4];
#pragma unroll
          for (int k = 0; k < 4; ++k) { const f32x4* xr = (const f32x4*)(x + (size_t)(m0 + k) * D) + F.lane;
#pragma unroll
              for (int j = 0; j < 4; ++j) v[k][j] = xr[64 * j]; }
#pragma unroll
          for (int k = 0; k < 4; ++k) { unsigned long long* o8 = (unsigned long long*)(hb + (size_t)(m0 + k) * D) + F.lane;
#pragma unroll
              for (int j = 0; j < 4; ++j) o8[64 * j] = (unsigned long long)pk2(v[k][j].x, v[k][j].y) | ((unsigned long long)pk2(v[k][j].z, v[k][j].w) << 32);
              unsigned* o4 = (unsigned*)(hb8 + (size_t)(m0 + k) * D) + F.lane;
#pragma unroll
              for (int j = 0; j < 4; ++j) o4[64 * j] = pk4_fp8(v[k][j].x, v[k][j].y, v[k][j].z, v[k][j].w); } } }
    const int gt = blockIdx.x * 512 + F.tid, NGT = F.G * 512;
    const float* rel = a.in[1];
    float* btA = (float*)(F.ws + WS_BTABA); float* btC = (float*)(F.ws + WS_BTABC);
    for (int i = gt; i < 48 * 132; i += NGT) { const int gh = i / 132, dl = i % 132, g = gh >> 4, hh = gh & 15; const int dil = g == 0 ? 1 : (g == 1 ? 4 : 16);
        btA[i] = dl <= 128 ? rel[t5_bucket(dl * dil) * NH + hh] * LOG2E : 0.f; }
    for (int i = gt; i < 16 * 2048; i += NGT) { const int hh = i >> 11, dd = i & 2047; btC[i] = rel[t5_bucket(dd) * NH + hh] * LOG2E; }
    { bf16* wst = (bf16*)(F.ws + WS_WST); const float* wsrc = a.in[14];
      for (int i = gt; i < 8 * 128 * 128; i += NGT) { const int tt = (i >> 7) & 127, ss = i & 127; wst[i] = (bf16)f2bf(ss <= tt ? wsrc[i] : 0.f); } }
}

__device__ __forceinline__ void unpack8(const u32x4 a, float* x) { x[0] = bflo(a.x); x[1] = bfhi(a.x); x[2] = bflo(a.y); x[3] = bfhi(a.y); x[4] = bflo(a.z); x[5] = bfhi(a.z); x[6] = bflo(a.w); x[7] = bfhi(a.w); }
template <int MODE, bool ROUTE, bool FINAL, bool HB8 = false>
__device__ __forceinline__ void ln_phase(Frame& F, const float* gain, const float* bias, const float* wr) {
    constexpr int NBT = 2;
    const int gw = F.vcu * NWAVES + F.wave, NGW = F.G * NWAVES, lane = F.lane;
    bf16* hb = (bf16*)(F.ws + WS_HB); const bf16* zb = (const bf16*)F.out;
    float gv[16], bv[16];
#pragma unroll
    for (int k = 0; k < 2; ++k)
#pragma unroll
        for (int j = 0; j < 2; ++j) { const f32x4 g4 = *(const f32x4*)(gain + 512 * k + 8 * lane + 4 * j), b4 = *(const f32x4*)(bias + 512 * k + 8 * lane + 4 * j);
            gv[8 * k + 4 * j] = g4.x; gv[8 * k + 4 * j + 1] = g4.y; gv[8 * k + 4 * j + 2] = g4.z; gv[8 * k + 4 * j + 3] = g4.w;
            bv[8 * k + 4 * j] = b4.x; bv[8 * k + 4 * j + 1] = b4.y; bv[8 * k + 4 * j + 2] = b4.z; bv[8 * k + 4 * j + 3] = b4.w; }
    LAS float* wrT = (LAS float*)F.lds;
    if (ROUTE) { for (int i = F.tid; i < 8 * 1024; i += 512) { const int e = i >> 10, c = i & 1023; wrT[i] = wr[c * 8 + e]; } __syncthreads(); }
    const unsigned char* ys = F.ws + WS_SCR + S_XG;
    const int* slots = (const int*)(F.ws + WS_SLOTS); const float* gates = (const float*)(F.ws + WS_GATES);
    int* route = (int*)(F.ws + WS_ROUTE); float* gout = (float*)(F.ws + WS_GATES);
    for (int grp = gw; grp < T / 32; grp += NGW) {
        int cnt_e = 0;
        int my_e1 = 0, my_e2 = 0, my_r1 = 0, my_r2 = 0; float my_g1 = 0.f, my_g2 = 0.f;
        int sl0 = 0, sl1 = 0; float gg0 = 0.f, gg1 = 0.f;
        if (MODE == 2) { const int mm = grp * 32 + (lane & 31); sl0 = slots[2 * mm]; sl1 = slots[2 * mm + 1]; gg0 = gates[2 * mm]; gg1 = gates[2 * mm + 1]; }
        for (int i0 = 0; i0 < 32; i0 += NBT) {
            float v[NBT][16]; float st[NBT][2];
#pragma unroll
            for (int k = 0; k < NBT; ++k) { const int m = grp * 32 + i0 + k;
                if (MODE == 0) { const u32x4* zr = (const u32x4*)(zb + (size_t)m * D) + lane; unpack8(zr[0], v[k]); unpack8(zr[64], v[k] + 8); }
                else { const u32x4* hr = (const u32x4*)(hb + (size_t)m * D) + lane; unpack8(hr[0], v[k]); unpack8(hr[64], v[k] + 8);
#pragma unroll
                    for (int j = 0; j < 16; ++j) v[k][j] *= ALPHA;
                    if (MODE == 3) { const u32x4* yr = (const u32x4*)((const bf16*)(F.ws + WS_SCR + S_Y) + (size_t)m * D) + lane; float a[16]; unpack8(yr[0], a); unpack8(yr[64], a + 8);
#pragma unroll
                        for (int j = 0; j < 16; ++j) v[k][j] += a[j]; }
                    if (MODE == 2) { const int s0 = __builtin_amdgcn_readlane(sl0, i0 + k), s1 = __builtin_amdgcn_readlane(sl1, i0 + k);
                        const float g0 = __builtin_bit_cast(float, __builtin_amdgcn_readlane(__builtin_bit_cast(int, gg0), i0 + k)), g1 = __builtin_bit_cast(float, __builtin_amdgcn_readlane(__builtin_bit_cast(int, gg1), i0 + k));
                        const u32x2* y0 = (const u32x2*)(ys + (size_t)s0 * D) + lane; const u32x2* y1 = (const u32x2*)(ys + (size_t)s1 * D) + lane;
                        const u32x2 ya0 = y0[0], ya1 = y0[64], yb0 = y1[0], yb1 = y1[64];
                        float a[16], b[16];
#pragma unroll
                        for (int c = 0; c < 2; ++c) { const unsigned wa0 = c ? ya0.y : ya0.x, wa1 = c ? ya1.y : ya1.x, wb0 = c ? yb0.y : yb0.x, wb1 = c ? yb1.y : yb1.x;
                            f32x2 t;
                            t = __builtin_amdgcn_cvt_pk_f32_fp8((int)wa0, false); a[4 * c] = t.x; a[4 * c + 1] = t.y; t = __builtin_amdgcn_cvt_pk_f32_fp8((int)wa0, true); a[4 * c + 2] = t.x; a[4 * c + 3] = t.y;
                            t = __builtin_amdgcn_cvt_pk_f32_fp8((int)wa1, false); a[8 + 4 * c] = t.x; a[8 + 4 * c + 1] = t.y; t = __builtin_amdgcn_cvt_pk_f32_fp8((int)wa1, true); a[8 + 4 * c + 2] = t.x; a[8 + 4 * c + 3] = t.y;
                            t = __builtin_amdgcn_cvt_pk_f32_fp8((int)wb0, false); b[4 * c] = t.x; b[4 * c + 1] = t.y; t = __builtin_amdgcn_cvt_pk_f32_fp8((int)wb0, true); b[4 * c + 2] = t.x; b[4 * c + 3] = t.y;
                            t = __builtin_amdgcn_cvt_pk_f32_fp8((int)wb1, false); b[8 + 4 * c] = t.x; b[8 + 4 * c + 1] = t.y; t = __builtin_amdgcn_cvt_pk_f32_fp8((int)wb1, true); b[8 + 4 * c + 2] = t.x; b[8 + 4 * c + 3] = t.y; }
                        const float h0 = g0 * (1.f / YSCALE8), h1 = g1 * (1.f / YSCALE8);
#pragma unroll
                        for (int j = 0; j < 16; ++j) v[k][j] += h0 * a[j] + h1 * b[j]; } }
                float s = 0.f, q2 = 0.f;
#pragma unroll
                for (int j = 0; j < 16; ++j) { s += v[k][j]; q2 += v[k][j] * v[k][j]; }
                st[k][0] = s; st[k][1] = q2; }
#pragma unroll
            for (int o = 1; o < 64; o <<= 1) {
#pragma unroll
                for (int k = 0; k < NBT; ++k) { st[k][0] += __shfl_xor(st[k][0], o); st[k][1] += __shfl_xor(st[k][1], o); } }
#pragma unroll
            for (int k = 0; k < NBT; ++k) { const int m = grp * 32 + i0 + k;
                const float mean = st[k][0] * (1.f / D), var = fmaxf(st[k][1] * (1.f / D) - mean * mean, 0.f), rstd = 1.f / sqrtf(var + LN_EPS);
#pragma unroll
                for (int j = 0; j < 16; ++j) v[k][j] = (v[k][j] - mean) * rstd * gv[j] + bv[j];
                if (FINAL) { f32x4* orow = (f32x4*)(F.out + (size_t)m * D) + 2 * lane;
                    orow[0] = (f32x4){v[k][0], v[k][1], v[k][2], v[k][3]}; orow[1] = (f32x4){v[k][4], v[k][5], v[k][6], v[k][7]}; orow[128] = (f32x4){v[k][8], v[k][9], v[k][10], v[k][11]}; orow[129] = (f32x4){v[k][12], v[k][13], v[k][14], v[k][15]}; }
                else { u32x4* o = (u32x4*)(hb + (size_t)m * D) + lane; u32x4 a, b;
                    a.x = pk2(v[k][0], v[k][1]); a.y = pk2(v[k][2], v[k][3]); a.z = pk2(v[k][4], v[k][5]); a.w = pk2(v[k][6], v[k][7]); b.x = pk2(v[k][8], v[k][9]); b.y = pk2(v[k][10], v[k][11]); b.z = pk2(v[k][12], v[k][13]); b.w = pk2(v[k][14], v[k][15]);
                    o[0] = a; o[64] = b;
                    if (HB8) { u32x2* o8 = (u32x2*)(F.ws + WS_SCR + S_HB8 + (size_t)m * D) + lane; u32x2 c, d;
                        c.x = pk4_fp8(v[k][0], v[k][1], v[k][2], v[k][3]); c.y = pk4_fp8(v[k][4], v[k][5], v[k][6], v[k][7]); d.x = pk4_fp8(v[k][8], v[k][9], v[k][10], v[k][11]); d.y = pk4_fp8(v[k][12], v[k][13], v[k][14], v[k][15]);
                        o8[0] = c; o8[64] = d; } }
                if (ROUTE) {
                    float lg[8];
#pragma unroll
                    for (int e = 0; e < 8; ++e) { float p = 0.f;
#pragma unroll
                        for (int kk = 0; kk < 2; ++kk)
#pragma unroll
                            for (int j = 0; j < 2; ++j) { const f32x4 w4 = *(const LAS f32x4*)(wrT + e * 1024 + 512 * kk + 8 * lane + 4 * j); p += (v[k][8 * kk + 4 * j] * w4.x + v[k][8 * kk + 4 * j + 1] * w4.y) + (v[k][8 * kk + 4 * j + 2] * w4.z + v[k][8 * kk + 4 * j + 3] * w4.w); }
                        lg[e] = p; }
#pragma unroll
                    for (int o = 1; o < 64; o <<= 1) {
#pragma unroll
                        for (int e = 0; e < 8; ++e) lg[e] += __shfl_xor(lg[e], o); }
                    int e1 = 0; float v1 = lg[0];
#pragma unroll
                    for (int e = 1; e < 8; ++e) if (lg[e] > v1) { v1 = lg[e]; e1 = e; }
                    int e2 = -1; float v2 = -3.4e38f;
#pragma unroll
                    for (int e = 0; e < 8; ++e) if (e != e1 && lg[e] > v2) { v2 = lg[e]; e2 = e; }
                    const float g2 = 1.f / (1.f + __expf(v1 - v2)), g1 = 1.f - g2;
                    const int r1 = __shfl(cnt_e, e1); if (lane == e1) ++cnt_e;
                    const int r2 = __shfl(cnt_e, e2); if (lane == e2) ++cnt_e;
                    if (lane == i0 + k) { my_e1 = e1; my_e2 = e2; my_r1 = r1; my_r2 = r2; my_g1 = g1; my_g2 = g2; }
                }
            }
        }
        if (ROUTE) {
            if (lane < 8) ((int*)(F.ws + WS_WCNT))[grp * 8 + lane] = cnt_e;
            if (lane < 32) { const int m = grp * 32 + lane; int* r = route + 4 * m; r[0] = my_e1; r[1] = my_r1; r[2] = my_e2; r[3] = my_r2; gout[2 * m] = my_g1; gout[2 * m + 1] = my_g2; }
        }
    }
}

__device__ __forceinline__ f32x16 mfma32(bf16x8 a, bf16x8 b, f32x16 c) { return __builtin_amdgcn_mfma_f32_32x32x16_bf16(a, b, c, 0, 0, 0); }
__device__ __forceinline__ bf16x8 pack8(const f32x16& s, int b0) {
    u32x4 w; w.x = pg8::cvt_pk_bf16(s[b0], s[b0 + 1]); w.y = pg8::cvt_pk_bf16(s[b0 + 2], s[b0 + 3]); w.z = pg8::cvt_pk_bf16(s[b0 + 4], s[b0 + 5]); w.w = pg8::cvt_pk_bf16(s[b0 + 6], s[b0 + 7]);
    return __builtin_bit_cast(bf16x8, w);
}
__device__ __forceinline__ float max16(const f32x16& s) {
    float a = fmaxf(fmaxf(s[0], s[1]), fmaxf(s[2], s[3])), b = fmaxf(fmaxf(s[4], s[5]), fmaxf(s[6], s[7]));
    float c = fmaxf(fmaxf(s[8], s[9]), fmaxf(s[10], s[11])), d = fmaxf(fmaxf(s[12], s[13]), fmaxf(s[14], s[15]));
    return fmaxf(fmaxf(a, b), fmaxf(c, d));
}
__device__ __forceinline__ void softmax_pv(f32x16& s, float& m_run, float& l_run, f32x16& o0, f32x16& o1, const bf16* vt0, const bf16* vt1, int h) {
    float mx = max16(s); mx = fmaxf(mx, __shfl_xor(mx, 32));
    const float mn = fmaxf(m_run, mx), alpha = __builtin_amdgcn_exp2f(m_run - mn); m_run = mn;
    float ps = 0.f;
#pragma unroll
    for (int r = 0; r < 16; ++r) { const float p = __builtin_amdgcn_exp2f(s[r] - mn); s[r] = p; ps += p; }
    l_run = l_run * alpha + ps;
#pragma unroll
    for (int r = 0; r < 16; ++r) { o0[r] *= alpha; o1[r] *= alpha; }
    const bf16x8 p0 = pack8(s, 0), p1 = pack8(s, 8);
    const bf16x8 v00 = *(const bf16x8*)(vt0 + 8 * h), v01 = *(const bf16x8*)(vt0 + 16 + 8 * h), v10 = *(const bf16x8*)(vt1 + 8 * h), v11 = *(const bf16x8*)(vt1 + 16 + 8 * h);
    o0 = mfma32(v00, p0, o0); o0 = mfma32(v01, p1, o0);
    o1 = mfma32(v10, p0, o1); o1 = mfma32(v11, p1, o1);
}
__device__ __forceinline__ int kperm(int i) { return (i & 19) | ((i & 8) >> 1) | ((i & 4) << 1); }

__device__ __forceinline__ void dil_attn_phase(Frame& F) {
    LAS float* bt = (LAS float*)F.lds;
    { const float* btA = (const float*)(F.ws + WS_BTABA); for (int i = F.tid; i < 48 * 192; i += 512) { const int gh = i / 192, dl = i % 192 - 32; bt[i] = (dl >= 0 && dl <= 128) ? btA[gh * 132 + dl] : NEGB; } }
    __syncthreads();
    const int gw = F.vcu * NWAVES + F.wave, NGW = F.G * NWAVES, lane = F.lane, q = lane & 31, h = lane >> 5;
    const bf16* QK = (const bf16*)(F.ws + WS_SCR + S_QK); const bf16* VT = (const bf16*)(F.ws + WS_SCR + S_VT);
    bf16* OG = (bf16*)((unsigned char*)F.out + O_OG); float* LSE = (float*)((unsigned char*)F.out + O_LSE);
    constexpr int NTASK = 3 * 16 * 8 * 64;
    const int per = (NTASK + NGW - 1) / NGW;
    const int t_lo = gw * per, t_hi = (t_lo + per) < NTASK ? (t_lo + per) : NTASK;
    for (int task = t_lo; task < t_hi; ++task) {
        const int qt = task & 3, rn = (task >> 2) & 15, bl = (task >> 6) & 7, gh = task >> 9, g = gh >> 4, hh = gh & 15;
        const int nblk = 16 >> (2 * g); const bool has_prev = (rn & (nblk - 1)) != 0;
        const int n0 = bl * 2048 + rn * 128;
        const bf16* qrow = QK + ((size_t)g * TC + n0 + 32 * qt + q) * 2048 + hh * 64;
        bf16x8 qf[4];
#pragma unroll
        for (int d0 = 0; d0 < 4; ++d0) qf[d0] = *(const bf16x8*)(qrow + d0 * 16 + 8 * h);
        float m_run = NEGB, l_run = 0.f; f32x16 o0 = {}, o1 = {};
        const bf16* vbase0 = VT + ((size_t)g * 1024 + hh * 64 + q) * TC; const bf16* vbase1 = vbase0 + (size_t)32 * TC;
        const LAS float* btl = bt + gh * 192 + (q - 8 * h + 137);
#pragma unroll
        for (int t = 0; t < 5; ++t) {
            if (has_prev || qt + t > 3) {
                const int kr0 = n0 - 128 + 32 * qt + 32 * t;
                const bf16* krow = QK + ((size_t)g * TC + kr0 + kperm(q)) * 2048 + 1024 + hh * 64;
                f32x16 s;
#pragma unroll
                for (int r = 0; r < 16; ++r) s[r] = btl[-32 * t + 23 - 16 * (r >> 3) - (r & 7)];
#pragma unroll
                for (int d0 = 0; d0 < 4; ++d0) { const bf16x8 kf = *(const bf16x8*)(krow + d0 * 16 + 8 * h); s = mfma32(kf, qf[d0], s); }
                softmax_pv(s, m_run, l_run, o0, o1, vbase0 + kr0, vbase1 + kr0, h);
            }
        }
        const float l_tot = l_run + __shfl_xor(l_run, 32), inv = 1.f / l_tot;
        const size_t orow = (size_t)g * TC + n0 + 32 * qt + q;
        bf16* op = OG + orow * 1024 + hh * 64 + 4 * h;
#pragma unroll
        for (int gq = 0; gq < 4; ++gq) {
            u32x2 w0, w1; w0.x = pg8::cvt_pk_bf16(o0[4 * gq] * inv, o0[4 * gq + 1] * inv); w0.y = pg8::cvt_pk_bf16(o0[4 * gq + 2] * inv, o0[4 * gq + 3] * inv);
            w1.x = pg8::cvt_pk_bf16(o1[4 * gq] * inv, o1[4 * gq + 1] * inv); w1.y = pg8::cvt_pk_bf16(o1[4 * gq + 2] * inv, o1[4 * gq + 3] * inv);
            *(u32x2*)(op + 8 * gq) = w0; *(u32x2*)(op + 32 + 8 * gq) = w1; }
        if (h == 0) LSE[orow * 16 + hh] = m_run + __log2f(l_tot);
    }
}
__device__ __forceinline__ void dil_merge_phase(Frame& F, int ck) {
    const int gw = F.vcu * NWAVES + F.wave, NGW = F.G * NWAVES, lane = F.lane;
    const bf16* OG = (const bf16*)((unsigned char*)F.out + O_OG); const float* LSE = (const float*)((unsigned char*)F.out + O_LSE);
    unsigned char* att = F.ws + WS_SCR + S_ATT + (size_t)ck * TC * 1024;
    const int hh = lane >> 2;
    for (int tl0 = 2 * gw; tl0 < TC; tl0 += 2 * NGW) {
        size_t n[2][3]; float ls[2][3]; u32x4 x[2][3];
#pragma unroll
        for (int k = 0; k < 2; ++k) { const int tl = tl0 + k, bl = tl >> 11, tt = tl & 2047;
            n[k][0] = tl; n[k][1] = bl * 2048 + (tt & 3) * 512 + (tt >> 2); n[k][2] = bl * 2048 + (tt & 15) * 128 + (tt >> 4);
#pragma unroll
            for (int g = 0; g < 3; ++g) { ls[k][g] = LSE[((size_t)g * TC + n[k][g]) * 16 + hh]; x[k][g] = *(const u32x4*)((const unsigned char*)OG + ((size_t)g * TC + n[k][g]) * 1024 + 16 * lane); } }
#pragma unroll
        for (int k = 0; k < 2; ++k) {
            const float M = fmaxf(fmaxf(ls[k][0], ls[k][1]), ls[k][2]);
            float w[3]; float W = 0.f;
#pragma unroll
            for (int g = 0; g < 3; ++g) { w[g] = __builtin_amdgcn_exp2f(ls[k][g] - M); W += w[g]; }
            const float iw = 1.f / W;
            float acc[16];
#pragma unroll
            for (int j = 0; j < 16; ++j) acc[j] = 0.f;
#pragma unroll
            for (int g = 0; g < 3; ++g) { const float wg = w[g] * iw; float a[16];
#pragma unroll
                for (int c = 0; c < 4; ++c) { const f32x2 lo = __builtin_amdgcn_cvt_pk_f32_fp8((int)x[k][g][c], false), hi = __builtin_amdgcn_cvt_pk_f32_fp8((int)x[k][g][c], true); a[4 * c] = lo.x; a[4 * c + 1] = lo.y; a[4 * c + 2] = hi.x; a[4 * c + 3] = hi.y; }
#pragma unroll
                for (int j = 0; j < 16; ++j) acc[j] += wg * a[j]; }
            u32x4 y; y.x = pk4_fp8(acc[0], acc[1], acc[2], acc[3]); y.y = pk4_fp8(acc[4], acc[5], acc[6], acc[7]); y.z = pk4_fp8(acc[8], acc[9], acc[10], acc[11]); y.w = pk4_fp8(acc[12], acc[13], acc[14], acc[15]);
            *(u32x4*)(att + (size_t)(tl0 + k) * 1024 + 16 * lane) = y;
        }
    }
}

__device__ __forceinline__ void conv_phase(Frame& F, const float* cw) {
    const int gw = F.vcu * NWAVES + F.wave, NGW = F.G * NWAVES, lane = F.lane;
    const bf16* gbp = (const bf16*)(F.ws + WS_SCR + S_BCX); const bf16* up = (const bf16*)(F.ws + WS_SCR + S_BCX + (size_t)128 * MiB); bf16* p = (bf16*)(F.ws + WS_SCR + S_P);
    for (int item = gw; item < (T / 32) * 2; item += NGW) {
        const int half = item & 1, tb = item >> 1, t0 = tb * 32, c0 = half * 512 + lane * 8;
        float w0[8], w1[8], w2[8];
#pragma unroll
        for (int j = 0; j < 8; ++j) { w0[j] = cw[c0 + j]; w1[j] = cw[1024 + c0 + j]; w2[j] = cw[2048 + c0 + j]; }
        float u1[8], u2[8];
        const bool first = (t0 & 2047) == 0;
#pragma unroll
        for (int j = 0; j < 8; ++j) { u1[j] = 0.f; u2[j] = 0.f; }
        if (!first) { unpack8(*(const u32x4*)(up + (size_t)(t0 - 2) * 1024 + c0), u2); unpack8(*(const u32x4*)(up + (size_t)(t0 - 1) * 1024 + c0), u1); }
        for (int i = 0; i < 32; ++i) { const size_t r = (size_t)(t0 + i) * 1024;
            const u32x4 gb = *(const u32x4*)(gbp + r + c0), uu = *(const u32x4*)(up + r + c0);
            float u0[8], b[8]; unpack8(uu, u0); unpack8(gb, b);
            float o[8];
#pragma unroll
            for (int j = 0; j < 8; ++j) { o[j] = b[j] * (w0[j] * u2[j] + w1[j] * u1[j] + w2[j] * u0[j]); u2[j] = u1[j]; u1[j] = u0[j]; }
            u32x4 x; x.x = pk2(o[0], o[1]); x.y = pk2(o[2], o[3]); x.z = pk2(o[4], o[5]); x.w = pk2(o[6], o[7]);
            *(u32x4*)(p + (size_t)(t0 + i) * 1024 + c0) = x; }
    }
}

__device__ __forceinline__ void kmean_phase(Frame& F) {
    const int gw = F.vcu * NWAVES + F.wave, NGW = F.G * NWAVES, lane = F.lane;
    const bf16* QK = (const bf16*)(F.ws + WS_SCR + S_CQK); float* km = (float*)(F.ws + WS_KMEAN);
    const int kq = lane >> 3, dc = lane & 7;
    for (int u = gw; u < NB * NH * 8; u += NGW) { const int blk = u & 7, hh = (u >> 3) & 15, b = u >> 7;
        float a[8];
#pragma unroll
        for (int j = 0; j < 8; ++j) a[j] = 0.f;
        const bf16* kp = QK + ((size_t)b * SEQ + blk * 256 + kq) * 2048 + 1024 + hh * 64 + dc * 8;
#pragma unroll 8
        for (int i = 0; i < 32; ++i) { const u32x4 x = *(const u32x4*)(kp + (size_t)i * 8 * 2048);
            a[0] += bflo(x.x); a[1] += bfhi(x.x); a[2] += bflo(x.y); a[3] += bfhi(x.y); a[4] += bflo(x.z); a[5] += bfhi(x.z); a[6] += bflo(x.w); a[7] += bfhi(x.w); }
#pragma unroll
        for (int j = 0; j < 8; ++j) { a[j] += __shfl_xor(a[j], 8); a[j] += __shfl_xor(a[j], 16); a[j] += __shfl_xor(a[j], 32); }
        if (lane < 8) { float* o = km + (size_t)u * 64 + lane * 8;
#pragma unroll
            for (int j = 0; j < 8; ++j) o[j] = a[j] * (1.f / 256.f); }
    }
}
__device__ __forceinline__ void moba_unit(Frame& F, int b, int hh, int nb, LAS float* bt, int& cur_h) {
    const int lane = F.lane, q = lane & 31, h = lane >> 5, w = F.wave;
    const bf16* QK = (const bf16*)(F.ws + WS_SCR + S_CQK); const bf16* VT = (const bf16*)(F.ws + WS_SCR + S_CVT);
    bf16* att = (bf16*)(F.ws + WS_SCR + S_CATT); const float* km = (const float*)(F.ws + WS_KMEAN);
    if (hh != cur_h) { __syncthreads(); const float* btC = (const float*)(F.ws + WS_BTABC) + hh * 2048; for (int i = F.tid; i < 2048; i += 512) bt[i] = btC[i]; cur_h = hh; __syncthreads(); }
    const size_t tq = (size_t)b * SEQ + nb * 256 + 32 * w + q;
    const bf16* qrow = QK + tq * 2048 + hh * 64;
    bf16x8 qf[4];
#pragma unroll
    for (int d0 = 0; d0 < 4; ++d0) qf[d0] = *(const bf16x8*)(qrow + d0 * 16 + 8 * h);
    unsigned sel = 0;
    if (nb > 0) {
        float gsc[7];
#pragma unroll
        for (int m = 0; m < 7; ++m) { float s = 0.f;
            if (m < nb) { const float* kmp = km + (((size_t)b * NH + hh) * 8 + m) * 64;
#pragma unroll
                for (int d0 = 0; d0 < 4; ++d0) { const f32x4 k0 = *(const f32x4*)(kmp + d0 * 16 + 8 * h), k1 = *(const f32x4*)(kmp + d0 * 16 + 8 * h + 4); const u32x4 qq = __builtin_bit_cast(u32x4, qf[d0]);
                    s += bflo(qq.x) * k0.x + bfhi(qq.x) * k0.y + bflo(qq.y) * k0.z + bfhi(qq.y) * k0.w + bflo(qq.z) * k1.x + bfhi(qq.z) * k1.y + bflo(qq.w) * k1.z + bfhi(qq.w) * k1.w; }
                s += __shfl_xor(s, 32); }
            gsc[m] = m < nb ? s : -3.0e38f; }
        const int nsel = nb < 3 ? nb : 3;
#pragma unroll
        for (int r = 0; r < 3; ++r) { if (r < nsel) { int bi = -1; float bv = -3.4e38f;
#pragma unroll
                for (int m = 0; m < 7; ++m) if (!((sel >> m) & 1u) && gsc[m] > bv) { bv = gsc[m]; bi = m; }
                sel |= 1u << bi; } }
    }
#ifdef MK_SELFCHECK
    if (h == 0) ((unsigned*)(F.ws + WS_NEED + 3 * MiB))[tq * 16 + hh] = sel;
#endif
    float m_run = NEGB, l_run = 0.f; f32x16 o0 = {}, o1 = {};
    const bf16* vbase0 = VT + ((size_t)hh * 64 + q) * T + (size_t)b * SEQ; const bf16* vbase1 = vbase0 + (size_t)32 * T;
    const int qpos = nb * 256 + 32 * w + q;
    for (int m = 0; m < nb; ++m) {
        const bool mine = (sel >> m) & 1u;
        if (__ballot(mine) == 0ull) continue;
        for (int kt = 0; kt < 8; ++kt) {
            const int kr0 = m * 256 + 32 * kt;
            const bf16* krow = QK + ((size_t)b * SEQ + kr0 + kperm(q)) * 2048 + 1024 + hh * 64;
            f32x16 s = {};
#pragma unroll
            for (int d0 = 0; d0 < 4; ++d0) { const bf16x8 kf = *(const bf16x8*)(krow + d0 * 16 + 8 * h); s = mfma32(kf, qf[d0], s); }
#pragma unroll
            for (int r = 0; r < 16; ++r) { const int kap = 16 * (r >> 3) + 8 * h + (r & 7); const float bb = bt[qpos - kr0 - kap]; s[r] = mine ? s[r] + bb : NEGB; }
            softmax_pv(s, m_run, l_run, o0, o1, vbase0 + kr0, vbase1 + kr0, h);
        }
    }
    for (int kt = 0; kt <= w; ++kt) {
        const int kr0 = nb * 256 + 32 * kt;
        const bf16* krow = QK + ((size_t)b * SEQ + kr0 + kperm(q)) * 2048 + 1024 + hh * 64;
        f32x16 s = {};
#pragma unroll
        for (int d0 = 0; d0 < 4; ++d0) { const bf16x8 kf = *(const bf16x8*)(krow + d0 * 16 + 8 * h); s = mfma32(kf, qf[d0], s); }
#pragma unroll
        for (int r = 0; r < 16; ++r) { const int kap = 16 * (r >> 3) + 8 * h + (r & 7); const int dd = qpos - kr0 - kap; const float bb = bt[dd < 0 ? 0 : dd]; s[r] = dd >= 0 ? s[r] + bb : NEGB; }
        softmax_pv(s, m_run, l_run, o0, o1, vbase0 + kr0, vbase1 + kr0, h);
    }
    const float l_tot = l_run + __shfl_xor(l_run, 32), inv = 1.f / l_tot;
#ifdef MK_SELFCHECK
    if (h == 0) ((float*)(F.ws + WS_NEED + 7 * MiB))[tq * 16 + hh] = m_run + __log2f(l_tot);
#endif
    bf16* op = att + tq * 1024 + hh * 64 + 4 * h;
#pragma unroll
    for (int gq = 0; gq < 4; ++gq) {
        u32x2 w0, w1; w0.x = pg8::cvt_pk_bf16(o0[4 * gq] * inv, o0[4 * gq + 1] * inv); w0.y = pg8::cvt_pk_bf16(o0[4 * gq + 2] * inv, o0[4 * gq + 3] * inv);
        w1.x = pg8::cvt_pk_bf16(o1[4 * gq] * inv, o1[4 * gq + 1] * inv); w1.y = pg8::cvt_pk_bf16(o1[4 * gq + 2] * inv, o1[4 * gq + 3] * inv);
        *(u32x2*)(op + 8 * gq) = w0; *(u32x2*)(op + 32 + 8 * gq) = w1; }
}
__device__ __forceinline__ void moba_phase(Frame& F) {
    LAS float* bt = (LAS float*)F.lds; int cur_h = -1;
    const int NP = NB * NH * 4, per = (NP + F.G - 1) / F.G;
    const int lo = F.vcu * per, hi = (lo + per) < NP ? (lo + per) : NP;
    for (int pu = lo; pu < hi; ++pu) { const int j = pu & 3, hh = (pu >> 2) & 15, b = pu >> 6;
        moba_unit(F, b, hh, 7 - j, bt, cur_h); moba_unit(F, b, hh, j, bt, cur_h); }
}


constexpr int AKP = 72;
constexpr int ATILE = 64 * AKP * 2;
struct AttnSt { float m, l; f32x16 o0, o1; };
template <bool MASKED>
__device__ __forceinline__ void attn_tile(const LAS bf16* Kt, const LAS bf16* Vt, const LAS float* bl, const bf16x8 (&qf)[4], AttnSt& st, int q, int h, bool mine) {
    f32x16 s;
#pragma unroll
    for (int r = 0; r < 16; ++r) s[r] = bl[23 - 16 * (r >> 3) - (r & 7)];
    const LAS bf16* kr = Kt + kperm(q) * AKP + 8 * h;
#pragma unroll
    for (int d0 = 0; d0 < 4; ++d0) s = mfma32(*(const LAS bf16x8*)(kr + d0 * 16), qf[d0], s);
    float mx = max16(s); mx = fmaxf(mx, __shfl_xor(mx, 32));
    float mn = fmaxf(st.m, mx); if (MASKED) mn = mine ? mn : st.m;
    const float alpha = __builtin_amdgcn_exp2f(st.m - mn);
    float ps = 0.f;
#pragma unroll
    for (int r = 0; r < 16; ++r) { const float p = __builtin_amdgcn_exp2f(s[r] - mn); s[r] = p; ps += p; }
    bf16x8 p0 = pack8(s, 0), p1 = pack8(s, 8);
    if (MASKED) { if (!mine) { p0 = (bf16x8){0, 0, 0, 0, 0, 0, 0, 0}; p1 = p0; ps = 0.f; } }
    st.l = st.l * alpha + ps; st.m = mn;
    if (__ballot(alpha != 1.0f) != 0ull) {
#pragma unroll
        for (int r = 0; r < 16; ++r) { st.o0[r] *= alpha; st.o1[r] *= alpha; } }
    const LAS bf16* v0 = Vt + q * AKP + 8 * h; const LAS bf16* v1 = v0 + 32 * AKP;
    st.o0 = mfma32(*(const LAS bf16x8*)v0, p0, st.o0); st.o0 = mfma32(*(const LAS bf16x8*)(v0 + 16), p1, st.o0);
    st.o1 = mfma32(*(const LAS bf16x8*)v1, p0, st.o1); st.o1 = mfma32(*(const LAS bf16x8*)(v1 + 16), p1, st.o1);
}
__device__ __forceinline__ void attn_store(const AttnSt& st, bf16* op  , float inv) {
#pragma unroll
    for (int gq = 0; gq < 4; ++gq) {
        u32x2 w0, w1; w0.x = pg8::cvt_pk_bf16(st.o0[4 * gq] * inv, st.o0[4 * gq + 1] * inv); w0.y = pg8::cvt_pk_bf16(st.o0[4 * gq + 2] * inv, st.o0[4 * gq + 3] * inv);
        w1.x = pg8::cvt_pk_bf16(st.o1[4 * gq] * inv, st.o1[4 * gq + 1] * inv); w1.y = pg8::cvt_pk_bf16(st.o1[4 * gq + 2] * inv, st.o1[4 * gq + 3] * inv);
        *(u32x2*)(op + 8 * gq) = w0; *(u32x2*)(op + 32 + 8 * gq) = w1; }
}

__device__ __forceinline__ void attn_store8(const AttnSt& st, unsigned char* op  , float inv) {
#pragma unroll
    for (int gq = 0; gq < 4; ++gq) {
        *(unsigned*)(op + 8 * gq) = pk4_fp8(st.o0[4 * gq] * inv, st.o0[4 * gq + 1] * inv, st.o0[4 * gq + 2] * inv, st.o0[4 * gq + 3] * inv);
        *(unsigned*)(op + 32 + 8 * gq) = pk4_fp8(st.o1[4 * gq] * inv, st.o1[4 * gq + 1] * inv, st.o1[4 * gq + 2] * inv, st.o1[4 * gq + 3] * inv); }
}

__device__ __forceinline__ void dil_attn_phase2(Frame& F) {
    LAS float* bt = (LAS float*)F.lds;
    { const float* btA = (const float*)(F.ws + WS_BTABA); for (int i = F.tid; i < 48 * 192; i += 512) { const int gh = i / 192, dl = i % 192 - 32; bt[i] = (dl >= 0 && dl <= 128) ? btA[gh * 132 + dl] : NEGB; } }
    __syncthreads();
    constexpr int TBL = 48 * 192 * 4;
    const int lane = F.lane, q = lane & 31, h = lane >> 5, w = F.wave, uw = w >> 2, qt = w & 3, t = F.tid, tu = t >> 8, tt = t & 255, srow = tt >> 3, sch = tt & 7;
    const bf16* QK = (const bf16*)(F.ws + WS_SCR + S_QK); const bf16* VT = (const bf16*)(F.ws + WS_SCR + S_VT);
    bf16* OG = (bf16*)((unsigned char*)F.out + O_OG); float* LSE = (float*)((unsigned char*)F.out + O_LSE);
    for (int du = F.vcu; du < 3072; du += F.G) {
        const int g = du >> 10, rem = du & 1023, hh = rem >> 6, blp = (rem >> 4) & 3, rn = rem & 15, gh = g * 16 + hh;
        const int nblk = 16 >> (2 * g); const bool has_prev = (rn & (nblk - 1)) != 0;
        const int j0 = has_prev ? 0 : 2;
        const int n0s = (2 * blp + tu) * 2048 + rn * 128;
        const bf16* ksrc = QK + ((size_t)g * TC + n0s - 128 + srow) * 2048 + 1024 + hh * 64 + sch * 8;
        const bf16* vsrc = VT + ((size_t)g * 1024 + hh * 64 + srow) * TC + (n0s - 128) + sch * 8;
        const int sdst = srow * AKP + sch * 8;
        const int n0 = (2 * blp + uw) * 2048 + rn * 128;
        const bf16* qrow = QK + ((size_t)g * TC + n0 + 32 * qt + q) * 2048 + hh * 64;
        bf16x8 qf[4];
#pragma unroll
        for (int d0 = 0; d0 < 4; ++d0) qf[d0] = *(const bf16x8*)(qrow + d0 * 16 + 8 * h);
        AttnSt st; st.m = NEGB; st.l = 0.f; st.o0 = (f32x16){}; st.o1 = (f32x16){};
        u32x4 k0, k1, v0, v1;
        k0 = *(const u32x4*)(ksrc + (size_t)(64 * j0) * 2048); k1 = *(const u32x4*)(ksrc + (size_t)(64 * j0 + 32) * 2048);
        v0 = *(const u32x4*)(vsrc + 64 * j0); v1 = *(const u32x4*)(vsrc + (size_t)32 * TC + 64 * j0);
        { LAS bf16* kb = (LAS bf16*)(F.lds + TBL + (0 * 2 + tu) * 2 * ATILE); LAS bf16* vb = kb + 64 * AKP;
          *(LAS u32x4*)(kb + sdst) = k0; *(LAS u32x4*)(kb + 32 * AKP + sdst) = k1; *(LAS u32x4*)(vb + sdst) = v0; *(LAS u32x4*)(vb + 32 * AKP + sdst) = v1; }
        __syncthreads();
        int pb = 0;
        for (int j = j0; j < 4; ++j) {
            const bool more = j + 1 < 4;
            if (more) { k0 = *(const u32x4*)(ksrc + (size_t)(64 * (j + 1)) * 2048); k1 = *(const u32x4*)(ksrc + (size_t)(64 * (j + 1) + 32) * 2048);
                        v0 = *(const u32x4*)(vsrc + 64 * (j + 1)); v1 = *(const u32x4*)(vsrc + (size_t)32 * TC + 64 * (j + 1)); }
            const LAS bf16* kb = (const LAS bf16*)(F.lds + TBL + (pb * 2 + uw) * 2 * ATILE); const LAS bf16* vb = kb + 64 * AKP;
#pragma unroll
            for (int t2 = 0; t2 < 2; ++t2) { const int t32 = 2 * j + t2;
                if (t32 >= qt && t32 <= qt + 4) {
                    const LAS float* bl = bt + gh * 192 + 32 + (32 * qt + q + 128 - 32 * t32 - 8 * h - 23);
                    attn_tile<false>(kb + 32 * t2 * AKP, vb + 32 * t2, bl, qf, st, q, h, true); } }
            if (more) { LAS bf16* kn = (LAS bf16*)(F.lds + TBL + ((pb ^ 1) * 2 + tu) * 2 * ATILE); LAS bf16* vn = kn + 64 * AKP;
                *(LAS u32x4*)(kn + sdst) = k0; *(LAS u32x4*)(kn + 32 * AKP + sdst) = k1; *(LAS u32x4*)(vn + sdst) = v0; *(LAS u32x4*)(vn + 32 * AKP + sdst) = v1; }
            __syncthreads();
            pb ^= 1;
        }
        const float l_tot = st.l + __shfl_xor(st.l, 32), inv = 1.f / l_tot;
        const size_t orow = (size_t)g * TC + n0 + 32 * qt + q;
        attn_store(st, OG + orow * 1024 + hh * 64 + 4 * h, inv);
        if (h == 0) LSE[orow * 16 + hh] = st.m + __log2f(l_tot);
    }
}

__device__ __forceinline__ void moba_unit2(Frame& F, int b, int hh, int nb, LAS float* bt, int& cur_h) {
    constexpr int TBL = 8448;
    const int lane = F.lane, q = lane & 31, h = lane >> 5, w = F.wave, t = F.tid, srow = t >> 3, sch = t & 7;
    const bf16* QK = (const bf16*)(F.ws + WS_SCR + S_CQK); const bf16* VT = (const bf16*)(F.ws + WS_SCR + S_CVT);
    bf16* att = (bf16*)(F.ws + WS_SCR + S_CATT); const float* km = (const float*)(F.ws + WS_KMEAN);
    if (hh != cur_h) { __syncthreads(); const float* btC = (const float*)(F.ws + WS_BTABC) + hh * 2048; for (int i = t; i < 2048 + 32; i += 512) bt[i] = i < 32 ? NEGB : btC[i - 32]; cur_h = hh; __syncthreads(); }
    const size_t tq = (size_t)b * SEQ + nb * 256 + 32 * w + q;
    const bf16* qrow = QK + tq * 2048 + hh * 64;
    bf16x8 qf[4];
#pragma unroll
    for (int d0 = 0; d0 < 4; ++d0) qf[d0] = *(const bf16x8*)(qrow + d0 * 16 + 8 * h);
    unsigned sel = 0;
    if (nb > 0) {
        float gsc[7];
#pragma unroll
        for (int m = 0; m < 7; ++m) { float s = 0.f;
            if (m < nb) { const float* kmp = km + (((size_t)b * NH + hh) * 8 + m) * 64;
#pragma unroll
                for (int d0 = 0; d0 < 4; ++d0) { const f32x4 k0 = *(const f32x4*)(kmp + d0 * 16 + 8 * h), k1 = *(const f32x4*)(kmp + d0 * 16 + 8 * h + 4); const u32x4 qq = __builtin_bit_cast(u32x4, qf[d0]);
                    s += bflo(qq.x) * k0.x + bfhi(qq.x) * k0.y + bflo(qq.y) * k0.z + bfhi(qq.y) * k0.w + bflo(qq.z) * k1.x + bfhi(qq.z) * k1.y + bflo(qq.w) * k1.z + bfhi(qq.w) * k1.w; }
                s += __shfl_xor(s, 32); }
            gsc[m] = m < nb ? s : -3.0e38f; }
        const int nsel = nb < 3 ? nb : 3;
#pragma unroll
        for (int r = 0; r < 3; ++r) { if (r < nsel) { int bi = 0; float bv = -3.4e38f;
#pragma unroll
                for (int m = 0; m < 7; ++m) if (!((sel >> m) & 1u) && gsc[m] > bv) { bv = gsc[m]; bi = m; }
                sel |= 1u << bi; } }
    }
    AttnSt st; st.m = NEGB; st.l = 0.f; st.o0 = (f32x16){}; st.o1 = (f32x16){};
    const int qpos = nb * 256 + 32 * w + q, nsteps = 4 * nb + 4;
    const bf16* ksrc = QK + ((size_t)b * SEQ + srow) * 2048 + 1024 + hh * 64 + sch * 8;
    const bf16* vsrc = VT + ((size_t)hh * 64 + srow) * T + (size_t)b * SEQ + sch * 8;
    const int sdst = srow * AKP + sch * 8;
    u32x4 kreg = *(const u32x4*)ksrc, vreg = *(const u32x4*)vsrc;
    { LAS bf16* kb = (LAS bf16*)(F.lds + TBL); *(LAS u32x4*)(kb + sdst) = kreg; *(LAS u32x4*)(kb + 64 * AKP + sdst) = vreg; }
    __syncthreads();
    int pb = 0;
    for (int s = 0; s < nsteps; ++s) {
        const bool more = s + 1 < nsteps;
        if (more) { kreg = *(const u32x4*)(ksrc + (size_t)(64 * (s + 1)) * 2048); vreg = *(const u32x4*)(vsrc + 64 * (s + 1)); }
        const LAS bf16* kb = (const LAS bf16*)(F.lds + TBL + pb * 2 * ATILE); const LAS bf16* vb = kb + 64 * AKP;
        if (s < 4 * nb) {
            const bool mine = (sel >> (s >> 2)) & 1u;
            if (__ballot(mine) != 0ull) {
#pragma unroll
                for (int t2 = 0; t2 < 2; ++t2) { const LAS float* bl = bt + 32 + (qpos - 8 * h - (64 * s + 32 * t2) - 23);
                    attn_tile<true>(kb + 32 * t2 * AKP, vb + 32 * t2, bl, qf, st, q, h, mine); } }
        } else {
#pragma unroll
            for (int t2 = 0; t2 < 2; ++t2) { const int t32 = (s - 4 * nb) * 2 + t2;
                if (t32 <= w) { const LAS float* bl = bt + 32 + (qpos - 8 * h - (64 * s + 32 * t2) - 23);
                    attn_tile<false>(kb + 32 * t2 * AKP, vb + 32 * t2, bl, qf, st, q, h, true); } }
        }
        if (more) { LAS bf16* kn = (LAS bf16*)(F.lds + TBL + (pb ^ 1) * 2 * ATILE); *(LAS u32x4*)(kn + sdst) = kreg; *(LAS u32x4*)(kn + 64 * AKP + sdst) = vreg; }
        __syncthreads();
        pb ^= 1;
    }
    const float l_tot = st.l + __shfl_xor(st.l, 32), inv = 1.f / l_tot;
    attn_store(st, att + tq * 1024 + hh * 64 + 4 * h, inv);
}
__device__ __forceinline__ void moba_phase2(Frame& F) {
    LAS float* bt = (LAS float*)F.lds; int cur_h = -1;
    const int NP = NB * NH * 4, per = (NP + F.G - 1) / F.G;
    const int lo = F.vcu * per, hi = (lo + per) < NP ? (lo + per) : NP;
    for (int pu = lo; pu < hi; ++pu) { const int j = pu & 3, hh = (pu >> 2) & 15, b = pu >> 6;
        moba_unit2(F, b, hh, 7 - j, bt, cur_h); moba_unit2(F, b, hh, j, bt, cur_h); }
}


__device__ __forceinline__ float xhalf_max(float m) { auto rr = __builtin_amdgcn_permlane32_swap(__float_as_uint(m), __float_as_uint(m), false, false); return fmaxf(__uint_as_float(rr[0]), __uint_as_float(rr[1])); }
__device__ __forceinline__ float xhalf_sum(float m) { auto rr = __builtin_amdgcn_permlane32_swap(__float_as_uint(m), __float_as_uint(m), false, false); return __uint_as_float(rr[0]) + __uint_as_float(rr[1]); }
template <bool MASKED>
__device__ __forceinline__ void attn_tile2(const LAS bf16* Kt, const LAS bf16* Vt, const LAS float* bl0, const bf16x8 (&qf)[4], AttnSt& st, int q, int h, bool mine) {
    f32x16 s0, s1;
#pragma unroll
    for (int r = 0; r < 16; ++r) { s0[r] = bl0[23 - 16 * (r >> 3) - (r & 7)]; s1[r] = bl0[-32 + 23 - 16 * (r >> 3) - (r & 7)]; }
    const LAS bf16* kr = Kt + kperm(q) * AKP + 8 * h;
#pragma unroll
    for (int d0 = 0; d0 < 4; ++d0) { s0 = mfma32(*(const LAS bf16x8*)(kr + d0 * 16), qf[d0], s0); s1 = mfma32(*(const LAS bf16x8*)(kr + 32 * AKP + d0 * 16), qf[d0], s1); }
    const float mx = xhalf_max(fmaxf(max16(s0), max16(s1)));
    float mn = fmaxf(st.m, mx); if (MASKED) mn = mine ? mn : st.m;
    const float alpha = __builtin_amdgcn_exp2f(st.m - mn);
    float ps0 = 0.f, ps1 = 0.f;
#pragma unroll
    for (int r = 0; r < 16; ++r) { const float p = __builtin_amdgcn_exp2f(s0[r] - mn); s0[r] = p; ps0 += p; const float p2 = __builtin_amdgcn_exp2f(s1[r] - mn); s1[r] = p2; ps1 += p2; }
    bf16x8 p00 = pack8(s0, 0), p01 = pack8(s0, 8), p10 = pack8(s1, 0), p11 = pack8(s1, 8);
    float ps = ps0 + ps1;
    if (MASKED) { if (!mine) { p00 = (bf16x8){0, 0, 0, 0, 0, 0, 0, 0}; p01 = p00; p10 = p00; p11 = p00; ps = 0.f; } }
    st.l = st.l * alpha + ps; st.m = mn;
    if (__ballot(alpha != 1.0f) != 0ull) {
#pragma unroll
        for (int r = 0; r < 16; ++r) { st.o0[r] *= alpha; st.o1[r] *= alpha; } }
    const LAS bf16* v0 = Vt + q * AKP + 8 * h; const LAS bf16* v1 = v0 + 32 * AKP;
    st.o0 = mfma32(*(const LAS bf16x8*)v0, p00, st.o0); st.o1 = mfma32(*(const LAS bf16x8*)v1, p00, st.o1);
    st.o0 = mfma32(*(const LAS bf16x8*)(v0 + 16), p01, st.o0); st.o1 = mfma32(*(const LAS bf16x8*)(v1 + 16), p01, st.o1);
    st.o0 = mfma32(*(const LAS bf16x8*)(v0 + 32), p10, st.o0); st.o1 = mfma32(*(const LAS bf16x8*)(v1 + 32), p10, st.o1);
    st.o0 = mfma32(*(const LAS bf16x8*)(v0 + 48), p11, st.o0); st.o1 = mfma32(*(const LAS bf16x8*)(v1 + 48), p11, st.o1);
}

__device__ __forceinline__ void attn_tile2r(const LAS bf16* Kt, const LAS bf16* Vt, const LAS float* b0, const LAS float* b1, const bf16x8 (&qf)[4], AttnSt& st, int q, int h) {
    f32x16 s0, s1;
#pragma unroll
    for (int r = 0; r < 16; ++r) { s0[r] = b0[16 * (r >> 3) + (r & 7)]; s1[r] = b1[16 * (r >> 3) + (r & 7)]; }
    const LAS bf16* kr = Kt + kperm(q) * AKP + 8 * h;
#pragma unroll
    for (int d0 = 0; d0 < 4; ++d0) { s0 = mfma32(*(const LAS bf16x8*)(kr + d0 * 16), qf[d0], s0); s1 = mfma32(*(const LAS bf16x8*)(kr + 32 * AKP + d0 * 16), qf[d0], s1); }
    const float mx = xhalf_max(fmaxf(max16(s0), max16(s1)));
    const float mn = fmaxf(st.m, mx);
    const float alpha = __builtin_amdgcn_exp2f(st.m - mn);
    float ps0 = 0.f, ps1 = 0.f;
#pragma unroll
    for (int r = 0; r < 16; ++r) { const float p = __builtin_amdgcn_exp2f(s0[r] - mn); s0[r] = p; ps0 += p; const float p2 = __builtin_amdgcn_exp2f(s1[r] - mn); s1[r] = p2; ps1 += p2; }
    const bf16x8 p00 = pack8(s0, 0), p01 = pack8(s0, 8), p10 = pack8(s1, 0), p11 = pack8(s1, 8);
    st.l = st.l * alpha + (ps0 + ps1); st.m = mn;
    if (__ballot(alpha != 1.0f) != 0ull) {
#pragma unroll
        for (int r = 0; r < 16; ++r) { st.o0[r] *= alpha; st.o1[r] *= alpha; } }
    const LAS bf16* v0 = Vt + q * AKP + 8 * h; const LAS bf16* v1 = v0 + 32 * AKP;
    st.o0 = mfma32(*(const LAS bf16x8*)v0, p00, st.o0); st.o1 = mfma32(*(const LAS bf16x8*)v1, p00, st.o1);
    st.o0 = mfma32(*(const LAS bf16x8*)(v0 + 16), p01, st.o0); st.o1 = mfma32(*(const LAS bf16x8*)(v1 + 16), p01, st.o1);
    st.o0 = mfma32(*(const LAS bf16x8*)(v0 + 32), p10, st.o0); st.o1 = mfma32(*(const LAS bf16x8*)(v1 + 32), p10, st.o1);
    st.o0 = mfma32(*(const LAS bf16x8*)(v0 + 48), p11, st.o0); st.o1 = mfma32(*(const LAS bf16x8*)(v1 + 48), p11, st.o1);
}

__device__ __forceinline__ u32x4 f8x8_bf16(u32x2 v) {
    const f32x2 a = __builtin_amdgcn_cvt_pk_f32_fp8((int)v.x, false), b = __builtin_amdgcn_cvt_pk_f32_fp8((int)v.x, true), c = __builtin_amdgcn_cvt_pk_f32_fp8((int)v.y, false), d = __builtin_amdgcn_cvt_pk_f32_fp8((int)v.y, true);
    u32x4 r; r.x = pg8::cvt_pk_bf16(a.x, a.y); r.y = pg8::cvt_pk_bf16(b.x, b.y); r.z = pg8::cvt_pk_bf16(c.x, c.y); r.w = pg8::cvt_pk_bf16(d.x, d.y); return r;
}
__device__ __forceinline__ void dil_attn_phase3(Frame& F) {
    LAS float* bt = (LAS float*)F.lds;
    { const float* btA = (const float*)(F.ws + WS_BTABA); for (int i = F.tid; i < 48 * 192; i += 512) { const int gh = i / 192, dl = 159 - i % 192; bt[i] = (dl >= 0 && dl <= 128) ? btA[gh * 132 + dl] : NEGB; } }
    constexpr int TBL = 48 * 192 * 4;
    const int lane = F.lane, q = lane & 31, h = lane >> 5, w = F.wave, uw = w >> 2, qt = w & 3, t = F.tid, tu = t >> 8, tt = t & 255, srow = tt >> 3, sch = tt & 7;
    const unsigned char* QK = F.ws + WS_SCR + S_QK; const unsigned char* VT = F.ws + WS_SCR + S_VT;
    bf16* OG = (bf16*)((unsigned char*)F.out + O_OG); float* LSE = (float*)((unsigned char*)F.out + O_LSE);
    const int sdst = srow * AKP + sch * 8;
    int du = F.vcu;
    if (du >= 3072) { __syncthreads(); return; }
    int g = du >> 10, hh = (du >> 6) & 15, blp = (du >> 4) & 3, rn = du & 15;
    int j = ((rn & ((16 >> (2 * g)) - 1)) != 0) ? 0 : 2;
    u32x2 k0, k1, v0, v1; u32x2 qn[4]; bf16x8 qf[4];
#define DIL_LOADS(G_, HH_, BLP_, RN_, J_) do { const int n0s_ = (2 * (BLP_) + tu) * 2048 + (RN_) * 128 - 128 + 64 * (J_); \
        const unsigned char* ks_ = QK + ((size_t)(G_) * TC + n0s_ + srow) * 2048 + 1024 + (HH_) * 64 + sch * 8; \
        const unsigned char* vs_ = VT + ((size_t)(G_) * 1024 + (HH_) * 64 + srow) * TC + n0s_ + sch * 8; \
        k0 = *(const u32x2*)ks_; k1 = *(const u32x2*)(ks_ + (size_t)32 * 2048); v0 = *(const u32x2*)vs_; v1 = *(const u32x2*)(vs_ + (size_t)32 * TC); } while (0)
#define DIL_QLOADS(G_, HH_, BLP_, RN_) do { const unsigned char* qr_ = QK + ((size_t)(G_) * TC + (2 * (BLP_) + uw) * 2048 + (RN_) * 128 + 32 * qt + q) * 2048 + (HH_) * 64; \
        _Pragma("unroll") for (int d0 = 0; d0 < 4; ++d0) qn[d0] = *(const u32x2*)(qr_ + d0 * 16 + 8 * h); } while (0)
#define DIL_WRITE(PB_) do { LAS bf16* kb_ = (LAS bf16*)(F.lds + TBL + ((PB_) * 2 + tu) * 2 * ATILE); LAS bf16* vb_ = kb_ + 64 * AKP; \
        *(LAS u32x4*)(kb_ + sdst) = f8x8_bf16(k0); *(LAS u32x4*)(kb_ + 32 * AKP + sdst) = f8x8_bf16(k1); *(LAS u32x4*)(vb_ + sdst) = f8x8_bf16(v0); *(LAS u32x4*)(vb_ + 32 * AKP + sdst) = f8x8_bf16(v1); } while (0)
    DIL_LOADS(g, hh, blp, rn, j); DIL_QLOADS(g, hh, blp, rn);
    DIL_WRITE(0);
#pragma unroll
    for (int d0 = 0; d0 < 4; ++d0) qf[d0] = __builtin_bit_cast(bf16x8, f8x8_bf16(qn[d0]));
    __syncthreads();
    AttnSt st; st.m = NEGB; st.l = 0.f; st.o0 = (f32x16){}; st.o1 = (f32x16){};
    int pb = 0;
    for (;;) {
        const bool last = (j == 3);
        int ng = g, nhh = hh, nblp = blp, nrn = rn, nj = j + 1; bool more = true;
        if (last) { const int nd = du + F.G; more = nd < 3072; ng = nd >> 10; nhh = (nd >> 6) & 15; nblp = (nd >> 4) & 3; nrn = nd & 15; nj = ((nrn & ((16 >> (2 * ng)) - 1)) != 0) ? 0 : 2; }
        if (more) { DIL_LOADS(ng, nhh, nblp, nrn, nj); if (last) DIL_QLOADS(ng, nhh, nblp, nrn); }
        { const LAS bf16* kb = (const LAS bf16*)(F.lds + TBL + (pb * 2 + uw) * 2 * ATILE); const LAS bf16* vb = kb + 64 * AKP;
          const int gh = g * 16 + hh, ta = 2 * j, tb = 2 * j + 1;
          const bool a_on = ta >= qt && ta <= qt + 4, b_on = tb >= qt && tb <= qt + 4;
          const LAS float* row = bt + gh * 192;
          const LAS float* ba = row + (168 - (32 + (32 * qt + q + 128 - 32 * ta - 8 * h - 23)));
          if (a_on || b_on) attn_tile2r(kb, vb, a_on ? ba : row + 160, b_on ? ba + 32 : row + 160, qf, st, q, h); }
        if (more) DIL_WRITE(pb ^ 1);
        if (last) {
            const float l_tot = xhalf_sum(st.l), inv = 1.f / l_tot;
            const size_t orow = (size_t)g * TC + (2 * blp + uw) * 2048 + rn * 128 + 32 * qt + q;
            attn_store8(st, (unsigned char*)OG + orow * 1024 + hh * 64 + 4 * h, inv * ASCALE8);
            if (h == 0) LSE[orow * 16 + hh] = st.m + __log2f(l_tot);
            st.m = NEGB; st.l = 0.f; st.o0 = (f32x16){}; st.o1 = (f32x16){};
#pragma unroll
            for (int d0 = 0; d0 < 4; ++d0) qf[d0] = __builtin_bit_cast(bf16x8, f8x8_bf16(qn[d0]));
        }
        __syncthreads();
        pb ^= 1;
        if (!more) break;
        if (last) du += F.G;
        g = ng; hh = nhh; blp = nblp; rn = nrn; j = nj;
    }
#undef DIL_LOADS
#undef DIL_QLOADS
#undef DIL_WRITE
}

__device__ __forceinline__ void moba_phase3(Frame& F) {
    constexpr int TBL = 8448, KMO = TBL + 4 * ATILE;
    LAS float* bt = (LAS float*)F.lds; LAS float* kml = (LAS float*)(F.lds + KMO);
    const int lane = F.lane, q = lane & 31, h = lane >> 5, w = F.wave, t = F.tid, srow = t >> 3, sch = t & 7;
    const bf16* QK = (const bf16*)(F.ws + WS_SCR + S_CQK); const bf16* VT = (const bf16*)(F.ws + WS_SCR + S_CVT);
    bf16* att = (bf16*)(F.ws + WS_SCR + S_CATT); const float* km = (const float*)(F.ws + WS_KMEAN);
    const int NP = NB * NH * 4, per = (NP + F.G - 1) / F.G;
    const int lo = F.vcu * per, hi = (lo + per) < NP ? (lo + per) : NP;
    const int nunits = 2 * (hi - lo);
    if (nunits <= 0) return;
    const int sdst = srow * AKP + sch * 8;
    int u = 0, cur_bh = -1;
    u32x4 kreg, vreg; bf16x8 qn[4], qf[4];
#define MB_LOADS(B_, HH_, S_) do { const bf16* ks_ = QK + ((size_t)(B_) * SEQ + 64 * (S_) + srow) * 2048 + 1024 + (HH_) * 64 + sch * 8; \
        const bf16* vs_ = VT + ((size_t)(HH_) * 64 + srow) * T + (size_t)(B_) * SEQ + 64 * (S_) + sch * 8; kreg = *(const u32x4*)ks_; vreg = *(const u32x4*)vs_; } while (0)
#define MB_QLOADS(B_, HH_, NB_) do { const bf16* qr_ = QK + ((size_t)(B_) * SEQ + (NB_) * 256 + 32 * w + q) * 2048 + (HH_) * 64; \
        _Pragma("unroll") for (int d0 = 0; d0 < 4; ++d0) qn[d0] = *(const bf16x8*)(qr_ + d0 * 16 + 8 * h); } while (0)
#define MB_WRITE(PB_) do { LAS bf16* kb_ = (LAS bf16*)(F.lds + TBL + (PB_) * 2 * ATILE); *(LAS u32x4*)(kb_ + sdst) = kreg; *(LAS u32x4*)(kb_ + 64 * AKP + sdst) = vreg; } while (0)
    int pu = lo, jj = pu & 3, hh = (pu >> 2) & 15, b = pu >> 6, nb = 7 - jj, s = 0, pb = 0;
    MB_LOADS(b, hh, 0); MB_QLOADS(b, hh, nb); MB_WRITE(0);
    unsigned sel = 0; bool fresh = true;
    AttnSt st; st.m = NEGB; st.l = 0.f; st.o0 = (f32x16){}; st.o1 = (f32x16){};
    for (;;) {
        if (fresh) {
            if (b * 16 + hh != cur_bh) { __syncthreads(); const float* btC = (const float*)(F.ws + WS_BTABC) + hh * 2048;
                for (int i = t; i < 2048 + 32; i += 512) bt[2079 - i] = i < 32 ? NEGB : btC[i - 32];
                { const float* kmp = km + ((size_t)b * NH + hh) * 512; kml[t] = kmp[t]; }
                cur_bh = b * 16 + hh; }
#pragma unroll
            for (int d0 = 0; d0 < 4; ++d0) qf[d0] = qn[d0];
            __syncthreads();
            sel = 0;
            if (nb > 0) {
                float gsc[7];
#pragma unroll
                for (int m = 0; m < 7; ++m) { float sc = 0.f;
                    if (m < nb) {
#pragma unroll
                        for (int d0 = 0; d0 < 4; ++d0) { const f32x4 c0 = *(const LAS f32x4*)(kml + m * 64 + d0 * 16 + 8 * h), c1 = *(const LAS f32x4*)(kml + m * 64 + d0 * 16 + 8 * h + 4); const u32x4 qq = __builtin_bit_cast(u32x4, qf[d0]);
                            sc += bflo(qq.x) * c0.x + bfhi(qq.x) * c0.y + bflo(qq.y) * c0.z + bfhi(qq.y) * c0.w + bflo(qq.z) * c1.x + bfhi(qq.z) * c1.y + bflo(qq.w) * c1.z + bfhi(qq.w) * c1.w; }
                        sc = xhalf_sum(sc); }
                    gsc[m] = m < nb ? sc : -3.0e38f; }
                const int nsel = nb < 3 ? nb : 3;
#pragma unroll
                for (int r = 0; r < 3; ++r) { if (r < nsel) { int bi = 0; float bv = -3.4e38f;
#pragma unroll
                        for (int m = 0; m < 7; ++m) if (!((sel >> m) & 1u) && gsc[m] > bv) { bv = gsc[m]; bi = m; }
                        sel |= 1u << bi; } }
            }
            fresh = false;
        }
        const int nsteps = 4 * nb + 4;
        const bool last = (s + 1 == nsteps);
        int nb2 = nb, b2 = b, hh2 = hh, s2 = s + 1; bool more = true;
        if (last) { const int u2 = u + 1; more = u2 < nunits; const int pu2 = lo + (u2 >> 1), j2 = pu2 & 3; hh2 = (pu2 >> 2) & 15; b2 = pu2 >> 6; nb2 = (u2 & 1) ? j2 : 7 - j2; s2 = 0; }
        if (more) { MB_LOADS(b2, hh2, s2); if (last) MB_QLOADS(b2, hh2, nb2); }
        { const LAS bf16* kb = (const LAS bf16*)(F.lds + TBL + pb * 2 * ATILE); const LAS bf16* vb = kb + 64 * AKP;
          const int qpos = nb * 256 + 32 * w + q;
          const LAS float* ba = bt + (2056 - (32 + (qpos - 8 * h - 64 * s - 23)));
          const LAS float* negp = bt + 2048;
          bool act; const LAS float* p0; const LAS float* p1;
          if (s < 4 * nb) { const bool mine = (sel >> (s >> 2)) & 1u; act = __ballot(mine) != 0ull; p0 = mine ? ba : negp; p1 = mine ? ba + 32 : negp; }
          else { const int ta = (s - 4 * nb) * 2; act = ta <= w; p0 = ba; p1 = (ta + 1 <= w) ? ba + 32 : negp; }
          if (act) attn_tile2r(kb, vb, p0, p1, qf, st, q, h); }
        if (more) MB_WRITE(pb ^ 1);
        if (last) {
            const float l_tot = xhalf_sum(st.l), inv = 1.f / l_tot;
            const size_t tq = (size_t)b * SEQ + nb * 256 + 32 * w + q;
            attn_store8(st, (unsigned char*)att + tq * 1024 + hh * 64 + 4 * h, inv * ASCALE8);
            st.m = NEGB; st.l = 0.f; st.o0 = (f32x16){}; st.o1 = (f32x16){};
        }
        if (!last) __syncthreads();
        pb ^= 1;
        if (!more) break;
        if (last) { ++u; fresh = true; }
        nb = nb2; b = b2; hh = hh2; s = s2;
    }
#undef MB_LOADS
#undef MB_QLOADS
#undef MB_WRITE
}

__device__ __forceinline__ void gmlp_phase(Frame& F, const float* lng, const float* lnb, const float* bs) {
    const int lane = F.lane, w = F.wave, q = lane & 31, h = lane >> 5;
    const bf16* uv = (const bf16*)(F.ws + WS_SCR + S_UV); bf16* p = (bf16*)(F.ws + WS_SCR + S_P); const bf16* wst = (const bf16*)(F.ws + WS_WST);
    LAS float* stat = (LAS float*)F.lds;
    LAS bf16* vnT = (LAS bf16*)(F.lds + 1024);
    constexpr int VP = 136;
    for (int unit = F.vcu; unit < T / 128; unit += F.G) {
        const size_t t0 = (size_t)unit * 128;
        __syncthreads();
        for (int i = 0; i < 16; ++i) { const int r = w * 16 + i; const u32x4* vr = (const u32x4*)(uv + (t0 + r) * 2048 + 1024) + lane;
            const u32x4 a = vr[0], b = vr[64]; float x[16];
            x[0] = bflo(a.x); x[1] = bfhi(a.x); x[2] = bflo(a.y); x[3] = bfhi(a.y); x[4] = bflo(a.z); x[5] = bfhi(a.z); x[6] = bflo(a.w); x[7] = bfhi(a.w);
            x[8] = bflo(b.x); x[9] = bfhi(b.x); x[10] = bflo(b.y); x[11] = bfhi(b.y); x[12] = bflo(b.z); x[13] = bfhi(b.z); x[14] = bflo(b.w); x[15] = bfhi(b.w);
            float s = 0.f;
#pragma unroll
            for (int j = 0; j < 16; ++j) s += x[j];
            const float mean = wave_sum(s) * (1.f / 1024.f); float s2 = 0.f;
#pragma unroll
            for (int j = 0; j < 16; ++j) { const float d = x[j] - mean; s2 += d * d; }
            const float rstd = 1.f / sqrtf(wave_sum(s2) * (1.f / 1024.f) + LN_EPS);
            if (lane == 0) { stat[2 * r] = mean; stat[2 * r + 1] = rstd; } }
        __syncthreads();
        for (int gg = 0; gg < 8; ++gg) {
#pragma unroll
            for (int k = 0; k < 4; ++k) { const int id = F.tid + 512 * k, s = id >> 4, cc = (id & 15) * 8;
                const u32x4 a = *(const u32x4*)(uv + (t0 + s) * 2048 + 1024 + gg * 128 + cc); const float mean = stat[2 * s], rstd = stat[2 * s + 1];
                float x[8]; x[0] = bflo(a.x); x[1] = bfhi(a.x); x[2] = bflo(a.y); x[3] = bfhi(a.y); x[4] = bflo(a.z); x[5] = bfhi(a.z); x[6] = bflo(a.w); x[7] = bfhi(a.w);
#pragma unroll
                for (int j = 0; j < 8; ++j) { const int c = gg * 128 + cc + j; const float y = (x[j] - mean) * rstd * lng[c] + lnb[c]; vnT[(cc + j) * VP + s] = (bf16)f2bf(y); } }
            __syncthreads();
            const int cr = 32 * (w & 3), tc0 = 64 * (w >> 2);
            f32x16 acc0 = {}, acc1 = {};
#pragma unroll
            for (int ks = 0; ks < 8; ++ks) {
                const bf16x8 af = *(const LAS bf16x8*)(vnT + (cr + q) * VP + ks * 16 + 8 * h);
                const bf16x8 b0 = *(const bf16x8*)(wst + ((size_t)gg * 128 + tc0 + q) * 128 + ks * 16 + 8 * h);
                const bf16x8 b1 = *(const bf16x8*)(wst + ((size_t)gg * 128 + tc0 + 32 + q) * 128 + ks * 16 + 8 * h);
                acc0 = mfma32(af, b0, acc0); acc1 = mfma32(af, b1, acc1);
            }
#pragma unroll
            for (int tt = 0; tt < 2; ++tt) { const f32x16& ac = tt == 0 ? acc0 : acc1; const int tl = tc0 + 32 * tt + q; const float bsv = bs[gg * 128 + tl];
                const size_t rowu = (t0 + tl) * 2048, rowp = (t0 + tl) * 1024;
#pragma unroll
                for (int gq = 0; gq < 4; ++gq) { const int c = gg * 128 + cr + 8 * gq + 4 * h; const u32x2 uu = *(const u32x2*)(uv + rowu + c);
                    u32x2 o; o.x = pk2(bflo(uu.x) * (ac[4 * gq] + bsv), bfhi(uu.x) * (ac[4 * gq + 1] + bsv)); o.y = pk2(bflo(uu.y) * (ac[4 * gq + 2] + bsv), bfhi(uu.y) * (ac[4 * gq + 3] + bsv));
                    *(u32x2*)(p + rowp + c) = o; } }
            __syncthreads();
        }
    }
}

struct MoeSeg { int ts[9]; };
__device__ __forceinline__ MoeSeg moe_seg(Frame& F, int moe_l) {
    MoeSeg s; int acc = 0;
#pragma unroll
    for (int e = 0; e < 8; ++e) { s.ts[e] = acc; const unsigned c = __hip_atomic_load((unsigned*)(F.ctl + CW_ECNT + 64 * moe_l + e), RLX_AGENT); acc += (int)((c + 255u) >> 8); }
    s.ts[8] = acc; return s;
}
__device__ __forceinline__ void moe_gather_phase(Frame& F, int moe_l) {
    LAS int* P = (LAS int*)F.lds;
    LAS int* wtot = (LAS int*)(F.lds + 65536);
    LAS int* tot = wtot + 64;
    const int* wcnt = (const int*)(F.ws + WS_WCNT);
    int t = F.tid; asm volatile("" : "+v"(t));
    const int lane = F.lane;
    int loc[4][8], sum[8], inc[8];
#pragma unroll
    for (int k = 0; k < 4; ++k) { const u32x4 a = *(const u32x4*)(wcnt + (4 * t + k) * 8), b = *(const u32x4*)(wcnt + (4 * t + k) * 8 + 4);
        loc[k][0] = (int)a.x; loc[k][1] = (int)a.y; loc[k][2] = (int)a.z; loc[k][3] = (int)a.w; loc[k][4] = (int)b.x; loc[k][5] = (int)b.y; loc[k][6] = (int)b.z; loc[k][7] = (int)b.w; }
#pragma unroll
    for (int e = 0; e < 8; ++e) { sum[e] = (loc[0][e] + loc[1][e]) + (loc[2][e] + loc[3][e]); inc[e] = sum[e]; }
#pragma unroll
    for (int off = 1; off < 64; off <<= 1) {
#pragma unroll
        for (int e = 0; e < 8; ++e) { const int v = __shfl_up(inc[e], off); if (lane >= off) inc[e] += v; } }
    if (lane == 63) {
#pragma unroll
        for (int e = 0; e < 8; ++e) wtot[F.wave * 8 + e] = inc[e]; }
    __syncthreads();
    int run[8];
#pragma unroll
    for (int e = 0; e < 8; ++e) { int wb = 0; for (int w = 0; w < F.wave; ++w) wb += wtot[w * 8 + e]; run[e] = wb + inc[e] - sum[e]; }
#pragma unroll
    for (int k = 0; k < 4; ++k) {
#pragma unroll
        for (int e = 0; e < 8; ++e) { P[(4 * t + k) * 8 + e] = run[e]; run[e] += loc[k][e]; } }
    if (t == 511) {
#pragma unroll
        for (int e = 0; e < 8; ++e) tot[e] = run[e]; }
    __syncthreads();
    MoeSeg sg; { int acc = 0;
#pragma unroll
        for (int e = 0; e < 8; ++e) { sg.ts[e] = acc; acc += (tot[e] + 255) >> 8; } sg.ts[8] = acc; }
    if (blockIdx.x == 0 && t < 8) __hip_atomic_store((unsigned*)(F.ctl + CW_ECNT + 64 * moe_l + t), (unsigned)tot[t], RLX_AGENT);
    const int gw = F.vcu * NWAVES + F.wave, NGW = F.G * NWAVES;
    const bf16* hb = (const bf16*)(F.ws + WS_HB); unsigned char* xg8 = (unsigned char*)F.out;
    const int* route = (const int*)(F.ws + WS_ROUTE); int* slots = (int*)(F.ws + WS_SLOTS);
    for (int m0 = 4 * gw; m0 < T; m0 += 4 * NGW) {
        int s1[4], s2[4]; u32x4 a[4], b[4];
#pragma unroll
        for (int k = 0; k < 4; ++k) { const int m = m0 + k, grp = m >> 5;
            const int e1 = route[4 * m], p1 = route[4 * m + 1], e2 = route[4 * m + 2], p2 = route[4 * m + 3];
            int ts1 = 0, ts2 = 0;
#pragma unroll
            for (int e = 0; e < 8; ++e) { ts1 = e == e1 ? sg.ts[e] : ts1; ts2 = e == e2 ? sg.ts[e] : ts2; }
            s1[k] = ts1 * 256 + P[grp * 8 + e1] + p1; s2[k] = ts2 * 256 + P[grp * 8 + e2] + p2;
            const u32x4* src = (const u32x4*)(hb + (size_t)m * D) + lane; a[k] = src[0]; b[k] = src[64]; }
#pragma unroll
        for (int k = 0; k < 4; ++k) { const int m = m0 + k;
            float x[16]; unpack8(a[k], x); unpack8(b[k], x + 8);
            u32x2 lo, hi; lo.x = pk4_fp8(x[0], x[1], x[2], x[3]); lo.y = pk4_fp8(x[4], x[5], x[6], x[7]); hi.x = pk4_fp8(x[8], x[9], x[10], x[11]); hi.y = pk4_fp8(x[12], x[13], x[14], x[15]);
            unsigned char* d1 = xg8 + (size_t)s1[k] * D + 8 * lane; unsigned char* d2 = xg8 + (size_t)s2[k] * D + 8 * lane;
            *(u32x2*)d1 = lo; *(u32x2*)(d1 + 512) = hi; *(u32x2*)d2 = lo; *(u32x2*)(d2 + 512) = hi;
            if (lane == 0) { slots[2 * m] = s1[k]; slots[2 * m + 1] = s2[k]; } }
    }
}
struct MoeOrder {
    int nM, nN, G, c, tile0; MoeSeg sg; const char* A0; const char* B0; size_t aT, bE, bT; bool a_local;
    bool out_local;
    __device__ __forceinline__ bool next(int i, pg8::Unit& u) const {
        int pm, pn; if (!pg8::tile_of((long)i * G + c, nM, nN, pm, pn)) return false;
        const int tile = tile0 + pm; int e = 0;
#pragma unroll
        for (int k = 1; k < 8; ++k) e += (tile >= sg.ts[k]) ? 1 : 0;
        u.pm = out_local ? pm : tile; u.pn = pn; u.a = (unsigned)((size_t)(a_local ? pm : tile) * aT); u.b = (unsigned)((size_t)e * bE + (size_t)pn * bT); return true;
    }
};


template <int GI> struct L0QKOrder { int G, c; const char* A0; const char* B0;
    __device__ __forceinline__ bool next(int i, pg8::Unit& u) const { if (!pg8::tile_of((long)i * G + c, 64, 8, u.pm, u.pn)) return false; const int pm = u.pm;
        const int tok = GI == 0 ? pm * 256 : (GI == 1 ? (pm >> 3) * 2048 + (pm & 1) * 1024 + ((pm >> 1) & 3) : (pm >> 3) * 2048 + (pm & 7) * 2);
        u.a = (unsigned)tok * 1024u; u.b = (unsigned)u.pn * 256u * 1024u; return true; } };
template <int GI> struct L0VtOrder { int G, c; const char* A0; const char* B0;
    __device__ __forceinline__ bool next(int i, pg8::Unit& u) const { if (!pg8::tile_of((long)i * G + c, 4, 64, u.pm, u.pn)) return false; const int pn = u.pn;
        const int tok = GI == 0 ? pn * 256 : (GI == 1 ? (pn >> 3) * 2048 + (pn & 1) * 1024 + ((pn >> 1) & 3) : (pn >> 3) * 2048 + (pn & 7) * 2);
        u.a = (unsigned)u.pm * 256u * 1024u; u.b = (unsigned)tok * 1024u; return true; } };
template <int GI> __device__ __forceinline__ void l0_gemms(Frame& F, int ck, int bx) {
    constexpr int rs = GI == 0 ? 1 : (GI == 1 ? 4 : 16);
    constexpr size_t hst = (GI == 0 ? (size_t)128 : (GI == 1 ? (size_t)512 : (size_t)1)) * 1024;
    const char* hbc = (const char*)(F.ws + WS_SCR + S_HB8) + (size_t)ck * TC * 1024;
    unsigned char* scr = F.ws + WS_SCR;
    { L0QKOrder<GI> S{F.G, bx, hbc, (const char*)(F.ws + W_A_QK) + (size_t)GI * 2048 * 1024};
      pg8::Gemm gm{512, rs, 1, hst, (size_t)128 * 1024};
      pg8::EpiF8 E{scr + S_QK + (size_t)GI * TC * 2048, 2048, 1.f / WSCALE8};
      pg8::gemm_phase<pg8::EpiF8, L0QKOrder<GI>, false, 1>(F.lds, F.wave, gm, S, E); }
    { L0VtOrder<GI> S{F.G, bx, (const char*)(F.ws + W_A_V) + (size_t)GI * 1024 * 1024, hbc};
      pg8::Gemm gm{512, 1, rs, (size_t)128 * 1024, hst};
      pg8::EpiF8 E{scr + S_VT + (size_t)GI * 1024 * TC, TC, 1.f / WSCALE8};
      pg8::gemm_phase<pg8::EpiF8, L0VtOrder<GI>, false, 1>(F.lds, F.wave, gm, S, E); }
}


#ifdef MK_SELFCHECK
__device__ __forceinline__ void selfcheck_buf(Frame& F, const void* ptr, size_t nbytes, int stage, int slot0) {
    if (!F.chk) return;
    const int gw = F.vcu * NWAVES + F.wave, NGW = F.G * NWAVES; unsigned* cks = (unsigned*)(F.ws + WS_NEED + 2 * MiB) + slot0;
    const int nch = (int)(nbytes >> 12);
    for (int c = gw; c < nch; c += NGW) { const u32x4* r = (const u32x4*)((const char*)ptr + ((size_t)c << 12)) + F.lane; unsigned x = 0;
#pragma unroll
        for (int j = 0; j < 4; ++j) { const u32x4 v = r[64 * j]; x ^= v.x * 3u + v.y * 5u + v.z * 7u + v.w * 11u + (unsigned)j; }
        x *= (unsigned)(2 * F.lane + 1);
#pragma unroll
        for (int o = 1; o < 64; o <<= 1) x ^= __shfl_xor(x, o);
        if (F.lane == 0) { if (F.chk == 1) cks[c] = x; else if (cks[c] != x) atomicMax((unsigned*)(F.ctl + 32), (unsigned)(1000 - stage)); } }
}
#endif

__global__ void __launch_bounds__(NWAVES * 64, 2) mk_fwd(Args args) {
    extern __shared__ __attribute__((aligned(16))) unsigned char lds[];
    Frame F;
    F.lds = (LAS unsigned char*)lds;
    F.tid = threadIdx.x; F.lane = F.tid & 63; F.wave = __builtin_amdgcn_readfirstlane(F.tid >> 6);
    F.G = gridDim.x; { const int bx = blockIdx.x; F.vcu = (F.G % 8 == 0) ? (bx % 8) * (F.G / 8) + bx / 8 : bx; }
    F.ws = args.ws; F.ctl = (gu32*)(args.ws + WS_CTL); F.out = args.out; F.chk = args.chk; F.stage = 0;
    volatile LAS unsigned* MISC = (volatile LAS unsigned*)(F.lds + MISC_OFF);
    for (int u = F.tid; u < (LDS_BYTES - RING_BYTES) / 4; u += NWAVES * 64) ((LAS unsigned*)(F.lds + RING_BYTES))[u] = 0u;
    __syncthreads();
    XcdBarrier bar; bar.bar = (unsigned*)(F.ctl + CW_BAR); bar.x = 0; bar.st = nullptr;
    if (!MK_MULTI) bar = xcd_barrier_post((unsigned*)(F.ctl + CW_BAR), MISC + 8);
    const int lo = args.ph_lo, hi = args.ph_hi;
    int ph = 0;
#define PHASE_BEGIN if (ph >= lo && ph < hi) { F.lane = (int)__builtin_amdgcn_mbcnt_hi(~0u, __builtin_amdgcn_mbcnt_lo(~0u, 0u)); asm volatile("" : "+v"(F.lane)); F.tid = F.wave * 64 + F.lane;
#define PHASE_END   if (!MK_MULTI && ph + 1 < hi) xcd_barrier(bar, F.tid); } ++ph;
    const int bx = (int)blockIdx.x;
#define scr (args.ws + WS_SCR)
#define hb ((const bf16*)(args.ws + WS_HB))
#define ln_g (args.in[2])
#define ln_b (args.in[3])

    PHASE_BEGIN p_prologue(F, args); if (MK_PROBE & 8) p_prologue(F, args); PHASE_END

    if (MK_ENABLE & 1) {
#define L0_CHUNK(ck) \
        PHASE_BEGIN \
        if ((ck) > 0) dil_merge_phase(F, (ck) - 1); \
        l0_gemms<0>(F, (ck), bx); l0_gemms<1>(F, (ck), bx); l0_gemms<2>(F, (ck), bx); \
        PHASE_END \
        PHASE_BEGIN dil_attn_phase3(F); if (MK_PROBE & 1) dil_attn_phase3(F); PHASE_END
        L0_CHUNK(0) L0_CHUNK(1) L0_CHUNK(2) L0_CHUNK(3)
#undef L0_CHUNK
        PHASE_BEGIN dil_merge_phase(F, 3); if (MK_PROBE & 4) { dil_merge_phase(F, 3); dil_merge_phase(F, 3); dil_merge_phase(F, 3); dil_merge_phase(F, 3); } PHASE_END
        PHASE_BEGIN
        { pg8::LinOrder S{T / 256, 4, F.G, bx, (const char*)(scr + S_ATT), (const char*)(F.ws + W_A_O), (size_t)256 * 1024, (size_t)256 * 1024};
          pg8::Gemm gm{512, 1, 1, (size_t)128 * 1024, (size_t)128 * 1024};
          pg8::EpiResLn<FFN_GU8 == 0> E{(bf16*)(F.ws + WS_HB), ln_g + 0 * 2048, ln_b + 0 * 2048, ALPHA, 1.f / (WSCALE8 * ASCALE8), (float*)scr, (unsigned*)(F.ctl + CW_LNC + 0 * 4096), (unsigned*)(F.ctl + CW_BAR) + XB_TMO, scr + S_HB8, F.lds + LNT_OFF};
          pg8::gemm_phase<pg8::EpiResLn<FFN_GU8 == 0>, pg8::LinOrder, true, 1>(F.lds, F.wave, gm, S, E); }
        PHASE_END
    } else {
        PHASE_BEGIN ln_phase<1, false, false>(F, ln_g + 0 * 2048, ln_b + 0 * 2048, nullptr); PHASE_END
    }
#define DENSE_FFN(f, lnidx, enbit) \
    if (MK_ENABLE & (enbit)) { \
        PHASE_BEGIN \
        if ((f) == FFN_GU8) { \
          pg8::LinOrder S{T / 256, 2 * DFF / 256, F.G, bx, (const char*)(scr + S_HB8), (const char*)(F.ws + W_F_GU) + (size_t)(f) * 2 * DFF * 2048, (size_t)256 * 1024, (size_t)256 * 1024}; \
          pg8::Gemm gm{512, 1, 1, (size_t)128 * 1024, (size_t)128 * 1024};     \
          pg8::EpiSwiglu8 E{(unsigned char*)(scr + S_HID), DFF, 1.f / WSCALE8}; \
          pg8::gemm_phase<pg8::EpiSwiglu8, pg8::LinOrder, true, 1>(F.lds, F.wave, gm, S, E); \
        } else { pg8::LinOrder S{T / 256, 2 * DFF / 256, F.G, bx, (const char*)hb, (const char*)(F.ws + W_F_GU) + (size_t)(f) * 2 * DFF * 2048, (size_t)256 * 2048, (size_t)256 * 2048}; \
          pg8::Gemm gm{1024, 1, 1, (size_t)128 * 2048, (size_t)128 * 2048}; \
          pg8::EpiSwiglu8 E{(unsigned char*)(scr + S_HID), DFF}; \
          pg8::gemm_phase(F.lds, F.wave, gm, S, E); } \
        PHASE_END \
        PHASE_BEGIN \
        { pg8::LinOrder S{T / 256, 4, F.G, bx, (const char*)(scr + S_HID), (const char*)(F.ws + W_F_D) + (size_t)(f) * 1024 * DFF * 2, (size_t)256 * DFF, (size_t)256 * DFF}; \
          pg8::Gemm gm{DFF / 2, 1, 1, (size_t)128 * DFF, (size_t)128 * DFF};     \
          pg8::EpiResLn<false> E{(bf16*)(F.ws + WS_HB), ln_g + (lnidx) * 1024, ln_b + (lnidx) * 1024, ALPHA, 1.f / WSCALE8D, (float*)(scr + S_Y), (unsigned*)(F.ctl + CW_LNC + (2 + (f)) * 4096), (unsigned*)(F.ctl + CW_BAR) + XB_TMO, nullptr, F.lds + LNT_OFF}; \
          pg8::gemm_phase<pg8::EpiResLn<false>, pg8::LinOrder, true, 1>(F.lds, F.wave, gm, S, E); }     \
        PHASE_END \
    } else { \
        PHASE_BEGIN ln_phase<1, false, false>(F, ln_g + (lnidx) * 1024, ln_b + (lnidx) * 1024, nullptr); PHASE_END \
    }
    DENSE_FFN(0, 1, 2)

    if (MK_ENABLE & 4) {
        PHASE_BEGIN
        { pg8::LinOrder S{T / 256, 4, F.G, bx, (const char*)hb, (const char*)(F.ws + W_B_IN), (size_t)256 * 2048, (size_t)256 * 2048};
          pg8::Gemm gm{1024, 1, 1, (size_t)128 * 2048, (size_t)128 * 2048};
          pg8::EpiBf16<0> E{(bf16*)(scr + S_BCX), 1024};
          pg8::gemm_phase(F.lds, F.wave, gm, S, E); }
        { pg8::LinOrder S{T / 256, 8, F.G, bx, (const char*)hb, (const char*)(F.ws + W_B_IN) + (size_t)1024 * 2048, (size_t)256 * 2048, (size_t)256 * 2048};
          pg8::Gemm gm{1024, 1, 1, (size_t)128 * 2048, (size_t)128 * 2048};
          pg8::EpiGlu<0> E{(bf16*)(scr + S_BCX + (size_t)128 * MiB), 1024};
          pg8::gemm_phase(F.lds, F.wave, gm, S, E); }
        PHASE_END
        PHASE_BEGIN conv_phase(F, args.in[7]); if (MK_PROBE & 4) conv_phase(F, args.in[7]); PHASE_END
        PHASE_BEGIN
        { pg8::LinOrder S{T / 256, 4, F.G, bx, (const char*)(scr + S_P), (const char*)(F.ws + W_B_O), (size_t)256 * 2048, (size_t)256 * 2048};
          pg8::Gemm gm{1024, 1, 1, (size_t)128 * 2048, (size_t)128 * 2048};
          pg8::EpiResBf16 E{hb, (bf16*)F.out, 1024, ALPHA};
          pg8::gemm_phase(F.lds, F.wave, gm, S, E); }
        PHASE_END
        PHASE_BEGIN ln_phase<0, true, false>(F, ln_g + 2 * 1024, ln_b + 2 * 1024, args.in[20]); PHASE_END
    } else {
        PHASE_BEGIN ln_phase<1, true, false>(F, ln_g + 2 * 1024, ln_b + 2 * 1024, args.in[20]); PHASE_END
    }
#define MOE_CHUNK(f, ck) \
        PHASE_BEGIN \
        { const MoeSeg sg = moe_seg(F, (f)); int nM = sg.ts[8] - (ck) * MOE_CH_TILES; nM = nM > MOE_CH_TILES ? MOE_CH_TILES : (nM < 0 ? 0 : nM); \
          MoeOrder S{nM, 2 * DFE / 256, F.G, bx, (ck) * MOE_CH_TILES, sg, (const char*)F.out, (const char*)(F.ws + W_E_GU) + (size_t)(f) * 8 * 2 * DFE * 2048, (size_t)256 * 1024, (size_t)2 * DFE * 2048, (size_t)256 * 1024, false, true}; \
          pg8::Gemm gm{512, 1, 1, (size_t)128 * 1024, (size_t)128 * 1024};     \
          pg8::EpiSwiglu8 E{(unsigned char*)(scr + S_MHID), DFE, 1.f / WSCALE8}; \
          pg8::gemm_phase<pg8::EpiSwiglu8, MoeOrder, true, 0x7C>(F.lds, F.wave, gm, S, E);     if ((ck) == 0 && (MK_PROBE & 32)) pg8::gemm_phase(F.lds, F.wave, gm, S, E); } \
        PHASE_END \
        PHASE_BEGIN \
        { const MoeSeg sg = moe_seg(F, (f)); int nM = sg.ts[8] - (ck) * MOE_CH_TILES; nM = nM > MOE_CH_TILES ? MOE_CH_TILES : (nM < 0 ? 0 : nM); \
          MoeOrder S{nM, 4, F.G, bx, (ck) * MOE_CH_TILES, sg, (const char*)(scr + S_MHID), (const char*)(F.ws + W_E_D) + (size_t)(f) * 8 * 1024 * DFE * 2, (size_t)256 * DFE, (size_t)1024 * DFE * 2, (size_t)256 * DFE, true, false}; \
          pg8::Gemm gm{DFE / 2, 1, 1, (size_t)128 * DFE, (size_t)128 * DFE};     \
          pg8::EpiF8 E{scr + S_XG, 1024, YSCALE8 / WSCALE8D};     \
          pg8::gemm_phase<pg8::EpiF8, MoeOrder, true, 0x7B>(F.lds, F.wave, gm, S, E);     if ((ck) == 0 && (MK_PROBE & 64)) pg8::gemm_phase(F.lds, F.wave, gm, S, E); } \
        PHASE_END
#define MOE_FFN(f, lnidx, enbit, fin) \
    if (MK_ENABLE & (enbit)) { \
        PHASE_BEGIN moe_gather_phase(F, (f)); if (MK_PROBE & 4) moe_gather_phase(F, (f)); PHASE_END \
        MOE_CHUNK(f, 0) MOE_CHUNK(f, 1) MOE_CHUNK(f, 2) \
        PHASE_BEGIN ln_phase<2, false, fin>(F, ln_g + (lnidx) * 1024, ln_b + (lnidx) * 1024, nullptr); PHASE_END \
    } else { \
        PHASE_BEGIN ln_phase<1, false, fin>(F, ln_g + (lnidx) * 1024, ln_b + (lnidx) * 1024, nullptr); PHASE_END \
    }
    MOE_FFN(0, 3, 8, false)

    if (MK_ENABLE & 16) {
        PHASE_BEGIN
        { pg8::LinOrder S{T / 256, 8, F.G, bx, (const char*)hb, (const char*)(F.ws + W_C_QK), (size_t)256 * 2048, (size_t)256 * 2048};
          pg8::Gemm gm{1024, 1, 1, (size_t)128 * 2048, (size_t)128 * 2048};
          pg8::EpiBf16<0> E{(bf16*)(scr + S_CQK), 2048};
          pg8::gemm_phase(F.lds, F.wave, gm, S, E); }
        { pg8::LinOrder S{4, T / 256, F.G, bx, (const char*)(F.ws + W_C_V), (const char*)hb, (size_t)256 * 2048, (size_t)256 * 2048};
          pg8::Gemm gm{1024, 1, 1, (size_t)128 * 2048, (size_t)128 * 2048};
          pg8::EpiBf16<0> E{(bf16*)(scr + S_CVT), T};
          pg8::gemm_phase(F.lds, F.wave, gm, S, E); }
        PHASE_END
#ifdef MK_SELFCHECK
        PHASE_BEGIN selfcheck_buf(F, scr + S_CQK, (size_t)256 * MiB, 40, 0); selfcheck_buf(F, scr + S_CVT, (size_t)128 * MiB, 41, 65536); PHASE_END
#endif
        PHASE_BEGIN kmean_phase(F); if (MK_PROBE & 4) kmean_phase(F); PHASE_END
#ifdef MK_SELFCHECK
        PHASE_BEGIN selfcheck_buf(F, F.ws + WS_KMEAN, (size_t)1 * MiB, 42, 65536 + 32768); PHASE_END
#endif
        PHASE_BEGIN moba_phase3(F); if (MK_PROBE & 2) moba_phase3(F); PHASE_END
#ifdef MK_SELFCHECK
        PHASE_BEGIN selfcheck_buf(F, F.ws + WS_NEED + 3 * MiB, (size_t)4 * MiB, 43, 65536 + 32768 + 256); selfcheck_buf(F, F.ws + WS_NEED + 7 * MiB, (size_t)4 * MiB, 44, 65536 + 32768 + 256 + 1024);
                    selfcheck_buf(F, scr + S_CATT, (size_t)128 * MiB, 45, 65536 + 32768 + 256 + 2048); PHASE_END
#endif
        PHASE_BEGIN
        { pg8::LinOrder S{T / 256, 4, F.G, bx, (const char*)(scr + S_CATT), (const char*)(F.ws + W_C_O), (size_t)256 * 1024, (size_t)256 * 1024};
          pg8::Gemm gm{512, 1, 1, (size_t)128 * 1024, (size_t)128 * 1024};
          pg8::EpiResLn<FFN_GU8 == 1> E{(bf16*)(F.ws + WS_HB), ln_g + 4 * 1024, ln_b + 4 * 1024, ALPHA, 1.f / (WSCALE8 * ASCALE8), (float*)scr, (unsigned*)(F.ctl + CW_LNC + 1 * 4096), (unsigned*)(F.ctl + CW_BAR) + XB_TMO, scr + S_HB8, F.lds + LNT_OFF};
          pg8::gemm_phase<pg8::EpiResLn<FFN_GU8 == 1>, pg8::LinOrder, true, 1>(F.lds, F.wave, gm, S, E); }
        PHASE_END
    } else {
        PHASE_BEGIN ln_phase<1, false, false>(F, ln_g + 4 * 1024, ln_b + 4 * 1024, nullptr); PHASE_END
    }
    DENSE_FFN(1, 5, 32)

    if (MK_ENABLE & 64) {
        PHASE_BEGIN
        { pg8::LinOrder S{T / 256, 8, F.G, bx, (const char*)hb, (const char*)(F.ws + W_D_IN), (size_t)256 * 2048, (size_t)256 * 2048};
          pg8::Gemm gm{1024, 1, 1, (size_t)128 * 2048, (size_t)128 * 2048};
          pg8::EpiBf16<1> E{(bf16*)(scr + S_UV), 2048};
          pg8::gemm_phase(F.lds, F.wave, gm, S, E); }
        PHASE_END
        PHASE_BEGIN gmlp_phase(F, args.in[12], args.in[13], args.in[15]); if (MK_PROBE & 4) gmlp_phase(F, args.in[12], args.in[13], args.in[15]); PHASE_END
        PHASE_BEGIN
        { pg8::LinOrder S{T / 256, 4, F.G, bx, (const char*)(scr + S_P), (const char*)(F.ws + W_D_O), (size_t)256 * 2048, (size_t)256 * 2048};
          pg8::Gemm gm{1024, 1, 1, (size_t)128 * 2048, (size_t)128 * 2048};
          pg8::EpiResBf16 E{hb, (bf16*)F.out, 1024, ALPHA};
          pg8::gemm_phase(F.lds, F.wave, gm, S, E); }
        PHASE_END
        PHASE_BEGIN ln_phase<0, true, false>(F, ln_g + 6 * 1024, ln_b + 6 * 1024, args.in[20] + 8192); PHASE_END
    } else {
        PHASE_BEGIN ln_phase<1, true, false>(F, ln_g + 6 * 1024, ln_b + 6 * 1024, args.in[20] + 8192); PHASE_END
    }
    MOE_FFN(1, 7, 128, true)
#ifdef MK_SELFCHECK
    PHASE_BEGIN
    { const unsigned fl = __hip_atomic_load((unsigned*)(F.ctl + 32), RLX_AGENT);
      if (fl != 0u) { const int code = 1000 - (int)fl; const float cval = (code >= 40 && code <= 45) ? (float)(20 + 2 * (code - 40)) : (float)(1u << (code / 10 + 1)); const int gw = F.vcu * NWAVES + F.wave, NGW = F.G * NWAVES;
          for (int m = gw; m < T; m += NGW) { f32x4* w = (f32x4*)(F.out + (size_t)m * D) + F.lane;
#pragma unroll
              for (int j = 0; j < 4; ++j) w[64 * j] = (f32x4){cval, cval, cval, cval}; } } }
    PHASE_END
#endif
#undef PHASE_BEGIN
#undef PHASE_END
#undef scr
#undef hb
#undef ln_g
#undef ln_b
}

static int count_phases() {
    int n = 1;
    n += (MK_ENABLE & 1) ? (8 + 1 + 1) : 1;
    n += (MK_ENABLE & 2) ? 2 : 1;
    n += (MK_ENABLE & 4) ? 4 : 1;
    n += (MK_ENABLE & 8) ? 8 : 1;
    n += (MK_ENABLE & 16) ? 4 : 1;
    n += (MK_ENABLE & 32) ? 2 : 1;
    n += (MK_ENABLE & 64) ? 4 : 1;
    n += (MK_ENABLE & 128) ? 8 : 1;
#ifdef MK_SELFCHECK
    n += 1 + 3;
#endif
    return n;
}
extern "C" void kernel_launch(void* const* d_in, const int* in_sizes, int n_in, void* d_out, int out_size, void* d_ws, size_t ws_size, hipStream_t stream) {
    static int grid = 0;
    if (grid == 0) {
        if (n_in != 24 || in_sizes[0] != T * D || out_size != T * D || ws_size < WS_NEED) { fprintf(stderr, "kernel_launch: unexpected shapes (n_in %d, in0 %d, out %d, ws %zu < %zu); nothing launched\n", n_in, n_in > 0 ? in_sizes[0] : -1, out_size, ws_size, (size_t)WS_NEED); grid = -1; return; }
        int dev = 0, cus = 0, per_cu = 0;
        if (hipGetDevice(&dev) != hipSuccess || hipDeviceGetAttribute(&cus, hipDeviceAttributeMultiprocessorCount, dev) != hipSuccess) { grid = -1; return; }
        if (hipFuncSetAttribute((const void*)mk_fwd, hipFuncAttributeMaxDynamicSharedMemorySize, LDS_BYTES) != hipSuccess) { fprintf(stderr, "kernel_launch: hipFuncSetAttribute failed\n"); grid = -1; return; }
        if (hipOccupancyMaxActiveBlocksPerMultiprocessor(&per_cu, (const void*)mk_fwd, NWAVES * 64, LDS_BYTES) != hipSuccess || per_cu < 1) fprintf(stderr, "kernel_launch: occupancy query reports %d\n", per_cu);
        (void)hipGetLastError();
        grid = cus;
    }
    if (grid < 0) return;
    (void)hipMemsetAsync((char*)d_ws + WS_CTL, 0, CTL_ZERO_BYTES, stream);
#ifdef SELF_POISON
    (void)hipMemsetAsync((char*)d_ws + CTL_ZERO_BYTES, 0xAA, WS_NEED - CTL_ZERO_BYTES, stream);
    (void)hipMemsetAsync(d_out, 0xAA, (size_t)T * D * 4, stream);
#endif
    Args a{};
    for (int i = 0; i < 24; ++i) a.in[i] = (const float*)d_in[i];
    a.out = (float*)d_out; a.ws = (unsigned char*)d_ws;
    const int nph = count_phases();
#if MK_MULTI
    for (int p = 0; p < nph; ++p) { a.ph_lo = p; a.ph_hi = p + 1; hipLaunchKernelGGL(mk_fwd, dim3(grid), dim3(NWAVES * 64), LDS_BYTES, stream, a); }
#else
    a.ph_lo = 0; a.ph_hi = nph;
#ifdef MK_SELFCHECK
    a.chk = 1;
    hipLaunchKernelGGL(mk_fwd, dim3(grid), dim3(NWAVES * 64), LDS_BYTES, stream, a);
    (void)hipMemsetAsync((char*)d_ws + WS_CTL, 0, CTL_ZERO_BYTES, stream);
    a.chk = 2;
#endif
    hipLaunchKernelGGL(mk_fwd, dim3(grid), dim3(NWAVES * 64), LDS_BYTES, stream, a);
#endif
    const hipError_t le = hipPeekAtLastError();
    if (le != hipSuccess) fprintf(stderr, "kernel_launch: launch failed: %s\n", hipGetErrorName(le));
}
```

```cpp
#include <hip/hip_runtime.h>
#include <cstdio>
#include <cstdint>

#ifndef MK_MULTI
#define MK_MULTI 0
#endif
#ifndef MK_PROBE
#define MK_PROBE 0
#endif
#ifndef MK_ENABLE
#define MK_ENABLE 0xFF
#endif

#define GAS __attribute__((address_space(1)))
#define LAS __attribute__((address_space(3)))
typedef unsigned short bf16;
typedef short bf16x8 __attribute__((ext_vector_type(8)));
typedef float f32x4 __attribute__((ext_vector_type(4)));
typedef float f32x2 __attribute__((ext_vector_type(2)));
typedef float f32x16 __attribute__((ext_vector_type(16)));
typedef unsigned u32x4 __attribute__((ext_vector_type(4)));
typedef unsigned u32x2 __attribute__((ext_vector_type(2)));
typedef GAS unsigned gu32;
typedef int v8i_t __attribute__((ext_vector_type(8)));
typedef int v4i_t __attribute__((ext_vector_type(4)));
typedef short s16x16_t __attribute__((ext_vector_type(16)));

constexpr int D = 1024, NB = 32, SEQ = 2048, T = NB * SEQ, NH = 16, HD = 64;
constexpr int DFF = 2816, NE = 8, DFE = 3584;
constexpr float ALPHA = 1.6817928305074290f;
constexpr float LN_EPS = 1e-5f;
constexpr float LOG2E = 1.4426950408889634f;
constexpr float QSCALE = 0.125f * LOG2E;
constexpr float NEGB = -1e30f;
constexpr int TC = 16384;
constexpr int MOE_CH_TILES = 256;
constexpr int MOE_MAX_TILES = 520;
constexpr int FFN_GU8 = 1;

constexpr size_t MiB = 1u << 20;
constexpr size_t WS_CTL = 0, CTL_ZERO_BYTES = 1 * MiB;
constexpr size_t WS_BUCKET = 1 * MiB;
constexpr size_t WS_BTABA = WS_BUCKET + 8192;
constexpr size_t WS_BTABC = WS_BTABA + 32768;
constexpr size_t WS_WST = WS_BTABC + 131072;
constexpr size_t WS_KMEAN = 2 * MiB;
constexpr size_t WS_ROUTE = 4 * MiB;
constexpr size_t WS_GATES = 5 * MiB;
constexpr size_t WS_SLOTS = 6 * MiB;
constexpr size_t WS_WCNT = 7 * MiB;
constexpr size_t WS_W = 8 * MiB;
constexpr size_t W_A_QK = WS_W;
constexpr size_t W_A_V = W_A_QK + 12 * MiB;
constexpr size_t W_A_O = W_A_V + 6 * MiB;
constexpr size_t W_B_IN = W_A_O + 2 * MiB;
constexpr size_t W_B_O = W_B_IN + 6 * MiB;
constexpr size_t W_C_QK = W_B_O + 2 * MiB;
constexpr size_t W_C_V = W_C_QK + 4 * MiB;
constexpr size_t W_C_O = W_C_V + 2 * MiB;
constexpr size_t W_D_IN = W_C_O + 2 * MiB;
constexpr size_t W_D_O = W_D_IN + 4 * MiB;
constexpr size_t W_F_GU = W_D_O + 2 * MiB;
constexpr size_t W_F_D = W_F_GU + 22 * MiB;
constexpr size_t W_E_GU = W_F_D + 11 * MiB;
constexpr size_t W_E_D = W_E_GU + 224 * MiB;
constexpr size_t WS_HB = W_E_D + 112 * MiB;
constexpr size_t WS_SCR = WS_HB + 128 * MiB;
constexpr size_t WS_NEED = WS_SCR + 512 * MiB;
static_assert(WS_HB == 419 * MiB, "map");
constexpr size_t S_QK = 0;
constexpr size_t S_VT = 192 * MiB;
constexpr size_t S_HB8 = 448 * MiB;
constexpr size_t S_ATT = 288 * MiB;
constexpr size_t S_HID = 0;
constexpr size_t S_BCX = 0;
constexpr size_t S_P = 384 * MiB;
constexpr size_t S_XG = 0;
constexpr size_t S_MHID = 260 * MiB;
constexpr size_t S_Y = 256 * MiB;
constexpr size_t S_CQK = 0;
constexpr size_t S_CVT = 256 * MiB;
constexpr size_t S_CATT = 384 * MiB;
constexpr size_t S_UV = 0;
constexpr size_t O_OG = 0;
constexpr size_t O_LSE = 96 * MiB;
constexpr int CW_TMO = 0;
constexpr int CW_ECNT = 64;
constexpr int CW_BAR = 4096;
constexpr int CW_LNC = 16384;

constexpr float YSCALE8 = 16.f;
constexpr float ASCALE8 = 8.f;
constexpr float WSCALE8 = 64.f, WSCALE8D = 256.f;
__device__ __forceinline__ unsigned pk4_fp8(float a, float b, float c, float d) { int p = 0; p = __builtin_amdgcn_cvt_pk_fp8_f32(a, b, p, false); p = __builtin_amdgcn_cvt_pk_fp8_f32(c, d, p, true); return (unsigned)p; }
namespace pg8 {
constexpr int BM = 256, BK = 64, HALF = 128, HTB = HALF * BK * 2, STAGE_BYTES = 8 * HTB, NXCD = 8, WGM = 8;
__host__ __device__ __forceinline__ int lds_byte(int r, int c) { const int st = (r >> 4) * 2 + (c >> 5), rr = r & 15, cc = c & 31, ob = rr * 64 + cc * 2; return st * 1024 + (ob ^ (((ob >> 9) & 1) << 5)); }
__host__ __device__ __forceinline__ void stage_rc(int b, int& R, int& C) { const int st = b / 1024, sb = b % 1024, swz = sb ^ (((sb >> 9) & 1) << 5); R = (st >> 1) * 16 + swz / 64; C = (st & 1) * 32 + (swz % 64) / 2; }
__host__ __device__ __forceinline__ int perm32(int rho) { const int n = rho >> 4, i = rho & 15; return 8 * (i >> 2) + 4 * n + (i & 3); }

struct Unit { int pm, pn; unsigned a, b; };
struct Gemm { int K; int rsA, rsB; size_t hstepA, hstepB; };

__device__ __forceinline__ bool tile_of(long L, int nM, int nN, int& pm, int& pn) {
    const int nwg = nM * nN; if (L >= nwg) return false;
    int wgid = (int)L; { const int q = nwg / NXCD, r = nwg % NXCD, xcd = wgid % NXCD, off = wgid / NXCD; wgid = (xcd < r ? xcd * (q + 1) : r * (q + 1) + (xcd - r) * q) + off; }
    const int nig = WGM * nN, gid = wgid / nig, fm = gid * WGM, gsz = (nM - fm) < WGM ? (nM - fm) : WGM;
    pm = fm + ((wgid % nig) % gsz); pn = (wgid % nig) / gsz; return true;
}
struct LinOrder {
    int nM, nN, G, c; const char* A0; const char* B0; size_t aT, bT;
    __device__ __forceinline__ bool next(int i, Unit& u) const { if (!tile_of((long)i * G + c, nM, nN, u.pm, u.pn)) return false; u.a = (unsigned)((size_t)u.pm * aT); u.b = (unsigned)((size_t)u.pn * bT); return true; }
};

typedef __bf16 bf16x2_t __attribute__((ext_vector_type(2)));
__device__ __forceinline__ unsigned cvt_pk_bf16(float lo, float hi) { f32x2 v = {lo, hi}; bf16x2_t b = __builtin_convertvector(v, bf16x2_t); return __builtin_bit_cast(unsigned, b); }
__device__ __forceinline__ f32x2 gelu_pk(f32x2 v) {
    const f32x2 av = __builtin_elementwise_abs(v), d = av * 0.2316418882f + 1.0f;
    f32x2 t; t.x = __builtin_amdgcn_rcpf(d.x); t.y = __builtin_amdgcn_rcpf(d.y);
    f32x2 q = t * 0.5307027145f + (-0.7265760135f); q = q * t + 0.7107068705f; q = q * t + (-0.142248368f); q = q * t + 0.127414796f; q = q * t;
    const f32x2 s = (v * v) * (-0.72134752044f);
    f32x2 e; e.x = __builtin_amdgcn_exp2f(s.x); e.y = __builtin_amdgcn_exp2f(s.y);
    const f32x2 m = v * (q * e), r = v - m;
    f32x2 o; o.x = v.x < 0.f ? m.x : r.x; o.y = v.y < 0.f ? m.y : r.y; return o;
}
__device__ __forceinline__ float silu_f(float g) { return g * __builtin_amdgcn_rcpf(1.0f + __builtin_amdgcn_exp2f(-LOG2E * g)); }

template <int ACT  > struct EpiBf16 {
    static constexpr bool PERM = true;
    bf16* O; int ldc; float sc = 1.f;
    __device__ __forceinline__ void operator()(const f32x4 (&acc)[2][2][4][2], const Unit& u, int wr, int wc, int fr, int fq) const {
        const int row0 = u.pm * BM + wr * 64 + fr, col0 = u.pn * BM + wc * 32 + 8 * fq;
#pragma unroll
        for (int ai = 0; ai < 2; ++ai)
#pragma unroll
            for (int m = 0; m < 4; ++m) { bf16* rowp = O + (size_t)(row0 + ai * HALF + m * 16) * ldc + col0;
#pragma unroll
                for (int bj = 0; bj < 2; ++bj) { f32x4 v0 = acc[ai][bj][m][0] * sc, v1 = acc[ai][bj][m][1] * sc;
                    if (ACT == 1) { f32x2 a = gelu_pk((f32x2){v0[0], v0[1]}), b = gelu_pk((f32x2){v0[2], v0[3]}), c = gelu_pk((f32x2){v1[0], v1[1]}), d = gelu_pk((f32x2){v1[2], v1[3]});
                        v0 = (f32x4){a.x, a.y, b.x, b.y}; v1 = (f32x4){c.x, c.y, d.x, d.y}; }
                    u32x4 w; w.x = cvt_pk_bf16(v0[0], v0[1]); w.y = cvt_pk_bf16(v0[2], v0[3]); w.z = cvt_pk_bf16(v1[0], v1[1]); w.w = cvt_pk_bf16(v1[2], v1[3]);
                    *(u32x4*)(rowp + bj * HALF) = w; } }
    }
};
struct EpiF8 {
    static constexpr bool PERM = true;
    unsigned char* O; int ldc; float sc = 1.f;
    __device__ __forceinline__ void operator()(const f32x4 (&acc)[2][2][4][2], const Unit& u, int wr, int wc, int fr, int fq) const {
        const int row0 = u.pm * BM + wr * 64 + fr, col0 = u.pn * BM + wc * 32 + 8 * fq;
#pragma unroll
        for (int ai = 0; ai < 2; ++ai)
#pragma unroll
            for (int m = 0; m < 4; ++m) { unsigned char* rowp = O + (size_t)(row0 + ai * HALF + m * 16) * ldc + col0;
#pragma unroll
                for (int bj = 0; bj < 2; ++bj) { const f32x4 v0 = acc[ai][bj][m][0] * sc, v1 = acc[ai][bj][m][1] * sc;
                    u32x2 w; w.x = pk4_fp8(v0[0], v0[1], v0[2], v0[3]); w.y = pk4_fp8(v1[0], v1[1], v1[2], v1[3]);
                    *(u32x2*)(rowp + bj * HALF) = w; } }
    }
};
template <int ACT  > struct EpiGlu {
    static constexpr bool PERM = true;
    bf16* O; int ldc;
    __device__ __forceinline__ void operator()(const f32x4 (&acc)[2][2][4][2], const Unit& u, int wr, int wc, int fr, int fq) const {
        const int row0 = u.pm * BM + wr * 64 + fr, col0 = u.pn * HALF + wc * 32 + 8 * fq;
#pragma unroll
        for (int ai = 0; ai < 2; ++ai)
#pragma unroll
            for (int m = 0; m < 4; ++m) { bf16* rowp = O + (size_t)(row0 + ai * HALF + m * 16) * ldc + col0;
                f32x4 g0 = acc[ai][0][m][0], g1 = acc[ai][0][m][1]; const f32x4 u0 = acc[ai][1][m][0], u1 = acc[ai][1][m][1];
                if (ACT == 1) { g0 = (f32x4){silu_f(g0[0]), silu_f(g0[1]), silu_f(g0[2]), silu_f(g0[3])}; g1 = (f32x4){silu_f(g1[0]), silu_f(g1[1]), silu_f(g1[2]), silu_f(g1[3])}; }
                const f32x4 p0 = g0 * u0, p1 = g1 * u1;
                u32x4 w; w.x = cvt_pk_bf16(p0[0], p0[1]); w.y = cvt_pk_bf16(p0[2], p0[3]); w.z = cvt_pk_bf16(p1[0], p1[1]); w.w = cvt_pk_bf16(p1[2], p1[3]);
                *(u32x4*)rowp = w; }
    }
};
struct EpiSwiglu8 {
    static constexpr bool PERM = true;
    unsigned char* O; int ldc; float s = 1.f;
    __device__ __forceinline__ void operator()(const f32x4 (&acc)[2][2][4][2], const Unit& u, int wr, int wc, int fr, int fq) const {
        const int row0 = u.pm * BM + wr * 64 + fr, col0 = u.pn * HALF + wc * 32 + 8 * fq;
#pragma unroll
        for (int ai = 0; ai < 2; ++ai)
#pragma unroll
            for (int m = 0; m < 4; ++m) { unsigned char* rowp = O + (size_t)(row0 + ai * HALF + m * 16) * ldc + col0;
                const f32x4 g0 = acc[ai][0][m][0], g1 = acc[ai][0][m][1], u0 = acc[ai][1][m][0], u1 = acc[ai][1][m][1];
                const float c1 = -LOG2E * s, s2 = s * s;
                const f32x4 p0 = (g0 * u0) * s2, p1 = (g1 * u1) * s2;
                f32x4 r0, r1;
#pragma unroll
                for (int j = 0; j < 4; ++j) { r0[j] = __builtin_amdgcn_rcpf(1.0f + __builtin_amdgcn_exp2f(g0[j] * c1)); r1[j] = __builtin_amdgcn_rcpf(1.0f + __builtin_amdgcn_exp2f(g1[j] * c1)); }
                const f32x4 o0 = p0 * r0, o1 = p1 * r1;
                u32x2 w; w.x = pk4_fp8(o0[0], o0[1], o0[2], o0[3]); w.y = pk4_fp8(o1[0], o1[1], o1[2], o1[3]);
                *(u32x2*)rowp = w; }
    }
};
struct EpiResBf16 {
    static constexpr bool PERM = true;
    const bf16* base; bf16* out; int ldc; float alpha; float sc = 1.f;
    __device__ __forceinline__ void operator()(const f32x4 (&acc)[2][2][4][2], const Unit& u, int wr, int wc, int fr, int fq) const {
        const int row0 = u.pm * BM + wr * 64 + fr, col0 = u.pn * BM + wc * 32 + 8 * fq;
#pragma unroll
        for (int ai = 0; ai < 2; ++ai)
#pragma unroll
            for (int m = 0; m < 4; ++m) { const size_t off = (size_t)(row0 + ai * HALF + m * 16) * ldc + col0;
#pragma unroll
                for (int bj = 0; bj < 2; ++bj) { const u32x4 b = *(const u32x4*)(base + off + bj * HALF); const f32x4 a0 = acc[ai][bj][m][0] * sc, a1 = acc[ai][bj][m][1] * sc;
                    u32x4 w; w.x = cvt_pk_bf16(__builtin_bit_cast(float, b.x << 16) * alpha + a0[0], __builtin_bit_cast(float, b.x & 0xffff0000u) * alpha + a0[1]);
                    w.y = cvt_pk_bf16(__builtin_bit_cast(float, b.y << 16) * alpha + a0[2], __builtin_bit_cast(float, b.y & 0xffff0000u) * alpha + a0[3]);
                    w.z = cvt_pk_bf16(__builtin_bit_cast(float, b.z << 16) * alpha + a1[0], __builtin_bit_cast(float, b.z & 0xffff0000u) * alpha + a1[1]);
                    w.w = cvt_pk_bf16(__builtin_bit_cast(float, b.w << 16) * alpha + a1[2], __builtin_bit_cast(float, b.w & 0xffff0000u) * alpha + a1[3]);
                    *(u32x4*)(out + off + bj * HALF) = w; }
                asm volatile("" ::: "memory"); }
    }
};

template <bool HB8> struct EpiResLn {
    static constexpr bool PERM = true;
    bf16* h; const float* gain; const float* bias; float alpha, sc;
    float* xbuf;
    unsigned* cnt;
    unsigned* tmo;
    unsigned char* h8;
    LAS unsigned char* tb;
    __device__ __forceinline__ void operator()(f32x4 (&acc)[2][2][4][2], const Unit& u, int wr, int wc, int fr, int fq) const {
        asm volatile("" : "+v"(fr), "+v"(fq));
        const int row0 = u.pm * BM + wr * 64 + fr, col0 = u.pn * BM + wc * 32 + 8 * fq;
        LAS f32x2* P = (LAS f32x2*)tb; LAS f32x2* S = (LAS f32x2*)(tb + 8192);
#pragma unroll
        for (int ai = 0; ai < 2; ++ai)
#pragma unroll
            for (int m = 0; m < 4; ++m) { const size_t off = (size_t)(row0 + ai * HALF + m * 16) * 1024 + col0; float sm = 0.f, sq = 0.f;
#pragma unroll
                for (int bj = 0; bj < 2; ++bj) { const u32x4 b = *(const u32x4*)(h + off + bj * HALF); const f32x4 a0 = acc[ai][bj][m][0] * sc, a1 = acc[ai][bj][m][1] * sc;
                    f32x4 z0, z1;
                    z0[0] = __builtin_bit_cast(float, b.x << 16) * alpha + a0[0]; z0[1] = __builtin_bit_cast(float, b.x & 0xffff0000u) * alpha + a0[1];
                    z0[2] = __builtin_bit_cast(float, b.y << 16) * alpha + a0[2]; z0[3] = __builtin_bit_cast(float, b.y & 0xffff0000u) * alpha + a0[3];
                    z1[0] = __builtin_bit_cast(float, b.z << 16) * alpha + a1[0]; z1[1] = __builtin_bit_cast(float, b.z & 0xffff0000u) * alpha + a1[1];
                    z1[2] = __builtin_bit_cast(float, b.w << 16) * alpha + a1[2]; z1[3] = __builtin_bit_cast(float, b.w & 0xffff0000u) * alpha + a1[3];
                    acc[ai][bj][m][0] = z0; acc[ai][bj][m][1] = z1;
                    sm += ((z0[0] + z0[1]) + (z0[2] + z0[3])) + ((z1[0] + z1[1]) + (z1[2] + z1[3]));
                    sq += ((z0[0] * z0[0] + z0[1] * z0[1]) + (z0[2] * z0[2] + z0[3] * z0[3])) + ((z1[0] * z1[0] + z1[1] * z1[1]) + (z1[2] * z1[2] + z1[3] * z1[3])); }
                sm += __shfl_xor(sm, 16); sm += __shfl_xor(sm, 32); sq += __shfl_xor(sq, 16); sq += __shfl_xor(sq, 32);
                if (fq == 0) P[(ai * HALF + wr * 64 + m * 16 + fr) * 4 + wc] = (f32x2){sm, sq};
                asm volatile("" ::: "memory"); }
        asm volatile("s_waitcnt lgkmcnt(0)" ::: "memory"); __builtin_amdgcn_s_barrier(); asm volatile("" ::: "memory");
        const int wid = wr * 4 + wc, lane = fq * 16 + fr, row = wid * 32 + (lane & 31);
        unsigned long long* slots = (unsigned long long*)xbuf + (size_t)(u.pm * BM + row) * 4;
        if (lane < 32) { const f32x2 a = P[row * 4 + 0], b = P[row * 4 + 1], c = P[row * 4 + 2], d = P[row * 4 + 3];
            const float ts = (a.x + b.x) + (c.x + d.x), tq = (a.y + b.y) + (c.y + d.y);
            __hip_atomic_store(slots + u.pn, ((unsigned long long)__builtin_bit_cast(unsigned, tq) << 32) | (unsigned long long)__builtin_bit_cast(unsigned, ts), __ATOMIC_RELAXED, __HIP_MEMORY_SCOPE_AGENT); }
        asm volatile("s_waitcnt vmcnt(0)" ::: "memory");
        if (lane == 0) (void)__hip_atomic_fetch_add(cnt + 16 * u.pm, 1u, __ATOMIC_RELAXED, __HIP_MEMORY_SCOPE_AGENT);
        if (wid == 0) { unsigned sp = 0u;
            while ((unsigned)__builtin_amdgcn_readfirstlane(__hip_atomic_load(cnt + 16 * u.pm, __ATOMIC_RELAXED, __HIP_MEMORY_SCOPE_AGENT)) < 32u) { __builtin_amdgcn_s_sleep(1);
                if ((++sp & 255u) == 0u) { if (__hip_atomic_load(tmo, __ATOMIC_RELAXED, __HIP_MEMORY_SCOPE_AGENT)) break; if (sp > (1u << 22)) { if (lane == 0) (void)__hip_atomic_fetch_add(tmo, 1u, __ATOMIC_RELAXED, __HIP_MEMORY_SCOPE_AGENT); break; } } }
            __builtin_amdgcn_fence(__ATOMIC_ACQUIRE, "agent"); }
        asm volatile("s_waitcnt vmcnt(0) lgkmcnt(0)" ::: "memory"); __builtin_amdgcn_s_barrier(); asm volatile("" ::: "memory");
        if (lane < 32) { float ts = 0.f, tq = 0.f;
#pragma unroll
            for (int t = 0; t < 4; ++t) { const unsigned long long w = __hip_atomic_load(slots + t, __ATOMIC_RELAXED, __HIP_MEMORY_SCOPE_AGENT); ts += __builtin_bit_cast(float, (unsigned)w); tq += __builtin_bit_cast(float, (unsigned)(w >> 32)); }
            const float mean = ts * (1.f / 1024.f), var = fmaxf(tq * (1.f / 1024.f) - mean * mean, 0.f);
            S[row] = (f32x2){mean, 1.f / sqrtf(var + LN_EPS)}; }
        asm volatile("s_waitcnt vmcnt(0) lgkmcnt(0)" ::: "memory"); __builtin_amdgcn_s_barrier(); asm volatile("" ::: "memory");
#pragma unroll
        for (int bj = 0; bj < 2; ++bj) { const f32x4 g0 = *(const f32x4*)(gain + col0 + bj * HALF), g1 = *(const f32x4*)(gain + col0 + bj * HALF + 4), b0 = *(const f32x4*)(bias + col0 + bj * HALF), b1 = *(const f32x4*)(bias + col0 + bj * HALF + 4);
#pragma unroll
            for (int ai = 0; ai < 2; ++ai)
#pragma unroll
                for (int m = 0; m < 4; ++m) { const int r = ai * HALF + wr * 64 + m * 16 + fr; const f32x2 sr = S[r]; const size_t off = (size_t)(u.pm * BM + r) * 1024 + col0 + bj * HALF;
                    const f32x4 y0 = (acc[ai][bj][m][0] - sr.x) * sr.y * g0 + b0, y1 = (acc[ai][bj][m][1] - sr.x) * sr.y * g1 + b1;
                    u32x4 w; w.x = cvt_pk_bf16(y0[0], y0[1]); w.y = cvt_pk_bf16(y0[2], y0[3]); w.z = cvt_pk_bf16(y1[0], y1[1]); w.w = cvt_pk_bf16(y1[2], y1[3]);
                    *(u32x4*)(h + off) = w;
                    if (HB8) { u32x2 w8; w8.x = pk4_fp8(y0[0], y0[1], y0[2], y0[3]); w8.y = pk4_fp8(y1[0], y1[1], y1[2], y1[3]); *(u32x2*)(h8 + off) = w8; }
                    asm volatile("" ::: "memory"); } }
    }
};

template <class Epi, class Sched, bool ALIGN_EPI = true, int FP8 = 0>
__device__ __forceinline__ void gemm_phase(LAS unsigned char* lds, const int wave_s, const Gemm g, const Sched& S, const Epi& E) {
    int tid = wave_s * 64 + (int)__builtin_amdgcn_mbcnt_hi(~0u, __builtin_amdgcn_mbcnt_lo(~0u, 0u)); asm volatile("" : "+v"(tid));
    const int wid = __builtin_amdgcn_readfirstlane(tid >> 6), lane = tid & 63, wr = wid >> 2, wc = wid & 3, fr = lane & 15, fq = lane >> 4;
    const int K = g.K, nt = K / BK;
    unsigned voffA[2], voffB[2];
#pragma unroll
    for (int i = 0; i < 2; ++i) { int R, C; stage_rc(tid * 16 + i * 8192, R, C); const int Rb = Epi::PERM ? ((R & ~31) + perm32(R & 31)) : R;
        voffA[i] = (unsigned)(R * g.rsA * K + C) * 2u; voffB[i] = (unsigned)(Rb * g.rsB * K + C) * 2u; }
    const unsigned kstep = (unsigned)(BK * 2);
    const unsigned hstepA = (unsigned)g.hstepA, hstepB = (unsigned)g.hstepB;
    const __amdgpu_buffer_rsrc_t rsrcA = __builtin_amdgcn_make_buffer_rsrc((void*)S.A0, 0, 0x7fffffff, 0x00020000), rsrcB = __builtin_amdgcn_make_buffer_rsrc((void*)S.B0, 0, 0x7fffffff, 0x00020000);
    const unsigned ldsw = (unsigned)wid * 1024u;
    const int aoff = lds_byte(wr * 64 + fr, fq * 8), boff = lds_byte(wc * 32 + fr, fq * 8);
    const int aoff8 = lds_byte(wr * 64 + fr, fq * 16), boff8 = lds_byte(wc * 32 + fr, fq * 16);
    unsigned bbase8_ = (unsigned)(4 * HTB + boff); asm volatile("" : "+v"(bbase8_));
    LAS unsigned char* const ldsB8 = lds + bbase8_;
#define PG8_SA(b, h) (((b) * 2 + (h)) * HTB)
#define PG8_SB(b, h) ((4 + (b) * 2 + (h)) * HTB)
#define PG8_STAGE(bufoff, gbase, voff) do { _Pragma("unroll") for (int _i = 0; _i < 2; ++_i) \
        __builtin_amdgcn_raw_ptr_buffer_load_lds(PG8_RS_##voff, (LAS unsigned*)(lds + (bufoff) + ldsw + _i * 8192), 16, (int)(voff)[_i], (int)(gbase), 0, 0); } while (0)
#define PG8_RS_voffA rsrcA
#define PG8_RS_voffB rsrcB
#define PG8_LD16(off) (*(const LAS bf16x8*)(lds + (off)))
#define PG8_CAT8(lo, hi) __builtin_shufflevector(__builtin_bit_cast(v4i_t, lo), __builtin_bit_cast(v4i_t, hi), 0, 1, 2, 3, 4, 5, 6, 7)
#define PG8_LDA(dst, b, h) do { if constexpr (FP8) { _Pragma("unroll") for (int m = 0; m < 4; ++m) dst##8[m] = PG8_CAT8(PG8_LD16(PG8_SA(b, h) + aoff + m * 2048), PG8_LD16(PG8_SA(b, h) + aoff + m * 2048 + 1024)); } \
        else { _Pragma("unroll") for (int m = 0; m < 4; ++m) _Pragma("unroll") for (int k = 0; k < 2; ++k) dst[m][k] = PG8_LD16(PG8_SA(b, h) + aoff + m * 2048 + k * 1024); } } while (0)
#define PG8_LDB(dst, b, h) do { if constexpr (FP8) { _Pragma("unroll") for (int n = 0; n < 2; ++n) dst##8[n] = PG8_CAT8(*(const LAS bf16x8*)(ldsB8 + ((b) * 2 + (h)) * HTB + n * 2048), *(const LAS bf16x8*)(ldsB8 + ((b) * 2 + (h)) * HTB + n * 2048 + 1024)); } \
        else { _Pragma("unroll") for (int n = 0; n < 2; ++n) _Pragma("unroll") for (int k = 0; k < 2; ++k) dst[n][k] = PG8_LD16(PG8_SB(b, h) + boff + n * 2048 + k * 1024); } } while (0)
#define PG8_MMA(ai, bj, At, Bt) do { __builtin_amdgcn_s_setprio(1); \
        if constexpr (FP8) { _Pragma("unroll") for (int m = 0; m < 4; ++m) _Pragma("unroll") for (int n = 0; n < 2; ++n) \
            acc[ai][bj][m][n] = __builtin_amdgcn_mfma_scale_f32_16x16x128_f8f6f4(Bt##8[n], At##8[m], acc[ai][bj][m][n], 0, 0, 0, 0, 0, 0); } \
        else { _Pragma("unroll") for (int m = 0; m < 4; ++m) _Pragma("unroll") for (int n = 0; n < 2; ++n) _Pragma("unroll") for (int k = 0; k < 2; ++k) \
            acc[ai][bj][m][n] = __builtin_amdgcn_mfma_f32_16x16x32_bf16(Bt[n][k], At[m][k], acc[ai][bj][m][n], 0, 0, 0); } \
        __builtin_amdgcn_s_setprio(0); } while (0)
#define PG8_WAIT_V(n) asm volatile("s_waitcnt vmcnt(" #n ")" ::: "memory")
#define PG8_WAIT_L(n) asm volatile("s_waitcnt lgkmcnt(" #n ")" ::: "memory")
#define PG8_BAR __builtin_amdgcn_s_barrier()
#define PG8_SCHED __builtin_amdgcn_sched_barrier(0)
    Unit cur, nxt; int ui = 0;
    if (!S.next(0, cur)) return;
    f32x4 acc[2][2][4][2];
#pragma unroll
    for (int a = 0; a < 2; ++a)
#pragma unroll
        for (int b = 0; b < 2; ++b)
#pragma unroll
            for (int m = 0; m < 4; ++m)
#pragma unroll
                for (int n = 0; n < 2; ++n) acc[a][b][m][n] = (f32x4){0.f, 0.f, 0.f, 0.f};
    bf16x8 At[4][2], B0[2][2], B1[2][2]; v8i_t At8[4], B08[2], B18[2];
    unsigned cA = cur.a, cB = cur.b;
    PG8_STAGE(PG8_SB(0, 0), cB, voffB); PG8_STAGE(PG8_SB(0, 1), cB + hstepB, voffB); PG8_STAGE(PG8_SA(0, 0), cA, voffA); PG8_STAGE(PG8_SA(0, 1), cA + hstepA, voffA);
    if (wr == 1) PG8_BAR;
    PG8_WAIT_V(2); PG8_BAR;
    PG8_STAGE(PG8_SB(1, 0), cB + kstep, voffB); PG8_STAGE(PG8_SA(1, 0), cA + kstep, voffA); PG8_STAGE(PG8_SB(1, 1), cB + hstepB + kstep, voffB);
    PG8_WAIT_V(6); PG8_BAR;
    for (;;) {
        const bool has_next = S.next(ui + 1, nxt);
        const unsigned nA = has_next ? nxt.a : cA, nB = has_next ? nxt.b : cB;
#pragma clang loop unroll(disable)
        for (int t = 0; t < nt; t += 2) {
            const bool last = (t == nt - 2);
            const unsigned a1 = cA + (unsigned)(t + 1) * kstep;
            const unsigned a2 = last ? nA : cA + (unsigned)(t + 2) * kstep, b2 = last ? nB : cB + (unsigned)(t + 2) * kstep;
            const unsigned a3 = a2 + kstep, b3 = b2 + kstep;
            PG8_LDB(B0, 0, 0); PG8_LDB(B1, 0, 1); PG8_SCHED; PG8_LDA(At, 0, 0); PG8_STAGE(PG8_SA(1, 1), a1 + hstepA, voffA);
            PG8_WAIT_V(8); PG8_WAIT_L(0); PG8_BAR; PG8_MMA(0, 0, At, B0); PG8_MMA(0, 1, At, B1); PG8_BAR; PG8_SCHED;
            PG8_LDA(At, 0, 1); PG8_STAGE(PG8_SB(0, 0), b2, voffB); PG8_STAGE(PG8_SB(0, 1), b2 + hstepB, voffB); PG8_STAGE(PG8_SA(0, 0), a2, voffA);
            PG8_WAIT_V(8); PG8_WAIT_L(0); PG8_BAR; PG8_MMA(1, 0, At, B0); PG8_MMA(1, 1, At, B1); PG8_BAR; PG8_SCHED;
            PG8_LDB(B0, 1, 0); PG8_LDB(B1, 1, 1); PG8_SCHED; PG8_LDA(At, 1, 0); PG8_STAGE(PG8_SA(0, 1), a2 + hstepA, voffA);
            PG8_WAIT_V(8); PG8_WAIT_L(0); PG8_BAR; PG8_MMA(0, 0, At, B0); PG8_MMA(0, 1, At, B1); PG8_BAR; PG8_SCHED;
            PG8_LDA(At, 1, 1); PG8_STAGE(PG8_SB(1, 0), b3, voffB); PG8_STAGE(PG8_SB(1, 1), b3 + hstepB, voffB); PG8_STAGE(PG8_SA(1, 0), a3, voffA);
            PG8_WAIT_V(8); PG8_WAIT_L(0); PG8_BAR; PG8_MMA(1, 0, At, B0); PG8_MMA(1, 1, At, B1); PG8_BAR; PG8_SCHED;
        }
        if constexpr (ALIGN_EPI) { if (wr == 0) PG8_BAR; }
        E(acc, cur, wr, wc, fr, fq);
        if (!has_next) break;
#pragma unroll
        for (int a = 0; a < 2; ++a)
#pragma unroll
            for (int b = 0; b < 2; ++b)
#pragma unroll
                for (int m = 0; m < 4; ++m)
#pragma unroll
                    for (int n = 0; n < 2; ++n) acc[a][b][m][n] = (f32x4){0.f, 0.f, 0.f, 0.f};
        cur = nxt; cA = nA; cB = nB; ++ui;
        if constexpr (ALIGN_EPI) { if (wr == 1) PG8_BAR; }
    }
    PG8_WAIT_V(0);
    if constexpr (!ALIGN_EPI) { if (wr == 0) PG8_BAR; }
    PG8_BAR;
#undef PG8_SA
#undef PG8_SB
#undef PG8_STAGE
#undef PG8_RS_voffA
#undef PG8_RS_voffB
#undef PG8_LDA
#undef PG8_LD16
#undef PG8_CAT8
#undef PG8_LDB
#undef PG8_MMA
#undef PG8_WAIT_V
#undef PG8_WAIT_L
#undef PG8_BAR
#undef PG8_SCHED
}
}

#define RLX_AGENT __ATOMIC_RELAXED, __HIP_MEMORY_SCOPE_AGENT
#define LDS_WAIT() asm volatile("s_waitcnt lgkmcnt(0)" ::: "memory")
#define VM_WAIT() asm volatile("s_waitcnt vmcnt(0)" ::: "memory")
__device__ __forceinline__ unsigned f2bf(float f) { unsigned u = __builtin_bit_cast(unsigned, f); return (u + 0x7fffu + ((u >> 16) & 1u)) >> 16; }
__device__ __forceinline__ unsigned pk2(float lo, float hi) { return pg8::cvt_pk_bf16(lo, hi); }
__device__ __forceinline__ float bflo(unsigned w) { return __builtin_bit_cast(float, w << 16); }
__device__ __forceinline__ float bfhi(unsigned w) { return __builtin_bit_cast(float, w & 0xffff0000u); }
__device__ __forceinline__ float wave_sum(float v) {
#pragma unroll
    for (int o = 1; o < 64; o <<= 1) v += __shfl_xor(v, o);
    return v;
}

#define XB_TMO      128
#define XB_XCNT(j)  (256  + 64 * (j))
#define XB_XSUB(j)  (1280 + 64 * (j))
#define XB_XGEN(j)  (2304 + 64 * (j))
#define XB_TOP      3328
#define XB_TOPGEN   3392
#define XCD_BAR_WORDS 3456
#define XB_SPIN_CAP (1u << 22)
__device__ __forceinline__ unsigned xb_ld(unsigned* p)              { return __hip_atomic_load(p, __ATOMIC_RELAXED, __HIP_MEMORY_SCOPE_AGENT); }
__device__ __forceinline__ unsigned xb_add(unsigned* p, unsigned v) { return __hip_atomic_fetch_add(p, v, __ATOMIC_RELAXED, __HIP_MEMORY_SCOPE_AGENT); }
__device__ __forceinline__ unsigned xb_xcc_id() { return (unsigned)__builtin_amdgcn_s_getreg((3 << 11) | 20) & 0xFu; }
#define XB_SPIN(cond, bar) do { unsigned _sp = 0; while (cond) { __builtin_amdgcn_s_sleep(1); \
    if ((++_sp & 255u) == 0u) { if (xb_ld(&(bar)[XB_TMO])) break; if (_sp > XB_SPIN_CAP) { atomicAdd(&(bar)[XB_TMO], 1u); break; } } } } while (0)
struct XcdBarrier { unsigned* bar; unsigned x; volatile LAS unsigned* st; };
__device__ __forceinline__ XcdBarrier xcd_barrier_post(unsigned* bar, volatile LAS unsigned* st) {
    XcdBarrier b; b.bar = bar; b.x = xb_xcc_id(); b.st = st;
    if (threadIdx.x == 0) (void)xb_add(&bar[XB_XCNT(b.x)], 1u);
    return b;
}
__device__ __forceinline__ void xcd_barrier_complete(unsigned* bar, unsigned x, unsigned& nloc, unsigned& nx) {
    const unsigned G = gridDim.x * gridDim.y * gridDim.z;
    unsigned sum, cnt, mine, sp = 0u;
    for (;;) {
        sum = 0u; cnt = 0u; mine = 0u;
#pragma unroll
        for (unsigned j = 0; j < 16; ++j) { const unsigned c = xb_ld(&bar[XB_XCNT(j)]); sum += c; cnt += (c > 0u) ? 1u : 0u; mine = (j == x) ? c : mine; }
        if (sum == G) break;
        __builtin_amdgcn_s_sleep(1);
        if ((++sp & 255u) == 0u) { if (xb_ld(&bar[XB_TMO])) break; if (sp > XB_SPIN_CAP) { atomicAdd(&bar[XB_TMO], 1u); break; } }
    }
    nloc = mine > 0u ? mine : 1u; nx = cnt > 0u ? cnt : 1u;
}
__device__ __forceinline__ void xcd_barrier(const XcdBarrier& b, const int tid) {
    asm volatile("s_waitcnt vmcnt(0)" ::: "memory");
    __syncthreads();
    if (tid == 0) {
        unsigned* bar = b.bar;
        __builtin_amdgcn_s_waitcnt(0);
        unsigned nloc = b.st[0], nx = b.st[1];
        if (nloc == 0u) { xcd_barrier_complete(bar, b.x, nloc, nx); b.st[0] = nloc; b.st[1] = nx; }
        const unsigned old = xb_add(&bar[XB_XSUB(b.x)], 1u);
        const unsigned gen = old / nloc;
        if (old + 1u == (gen + 1u) * nloc) {
            __builtin_amdgcn_fence(__ATOMIC_RELEASE, "agent");
            asm volatile("s_waitcnt vmcnt(0)" ::: "memory");
            const unsigned og = xb_add(&bar[XB_TOP], 1u);
            const unsigned tg = og / nx;
            if (og + 1u == (tg + 1u) * nx) xb_add(&bar[XB_TOPGEN], 1u);
            else XB_SPIN(xb_ld(&bar[XB_TOPGEN]) == tg, bar);
            __builtin_amdgcn_fence(__ATOMIC_ACQUIRE, "agent");
            xb_add(&bar[XB_XGEN(b.x)], 1u);
            asm volatile("s_waitcnt vmcnt(0)" ::: "memory");
        } else {
            XB_SPIN(xb_ld(&bar[XB_XGEN(b.x)]) == gen, bar);
            __builtin_amdgcn_fence(__ATOMIC_ACQUIRE, "agent");
            asm volatile("s_waitcnt vmcnt(0)" ::: "memory");
        }
    }
    __syncthreads();
}

constexpr int NWAVES = 8;
constexpr int RING_BYTES = 131072, MISC_OFF = RING_BYTES + 320, LNT_OFF = RING_BYTES + 2048  , LDS_BYTES = 147456;
struct Args { const float* in[24]; float* out; unsigned char* ws; int ph_lo, ph_hi; int chk, pad; };
struct Frame {
    LAS unsigned char* lds;
    gu32* ctl; unsigned char* ws; float* out;
    int tid, lane, wave, vcu, G;
    int chk, stage;
};

struct Job { const float* src; bf16* dst; int ld, K, N, mode, start; float scale; int fp8, pad; };
constexpr int NJOBS = 74;
__device__ __forceinline__ void make_job(const Args& a, int j, Job& J) {
    unsigned char* ws = a.ws; J.scale = 1.f; J.mode = 0; J.start = 0; J.fp8 = 0; J.pad = 0;
    if (j < 9) { const int g = j / 3, t = j % 3; J.src = a.in[4] + g * 3072 + t * 1024; J.ld = 9216; J.K = 1024; J.N = 1024;
        if (t == 2) J.dst = (bf16*)(ws + W_A_V + (size_t)g * 1024 * 1024); else J.dst = (bf16*)(ws + W_A_QK + (size_t)g * 2048 * 1024 + (size_t)t * 1024 * 1024);
        J.fp8 = 1; J.scale = (t == 0 ? QSCALE : 1.f) * WSCALE8; return; }
    j -= 9;
    if (j == 0) { J.src = a.in[5]; J.ld = 1024; J.K = 1024; J.N = 1024; J.dst = (bf16*)(ws + W_A_O); J.fp8 = 1; J.scale = WSCALE8; return; }
    if (j == 1) { J.src = a.in[6]; J.ld = 3072; J.K = 1024; J.N = 1024; J.dst = (bf16*)(ws + W_B_IN); return; }
    if (j == 9 || j == 10) { J.src = a.in[6] + 1024 * (j - 8); J.ld = 3072; J.K = 1024; J.N = 1024; J.dst = (bf16*)(ws + W_B_IN) + (size_t)1024 * 1024; J.mode = j - 8; return; }
    if (j == 2) { J.src = a.in[8]; J.ld = 1024; J.K = 1024; J.N = 1024; J.dst = (bf16*)(ws + W_B_O); return; }
    if (j == 3) { J.src = a.in[9]; J.ld = 3072; J.K = 1024; J.N = 1024; J.dst = (bf16*)(ws + W_C_QK); J.scale = QSCALE; return; }
    if (j == 4) { J.src = a.in[9] + 1024; J.ld = 3072; J.K = 1024; J.N = 1024; J.dst = (bf16*)(ws + W_C_QK) + (size_t)1024 * 1024; return; }
    if (j == 5) { J.src = a.in[9] + 2048; J.ld = 3072; J.K = 1024; J.N = 1024; J.dst = (bf16*)(ws + W_C_V); return; }
    if (j == 6) { J.src = a.in[10]; J.ld = 1024; J.K = 1024; J.N = 1024; J.dst = (bf16*)(ws + W_C_O); J.fp8 = 1; J.scale = WSCALE8; return; }
    if (j == 7) { J.src = a.in[11]; J.ld = 2048; J.K = 1024; J.N = 2048; J.dst = (bf16*)(ws + W_D_IN); return; }
    if (j == 8) { J.src = a.in[16]; J.ld = 1024; J.K = 1024; J.N = 1024; J.dst = (bf16*)(ws + W_D_O); return; }
    j -= 11;
    if (j < 6) { const int f = j / 3, t = j % 3;
        if (t < 2) { J.src = a.in[17 + t] + (size_t)f * 1024 * DFF; J.ld = DFF; J.K = 1024; J.N = DFF; J.dst = (bf16*)(ws + W_F_GU) + (size_t)f * 2 * DFF * 1024; J.mode = 1 + t;
            if (f == FFN_GU8) { J.fp8 = 1; J.scale = WSCALE8; } }
        else { J.src = a.in[19] + (size_t)f * DFF * 1024; J.ld = 1024; J.K = DFF; J.N = 1024; J.dst = (bf16*)(ws + W_F_D) + (size_t)f * 1024 * DFF; J.fp8 = 1; J.scale = WSCALE8D; }
        return; }
    j -= 6;
    { const int fe = j / 3, t = j % 3;
        if (t < 2) { J.src = a.in[21 + t] + (size_t)fe * 1024 * DFE; J.ld = DFE; J.K = 1024; J.N = DFE; J.dst = (bf16*)(ws + W_E_GU) + (size_t)fe * 2 * DFE * 1024; J.mode = 1 + t; J.fp8 = 1; J.scale = WSCALE8; }
        else { J.src = a.in[23] + (size_t)fe * DFE * 1024; J.ld = 1024; J.K = DFE; J.N = 1024; J.dst = (bf16*)(ws + W_E_D) + (size_t)fe * 1024 * DFE; J.fp8 = 1; J.scale = WSCALE8D; } }
}
__device__ __forceinline__ void transpose_item(const Job& J, int item, int lane) {
    const int nblk = J.N >> 6, kb = item / nblk, nb = item - kb * nblk, k0 = 64 * kb, n = 64 * nb + lane;
    const float* W = J.src + (size_t)k0 * J.ld + n;
    int r = n; if (J.mode) r = (n >> 7) * 256 + (n & 127) + (J.mode == 2 ? 128 : 0);
    const float sc = J.scale; const size_t ld = (size_t)J.ld;
    if (J.fp8) {
        unsigned char* dst8 = (unsigned char*)J.dst + (size_t)r * J.K + k0;
#pragma unroll
        for (int hf = 0; hf < 2; ++hf) {
            float v[32];
#pragma unroll
            for (int j = 0; j < 32; ++j) v[j] = W[(size_t)(32 * hf + j) * ld];
#pragma unroll
            for (int c = 0; c < 2; ++c) { u32x4 o; o.x = pk4_fp8(v[16 * c] * sc, v[16 * c + 1] * sc, v[16 * c + 2] * sc, v[16 * c + 3] * sc); o.y = pk4_fp8(v[16 * c + 4] * sc, v[16 * c + 5] * sc, v[16 * c + 6] * sc, v[16 * c + 7] * sc);
                o.z = pk4_fp8(v[16 * c + 8] * sc, v[16 * c + 9] * sc, v[16 * c + 10] * sc, v[16 * c + 11] * sc); o.w = pk4_fp8(v[16 * c + 12] * sc, v[16 * c + 13] * sc, v[16 * c + 14] * sc, v[16 * c + 15] * sc);
                *(u32x4*)(dst8 + 32 * hf + 16 * c) = o; }
        }
        return;
    }
    bf16* dst = J.dst + (size_t)r * J.K + k0;
#pragma unroll
    for (int hf = 0; hf < 2; ++hf) {
        float v[32];
#pragma unroll
        for (int j = 0; j < 32; ++j) v[j] = W[(size_t)(32 * hf + j) * ld];
#pragma unroll
        for (int c = 0; c < 4; ++c) { u32x4 o; o.x = pk2(v[8 * c] * sc, v[8 * c + 1] * sc); o.y = pk2(v[8 * c + 2] * sc, v[8 * c + 3] * sc); o.z = pk2(v[8 * c + 4] * sc, v[8 * c + 5] * sc); o.w = pk2(v[8 * c + 6] * sc, v[8 * c + 7] * sc);
            *(u32x4*)(dst + 32 * hf + 8 * c) = o; }
    }
}
__device__ __forceinline__ int t5_bucket(int d) {
    if (d < 16) return d;
    int b = 16 + (int)(log((double)d / 16.0) / log(128.0) * 16.0);
    return b < 16 ? 16 : (b > 31 ? 31 : b);
}
__device__ __forceinline__ void p_prologue(Frame& F, const Args& a) {
    unsigned char* gl_ = (unsigned char*)F.lds;
    Job* jobs = (Job*)(gl_ + 7 * 16384 + 8704);
    int* tot = (int*)(gl_ + 7 * 16384 + 8704 + NJOBS * sizeof(Job));
    static_assert(8704 + NJOBS * sizeof(Job) + 16 <= 16384, "job table fits");
    if (F.tid < NJOBS) { Job J; make_job(a, F.tid, J); jobs[F.tid] = J; }
    __syncthreads();
    if (F.tid == 0) { int s = 0; for (int j = 0; j < NJOBS; ++j) { jobs[j].start = s; s += (jobs[j].K / 64) * (jobs[j].N / 64); } tot[0] = s; }
    __syncthreads();
    const int total = tot[0];
    const int gw = F.vcu * NWAVES + F.wave, NGW = F.G * NWAVES;
    int jc = 0;
    for (int it = gw; it < total; it += NGW) {
        while (jc + 1 < NJOBS && jobs[jc + 1].start <= it) ++jc;
        const Job J = jobs[jc];
        transpose_item(J, it - J.start, F.lane);
    }
    { bf16* hb = (bf16*)(F.ws + WS_HB); const float* x = a.in[0]; unsigned char* hb8 = F.ws + WS_SCR + S_HB8;
      for (int m0 = 4 * gw; m0 < T; m0 += 4 * NGW) { f32x4 v[4][4];
#pragma unroll
          for (int k = 0; k < 4; ++k) { const f32x4* xr = (const f32x4*)(x + (size_t)(m0 + k) * D) + F.lane;
#pragma unroll
              for (int j = 0; j < 4; ++j) v[k][j] = xr[64 * j]; }
#pragma unroll
          for (int k = 0; k < 4; ++k) { unsigned long long* o8 = (unsigned long long*)(hb + (size_t)(m0 + k) * D) + F.lane;
#pragma unroll
              for (int j = 0; j < 4; ++j) o8[64 * j] = (unsigned long long)pk2(v[k][j].x, v[k][j].y) | ((unsigned long long)pk2(v[k][j].z, v[k][j].w) << 32);
              unsigned* o4 = (unsigned*)(hb8 + (size_t)(m0 + k) * D) + F.lane;
#pragma unroll
              for (int j = 0; j < 4; ++j) o4[64 * j] = pk4_fp8(v[k][j].x, v[k][j].y, v[k][j].z, v[k][j].w); } } }
    const int gt = blockIdx.x * 512 + F.tid, NGT = F.G * 512;
    const float* rel = a.in[1];
    float* btA = (float*)(F.ws + WS_BTABA); float* btC = (float*)(F.ws + WS_BTABC);
    for (int i = gt; i < 48 * 132; i += NGT) { const int gh = i / 132, dl = i % 132, g = gh >> 4, hh = gh & 15; const int dil = g == 0 ? 1 : (g == 1 ? 4 : 16);
        btA[i] = dl <= 128 ? rel[t5_bucket(dl * dil) * NH + hh] * LOG2E : 0.f; }
    for (int i = gt; i < 16 * 2048; i += NGT) { const int hh = i >> 11, dd = i & 2047; btC[i] = rel[t5_bucket(dd) * NH + hh] * LOG2E; }
    { bf16* wst = (bf16*)(F.ws + WS_WST); const float* wsrc = a.in[14];
      for (int i = gt; i < 8 * 128 * 128; i += NGT) { const int tt = (i >> 7) & 127, ss = i & 127; wst[i] = (bf16)f2bf(ss <= tt ? wsrc[i] : 0.f); } }
}

__device__ __forceinline__ void unpack8(const u32x4 a, float* x) { x[0] = bflo(a.x); x[1] = bfhi(a.x); x[2] = bflo(a.y); x[3] = bfhi(a.y); x[4] = bflo(a.z); x[5] = bfhi(a.z); x[6] = bflo(a.w); x[7] = bfhi(a.w); }
template <int MODE, bool ROUTE, bool FINAL, bool HB8 = false>
__device__ __forceinline__ void ln_phase(Frame& F, const float* gain, const float* bias, const float* wr) {
    constexpr int NBT = 2;
    const int gw = F.vcu * NWAVES + F.wave, NGW = F.G * NWAVES, lane = F.lane;
    bf16* hb = (bf16*)(F.ws + WS_HB); const bf16* zb = (const bf16*)F.out;
    float gv[16], bv[16];
#pragma unroll
    for (int k = 0; k < 2; ++k)
#pragma unroll
        for (int j = 0; j < 2; ++j) { const f32x4 g4 = *(const f32x4*)(gain + 512 * k + 8 * lane + 4 * j), b4 = *(const f32x4*)(bias + 512 * k + 8 * lane + 4 * j);
            gv[8 * k + 4 * j] = g4.x; gv[8 * k + 4 * j + 1] = g4.y; gv[8 * k + 4 * j + 2] = g4.z; gv[8 * k + 4 * j + 3] = g4.w;
            bv[8 * k + 4 * j] = b4.x; bv[8 * k + 4 * j + 1] = b4.y; bv[8 * k + 4 * j + 2] = b4.z; bv[8 * k + 4 * j + 3] = b4.w; }
    LAS float* wrT = (LAS float*)F.lds;
    if (ROUTE) { for (int i = F.tid; i < 8 * 1024; i += 512) { const int e = i >> 10, c = i & 1023; wrT[i] = wr[c * 8 + e]; } __syncthreads(); }
    const unsigned char* ys = F.ws + WS_SCR + S_XG;
    const int* slots = (const int*)(F.ws + WS_SLOTS); const float* gates = (const float*)(F.ws + WS_GATES);
    int* route = (int*)(F.ws + WS_ROUTE); float* gout = (float*)(F.ws + WS_GATES);
    for (int grp = gw; grp < T / 32; grp += NGW) {
        int cnt_e = 0;
        int my_e1 = 0, my_e2 = 0, my_r1 = 0, my_r2 = 0; float my_g1 = 0.f, my_g2 = 0.f;
        int sl0 = 0, sl1 = 0; float gg0 = 0.f, gg1 = 0.f;
        if (MODE == 2) { const int mm = grp * 32 + (lane & 31); sl0 = slots[2 * mm]; sl1 = slots[2 * mm + 1]; gg0 = gates[2 * mm]; gg1 = gates[2 * mm + 1]; }
        for (int i0 = 0; i0 < 32; i0 += NBT) {
            float v[NBT][16]; float st[NBT][2];
#pragma unroll
            for (int k = 0; k < NBT; ++k) { const int m = grp * 32 + i0 + k;
                if (MODE == 0) { const u32x4* zr = (const u32x4*)(zb + (size_t)m * D) + lane; unpack8(zr[0], v[k]); unpack8(zr[64], v[k] + 8); }
                else { const u32x4* hr = (const u32x4*)(hb + (size_t)m * D) + lane; unpack8(hr[0], v[k]); unpack8(hr[64], v[k] + 8);
#pragma unroll
                    for (int j = 0; j < 16; ++j) v[k][j] *= ALPHA;
                    if (MODE == 3) { const u32x4* yr = (const u32x4*)((const bf16*)(F.ws + WS_SCR + S_Y) + (size_t)m * D) + lane; float a[16]; unpack8(yr[0], a); unpack8(yr[64], a + 8);
#pragma unroll
                        for (int j = 0; j < 16; ++j) v[k][j] += a[j]; }
                    if (MODE == 2) { const int s0 = __builtin_amdgcn_readlane(sl0, i0 + k), s1 = __builtin_amdgcn_readlane(sl1, i0 + k);
                        const float g0 = __builtin_bit_cast(float, __builtin_amdgcn_readlane(__builtin_bit_cast(int, gg0), i0 + k)), g1 = __builtin_bit_cast(float, __builtin_amdgcn_readlane(__builtin_bit_cast(int, gg1), i0 + k));
                        const u32x2* y0 = (const u32x2*)(ys + (size_t)s0 * D) + lane; const u32x2* y1 = (const u32x2*)(ys + (size_t)s1 * D) + lane;
                        const u32x2 ya0 = y0[0], ya1 = y0[64], yb0 = y1[0], yb1 = y1[64];
                        float a[16], b[16];
#pragma unroll
                        for (int c = 0; c < 2; ++c) { const unsigned wa0 = c ? ya0.y : ya0.x, wa1 = c ? ya1.y : ya1.x, wb0 = c ? yb0.y : yb0.x, wb1 = c ? yb1.y : yb1.x;
                            f32x2 t;
                            t = __builtin_amdgcn_cvt_pk_f32_fp8((int)wa0, false); a[4 * c] = t.x; a[4 * c + 1] = t.y; t = __builtin_amdgcn_cvt_pk_f32_fp8((int)wa0, true); a[4 * c + 2] = t.x; a[4 * c + 3] = t.y;
                            t = __builtin_amdgcn_cvt_pk_f32_fp8((int)wa1, false); a[8 + 4 * c] = t.x; a[8 + 4 * c + 1] = t.y; t = __builtin_amdgcn_cvt_pk_f32_fp8((int)wa1, true); a[8 + 4 * c + 2] = t.x; a[8 + 4 * c + 3] = t.y;
                            t = __builtin_amdgcn_cvt_pk_f32_fp8((int)wb0, false); b[4 * c] = t.x; b[4 * c + 1] = t.y; t = __builtin_amdgcn_cvt_pk_f32_fp8((int)wb0, true); b[4 * c + 2] = t.x; b[4 * c + 3] = t.y;
                            t = __builtin_amdgcn_cvt_pk_f32_fp8((int)wb1, false); b[8 + 4 * c] = t.x; b[8 + 4 * c + 1] = t.y; t = __builtin_amdgcn_cvt_pk_f32_fp8((int)wb1, true); b[8 + 4 * c + 2] = t.x; b[8 + 4 * c + 3] = t.y; }
                        const float h0 = g0 * (1.f / YSCALE8), h1 = g1 * (1.f / YSCALE8);
#pragma unroll
                        for (int j = 0; j < 16; ++j) v[k][j] += h0 * a[j] + h1 * b[j]; } }
                float s = 0.f, q2 = 0.f;
#pragma unroll
                for (int j = 0; j < 16; ++j) { s += v[k][j]; q2 += v[k][j] * v[k][j]; }
                st[k][0] = s; st[k][1] = q2; }
#pragma unroll
            for (int o = 1; o < 64; o <<= 1) {
#pragma unroll
                for (int k = 0; k < NBT; ++k) { st[k][0] += __shfl_xor(st[k][0], o); st[k][1] += __shfl_xor(st[k][1], o); } }
#pragma unroll
            for (int k = 0; k < NBT; ++k) { const int m = grp * 32 + i0 + k;
                const float mean = st[k][0] * (1.f / D), var = fmaxf(st[k][1] * (1.f / D) - mean * mean, 0.f), rstd = 1.f / sqrtf(var + LN_EPS);
#pragma unroll
                for (int j = 0; j < 16; ++j) v[k][j] = (v[k][j] - mean) * rstd * gv[j] + bv[j];
                if (FINAL) { f32x4* orow = (f32x4*)(F.out + (size_t)m * D) + 2 * lane;
                    orow[0] = (f32x4){v[k][0], v[k][1], v[k][2], v[k][3]}; orow[1] = (f32x4){v[k][4], v[k][5], v[k][6], v[k][7]}; orow[128] = (f32x4){v[k][8], v[k][9], v[k][10], v[k][11]}; orow[129] = (f32x4){v[k][12], v[k][13], v[k][14], v[k][15]}; }
                else { u32x4* o = (u32x4*)(hb + (size_t)m * D) + lane; u32x4 a, b;
                    a.x = pk2(v[k][0], v[k][1]); a.y = pk2(v[k][2], v[k][3]); a.z = pk2(v[k][4], v[k][5]); a.w = pk2(v[k][6], v[k][7]); b.x = pk2(v[k][8], v[k][9]); b.y = pk2(v[k][10], v[k][11]); b.z = pk2(v[k][12], v[k][13]); b.w = pk2(v[k][14], v[k][15]);
                    o[0] = a; o[64] = b;
                    if (HB8) { u32x2* o8 = (u32x2*)(F.ws + WS_SCR + S_HB8 + (size_t)m * D) + lane; u32x2 c, d;
                        c.x = pk4_fp8(v[k][0], v[k][1], v[k][2], v[k][3]); c.y = pk4_fp8(v[k][4], v[k][5], v[k][6], v[k][7]); d.x = pk4_fp8(v[k][8], v[k][9], v[k][10], v[k][11]); d.y = pk4_fp8(v[k][12], v[k][13], v[k][14], v[k][15]);
                        o8[0] = c; o8[64] = d; } }
                if (ROUTE) {
                    float lg[8];
#pragma unroll
                    for (int e = 0; e < 8; ++e) { float p = 0.f;
#pragma unroll
                        for (int kk = 0; kk < 2; ++kk)
#pragma unroll
                            for (int j = 0; j < 2; ++j) { const f32x4 w4 = *(const LAS f32x4*)(wrT + e * 1024 + 512 * kk + 8 * lane + 4 * j); p += (v[k][8 * kk + 4 * j] * w4.x + v[k][8 * kk + 4 * j + 1] * w4.y) + (v[k][8 * kk + 4 * j + 2] * w4.z + v[k][8 * kk + 4 * j + 3] * w4.w); }
                        lg[e] = p; }
#pragma unroll
                    for (int o = 1; o < 64; o <<= 1) {
#pragma unroll
                        for (int e = 0; e < 8; ++e) lg[e] += __shfl_xor(lg[e], o); }
                    int e1 = 0; float v1 = lg[0];
#pragma unroll
                    for (int e = 1; e < 8; ++e) if (lg[e] > v1) { v1 = lg[e]; e1 = e; }
                    int e2 = -1; float v2 = -3.4e38f;
#pragma unroll
                    for (int e = 0; e < 8; ++e) if (e != e1 && lg[e] > v2) { v2 = lg[e]; e2 = e; }
                    const float g2 = 1.f / (1.f + __expf(v1 - v2)), g1 = 1.f - g2;
                    const int r1 = __shfl(cnt_e, e1); if (lane == e1) ++cnt_e;
                    const int r2 = __shfl(cnt_e, e2); if (lane == e2) ++cnt_e;
                    if (lane == i0 + k) { my_e1 = e1; my_e2 = e2; my_r1 = r1; my_r2 = r2; my_g1 = g1; my_g2 = g2; }
                }
            }
        }
        if (ROUTE) {
            if (lane < 8) ((int*)(F.ws + WS_WCNT))[grp * 8 + lane] = cnt_e;
            if (lane < 32) { const int m = grp * 32 + lane; int* r = route + 4 * m; r[0] = my_e1; r[1] = my_r1; r[2] = my_e2; r[3] = my_r2; gout[2 * m] = my_g1; gout[2 * m + 1] = my_g2; }
        }
    }
}

__device__ __forceinline__ f32x16 mfma32(bf16x8 a, bf16x8 b, f32x16 c) { return __builtin_amdgcn_mfma_f32_32x32x16_bf16(a, b, c, 0, 0, 0); }
__device__ __forceinline__ bf16x8 pack8(const f32x16& s, int b0) {
    u32x4 w; w.x = pg8::cvt_pk_bf16(s[b0], s[b0 + 1]); w.y = pg8::cvt_pk_bf16(s[b0 + 2], s[b0 + 3]); w.z = pg8::cvt_pk_bf16(s[b0 + 4], s[b0 + 5]); w.w = pg8::cvt_pk_bf16(s[b0 + 6], s[b0 + 7]);
    return __builtin_bit_cast(bf16x8, w);
}
__device__ __forceinline__ float max16(const f32x16& s) {
    float a = fmaxf(fmaxf(s[0], s[1]), fmaxf(s[2], s[3])), b = fmaxf(fmaxf(s[4], s[5]), fmaxf(s[6], s[7]));
    float c = fmaxf(fmaxf(s[8], s[9]), fmaxf(s[10], s[11])), d = fmaxf(fmaxf(s[12], s[13]), fmaxf(s[14], s[15]));
    return fmaxf(fmaxf(a, b), fmaxf(c, d));
}
__device__ __forceinline__ void softmax_pv(f32x16& s, float& m_run, float& l_run, f32x16& o0, f32x16& o1, const bf16* vt0, const bf16* vt1, int h) {
    float mx = max16(s); mx = fmaxf(mx, __shfl_xor(mx, 32));
    const float mn = fmaxf(m_run, mx), alpha = __builtin_amdgcn_exp2f(m_run - mn); m_run = mn;
    float ps = 0.f;
#pragma unroll
    for (int r = 0; r < 16; ++r) { const float p = __builtin_amdgcn_exp2f(s[r] - mn); s[r] = p; ps += p; }
    l_run = l_run * alpha + ps;
#pragma unroll
    for (int r = 0; r < 16; ++r) { o0[r] *= alpha; o1[r] *= alpha; }
    const bf16x8 p0 = pack8(s, 0), p1 = pack8(s, 8);
    const bf16x8 v00 = *(const bf16x8*)(vt0 + 8 * h), v01 = *(const bf16x8*)(vt0 + 16 + 8 * h), v10 = *(const bf16x8*)(vt1 + 8 * h), v11 = *(const bf16x8*)(vt1 + 16 + 8 * h);
    o0 = mfma32(v00, p0, o0); o0 = mfma32(v01, p1, o0);
    o1 = mfma32(v10, p0, o1); o1 = mfma32(v11, p1, o1);
}
__device__ __forceinline__ int kperm(int i) { return (i & 19) | ((i & 8) >> 1) | ((i & 4) << 1); }

__device__ __forceinline__ void dil_attn_phase(Frame& F) {
    LAS float* bt = (LAS float*)F.lds;
    { const float* btA = (const float*)(F.ws + WS_BTABA); for (int i = F.tid; i < 48 * 192; i += 512) { const int gh = i / 192, dl = i % 192 - 32; bt[i] = (dl >= 0 && dl <= 128) ? btA[gh * 132 + dl] : NEGB; } }
    __syncthreads();
    const int gw = F.vcu * NWAVES + F.wave, NGW = F.G * NWAVES, lane = F.lane, q = lane & 31, h = lane >> 5;
    const bf16* QK = (const bf16*)(F.ws + WS_SCR + S_QK); const bf16* VT = (const bf16*)(F.ws + WS_SCR + S_VT);
    bf16* OG = (bf16*)((unsigned char*)F.out + O_OG); float* LSE = (float*)((unsigned char*)F.out + O_LSE);
    constexpr int NTASK = 3 * 16 * 8 * 64;
    const int per = (NTASK + NGW - 1) / NGW;
    const int t_lo = gw * per, t_hi = (t_lo + per) < NTASK ? (t_lo + per) : NTASK;
    for (int task = t_lo; task < t_hi; ++task) {
        const int qt = task & 3, rn = (task >> 2) & 15, bl = (task >> 6) & 7, gh = task >> 9, g = gh >> 4, hh = gh & 15;
        const int nblk = 16 >> (2 * g); const bool has_prev = (rn & (nblk - 1)) != 0;
        const int n0 = bl * 2048 + rn * 128;
        const bf16* qrow = QK + ((size_t)g * TC + n0 + 32 * qt + q) * 2048 + hh * 64;
        bf16x8 qf[4];
#pragma unroll
        for (int d0 = 0; d0 < 4; ++d0) qf[d0] = *(const bf16x8*)(qrow + d0 * 16 + 8 * h);
        float m_run = NEGB, l_run = 0.f; f32x16 o0 = {}, o1 = {};
        const bf16* vbase0 = VT + ((size_t)g * 1024 + hh * 64 + q) * TC; const bf16* vbase1 = vbase0 + (size_t)32 * TC;
        const LAS float* btl = bt + gh * 192 + (q - 8 * h + 137);
#pragma unroll
        for (int t = 0; t < 5; ++t) {
            if (has_prev || qt + t > 3) {
                const int kr0 = n0 - 128 + 32 * qt + 32 * t;
                const bf16* krow = QK + ((size_t)g * TC + kr0 + kperm(q)) * 2048 + 1024 + hh * 64;
                f32x16 s;
#pragma unroll
                for (int r = 0; r < 16; ++r) s[r] = btl[-32 * t + 23 - 16 * (r >> 3) - (r & 7)];
#pragma unroll
                for (int d0 = 0; d0 < 4; ++d0) { const bf16x8 kf = *(const bf16x8*)(krow + d0 * 16 + 8 * h); s = mfma32(kf, qf[d0], s); }
                softmax_pv(s, m_run, l_run, o0, o1, vbase0 + kr0, vbase1 + kr0, h);
            }
        }
        const float l_tot = l_run + __shfl_xor(l_run, 32), inv = 1.f / l_tot;
        const size_t orow = (size_t)g * TC + n0 + 32 * qt + q;
        bf16* op = OG + orow * 1024 + hh * 64 + 4 * h;
#pragma unroll
        for (int gq = 0; gq < 4; ++gq) {
            u32x2 w0, w1; w0.x = pg8::cvt_pk_bf16(o0[4 * gq] * inv, o0[4 * gq + 1] * inv); w0.y = pg8::cvt_pk_bf16(o0[4 * gq + 2] * inv, o0[4 * gq + 3] * inv);
            w1.x = pg8::cvt_pk_bf16(o1[4 * gq] * inv, o1[4 * gq + 1] * inv); w1.y = pg8::cvt_pk_bf16(o1[4 * gq + 2] * inv, o1[4 * gq + 3] * inv);
            *(u32x2*)(op + 8 * gq) = w0; *(u32x2*)(op + 32 + 8 * gq) = w1; }
        if (h == 0) LSE[orow * 16 + hh] = m_run + __log2f(l_tot);
    }
}
__device__ __forceinline__ void dil_merge_phase(Frame& F, int ck) {
    const int gw = F.vcu * NWAVES + F.wave, NGW = F.G * NWAVES, lane = F.lane;
    const bf16* OG = (const bf16*)((unsigned char*)F.out + O_OG); const float* LSE = (const float*)((unsigned char*)F.out + O_LSE);
    unsigned char* att = F.ws + WS_SCR + S_ATT + (size_t)ck * TC * 1024;
    const int hh = lane >> 2;
    for (int tl0 = 2 * gw; tl0 < TC; tl0 += 2 * NGW) {
        size_t n[2][3]; float ls[2][3]; u32x4 x[2][3];
#pragma unroll
        for (int k = 0; k < 2; ++k) { const int tl = tl0 + k, bl = tl >> 11, tt = tl & 2047;
            n[k][0] = tl; n[k][1] = bl * 2048 + (tt & 3) * 512 + (tt >> 2); n[k][2] = bl * 2048 + (tt & 15) * 128 + (tt >> 4);
#pragma unroll
            for (int g = 0; g < 3; ++g) { ls[k][g] = LSE[((size_t)g * TC + n[k][g]) * 16 + hh]; x[k][g] = *(const u32x4*)((const unsigned char*)OG + ((size_t)g * TC + n[k][g]) * 1024 + 16 * lane); } }
#pragma unroll
        for (int k = 0; k < 2; ++k) {
            const float M = fmaxf(fmaxf(ls[k][0], ls[k][1]), ls[k][2]);
            float w[3]; float W = 0.f;
#pragma unroll
            for (int g = 0; g < 3; ++g) { w[g] = __builtin_amdgcn_exp2f(ls[k][g] - M); W += w[g]; }
            const float iw = 1.f / W;
            float acc[16];
#pragma unroll
            for (int j = 0; j < 16; ++j) acc[j] = 0.f;
#pragma unroll
            for (int g = 0; g < 3; ++g) { const float wg = w[g] * iw; float a[16];
#pragma unroll
                for (int c = 0; c < 4; ++c) { const f32x2 lo = __builtin_amdgcn_cvt_pk_f32_fp8((int)x[k][g][c], false), hi = __builtin_amdgcn_cvt_pk_f32_fp8((int)x[k][g][c], true); a[4 * c] = lo.x; a[4 * c + 1] = lo.y; a[4 * c + 2] = hi.x; a[4 * c + 3] = hi.y; }
#pragma unroll
                for (int j = 0; j < 16; ++j) acc[j] += wg * a[j]; }
            u32x4 y; y.x = pk4_fp8(acc[0], acc[1], acc[2], acc[3]); y.y = pk4_fp8(acc[4], acc[5], acc[6], acc[7]); y.z = pk4_fp8(acc[8], acc[9], acc[10], acc[11]); y.w = pk4_fp8(acc[12], acc[13], acc[14], acc[15]);
            *(u32x4*)(att + (size_t)(tl0 + k) * 1024 + 16 * lane) = y;
        }
    }
}

__device__ __forceinline__ void conv_phase(Frame& F, const float* cw) {
    const int gw = F.vcu * NWAVES + F.wave, NGW = F.G * NWAVES, lane = F.lane;
    const bf16* gbp = (const bf16*)(F.ws + WS_SCR + S_BCX); const bf16* up = (const bf16*)(F.ws + WS_SCR + S_BCX + (size_t)128 * MiB); bf16* p = (bf16*)(F.ws + WS_SCR + S_P);
    for (int item = gw; item < (T / 32) * 2; item += NGW) {
        const int half = item & 1, tb = item >> 1, t0 = tb * 32, c0 = half * 512 + lane * 8;
        float w0[8], w1[8], w2[8];
#pragma unroll
        for (int j = 0; j < 8; ++j) { w0[j] = cw[c0 + j]; w1[j] = cw[1024 + c0 + j]; w2[j] = cw[2048 + c0 + j]; }
        float u1[8], u2[8];
        const bool first = (t0 & 2047) == 0;
#pragma unroll
        for (int j = 0; j < 8; ++j) { u1[j] = 0.f; u2[j] = 0.f; }
        if (!first) { unpack8(*(const u32x4*)(up + (size_t)(t0 - 2) * 1024 + c0), u2); unpack8(*(const u32x4*)(up + (size_t)(t0 - 1) * 1024 + c0), u1); }
        for (int i = 0; i < 32; ++i) { const size_t r = (size_t)(t0 + i) * 1024;
            const u32x4 gb = *(const u32x4*)(gbp + r + c0), uu = *(const u32x4*)(up + r + c0);
            float u0[8], b[8]; unpack8(uu, u0); unpack8(gb, b);
            float o[8];
#pragma unroll
            for (int j = 0; j < 8; ++j) { o[j] = b[j] * (w0[j] * u2[j] + w1[j] * u1[j] + w2[j] * u0[j]); u2[j] = u1[j]; u1[j] = u0[j]; }
            u32x4 x; x.x = pk2(o[0], o[1]); x.y = pk2(o[2], o[3]); x.z = pk2(o[4], o[5]); x.w = pk2(o[6], o[7]);
            *(u32x4*)(p + (size_t)(t0 + i) * 1024 + c0) = x; }
    }
}

__device__ __forceinline__ void kmean_phase(Frame& F) {
    const int gw = F.vcu * NWAVES + F.wave, NGW = F.G * NWAVES, lane = F.lane;
    const bf16* QK = (const bf16*)(F.ws + WS_SCR + S_CQK); float* km = (float*)(F.ws + WS_KMEAN);
    const int kq = lane >> 3, dc = lane & 7;
    for (int u = gw; u < NB * NH * 8; u += NGW) { const int blk = u & 7, hh = (u >> 3) & 15, b = u >> 7;
        float a[8];
#pragma unroll
        for (int j = 0; j < 8; ++j) a[j] = 0.f;
        const bf16* kp = QK + ((size_t)b * SEQ + blk * 256 + kq) * 2048 + 1024 + hh * 64 + dc * 8;
#pragma unroll 8
        for (int i = 0; i < 32; ++i) { const u32x4 x = *(const u32x4*)(kp + (size_t)i * 8 * 2048);
            a[0] += bflo(x.x); a[1] += bfhi(x.x); a[2] += bflo(x.y); a[3] += bfhi(x.y); a[4] += bflo(x.z); a[5] += bfhi(x.z); a[6] += bflo(x.w); a[7] += bfhi(x.w); }
#pragma unroll
        for (int j = 0; j < 8; ++j) { a[j] += __shfl_xor(a[j], 8); a[j] += __shfl_xor(a[j], 16); a[j] += __shfl_xor(a[j], 32); }
        if (lane < 8) { float* o = km + (size_t)u * 64 + lane * 8;
#pragma unroll
            for (int j = 0; j < 8; ++j) o[j] = a[j] * (1.f / 256.f); }
    }
}
__device__ __forceinline__ void moba_unit(Frame& F, int b, int hh, int nb, LAS float* bt, int& cur_h) {
    const int lane = F.lane, q = lane & 31, h = lane >> 5, w = F.wave;
    const bf16* QK = (const bf16*)(F.ws + WS_SCR + S_CQK); const bf16* VT = (const bf16*)(F.ws + WS_SCR + S_CVT);
    bf16* att = (bf16*)(F.ws + WS_SCR + S_CATT); const float* km = (const float*)(F.ws + WS_KMEAN);
    if (hh != cur_h) { __syncthreads(); const float* btC = (const float*)(F.ws + WS_BTABC) + hh * 2048; for (int i = F.tid; i < 2048; i += 512) bt[i] = btC[i]; cur_h = hh; __syncthreads(); }
    const size_t tq = (size_t)b * SEQ + nb * 256 + 32 * w + q;
    const bf16* qrow = QK + tq * 2048 + hh * 64;
    bf16x8 qf[4];
#pragma unroll
    for (int d0 = 0; d0 < 4; ++d0) qf[d0] = *(const bf16x8*)(qrow + d0 * 16 + 8 * h);
    unsigned sel = 0;
    if (nb > 0) {
        float gsc[7];
#pragma unroll
        for (int m = 0; m < 7; ++m) { float s = 0.f;
            if (m < nb) { const float* kmp = km + (((size_t)b * NH + hh) * 8 + m) * 64;
#pragma unroll
                for (int d0 = 0; d0 < 4; ++d0) { const f32x4 k0 = *(const f32x4*)(kmp + d0 * 16 + 8 * h), k1 = *(const f32x4*)(kmp + d0 * 16 + 8 * h + 4); const u32x4 qq = __builtin_bit_cast(u32x4, qf[d0]);
                    s += bflo(qq.x) * k0.x + bfhi(qq.x) * k0.y + bflo(qq.y) * k0.z + bfhi(qq.y) * k0.w + bflo(qq.z) * k1.x + bfhi(qq.z) * k1.y + bflo(qq.w) * k1.z + bfhi(qq.w) * k1.w; }
                s += __shfl_xor(s, 32); }
            gsc[m] = m < nb ? s : -3.0e38f; }
        const int nsel = nb < 3 ? nb : 3;
#pragma unroll
        for (int r = 0; r < 3; ++r) { if (r < nsel) { int bi = -1; float bv = -3.4e38f;
#pragma unroll
                for (int m = 0; m < 7; ++m) if (!((sel >> m) & 1u) && gsc[m] > bv) { bv = gsc[m]; bi = m; }
                sel |= 1u << bi; } }
    }
#ifdef MK_SELFCHECK
    if (h == 0) ((unsigned*)(F.ws + WS_NEED + 3 * MiB))[tq * 16 + hh] = sel;
#endif
    float m_run = NEGB, l_run = 0.f; f32x16 o0 = {}, o1 = {};
    const bf16* vbase0 = VT + ((size_t)hh * 64 + q) * T + (size_t)b * SEQ; const bf16* vbase1 = vbase0 + (size_t)32 * T;
    const int qpos = nb * 256 + 32 * w + q;
    for (int m = 0; m < nb; ++m) {
        const bool mine = (sel >> m) & 1u;
        if (__ballot(mine) == 0ull) continue;
        for (int kt = 0; kt < 8; ++kt) {
            const int kr0 = m * 256 + 32 * kt;
            const bf16* krow = QK + ((size_t)b * SEQ + kr0 + kperm(q)) * 2048 + 1024 + hh * 64;
            f32x16 s = {};
#pragma unroll
            for (int d0 = 0; d0 < 4; ++d0) { const bf16x8 kf = *(const bf16x8*)(krow + d0 * 16 + 8 * h); s = mfma32(kf, qf[d0], s); }
#pragma unroll
            for (int r = 0; r < 16; ++r) { const int kap = 16 * (r >> 3) + 8 * h + (r & 7); const float bb = bt[qpos - kr0 - kap]; s[r] = mine ? s[r] + bb : NEGB; }
            softmax_pv(s, m_run, l_run, o0, o1, vbase0 + kr0, vbase1 + kr0, h);
        }
    }
    for (int kt = 0; kt <= w; ++kt) {
        const int kr0 = nb * 256 + 32 * kt;
        const bf16* krow = QK + ((size_t)b * SEQ + kr0 + kperm(q)) * 2048 + 1024 + hh * 64;
        f32x16 s = {};
#pragma unroll
        for (int d0 = 0; d0 < 4; ++d0) { const bf16x8 kf = *(const bf16x8*)(krow + d0 * 16 + 8 * h); s = mfma32(kf, qf[d0], s); }
#pragma unroll
        for (int r = 0; r < 16; ++r) { const int kap = 16 * (r >> 3) + 8 * h + (r & 7); const int dd = qpos - kr0 - kap; const float bb = bt[dd < 0 ? 0 : dd]; s[r] = dd >= 0 ? s[r] + bb : NEGB; }
        softmax_pv(s, m_run, l_run, o0, o1, vbase0 + kr0, vbase1 + kr0, h);
    }
    const float l_tot = l_run + __shfl_xor(l_run, 32), inv = 1.f / l_tot;
#ifdef MK_SELFCHECK
    if (h == 0) ((float*)(F.ws + WS_NEED + 7 * MiB))[tq * 16 + hh] = m_run + __log2f(l_tot);
#endif
    bf16* op = att + tq * 1024 + hh * 64 + 4 * h;
#pragma unroll
    for (int gq = 0; gq < 4; ++gq) {
        u32x2 w0, w1; w0.x = pg8::cvt_pk_bf16(o0[4 * gq] * inv, o0[4 * gq + 1] * inv); w0.y = pg8::cvt_pk_bf16(o0[4 * gq + 2] * inv, o0[4 * gq + 3] * inv);
        w1.x = pg8::cvt_pk_bf16(o1[4 * gq] * inv, o1[4 * gq + 1] * inv); w1.y = pg8::cvt_pk_bf16(o1[4 * gq + 2] * inv, o1[4 * gq + 3] * inv);
        *(u32x2*)(op + 8 * gq) = w0; *(u32x2*)(op + 32 + 8 * gq) = w1; }
}
__device__ __forceinline__ void moba_phase(Frame& F) {
    LAS float* bt = (LAS float*)F.lds; int cur_h = -1;
    const int NP = NB * NH * 4, per = (NP + F.G - 1) / F.G;
    const int lo = F.vcu * per, hi = (lo + per) < NP ? (lo + per) : NP;
    for (int pu = lo; pu < hi; ++pu) { const int j = pu & 3, hh = (pu >> 2) & 15, b = pu >> 6;
        moba_unit(F, b, hh, 7 - j, bt, cur_h); moba_unit(F, b, hh, j, bt, cur_h); }
}


constexpr int AKP = 72;
constexpr int ATILE = 64 * AKP * 2;
struct AttnSt { float m, l; f32x16 o0, o1; };
template <bool MASKED>
__device__ __forceinline__ void attn_tile(const LAS bf16* Kt, const LAS bf16* Vt, const LAS float* bl, const bf16x8 (&qf)[4], AttnSt& st, int q, int h, bool mine) {
    f32x16 s;
#pragma unroll
    for (int r = 0; r < 16; ++r) s[r] = bl[23 - 16 * (r >> 3) - (r & 7)];
    const LAS bf16* kr = Kt + kperm(q) * AKP + 8 * h;
#pragma unroll
    for (int d0 = 0; d0 < 4; ++d0) s = mfma32(*(const LAS bf16x8*)(kr + d0 * 16), qf[d0], s);
    float mx = max16(s); mx = fmaxf(mx, __shfl_xor(mx, 32));
    float mn = fmaxf(st.m, mx); if (MASKED) mn = mine ? mn : st.m;
    const float alpha = __builtin_amdgcn_exp2f(st.m - mn);
    float ps = 0.f;
#pragma unroll
    for (int r = 0; r < 16; ++r) { const float p = __builtin_amdgcn_exp2f(s[r] - mn); s[r] = p; ps += p; }
    bf16x8 p0 = pack8(s, 0), p1 = pack8(s, 8);
    if (MASKED) { if (!mine) { p0 = (bf16x8){0, 0, 0, 0, 0, 0, 0, 0}; p1 = p0; ps = 0.f; } }
    st.l = st.l * alpha + ps; st.m = mn;
    if (__ballot(alpha != 1.0f) != 0ull) {
#pragma unroll
        for (int r = 0; r < 16; ++r) { st.o0[r] *= alpha; st.o1[r] *= alpha; } }
    const LAS bf16* v0 = Vt + q * AKP + 8 * h; const LAS bf16* v1 = v0 + 32 * AKP;
    st.o0 = mfma32(*(const LAS bf16x8*)v0, p0, st.o0); st.o0 = mfma32(*(const LAS bf16x8*)(v0 + 16), p1, st.o0);
    st.o1 = mfma32(*(const LAS bf16x8*)v1, p0, st.o1); st.o1 = mfma32(*(const LAS bf16x8*)(v1 + 16), p1, st.o1);
}
__device__ __forceinline__ void attn_store(const AttnSt& st, bf16* op  , float inv) {
#pragma unroll
    for (int gq = 0; gq < 4; ++gq) {
        u32x2 w0, w1; w0.x = pg8::cvt_pk_bf16(st.o0[4 * gq] * inv, st.o0[4 * gq + 1] * inv); w0.y = pg8::cvt_pk_bf16(st.o0[4 * gq + 2] * inv, st.o0[4 * gq + 3] * inv);
        w1.x = pg8::cvt_pk_bf16(st.o1[4 * gq] * inv, st.o1[4 * gq + 1] * inv); w1.y = pg8::cvt_pk_bf16(st.o1[4 * gq + 2] * inv, st.o1[4 * gq + 3] * inv);
        *(u32x2*)(op + 8 * gq) = w0; *(u32x2*)(op + 32 + 8 * gq) = w1; }
}

__device__ __forceinline__ void attn_store8(const AttnSt& st, unsigned char* op  , float inv) {
#pragma unroll
    for (int gq = 0; gq < 4; ++gq) {
        *(unsigned*)(op + 8 * gq) = pk4_fp8(st.o0[4 * gq] * inv, st.o0[4 * gq + 1] * inv, st.o0[4 * gq + 2] * inv, st.o0[4 * gq + 3] * inv);
        *(unsigned*)(op + 32 + 8 * gq) = pk4_fp8(st.o1[4 * gq] * inv, st.o1[4 * gq + 1] * inv, st.o1[4 * gq + 2] * inv, st.o1[4 * gq + 3] * inv); }
}

__device__ __forceinline__ void dil_attn_phase2(Frame& F) {
    LAS float* bt = (LAS float*)F.lds;
    { const float* btA = (const float*)(F.ws + WS_BTABA); for (int i = F.tid; i < 48 * 192; i += 512) { const int gh = i / 192, dl = i % 192 - 32; bt[i] = (dl >= 0 && dl <= 128) ? btA[gh * 132 + dl] : NEGB; } }
    __syncthreads();
    constexpr int TBL = 48 * 192 * 4;
    const int lane = F.lane, q = lane & 31, h = lane >> 5, w = F.wave, uw = w >> 2, qt = w & 3, t = F.tid, tu = t >> 8, tt = t & 255, srow = tt >> 3, sch = tt & 7;
    const bf16* QK = (const bf16*)(F.ws + WS_SCR + S_QK); const bf16* VT = (const bf16*)(F.ws + WS_SCR + S_VT);
    bf16* OG = (bf16*)((unsigned char*)F.out + O_OG); float* LSE = (float*)((unsigned char*)F.out + O_LSE);
    for (int du = F.vcu; du < 3072; du += F.G) {
        const int g = du >> 10, rem = du & 1023, hh = rem >> 6, blp = (rem >> 4) & 3, rn = rem & 15, gh = g * 16 + hh;
        const int nblk = 16 >> (2 * g); const bool has_prev = (rn & (nblk - 1)) != 0;
        const int j0 = has_prev ? 0 : 2;
        const int n0s = (2 * blp + tu) * 2048 + rn * 128;
        const bf16* ksrc = QK + ((size_t)g * TC + n0s - 128 + srow) * 2048 + 1024 + hh * 64 + sch * 8;
        const bf16* vsrc = VT + ((size_t)g * 1024 + hh * 64 + srow) * TC + (n0s - 128) + sch * 8;
        const int sdst = srow * AKP + sch * 8;
        const int n0 = (2 * blp + uw) * 2048 + rn * 128;
        const bf16* qrow = QK + ((size_t)g * TC + n0 + 32 * qt + q) * 2048 + hh * 64;
        bf16x8 qf[4];
#pragma unroll
        for (int d0 = 0; d0 < 4; ++d0) qf[d0] = *(const bf16x8*)(qrow + d0 * 16 + 8 * h);
        AttnSt st; st.m = NEGB; st.l = 0.f; st.o0 = (f32x16){}; st.o1 = (f32x16){};
        u32x4 k0, k1, v0, v1;
        k0 = *(const u32x4*)(ksrc + (size_t)(64 * j0) * 2048); k1 = *(const u32x4*)(ksrc + (size_t)(64 * j0 + 32) * 2048);
        v0 = *(const u32x4*)(vsrc + 64 * j0); v1 = *(const u32x4*)(vsrc + (size_t)32 * TC + 64 * j0);
        { LAS bf16* kb = (LAS bf16*)(F.lds + TBL + (0 * 2 + tu) * 2 * ATILE); LAS bf16* vb = kb + 64 * AKP;
          *(LAS u32x4*)(kb + sdst) = k0; *(LAS u32x4*)(kb + 32 * AKP + sdst) = k1; *(LAS u32x4*)(vb + sdst) = v0; *(LAS u32x4*)(vb + 32 * AKP + sdst) = v1; }
        __syncthreads();
        int pb = 0;
        for (int j = j0; j < 4; ++j) {
            const bool more = j + 1 < 4;
            if (more) { k0 = *(const u32x4*)(ksrc + (size_t)(64 * (j + 1)) * 2048); k1 = *(const u32x4*)(ksrc + (size_t)(64 * (j + 1) + 32) * 2048);
                        v0 = *(const u32x4*)(vsrc + 64 * (j + 1)); v1 = *(const u32x4*)(vsrc + (size_t)32 * TC + 64 * (j + 1)); }
            const LAS bf16* kb = (const LAS bf16*)(F.lds + TBL + (pb * 2 + uw) * 2 * ATILE); const LAS bf16* vb = kb + 64 * AKP;
#pragma unroll
            for (int t2 = 0; t2 < 2; ++t2) { const int t32 = 2 * j + t2;
                if (t32 >= qt && t32 <= qt + 4) {
                    const LAS float* bl = bt + gh * 192 + 32 + (32 * qt + q + 128 - 32 * t32 - 8 * h - 23);
                    attn_tile<false>(kb + 32 * t2 * AKP, vb + 32 * t2, bl, qf, st, q, h, true); } }
            if (more) { LAS bf16* kn = (LAS bf16*)(F.lds + TBL + ((pb ^ 1) * 2 + tu) * 2 * ATILE); LAS bf16* vn = kn + 64 * AKP;
                *(LAS u32x4*)(kn + sdst) = k0; *(LAS u32x4*)(kn + 32 * AKP + sdst) = k1; *(LAS u32x4*)(vn + sdst) = v0; *(LAS u32x4*)(vn + 32 * AKP + sdst) = v1; }
            __syncthreads();
            pb ^= 1;
        }
        const float l_tot = st.l + __shfl_xor(st.l, 32), inv = 1.f / l_tot;
        const size_t orow = (size_t)g * TC + n0 + 32 * qt + q;
        attn_store(st, OG + orow * 1024 + hh * 64 + 4 * h, inv);
        if (h == 0) LSE[orow * 16 + hh] = st.m + __log2f(l_tot);
    }
}

__device__ __forceinline__ void moba_unit2(Frame& F, int b, int hh, int nb, LAS float* bt, int& cur_h) {
    constexpr int TBL = 8448;
    const int lane = F.lane, q = lane & 31, h = lane >> 5, w = F.wave, t = F.tid, srow = t >> 3, sch = t & 7;
    const bf16* QK = (const bf16*)(F.ws + WS_SCR + S_CQK); const bf16* VT = (const bf16*)(F.ws + WS_SCR + S_CVT);
    bf16* att = (bf16*)(F.ws + WS_SCR + S_CATT); const float* km = (const float*)(F.ws + WS_KMEAN);
    if (hh != cur_h) { __syncthreads(); const float* btC = (const float*)(F.ws + WS_BTABC) + hh * 2048; for (int i = t; i < 2048 + 32; i += 512) bt[i] = i < 32 ? NEGB : btC[i - 32]; cur_h = hh; __syncthreads(); }
    const size_t tq = (size_t)b * SEQ + nb * 256 + 32 * w + q;
    const bf16* qrow = QK + tq * 2048 + hh * 64;
    bf16x8 qf[4];
#pragma unroll
    for (int d0 = 0; d0 < 4; ++d0) qf[d0] = *(const bf16x8*)(qrow + d0 * 16 + 8 * h);
    unsigned sel = 0;
    if (nb > 0) {
        float gsc[7];
#pragma unroll
        for (int m = 0; m < 7; ++m) { float s = 0.f;
            if (m < nb) { const float* kmp = km + (((size_t)b * NH + hh) * 8 + m) * 64;
#pragma unroll
                for (int d0 = 0; d0 < 4; ++d0) { const f32x4 k0 = *(const f32x4*)(kmp + d0 * 16 + 8 * h), k1 = *(const f32x4*)(kmp + d0 * 16 + 8 * h + 4); const u32x4 qq = __builtin_bit_cast(u32x4, qf[d0]);
                    s += bflo(qq.x) * k0.x + bfhi(qq.x) * k0.y + bflo(qq.y) * k0.z + bfhi(qq.y) * k0.w + bflo(qq.z) * k1.x + bfhi(qq.z) * k1.y + bflo(qq.w) * k1.z + bfhi(qq.w) * k1.w; }
                s += __shfl_xor(s, 32); }
            gsc[m] = m < nb ? s : -3.0e38f; }
        const int nsel = nb < 3 ? nb : 3;
#pragma unroll
        for (int r = 0; r < 3; ++r) { if (r < nsel) { int bi = 0; float bv = -3.4e38f;
#pragma unroll
                for (int m = 0; m < 7; ++m) if (!((sel >> m) & 1u) && gsc[m] > bv) { bv = gsc[m]; bi = m; }
                sel |= 1u << bi; } }
    }
    AttnSt st; st.m = NEGB; st.l = 0.f; st.o0 = (f32x16){}; st.o1 = (f32x16){};
    const int qpos = nb * 256 + 32 * w + q, nsteps = 4 * nb + 4;
    const bf16* ksrc = QK + ((size_t)b * SEQ + srow) * 2048 + 1024 + hh * 64 + sch * 8;
    const bf16* vsrc = VT + ((size_t)hh * 64 + srow) * T + (size_t)b * SEQ + sch * 8;
    const int sdst = srow * AKP + sch * 8;
    u32x4 kreg = *(const u32x4*)ksrc, vreg = *(const u32x4*)vsrc;
    { LAS bf16* kb = (LAS bf16*)(F.lds + TBL); *(LAS u32x4*)(kb + sdst) = kreg; *(LAS u32x4*)(kb + 64 * AKP + sdst) = vreg; }
    __syncthreads();
    int pb = 0;
    for (int s = 0; s < nsteps; ++s) {
        const bool more = s + 1 < nsteps;
        if (more) { kreg = *(const u32x4*)(ksrc + (size_t)(64 * (s + 1)) * 2048); vreg = *(const u32x4*)(vsrc + 64 * (s + 1)); }
        const LAS bf16* kb = (const LAS bf16*)(F.lds + TBL + pb * 2 * ATILE); const LAS bf16* vb = kb + 64 * AKP;
        if (s < 4 * nb) {
            const bool mine = (sel >> (s >> 2)) & 1u;
            if (__ballot(mine) != 0ull) {
#pragma unroll
                for (int t2 = 0; t2 < 2; ++t2) { const LAS float* bl = bt + 32 + (qpos - 8 * h - (64 * s + 32 * t2) - 23);
                    attn_tile<true>(kb + 32 * t2 * AKP, vb + 32 * t2, bl, qf, st, q, h, mine); } }
        } else {
#pragma unroll
            for (int t2 = 0; t2 < 2; ++t2) { const int t32 = (s - 4 * nb) * 2 + t2;
                if (t32 <= w) { const LAS float* bl = bt + 32 + (qpos - 8 * h - (64 * s + 32 * t2) - 23);
                    attn_tile<false>(kb + 32 * t2 * AKP, vb + 32 * t2, bl, qf, st, q, h, true); } }
        }
        if (more) { LAS bf16* kn = (LAS bf16*)(F.lds + TBL + (pb ^ 1) * 2 * ATILE); *(LAS u32x4*)(kn + sdst) = kreg; *(LAS u32x4*)(kn + 64 * AKP + sdst) = vreg; }
        __syncthreads();
        pb ^= 1;
    }
    const float l_tot = st.l + __shfl_xor(st.l, 32), inv = 1.f / l_tot;
    attn_store(st, att + tq * 1024 + hh * 64 + 4 * h, inv);
}
__device__ __forceinline__ void moba_phase2(Frame& F) {
    LAS float* bt = (LAS float*)F.lds; int cur_h = -1;
    const int NP = NB * NH * 4, per = (NP + F.G - 1) / F.G;
    const int lo = F.vcu * per, hi = (lo + per) < NP ? (lo + per) : NP;
    for (int pu = lo; pu < hi; ++pu) { const int j = pu & 3, hh = (pu >> 2) & 15, b = pu >> 6;
        moba_unit2(F, b, hh, 7 - j, bt, cur_h); moba_unit2(F, b, hh, j, bt, cur_h); }
}


__device__ __forceinline__ float xhalf_max(float m) { auto rr = __builtin_amdgcn_permlane32_swap(__float_as_uint(m), __float_as_uint(m), false, false); return fmaxf(__uint_as_float(rr[0]), __uint_as_float(rr[1])); }
__device__ __forceinline__ float xhalf_sum(float m) { auto rr = __builtin_amdgcn_permlane32_swap(__float_as_uint(m), __float_as_uint(m), false, false); return __uint_as_float(rr[0]) + __uint_as_float(rr[1]); }
template <bool MASKED>
__device__ __forceinline__ void attn_tile2(const LAS bf16* Kt, const LAS bf16* Vt, const LAS float* bl0, const bf16x8 (&qf)[4], AttnSt& st, int q, int h, bool mine) {
    f32x16 s0, s1;
#pragma unroll
    for (int r = 0; r < 16; ++r) { s0[r] = bl0[23 - 16 * (r >> 3) - (r & 7)]; s1[r] = bl0[-32 + 23 - 16 * (r >> 3) - (r & 7)]; }
    const LAS bf16* kr = Kt + kperm(q) * AKP + 8 * h;
#pragma unroll
    for (int d0 = 0; d0 < 4; ++d0) { s0 = mfma32(*(const LAS bf16x8*)(kr + d0 * 16), qf[d0], s0); s1 = mfma32(*(const LAS bf16x8*)(kr + 32 * AKP + d0 * 16), qf[d0], s1); }
    const float mx = xhalf_max(fmaxf(max16(s0), max16(s1)));
    float mn = fmaxf(st.m, mx); if (MASKED) mn = mine ? mn : st.m;
    const float alpha = __builtin_amdgcn_exp2f(st.m - mn);
    float ps0 = 0.f, ps1 = 0.f;
#pragma unroll
    for (int r = 0; r < 16; ++r) { const float p = __builtin_amdgcn_exp2f(s0[r] - mn); s0[r] = p; ps0 += p; const float p2 = __builtin_amdgcn_exp2f(s1[r] - mn); s1[r] = p2; ps1 += p2; }
    bf16x8 p00 = pack8(s0, 0), p01 = pack8(s0, 8), p10 = pack8(s1, 0), p11 = pack8(s1, 8);
    float ps = ps0 + ps1;
    if (MASKED) { if (!mine) { p00 = (bf16x8){0, 0, 0, 0, 0, 0, 0, 0}; p01 = p00; p10 = p00; p11 = p00; ps = 0.f; } }
    st.l = st.l * alpha + ps; st.m = mn;
    if (__ballot(alpha != 1.0f) != 0ull) {
#pragma unroll
        for (int r = 0; r < 16; ++r) { st.o0[r] *= alpha; st.o1[r] *= alpha; } }
    const LAS bf16* v0 = Vt + q * AKP + 8 * h; const LAS bf16* v1 = v0 + 32 * AKP;
    st.o0 = mfma32(*(const LAS bf16x8*)v0, p00, st.o0); st.o1 = mfma32(*(const LAS bf16x8*)v1, p00, st.o1);
    st.o0 = mfma32(*(const LAS bf16x8*)(v0 + 16), p01, st.o0); st.o1 = mfma32(*(const LAS bf16x8*)(v1 + 16), p01, st.o1);
    st.o0 = mfma32(*(const LAS bf16x8*)(v0 + 32), p10, st.o0); st.o1 = mfma32(*(const LAS bf16x8*)(v1 + 32), p10, st.o1);
    st.o0 = mfma32(*(const LAS bf16x8*)(v0 + 48), p11, st.o0); st.o1 = mfma32(*(const LAS bf16x8*)(v1 + 48), p11, st.o1);
}

__device__ __forceinline__ void attn_tile2r(const LAS bf16* Kt, const LAS bf16* Vt, const LAS float* b0, const LAS float* b1, const bf16x8 (&qf)[4], AttnSt& st, int q, int h) {
    f32x16 s0, s1;
#pragma unroll
    for (int r = 0; r < 16; ++r) { s0[r] = b0[16 * (r >> 3) + (r & 7)]; s1[r] = b1[16 * (r >> 3) + (r & 7)]; }
    const LAS bf16* kr = Kt + kperm(q) * AKP + 8 * h;
#pragma unroll
    for (int d0 = 0; d0 < 4; ++d0) { s0 = mfma32(*(const LAS bf16x8*)(kr + d0 * 16), qf[d0], s0); s1 = mfma32(*(const LAS bf16x8*)(kr + 32 * AKP + d0 * 16), qf[d0], s1); }
    const float mx = xhalf_max(fmaxf(max16(s0), max16(s1)));
    const float mn = fmaxf(st.m, mx);
    const float alpha = __builtin_amdgcn_exp2f(st.m - mn);
    float ps0 = 0.f, ps1 = 0.f;
#pragma unroll
    for (int r = 0; r < 16; ++r) { const float p = __builtin_amdgcn_exp2f(s0[r] - mn); s0[r] = p; ps0 += p; const float p2 = __builtin_amdgcn_exp2f(s1[r] - mn); s1[r] = p2; ps1 += p2; }
    const bf16x8 p00 = pack8(s0, 0), p01 = pack8(s0, 8), p10 = pack8(s1, 0), p11 = pack8(s1, 8);
    st.l = st.l * alpha + (ps0 + ps1); st.m = mn;
    if (__ballot(alpha != 1.0f) != 0ull) {
#pragma unroll
        for (int r = 0; r < 16; ++r) { st.o0[r] *= alpha; st.o1[r] *= alpha; } }
    const LAS bf16* v0 = Vt + q * AKP + 8 * h; const LAS bf16* v1 = v0 + 32 * AKP;
    st.o0 = mfma32(*(const LAS bf16x8*)v0, p00, st.o0); st.o1 = mfma32(*(const LAS bf16x8*)v1, p00, st.o1);
    st.o0 = mfma32(*(const LAS bf16x8*)(v0 + 16), p01, st.o0); st.o1 = mfma32(*(const LAS bf16x8*)(v1 + 16), p01, st.o1);
    st.o0 = mfma32(*(const LAS bf16x8*)(v0 + 32), p10, st.o0); st.o1 = mfma32(*(const LAS bf16x8*)(v1 + 32), p10, st.o1);
    st.o0 = mfma32(*(const LAS bf16x8*)(v0 + 48), p11, st.o0); st.o1 = mfma32(*(const LAS bf16x8*)(v1 + 48), p11, st.o1);
}

__device__ __forceinline__ u32x4 f8x8_bf16(u32x2 v) {
    const f32x2 a = __builtin_amdgcn_cvt_pk_f32_fp8((int)v.x, false), b = __builtin_amdgcn_cvt_pk_f32_fp8((int)v.x, true), c = __builtin_amdgcn_cvt_pk_f32_fp8((int)v.y, false), d = __builtin_amdgcn_cvt_pk_f32_fp8((int)v.y, true);
    u32x4 r; r.x = pg8::cvt_pk_bf16(a.x, a.y); r.y = pg8::cvt_pk_bf16(b.x, b.y); r.z = pg8::cvt_pk_bf16(c.x, c.y); r.w = pg8::cvt_pk_bf16(d.x, d.y); return r;
}
__device__ __forceinline__ void dil_attn_phase3(Frame& F) {
    LAS float* bt = (LAS float*)F.lds;
    { const float* btA = (const float*)(F.ws + WS_BTABA); for (int i = F.tid; i < 48 * 192; i += 512) { const int gh = i / 192, dl = 159 - i % 192; bt[i] = (dl >= 0 && dl <= 128) ? btA[gh * 132 + dl] : NEGB; } }
    constexpr int TBL = 48 * 192 * 4;
    const int lane = F.lane, q = lane & 31, h = lane >> 5, w = F.wave, uw = w >> 2, qt = w & 3, t = F.tid, tu = t >> 8, tt = t & 255, srow = tt >> 3, sch = tt & 7;
    const unsigned char* QK = F.ws + WS_SCR + S_QK; const unsigned char* VT = F.ws + WS_SCR + S_VT;
    bf16* OG = (bf16*)((unsigned char*)F.out + O_OG); float* LSE = (float*)((unsigned char*)F.out + O_LSE);
    const int sdst = srow * AKP + sch * 8;
    int du = F.vcu;
    if (du >= 3072) { __syncthreads(); return; }
    int g = du >> 10, hh = (du >> 6) & 15, blp = (du >> 4) & 3, rn = du & 15;
    int j = ((rn & ((16 >> (2 * g)) - 1)) != 0) ? 0 : 2;
    u32x2 k0, k1, v0, v1; u32x2 qn[4]; bf16x8 qf[4];
#define DIL_LOADS(G_, HH_, BLP_, RN_, J_) do { const int n0s_ = (2 * (BLP_) + tu) * 2048 + (RN_) * 128 - 128 + 64 * (J_); \
        const unsigned char* ks_ = QK + ((size_t)(G_) * TC + n0s_ + srow) * 2048 + 1024 + (HH_) * 64 + sch * 8; \
        const unsigned char* vs_ = VT + ((size_t)(G_) * 1024 + (HH_) * 64 + srow) * TC + n0s_ + sch * 8; \
        k0 = *(const u32x2*)ks_; k1 = *(const u32x2*)(ks_ + (size_t)32 * 2048); v0 = *(const u32x2*)vs_; v1 = *(const u32x2*)(vs_ + (size_t)32 * TC); } while (0)
#define DIL_QLOADS(G_, HH_, BLP_, RN_) do { const unsigned char* qr_ = QK + ((size_t)(G_) * TC + (2 * (BLP_) + uw) * 2048 + (RN_) * 128 + 32 * qt + q) * 2048 + (HH_) * 64; \
        _Pragma("unroll") for (int d0 = 0; d0 < 4; ++d0) qn[d0] = *(const u32x2*)(qr_ + d0 * 16 + 8 * h); } while (0)
#define DIL_WRITE(PB_) do { LAS bf16* kb_ = (LAS bf16*)(F.lds + TBL + ((PB_) * 2 + tu) * 2 * ATILE); LAS bf16* vb_ = kb_ + 64 * AKP; \
        *(LAS u32x4*)(kb_ + sdst) = f8x8_bf16(k0); *(LAS u32x4*)(kb_ + 32 * AKP + sdst) = f8x8_bf16(k1); *(LAS u32x4*)(vb_ + sdst) = f8x8_bf16(v0); *(LAS u32x4*)(vb_ + 32 * AKP + sdst) = f8x8_bf16(v1); } while (0)
    DIL_LOADS(g, hh, blp, rn, j); DIL_QLOADS(g, hh, blp, rn);
    DIL_WRITE(0);
#pragma unroll
    for (int d0 = 0; d0 < 4; ++d0) qf[d0] = __builtin_bit_cast(bf16x8, f8x8_bf16(qn[d0]));
    __syncthreads();
    AttnSt st; st.m = NEGB; st.l = 0.f; st.o0 = (f32x16){}; st.o1 = (f32x16){};
    int pb = 0;
    for (;;) {
        const bool last = (j == 3);
        int ng = g, nhh = hh, nblp = blp, nrn = rn, nj = j + 1; bool more = true;
        if (last) { const int nd = du + F.G; more = nd < 3072; ng = nd >> 10; nhh = (nd >> 6) & 15; nblp = (nd >> 4) & 3; nrn = nd & 15; nj = ((nrn & ((16 >> (2 * ng)) - 1)) != 0) ? 0 : 2; }
        if (more) { DIL_LOADS(ng, nhh, nblp, nrn, nj); if (last) DIL_QLOADS(ng, nhh, nblp, nrn); }
        { const LAS bf16* kb = (const LAS bf16*)(F.lds + TBL + (pb * 2 + uw) * 2 * ATILE); const LAS bf16* vb = kb + 64 * AKP;
          const int gh = g * 16 + hh, ta = 2 * j, tb = 2 * j + 1;
          const bool a_on = ta >= qt && ta <= qt + 4, b_on = tb >= qt && tb <= qt + 4;
          const LAS float* row = bt + gh * 192;
          const LAS float* ba = row + (168 - (32 + (32 * qt + q + 128 - 32 * ta - 8 * h - 23)));
          if (a_on || b_on) attn_tile2r(kb, vb, a_on ? ba : row + 160, b_on ? ba + 32 : row + 160, qf, st, q, h); }
        if (more) DIL_WRITE(pb ^ 1);
        if (last) {
            const float l_tot = xhalf_sum(st.l), inv = 1.f / l_tot;
            const size_t orow = (size_t)g * TC + (2 * blp + uw) * 2048 + rn * 128 + 32 * qt + q;
            attn_store8(st, (unsigned char*)OG + orow * 1024 + hh * 64 + 4 * h, inv * ASCALE8);
            if (h == 0) LSE[orow * 16 + hh] = st.m + __log2f(l_tot);
            st.m = NEGB; st.l = 0.f; st.o0 = (f32x16){}; st.o1 = (f32x16){};
#pragma unroll
            for (int d0 = 0; d0 < 4; ++d0) qf[d0] = __builtin_bit_cast(bf16x8, f8x8_bf16(qn[d0]));
        }
        __syncthreads();
        pb ^= 1;
        if (!more) break;
        if (last) du += F.G;
        g = ng; hh = nhh; blp = nblp; rn = nrn; j = nj;
    }
#undef DIL_LOADS
#undef DIL_QLOADS
#undef DIL_WRITE
}

__device__ __forceinline__ void moba_phase3(Frame& F) {
    constexpr int TBL = 8448, KMO = TBL + 4 * ATILE;
    LAS float* bt = (LAS float*)F.lds; LAS float* kml = (LAS float*)(F.lds + KMO);
    const int lane = F.lane, q = lane & 31, h = lane >> 5, w = F.wave, t = F.tid, srow = t >> 3, sch = t & 7;
    const bf16* QK = (const bf16*)(F.ws + WS_SCR + S_CQK); const bf16* VT = (const bf16*)(F.ws + WS_SCR + S_CVT);
    bf16* att = (bf16*)(F.ws + WS_SCR + S_CATT); const float* km = (const float*)(F.ws + WS_KMEAN);
    const int NP = NB * NH * 4, per = (NP + F.G - 1) / F.G;
    const int lo = F.vcu * per, hi = (lo + per) < NP ? (lo + per) : NP;
    const int nunits = 2 * (hi - lo);
    if (nunits <= 0) return;
    const int sdst = srow * AKP + sch * 8;
    int u = 0, cur_bh = -1;
    u32x4 kreg, vreg; bf16x8 qn[4], qf[4];
#define MB_LOADS(B_, HH_, S_) do { const bf16* ks_ = QK + ((size_t)(B_) * SEQ + 64 * (S_) + srow) * 2048 + 1024 + (HH_) * 64 + sch * 8; \
        const bf16* vs_ = VT + ((size_t)(HH_) * 64 + srow) * T + (size_t)(B_) * SEQ + 64 * (S_) + sch * 8; kreg = *(const u32x4*)ks_; vreg = *(const u32x4*)vs_; } while (0)
#define MB_QLOADS(B_, HH_, NB_) do { const bf16* qr_ = QK + ((size_t)(B_) * SEQ + (NB_) * 256 + 32 * w + q) * 2048 + (HH_) * 64; \
        _Pragma("unroll") for (int d0 = 0; d0 < 4; ++d0) qn[d0] = *(const bf16x8*)(qr_ + d0 * 16 + 8 * h); } while (0)
#define MB_WRITE(PB_) do { LAS bf16* kb_ = (LAS bf16*)(F.lds + TBL + (PB_) * 2 * ATILE); *(LAS u32x4*)(kb_ + sdst) = kreg; *(LAS u32x4*)(kb_ + 64 * AKP + sdst) = vreg; } while (0)
    int pu = lo, jj = pu & 3, hh = (pu >> 2) & 15, b = pu >> 6, nb = 7 - jj, s = 0, pb = 0;
    MB_LOADS(b, hh, 0); MB_QLOADS(b, hh, nb); MB_WRITE(0);
    unsigned sel = 0; bool fresh = true;
    AttnSt st; st.m = NEGB; st.l = 0.f; st.o0 = (f32x16){}; st.o1 = (f32x16){};
    for (;;) {
        if (fresh) {
            if (b * 16 + hh != cur_bh) { __syncthreads(); const float* btC = (const float*)(F.ws + WS_BTABC) + hh * 2048;
                for (int i = t; i < 2048 + 32; i += 512) bt[2079 - i] = i < 32 ? NEGB : btC[i - 32];
                { const float* kmp = km + ((size_t)b * NH + hh) * 512; kml[t] = kmp[t]; }
                cur_bh = b * 16 + hh; }
#pragma unroll
            for (int d0 = 0; d0 < 4; ++d0) qf[d0] = qn[d0];
            __syncthreads();
            sel = 0;
            if (nb > 0) {
                float gsc[7];
#pragma unroll
                for (int m = 0; m < 7; ++m) { float sc = 0.f;
                    if (m < nb) {
#pragma unroll
                        for (int d0 = 0; d0 < 4; ++d0) { const f32x4 c0 = *(const LAS f32x4*)(kml + m * 64 + d0 * 16 + 8 * h), c1 = *(const LAS f32x4*)(kml + m * 64 + d0 * 16 + 8 * h + 4); const u32x4 qq = __builtin_bit_cast(u32x4, qf[d0]);
                            sc += bflo(qq.x) * c0.x + bfhi(qq.x) * c0.y + bflo(qq.y) * c0.z + bfhi(qq.y) * c0.w + bflo(qq.z) * c1.x + bfhi(qq.z) * c1.y + bflo(qq.w) * c1.z + bfhi(qq.w) * c1.w; }
                        sc = xhalf_sum(sc); }
                    gsc[m] = m < nb ? sc : -3.0e38f; }
                const int nsel = nb < 3 ? nb : 3;
#pragma unroll
                for (int r = 0; r < 3; ++r) { if (r < nsel) { int bi = 0; float bv = -3.4e38f;
#pragma unroll
                        for (int m = 0; m < 7; ++m) if (!((sel >> m) & 1u) && gsc[m] > bv) { bv = gsc[m]; bi = m; }
                        sel |= 1u << bi; } }
            }
            fresh = false;
        }
        const int nsteps = 4 * nb + 4;
        const bool last = (s + 1 == nsteps);
        int nb2 = nb, b2 = b, hh2 = hh, s2 = s + 1; bool more = true;
        if (last) { const int u2 = u + 1; more = u2 < nunits; const int pu2 = lo + (u2 >> 1), j2 = pu2 & 3; hh2 = (pu2 >> 2) & 15; b2 = pu2 >> 6; nb2 = (u2 & 1) ? j2 : 7 - j2; s2 = 0; }
        if (more) { MB_LOADS(b2, hh2, s2); if (last) MB_QLOADS(b2, hh2, nb2); }
        { const LAS bf16* kb = (const LAS bf16*)(F.lds + TBL + pb * 2 * ATILE); const LAS bf16* vb = kb + 64 * AKP;
          const int qpos = nb * 256 + 32 * w + q;
          const LAS float* ba = bt + (2056 - (32 + (qpos - 8 * h - 64 * s - 23)));
          const LAS float* negp = bt + 2048;
          bool act; const LAS float* p0; const LAS float* p1;
          if (s < 4 * nb) { const bool mine = (sel >> (s >> 2)) & 1u; act = __ballot(mine) != 0ull; p0 = mine ? ba : negp; p1 = mine ? ba + 32 : negp; }
          else { const int ta = (s - 4 * nb) * 2; act = ta <= w; p0 = ba; p1 = (ta + 1 <= w) ? ba + 32 : negp; }
          if (act) attn_tile2r(kb, vb, p0, p1, qf, st, q, h); }
        if (more) MB_WRITE(pb ^ 1);
        if (last) {
            const float l_tot = xhalf_sum(st.l), inv = 1.f / l_tot;
            const size_t tq = (size_t)b * SEQ + nb * 256 + 32 * w + q;
            attn_store8(st, (unsigned char*)att + tq * 1024 + hh * 64 + 4 * h, inv * ASCALE8);
            st.m = NEGB; st.l = 0.f; st.o0 = (f32x16){}; st.o1 = (f32x16){};
        }
        if (!last) __syncthreads();
        pb ^= 1;
        if (!more) break;
        if (last) { ++u; fresh = true; }
        nb = nb2; b = b2; hh = hh2; s = s2;
    }
#undef MB_LOADS
#undef MB_QLOADS
#undef MB_WRITE
}

__device__ __forceinline__ void gmlp_phase(Frame& F, const float* lng, const float* lnb, const float* bs) {
    const int lane = F.lane, w = F.wave, q = lane & 31, h = lane >> 5;
    const bf16* uv = (const bf16*)(F.ws + WS_SCR + S_UV); bf16* p = (bf16*)(F.ws + WS_SCR + S_P); const bf16* wst = (const bf16*)(F.ws + WS_WST);
    LAS float* stat = (LAS float*)F.lds;
    LAS bf16* vnT = (LAS bf16*)(F.lds + 1024);
    constexpr int VP = 136;
    for (int unit = F.vcu; unit < T / 128; unit += F.G) {
        const size_t t0 = (size_t)unit * 128;
        __syncthreads();
        for (int i = 0; i < 16; ++i) { const int r = w * 16 + i; const u32x4* vr = (const u32x4*)(uv + (t0 + r) * 2048 + 1024) + lane;
            const u32x4 a = vr[0], b = vr[64]; float x[16];
            x[0] = bflo(a.x); x[1] = bfhi(a.x); x[2] = bflo(a.y); x[3] = bfhi(a.y); x[4] = bflo(a.z); x[5] = bfhi(a.z); x[6] = bflo(a.w); x[7] = bfhi(a.w);
            x[8] = bflo(b.x); x[9] = bfhi(b.x); x[10] = bflo(b.y); x[11] = bfhi(b.y); x[12] = bflo(b.z); x[13] = bfhi(b.z); x[14] = bflo(b.w); x[15] = bfhi(b.w);
            float s = 0.f;
#pragma unroll
            for (int j = 0; j < 16; ++j) s += x[j];
            const float mean = wave_sum(s) * (1.f / 1024.f); float s2 = 0.f;
#pragma unroll
            for (int j = 0; j < 16; ++j) { const float d = x[j] - mean; s2 += d * d; }
            const float rstd = 1.f / sqrtf(wave_sum(s2) * (1.f / 1024.f) + LN_EPS);
            if (lane == 0) { stat[2 * r] = mean; stat[2 * r + 1] = rstd; } }
        __syncthreads();
        for (int gg = 0; gg < 8; ++gg) {
#pragma unroll
            for (int k = 0; k < 4; ++k) { const int id = F.tid + 512 * k, s = id >> 4, cc = (id & 15) * 8;
                const u32x4 a = *(const u32x4*)(uv + (t0 + s) * 2048 + 1024 + gg * 128 + cc); const float mean = stat[2 * s], rstd = stat[2 * s + 1];
                float x[8]; x[0] = bflo(a.x); x[1] = bfhi(a.x); x[2] = bflo(a.y); x[3] = bfhi(a.y); x[4] = bflo(a.z); x[5] = bfhi(a.z); x[6] = bflo(a.w); x[7] = bfhi(a.w);
#pragma unroll
                for (int j = 0; j < 8; ++j) { const int c = gg * 128 + cc + j; const float y = (x[j] - mean) * rstd * lng[c] + lnb[c]; vnT[(cc + j) * VP + s] = (bf16)f2bf(y); } }
            __syncthreads();
            const int cr = 32 * (w & 3), tc0 = 64 * (w >> 2);
            f32x16 acc0 = {}, acc1 = {};
#pragma unroll
            for (int ks = 0; ks < 8; ++ks) {
                const bf16x8 af = *(const LAS bf16x8*)(vnT + (cr + q) * VP + ks * 16 + 8 * h);
                const bf16x8 b0 = *(const bf16x8*)(wst + ((size_t)gg * 128 + tc0 + q) * 128 + ks * 16 + 8 * h);
                const bf16x8 b1 = *(const bf16x8*)(wst + ((size_t)gg * 128 + tc0 + 32 + q) * 128 + ks * 16 + 8 * h);
                acc0 = mfma32(af, b0, acc0); acc1 = mfma32(af, b1, acc1);
            }
#pragma unroll
            for (int tt = 0; tt < 2; ++tt) { const f32x16& ac = tt == 0 ? acc0 : acc1; const int tl = tc0 + 32 * tt + q; const float bsv = bs[gg * 128 + tl];
                const size_t rowu = (t0 + tl) * 2048, rowp = (t0 + tl) * 1024;
#pragma unroll
                for (int gq = 0; gq < 4; ++gq) { const int c = gg * 128 + cr + 8 * gq + 4 * h; const u32x2 uu = *(const u32x2*)(uv + rowu + c);
                    u32x2 o; o.x = pk2(bflo(uu.x) * (ac[4 * gq] + bsv), bfhi(uu.x) * (ac[4 * gq + 1] + bsv)); o.y = pk2(bflo(uu.y) * (ac[4 * gq + 2] + bsv), bfhi(uu.y) * (ac[4 * gq + 3] + bsv));
                    *(u32x2*)(p + rowp + c) = o; } }
            __syncthreads();
        }
    }
}

struct MoeSeg { int ts[9]; };
__device__ __forceinline__ MoeSeg moe_seg(Frame& F, int moe_l) {
    MoeSeg s; int acc = 0;
#pragma unroll
    for (int e = 0; e < 8; ++e) { s.ts[e] = acc; const unsigned c = __hip_atomic_load((unsigned*)(F.ctl + CW_ECNT + 64 * moe_l + e), RLX_AGENT); acc += (int)((c + 255u) >> 8); }
    s.ts[8] = acc; return s;
}
__device__ __forceinline__ void moe_gather_phase(Frame& F, int moe_l) {
    LAS int* P = (LAS int*)F.lds;
    LAS int* wtot = (LAS int*)(F.lds + 65536);
    LAS int* tot = wtot + 64;
    const int* wcnt = (const int*)(F.ws + WS_WCNT);
    int t = F.tid; asm volatile("" : "+v"(t));
    const int lane = F.lane;
    int loc[4][8], sum[8], inc[8];
#pragma unroll
    for (int k = 0; k < 4; ++k) { const u32x4 a = *(const u32x4*)(wcnt + (4 * t + k) * 8), b = *(const u32x4*)(wcnt + (4 * t + k) * 8 + 4);
        loc[k][0] = (int)a.x; loc[k][1] = (int)a.y; loc[k][2] = (int)a.z; loc[k][3] = (int)a.w; loc[k][4] = (int)b.x; loc[k][5] = (int)b.y; loc[k][6] = (int)b.z; loc[k][7] = (int)b.w; }
#pragma unroll
    for (int e = 0; e < 8; ++e) { sum[e] = (loc[0][e] + loc[1][e]) + (loc[2][e] + loc[3][e]); inc[e] = sum[e]; }
#pragma unroll
    for (int off = 1; off < 64; off <<= 1) {
#pragma unroll
        for (int e = 0; e < 8; ++e) { const int v = __shfl_up(inc[e], off); if (lane >= off) inc[e] += v; } }
    if (lane == 63) {
#pragma unroll
        for (int e = 0; e < 8; ++e) wtot[F.wave * 8 + e] = inc[e]; }
    __syncthreads();
    int run[8];
#pragma unroll
    for (int e = 0; e < 8; ++e) { int wb = 0; for (int w = 0; w < F.wave; ++w) wb += wtot[w * 8 + e]; run[e] = wb + inc[e] - sum[e]; }
#pragma unroll
    for (int k = 0; k < 4; ++k) {
#pragma unroll
        for (int e = 0; e < 8; ++e) { P[(4 * t + k) * 8 + e] = run[e]; run[e] += loc[k][e]; } }
    if (t == 511) {
#pragma unroll
        for (int e = 0; e < 8; ++e) tot[e] = run[e]; }
    __syncthreads();
    MoeSeg sg; { int acc = 0;
#pragma unroll
        for (int e = 0; e < 8; ++e) { sg.ts[e] = acc; acc += (tot[e] + 255) >> 8; } sg.ts[8] = acc; }
    if (blockIdx.x == 0 && t < 8) __hip_atomic_store((unsigned*)(F.ctl + CW_ECNT + 64 * moe_l + t), (unsigned)tot[t], RLX_AGENT);
    const int gw = F.vcu * NWAVES + F.wave, NGW = F.G * NWAVES;
    const bf16* hb = (const bf16*)(F.ws + WS_HB); unsigned char* xg8 = (unsigned char*)F.out;
    const int* route = (const int*)(F.ws + WS_ROUTE); int* slots = (int*)(F.ws + WS_SLOTS);
    for (int m0 = 4 * gw; m0 < T; m0 += 4 * NGW) {
        int s1[4], s2[4]; u32x4 a[4], b[4];
#pragma unroll
        for (int k = 0; k < 4; ++k) { const int m = m0 + k, grp = m >> 5;
            const int e1 = route[4 * m], p1 = route[4 * m + 1], e2 = route[4 * m + 2], p2 = route[4 * m + 3];
            int ts1 = 0, ts2 = 0;
#pragma unroll
            for (int e = 0; e < 8; ++e) { ts1 = e == e1 ? sg.ts[e] : ts1; ts2 = e == e2 ? sg.ts[e] : ts2; }
            s1[k] = ts1 * 256 + P[grp * 8 + e1] + p1; s2[k] = ts2 * 256 + P[grp * 8 + e2] + p2;
            const u32x4* src = (const u32x4*)(hb + (size_t)m * D) + lane; a[k] = src[0]; b[k] = src[64]; }
#pragma unroll
        for (int k = 0; k < 4; ++k) { const int m = m0 + k;
            float x[16]; unpack8(a[k], x); unpack8(b[k], x + 8);
            u32x2 lo, hi; lo.x = pk4_fp8(x[0], x[1], x[2], x[3]); lo.y = pk4_fp8(x[4], x[5], x[6], x[7]); hi.x = pk4_fp8(x[8], x[9], x[10], x[11]); hi.y = pk4_fp8(x[12], x[13], x[14], x[15]);
            unsigned char* d1 = xg8 + (size_t)s1[k] * D + 8 * lane; unsigned char* d2 = xg8 + (size_t)s2[k] * D + 8 * lane;
            *(u32x2*)d1 = lo; *(u32x2*)(d1 + 512) = hi; *(u32x2*)d2 = lo; *(u32x2*)(d2 + 512) = hi;
            if (lane == 0) { slots[2 * m] = s1[k]; slots[2 * m + 1] = s2[k]; } }
    }
}
struct MoeOrder {
    int nM, nN, G, c, tile0; MoeSeg sg; const char* A0; const char* B0; size_t aT, bE, bT; bool a_local;
    bool out_local;
    __device__ __forceinline__ bool next(int i, pg8::Unit& u) const {
        int pm, pn; if (!pg8::tile_of((long)i * G + c, nM, nN, pm, pn)) return false;
        const int tile = tile0 + pm; int e = 0;
#pragma unroll
        for (int k = 1; k < 8; ++k) e += (tile >= sg.ts[k]) ? 1 : 0;
        u.pm = out_local ? pm : tile; u.pn = pn; u.a = (unsigned)((size_t)(a_local ? pm : tile) * aT); u.b = (unsigned)((size_t)e * bE + (size_t)pn * bT); return true;
    }
};


template <int GI> struct L0QKOrder { int G, c; const char* A0; const char* B0;
    __device__ __forceinline__ bool next(int i, pg8::Unit& u) const { if (!pg8::tile_of((long)i * G + c, 64, 8, u.pm, u.pn)) return false; const int pm = u.pm;
        const int tok = GI == 0 ? pm * 256 : (GI == 1 ? (pm >> 3) * 2048 + (pm & 1) * 1024 + ((pm >> 1) & 3) : (pm >> 3) * 2048 + (pm & 7) * 2);
        u.a = (unsigned)tok * 1024u; u.b = (unsigned)u.pn * 256u * 1024u; return true; } };
template <int GI> struct L0VtOrder { int G, c; const char* A0; const char* B0;
    __device__ __forceinline__ bool next(int i, pg8::Unit& u) const { if (!pg8::tile_of((long)i * G + c, 4, 64, u.pm, u.pn)) return false; const int pn = u.pn;
        const int tok = GI == 0 ? pn * 256 : (GI == 1 ? (pn >> 3) * 2048 + (pn & 1) * 1024 + ((pn >> 1) & 3) : (pn >> 3) * 2048 + (pn & 7) * 2);
        u.a = (unsigned)u.pm * 256u * 1024u; u.b = (unsigned)tok * 1024u; return true; } };
template <int GI> __device__ __forceinline__ void l0_gemms(Frame& F, int ck, int bx) {
    constexpr int rs = GI == 0 ? 1 : (GI == 1 ? 4 : 16);
    constexpr size_t hst = (GI == 0 ? (size_t)128 : (GI == 1 ? (size_t)512 : (size_t)1)) * 1024;
    const char* hbc = (const char*)(F.ws + WS_SCR + S_HB8) + (size_t)ck * TC * 1024;
    unsigned char* scr = F.ws + WS_SCR;
    { L0QKOrder<GI> S{F.G, bx, hbc, (const char*)(F.ws + W_A_QK) + (size_t)GI * 2048 * 1024};
      pg8::Gemm gm{512, rs, 1, hst, (size_t)128 * 1024};
      pg8::EpiF8 E{scr + S_QK + (size_t)GI * TC * 2048, 2048, 1.f / WSCALE8};
      pg8::gemm_phase<pg8::EpiF8, L0QKOrder<GI>, false, 1>(F.lds, F.wave, gm, S, E); }
    { L0VtOrder<GI> S{F.G, bx, (const char*)(F.ws + W_A_V) + (size_t)GI * 1024 * 1024, hbc};
      pg8::Gemm gm{512, 1, rs, (size_t)128 * 1024, hst};
      pg8::EpiF8 E{scr + S_VT + (size_t)GI * 1024 * TC, TC, 1.f / WSCALE8};
      pg8::gemm_phase<pg8::EpiF8, L0VtOrder<GI>, false, 1>(F.lds, F.wave, gm, S, E); }
}


#ifdef MK_SELFCHECK
__device__ __forceinline__ void selfcheck_buf(Frame& F, const void* ptr, size_t nbytes, int stage, int slot0) {
    if (!F.chk) return;
    const int gw = F.vcu * NWAVES + F.wave, NGW = F.G * NWAVES; unsigned* cks = (unsigned*)(F.ws + WS_NEED + 2 * MiB) + slot0;
    const int nch = (int)(nbytes >> 12);
    for (int c = gw; c < nch; c += NGW) { const u32x4* r = (const u32x4*)((const char*)ptr + ((size_t)c << 12)) + F.lane; unsigned x = 0;
#pragma unroll
        for (int j = 0; j < 4; ++j) { const u32x4 v = r[64 * j]; x ^= v.x * 3u + v.y * 5u + v.z * 7u + v.w * 11u + (unsigned)j; }
        x *= (unsigned)(2 * F.lane + 1);
#pragma unroll
        for (int o = 1; o < 64; o <<= 1) x ^= __shfl_xor(x, o);
        if (F.lane == 0) { if (F.chk == 1) cks[c] = x; else if (cks[c] != x) atomicMax((unsigned*)(F.ctl + 32), (unsigned)(1000 - stage)); } }
}
#endif

__global__ void __launch_bounds__(NWAVES * 64, 2) mk_fwd(Args args) {
    extern __shared__ __attribute__((aligned(16))) unsigned char lds[];
    Frame F;
    F.lds = (LAS unsigned char*)lds;
    F.tid = threadIdx.x; F.lane = F.tid & 63; F.wave = __builtin_amdgcn_readfirstlane(F.tid >> 6);
    F.G = gridDim.x; { const int bx = blockIdx.x; F.vcu = (F.G % 8 == 0) ? (bx % 8) * (F.G / 8) + bx / 8 : bx; }
    F.ws = args.ws; F.ctl = (gu32*)(args.ws + WS_CTL); F.out = args.out; F.chk = args.chk; F.stage = 0;
    volatile LAS unsigned* MISC = (volatile LAS unsigned*)(F.lds + MISC_OFF);
    for (int u = F.tid; u < (LDS_BYTES - RING_BYTES) / 4; u += NWAVES * 64) ((LAS unsigned*)(F.lds + RING_BYTES))[u] = 0u;
    __syncthreads();
    XcdBarrier bar; bar.bar = (unsigned*)(F.ctl + CW_BAR); bar.x = 0; bar.st = nullptr;
    if (!MK_MULTI) bar = xcd_barrier_post((unsigned*)(F.ctl + CW_BAR), MISC + 8);
    const int lo = args.ph_lo, hi = args.ph_hi;
    int ph = 0;
#define PHASE_BEGIN if (ph >= lo && ph < hi) { F.lane = (int)__builtin_amdgcn_mbcnt_hi(~0u, __builtin_amdgcn_mbcnt_lo(~0u, 0u)); asm volatile("" : "+v"(F.lane)); F.tid = F.wave * 64 + F.lane;
#define PHASE_END   if (!MK_MULTI && ph + 1 < hi) xcd_barrier(bar, F.tid); } ++ph;
    const int bx = (int)blockIdx.x;
#define scr (args.ws + WS_SCR)
#define hb ((const bf16*)(args.ws + WS_HB))
#define ln_g (args.in[2])
#define ln_b (args.in[3])

    PHASE_BEGIN p_prologue(F, args); if (MK_PROBE & 8) p_prologue(F, args); PHASE_END

    if (MK_ENABLE & 1) {
#define L0_CHUNK(ck) \
        PHASE_BEGIN \
        if ((ck) > 0) dil_merge_phase(F, (ck) - 1); \
        l0_gemms<0>(F, (ck), bx); l0_gemms<1>(F, (ck), bx); l0_gemms<2>(F, (ck), bx); \
        PHASE_END \
        PHASE_BEGIN dil_attn_phase3(F); if (MK_PROBE & 1) dil_attn_phase3(F); PHASE_END
        L0_CHUNK(0) L0_CHUNK(1) L0_CHUNK(2) L0_CHUNK(3)
#undef L0_CHUNK
        PHASE_BEGIN dil_merge_phase(F, 3); if (MK_PROBE & 4) { dil_merge_phase(F, 3); dil_merge_phase(F, 3); dil_merge_phase(F, 3); dil_merge_phase(F, 3); } PHASE_END
        PHASE_BEGIN
        { pg8::LinOrder S{T / 256, 4, F.G, bx, (const char*)(scr + S_ATT), (const char*)(F.ws + W_A_O), (size_t)256 * 1024, (size_t)256 * 1024};
          pg8::Gemm gm{512, 1, 1, (size_t)128 * 1024, (size_t)128 * 1024};
          pg8::EpiResLn<FFN_GU8 == 0> E{(bf16*)(F.ws + WS_HB), ln_g + 0 * 2048, ln_b + 0 * 2048, ALPHA, 1.f / (WSCALE8 * ASCALE8), (float*)scr, (unsigned*)(F.ctl + CW_LNC + 0 * 4096), (unsigned*)(F.ctl + CW_BAR) + XB_TMO, scr + S_HB8, F.lds + LNT_OFF};
          pg8::gemm_phase<pg8::EpiResLn<FFN_GU8 == 0>, pg8::LinOrder, true, 1>(F.lds, F.wave, gm, S, E); }
        PHASE_END
    } else {
        PHASE_BEGIN ln_phase<1, false, false>(F, ln_g + 0 * 2048, ln_b + 0 * 2048, nullptr); PHASE_END
    }
#define DENSE_FFN(f, lnidx, enbit) \
    if (MK_ENABLE & (enbit)) { \
        PHASE_BEGIN \
        if ((f) == FFN_GU8) { \
          pg8::LinOrder S{T / 256, 2 * DFF / 256, F.G, bx, (const char*)(scr + S_HB8), (const char*)(F.ws + W_F_GU) + (size_t)(f) * 2 * DFF * 2048, (size_t)256 * 1024, (size_t)256 * 1024}; \
          pg8::Gemm gm{512, 1, 1, (size_t)128 * 1024, (size_t)128 * 1024};     \
          pg8::EpiSwiglu8 E{(unsigned char*)(scr + S_HID), DFF, 1.f / WSCALE8}; \
          pg8::gemm_phase<pg8::EpiSwiglu8, pg8::LinOrder, true, 1>(F.lds, F.wave, gm, S, E); \
        } else { pg8::LinOrder S{T / 256, 2 * DFF / 256, F.G, bx, (const char*)hb, (const char*)(F.ws + W_F_GU) + (size_t)(f) * 2 * DFF * 2048, (size_t)256 * 2048, (size_t)256 * 2048}; \
          pg8::Gemm gm{1024, 1, 1, (size_t)128 * 2048, (size_t)128 * 2048}; \
          pg8::EpiSwiglu8 E{(unsigned char*)(scr + S_HID), DFF}; \
          pg8::gemm_phase(F.lds, F.wave, gm, S, E); } \
        PHASE_END \
        PHASE_BEGIN \
        { pg8::LinOrder S{T / 256, 4, F.G, bx, (const char*)(scr + S_HID), (const char*)(F.ws + W_F_D) + (size_t)(f) * 1024 * DFF * 2, (size_t)256 * DFF, (size_t)256 * DFF}; \
          pg8::Gemm gm{DFF / 2, 1, 1, (size_t)128 * DFF, (size_t)128 * DFF};     \
          pg8::EpiResLn<false> E{(bf16*)(F.ws + WS_HB), ln_g + (lnidx) * 1024, ln_b + (lnidx) * 1024, ALPHA, 1.f / WSCALE8D, (float*)(scr + S_Y), (unsigned*)(F.ctl + CW_LNC + (2 + (f)) * 4096), (unsigned*)(F.ctl + CW_BAR) + XB_TMO, nullptr, F.lds + LNT_OFF}; \
          pg8::gemm_phase<pg8::EpiResLn<false>, pg8::LinOrder, true, 1>(F.lds, F.wave, gm, S, E); }     \
        PHASE_END \
    } else { \
        PHASE_BEGIN ln_phase<1, false, false>(F, ln_g + (lnidx) * 1024, ln_b + (lnidx) * 1024, nullptr); PHASE_END \
    }
    DENSE_FFN(0, 1, 2)

    if (MK_ENABLE & 4) {
        PHASE_BEGIN
        { pg8::LinOrder S{T / 256, 4, F.G, bx, (const char*)hb, (const char*)(F.ws + W_B_IN), (size_t)256 * 2048, (size_t)256 * 2048};
          pg8::Gemm gm{1024, 1, 1, (size_t)128 * 2048, (size_t)128 * 2048};
          pg8::EpiBf16<0> E{(bf16*)(scr + S_BCX), 1024};
          pg8::gemm_phase(F.lds, F.wave, gm, S, E); }
        { pg8::LinOrder S{T / 256, 8, F.G, bx, (const char*)hb, (const char*)(F.ws + W_B_IN) + (size_t)1024 * 2048, (size_t)256 * 2048, (size_t)256 * 2048};
          pg8::Gemm gm{1024, 1, 1, (size_t)128 * 2048, (size_t)128 * 2048};
          pg8::EpiGlu<0> E{(bf16*)(scr + S_BCX + (size_t)128 * MiB), 1024};
          pg8::gemm_phase(F.lds, F.wave, gm, S, E); }
        PHASE_END
        PHASE_BEGIN conv_phase(F, args.in[7]); if (MK_PROBE & 4) conv_phase(F, args.in[7]); PHASE_END
        PHASE_BEGIN
        { pg8::LinOrder S{T / 256, 4, F.G, bx, (const char*)(scr + S_P), (const char*)(F.ws + W_B_O), (size_t)256 * 2048, (size_t)256 * 2048};
          pg8::Gemm gm{1024, 1, 1, (size_t)128 * 2048, (size_t)128 * 2048};
          pg8::EpiResBf16 E{hb, (bf16*)F.out, 1024, ALPHA};
          pg8::gemm_phase(F.lds, F.wave, gm, S, E); }
        PHASE_END
        PHASE_BEGIN ln_phase<0, true, false>(F, ln_g + 2 * 1024, ln_b + 2 * 1024, args.in[20]); PHASE_END
    } else {
        PHASE_BEGIN ln_phase<1, true, false>(F, ln_g + 2 * 1024, ln_b + 2 * 1024, args.in[20]); PHASE_END
    }
#define MOE_CHUNK(f, ck) \
        PHASE_BEGIN \
        { const MoeSeg sg = moe_seg(F, (f)); int nM = sg.ts[8] - (ck) * MOE_CH_TILES; nM = nM > MOE_CH_TILES ? MOE_CH_TILES : (nM < 0 ? 0 : nM); \
          MoeOrder S{nM, 2 * DFE / 256, F.G, bx, (ck) * MOE_CH_TILES, sg, (const char*)F.out, (const char*)(F.ws + W_E_GU) + (size_t)(f) * 8 * 2 * DFE * 2048, (size_t)256 * 1024, (size_t)2 * DFE * 2048, (size_t)256 * 1024, false, true}; \
          pg8::Gemm gm{512, 1, 1, (size_t)128 * 1024, (size_t)128 * 1024};     \
          pg8::EpiSwiglu8 E{(unsigned char*)(scr + S_MHID), DFE, 1.f / WSCALE8}; \
          pg8::gemm_phase<pg8::EpiSwiglu8, MoeOrder, true, 0x7C>(F.lds, F.wave, gm, S, E);     if ((ck) == 0 && (MK_PROBE & 32)) pg8::gemm_phase(F.lds, F.wave, gm, S, E); } \
        PHASE_END \
        PHASE_BEGIN \
        { const MoeSeg sg = moe_seg(F, (f)); int nM = sg.ts[8] - (ck) * MOE_CH_TILES; nM = nM > MOE_CH_TILES ? MOE_CH_TILES : (nM < 0 ? 0 : nM); \
          MoeOrder S{nM, 4, F.G, bx, (ck) * MOE_CH_TILES, sg, (const char*)(scr + S_MHID), (const char*)(F.ws + W_E_D) + (size_t)(f) * 8 * 1024 * DFE * 2, (size_t)256 * DFE, (size_t)1024 * DFE * 2, (size_t)256 * DFE, true, false}; \
          pg8::Gemm gm{DFE / 2, 1, 1, (size_t)128 * DFE, (size_t)128 * DFE};     \
          pg8::EpiF8 E{scr + S_XG, 1024, YSCALE8 / WSCALE8D};     \
          pg8::gemm_phase<pg8::EpiF8, MoeOrder, true, 0x7B>(F.lds, F.wave, gm, S, E);     if ((ck) == 0 && (MK_PROBE & 64)) pg8::gemm_phase(F.lds, F.wave, gm, S, E); } \
        PHASE_END
#define MOE_FFN(f, lnidx, enbit, fin) \
    if (MK_ENABLE & (enbit)) { \
        PHASE_BEGIN moe_gather_phase(F, (f)); if (MK_PROBE & 4) moe_gather_phase(F, (f)); PHASE_END \
        MOE_CHUNK(f, 0) MOE_CHUNK(f, 1) MOE_CHUNK(f, 2) \
        PHASE_BEGIN ln_phase<2, false, fin>(F, ln_g + (lnidx) * 1024, ln_b + (lnidx) * 1024, nullptr); PHASE_END \
    } else { \
        PHASE_BEGIN ln_phase<1, false, fin>(F, ln_g + (lnidx) * 1024, ln_b + (lnidx) * 1024, nullptr); PHASE_END \
    }
    MOE_FFN(0, 3, 8, false)

    if (MK_ENABLE & 16) {
        PHASE_BEGIN
        { pg8::LinOrder S{T / 256, 8, F.G, bx, (const char*)hb, (const char*)(F.ws + W_C_QK), (size_t)256 * 2048, (size_t)256 * 2048};
          pg8::Gemm gm{1024, 1, 1, (size_t)128 * 2048, (size_t)128 * 2048};
          pg8::EpiBf16<0> E{(bf16*)(scr + S_CQK), 2048};
          pg8::gemm_phase(F.lds, F.wave, gm, S, E); }
        { pg8::LinOrder S{4, T / 256, F.G, bx, (const char*)(F.ws + W_C_V), (const char*)hb, (size_t)256 * 2048, (size_t)256 * 2048};
          pg8::Gemm gm{1024, 1, 1, (size_t)128 * 2048, (size_t)128 * 2048};
          pg8::EpiBf16<0> E{(bf16*)(scr + S_CVT), T};
          pg8::gemm_phase(F.lds, F.wave, gm, S, E); }
        PHASE_END
#ifdef MK_SELFCHECK
        PHASE_BEGIN selfcheck_buf(F, scr + S_CQK, (size_t)256 * MiB, 40, 0); selfcheck_buf(F, scr + S_CVT, (size_t)128 * MiB, 41, 65536); PHASE_END
#endif
        PHASE_BEGIN kmean_phase(F); if (MK_PROBE & 4) kmean_phase(F); PHASE_END
#ifdef MK_SELFCHECK
        PHASE_BEGIN selfcheck_buf(F, F.ws + WS_KMEAN, (size_t)1 * MiB, 42, 65536 + 32768); PHASE_END
#endif
        PHASE_BEGIN moba_phase3(F); if (MK_PROBE & 2) moba_phase3(F); PHASE_END
#ifdef MK_SELFCHECK
        PHASE_BEGIN selfcheck_buf(F, F.ws + WS_NEED + 3 * MiB, (size_t)4 * MiB, 43, 65536 + 32768 + 256); selfcheck_buf(F, F.ws + WS_NEED + 7 * MiB, (size_t)4 * MiB, 44, 65536 + 32768 + 256 + 1024);
                    selfcheck_buf(F, scr + S_CATT, (size_t)128 * MiB, 45, 65536 + 32768 + 256 + 2048); PHASE_END
#endif
        PHASE_BEGIN
        { pg8::LinOrder S{T / 256, 4, F.G, bx, (const char*)(scr + S_CATT), (const char*)(F.ws + W_C_O), (size_t)256 * 1024, (size_t)256 * 1024};
          pg8::Gemm gm{512, 1, 1, (size_t)128 * 1024, (size_t)128 * 1024};
          pg8::EpiResLn<FFN_GU8 == 1> E{(bf16*)(F.ws + WS_HB), ln_g + 4 * 1024, ln_b + 4 * 1024, ALPHA, 1.f / (WSCALE8 * ASCALE8), (float*)scr, (unsigned*)(F.ctl + CW_LNC + 1 * 4096), (unsigned*)(F.ctl + CW_BAR) + XB_TMO, scr + S_HB8, F.lds + LNT_OFF};
          pg8::gemm_phase<pg8::EpiResLn<FFN_GU8 == 1>, pg8::LinOrder, true, 1>(F.lds, F.wave, gm, S, E); }
        PHASE_END
    } else {
        PHASE_BEGIN ln_phase<1, false, false>(F, ln_g + 4 * 1024, ln_b + 4 * 1024, nullptr); PHASE_END
    }
    DENSE_FFN(1, 5, 32)

    if (MK_ENABLE & 64) {
        PHASE_BEGIN
        { pg8::LinOrder S{T / 256, 8, F.G, bx, (const char*)hb, (const char*)(F.ws + W_D_IN), (size_t)256 * 2048, (size_t)256 * 2048};
          pg8::Gemm gm{1024, 1, 1, (size_t)128 * 2048, (size_t)128 * 2048};
          pg8::EpiBf16<1> E{(bf16*)(scr + S_UV), 2048};
          pg8::gemm_phase(F.lds, F.wave, gm, S, E); }
        PHASE_END
        PHASE_BEGIN gmlp_phase(F, args.in[12], args.in[13], args.in[15]); if (MK_PROBE & 4) gmlp_phase(F, args.in[12], args.in[13], args.in[15]); PHASE_END
        PHASE_BEGIN
        { pg8::LinOrder S{T / 256, 4, F.G, bx, (const char*)(scr + S_P), (const char*)(F.ws + W_D_O), (size_t)256 * 2048, (size_t)256 * 2048};
          pg8::Gemm gm{1024, 1, 1, (size_t)128 * 2048, (size_t)128 * 2048};
          pg8::EpiResBf16 E{hb, (bf16*)F.out, 1024, ALPHA};
          pg8::gemm_phase(F.lds, F.wave, gm, S, E); }
        PHASE_END
        PHASE_BEGIN ln_phase<0, true, false>(F, ln_g + 6 * 1024, ln_b + 6 * 1024, args.in[20] + 8192); PHASE_END
    } else {
        PHASE_BEGIN ln_phase<1, true, false>(F, ln_g + 6 * 1024, ln_b + 6 * 1024, args.in[20] + 8192); PHASE_END
    }
    MOE_FFN(1, 7, 128, true)
#ifdef MK_SELFCHECK
    PHASE_BEGIN
    { const unsigned fl = __hip_atomic_load((unsigned*)(F.ctl + 32), RLX_AGENT);
      if (fl != 0u) { const int code = 1000 - (int)fl; const float cval = (code >= 40 && code <= 45) ? (float)(20 + 2 * (code - 40)) : (float)(1u << (code / 10 + 1)); const int gw = F.vcu * NWAVES + F.wave, NGW = F.G * NWAVES;
          for (int m = gw; m < T; m += NGW) { f32x4* w = (f32x4*)(F.out + (size_t)m * D) + F.lane;
#pragma unroll
              for (int j = 0; j < 4; ++j) w[64 * j] = (f32x4){cval, cval, cval, cval}; } } }
    PHASE_END
#endif
#undef PHASE_BEGIN
#undef PHASE_END
#undef scr
#undef hb
#undef ln_g
#undef ln_b
}

static int count_phases() {
    int n = 1;
    n += (MK_ENABLE & 1) ? (8 + 1 + 1) : 1;
    n += (MK_ENABLE & 2) ? 2 : 1;
    n += (MK_ENABLE & 4) ? 4 : 1;
    n += (MK_ENABLE & 8) ? 8 : 1;
    n += (MK_ENABLE & 16) ? 4 : 1;
    n += (MK_ENABLE & 32) ? 2 : 1;
    n += (MK_ENABLE & 64) ? 4 : 1;
    n += (MK_ENABLE & 128) ? 8 : 1;
#ifdef MK_SELFCHECK
    n += 1 + 3;
#endif
    return n;
}
extern "C" void kernel_launch(void* const* d_in, const int* in_sizes, int n_in, void* d_out, int out_size, void* d_ws, size_t ws_size, hipStream_t stream) {
    static int grid = 0;
    if (grid == 0) {
        if (n_in != 24 || in_sizes[0] != T * D || out_size != T * D || ws_size < WS_NEED) { fprintf(stderr, "kernel_launch: unexpected shapes (n_in %d, in0 %d, out %d, ws %zu < %zu); nothing launched\n", n_in, n_in > 0 ? in_sizes[0] : -1, out_size, ws_size, (size_t)WS_NEED); grid = -1; return; }
        int dev = 0, cus = 0, per_cu = 0;
        if (hipGetDevice(&dev) != hipSuccess || hipDeviceGetAttribute(&cus, hipDeviceAttributeMultiprocessorCount, dev) != hipSuccess) { grid = -1; return; }
        if (hipFuncSetAttribute((const void*)mk_fwd, hipFuncAttributeMaxDynamicSharedMemorySize, LDS_BYTES) != hipSuccess) { fprintf(stderr, "kernel_launch: hipFuncSetAttribute failed\n"); grid = -1; return; }
        if (hipOccupancyMaxActiveBlocksPerMultiprocessor(&per_cu, (const void*)mk_fwd, NWAVES * 64, LDS_BYTES) != hipSuccess || per_cu < 1) fprintf(stderr, "kernel_launch: occupancy query reports %d\n", per_cu);
        (void)hipGetLastError();
        grid = cus;
    }
    if (grid < 0) return;
    (void)hipMemsetAsync((char*)d_ws + WS_CTL, 0, CTL_ZERO_BYTES, stream);
#ifdef SELF_POISON
    (void)hipMemsetAsync((char*)d_ws + CTL_ZERO_BYTES, 0xAA, WS_NEED - CTL_ZERO_BYTES, stream);
    (void)hipMemsetAsync(d_out, 0xAA, (size_t)T * D * 4, stream);
#endif
    Args a{};
    for (int i = 0; i < 24; ++i) a.in[i] = (const float*)d_in[i];
    a.out = (float*)d_out; a.ws = (unsigned char*)d_ws;
    const int nph = count_phases();
#if MK_MULTI
    for (int p = 0; p < nph; ++p) { a.ph_lo = p; a.ph_hi = p + 1; hipLaunchKernelGGL(mk_fwd, dim3(grid), dim3(NWAVES * 64), LDS_BYTES, stream, a); }
#else
    a.ph_lo = 0; a.ph_hi = nph;
#ifdef MK_SELFCHECK
    a.chk = 1;
    hipLaunchKernelGGL(mk_fwd, dim3(grid), dim3(NWAVES * 64), LDS_BYTES, stream, a);
    (void)hipMemsetAsync((char*)d_ws + WS_CTL, 0, CTL_ZERO_BYTES, stream);
    a.chk = 2;
#endif
    hipLaunchKernelGGL(mk_fwd, dim3(grid), dim3(NWAVES * 64), LDS_BYTES, stream, a);
#endif
    const hipError_t le = hipPeekAtLastError();
    if (le != hipSuccess) fprintf(stderr, "kernel_launch: launch failed: %s\n", hipGetErrorName(le));
}
```

```cpp
#include <hip/hip_runtime.h>
#include <cstdio>
#include <cstdint>

#ifndef MK_MULTI
#define MK_MULTI 0
#endif
#ifndef MK_PROBE
#define MK_PROBE 0
#endif
#ifndef MK_ENABLE
#define MK_ENABLE 0xFF
#endif

#define GAS __attribute__((address_space(1)))
#define LAS __attribute__((address_space(3)))
typedef unsigned short bf16;
typedef short bf16x8 __attribute__((ext_vector_type(8)));
typedef float f32x4 __attribute__((ext_vector_type(4)));
typedef float f32x2 __attribute__((ext_vector_type(2)));
typedef float f32x16 __attribute__((ext_vector_type(16)));
typedef unsigned u32x4 __attribute__((ext_vector_type(4)));
typedef unsigned u32x2 __attribute__((ext_vector_type(2)));
typedef GAS unsigned gu32;
typedef int v8i_t __attribute__((ext_vector_type(8)));
typedef int v4i_t __attribute__((ext_vector_type(4)));
typedef short s16x16_t __attribute__((ext_vector_type(16)));

constexpr int D = 1024, NB = 32, SEQ = 2048, T = NB * SEQ, NH = 16, HD = 64;
constexpr int DFF = 2816, NE = 8, DFE = 3584;
constexpr float ALPHA = 1.6817928305074290f;
constexpr float LN_EPS = 1e-5f;
constexpr float LOG2E = 1.4426950408889634f;
constexpr float QSCALE = 0.125f * LOG2E;
constexpr float NEGB = -1e30f;
constexpr int TC = 16384;
constexpr int MOE_CH_TILES = 256;
constexpr int MOE_MAX_TILES = 520;
constexpr int FFN_GU8 = 1;

constexpr size_t MiB = 1u << 20;
constexpr size_t WS_CTL = 0, CTL_ZERO_BYTES = 1 * MiB;
constexpr size_t WS_BUCKET = 1 * MiB;
constexpr size_t WS_BTABA = WS_BUCKET + 8192;
constexpr size_t WS_BTABC = WS_BTABA + 32768;
constexpr size_t WS_WST = WS_BTABC + 131072;
constexpr size_t WS_KMEAN = 2 * MiB;
constexpr size_t WS_ROUTE = 4 * MiB;
constexpr size_t WS_GATES = 5 * MiB;
constexpr size_t WS_SLOTS = 6 * MiB;
constexpr size_t WS_WCNT = 7 * MiB;
constexpr size_t WS_W = 8 * MiB;
constexpr size_t W_A_QK = WS_W;
constexpr size_t W_A_V = W_A_QK + 12 * MiB;
constexpr size_t W_A_O = W_A_V + 6 * MiB;
constexpr size_t W_B_IN = W_A_O + 2 * MiB;
constexpr size_t W_B_O = W_B_IN + 6 * MiB;
constexpr size_t W_C_QK = W_B_O + 2 * MiB;
constexpr size_t W_C_V = W_C_QK + 4 * MiB;
constexpr size_t W_C_O = W_C_V + 2 * MiB;
constexpr size_t W_D_IN = W_C_O + 2 * MiB;
constexpr size_t W_D_O = W_D_IN + 4 * MiB;
constexpr size_t W_F_GU = W_D_O + 2 * MiB;
constexpr size_t W_F_D = W_F_GU + 22 * MiB;
constexpr size_t W_E_GU = W_F_D + 11 * MiB;
constexpr size_t W_E_D = W_E_GU + 224 * MiB;
constexpr size_t WS_HB = W_E_D + 112 * MiB;
constexpr size_t WS_SCR = WS_HB + 128 * MiB;
constexpr size_t WS_NEED = WS_SCR + 512 * MiB;
static_assert(WS_HB == 419 * MiB, "map");
constexpr size_t S_QK = 0;
constexpr size_t S_VT = 192 * MiB;
constexpr size_t S_HB8 = 448 * MiB;
constexpr size_t S_ATT = 288 * MiB;
constexpr size_t S_HID = 0;
constexpr size_t S_BCX = 0;
constexpr size_t S_P = 384 * MiB;
constexpr size_t S_XG = 0;
constexpr size_t S_MHID = 260 * MiB;
constexpr size_t S_Y = 256 * MiB;
constexpr size_t S_CQK = 0;
constexpr size_t S_CVT = 256 * MiB;
constexpr size_t S_CATT = 384 * MiB;
constexpr size_t S_UV = 0;
constexpr size_t O_OG = 0;
constexpr size_t O_LSE = 96 * MiB;
constexpr int CW_TMO = 0;
constexpr int CW_ECNT = 64;
constexpr int CW_BAR = 4096;
constexpr int CW_LNC = 16384;

constexpr float YSCALE8 = 16.f;
constexpr float ASCALE8 = 8.f;
constexpr float WSCALE8 = 64.f, WSCALE8D = 256.f;
__device__ __forceinline__ unsigned pk4_fp8(float a, float b, float c, float d) { int p = 0; p = __builtin_amdgcn_cvt_pk_fp8_f32(a, b, p, false); p = __builtin_amdgcn_cvt_pk_fp8_f32(c, d, p, true); return (unsigned)p; }
namespace pg8 {
constexpr int BM = 256, BK = 64, HALF = 128, HTB = HALF * BK * 2, STAGE_BYTES = 8 * HTB, NXCD = 8, WGM = 8;
__host__ __device__ __forceinline__ int lds_byte(int r, int c) { const int st = (r >> 4) * 2 + (c >> 5), rr = r & 15, cc = c & 31, ob = rr * 64 + cc * 2; return st * 1024 + (ob ^ (((ob >> 9) & 1) << 5)); }
__host__ __device__ __forceinline__ void stage_rc(int b, int& R, int& C) { const int st = b / 1024, sb = b % 1024, swz = sb ^ (((sb >> 9) & 1) << 5); R = (st >> 1) * 16 + swz / 64; C = (st & 1) * 32 + (swz % 64) / 2; }
__host__ __device__ __forceinline__ int perm32(int rho) { const int n = rho >> 4, i = rho & 15; return 8 * (i >> 2) + 4 * n + (i & 3); }

struct Unit { int pm, pn; unsigned a, b; };
struct Gemm { int K; int rsA, rsB; size_t hstepA, hstepB; };

__device__ __forceinline__ bool tile_of(long L, int nM, int nN, int& pm, int& pn) {
    const int nwg = nM * nN; if (L >= nwg) return false;
    int wgid = (int)L; { const int q = nwg / NXCD, r = nwg % NXCD, xcd = wgid % NXCD, off = wgid / NXCD; wgid = (xcd < r ? xcd * (q + 1) : r * (q + 1) + (xcd - r) * q) + off; }
    const int nig = WGM * nN, gid = wgid / nig, fm = gid * WGM, gsz = (nM - fm) < WGM ? (nM - fm) : WGM;
    pm = fm + ((wgid % nig) % gsz); pn = (wgid % nig) / gsz; return true;
}
struct LinOrder {
    int nM, nN, G, c; const char* A0; const char* B0; size_t aT, bT;
    __device__ __forceinline__ bool next(int i, Unit& u) const { if (!tile_of((long)i * G + c, nM, nN, u.pm, u.pn)) return false; u.a = (unsigned)((size_t)u.pm * aT); u.b = (unsigned)((size_t)u.pn * bT); return true; }
};

typedef __bf16 bf16x2_t __attribute__((ext_vector_type(2)));
__device__ __forceinline__ unsigned cvt_pk_bf16(float lo, float hi) { f32x2 v = {lo, hi}; bf16x2_t b = __builtin_convertvector(v, bf16x2_t); return __builtin_bit_cast(unsigned, b); }
__device__ __forceinline__ f32x2 gelu_pk(f32x2 v) {
    const f32x2 av = __builtin_elementwise_abs(v), d = av * 0.2316418882f + 1.0f;
    f32x2 t; t.x = __builtin_amdgcn_rcpf(d.x); t.y = __builtin_amdgcn_rcpf(d.y);
    f32x2 q = t * 0.5307027145f + (-0.7265760135f); q = q * t + 0.7107068705f; q = q * t + (-0.142248368f); q = q * t + 0.127414796f; q = q * t;
    const f32x2 s = (v * v) * (-0.72134752044f);
    f32x2 e; e.x = __builtin_amdgcn_exp2f(s.x); e.y = __builtin_amdgcn_exp2f(s.y);
    const f32x2 m = v * (q * e), r = v - m;
    f32x2 o; o.x = v.x < 0.f ? m.x : r.x; o.y = v.y < 0.f ? m.y : r.y; return o;
}
__device__ __forceinline__ float silu_f(float g) { return g * __builtin_amdgcn_rcpf(1.0f + __builtin_amdgcn_exp2f(-LOG2E * g)); }

template <int ACT  > struct EpiBf16 {
    static constexpr bool PERM = true;
    bf16* O; int ldc; float sc = 1.f;
    __device__ __forceinline__ void operator()(const f32x4 (&acc)[2][2][4][2], const Unit& u, int wr, int wc, int fr, int fq) const {
        const int row0 = u.pm * BM + wr * 64 + fr, col0 = u.pn * BM + wc * 32 + 8 * fq;
#pragma unroll
        for (int ai = 0; ai < 2; ++ai)
#pragma unroll
            for (int m = 0; m < 4; ++m) { bf16* rowp = O + (size_t)(row0 + ai * HALF + m * 16) * ldc + col0;
#pragma unroll
                for (int bj = 0; bj < 2; ++bj) { f32x4 v0 = acc[ai][bj][m][0] * sc, v1 = acc[ai][bj][m][1] * sc;
                    if (ACT == 1) { f32x2 a = gelu_pk((f32x2){v0[0], v0[1]}), b = gelu_pk((f32x2){v0[2], v0[3]}), c = gelu_pk((f32x2){v1[0], v1[1]}), d = gelu_pk((f32x2){v1[2], v1[3]});
                        v0 = (f32x4){a.x, a.y, b.x, b.y}; v1 = (f32x4){c.x, c.y, d.x, d.y}; }
                    u32x4 w; w.x = cvt_pk_bf16(v0[0], v0[1]); w.y = cvt_pk_bf16(v0[2], v0[3]); w.z = cvt_pk_bf16(v1[0], v1[1]); w.w = cvt_pk_bf16(v1[2], v1[3]);
                    *(u32x4*)(rowp + bj * HALF) = w; } }
    }
};
struct EpiF8 {
    static constexpr bool PERM = true;
    unsigned char* O; int ldc; float sc = 1.f;
    __device__ __forceinline__ void operator()(const f32x4 (&acc)[2][2][4][2], const Unit& u, int wr, int wc, int fr, int fq) const {
        const int row0 = u.pm * BM + wr * 64 + fr, col0 = u.pn * BM + wc * 32 + 8 * fq;
#pragma unroll
        for (int ai = 0; ai < 2; ++ai)
#pragma unroll
            for (int m = 0; m < 4; ++m) { unsigned char* rowp = O + (size_t)(row0 + ai * HALF + m * 16) * ldc + col0;
#pragma unroll
                for (int bj = 0; bj < 2; ++bj) { const f32x4 v0 = acc[ai][bj][m][0] * sc, v1 = acc[ai][bj][m][1] * sc;
                    u32x2 w; w.x = pk4_fp8(v0[0], v0[1], v0[2], v0[3]); w.y = pk4_fp8(v1[0], v1[1], v1[2], v1[3]);
                    *(u32x2*)(rowp + bj * HALF) = w; } }
    }
};
template <int ACT  > struct EpiGlu {
    static constexpr bool PERM = true;
    bf16* O; int ldc;
    __device__ __forceinline__ void operator()(const f32x4 (&acc)[2][2][4][2], const Unit& u, int wr, int wc, int fr, int fq) const {
        const int row0 = u.pm * BM + wr * 64 + fr, col0 = u.pn * HALF + wc * 32 + 8 * fq;
#pragma unroll
        for (int ai = 0; ai < 2; ++ai)
#pragma unroll
            for (int m = 0; m < 4; ++m) { bf16* rowp = O + (size_t)(row0 + ai * HALF + m * 16) * ldc + col0;
                f32x4 g0 = acc[ai][0][m][0], g1 = acc[ai][0][m][1]; const f32x4 u0 = acc[ai][1][m][0], u1 = acc[ai][1][m][1];
                if (ACT == 1) { g0 = (f32x4){silu_f(g0[0]), silu_f(g0[1]), silu_f(g0[2]), silu_f(g0[3])}; g1 = (f32x4){silu_f(g1[0]), silu_f(g1[1]), silu_f(g1[2]), silu_f(g1[3])}; }
                const f32x4 p0 = g0 * u0, p1 = g1 * u1;
                u32x4 w; w.x = cvt_pk_bf16(p0[0], p0[1]); w.y = cvt_pk_bf16(p0[2], p0[3]); w.z = cvt_pk_bf16(p1[0], p1[1]); w.w = cvt_pk_bf16(p1[2], p1[3]);
                *(u32x4*)rowp = w; }
    }
};
struct EpiSwiglu8 {
    static constexpr bool PERM = true;
    unsigned char* O; int ldc; float s = 1.f;
    __device__ __forceinline__ void operator()(const f32x4 (&acc)[2][2][4][2], const Unit& u, int wr, int wc, int fr, int fq) const {
        const int row0 = u.pm * BM + wr * 64 + fr, col0 = u.pn * HALF + wc * 32 + 8 * fq;
#pragma unroll
        for (int ai = 0; ai < 2; ++ai)
#pragma unroll
            for (int m = 0; m < 4; ++m) { unsigned char* rowp = O + (size_t)(row0 + ai * HALF + m * 16) * ldc + col0;
                const f32x4 g0 = acc[ai][0][m][0], g1 = acc[ai][0][m][1], u0 = acc[ai][1][m][0], u1 = acc[ai][1][m][1];
                const float c1 = -LOG2E * s, s2 = s * s;
                const f32x4 p0 = (g0 * u0) * s2, p1 = (g1 * u1) * s2;
                f32x4 r0, r1;
#pragma unroll
                for (int j = 0; j < 4; ++j) { r0[j] = __builtin_amdgcn_rcpf(1.0f + __builtin_amdgcn_exp2f(g0[j] * c1)); r1[j] = __builtin_amdgcn_rcpf(1.0f + __builtin_amdgcn_exp2f(g1[j] * c1)); }
                const f32x4 o0 = p0 * r0, o1 = p1 * r1;
                u32x2 w; w.x = pk4_fp8(o0[0], o0[1], o0[2], o0[3]); w.y = pk4_fp8(o1[0], o1[1], o1[2], o1[3]);
                *(u32x2*)rowp = w; }
    }
};
struct EpiResBf16 {
    static constexpr bool PERM = true;
    const bf16* base; bf16* out; int ldc; float alpha; float sc = 1.f;
    __device__ __forceinline__ void operator()(const f32x4 (&acc)[2][2][4][2], const Unit& u, int wr, int wc, int fr, int fq) const {
        const int row0 = u.pm * BM + wr * 64 + fr, col0 = u.pn * BM + wc * 32 + 8 * fq;
#pragma unroll
        for (int ai = 0; ai < 2; ++ai)
#pragma unroll
            for (int m = 0; m < 4; ++m) { const size_t off = (size_t)(row0 + ai * HALF + m * 16) * ldc + col0;
#pragma unroll
                for (int bj = 0; bj < 2; ++bj) { const u32x4 b = *(const u32x4*)(base + off + bj * HALF); const f32x4 a0 = acc[ai][bj][m][0] * sc, a1 = acc[ai][bj][m][1] * sc;
                    u32x4 w; w.x = cvt_pk_bf16(__builtin_bit_cast(float, b.x << 16) * alpha + a0[0], __builtin_bit_cast(float, b.x & 0xffff0000u) * alpha + a0[1]);
                    w.y = cvt_pk_bf16(__builtin_bit_cast(float, b.y << 16) * alpha + a0[2], __builtin_bit_cast(float, b.y & 0xffff0000u) * alpha + a0[3]);
                    w.z = cvt_pk_bf16(__builtin_bit_cast(float, b.z << 16) * alpha + a1[0], __builtin_bit_cast(float, b.z & 0xffff0000u) * alpha + a1[1]);
                    w.w = cvt_pk_bf16(__builtin_bit_cast(float, b.w << 16) * alpha + a1[2], __builtin_bit_cast(float, b.w & 0xffff0000u) * alpha + a1[3]);
                    *(u32x4*)(out + off + bj * HALF) = w; }
                asm volatile("" ::: "memory"); }
    }
};

template <bool HB8> struct EpiResLn {
    static constexpr bool PERM = true;
    bf16* h; const float* gain; const float* bias; float alpha, sc;
    float* xbuf;
    unsigned* cnt;
    unsigned* tmo;
    unsigned char* h8;
    LAS unsigned char* tb;
    __device__ __forceinline__ void operator()(f32x4 (&acc)[2][2][4][2], const Unit& u, int wr, int wc, int fr, int fq) const {
        asm volatile("" : "+v"(fr), "+v"(fq));
        const int row0 = u.pm * BM + wr * 64 + fr, col0 = u.pn * BM + wc * 32 + 8 * fq;
        LAS f32x2* P = (LAS f32x2*)tb; LAS f32x2* S = (LAS f32x2*)(tb + 8192);
#pragma unroll
        for (int ai = 0; ai < 2; ++ai)
#pragma unroll
            for (int m = 0; m < 4; ++m) { const size_t off = (size_t)(row0 + ai * HALF + m * 16) * 1024 + col0; float sm = 0.f, sq = 0.f;
#pragma unroll
                for (int bj = 0; bj < 2; ++bj) { const u32x4 b = *(const u32x4*)(h + off + bj * HALF); const f32x4 a0 = acc[ai][bj][m][0] * sc, a1 = acc[ai][bj][m][1] * sc;
                    f32x4 z0, z1;
                    z0[0] = __builtin_bit_cast(float, b.x << 16) * alpha + a0[0]; z0[1] = __builtin_bit_cast(float, b.x & 0xffff0000u) * alpha + a0[1];
                    z0[2] = __builtin_bit_cast(float, b.y << 16) * alpha + a0[2]; z0[3] = __builtin_bit_cast(float, b.y & 0xffff0000u) * alpha + a0[3];
                    z1[0] = __builtin_bit_cast(float, b.z << 16) * alpha + a1[0]; z1[1] = __builtin_bit_cast(float, b.z & 0xffff0000u) * alpha + a1[1];
                    z1[2] = __builtin_bit_cast(float, b.w << 16) * alpha + a1[2]; z1[3] = __builtin_bit_cast(float, b.w & 0xffff0000u) * alpha + a1[3];
                    acc[ai][bj][m][0] = z0; acc[ai][bj][m][1] = z1;
                    sm += ((z0[0] + z0[1]) + (z0[2] + z0[3])) + ((z1[0] + z1[1]) + (z1[2] + z1[3]));
                    sq += ((z0[0] * z0[0] + z0[1] * z0[1]) + (z0[2] * z0[2] + z0[3] * z0[3])) + ((z1[0] * z1[0] + z1[1] * z1[1]) + (z1[2] * z1[2] + z1[3] * z1[3])); }
                sm += __shfl_xor(sm, 16); sm += __shfl_xor(sm, 32); sq += __shfl_xor(sq, 16); sq += __shfl_xor(sq, 32);
                if (fq == 0) P[(ai * HALF + wr * 64 + m * 16 + fr) * 4 + wc] = (f32x2){sm, sq};
                asm volatile("" ::: "memory"); }
        asm volatile("s_waitcnt lgkmcnt(0)" ::: "memory"); __builtin_amdgcn_s_barrier(); asm volatile("" ::: "memory");
        const int wid = wr * 4 + wc, lane = fq * 16 + fr, row = wid * 32 + (lane & 31);
        unsigned long long* slots = (unsigned long long*)xbuf + (size_t)(u.pm * BM + row) * 4;
        if (lane < 32) { const f32x2 a = P[row * 4 + 0], b = P[row * 4 + 1], c = P[row * 4 + 2], d = P[row * 4 + 3];
            const float ts = (a.x + b.x) + (c.x + d.x), tq = (a.y + b.y) + (c.y + d.y);
            __hip_atomic_store(slots + u.pn, ((unsigned long long)__builtin_bit_cast(unsigned, tq) << 32) | (unsigned long long)__builtin_bit_cast(unsigned, ts), __ATOMIC_RELAXED, __HIP_MEMORY_SCOPE_AGENT); }
        asm volatile("s_waitcnt vmcnt(0)" ::: "memory");
        if (lane == 0) (void)__hip_atomic_fetch_add(cnt + 16 * u.pm, 1u, __ATOMIC_RELAXED, __HIP_MEMORY_SCOPE_AGENT);
        if (wid == 0) { unsigned sp = 0u;
            while ((unsigned)__builtin_amdgcn_readfirstlane(__hip_atomic_load(cnt + 16 * u.pm, __ATOMIC_RELAXED, __HIP_MEMORY_SCOPE_AGENT)) < 32u) { __builtin_amdgcn_s_sleep(1);
                if ((++sp & 255u) == 0u) { if (__hip_atomic_load(tmo, __ATOMIC_RELAXED, __HIP_MEMORY_SCOPE_AGENT)) break; if (sp > (1u << 22)) { if (lane == 0) (void)__hip_atomic_fetch_add(tmo, 1u, __ATOMIC_RELAXED, __HIP_MEMORY_SCOPE_AGENT); break; } } }
            __builtin_amdgcn_fence(__ATOMIC_ACQUIRE, "agent"); }
        asm volatile("s_waitcnt vmcnt(0) lgkmcnt(0)" ::: "memory"); __builtin_amdgcn_s_barrier(); asm volatile("" ::: "memory");
        if (lane < 32) { float ts = 0.f, tq = 0.f;
#pragma unroll
            for (int t = 0; t < 4; ++t) { const unsigned long long w = __hip_atomic_load(slots + t, __ATOMIC_RELAXED, __HIP_MEMORY_SCOPE_AGENT); ts += __builtin_bit_cast(float, (unsigned)w); tq += __builtin_bit_cast(float, (unsigned)(w >> 32)); }
            const float mean = ts * (1.f / 1024.f), var = fmaxf(tq * (1.f / 1024.f) - mean * mean, 0.f);
            S[row] = (f32x2){mean, 1.f / sqrtf(var + LN_EPS)}; }
        asm volatile("s_waitcnt vmcnt(0) lgkmcnt(0)" ::: "memory"); __builtin_amdgcn_s_barrier(); asm volatile("" ::: "memory");
#pragma unroll
        for (int bj = 0; bj < 2; ++bj) { const f32x4 g0 = *(const f32x4*)(gain + col0 + bj * HALF), g1 = *(const f32x4*)(gain + col0 + bj * HALF + 4), b0 = *(const f32x4*)(bias + col0 + bj * HALF), b1 = *(const f32x4*)(bias + col0 + bj * HALF + 4);
#pragma unroll
            for (int ai = 0; ai < 2; ++ai)
#pragma unroll
                for (int m = 0; m < 4; ++m) { const int r = ai * HALF + wr * 64 + m * 16 + fr; const f32x2 sr = S[r]; const size_t off = (size_t)(u.pm * BM + r) * 1024 + col0 + bj * HALF;
                    const f32x4 y0 = (acc[ai][bj][m][0] - sr.x) * sr.y * g0 + b0, y1 = (acc[ai][bj][m][1] - sr.x) * sr.y * g1 + b1;
                    u32x4 w; w.x = cvt_pk_bf16(y0[0], y0[1]); w.y = cvt_pk_bf16(y0[2], y0[3]); w.z = cvt_pk_bf16(y1[0], y1[1]); w.w = cvt_pk_bf16(y1[2], y1[3]);
                    *(u32x4*)(h + off) = w;
                    if (HB8) { u32x2 w8; w8.x = pk4_fp8(y0[0], y0[1], y0[2], y0[3]); w8.y = pk4_fp8(y1[0], y1[1], y1[2], y1[3]); *(u32x2*)(h8 + off) = w8; }
                    asm volatile("" ::: "memory"); } }
    }
};

template <class Epi, class Sched, bool ALIGN_EPI = true, int FP8 = 0>
__device__ __forceinline__ void gemm_phase(LAS unsigned char* lds, const int wave_s, const Gemm g, const Sched& S, const Epi& E) {
    int tid = wave_s * 64 + (int)__builtin_amdgcn_mbcnt_hi(~0u, __builtin_amdgcn_mbcnt_lo(~0u, 0u)); asm volatile("" : "+v"(tid));
    const int wid = __builtin_amdgcn_readfirstlane(tid >> 6), lane = tid & 63, wr = wid >> 2, wc = wid & 3, fr = lane & 15, fq = lane >> 4;
    const int K = g.K, nt = K / BK;
    unsigned voffA[2], voffB[2];
#pragma unroll
    for (int i = 0; i < 2; ++i) { int R, C; stage_rc(tid * 16 + i * 8192, R, C); const int Rb = Epi::PERM ? ((R & ~31) + perm32(R & 31)) : R;
        voffA[i] = (unsigned)(R * g.rsA * K + C) * 2u; voffB[i] = (unsigned)(Rb * g.rsB * K + C) * 2u; }
    const unsigned kstep = (unsigned)(BK * 2);
    const unsigned hstepA = (unsigned)g.hstepA, hstepB = (unsigned)g.hstepB;
    const __amdgpu_buffer_rsrc_t rsrcA = __builtin_amdgcn_make_buffer_rsrc((void*)S.A0, 0, 0x7fffffff, 0x00020000), rsrcB = __builtin_amdgcn_make_buffer_rsrc((void*)S.B0, 0, 0x7fffffff, 0x00020000);
    const unsigned ldsw = (unsigned)wid * 1024u;
    const int aoff = lds_byte(wr * 64 + fr, fq * 8), boff = lds_byte(wc * 32 + fr, fq * 8);
    const int aoff8 = lds_byte(wr * 64 + fr, fq * 16), boff8 = lds_byte(wc * 32 + fr, fq * 16);
    unsigned bbase8_ = (unsigned)(4 * HTB + boff); asm volatile("" : "+v"(bbase8_));
    LAS unsigned char* const ldsB8 = lds + bbase8_;
#define PG8_SA(b, h) (((b) * 2 + (h)) * HTB)
#define PG8_SB(b, h) ((4 + (b) * 2 + (h)) * HTB)
#define PG8_STAGE(bufoff, gbase, voff) do { _Pragma("unroll") for (int _i = 0; _i < 2; ++_i) \
        __builtin_amdgcn_raw_ptr_buffer_load_lds(PG8_RS_##voff, (LAS unsigned*)(lds + (bufoff) + ldsw + _i * 8192), 16, (int)(voff)[_i], (int)(gbase), 0, 0); } while (0)
#define PG8_RS_voffA rsrcA
#define PG8_RS_voffB rsrcB
#define PG8_LD16(off) (*(const LAS bf16x8*)(lds + (off)))
#define PG8_CAT8(lo, hi) __builtin_shufflevector(__builtin_bit_cast(v4i_t, lo), __builtin_bit_cast(v4i_t, hi), 0, 1, 2, 3, 4, 5, 6, 7)
#define PG8_LDA(dst, b, h) do { if constexpr (FP8) { _Pragma("unroll") for (int m = 0; m < 4; ++m) dst##8[m] = PG8_CAT8(PG8_LD16(PG8_SA(b, h) + aoff + m * 2048), PG8_LD16(PG8_SA(b, h) + aoff + m * 2048 + 1024)); } \
        else { _Pragma("unroll") for (int m = 0; m < 4; ++m) _Pragma("unroll") for (int k = 0; k < 2; ++k) dst[m][k] = PG8_LD16(PG8_SA(b, h) + aoff + m * 2048 + k * 1024); } } while (0)
#define PG8_LDB(dst, b, h) do { if constexpr (FP8) { _Pragma("unroll") for (int n = 0; n < 2; ++n) dst##8[n] = PG8_CAT8(*(const LAS bf16x8*)(ldsB8 + ((b) * 2 + (h)) * HTB + n * 2048), *(const LAS bf16x8*)(ldsB8 + ((b) * 2 + (h)) * HTB + n * 2048 + 1024)); } \
        else { _Pragma("unroll") for (int n = 0; n < 2; ++n) _Pragma("unroll") for (int k = 0; k < 2; ++k) dst[n][k] = PG8_LD16(PG8_SB(b, h) + boff + n * 2048 + k * 1024); } } while (0)
#define PG8_MMA(ai, bj, At, Bt) do { __builtin_amdgcn_s_setprio(1); \
        if constexpr (FP8) { _Pragma("unroll") for (int m = 0; m < 4; ++m) _Pragma("unroll") for (int n = 0; n < 2; ++n) \
            acc[ai][bj][m][n] = __builtin_amdgcn_mfma_scale_f32_16x16x128_f8f6f4(Bt##8[n], At##8[m], acc[ai][bj][m][n], 0, 0, 0, 0, 0, 0); } \
        else { _Pragma("unroll") for (int m = 0; m < 4; ++m) _Pragma("unroll") for (int n = 0; n < 2; ++n) _Pragma("unroll") for (int k = 0; k < 2; ++k) \
            acc[ai][bj][m][n] = __builtin_amdgcn_mfma_f32_16x16x32_bf16(Bt[n][k], At[m][k], acc[ai][bj][m][n], 0, 0, 0); } \
        __builtin_amdgcn_s_setprio(0); } while (0)
#define PG8_WAIT_V(n) asm volatile("s_waitcnt vmcnt(" #n ")" ::: "memory")
#define PG8_WAIT_L(n) asm volatile("s_waitcnt lgkmcnt(" #n ")" ::: "memory")
#define PG8_BAR __builtin_amdgcn_s_barrier()
#define PG8_SCHED __builtin_amdgcn_sched_barrier(0)
    Unit cur, nxt; int ui = 0;
    if (!S.next(0, cur)) return;
    f32x4 acc[2][2][4][2];
#pragma unroll
    for (int a = 0; a < 2; ++a)
#pragma unroll
        for (int b = 0; b < 2; ++b)
#pragma unroll
            for (int m = 0; m < 4; ++m)
#pragma unroll
                for (int n = 0; n < 2; ++n) acc[a][b][m][n] = (f32x4){0.f, 0.f, 0.f, 0.f};
    bf16x8 At[4][2], B0[2][2], B1[2][2]; v8i_t At8[4], B08[2], B18[2];
    unsigned cA = cur.a, cB = cur.b;
    PG8_STAGE(PG8_SB(0, 0), cB, voffB); PG8_STAGE(PG8_SB(0, 1), cB + hstepB, voffB); PG8_STAGE(PG8_SA(0, 0), cA, voffA); PG8_STAGE(PG8_SA(0, 1), cA + hstepA, voffA);
    if (wr == 1) PG8_BAR;
    PG8_WAIT_V(2); PG8_BAR;
    PG8_STAGE(PG8_SB(1, 0), cB + kstep, voffB); PG8_STAGE(PG8_SA(1, 0), cA + kstep, voffA); PG8_STAGE(PG8_SB(1, 1), cB + hstepB + kstep, voffB);
    PG8_WAIT_V(6); PG8_BAR;
    for (;;) {
        const bool has_next = S.next(ui + 1, nxt);
        const unsigned nA = has_next ? nxt.a : cA, nB = has_next ? nxt.b : cB;
#pragma clang loop unroll(disable)
        for (int t = 0; t < nt; t += 2) {
            const bool last = (t == nt - 2);
            const unsigned a1 = cA + (unsigned)(t + 1) * kstep;
            const unsigned a2 = last ? nA : cA + (unsigned)(t + 2) * kstep, b2 = last ? nB : cB + (unsigned)(t + 2) * kstep;
            const unsigned a3 = a2 + kstep, b3 = b2 + kstep;
            PG8_LDB(B0, 0, 0); PG8_LDB(B1, 0, 1); PG8_SCHED; PG8_LDA(At, 0, 0); PG8_STAGE(PG8_SA(1, 1), a1 + hstepA, voffA);
            PG8_WAIT_V(8); PG8_WAIT_L(0); PG8_BAR; PG8_MMA(0, 0, At, B0); PG8_MMA(0, 1, At, B1); PG8_BAR; PG8_SCHED;
            PG8_LDA(At, 0, 1); PG8_STAGE(PG8_SB(0, 0), b2, voffB); PG8_STAGE(PG8_SB(0, 1), b2 + hstepB, voffB); PG8_STAGE(PG8_SA(0, 0), a2, voffA);
            PG8_WAIT_V(8); PG8_WAIT_L(0); PG8_BAR; PG8_MMA(1, 0, At, B0); PG8_MMA(1, 1, At, B1); PG8_BAR; PG8_SCHED;
            PG8_LDB(B0, 1, 0); PG8_LDB(B1, 1, 1); PG8_SCHED; PG8_LDA(At, 1, 0); PG8_STAGE(PG8_SA(0, 1), a2 + hstepA, voffA);
            PG8_WAIT_V(8); PG8_WAIT_L(0); PG8_BAR; PG8_MMA(0, 0, At, B0); PG8_MMA(0, 1, At, B1); PG8_BAR; PG8_SCHED;
            PG8_LDA(At, 1, 1); PG8_STAGE(PG8_SB(1, 0), b3, voffB); PG8_STAGE(PG8_SB(1, 1), b3 + hstepB, voffB); PG8_STAGE(PG8_SA(1, 0), a3, voffA);
            PG8_WAIT_V(8); PG8_WAIT_L(0); PG8_BAR; PG8_MMA(1, 0, At, B0); PG8_MMA(1, 1, At, B1); PG8_BAR; PG8_SCHED;
        }
        if constexpr (ALIGN_EPI) { if (wr == 0) PG8_BAR; }
        E(acc, cur, wr, wc, fr, fq);
        if (!has_next) break;
#pragma unroll
        for (int a = 0; a < 2; ++a)
#pragma unroll
            for (int b = 0; b < 2; ++b)
#pragma unroll
                for (int m = 0; m < 4; ++m)
#pragma unroll
                    for (int n = 0; n < 2; ++n) acc[a][b][m][n] = (f32x4){0.f, 0.f, 0.f, 0.f};
        cur = nxt; cA = nA; cB = nB; ++ui;
        if constexpr (ALIGN_EPI) { if (wr == 1) PG8_BAR; }
    }
    PG8_WAIT_V(0);
    if constexpr (!ALIGN_EPI) { if (wr == 0) PG8_BAR; }
    PG8_BAR;
#undef PG8_SA
#undef PG8_SB
#undef PG8_STAGE
#undef PG8_RS_voffA
#undef PG8_RS_voffB
#undef PG8_LDA
#undef PG8_LD16
#undef PG8_CAT8
#undef PG8_LDB
#undef PG8_MMA
#undef PG8_WAIT_V
#undef PG8_WAIT_L
#undef PG8_BAR
#undef PG8_SCHED
}
}

#define RLX_AGENT __ATOMIC_RELAXED, __HIP_MEMORY_SCOPE_AGENT
#define LDS_WAIT() asm volatile("s_waitcnt lgkmcnt(0)" ::: "memory")
#define VM_WAIT() asm volatile("s_waitcnt vmcnt(0)" ::: "memory")
__device__ __forceinline__ unsigned f2bf(float f) { unsigned u = __builtin_bit_cast(unsigned, f); return (u + 0x7fffu + ((u >> 16) & 1u)) >> 16; }
__device__ __forceinline__ unsigned pk2(float lo, float hi) { return pg8::cvt_pk_bf16(lo, hi); }
__device__ __forceinline__ float bflo(unsigned w) { return __builtin_bit_cast(float, w << 16); }
__device__ __forceinline__ float bfhi(unsigned w) { return __builtin_bit_cast(float, w & 0xffff0000u); }
__device__ __forceinline__ float wave_sum(float v) {
#pragma unroll
    for (int o = 1; o < 64; o <<= 1) v += __shfl_xor(v, o);
    return v;
}

#define XB_TMO      128
#define XB_XCNT(j)  (256  + 64 * (j))
#define XB_XSUB(j)  (1280 + 64 * (j))
#define XB_XGEN(j)  (2304 + 64 * (j))
#define XB_TOP      3328
#define XB_TOPGEN   3392
#define XCD_BAR_WORDS 3456
#define XB_SPIN_CAP (1u << 22)
__device__ __forceinline__ unsigned xb_ld(unsigned* p)              { return __hip_atomic_load(p, __ATOMIC_RELAXED, __HIP_MEMORY_SCOPE_AGENT); }
__device__ __forceinline__ unsigned xb_add(unsigned* p, unsigned v) { return __hip_atomic_fetch_add(p, v, __ATOMIC_RELAXED, __HIP_MEMORY_SCOPE_AGENT); }
__device__ __forceinline__ unsigned xb_xcc_id() { return (unsigned)__builtin_amdgcn_s_getreg((3 << 11) | 20) & 0xFu; }
#define XB_SPIN(cond, bar) do { unsigned _sp = 0; while (cond) { __builtin_amdgcn_s_sleep(1); \
    if ((++_sp & 255u) == 0u) { if (xb_ld(&(bar)[XB_TMO])) break; if (_sp > XB_SPIN_CAP) { atomicAdd(&(bar)[XB_TMO], 1u); break; } } } } while (0)
struct XcdBarrier { unsigned* bar; unsigned x; volatile LAS unsigned* st; };
__device__ __forceinline__ XcdBarrier xcd_barrier_post(unsigned* bar, volatile LAS unsigned* st) {
    XcdBarrier b; b.bar = bar; b.x = xb_xcc_id(); b.st = st;
    if (threadIdx.x == 0) (void)xb_add(&bar[XB_XCNT(b.x)], 1u);
    return b;
}
__device__ __forceinline__ void xcd_barrier_complete(unsigned* bar, unsigned x, unsigned& nloc, unsigned& nx) {
    const unsigned G = gridDim.x * gridDim.y * gridDim.z;
    unsigned sum, cnt, mine, sp = 0u;
    for (;;) {
        sum = 0u; cnt = 0u; mine = 0u;
#pragma unroll
        for (unsigned j = 0; j < 16; ++j) { const unsigned c = xb_ld(&bar[XB_XCNT(j)]); sum += c; cnt += (c > 0u) ? 1u : 0u; mine = (j == x) ? c : mine; }
        if (sum == G) break;
        __builtin_amdgcn_s_sleep(1);
        if ((++sp & 255u) == 0u) { if (xb_ld(&bar[XB_TMO])) break; if (sp > XB_SPIN_CAP) { atomicAdd(&bar[XB_TMO], 1u); break; } }
    }
    nloc = mine > 0u ? mine : 1u; nx = cnt > 0u ? cnt : 1u;
}
__device__ __forceinline__ void xcd_barrier(const XcdBarrier& b, const int tid) {
    asm volatile("s_waitcnt vmcnt(0)" ::: "memory");
    __syncthreads();
    if (tid == 0) {
        unsigned* bar = b.bar;
        __builtin_amdgcn_s_waitcnt(0);
        unsigned nloc = b.st[0], nx = b.st[1];
        if (nloc == 0u) { xcd_barrier_complete(bar, b.x, nloc, nx); b.st[0] = nloc; b.st[1] = nx; }
        const unsigned old = xb_add(&bar[XB_XSUB(b.x)], 1u);
        const unsigned gen = old / nloc;
        if (old + 1u == (gen + 1u) * nloc) {
            __builtin_amdgcn_fence(__ATOMIC_RELEASE, "agent");
            asm volatile("s_waitcnt vmcnt(0)" ::: "memory");
            const unsigned og = xb_add(&bar[XB_TOP], 1u);
            const unsigned tg = og / nx;
            if (og + 1u == (tg + 1u) * nx) xb_add(&bar[XB_TOPGEN], 1u);
            else XB_SPIN(xb_ld(&bar[XB_TOPGEN]) == tg, bar);
            __builtin_amdgcn_fence(__ATOMIC_ACQUIRE, "agent");
            xb_add(&bar[XB_XGEN(b.x)], 1u);
            asm volatile("s_waitcnt vmcnt(0)" ::: "memory");
        } else {
            XB_SPIN(xb_ld(&bar[XB_XGEN(b.x)]) == gen, bar);
            __builtin_amdgcn_fence(__ATOMIC_ACQUIRE, "agent");
            asm volatile("s_waitcnt vmcnt(0)" ::: "memory");
        }
    }
    __syncthreads();
}

constexpr int NWAVES = 8;
constexpr int RING_BYTES = 131072, MISC_OFF = RING_BYTES + 320, LNT_OFF = RING_BYTES + 2048  , LDS_BYTES = 147456;
struct Args { const float* in[24]; float* out; unsigned char* ws; int ph_lo, ph_hi; int chk, pad; };
struct Frame {
    LAS unsigned char* lds;
    gu32* ctl; unsigned char* ws; float* out;
    int tid, lane, wave, vcu, G;
    int chk, stage;
};

struct Job { const float* src; bf16* dst; int ld, K, N, mode, start; float scale; int fp8, pad; };
constexpr int NJOBS = 74;
__device__ __forceinline__ void make_job(const Args& a, int j, Job& J) {
    unsigned char* ws = a.ws; J.scale = 1.f; J.mode = 0; J.start = 0; J.fp8 = 0; J.pad = 0;
    if (j < 9) { const int g = j / 3, t = j % 3; J.src = a.in[4] + g * 3072 + t * 1024; J.ld = 9216; J.K = 1024; J.N = 1024;
        if (t == 2) J.dst = (bf16*)(ws + W_A_V + (size_t)g * 1024 * 1024); else J.dst = (bf16*)(ws + W_A_QK + (size_t)g * 2048 * 1024 + (size_t)t * 1024 * 1024);
        J.fp8 = 1; J.scale = (t == 0 ? QSCALE : 1.f) * WSCALE8; return; }
    j -= 9;
    if (j == 0) { J.src = a.in[5]; J.ld = 1024; J.K = 1024; J.N = 1024; J.dst = (bf16*)(ws + W_A_O); J.fp8 = 1; J.scale = WSCALE8; return; }
    if (j == 1) { J.src = a.in[6]; J.ld = 3072; J.K = 1024; J.N = 1024; J.dst = (bf16*)(ws + W_B_IN); return; }
    if (j == 9 || j == 10) { J.src = a.in[6] + 1024 * (j - 8); J.ld = 3072; J.K = 1024; J.N = 1024; J.dst = (bf16*)(ws + W_B_IN) + (size_t)1024 * 1024; J.mode = j - 8; return; }
    if (j == 2) { J.src = a.in[8]; J.ld = 1024; J.K = 1024; J.N = 1024; J.dst = (bf16*)(ws + W_B_O); return; }
    if (j == 3) { J.src = a.in[9]; J.ld = 3072; J.K = 1024; J.N = 1024; J.dst = (bf16*)(ws + W_C_QK); J.scale = QSCALE; return; }
    if (j == 4) { J.src = a.in[9] + 1024; J.ld = 3072; J.K = 1024; J.N = 1024; J.dst = (bf16*)(ws + W_C_QK) + (size_t)1024 * 1024; return; }
    if (j == 5) { J.src = a.in[9] + 2048; J.ld = 3072; J.K = 1024; J.N = 1024; J.dst = (bf16*)(ws + W_C_V); J.fp8 = 1; J.scale = WSCALE8; return; }
    if (j == 6) { J.src = a.in[10]; J.ld = 1024; J.K = 1024; J.N = 1024; J.dst = (bf16*)(ws + W_C_O); J.fp8 = 1; J.scale = WSCALE8; return; }
    if (j == 7) { J.src = a.in[11]; J.ld = 2048; J.K = 1024; J.N = 2048; J.dst = (bf16*)(ws + W_D_IN); return; }
    if (j == 8) { J.src = a.in[16]; J.ld = 1024; J.K = 1024; J.N = 1024; J.dst = (bf16*)(ws + W_D_O); return; }
    j -= 11;
    if (j < 6) { const int f = j / 3, t = j % 3;
        if (t < 2) { J.src = a.in[17 + t] + (size_t)f * 1024 * DFF; J.ld = DFF; J.K = 1024; J.N = DFF; J.dst = (bf16*)(ws + W_F_GU) + (size_t)f * 2 * DFF * 1024; J.mode = 1 + t;
            if (f == FFN_GU8) { J.fp8 = 1; J.scale = WSCALE8; } }
        else { J.src = a.in[19] + (size_t)f * DFF * 1024; J.ld = 1024; J.K = DFF; J.N = 1024; J.dst = (bf16*)(ws + W_F_D) + (size_t)f * 1024 * DFF; J.fp8 = 1; J.scale = WSCALE8D; }
        return; }
    j -= 6;
    { const int fe = j / 3, t = j % 3;
        if (t < 2) { J.src = a.in[21 + t] + (size_t)fe * 1024 * DFE; J.ld = DFE; J.K = 1024; J.N = DFE; J.dst = (bf16*)(ws + W_E_GU) + (size_t)fe * 2 * DFE * 1024; J.mode = 1 + t; J.fp8 = 1; J.scale = WSCALE8; }
        else { J.src = a.in[23] + (size_t)fe * DFE * 1024; J.ld = 1024; J.K = DFE; J.N = 1024; J.dst = (bf16*)(ws + W_E_D) + (size_t)fe * 1024 * DFE; J.fp8 = 1; J.scale = WSCALE8D; } }
}
__device__ __forceinline__ void transpose_item(const Job& J, int item, int lane) {
    const int nblk = J.N >> 6, kb = item / nblk, nb = item - kb * nblk, k0 = 64 * kb, n = 64 * nb + lane;
    const float* W = J.src + (size_t)k0 * J.ld + n;
    int r = n; if (J.mode) r = (n >> 7) * 256 + (n & 127) + (J.mode == 2 ? 128 : 0);
    const float sc = J.scale; const size_t ld = (size_t)J.ld;
    if (J.fp8) {
        unsigned char* dst8 = (unsigned char*)J.dst + (size_t)r * J.K + k0;
#pragma unroll
        for (int hf = 0; hf < 2; ++hf) {
            float v[32];
#pragma unroll
            for (int j = 0; j < 32; ++j) v[j] = W[(size_t)(32 * hf + j) * ld];
#pragma unroll
            for (int c = 0; c < 2; ++c) { u32x4 o; o.x = pk4_fp8(v[16 * c] * sc, v[16 * c + 1] * sc, v[16 * c + 2] * sc, v[16 * c + 3] * sc); o.y = pk4_fp8(v[16 * c + 4] * sc, v[16 * c + 5] * sc, v[16 * c + 6] * sc, v[16 * c + 7] * sc);
                o.z = pk4_fp8(v[16 * c + 8] * sc, v[16 * c + 9] * sc, v[16 * c + 10] * sc, v[16 * c + 11] * sc); o.w = pk4_fp8(v[16 * c + 12] * sc, v[16 * c + 13] * sc, v[16 * c + 14] * sc, v[16 * c + 15] * sc);
                *(u32x4*)(dst8 + 32 * hf + 16 * c) = o; }
        }
        return;
    }
    bf16* dst = J.dst + (size_t)r * J.K + k0;
#pragma unroll
    for (int hf = 0; hf < 2; ++hf) {
        float v[32];
#pragma unroll
        for (int j = 0; j < 32; ++j) v[j] = W[(size_t)(32 * hf + j) * ld];
#pragma unroll
        for (int c = 0; c < 4; ++c) { u32x4 o; o.x = pk2(v[8 * c] * sc, v[8 * c + 1] * sc); o.y = pk2(v[8 * c + 2] * sc, v[8 * c + 3] * sc); o.z = pk2(v[8 * c + 4] * sc, v[8 * c + 5] * sc); o.w = pk2(v[8 * c + 6] * sc, v[8 * c + 7] * sc);
            *(u32x4*)(dst + 32 * hf + 8 * c) = o; }
    }
}
__device__ __forceinline__ int t5_bucket(int d) {
    if (d < 16) return d;
    int b = 16 + (int)(log((double)d / 16.0) / log(128.0) * 16.0);
    return b < 16 ? 16 : (b > 31 ? 31 : b);
}
__device__ __forceinline__ void p_prologue(Frame& F, const Args& a) {
    unsigned char* gl_ = (unsigned char*)F.lds;
    Job* jobs = (Job*)(gl_ + 7 * 16384 + 8704);
    int* tot = (int*)(gl_ + 7 * 16384 + 8704 + NJOBS * sizeof(Job));
    static_assert(8704 + NJOBS * sizeof(Job) + 16 <= 16384, "job table fits");
    if (F.tid < NJOBS) { Job J; make_job(a, F.tid, J); jobs[F.tid] = J; }
    __syncthreads();
    if (F.tid == 0) { int s = 0; for (int j = 0; j < NJOBS; ++j) { jobs[j].start = s; s += (jobs[j].K / 64) * (jobs[j].N / 64); } tot[0] = s; }
    __syncthreads();
    const int total = tot[0];
    const int gw = F.vcu * NWAVES + F.wave, NGW = F.G * NWAVES;
    int jc = 0;
    for (int it = gw; it < total; it += NGW) {
        while (jc + 1 < NJOBS && jobs[jc + 1].start <= it) ++jc;
        const Job J = jobs[jc];
        transpose_item(J, it - J.start, F.lane);
    }
    { bf16* hb = (bf16*)(F.ws + WS_HB); const float* x = a.in[0]; unsigned char* hb8 = F.ws + WS_SCR + S_HB8;
      for (int m0 = 4 * gw; m0 < T; m0 += 4 * NGW) { f32x4 v[4][4];
#pragma unroll
          for (int k = 0; k < 4; ++k) { const f32x4* xr = (const f32x4*)(x + (size_t)(m0 + k) * D) + F.lane;
#pragma unroll
              for (int j = 0; j < 4; ++j) v[k][j] = xr[64 * j]; }
#pragma unroll
          for (int k = 0; k < 4; ++k) { unsigned long long* o8 = (unsigned long long*)(hb + (size_t)(m0 + k) * D) + F.lane;
#pragma unroll
              for (int j = 0; j < 4; ++j) o8[64 * j] = (unsigned long long)pk2(v[k][j].x, v[k][j].y) | ((unsigned long long)pk2(v[k][j].z, v[k][j].w) << 32);
              unsigned* o4 = (unsigned*)(hb8 + (size_t)(m0 + k) * D) + F.lane;
#pragma unroll
              for (int j = 0; j < 4; ++j) o4[64 * j] = pk4_fp8(v[k][j].x, v[k][j].y, v[k][j].z, v[k][j].w); } } }
    const int gt = blockIdx.x * 512 + F.tid, NGT = F.G * 512;
    const float* rel = a.in[1];
    float* btA = (float*)(F.ws + WS_BTABA); float* btC = (float*)(F.ws + WS_BTABC);
    for (int i = gt; i < 48 * 132; i += NGT) { const int gh = i / 132, dl = i % 132, g = gh >> 4, hh = gh & 15; const int dil = g == 0 ? 1 : (g == 1 ? 4 : 16);
        btA[i] = dl <= 128 ? rel[t5_bucket(dl * dil) * NH + hh] * LOG2E : 0.f; }
    for (int i = gt; i < 16 * 2048; i += NGT) { const int hh = i >> 11, dd = i & 2047; btC[i] = rel[t5_bucket(dd) * NH + hh] * LOG2E; }
    { bf16* wst = (bf16*)(F.ws + WS_WST); const float* wsrc = a.in[14];
      for (int i = gt; i < 8 * 128 * 128; i += NGT) { const int tt = (i >> 7) & 127, ss = i & 127; wst[i] = (bf16)f2bf(ss <= tt ? wsrc[i] : 0.f); } }
}

__device__ __forceinline__ void unpack8(const u32x4 a, float* x) { x[0] = bflo(a.x); x[1] = bfhi(a.x); x[2] = bflo(a.y); x[3] = bfhi(a.y); x[4] = bflo(a.z); x[5] = bfhi(a.z); x[6] = bflo(a.w); x[7] = bfhi(a.w); }
template <int MODE, bool ROUTE, bool FINAL, bool HB8 = false>
__device__ __forceinline__ void ln_phase(Frame& F, const float* gain, const float* bias, const float* wr) {
    constexpr int NBT = 2;
    const int gw = F.vcu * NWAVES + F.wave, NGW = F.G * NWAVES, lane = F.lane;
    bf16* hb = (bf16*)(F.ws + WS_HB); const bf16* zb = (const bf16*)F.out;
    float gv[16], bv[16];
#pragma unroll
    for (int k = 0; k < 2; ++k)
#pragma unroll
        for (int j = 0; j < 2; ++j) { const f32x4 g4 = *(const f32x4*)(gain + 512 * k + 8 * lane + 4 * j), b4 = *(const f32x4*)(bias + 512 * k + 8 * lane + 4 * j);
            gv[8 * k + 4 * j] = g4.x; gv[8 * k + 4 * j + 1] = g4.y; gv[8 * k + 4 * j + 2] = g4.z; gv[8 * k + 4 * j + 3] = g4.w;
            bv[8 * k + 4 * j] = b4.x; bv[8 * k + 4 * j + 1] = b4.y; bv[8 * k + 4 * j + 2] = b4.z; bv[8 * k + 4 * j + 3] = b4.w; }
    LAS float* wrT = (LAS float*)F.lds;
    if (ROUTE) { for (int i = F.tid; i < 8 * 1024; i += 512) { const int e = i >> 10, c = i & 1023; wrT[i] = wr[c * 8 + e]; } __syncthreads(); }
    const unsigned char* ys = F.ws + WS_SCR + S_XG;
    const int* slots = (const int*)(F.ws + WS_SLOTS); const float* gates = (const float*)(F.ws + WS_GATES);
    int* route = (int*)(F.ws + WS_ROUTE); float* gout = (float*)(F.ws + WS_GATES);
    for (int grp = gw; grp < T / 32; grp += NGW) {
        int cnt_e = 0;
        int my_e1 = 0, my_e2 = 0, my_r1 = 0, my_r2 = 0; float my_g1 = 0.f, my_g2 = 0.f;
        int sl0 = 0, sl1 = 0; float gg0 = 0.f, gg1 = 0.f;
        if (MODE == 2) { const int mm = grp * 32 + (lane & 31); sl0 = slots[2 * mm]; sl1 = slots[2 * mm + 1]; gg0 = gates[2 * mm]; gg1 = gates[2 * mm + 1]; }
        for (int i0 = 0; i0 < 32; i0 += NBT) {
            float v[NBT][16]; float st[NBT][2];
#pragma unroll
            for (int k = 0; k < NBT; ++k) { const int m = grp * 32 + i0 + k;
                if (MODE == 0) { const u32x4* zr = (const u32x4*)(zb + (size_t)m * D) + lane; unpack8(zr[0], v[k]); unpack8(zr[64], v[k] + 8); }
                else { const u32x4* hr = (const u32x4*)(hb + (size_t)m * D) + lane; unpack8(hr[0], v[k]); unpack8(hr[64], v[k] + 8);
#pragma unroll
                    for (int j = 0; j < 16; ++j) v[k][j] *= ALPHA;
                    if (MODE == 3) { const u32x4* yr = (const u32x4*)((const bf16*)(F.ws + WS_SCR + S_Y) + (size_t)m * D) + lane; float a[16]; unpack8(yr[0], a); unpack8(yr[64], a + 8);
#pragma unroll
                        for (int j = 0; j < 16; ++j) v[k][j] += a[j]; }
                    if (MODE == 2) { const int s0 = __builtin_amdgcn_readlane(sl0, i0 + k), s1 = __builtin_amdgcn_readlane(sl1, i0 + k);
                        const float g0 = __builtin_bit_cast(float, __builtin_amdgcn_readlane(__builtin_bit_cast(int, gg0), i0 + k)), g1 = __builtin_bit_cast(float, __builtin_amdgcn_readlane(__builtin_bit_cast(int, gg1), i0 + k));
                        const u32x2* y0 = (const u32x2*)(ys + (size_t)s0 * D) + lane; const u32x2* y1 = (const u32x2*)(ys + (size_t)s1 * D) + lane;
                        const u32x2 ya0 = y0[0], ya1 = y0[64], yb0 = y1[0], yb1 = y1[64];
                        float a[16], b[16];
#pragma unroll
                        for (int c = 0; c < 2; ++c) { const unsigned wa0 = c ? ya0.y : ya0.x, wa1 = c ? ya1.y : ya1.x, wb0 = c ? yb0.y : yb0.x, wb1 = c ? yb1.y : yb1.x;
                            f32x2 t;
                            t = __builtin_amdgcn_cvt_pk_f32_fp8((int)wa0, false); a[4 * c] = t.x; a[4 * c + 1] = t.y; t = __builtin_amdgcn_cvt_pk_f32_fp8((int)wa0, true); a[4 * c + 2] = t.x; a[4 * c + 3] = t.y;
                            t = __builtin_amdgcn_cvt_pk_f32_fp8((int)wa1, false); a[8 + 4 * c] = t.x; a[8 + 4 * c + 1] = t.y; t = __builtin_amdgcn_cvt_pk_f32_fp8((int)wa1, true); a[8 + 4 * c + 2] = t.x; a[8 + 4 * c + 3] = t.y;
                            t = __builtin_amdgcn_cvt_pk_f32_fp8((int)wb0, false); b[4 * c] = t.x; b[4 * c + 1] = t.y; t = __builtin_amdgcn_cvt_pk_f32_fp8((int)wb0, true); b[4 * c + 2] = t.x; b[4 * c + 3] = t.y;
                            t = __builtin_amdgcn_cvt_pk_f32_fp8((int)wb1, false); b[8 + 4 * c] = t.x; b[8 + 4 * c + 1] = t.y; t = __builtin_amdgcn_cvt_pk_f32_fp8((int)wb1, true); b[8 + 4 * c + 2] = t.x; b[8 + 4 * c + 3] = t.y; }
                        const float h0 = g0 * (1.f / YSCALE8), h1 = g1 * (1.f / YSCALE8);
#pragma unroll
                        for (int j = 0; j < 16; ++j) v[k][j] += h0 * a[j] + h1 * b[j]; } }
                float s = 0.f, q2 = 0.f;
#pragma unroll
                for (int j = 0; j < 16; ++j) { s += v[k][j]; q2 += v[k][j] * v[k][j]; }
                st[k][0] = s; st[k][1] = q2; }
#pragma unroll
            for (int o = 1; o < 64; o <<= 1) {
#pragma unroll
                for (int k = 0; k < NBT; ++k) { st[k][0] += __shfl_xor(st[k][0], o); st[k][1] += __shfl_xor(st[k][1], o); } }
#pragma unroll
            for (int k = 0; k < NBT; ++k) { const int m = grp * 32 + i0 + k;
                const float mean = st[k][0] * (1.f / D), var = fmaxf(st[k][1] * (1.f / D) - mean * mean, 0.f), rstd = 1.f / sqrtf(var + LN_EPS);
#pragma unroll
                for (int j = 0; j < 16; ++j) v[k][j] = (v[k][j] - mean) * rstd * gv[j] + bv[j];
                if (FINAL) { f32x4* orow = (f32x4*)(F.out + (size_t)m * D) + 2 * lane;
                    orow[0] = (f32x4){v[k][0], v[k][1], v[k][2], v[k][3]}; orow[1] = (f32x4){v[k][4], v[k][5], v[k][6], v[k][7]}; orow[128] = (f32x4){v[k][8], v[k][9], v[k][10], v[k][11]}; orow[129] = (f32x4){v[k][12], v[k][13], v[k][14], v[k][15]}; }
                else { u32x4* o = (u32x4*)(hb + (size_t)m * D) + lane; u32x4 a, b;
                    a.x = pk2(v[k][0], v[k][1]); a.y = pk2(v[k][2], v[k][3]); a.z = pk2(v[k][4], v[k][5]); a.w = pk2(v[k][6], v[k][7]); b.x = pk2(v[k][8], v[k][9]); b.y = pk2(v[k][10], v[k][11]); b.z = pk2(v[k][12], v[k][13]); b.w = pk2(v[k][14], v[k][15]);
                    o[0] = a; o[64] = b;
                    if (HB8) { u32x2* o8 = (u32x2*)(F.ws + WS_SCR + S_HB8 + (size_t)m * D) + lane; u32x2 c, d;
                        c.x = pk4_fp8(v[k][0], v[k][1], v[k][2], v[k][3]); c.y = pk4_fp8(v[k][4], v[k][5], v[k][6], v[k][7]); d.x = pk4_fp8(v[k][8], v[k][9], v[k][10], v[k][11]); d.y = pk4_fp8(v[k][12], v[k][13], v[k][14], v[k][15]);
                        o8[0] = c; o8[64] = d; } }
                if (ROUTE) {
                    float lg[8];
#pragma unroll
                    for (int e = 0; e < 8; ++e) { float p = 0.f;
#pragma unroll
                        for (int kk = 0; kk < 2; ++kk)
#pragma unroll
                            for (int j = 0; j < 2; ++j) { const f32x4 w4 = *(const LAS f32x4*)(wrT + e * 1024 + 512 * kk + 8 * lane + 4 * j); p += (v[k][8 * kk + 4 * j] * w4.x + v[k][8 * kk + 4 * j + 1] * w4.y) + (v[k][8 * kk + 4 * j + 2] * w4.z + v[k][8 * kk + 4 * j + 3] * w4.w); }
                        lg[e] = p; }
#pragma unroll
                    for (int o = 1; o < 64; o <<= 1) {
#pragma unroll
                        for (int e = 0; e < 8; ++e) lg[e] += __shfl_xor(lg[e], o); }
                    int e1 = 0; float v1 = lg[0];
#pragma unroll
                    for (int e = 1; e < 8; ++e) if (lg[e] > v1) { v1 = lg[e]; e1 = e; }
                    int e2 = -1; float v2 = -3.4e38f;
#pragma unroll
                    for (int e = 0; e < 8; ++e) if (e != e1 && lg[e] > v2) { v2 = lg[e]; e2 = e; }
                    const float g2 = 1.f / (1.f + __expf(v1 - v2)), g1 = 1.f - g2;
                    const int r1 = __shfl(cnt_e, e1); if (lane == e1) ++cnt_e;
                    const int r2 = __shfl(cnt_e, e2); if (lane == e2) ++cnt_e;
                    if (lane == i0 + k) { my_e1 = e1; my_e2 = e2; my_r1 = r1; my_r2 = r2; my_g1 = g1; my_g2 = g2; }
                }
            }
        }
        if (ROUTE) {
            if (lane < 8) ((int*)(F.ws + WS_WCNT))[grp * 8 + lane] = cnt_e;
            if (lane < 32) { const int m = grp * 32 + lane; int* r = route + 4 * m; r[0] = my_e1; r[1] = my_r1; r[2] = my_e2; r[3] = my_r2; gout[2 * m] = my_g1; gout[2 * m + 1] = my_g2; }
        }
    }
}

__device__ __forceinline__ f32x16 mfma32(bf16x8 a, bf16x8 b, f32x16 c) { return __builtin_amdgcn_mfma_f32_32x32x16_bf16(a, b, c, 0, 0, 0); }
__device__ __forceinline__ bf16x8 pack8(const f32x16& s, int b0) {
    u32x4 w; w.x = pg8::cvt_pk_bf16(s[b0], s[b0 + 1]); w.y = pg8::cvt_pk_bf16(s[b0 + 2], s[b0 + 3]); w.z = pg8::cvt_pk_bf16(s[b0 + 4], s[b0 + 5]); w.w = pg8::cvt_pk_bf16(s[b0 + 6], s[b0 + 7]);
    return __builtin_bit_cast(bf16x8, w);
}
__device__ __forceinline__ float max16(const f32x16& s) {
    float a = fmaxf(fmaxf(s[0], s[1]), fmaxf(s[2], s[3])), b = fmaxf(fmaxf(s[4], s[5]), fmaxf(s[6], s[7]));
    float c = fmaxf(fmaxf(s[8], s[9]), fmaxf(s[10], s[11])), d = fmaxf(fmaxf(s[12], s[13]), fmaxf(s[14], s[15]));
    return fmaxf(fmaxf(a, b), fmaxf(c, d));
}
__device__ __forceinline__ void softmax_pv(f32x16& s, float& m_run, float& l_run, f32x16& o0, f32x16& o1, const bf16* vt0, const bf16* vt1, int h) {
    float mx = max16(s); mx = fmaxf(mx, __shfl_xor(mx, 32));
    const float mn = fmaxf(m_run, mx), alpha = __builtin_amdgcn_exp2f(m_run - mn); m_run = mn;
    float ps = 0.f;
#pragma unroll
    for (int r = 0; r < 16; ++r) { const float p = __builtin_amdgcn_exp2f(s[r] - mn); s[r] = p; ps += p; }
    l_run = l_run * alpha + ps;
#pragma unroll
    for (int r = 0; r < 16; ++r) { o0[r] *= alpha; o1[r] *= alpha; }
    const bf16x8 p0 = pack8(s, 0), p1 = pack8(s, 8);
    const bf16x8 v00 = *(const bf16x8*)(vt0 + 8 * h), v01 = *(const bf16x8*)(vt0 + 16 + 8 * h), v10 = *(const bf16x8*)(vt1 + 8 * h), v11 = *(const bf16x8*)(vt1 + 16 + 8 * h);
    o0 = mfma32(v00, p0, o0); o0 = mfma32(v01, p1, o0);
    o1 = mfma32(v10, p0, o1); o1 = mfma32(v11, p1, o1);
}
__device__ __forceinline__ int kperm(int i) { return (i & 19) | ((i & 8) >> 1) | ((i & 4) << 1); }

__device__ __forceinline__ void dil_attn_phase(Frame& F) {
    LAS float* bt = (LAS float*)F.lds;
    { const float* btA = (const float*)(F.ws + WS_BTABA); for (int i = F.tid; i < 48 * 192; i += 512) { const int gh = i / 192, dl = i % 192 - 32; bt[i] = (dl >= 0 && dl <= 128) ? btA[gh * 132 + dl] : NEGB; } }
    __syncthreads();
    const int gw = F.vcu * NWAVES + F.wave, NGW = F.G * NWAVES, lane = F.lane, q = lane & 31, h = lane >> 5;
    const bf16* QK = (const bf16*)(F.ws + WS_SCR + S_QK); const bf16* VT = (const bf16*)(F.ws + WS_SCR + S_VT);
    bf16* OG = (bf16*)((unsigned char*)F.out + O_OG); float* LSE = (float*)((unsigned char*)F.out + O_LSE);
    constexpr int NTASK = 3 * 16 * 8 * 64;
    const int per = (NTASK + NGW - 1) / NGW;
    const int t_lo = gw * per, t_hi = (t_lo + per) < NTASK ? (t_lo + per) : NTASK;
    for (int task = t_lo; task < t_hi; ++task) {
        const int qt = task & 3, rn = (task >> 2) & 15, bl = (task >> 6) & 7, gh = task >> 9, g = gh >> 4, hh = gh & 15;
        const int nblk = 16 >> (2 * g); const bool has_prev = (rn & (nblk - 1)) != 0;
        const int n0 = bl * 2048 + rn * 128;
        const bf16* qrow = QK + ((size_t)g * TC + n0 + 32 * qt + q) * 2048 + hh * 64;
        bf16x8 qf[4];
#pragma unroll
        for (int d0 = 0; d0 < 4; ++d0) qf[d0] = *(const bf16x8*)(qrow + d0 * 16 + 8 * h);
        float m_run = NEGB, l_run = 0.f; f32x16 o0 = {}, o1 = {};
        const bf16* vbase0 = VT + ((size_t)g * 1024 + hh * 64 + q) * TC; const bf16* vbase1 = vbase0 + (size_t)32 * TC;
        const LAS float* btl = bt + gh * 192 + (q - 8 * h + 137);
#pragma unroll
        for (int t = 0; t < 5; ++t) {
            if (has_prev || qt + t > 3) {
                const int kr0 = n0 - 128 + 32 * qt + 32 * t;
                const bf16* krow = QK + ((size_t)g * TC + kr0 + kperm(q)) * 2048 + 1024 + hh * 64;
                f32x16 s;
#pragma unroll
                for (int r = 0; r < 16; ++r) s[r] = btl[-32 * t + 23 - 16 * (r >> 3) - (r & 7)];
#pragma unroll
                for (int d0 = 0; d0 < 4; ++d0) { const bf16x8 kf = *(const bf16x8*)(krow + d0 * 16 + 8 * h); s = mfma32(kf, qf[d0], s); }
                softmax_pv(s, m_run, l_run, o0, o1, vbase0 + kr0, vbase1 + kr0, h);
            }
        }
        const float l_tot = l_run + __shfl_xor(l_run, 32), inv = 1.f / l_tot;
        const size_t orow = (size_t)g * TC + n0 + 32 * qt + q;
        bf16* op = OG + orow * 1024 + hh * 64 + 4 * h;
#pragma unroll
        for (int gq = 0; gq < 4; ++gq) {
            u32x2 w0, w1; w0.x = pg8::cvt_pk_bf16(o0[4 * gq] * inv, o0[4 * gq + 1] * inv); w0.y = pg8::cvt_pk_bf16(o0[4 * gq + 2] * inv, o0[4 * gq + 3] * inv);
            w1.x = pg8::cvt_pk_bf16(o1[4 * gq] * inv, o1[4 * gq + 1] * inv); w1.y = pg8::cvt_pk_bf16(o1[4 * gq + 2] * inv, o1[4 * gq + 3] * inv);
            *(u32x2*)(op + 8 * gq) = w0; *(u32x2*)(op + 32 + 8 * gq) = w1; }
        if (h == 0) LSE[orow * 16 + hh] = m_run + __log2f(l_tot);
    }
}
__device__ __forceinline__ void dil_merge_phase(Frame& F, int ck) {
    const int gw = F.vcu * NWAVES + F.wave, NGW = F.G * NWAVES, lane = F.lane;
    const bf16* OG = (const bf16*)((unsigned char*)F.out + O_OG); const float* LSE = (const float*)((unsigned char*)F.out + O_LSE);
    unsigned char* att = F.ws + WS_SCR + S_ATT + (size_t)ck * TC * 1024;
    const int hh = lane >> 2;
    for (int tl0 = 2 * gw; tl0 < TC; tl0 += 2 * NGW) {
        size_t n[2][3]; float ls[2][3]; u32x4 x[2][3];
#pragma unroll
        for (int k = 0; k < 2; ++k) { const int tl = tl0 + k, bl = tl >> 11, tt = tl & 2047;
            n[k][0] = tl; n[k][1] = bl * 2048 + (tt & 3) * 512 + (tt >> 2); n[k][2] = bl * 2048 + (tt & 15) * 128 + (tt >> 4);
#pragma unroll
            for (int g = 0; g < 3; ++g) { ls[k][g] = LSE[((size_t)g * TC + n[k][g]) * 16 + hh]; x[k][g] = *(const u32x4*)((const unsigned char*)OG + ((size_t)g * TC + n[k][g]) * 1024 + 16 * lane); } }
#pragma unroll
        for (int k = 0; k < 2; ++k) {
            const float M = fmaxf(fmaxf(ls[k][0], ls[k][1]), ls[k][2]);
            float w[3]; float W = 0.f;
#pragma unroll
            for (int g = 0; g < 3; ++g) { w[g] = __builtin_amdgcn_exp2f(ls[k][g] - M); W += w[g]; }
            const float iw = 1.f / W;
            float acc[16];
#pragma unroll
            for (int j = 0; j < 16; ++j) acc[j] = 0.f;
#pragma unroll
            for (int g = 0; g < 3; ++g) { const float wg = w[g] * iw; float a[16];
#pragma unroll
                for (int c = 0; c < 4; ++c) { const f32x2 lo = __builtin_amdgcn_cvt_pk_f32_fp8((int)x[k][g][c], false), hi = __builtin_amdgcn_cvt_pk_f32_fp8((int)x[k][g][c], true); a[4 * c] = lo.x; a[4 * c + 1] = lo.y; a[4 * c + 2] = hi.x; a[4 * c + 3] = hi.y; }
#pragma unroll
                for (int j = 0; j < 16; ++j) acc[j] += wg * a[j]; }
            u32x4 y; y.x = pk4_fp8(acc[0], acc[1], acc[2], acc[3]); y.y = pk4_fp8(acc[4], acc[5], acc[6], acc[7]); y.z = pk4_fp8(acc[8], acc[9], acc[10], acc[11]); y.w = pk4_fp8(acc[12], acc[13], acc[14], acc[15]);
            *(u32x4*)(att + (size_t)(tl0 + k) * 1024 + 16 * lane) = y;
        }
    }
}

__device__ __forceinline__ void conv_phase(Frame& F, const float* cw) {
    const int gw = F.vcu * NWAVES + F.wave, NGW = F.G * NWAVES, lane = F.lane;
    const bf16* gbp = (const bf16*)(F.ws + WS_SCR + S_BCX); const bf16* up = (const bf16*)(F.ws + WS_SCR + S_BCX + (size_t)128 * MiB); bf16* p = (bf16*)(F.ws + WS_SCR + S_P);
    for (int item = gw; item < (T / 32) * 2; item += NGW) {
        const int half = item & 1, tb = item >> 1, t0 = tb * 32, c0 = half * 512 + lane * 8;
        float w0[8], w1[8], w2[8];
#pragma unroll
        for (int j = 0; j < 8; ++j) { w0[j] = cw[c0 + j]; w1[j] = cw[1024 + c0 + j]; w2[j] = cw[2048 + c0 + j]; }
        float u1[8], u2[8];
        const bool first = (t0 & 2047) == 0;
#pragma unroll
        for (int j = 0; j < 8; ++j) { u1[j] = 0.f; u2[j] = 0.f; }
        if (!first) { unpack8(*(const u32x4*)(up + (size_t)(t0 - 2) * 1024 + c0), u2); unpack8(*(const u32x4*)(up + (size_t)(t0 - 1) * 1024 + c0), u1); }
        for (int i = 0; i < 32; ++i) { const size_t r = (size_t)(t0 + i) * 1024;
            const u32x4 gb = *(const u32x4*)(gbp + r + c0), uu = *(const u32x4*)(up + r + c0);
            float u0[8], b[8]; unpack8(uu, u0); unpack8(gb, b);
            float o[8];
#pragma unroll
            for (int j = 0; j < 8; ++j) { o[j] = b[j] * (w0[j] * u2[j] + w1[j] * u1[j] + w2[j] * u0[j]); u2[j] = u1[j]; u1[j] = u0[j]; }
            u32x4 x; x.x = pk2(o[0], o[1]); x.y = pk2(o[2], o[3]); x.z = pk2(o[4], o[5]); x.w = pk2(o[6], o[7]);
            *(u32x4*)(p + (size_t)(t0 + i) * 1024 + c0) = x; }
    }
}

__device__ __forceinline__ void kmean_phase(Frame& F) {
    const int gw = F.vcu * NWAVES + F.wave, NGW = F.G * NWAVES, lane = F.lane;
    const bf16* QK = (const bf16*)(F.ws + WS_SCR + S_CQK); float* km = (float*)(F.ws + WS_KMEAN);
    const int kq = lane >> 3, dc = lane & 7;
    for (int u = gw; u < NB * NH * 8; u += NGW) { const int blk = u & 7, hh = (u >> 3) & 15, b = u >> 7;
        float a[8];
#pragma unroll
        for (int j = 0; j < 8; ++j) a[j] = 0.f;
        const bf16* kp = QK + ((size_t)b * SEQ + blk * 256 + kq) * 2048 + 1024 + hh * 64 + dc * 8;
#pragma unroll 8
        for (int i = 0; i < 32; ++i) { const u32x4 x = *(const u32x4*)(kp + (size_t)i * 8 * 2048);
            a[0] += bflo(x.x); a[1] += bfhi(x.x); a[2] += bflo(x.y); a[3] += bfhi(x.y); a[4] += bflo(x.z); a[5] += bfhi(x.z); a[6] += bflo(x.w); a[7] += bfhi(x.w); }
#pragma unroll
        for (int j = 0; j < 8; ++j) { a[j] += __shfl_xor(a[j], 8); a[j] += __shfl_xor(a[j], 16); a[j] += __shfl_xor(a[j], 32); }
        if (lane < 8) { float* o = km + (size_t)u * 64 + lane * 8;
#pragma unroll
            for (int j = 0; j < 8; ++j) o[j] = a[j] * (1.f / 256.f); }
    }
}
__device__ __forceinline__ void moba_unit(Frame& F, int b, int hh, int nb, LAS float* bt, int& cur_h) {
    const int lane = F.lane, q = lane & 31, h = lane >> 5, w = F.wave;
    const bf16* QK = (const bf16*)(F.ws + WS_SCR + S_CQK); const bf16* VT = (const bf16*)(F.ws + WS_SCR + S_CVT);
    bf16* att = (bf16*)(F.ws + WS_SCR + S_CATT); const float* km = (const float*)(F.ws + WS_KMEAN);
    if (hh != cur_h) { __syncthreads(); const float* btC = (const float*)(F.ws + WS_BTABC) + hh * 2048; for (int i = F.tid; i < 2048; i += 512) bt[i] = btC[i]; cur_h = hh; __syncthreads(); }
    const size_t tq = (size_t)b * SEQ + nb * 256 + 32 * w + q;
    const bf16* qrow = QK + tq * 2048 + hh * 64;
    bf16x8 qf[4];
#pragma unroll
    for (int d0 = 0; d0 < 4; ++d0) qf[d0] = *(const bf16x8*)(qrow + d0 * 16 + 8 * h);
    unsigned sel = 0;
    if (nb > 0) {
        float gsc[7];
#pragma unroll
        for (int m = 0; m < 7; ++m) { float s = 0.f;
            if (m < nb) { const float* kmp = km + (((size_t)b * NH + hh) * 8 + m) * 64;
#pragma unroll
                for (int d0 = 0; d0 < 4; ++d0) { const f32x4 k0 = *(const f32x4*)(kmp + d0 * 16 + 8 * h), k1 = *(const f32x4*)(kmp + d0 * 16 + 8 * h + 4); const u32x4 qq = __builtin_bit_cast(u32x4, qf[d0]);
                    s += bflo(qq.x) * k0.x + bfhi(qq.x) * k0.y + bflo(qq.y) * k0.z + bfhi(qq.y) * k0.w + bflo(qq.z) * k1.x + bfhi(qq.z) * k1.y + bflo(qq.w) * k1.z + bfhi(qq.w) * k1.w; }
                s += __shfl_xor(s, 32); }
            gsc[m] = m < nb ? s : -3.0e38f; }
        const int nsel = nb < 3 ? nb : 3;
#pragma unroll
        for (int r = 0; r < 3; ++r) { if (r < nsel) { int bi = -1; float bv = -3.4e38f;
#pragma unroll
                for (int m = 0; m < 7; ++m) if (!((sel >> m) & 1u) && gsc[m] > bv) { bv = gsc[m]; bi = m; }
                sel |= 1u << bi; } }
    }
#ifdef MK_SELFCHECK
    if (h == 0) ((unsigned*)(F.ws + WS_NEED + 3 * MiB))[tq * 16 + hh] = sel;
#endif
    float m_run = NEGB, l_run = 0.f; f32x16 o0 = {}, o1 = {};
    const bf16* vbase0 = VT + ((size_t)hh * 64 + q) * T + (size_t)b * SEQ; const bf16* vbase1 = vbase0 + (size_t)32 * T;
    const int qpos = nb * 256 + 32 * w + q;
    for (int m = 0; m < nb; ++m) {
        const bool mine = (sel >> m) & 1u;
        if (__ballot(mine) == 0ull) continue;
        for (int kt = 0; kt < 8; ++kt) {
            const int kr0 = m * 256 + 32 * kt;
            const bf16* krow = QK + ((size_t)b * SEQ + kr0 + kperm(q)) * 2048 + 1024 + hh * 64;
            f32x16 s = {};
#pragma unroll
            for (int d0 = 0; d0 < 4; ++d0) { const bf16x8 kf = *(const bf16x8*)(krow + d0 * 16 + 8 * h); s = mfma32(kf, qf[d0], s); }
#pragma unroll
            for (int r = 0; r < 16; ++r) { const int kap = 16 * (r >> 3) + 8 * h + (r & 7); const float bb = bt[qpos - kr0 - kap]; s[r] = mine ? s[r] + bb : NEGB; }
            softmax_pv(s, m_run, l_run, o0, o1, vbase0 + kr0, vbase1 + kr0, h);
        }
    }
    for (int kt = 0; kt <= w; ++kt) {
        const int kr0 = nb * 256 + 32 * kt;
        const bf16* krow = QK + ((size_t)b * SEQ + kr0 + kperm(q)) * 2048 + 1024 + hh * 64;
        f32x16 s = {};
#pragma unroll
        for (int d0 = 0; d0 < 4; ++d0) { const bf16x8 kf = *(const bf16x8*)(krow + d0 * 16 + 8 * h); s = mfma32(kf, qf[d0], s); }
#pragma unroll
        for (int r = 0; r < 16; ++r) { const int kap = 16 * (r >> 3) + 8 * h + (r & 7); const int dd = qpos - kr0 - kap; const float bb = bt[dd < 0 ? 0 : dd]; s[r] = dd >= 0 ? s[r] + bb : NEGB; }
        softmax_pv(s, m_run, l_run, o0, o1, vbase0 + kr0, vbase1 + kr0, h);
    }
    const float l_tot = l_run + __shfl_xor(l_run, 32), inv = 1.f / l_tot;
#ifdef MK_SELFCHECK
    if (h == 0) ((float*)(F.ws + WS_NEED + 7 * MiB))[tq * 16 + hh] = m_run + __log2f(l_tot);
#endif
    bf16* op = att + tq * 1024 + hh * 64 + 4 * h;
#pragma unroll
    for (int gq = 0; gq < 4; ++gq) {
        u32x2 w0, w1; w0.x = pg8::cvt_pk_bf16(o0[4 * gq] * inv, o0[4 * gq + 1] * inv); w0.y = pg8::cvt_pk_bf16(o0[4 * gq + 2] * inv, o0[4 * gq + 3] * inv);
        w1.x = pg8::cvt_pk_bf16(o1[4 * gq] * inv, o1[4 * gq + 1] * inv); w1.y = pg8::cvt_pk_bf16(o1[4 * gq + 2] * inv, o1[4 * gq + 3] * inv);
        *(u32x2*)(op + 8 * gq) = w0; *(u32x2*)(op + 32 + 8 * gq) = w1; }
}
__device__ __forceinline__ void moba_phase(Frame& F) {
    LAS float* bt = (LAS float*)F.lds; int cur_h = -1;
    const int NP = NB * NH * 4, per = (NP + F.G - 1) / F.G;
    const int lo = F.vcu * per, hi = (lo + per) < NP ? (lo + per) : NP;
    for (int pu = lo; pu < hi; ++pu) { const int j = pu & 3, hh = (pu >> 2) & 15, b = pu >> 6;
        moba_unit(F, b, hh, 7 - j, bt, cur_h); moba_unit(F, b, hh, j, bt, cur_h); }
}


constexpr int AKP = 72;
constexpr int ATILE = 64 * AKP * 2;
struct AttnSt { float m, l; f32x16 o0, o1; };
template <bool MASKED>
__device__ __forceinline__ void attn_tile(const LAS bf16* Kt, const LAS bf16* Vt, const LAS float* bl, const bf16x8 (&qf)[4], AttnSt& st, int q, int h, bool mine) {
    f32x16 s;
#pragma unroll
    for (int r = 0; r < 16; ++r) s[r] = bl[23 - 16 * (r >> 3) - (r & 7)];
    const LAS bf16* kr = Kt + kperm(q) * AKP + 8 * h;
#pragma unroll
    for (int d0 = 0; d0 < 4; ++d0) s = mfma32(*(const LAS bf16x8*)(kr + d0 * 16), qf[d0], s);
    float mx = max16(s); mx = fmaxf(mx, __shfl_xor(mx, 32));
    float mn = fmaxf(st.m, mx); if (MASKED) mn = mine ? mn : st.m;
    const float alpha = __builtin_amdgcn_exp2f(st.m - mn);
    float ps = 0.f;
#pragma unroll
    for (int r = 0; r < 16; ++r) { const float p = __builtin_amdgcn_exp2f(s[r] - mn); s[r] = p; ps += p; }
    bf16x8 p0 = pack8(s, 0), p1 = pack8(s, 8);
    if (MASKED) { if (!mine) { p0 = (bf16x8){0, 0, 0, 0, 0, 0, 0, 0}; p1 = p0; ps = 0.f; } }
    st.l = st.l * alpha + ps; st.m = mn;
    if (__ballot(alpha != 1.0f) != 0ull) {
#pragma unroll
        for (int r = 0; r < 16; ++r) { st.o0[r] *= alpha; st.o1[r] *= alpha; } }
    const LAS bf16* v0 = Vt + q * AKP + 8 * h; const LAS bf16* v1 = v0 + 32 * AKP;
    st.o0 = mfma32(*(const LAS bf16x8*)v0, p0, st.o0); st.o0 = mfma32(*(const LAS bf16x8*)(v0 + 16), p1, st.o0);
    st.o1 = mfma32(*(const LAS bf16x8*)v1, p0, st.o1); st.o1 = mfma32(*(const LAS bf16x8*)(v1 + 16), p1, st.o1);
}
__device__ __forceinline__ void attn_store(const AttnSt& st, bf16* op  , float inv) {
#pragma unroll
    for (int gq = 0; gq < 4; ++gq) {
        u32x2 w0, w1; w0.x = pg8::cvt_pk_bf16(st.o0[4 * gq] * inv, st.o0[4 * gq + 1] * inv); w0.y = pg8::cvt_pk_bf16(st.o0[4 * gq + 2] * inv, st.o0[4 * gq + 3] * inv);
        w1.x = pg8::cvt_pk_bf16(st.o1[4 * gq] * inv, st.o1[4 * gq + 1] * inv); w1.y = pg8::cvt_pk_bf16(st.o1[4 * gq + 2] * inv, st.o1[4 * gq + 3] * inv);
        *(u32x2*)(op + 8 * gq) = w0; *(u32x2*)(op + 32 + 8 * gq) = w1; }
}

__device__ __forceinline__ void attn_store8(const AttnSt& st, unsigned char* op  , float inv) {
#pragma unroll
    for (int gq = 0; gq < 4; ++gq) {
        *(unsigned*)(op + 8 * gq) = pk4_fp8(st.o0[4 * gq] * inv, st.o0[4 * gq + 1] * inv, st.o0[4 * gq + 2] * inv, st.o0[4 * gq + 3] * inv);
        *(unsigned*)(op + 32 + 8 * gq) = pk4_fp8(st.o1[4 * gq] * inv, st.o1[4 * gq + 1] * inv, st.o1[4 * gq + 2] * inv, st.o1[4 * gq + 3] * inv); }
}

__device__ __forceinline__ void dil_attn_phase2(Frame& F) {
    LAS float* bt = (LAS float*)F.lds;
    { const float* btA = (const float*)(F.ws + WS_BTABA); for (int i = F.tid; i < 48 * 192; i += 512) { const int gh = i / 192, dl = i % 192 - 32; bt[i] = (dl >= 0 && dl <= 128) ? btA[gh * 132 + dl] : NEGB; } }
    __syncthreads();
    constexpr int TBL = 48 * 192 * 4;
    const int lane = F.lane, q = lane & 31, h = lane >> 5, w = F.wave, uw = w >> 2, qt = w & 3, t = F.tid, tu = t >> 8, tt = t & 255, srow = tt >> 3, sch = tt & 7;
    const bf16* QK = (const bf16*)(F.ws + WS_SCR + S_QK); const bf16* VT = (const bf16*)(F.ws + WS_SCR + S_VT);
    bf16* OG = (bf16*)((unsigned char*)F.out + O_OG); float* LSE = (float*)((unsigned char*)F.out + O_LSE);
    for (int du = F.vcu; du < 3072; du += F.G) {
        const int g = du >> 10, rem = du & 1023, hh = rem >> 6, blp = (rem >> 4) & 3, rn = rem & 15, gh = g * 16 + hh;
        const int nblk = 16 >> (2 * g); const bool has_prev = (rn & (nblk - 1)) != 0;
        const int j0 = has_prev ? 0 : 2;
        const int n0s = (2 * blp + tu) * 2048 + rn * 128;
        const bf16* ksrc = QK + ((size_t)g * TC + n0s - 128 + srow) * 2048 + 1024 + hh * 64 + sch * 8;
        const bf16* vsrc = VT + ((size_t)g * 1024 + hh * 64 + srow) * TC + (n0s - 128) + sch * 8;
        const int sdst = srow * AKP + sch * 8;
        const int n0 = (2 * blp + uw) * 2048 + rn * 128;
        const bf16* qrow = QK + ((size_t)g * TC + n0 + 32 * qt + q) * 2048 + hh * 64;
        bf16x8 qf[4];
#pragma unroll
        for (int d0 = 0; d0 < 4; ++d0) qf[d0] = *(const bf16x8*)(qrow + d0 * 16 + 8 * h);
        AttnSt st; st.m = NEGB; st.l = 0.f; st.o0 = (f32x16){}; st.o1 = (f32x16){};
        u32x4 k0, k1, v0, v1;
        k0 = *(const u32x4*)(ksrc + (size_t)(64 * j0) * 2048); k1 = *(const u32x4*)(ksrc + (size_t)(64 * j0 + 32) * 2048);
        v0 = *(const u32x4*)(vsrc + 64 * j0); v1 = *(const u32x4*)(vsrc + (size_t)32 * TC + 64 * j0);
        { LAS bf16* kb = (LAS bf16*)(F.lds + TBL + (0 * 2 + tu) * 2 * ATILE); LAS bf16* vb = kb + 64 * AKP;
          *(LAS u32x4*)(kb + sdst) = k0; *(LAS u32x4*)(kb + 32 * AKP + sdst) = k1; *(LAS u32x4*)(vb + sdst) = v0; *(LAS u32x4*)(vb + 32 * AKP + sdst) = v1; }
        __syncthreads();
        int pb = 0;
        for (int j = j0; j < 4; ++j) {
            const bool more = j + 1 < 4;
            if (more) { k0 = *(const u32x4*)(ksrc + (size_t)(64 * (j + 1)) * 2048); k1 = *(const u32x4*)(ksrc + (size_t)(64 * (j + 1) + 32) * 2048);
                        v0 = *(const u32x4*)(vsrc + 64 * (j + 1)); v1 = *(const u32x4*)(vsrc + (size_t)32 * TC + 64 * (j + 1)); }
            const LAS bf16* kb = (const LAS bf16*)(F.lds + TBL + (pb * 2 + uw) * 2 * ATILE); const LAS bf16* vb = kb + 64 * AKP;
#pragma unroll
            for (int t2 = 0; t2 < 2; ++t2) { const int t32 = 2 * j + t2;
                if (t32 >= qt && t32 <= qt + 4) {
                    const LAS float* bl = bt + gh * 192 + 32 + (32 * qt + q + 128 - 32 * t32 - 8 * h - 23);
                    attn_tile<false>(kb + 32 * t2 * AKP, vb + 32 * t2, bl, qf, st, q, h, true); } }
            if (more) { LAS bf16* kn = (LAS bf16*)(F.lds + TBL + ((pb ^ 1) * 2 + tu) * 2 * ATILE); LAS bf16* vn = kn + 64 * AKP;
                *(LAS u32x4*)(kn + sdst) = k0; *(LAS u32x4*)(kn + 32 * AKP + sdst) = k1; *(LAS u32x4*)(vn + sdst) = v0; *(LAS u32x4*)(vn + 32 * AKP + sdst) = v1; }
            __syncthreads();
            pb ^= 1;
        }
        const float l_tot = st.l + __shfl_xor(st.l, 32), inv = 1.f / l_tot;
        const size_t orow = (size_t)g * TC + n0 + 32 * qt + q;
        attn_store(st, OG + orow * 1024 + hh * 64 + 4 * h, inv);
        if (h == 0) LSE[orow * 16 + hh] = st.m + __log2f(l_tot);
    }
}

__device__ __forceinline__ void moba_unit2(Frame& F, int b, int hh, int nb, LAS float* bt, int& cur_h) {
    constexpr int TBL = 8448;
    const int lane = F.lane, q = lane & 31, h = lane >> 5, w = F.wave, t = F.tid, srow = t >> 3, sch = t & 7;
    const bf16* QK = (const bf16*)(F.ws + WS_SCR + S_CQK); const bf16* VT = (const bf16*)(F.ws + WS_SCR + S_CVT);
    bf16* att = (bf16*)(F.ws + WS_SCR + S_CATT); const float* km = (const float*)(F.ws + WS_KMEAN);
    if (hh != cur_h) { __syncthreads(); const float* btC = (const float*)(F.ws + WS_BTABC) + hh * 2048; for (int i = t; i < 2048 + 32; i += 512) bt[i] = i < 32 ? NEGB : btC[i - 32]; cur_h = hh; __syncthreads(); }
    const size_t tq = (size_t)b * SEQ + nb * 256 + 32 * w + q;
    const bf16* qrow = QK + tq * 2048 + hh * 64;
    bf16x8 qf[4];
#pragma unroll
    for (int d0 = 0; d0 < 4; ++d0) qf[d0] = *(const bf16x8*)(qrow + d0 * 16 + 8 * h);
    unsigned sel = 0;
    if (nb > 0) {
        float gsc[7];
#pragma unroll
        for (int m = 0; m < 7; ++m) { float s = 0.f;
            if (m < nb) { const float* kmp = km + (((size_t)b * NH + hh) * 8 + m) * 64;
#pragma unroll
                for (int d0 = 0; d0 < 4; ++d0) { const f32x4 k0 = *(const f32x4*)(kmp + d0 * 16 + 8 * h), k1 = *(const f32x4*)(kmp + d0 * 16 + 8 * h + 4); const u32x4 qq = __builtin_bit_cast(u32x4, qf[d0]);
                    s += bflo(qq.x) * k0.x + bfhi(qq.x) * k0.y + bflo(qq.y) * k0.z + bfhi(qq.y) * k0.w + bflo(qq.z) * k1.x + bfhi(qq.z) * k1.y + bflo(qq.w) * k1.z + bfhi(qq.w) * k1.w; }
                s += __shfl_xor(s, 32); }
            gsc[m] = m < nb ? s : -3.0e38f; }
        const int nsel = nb < 3 ? nb : 3;
#pragma unroll
        for (int r = 0; r < 3; ++r) { if (r < nsel) { int bi = 0; float bv = -3.4e38f;
#pragma unroll
                for (int m = 0; m < 7; ++m) if (!((sel >> m) & 1u) && gsc[m] > bv) { bv = gsc[m]; bi = m; }
                sel |= 1u << bi; } }
    }
    AttnSt st; st.m = NEGB; st.l = 0.f; st.o0 = (f32x16){}; st.o1 = (f32x16){};
    const int qpos = nb * 256 + 32 * w + q, nsteps = 4 * nb + 4;
    const bf16* ksrc = QK + ((size_t)b * SEQ + srow) * 2048 + 1024 + hh * 64 + sch * 8;
    const bf16* vsrc = VT + ((size_t)hh * 64 + srow) * T + (size_t)b * SEQ + sch * 8;
    const int sdst = srow * AKP + sch * 8;
    u32x4 kreg = *(const u32x4*)ksrc, vreg = *(const u32x4*)vsrc;
    { LAS bf16* kb = (LAS bf16*)(F.lds + TBL); *(LAS u32x4*)(kb + sdst) = kreg; *(LAS u32x4*)(kb + 64 * AKP + sdst) = vreg; }
    __syncthreads();
    int pb = 0;
    for (int s = 0; s < nsteps; ++s) {
        const bool more = s + 1 < nsteps;
        if (more) { kreg = *(const u32x4*)(ksrc + (size_t)(64 * (s + 1)) * 2048); vreg = *(const u32x4*)(vsrc + 64 * (s + 1)); }
        const LAS bf16* kb = (const LAS bf16*)(F.lds + TBL + pb * 2 * ATILE); const LAS bf16* vb = kb + 64 * AKP;
        if (s < 4 * nb) {
            const bool mine = (sel >> (s >> 2)) & 1u;
            if (__ballot(mine) != 0ull) {
#pragma unroll
                for (int t2 = 0; t2 < 2; ++t2) { const LAS float* bl = bt + 32 + (qpos - 8 * h - (64 * s + 32 * t2) - 23);
                    attn_tile<true>(kb + 32 * t2 * AKP, vb + 32 * t2, bl, qf, st, q, h, mine); } }
        } else {
#pragma unroll
            for (int t2 = 0; t2 < 2; ++t2) { const int t32 = (s - 4 * nb) * 2 + t2;
                if (t32 <= w) { const LAS float* bl = bt + 32 + (qpos - 8 * h - (64 * s + 32 * t2) - 23);
                    attn_tile<false>(kb + 32 * t2 * AKP, vb + 32 * t2, bl, qf, st, q, h, true); } }
        }
        if (more) { LAS bf16* kn = (LAS bf16*)(F.lds + TBL + (pb ^ 1) * 2 * ATILE); *(LAS u32x4*)(kn + sdst) = kreg; *(LAS u32x4*)(kn + 64 * AKP + sdst) = vreg; }
        __syncthreads();
        pb ^= 1;
    }
    const float l_tot = st.l + __shfl_xor(st.l, 32), inv = 1.f / l_tot;
    attn_store(st, att + tq * 1024 + hh * 64 + 4 * h, inv);
}
__device__ __forceinline__ void moba_phase2(Frame& F) {
    LAS float* bt = (LAS float*)F.lds; int cur_h = -1;
    const int NP = NB * NH * 4, per = (NP + F.G - 1) / F.G;
    const int lo = F.vcu * per, hi = (lo + per) < NP ? (lo + per) : NP;
    for (int pu = lo; pu < hi; ++pu) { const int j = pu & 3, hh = (pu >> 2) & 15, b = pu >> 6;
        moba_unit2(F, b, hh, 7 - j, bt, cur_h); moba_unit2(F, b, hh, j, bt, cur_h); }
}


__device__ __forceinline__ float xhalf_max(float m) { auto rr = __builtin_amdgcn_permlane32_swap(__float_as_uint(m), __float_as_uint(m), false, false); return fmaxf(__uint_as_float(rr[0]), __uint_as_float(rr[1])); }
__device__ __forceinline__ float xhalf_sum(float m) { auto rr = __builtin_amdgcn_permlane32_swap(__float_as_uint(m), __float_as_uint(m), false, false); return __uint_as_float(rr[0]) + __uint_as_float(rr[1]); }
template <bool MASKED>
__device__ __forceinline__ void attn_tile2(const LAS bf16* Kt, const LAS bf16* Vt, const LAS float* bl0, const bf16x8 (&qf)[4], AttnSt& st, int q, int h, bool mine) {
    f32x16 s0, s1;
#pragma unroll
    for (int r = 0; r < 16; ++r) { s0[r] = bl0[23 - 16 * (r >> 3) - (r & 7)]; s1[r] = bl0[-32 + 23 - 16 * (r >> 3) - (r & 7)]; }
    const LAS bf16* kr = Kt + kperm(q) * AKP + 8 * h;
#pragma unroll
    for (int d0 = 0; d0 < 4; ++d0) { s0 = mfma32(*(const LAS bf16x8*)(kr + d0 * 16), qf[d0], s0); s1 = mfma32(*(const LAS bf16x8*)(kr + 32 * AKP + d0 * 16), qf[d0], s1); }
    const float mx = xhalf_max(fmaxf(max16(s0), max16(s1)));
    float mn = fmaxf(st.m, mx); if (MASKED) mn = mine ? mn : st.m;
    const float alpha = __builtin_amdgcn_exp2f(st.m - mn);
    float ps0 = 0.f, ps1 = 0.f;
#pragma unroll
    for (int r = 0; r < 16; ++r) { const float p = __builtin_amdgcn_exp2f(s0[r] - mn); s0[r] = p; ps0 += p; const float p2 = __builtin_amdgcn_exp2f(s1[r] - mn); s1[r] = p2; ps1 += p2; }
    bf16x8 p00 = pack8(s0, 0), p01 = pack8(s0, 8), p10 = pack8(s1, 0), p11 = pack8(s1, 8);
    float ps = ps0 + ps1;
    if (MASKED) { if (!mine) { p00 = (bf16x8){0, 0, 0, 0, 0, 0, 0, 0}; p01 = p00; p10 = p00; p11 = p00; ps = 0.f; } }
    st.l = st.l * alpha + ps; st.m = mn;
    if (__ballot(alpha != 1.0f) != 0ull) {
#pragma unroll
        for (int r = 0; r < 16; ++r) { st.o0[r] *= alpha; st.o1[r] *= alpha; } }
    const LAS bf16* v0 = Vt + q * AKP + 8 * h; const LAS bf16* v1 = v0 + 32 * AKP;
    st.o0 = mfma32(*(const LAS bf16x8*)v0, p00, st.o0); st.o1 = mfma32(*(const LAS bf16x8*)v1, p00, st.o1);
    st.o0 = mfma32(*(const LAS bf16x8*)(v0 + 16), p01, st.o0); st.o1 = mfma32(*(const LAS bf16x8*)(v1 + 16), p01, st.o1);
    st.o0 = mfma32(*(const LAS bf16x8*)(v0 + 32), p10, st.o0); st.o1 = mfma32(*(const LAS bf16x8*)(v1 + 32), p10, st.o1);
    st.o0 = mfma32(*(const LAS bf16x8*)(v0 + 48), p11, st.o0); st.o1 = mfma32(*(const LAS bf16x8*)(v1 + 48), p11, st.o1);
}

__device__ __forceinline__ void attn_tile2r(const LAS bf16* Kt, const LAS bf16* Vt, const LAS float* b0, const LAS float* b1, const bf16x8 (&qf)[4], AttnSt& st, int q, int h) {
    f32x16 s0, s1;
#pragma unroll
    for (int r = 0; r < 16; ++r) { s0[r] = b0[16 * (r >> 3) + (r & 7)]; s1[r] = b1[16 * (r >> 3) + (r & 7)]; }
    const LAS bf16* kr = Kt + kperm(q) * AKP + 8 * h;
#pragma unroll
    for (int d0 = 0; d0 < 4; ++d0) { s0 = mfma32(*(const LAS bf16x8*)(kr + d0 * 16), qf[d0], s0); s1 = mfma32(*(const LAS bf16x8*)(kr + 32 * AKP + d0 * 16), qf[d0], s1); }
    const float mx = xhalf_max(fmaxf(max16(s0), max16(s1)));
    const float mn = fmaxf(st.m, mx);
    const float alpha = __builtin_amdgcn_exp2f(st.m - mn);
    float ps0 = 0.f, ps1 = 0.f;
#pragma unroll
    for (int r = 0; r < 16; ++r) { const float p = __builtin_amdgcn_exp2f(s0[r] - mn); s0[r] = p; ps0 += p; const float p2 = __builtin_amdgcn_exp2f(s1[r] - mn); s1[r] = p2; ps1 += p2; }
    const bf16x8 p00 = pack8(s0, 0), p01 = pack8(s0, 8), p10 = pack8(s1, 0), p11 = pack8(s1, 8);
    st.l = st.l * alpha + (ps0 + ps1); st.m = mn;
    if (__ballot(alpha != 1.0f) != 0ull) {
#pragma unroll
        for (int r = 0; r < 16; ++r) { st.o0[r] *= alpha; st.o1[r] *= alpha; } }
    const LAS bf16* v0 = Vt + q * AKP + 8 * h; const LAS bf16* v1 = v0 + 32 * AKP;
    st.o0 = mfma32(*(const LAS bf16x8*)v0, p00, st.o0); st.o1 = mfma32(*(const LAS bf16x8*)v1, p00, st.o1);
    st.o0 = mfma32(*(const LAS bf16x8*)(v0 + 16), p01, st.o0); st.o1 = mfma32(*(const LAS bf16x8*)(v1 + 16), p01, st.o1);
    st.o0 = mfma32(*(const LAS bf16x8*)(v0 + 32), p10, st.o0); st.o1 = mfma32(*(const LAS bf16x8*)(v1 + 32), p10, st.o1);
    st.o0 = mfma32(*(const LAS bf16x8*)(v0 + 48), p11, st.o0); st.o1 = mfma32(*(const LAS bf16x8*)(v1 + 48), p11, st.o1);
}

__device__ __forceinline__ u32x4 f8x8_bf16(u32x2 v) {
    const f32x2 a = __builtin_amdgcn_cvt_pk_f32_fp8((int)v.x, false), b = __builtin_amdgcn_cvt_pk_f32_fp8((int)v.x, true), c = __builtin_amdgcn_cvt_pk_f32_fp8((int)v.y, false), d = __builtin_amdgcn_cvt_pk_f32_fp8((int)v.y, true);
    u32x4 r; r.x = pg8::cvt_pk_bf16(a.x, a.y); r.y = pg8::cvt_pk_bf16(b.x, b.y); r.z = pg8::cvt_pk_bf16(c.x, c.y); r.w = pg8::cvt_pk_bf16(d.x, d.y); return r;
}
__device__ __forceinline__ void dil_attn_phase3(Frame& F) {
    LAS float* bt = (LAS float*)F.lds;
    { const float* btA = (const float*)(F.ws + WS_BTABA); for (int i = F.tid; i < 48 * 192; i += 512) { const int gh = i / 192, dl = 159 - i % 192; bt[i] = (dl >= 0 && dl <= 128) ? btA[gh * 132 + dl] : NEGB; } }
    constexpr int TBL = 48 * 192 * 4;
    const int lane = F.lane, q = lane & 31, h = lane >> 5, w = F.wave, uw = w >> 2, qt = w & 3, t = F.tid, tu = t >> 8, tt = t & 255, srow = tt >> 3, sch = tt & 7;
    const unsigned char* QK = F.ws + WS_SCR + S_QK; const unsigned char* VT = F.ws + WS_SCR + S_VT;
    bf16* OG = (bf16*)((unsigned char*)F.out + O_OG); float* LSE = (float*)((unsigned char*)F.out + O_LSE);
    const int sdst = srow * AKP + sch * 8;
    int du = F.vcu;
    if (du >= 3072) { __syncthreads(); return; }
    int g = du >> 10, hh = (du >> 6) & 15, blp = (du >> 4) & 3, rn = du & 15;
    int j = ((rn & ((16 >> (2 * g)) - 1)) != 0) ? 0 : 2;
    u32x2 k0, k1, v0, v1; u32x2 qn[4]; bf16x8 qf[4];
#define DIL_LOADS(G_, HH_, BLP_, RN_, J_) do { const int n0s_ = (2 * (BLP_) + tu) * 2048 + (RN_) * 128 - 128 + 64 * (J_); \
        const unsigned char* ks_ = QK + ((size_t)(G_) * TC + n0s_ + srow) * 2048 + 1024 + (HH_) * 64 + sch * 8; \
        const unsigned char* vs_ = VT + ((size_t)(G_) * 1024 + (HH_) * 64 + srow) * TC + n0s_ + sch * 8; \
        k0 = *(const u32x2*)ks_; k1 = *(const u32x2*)(ks_ + (size_t)32 * 2048); v0 = *(const u32x2*)vs_; v1 = *(const u32x2*)(vs_ + (size_t)32 * TC); } while (0)
#define DIL_QLOADS(G_, HH_, BLP_, RN_) do { const unsigned char* qr_ = QK + ((size_t)(G_) * TC + (2 * (BLP_) + uw) * 2048 + (RN_) * 128 + 32 * qt + q) * 2048 + (HH_) * 64; \
        _Pragma("unroll") for (int d0 = 0; d0 < 4; ++d0) qn[d0] = *(const u32x2*)(qr_ + d0 * 16 + 8 * h); } while (0)
#define DIL_WRITE(PB_) do { LAS bf16* kb_ = (LAS bf16*)(F.lds + TBL + ((PB_) * 2 + tu) * 2 * ATILE); LAS bf16* vb_ = kb_ + 64 * AKP; \
        *(LAS u32x4*)(kb_ + sdst) = f8x8_bf16(k0); *(LAS u32x4*)(kb_ + 32 * AKP + sdst) = f8x8_bf16(k1); *(LAS u32x4*)(vb_ + sdst) = f8x8_bf16(v0); *(LAS u32x4*)(vb_ + 32 * AKP + sdst) = f8x8_bf16(v1); } while (0)
    DIL_LOADS(g, hh, blp, rn, j); DIL_QLOADS(g, hh, blp, rn);
    DIL_WRITE(0);
#pragma unroll
    for (int d0 = 0; d0 < 4; ++d0) qf[d0] = __builtin_bit_cast(bf16x8, f8x8_bf16(qn[d0]));
    __syncthreads();
    AttnSt st; st.m = NEGB; st.l = 0.f; st.o0 = (f32x16){}; st.o1 = (f32x16){};
    int pb = 0;
    for (;;) {
        const bool last = (j == 3);
        int ng = g, nhh = hh, nblp = blp, nrn = rn, nj = j + 1; bool more = true;
        if (last) { const int nd = du + F.G; more = nd < 3072; ng = nd >> 10; nhh = (nd >> 6) & 15; nblp = (nd >> 4) & 3; nrn = nd & 15; nj = ((nrn & ((16 >> (2 * ng)) - 1)) != 0) ? 0 : 2; }
        if (more) { DIL_LOADS(ng, nhh, nblp, nrn, nj); if (last) DIL_QLOADS(ng, nhh, nblp, nrn); }
        { const LAS bf16* kb = (const LAS bf16*)(F.lds + TBL + (pb * 2 + uw) * 2 * ATILE); const LAS bf16* vb = kb + 64 * AKP;
          const int gh = g * 16 + hh, ta = 2 * j, tb = 2 * j + 1;
          const bool a_on = ta >= qt && ta <= qt + 4, b_on = tb >= qt && tb <= qt + 4;
          const LAS float* row = bt + gh * 192;
          const LAS float* ba = row + (168 - (32 + (32 * qt + q + 128 - 32 * ta - 8 * h - 23)));
          if (a_on || b_on) attn_tile2r(kb, vb, a_on ? ba : row + 160, b_on ? ba + 32 : row + 160, qf, st, q, h); }
        if (more) DIL_WRITE(pb ^ 1);
        if (last) {
            const float l_tot = xhalf_sum(st.l), inv = 1.f / l_tot;
            const size_t orow = (size_t)g * TC + (2 * blp + uw) * 2048 + rn * 128 + 32 * qt + q;
            attn_store8(st, (unsigned char*)OG + orow * 1024 + hh * 64 + 4 * h, inv * ASCALE8);
            if (h == 0) LSE[orow * 16 + hh] = st.m + __log2f(l_tot);
            st.m = NEGB; st.l = 0.f; st.o0 = (f32x16){}; st.o1 = (f32x16){};
#pragma unroll
            for (int d0 = 0; d0 < 4; ++d0) qf[d0] = __builtin_bit_cast(bf16x8, f8x8_bf16(qn[d0]));
        }
        __syncthreads();
        pb ^= 1;
        if (!more) break;
        if (last) du += F.G;
        g = ng; hh = nhh; blp = nblp; rn = nrn; j = nj;
    }
#undef DIL_LOADS
#undef DIL_QLOADS
#undef DIL_WRITE
}

__device__ __forceinline__ void moba_phase3(Frame& F) {
    constexpr int TBL = 8448, KMO = TBL + 4 * ATILE;
    LAS float* bt = (LAS float*)F.lds; LAS float* kml = (LAS float*)(F.lds + KMO);
    const int lane = F.lane, q = lane & 31, h = lane >> 5, w = F.wave, t = F.tid, srow = t >> 3, sch = t & 7;
    const bf16* QK = (const bf16*)(F.ws + WS_SCR + S_CQK); const bf16* VT = (const bf16*)(F.ws + WS_SCR + S_CVT);
    bf16* att = (bf16*)(F.ws + WS_SCR + S_CATT); const float* km = (const float*)(F.ws + WS_KMEAN);
    const int NP = NB * NH * 4, per = (NP + F.G - 1) / F.G;
    const int lo = F.vcu * per, hi = (lo + per) < NP ? (lo + per) : NP;
    const int nunits = 2 * (hi - lo);
    if (nunits <= 0) return;
    const int sdst = srow * AKP + sch * 8;
    int u = 0, cur_bh = -1;
    u32x4 kreg, vreg; bf16x8 qn[4], qf[4];
#define MB_LOADS(B_, HH_, S_) do { const bf16* ks_ = QK + ((size_t)(B_) * SEQ + 64 * (S_) + srow) * 2048 + 1024 + (HH_) * 64 + sch * 8; \
        const bf16* vs_ = VT + ((size_t)(HH_) * 64 + srow) * T + (size_t)(B_) * SEQ + 64 * (S_) + sch * 8; kreg = *(const u32x4*)ks_; vreg = *(const u32x4*)vs_; } while (0)
#define MB_QLOADS(B_, HH_, NB_) do { const bf16* qr_ = QK + ((size_t)(B_) * SEQ + (NB_) * 256 + 32 * w + q) * 2048 + (HH_) * 64; \
        _Pragma("unroll") for (int d0 = 0; d0 < 4; ++d0) qn[d0] = *(const bf16x8*)(qr_ + d0 * 16 + 8 * h); } while (0)
#define MB_WRITE(PB_) do { LAS bf16* kb_ = (LAS bf16*)(F.lds + TBL + (PB_) * 2 * ATILE); *(LAS u32x4*)(kb_ + sdst) = kreg; *(LAS u32x4*)(kb_ + 64 * AKP + sdst) = vreg; } while (0)
    int pu = lo, jj = pu & 3, hh = (pu >> 2) & 15, b = pu >> 6, nb = 7 - jj, s = 0, pb = 0;
    MB_LOADS(b, hh, 0); MB_QLOADS(b, hh, nb); MB_WRITE(0);
    unsigned sel = 0; bool fresh = true;
    AttnSt st; st.m = NEGB; st.l = 0.f; st.o0 = (f32x16){}; st.o1 = (f32x16){};
    for (;;) {
        if (fresh) {
            if (b * 16 + hh != cur_bh) { __syncthreads(); const float* btC = (const float*)(F.ws + WS_BTABC) + hh * 2048;
                for (int i = t; i < 2048 + 32; i += 512) bt[2079 - i] = i < 32 ? NEGB : btC[i - 32];
                { const float* kmp = km + ((size_t)b * NH + hh) * 512; kml[t] = kmp[t]; }
                cur_bh = b * 16 + hh; }
#pragma unroll
            for (int d0 = 0; d0 < 4; ++d0) qf[d0] = qn[d0];
            __syncthreads();
            sel = 0;
            if (nb > 0) {
                float gsc[7];
#pragma unroll
                for (int m = 0; m < 7; ++m) { float sc = 0.f;
                    if (m < nb) {
#pragma unroll
                        for (int d0 = 0; d0 < 4; ++d0) { const f32x4 c0 = *(const LAS f32x4*)(kml + m * 64 + d0 * 16 + 8 * h), c1 = *(const LAS f32x4*)(kml + m * 64 + d0 * 16 + 8 * h + 4); const u32x4 qq = __builtin_bit_cast(u32x4, qf[d0]);
                            sc += bflo(qq.x) * c0.x + bfhi(qq.x) * c0.y + bflo(qq.y) * c0.z + bfhi(qq.y) * c0.w + bflo(qq.z) * c1.x + bfhi(qq.z) * c1.y + bflo(qq.w) * c1.z + bfhi(qq.w) * c1.w; }
                        sc = xhalf_sum(sc); }
                    gsc[m] = m < nb ? sc : -3.0e38f; }
                const int nsel = nb < 3 ? nb : 3;
#pragma unroll
                for (int r = 0; r < 3; ++r) { if (r < nsel) { int bi = 0; float bv = -3.4e38f;
#pragma unroll
                        for (int m = 0; m < 7; ++m) if (!((sel >> m) & 1u) && gsc[m] > bv) { bv = gsc[m]; bi = m; }
                        sel |= 1u << bi; } }
            }
            fresh = false;
        }
        const int nsteps = 4 * nb + 4;
        const bool last = (s + 1 == nsteps);
        int nb2 = nb, b2 = b, hh2 = hh, s2 = s + 1; bool more = true;
        if (last) { const int u2 = u + 1; more = u2 < nunits; const int pu2 = lo + (u2 >> 1), j2 = pu2 & 3; hh2 = (pu2 >> 2) & 15; b2 = pu2 >> 6; nb2 = (u2 & 1) ? j2 : 7 - j2; s2 = 0; }
        if (more) { MB_LOADS(b2, hh2, s2); if (last) MB_QLOADS(b2, hh2, nb2); }
        { const LAS bf16* kb = (const LAS bf16*)(F.lds + TBL + pb * 2 * ATILE); const LAS bf16* vb = kb + 64 * AKP;
          const int qpos = nb * 256 + 32 * w + q;
          const LAS float* ba = bt + (2056 - (32 + (qpos - 8 * h - 64 * s - 23)));
          const LAS float* negp = bt + 2048;
          bool act; const LAS float* p0; const LAS float* p1;
          if (s < 4 * nb) { const bool mine = (sel >> (s >> 2)) & 1u; act = __ballot(mine) != 0ull; p0 = mine ? ba : negp; p1 = mine ? ba + 32 : negp; }
          else { const int ta = (s - 4 * nb) * 2; act = ta <= w; p0 = ba; p1 = (ta + 1 <= w) ? ba + 32 : negp; }
          if (act) attn_tile2r(kb, vb, p0, p1, qf, st, q, h); }
        if (more) MB_WRITE(pb ^ 1);
        if (last) {
            const float l_tot = xhalf_sum(st.l), inv = 1.f / l_tot;
            const size_t tq = (size_t)b * SEQ + nb * 256 + 32 * w + q;
            attn_store8(st, (unsigned char*)att + tq * 1024 + hh * 64 + 4 * h, inv * ASCALE8);
            st.m = NEGB; st.l = 0.f; st.o0 = (f32x16){}; st.o1 = (f32x16){};
        }
        if (!last) __syncthreads();
        pb ^= 1;
        if (!more) break;
        if (last) { ++u; fresh = true; }
        nb = nb2; b = b2; hh = hh2; s = s2;
    }
#undef MB_LOADS
#undef MB_QLOADS
#undef MB_WRITE
}

__device__ __forceinline__ void gmlp_phase(Frame& F, const float* lng, const float* lnb, const float* bs) {
    const int lane = F.lane, w = F.wave, q = lane & 31, h = lane >> 5;
    const bf16* uv = (const bf16*)(F.ws + WS_SCR + S_UV); bf16* p = (bf16*)(F.ws + WS_SCR + S_P); const bf16* wst = (const bf16*)(F.ws + WS_WST);
    LAS float* stat = (LAS float*)F.lds;
    LAS bf16* vnT = (LAS bf16*)(F.lds + 1024);
    constexpr int VP = 136;
    for (int unit = F.vcu; unit < T / 128; unit += F.G) {
        const size_t t0 = (size_t)unit * 128;
        __syncthreads();
        for (int i = 0; i < 16; ++i) { const int r = w * 16 + i; const u32x4* vr = (const u32x4*)(uv + (t0 + r) * 2048 + 1024) + lane;
            const u32x4 a = vr[0], b = vr[64]; float x[16];
            x[0] = bflo(a.x); x[1] = bfhi(a.x); x[2] = bflo(a.y); x[3] = bfhi(a.y); x[4] = bflo(a.z); x[5] = bfhi(a.z); x[6] = bflo(a.w); x[7] = bfhi(a.w);
            x[8] = bflo(b.x); x[9] = bfhi(b.x); x[10] = bflo(b.y); x[11] = bfhi(b.y); x[12] = bflo(b.z); x[13] = bfhi(b.z); x[14] = bflo(b.w); x[15] = bfhi(b.w);
            float s = 0.f;
#pragma unroll
            for (int j = 0; j < 16; ++j) s += x[j];
            const float mean = wave_sum(s) * (1.f / 1024.f); float s2 = 0.f;
#pragma unroll
            for (int j = 0; j < 16; ++j) { const float d = x[j] - mean; s2 += d * d; }
            const float rstd = 1.f / sqrtf(wave_sum(s2) * (1.f / 1024.f) + LN_EPS);
            if (lane == 0) { stat[2 * r] = mean; stat[2 * r + 1] = rstd; } }
        __syncthreads();
        for (int gg = 0; gg < 8; ++gg) {
#pragma unroll
            for (int k = 0; k < 4; ++k) { const int id = F.tid + 512 * k, s = id >> 4, cc = (id & 15) * 8;
                const u32x4 a = *(const u32x4*)(uv + (t0 + s) * 2048 + 1024 + gg * 128 + cc); const float mean = stat[2 * s], rstd = stat[2 * s + 1];
                float x[8]; x[0] = bflo(a.x); x[1] = bfhi(a.x); x[2] = bflo(a.y); x[3] = bfhi(a.y); x[4] = bflo(a.z); x[5] = bfhi(a.z); x[6] = bflo(a.w); x[7] = bfhi(a.w);
#pragma unroll
                for (int j = 0; j < 8; ++j) { const int c = gg * 128 + cc + j; const float y = (x[j] - mean) * rstd * lng[c] + lnb[c]; vnT[(cc + j) * VP + s] = (bf16)f2bf(y); } }
            __syncthreads();
            const int cr = 32 * (w & 3), tc0 = 64 * (w >> 2);
            f32x16 acc0 = {}, acc1 = {};
#pragma unroll
            for (int ks = 0; ks < 8; ++ks) {
                const bf16x8 af = *(const LAS bf16x8*)(vnT + (cr + q) * VP + ks * 16 + 8 * h);
                const bf16x8 b0 = *(const bf16x8*)(wst + ((size_t)gg * 128 + tc0 + q) * 128 + ks * 16 + 8 * h);
                const bf16x8 b1 = *(const bf16x8*)(wst + ((size_t)gg * 128 + tc0 + 32 + q) * 128 + ks * 16 + 8 * h);
                acc0 = mfma32(af, b0, acc0); acc1 = mfma32(af, b1, acc1);
            }
#pragma unroll
            for (int tt = 0; tt < 2; ++tt) { const f32x16& ac = tt == 0 ? acc0 : acc1; const int tl = tc0 + 32 * tt + q; const float bsv = bs[gg * 128 + tl];
                const size_t rowu = (t0 + tl) * 2048, rowp = (t0 + tl) * 1024;
#pragma unroll
                for (int gq = 0; gq < 4; ++gq) { const int c = gg * 128 + cr + 8 * gq + 4 * h; const u32x2 uu = *(const u32x2*)(uv + rowu + c);
                    u32x2 o; o.x = pk2(bflo(uu.x) * (ac[4 * gq] + bsv), bfhi(uu.x) * (ac[4 * gq + 1] + bsv)); o.y = pk2(bflo(uu.y) * (ac[4 * gq + 2] + bsv), bfhi(uu.y) * (ac[4 * gq + 3] + bsv));
                    *(u32x2*)(p + rowp + c) = o; } }
            __syncthreads();
        }
    }
}

struct MoeSeg { int ts[9]; };
__device__ __forceinline__ MoeSeg moe_seg(Frame& F, int moe_l) {
    MoeSeg s; int acc = 0;
#pragma unroll
    for (int e = 0; e < 8; ++e) { s.ts[e] = acc; const unsigned c = __hip_atomic_load((unsigned*)(F.ctl + CW_ECNT + 64 * moe_l + e), RLX_AGENT); acc += (int)((c + 255u) >> 8); }
    s.ts[8] = acc; return s;
}
__device__ __forceinline__ void moe_gather_phase(Frame& F, int moe_l) {
    LAS int* P = (LAS int*)F.lds;
    LAS int* wtot = (LAS int*)(F.lds + 65536);
    LAS int* tot = wtot + 64;
    const int* wcnt = (const int*)(F.ws + WS_WCNT);
    int t = F.tid; asm volatile("" : "+v"(t));
    const int lane = F.lane;
    int loc[4][8], sum[8], inc[8];
#pragma unroll
    for (int k = 0; k < 4; ++k) { const u32x4 a = *(const u32x4*)(wcnt + (4 * t + k) * 8), b = *(const u32x4*)(wcnt + (4 * t + k) * 8 + 4);
        loc[k][0] = (int)a.x; loc[k][1] = (int)a.y; loc[k][2] = (int)a.z; loc[k][3] = (int)a.w; loc[k][4] = (int)b.x; loc[k][5] = (int)b.y; loc[k][6] = (int)b.z; loc[k][7] = (int)b.w; }
#pragma unroll
    for (int e = 0; e < 8; ++e) { sum[e] = (loc[0][e] + loc[1][e]) + (loc[2][e] + loc[3][e]); inc[e] = sum[e]; }
#pragma unroll
    for (int off = 1; off < 64; off <<= 1) {
#pragma unroll
        for (int e = 0; e < 8; ++e) { const int v = __shfl_up(inc[e], off); if (lane >= off) inc[e] += v; } }
    if (lane == 63) {
#pragma unroll
        for (int e = 0; e < 8; ++e) wtot[F.wave * 8 + e] = inc[e]; }
    __syncthreads();
    int run[8];
#pragma unroll
    for (int e = 0; e < 8; ++e) { int wb = 0; for (int w = 0; w < F.wave; ++w) wb += wtot[w * 8 + e]; run[e] = wb + inc[e] - sum[e]; }
#pragma unroll
    for (int k = 0; k < 4; ++k) {
#pragma unroll
        for (int e = 0; e < 8; ++e) { P[(4 * t + k) * 8 + e] = run[e]; run[e] += loc[k][e]; } }
    if (t == 511) {
#pragma unroll
        for (int e = 0; e < 8; ++e) tot[e] = run[e]; }
    __syncthreads();
    MoeSeg sg; { int acc = 0;
#pragma unroll
        for (int e = 0; e < 8; ++e) { sg.ts[e] = acc; acc += (tot[e] + 255) >> 8; } sg.ts[8] = acc; }
    if (blockIdx.x == 0 && t < 8) __hip_atomic_store((unsigned*)(F.ctl + CW_ECNT + 64 * moe_l + t), (unsigned)tot[t], RLX_AGENT);
    const int gw = F.vcu * NWAVES + F.wave, NGW = F.G * NWAVES;
    const bf16* hb = (const bf16*)(F.ws + WS_HB); unsigned char* xg8 = (unsigned char*)F.out;
    const int* route = (const int*)(F.ws + WS_ROUTE); int* slots = (int*)(F.ws + WS_SLOTS);
    for (int m0 = 4 * gw; m0 < T; m0 += 4 * NGW) {
        int s1[4], s2[4]; u32x4 a[4], b[4];
#pragma unroll
        for (int k = 0; k < 4; ++k) { const int m = m0 + k, grp = m >> 5;
            const int e1 = route[4 * m], p1 = route[4 * m + 1], e2 = route[4 * m + 2], p2 = route[4 * m + 3];
            int ts1 = 0, ts2 = 0;
#pragma unroll
            for (int e = 0; e < 8; ++e) { ts1 = e == e1 ? sg.ts[e] : ts1; ts2 = e == e2 ? sg.ts[e] : ts2; }
            s1[k] = ts1 * 256 + P[grp * 8 + e1] + p1; s2[k] = ts2 * 256 + P[grp * 8 + e2] + p2;
            const u32x4* src = (const u32x4*)(hb + (size_t)m * D) + lane; a[k] = src[0]; b[k] = src[64]; }
#pragma unroll
        for (int k = 0; k < 4; ++k) { const int m = m0 + k;
            float x[16]; unpack8(a[k], x); unpack8(b[k], x + 8);
            u32x2 lo, hi; lo.x = pk4_fp8(x[0], x[1], x[2], x[3]); lo.y = pk4_fp8(x[4], x[5], x[6], x[7]); hi.x = pk4_fp8(x[8], x[9], x[10], x[11]); hi.y = pk4_fp8(x[12], x[13], x[14], x[15]);
            unsigned char* d1 = xg8 + (size_t)s1[k] * D + 8 * lane; unsigned char* d2 = xg8 + (size_t)s2[k] * D + 8 * lane;
            *(u32x2*)d1 = lo; *(u32x2*)(d1 + 512) = hi; *(u32x2*)d2 = lo; *(u32x2*)(d2 + 512) = hi;
            if (lane == 0) { slots[2 * m] = s1[k]; slots[2 * m + 1] = s2[k]; } }
    }
}
struct MoeOrder {
    int nM, nN, G, c, tile0; MoeSeg sg; const char* A0; const char* B0; size_t aT, bE, bT; bool a_local;
    bool out_local;
    __device__ __forceinline__ bool next(int i, pg8::Unit& u) const {
        int pm, pn; if (!pg8::tile_of((long)i * G + c, nM, nN, pm, pn)) return false;
        const int tile = tile0 + pm; int e = 0;
#pragma unroll
        for (int k = 1; k < 8; ++k) e += (tile >= sg.ts[k]) ? 1 : 0;
        u.pm = out_local ? pm : tile; u.pn = pn; u.a = (unsigned)((size_t)(a_local ? pm : tile) * aT); u.b = (unsigned)((size_t)e * bE + (size_t)pn * bT); return true;
    }
};


template <int GI> struct L0QKOrder { int G, c; const char* A0; const char* B0;
    __device__ __forceinline__ bool next(int i, pg8::Unit& u) const { if (!pg8::tile_of((long)i * G + c, 64, 8, u.pm, u.pn)) return false; const int pm = u.pm;
        const int tok = GI == 0 ? pm * 256 : (GI == 1 ? (pm >> 3) * 2048 + (pm & 1) * 1024 + ((pm >> 1) & 3) : (pm >> 3) * 2048 + (pm & 7) * 2);
        u.a = (unsigned)tok * 1024u; u.b = (unsigned)u.pn * 256u * 1024u; return true; } };
template <int GI> struct L0VtOrder { int G, c; const char* A0; const char* B0;
    __device__ __forceinline__ bool next(int i, pg8::Unit& u) const { if (!pg8::tile_of((long)i * G + c, 4, 64, u.pm, u.pn)) return false; const int pn = u.pn;
        const int tok = GI == 0 ? pn * 256 : (GI == 1 ? (pn >> 3) * 2048 + (pn & 1) * 1024 + ((pn >> 1) & 3) : (pn >> 3) * 2048 + (pn & 7) * 2);
        u.a = (unsigned)u.pm * 256u * 1024u; u.b = (unsigned)tok * 1024u; return true; } };
template <int GI> __device__ __forceinline__ void l0_gemms(Frame& F, int ck, int bx) {
    constexpr int rs = GI == 0 ? 1 : (GI == 1 ? 4 : 16);
    constexpr size_t hst = (GI == 0 ? (size_t)128 : (GI == 1 ? (size_t)512 : (size_t)1)) * 1024;
    const char* hbc = (const char*)(F.ws + WS_SCR + S_HB8) + (size_t)ck * TC * 1024;
    unsigned char* scr = F.ws + WS_SCR;
    { L0QKOrder<GI> S{F.G, bx, hbc, (const char*)(F.ws + W_A_QK) + (size_t)GI * 2048 * 1024};
      pg8::Gemm gm{512, rs, 1, hst, (size_t)128 * 1024};
      pg8::EpiF8 E{scr + S_QK + (size_t)GI * TC * 2048, 2048, 1.f / WSCALE8};
      pg8::gemm_phase<pg8::EpiF8, L0QKOrder<GI>, false, 1>(F.lds, F.wave, gm, S, E); }
    { L0VtOrder<GI> S{F.G, bx, (const char*)(F.ws + W_A_V) + (size_t)GI * 1024 * 1024, hbc};
      pg8::Gemm gm{512, 1, rs, (size_t)128 * 1024, hst};
      pg8::EpiF8 E{scr + S_VT + (size_t)GI * 1024 * TC, TC, 1.f / WSCALE8};
      pg8::gemm_phase<pg8::EpiF8, L0VtOrder<GI>, false, 1>(F.lds, F.wave, gm, S, E); }
}


#ifdef MK_SELFCHECK
__device__ __forceinline__ void selfcheck_buf(Frame& F, const void* ptr, size_t nbytes, int stage, int slot0) {
    if (!F.chk) return;
    const int gw = F.vcu * NWAVES + F.wave, NGW = F.G * NWAVES; unsigned* cks = (unsigned*)(F.ws + WS_NEED + 2 * MiB) + slot0;
    const int nch = (int)(nbytes >> 12);
    for (int c = gw; c < nch; c += NGW) { const u32x4* r = (const u32x4*)((const char*)ptr + ((size_t)c << 12)) + F.lane; unsigned x = 0;
#pragma unroll
        for (int j = 0; j < 4; ++j) { const u32x4 v = r[64 * j]; x ^= v.x * 3u + v.y * 5u + v.z * 7u + v.w * 11u + (unsigned)j; }
        x *= (unsigned)(2 * F.lane + 1);
#pragma unroll
        for (int o = 1; o < 64; o <<= 1) x ^= __shfl_xor(x, o);
        if (F.lane == 0) { if (F.chk == 1) cks[c] = x; else if (cks[c] != x) atomicMax((unsigned*)(F.ctl + 32), (unsigned)(1000 - stage)); } }
}
#endif

__global__ void __launch_bounds__(NWAVES * 64, 2) mk_fwd(Args args) {
    extern __shared__ __attribute__((aligned(16))) unsigned char lds[];
    Frame F;
    F.lds = (LAS unsigned char*)lds;
    F.tid = threadIdx.x; F.lane = F.tid & 63; F.wave = __builtin_amdgcn_readfirstlane(F.tid >> 6);
    F.G = gridDim.x; { const int bx = blockIdx.x; F.vcu = (F.G % 8 == 0) ? (bx % 8) * (F.G / 8) + bx / 8 : bx; }
    F.ws = args.ws; F.ctl = (gu32*)(args.ws + WS_CTL); F.out = args.out; F.chk = args.chk; F.stage = 0;
    volatile LAS unsigned* MISC = (volatile LAS unsigned*)(F.lds + MISC_OFF);
    for (int u = F.tid; u < (LDS_BYTES - RING_BYTES) / 4; u += NWAVES * 64) ((LAS unsigned*)(F.lds + RING_BYTES))[u] = 0u;
    __syncthreads();
    XcdBarrier bar; bar.bar = (unsigned*)(F.ctl + CW_BAR); bar.x = 0; bar.st = nullptr;
    if (!MK_MULTI) bar = xcd_barrier_post((unsigned*)(F.ctl + CW_BAR), MISC + 8);
    const int lo = args.ph_lo, hi = args.ph_hi;
    int ph = 0;
#define PHASE_BEGIN if (ph >= lo && ph < hi) { F.lane = (int)__builtin_amdgcn_mbcnt_hi(~0u, __builtin_amdgcn_mbcnt_lo(~0u, 0u)); asm volatile("" : "+v"(F.lane)); F.tid = F.wave * 64 + F.lane;
#define PHASE_END   if (!MK_MULTI && ph + 1 < hi) xcd_barrier(bar, F.tid); } ++ph;
    const int bx = (int)blockIdx.x;
#define scr (args.ws + WS_SCR)
#define hb ((const bf16*)(args.ws + WS_HB))
#define ln_g (args.in[2])
#define ln_b (args.in[3])

    PHASE_BEGIN p_prologue(F, args); if (MK_PROBE & 8) p_prologue(F, args); PHASE_END

    if (MK_ENABLE & 1) {
#define L0_CHUNK(ck) \
        PHASE_BEGIN \
        if ((ck) > 0) dil_merge_phase(F, (ck) - 1); \
        l0_gemms<0>(F, (ck), bx); l0_gemms<1>(F, (ck), bx); l0_gemms<2>(F, (ck), bx); \
        PHASE_END \
        PHASE_BEGIN dil_attn_phase3(F); if (MK_PROBE & 1) dil_attn_phase3(F); PHASE_END
        L0_CHUNK(0) L0_CHUNK(1) L0_CHUNK(2) L0_CHUNK(3)
#undef L0_CHUNK
        PHASE_BEGIN dil_merge_phase(F, 3); if (MK_PROBE & 4) { dil_merge_phase(F, 3); dil_merge_phase(F, 3); dil_merge_phase(F, 3); dil_merge_phase(F, 3); } PHASE_END
        PHASE_BEGIN
        { pg8::LinOrder S{T / 256, 4, F.G, bx, (const char*)(scr + S_ATT), (const char*)(F.ws + W_A_O), (size_t)256 * 1024, (size_t)256 * 1024};
          pg8::Gemm gm{512, 1, 1, (size_t)128 * 1024, (size_t)128 * 1024};
          pg8::EpiResLn<FFN_GU8 == 0> E{(bf16*)(F.ws + WS_HB), ln_g + 0 * 2048, ln_b + 0 * 2048, ALPHA, 1.f / (WSCALE8 * ASCALE8), (float*)scr, (unsigned*)(F.ctl + CW_LNC + 0 * 4096), (unsigned*)(F.ctl + CW_BAR) + XB_TMO, scr + S_HB8, F.lds + LNT_OFF};
          pg8::gemm_phase<pg8::EpiResLn<FFN_GU8 == 0>, pg8::LinOrder, true, 1>(F.lds, F.wave, gm, S, E); }
        PHASE_END
    } else {
        PHASE_BEGIN ln_phase<1, false, false>(F, ln_g + 0 * 2048, ln_b + 0 * 2048, nullptr); PHASE_END
    }
#define DENSE_FFN(f, lnidx, enbit) \
    if (MK_ENABLE & (enbit)) { \
        PHASE_BEGIN \
        if ((f) == FFN_GU8) { \
          pg8::LinOrder S{T / 256, 2 * DFF / 256, F.G, bx, (const char*)(scr + S_HB8), (const char*)(F.ws + W_F_GU) + (size_t)(f) * 2 * DFF * 2048, (size_t)256 * 1024, (size_t)256 * 1024}; \
          pg8::Gemm gm{512, 1, 1, (size_t)128 * 1024, (size_t)128 * 1024};     \
          pg8::EpiSwiglu8 E{(unsigned char*)(scr + S_HID), DFF, 1.f / WSCALE8}; \
          pg8::gemm_phase<pg8::EpiSwiglu8, pg8::LinOrder, true, 1>(F.lds, F.wave, gm, S, E); \
        } else { pg8::LinOrder S{T / 256, 2 * DFF / 256, F.G, bx, (const char*)hb, (const char*)(F.ws + W_F_GU) + (size_t)(f) * 2 * DFF * 2048, (size_t)256 * 2048, (size_t)256 * 2048}; \
          pg8::Gemm gm{1024, 1, 1, (size_t)128 * 2048, (size_t)128 * 2048}; \
          pg8::EpiSwiglu8 E{(unsigned char*)(scr + S_HID), DFF}; \
          pg8::gemm_phase(F.lds, F.wave, gm, S, E); } \
        PHASE_END \
        PHASE_BEGIN \
        { pg8::LinOrder S{T / 256, 4, F.G, bx, (const char*)(scr + S_HID), (const char*)(F.ws + W_F_D) + (size_t)(f) * 1024 * DFF * 2, (size_t)256 * DFF, (size_t)256 * DFF}; \
          pg8::Gemm gm{DFF / 2, 1, 1, (size_t)128 * DFF, (size_t)128 * DFF};     \
          pg8::EpiResLn<false> E{(bf16*)(F.ws + WS_HB), ln_g + (lnidx) * 1024, ln_b + (lnidx) * 1024, ALPHA, 1.f / WSCALE8D, (float*)(scr + S_Y), (unsigned*)(F.ctl + CW_LNC + (2 + (f)) * 4096), (unsigned*)(F.ctl + CW_BAR) + XB_TMO, nullptr, F.lds + LNT_OFF}; \
          pg8::gemm_phase<pg8::EpiResLn<false>, pg8::LinOrder, true, 1>(F.lds, F.wave, gm, S, E); }     \
        PHASE_END \
    } else { \
        PHASE_BEGIN ln_phase<1, false, false>(F, ln_g + (lnidx) * 1024, ln_b + (lnidx) * 1024, nullptr); PHASE_END \
    }
    DENSE_FFN(0, 1, 2)

    if (MK_ENABLE & 4) {
        PHASE_BEGIN
        { pg8::LinOrder S{T / 256, 4, F.G, bx, (const char*)hb, (const char*)(F.ws + W_B_IN), (size_t)256 * 2048, (size_t)256 * 2048};
          pg8::Gemm gm{1024, 1, 1, (size_t)128 * 2048, (size_t)128 * 2048};
          pg8::EpiBf16<0> E{(bf16*)(scr + S_BCX), 1024};
          pg8::gemm_phase(F.lds, F.wave, gm, S, E); }
        { pg8::LinOrder S{T / 256, 8, F.G, bx, (const char*)hb, (const char*)(F.ws + W_B_IN) + (size_t)1024 * 2048, (size_t)256 * 2048, (size_t)256 * 2048};
          pg8::Gemm gm{1024, 1, 1, (size_t)128 * 2048, (size_t)128 * 2048};
          pg8::EpiGlu<0> E{(bf16*)(scr + S_BCX + (size_t)128 * MiB), 1024};
          pg8::gemm_phase(F.lds, F.wave, gm, S, E); }
        PHASE_END
        PHASE_BEGIN conv_phase(F, args.in[7]); if (MK_PROBE & 4) conv_phase(F, args.in[7]); PHASE_END
        PHASE_BEGIN
        { pg8::LinOrder S{T / 256, 4, F.G, bx, (const char*)(scr + S_P), (const char*)(F.ws + W_B_O), (size_t)256 * 2048, (size_t)256 * 2048};
          pg8::Gemm gm{1024, 1, 1, (size_t)128 * 2048, (size_t)128 * 2048};
          pg8::EpiResBf16 E{hb, (bf16*)F.out, 1024, ALPHA};
          pg8::gemm_phase(F.lds, F.wave, gm, S, E); }
        PHASE_END
        PHASE_BEGIN ln_phase<0, true, false>(F, ln_g + 2 * 1024, ln_b + 2 * 1024, args.in[20]); PHASE_END
    } else {
        PHASE_BEGIN ln_phase<1, true, false>(F, ln_g + 2 * 1024, ln_b + 2 * 1024, args.in[20]); PHASE_END
    }
#define MOE_CHUNK(f, ck) \
        PHASE_BEGIN \
        { const MoeSeg sg = moe_seg(F, (f)); int nM = sg.ts[8] - (ck) * MOE_CH_TILES; nM = nM > MOE_CH_TILES ? MOE_CH_TILES : (nM < 0 ? 0 : nM); \
          MoeOrder S{nM, 2 * DFE / 256, F.G, bx, (ck) * MOE_CH_TILES, sg, (const char*)F.out, (const char*)(F.ws + W_E_GU) + (size_t)(f) * 8 * 2 * DFE * 2048, (size_t)256 * 1024, (size_t)2 * DFE * 2048, (size_t)256 * 1024, false, true}; \
          pg8::Gemm gm{512, 1, 1, (size_t)128 * 1024, (size_t)128 * 1024};     \
          pg8::EpiSwiglu8 E{(unsigned char*)(scr + S_MHID), DFE, 1.f / WSCALE8}; \
          pg8::gemm_phase<pg8::EpiSwiglu8, MoeOrder, true, 0x7C>(F.lds, F.wave, gm, S, E);     if ((ck) == 0 && (MK_PROBE & 32)) pg8::gemm_phase(F.lds, F.wave, gm, S, E); } \
        PHASE_END \
        PHASE_BEGIN \
        { const MoeSeg sg = moe_seg(F, (f)); int nM = sg.ts[8] - (ck) * MOE_CH_TILES; nM = nM > MOE_CH_TILES ? MOE_CH_TILES : (nM < 0 ? 0 : nM); \
          MoeOrder S{nM, 4, F.G, bx, (ck) * MOE_CH_TILES, sg, (const char*)(scr + S_MHID), (const char*)(F.ws + W_E_D) + (size_t)(f) * 8 * 1024 * DFE * 2, (size_t)256 * DFE, (size_t)1024 * DFE * 2, (size_t)256 * DFE, true, false}; \
          pg8::Gemm gm{DFE / 2, 1, 1, (size_t)128 * DFE, (size_t)128 * DFE};     \
          pg8::EpiF8 E{scr + S_XG, 1024, YSCALE8 / WSCALE8D};     \
          pg8::gemm_phase<pg8::EpiF8, MoeOrder, true, 0x7B>(F.lds, F.wave, gm, S, E);     if ((ck) == 0 && (MK_PROBE & 64)) pg8::gemm_phase(F.lds, F.wave, gm, S, E); } \
        PHASE_END
#define MOE_FFN(f, lnidx, enbit, fin) \
    if (MK_ENABLE & (enbit)) { \
        PHASE_BEGIN moe_gather_phase(F, (f)); if (MK_PROBE & 4) moe_gather_phase(F, (f)); PHASE_END \
        MOE_CHUNK(f, 0) MOE_CHUNK(f, 1) MOE_CHUNK(f, 2) \
        PHASE_BEGIN ln_phase<2, false, fin, (f) == 0>(F, ln_g + (lnidx) * 1024, ln_b + (lnidx) * 1024, nullptr); PHASE_END \
    } else { \
        PHASE_BEGIN ln_phase<1, false, fin>(F, ln_g + (lnidx) * 1024, ln_b + (lnidx) * 1024, nullptr); PHASE_END \
    }
    MOE_FFN(0, 3, 8, false)

    if (MK_ENABLE & 16) {
        PHASE_BEGIN
        { pg8::LinOrder S{T / 256, 8, F.G, bx, (const char*)hb, (const char*)(F.ws + W_C_QK), (size_t)256 * 2048, (size_t)256 * 2048};
          pg8::Gemm gm{1024, 1, 1, (size_t)128 * 2048, (size_t)128 * 2048};
          pg8::EpiBf16<0> E{(bf16*)(scr + S_CQK), 2048};
          pg8::gemm_phase(F.lds, F.wave, gm, S, E); }
        { pg8::LinOrder S{4, T / 256, F.G, bx, (const char*)(F.ws + W_C_V), (const char*)(scr + S_HB8), (size_t)256 * 1024, (size_t)256 * 1024};
          pg8::Gemm gm{512, 1, 1, (size_t)128 * 1024, (size_t)128 * 1024};
          pg8::EpiBf16<0> E{(bf16*)(scr + S_CVT), T, 1.f / WSCALE8};
          pg8::gemm_phase<pg8::EpiBf16<0>, pg8::LinOrder, true, 1>(F.lds, F.wave, gm, S, E); }
        PHASE_END
#ifdef MK_SELFCHECK
        PHASE_BEGIN selfcheck_buf(F, scr + S_CQK, (size_t)256 * MiB, 40, 0); selfcheck_buf(F, scr + S_CVT, (size_t)128 * MiB, 41, 65536); PHASE_END
#endif
        PHASE_BEGIN kmean_phase(F); if (MK_PROBE & 4) kmean_phase(F); PHASE_END
#ifdef MK_SELFCHECK
        PHASE_BEGIN selfcheck_buf(F, F.ws + WS_KMEAN, (size_t)1 * MiB, 42, 65536 + 32768); PHASE_END
#endif
        PHASE_BEGIN moba_phase3(F); if (MK_PROBE & 2) moba_phase3(F); PHASE_END
#ifdef MK_SELFCHECK
        PHASE_BEGIN selfcheck_buf(F, F.ws + WS_NEED + 3 * MiB, (size_t)4 * MiB, 43, 65536 + 32768 + 256); selfcheck_buf(F, F.ws + WS_NEED + 7 * MiB, (size_t)4 * MiB, 44, 65536 + 32768 + 256 + 1024);
                    selfcheck_buf(F, scr + S_CATT, (size_t)128 * MiB, 45, 65536 + 32768 + 256 + 2048); PHASE_END
#endif
        PHASE_BEGIN
        { pg8::LinOrder S{T / 256, 4, F.G, bx, (const char*)(scr + S_CATT), (const char*)(F.ws + W_C_O), (size_t)256 * 1024, (size_t)256 * 1024};
          pg8::Gemm gm{512, 1, 1, (size_t)128 * 1024, (size_t)128 * 1024};
          pg8::EpiResLn<FFN_GU8 == 1> E{(bf16*)(F.ws + WS_HB), ln_g + 4 * 1024, ln_b + 4 * 1024, ALPHA, 1.f / (WSCALE8 * ASCALE8), (float*)scr, (unsigned*)(F.ctl + CW_LNC + 1 * 4096), (unsigned*)(F.ctl + CW_BAR) + XB_TMO, scr + S_HB8, F.lds + LNT_OFF};
          pg8::gemm_phase<pg8::EpiResLn<FFN_GU8 == 1>, pg8::LinOrder, true, 1>(F.lds, F.wave, gm, S, E); }
        PHASE_END
    } else {
        PHASE_BEGIN ln_phase<1, false, false>(F, ln_g + 4 * 1024, ln_b + 4 * 1024, nullptr); PHASE_END
    }
    DENSE_FFN(1, 5, 32)

    if (MK_ENABLE & 64) {
        PHASE_BEGIN
        { pg8::LinOrder S{T / 256, 8, F.G, bx, (const char*)hb, (const char*)(F.ws + W_D_IN), (size_t)256 * 2048, (size_t)256 * 2048};
          pg8::Gemm gm{1024, 1, 1, (size_t)128 * 2048, (size_t)128 * 2048};
          pg8::EpiBf16<1> E{(bf16*)(scr + S_UV), 2048};
          pg8::gemm_phase(F.lds, F.wave, gm, S, E); }
        PHASE_END
        PHASE_BEGIN gmlp_phase(F, args.in[12], args.in[13], args.in[15]); if (MK_PROBE & 4) gmlp_phase(F, args.in[12], args.in[13], args.in[15]); PHASE_END
        PHASE_BEGIN
        { pg8::LinOrder S{T / 256, 4, F.G, bx, (const char*)(scr + S_P), (const char*)(F.ws + W_D_O), (size_t)256 * 2048, (size_t)256 * 2048};
          pg8::Gemm gm{1024, 1, 1, (size_t)128 * 2048, (size_t)128 * 2048};
          pg8::EpiResBf16 E{hb, (bf16*)F.out, 1024, ALPHA};
          pg8::gemm_phase(F.lds, F.wave, gm, S, E); }
        PHASE_END
        PHASE_BEGIN ln_phase<0, true, false>(F, ln_g + 6 * 1024, ln_b + 6 * 1024, args.in[20] + 8192); PHASE_END
    } else {
        PHASE_BEGIN ln_phase<1, true, false>(F, ln_g + 6 * 1024, ln_b + 6 * 1024, args.in[20] + 8192); PHASE_END
    }
    MOE_FFN(1, 7, 128, true)
#ifdef MK_SELFCHECK
    PHASE_BEGIN
    { const unsigned fl = __hip_atomic_load((unsigned*)(F.ctl + 32), RLX_AGENT);
      if (fl != 0u) { const int code = 1000 - (int)fl; const float cval = (code >= 40 && code <= 45) ? (float)(20 + 2 * (code - 40)) : (float)(1u << (code / 10 + 1)); const int gw = F.vcu * NWAVES + F.wave, NGW = F.G * NWAVES;
          for (int m = gw; m < T; m += NGW) { f32x4* w = (f32x4*)(F.out + (size_t)m * D) + F.lane;
#pragma unroll
              for (int j = 0; j < 4; ++j) w[64 * j] = (f32x4){cval, cval, cval, cval}; } } }
    PHASE_END
#endif
#undef PHASE_BEGIN
#undef PHASE_END
#undef scr
#undef hb
#undef ln_g
#undef ln_b
}

static int count_phases() {
    int n = 1;
    n += (MK_ENABLE & 1) ? (8 + 1 + 1) : 1;
    n += (MK_ENABLE & 2) ? 2 : 1;
    n += (MK_ENABLE & 4) ? 4 : 1;
    n += (MK_ENABLE & 8) ? 8 : 1;
    n += (MK_ENABLE & 16) ? 4 : 1;
    n += (MK_ENABLE & 32) ? 2 : 1;
    n += (MK_ENABLE & 64) ? 4 : 1;
    n += (MK_ENABLE & 128) ? 8 : 1;
#ifdef MK_SELFCHECK
    n += 1 + 3;
#endif
    return n;
}
extern "C" void kernel_launch(void* const* d_in, const int* in_sizes, int n_in, void* d_out, int out_size, void* d_ws, size_t ws_size, hipStream_t stream) {
    static int grid = 0;
    if (grid == 0) {
        if (n_in != 24 || in_sizes[0] != T * D || out_size != T * D || ws_size < WS_NEED) { fprintf(stderr, "kernel_launch: unexpected shapes (n_in %d, in0 %d, out %d, ws %zu < %zu); nothing launched\n", n_in, n_in > 0 ? in_sizes[0] : -1, out_size, ws_size, (size_t)WS_NEED); grid = -1; return; }
        int dev = 0, cus = 0, per_cu = 0;
        if (hipGetDevice(&dev) != hipSuccess || hipDeviceGetAttribute(&cus, hipDeviceAttributeMultiprocessorCount, dev) != hipSuccess) { grid = -1; return; }
        if (hipFuncSetAttribute((const void*)mk_fwd, hipFuncAttributeMaxDynamicSharedMemorySize, LDS_BYTES) != hipSuccess) { fprintf(stderr, "kernel_launch: hipFuncSetAttribute failed\n"); grid = -1; return; }
        if (hipOccupancyMaxActiveBlocksPerMultiprocessor(&per_cu, (const void*)mk_fwd, NWAVES * 64, LDS_BYTES) != hipSuccess || per_cu < 1) fprintf(stderr, "kernel_launch: occupancy query reports %d\n", per_cu);
        (void)hipGetLastError();
        grid = cus;
    }
    if (grid < 0) return;
    (void)hipMemsetAsync((char*)d_ws + WS_CTL, 0, CTL_ZERO_BYTES, stream);
#ifdef SELF_POISON
    (void)hipMemsetAsync((char*)d_ws + CTL_ZERO_BYTES, 0xAA, WS_NEED - CTL_ZERO_BYTES, stream);
    (void)hipMemsetAsync(d_out, 0xAA, (size_t)T * D * 4, stream);
#endif
    Args a{};
    for (int i = 0; i < 24; ++i) a.in[i] = (const float*)d_in[i];
    a.out = (float*)d_out; a.ws = (unsigned char*)d_ws;
    const int nph = count_phases();
#if MK_MULTI
    for (int p = 0; p < nph; ++p) { a.ph_lo = p; a.ph_hi = p + 1; hipLaunchKernelGGL(mk_fwd, dim3(grid), dim3(NWAVES * 64), LDS_BYTES, stream, a); }
#else
    a.ph_lo = 0; a.ph_hi = nph;
#ifdef MK_SELFCHECK
    a.chk = 1;
    hipLaunchKernelGGL(mk_fwd, dim3(grid), dim3(NWAVES * 64), LDS_BYTES, stream, a);
    (void)hipMemsetAsync((char*)d_ws + WS_CTL, 0, CTL_ZERO_BYTES, stream);
    a.chk = 2;
#endif
    hipLaunchKernelGGL(mk_fwd, dim3(grid), dim3(NWAVES * 64), LDS_BYTES, stream, a);
#endif
    const hipError_t le = hipPeekAtLastError();
    if (le != hipSuccess) fprintf(stderr, "kernel_launch: launch failed: %s\n", hipGetErrorName(le));
}
```

```cpp
#include <hip/hip_runtime.h>
#include <cstdio>
#include <cstdint>

#ifndef MK_MULTI
#define MK_MULTI 0
#endif
#ifndef MK_PROBE
#define MK_PROBE 0
#endif
#ifndef MK_ENABLE
#define MK_ENABLE 0xFF
#endif

#define GAS __attribute__((address_space(1)))
#define LAS __attribute__((address_space(3)))
typedef unsigned short bf16;
typedef short bf16x8 __attribute__((ext_vector_type(8)));
typedef float f32x4 __attribute__((ext_vector_type(4)));
typedef float f32x2 __attribute__((ext_vector_type(2)));
typedef float f32x16 __attribute__((ext_vector_type(16)));
typedef unsigned u32x4 __attribute__((ext_vector_type(4)));
typedef unsigned u32x2 __attribute__((ext_vector_type(2)));
typedef GAS unsigned gu32;
typedef int v8i_t __attribute__((ext_vector_type(8)));
typedef int v4i_t __attribute__((ext_vector_type(4)));
typedef short s16x16_t __attribute__((ext_vector_type(16)));

constexpr int D = 1024, NB = 32, SEQ = 2048, T = NB * SEQ, NH = 16, HD = 64;
constexpr int DFF = 2816, NE = 8, DFE = 3584;
constexpr float ALPHA = 1.6817928305074290f;
constexpr float LN_EPS = 1e-5f;
constexpr float LOG2E = 1.4426950408889634f;
constexpr float QSCALE = 0.125f * LOG2E;
constexpr float NEGB = -1e30f;
constexpr int TC = 16384;
constexpr int MOE_CH_TILES = 256;
constexpr int MOE_MAX_TILES = 520;
constexpr int FFN_GU8 = 1;

constexpr size_t MiB = 1u << 20;
constexpr size_t WS_CTL = 0, CTL_ZERO_BYTES = 1 * MiB;
constexpr size_t WS_BUCKET = 1 * MiB;
constexpr size_t WS_BTABA = WS_BUCKET + 8192;
constexpr size_t WS_BTABC = WS_BTABA + 32768;
constexpr size_t WS_WST = WS_BTABC + 131072;
constexpr size_t WS_KMEAN = 2 * MiB;
constexpr size_t WS_ROUTE = 4 * MiB;
constexpr size_t WS_GATES = 5 * MiB;
constexpr size_t WS_SLOTS = 6 * MiB;
constexpr size_t WS_WCNT = 7 * MiB;
constexpr size_t WS_W = 8 * MiB;
constexpr size_t W_A_QK = WS_W;
constexpr size_t W_A_V = W_A_QK + 12 * MiB;
constexpr size_t W_A_O = W_A_V + 6 * MiB;
constexpr size_t W_B_IN = W_A_O + 2 * MiB;
constexpr size_t W_B_O = W_B_IN + 6 * MiB;
constexpr size_t W_C_QK = W_B_O + 2 * MiB;
constexpr size_t W_C_V = W_C_QK + 4 * MiB;
constexpr size_t W_C_O = W_C_V + 2 * MiB;
constexpr size_t W_D_IN = W_C_O + 2 * MiB;
constexpr size_t W_D_O = W_D_IN + 4 * MiB;
constexpr size_t W_F_GU = W_D_O + 2 * MiB;
constexpr size_t W_F_D = W_F_GU + 22 * MiB;
constexpr size_t W_E_GU = W_F_D + 11 * MiB;
constexpr size_t W_E_D = W_E_GU + 224 * MiB;
constexpr size_t WS_HB = W_E_D + 112 * MiB;
constexpr size_t WS_SCR = WS_HB + 128 * MiB;
constexpr size_t WS_NEED = WS_SCR + 512 * MiB;
static_assert(WS_HB == 419 * MiB, "map");
constexpr size_t S_QK = 0;
constexpr size_t S_VT = 192 * MiB;
constexpr size_t S_HB8 = 448 * MiB;
constexpr size_t S_ATT = 288 * MiB;
constexpr size_t S_HID = 0;
constexpr size_t S_BCX = 0;
constexpr size_t S_P = 384 * MiB;
constexpr size_t S_XG = 0;
constexpr size_t S_MHID = 260 * MiB;
constexpr size_t S_Y = 256 * MiB;
constexpr size_t S_CQK = 0;
constexpr size_t S_CVT = 256 * MiB;
constexpr size_t S_CATT = 384 * MiB;
constexpr size_t S_UV = 0;
constexpr size_t O_OG = 0;
constexpr size_t O_LSE = 96 * MiB;
constexpr int CW_TMO = 0;
constexpr int CW_ECNT = 64;
constexpr int CW_BAR = 4096;
constexpr int CW_LNC = 16384;

constexpr float YSCALE8 = 16.f;
constexpr float ASCALE8 = 8.f;
constexpr float WSCALE8 = 64.f, WSCALE8D = 256.f;
__device__ __forceinline__ unsigned pk4_fp8(float a, float b, float c, float d) { int p = 0; p = __builtin_amdgcn_cvt_pk_fp8_f32(a, b, p, false); p = __builtin_amdgcn_cvt_pk_fp8_f32(c, d, p, true); return (unsigned)p; }
namespace pg8 {
constexpr int BM = 256, BK = 64, HALF = 128, HTB = HALF * BK * 2, STAGE_BYTES = 8 * HTB, NXCD = 8, WGM = 8;
__host__ __device__ __forceinline__ int lds_byte(int r, int c) { const int st = (r >> 4) * 2 + (c >> 5), rr = r & 15, cc = c & 31, ob = rr * 64 + cc * 2; return st * 1024 + (ob ^ (((ob >> 9) & 1) << 5)); }
__host__ __device__ __forceinline__ void stage_rc(int b, int& R, int& C) { const int st = b / 1024, sb = b % 1024, swz = sb ^ (((sb >> 9) & 1) << 5); R = (st >> 1) * 16 + swz / 64; C = (st & 1) * 32 + (swz % 64) / 2; }
__host__ __device__ __forceinline__ int perm32(int rho) { const int n = rho >> 4, i = rho & 15; return 8 * (i >> 2) + 4 * n + (i & 3); }

struct Unit { int pm, pn; unsigned a, b; };
struct Gemm { int K; int rsA, rsB; size_t hstepA, hstepB; };

__device__ __forceinline__ bool tile_of(long L, int nM, int nN, int& pm, int& pn) {
    const int nwg = nM * nN; if (L >= nwg) return false;
    int wgid = (int)L; { const int q = nwg / NXCD, r = nwg % NXCD, xcd = wgid % NXCD, off = wgid / NXCD; wgid = (xcd < r ? xcd * (q + 1) : r * (q + 1) + (xcd - r) * q) + off; }
    const int nig = WGM * nN, gid = wgid / nig, fm = gid * WGM, gsz = (nM - fm) < WGM ? (nM - fm) : WGM;
    pm = fm + ((wgid % nig) % gsz); pn = (wgid % nig) / gsz; return true;
}
struct LinOrder {
    int nM, nN, G, c; const char* A0; const char* B0; size_t aT, bT;
    __device__ __forceinline__ bool next(int i, Unit& u) const { if (!tile_of((long)i * G + c, nM, nN, u.pm, u.pn)) return false; u.a = (unsigned)((size_t)u.pm * aT); u.b = (unsigned)((size_t)u.pn * bT); return true; }
};

typedef __bf16 bf16x2_t __attribute__((ext_vector_type(2)));
__device__ __forceinline__ unsigned cvt_pk_bf16(float lo, float hi) { f32x2 v = {lo, hi}; bf16x2_t b = __builtin_convertvector(v, bf16x2_t); return __builtin_bit_cast(unsigned, b); }
__device__ __forceinline__ f32x2 gelu_pk(f32x2 v) {
    const f32x2 av = __builtin_elementwise_abs(v), d = av * 0.2316418882f + 1.0f;
    f32x2 t; t.x = __builtin_amdgcn_rcpf(d.x); t.y = __builtin_amdgcn_rcpf(d.y);
    f32x2 q = t * 0.5307027145f + (-0.7265760135f); q = q * t + 0.7107068705f; q = q * t + (-0.142248368f); q = q * t + 0.127414796f; q = q * t;
    const f32x2 s = (v * v) * (-0.72134752044f);
    f32x2 e; e.x = __builtin_amdgcn_exp2f(s.x); e.y = __builtin_amdgcn_exp2f(s.y);
    const f32x2 m = v * (q * e), r = v - m;
    f32x2 o; o.x = v.x < 0.f ? m.x : r.x; o.y = v.y < 0.f ? m.y : r.y; return o;
}
__device__ __forceinline__ float silu_f(float g) { return g * __builtin_amdgcn_rcpf(1.0f + __builtin_amdgcn_exp2f(-LOG2E * g)); }

template <int ACT  > struct EpiBf16 {
    static constexpr bool PERM = true;
    bf16* O; int ldc; float sc = 1.f;
    __device__ __forceinline__ void operator()(const f32x4 (&acc)[2][2][4][2], const Unit& u, int wr, int wc, int fr, int fq) const {
        const int row0 = u.pm * BM + wr * 64 + fr, col0 = u.pn * BM + wc * 32 + 8 * fq;
#pragma unroll
        for (int ai = 0; ai < 2; ++ai)
#pragma unroll
            for (int m = 0; m < 4; ++m) { bf16* rowp = O + (size_t)(row0 + ai * HALF + m * 16) * ldc + col0;
#pragma unroll
                for (int bj = 0; bj < 2; ++bj) { f32x4 v0 = acc[ai][bj][m][0] * sc, v1 = acc[ai][bj][m][1] * sc;
                    if (ACT == 1) { f32x2 a = gelu_pk((f32x2){v0[0], v0[1]}), b = gelu_pk((f32x2){v0[2], v0[3]}), c = gelu_pk((f32x2){v1[0], v1[1]}), d = gelu_pk((f32x2){v1[2], v1[3]});
                        v0 = (f32x4){a.x, a.y, b.x, b.y}; v1 = (f32x4){c.x, c.y, d.x, d.y}; }
                    u32x4 w; w.x = cvt_pk_bf16(v0[0], v0[1]); w.y = cvt_pk_bf16(v0[2], v0[3]); w.z = cvt_pk_bf16(v1[0], v1[1]); w.w = cvt_pk_bf16(v1[2], v1[3]);
                    *(u32x4*)(rowp + bj * HALF) = w; } }
    }
};
struct EpiF8 {
    static constexpr bool PERM = true;
    unsigned char* O; int ldc; float sc = 1.f;
    __device__ __forceinline__ void operator()(const f32x4 (&acc)[2][2][4][2], const Unit& u, int wr, int wc, int fr, int fq) const {
        const int row0 = u.pm * BM + wr * 64 + fr, col0 = u.pn * BM + wc * 32 + 8 * fq;
#pragma unroll
        for (int ai = 0; ai < 2; ++ai)
#pragma unroll
            for (int m = 0; m < 4; ++m) { unsigned char* rowp = O + (size_t)(row0 + ai * HALF + m * 16) * ldc + col0;
#pragma unroll
                for (int bj = 0; bj < 2; ++bj) { const f32x4 v0 = acc[ai][bj][m][0] * sc, v1 = acc[ai][bj][m][1] * sc;
                    u32x2 w; w.x = pk4_fp8(v0[0], v0[1], v0[2], v0[3]); w.y = pk4_fp8(v1[0], v1[1], v1[2], v1[3]);
                    *(u32x2*)(rowp + bj * HALF) = w; } }
    }
};
template <int ACT  > struct EpiGlu {
    static constexpr bool PERM = true;
    bf16* O; int ldc;
    __device__ __forceinline__ void operator()(const f32x4 (&acc)[2][2][4][2], const Unit& u, int wr, int wc, int fr, int fq) const {
        const int row0 = u.pm * BM + wr * 64 + fr, col0 = u.pn * HALF + wc * 32 + 8 * fq;
#pragma unroll
        for (int ai = 0; ai < 2; ++ai)
#pragma unroll
            for (int m = 0; m < 4; ++m) { bf16* rowp = O + (size_t)(row0 + ai * HALF + m * 16) * ldc + col0;
                f32x4 g0 = acc[ai][0][m][0], g1 = acc[ai][0][m][1]; const f32x4 u0 = acc[ai][1][m][0], u1 = acc[ai][1][m][1];
                if (ACT == 1) { g0 = (f32x4){silu_f(g0[0]), silu_f(g0[1]), silu_f(g0[2]), silu_f(g0[3])}; g1 = (f32x4){silu_f(g1[0]), silu_f(g1[1]), silu_f(g1[2]), silu_f(g1[3])}; }
                const f32x4 p0 = g0 * u0, p1 = g1 * u1;
                u32x4 w; w.x = cvt_pk_bf16(p0[0], p0[1]); w.y = cvt_pk_bf16(p0[2], p0[3]); w.z = cvt_pk_bf16(p1[0], p1[1]); w.w = cvt_pk_bf16(p1[2], p1[3]);
                *(u32x4*)rowp = w; }
    }
};
struct EpiSwiglu8 {
    static constexpr bool PERM = true;
    unsigned char* O; int ldc; float s = 1.f;
    __device__ __forceinline__ void operator()(const f32x4 (&acc)[2][2][4][2], const Unit& u, int wr, int wc, int fr, int fq) const {
        const int row0 = u.pm * BM + wr * 64 + fr, col0 = u.pn * HALF + wc * 32 + 8 * fq;
#pragma unroll
        for (int ai = 0; ai < 2; ++ai)
#pragma unroll
            for (int m = 0; m < 4; ++m) { unsigned char* rowp = O + (size_t)(row0 + ai * HALF + m * 16) * ldc + col0;
                const f32x4 g0 = acc[ai][0][m][0], g1 = acc[ai][0][m][1], u0 = acc[ai][1][m][0], u1 = acc[ai][1][m][1];
                const float c1 = -LOG2E * s, s2 = s * s;
                const f32x4 p0 = (g0 * u0) * s2, p1 = (g1 * u1) * s2;
                f32x4 r0, r1;
#pragma unroll
                for (int j = 0; j < 4; ++j) { r0[j] = __builtin_amdgcn_rcpf(1.0f + __builtin_amdgcn_exp2f(g0[j] * c1)); r1[j] = __builtin_amdgcn_rcpf(1.0f + __builtin_amdgcn_exp2f(g1[j] * c1)); }
                const f32x4 o0 = p0 * r0, o1 = p1 * r1;
                u32x2 w; w.x = pk4_fp8(o0[0], o0[1], o0[2], o0[3]); w.y = pk4_fp8(o1[0], o1[1], o1[2], o1[3]);
                *(u32x2*)rowp = w; }
    }
};
struct EpiResBf16 {
    static constexpr bool PERM = true;
    const bf16* base; bf16* out; int ldc; float alpha; float sc = 1.f;
    __device__ __forceinline__ void operator()(const f32x4 (&acc)[2][2][4][2], const Unit& u, int wr, int wc, int fr, int fq) const {
        const int row0 = u.pm * BM + wr * 64 + fr, col0 = u.pn * BM + wc * 32 + 8 * fq;
#pragma unroll
        for (int ai = 0; ai < 2; ++ai)
#pragma unroll
            for (int m = 0; m < 4; ++m) { const size_t off = (size_t)(row0 + ai * HALF + m * 16) * ldc + col0;
#pragma unroll
                for (int bj = 0; bj < 2; ++bj) { const u32x4 b = *(const u32x4*)(base + off + bj * HALF); const f32x4 a0 = acc[ai][bj][m][0] * sc, a1 = acc[ai][bj][m][1] * sc;
                    u32x4 w; w.x = cvt_pk_bf16(__builtin_bit_cast(float, b.x << 16) * alpha + a0[0], __builtin_bit_cast(float, b.x & 0xffff0000u) * alpha + a0[1]);
                    w.y = cvt_pk_bf16(__builtin_bit_cast(float, b.y << 16) * alpha + a0[2], __builtin_bit_cast(float, b.y & 0xffff0000u) * alpha + a0[3]);
                    w.z = cvt_pk_bf16(__builtin_bit_cast(float, b.z << 16) * alpha + a1[0], __builtin_bit_cast(float, b.z & 0xffff0000u) * alpha + a1[1]);
                    w.w = cvt_pk_bf16(__builtin_bit_cast(float, b.w << 16) * alpha + a1[2], __builtin_bit_cast(float, b.w & 0xffff0000u) * alpha + a1[3]);
                    *(u32x4*)(out + off + bj * HALF) = w; }
                asm volatile("" ::: "memory"); }
    }
};

template <bool HB8> struct EpiResLn {
    static constexpr bool PERM = true;
    bf16* h; const float* gain; const float* bias; float alpha, sc;
    float* xbuf;
    unsigned* cnt;
    unsigned* tmo;
    unsigned char* h8;
    LAS unsigned char* tb;
    __device__ __forceinline__ void operator()(f32x4 (&acc)[2][2][4][2], const Unit& u, int wr, int wc, int fr, int fq) const {
        asm volatile("" : "+v"(fr), "+v"(fq));
        const int row0 = u.pm * BM + wr * 64 + fr, col0 = u.pn * BM + wc * 32 + 8 * fq;
        LAS f32x2* P = (LAS f32x2*)tb; LAS f32x2* S = (LAS f32x2*)(tb + 8192);
#pragma unroll
        for (int ai = 0; ai < 2; ++ai)
#pragma unroll
            for (int m = 0; m < 4; ++m) { const size_t off = (size_t)(row0 + ai * HALF + m * 16) * 1024 + col0; float sm = 0.f, sq = 0.f;
#pragma unroll
                for (int bj = 0; bj < 2; ++bj) { const u32x4 b = *(const u32x4*)(h + off + bj * HALF); const f32x4 a0 = acc[ai][bj][m][0] * sc, a1 = acc[ai][bj][m][1] * sc;
                    f32x4 z0, z1;
                    z0[0] = __builtin_bit_cast(float, b.x << 16) * alpha + a0[0]; z0[1] = __builtin_bit_cast(float, b.x & 0xffff0000u) * alpha + a0[1];
                    z0[2] = __builtin_bit_cast(float, b.y << 16) * alpha + a0[2]; z0[3] = __builtin_bit_cast(float, b.y & 0xffff0000u) * alpha + a0[3];
                    z1[0] = __builtin_bit_cast(float, b.z << 16) * alpha + a1[0]; z1[1] = __builtin_bit_cast(float, b.z & 0xffff0000u) * alpha + a1[1];
                    z1[2] = __builtin_bit_cast(float, b.w << 16) * alpha + a1[2]; z1[3] = __builtin_bit_cast(float, b.w & 0xffff0000u) * alpha + a1[3];
                    acc[ai][bj][m][0] = z0; acc[ai][bj][m][1] = z1;
                    sm += ((z0[0] + z0[1]) + (z0[2] + z0[3])) + ((z1[0] + z1[1]) + (z1[2] + z1[3]));
                    sq += ((z0[0] * z0[0] + z0[1] * z0[1]) + (z0[2] * z0[2] + z0[3] * z0[3])) + ((z1[0] * z1[0] + z1[1] * z1[1]) + (z1[2] * z1[2] + z1[3] * z1[3])); }
                sm += __shfl_xor(sm, 16); sm += __shfl_xor(sm, 32); sq += __shfl_xor(sq, 16); sq += __shfl_xor(sq, 32);
                if (fq == 0) P[(ai * HALF + wr * 64 + m * 16 + fr) * 4 + wc] = (f32x2){sm, sq};
                asm volatile("" ::: "memory"); }
        asm volatile("s_waitcnt lgkmcnt(0)" ::: "memory"); __builtin_amdgcn_s_barrier(); asm volatile("" ::: "memory");
        const int wid = wr * 4 + wc, lane = fq * 16 + fr, row = wid * 32 + (lane & 31);
        unsigned long long* slots = (unsigned long long*)xbuf + (size_t)(u.pm * BM + row) * 4;
        if (lane < 32) { const f32x2 a = P[row * 4 + 0], b = P[row * 4 + 1], c = P[row * 4 + 2], d = P[row * 4 + 3];
            const float ts = (a.x + b.x) + (c.x + d.x), tq = (a.y + b.y) + (c.y + d.y);
            __hip_atomic_store(slots + u.pn, ((unsigned long long)__builtin_bit_cast(unsigned, tq) << 32) | (unsigned long long)__builtin_bit_cast(unsigned, ts), __ATOMIC_RELAXED, __HIP_MEMORY_SCOPE_AGENT); }
        asm volatile("s_waitcnt vmcnt(0)" ::: "memory");
        if (lane == 0) (void)__hip_atomic_fetch_add(cnt + 16 * u.pm, 1u, __ATOMIC_RELAXED, __HIP_MEMORY_SCOPE_AGENT);
        if (wid == 0) { unsigned sp = 0u;
            while ((unsigned)__builtin_amdgcn_readfirstlane(__hip_atomic_load(cnt + 16 * u.pm, __ATOMIC_RELAXED, __HIP_MEMORY_SCOPE_AGENT)) < 32u) { __builtin_amdgcn_s_sleep(1);
                if ((++sp & 255u) == 0u) { if (__hip_atomic_load(tmo, __ATOMIC_RELAXED, __HIP_MEMORY_SCOPE_AGENT)) break; if (sp > (1u << 22)) { if (lane == 0) (void)__hip_atomic_fetch_add(tmo, 1u, __ATOMIC_RELAXED, __HIP_MEMORY_SCOPE_AGENT); break; } } }
            __builtin_amdgcn_fence(__ATOMIC_ACQUIRE, "agent"); }
        asm volatile("s_waitcnt vmcnt(0) lgkmcnt(0)" ::: "memory"); __builtin_amdgcn_s_barrier(); asm volatile("" ::: "memory");
        if (lane < 32) { float ts = 0.f, tq = 0.f;
#pragma unroll
            for (int t = 0; t < 4; ++t) { const unsigned long long w = __hip_atomic_load(slots + t, __ATOMIC_RELAXED, __HIP_MEMORY_SCOPE_AGENT); ts += __builtin_bit_cast(float, (unsigned)w); tq += __builtin_bit_cast(float, (unsigned)(w >> 32)); }
            const float mean = ts * (1.f / 1024.f), var = fmaxf(tq * (1.f / 1024.f) - mean * mean, 0.f);
            S[row] = (f32x2){mean, 1.f / sqrtf(var + LN_EPS)}; }
        asm volatile("s_waitcnt vmcnt(0) lgkmcnt(0)" ::: "memory"); __builtin_amdgcn_s_barrier(); asm volatile("" ::: "memory");
#pragma unroll
        for (int bj = 0; bj < 2; ++bj) { const f32x4 g0 = *(const f32x4*)(gain + col0 + bj * HALF), g1 = *(const f32x4*)(gain + col0 + bj * HALF + 4), b0 = *(const f32x4*)(bias + col0 + bj * HALF), b1 = *(const f32x4*)(bias + col0 + bj * HALF + 4);
#pragma unroll
            for (int ai = 0; ai < 2; ++ai)
#pragma unroll
                for (int m = 0; m < 4; ++m) { const int r = ai * HALF + wr * 64 + m * 16 + fr; const f32x2 sr = S[r]; const size_t off = (size_t)(u.pm * BM + r) * 1024 + col0 + bj * HALF;
                    const f32x4 y0 = (acc[ai][bj][m][0] - sr.x) * sr.y * g0 + b0, y1 = (acc[ai][bj][m][1] - sr.x) * sr.y * g1 + b1;
                    u32x4 w; w.x = cvt_pk_bf16(y0[0], y0[1]); w.y = cvt_pk_bf16(y0[2], y0[3]); w.z = cvt_pk_bf16(y1[0], y1[1]); w.w = cvt_pk_bf16(y1[2], y1[3]);
                    *(u32x4*)(h + off) = w;
                    if (HB8) { u32x2 w8; w8.x = pk4_fp8(y0[0], y0[1], y0[2], y0[3]); w8.y = pk4_fp8(y1[0], y1[1], y1[2], y1[3]); *(u32x2*)(h8 + off) = w8; }
                    asm volatile("" ::: "memory"); } }
    }
};

template <class Epi, class Sched, bool ALIGN_EPI = true, int FP8 = 0>
__device__ __forceinline__ void gemm_phase(LAS unsigned char* lds, const int wave_s, const Gemm g, const Sched& S, const Epi& E) {
    int tid = wave_s * 64 + (int)__builtin_amdgcn_mbcnt_hi(~0u, __builtin_amdgcn_mbcnt_lo(~0u, 0u)); asm volatile("" : "+v"(tid));
    const int wid = __builtin_amdgcn_readfirstlane(tid >> 6), lane = tid & 63, wr = wid >> 2, wc = wid & 3, fr = lane & 15, fq = lane >> 4;
    const int K = g.K, nt = K / BK;
    unsigned voffA[2], voffB[2];
#pragma unroll
    for (int i = 0; i < 2; ++i) { int R, C; stage_rc(tid * 16 + i * 8192, R, C); const int Rb = Epi::PERM ? ((R & ~31) + perm32(R & 31)) : R;
        voffA[i] = (unsigned)(R * g.rsA * K + C) * 2u; voffB[i] = (unsigned)(Rb * g.rsB * K + C) * 2u; }
    const unsigned kstep = (unsigned)(BK * 2);
    const unsigned hstepA = (unsigned)g.hstepA, hstepB = (unsigned)g.hstepB;
    const __amdgpu_buffer_rsrc_t rsrcA = __builtin_amdgcn_make_buffer_rsrc((void*)S.A0, 0, 0x7fffffff, 0x00020000), rsrcB = __builtin_amdgcn_make_buffer_rsrc((void*)S.B0, 0, 0x7fffffff, 0x00020000);
    const unsigned ldsw = (unsigned)wid * 1024u;
    const int aoff = lds_byte(wr * 64 + fr, fq * 8), boff = lds_byte(wc * 32 + fr, fq * 8);
    const int aoff8 = lds_byte(wr * 64 + fr, fq * 16), boff8 = lds_byte(wc * 32 + fr, fq * 16);
    unsigned bbase8_ = (unsigned)(4 * HTB + boff); asm volatile("" : "+v"(bbase8_));
    LAS unsigned char* const ldsB8 = lds + bbase8_;
#define PG8_SA(b, h) (((b) * 2 + (h)) * HTB)
#define PG8_SB(b, h) ((4 + (b) * 2 + (h)) * HTB)
#define PG8_STAGE(bufoff, gbase, voff) do { _Pragma("unroll") for (int _i = 0; _i < 2; ++_i) \
        __builtin_amdgcn_raw_ptr_buffer_load_lds(PG8_RS_##voff, (LAS unsigned*)(lds + (bufoff) + ldsw + _i * 8192), 16, (int)(voff)[_i], (int)(gbase), 0, 0); } while (0)
#define PG8_RS_voffA rsrcA
#define PG8_RS_voffB rsrcB
#define PG8_LD16(off) (*(const LAS bf16x8*)(lds + (off)))
#define PG8_CAT8(lo, hi) __builtin_shufflevector(__builtin_bit_cast(v4i_t, lo), __builtin_bit_cast(v4i_t, hi), 0, 1, 2, 3, 4, 5, 6, 7)
#define PG8_LDA(dst, b, h) do { if constexpr (FP8) { _Pragma("unroll") for (int m = 0; m < 4; ++m) dst##8[m] = PG8_CAT8(PG8_LD16(PG8_SA(b, h) + aoff + m * 2048), PG8_LD16(PG8_SA(b, h) + aoff + m * 2048 + 1024)); } \
        else { _Pragma("unroll") for (int m = 0; m < 4; ++m) _Pragma("unroll") for (int k = 0; k < 2; ++k) dst[m][k] = PG8_LD16(PG8_SA(b, h) + aoff + m * 2048 + k * 1024); } } while (0)
#define PG8_LDB(dst, b, h) do { if constexpr (FP8) { _Pragma("unroll") for (int n = 0; n < 2; ++n) dst##8[n] = PG8_CAT8(*(const LAS bf16x8*)(ldsB8 + ((b) * 2 + (h)) * HTB + n * 2048), *(const LAS bf16x8*)(ldsB8 + ((b) * 2 + (h)) * HTB + n * 2048 + 1024)); } \
        else { _Pragma("unroll") for (int n = 0; n < 2; ++n) _Pragma("unroll") for (int k = 0; k < 2; ++k) dst[n][k] = PG8_LD16(PG8_SB(b, h) + boff + n * 2048 + k * 1024); } } while (0)
#define PG8_MMA(ai, bj, At, Bt) do { __builtin_amdgcn_s_setprio(1); \
        if constexpr (FP8) { _Pragma("unroll") for (int m = 0; m < 4; ++m) _Pragma("unroll") for (int n = 0; n < 2; ++n) \
            acc[ai][bj][m][n] = __builtin_amdgcn_mfma_scale_f32_16x16x128_f8f6f4(Bt##8[n], At##8[m], acc[ai][bj][m][n], 0, 0, 0, 0, 0, 0); } \
        else { _Pragma("unroll") for (int m = 0; m < 4; ++m) _Pragma("unroll") for (int n = 0; n < 2; ++n) _Pragma("unroll") for (int k = 0; k < 2; ++k) \
            acc[ai][bj][m][n] = __builtin_amdgcn_mfma_f32_16x16x32_bf16(Bt[n][k], At[m][k], acc[ai][bj][m][n], 0, 0, 0); } \
        __builtin_amdgcn_s_setprio(0); } while (0)
#define PG8_WAIT_V(n) asm volatile("s_waitcnt vmcnt(" #n ")" ::: "memory")
#define PG8_WAIT_L(n) asm volatile("s_waitcnt lgkmcnt(" #n ")" ::: "memory")
#define PG8_BAR __builtin_amdgcn_s_barrier()
#define PG8_SCHED __builtin_amdgcn_sched_barrier(0)
    Unit cur, nxt; int ui = 0;
    if (!S.next(0, cur)) return;
    f32x4 acc[2][2][4][2];
#pragma unroll
    for (int a = 0; a < 2; ++a)
#pragma unroll
        for (int b = 0; b < 2; ++b)
#pragma unroll
            for (int m = 0; m < 4; ++m)
#pragma unroll
                for (int n = 0; n < 2; ++n) acc[a][b][m][n] = (f32x4){0.f, 0.f, 0.f, 0.f};
    bf16x8 At[4][2], B0[2][2], B1[2][2]; v8i_t At8[4], B08[2], B18[2];
    unsigned cA = cur.a, cB = cur.b;
    PG8_STAGE(PG8_SB(0, 0), cB, voffB); PG8_STAGE(PG8_SB(0, 1), cB + hstepB, voffB); PG8_STAGE(PG8_SA(0, 0), cA, voffA); PG8_STAGE(PG8_SA(0, 1), cA + hstepA, voffA);
    if (wr == 1) PG8_BAR;
    PG8_WAIT_V(2); PG8_BAR;
    PG8_STAGE(PG8_SB(1, 0), cB + kstep, voffB); PG8_STAGE(PG8_SA(1, 0), cA + kstep, voffA); PG8_STAGE(PG8_SB(1, 1), cB + hstepB + kstep, voffB);
    PG8_WAIT_V(6); PG8_BAR;
    for (;;) {
        const bool has_next = S.next(ui + 1, nxt);
        const unsigned nA = has_next ? nxt.a : cA, nB = has_next ? nxt.b : cB;
#pragma clang loop unroll(disable)
        for (int t = 0; t < nt; t += 2) {
            const bool last = (t == nt - 2);
            const unsigned a1 = cA + (unsigned)(t + 1) * kstep;
            const unsigned a2 = last ? nA : cA + (unsigned)(t + 2) * kstep, b2 = last ? nB : cB + (unsigned)(t + 2) * kstep;
            const unsigned a3 = a2 + kstep, b3 = b2 + kstep;
            PG8_LDB(B0, 0, 0); PG8_LDB(B1, 0, 1); PG8_SCHED; PG8_LDA(At, 0, 0); PG8_STAGE(PG8_SA(1, 1), a1 + hstepA, voffA);
            PG8_WAIT_V(8); PG8_WAIT_L(0); PG8_BAR; PG8_MMA(0, 0, At, B0); PG8_MMA(0, 1, At, B1); PG8_BAR; PG8_SCHED;
            PG8_LDA(At, 0, 1); PG8_STAGE(PG8_SB(0, 0), b2, voffB); PG8_STAGE(PG8_SB(0, 1), b2 + hstepB, voffB); PG8_STAGE(PG8_SA(0, 0), a2, voffA);
            PG8_WAIT_V(8); PG8_WAIT_L(0); PG8_BAR; PG8_MMA(1, 0, At, B0); PG8_MMA(1, 1, At, B1); PG8_BAR; PG8_SCHED;
            PG8_LDB(B0, 1, 0); PG8_LDB(B1, 1, 1); PG8_SCHED; PG8_LDA(At, 1, 0); PG8_STAGE(PG8_SA(0, 1), a2 + hstepA, voffA);
            PG8_WAIT_V(8); PG8_WAIT_L(0); PG8_BAR; PG8_MMA(0, 0, At, B0); PG8_MMA(0, 1, At, B1); PG8_BAR; PG8_SCHED;
            PG8_LDA(At, 1, 1); PG8_STAGE(PG8_SB(1, 0), b3, voffB); PG8_STAGE(PG8_SB(1, 1), b3 + hstepB, voffB); PG8_STAGE(PG8_SA(1, 0), a3, voffA);
            PG8_WAIT_V(8); PG8_WAIT_L(0); PG8_BAR; PG8_MMA(1, 0, At, B0); PG8_MMA(1, 1, At, B1); PG8_BAR; PG8_SCHED;
        }
        if constexpr (ALIGN_EPI) { if (wr == 0) PG8_BAR; }
        E(acc, cur, wr, wc, fr, fq);
        if (!has_next) break;
#pragma unroll
        for (int a = 0; a < 2; ++a)
#pragma unroll
            for (int b = 0; b < 2; ++b)
#pragma unroll
                for (int m = 0; m < 4; ++m)
#pragma unroll
                    for (int n = 0; n < 2; ++n) acc[a][b][m][n] = (f32x4){0.f, 0.f, 0.f, 0.f};
        cur = nxt; cA = nA; cB = nB; ++ui;
        if constexpr (ALIGN_EPI) { if (wr == 1) PG8_BAR; }
    }
    PG8_WAIT_V(0);
    if constexpr (!ALIGN_EPI) { if (wr == 0) PG8_BAR; }
    PG8_BAR;
#undef PG8_SA
#undef PG8_SB
#undef PG8_STAGE
#undef PG8_RS_voffA
#undef PG8_RS_voffB
#undef PG8_LDA
#undef PG8_LD16
#undef PG8_CAT8
#undef PG8_LDB
#undef PG8_MMA
#undef PG8_WAIT_V
#undef PG8_WAIT_L
#undef PG8_BAR
#undef PG8_SCHED
}
}

#define RLX_AGENT __ATOMIC_RELAXED, __HIP_MEMORY_SCOPE_AGENT
#define LDS_WAIT() asm volatile("s_waitcnt lgkmcnt(0)" ::: "memory")
#define VM_WAIT() asm volatile("s_waitcnt vmcnt(0)" ::: "memory")
__device__ __forceinline__ unsigned f2bf(float f) { unsigned u = __builtin_bit_cast(unsigned, f); return (u + 0x7fffu + ((u >> 16) & 1u)) >> 16; }
__device__ __forceinline__ unsigned pk2(float lo, float hi) { return pg8::cvt_pk_bf16(lo, hi); }
__device__ __forceinline__ float bflo(unsigned w) { return __builtin_bit_cast(float, w << 16); }
__device__ __forceinline__ float bfhi(unsigned w) { return __builtin_bit_cast(float, w & 0xffff0000u); }
__device__ __forceinline__ float wave_sum(float v) {
#pragma unroll
    for (int o = 1; o < 64; o <<= 1) v += __shfl_xor(v, o);
    return v;
}

#define XB_TMO      128
#define XB_XCNT(j)  (256  + 64 * (j))
#define XB_XSUB(j)  (1280 + 64 * (j))
#define XB_XGEN(j)  (2304 + 64 * (j))
#define XB_TOP      3328
#define XB_TOPGEN   3392
#define XCD_BAR_WORDS 3456
#define XB_SPIN_CAP (1u << 22)
__device__ __forceinline__ unsigned xb_ld(unsigned* p)              { return __hip_atomic_load(p, __ATOMIC_RELAXED, __HIP_MEMORY_SCOPE_AGENT); }
__device__ __forceinline__ unsigned xb_add(unsigned* p, unsigned v) { return __hip_atomic_fetch_add(p, v, __ATOMIC_RELAXED, __HIP_MEMORY_SCOPE_AGENT); }
__device__ __forceinline__ unsigned xb_xcc_id() { return (unsigned)__builtin_amdgcn_s_getreg((3 << 11) | 20) & 0xFu; }
#define XB_SPIN(cond, bar) do { unsigned _sp = 0; while (cond) { __builtin_amdgcn_s_sleep(1); \
    if ((++_sp & 255u) == 0u) { if (xb_ld(&(bar)[XB_TMO])) break; if (_sp > XB_SPIN_CAP) { atomicAdd(&(bar)[XB_TMO], 1u); break; } } } } while (0)
struct XcdBarrier { unsigned* bar; unsigned x; volatile LAS unsigned* st; };
__device__ __forceinline__ XcdBarrier xcd_barrier_post(unsigned* bar, volatile LAS unsigned* st) {
    XcdBarrier b; b.bar = bar; b.x = xb_xcc_id(); b.st = st;
    if (threadIdx.x == 0) (void)xb_add(&bar[XB_XCNT(b.x)], 1u);
    return b;
}
__device__ __forceinline__ void xcd_barrier_complete(unsigned* bar, unsigned x, unsigned& nloc, unsigned& nx) {
    const unsigned G = gridDim.x * gridDim.y * gridDim.z;
    unsigned sum, cnt, mine, sp = 0u;
    for (;;) {
        sum = 0u; cnt = 0u; mine = 0u;
#pragma unroll
        for (unsigned j = 0; j < 16; ++j) { const unsigned c = xb_ld(&bar[XB_XCNT(j)]); sum += c; cnt += (c > 0u) ? 1u : 0u; mine = (j == x) ? c : mine; }
        if (sum == G) break;
        __builtin_amdgcn_s_sleep(1);
        if ((++sp & 255u) == 0u) { if (xb_ld(&bar[XB_TMO])) break; if (sp > XB_SPIN_CAP) { atomicAdd(&bar[XB_TMO], 1u); break; } }
    }
    nloc = mine > 0u ? mine : 1u; nx = cnt > 0u ? cnt : 1u;
}
__device__ __forceinline__ void xcd_barrier(const XcdBarrier& b, const int tid) {
    asm volatile("s_waitcnt vmcnt(0)" ::: "memory");
    __syncthreads();
    if (tid == 0) {
        unsigned* bar = b.bar;
        __builtin_amdgcn_s_waitcnt(0);
        unsigned nloc = b.st[0], nx = b.st[1];
        if (nloc == 0u) { xcd_barrier_complete(bar, b.x, nloc, nx); b.st[0] = nloc; b.st[1] = nx; }
        const unsigned old = xb_add(&bar[XB_XSUB(b.x)], 1u);
        const unsigned gen = old / nloc;
        if (old + 1u == (gen + 1u) * nloc) {
            __builtin_amdgcn_fence(__ATOMIC_RELEASE, "agent");
            asm volatile("s_waitcnt vmcnt(0)" ::: "memory");
            const unsigned og = xb_add(&bar[XB_TOP], 1u);
            const unsigned tg = og / nx;
            if (og + 1u == (tg + 1u) * nx) xb_add(&bar[XB_TOPGEN], 1u);
            else XB_SPIN(xb_ld(&bar[XB_TOPGEN]) == tg, bar);
            __builtin_amdgcn_fence(__ATOMIC_ACQUIRE, "agent");
            xb_add(&bar[XB_XGEN(b.x)], 1u);
            asm volatile("s_waitcnt vmcnt(0)" ::: "memory");
        } else {
            XB_SPIN(xb_ld(&bar[XB_XGEN(b.x)]) == gen, bar);
            __builtin_amdgcn_fence(__ATOMIC_ACQUIRE, "agent");
            asm volatile("s_waitcnt vmcnt(0)" ::: "memory");
        }
    }
    __syncthreads();
}

constexpr int NWAVES = 8;
constexpr int RING_BYTES = 131072, MISC_OFF = RING_BYTES + 320, LNT_OFF = RING_BYTES + 2048  , LDS_BYTES = 147456;
struct Args { const float* in[24]; float* out; unsigned char* ws; int ph_lo, ph_hi; int chk, pad; };
struct Frame {
    LAS unsigned char* lds;
    gu32* ctl; unsigned char* ws; float* out;
    int tid, lane, wave, vcu, G;
    int chk, stage;
};

struct Job { const float* src; bf16* dst; int ld, K, N, mode, start; float scale; int fp8, pad; };
constexpr int NJOBS = 74;
__device__ __forceinline__ void make_job(const Args& a, int j, Job& J) {
    unsigned char* ws = a.ws; J.scale = 1.f; J.mode = 0; J.start = 0; J.fp8 = 0; J.pad = 0;
    if (j < 9) { const int g = j / 3, t = j % 3; J.src = a.in[4] + g * 3072 + t * 1024; J.ld = 9216; J.K = 1024; J.N = 1024;
        if (t == 2) J.dst = (bf16*)(ws + W_A_V + (size_t)g * 1024 * 1024); else J.dst = (bf16*)(ws + W_A_QK + (size_t)g * 2048 * 1024 + (size_t)t * 1024 * 1024);
        J.fp8 = 1; J.scale = (t == 0 ? QSCALE : 1.f) * WSCALE8; return; }
    j -= 9;
    if (j == 0) { J.src = a.in[5]; J.ld = 1024; J.K = 1024; J.N = 1024; J.dst = (bf16*)(ws + W_A_O); J.fp8 = 1; J.scale = WSCALE8; return; }
    if (j == 1) { J.src = a.in[6]; J.ld = 3072; J.K = 1024; J.N = 1024; J.dst = (bf16*)(ws + W_B_IN); return; }
    if (j == 9 || j == 10) { J.src = a.in[6] + 1024 * (j - 8); J.ld = 3072; J.K = 1024; J.N = 1024; J.dst = (bf16*)(ws + W_B_IN) + (size_t)1024 * 1024; J.mode = j - 8; return; }
    if (j == 2) { J.src = a.in[8]; J.ld = 1024; J.K = 1024; J.N = 1024; J.dst = (bf16*)(ws + W_B_O); return; }
    if (j == 3) { J.src = a.in[9]; J.ld = 3072; J.K = 1024; J.N = 1024; J.dst = (bf16*)(ws + W_C_QK); J.scale = QSCALE; return; }
    if (j == 4) { J.src = a.in[9] + 1024; J.ld = 3072; J.K = 1024; J.N = 1024; J.dst = (bf16*)(ws + W_C_QK) + (size_t)1024 * 1024; return; }
    if (j == 5) { J.src = a.in[9] + 2048; J.ld = 3072; J.K = 1024; J.N = 1024; J.dst = (bf16*)(ws + W_C_V); J.fp8 = 1; J.scale = WSCALE8; return; }
    if (j == 6) { J.src = a.in[10]; J.ld = 1024; J.K = 1024; J.N = 1024; J.dst = (bf16*)(ws + W_C_O); J.fp8 = 1; J.scale = WSCALE8; return; }
    if (j == 7) { J.src = a.in[11]; J.ld = 2048; J.K = 1024; J.N = 2048; J.dst = (bf16*)(ws + W_D_IN); return; }
    if (j == 8) { J.src = a.in[16]; J.ld = 1024; J.K = 1024; J.N = 1024; J.dst = (bf16*)(ws + W_D_O); return; }
    j -= 11;
    if (j < 6) { const int f = j / 3, t = j % 3;
        if (t < 2) { J.src = a.in[17 + t] + (size_t)f * 1024 * DFF; J.ld = DFF; J.K = 1024; J.N = DFF; J.dst = (bf16*)(ws + W_F_GU) + (size_t)f * 2 * DFF * 1024; J.mode = 1 + t;
            if (f == FFN_GU8) { J.fp8 = 1; J.scale = WSCALE8; } }
        else { J.src = a.in[19] + (size_t)f * DFF * 1024; J.ld = 1024; J.K = DFF; J.N = 1024; J.dst = (bf16*)(ws + W_F_D) + (size_t)f * 1024 * DFF; J.fp8 = 1; J.scale = WSCALE8D; }
        return; }
    j -= 6;
    { const int fe = j / 3, t = j % 3;
        if (t < 2) { J.src = a.in[21 + t] + (size_t)fe * 1024 * DFE; J.ld = DFE; J.K = 1024; J.N = DFE; J.dst = (bf16*)(ws + W_E_GU) + (size_t)fe * 2 * DFE * 1024; J.mode = 1 + t; J.fp8 = 1; J.scale = WSCALE8; }
        else { J.src = a.in[23] + (size_t)fe * DFE * 1024; J.ld = 1024; J.K = DFE; J.N = 1024; J.dst = (bf16*)(ws + W_E_D) + (size_t)fe * 1024 * DFE; J.fp8 = 1; J.scale = WSCALE8D; } }
}
__device__ __forceinline__ void transpose_item(const Job& J, int item, int lane) {
    const int nblk = J.N >> 6, kb = item / nblk, nb = item - kb * nblk, k0 = 64 * kb, n = 64 * nb + lane;
    const float* W = J.src + (size_t)k0 * J.ld + n;
    int r = n; if (J.mode) r = (n >> 7) * 256 + (n & 127) + (J.mode == 2 ? 128 : 0);
    const float sc = J.scale; const size_t ld = (size_t)J.ld;
    if (J.fp8) {
        unsigned char* dst8 = (unsigned char*)J.dst + (size_t)r * J.K + k0;
#pragma unroll
        for (int hf = 0; hf < 2; ++hf) {
            float v[32];
#pragma unroll
            for (int j = 0; j < 32; ++j) v[j] = W[(size_t)(32 * hf + j) * ld];
#pragma unroll
            for (int c = 0; c < 2; ++c) { u32x4 o; o.x = pk4_fp8(v[16 * c] * sc, v[16 * c + 1] * sc, v[16 * c + 2] * sc, v[16 * c + 3] * sc); o.y = pk4_fp8(v[16 * c + 4] * sc, v[16 * c + 5] * sc, v[16 * c + 6] * sc, v[16 * c + 7] * sc);
                o.z = pk4_fp8(v[16 * c + 8] * sc, v[16 * c + 9] * sc, v[16 * c + 10] * sc, v[16 * c + 11] * sc); o.w = pk4_fp8(v[16 * c + 12] * sc, v[16 * c + 13] * sc, v[16 * c + 14] * sc, v[16 * c + 15] * sc);
                *(u32x4*)(dst8 + 32 * hf + 16 * c) = o; }
        }
        return;
    }
    bf16* dst = J.dst + (size_t)r * J.K + k0;
#pragma unroll
    for (int hf = 0; hf < 2; ++hf) {
        float v[32];
#pragma unroll
        for (int j = 0; j < 32; ++j) v[j] = W[(size_t)(32 * hf + j) * ld];
#pragma unroll
        for (int c = 0; c < 4; ++c) { u32x4 o; o.x = pk2(v[8 * c] * sc, v[8 * c + 1] * sc); o.y = pk2(v[8 * c + 2] * sc, v[8 * c + 3] * sc); o.z = pk2(v[8 * c + 4] * sc, v[8 * c + 5] * sc); o.w = pk2(v[8 * c + 6] * sc, v[8 * c + 7] * sc);
            *(u32x4*)(dst + 32 * hf + 8 * c) = o; }
    }
}
__device__ __forceinline__ int t5_bucket(int d) {
    if (d < 16) return d;
    int b = 16 + (int)(log((double)d / 16.0) / log(128.0) * 16.0);
    return b < 16 ? 16 : (b > 31 ? 31 : b);
}
__device__ __forceinline__ void p_prologue(Frame& F, const Args& a) {
    unsigned char* gl_ = (unsigned char*)F.lds;
    Job* jobs = (Job*)(gl_ + 7 * 16384 + 8704);
    int* tot = (int*)(gl_ + 7 * 16384 + 8704 + NJOBS * sizeof(Job));
    static_assert(8704 + NJOBS * sizeof(Job) + 16 <= 16384, "job table fits");
    if (F.tid < NJOBS) { Job J; make_job(a, F.tid, J); jobs[F.tid] = J; }
    __syncthreads();
    if (F.tid == 0) { int s = 0; for (int j = 0; j < NJOBS; ++j) { jobs[j].start = s; s += (jobs[j].K / 64) * (jobs[j].N / 64); } tot[0] = s; }
    __syncthreads();
    const int total = tot[0];
    const int gw = F.vcu * NWAVES + F.wave, NGW = F.G * NWAVES;
    int jc = 0;
    for (int it = gw; it < total; it += NGW) {
        while (jc + 1 < NJOBS && jobs[jc + 1].start <= it) ++jc;
        const Job J = jobs[jc];
        transpose_item(J, it - J.start, F.lane);
    }
    { bf16* hb = (bf16*)(F.ws + WS_HB); const float* x = a.in[0]; unsigned char* hb8 = F.ws + WS_SCR + S_HB8;
      for (int m0 = 4 * gw; m0 < T; m0 += 4 * NGW) { f32x4 v[4][4];
#pragma unroll
          for (int k = 0; k < 4; ++k) { const f32x4* xr = (const f32x4*)(x + (size_t)(m0 + k) * D) + F.lane;
#pragma unroll
              for (int j = 0; j < 4; ++j) v[k][j] = xr[64 * j]; }
#pragma unroll
          for (int k = 0; k < 4; ++k) { unsigned long long* o8 = (unsigned long long*)(hb + (size_t)(m0 + k) * D) + F.lane;
#pragma unroll
              for (int j = 0; j < 4; ++j) o8[64 * j] = (unsigned long long)pk2(v[k][j].x, v[k][j].y) | ((unsigned long long)pk2(v[k][j].z, v[k][j].w) << 32);
              unsigned* o4 = (unsigned*)(hb8 + (size_t)(m0 + k) * D) + F.lane;
#pragma unroll
              for (int j = 0; j < 4; ++j) o4[64 * j] = pk4_fp8(v[k][j].x, v[k][j].y, v[k][j].z, v[k][j].w); } } }
    const int gt = blockIdx.x * 512 + F.tid, NGT = F.G * 512;
    const float* rel = a.in[1];
    float* btA = (float*)(F.ws + WS_BTABA); float* btC = (float*)(F.ws + WS_BTABC);
    for (int i = gt; i < 48 * 132; i += NGT) { const int gh = i / 132, dl = i % 132, g = gh >> 4, hh = gh & 15; const int dil = g == 0 ? 1 : (g == 1 ? 4 : 16);
        btA[i] = dl <= 128 ? rel[t5_bucket(dl * dil) * NH + hh] * LOG2E : 0.f; }
    for (int i = gt; i < 16 * 2048; i += NGT) { const int hh = i >> 11, dd = i & 2047; btC[i] = rel[t5_bucket(dd) * NH + hh] * LOG2E; }
    { bf16* wst = (bf16*)(F.ws + WS_WST); const float* wsrc = a.in[14];
      for (int i = gt; i < 8 * 128 * 128; i += NGT) { const int tt = (i >> 7) & 127, ss = i & 127; wst[i] = (bf16)f2bf(ss <= tt ? wsrc[i] : 0.f); } }
}

__device__ __forceinline__ void unpack8(const u32x4 a, float* x) { x[0] = bflo(a.x); x[1] = bfhi(a.x); x[2] = bflo(a.y); x[3] = bfhi(a.y); x[4] = bflo(a.z); x[5] = bfhi(a.z); x[6] = bflo(a.w); x[7] = bfhi(a.w); }
template <int MODE, bool ROUTE, bool FINAL, bool HB8 = false>
__device__ __forceinline__ void ln_phase(Frame& F, const float* gain, const float* bias, const float* wr) {
    constexpr int NBT = 2;
    const int gw = F.vcu * NWAVES + F.wave, NGW = F.G * NWAVES, lane = F.lane;
    bf16* hb = (bf16*)(F.ws + WS_HB); const bf16* zb = (const bf16*)F.out;
    float gv[16], bv[16];
#pragma unroll
    for (int k = 0; k < 2; ++k)
#pragma unroll
        for (int j = 0; j < 2; ++j) { const f32x4 g4 = *(const f32x4*)(gain + 512 * k + 8 * lane + 4 * j), b4 = *(const f32x4*)(bias + 512 * k + 8 * lane + 4 * j);
            gv[8 * k + 4 * j] = g4.x; gv[8 * k + 4 * j + 1] = g4.y; gv[8 * k + 4 * j + 2] = g4.z; gv[8 * k + 4 * j + 3] = g4.w;
            bv[8 * k + 4 * j] = b4.x; bv[8 * k + 4 * j + 1] = b4.y; bv[8 * k + 4 * j + 2] = b4.z; bv[8 * k + 4 * j + 3] = b4.w; }
    LAS float* wrT = (LAS float*)F.lds;
    if (ROUTE) { for (int i = F.tid; i < 8 * 1024; i += 512) { const int e = i >> 10, c = i & 1023; wrT[i] = wr[c * 8 + e]; } __syncthreads(); }
    const unsigned char* ys = F.ws + WS_SCR + S_XG;
    const int* slots = (const int*)(F.ws + WS_SLOTS); const float* gates = (const float*)(F.ws + WS_GATES);
    int* route = (int*)(F.ws + WS_ROUTE); float* gout = (float*)(F.ws + WS_GATES);
    for (int grp = gw; grp < T / 32; grp += NGW) {
        int cnt_e = 0;
        int my_e1 = 0, my_e2 = 0, my_r1 = 0, my_r2 = 0; float my_g1 = 0.f, my_g2 = 0.f;
        int sl0 = 0, sl1 = 0; float gg0 = 0.f, gg1 = 0.f;
        if (MODE == 2) { const int mm = grp * 32 + (lane & 31); sl0 = slots[2 * mm]; sl1 = slots[2 * mm + 1]; gg0 = gates[2 * mm]; gg1 = gates[2 * mm + 1]; }
        for (int i0 = 0; i0 < 32; i0 += NBT) {
            float v[NBT][16]; float st[NBT][2];
#pragma unroll
            for (int k = 0; k < NBT; ++k) { const int m = grp * 32 + i0 + k;
                if (MODE == 0) { const u32x4* zr = (const u32x4*)(zb + (size_t)m * D) + lane; unpack8(zr[0], v[k]); unpack8(zr[64], v[k] + 8); }
                else { const u32x4* hr = (const u32x4*)(hb + (size_t)m * D) + lane; unpack8(hr[0], v[k]); unpack8(hr[64], v[k] + 8);
#pragma unroll
                    for (int j = 0; j < 16; ++j) v[k][j] *= ALPHA;
                    if (MODE == 3) { const u32x4* yr = (const u32x4*)((const bf16*)(F.ws + WS_SCR + S_Y) + (size_t)m * D) + lane; float a[16]; unpack8(yr[0], a); unpack8(yr[64], a + 8);
#pragma unroll
                        for (int j = 0; j < 16; ++j) v[k][j] += a[j]; }
                    if (MODE == 2) { const int s0 = __builtin_amdgcn_readlane(sl0, i0 + k), s1 = __builtin_amdgcn_readlane(sl1, i0 + k);
                        const float g0 = __builtin_bit_cast(float, __builtin_amdgcn_readlane(__builtin_bit_cast(int, gg0), i0 + k)), g1 = __builtin_bit_cast(float, __builtin_amdgcn_readlane(__builtin_bit_cast(int, gg1), i0 + k));
                        const u32x2* y0 = (const u32x2*)(ys + (size_t)s0 * D) + lane; const u32x2* y1 = (const u32x2*)(ys + (size_t)s1 * D) + lane;
                        const u32x2 ya0 = y0[0], ya1 = y0[64], yb0 = y1[0], yb1 = y1[64];
                        float a[16], b[16];
#pragma unroll
                        for (int c = 0; c < 2; ++c) { const unsigned wa0 = c ? ya0.y : ya0.x, wa1 = c ? ya1.y : ya1.x, wb0 = c ? yb0.y : yb0.x, wb1 = c ? yb1.y : yb1.x;
                            f32x2 t;
                            t = __builtin_amdgcn_cvt_pk_f32_fp8((int)wa0, false); a[4 * c] = t.x; a[4 * c + 1] = t.y; t = __builtin_amdgcn_cvt_pk_f32_fp8((int)wa0, true); a[4 * c + 2] = t.x; a[4 * c + 3] = t.y;
                            t = __builtin_amdgcn_cvt_pk_f32_fp8((int)wa1, false); a[8 + 4 * c] = t.x; a[8 + 4 * c + 1] = t.y; t = __builtin_amdgcn_cvt_pk_f32_fp8((int)wa1, true); a[8 + 4 * c + 2] = t.x; a[8 + 4 * c + 3] = t.y;
                            t = __builtin_amdgcn_cvt_pk_f32_fp8((int)wb0, false); b[4 * c] = t.x; b[4 * c + 1] = t.y; t = __builtin_amdgcn_cvt_pk_f32_fp8((int)wb0, true); b[4 * c + 2] = t.x; b[4 * c + 3] = t.y;
                            t = __builtin_amdgcn_cvt_pk_f32_fp8((int)wb1, false); b[8 + 4 * c] = t.x; b[8 + 4 * c + 1] = t.y; t = __builtin_amdgcn_cvt_pk_f32_fp8((int)wb1, true); b[8 + 4 * c + 2] = t.x; b[8 + 4 * c + 3] = t.y; }
                        const float h0 = g0 * (1.f / YSCALE8), h1 = g1 * (1.f / YSCALE8);
#pragma unroll
                        for (int j = 0; j < 16; ++j) v[k][j] += h0 * a[j] + h1 * b[j]; } }
                float s = 0.f, q2 = 0.f;
#pragma unroll
                for (int j = 0; j < 16; ++j) { s += v[k][j]; q2 += v[k][j] * v[k][j]; }
                st[k][0] = s; st[k][1] = q2; }
#pragma unroll
            for (int o = 1; o < 64; o <<= 1) {
#pragma unroll
                for (int k = 0; k < NBT; ++k) { st[k][0] += __shfl_xor(st[k][0], o); st[k][1] += __shfl_xor(st[k][1], o); } }
#pragma unroll
            for (int k = 0; k < NBT; ++k) { const int m = grp * 32 + i0 + k;
                const float mean = st[k][0] * (1.f / D), var = fmaxf(st[k][1] * (1.f / D) - mean * mean, 0.f), rstd = 1.f / sqrtf(var + LN_EPS);
#pragma unroll
                for (int j = 0; j < 16; ++j) v[k][j] = (v[k][j] - mean) * rstd * gv[j] + bv[j];
                if (FINAL) { f32x4* orow = (f32x4*)(F.out + (size_t)m * D) + 2 * lane;
                    orow[0] = (f32x4){v[k][0], v[k][1], v[k][2], v[k][3]}; orow[1] = (f32x4){v[k][4], v[k][5], v[k][6], v[k][7]}; orow[128] = (f32x4){v[k][8], v[k][9], v[k][10], v[k][11]}; orow[129] = (f32x4){v[k][12], v[k][13], v[k][14], v[k][15]}; }
                else { u32x4* o = (u32x4*)(hb + (size_t)m * D) + lane; u32x4 a, b;
                    a.x = pk2(v[k][0], v[k][1]); a.y = pk2(v[k][2], v[k][3]); a.z = pk2(v[k][4], v[k][5]); a.w = pk2(v[k][6], v[k][7]); b.x = pk2(v[k][8], v[k][9]); b.y = pk2(v[k][10], v[k][11]); b.z = pk2(v[k][12], v[k][13]); b.w = pk2(v[k][14], v[k][15]);
                    o[0] = a; o[64] = b;
                    if (HB8) { u32x2* o8 = (u32x2*)(F.ws + WS_SCR + S_HB8 + (size_t)m * D) + lane; u32x2 c, d;
                        c.x = pk4_fp8(v[k][0], v[k][1], v[k][2], v[k][3]); c.y = pk4_fp8(v[k][4], v[k][5], v[k][6], v[k][7]); d.x = pk4_fp8(v[k][8], v[k][9], v[k][10], v[k][11]); d.y = pk4_fp8(v[k][12], v[k][13], v[k][14], v[k][15]);
                        o8[0] = c; o8[64] = d; } }
                if (ROUTE) {
                    float lg[8];
#pragma unroll
                    for (int e = 0; e < 8; ++e) { float p = 0.f;
#pragma unroll
                        for (int kk = 0; kk < 2; ++kk)
#pragma unroll
                            for (int j = 0; j < 2; ++j) { const f32x4 w4 = *(const LAS f32x4*)(wrT + e * 1024 + 512 * kk + 8 * lane + 4 * j); p += (v[k][8 * kk + 4 * j] * w4.x + v[k][8 * kk + 4 * j + 1] * w4.y) + (v[k][8 * kk + 4 * j + 2] * w4.z + v[k][8 * kk + 4 * j + 3] * w4.w); }
                        lg[e] = p; }
#pragma unroll
                    for (int o = 1; o < 64; o <<= 1) {
#pragma unroll
                        for (int e = 0; e < 8; ++e) lg[e] += __shfl_xor(lg[e], o); }
                    int e1 = 0; float v1 = lg[0];
#pragma unroll
                    for (int e = 1; e < 8; ++e) if (lg[e] > v1) { v1 = lg[e]; e1 = e; }
                    int e2 = -1; float v2 = -3.4e38f;
#pragma unroll
                    for (int e = 0; e < 8; ++e) if (e != e1 && lg[e] > v2) { v2 = lg[e]; e2 = e; }
                    const float g2 = 1.f / (1.f + __expf(v1 - v2)), g1 = 1.f - g2;
                    const int r1 = __shfl(cnt_e, e1); if (lane == e1) ++cnt_e;
                    const int r2 = __shfl(cnt_e, e2); if (lane == e2) ++cnt_e;
                    if (lane == i0 + k) { my_e1 = e1; my_e2 = e2; my_r1 = r1; my_r2 = r2; my_g1 = g1; my_g2 = g2; }
                }
            }
        }
        if (ROUTE) {
            if (lane < 8) ((int*)(F.ws + WS_WCNT))[grp * 8 + lane] = cnt_e;
            if (lane < 32) { const int m = grp * 32 + lane; int* r = route + 4 * m; r[0] = my_e1; r[1] = my_r1; r[2] = my_e2; r[3] = my_r2; gout[2 * m] = my_g1; gout[2 * m + 1] = my_g2; }
        }
    }
}

__device__ __forceinline__ f32x16 mfma32(bf16x8 a, bf16x8 b, f32x16 c) { return __builtin_amdgcn_mfma_f32_32x32x16_bf16(a, b, c, 0, 0, 0); }
__device__ __forceinline__ bf16x8 pack8(const f32x16& s, int b0) {
    u32x4 w; w.x = pg8::cvt_pk_bf16(s[b0], s[b0 + 1]); w.y = pg8::cvt_pk_bf16(s[b0 + 2], s[b0 + 3]); w.z = pg8::cvt_pk_bf16(s[b0 + 4], s[b0 + 5]); w.w = pg8::cvt_pk_bf16(s[b0 + 6], s[b0 + 7]);
    return __builtin_bit_cast(bf16x8, w);
}
__device__ __forceinline__ float max16(const f32x16& s) {
    float a = fmaxf(fmaxf(s[0], s[1]), fmaxf(s[2], s[3])), b = fmaxf(fmaxf(s[4], s[5]), fmaxf(s[6], s[7]));
    float c = fmaxf(fmaxf(s[8], s[9]), fmaxf(s[10], s[11])), d = fmaxf(fmaxf(s[12], s[13]), fmaxf(s[14], s[15]));
    return fmaxf(fmaxf(a, b), fmaxf(c, d));
}
__device__ __forceinline__ void softmax_pv(f32x16& s, float& m_run, float& l_run, f32x16& o0, f32x16& o1, const bf16* vt0, const bf16* vt1, int h) {
    float mx = max16(s); mx = fmaxf(mx, __shfl_xor(mx, 32));
    const float mn = fmaxf(m_run, mx), alpha = __builtin_amdgcn_exp2f(m_run - mn); m_run = mn;
    float ps = 0.f;
#pragma unroll
    for (int r = 0; r < 16; ++r) { const float p = __builtin_amdgcn_exp2f(s[r] - mn); s[r] = p; ps += p; }
    l_run = l_run * alpha + ps;
#pragma unroll
    for (int r = 0; r < 16; ++r) { o0[r] *= alpha; o1[r] *= alpha; }
    const bf16x8 p0 = pack8(s, 0), p1 = pack8(s, 8);
    const bf16x8 v00 = *(const bf16x8*)(vt0 + 8 * h), v01 = *(const bf16x8*)(vt0 + 16 + 8 * h), v10 = *(const bf16x8*)(vt1 + 8 * h), v11 = *(const bf16x8*)(vt1 + 16 + 8 * h);
    o0 = mfma32(v00, p0, o0); o0 = mfma32(v01, p1, o0);
    o1 = mfma32(v10, p0, o1); o1 = mfma32(v11, p1, o1);
}
__device__ __forceinline__ int kperm(int i) { return (i & 19) | ((i & 8) >> 1) | ((i & 4) << 1); }

__device__ __forceinline__ void dil_attn_phase(Frame& F) {
    LAS float* bt = (LAS float*)F.lds;
    { const float* btA = (const float*)(F.ws + WS_BTABA); for (int i = F.tid; i < 48 * 192; i += 512) { const int gh = i / 192, dl = i % 192 - 32; bt[i] = (dl >= 0 && dl <= 128) ? btA[gh * 132 + dl] : NEGB; } }
    __syncthreads();
    const int gw = F.vcu * NWAVES + F.wave, NGW = F.G * NWAVES, lane = F.lane, q = lane & 31, h = lane >> 5;
    const bf16* QK = (const bf16*)(F.ws + WS_SCR + S_QK); const bf16* VT = (const bf16*)(F.ws + WS_SCR + S_VT);
    bf16* OG = (bf16*)((unsigned char*)F.out + O_OG); float* LSE = (float*)((unsigned char*)F.out + O_LSE);
    constexpr int NTASK = 3 * 16 * 8 * 64;
    const int per = (NTASK + NGW - 1) / NGW;
    const int t_lo = gw * per, t_hi = (t_lo + per) < NTASK ? (t_lo + per) : NTASK;
    for (int task = t_lo; task < t_hi; ++task) {
        const int qt = task & 3, rn = (task >> 2) & 15, bl = (task >> 6) & 7, gh = task >> 9, g = gh >> 4, hh = gh & 15;
        const int nblk = 16 >> (2 * g); const bool has_prev = (rn & (nblk - 1)) != 0;
        const int n0 = bl * 2048 + rn * 128;
        const bf16* qrow = QK + ((size_t)g * TC + n0 + 32 * qt + q) * 2048 + hh * 64;
        bf16x8 qf[4];
#pragma unroll
        for (int d0 = 0; d0 < 4; ++d0) qf[d0] = *(const bf16x8*)(qrow + d0 * 16 + 8 * h);
        float m_run = NEGB, l_run = 0.f; f32x16 o0 = {}, o1 = {};
        const bf16* vbase0 = VT + ((size_t)g * 1024 + hh * 64 + q) * TC; const bf16* vbase1 = vbase0 + (size_t)32 * TC;
        const LAS float* btl = bt + gh * 192 + (q - 8 * h + 137);
#pragma unroll
        for (int t = 0; t < 5; ++t) {
            if (has_prev || qt + t > 3) {
                const int kr0 = n0 - 128 + 32 * qt + 32 * t;
                const bf16* krow = QK + ((size_t)g * TC + kr0 + kperm(q)) * 2048 + 1024 + hh * 64;
                f32x16 s;
#pragma unroll
                for (int r = 0; r < 16; ++r) s[r] = btl[-32 * t + 23 - 16 * (r >> 3) - (r & 7)];
#pragma unroll
                for (int d0 = 0; d0 < 4; ++d0) { const bf16x8 kf = *(const bf16x8*)(krow + d0 * 16 + 8 * h); s = mfma32(kf, qf[d0], s); }
                softmax_pv(s, m_run, l_run, o0, o1, vbase0 + kr0, vbase1 + kr0, h);
            }
        }
        const float l_tot = l_run + __shfl_xor(l_run, 32), inv = 1.f / l_tot;
        const size_t orow = (size_t)g * TC + n0 + 32 * qt + q;
        bf16* op = OG + orow * 1024 + hh * 64 + 4 * h;
#pragma unroll
        for (int gq = 0; gq < 4; ++gq) {
            u32x2 w0, w1; w0.x = pg8::cvt_pk_bf16(o0[4 * gq] * inv, o0[4 * gq + 1] * inv); w0.y = pg8::cvt_pk_bf16(o0[4 * gq + 2] * inv, o0[4 * gq + 3] * inv);
            w1.x = pg8::cvt_pk_bf16(o1[4 * gq] * inv, o1[4 * gq + 1] * inv); w1.y = pg8::cvt_pk_bf16(o1[4 * gq + 2] * inv, o1[4 * gq + 3] * inv);
            *(u32x2*)(op + 8 * gq) = w0; *(u32x2*)(op + 32 + 8 * gq) = w1; }
        if (h == 0) LSE[orow * 16 + hh] = m_run + __log2f(l_tot);
    }
}
__device__ __forceinline__ void dil_merge_phase(Frame& F, int ck) {
    const int gw = F.vcu * NWAVES + F.wave, NGW = F.G * NWAVES, lane = F.lane;
    const bf16* OG = (const bf16*)((unsigned char*)F.out + O_OG); const float* LSE = (const float*)((unsigned char*)F.out + O_LSE);
    unsigned char* att = F.ws + WS_SCR + S_ATT + (size_t)ck * TC * 1024;
    const int hh = lane >> 2;
    for (int tl0 = 2 * gw; tl0 < TC; tl0 += 2 * NGW) {
        size_t n[2][3]; float ls[2][3]; u32x4 x[2][3];
#pragma unroll
        for (int k = 0; k < 2; ++k) { const int tl = tl0 + k, bl = tl >> 11, tt = tl & 2047;
            n[k][0] = tl; n[k][1] = bl * 2048 + (tt & 3) * 512 + (tt >> 2); n[k][2] = bl * 2048 + (tt & 15) * 128 + (tt >> 4);
#pragma unroll
            for (int g = 0; g < 3; ++g) { ls[k][g] = LSE[((size_t)g * TC + n[k][g]) * 16 + hh]; x[k][g] = *(const u32x4*)((const unsigned char*)OG + ((size_t)g * TC + n[k][g]) * 1024 + 16 * lane); } }
#pragma unroll
        for (int k = 0; k < 2; ++k) {
            const float M = fmaxf(fmaxf(ls[k][0], ls[k][1]), ls[k][2]);
            float w[3]; float W = 0.f;
#pragma unroll
            for (int g = 0; g < 3; ++g) { w[g] = __builtin_amdgcn_exp2f(ls[k][g] - M); W += w[g]; }
            const float iw = 1.f / W;
            float acc[16];
#pragma unroll
            for (int j = 0; j < 16; ++j) acc[j] = 0.f;
#pragma unroll
            for (int g = 0; g < 3; ++g) { const float wg = w[g] * iw; float a[16];
#pragma unroll
                for (int c = 0; c < 4; ++c) { const f32x2 lo = __builtin_amdgcn_cvt_pk_f32_fp8((int)x[k][g][c], false), hi = __builtin_amdgcn_cvt_pk_f32_fp8((int)x[k][g][c], true); a[4 * c] = lo.x; a[4 * c + 1] = lo.y; a[4 * c + 2] = hi.x; a[4 * c + 3] = hi.y; }
#pragma unroll
                for (int j = 0; j < 16; ++j) acc[j] += wg * a[j]; }
            u32x4 y; y.x = pk4_fp8(acc[0], acc[1], acc[2], acc[3]); y.y = pk4_fp8(acc[4], acc[5], acc[6], acc[7]); y.z = pk4_fp8(acc[8], acc[9], acc[10], acc[11]); y.w = pk4_fp8(acc[12], acc[13], acc[14], acc[15]);
            *(u32x4*)(att + (size_t)(tl0 + k) * 1024 + 16 * lane) = y;
        }
    }
}

__device__ __forceinline__ void conv_phase(Frame& F, const float* cw) {
    const int gw = F.vcu * NWAVES + F.wave, NGW = F.G * NWAVES, lane = F.lane;
    const bf16* gbp = (const bf16*)(F.ws + WS_SCR + S_BCX); const bf16* up = (const bf16*)(F.ws + WS_SCR + S_BCX + (size_t)128 * MiB); bf16* p = (bf16*)(F.ws + WS_SCR + S_P);
    for (int item = gw; item < (T / 32) * 2; item += NGW) {
        const int half = item & 1, tb = item >> 1, t0 = tb * 32, c0 = half * 512 + lane * 8;
        float w0[8], w1[8], w2[8];
#pragma unroll
        for (int j = 0; j < 8; ++j) { w0[j] = cw[c0 + j]; w1[j] = cw[1024 + c0 + j]; w2[j] = cw[2048 + c0 + j]; }
        float u1[8], u2[8];
        const bool first = (t0 & 2047) == 0;
#pragma unroll
        for (int j = 0; j < 8; ++j) { u1[j] = 0.f; u2[j] = 0.f; }
        if (!first) { unpack8(*(const u32x4*)(up + (size_t)(t0 - 2) * 1024 + c0), u2); unpack8(*(const u32x4*)(up + (size_t)(t0 - 1) * 1024 + c0), u1); }
        for (int i = 0; i < 32; ++i) { const size_t r = (size_t)(t0 + i) * 1024;
            const u32x4 gb = *(const u32x4*)(gbp + r + c0), uu = *(const u32x4*)(up + r + c0);
            float u0[8], b[8]; unpack8(uu, u0); unpack8(gb, b);
            float o[8];
#pragma unroll
            for (int j = 0; j < 8; ++j) { o[j] = b[j] * (w0[j] * u2[j] + w1[j] * u1[j] + w2[j] * u0[j]); u2[j] = u1[j]; u1[j] = u0[j]; }
            u32x4 x; x.x = pk2(o[0], o[1]); x.y = pk2(o[2], o[3]); x.z = pk2(o[4], o[5]); x.w = pk2(o[6], o[7]);
            *(u32x4*)(p + (size_t)(t0 + i) * 1024 + c0) = x; }
    }
}

__device__ __forceinline__ void kmean_phase(Frame& F) {
    const int gw = F.vcu * NWAVES + F.wave, NGW = F.G * NWAVES, lane = F.lane;
    const bf16* QK = (const bf16*)(F.ws + WS_SCR + S_CQK); float* km = (float*)(F.ws + WS_KMEAN);
    const int kq = lane >> 3, dc = lane & 7;
    for (int u = gw; u < NB * NH * 8; u += NGW) { const int blk = u & 7, hh = (u >> 3) & 15, b = u >> 7;
        float a[8];
#pragma unroll
        for (int j = 0; j < 8; ++j) a[j] = 0.f;
        const bf16* kp = QK + ((size_t)b * SEQ + blk * 256 + kq) * 2048 + 1024 + hh * 64 + dc * 8;
#pragma unroll 8
        for (int i = 0; i < 32; ++i) { const u32x4 x = *(const u32x4*)(kp + (size_t)i * 8 * 2048);
            a[0] += bflo(x.x); a[1] += bfhi(x.x); a[2] += bflo(x.y); a[3] += bfhi(x.y); a[4] += bflo(x.z); a[5] += bfhi(x.z); a[6] += bflo(x.w); a[7] += bfhi(x.w); }
#pragma unroll
        for (int j = 0; j < 8; ++j) { a[j] += __shfl_xor(a[j], 8); a[j] += __shfl_xor(a[j], 16); a[j] += __shfl_xor(a[j], 32); }
        if (lane < 8) { float* o = km + (size_t)u * 64 + lane * 8;
#pragma unroll
            for (int j = 0; j < 8; ++j) o[j] = a[j] * (1.f / 256.f); }
    }
}
__device__ __forceinline__ void moba_unit(Frame& F, int b, int hh, int nb, LAS float* bt, int& cur_h) {
    const int lane = F.lane, q = lane & 31, h = lane >> 5, w = F.wave;
    const bf16* QK = (const bf16*)(F.ws + WS_SCR + S_CQK); const bf16* VT = (const bf16*)(F.ws + WS_SCR + S_CVT);
    bf16* att = (bf16*)(F.ws + WS_SCR + S_CATT); const float* km = (const float*)(F.ws + WS_KMEAN);
    if (hh != cur_h) { __syncthreads(); const float* btC = (const float*)(F.ws + WS_BTABC) + hh * 2048; for (int i = F.tid; i < 2048; i += 512) bt[i] = btC[i]; cur_h = hh; __syncthreads(); }
    const size_t tq = (size_t)b * SEQ + nb * 256 + 32 * w + q;
    const bf16* qrow = QK + tq * 2048 + hh * 64;
    bf16x8 qf[4];
#pragma unroll
    for (int d0 = 0; d0 < 4; ++d0) qf[d0] = *(const bf16x8*)(qrow + d0 * 16 + 8 * h);
    unsigned sel = 0;
    if (nb > 0) {
        float gsc[7];
#pragma unroll
        for (int m = 0; m < 7; ++m) { float s = 0.f;
            if (m < nb) { const float* kmp = km + (((size_t)b * NH + hh) * 8 + m) * 64;
#pragma unroll
                for (int d0 = 0; d0 < 4; ++d0) { const f32x4 k0 = *(const f32x4*)(kmp + d0 * 16 + 8 * h), k1 = *(const f32x4*)(kmp + d0 * 16 + 8 * h + 4); const u32x4 qq = __builtin_bit_cast(u32x4, qf[d0]);
                    s += bflo(qq.x) * k0.x + bfhi(qq.x) * k0.y + bflo(qq.y) * k0.z + bfhi(qq.y) * k0.w + bflo(qq.z) * k1.x + bfhi(qq.z) * k1.y + bflo(qq.w) * k1.z + bfhi(qq.w) * k1.w; }
                s += __shfl_xor(s, 32); }
            gsc[m] = m < nb ? s : -3.0e38f; }
        const int nsel = nb < 3 ? nb : 3;
#pragma unroll
        for (int r = 0; r < 3; ++r) { if (r < nsel) { int bi = -1; float bv = -3.4e38f;
#pragma unroll
                for (int m = 0; m < 7; ++m) if (!((sel >> m) & 1u) && gsc[m] > bv) { bv = gsc[m]; bi = m; }
                sel |= 1u << bi; } }
    }
#ifdef MK_SELFCHECK
    if (h == 0) ((unsigned*)(F.ws + WS_NEED + 3 * MiB))[tq * 16 + hh] = sel;
#endif
    float m_run = NEGB, l_run = 0.f; f32x16 o0 = {}, o1 = {};
    const bf16* vbase0 = VT + ((size_t)hh * 64 + q) * T + (size_t)b * SEQ; const bf16* vbase1 = vbase0 + (size_t)32 * T;
    const int qpos = nb * 256 + 32 * w + q;
    for (int m = 0; m < nb; ++m) {
        const bool mine = (sel >> m) & 1u;
        if (__ballot(mine) == 0ull) continue;
        for (int kt = 0; kt < 8; ++kt) {
            const int kr0 = m * 256 + 32 * kt;
            const bf16* krow = QK + ((size_t)b * SEQ + kr0 + kperm(q)) * 2048 + 1024 + hh * 64;
            f32x16 s = {};
#pragma unroll
            for (int d0 = 0; d0 < 4; ++d0) { const bf16x8 kf = *(const bf16x8*)(krow + d0 * 16 + 8 * h); s = mfma32(kf, qf[d0], s); }
#pragma unroll
            for (int r = 0; r < 16; ++r) { const int kap = 16 * (r >> 3) + 8 * h + (r & 7); const float bb = bt[qpos - kr0 - kap]; s[r] = mine ? s[r] + bb : NEGB; }
            softmax_pv(s, m_run, l_run, o0, o1, vbase0 + kr0, vbase1 + kr0, h);
        }
    }
    for (int kt = 0; kt <= w; ++kt) {
        const int kr0 = nb * 256 + 32 * kt;
        const bf16* krow = QK + ((size_t)b * SEQ + kr0 + kperm(q)) * 2048 + 1024 + hh * 64;
        f32x16 s = {};
#pragma unroll
        for (int d0 = 0; d0 < 4; ++d0) { const bf16x8 kf = *(const bf16x8*)(krow + d0 * 16 + 8 * h); s = mfma32(kf, qf[d0], s); }
#pragma unroll
        for (int r = 0; r < 16; ++r) { const int kap = 16 * (r >> 3) + 8 * h + (r & 7); const int dd = qpos - kr0 - kap; const float bb = bt[dd < 0 ? 0 : dd]; s[r] = dd >= 0 ? s[r] + bb : NEGB; }
        softmax_pv(s, m_run, l_run, o0, o1, vbase0 + kr0, vbase1 + kr0, h);
    }
    const float l_tot = l_run + __shfl_xor(l_run, 32), inv = 1.f / l_tot;
#ifdef MK_SELFCHECK
    if (h == 0) ((float*)(F.ws + WS_NEED + 7 * MiB))[tq * 16 + hh] = m_run + __log2f(l_tot);
#endif
    bf16* op = att + tq * 1024 + hh * 64 + 4 * h;
#pragma unroll
    for (int gq = 0; gq < 4; ++gq) {
        u32x2 w0, w1; w0.x = pg8::cvt_pk_bf16(o0[4 * gq] * inv, o0[4 * gq + 1] * inv); w0.y = pg8::cvt_pk_bf16(o0[4 * gq + 2] * inv, o0[4 * gq + 3] * inv);
        w1.x = pg8::cvt_pk_bf16(o1[4 * gq] * inv, o1[4 * gq + 1] * inv); w1.y = pg8::cvt_pk_bf16(o1[4 * gq + 2] * inv, o1[4 * gq + 3] * inv);
        *(u32x2*)(op + 8 * gq) = w0; *(u32x2*)(op + 32 + 8 * gq) = w1; }
}
__device__ __forceinline__ void moba_phase(Frame& F) {
    LAS float* bt = (LAS float*)F.lds; int cur_h = -1;
    const int NP = NB * NH * 4, per = (NP + F.G - 1) / F.G;
    const int lo = F.vcu * per, hi = (lo + per) < NP ? (lo + per) : NP;
    for (int pu = lo; pu < hi; ++pu) { const int j = pu & 3, hh = (pu >> 2) & 15, b = pu >> 6;
        moba_unit(F, b, hh, 7 - j, bt, cur_h); moba_unit(F, b, hh, j, bt, cur_h); }
}


constexpr int AKP = 72;
constexpr int ATILE = 64 * AKP * 2;
struct AttnSt { float m, l; f32x16 o0, o1; };
template <bool MASKED>
__device__ __forceinline__ void attn_tile(const LAS bf16* Kt, const LAS bf16* Vt, const LAS float* bl, const bf16x8 (&qf)[4], AttnSt& st, int q, int h, bool mine) {
    f32x16 s;
#pragma unroll
    for (int r = 0; r < 16; ++r) s[r] = bl[23 - 16 * (r >> 3) - (r & 7)];
    const LAS bf16* kr = Kt + kperm(q) * AKP + 8 * h;
#pragma unroll
    for (int d0 = 0; d0 < 4; ++d0) s = mfma32(*(const LAS bf16x8*)(kr + d0 * 16), qf[d0], s);
    float mx = max16(s); mx = fmaxf(mx, __shfl_xor(mx, 32));
    float mn = fmaxf(st.m, mx); if (MASKED) mn = mine ? mn : st.m;
    const float alpha = __builtin_amdgcn_exp2f(st.m - mn);
    float ps = 0.f;
#pragma unroll
    for (int r = 0; r < 16; ++r) { const float p = __builtin_amdgcn_exp2f(s[r] - mn); s[r] = p; ps += p; }
    bf16x8 p0 = pack8(s, 0), p1 = pack8(s, 8);
    if (MASKED) { if (!mine) { p0 = (bf16x8){0, 0, 0, 0, 0, 0, 0, 0}; p1 = p0; ps = 0.f; } }
    st.l = st.l * alpha + ps; st.m = mn;
    if (__ballot(alpha != 1.0f) != 0ull) {
#pragma unroll
        for (int r = 0; r < 16; ++r) { st.o0[r] *= alpha; st.o1[r] *= alpha; } }
    const LAS bf16* v0 = Vt + q * AKP + 8 * h; const LAS bf16* v1 = v0 + 32 * AKP;
    st.o0 = mfma32(*(const LAS bf16x8*)v0, p0, st.o0); st.o0 = mfma32(*(const LAS bf16x8*)(v0 + 16), p1, st.o0);
    st.o1 = mfma32(*(const LAS bf16x8*)v1, p0, st.o1); st.o1 = mfma32(*(const LAS bf16x8*)(v1 + 16), p1, st.o1);
}
__device__ __forceinline__ void attn_store(const AttnSt& st, bf16* op  , float inv) {
#pragma unroll
    for (int gq = 0; gq < 4; ++gq) {
        u32x2 w0, w1; w0.x = pg8::cvt_pk_bf16(st.o0[4 * gq] * inv, st.o0[4 * gq + 1] * inv); w0.y = pg8::cvt_pk_bf16(st.o0[4 * gq + 2] * inv, st.o0[4 * gq + 3] * inv);
        w1.x = pg8::cvt_pk_bf16(st.o1[4 * gq] * inv, st.o1[4 * gq + 1] * inv); w1.y = pg8::cvt_pk_bf16(st.o1[4 * gq + 2] * inv, st.o1[4 * gq + 3] * inv);
        *(u32x2*)(op + 8 * gq) = w0; *(u32x2*)(op + 32 + 8 * gq) = w1; }
}

__device__ __forceinline__ void attn_store8(const AttnSt& st, unsigned char* op  , float inv) {
#pragma unroll
    for (int gq = 0; gq < 4; ++gq) {
        *(unsigned*)(op + 8 * gq) = pk4_fp8(st.o0[4 * gq] * inv, st.o0[4 * gq + 1] * inv, st.o0[4 * gq + 2] * inv, st.o0[4 * gq + 3] * inv);
        *(unsigned*)(op + 32 + 8 * gq) = pk4_fp8(st.o1[4 * gq] * inv, st.o1[4 * gq + 1] * inv, st.o1[4 * gq + 2] * inv, st.o1[4 * gq + 3] * inv); }
}

__device__ __forceinline__ void dil_attn_phase2(Frame& F) {
    LAS float* bt = (LAS float*)F.lds;
    { const float* btA = (const float*)(F.ws + WS_BTABA); for (int i = F.tid; i < 48 * 192; i += 512) { const int gh = i / 192, dl = i % 192 - 32; bt[i] = (dl >= 0 && dl <= 128) ? btA[gh * 132 + dl] : NEGB; } }
    __syncthreads();
    constexpr int TBL = 48 * 192 * 4;
    const int lane = F.lane, q = lane & 31, h = lane >> 5, w = F.wave, uw = w >> 2, qt = w & 3, t = F.tid, tu = t >> 8, tt = t & 255, srow = tt >> 3, sch = tt & 7;
    const bf16* QK = (const bf16*)(F.ws + WS_SCR + S_QK); const bf16* VT = (const bf16*)(F.ws + WS_SCR + S_VT);
    bf16* OG = (bf16*)((unsigned char*)F.out + O_OG); float* LSE = (float*)((unsigned char*)F.out + O_LSE);
    for (int du = F.vcu; du < 3072; du += F.G) {
        const int g = du >> 10, rem = du & 1023, hh = rem >> 6, blp = (rem >> 4) & 3, rn = rem & 15, gh = g * 16 + hh;
        const int nblk = 16 >> (2 * g); const bool has_prev = (rn & (nblk - 1)) != 0;
        const int j0 = has_prev ? 0 : 2;
        const int n0s = (2 * blp + tu) * 2048 + rn * 128;
        const bf16* ksrc = QK + ((size_t)g * TC + n0s - 128 + srow) * 2048 + 1024 + hh * 64 + sch * 8;
        const bf16* vsrc = VT + ((size_t)g * 1024 + hh * 64 + srow) * TC + (n0s - 128) + sch * 8;
        const int sdst = srow * AKP + sch * 8;
        const int n0 = (2 * blp + uw) * 2048 + rn * 128;
        const bf16* qrow = QK + ((size_t)g * TC + n0 + 32 * qt + q) * 2048 + hh * 64;
        bf16x8 qf[4];
#pragma unroll
        for (int d0 = 0; d0 < 4; ++d0) qf[d0] = *(const bf16x8*)(qrow + d0 * 16 + 8 * h);
        AttnSt st; st.m = NEGB; st.l = 0.f; st.o0 = (f32x16){}; st.o1 = (f32x16){};
        u32x4 k0, k1, v0, v1;
        k0 = *(const u32x4*)(ksrc + (size_t)(64 * j0) * 2048); k1 = *(const u32x4*)(ksrc + (size_t)(64 * j0 + 32) * 2048);
        v0 = *(const u32x4*)(vsrc + 64 * j0); v1 = *(const u32x4*)(vsrc + (size_t)32 * TC + 64 * j0);
        { LAS bf16* kb = (LAS bf16*)(F.lds + TBL + (0 * 2 + tu) * 2 * ATILE); LAS bf16* vb = kb + 64 * AKP;
          *(LAS u32x4*)(kb + sdst) = k0; *(LAS u32x4*)(kb + 32 * AKP + sdst) = k1; *(LAS u32x4*)(vb + sdst) = v0; *(LAS u32x4*)(vb + 32 * AKP + sdst) = v1; }
        __syncthreads();
        int pb = 0;
        for (int j = j0; j < 4; ++j) {
            const bool more = j + 1 < 4;
            if (more) { k0 = *(const u32x4*)(ksrc + (size_t)(64 * (j + 1)) * 2048); k1 = *(const u32x4*)(ksrc + (size_t)(64 * (j + 1) + 32) * 2048);
                        v0 = *(const u32x4*)(vsrc + 64 * (j + 1)); v1 = *(const u32x4*)(vsrc + (size_t)32 * TC + 64 * (j + 1)); }
            const LAS bf16* kb = (const LAS bf16*)(F.lds + TBL + (pb * 2 + uw) * 2 * ATILE); const LAS bf16* vb = kb + 64 * AKP;
#pragma unroll
            for (int t2 = 0; t2 < 2; ++t2) { const int t32 = 2 * j + t2;
                if (t32 >= qt && t32 <= qt + 4) {
                    const LAS float* bl = bt + gh * 192 + 32 + (32 * qt + q + 128 - 32 * t32 - 8 * h - 23);
                    attn_tile<false>(kb + 32 * t2 * AKP, vb + 32 * t2, bl, qf, st, q, h, true); } }
            if (more) { LAS bf16* kn = (LAS bf16*)(F.lds + TBL + ((pb ^ 1) * 2 + tu) * 2 * ATILE); LAS bf16* vn = kn + 64 * AKP;
                *(LAS u32x4*)(kn + sdst) = k0; *(LAS u32x4*)(kn + 32 * AKP + sdst) = k1; *(LAS u32x4*)(vn + sdst) = v0; *(LAS u32x4*)(vn + 32 * AKP + sdst) = v1; }
            __syncthreads();
            pb ^= 1;
        }
        const float l_tot = st.l + __shfl_xor(st.l, 32), inv = 1.f / l_tot;
        const size_t orow = (size_t)g * TC + n0 + 32 * qt + q;
        attn_store(st, OG + orow * 1024 + hh * 64 + 4 * h, inv);
        if (h == 0) LSE[orow * 16 + hh] = st.m + __log2f(l_tot);
    }
}

__device__ __forceinline__ void moba_unit2(Frame& F, int b, int hh, int nb, LAS float* bt, int& cur_h) {
    constexpr int TBL = 8448;
    const int lane = F.lane, q = lane & 31, h = lane >> 5, w = F.wave, t = F.tid, srow = t >> 3, sch = t & 7;
    const bf16* QK = (const bf16*)(F.ws + WS_SCR + S_CQK); const bf16* VT = (const bf16*)(F.ws + WS_SCR + S_CVT);
    bf16* att = (bf16*)(F.ws + WS_SCR + S_CATT); const float* km = (const float*)(F.ws + WS_KMEAN);
    if (hh != cur_h) { __syncthreads(); const float* btC = (const float*)(F.ws + WS_BTABC) + hh * 2048; for (int i = t; i < 2048 + 32; i += 512) bt[i] = i < 32 ? NEGB : btC[i - 32]; cur_h = hh; __syncthreads(); }
    const size_t tq = (size_t)b * SEQ + nb * 256 + 32 * w + q;
    const bf16* qrow = QK + tq * 2048 + hh * 64;
    bf16x8 qf[4];
#pragma unroll
    for (int d0 = 0; d0 < 4; ++d0) qf[d0] = *(const bf16x8*)(qrow + d0 * 16 + 8 * h);
    unsigned sel = 0;
    if (nb > 0) {
        float gsc[7];
#pragma unroll
        for (int m = 0; m < 7; ++m) { float s = 0.f;
            if (m < nb) { const float* kmp = km + (((size_t)b * NH + hh) * 8 + m) * 64;
#pragma unroll
                for (int d0 = 0; d0 < 4; ++d0) { const f32x4 k0 = *(const f32x4*)(kmp + d0 * 16 + 8 * h), k1 = *(const f32x4*)(kmp + d0 * 16 + 8 * h + 4); const u32x4 qq = __builtin_bit_cast(u32x4, qf[d0]);
                    s += bflo(qq.x) * k0.x + bfhi(qq.x) * k0.y + bflo(qq.y) * k0.z + bfhi(qq.y) * k0.w + bflo(qq.z) * k1.x + bfhi(qq.z) * k1.y + bflo(qq.w) * k1.z + bfhi(qq.w) * k1.w; }
                s += __shfl_xor(s, 32); }
            gsc[m] = m < nb ? s : -3.0e38f; }
        const int nsel = nb < 3 ? nb : 3;
#pragma unroll
        for (int r = 0; r < 3; ++r) { if (r < nsel) { int bi = 0; float bv = -3.4e38f;
#pragma unroll
                for (int m = 0; m < 7; ++m) if (!((sel >> m) & 1u) && gsc[m] > bv) { bv = gsc[m]; bi = m; }
                sel |= 1u << bi; } }
    }
    AttnSt st; st.m = NEGB; st.l = 0.f; st.o0 = (f32x16){}; st.o1 = (f32x16){};
    const int qpos = nb * 256 + 32 * w + q, nsteps = 4 * nb + 4;
    const bf16* ksrc = QK + ((size_t)b * SEQ + srow) * 2048 + 1024 + hh * 64 + sch * 8;
    const bf16* vsrc = VT + ((size_t)hh * 64 + srow) * T + (size_t)b * SEQ + sch * 8;
    const int sdst = srow * AKP + sch * 8;
    u32x4 kreg = *(const u32x4*)ksrc, vreg = *(const u32x4*)vsrc;
    { LAS bf16* kb = (LAS bf16*)(F.lds + TBL); *(LAS u32x4*)(kb + sdst) = kreg; *(LAS u32x4*)(kb + 64 * AKP + sdst) = vreg; }
    __syncthreads();
    int pb = 0;
    for (int s = 0; s < nsteps; ++s) {
        const bool more = s + 1 < nsteps;
        if (more) { kreg = *(const u32x4*)(ksrc + (size_t)(64 * (s + 1)) * 2048); vreg = *(const u32x4*)(vsrc + 64 * (s + 1)); }
        const LAS bf16* kb = (const LAS bf16*)(F.lds + TBL + pb * 2 * ATILE); const LAS bf16* vb = kb + 64 * AKP;
        if (s < 4 * nb) {
            const bool mine = (sel >> (s >> 2)) & 1u;
            if (__ballot(mine) != 0ull) {
#pragma unroll
                for (int t2 = 0; t2 < 2; ++t2) { const LAS float* bl = bt + 32 + (qpos - 8 * h - (64 * s + 32 * t2) - 23);
                    attn_tile<true>(kb + 32 * t2 * AKP, vb + 32 * t2, bl, qf, st, q, h, mine); } }
        } else {
#pragma unroll
            for (int t2 = 0; t2 < 2; ++t2) { const int t32 = (s - 4 * nb) * 2 + t2;
                if (t32 <= w) { const LAS float* bl = bt + 32 + (qpos - 8 * h - (64 * s + 32 * t2) - 23);
                    attn_tile<false>(kb + 32 * t2 * AKP, vb + 32 * t2, bl, qf, st, q, h, true); } }
        }
        if (more) { LAS bf16* kn = (LAS bf16*)(F.lds + TBL + (pb ^ 1) * 2 * ATILE); *(LAS u32x4*)(kn + sdst) = kreg; *(LAS u32x4*)(kn + 64 * AKP + sdst) = vreg; }
        __syncthreads();
        pb ^= 1;
    }
    const float l_tot = st.l + __shfl_xor(st.l, 32), inv = 1.f / l_tot;
    attn_store(st, att + tq * 1024 + hh * 64 + 4 * h, inv);
}
__device__ __forceinline__ void moba_phase2(Frame& F) {
    LAS float* bt = (LAS float*)F.lds; int cur_h = -1;
    const int NP = NB * NH * 4, per = (NP + F.G - 1) / F.G;
    const int lo = F.vcu * per, hi = (lo + per) < NP ? (lo + per) : NP;
    for (int pu = lo; pu < hi; ++pu) { const int j = pu & 3, hh = (pu >> 2) & 15, b = pu >> 6;
        moba_unit2(F, b, hh, 7 - j, bt, cur_h); moba_unit2(F, b, hh, j, bt, cur_h); }
}


__device__ __forceinline__ float xhalf_max(float m) { auto rr = __builtin_amdgcn_permlane32_swap(__float_as_uint(m), __float_as_uint(m), false, false); return fmaxf(__uint_as_float(rr[0]), __uint_as_float(rr[1])); }
__device__ __forceinline__ float xhalf_sum(float m) { auto rr = __builtin_amdgcn_permlane32_swap(__float_as_uint(m), __float_as_uint(m), false, false); return __uint_as_float(rr[0]) + __uint_as_float(rr[1]); }
template <bool MASKED>
__device__ __forceinline__ void attn_tile2(const LAS bf16* Kt, const LAS bf16* Vt, const LAS float* bl0, const bf16x8 (&qf)[4], AttnSt& st, int q, int h, bool mine) {
    f32x16 s0, s1;
#pragma unroll
    for (int r = 0; r < 16; ++r) { s0[r] = bl0[23 - 16 * (r >> 3) - (r & 7)]; s1[r] = bl0[-32 + 23 - 16 * (r >> 3) - (r & 7)]; }
    const LAS bf16* kr = Kt + kperm(q) * AKP + 8 * h;
#pragma unroll
    for (int d0 = 0; d0 < 4; ++d0) { s0 = mfma32(*(const LAS bf16x8*)(kr + d0 * 16), qf[d0], s0); s1 = mfma32(*(const LAS bf16x8*)(kr + 32 * AKP + d0 * 16), qf[d0], s1); }
    const float mx = xhalf_max(fmaxf(max16(s0), max16(s1)));
    float mn = fmaxf(st.m, mx); if (MASKED) mn = mine ? mn : st.m;
    const float alpha = __builtin_amdgcn_exp2f(st.m - mn);
    float ps0 = 0.f, ps1 = 0.f;
#pragma unroll
    for (int r = 0; r < 16; ++r) { const float p = __builtin_amdgcn_exp2f(s0[r] - mn); s0[r] = p; ps0 += p; const float p2 = __builtin_amdgcn_exp2f(s1[r] - mn); s1[r] = p2; ps1 += p2; }
    bf16x8 p00 = pack8(s0, 0), p01 = pack8(s0, 8), p10 = pack8(s1, 0), p11 = pack8(s1, 8);
    float ps = ps0 + ps1;
    if (MASKED) { if (!mine) { p00 = (bf16x8){0, 0, 0, 0, 0, 0, 0, 0}; p01 = p00; p10 = p00; p11 = p00; ps = 0.f; } }
    st.l = st.l * alpha + ps; st.m = mn;
    if (__ballot(alpha != 1.0f) != 0ull) {
#pragma unroll
        for (int r = 0; r < 16; ++r) { st.o0[r] *= alpha; st.o1[r] *= alpha; } }
    const LAS bf16* v0 = Vt + q * AKP + 8 * h; const LAS bf16* v1 = v0 + 32 * AKP;
    st.o0 = mfma32(*(const LAS bf16x8*)v0, p00, st.o0); st.o1 = mfma32(*(const LAS bf16x8*)v1, p00, st.o1);
    st.o0 = mfma32(*(const LAS bf16x8*)(v0 + 16), p01, st.o0); st.o1 = mfma32(*(const LAS bf16x8*)(v1 + 16), p01, st.o1);
    st.o0 = mfma32(*(const LAS bf16x8*)(v0 + 32), p10, st.o0); st.o1 = mfma32(*(const LAS bf16x8*)(v1 + 32), p10, st.o1);
    st.o0 = mfma32(*(const LAS bf16x8*)(v0 + 48), p11, st.o0); st.o1 = mfma32(*(const LAS bf16x8*)(v1 + 48), p11, st.o1);
}

__device__ __forceinline__ void attn_tile2r(const LAS bf16* Kt, const LAS bf16* Vt, const LAS float* b0, const LAS float* b1, const bf16x8 (&qf)[4], AttnSt& st, int q, int h) {
    f32x16 s0, s1;
#pragma unroll
    for (int r = 0; r < 16; ++r) { s0[r] = b0[16 * (r >> 3) + (r & 7)]; s1[r] = b1[16 * (r >> 3) + (r & 7)]; }
    const LAS bf16* kr = Kt + kperm(q) * AKP + 8 * h;
#pragma unroll
    for (int d0 = 0; d0 < 4; ++d0) { s0 = mfma32(*(const LAS bf16x8*)(kr + d0 * 16), qf[d0], s0); s1 = mfma32(*(const LAS bf16x8*)(kr + 32 * AKP + d0 * 16), qf[d0], s1); }
    const float mx = xhalf_max(fmaxf(max16(s0), max16(s1)));
    const float mn = fmaxf(st.m, mx);
    const float alpha = __builtin_amdgcn_exp2f(st.m - mn);
    float ps0 = 0.f, ps1 = 0.f;
#pragma unroll
    for (int r = 0; r < 16; ++r) { const float p = __builtin_amdgcn_exp2f(s0[r] - mn); s0[r] = p; ps0 += p; const float p2 = __builtin_amdgcn_exp2f(s1[r] - mn); s1[r] = p2; ps1 += p2; }
    const bf16x8 p00 = pack8(s0, 0), p01 = pack8(s0, 8), p10 = pack8(s1, 0), p11 = pack8(s1, 8);
    st.l = st.l * alpha + (ps0 + ps1); st.m = mn;
    if (__ballot(alpha != 1.0f) != 0ull) {
#pragma unroll
        for (int r = 0; r < 16; ++r) { st.o0[r] *= alpha; st.o1[r] *= alpha; } }
    const LAS bf16* v0 = Vt + q * AKP + 8 * h; const LAS bf16* v1 = v0 + 32 * AKP;
    st.o0 = mfma32(*(const LAS bf16x8*)v0, p00, st.o0); st.o1 = mfma32(*(const LAS bf16x8*)v1, p00, st.o1);
    st.o0 = mfma32(*(const LAS bf16x8*)(v0 + 16), p01, st.o0); st.o1 = mfma32(*(const LAS bf16x8*)(v1 + 16), p01, st.o1);
    st.o0 = mfma32(*(const LAS bf16x8*)(v0 + 32), p10, st.o0); st.o1 = mfma32(*(const LAS bf16x8*)(v1 + 32), p10, st.o1);
    st.o0 = mfma32(*(const LAS bf16x8*)(v0 + 48), p11, st.o0); st.o1 = mfma32(*(const LAS bf16x8*)(v1 + 48), p11, st.o1);
}

__device__ __forceinline__ u32x4 f8x8_bf16(u32x2 v) {
    const f32x2 a = __builtin_amdgcn_cvt_pk_f32_fp8((int)v.x, false), b = __builtin_amdgcn_cvt_pk_f32_fp8((int)v.x, true), c = __builtin_amdgcn_cvt_pk_f32_fp8((int)v.y, false), d = __builtin_amdgcn_cvt_pk_f32_fp8((int)v.y, true);
    u32x4 r; r.x = pg8::cvt_pk_bf16(a.x, a.y); r.y = pg8::cvt_pk_bf16(b.x, b.y); r.z = pg8::cvt_pk_bf16(c.x, c.y); r.w = pg8::cvt_pk_bf16(d.x, d.y); return r;
}
__device__ __forceinline__ void dil_attn_phase3(Frame& F) {
    LAS float* bt = (LAS float*)F.lds;
    { const float* btA = (const float*)(F.ws + WS_BTABA); for (int i = F.tid; i < 48 * 192; i += 512) { const int gh = i / 192, dl = 159 - i % 192; bt[i] = (dl >= 0 && dl <= 128) ? btA[gh * 132 + dl] : NEGB; } }
    constexpr int TBL = 48 * 192 * 4;
    const int lane = F.lane, q = lane & 31, h = lane >> 5, w = F.wave, uw = w >> 2, qt = w & 3, t = F.tid, tu = t >> 8, tt = t & 255, srow = tt >> 3, sch = tt & 7;
    const unsigned char* QK = F.ws + WS_SCR + S_QK; const unsigned char* VT = F.ws + WS_SCR + S_VT;
    bf16* OG = (bf16*)((unsigned char*)F.out + O_OG); float* LSE = (float*)((unsigned char*)F.out + O_LSE);
    const int sdst = srow * AKP + sch * 8;
    int du = F.vcu;
    if (du >= 3072) { __syncthreads(); return; }
    int g = du >> 10, hh = (du >> 6) & 15, blp = (du >> 4) & 3, rn = du & 15;
    int j = ((rn & ((16 >> (2 * g)) - 1)) != 0) ? 0 : 2;
    u32x2 k0, k1, v0, v1; u32x2 qn[4]; bf16x8 qf[4];
#define DIL_LOADS(G_, HH_, BLP_, RN_, J_) do { const int n0s_ = (2 * (BLP_) + tu) * 2048 + (RN_) * 128 - 128 + 64 * (J_); \
        const unsigned char* ks_ = QK + ((size_t)(G_) * TC + n0s_ + srow) * 2048 + 1024 + (HH_) * 64 + sch * 8; \
        const unsigned char* vs_ = VT + ((size_t)(G_) * 1024 + (HH_) * 64 + srow) * TC + n0s_ + sch * 8; \
        k0 = *(const u32x2*)ks_; k1 = *(const u32x2*)(ks_ + (size_t)32 * 2048); v0 = *(const u32x2*)vs_; v1 = *(const u32x2*)(vs_ + (size_t)32 * TC); } while (0)
#define DIL_QLOADS(G_, HH_, BLP_, RN_) do { const unsigned char* qr_ = QK + ((size_t)(G_) * TC + (2 * (BLP_) + uw) * 2048 + (RN_) * 128 + 32 * qt + q) * 2048 + (HH_) * 64; \
        _Pragma("unroll") for (int d0 = 0; d0 < 4; ++d0) qn[d0] = *(const u32x2*)(qr_ + d0 * 16 + 8 * h); } while (0)
#define DIL_WRITE(PB_) do { LAS bf16* kb_ = (LAS bf16*)(F.lds + TBL + ((PB_) * 2 + tu) * 2 * ATILE); LAS bf16* vb_ = kb_ + 64 * AKP; \
        *(LAS u32x4*)(kb_ + sdst) = f8x8_bf16(k0); *(LAS u32x4*)(kb_ + 32 * AKP + sdst) = f8x8_bf16(k1); *(LAS u32x4*)(vb_ + sdst) = f8x8_bf16(v0); *(LAS u32x4*)(vb_ + 32 * AKP + sdst) = f8x8_bf16(v1); } while (0)
    DIL_LOADS(g, hh, blp, rn, j); DIL_QLOADS(g, hh, blp, rn);
    DIL_WRITE(0);
#pragma unroll
    for (int d0 = 0; d0 < 4; ++d0) qf[d0] = __builtin_bit_cast(bf16x8, f8x8_bf16(qn[d0]));
    __syncthreads();
    AttnSt st; st.m = NEGB; st.l = 0.f; st.o0 = (f32x16){}; st.o1 = (f32x16){};
    int pb = 0;
    for (;;) {
        const bool last = (j == 3);
        int ng = g, nhh = hh, nblp = blp, nrn = rn, nj = j + 1; bool more = true;
        if (last) { const int nd = du + F.G; more = nd < 3072; ng = nd >> 10; nhh = (nd >> 6) & 15; nblp = (nd >> 4) & 3; nrn = nd & 15; nj = ((nrn & ((16 >> (2 * ng)) - 1)) != 0) ? 0 : 2; }
        if (more) { DIL_LOADS(ng, nhh, nblp, nrn, nj); if (last) DIL_QLOADS(ng, nhh, nblp, nrn); }
        { const LAS bf16* kb = (const LAS bf16*)(F.lds + TBL + (pb * 2 + uw) * 2 * ATILE); const LAS bf16* vb = kb + 64 * AKP;
          const int gh = g * 16 + hh, ta = 2 * j, tb = 2 * j + 1;
          const bool a_on = ta >= qt && ta <= qt + 4, b_on = tb >= qt && tb <= qt + 4;
          const LAS float* row = bt + gh * 192;
          const LAS float* ba = row + (168 - (32 + (32 * qt + q + 128 - 32 * ta - 8 * h - 23)));
          if (a_on || b_on) attn_tile2r(kb, vb, a_on ? ba : row + 160, b_on ? ba + 32 : row + 160, qf, st, q, h); }
        if (more) DIL_WRITE(pb ^ 1);
        if (last) {
            const float l_tot = xhalf_sum(st.l), inv = 1.f / l_tot;
            const size_t orow = (size_t)g * TC + (2 * blp + uw) * 2048 + rn * 128 + 32 * qt + q;
            attn_store8(st, (unsigned char*)OG + orow * 1024 + hh * 64 + 4 * h, inv * ASCALE8);
            if (h == 0) LSE[orow * 16 + hh] = st.m + __log2f(l_tot);
            st.m = NEGB; st.l = 0.f; st.o0 = (f32x16){}; st.o1 = (f32x16){};
#pragma unroll
            for (int d0 = 0; d0 < 4; ++d0) qf[d0] = __builtin_bit_cast(bf16x8, f8x8_bf16(qn[d0]));
        }
        __syncthreads();
        pb ^= 1;
        if (!more) break;
        if (last) du += F.G;
        g = ng; hh = nhh; blp = nblp; rn = nrn; j = nj;
    }
#undef DIL_LOADS
#undef DIL_QLOADS
#undef DIL_WRITE
}

__device__ __forceinline__ void moba_phase3(Frame& F) {
    constexpr int TBL = 8448, KMO = TBL + 4 * ATILE;
    LAS float* bt = (LAS float*)F.lds; LAS float* kml = (LAS float*)(F.lds + KMO);
    const int lane = F.lane, q = lane & 31, h = lane >> 5, w = F.wave, t = F.tid, srow = t >> 3, sch = t & 7;
    const bf16* QK = (const bf16*)(F.ws + WS_SCR + S_CQK); const bf16* VT = (const bf16*)(F.ws + WS_SCR + S_CVT);
    bf16* att = (bf16*)(F.ws + WS_SCR + S_CATT); const float* km = (const float*)(F.ws + WS_KMEAN);
    const int NP = NB * NH * 4, per = (NP + F.G - 1) / F.G;
    const int lo = F.vcu * per, hi = (lo + per) < NP ? (lo + per) : NP;
    const int nunits = 2 * (hi - lo);
    if (nunits <= 0) return;
    const int sdst = srow * AKP + sch * 8;
    int u = 0, cur_bh = -1;
    u32x4 kreg, vreg; bf16x8 qn[4], qf[4];
#define MB_LOADS(B_, HH_, S_) do { const bf16* ks_ = QK + ((size_t)(B_) * SEQ + 64 * (S_) + srow) * 2048 + 1024 + (HH_) * 64 + sch * 8; \
        const bf16* vs_ = VT + ((size_t)(HH_) * 64 + srow) * T + (size_t)(B_) * SEQ + 64 * (S_) + sch * 8; kreg = *(const u32x4*)ks_; vreg = *(const u32x4*)vs_; } while (0)
#define MB_QLOADS(B_, HH_, NB_) do { const bf16* qr_ = QK + ((size_t)(B_) * SEQ + (NB_) * 256 + 32 * w + q) * 2048 + (HH_) * 64; \
        _Pragma("unroll") for (int d0 = 0; d0 < 4; ++d0) qn[d0] = *(const bf16x8*)(qr_ + d0 * 16 + 8 * h); } while (0)
#define MB_WRITE(PB_) do { LAS bf16* kb_ = (LAS bf16*)(F.lds + TBL + (PB_) * 2 * ATILE); *(LAS u32x4*)(kb_ + sdst) = kreg; *(LAS u32x4*)(kb_ + 64 * AKP + sdst) = vreg; } while (0)
    int pu = lo, jj = pu & 3, hh = (pu >> 2) & 15, b = pu >> 6, nb = 7 - jj, s = 0, pb = 0;
    MB_LOADS(b, hh, 0); MB_QLOADS(b, hh, nb); MB_WRITE(0);
    unsigned sel = 0; bool fresh = true;
    AttnSt st; st.m = NEGB; st.l = 0.f; st.o0 = (f32x16){}; st.o1 = (f32x16){};
    for (;;) {
        if (fresh) {
            if (b * 16 + hh != cur_bh) { __syncthreads(); const float* btC = (const float*)(F.ws + WS_BTABC) + hh * 2048;
                for (int i = t; i < 2048 + 32; i += 512) bt[2079 - i] = i < 32 ? NEGB : btC[i - 32];
                { const float* kmp = km + ((size_t)b * NH + hh) * 512; kml[t] = kmp[t]; }
                cur_bh = b * 16 + hh; }
#pragma unroll
            for (int d0 = 0; d0 < 4; ++d0) qf[d0] = qn[d0];
            __syncthreads();
            sel = 0;
            if (nb > 0) {
                float gsc[7];
#pragma unroll
                for (int m = 0; m < 7; ++m) { float sc = 0.f;
                    if (m < nb) {
#pragma unroll
                        for (int d0 = 0; d0 < 4; ++d0) { const f32x4 c0 = *(const LAS f32x4*)(kml + m * 64 + d0 * 16 + 8 * h), c1 = *(const LAS f32x4*)(kml + m * 64 + d0 * 16 + 8 * h + 4); const u32x4 qq = __builtin_bit_cast(u32x4, qf[d0]);
                            sc += bflo(qq.x) * c0.x + bfhi(qq.x) * c0.y + bflo(qq.y) * c0.z + bfhi(qq.y) * c0.w + bflo(qq.z) * c1.x + bfhi(qq.z) * c1.y + bflo(qq.w) * c1.z + bfhi(qq.w) * c1.w; }
                        sc = xhalf_sum(sc); }
                    gsc[m] = m < nb ? sc : -3.0e38f; }
                const int nsel = nb < 3 ? nb : 3;
#pragma unroll
                for (int r = 0; r < 3; ++r) { if (r < nsel) { int bi = 0; float bv = -3.4e38f;
#pragma unroll
                        for (int m = 0; m < 7; ++m) if (!((sel >> m) & 1u) && gsc[m] > bv) { bv = gsc[m]; bi = m; }
                        sel |= 1u << bi; } }
            }
            fresh = false;
        }
        const int nsteps = 4 * nb + 4;
        const bool last = (s + 1 == nsteps);
        int nb2 = nb, b2 = b, hh2 = hh, s2 = s + 1; bool more = true;
        if (last) { const int u2 = u + 1; more = u2 < nunits; const int pu2 = lo + (u2 >> 1), j2 = pu2 & 3; hh2 = (pu2 >> 2) & 15; b2 = pu2 >> 6; nb2 = (u2 & 1) ? j2 : 7 - j2; s2 = 0; }
        if (more) { MB_LOADS(b2, hh2, s2); if (last) MB_QLOADS(b2, hh2, nb2); }
        { const LAS bf16* kb = (const LAS bf16*)(F.lds + TBL + pb * 2 * ATILE); const LAS bf16* vb = kb + 64 * AKP;
          const int qpos = nb * 256 + 32 * w + q;
          const LAS float* ba = bt + (2056 - (32 + (qpos - 8 * h - 64 * s - 23)));
          const LAS float* negp = bt + 2048;
          bool act; const LAS float* p0; const LAS float* p1;
          if (s < 4 * nb) { const bool mine = (sel >> (s >> 2)) & 1u; act = __ballot(mine) != 0ull; p0 = mine ? ba : negp; p1 = mine ? ba + 32 : negp; }
          else { const int ta = (s - 4 * nb) * 2; act = ta <= w; p0 = ba; p1 = (ta + 1 <= w) ? ba + 32 : negp; }
          if (act) attn_tile2r(kb, vb, p0, p1, qf, st, q, h); }
        if (more) MB_WRITE(pb ^ 1);
        if (last) {
            const float l_tot = xhalf_sum(st.l), inv = 1.f / l_tot;
            const size_t tq = (size_t)b * SEQ + nb * 256 + 32 * w + q;
            attn_store8(st, (unsigned char*)att + tq * 1024 + hh * 64 + 4 * h, inv * ASCALE8);
            st.m = NEGB; st.l = 0.f; st.o0 = (f32x16){}; st.o1 = (f32x16){};
        }
        if (!last) __syncthreads();
        pb ^= 1;
        if (!more) break;
        if (last) { ++u; fresh = true; }
        nb = nb2; b = b2; hh = hh2; s = s2;
    }
#undef MB_LOADS
#undef MB_QLOADS
#undef MB_WRITE
}

__device__ __forceinline__ void gmlp_phase(Frame& F, const float* lng, const float* lnb, const float* bs) {
    const int lane = F.lane, w = F.wave, q = lane & 31, h = lane >> 5;
    const bf16* uv = (const bf16*)(F.ws + WS_SCR + S_UV); bf16* p = (bf16*)(F.ws + WS_SCR + S_P); const bf16* wst = (const bf16*)(F.ws + WS_WST);
    LAS float* stat = (LAS float*)F.lds;
    LAS bf16* vnT = (LAS bf16*)(F.lds + 1024);
    constexpr int VP = 136;
    for (int unit = F.vcu; unit < T / 128; unit += F.G) {
        const size_t t0 = (size_t)unit * 128;
        __syncthreads();
        for (int i = 0; i < 16; ++i) { const int r = w * 16 + i; const u32x4* vr = (const u32x4*)(uv + (t0 + r) * 2048 + 1024) + lane;
            const u32x4 a = vr[0], b = vr[64]; float x[16];
            x[0] = bflo(a.x); x[1] = bfhi(a.x); x[2] = bflo(a.y); x[3] = bfhi(a.y); x[4] = bflo(a.z); x[5] = bfhi(a.z); x[6] = bflo(a.w); x[7] = bfhi(a.w);
            x[8] = bflo(b.x); x[9] = bfhi(b.x); x[10] = bflo(b.y); x[11] = bfhi(b.y); x[12] = bflo(b.z); x[13] = bfhi(b.z); x[14] = bflo(b.w); x[15] = bfhi(b.w);
            float s = 0.f;
#pragma unroll
            for (int j = 0; j < 16; ++j) s += x[j];
            const float mean = wave_sum(s) * (1.f / 1024.f); float s2 = 0.f;
#pragma unroll
            for (int j = 0; j < 16; ++j) { const float d = x[j] - mean; s2 += d * d; }
            const float rstd = 1.f / sqrtf(wave_sum(s2) * (1.f / 1024.f) + LN_EPS);
            if (lane == 0) { stat[2 * r] = mean; stat[2 * r + 1] = rstd; } }
        __syncthreads();
        for (int gg = 0; gg < 8; ++gg) {
#pragma unroll
            for (int k = 0; k < 4; ++k) { const int id = F.tid + 512 * k, s = id >> 4, cc = (id & 15) * 8;
                const u32x4 a = *(const u32x4*)(uv + (t0 + s) * 2048 + 1024 + gg * 128 + cc); const float mean = stat[2 * s], rstd = stat[2 * s + 1];
                float x[8]; x[0] = bflo(a.x); x[1] = bfhi(a.x); x[2] = bflo(a.y); x[3] = bfhi(a.y); x[4] = bflo(a.z); x[5] = bfhi(a.z); x[6] = bflo(a.w); x[7] = bfhi(a.w);
#pragma unroll
                for (int j = 0; j < 8; ++j) { const int c = gg * 128 + cc + j; const float y = (x[j] - mean) * rstd * lng[c] + lnb[c]; vnT[(cc + j) * VP + s] = (bf16)f2bf(y); } }
            __syncthreads();
            const int cr = 32 * (w & 3), tc0 = 64 * (w >> 2);
            f32x16 acc0 = {}, acc1 = {};
#pragma unroll
            for (int ks = 0; ks < 8; ++ks) {
                const bf16x8 af = *(const LAS bf16x8*)(vnT + (cr + q) * VP + ks * 16 + 8 * h);
                const bf16x8 b0 = *(const bf16x8*)(wst + ((size_t)gg * 128 + tc0 + q) * 128 + ks * 16 + 8 * h);
                const bf16x8 b1 = *(const bf16x8*)(wst + ((size_t)gg * 128 + tc0 + 32 + q) * 128 + ks * 16 + 8 * h);
                acc0 = mfma32(af, b0, acc0); acc1 = mfma32(af, b1, acc1);
            }
#pragma unroll
            for (int tt = 0; tt < 2; ++tt) { const f32x16& ac = tt == 0 ? acc0 : acc1; const int tl = tc0 + 32 * tt + q; const float bsv = bs[gg * 128 + tl];
                const size_t rowu = (t0 + tl) * 2048, rowp = (t0 + tl) * 1024;
#pragma unroll
                for (int gq = 0; gq < 4; ++gq) { const int c = gg * 128 + cr + 8 * gq + 4 * h; const u32x2 uu = *(const u32x2*)(uv + rowu + c);
                    u32x2 o; o.x = pk2(bflo(uu.x) * (ac[4 * gq] + bsv), bfhi(uu.x) * (ac[4 * gq + 1] + bsv)); o.y = pk2(bflo(uu.y) * (ac[4 * gq + 2] + bsv), bfhi(uu.y) * (ac[4 * gq + 3] + bsv));
                    *(u32x2*)(p + rowp + c) = o; } }
            __syncthreads();
        }
    }
}

struct MoeSeg { int ts[9]; };
__device__ __forceinline__ MoeSeg moe_seg(Frame& F, int moe_l) {
    MoeSeg s; int acc = 0;
#pragma unroll
    for (int e = 0; e < 8; ++e) { s.ts[e] = acc; const unsigned c = __hip_atomic_load((unsigned*)(F.ctl + CW_ECNT + 64 * moe_l + e), RLX_AGENT); acc += (int)((c + 255u) >> 8); }
    s.ts[8] = acc; return s;
}
__device__ __forceinline__ void moe_gather_phase(Frame& F, int moe_l) {
    LAS int* P = (LAS int*)F.lds;
    LAS int* wtot = (LAS int*)(F.lds + 65536);
    LAS int* tot = wtot + 64;
    const int* wcnt = (const int*)(F.ws + WS_WCNT);
    int t = F.tid; asm volatile("" : "+v"(t));
    const int lane = F.lane;
    int loc[4][8], sum[8], inc[8];
#pragma unroll
    for (int k = 0; k < 4; ++k) { const u32x4 a = *(const u32x4*)(wcnt + (4 * t + k) * 8), b = *(const u32x4*)(wcnt + (4 * t + k) * 8 + 4);
        loc[k][0] = (int)a.x; loc[k][1] = (int)a.y; loc[k][2] = (int)a.z; loc[k][3] = (int)a.w; loc[k][4] = (int)b.x; loc[k][5] = (int)b.y; loc[k][6] = (int)b.z; loc[k][7] = (int)b.w; }
#pragma unroll
    for (int e = 0; e < 8; ++e) { sum[e] = (loc[0][e] + loc[1][e]) + (loc[2][e] + loc[3][e]); inc[e] = sum[e]; }
#pragma unroll
    for (int off = 1; off < 64; off <<= 1) {
#pragma unroll
        for (int e = 0; e < 8; ++e) { const int v = __shfl_up(inc[e], off); if (lane >= off) inc[e] += v; } }
    if (lane == 63) {
#pragma unroll
        for (int e = 0; e < 8; ++e) wtot[F.wave * 8 + e] = inc[e]; }
    __syncthreads();
    int run[8];
#pragma unroll
    for (int e = 0; e < 8; ++e) { int wb = 0; for (int w = 0; w < F.wave; ++w) wb += wtot[w * 8 + e]; run[e] = wb + inc[e] - sum[e]; }
#pragma unroll
    for (int k = 0; k < 4; ++k) {
#pragma unroll
        for (int e = 0; e < 8; ++e) { P[(4 * t + k) * 8 + e] = run[e]; run[e] += loc[k][e]; } }
    if (t == 511) {
#pragma unroll
        for (int e = 0; e < 8; ++e) tot[e] = run[e]; }
    __syncthreads();
    MoeSeg sg; { int acc = 0;
#pragma unroll
        for (int e = 0; e < 8; ++e) { sg.ts[e] = acc; acc += (tot[e] + 255) >> 8; } sg.ts[8] = acc; }
    if (blockIdx.x == 0 && t < 8) __hip_atomic_store((unsigned*)(F.ctl + CW_ECNT + 64 * moe_l + t), (unsigned)tot[t], RLX_AGENT);
    const int gw = F.vcu * NWAVES + F.wave, NGW = F.G * NWAVES;
    const bf16* hb = (const bf16*)(F.ws + WS_HB); unsigned char* xg8 = (unsigned char*)F.out;
    const int* route = (const int*)(F.ws + WS_ROUTE); int* slots = (int*)(F.ws + WS_SLOTS);
    for (int m0 = 4 * gw; m0 < T; m0 += 4 * NGW) {
        int s1[4], s2[4]; u32x4 a[4], b[4];
#pragma unroll
        for (int k = 0; k < 4; ++k) { const int m = m0 + k, grp = m >> 5;
            const int e1 = route[4 * m], p1 = route[4 * m + 1], e2 = route[4 * m + 2], p2 = route[4 * m + 3];
            int ts1 = 0, ts2 = 0;
#pragma unroll
            for (int e = 0; e < 8; ++e) { ts1 = e == e1 ? sg.ts[e] : ts1; ts2 = e == e2 ? sg.ts[e] : ts2; }
            s1[k] = ts1 * 256 + P[grp * 8 + e1] + p1; s2[k] = ts2 * 256 + P[grp * 8 + e2] + p2;
            const u32x4* src = (const u32x4*)(hb + (size_t)m * D) + lane; a[k] = src[0]; b[k] = src[64]; }
#pragma unroll
        for (int k = 0; k < 4; ++k) { const int m = m0 + k;
            float x[16]; unpack8(a[k], x); unpack8(b[k], x + 8);
            u32x2 lo, hi; lo.x = pk4_fp8(x[0], x[1], x[2], x[3]); lo.y = pk4_fp8(x[4], x[5], x[6], x[7]); hi.x = pk4_fp8(x[8], x[9], x[10], x[11]); hi.y = pk4_fp8(x[12], x[13], x[14], x[15]);
            unsigned char* d1 = xg8 + (size_t)s1[k] * D + 8 * lane; unsigned char* d2 = xg8 + (size_t)s2[k] * D + 8 * lane;
            *(u32x2*)d1 = lo; *(u32x2*)(d1 + 512) = hi; *(u32x2*)d2 = lo; *(u32x2*)(d2 + 512) = hi;
            if (lane == 0) { slots[2 * m] = s1[k]; slots[2 * m + 1] = s2[k]; } }
    }
}
struct MoeOrder {
    int nM, nN, G, c, tile0; MoeSeg sg; const char* A0; const char* B0; size_t aT, bE, bT; bool a_local;
    bool out_local;
    __device__ __forceinline__ bool next(int i, pg8::Unit& u) const {
        int pm, pn; if (!pg8::tile_of((long)i * G + c, nM, nN, pm, pn)) return false;
        if (a_local) pm = nM - 1 - pm;
        const int tile = tile0 + pm; int e = 0;
#pragma unroll
        for (int k = 1; k < 8; ++k) e += (tile >= sg.ts[k]) ? 1 : 0;
        u.pm = out_local ? pm : tile; u.pn = pn; u.a = (unsigned)((size_t)(a_local ? pm : tile) * aT); u.b = (unsigned)((size_t)e * bE + (size_t)pn * bT); return true;
    }
};


template <int GI> struct L0QKOrder { int G, c; const char* A0; const char* B0;
    __device__ __forceinline__ bool next(int i, pg8::Unit& u) const { if (!pg8::tile_of((long)i * G + c, 64, 8, u.pm, u.pn)) return false; const int pm = u.pm;
        const int tok = GI == 0 ? pm * 256 : (GI == 1 ? (pm >> 3) * 2048 + (pm & 1) * 1024 + ((pm >> 1) & 3) : (pm >> 3) * 2048 + (pm & 7) * 2);
        u.a = (unsigned)tok * 1024u; u.b = (unsigned)u.pn * 256u * 1024u; return true; } };
template <int GI> struct L0VtOrder { int G, c; const char* A0; const char* B0;
    __device__ __forceinline__ bool next(int i, pg8::Unit& u) const { if (!pg8::tile_of((long)i * G + c, 4, 64, u.pm, u.pn)) return false; const int pn = u.pn;
        const int tok = GI == 0 ? pn * 256 : (GI == 1 ? (pn >> 3) * 2048 + (pn & 1) * 1024 + ((pn >> 1) & 3) : (pn >> 3) * 2048 + (pn & 7) * 2);
        u.a = (unsigned)u.pm * 256u * 1024u; u.b = (unsigned)tok * 1024u; return true; } };
template <int GI> __device__ __forceinline__ void l0_gemms(Frame& F, int ck, int bx) {
    constexpr int rs = GI == 0 ? 1 : (GI == 1 ? 4 : 16);
    constexpr size_t hst = (GI == 0 ? (size_t)128 : (GI == 1 ? (size_t)512 : (size_t)1)) * 1024;
    const char* hbc = (const char*)(F.ws + WS_SCR + S_HB8) + (size_t)ck * TC * 1024;
    unsigned char* scr = F.ws + WS_SCR;
    { L0QKOrder<GI> S{F.G, bx, hbc, (const char*)(F.ws + W_A_QK) + (size_t)GI * 2048 * 1024};
      pg8::Gemm gm{512, rs, 1, hst, (size_t)128 * 1024};
      pg8::EpiF8 E{scr + S_QK + (size_t)GI * TC * 2048, 2048, 1.f / WSCALE8};
      pg8::gemm_phase<pg8::EpiF8, L0QKOrder<GI>, false, 1>(F.lds, F.wave, gm, S, E); }
    { L0VtOrder<GI> S{F.G, bx, (const char*)(F.ws + W_A_V) + (size_t)GI * 1024 * 1024, hbc};
      pg8::Gemm gm{512, 1, rs, (size_t)128 * 1024, hst};
      pg8::EpiF8 E{scr + S_VT + (size_t)GI * 1024 * TC, TC, 1.f / WSCALE8};
      pg8::gemm_phase<pg8::EpiF8, L0VtOrder<GI>, false, 1>(F.lds, F.wave, gm, S, E); }
}


#ifdef MK_SELFCHECK
__device__ __forceinline__ void selfcheck_buf(Frame& F, const void* ptr, size_t nbytes, int stage, int slot0) {
    if (!F.chk) return;
    const int gw = F.vcu * NWAVES + F.wave, NGW = F.G * NWAVES; unsigned* cks = (unsigned*)(F.ws + WS_NEED + 2 * MiB) + slot0;
    const int nch = (int)(nbytes >> 12);
    for (int c = gw; c < nch; c += NGW) { const u32x4* r = (const u32x4*)((const char*)ptr + ((size_t)c << 12)) + F.lane; unsigned x = 0;
#pragma unroll
        for (int j = 0; j < 4; ++j) { const u32x4 v = r[64 * j]; x ^= v.x * 3u + v.y * 5u + v.z * 7u + v.w * 11u + (unsigned)j; }
        x *= (unsigned)(2 * F.lane + 1);
#pragma unroll
        for (int o = 1; o < 64; o <<= 1) x ^= __shfl_xor(x, o);
        if (F.lane == 0) { if (F.chk == 1) cks[c] = x; else if (cks[c] != x) atomicMax((unsigned*)(F.ctl + 32), (unsigned)(1000 - stage)); } }
}
#endif

__global__ void __launch_bounds__(NWAVES * 64, 2) mk_fwd(Args args) {
    extern __shared__ __attribute__((aligned(16))) unsigned char lds[];
    Frame F;
    F.lds = (LAS unsigned char*)lds;
    F.tid = threadIdx.x; F.lane = F.tid & 63; F.wave = __builtin_amdgcn_readfirstlane(F.tid >> 6);
    F.G = gridDim.x; { const int bx = blockIdx.x; F.vcu = (F.G % 8 == 0) ? (bx % 8) * (F.G / 8) + bx / 8 : bx; }
    F.ws = args.ws; F.ctl = (gu32*)(args.ws + WS_CTL); F.out = args.out; F.chk = args.chk; F.stage = 0;
    volatile LAS unsigned* MISC = (volatile LAS unsigned*)(F.lds + MISC_OFF);
    for (int u = F.tid; u < (LDS_BYTES - RING_BYTES) / 4; u += NWAVES * 64) ((LAS unsigned*)(F.lds + RING_BYTES))[u] = 0u;
    __syncthreads();
    XcdBarrier bar; bar.bar = (unsigned*)(F.ctl + CW_BAR); bar.x = 0; bar.st = nullptr;
    if (!MK_MULTI) bar = xcd_barrier_post((unsigned*)(F.ctl + CW_BAR), MISC + 8);
    const int lo = args.ph_lo, hi = args.ph_hi;
    int ph = 0;
#define PHASE_BEGIN if (ph >= lo && ph < hi) { F.lane = (int)__builtin_amdgcn_mbcnt_hi(~0u, __builtin_amdgcn_mbcnt_lo(~0u, 0u)); asm volatile("" : "+v"(F.lane)); F.tid = F.wave * 64 + F.lane;
#define PHASE_END   if (!MK_MULTI && ph + 1 < hi) xcd_barrier(bar, F.tid); } ++ph;
    const int bx = (int)blockIdx.x;
#define scr (args.ws + WS_SCR)
#define hb ((const bf16*)(args.ws + WS_HB))
#define ln_g (args.in[2])
#define ln_b (args.in[3])

    PHASE_BEGIN p_prologue(F, args); if (MK_PROBE & 8) p_prologue(F, args); PHASE_END

    if (MK_ENABLE & 1) {
#define L0_CHUNK(ck) \
        PHASE_BEGIN \
        if ((ck) > 0) dil_merge_phase(F, (ck) - 1); \
        l0_gemms<0>(F, (ck), bx); l0_gemms<1>(F, (ck), bx); l0_gemms<2>(F, (ck), bx); \
        PHASE_END \
        PHASE_BEGIN dil_attn_phase3(F); if (MK_PROBE & 1) dil_attn_phase3(F); PHASE_END
        L0_CHUNK(0) L0_CHUNK(1) L0_CHUNK(2) L0_CHUNK(3)
#undef L0_CHUNK
        PHASE_BEGIN dil_merge_phase(F, 3); if (MK_PROBE & 4) { dil_merge_phase(F, 3); dil_merge_phase(F, 3); dil_merge_phase(F, 3); dil_merge_phase(F, 3); } PHASE_END
        PHASE_BEGIN
        { pg8::LinOrder S{T / 256, 4, F.G, bx, (const char*)(scr + S_ATT), (const char*)(F.ws + W_A_O), (size_t)256 * 1024, (size_t)256 * 1024};
          pg8::Gemm gm{512, 1, 1, (size_t)128 * 1024, (size_t)128 * 1024};
          pg8::EpiResLn<FFN_GU8 == 0> E{(bf16*)(F.ws + WS_HB), ln_g + 0 * 2048, ln_b + 0 * 2048, ALPHA, 1.f / (WSCALE8 * ASCALE8), (float*)scr, (unsigned*)(F.ctl + CW_LNC + 0 * 4096), (unsigned*)(F.ctl + CW_BAR) + XB_TMO, scr + S_HB8, F.lds + LNT_OFF};
          pg8::gemm_phase<pg8::EpiResLn<FFN_GU8 == 0>, pg8::LinOrder, true, 1>(F.lds, F.wave, gm, S, E); }
        PHASE_END
    } else {
        PHASE_BEGIN ln_phase<1, false, false>(F, ln_g + 0 * 2048, ln_b + 0 * 2048, nullptr); PHASE_END
    }
#define DENSE_FFN(f, lnidx, enbit) \
    if (MK_ENABLE & (enbit)) { \
        PHASE_BEGIN \
        if ((f) == FFN_GU8) { \
          pg8::LinOrder S{T / 256, 2 * DFF / 256, F.G, bx, (const char*)(scr + S_HB8), (const char*)(F.ws + W_F_GU) + (size_t)(f) * 2 * DFF * 2048, (size_t)256 * 1024, (size_t)256 * 1024}; \
          pg8::Gemm gm{512, 1, 1, (size_t)128 * 1024, (size_t)128 * 1024};     \
          pg8::EpiSwiglu8 E{(unsigned char*)(scr + S_HID), DFF, 1.f / WSCALE8}; \
          pg8::gemm_phase<pg8::EpiSwiglu8, pg8::LinOrder, true, 1>(F.lds, F.wave, gm, S, E); \
        } else { pg8::LinOrder S{T / 256, 2 * DFF / 256, F.G, bx, (const char*)hb, (const char*)(F.ws + W_F_GU) + (size_t)(f) * 2 * DFF * 2048, (size_t)256 * 2048, (size_t)256 * 2048}; \
          pg8::Gemm gm{1024, 1, 1, (size_t)128 * 2048, (size_t)128 * 2048}; \
          pg8::EpiSwiglu8 E{(unsigned char*)(scr + S_HID), DFF}; \
          pg8::gemm_phase(F.lds, F.wave, gm, S, E); } \
        PHASE_END \
        PHASE_BEGIN \
        { pg8::LinOrder S{T / 256, 4, F.G, bx, (const char*)(scr + S_HID), (const char*)(F.ws + W_F_D) + (size_t)(f) * 1024 * DFF * 2, (size_t)256 * DFF, (size_t)256 * DFF}; \
          pg8::Gemm gm{DFF / 2, 1, 1, (size_t)128 * DFF, (size_t)128 * DFF};     \
          pg8::EpiResLn<false> E{(bf16*)(F.ws + WS_HB), ln_g + (lnidx) * 1024, ln_b + (lnidx) * 1024, ALPHA, 1.f / WSCALE8D, (float*)(scr + S_Y), (unsigned*)(F.ctl + CW_LNC + (2 + (f)) * 4096), (unsigned*)(F.ctl + CW_BAR) + XB_TMO, nullptr, F.lds + LNT_OFF}; \
          pg8::gemm_phase<pg8::EpiResLn<false>, pg8::LinOrder, true, 1>(F.lds, F.wave, gm, S, E); }     \
        PHASE_END \
    } else { \
        PHASE_BEGIN ln_phase<1, false, false>(F, ln_g + (lnidx) * 1024, ln_b + (lnidx) * 1024, nullptr); PHASE_END \
    }
    DENSE_FFN(0, 1, 2)

    if (MK_ENABLE & 4) {
        PHASE_BEGIN
        { pg8::LinOrder S{T / 256, 4, F.G, bx, (const char*)hb, (const char*)(F.ws + W_B_IN), (size_t)256 * 2048, (size_t)256 * 2048};
          pg8::Gemm gm{1024, 1, 1, (size_t)128 * 2048, (size_t)128 * 2048};
          pg8::EpiBf16<0> E{(bf16*)(scr + S_BCX), 1024};
          pg8::gemm_phase(F.lds, F.wave, gm, S, E); }
        { pg8::LinOrder S{T / 256, 8, F.G, bx, (const char*)hb, (const char*)(F.ws + W_B_IN) + (size_t)1024 * 2048, (size_t)256 * 2048, (size_t)256 * 2048};
          pg8::Gemm gm{1024, 1, 1, (size_t)128 * 2048, (size_t)128 * 2048};
          pg8::EpiGlu<0> E{(bf16*)(scr + S_BCX + (size_t)128 * MiB), 1024};
          pg8::gemm_phase(F.lds, F.wave, gm, S, E); }
        PHASE_END
        PHASE_BEGIN conv_phase(F, args.in[7]); if (MK_PROBE & 4) conv_phase(F, args.in[7]); PHASE_END
        PHASE_BEGIN
        { pg8::LinOrder S{T / 256, 4, F.G, bx, (const char*)(scr + S_P), (const char*)(F.ws + W_B_O), (size_t)256 * 2048, (size_t)256 * 2048};
          pg8::Gemm gm{1024, 1, 1, (size_t)128 * 2048, (size_t)128 * 2048};
          pg8::EpiResBf16 E{hb, (bf16*)F.out, 1024, ALPHA};
          pg8::gemm_phase(F.lds, F.wave, gm, S, E); }
        PHASE_END
        PHASE_BEGIN ln_phase<0, true, false>(F, ln_g + 2 * 1024, ln_b + 2 * 1024, args.in[20]); PHASE_END
    } else {
        PHASE_BEGIN ln_phase<1, true, false>(F, ln_g + 2 * 1024, ln_b + 2 * 1024, args.in[20]); PHASE_END
    }
#define MOE_CHUNK(f, ck) \
        PHASE_BEGIN \
        { const MoeSeg sg = moe_seg(F, (f)); int nM = sg.ts[8] - (ck) * MOE_CH_TILES; nM = nM > MOE_CH_TILES ? MOE_CH_TILES : (nM < 0 ? 0 : nM); \
          MoeOrder S{nM, 2 * DFE / 256, F.G, bx, (ck) * MOE_CH_TILES, sg, (const char*)F.out, (const char*)(F.ws + W_E_GU) + (size_t)(f) * 8 * 2 * DFE * 2048, (size_t)256 * 1024, (size_t)2 * DFE * 2048, (size_t)256 * 1024, false, true}; \
          pg8::Gemm gm{512, 1, 1, (size_t)128 * 1024, (size_t)128 * 1024};     \
          pg8::EpiSwiglu8 E{(unsigned char*)(scr + S_MHID), DFE, 1.f / WSCALE8}; \
          pg8::gemm_phase<pg8::EpiSwiglu8, MoeOrder, true, 0x7C>(F.lds, F.wave, gm, S, E);     if ((ck) == 0 && (MK_PROBE & 32)) pg8::gemm_phase(F.lds, F.wave, gm, S, E); } \
        PHASE_END \
        PHASE_BEGIN \
        { const MoeSeg sg = moe_seg(F, (f)); int nM = sg.ts[8] - (ck) * MOE_CH_TILES; nM = nM > MOE_CH_TILES ? MOE_CH_TILES : (nM < 0 ? 0 : nM); \
          MoeOrder S{nM, 4, F.G, bx, (ck) * MOE_CH_TILES, sg, (const char*)(scr + S_MHID), (const char*)(F.ws + W_E_D) + (size_t)(f) * 8 * 1024 * DFE * 2, (size_t)256 * DFE, (size_t)1024 * DFE * 2, (size_t)256 * DFE, true, false}; \
          pg8::Gemm gm{DFE / 2, 1, 1, (size_t)128 * DFE, (size_t)128 * DFE};     \
          pg8::EpiF8 E{scr + S_XG, 1024, YSCALE8 / WSCALE8D};     \
          pg8::gemm_phase<pg8::EpiF8, MoeOrder, true, 0x7B>(F.lds, F.wave, gm, S, E);     if ((ck) == 0 && (MK_PROBE & 64)) pg8::gemm_phase(F.lds, F.wave, gm, S, E); } \
        PHASE_END
#define MOE_FFN(f, lnidx, enbit, fin) \
    if (MK_ENABLE & (enbit)) { \
        PHASE_BEGIN moe_gather_phase(F, (f)); if (MK_PROBE & 4) moe_gather_phase(F, (f)); PHASE_END \
        MOE_CHUNK(f, 0) MOE_CHUNK(f, 1) MOE_CHUNK(f, 2) \
        PHASE_BEGIN ln_phase<2, false, fin, (f) == 0>(F, ln_g + (lnidx) * 1024, ln_b + (lnidx) * 1024, nullptr); PHASE_END \
    } else { \
        PHASE_BEGIN ln_phase<1, false, fin>(F, ln_g + (lnidx) * 1024, ln_b + (lnidx) * 1024, nullptr); PHASE_END \
    }
    MOE_FFN(0, 3, 8, false)

    if (MK_ENABLE & 16) {
        PHASE_BEGIN
        { pg8::LinOrder S{T / 256, 8, F.G, bx, (const char*)hb, (const char*)(F.ws + W_C_QK), (size_t)256 * 2048, (size_t)256 * 2048};
          pg8::Gemm gm{1024, 1, 1, (size_t)128 * 2048, (size_t)128 * 2048};
          pg8::EpiBf16<0> E{(bf16*)(scr + S_CQK), 2048};
          pg8::gemm_phase(F.lds, F.wave, gm, S, E); }
        { pg8::LinOrder S{4, T / 256, F.G, bx, (const char*)(F.ws + W_C_V), (const char*)(scr + S_HB8), (size_t)256 * 1024, (size_t)256 * 1024};
          pg8::Gemm gm{512, 1, 1, (size_t)128 * 1024, (size_t)128 * 1024};
          pg8::EpiBf16<0> E{(bf16*)(scr + S_CVT), T, 1.f / WSCALE8};
          pg8::gemm_phase<pg8::EpiBf16<0>, pg8::LinOrder, true, 1>(F.lds, F.wave, gm, S, E); }
        PHASE_END
#ifdef MK_SELFCHECK
        PHASE_BEGIN selfcheck_buf(F, scr + S_CQK, (size_t)256 * MiB, 40, 0); selfcheck_buf(F, scr + S_CVT, (size_t)128 * MiB, 41, 65536); PHASE_END
#endif
        PHASE_BEGIN kmean_phase(F); if (MK_PROBE & 4) kmean_phase(F); PHASE_END
#ifdef MK_SELFCHECK
        PHASE_BEGIN selfcheck_buf(F, F.ws + WS_KMEAN, (size_t)1 * MiB, 42, 65536 + 32768); PHASE_END
#endif
        PHASE_BEGIN moba_phase3(F); if (MK_PROBE & 2) moba_phase3(F); PHASE_END
#ifdef MK_SELFCHECK
        PHASE_BEGIN selfcheck_buf(F, F.ws + WS_NEED + 3 * MiB, (size_t)4 * MiB, 43, 65536 + 32768 + 256); selfcheck_buf(F, F.ws + WS_NEED + 7 * MiB, (size_t)4 * MiB, 44, 65536 + 32768 + 256 + 1024);
                    selfcheck_buf(F, scr + S_CATT, (size_t)128 * MiB, 45, 65536 + 32768 + 256 + 2048); PHASE_END
#endif
        PHASE_BEGIN
        { pg8::LinOrder S{T / 256, 4, F.G, bx, (const char*)(scr + S_CATT), (const char*)(F.ws + W_C_O), (size_t)256 * 1024, (size_t)256 * 1024};
          pg8::Gemm gm{512, 1, 1, (size_t)128 * 1024, (size_t)128 * 1024};
          pg8::EpiResLn<FFN_GU8 == 1> E{(bf16*)(F.ws + WS_HB), ln_g + 4 * 1024, ln_b + 4 * 1024, ALPHA, 1.f / (WSCALE8 * ASCALE8), (float*)scr, (unsigned*)(F.ctl + CW_LNC + 1 * 4096), (unsigned*)(F.ctl + CW_BAR) + XB_TMO, scr + S_HB8, F.lds + LNT_OFF};
          pg8::gemm_phase<pg8::EpiResLn<FFN_GU8 == 1>, pg8::LinOrder, true, 1>(F.lds, F.wave, gm, S, E); }
        PHASE_END
    } else {
        PHASE_BEGIN ln_phase<1, false, false>(F, ln_g + 4 * 1024, ln_b + 4 * 1024, nullptr); PHASE_END
    }
    DENSE_FFN(1, 5, 32)

    if (MK_ENABLE & 64) {
        PHASE_BEGIN
        { pg8::LinOrder S{T / 256, 8, F.G, bx, (const char*)hb, (const char*)(F.ws + W_D_IN), (size_t)256 * 2048, (size_t)256 * 2048};
          pg8::Gemm gm{1024, 1, 1, (size_t)128 * 2048, (size_t)128 * 2048};
          pg8::EpiBf16<1> E{(bf16*)(scr + S_UV), 2048};
          pg8::gemm_phase(F.lds, F.wave, gm, S, E); }
        PHASE_END
        PHASE_BEGIN gmlp_phase(F, args.in[12], args.in[13], args.in[15]); if (MK_PROBE & 4) gmlp_phase(F, args.in[12], args.in[13], args.in[15]); PHASE_END
        PHASE_BEGIN
        { pg8::LinOrder S{T / 256, 4, F.G, bx, (const char*)(scr + S_P), (const char*)(F.ws + W_D_O), (size_t)256 * 2048, (size_t)256 * 2048};
          pg8::Gemm gm{1024, 1, 1, (size_t)128 * 2048, (size_t)128 * 2048};
          pg8::EpiResBf16 E{hb, (bf16*)F.out, 1024, ALPHA};
          pg8::gemm_phase(F.lds, F.wave, gm, S, E); }
        PHASE_END
        PHASE_BEGIN ln_phase<0, true, false>(F, ln_g + 6 * 1024, ln_b + 6 * 1024, args.in[20] + 8192); PHASE_END
    } else {
        PHASE_BEGIN ln_phase<1, true, false>(F, ln_g + 6 * 1024, ln_b + 6 * 1024, args.in[20] + 8192); PHASE_END
    }
    MOE_FFN(1, 7, 128, true)
#ifdef MK_SELFCHECK
    PHASE_BEGIN
    { const unsigned fl = __hip_atomic_load((unsigned*)(F.ctl + 32), RLX_AGENT);
      if (fl != 0u) { const int code = 1000 - (int)fl; const float cval = (code >= 40 && code <= 45) ? (float)(20 + 2 * (code - 40)) : (float)(1u << (code / 10 + 1)); const int gw = F.vcu * NWAVES + F.wave, NGW = F.G * NWAVES;
          for (int m = gw; m < T; m += NGW) { f32x4* w = (f32x4*)(F.out + (size_t)m * D) + F.lane;
#pragma unroll
              for (int j = 0; j < 4; ++j) w[64 * j] = (f32x4){cval, cval, cval, cval}; } } }
    PHASE_END
#endif
#undef PHASE_BEGIN
#undef PHASE_END
#undef scr
#undef hb
#undef ln_g
#undef ln_b
}

static int count_phases() {
    int n = 1;
    n += (MK_ENABLE & 1) ? (8 + 1 + 1) : 1;
    n += (MK_ENABLE & 2) ? 2 : 1;
    n += (MK_ENABLE & 4) ? 4 : 1;
    n += (MK_ENABLE & 8) ? 8 : 1;
    n += (MK_ENABLE & 16) ? 4 : 1;
    n += (MK_ENABLE & 32) ? 2 : 1;
    n += (MK_ENABLE & 64) ? 4 : 1;
    n += (MK_ENABLE & 128) ? 8 : 1;
#ifdef MK_SELFCHECK
    n += 1 + 3;
#endif
    return n;
}
extern "C" void kernel_launch(void* const* d_in, const int* in_sizes, int n_in, void* d_out, int out_size, void* d_ws, size_t ws_size, hipStream_t stream) {
    static int grid = 0;
    if (grid == 0) {
        if (n_in != 24 || in_sizes[0] != T * D || out_size != T * D || ws_size < WS_NEED) { fprintf(stderr, "kernel_launch: unexpected shapes (n_in %d, in0 %d, out %d, ws %zu < %zu); nothing launched\n", n_in, n_in > 0 ? in_sizes[0] : -1, out_size, ws_size, (size_t)WS_NEED); grid = -1; return; }
        int dev = 0, cus = 0, per_cu = 0;
        if (hipGetDevice(&dev) != hipSuccess || hipDeviceGetAttribute(&cus, hipDeviceAttributeMultiprocessorCount, dev) != hipSuccess) { grid = -1; return; }
        if (hipFuncSetAttribute((const void*)mk_fwd, hipFuncAttributeMaxDynamicSharedMemorySize, LDS_BYTES) != hipSuccess) { fprintf(stderr, "kernel_launch: hipFuncSetAttribute failed\n"); grid = -1; return; }
        if (hipOccupancyMaxActiveBlocksPerMultiprocessor(&per_cu, (const void*)mk_fwd, NWAVES * 64, LDS_BYTES) != hipSuccess || per_cu < 1) fprintf(stderr, "kernel_launch: occupancy query reports %d\n", per_cu);
        (void)hipGetLastError();
        grid = cus;
    }
    if (grid < 0) return;
    (void)hipMemsetAsync((char*)d_ws + WS_CTL, 0, CTL_ZERO_BYTES, stream);
#ifdef SELF_POISON
    (void)hipMemsetAsync((char*)d_ws + CTL_ZERO_BYTES, 0xAA, WS_NEED - CTL_ZERO_BYTES, stream);
    (void)hipMemsetAsync(d_out, 0xAA, (size_t)T * D * 4, stream);
#endif
    Args a{};
    for (int i = 0; i < 24; ++i) a.in[i] = (const float*)d_in[i];
    a.out = (float*)d_out; a.ws = (unsigned char*)d_ws;
    const int nph = count_phases();
#if MK_MULTI
    for (int p = 0; p < nph; ++p) { a.ph_lo = p; a.ph_hi = p + 1; hipLaunchKernelGGL(mk_fwd, dim3(grid), dim3(NWAVES * 64), LDS_BYTES, stream, a); }
#else
    a.ph_lo = 0; a.ph_hi = nph;
#ifdef MK_SELFCHECK
    a.chk = 1;
    hipLaunchKernelGGL(mk_fwd, dim3(grid), dim3(NWAVES * 64), LDS_BYTES, stream, a);
    (void)hipMemsetAsync((char*)d_ws + WS_CTL, 0, CTL_ZERO_BYTES, stream);
    a.chk = 2;
#endif
    hipLaunchKernelGGL(mk_fwd, dim3(grid), dim3(NWAVES * 64), LDS_BYTES, stream, a);
#endif
    const hipError_t le = hipPeekAtLastError();
    if (le != hipSuccess) fprintf(stderr, "kernel_launch: launch failed: %s\n", hipGetErrorName(le));
}
```

```cpp
#include <hip/hip_runtime.h>
#include <cstdio>
#include <cstdint>

#ifndef MK_MULTI
#define MK_MULTI 0
#endif
#ifndef MK_PROBE
#define MK_PROBE 0
#endif
#ifndef MK_ENABLE
#define MK_ENABLE 0xFF
#endif

#define GAS __attribute__((address_space(1)))
#define LAS __attribute__((address_space(3)))
typedef unsigned short bf16;
typedef short bf16x8 __attribute__((ext_vector_type(8)));
typedef float f32x4 __attribute__((ext_vector_type(4)));
typedef float f32x2 __attribute__((ext_vector_type(2)));
typedef float f32x16 __attribute__((ext_vector_type(16)));
typedef unsigned u32x4 __attribute__((ext_vector_type(4)));
typedef unsigned u32x2 __attribute__((ext_vector_type(2)));
typedef GAS unsigned gu32;
typedef int v8i_t __attribute__((ext_vector_type(8)));
typedef int v4i_t __attribute__((ext_vector_type(4)));
typedef short s16x16_t __attribute__((ext_vector_type(16)));

constexpr int D = 1024, NB = 32, SEQ = 2048, T = NB * SEQ, NH = 16, HD = 64;
constexpr int DFF = 2816, NE = 8, DFE = 3584;
constexpr float ALPHA = 1.6817928305074290f;
constexpr float LN_EPS = 1e-5f;
constexpr float LOG2E = 1.4426950408889634f;
constexpr float QSCALE = 0.125f * LOG2E;
constexpr float NEGB = -1e30f;
constexpr int TC = 16384;
constexpr int MOE_CH_TILES = 192;
constexpr int MOE_MAX_TILES = 520;
constexpr int FFN_GU8 = 1;

constexpr size_t MiB = 1u << 20;
constexpr size_t WS_CTL = 0, CTL_ZERO_BYTES = 1 * MiB;
constexpr size_t WS_BUCKET = 1 * MiB;
constexpr size_t WS_BTABA = WS_BUCKET + 8192;
constexpr size_t WS_BTABC = WS_BTABA + 32768;
constexpr size_t WS_WST = WS_BTABC + 131072;
constexpr size_t WS_KMEAN = 2 * MiB;
constexpr size_t WS_ROUTE = 4 * MiB;
constexpr size_t WS_GATES = 5 * MiB;
constexpr size_t WS_SLOTS = 6 * MiB;
constexpr size_t WS_WCNT = 7 * MiB;
constexpr size_t WS_W = 8 * MiB;
constexpr size_t W_A_QK = WS_W;
constexpr size_t W_A_V = W_A_QK + 12 * MiB;
constexpr size_t W_A_O = W_A_V + 6 * MiB;
constexpr size_t W_B_IN = W_A_O + 2 * MiB;
constexpr size_t W_B_O = W_B_IN + 6 * MiB;
constexpr size_t W_C_QK = W_B_O + 2 * MiB;
constexpr size_t W_C_V = W_C_QK + 4 * MiB;
constexpr size_t W_C_O = W_C_V + 2 * MiB;
constexpr size_t W_D_IN = W_C_O + 2 * MiB;
constexpr size_t W_D_O = W_D_IN + 4 * MiB;
constexpr size_t W_F_GU = W_D_O + 2 * MiB;
constexpr size_t W_F_D = W_F_GU + 22 * MiB;
constexpr size_t W_E_GU = W_F_D + 11 * MiB;
constexpr size_t W_E_D = W_E_GU + 224 * MiB;
constexpr size_t WS_HB = W_E_D + 112 * MiB;
constexpr size_t WS_SCR = WS_HB + 128 * MiB;
constexpr size_t WS_NEED = WS_SCR + 512 * MiB;
static_assert(WS_HB == 419 * MiB, "map");
constexpr size_t S_QK = 0;
constexpr size_t S_VT = 192 * MiB;
constexpr size_t S_HB8 = 448 * MiB;
constexpr size_t S_ATT = 288 * MiB;
constexpr size_t S_HID = 0;
constexpr size_t S_BCX = 0;
constexpr size_t S_P = 384 * MiB;
constexpr size_t S_XG = 0;
constexpr size_t S_MHID = 260 * MiB;
constexpr size_t S_Y = 256 * MiB;
constexpr size_t S_CQK = 0;
constexpr size_t S_CVT = 256 * MiB;
constexpr size_t S_CATT = 384 * MiB;
constexpr size_t S_UV = 0;
constexpr size_t O_OG = 0;
constexpr size_t O_LSE = 96 * MiB;
constexpr int CW_TMO = 0;
constexpr int CW_ECNT = 64;
constexpr int CW_BAR = 4096;
constexpr int CW_LNC = 16384;

constexpr float YSCALE8 = 16.f;
constexpr float ASCALE8 = 8.f;
constexpr float WSCALE8 = 64.f, WSCALE8D = 256.f;
__device__ __forceinline__ unsigned pk4_fp8(float a, float b, float c, float d) { int p = 0; p = __builtin_amdgcn_cvt_pk_fp8_f32(a, b, p, false); p = __builtin_amdgcn_cvt_pk_fp8_f32(c, d, p, true); return (unsigned)p; }
namespace pg8 {
constexpr int BM = 256, BK = 64, HALF = 128, HTB = HALF * BK * 2, STAGE_BYTES = 8 * HTB, NXCD = 8, WGM = 8;
__host__ __device__ __forceinline__ int lds_byte(int r, int c) { const int st = (r >> 4) * 2 + (c >> 5), rr = r & 15, cc = c & 31, ob = rr * 64 + cc * 2; return st * 1024 + (ob ^ (((ob >> 9) & 1) << 5)); }
__host__ __device__ __forceinline__ void stage_rc(int b, int& R, int& C) { const int st = b / 1024, sb = b % 1024, swz = sb ^ (((sb >> 9) & 1) << 5); R = (st >> 1) * 16 + swz / 64; C = (st & 1) * 32 + (swz % 64) / 2; }
__host__ __device__ __forceinline__ int perm32(int rho) { const int n = rho >> 4, i = rho & 15; return 8 * (i >> 2) + 4 * n + (i & 3); }

struct Unit { int pm, pn; unsigned a, b; };
struct Gemm { int K; int rsA, rsB; size_t hstepA, hstepB; };

__device__ __forceinline__ bool tile_of(long L, int nM, int nN, int& pm, int& pn) {
    const int nwg = nM * nN; if (L >= nwg) return false;
    int wgid = (int)L; { const int q = nwg / NXCD, r = nwg % NXCD, xcd = wgid % NXCD, off = wgid / NXCD; wgid = (xcd < r ? xcd * (q + 1) : r * (q + 1) + (xcd - r) * q) + off; }
    const int nig = WGM * nN, gid = wgid / nig, fm = gid * WGM, gsz = (nM - fm) < WGM ? (nM - fm) : WGM;
    pm = fm + ((wgid % nig) % gsz); pn = (wgid % nig) / gsz; return true;
}
struct LinOrder {
    int nM, nN, G, c; const char* A0; const char* B0; size_t aT, bT;
    __device__ __forceinline__ bool next(int i, Unit& u) const { if (!tile_of((long)i * G + c, nM, nN, u.pm, u.pn)) return false; u.a = (unsigned)((size_t)u.pm * aT); u.b = (unsigned)((size_t)u.pn * bT); return true; }
};

typedef __bf16 bf16x2_t __attribute__((ext_vector_type(2)));
__device__ __forceinline__ unsigned cvt_pk_bf16(float lo, float hi) { f32x2 v = {lo, hi}; bf16x2_t b = __builtin_convertvector(v, bf16x2_t); return __builtin_bit_cast(unsigned, b); }
__device__ __forceinline__ f32x2 gelu_pk(f32x2 v) {
    const f32x2 av = __builtin_elementwise_abs(v), d = av * 0.2316418882f + 1.0f;
    f32x2 t; t.x = __builtin_amdgcn_rcpf(d.x); t.y = __builtin_amdgcn_rcpf(d.y);
    f32x2 q = t * 0.5307027145f + (-0.7265760135f); q = q * t + 0.7107068705f; q = q * t + (-0.142248368f); q = q * t + 0.127414796f; q = q * t;
    const f32x2 s = (v * v) * (-0.72134752044f);
    f32x2 e; e.x = __builtin_amdgcn_exp2f(s.x); e.y = __builtin_amdgcn_exp2f(s.y);
    const f32x2 m = v * (q * e), r = v - m;
    f32x2 o; o.x = v.x < 0.f ? m.x : r.x; o.y = v.y < 0.f ? m.y : r.y; return o;
}
__device__ __forceinline__ float silu_f(float g) { return g * __builtin_amdgcn_rcpf(1.0f + __builtin_amdgcn_exp2f(-LOG2E * g)); }

template <int ACT  > struct EpiBf16 {
    static constexpr bool PERM = true;
    bf16* O; int ldc; float sc = 1.f;
    __device__ __forceinline__ void operator()(const f32x4 (&acc)[2][2][4][2], const Unit& u, int wr, int wc, int fr, int fq) const {
        const int row0 = u.pm * BM + wr * 64 + fr, col0 = u.pn * BM + wc * 32 + 8 * fq;
#pragma unroll
        for (int ai = 0; ai < 2; ++ai)
#pragma unroll
            for (int m = 0; m < 4; ++m) { bf16* rowp = O + (size_t)(row0 + ai * HALF + m * 16) * ldc + col0;
#pragma unroll
                for (int bj = 0; bj < 2; ++bj) { f32x4 v0 = acc[ai][bj][m][0] * sc, v1 = acc[ai][bj][m][1] * sc;
                    if (ACT == 1) { f32x2 a = gelu_pk((f32x2){v0[0], v0[1]}), b = gelu_pk((f32x2){v0[2], v0[3]}), c = gelu_pk((f32x2){v1[0], v1[1]}), d = gelu_pk((f32x2){v1[2], v1[3]});
                        v0 = (f32x4){a.x, a.y, b.x, b.y}; v1 = (f32x4){c.x, c.y, d.x, d.y}; }
                    u32x4 w; w.x = cvt_pk_bf16(v0[0], v0[1]); w.y = cvt_pk_bf16(v0[2], v0[3]); w.z = cvt_pk_bf16(v1[0], v1[1]); w.w = cvt_pk_bf16(v1[2], v1[3]);
                    *(u32x4*)(rowp + bj * HALF) = w; } }
    }
};
struct EpiF8 {
    static constexpr bool PERM = true;
    unsigned char* O; int ldc; float sc = 1.f;
    __device__ __forceinline__ void operator()(const f32x4 (&acc)[2][2][4][2], const Unit& u, int wr, int wc, int fr, int fq) const {
        const int row0 = u.pm * BM + wr * 64 + fr, col0 = u.pn * BM + wc * 32 + 8 * fq;
#pragma unroll
        for (int ai = 0; ai < 2; ++ai)
#pragma unroll
            for (int m = 0; m < 4; ++m) { unsigned char* rowp = O + (size_t)(row0 + ai * HALF + m * 16) * ldc + col0;
#pragma unroll
                for (int bj = 0; bj < 2; ++bj) { const f32x4 v0 = acc[ai][bj][m][0] * sc, v1 = acc[ai][bj][m][1] * sc;
                    u32x2 w; w.x = pk4_fp8(v0[0], v0[1], v0[2], v0[3]); w.y = pk4_fp8(v1[0], v1[1], v1[2], v1[3]);
                    *(u32x2*)(rowp + bj * HALF) = w; } }
    }
};
template <int ACT  > struct EpiGlu {
    static constexpr bool PERM = true;
    bf16* O; int ldc;
    __device__ __forceinline__ void operator()(const f32x4 (&acc)[2][2][4][2], const Unit& u, int wr, int wc, int fr, int fq) const {
        const int row0 = u.pm * BM + wr * 64 + fr, col0 = u.pn * HALF + wc * 32 + 8 * fq;
#pragma unroll
        for (int ai = 0; ai < 2; ++ai)
#pragma unroll
            for (int m = 0; m < 4; ++m) { bf16* rowp = O + (size_t)(row0 + ai * HALF + m * 16) * ldc + col0;
                f32x4 g0 = acc[ai][0][m][0], g1 = acc[ai][0][m][1]; const f32x4 u0 = acc[ai][1][m][0], u1 = acc[ai][1][m][1];
                if (ACT == 1) { g0 = (f32x4){silu_f(g0[0]), silu_f(g0[1]), silu_f(g0[2]), silu_f(g0[3])}; g1 = (f32x4){silu_f(g1[0]), silu_f(g1[1]), silu_f(g1[2]), silu_f(g1[3])}; }
                const f32x4 p0 = g0 * u0, p1 = g1 * u1;
                u32x4 w; w.x = cvt_pk_bf16(p0[0], p0[1]); w.y = cvt_pk_bf16(p0[2], p0[3]); w.z = cvt_pk_bf16(p1[0], p1[1]); w.w = cvt_pk_bf16(p1[2], p1[3]);
                *(u32x4*)rowp = w; }
    }
};
struct EpiSwiglu8 {
    static constexpr bool PERM = true;
    unsigned char* O; int ldc; float s = 1.f;
    __device__ __forceinline__ void operator()(const f32x4 (&acc)[2][2][4][2], const Unit& u, int wr, int wc, int fr, int fq) const {
        const int row0 = u.pm * BM + wr * 64 + fr, col0 = u.pn * HALF + wc * 32 + 8 * fq;
#pragma unroll
        for (int ai = 0; ai < 2; ++ai)
#pragma unroll
            for (int m = 0; m < 4; ++m) { unsigned char* rowp = O + (size_t)(row0 + ai * HALF + m * 16) * ldc + col0;
                const f32x4 g0 = acc[ai][0][m][0], g1 = acc[ai][0][m][1], u0 = acc[ai][1][m][0], u1 = acc[ai][1][m][1];
                const float c1 = -LOG2E * s, s2 = s * s;
                const f32x4 p0 = (g0 * u0) * s2, p1 = (g1 * u1) * s2;
                f32x4 r0, r1;
#pragma unroll
                for (int j = 0; j < 4; ++j) { r0[j] = __builtin_amdgcn_rcpf(1.0f + __builtin_amdgcn_exp2f(g0[j] * c1)); r1[j] = __builtin_amdgcn_rcpf(1.0f + __builtin_amdgcn_exp2f(g1[j] * c1)); }
                const f32x4 o0 = p0 * r0, o1 = p1 * r1;
                u32x2 w; w.x = pk4_fp8(o0[0], o0[1], o0[2], o0[3]); w.y = pk4_fp8(o1[0], o1[1], o1[2], o1[3]);
                *(u32x2*)rowp = w; }
    }
};
struct EpiResBf16 {
    static constexpr bool PERM = true;
    const bf16* base; bf16* out; int ldc; float alpha; float sc = 1.f;
    __device__ __forceinline__ void operator()(const f32x4 (&acc)[2][2][4][2], const Unit& u, int wr, int wc, int fr, int fq) const {
        const int row0 = u.pm * BM + wr * 64 + fr, col0 = u.pn * BM + wc * 32 + 8 * fq;
#pragma unroll
        for (int ai = 0; ai < 2; ++ai)
#pragma unroll
            for (int m = 0; m < 4; ++m) { const size_t off = (size_t)(row0 + ai * HALF + m * 16) * ldc + col0;
#pragma unroll
                for (int bj = 0; bj < 2; ++bj) { const u32x4 b = *(const u32x4*)(base + off + bj * HALF); const f32x4 a0 = acc[ai][bj][m][0] * sc, a1 = acc[ai][bj][m][1] * sc;
                    u32x4 w; w.x = cvt_pk_bf16(__builtin_bit_cast(float, b.x << 16) * alpha + a0[0], __builtin_bit_cast(float, b.x & 0xffff0000u) * alpha + a0[1]);
                    w.y = cvt_pk_bf16(__builtin_bit_cast(float, b.y << 16) * alpha + a0[2], __builtin_bit_cast(float, b.y & 0xffff0000u) * alpha + a0[3]);
                    w.z = cvt_pk_bf16(__builtin_bit_cast(float, b.z << 16) * alpha + a1[0], __builtin_bit_cast(float, b.z & 0xffff0000u) * alpha + a1[1]);
                    w.w = cvt_pk_bf16(__builtin_bit_cast(float, b.w << 16) * alpha + a1[2], __builtin_bit_cast(float, b.w & 0xffff0000u) * alpha + a1[3]);
                    *(u32x4*)(out + off + bj * HALF) = w; }
                asm volatile("" ::: "memory"); }
    }
};

template <bool HB8> struct EpiResLn {
    static constexpr bool PERM = true;
    bf16* h; const float* gain; const float* bias; float alpha, sc;
    float* xbuf;
    unsigned* cnt;
    unsigned* tmo;
    unsigned char* h8;
    LAS unsigned char* tb;
    __device__ __forceinline__ void operator()(f32x4 (&acc)[2][2][4][2], const Unit& u, int wr, int wc, int fr, int fq) const {
        asm volatile("" : "+v"(fr), "+v"(fq));
        const int row0 = u.pm * BM + wr * 64 + fr, col0 = u.pn * BM + wc * 32 + 8 * fq;
        LAS f32x2* P = (LAS f32x2*)tb; LAS f32x2* S = (LAS f32x2*)(tb + 8192);
#pragma unroll
        for (int ai = 0; ai < 2; ++ai)
#pragma unroll
            for (int m = 0; m < 4; ++m) { const size_t off = (size_t)(row0 + ai * HALF + m * 16) * 1024 + col0; float sm = 0.f, sq = 0.f;
#pragma unroll
                for (int bj = 0; bj < 2; ++bj) { const u32x4 b = *(const u32x4*)(h + off + bj * HALF); const f32x4 a0 = acc[ai][bj][m][0] * sc, a1 = acc[ai][bj][m][1] * sc;
                    f32x4 z0, z1;
                    z0[0] = __builtin_bit_cast(float, b.x << 16) * alpha + a0[0]; z0[1] = __builtin_bit_cast(float, b.x & 0xffff0000u) * alpha + a0[1];
                    z0[2] = __builtin_bit_cast(float, b.y << 16) * alpha + a0[2]; z0[3] = __builtin_bit_cast(float, b.y & 0xffff0000u) * alpha + a0[3];
                    z1[0] = __builtin_bit_cast(float, b.z << 16) * alpha + a1[0]; z1[1] = __builtin_bit_cast(float, b.z & 0xffff0000u) * alpha + a1[1];
                    z1[2] = __builtin_bit_cast(float, b.w << 16) * alpha + a1[2]; z1[3] = __builtin_bit_cast(float, b.w & 0xffff0000u) * alpha + a1[3];
                    acc[ai][bj][m][0] = z0; acc[ai][bj][m][1] = z1;
                    sm += ((z0[0] + z0[1]) + (z0[2] + z0[3])) + ((z1[0] + z1[1]) + (z1[2] + z1[3]));
                    sq += ((z0[0] * z0[0] + z0[1] * z0[1]) + (z0[2] * z0[2] + z0[3] * z0[3])) + ((z1[0] * z1[0] + z1[1] * z1[1]) + (z1[2] * z1[2] + z1[3] * z1[3])); }
                sm += __shfl_xor(sm, 16); sm += __shfl_xor(sm, 32); sq += __shfl_xor(sq, 16); sq += __shfl_xor(sq, 32);
                if (fq == 0) P[(ai * HALF + wr * 64 + m * 16 + fr) * 4 + wc] = (f32x2){sm, sq};
                asm volatile("" ::: "memory"); }
        asm volatile("s_waitcnt lgkmcnt(0)" ::: "memory"); __builtin_amdgcn_s_barrier(); asm volatile("" ::: "memory");
        const int wid = wr * 4 + wc, lane = fq * 16 + fr, row = wid * 32 + (lane & 31);
        unsigned long long* slots = (unsigned long long*)xbuf + (size_t)(u.pm * BM + row) * 4;
        if (lane < 32) { const f32x2 a = P[row * 4 + 0], b = P[row * 4 + 1], c = P[row * 4 + 2], d = P[row * 4 + 3];
            const float ts = (a.x + b.x) + (c.x + d.x), tq = (a.y + b.y) + (c.y + d.y);
            __hip_atomic_store(slots + u.pn, ((unsigned long long)__builtin_bit_cast(unsigned, tq) << 32) | (unsigned long long)__builtin_bit_cast(unsigned, ts), __ATOMIC_RELAXED, __HIP_MEMORY_SCOPE_AGENT); }
        asm volatile("s_waitcnt vmcnt(0)" ::: "memory");
        if (lane == 0) (void)__hip_atomic_fetch_add(cnt + 16 * u.pm, 1u, __ATOMIC_RELAXED, __HIP_MEMORY_SCOPE_AGENT);
        if (wid == 0) { unsigned sp = 0u;
            while ((unsigned)__builtin_amdgcn_readfirstlane(__hip_atomic_load(cnt + 16 * u.pm, __ATOMIC_RELAXED, __HIP_MEMORY_SCOPE_AGENT)) < 32u) { __builtin_amdgcn_s_sleep(1);
                if ((++sp & 255u) == 0u) { if (__hip_atomic_load(tmo, __ATOMIC_RELAXED, __HIP_MEMORY_SCOPE_AGENT)) break; if (sp > (1u << 22)) { if (lane == 0) (void)__hip_atomic_fetch_add(tmo, 1u, __ATOMIC_RELAXED, __HIP_MEMORY_SCOPE_AGENT); break; } } }
            __builtin_amdgcn_fence(__ATOMIC_ACQUIRE, "agent"); }
        asm volatile("s_waitcnt vmcnt(0) lgkmcnt(0)" ::: "memory"); __builtin_amdgcn_s_barrier(); asm volatile("" ::: "memory");
        if (lane < 32) { float ts = 0.f, tq = 0.f;
#pragma unroll
            for (int t = 0; t < 4; ++t) { const unsigned long long w = __hip_atomic_load(slots + t, __ATOMIC_RELAXED, __HIP_MEMORY_SCOPE_AGENT); ts += __builtin_bit_cast(float, (unsigned)w); tq += __builtin_bit_cast(float, (unsigned)(w >> 32)); }
            const float mean = ts * (1.f / 1024.f), var = fmaxf(tq * (1.f / 1024.f) - mean * mean, 0.f);
            S[row] = (f32x2){mean, 1.f / sqrtf(var + LN_EPS)}; }
        asm volatile("s_waitcnt vmcnt(0) lgkmcnt(0)" ::: "memory"); __builtin_amdgcn_s_barrier(); asm volatile("" ::: "memory");
#pragma unroll
        for (int bj = 0; bj < 2; ++bj) { const f32x4 g0 = *(const f32x4*)(gain + col0 + bj * HALF), g1 = *(const f32x4*)(gain + col0 + bj * HALF + 4), b0 = *(const f32x4*)(bias + col0 + bj * HALF), b1 = *(const f32x4*)(bias + col0 + bj * HALF + 4);
#pragma unroll
            for (int ai = 0; ai < 2; ++ai)
#pragma unroll
                for (int m = 0; m < 4; ++m) { const int r = ai * HALF + wr * 64 + m * 16 + fr; const f32x2 sr = S[r]; const size_t off = (size_t)(u.pm * BM + r) * 1024 + col0 + bj * HALF;
                    const f32x4 y0 = (acc[ai][bj][m][0] - sr.x) * sr.y * g0 + b0, y1 = (acc[ai][bj][m][1] - sr.x) * sr.y * g1 + b1;
                    u32x4 w; w.x = cvt_pk_bf16(y0[0], y0[1]); w.y = cvt_pk_bf16(y0[2], y0[3]); w.z = cvt_pk_bf16(y1[0], y1[1]); w.w = cvt_pk_bf16(y1[2], y1[3]);
                    *(u32x4*)(h + off) = w;
                    if (HB8) { u32x2 w8; w8.x = pk4_fp8(y0[0], y0[1], y0[2], y0[3]); w8.y = pk4_fp8(y1[0], y1[1], y1[2], y1[3]); *(u32x2*)(h8 + off) = w8; }
                    asm volatile("" ::: "memory"); } }
    }
};

template <class Epi, class Sched, bool ALIGN_EPI = true, int FP8 = 0>
__device__ __forceinline__ void gemm_phase(LAS unsigned char* lds, const int wave_s, const Gemm g, const Sched& S, const Epi& E) {
    int tid = wave_s * 64 + (int)__builtin_amdgcn_mbcnt_hi(~0u, __builtin_amdgcn_mbcnt_lo(~0u, 0u)); asm volatile("" : "+v"(tid));
    const int wid = __builtin_amdgcn_readfirstlane(tid >> 6), lane = tid & 63, wr = wid >> 2, wc = wid & 3, fr = lane & 15, fq = lane >> 4;
    const int K = g.K, nt = K / BK;
    unsigned voffA[2], voffB[2];
#pragma unroll
    for (int i = 0; i < 2; ++i) { int R, C; stage_rc(tid * 16 + i * 8192, R, C); const int Rb = Epi::PERM ? ((R & ~31) + perm32(R & 31)) : R;
        voffA[i] = (unsigned)(R * g.rsA * K + C) * 2u; voffB[i] = (unsigned)(Rb * g.rsB * K + C) * 2u; }
    const unsigned kstep = (unsigned)(BK * 2);
    const unsigned hstepA = (unsigned)g.hstepA, hstepB = (unsigned)g.hstepB;
    const __amdgpu_buffer_rsrc_t rsrcA = __builtin_amdgcn_make_buffer_rsrc((void*)S.A0, 0, 0x7fffffff, 0x00020000), rsrcB = __builtin_amdgcn_make_buffer_rsrc((void*)S.B0, 0, 0x7fffffff, 0x00020000);
    const unsigned ldsw = (unsigned)wid * 1024u;
    const int aoff = lds_byte(wr * 64 + fr, fq * 8), boff = lds_byte(wc * 32 + fr, fq * 8);
    const int aoff8 = lds_byte(wr * 64 + fr, fq * 16), boff8 = lds_byte(wc * 32 + fr, fq * 16);
    unsigned bbase8_ = (unsigned)(4 * HTB + boff); asm volatile("" : "+v"(bbase8_));
    LAS unsigned char* const ldsB8 = lds + bbase8_;
#define PG8_SA(b, h) (((b) * 2 + (h)) * HTB)
#define PG8_SB(b, h) ((4 + (b) * 2 + (h)) * HTB)
#define PG8_STAGE(bufoff, gbase, voff) do { _Pragma("unroll") for (int _i = 0; _i < 2; ++_i) \
        __builtin_amdgcn_raw_ptr_buffer_load_lds(PG8_RS_##voff, (LAS unsigned*)(lds + (bufoff) + ldsw + _i * 8192), 16, (int)(voff)[_i], (int)(gbase), 0, 0); } while (0)
#define PG8_RS_voffA rsrcA
#define PG8_RS_voffB rsrcB
#define PG8_LD16(off) (*(const LAS bf16x8*)(lds + (off)))
#define PG8_CAT8(lo, hi) __builtin_shufflevector(__builtin_bit_cast(v4i_t, lo), __builtin_bit_cast(v4i_t, hi), 0, 1, 2, 3, 4, 5, 6, 7)
#define PG8_LDA(dst, b, h) do { if constexpr (FP8) { _Pragma("unroll") for (int m = 0; m < 4; ++m) dst##8[m] = PG8_CAT8(PG8_LD16(PG8_SA(b, h) + aoff + m * 2048), PG8_LD16(PG8_SA(b, h) + aoff + m * 2048 + 1024)); } \
        else { _Pragma("unroll") for (int m = 0; m < 4; ++m) _Pragma("unroll") for (int k = 0; k < 2; ++k) dst[m][k] = PG8_LD16(PG8_SA(b, h) + aoff + m * 2048 + k * 1024); } } while (0)
#define PG8_LDB(dst, b, h) do { if constexpr (FP8) { _Pragma("unroll") for (int n = 0; n < 2; ++n) dst##8[n] = PG8_CAT8(*(const LAS bf16x8*)(ldsB8 + ((b) * 2 + (h)) * HTB + n * 2048), *(const LAS bf16x8*)(ldsB8 + ((b) * 2 + (h)) * HTB + n * 2048 + 1024)); } \
        else { _Pragma("unroll") for (int n = 0; n < 2; ++n) _Pragma("unroll") for (int k = 0; k < 2; ++k) dst[n][k] = PG8_LD16(PG8_SB(b, h) + boff + n * 2048 + k * 1024); } } while (0)
#define PG8_MMA(ai, bj, At, Bt) do { __builtin_amdgcn_s_setprio(1); \
        if constexpr (FP8) { _Pragma("unroll") for (int m = 0; m < 4; ++m) _Pragma("unroll") for (int n = 0; n < 2; ++n) \
            acc[ai][bj][m][n] = __builtin_amdgcn_mfma_scale_f32_16x16x128_f8f6f4(Bt##8[n], At##8[m], acc[ai][bj][m][n], 0, 0, 0, 0, 0, 0); } \
        else { _Pragma("unroll") for (int m = 0; m < 4; ++m) _Pragma("unroll") for (int n = 0; n < 2; ++n) _Pragma("unroll") for (int k = 0; k < 2; ++k) \
            acc[ai][bj][m][n] = __builtin_amdgcn_mfma_f32_16x16x32_bf16(Bt[n][k], At[m][k], acc[ai][bj][m][n], 0, 0, 0); } \
        __builtin_amdgcn_s_setprio(0); } while (0)
#define PG8_WAIT_V(n) asm volatile("s_waitcnt vmcnt(" #n ")" ::: "memory")
#define PG8_WAIT_L(n) asm volatile("s_waitcnt lgkmcnt(" #n ")" ::: "memory")
#define PG8_BAR __builtin_amdgcn_s_barrier()
#define PG8_SCHED __builtin_amdgcn_sched_barrier(0)
    Unit cur, nxt; int ui = 0;
    if (!S.next(0, cur)) return;
    f32x4 acc[2][2][4][2];
#pragma unroll
    for (int a = 0; a < 2; ++a)
#pragma unroll
        for (int b = 0; b < 2; ++b)
#pragma unroll
            for (int m = 0; m < 4; ++m)
#pragma unroll
                for (int n = 0; n < 2; ++n) acc[a][b][m][n] = (f32x4){0.f, 0.f, 0.f, 0.f};
    bf16x8 At[4][2], B0[2][2], B1[2][2]; v8i_t At8[4], B08[2], B18[2];
    unsigned cA = cur.a, cB = cur.b;
    PG8_STAGE(PG8_SB(0, 0), cB, voffB); PG8_STAGE(PG8_SB(0, 1), cB + hstepB, voffB); PG8_STAGE(PG8_SA(0, 0), cA, voffA); PG8_STAGE(PG8_SA(0, 1), cA + hstepA, voffA);
    if (wr == 1) PG8_BAR;
    PG8_WAIT_V(2); PG8_BAR;
    PG8_STAGE(PG8_SB(1, 0), cB + kstep, voffB); PG8_STAGE(PG8_SA(1, 0), cA + kstep, voffA); PG8_STAGE(PG8_SB(1, 1), cB + hstepB + kstep, voffB);
    PG8_WAIT_V(6); PG8_BAR;
    for (;;) {
        const bool has_next = S.next(ui + 1, nxt);
        const unsigned nA = has_next ? nxt.a : cA, nB = has_next ? nxt.b : cB;
#pragma clang loop unroll(disable)
        for (int t = 0; t < nt; t += 2) {
            const bool last = (t == nt - 2);
            const unsigned a1 = cA + (unsigned)(t + 1) * kstep;
            const unsigned a2 = last ? nA : cA + (unsigned)(t + 2) * kstep, b2 = last ? nB : cB + (unsigned)(t + 2) * kstep;
            const unsigned a3 = a2 + kstep, b3 = b2 + kstep;
            PG8_LDB(B0, 0, 0); PG8_LDB(B1, 0, 1); PG8_SCHED; PG8_LDA(At, 0, 0); PG8_STAGE(PG8_SA(1, 1), a1 + hstepA, voffA);
            PG8_WAIT_V(8); PG8_WAIT_L(0); PG8_BAR; PG8_MMA(0, 0, At, B0); PG8_MMA(0, 1, At, B1); PG8_BAR; PG8_SCHED;
            PG8_LDA(At, 0, 1); PG8_STAGE(PG8_SB(0, 0), b2, voffB); PG8_STAGE(PG8_SB(0, 1), b2 + hstepB, voffB); PG8_STAGE(PG8_SA(0, 0), a2, voffA);
            PG8_WAIT_V(8); PG8_WAIT_L(0); PG8_BAR; PG8_MMA(1, 0, At, B0); PG8_MMA(1, 1, At, B1); PG8_BAR; PG8_SCHED;
            PG8_LDB(B0, 1, 0); PG8_LDB(B1, 1, 1); PG8_SCHED; PG8_LDA(At, 1, 0); PG8_STAGE(PG8_SA(0, 1), a2 + hstepA, voffA);
            PG8_WAIT_V(8); PG8_WAIT_L(0); PG8_BAR; PG8_MMA(0, 0, At, B0); PG8_MMA(0, 1, At, B1); PG8_BAR; PG8_SCHED;
            PG8_LDA(At, 1, 1); PG8_STAGE(PG8_SB(1, 0), b3, voffB); PG8_STAGE(PG8_SB(1, 1), b3 + hstepB, voffB); PG8_STAGE(PG8_SA(1, 0), a3, voffA);
            PG8_WAIT_V(8); PG8_WAIT_L(0); PG8_BAR; PG8_MMA(1, 0, At, B0); PG8_MMA(1, 1, At, B1); PG8_BAR; PG8_SCHED;
        }
        if constexpr (ALIGN_EPI) { if (wr == 0) PG8_BAR; }
        E(acc, cur, wr, wc, fr, fq);
        if (!has_next) break;
#pragma unroll
        for (int a = 0; a < 2; ++a)
#pragma unroll
            for (int b = 0; b < 2; ++b)
#pragma unroll
                for (int m = 0; m < 4; ++m)
#pragma unroll
                    for (int n = 0; n < 2; ++n) acc[a][b][m][n] = (f32x4){0.f, 0.f, 0.f, 0.f};
        cur = nxt; cA = nA; cB = nB; ++ui;
        if constexpr (ALIGN_EPI) { if (wr == 1) PG8_BAR; }
    }
    PG8_WAIT_V(0);
    if constexpr (!ALIGN_EPI) { if (wr == 0) PG8_BAR; }
    PG8_BAR;
#undef PG8_SA
#undef PG8_SB
#undef PG8_STAGE
#undef PG8_RS_voffA
#undef PG8_RS_voffB
#undef PG8_LDA
#undef PG8_LD16
#undef PG8_CAT8
#undef PG8_LDB
#undef PG8_MMA
#undef PG8_WAIT_V
#undef PG8_WAIT_L
#undef PG8_BAR
#undef PG8_SCHED
}
}

#define RLX_AGENT __ATOMIC_RELAXED, __HIP_MEMORY_SCOPE_AGENT
#define LDS_WAIT() asm volatile("s_waitcnt lgkmcnt(0)" ::: "memory")
#define VM_WAIT() asm volatile("s_waitcnt vmcnt(0)" ::: "memory")
__device__ __forceinline__ unsigned f2bf(float f) { unsigned u = __builtin_bit_cast(unsigned, f); return (u + 0x7fffu + ((u >> 16) & 1u)) >> 16; }
__device__ __forceinline__ unsigned pk2(float lo, float hi) { return pg8::cvt_pk_bf16(lo, hi); }
__device__ __forceinline__ float bflo(unsigned w) { return __builtin_bit_cast(float, w << 16); }
__device__ __forceinline__ float bfhi(unsigned w) { return __builtin_bit_cast(float, w & 0xffff0000u); }
__device__ __forceinline__ float wave_sum(float v) {
#pragma unroll
    for (int o = 1; o < 64; o <<= 1) v += __shfl_xor(v, o);
    return v;
}

#define XB_TMO      128
#define XB_XCNT(j)  (256  + 64 * (j))
#define XB_XSUB(j)  (1280 + 64 * (j))
#define XB_XGEN(j)  (2304 + 64 * (j))
#define XB_TOP      3328
#define XB_TOPGEN   3392
#define XCD_BAR_WORDS 3456
#define XB_SPIN_CAP (1u << 22)
__device__ __forceinline__ unsigned xb_ld(unsigned* p)              { return __hip_atomic_load(p, __ATOMIC_RELAXED, __HIP_MEMORY_SCOPE_AGENT); }
__device__ __forceinline__ unsigned xb_add(unsigned* p, unsigned v) { return __hip_atomic_fetch_add(p, v, __ATOMIC_RELAXED, __HIP_MEMORY_SCOPE_AGENT); }
__device__ __forceinline__ unsigned xb_xcc_id() { return (unsigned)__builtin_amdgcn_s_getreg((3 << 11) | 20) & 0xFu; }
#define XB_SPIN(cond, bar) do { unsigned _sp = 0; while (cond) { __builtin_amdgcn_s_sleep(1); \
    if ((++_sp & 255u) == 0u) { if (xb_ld(&(bar)[XB_TMO])) break; if (_sp > XB_SPIN_CAP) { atomicAdd(&(bar)[XB_TMO], 1u); break; } } } } while (0)
struct XcdBarrier { unsigned* bar; unsigned x; volatile LAS unsigned* st; };
__device__ __forceinline__ XcdBarrier xcd_barrier_post(unsigned* bar, volatile LAS unsigned* st) {
    XcdBarrier b; b.bar = bar; b.x = xb_xcc_id(); b.st = st;
    if (threadIdx.x == 0) (void)xb_add(&bar[XB_XCNT(b.x)], 1u);
    return b;
}
__device__ __forceinline__ void xcd_barrier_complete(unsigned* bar, unsigned x, unsigned& nloc, unsigned& nx) {
    const unsigned G = gridDim.x * gridDim.y * gridDim.z;
    unsigned sum, cnt, mine, sp = 0u;
    for (;;) {
        sum = 0u; cnt = 0u; mine = 0u;
#pragma unroll
        for (unsigned j = 0; j < 16; ++j) { const unsigned c = xb_ld(&bar[XB_XCNT(j)]); sum += c; cnt += (c > 0u) ? 1u : 0u; mine = (j == x) ? c : mine; }
        if (sum == G) break;
        __builtin_amdgcn_s_sleep(1);
        if ((++sp & 255u) == 0u) { if (xb_ld(&bar[XB_TMO])) break; if (sp > XB_SPIN_CAP) { atomicAdd(&bar[XB_TMO], 1u); break; } }
    }
    nloc = mine > 0u ? mine : 1u; nx = cnt > 0u ? cnt : 1u;
}
__device__ __forceinline__ void xcd_barrier(const XcdBarrier& b, const int tid) {
    asm volatile("s_waitcnt vmcnt(0)" ::: "memory");
    __syncthreads();
    if (tid == 0) {
        unsigned* bar = b.bar;
        __builtin_amdgcn_s_waitcnt(0);
        unsigned nloc = b.st[0], nx = b.st[1];
        if (nloc == 0u) { xcd_barrier_complete(bar, b.x, nloc, nx); b.st[0] = nloc; b.st[1] = nx; }
        const unsigned old = xb_add(&bar[XB_XSUB(b.x)], 1u);
        const unsigned gen = old / nloc;
        if (old + 1u == (gen + 1u) * nloc) {
            __builtin_amdgcn_fence(__ATOMIC_RELEASE, "agent");
            asm volatile("s_waitcnt vmcnt(0)" ::: "memory");
            const unsigned og = xb_add(&bar[XB_TOP], 1u);
            const unsigned tg = og / nx;
            if (og + 1u == (tg + 1u) * nx) xb_add(&bar[XB_TOPGEN], 1u);
            else XB_SPIN(xb_ld(&bar[XB_TOPGEN]) == tg, bar);
            __builtin_amdgcn_fence(__ATOMIC_ACQUIRE, "agent");
            xb_add(&bar[XB_XGEN(b.x)], 1u);
            asm volatile("s_waitcnt vmcnt(0)" ::: "memory");
        } else {
            XB_SPIN(xb_ld(&bar[XB_XGEN(b.x)]) == gen, bar);
            __builtin_amdgcn_fence(__ATOMIC_ACQUIRE, "agent");
            asm volatile("s_waitcnt vmcnt(0)" ::: "memory");
        }
    }
    __syncthreads();
}

constexpr int NWAVES = 8;
constexpr int RING_BYTES = 131072, MISC_OFF = RING_BYTES + 320, LNT_OFF = RING_BYTES + 2048  , LDS_BYTES = 147456;
struct Args { const float* in[24]; float* out; unsigned char* ws; int ph_lo, ph_hi; int chk, pad; };
struct Frame {
    LAS unsigned char* lds;
    gu32* ctl; unsigned char* ws; float* out;
    int tid, lane, wave, vcu, G;
    int chk, stage;
};

struct Job { const float* src; bf16* dst; int ld, K, N, mode, start; float scale; int fp8, pad; };
constexpr int NJOBS = 74;
__device__ __forceinline__ void make_job(const Args& a, int j, Job& J) {
    unsigned char* ws = a.ws; J.scale = 1.f; J.mode = 0; J.start = 0; J.fp8 = 0; J.pad = 0;
    if (j < 9) { const int g = j / 3, t = j % 3; J.src = a.in[4] + g * 3072 + t * 1024; J.ld = 9216; J.K = 1024; J.N = 1024;
        if (t == 2) J.dst = (bf16*)(ws + W_A_V + (size_t)g * 1024 * 1024); else J.dst = (bf16*)(ws + W_A_QK + (size_t)g * 2048 * 1024 + (size_t)t * 1024 * 1024);
        J.fp8 = 1; J.scale = (t == 0 ? QSCALE : 1.f) * WSCALE8; return; }
    j -= 9;
    if (j == 0) { J.src = a.in[5]; J.ld = 1024; J.K = 1024; J.N = 1024; J.dst = (bf16*)(ws + W_A_O); J.fp8 = 1; J.scale = WSCALE8; return; }
    if (j == 1) { J.src = a.in[6]; J.ld = 3072; J.K = 1024; J.N = 1024; J.dst = (bf16*)(ws + W_B_IN); return; }
    if (j == 9 || j == 10) { J.src = a.in[6] + 1024 * (j - 8); J.ld = 3072; J.K = 1024; J.N = 1024; J.dst = (bf16*)(ws + W_B_IN) + (size_t)1024 * 1024; J.mode = j - 8; return; }
    if (j == 2) { J.src = a.in[8]; J.ld = 1024; J.K = 1024; J.N = 1024; J.dst = (bf16*)(ws + W_B_O); return; }
    if (j == 3) { J.src = a.in[9]; J.ld = 3072; J.K = 1024; J.N = 1024; J.dst = (bf16*)(ws + W_C_QK); J.scale = QSCALE; return; }
    if (j == 4) { J.src = a.in[9] + 1024; J.ld = 3072; J.K = 1024; J.N = 1024; J.dst = (bf16*)(ws + W_C_QK) + (size_t)1024 * 1024; return; }
    if (j == 5) { J.src = a.in[9] + 2048; J.ld = 3072; J.K = 1024; J.N = 1024; J.dst = (bf16*)(ws + W_C_V); J.fp8 = 1; J.scale = WSCALE8; return; }
    if (j == 6) { J.src = a.in[10]; J.ld = 1024; J.K = 1024; J.N = 1024; J.dst = (bf16*)(ws + W_C_O); J.fp8 = 1; J.scale = WSCALE8; return; }
    if (j == 7) { J.src = a.in[11]; J.ld = 2048; J.K = 1024; J.N = 2048; J.dst = (bf16*)(ws + W_D_IN); return; }
    if (j == 8) { J.src = a.in[16]; J.ld = 1024; J.K = 1024; J.N = 1024; J.dst = (bf16*)(ws + W_D_O); return; }
    j -= 11;
    if (j < 6) { const int f = j / 3, t = j % 3;
        if (t < 2) { J.src = a.in[17 + t] + (size_t)f * 1024 * DFF; J.ld = DFF; J.K = 1024; J.N = DFF; J.dst = (bf16*)(ws + W_F_GU) + (size_t)f * 2 * DFF * 1024; J.mode = 1 + t;
            if (f == FFN_GU8) { J.fp8 = 1; J.scale = WSCALE8; } }
        else { J.src = a.in[19] + (size_t)f * DFF * 1024; J.ld = 1024; J.K = DFF; J.N = 1024; J.dst = (bf16*)(ws + W_F_D) + (size_t)f * 1024 * DFF; J.fp8 = 1; J.scale = WSCALE8D; }
        return; }
    j -= 6;
    { const int fe = j / 3, t = j % 3;
        if (t < 2) { J.src = a.in[21 + t] + (size_t)fe * 1024 * DFE; J.ld = DFE; J.K = 1024; J.N = DFE; J.dst = (bf16*)(ws + W_E_GU) + (size_t)fe * 2 * DFE * 1024; J.mode = 1 + t; J.fp8 = 1; J.scale = WSCALE8; }
        else { J.src = a.in[23] + (size_t)fe * DFE * 1024; J.ld = 1024; J.K = DFE; J.N = 1024; J.dst = (bf16*)(ws + W_E_D) + (size_t)fe * 1024 * DFE; J.fp8 = 1; J.scale = WSCALE8D; } }
}
__device__ __forceinline__ void transpose_item(const Job& J, int item, int lane) {
    const int nblk = J.N >> 6, kb = item / nblk, nb = item - kb * nblk, k0 = 64 * kb, n = 64 * nb + lane;
    const float* W = J.src + (size_t)k0 * J.ld + n;
    int r = n; if (J.mode) r = (n >> 7) * 256 + (n & 127) + (J.mode == 2 ? 128 : 0);
    const float sc = J.scale; const size_t ld = (size_t)J.ld;
    if (J.fp8) {
        unsigned char* dst8 = (unsigned char*)J.dst + (size_t)r * J.K + k0;
#pragma unroll
        for (int hf = 0; hf < 2; ++hf) {
            float v[32];
#pragma unroll
            for (int j = 0; j < 32; ++j) v[j] = W[(size_t)(32 * hf + j) * ld];
#pragma unroll
            for (int c = 0; c < 2; ++c) { u32x4 o; o.x = pk4_fp8(v[16 * c] * sc, v[16 * c + 1] * sc, v[16 * c + 2] * sc, v[16 * c + 3] * sc); o.y = pk4_fp8(v[16 * c + 4] * sc, v[16 * c + 5] * sc, v[16 * c + 6] * sc, v[16 * c + 7] * sc);
                o.z = pk4_fp8(v[16 * c + 8] * sc, v[16 * c + 9] * sc, v[16 * c + 10] * sc, v[16 * c + 11] * sc); o.w = pk4_fp8(v[16 * c + 12] * sc, v[16 * c + 13] * sc, v[16 * c + 14] * sc, v[16 * c + 15] * sc);
                *(u32x4*)(dst8 + 32 * hf + 16 * c) = o; }
        }
        return;
    }
    bf16* dst = J.dst + (size_t)r * J.K + k0;
#pragma unroll
    for (int hf = 0; hf < 2; ++hf) {
        float v[32];
#pragma unroll
        for (int j = 0; j < 32; ++j) v[j] = W[(size_t)(32 * hf + j) * ld];
#pragma unroll
        for (int c = 0; c < 4; ++c) { u32x4 o; o.x = pk2(v[8 * c] * sc, v[8 * c + 1] * sc); o.y = pk2(v[8 * c + 2] * sc, v[8 * c + 3] * sc); o.z = pk2(v[8 * c + 4] * sc, v[8 * c + 5] * sc); o.w = pk2(v[8 * c + 6] * sc, v[8 * c + 7] * sc);
            *(u32x4*)(dst + 32 * hf + 8 * c) = o; }
    }
}
__device__ __forceinline__ int t5_bucket(int d) {
    if (d < 16) return d;
    int b = 16 + (int)(log((double)d / 16.0) / log(128.0) * 16.0);
    return b < 16 ? 16 : (b > 31 ? 31 : b);
}
__device__ __forceinline__ void p_prologue(Frame& F, const Args& a) {
    unsigned char* gl_ = (unsigned char*)F.lds;
    Job* jobs = (Job*)(gl_ + 7 * 16384 + 8704);
    int* tot = (int*)(gl_ + 7 * 16384 + 8704 + NJOBS * sizeof(Job));
    static_assert(8704 + NJOBS * sizeof(Job) + 16 <= 16384, "job table fits");
    if (F.tid < NJOBS) { Job J; make_job(a, F.tid, J); jobs[F.tid] = J; }
    __syncthreads();
    if (F.tid == 0) { int s = 0; for (int j = 0; j < NJOBS; ++j) { jobs[j].start = s; s += (jobs[j].K / 64) * (jobs[j].N / 64); } tot[0] = s; }
    __syncthreads();
    const int total = tot[0];
    const int gw = F.vcu * NWAVES + F.wave, NGW = F.G * NWAVES;
    int jc = 0;
    for (int it = gw; it < total; it += NGW) {
        while (jc + 1 < NJOBS && jobs[jc + 1].start <= it) ++jc;
        const Job J = jobs[jc];
        transpose_item(J, it - J.start, F.lane);
    }
    { bf16* hb = (bf16*)(F.ws + WS_HB); const float* x = a.in[0]; unsigned char* hb8 = F.ws + WS_SCR + S_HB8;
      for (int m0 = 4 * gw; m0 < T; m0 += 4 * NGW) { f32x4 v[4][4];
#pragma unroll
          for (int k = 0; k < 4; ++k) { const f32x4* xr = (const f32x4*)(x + (size_t)(m0 + k) * D) + F.lane;
#pragma unroll
              for (int j = 0; j < 4; ++j) v[k][j] = xr[64 * j]; }
#pragma unroll
          for (int k = 0; k < 4; ++k) { unsigned long long* o8 = (unsigned long long*)(hb + (size_t)(m0 + k) * D) + F.lane;
#pragma unroll
              for (int j = 0; j < 4; ++j) o8[64 * j] = (unsigned long long)pk2(v[k][j].x, v[k][j].y) | ((unsigned long long)pk2(v[k][j].z, v[k][j].w) << 32);
              unsigned* o4 = (unsigned*)(hb8 + (size_t)(m0 + k) * D) + F.lane;
#pragma unroll
              for (int j = 0; j < 4; ++j) o4[64 * j] = pk4_fp8(v[k][j].x, v[k][j].y, v[k][j].z, v[k][j].w); } } }
    const int gt = blockIdx.x * 512 + F.tid, NGT = F.G * 512;
    const float* rel = a.in[1];
    float* btA = (float*)(F.ws + WS_BTABA); float* btC = (float*)(F.ws + WS_BTABC);
    for (int i = gt; i < 48 * 132; i += NGT) { const int gh = i / 132, dl = i % 132, g = gh >> 4, hh = gh & 15; const int dil = g == 0 ? 1 : (g == 1 ? 4 : 16);
        btA[i] = dl <= 128 ? rel[t5_bucket(dl * dil) * NH + hh] * LOG2E : 0.f; }
    for (int i = gt; i < 16 * 2048; i += NGT) { const int hh = i >> 11, dd = i & 2047; btC[i] = rel[t5_bucket(dd) * NH + hh] * LOG2E; }
    { bf16* wst = (bf16*)(F.ws + WS_WST); const float* wsrc = a.in[14];
      for (int i = gt; i < 8 * 128 * 128; i += NGT) { const int tt = (i >> 7) & 127, ss = i & 127; wst[i] = (bf16)f2bf(ss <= tt ? wsrc[i] : 0.f); } }
}

__device__ __forceinline__ void unpack8(const u32x4 a, float* x) { x[0] = bflo(a.x); x[1] = bfhi(a.x); x[2] = bflo(a.y); x[3] = bfhi(a.y); x[4] = bflo(a.z); x[5] = bfhi(a.z); x[6] = bflo(a.w); x[7] = bfhi(a.w); }
template <int MODE, bool ROUTE, bool FINAL, bool HB8 = false>
__device__ __forceinline__ void ln_phase(Frame& F, const float* gain, const float* bias, const float* wr) {
    constexpr int NBT = 2;
    const int gw = F.vcu * NWAVES + F.wave, NGW = F.G * NWAVES, lane = F.lane;
    bf16* hb = (bf16*)(F.ws + WS_HB); const bf16* zb = (const bf16*)F.out;
    float gv[16], bv[16];
#pragma unroll
    for (int k = 0; k < 2; ++k)
#pragma unroll
        for (int j = 0; j < 2; ++j) { const f32x4 g4 = *(const f32x4*)(gain + 512 * k + 8 * lane + 4 * j), b4 = *(const f32x4*)(bias + 512 * k + 8 * lane + 4 * j);
            gv[8 * k + 4 * j] = g4.x; gv[8 * k + 4 * j + 1] = g4.y; gv[8 * k + 4 * j + 2] = g4.z; gv[8 * k + 4 * j + 3] = g4.w;
            bv[8 * k + 4 * j] = b4.x; bv[8 * k + 4 * j + 1] = b4.y; bv[8 * k + 4 * j + 2] = b4.z; bv[8 * k + 4 * j + 3] = b4.w; }
    LAS float* wrT = (LAS float*)F.lds;
    if (ROUTE) { for (int i = F.tid; i < 8 * 1024; i += 512) { const int e = i >> 10, c = i & 1023; wrT[i] = wr[c * 8 + e]; } __syncthreads(); }
    const unsigned char* ys = F.ws + WS_SCR + S_XG;
    const int* slots = (const int*)(F.ws + WS_SLOTS); const float* gates = (const float*)(F.ws + WS_GATES);
    int* route = (int*)(F.ws + WS_ROUTE); float* gout = (float*)(F.ws + WS_GATES);
    for (int grp = gw; grp < T / 32; grp += NGW) {
        int cnt_e = 0;
        int my_e1 = 0, my_e2 = 0, my_r1 = 0, my_r2 = 0; float my_g1 = 0.f, my_g2 = 0.f;
        int sl0 = 0, sl1 = 0; float gg0 = 0.f, gg1 = 0.f;
        if (MODE == 2) { const int mm = grp * 32 + (lane & 31); sl0 = slots[2 * mm]; sl1 = slots[2 * mm + 1]; gg0 = gates[2 * mm]; gg1 = gates[2 * mm + 1]; }
        for (int i0 = 0; i0 < 32; i0 += NBT) {
            float v[NBT][16]; float st[NBT][2];
#pragma unroll
            for (int k = 0; k < NBT; ++k) { const int m = grp * 32 + i0 + k;
                if (MODE == 0) { const u32x4* zr = (const u32x4*)(zb + (size_t)m * D) + lane; unpack8(zr[0], v[k]); unpack8(zr[64], v[k] + 8); }
                else { const u32x4* hr = (const u32x4*)(hb + (size_t)m * D) + lane; unpack8(hr[0], v[k]); unpack8(hr[64], v[k] + 8);
#pragma unroll
                    for (int j = 0; j < 16; ++j) v[k][j] *= ALPHA;
                    if (MODE == 3) { const u32x4* yr = (const u32x4*)((const bf16*)(F.ws + WS_SCR + S_Y) + (size_t)m * D) + lane; float a[16]; unpack8(yr[0], a); unpack8(yr[64], a + 8);
#pragma unroll
                        for (int j = 0; j < 16; ++j) v[k][j] += a[j]; }
                    if (MODE == 2) { const int s0 = __builtin_amdgcn_readlane(sl0, i0 + k), s1 = __builtin_amdgcn_readlane(sl1, i0 + k);
                        const float g0 = __builtin_bit_cast(float, __builtin_amdgcn_readlane(__builtin_bit_cast(int, gg0), i0 + k)), g1 = __builtin_bit_cast(float, __builtin_amdgcn_readlane(__builtin_bit_cast(int, gg1), i0 + k));
                        const u32x2* y0 = (const u32x2*)(ys + (size_t)s0 * D) + lane; const u32x2* y1 = (const u32x2*)(ys + (size_t)s1 * D) + lane;
                        const u32x2 ya0 = y0[0], ya1 = y0[64], yb0 = y1[0], yb1 = y1[64];
                        float a[16], b[16];
#pragma unroll
                        for (int c = 0; c < 2; ++c) { const unsigned wa0 = c ? ya0.y : ya0.x, wa1 = c ? ya1.y : ya1.x, wb0 = c ? yb0.y : yb0.x, wb1 = c ? yb1.y : yb1.x;
                            f32x2 t;
                            t = __builtin_amdgcn_cvt_pk_f32_fp8((int)wa0, false); a[4 * c] = t.x; a[4 * c + 1] = t.y; t = __builtin_amdgcn_cvt_pk_f32_fp8((int)wa0, true); a[4 * c + 2] = t.x; a[4 * c + 3] = t.y;
                            t = __builtin_amdgcn_cvt_pk_f32_fp8((int)wa1, false); a[8 + 4 * c] = t.x; a[8 + 4 * c + 1] = t.y; t = __builtin_amdgcn_cvt_pk_f32_fp8((int)wa1, true); a[8 + 4 * c + 2] = t.x; a[8 + 4 * c + 3] = t.y;
                            t = __builtin_amdgcn_cvt_pk_f32_fp8((int)wb0, false); b[4 * c] = t.x; b[4 * c + 1] = t.y; t = __builtin_amdgcn_cvt_pk_f32_fp8((int)wb0, true); b[4 * c + 2] = t.x; b[4 * c + 3] = t.y;
                            t = __builtin_amdgcn_cvt_pk_f32_fp8((int)wb1, false); b[8 + 4 * c] = t.x; b[8 + 4 * c + 1] = t.y; t = __builtin_amdgcn_cvt_pk_f32_fp8((int)wb1, true); b[8 + 4 * c + 2] = t.x; b[8 + 4 * c + 3] = t.y; }
                        const float h0 = g0 * (1.f / YSCALE8), h1 = g1 * (1.f / YSCALE8);
#pragma unroll
                        for (int j = 0; j < 16; ++j) v[k][j] += h0 * a[j] + h1 * b[j]; } }
                float s = 0.f, q2 = 0.f;
#pragma unroll
                for (int j = 0; j < 16; ++j) { s += v[k][j]; q2 += v[k][j] * v[k][j]; }
                st[k][0] = s; st[k][1] = q2; }
#pragma unroll
            for (int o = 1; o < 64; o <<= 1) {
#pragma unroll
                for (int k = 0; k < NBT; ++k) { st[k][0] += __shfl_xor(st[k][0], o); st[k][1] += __shfl_xor(st[k][1], o); } }
#pragma unroll
            for (int k = 0; k < NBT; ++k) { const int m = grp * 32 + i0 + k;
                const float mean = st[k][0] * (1.f / D), var = fmaxf(st[k][1] * (1.f / D) - mean * mean, 0.f), rstd = 1.f / sqrtf(var + LN_EPS);
#pragma unroll
                for (int j = 0; j < 16; ++j) v[k][j] = (v[k][j] - mean) * rstd * gv[j] + bv[j];
                if (FINAL) { f32x4* orow = (f32x4*)(F.out + (size_t)m * D) + 2 * lane;
                    orow[0] = (f32x4){v[k][0], v[k][1], v[k][2], v[k][3]}; orow[1] = (f32x4){v[k][4], v[k][5], v[k][6], v[k][7]}; orow[128] = (f32x4){v[k][8], v[k][9], v[k][10], v[k][11]}; orow[129] = (f32x4){v[k][12], v[k][13], v[k][14], v[k][15]}; }
                else { u32x4* o = (u32x4*)(hb + (size_t)m * D) + lane; u32x4 a, b;
                    a.x = pk2(v[k][0], v[k][1]); a.y = pk2(v[k][2], v[k][3]); a.z = pk2(v[k][4], v[k][5]); a.w = pk2(v[k][6], v[k][7]); b.x = pk2(v[k][8], v[k][9]); b.y = pk2(v[k][10], v[k][11]); b.z = pk2(v[k][12], v[k][13]); b.w = pk2(v[k][14], v[k][15]);
                    o[0] = a; o[64] = b;
                    if (HB8) { u32x2* o8 = (u32x2*)(F.ws + WS_SCR + S_HB8 + (size_t)m * D) + lane; u32x2 c, d;
                        c.x = pk4_fp8(v[k][0], v[k][1], v[k][2], v[k][3]); c.y = pk4_fp8(v[k][4], v[k][5], v[k][6], v[k][7]); d.x = pk4_fp8(v[k][8], v[k][9], v[k][10], v[k][11]); d.y = pk4_fp8(v[k][12], v[k][13], v[k][14], v[k][15]);
                        o8[0] = c; o8[64] = d; } }
                if (ROUTE) {
                    float lg[8];
#pragma unroll
                    for (int e = 0; e < 8; ++e) { float p = 0.f;
#pragma unroll
                        for (int kk = 0; kk < 2; ++kk)
#pragma unroll
                            for (int j = 0; j < 2; ++j) { const f32x4 w4 = *(const LAS f32x4*)(wrT + e * 1024 + 512 * kk + 8 * lane + 4 * j); p += (v[k][8 * kk + 4 * j] * w4.x + v[k][8 * kk + 4 * j + 1] * w4.y) + (v[k][8 * kk + 4 * j + 2] * w4.z + v[k][8 * kk + 4 * j + 3] * w4.w); }
                        lg[e] = p; }
#pragma unroll
                    for (int o = 1; o < 64; o <<= 1) {
#pragma unroll
                        for (int e = 0; e < 8; ++e) lg[e] += __shfl_xor(lg[e], o); }
                    int e1 = 0; float v1 = lg[0];
#pragma unroll
                    for (int e = 1; e < 8; ++e) if (lg[e] > v1) { v1 = lg[e]; e1 = e; }
                    int e2 = -1; float v2 = -3.4e38f;
#pragma unroll
                    for (int e = 0; e < 8; ++e) if (e != e1 && lg[e] > v2) { v2 = lg[e]; e2 = e; }
                    const float g2 = 1.f / (1.f + __expf(v1 - v2)), g1 = 1.f - g2;
                    const int r1 = __shfl(cnt_e, e1); if (lane == e1) ++cnt_e;
                    const int r2 = __shfl(cnt_e, e2); if (lane == e2) ++cnt_e;
                    if (lane == i0 + k) { my_e1 = e1; my_e2 = e2; my_r1 = r1; my_r2 = r2; my_g1 = g1; my_g2 = g2; }
                }
            }
        }
        if (ROUTE) {
            if (lane < 8) ((int*)(F.ws + WS_WCNT))[grp * 8 + lane] = cnt_e;
            if (lane < 32) { const int m = grp * 32 + lane; int* r = route + 4 * m; r[0] = my_e1; r[1] = my_r1; r[2] = my_e2; r[3] = my_r2; gout[2 * m] = my_g1; gout[2 * m + 1] = my_g2; }
        }
    }
}

__device__ __forceinline__ f32x16 mfma32(bf16x8 a, bf16x8 b, f32x16 c) { return __builtin_amdgcn_mfma_f32_32x32x16_bf16(a, b, c, 0, 0, 0); }
__device__ __forceinline__ bf16x8 pack8(const f32x16& s, int b0) {
    u32x4 w; w.x = pg8::cvt_pk_bf16(s[b0], s[b0 + 1]); w.y = pg8::cvt_pk_bf16(s[b0 + 2], s[b0 + 3]); w.z = pg8::cvt_pk_bf16(s[b0 + 4], s[b0 + 5]); w.w = pg8::cvt_pk_bf16(s[b0 + 6], s[b0 + 7]);
    return __builtin_bit_cast(bf16x8, w);
}
__device__ __forceinline__ float max16(const f32x16& s) {
    float a = fmaxf(fmaxf(s[0], s[1]), fmaxf(s[2], s[3])), b = fmaxf(fmaxf(s[4], s[5]), fmaxf(s[6], s[7]));
    float c = fmaxf(fmaxf(s[8], s[9]), fmaxf(s[10], s[11])), d = fmaxf(fmaxf(s[12], s[13]), fmaxf(s[14], s[15]));
    return fmaxf(fmaxf(a, b), fmaxf(c, d));
}
__device__ __forceinline__ void softmax_pv(f32x16& s, float& m_run, float& l_run, f32x16& o0, f32x16& o1, const bf16* vt0, const bf16* vt1, int h) {
    float mx = max16(s); mx = fmaxf(mx, __shfl_xor(mx, 32));
    const float mn = fmaxf(m_run, mx), alpha = __builtin_amdgcn_exp2f(m_run - mn); m_run = mn;
    float ps = 0.f;
#pragma unroll
    for (int r = 0; r < 16; ++r) { const float p = __builtin_amdgcn_exp2f(s[r] - mn); s[r] = p; ps += p; }
    l_run = l_run * alpha + ps;
#pragma unroll
    for (int r = 0; r < 16; ++r) { o0[r] *= alpha; o1[r] *= alpha; }
    const bf16x8 p0 = pack8(s, 0), p1 = pack8(s, 8);
    const bf16x8 v00 = *(const bf16x8*)(vt0 + 8 * h), v01 = *(const bf16x8*)(vt0 + 16 + 8 * h), v10 = *(const bf16x8*)(vt1 + 8 * h), v11 = *(const bf16x8*)(vt1 + 16 + 8 * h);
    o0 = mfma32(v00, p0, o0); o0 = mfma32(v01, p1, o0);
    o1 = mfma32(v10, p0, o1); o1 = mfma32(v11, p1, o1);
}
__device__ __forceinline__ int kperm(int i) { return (i & 19) | ((i & 8) >> 1) | ((i & 4) << 1); }

__device__ __forceinline__ void dil_attn_phase(Frame& F) {
    LAS float* bt = (LAS float*)F.lds;
    { const float* btA = (const float*)(F.ws + WS_BTABA); for (int i = F.tid; i < 48 * 192; i += 512) { const int gh = i / 192, dl = i % 192 - 32; bt[i] = (dl >= 0 && dl <= 128) ? btA[gh * 132 + dl] : NEGB; } }
    __syncthreads();
    const int gw = F.vcu * NWAVES + F.wave, NGW = F.G * NWAVES, lane = F.lane, q = lane & 31, h = lane >> 5;
    const bf16* QK = (const bf16*)(F.ws + WS_SCR + S_QK); const bf16* VT = (const bf16*)(F.ws + WS_SCR + S_VT);
    bf16* OG = (bf16*)((unsigned char*)F.out + O_OG); float* LSE = (float*)((unsigned char*)F.out + O_LSE);
    constexpr int NTASK = 3 * 16 * 8 * 64;
    const int per = (NTASK + NGW - 1) / NGW;
    const int t_lo = gw * per, t_hi = (t_lo + per) < NTASK ? (t_lo + per) : NTASK;
    for (int task = t_lo; task < t_hi; ++task) {
        const int qt = task & 3, rn = (task >> 2) & 15, bl = (task >> 6) & 7, gh = task >> 9, g = gh >> 4, hh = gh & 15;
        const int nblk = 16 >> (2 * g); const bool has_prev = (rn & (nblk - 1)) != 0;
        const int n0 = bl * 2048 + rn * 128;
        const bf16* qrow = QK + ((size_t)g * TC + n0 + 32 * qt + q) * 2048 + hh * 64;
        bf16x8 qf[4];
#pragma unroll
        for (int d0 = 0; d0 < 4; ++d0) qf[d0] = *(const bf16x8*)(qrow + d0 * 16 + 8 * h);
        float m_run = NEGB, l_run = 0.f; f32x16 o0 = {}, o1 = {};
        const bf16* vbase0 = VT + ((size_t)g * 1024 + hh * 64 + q) * TC; const bf16* vbase1 = vbase0 + (size_t)32 * TC;
        const LAS float* btl = bt + gh * 192 + (q - 8 * h + 137);
#pragma unroll
        for (int t = 0; t < 5; ++t) {
            if (has_prev || qt + t > 3) {
                const int kr0 = n0 - 128 + 32 * qt + 32 * t;
                const bf16* krow = QK + ((size_t)g * TC + kr0 + kperm(q)) * 2048 + 1024 + hh * 64;
                f32x16 s;
#pragma unroll
                for (int r = 0; r < 16; ++r) s[r] = btl[-32 * t + 23 - 16 * (r >> 3) - (r & 7)];
#pragma unroll
                for (int d0 = 0; d0 < 4; ++d0) { const bf16x8 kf = *(const bf16x8*)(krow + d0 * 16 + 8 * h); s = mfma32(kf, qf[d0], s); }
                softmax_pv(s, m_run, l_run, o0, o1, vbase0 + kr0, vbase1 + kr0, h);
            }
        }
        const float l_tot = l_run + __shfl_xor(l_run, 32), inv = 1.f / l_tot;
        const size_t orow = (size_t)g * TC + n0 + 32 * qt + q;
        bf16* op = OG + orow * 1024 + hh * 64 + 4 * h;
#pragma unroll
        for (int gq = 0; gq < 4; ++gq) {
            u32x2 w0, w1; w0.x = pg8::cvt_pk_bf16(o0[4 * gq] * inv, o0[4 * gq + 1] * inv); w0.y = pg8::cvt_pk_bf16(o0[4 * gq + 2] * inv, o0[4 * gq + 3] * inv);
            w1.x = pg8::cvt_pk_bf16(o1[4 * gq] * inv, o1[4 * gq + 1] * inv); w1.y = pg8::cvt_pk_bf16(o1[4 * gq + 2] * inv, o1[4 * gq + 3] * inv);
            *(u32x2*)(op + 8 * gq) = w0; *(u32x2*)(op + 32 + 8 * gq) = w1; }
        if (h == 0) LSE[orow * 16 + hh] = m_run + __log2f(l_tot);
    }
}
__device__ __forceinline__ void dil_merge_phase(Frame& F, int ck) {
    const int gw = F.vcu * NWAVES + F.wave, NGW = F.G * NWAVES, lane = F.lane;
    const bf16* OG = (const bf16*)((unsigned char*)F.out + O_OG); const float* LSE = (const float*)((unsigned char*)F.out + O_LSE);
    unsigned char* att = F.ws + WS_SCR + S_ATT + (size_t)ck * TC * 1024;
    const int hh = lane >> 2;
    for (int tl0 = 2 * gw; tl0 < TC; tl0 += 2 * NGW) {
        size_t n[2][3]; float ls[2][3]; u32x4 x[2][3];
#pragma unroll
        for (int k = 0; k < 2; ++k) { const int tl = tl0 + k, bl = tl >> 11, tt = tl & 2047;
            n[k][0] = tl; n[k][1] = bl * 2048 + (tt & 3) * 512 + (tt >> 2); n[k][2] = bl * 2048 + (tt & 15) * 128 + (tt >> 4);
#pragma unroll
            for (int g = 0; g < 3; ++g) { ls[k][g] = LSE[((size_t)g * TC + n[k][g]) * 16 + hh]; x[k][g] = *(const u32x4*)((const unsigned char*)OG + ((size_t)g * TC + n[k][g]) * 1024 + 16 * lane); } }
#pragma unroll
        for (int k = 0; k < 2; ++k) {
            const float M = fmaxf(fmaxf(ls[k][0], ls[k][1]), ls[k][2]);
            float w[3]; float W = 0.f;
#pragma unroll
            for (int g = 0; g < 3; ++g) { w[g] = __builtin_amdgcn_exp2f(ls[k][g] - M); W += w[g]; }
            const float iw = 1.f / W;
            float acc[16];
#pragma unroll
            for (int j = 0; j < 16; ++j) acc[j] = 0.f;
#pragma unroll
            for (int g = 0; g < 3; ++g) { const float wg = w[g] * iw; float a[16];
#pragma unroll
                for (int c = 0; c < 4; ++c) { const f32x2 lo = __builtin_amdgcn_cvt_pk_f32_fp8((int)x[k][g][c], false), hi = __builtin_amdgcn_cvt_pk_f32_fp8((int)x[k][g][c], true); a[4 * c] = lo.x; a[4 * c + 1] = lo.y; a[4 * c + 2] = hi.x; a[4 * c + 3] = hi.y; }
#pragma unroll
                for (int j = 0; j < 16; ++j) acc[j] += wg * a[j]; }
            u32x4 y; y.x = pk4_fp8(acc[0], acc[1], acc[2], acc[3]); y.y = pk4_fp8(acc[4], acc[5], acc[6], acc[7]); y.z = pk4_fp8(acc[8], acc[9], acc[10], acc[11]); y.w = pk4_fp8(acc[12], acc[13], acc[14], acc[15]);
            *(u32x4*)(att + (size_t)(tl0 + k) * 1024 + 16 * lane) = y;
        }
    }
}

__device__ __forceinline__ void conv_phase(Frame& F, const float* cw) {
    const int gw = F.vcu * NWAVES + F.wave, NGW = F.G * NWAVES, lane = F.lane;
    const bf16* gbp = (const bf16*)(F.ws + WS_SCR + S_BCX); const bf16* up = (const bf16*)(F.ws + WS_SCR + S_BCX + (size_t)128 * MiB); bf16* p = (bf16*)(F.ws + WS_SCR + S_P);
    for (int item = gw; item < (T / 32) * 2; item += NGW) {
        const int half = item & 1, tb = item >> 1, t0 = tb * 32, c0 = half * 512 + lane * 8;
        float w0[8], w1[8], w2[8];
#pragma unroll
        for (int j = 0; j < 8; ++j) { w0[j] = cw[c0 + j]; w1[j] = cw[1024 + c0 + j]; w2[j] = cw[2048 + c0 + j]; }
        float u1[8], u2[8];
        const bool first = (t0 & 2047) == 0;
#pragma unroll
        for (int j = 0; j < 8; ++j) { u1[j] = 0.f; u2[j] = 0.f; }
        if (!first) { unpack8(*(const u32x4*)(up + (size_t)(t0 - 2) * 1024 + c0), u2); unpack8(*(const u32x4*)(up + (size_t)(t0 - 1) * 1024 + c0), u1); }
        for (int i = 0; i < 32; ++i) { const size_t r = (size_t)(t0 + i) * 1024;
            const u32x4 gb = *(const u32x4*)(gbp + r + c0), uu = *(const u32x4*)(up + r + c0);
            float u0[8], b[8]; unpack8(uu, u0); unpack8(gb, b);
            float o[8];
#pragma unroll
            for (int j = 0; j < 8; ++j) { o[j] = b[j] * (w0[j] * u2[j] + w1[j] * u1[j] + w2[j] * u0[j]); u2[j] = u1[j]; u1[j] = u0[j]; }
            u32x4 x; x.x = pk2(o[0], o[1]); x.y = pk2(o[2], o[3]); x.z = pk2(o[4], o[5]); x.w = pk2(o[6], o[7]);
            *(u32x4*)(p + (size_t)(t0 + i) * 1024 + c0) = x; }
    }
}

__device__ __forceinline__ void kmean_phase(Frame& F) {
    const int gw = F.vcu * NWAVES + F.wave, NGW = F.G * NWAVES, lane = F.lane;
    const bf16* QK = (const bf16*)(F.ws + WS_SCR + S_CQK); float* km = (float*)(F.ws + WS_KMEAN);
    const int kq = lane >> 3, dc = lane & 7;
    for (int u = gw; u < NB * NH * 8; u += NGW) { const int blk = u & 7, hh = (u >> 3) & 15, b = u >> 7;
        float a[8];
#pragma unroll
        for (int j = 0; j < 8; ++j) a[j] = 0.f;
        const bf16* kp = QK + ((size_t)b * SEQ + blk * 256 + kq) * 2048 + 1024 + hh * 64 + dc * 8;
#pragma unroll 8
        for (int i = 0; i < 32; ++i) { const u32x4 x = *(const u32x4*)(kp + (size_t)i * 8 * 2048);
            a[0] += bflo(x.x); a[1] += bfhi(x.x); a[2] += bflo(x.y); a[3] += bfhi(x.y); a[4] += bflo(x.z); a[5] += bfhi(x.z); a[6] += bflo(x.w); a[7] += bfhi(x.w); }
#pragma unroll
        for (int j = 0; j < 8; ++j) { a[j] += __shfl_xor(a[j], 8); a[j] += __shfl_xor(a[j], 16); a[j] += __shfl_xor(a[j], 32); }
        if (lane < 8) { float* o = km + (size_t)u * 64 + lane * 8;
#pragma unroll
            for (int j = 0; j < 8; ++j) o[j] = a[j] * (1.f / 256.f); }
    }
}
__device__ __forceinline__ void moba_unit(Frame& F, int b, int hh, int nb, LAS float* bt, int& cur_h) {
    const int lane = F.lane, q = lane & 31, h = lane >> 5, w = F.wave;
    const bf16* QK = (const bf16*)(F.ws + WS_SCR + S_CQK); const bf16* VT = (const bf16*)(F.ws + WS_SCR + S_CVT);
    bf16* att = (bf16*)(F.ws + WS_SCR + S_CATT); const float* km = (const float*)(F.ws + WS_KMEAN);
    if (hh != cur_h) { __syncthreads(); const float* btC = (const float*)(F.ws + WS_BTABC) + hh * 2048; for (int i = F.tid; i < 2048; i += 512) bt[i] = btC[i]; cur_h = hh; __syncthreads(); }
    const size_t tq = (size_t)b * SEQ + nb * 256 + 32 * w + q;
    const bf16* qrow = QK + tq * 2048 + hh * 64;
    bf16x8 qf[4];
#pragma unroll
    for (int d0 = 0; d0 < 4; ++d0) qf[d0] = *(const bf16x8*)(qrow + d0 * 16 + 8 * h);
    unsigned sel = 0;
    if (nb > 0) {
        float gsc[7];
#pragma unroll
        for (int m = 0; m < 7; ++m) { float s = 0.f;
            if (m < nb) { const float* kmp = km + (((size_t)b * NH + hh) * 8 + m) * 64;
#pragma unroll
                for (int d0 = 0; d0 < 4; ++d0) { const f32x4 k0 = *(const f32x4*)(kmp + d0 * 16 + 8 * h), k1 = *(const f32x4*)(kmp + d0 * 16 + 8 * h + 4); const u32x4 qq = __builtin_bit_cast(u32x4, qf[d0]);
                    s += bflo(qq.x) * k0.x + bfhi(qq.x) * k0.y + bflo(qq.y) * k0.z + bfhi(qq.y) * k0.w + bflo(qq.z) * k1.x + bfhi(qq.z) * k1.y + bflo(qq.w) * k1.z + bfhi(qq.w) * k1.w; }
                s += __shfl_xor(s, 32); }
            gsc[m] = m < nb ? s : -3.0e38f; }
        const int nsel = nb < 3 ? nb : 3;
#pragma unroll
        for (int r = 0; r < 3; ++r) { if (r < nsel) { int bi = -1; float bv = -3.4e38f;
#pragma unroll
                for (int m = 0; m < 7; ++m) if (!((sel >> m) & 1u) && gsc[m] > bv) { bv = gsc[m]; bi = m; }
                sel |= 1u << bi; } }
    }
#ifdef MK_SELFCHECK
    if (h == 0) ((unsigned*)(F.ws + WS_NEED + 3 * MiB))[tq * 16 + hh] = sel;
#endif
    float m_run = NEGB, l_run = 0.f; f32x16 o0 = {}, o1 = {};
    const bf16* vbase0 = VT + ((size_t)hh * 64 + q) * T + (size_t)b * SEQ; const bf16* vbase1 = vbase0 + (size_t)32 * T;
    const int qpos = nb * 256 + 32 * w + q;
    for (int m = 0; m < nb; ++m) {
        const bool mine = (sel >> m) & 1u;
        if (__ballot(mine) == 0ull) continue;
        for (int kt = 0; kt < 8; ++kt) {
            const int kr0 = m * 256 + 32 * kt;
            const bf16* krow = QK + ((size_t)b * SEQ + kr0 + kperm(q)) * 2048 + 1024 + hh * 64;
            f32x16 s = {};
#pragma unroll
            for (int d0 = 0; d0 < 4; ++d0) { const bf16x8 kf = *(const bf16x8*)(krow + d0 * 16 + 8 * h); s = mfma32(kf, qf[d0], s); }
#pragma unroll
            for (int r = 0; r < 16; ++r) { const int kap = 16 * (r >> 3) + 8 * h + (r & 7); const float bb = bt[qpos - kr0 - kap]; s[r] = mine ? s[r] + bb : NEGB; }
            softmax_pv(s, m_run, l_run, o0, o1, vbase0 + kr0, vbase1 + kr0, h);
        }
    }
    for (int kt = 0; kt <= w; ++kt) {
        const int kr0 = nb * 256 + 32 * kt;
        const bf16* krow = QK + ((size_t)b * SEQ + kr0 + kperm(q)) * 2048 + 1024 + hh * 64;
        f32x16 s = {};
#pragma unroll
        for (int d0 = 0; d0 < 4; ++d0) { const bf16x8 kf = *(const bf16x8*)(krow + d0 * 16 + 8 * h); s = mfma32(kf, qf[d0], s); }
#pragma unroll
        for (int r = 0; r < 16; ++r) { const int kap = 16 * (r >> 3) + 8 * h + (r & 7); const int dd = qpos - kr0 - kap; const float bb = bt[dd < 0 ? 0 : dd]; s[r] = dd >= 0 ? s[r] + bb : NEGB; }
        softmax_pv(s, m_run, l_run, o0, o1, vbase0 + kr0, vbase1 + kr0, h);
    }
    const float l_tot = l_run + __shfl_xor(l_run, 32), inv = 1.f / l_tot;
#ifdef MK_SELFCHECK
    if (h == 0) ((float*)(F.ws + WS_NEED + 7 * MiB))[tq * 16 + hh] = m_run + __log2f(l_tot);
#endif
    bf16* op = att + tq * 1024 + hh * 64 + 4 * h;
#pragma unroll
    for (int gq = 0; gq < 4; ++gq) {
        u32x2 w0, w1; w0.x = pg8::cvt_pk_bf16(o0[4 * gq] * inv, o0[4 * gq + 1] * inv); w0.y = pg8::cvt_pk_bf16(o0[4 * gq + 2] * inv, o0[4 * gq + 3] * inv);
        w1.x = pg8::cvt_pk_bf16(o1[4 * gq] * inv, o1[4 * gq + 1] * inv); w1.y = pg8::cvt_pk_bf16(o1[4 * gq + 2] * inv, o1[4 * gq + 3] * inv);
        *(u32x2*)(op + 8 * gq) = w0; *(u32x2*)(op + 32 + 8 * gq) = w1; }
}
__device__ __forceinline__ void moba_phase(Frame& F) {
    LAS float* bt = (LAS float*)F.lds; int cur_h = -1;
    const int NP = NB * NH * 4, per = (NP + F.G - 1) / F.G;
    const int lo = F.vcu * per, hi = (lo + per) < NP ? (lo + per) : NP;
    for (int pu = lo; pu < hi; ++pu) { const int j = pu & 3, hh = (pu >> 2) & 15, b = pu >> 6;
        moba_unit(F, b, hh, 7 - j, bt, cur_h); moba_unit(F, b, hh, j, bt, cur_h); }
}


constexpr int AKP = 72;
constexpr int ATILE = 64 * AKP * 2;
struct AttnSt { float m, l; f32x16 o0, o1; };
template <bool MASKED>
__device__ __forceinline__ void attn_tile(const LAS bf16* Kt, const LAS bf16* Vt, const LAS float* bl, const bf16x8 (&qf)[4], AttnSt& st, int q, int h, bool mine) {
    f32x16 s;
#pragma unroll
    for (int r = 0; r < 16; ++r) s[r] = bl[23 - 16 * (r >> 3) - (r & 7)];
    const LAS bf16* kr = Kt + kperm(q) * AKP + 8 * h;
#pragma unroll
    for (int d0 = 0; d0 < 4; ++d0) s = mfma32(*(const LAS bf16x8*)(kr + d0 * 16), qf[d0], s);
    float mx = max16(s); mx = fmaxf(mx, __shfl_xor(mx, 32));
    float mn = fmaxf(st.m, mx); if (MASKED) mn = mine ? mn : st.m;
    const float alpha = __builtin_amdgcn_exp2f(st.m - mn);
    float ps = 0.f;
#pragma unroll
    for (int r = 0; r < 16; ++r) { const float p = __builtin_amdgcn_exp2f(s[r] - mn); s[r] = p; ps += p; }
    bf16x8 p0 = pack8(s, 0), p1 = pack8(s, 8);
    if (MASKED) { if (!mine) { p0 = (bf16x8){0, 0, 0, 0, 0, 0, 0, 0}; p1 = p0; ps = 0.f; } }
    st.l = st.l * alpha + ps; st.m = mn;
    if (__ballot(alpha != 1.0f) != 0ull) {
#pragma unroll
        for (int r = 0; r < 16; ++r) { st.o0[r] *= alpha; st.o1[r] *= alpha; } }
    const LAS bf16* v0 = Vt + q * AKP + 8 * h; const LAS bf16* v1 = v0 + 32 * AKP;
    st.o0 = mfma32(*(const LAS bf16x8*)v0, p0, st.o0); st.o0 = mfma32(*(const LAS bf16x8*)(v0 + 16), p1, st.o0);
    st.o1 = mfma32(*(const LAS bf16x8*)v1, p0, st.o1); st.o1 = mfma32(*(const LAS bf16x8*)(v1 + 16), p1, st.o1);
}
__device__ __forceinline__ void attn_store(const AttnSt& st, bf16* op  , float inv) {
#pragma unroll
    for (int gq = 0; gq < 4; ++gq) {
        u32x2 w0, w1; w0.x = pg8::cvt_pk_bf16(st.o0[4 * gq] * inv, st.o0[4 * gq + 1] * inv); w0.y = pg8::cvt_pk_bf16(st.o0[4 * gq + 2] * inv, st.o0[4 * gq + 3] * inv);
        w1.x = pg8::cvt_pk_bf16(st.o1[4 * gq] * inv, st.o1[4 * gq + 1] * inv); w1.y = pg8::cvt_pk_bf16(st.o1[4 * gq + 2] * inv, st.o1[4 * gq + 3] * inv);
        *(u32x2*)(op + 8 * gq) = w0; *(u32x2*)(op + 32 + 8 * gq) = w1; }
}

__device__ __forceinline__ void attn_store8(const AttnSt& st, unsigned char* op  , float inv) {
#pragma unroll
    for (int gq = 0; gq < 4; ++gq) {
        *(unsigned*)(op + 8 * gq) = pk4_fp8(st.o0[4 * gq] * inv, st.o0[4 * gq + 1] * inv, st.o0[4 * gq + 2] * inv, st.o0[4 * gq + 3] * inv);
        *(unsigned*)(op + 32 + 8 * gq) = pk4_fp8(st.o1[4 * gq] * inv, st.o1[4 * gq + 1] * inv, st.o1[4 * gq + 2] * inv, st.o1[4 * gq + 3] * inv); }
}

__device__ __forceinline__ void dil_attn_phase2(Frame& F) {
    LAS float* bt = (LAS float*)F.lds;
    { const float* btA = (const float*)(F.ws + WS_BTABA); for (int i = F.tid; i < 48 * 192; i += 512) { const int gh = i / 192, dl = i % 192 - 32; bt[i] = (dl >= 0 && dl <= 128) ? btA[gh * 132 + dl] : NEGB; } }
    __syncthreads();
    constexpr int TBL = 48 * 192 * 4;
    const int lane = F.lane, q = lane & 31, h = lane >> 5, w = F.wave, uw = w >> 2, qt = w & 3, t = F.tid, tu = t >> 8, tt = t & 255, srow = tt >> 3, sch = tt & 7;
    const bf16* QK = (const bf16*)(F.ws + WS_SCR + S_QK); const bf16* VT = (const bf16*)(F.ws + WS_SCR + S_VT);
    bf16* OG = (bf16*)((unsigned char*)F.out + O_OG); float* LSE = (float*)((unsigned char*)F.out + O_LSE);
    for (int du = F.vcu; du < 3072; du += F.G) {
        const int g = du >> 10, rem = du & 1023, hh = rem >> 6, blp = (rem >> 4) & 3, rn = rem & 15, gh = g * 16 + hh;
        const int nblk = 16 >> (2 * g); const bool has_prev = (rn & (nblk - 1)) != 0;
        const int j0 = has_prev ? 0 : 2;
        const int n0s = (2 * blp + tu) * 2048 + rn * 128;
        const bf16* ksrc = QK + ((size_t)g * TC + n0s - 128 + srow) * 2048 + 1024 + hh * 64 + sch * 8;
        const bf16* vsrc = VT + ((size_t)g * 1024 + hh * 64 + srow) * TC + (n0s - 128) + sch * 8;
        const int sdst = srow * AKP + sch * 8;
        const int n0 = (2 * blp + uw) * 2048 + rn * 128;
        const bf16* qrow = QK + ((size_t)g * TC + n0 + 32 * qt + q) * 2048 + hh * 64;
        bf16x8 qf[4];
#pragma unroll
        for (int d0 = 0; d0 < 4; ++d0) qf[d0] = *(const bf16x8*)(qrow + d0 * 16 + 8 * h);
        AttnSt st; st.m = NEGB; st.l = 0.f; st.o0 = (f32x16){}; st.o1 = (f32x16){};
        u32x4 k0, k1, v0, v1;
        k0 = *(const u32x4*)(ksrc + (size_t)(64 * j0) * 2048); k1 = *(const u32x4*)(ksrc + (size_t)(64 * j0 + 32) * 2048);
        v0 = *(const u32x4*)(vsrc + 64 * j0); v1 = *(const u32x4*)(vsrc + (size_t)32 * TC + 64 * j0);
        { LAS bf16* kb = (LAS bf16*)(F.lds + TBL + (0 * 2 + tu) * 2 * ATILE); LAS bf16* vb = kb + 64 * AKP;
          *(LAS u32x4*)(kb + sdst) = k0; *(LAS u32x4*)(kb + 32 * AKP + sdst) = k1; *(LAS u32x4*)(vb + sdst) = v0; *(LAS u32x4*)(vb + 32 * AKP + sdst) = v1; }
        __syncthreads();
        int pb = 0;
        for (int j = j0; j < 4; ++j) {
            const bool more = j + 1 < 4;
            if (more) { k0 = *(const u32x4*)(ksrc + (size_t)(64 * (j + 1)) * 2048); k1 = *(const u32x4*)(ksrc + (size_t)(64 * (j + 1) + 32) * 2048);
                        v0 = *(const u32x4*)(vsrc + 64 * (j + 1)); v1 = *(const u32x4*)(vsrc + (size_t)32 * TC + 64 * (j + 1)); }
            const LAS bf16* kb = (const LAS bf16*)(F.lds + TBL + (pb * 2 + uw) * 2 * ATILE); const LAS bf16* vb = kb + 64 * AKP;
#pragma unroll
            for (int t2 = 0; t2 < 2; ++t2) { const int t32 = 2 * j + t2;
                if (t32 >= qt && t32 <= qt + 4) {
                    const LAS float* bl = bt + gh * 192 + 32 + (32 * qt + q + 128 - 32 * t32 - 8 * h - 23);
                    attn_tile<false>(kb + 32 * t2 * AKP, vb + 32 * t2, bl, qf, st, q, h, true); } }
            if (more) { LAS bf16* kn = (LAS bf16*)(F.lds + TBL + ((pb ^ 1) * 2 + tu) * 2 * ATILE); LAS bf16* vn = kn + 64 * AKP;
                *(LAS u32x4*)(kn + sdst) = k0; *(LAS u32x4*)(kn + 32 * AKP + sdst) = k1; *(LAS u32x4*)(vn + sdst) = v0; *(LAS u32x4*)(vn + 32 * AKP + sdst) = v1; }
            __syncthreads();
            pb ^= 1;
        }
        const float l_tot = st.l + __shfl_xor(st.l, 32), inv = 1.f / l_tot;
        const size_t orow = (size_t)g * TC + n0 + 32 * qt + q;
        attn_store(st, OG + orow * 1024 + hh * 64 + 4 * h, inv);
        if (h == 0) LSE[orow * 16 + hh] = st.m + __log2f(l_tot);
    }
}

__device__ __forceinline__ void moba_unit2(Frame& F, int b, int hh, int nb, LAS float* bt, int& cur_h) {
    constexpr int TBL = 8448;
    const int lane = F.lane, q = lane & 31, h = lane >> 5, w = F.wave, t = F.tid, srow = t >> 3, sch = t & 7;
    const bf16* QK = (const bf16*)(F.ws + WS_SCR + S_CQK); const bf16* VT = (const bf16*)(F.ws + WS_SCR + S_CVT);
    bf16* att = (bf16*)(F.ws + WS_SCR + S_CATT); const float* km = (const float*)(F.ws + WS_KMEAN);
    if (hh != cur_h) { __syncthreads(); const float* btC = (const float*)(F.ws + WS_BTABC) + hh * 2048; for (int i = t; i < 2048 + 32; i += 512) bt[i] = i < 32 ? NEGB : btC[i - 32]; cur_h = hh; __syncthreads(); }
    const size_t tq = (size_t)b * SEQ + nb * 256 + 32 * w + q;
    const bf16* qrow = QK + tq * 2048 + hh * 64;
    bf16x8 qf[4];
#pragma unroll
    for (int d0 = 0; d0 < 4; ++d0) qf[d0] = *(const bf16x8*)(qrow + d0 * 16 + 8 * h);
    unsigned sel = 0;
    if (nb > 0) {
        float gsc[7];
#pragma unroll
        for (int m = 0; m < 7; ++m) { float s = 0.f;
            if (m < nb) { const float* kmp = km + (((size_t)b * NH + hh) * 8 + m) * 64;
#pragma unroll
                for (int d0 = 0; d0 < 4; ++d0) { const f32x4 k0 = *(const f32x4*)(kmp + d0 * 16 + 8 * h), k1 = *(const f32x4*)(kmp + d0 * 16 + 8 * h + 4); const u32x4 qq = __builtin_bit_cast(u32x4, qf[d0]);
                    s += bflo(qq.x) * k0.x + bfhi(qq.x) * k0.y + bflo(qq.y) * k0.z + bfhi(qq.y) * k0.w + bflo(qq.z) * k1.x + bfhi(qq.z) * k1.y + bflo(qq.w) * k1.z + bfhi(qq.w) * k1.w; }
                s += __shfl_xor(s, 32); }
            gsc[m] = m < nb ? s : -3.0e38f; }
        const int nsel = nb < 3 ? nb : 3;
#pragma unroll
        for (int r = 0; r < 3; ++r) { if (r < nsel) { int bi = 0; float bv = -3.4e38f;
#pragma unroll
                for (int m = 0; m < 7; ++m) if (!((sel >> m) & 1u) && gsc[m] > bv) { bv = gsc[m]; bi = m; }
                sel |= 1u << bi; } }
    }
    AttnSt st; st.m = NEGB; st.l = 0.f; st.o0 = (f32x16){}; st.o1 = (f32x16){};
    const int qpos = nb * 256 + 32 * w + q, nsteps = 4 * nb + 4;
    const bf16* ksrc = QK + ((size_t)b * SEQ + srow) * 2048 + 1024 + hh * 64 + sch * 8;
    const bf16* vsrc = VT + ((size_t)hh * 64 + srow) * T + (size_t)b * SEQ + sch * 8;
    const int sdst = srow * AKP + sch * 8;
    u32x4 kreg = *(const u32x4*)ksrc, vreg = *(const u32x4*)vsrc;
    { LAS bf16* kb = (LAS bf16*)(F.lds + TBL); *(LAS u32x4*)(kb + sdst) = kreg; *(LAS u32x4*)(kb + 64 * AKP + sdst) = vreg; }
    __syncthreads();
    int pb = 0;
    for (int s = 0; s < nsteps; ++s) {
        const bool more = s + 1 < nsteps;
        if (more) { kreg = *(const u32x4*)(ksrc + (size_t)(64 * (s + 1)) * 2048); vreg = *(const u32x4*)(vsrc + 64 * (s + 1)); }
        const LAS bf16* kb = (const LAS bf16*)(F.lds + TBL + pb * 2 * ATILE); const LAS bf16* vb = kb + 64 * AKP;
        if (s < 4 * nb) {
            const bool mine = (sel >> (s >> 2)) & 1u;
            if (__ballot(mine) != 0ull) {
#pragma unroll
                for (int t2 = 0; t2 < 2; ++t2) { const LAS float* bl = bt + 32 + (qpos - 8 * h - (64 * s + 32 * t2) - 23);
                    attn_tile<true>(kb + 32 * t2 * AKP, vb + 32 * t2, bl, qf, st, q, h, mine); } }
        } else {
#pragma unroll
            for (int t2 = 0; t2 < 2; ++t2) { const int t32 = (s - 4 * nb) * 2 + t2;
                if (t32 <= w) { const LAS float* bl = bt + 32 + (qpos - 8 * h - (64 * s + 32 * t2) - 23);
                    attn_tile<false>(kb + 32 * t2 * AKP, vb + 32 * t2, bl, qf, st, q, h, true); } }
        }
        if (more) { LAS bf16* kn = (LAS bf16*)(F.lds + TBL + (pb ^ 1) * 2 * ATILE); *(LAS u32x4*)(kn + sdst) = kreg; *(LAS u32x4*)(kn + 64 * AKP + sdst) = vreg; }
        __syncthreads();
        pb ^= 1;
    }
    const float l_tot = st.l + __shfl_xor(st.l, 32), inv = 1.f / l_tot;
    attn_store(st, att + tq * 1024 + hh * 64 + 4 * h, inv);
}
__device__ __forceinline__ void moba_phase2(Frame& F) {
    LAS float* bt = (LAS float*)F.lds; int cur_h = -1;
    const int NP = NB * NH * 4, per = (NP + F.G - 1) / F.G;
    const int lo = F.vcu * per, hi = (lo + per) < NP ? (lo + per) : NP;
    for (int pu = lo; pu < hi; ++pu) { const int j = pu & 3, hh = (pu >> 2) & 15, b = pu >> 6;
        moba_unit2(F, b, hh, 7 - j, bt, cur_h); moba_unit2(F, b, hh, j, bt, cur_h); }
}


__device__ __forceinline__ float xhalf_max(float m) { auto rr = __builtin_amdgcn_permlane32_swap(__float_as_uint(m), __float_as_uint(m), false, false); return fmaxf(__uint_as_float(rr[0]), __uint_as_float(rr[1])); }
__device__ __forceinline__ float xhalf_sum(float m) { auto rr = __builtin_amdgcn_permlane32_swap(__float_as_uint(m), __float_as_uint(m), false, false); return __uint_as_float(rr[0]) + __uint_as_float(rr[1]); }
template <bool MASKED>
__device__ __forceinline__ void attn_tile2(const LAS bf16* Kt, const LAS bf16* Vt, const LAS float* bl0, const bf16x8 (&qf)[4], AttnSt& st, int q, int h, bool mine) {
    f32x16 s0, s1;
#pragma unroll
    for (int r = 0; r < 16; ++r) { s0[r] = bl0[23 - 16 * (r >> 3) - (r & 7)]; s1[r] = bl0[-32 + 23 - 16 * (r >> 3) - (r & 7)]; }
    const LAS bf16* kr = Kt + kperm(q) * AKP + 8 * h;
#pragma unroll
    for (int d0 = 0; d0 < 4; ++d0) { s0 = mfma32(*(const LAS bf16x8*)(kr + d0 * 16), qf[d0], s0); s1 = mfma32(*(const LAS bf16x8*)(kr + 32 * AKP + d0 * 16), qf[d0], s1); }
    const float mx = xhalf_max(fmaxf(max16(s0), max16(s1)));
    float mn = fmaxf(st.m, mx); if (MASKED) mn = mine ? mn : st.m;
    const float alpha = __builtin_amdgcn_exp2f(st.m - mn);
    float ps0 = 0.f, ps1 = 0.f;
#pragma unroll
    for (int r = 0; r < 16; ++r) { const float p = __builtin_amdgcn_exp2f(s0[r] - mn); s0[r] = p; ps0 += p; const float p2 = __builtin_amdgcn_exp2f(s1[r] - mn); s1[r] = p2; ps1 += p2; }
    bf16x8 p00 = pack8(s0, 0), p01 = pack8(s0, 8), p10 = pack8(s1, 0), p11 = pack8(s1, 8);
    float ps = ps0 + ps1;
    if (MASKED) { if (!mine) { p00 = (bf16x8){0, 0, 0, 0, 0, 0, 0, 0}; p01 = p00; p10 = p00; p11 = p00; ps = 0.f; } }
    st.l = st.l * alpha + ps; st.m = mn;
    if (__ballot(alpha != 1.0f) != 0ull) {
#pragma unroll
        for (int r = 0; r < 16; ++r) { st.o0[r] *= alpha; st.o1[r] *= alpha; } }
    const LAS bf16* v0 = Vt + q * AKP + 8 * h; const LAS bf16* v1 = v0 + 32 * AKP;
    st.o0 = mfma32(*(const LAS bf16x8*)v0, p00, st.o0); st.o1 = mfma32(*(const LAS bf16x8*)v1, p00, st.o1);
    st.o0 = mfma32(*(const LAS bf16x8*)(v0 + 16), p01, st.o0); st.o1 = mfma32(*(const LAS bf16x8*)(v1 + 16), p01, st.o1);
    st.o0 = mfma32(*(const LAS bf16x8*)(v0 + 32), p10, st.o0); st.o1 = mfma32(*(const LAS bf16x8*)(v1 + 32), p10, st.o1);
    st.o0 = mfma32(*(const LAS bf16x8*)(v0 + 48), p11, st.o0); st.o1 = mfma32(*(const LAS bf16x8*)(v1 + 48), p11, st.o1);
}

__device__ __forceinline__ void attn_tile2r(const LAS bf16* Kt, const LAS bf16* Vt, const LAS float* b0, const LAS float* b1, const bf16x8 (&qf)[4], AttnSt& st, int q, int h) {
    f32x16 s0, s1;
#pragma unroll
    for (int r = 0; r < 16; ++r) { s0[r] = b0[16 * (r >> 3) + (r & 7)]; s1[r] = b1[16 * (r >> 3) + (r & 7)]; }
    const LAS bf16* kr = Kt + kperm(q) * AKP + 8 * h;
#pragma unroll
    for (int d0 = 0; d0 < 4; ++d0) { s0 = mfma32(*(const LAS bf16x8*)(kr + d0 * 16), qf[d0], s0); s1 = mfma32(*(const LAS bf16x8*)(kr + 32 * AKP + d0 * 16), qf[d0], s1); }
    const float mx = xhalf_max(fmaxf(max16(s0), max16(s1)));
    const float mn = fmaxf(st.m, mx);
    const float alpha = __builtin_amdgcn_exp2f(st.m - mn);
    float ps0 = 0.f, ps1 = 0.f;
#pragma unroll
    for (int r = 0; r < 16; ++r) { const float p = __builtin_amdgcn_exp2f(s0[r] - mn); s0[r] = p; ps0 += p; const float p2 = __builtin_amdgcn_exp2f(s1[r] - mn); s1[r] = p2; ps1 += p2; }
    const bf16x8 p00 = pack8(s0, 0), p01 = pack8(s0, 8), p10 = pack8(s1, 0), p11 = pack8(s1, 8);
    st.l = st.l * alpha + (ps0 + ps1); st.m = mn;
    if (__ballot(alpha != 1.0f) != 0ull) {
#pragma unroll
        for (int r = 0; r < 16; ++r) { st.o0[r] *= alpha; st.o1[r] *= alpha; } }
    const LAS bf16* v0 = Vt + q * AKP + 8 * h; const LAS bf16* v1 = v0 + 32 * AKP;
    st.o0 = mfma32(*(const LAS bf16x8*)v0, p00, st.o0); st.o1 = mfma32(*(const LAS bf16x8*)v1, p00, st.o1);
    st.o0 = mfma32(*(const LAS bf16x8*)(v0 + 16), p01, st.o0); st.o1 = mfma32(*(const LAS bf16x8*)(v1 + 16), p01, st.o1);
    st.o0 = mfma32(*(const LAS bf16x8*)(v0 + 32), p10, st.o0); st.o1 = mfma32(*(const LAS bf16x8*)(v1 + 32), p10, st.o1);
    st.o0 = mfma32(*(const LAS bf16x8*)(v0 + 48), p11, st.o0); st.o1 = mfma32(*(const LAS bf16x8*)(v1 + 48), p11, st.o1);
}

__device__ __forceinline__ u32x4 f8x8_bf16(u32x2 v) {
    const f32x2 a = __builtin_amdgcn_cvt_pk_f32_fp8((int)v.x, false), b = __builtin_amdgcn_cvt_pk_f32_fp8((int)v.x, true), c = __builtin_amdgcn_cvt_pk_f32_fp8((int)v.y, false), d = __builtin_amdgcn_cvt_pk_f32_fp8((int)v.y, true);
    u32x4 r; r.x = pg8::cvt_pk_bf16(a.x, a.y); r.y = pg8::cvt_pk_bf16(b.x, b.y); r.z = pg8::cvt_pk_bf16(c.x, c.y); r.w = pg8::cvt_pk_bf16(d.x, d.y); return r;
}
__device__ __forceinline__ void dil_attn_phase3(Frame& F) {
    LAS float* bt = (LAS float*)F.lds;
    { const float* btA = (const float*)(F.ws + WS_BTABA); for (int i = F.tid; i < 48 * 192; i += 512) { const int gh = i / 192, dl = 159 - i % 192; bt[i] = (dl >= 0 && dl <= 128) ? btA[gh * 132 + dl] : NEGB; } }
    constexpr int TBL = 48 * 192 * 4;
    const int lane = F.lane, q = lane & 31, h = lane >> 5, w = F.wave, uw = w >> 2, qt = w & 3, t = F.tid, tu = t >> 8, tt = t & 255, srow = tt >> 3, sch = tt & 7;
    const unsigned char* QK = F.ws + WS_SCR + S_QK; const unsigned char* VT = F.ws + WS_SCR + S_VT;
    bf16* OG = (bf16*)((unsigned char*)F.out + O_OG); float* LSE = (float*)((unsigned char*)F.out + O_LSE);
    const int sdst = srow * AKP + sch * 8;
    int du = F.vcu;
    if (du >= 3072) { __syncthreads(); return; }
    int g = du >> 10, hh = (du >> 6) & 15, blp = (du >> 4) & 3, rn = du & 15;
    int j = ((rn & ((16 >> (2 * g)) - 1)) != 0) ? 0 : 2;
    u32x2 k0, k1, v0, v1; u32x2 qn[4]; bf16x8 qf[4];
#define DIL_LOADS(G_, HH_, BLP_, RN_, J_) do { const int n0s_ = (2 * (BLP_) + tu) * 2048 + (RN_) * 128 - 128 + 64 * (J_); \
        const unsigned char* ks_ = QK + ((size_t)(G_) * TC + n0s_ + srow) * 2048 + 1024 + (HH_) * 64 + sch * 8; \
        const unsigned char* vs_ = VT + ((size_t)(G_) * 1024 + (HH_) * 64 + srow) * TC + n0s_ + sch * 8; \
        k0 = *(const u32x2*)ks_; k1 = *(const u32x2*)(ks_ + (size_t)32 * 2048); v0 = *(const u32x2*)vs_; v1 = *(const u32x2*)(vs_ + (size_t)32 * TC); } while (0)
#define DIL_QLOADS(G_, HH_, BLP_, RN_) do { const unsigned char* qr_ = QK + ((size_t)(G_) * TC + (2 * (BLP_) + uw) * 2048 + (RN_) * 128 + 32 * qt + q) * 2048 + (HH_) * 64; \
        _Pragma("unroll") for (int d0 = 0; d0 < 4; ++d0) qn[d0] = *(const u32x2*)(qr_ + d0 * 16 + 8 * h); } while (0)
#define DIL_WRITE(PB_) do { LAS bf16* kb_ = (LAS bf16*)(F.lds + TBL + ((PB_) * 2 + tu) * 2 * ATILE); LAS bf16* vb_ = kb_ + 64 * AKP; \
        *(LAS u32x4*)(kb_ + sdst) = f8x8_bf16(k0); *(LAS u32x4*)(kb_ + 32 * AKP + sdst) = f8x8_bf16(k1); *(LAS u32x4*)(vb_ + sdst) = f8x8_bf16(v0); *(LAS u32x4*)(vb_ + 32 * AKP + sdst) = f8x8_bf16(v1); } while (0)
    DIL_LOADS(g, hh, blp, rn, j); DIL_QLOADS(g, hh, blp, rn);
    DIL_WRITE(0);
#pragma unroll
    for (int d0 = 0; d0 < 4; ++d0) qf[d0] = __builtin_bit_cast(bf16x8, f8x8_bf16(qn[d0]));
    __syncthreads();
    AttnSt st; st.m = NEGB; st.l = 0.f; st.o0 = (f32x16){}; st.o1 = (f32x16){};
    int pb = 0;
    for (;;) {
        const bool last = (j == 3);
        int ng = g, nhh = hh, nblp = blp, nrn = rn, nj = j + 1; bool more = true;
        if (last) { const int nd = du + F.G; more = nd < 3072; ng = nd >> 10; nhh = (nd >> 6) & 15; nblp = (nd >> 4) & 3; nrn = nd & 15; nj = ((nrn & ((16 >> (2 * ng)) - 1)) != 0) ? 0 : 2; }
        if (more) { DIL_LOADS(ng, nhh, nblp, nrn, nj); if (last) DIL_QLOADS(ng, nhh, nblp, nrn); }
        { const LAS bf16* kb = (const LAS bf16*)(F.lds + TBL + (pb * 2 + uw) * 2 * ATILE); const LAS bf16* vb = kb + 64 * AKP;
          const int gh = g * 16 + hh, ta = 2 * j, tb = 2 * j + 1;
          const bool a_on = ta >= qt && ta <= qt + 4, b_on = tb >= qt && tb <= qt + 4;
          const LAS float* row = bt + gh * 192;
          const LAS float* ba = row + (168 - (32 + (32 * qt + q + 128 - 32 * ta - 8 * h - 23)));
          if (a_on || b_on) attn_tile2r(kb, vb, a_on ? ba : row + 160, b_on ? ba + 32 : row + 160, qf, st, q, h); }
        if (more) DIL_WRITE(pb ^ 1);
        if (last) {
            const float l_tot = xhalf_sum(st.l), inv = 1.f / l_tot;
            const size_t orow = (size_t)g * TC + (2 * blp + uw) * 2048 + rn * 128 + 32 * qt + q;
            attn_store8(st, (unsigned char*)OG + orow * 1024 + hh * 64 + 4 * h, inv * ASCALE8);
            if (h == 0) LSE[orow * 16 + hh] = st.m + __log2f(l_tot);
            st.m = NEGB; st.l = 0.f; st.o0 = (f32x16){}; st.o1 = (f32x16){};
#pragma unroll
            for (int d0 = 0; d0 < 4; ++d0) qf[d0] = __builtin_bit_cast(bf16x8, f8x8_bf16(qn[d0]));
        }
        __syncthreads();
        pb ^= 1;
        if (!more) break;
        if (last) du += F.G;
        g = ng; hh = nhh; blp = nblp; rn = nrn; j = nj;
    }
#undef DIL_LOADS
#undef DIL_QLOADS
#undef DIL_WRITE
}

__device__ __forceinline__ void moba_phase3(Frame& F) {
    constexpr int TBL = 8448, KMO = TBL + 4 * ATILE;
    LAS float* bt = (LAS float*)F.lds; LAS float* kml = (LAS float*)(F.lds + KMO);
    const int lane = F.lane, q = lane & 31, h = lane >> 5, w = F.wave, t = F.tid, srow = t >> 3, sch = t & 7;
    const bf16* QK = (const bf16*)(F.ws + WS_SCR + S_CQK); const bf16* VT = (const bf16*)(F.ws + WS_SCR + S_CVT);
    bf16* att = (bf16*)(F.ws + WS_SCR + S_CATT); const float* km = (const float*)(F.ws + WS_KMEAN);
    const int NP = NB * NH * 4, per = (NP + F.G - 1) / F.G;
    const int lo = F.vcu * per, hi = (lo + per) < NP ? (lo + per) : NP;
    const int nunits = 2 * (hi - lo);
    if (nunits <= 0) return;
    const int sdst = srow * AKP + sch * 8;
    int u = 0, cur_bh = -1;
    u32x4 kreg, vreg; bf16x8 qn[4], qf[4];
#define MB_LOADS(B_, HH_, S_) do { const bf16* ks_ = QK + ((size_t)(B_) * SEQ + 64 * (S_) + srow) * 2048 + 1024 + (HH_) * 64 + sch * 8; \
        const bf16* vs_ = VT + ((size_t)(HH_) * 64 + srow) * T + (size_t)(B_) * SEQ + 64 * (S_) + sch * 8; kreg = *(const u32x4*)ks_; vreg = *(const u32x4*)vs_; } while (0)
#define MB_QLOADS(B_, HH_, NB_) do { const bf16* qr_ = QK + ((size_t)(B_) * SEQ + (NB_) * 256 + 32 * w + q) * 2048 + (HH_) * 64; \
        _Pragma("unroll") for (int d0 = 0; d0 < 4; ++d0) qn[d0] = *(const bf16x8*)(qr_ + d0 * 16 + 8 * h); } while (0)
#define MB_WRITE(PB_) do { LAS bf16* kb_ = (LAS bf16*)(F.lds + TBL + (PB_) * 2 * ATILE); *(LAS u32x4*)(kb_ + sdst) = kreg; *(LAS u32x4*)(kb_ + 64 * AKP + sdst) = vreg; } while (0)
    int pu = lo, jj = pu & 3, hh = (pu >> 2) & 15, b = pu >> 6, nb = 7 - jj, s = 0, pb = 0;
    MB_LOADS(b, hh, 0); MB_QLOADS(b, hh, nb); MB_WRITE(0);
    unsigned sel = 0; bool fresh = true;
    AttnSt st; st.m = NEGB; st.l = 0.f; st.o0 = (f32x16){}; st.o1 = (f32x16){};
    for (;;) {
        if (fresh) {
            if (b * 16 + hh != cur_bh) { __syncthreads(); const float* btC = (const float*)(F.ws + WS_BTABC) + hh * 2048;
                for (int i = t; i < 2048 + 32; i += 512) bt[2079 - i] = i < 32 ? NEGB : btC[i - 32];
                { const float* kmp = km + ((size_t)b * NH + hh) * 512; kml[t] = kmp[t]; }
                cur_bh = b * 16 + hh; }
#pragma unroll
            for (int d0 = 0; d0 < 4; ++d0) qf[d0] = qn[d0];
            __syncthreads();
            sel = 0;
            if (nb > 0) {
                float gsc[7];
#pragma unroll
                for (int m = 0; m < 7; ++m) { float sc = 0.f;
                    if (m < nb) {
#pragma unroll
                        for (int d0 = 0; d0 < 4; ++d0) { const f32x4 c0 = *(const LAS f32x4*)(kml + m * 64 + d0 * 16 + 8 * h), c1 = *(const LAS f32x4*)(kml + m * 64 + d0 * 16 + 8 * h + 4); const u32x4 qq = __builtin_bit_cast(u32x4, qf[d0]);
                            sc += bflo(qq.x) * c0.x + bfhi(qq.x) * c0.y + bflo(qq.y) * c0.z + bfhi(qq.y) * c0.w + bflo(qq.z) * c1.x + bfhi(qq.z) * c1.y + bflo(qq.w) * c1.z + bfhi(qq.w) * c1.w; }
                        sc = xhalf_sum(sc); }
                    gsc[m] = m < nb ? sc : -3.0e38f; }
                const int nsel = nb < 3 ? nb : 3;
#pragma unroll
                for (int r = 0; r < 3; ++r) { if (r < nsel) { int bi = 0; float bv = -3.4e38f;
#pragma unroll
                        for (int m = 0; m < 7; ++m) if (!((sel >> m) & 1u) && gsc[m] > bv) { bv = gsc[m]; bi = m; }
                        sel |= 1u << bi; } }
            }
            fresh = false;
        }
        const int nsteps = 4 * nb + 4;
        const bool last = (s + 1 == nsteps);
        int nb2 = nb, b2 = b, hh2 = hh, s2 = s + 1; bool more = true;
        if (last) { const int u2 = u + 1; more = u2 < nunits; const int pu2 = lo + (u2 >> 1), j2 = pu2 & 3; hh2 = (pu2 >> 2) & 15; b2 = pu2 >> 6; nb2 = (u2 & 1) ? j2 : 7 - j2; s2 = 0; }
        if (more) { MB_LOADS(b2, hh2, s2); if (last) MB_QLOADS(b2, hh2, nb2); }
        { const LAS bf16* kb = (const LAS bf16*)(F.lds + TBL + pb * 2 * ATILE); const LAS bf16* vb = kb + 64 * AKP;
          const int qpos = nb * 256 + 32 * w + q;
          const LAS float* ba = bt + (2056 - (32 + (qpos - 8 * h - 64 * s - 23)));
          const LAS float* negp = bt + 2048;
          bool act; const LAS float* p0; const LAS float* p1;
          if (s < 4 * nb) { const bool mine = (sel >> (s >> 2)) & 1u; act = __ballot(mine) != 0ull; p0 = mine ? ba : negp; p1 = mine ? ba + 32 : negp; }
          else { const int ta = (s - 4 * nb) * 2; act = ta <= w; p0 = ba; p1 = (ta + 1 <= w) ? ba + 32 : negp; }
          if (act) attn_tile2r(kb, vb, p0, p1, qf, st, q, h); }
        if (more) MB_WRITE(pb ^ 1);
        if (last) {
            const float l_tot = xhalf_sum(st.l), inv = 1.f / l_tot;
            const size_t tq = (size_t)b * SEQ + nb * 256 + 32 * w + q;
            attn_store8(st, (unsigned char*)att + tq * 1024 + hh * 64 + 4 * h, inv * ASCALE8);
            st.m = NEGB; st.l = 0.f; st.o0 = (f32x16){}; st.o1 = (f32x16){};
        }
        if (!last) __syncthreads();
        pb ^= 1;
        if (!more) break;
        if (last) { ++u; fresh = true; }
        nb = nb2; b = b2; hh = hh2; s = s2;
    }
#undef MB_LOADS
#undef MB_QLOADS
#undef MB_WRITE
}

__device__ __forceinline__ void gmlp_phase(Frame& F, const float* lng, const float* lnb, const float* bs) {
    const int lane = F.lane, w = F.wave, q = lane & 31, h = lane >> 5;
    const bf16* uv = (const bf16*)(F.ws + WS_SCR + S_UV); bf16* p = (bf16*)(F.ws + WS_SCR + S_P); const bf16* wst = (const bf16*)(F.ws + WS_WST);
    LAS float* stat = (LAS float*)F.lds;
    LAS bf16* vnT = (LAS bf16*)(F.lds + 1024);
    constexpr int VP = 136;
    for (int unit = F.vcu; unit < T / 128; unit += F.G) {
        const size_t t0 = (size_t)unit * 128;
        __syncthreads();
        for (int i = 0; i < 16; ++i) { const int r = w * 16 + i; const u32x4* vr = (const u32x4*)(uv + (t0 + r) * 2048 + 1024) + lane;
            const u32x4 a = vr[0], b = vr[64]; float x[16];
            x[0] = bflo(a.x); x[1] = bfhi(a.x); x[2] = bflo(a.y); x[3] = bfhi(a.y); x[4] = bflo(a.z); x[5] = bfhi(a.z); x[6] = bflo(a.w); x[7] = bfhi(a.w);
            x[8] = bflo(b.x); x[9] = bfhi(b.x); x[10] = bflo(b.y); x[11] = bfhi(b.y); x[12] = bflo(b.z); x[13] = bfhi(b.z); x[14] = bflo(b.w); x[15] = bfhi(b.w);
            float s = 0.f;
#pragma unroll
            for (int j = 0; j < 16; ++j) s += x[j];
            const float mean = wave_sum(s) * (1.f / 1024.f); float s2 = 0.f;
#pragma unroll
            for (int j = 0; j < 16; ++j) { const float d = x[j] - mean; s2 += d * d; }
            const float rstd = 1.f / sqrtf(wave_sum(s2) * (1.f / 1024.f) + LN_EPS);
            if (lane == 0) { stat[2 * r] = mean; stat[2 * r + 1] = rstd; } }
        __syncthreads();
        for (int gg = 0; gg < 8; ++gg) {
#pragma unroll
            for (int k = 0; k < 4; ++k) { const int id = F.tid + 512 * k, s = id >> 4, cc = (id & 15) * 8;
                const u32x4 a = *(const u32x4*)(uv + (t0 + s) * 2048 + 1024 + gg * 128 + cc); const float mean = stat[2 * s], rstd = stat[2 * s + 1];
                float x[8]; x[0] = bflo(a.x); x[1] = bfhi(a.x); x[2] = bflo(a.y); x[3] = bfhi(a.y); x[4] = bflo(a.z); x[5] = bfhi(a.z); x[6] = bflo(a.w); x[7] = bfhi(a.w);
#pragma unroll
                for (int j = 0; j < 8; ++j) { const int c = gg * 128 + cc + j; const float y = (x[j] - mean) * rstd * lng[c] + lnb[c]; vnT[(cc + j) * VP + s] = (bf16)f2bf(y); } }
            __syncthreads();
            const int cr = 32 * (w & 3), tc0 = 64 * (w >> 2);
            f32x16 acc0 = {}, acc1 = {};
#pragma unroll
            for (int ks = 0; ks < 8; ++ks) {
                const bf16x8 af = *(const LAS bf16x8*)(vnT + (cr + q) * VP + ks * 16 + 8 * h);
                const bf16x8 b0 = *(const bf16x8*)(wst + ((size_t)gg * 128 + tc0 + q) * 128 + ks * 16 + 8 * h);
                const bf16x8 b1 = *(const bf16x8*)(wst + ((size_t)gg * 128 + tc0 + 32 + q) * 128 + ks * 16 + 8 * h);
                acc0 = mfma32(af, b0, acc0); acc1 = mfma32(af, b1, acc1);
            }
#pragma unroll
            for (int tt = 0; tt < 2; ++tt) { const f32x16& ac = tt == 0 ? acc0 : acc1; const int tl = tc0 + 32 * tt + q; const float bsv = bs[gg * 128 + tl];
                const size_t rowu = (t0 + tl) * 2048, rowp = (t0 + tl) * 1024;
#pragma unroll
                for (int gq = 0; gq < 4; ++gq) { const int c = gg * 128 + cr + 8 * gq + 4 * h; const u32x2 uu = *(const u32x2*)(uv + rowu + c);
                    u32x2 o; o.x = pk2(bflo(uu.x) * (ac[4 * gq] + bsv), bfhi(uu.x) * (ac[4 * gq + 1] + bsv)); o.y = pk2(bflo(uu.y) * (ac[4 * gq + 2] + bsv), bfhi(uu.y) * (ac[4 * gq + 3] + bsv));
                    *(u32x2*)(p + rowp + c) = o; } }
            __syncthreads();
        }
    }
}

struct MoeSeg { int ts[9]; };
__device__ __forceinline__ MoeSeg moe_seg(Frame& F, int moe_l) {
    MoeSeg s; int acc = 0;
#pragma unroll
    for (int e = 0; e < 8; ++e) { s.ts[e] = acc; const unsigned c = __hip_atomic_load((unsigned*)(F.ctl + CW_ECNT + 64 * moe_l + e), RLX_AGENT); acc += (int)((c + 255u) >> 8); }
    s.ts[8] = acc; return s;
}
__device__ __forceinline__ void moe_gather_phase(Frame& F, int moe_l) {
    LAS int* P = (LAS int*)F.lds;
    LAS int* wtot = (LAS int*)(F.lds + 65536);
    LAS int* tot = wtot + 64;
    const int* wcnt = (const int*)(F.ws + WS_WCNT);
    int t = F.tid; asm volatile("" : "+v"(t));
    const int lane = F.lane;
    int loc[4][8], sum[8], inc[8];
#pragma unroll
    for (int k = 0; k < 4; ++k) { const u32x4 a = *(const u32x4*)(wcnt + (4 * t + k) * 8), b = *(const u32x4*)(wcnt + (4 * t + k) * 8 + 4);
        loc[k][0] = (int)a.x; loc[k][1] = (int)a.y; loc[k][2] = (int)a.z; loc[k][3] = (int)a.w; loc[k][4] = (int)b.x; loc[k][5] = (int)b.y; loc[k][6] = (int)b.z; loc[k][7] = (int)b.w; }
#pragma unroll
    for (int e = 0; e < 8; ++e) { sum[e] = (loc[0][e] + loc[1][e]) + (loc[2][e] + loc[3][e]); inc[e] = sum[e]; }
#pragma unroll
    for (int off = 1; off < 64; off <<= 1) {
#pragma unroll
        for (int e = 0; e < 8; ++e) { const int v = __shfl_up(inc[e], off); if (lane >= off) inc[e] += v; } }
    if (lane == 63) {
#pragma unroll
        for (int e = 0; e < 8; ++e) wtot[F.wave * 8 + e] = inc[e]; }
    __syncthreads();
    int run[8];
#pragma unroll
    for (int e = 0; e < 8; ++e) { int wb = 0; for (int w = 0; w < F.wave; ++w) wb += wtot[w * 8 + e]; run[e] = wb + inc[e] - sum[e]; }
#pragma unroll
    for (int k = 0; k < 4; ++k) {
#pragma unroll
        for (int e = 0; e < 8; ++e) { P[(4 * t + k) * 8 + e] = run[e]; run[e] += loc[k][e]; } }
    if (t == 511) {
#pragma unroll
        for (int e = 0; e < 8; ++e) tot[e] = run[e]; }
    __syncthreads();
    MoeSeg sg; { int acc = 0;
#pragma unroll
        for (int e = 0; e < 8; ++e) { sg.ts[e] = acc; acc += (tot[e] + 255) >> 8; } sg.ts[8] = acc; }
    if (blockIdx.x == 0 && t < 8) __hip_atomic_store((unsigned*)(F.ctl + CW_ECNT + 64 * moe_l + t), (unsigned)tot[t], RLX_AGENT);
    const int gw = F.vcu * NWAVES + F.wave, NGW = F.G * NWAVES;
    const bf16* hb = (const bf16*)(F.ws + WS_HB); unsigned char* xg8 = (unsigned char*)F.out;
    const int* route = (const int*)(F.ws + WS_ROUTE); int* slots = (int*)(F.ws + WS_SLOTS);
    for (int m0 = 4 * gw; m0 < T; m0 += 4 * NGW) {
        int s1[4], s2[4]; u32x4 a[4], b[4];
#pragma unroll
        for (int k = 0; k < 4; ++k) { const int m = m0 + k, grp = m >> 5;
            const int e1 = route[4 * m], p1 = route[4 * m + 1], e2 = route[4 * m + 2], p2 = route[4 * m + 3];
            int ts1 = 0, ts2 = 0;
#pragma unroll
            for (int e = 0; e < 8; ++e) { ts1 = e == e1 ? sg.ts[e] : ts1; ts2 = e == e2 ? sg.ts[e] : ts2; }
            s1[k] = ts1 * 256 + P[grp * 8 + e1] + p1; s2[k] = ts2 * 256 + P[grp * 8 + e2] + p2;
            const u32x4* src = (const u32x4*)(hb + (size_t)m * D) + lane; a[k] = src[0]; b[k] = src[64]; }
#pragma unroll
        for (int k = 0; k < 4; ++k) { const int m = m0 + k;
            float x[16]; unpack8(a[k], x); unpack8(b[k], x + 8);
            u32x2 lo, hi; lo.x = pk4_fp8(x[0], x[1], x[2], x[3]); lo.y = pk4_fp8(x[4], x[5], x[6], x[7]); hi.x = pk4_fp8(x[8], x[9], x[10], x[11]); hi.y = pk4_fp8(x[12], x[13], x[14], x[15]);
            unsigned char* d1 = xg8 + (size_t)s1[k] * D + 8 * lane; unsigned char* d2 = xg8 + (size_t)s2[k] * D + 8 * lane;
            *(u32x2*)d1 = lo; *(u32x2*)(d1 + 512) = hi; *(u32x2*)d2 = lo; *(u32x2*)(d2 + 512) = hi;
            if (lane == 0) { slots[2 * m] = s1[k]; slots[2 * m + 1] = s2[k]; } }
    }
}
struct MoeOrder {
    int nM, nN, G, c, tile0; MoeSeg sg; const char* A0; const char* B0; size_t aT, bE, bT; bool a_local;
    bool out_local;
    __device__ __forceinline__ bool next(int i, pg8::Unit& u) const {
        int pm, pn; if (!pg8::tile_of((long)i * G + c, nM, nN, pm, pn)) return false;
        if (a_local) pm = nM - 1 - pm;
        const int tile = tile0 + pm; int e = 0;
#pragma unroll
        for (int k = 1; k < 8; ++k) e += (tile >= sg.ts[k]) ? 1 : 0;
        u.pm = out_local ? pm : tile; u.pn = pn; u.a = (unsigned)((size_t)(a_local ? pm : tile) * aT); u.b = (unsigned)((size_t)e * bE + (size_t)pn * bT); return true;
    }
};


template <int GI> struct L0QKOrder { int G, c; const char* A0; const char* B0;
    __device__ __forceinline__ bool next(int i, pg8::Unit& u) const { if (!pg8::tile_of((long)i * G + c, 64, 8, u.pm, u.pn)) return false; const int pm = u.pm;
        const int tok = GI == 0 ? pm * 256 : (GI == 1 ? (pm >> 3) * 2048 + (pm & 1) * 1024 + ((pm >> 1) & 3) : (pm >> 3) * 2048 + (pm & 7) * 2);
        u.a = (unsigned)tok * 1024u; u.b = (unsigned)u.pn * 256u * 1024u; return true; } };
template <int GI> struct L0VtOrder { int G, c; const char* A0; const char* B0;
    __device__ __forceinline__ bool next(int i, pg8::Unit& u) const { if (!pg8::tile_of((long)i * G + c, 4, 64, u.pm, u.pn)) return false; const int pn = u.pn;
        const int tok = GI == 0 ? pn * 256 : (GI == 1 ? (pn >> 3) * 2048 + (pn & 1) * 1024 + ((pn >> 1) & 3) : (pn >> 3) * 2048 + (pn & 7) * 2);
        u.a = (unsigned)u.pm * 256u * 1024u; u.b = (unsigned)tok * 1024u; return true; } };
template <int GI> __device__ __forceinline__ void l0_gemms(Frame& F, int ck, int bx) {
    constexpr int rs = GI == 0 ? 1 : (GI == 1 ? 4 : 16);
    constexpr size_t hst = (GI == 0 ? (size_t)128 : (GI == 1 ? (size_t)512 : (size_t)1)) * 1024;
    const char* hbc = (const char*)(F.ws + WS_SCR + S_HB8) + (size_t)ck * TC * 1024;
    unsigned char* scr = F.ws + WS_SCR;
    { L0QKOrder<GI> S{F.G, bx, hbc, (const char*)(F.ws + W_A_QK) + (size_t)GI * 2048 * 1024};
      pg8::Gemm gm{512, rs, 1, hst, (size_t)128 * 1024};
      pg8::EpiF8 E{scr + S_QK + (size_t)GI * TC * 2048, 2048, 1.f / WSCALE8};
      pg8::gemm_phase<pg8::EpiF8, L0QKOrder<GI>, false, 1>(F.lds, F.wave, gm, S, E); }
    { L0VtOrder<GI> S{F.G, bx, (const char*)(F.ws + W_A_V) + (size_t)GI * 1024 * 1024, hbc};
      pg8::Gemm gm{512, 1, rs, (size_t)128 * 1024, hst};
      pg8::EpiF8 E{scr + S_VT + (size_t)GI * 1024 * TC, TC, 1.f / WSCALE8};
      pg8::gemm_phase<pg8::EpiF8, L0VtOrder<GI>, false, 1>(F.lds, F.wave, gm, S, E); }
}


#ifdef MK_SELFCHECK
__device__ __forceinline__ void selfcheck_buf(Frame& F, const void* ptr, size_t nbytes, int stage, int slot0) {
    if (!F.chk) return;
    const int gw = F.vcu * NWAVES + F.wave, NGW = F.G * NWAVES; unsigned* cks = (unsigned*)(F.ws + WS_NEED + 2 * MiB) + slot0;
    const int nch = (int)(nbytes >> 12);
    for (int c = gw; c < nch; c += NGW) { const u32x4* r = (const u32x4*)((const char*)ptr + ((size_t)c << 12)) + F.lane; unsigned x = 0;
#pragma unroll
        for (int j = 0; j < 4; ++j) { const u32x4 v = r[64 * j]; x ^= v.x * 3u + v.y * 5u + v.z * 7u + v.w * 11u + (unsigned)j; }
        x *= (unsigned)(2 * F.lane + 1);
#pragma unroll
        for (int o = 1; o < 64; o <<= 1) x ^= __shfl_xor(x, o);
        if (F.lane == 0) { if (F.chk == 1) cks[c] = x; else if (cks[c] != x) atomicMax((unsigned*)(F.ctl + 32), (unsigned)(1000 - stage)); } }
}
#endif

__global__ void __launch_bounds__(NWAVES * 64, 2) mk_fwd(Args args) {
    extern __shared__ __attribute__((aligned(16))) unsigned char lds[];
    Frame F;
    F.lds = (LAS unsigned char*)lds;
    F.tid = threadIdx.x; F.lane = F.tid & 63; F.wave = __builtin_amdgcn_readfirstlane(F.tid >> 6);
    F.G = gridDim.x; { const int bx = blockIdx.x; F.vcu = (F.G % 8 == 0) ? (bx % 8) * (F.G / 8) + bx / 8 : bx; }
    F.ws = args.ws; F.ctl = (gu32*)(args.ws + WS_CTL); F.out = args.out; F.chk = args.chk; F.stage = 0;
    volatile LAS unsigned* MISC = (volatile LAS unsigned*)(F.lds + MISC_OFF);
    for (int u = F.tid; u < (LDS_BYTES - RING_BYTES) / 4; u += NWAVES * 64) ((LAS unsigned*)(F.lds + RING_BYTES))[u] = 0u;
    __syncthreads();
    XcdBarrier bar; bar.bar = (unsigned*)(F.ctl + CW_BAR); bar.x = 0; bar.st = nullptr;
    if (!MK_MULTI) bar = xcd_barrier_post((unsigned*)(F.ctl + CW_BAR), MISC + 8);
    const int lo = args.ph_lo, hi = args.ph_hi;
    int ph = 0;
#define PHASE_BEGIN if (ph >= lo && ph < hi) { F.lane = (int)__builtin_amdgcn_mbcnt_hi(~0u, __builtin_amdgcn_mbcnt_lo(~0u, 0u)); asm volatile("" : "+v"(F.lane)); F.tid = F.wave * 64 + F.lane;
#define PHASE_END   if (!MK_MULTI && ph + 1 < hi) xcd_barrier(bar, F.tid); } ++ph;
    const int bx = (int)blockIdx.x;
#define scr (args.ws + WS_SCR)
#define hb ((const bf16*)(args.ws + WS_HB))
#define ln_g (args.in[2])
#define ln_b (args.in[3])

    PHASE_BEGIN p_prologue(F, args); if (MK_PROBE & 8) p_prologue(F, args); PHASE_END

    if (MK_ENABLE & 1) {
#define L0_CHUNK(ck) \
        PHASE_BEGIN \
        if ((ck) > 0) dil_merge_phase(F, (ck) - 1); \
        l0_gemms<0>(F, (ck), bx); l0_gemms<1>(F, (ck), bx); l0_gemms<2>(F, (ck), bx); \
        PHASE_END \
        PHASE_BEGIN dil_attn_phase3(F); if (MK_PROBE & 1) dil_attn_phase3(F); PHASE_END
        L0_CHUNK(0) L0_CHUNK(1) L0_CHUNK(2) L0_CHUNK(3)
#undef L0_CHUNK
        PHASE_BEGIN dil_merge_phase(F, 3); if (MK_PROBE & 4) { dil_merge_phase(F, 3); dil_merge_phase(F, 3); dil_merge_phase(F, 3); dil_merge_phase(F, 3); } PHASE_END
        PHASE_BEGIN
        { pg8::LinOrder S{T / 256, 4, F.G, bx, (const char*)(scr + S_ATT), (const char*)(F.ws + W_A_O), (size_t)256 * 1024, (size_t)256 * 1024};
          pg8::Gemm gm{512, 1, 1, (size_t)128 * 1024, (size_t)128 * 1024};
          pg8::EpiResLn<FFN_GU8 == 0> E{(bf16*)(F.ws + WS_HB), ln_g + 0 * 2048, ln_b + 0 * 2048, ALPHA, 1.f / (WSCALE8 * ASCALE8), (float*)scr, (unsigned*)(F.ctl + CW_LNC + 0 * 4096), (unsigned*)(F.ctl + CW_BAR) + XB_TMO, scr + S_HB8, F.lds + LNT_OFF};
          pg8::gemm_phase<pg8::EpiResLn<FFN_GU8 == 0>, pg8::LinOrder, true, 1>(F.lds, F.wave, gm, S, E); }
        PHASE_END
    } else {
        PHASE_BEGIN ln_phase<1, false, false>(F, ln_g + 0 * 2048, ln_b + 0 * 2048, nullptr); PHASE_END
    }
#define DENSE_FFN(f, lnidx, enbit) \
    if (MK_ENABLE & (enbit)) { \
        PHASE_BEGIN \
        if ((f) == FFN_GU8) { \
          pg8::LinOrder S{T / 256, 2 * DFF / 256, F.G, bx, (const char*)(scr + S_HB8), (const char*)(F.ws + W_F_GU) + (size_t)(f) * 2 * DFF * 2048, (size_t)256 * 1024, (size_t)256 * 1024}; \
          pg8::Gemm gm{512, 1, 1, (size_t)128 * 1024, (size_t)128 * 1024};     \
          pg8::EpiSwiglu8 E{(unsigned char*)(scr + S_HID), DFF, 1.f / WSCALE8}; \
          pg8::gemm_phase<pg8::EpiSwiglu8, pg8::LinOrder, true, 1>(F.lds, F.wave, gm, S, E); \
        } else { pg8::LinOrder S{T / 256, 2 * DFF / 256, F.G, bx, (const char*)hb, (const char*)(F.ws + W_F_GU) + (size_t)(f) * 2 * DFF * 2048, (size_t)256 * 2048, (size_t)256 * 2048}; \
          pg8::Gemm gm{1024, 1, 1, (size_t)128 * 2048, (size_t)128 * 2048}; \
          pg8::EpiSwiglu8 E{(unsigned char*)(scr + S_HID), DFF}; \
          pg8::gemm_phase(F.lds, F.wave, gm, S, E); } \
        PHASE_END \
        PHASE_BEGIN \
        { pg8::LinOrder S{T / 256, 4, F.G, bx, (const char*)(scr + S_HID), (const char*)(F.ws + W_F_D) + (size_t)(f) * 1024 * DFF * 2, (size_t)256 * DFF, (size_t)256 * DFF}; \
          pg8::Gemm gm{DFF / 2, 1, 1, (size_t)128 * DFF, (size_t)128 * DFF};     \
          pg8::EpiResLn<false> E{(bf16*)(F.ws + WS_HB), ln_g + (lnidx) * 1024, ln_b + (lnidx) * 1024, ALPHA, 1.f / WSCALE8D, (float*)(scr + S_Y), (unsigned*)(F.ctl + CW_LNC + (2 + (f)) * 4096), (unsigned*)(F.ctl + CW_BAR) + XB_TMO, nullptr, F.lds + LNT_OFF}; \
          pg8::gemm_phase<pg8::EpiResLn<false>, pg8::LinOrder, true, 1>(F.lds, F.wave, gm, S, E); }     \
        PHASE_END \
    } else { \
        PHASE_BEGIN ln_phase<1, false, false>(F, ln_g + (lnidx) * 1024, ln_b + (lnidx) * 1024, nullptr); PHASE_END \
    }
    DENSE_FFN(0, 1, 2)

    if (MK_ENABLE & 4) {
        PHASE_BEGIN
        { pg8::LinOrder S{T / 256, 4, F.G, bx, (const char*)hb, (const char*)(F.ws + W_B_IN), (size_t)256 * 2048, (size_t)256 * 2048};
          pg8::Gemm gm{1024, 1, 1, (size_t)128 * 2048, (size_t)128 * 2048};
          pg8::EpiBf16<0> E{(bf16*)(scr + S_BCX), 1024};
          pg8::gemm_phase(F.lds, F.wave, gm, S, E); }
        { pg8::LinOrder S{T / 256, 8, F.G, bx, (const char*)hb, (const char*)(F.ws + W_B_IN) + (size_t)1024 * 2048, (size_t)256 * 2048, (size_t)256 * 2048};
          pg8::Gemm gm{1024, 1, 1, (size_t)128 * 2048, (size_t)128 * 2048};
          pg8::EpiGlu<0> E{(bf16*)(scr + S_BCX + (size_t)128 * MiB), 1024};
          pg8::gemm_phase(F.lds, F.wave, gm, S, E); }
        PHASE_END
        PHASE_BEGIN conv_phase(F, args.in[7]); if (MK_PROBE & 4) conv_phase(F, args.in[7]); PHASE_END
        PHASE_BEGIN
        { pg8::LinOrder S{T / 256, 4, F.G, bx, (const char*)(scr + S_P), (const char*)(F.ws + W_B_O), (size_t)256 * 2048, (size_t)256 * 2048};
          pg8::Gemm gm{1024, 1, 1, (size_t)128 * 2048, (size_t)128 * 2048};
          pg8::EpiResBf16 E{hb, (bf16*)F.out, 1024, ALPHA};
          pg8::gemm_phase(F.lds, F.wave, gm, S, E); }
        PHASE_END
        PHASE_BEGIN ln_phase<0, true, false>(F, ln_g + 2 * 1024, ln_b + 2 * 1024, args.in[20]); PHASE_END
    } else {
        PHASE_BEGIN ln_phase<1, true, false>(F, ln_g + 2 * 1024, ln_b + 2 * 1024, args.in[20]); PHASE_END
    }
#define MOE_CHUNK(f, ck) \
        PHASE_BEGIN \
        { const MoeSeg sg = moe_seg(F, (f)); int nM = sg.ts[8] - (ck) * MOE_CH_TILES; nM = nM > MOE_CH_TILES ? MOE_CH_TILES : (nM < 0 ? 0 : nM); \
          MoeOrder S{nM, 2 * DFE / 256, F.G, bx, (ck) * MOE_CH_TILES, sg, (const char*)F.out, (const char*)(F.ws + W_E_GU) + (size_t)(f) * 8 * 2 * DFE * 2048, (size_t)256 * 1024, (size_t)2 * DFE * 2048, (size_t)256 * 1024, false, true}; \
          pg8::Gemm gm{512, 1, 1, (size_t)128 * 1024, (size_t)128 * 1024};     \
          pg8::EpiSwiglu8 E{(unsigned char*)(scr + S_MHID), DFE, 1.f / WSCALE8}; \
          pg8::gemm_phase<pg8::EpiSwiglu8, MoeOrder, true, 0x7C>(F.lds, F.wave, gm, S, E);     if ((ck) == 0 && (MK_PROBE & 32)) pg8::gemm_phase(F.lds, F.wave, gm, S, E); } \
        PHASE_END \
        PHASE_BEGIN \
        { const MoeSeg sg = moe_seg(F, (f)); int nM = sg.ts[8] - (ck) * MOE_CH_TILES; nM = nM > MOE_CH_TILES ? MOE_CH_TILES : (nM < 0 ? 0 : nM); \
          MoeOrder S{nM, 4, F.G, bx, (ck) * MOE_CH_TILES, sg, (const char*)(scr + S_MHID), (const char*)(F.ws + W_E_D) + (size_t)(f) * 8 * 1024 * DFE * 2, (size_t)256 * DFE, (size_t)1024 * DFE * 2, (size_t)256 * DFE, true, false}; \
          pg8::Gemm gm{DFE / 2, 1, 1, (size_t)128 * DFE, (size_t)128 * DFE};     \
          pg8::EpiF8 E{scr + S_XG, 1024, YSCALE8 / WSCALE8D};     \
          pg8::gemm_phase<pg8::EpiF8, MoeOrder, true, 0x7B>(F.lds, F.wave, gm, S, E);     if ((ck) == 0 && (MK_PROBE & 64)) pg8::gemm_phase(F.lds, F.wave, gm, S, E); } \
        PHASE_END
#define MOE_FFN(f, lnidx, enbit, fin) \
    if (MK_ENABLE & (enbit)) { \
        PHASE_BEGIN moe_gather_phase(F, (f)); if (MK_PROBE & 4) moe_gather_phase(F, (f)); PHASE_END \
        MOE_CHUNK(f, 0) MOE_CHUNK(f, 1) MOE_CHUNK(f, 2) \
        PHASE_BEGIN ln_phase<2, false, fin, (f) == 0>(F, ln_g + (lnidx) * 1024, ln_b + (lnidx) * 1024, nullptr); PHASE_END \
    } else { \
        PHASE_BEGIN ln_phase<1, false, fin>(F, ln_g + (lnidx) * 1024, ln_b + (lnidx) * 1024, nullptr); PHASE_END \
    }
    MOE_FFN(0, 3, 8, false)

    if (MK_ENABLE & 16) {
        PHASE_BEGIN
        { pg8::LinOrder S{T / 256, 8, F.G, bx, (const char*)hb, (const char*)(F.ws + W_C_QK), (size_t)256 * 2048, (size_t)256 * 2048};
          pg8::Gemm gm{1024, 1, 1, (size_t)128 * 2048, (size_t)128 * 2048};
          pg8::EpiBf16<0> E{(bf16*)(scr + S_CQK), 2048};
          pg8::gemm_phase(F.lds, F.wave, gm, S, E); }
        { pg8::LinOrder S{4, T / 256, F.G, bx, (const char*)(F.ws + W_C_V), (const char*)(scr + S_HB8), (size_t)256 * 1024, (size_t)256 * 1024};
          pg8::Gemm gm{512, 1, 1, (size_t)128 * 1024, (size_t)128 * 1024};
          pg8::EpiBf16<0> E{(bf16*)(scr + S_CVT), T, 1.f / WSCALE8};
          pg8::gemm_phase<pg8::EpiBf16<0>, pg8::LinOrder, true, 1>(F.lds, F.wave, gm, S, E); }
        PHASE_END
#ifdef MK_SELFCHECK
        PHASE_BEGIN selfcheck_buf(F, scr + S_CQK, (size_t)256 * MiB, 40, 0); selfcheck_buf(F, scr + S_CVT, (size_t)128 * MiB, 41, 65536); PHASE_END
#endif
        PHASE_BEGIN kmean_phase(F); if (MK_PROBE & 4) kmean_phase(F); PHASE_END
#ifdef MK_SELFCHECK
        PHASE_BEGIN selfcheck_buf(F, F.ws + WS_KMEAN, (size_t)1 * MiB, 42, 65536 + 32768); PHASE_END
#endif
        PHASE_BEGIN moba_phase3(F); if (MK_PROBE & 2) moba_phase3(F); PHASE_END
#ifdef MK_SELFCHECK
        PHASE_BEGIN selfcheck_buf(F, F.ws + WS_NEED + 3 * MiB, (size_t)4 * MiB, 43, 65536 + 32768 + 256); selfcheck_buf(F, F.ws + WS_NEED + 7 * MiB, (size_t)4 * MiB, 44, 65536 + 32768 + 256 + 1024);
                    selfcheck_buf(F, scr + S_CATT, (size_t)128 * MiB, 45, 65536 + 32768 + 256 + 2048); PHASE_END
#endif
        PHASE_BEGIN
        { pg8::LinOrder S{T / 256, 4, F.G, bx, (const char*)(scr + S_CATT), (const char*)(F.ws + W_C_O), (size_t)256 * 1024, (size_t)256 * 1024};
          pg8::Gemm gm{512, 1, 1, (size_t)128 * 1024, (size_t)128 * 1024};
          pg8::EpiResLn<FFN_GU8 == 1> E{(bf16*)(F.ws + WS_HB), ln_g + 4 * 1024, ln_b + 4 * 1024, ALPHA, 1.f / (WSCALE8 * ASCALE8), (float*)scr, (unsigned*)(F.ctl + CW_LNC + 1 * 4096), (unsigned*)(F.ctl + CW_BAR) + XB_TMO, scr + S_HB8, F.lds + LNT_OFF};
          pg8::gemm_phase<pg8::EpiResLn<FFN_GU8 == 1>, pg8::LinOrder, true, 1>(F.lds, F.wave, gm, S, E); }
        PHASE_END
    } else {
        PHASE_BEGIN ln_phase<1, false, false>(F, ln_g + 4 * 1024, ln_b + 4 * 1024, nullptr); PHASE_END
    }
    DENSE_FFN(1, 5, 32)

    if (MK_ENABLE & 64) {
        PHASE_BEGIN
        { pg8::LinOrder S{T / 256, 8, F.G, bx, (const char*)hb, (const char*)(F.ws + W_D_IN), (size_t)256 * 2048, (size_t)256 * 2048};
          pg8::Gemm gm{1024, 1, 1, (size_t)128 * 2048, (size_t)128 * 2048};
          pg8::EpiBf16<1> E{(bf16*)(scr + S_UV), 2048};
          pg8::gemm_phase(F.lds, F.wave, gm, S, E); }
        PHASE_END
        PHASE_BEGIN gmlp_phase(F, args.in[12], args.in[13], args.in[15]); if (MK_PROBE & 4) gmlp_phase(F, args.in[12], args.in[13], args.in[15]); PHASE_END
        PHASE_BEGIN
        { pg8::LinOrder S{T / 256, 4, F.G, bx, (const char*)(scr + S_P), (const char*)(F.ws + W_D_O), (size_t)256 * 2048, (size_t)256 * 2048};
          pg8::Gemm gm{1024, 1, 1, (size_t)128 * 2048, (size_t)128 * 2048};
          pg8::EpiResBf16 E{hb, (bf16*)F.out, 1024, ALPHA};
          pg8::gemm_phase(F.lds, F.wave, gm, S, E); }
        PHASE_END
        PHASE_BEGIN ln_phase<0, true, false>(F, ln_g + 6 * 1024, ln_b + 6 * 1024, args.in[20] + 8192); PHASE_END
    } else {
        PHASE_BEGIN ln_phase<1, true, false>(F, ln_g + 6 * 1024, ln_b + 6 * 1024, args.in[20] + 8192); PHASE_END
    }
    MOE_FFN(1, 7, 128, true)
#ifdef MK_SELFCHECK
    PHASE_BEGIN
    { const unsigned fl = __hip_atomic_load((unsigned*)(F.ctl + 32), RLX_AGENT);
      if (fl != 0u) { const int code = 1000 - (int)fl; const float cval = (code >= 40 && code <= 45) ? (float)(20 + 2 * (code - 40)) : (float)(1u << (code / 10 + 1)); const int gw = F.vcu * NWAVES + F.wave, NGW = F.G * NWAVES;
          for (int m = gw; m < T; m += NGW) { f32x4* w = (f32x4*)(F.out + (size_t)m * D) + F.lane;
#pragma unroll
              for (int j = 0; j < 4; ++j) w[64 * j] = (f32x4){cval, cval, cval, cval}; } } }
    PHASE_END
#endif
#undef PHASE_BEGIN
#undef PHASE_END
#undef scr
#undef hb
#undef ln_g
#undef ln_b
}

static int count_phases() {
    int n = 1;
    n += (MK_ENABLE & 1) ? (8 + 1 + 1) : 1;
    n += (MK_ENABLE & 2) ? 2 : 1;
    n += (MK_ENABLE & 4) ? 4 : 1;
    n += (MK_ENABLE & 8) ? 8 : 1;
    n += (MK_ENABLE & 16) ? 4 : 1;
    n += (MK_ENABLE & 32) ? 2 : 1;
    n += (MK_ENABLE & 64) ? 4 : 1;
    n += (MK_ENABLE & 128) ? 8 : 1;
#ifdef MK_SELFCHECK
    n += 1 + 3;
#endif
    return n;
}
extern "C" void kernel_launch(void* const* d_in, const int* in_sizes, int n_in, void* d_out, int out_size, void* d_ws, size_t ws_size, hipStream_t stream) {
    static int grid = 0;
    if (grid == 0) {
        if (n_in != 24 || in_sizes[0] != T * D || out_size != T * D || ws_size < WS_NEED) { fprintf(stderr, "kernel_launch: unexpected shapes (n_in %d, in0 %d, out %d, ws %zu < %zu); nothing launched\n", n_in, n_in > 0 ? in_sizes[0] : -1, out_size, ws_size, (size_t)WS_NEED); grid = -1; return; }
        int dev = 0, cus = 0, per_cu = 0;
        if (hipGetDevice(&dev) != hipSuccess || hipDeviceGetAttribute(&cus, hipDeviceAttributeMultiprocessorCount, dev) != hipSuccess) { grid = -1; return; }
        if (hipFuncSetAttribute((const void*)mk_fwd, hipFuncAttributeMaxDynamicSharedMemorySize, LDS_BYTES) != hipSuccess) { fprintf(stderr, "kernel_launch: hipFuncSetAttribute failed\n"); grid = -1; return; }
        if (hipOccupancyMaxActiveBlocksPerMultiprocessor(&per_cu, (const void*)mk_fwd, NWAVES * 64, LDS_BYTES) != hipSuccess || per_cu < 1) fprintf(stderr, "kernel_launch: occupancy query reports %d\n", per_cu);
        (void)hipGetLastError();
        grid = cus;
    }
    if (grid < 0) return;
    (void)hipMemsetAsync((char*)d_ws + WS_CTL, 0, CTL_ZERO_BYTES, stream);
#ifdef SELF_POISON
    (void)hipMemsetAsync((char*)d_ws + CTL_ZERO_BYTES, 0xAA, WS_NEED - CTL_ZERO_BYTES, stream);
    (void)hipMemsetAsync(d_out, 0xAA, (size_t)T * D * 4, stream);
#endif
    Args a{};
    for (int i = 0; i < 24; ++i) a.in[i] = (const float*)d_in[i];
    a.out = (float*)d_out; a.ws = (unsigned char*)d_ws;
    const int nph = count_phases();
#if MK_MULTI
    for (int p = 0; p < nph; ++p) { a.ph_lo = p; a.ph_hi = p + 1; hipLaunchKernelGGL(mk_fwd, dim3(grid), dim3(NWAVES * 64), LDS_BYTES, stream, a); }
#else
    a.ph_lo = 0; a.ph_hi = nph;
#ifdef MK_SELFCHECK
    a.chk = 1;
    hipLaunchKernelGGL(mk_fwd, dim3(grid), dim3(NWAVES * 64), LDS_BYTES, stream, a);
    (void)hipMemsetAsync((char*)d_ws + WS_CTL, 0, CTL_ZERO_BYTES, stream);
    a.chk = 2;
#endif
    hipLaunchKernelGGL(mk_fwd, dim3(grid), dim3(NWAVES * 64), LDS_BYTES, stream, a);
#endif
    const hipError_t le = hipPeekAtLastError();
    if (le != hipSuccess) fprintf(stderr, "kernel_launch: launch failed: %s\n", hipGetErrorName(le));
}
```

```cpp
#include <hip/hip_runtime.h>
#include <cstdio>
#include <cstdint>

#ifndef MK_MULTI
#define MK_MULTI 0
#endif
#ifndef MK_PROBE
#define MK_PROBE 0
#endif
#ifndef MK_ENABLE
#define MK_ENABLE 0xFF
#endif

#define GAS __attribute__((address_space(1)))
#define LAS __attribute__((address_space(3)))
typedef unsigned short bf16;
typedef short bf16x8 __attribute__((ext_vector_type(8)));
typedef float f32x4 __attribute__((ext_vector_type(4)));
typedef float f32x2 __attribute__((ext_vector_type(2)));
typedef float f32x16 __attribute__((ext_vector_type(16)));
typedef unsigned u32x4 __attribute__((ext_vector_type(4)));
typedef unsigned u32x2 __attribute__((ext_vector_type(2)));
typedef GAS unsigned gu32;
typedef int v8i_t __attribute__((ext_vector_type(8)));
typedef int v4i_t __attribute__((ext_vector_type(4)));
typedef short s16x16_t __attribute__((ext_vector_type(16)));

constexpr int D = 1024, NB = 32, SEQ = 2048, T = NB * SEQ, NH = 16, HD = 64;
constexpr int DFF = 2816, NE = 8, DFE = 3584;
constexpr float ALPHA = 1.6817928305074290f;
constexpr float LN_EPS = 1e-5f;
constexpr float LOG2E = 1.4426950408889634f;
constexpr float QSCALE = 0.125f * LOG2E;
constexpr float NEGB = -1e30f;
constexpr int TC = 16384;
constexpr int MOE_CH_TILES = 192;
constexpr int MOE_MAX_TILES = 520;
constexpr int FFN_GU8 = 1;

constexpr size_t MiB = 1u << 20;
constexpr size_t WS_CTL = 0, CTL_ZERO_BYTES = 1 * MiB;
constexpr size_t WS_BUCKET = 1 * MiB;
constexpr size_t WS_BTABA = WS_BUCKET + 8192;
constexpr size_t WS_BTABC = WS_BTABA + 32768;
constexpr size_t WS_WST = WS_BTABC + 131072;
constexpr size_t WS_KMEAN = 2 * MiB;
constexpr size_t WS_ROUTE = 4 * MiB;
constexpr size_t WS_GATES = 5 * MiB;
constexpr size_t WS_SLOTS = 6 * MiB;
constexpr size_t WS_WCNT = 7 * MiB;
constexpr size_t WS_W = 8 * MiB;
constexpr size_t W_A_QK = WS_W;
constexpr size_t W_A_V = W_A_QK + 12 * MiB;
constexpr size_t W_A_O = W_A_V + 6 * MiB;
constexpr size_t W_B_IN = W_A_O + 2 * MiB;
constexpr size_t W_B_O = W_B_IN + 6 * MiB;
constexpr size_t W_C_QK = W_B_O + 2 * MiB;
constexpr size_t W_C_V = W_C_QK + 4 * MiB;
constexpr size_t W_C_O = W_C_V + 2 * MiB;
constexpr size_t W_D_IN = W_C_O + 2 * MiB;
constexpr size_t W_D_O = W_D_IN + 4 * MiB;
constexpr size_t W_F_GU = W_D_O + 2 * MiB;
constexpr size_t W_F_D = W_F_GU + 22 * MiB;
constexpr size_t W_E_GU = W_F_D + 11 * MiB;
constexpr size_t W_E_D = W_E_GU + 224 * MiB;
constexpr size_t WS_HB = W_E_D + 112 * MiB;
constexpr size_t WS_SCR = WS_HB + 128 * MiB;
constexpr size_t WS_NEED = WS_SCR + 512 * MiB;
static_assert(WS_HB == 419 * MiB, "map");
constexpr size_t S_QK = 0;
constexpr size_t S_VT = 192 * MiB;
constexpr size_t S_HB8 = 448 * MiB;
constexpr size_t S_ATT = 288 * MiB;
constexpr size_t S_HID = 0;
constexpr size_t S_BCX = 0;
constexpr size_t S_P = 384 * MiB;
constexpr size_t S_XG = 0;
constexpr size_t S_MHID = 260 * MiB;
constexpr size_t S_Y = 256 * MiB;
constexpr size_t S_CQK = 0;
constexpr size_t S_CVT = 256 * MiB;
constexpr size_t S_CATT = 384 * MiB;
constexpr size_t S_UV = 0;
constexpr size_t O_OG = 0;
constexpr size_t O_LSE = 96 * MiB;
constexpr int CW_TMO = 0;
constexpr int CW_ECNT = 64;
constexpr int CW_BAR = 4096;
constexpr int CW_LNC = 16384;

constexpr float YSCALE8 = 16.f;
constexpr float ASCALE8 = 8.f;
constexpr float WSCALE8 = 64.f, WSCALE8D = 256.f;
__device__ __forceinline__ unsigned pk4_fp8(float a, float b, float c, float d) { int p = 0; p = __builtin_amdgcn_cvt_pk_fp8_f32(a, b, p, false); p = __builtin_amdgcn_cvt_pk_fp8_f32(c, d, p, true); return (unsigned)p; }
namespace pg8 {
constexpr int BM = 256, BK = 64, HALF = 128, HTB = HALF * BK * 2, STAGE_BYTES = 8 * HTB, NXCD = 8, WGM = 8;
__host__ __device__ __forceinline__ int lds_byte(int r, int c) { const int st = (r >> 4) * 2 + (c >> 5), rr = r & 15, cc = c & 31, ob = rr * 64 + cc * 2; return st * 1024 + (ob ^ (((ob >> 9) & 1) << 5)); }
__host__ __device__ __forceinline__ void stage_rc(int b, int& R, int& C) { const int st = b / 1024, sb = b % 1024, swz = sb ^ (((sb >> 9) & 1) << 5); R = (st >> 1) * 16 + swz / 64; C = (st & 1) * 32 + (swz % 64) / 2; }
__host__ __device__ __forceinline__ int perm32(int rho) { const int n = rho >> 4, i = rho & 15; return 8 * (i >> 2) + 4 * n + (i & 3); }

struct Unit { int pm, pn; unsigned a, b; };
struct Gemm { int K; int rsA, rsB; size_t hstepA, hstepB; };

__device__ __forceinline__ bool tile_of(long L, int nM, int nN, int& pm, int& pn) {
    const int nwg = nM * nN; if (L >= nwg) return false;
    int wgid = (int)L; { const int q = nwg / NXCD, r = nwg % NXCD, xcd = wgid % NXCD, off = wgid / NXCD; wgid = (xcd < r ? xcd * (q + 1) : r * (q + 1) + (xcd - r) * q) + off; }
    const int nig = WGM * nN, gid = wgid / nig, fm = gid * WGM, gsz = (nM - fm) < WGM ? (nM - fm) : WGM;
    pm = fm + ((wgid % nig) % gsz); pn = (wgid % nig) / gsz; return true;
}
struct LinOrder {
    int nM, nN, G, c; const char* A0; const char* B0; size_t aT, bT;
    __device__ __forceinline__ bool next(int i, Unit& u) const { if (!tile_of((long)i * G + c, nM, nN, u.pm, u.pn)) return false; u.a = (unsigned)((size_t)u.pm * aT); u.b = (unsigned)((size_t)u.pn * bT); return true; }
};

typedef __bf16 bf16x2_t __attribute__((ext_vector_type(2)));
__device__ __forceinline__ unsigned cvt_pk_bf16(float lo, float hi) { f32x2 v = {lo, hi}; bf16x2_t b = __builtin_convertvector(v, bf16x2_t); return __builtin_bit_cast(unsigned, b); }
__device__ __forceinline__ f32x2 gelu_pk(f32x2 v) {
    const f32x2 av = __builtin_elementwise_abs(v), d = av * 0.2316418882f + 1.0f;
    f32x2 t; t.x = __builtin_amdgcn_rcpf(d.x); t.y = __builtin_amdgcn_rcpf(d.y);
    f32x2 q = t * 0.5307027145f + (-0.7265760135f); q = q * t + 0.7107068705f; q = q * t + (-0.142248368f); q = q * t + 0.127414796f; q = q * t;
    const f32x2 s = (v * v) * (-0.72134752044f);
    f32x2 e; e.x = __builtin_amdgcn_exp2f(s.x); e.y = __builtin_amdgcn_exp2f(s.y);
    const f32x2 m = v * (q * e), r = v - m;
    f32x2 o; o.x = v.x < 0.f ? m.x : r.x; o.y = v.y < 0.f ? m.y : r.y; return o;
}
__device__ __forceinline__ float silu_f(float g) { return g * __builtin_amdgcn_rcpf(1.0f + __builtin_amdgcn_exp2f(-LOG2E * g)); }

template <int ACT  > struct EpiBf16 {
    static constexpr bool PERM = true;
    bf16* O; int ldc; float sc = 1.f;
    __device__ __forceinline__ void operator()(const f32x4 (&acc)[2][2][4][2], const Unit& u, int wr, int wc, int fr, int fq) const {
        const int row0 = u.pm * BM + wr * 64 + fr, col0 = u.pn * BM + wc * 32 + 8 * fq;
#pragma unroll
        for (int ai = 0; ai < 2; ++ai)
#pragma unroll
            for (int m = 0; m < 4; ++m) { bf16* rowp = O + (size_t)(row0 + ai * HALF + m * 16) * ldc + col0;
#pragma unroll
                for (int bj = 0; bj < 2; ++bj) { f32x4 v0 = acc[ai][bj][m][0] * sc, v1 = acc[ai][bj][m][1] * sc;
                    if (ACT == 1) { f32x2 a = gelu_pk((f32x2){v0[0], v0[1]}), b = gelu_pk((f32x2){v0[2], v0[3]}), c = gelu_pk((f32x2){v1[0], v1[1]}), d = gelu_pk((f32x2){v1[2], v1[3]});
                        v0 = (f32x4){a.x, a.y, b.x, b.y}; v1 = (f32x4){c.x, c.y, d.x, d.y}; }
                    u32x4 w; w.x = cvt_pk_bf16(v0[0], v0[1]); w.y = cvt_pk_bf16(v0[2], v0[3]); w.z = cvt_pk_bf16(v1[0], v1[1]); w.w = cvt_pk_bf16(v1[2], v1[3]);
                    *(u32x4*)(rowp + bj * HALF) = w; } }
    }
};
struct EpiF8 {
    static constexpr bool PERM = true;
    unsigned char* O; int ldc; float sc = 1.f;
    __device__ __forceinline__ void operator()(const f32x4 (&acc)[2][2][4][2], const Unit& u, int wr, int wc, int fr, int fq) const {
        const int row0 = u.pm * BM + wr * 64 + fr, col0 = u.pn * BM + wc * 32 + 8 * fq;
#pragma unroll
        for (int ai = 0; ai < 2; ++ai)
#pragma unroll
            for (int m = 0; m < 4; ++m) { unsigned char* rowp = O + (size_t)(row0 + ai * HALF + m * 16) * ldc + col0;
#pragma unroll
                for (int bj = 0; bj < 2; ++bj) { const f32x4 v0 = acc[ai][bj][m][0] * sc, v1 = acc[ai][bj][m][1] * sc;
                    u32x2 w; w.x = pk4_fp8(v0[0], v0[1], v0[2], v0[3]); w.y = pk4_fp8(v1[0], v1[1], v1[2], v1[3]);
                    *(u32x2*)(rowp + bj * HALF) = w; } }
    }
};
template <int ACT  > struct EpiGlu {
    static constexpr bool PERM = true;
    bf16* O; int ldc;
    __device__ __forceinline__ void operator()(const f32x4 (&acc)[2][2][4][2], const Unit& u, int wr, int wc, int fr, int fq) const {
        const int row0 = u.pm * BM + wr * 64 + fr, col0 = u.pn * HALF + wc * 32 + 8 * fq;
#pragma unroll
        for (int ai = 0; ai < 2; ++ai)
#pragma unroll
            for (int m = 0; m < 4; ++m) { bf16* rowp = O + (size_t)(row0 + ai * HALF + m * 16) * ldc + col0;
                f32x4 g0 = acc[ai][0][m][0], g1 = acc[ai][0][m][1]; const f32x4 u0 = acc[ai][1][m][0], u1 = acc[ai][1][m][1];
                if (ACT == 1) { g0 = (f32x4){silu_f(g0[0]), silu_f(g0[1]), silu_f(g0[2]), silu_f(g0[3])}; g1 = (f32x4){silu_f(g1[0]), silu_f(g1[1]), silu_f(g1[2]), silu_f(g1[3])}; }
                const f32x4 p0 = g0 * u0, p1 = g1 * u1;
                u32x4 w; w.x = cvt_pk_bf16(p0[0], p0[1]); w.y = cvt_pk_bf16(p0[2], p0[3]); w.z = cvt_pk_bf16(p1[0], p1[1]); w.w = cvt_pk_bf16(p1[2], p1[3]);
                *(u32x4*)rowp = w; }
    }
};
struct EpiSwiglu8 {
    static constexpr bool PERM = true;
    unsigned char* O; int ldc; float s = 1.f;
    __device__ __forceinline__ void operator()(const f32x4 (&acc)[2][2][4][2], const Unit& u, int wr, int wc, int fr, int fq) const {
        const int row0 = u.pm * BM + wr * 64 + fr, col0 = u.pn * HALF + wc * 32 + 8 * fq;
#pragma unroll
        for (int ai = 0; ai < 2; ++ai)
#pragma unroll
            for (int m = 0; m < 4; ++m) { unsigned char* rowp = O + (size_t)(row0 + ai * HALF + m * 16) * ldc + col0;
                const f32x4 g0 = acc[ai][0][m][0], g1 = acc[ai][0][m][1], u0 = acc[ai][1][m][0], u1 = acc[ai][1][m][1];
                const float c1 = -LOG2E * s, s2 = s * s;
                const f32x4 p0 = (g0 * u0) * s2, p1 = (g1 * u1) * s2;
                f32x4 r0, r1;
#pragma unroll
                for (int j = 0; j < 4; ++j) { r0[j] = __builtin_amdgcn_rcpf(1.0f + __builtin_amdgcn_exp2f(g0[j] * c1)); r1[j] = __builtin_amdgcn_rcpf(1.0f + __builtin_amdgcn_exp2f(g1[j] * c1)); }
                const f32x4 o0 = p0 * r0, o1 = p1 * r1;
                u32x2 w; w.x = pk4_fp8(o0[0], o0[1], o0[2], o0[3]); w.y = pk4_fp8(o1[0], o1[1], o1[2], o1[3]);
                *(u32x2*)rowp = w; }
    }
};
struct EpiResBf16 {
    static constexpr bool PERM = true;
    const bf16* base; bf16* out; int ldc; float alpha; float sc = 1.f;
    __device__ __forceinline__ void operator()(const f32x4 (&acc)[2][2][4][2], const Unit& u, int wr, int wc, int fr, int fq) const {
        const int row0 = u.pm * BM + wr * 64 + fr, col0 = u.pn * BM + wc * 32 + 8 * fq;
#pragma unroll
        for (int ai = 0; ai < 2; ++ai)
#pragma unroll
            for (int m = 0; m < 4; ++m) { const size_t off = (size_t)(row0 + ai * HALF + m * 16) * ldc + col0;
#pragma unroll
                for (int bj = 0; bj < 2; ++bj) { const u32x4 b = *(const u32x4*)(base + off + bj * HALF); const f32x4 a0 = acc[ai][bj][m][0] * sc, a1 = acc[ai][bj][m][1] * sc;
                    u32x4 w; w.x = cvt_pk_bf16(__builtin_bit_cast(float, b.x << 16) * alpha + a0[0], __builtin_bit_cast(float, b.x & 0xffff0000u) * alpha + a0[1]);
                    w.y = cvt_pk_bf16(__builtin_bit_cast(float, b.y << 16) * alpha + a0[2], __builtin_bit_cast(float, b.y & 0xffff0000u) * alpha + a0[3]);
                    w.z = cvt_pk_bf16(__builtin_bit_cast(float, b.z << 16) * alpha + a1[0], __builtin_bit_cast(float, b.z & 0xffff0000u) * alpha + a1[1]);
                    w.w = cvt_pk_bf16(__builtin_bit_cast(float, b.w << 16) * alpha + a1[2], __builtin_bit_cast(float, b.w & 0xffff0000u) * alpha + a1[3]);
                    *(u32x4*)(out + off + bj * HALF) = w; }
                asm volatile("" ::: "memory"); }
    }
};

template <bool HB8> struct EpiResLn {
    static constexpr bool PERM = true;
    bf16* h; const float* gain; const float* bias; float alpha, sc;
    float* xbuf;
    unsigned* cnt;
    unsigned* tmo;
    unsigned char* h8;
    LAS unsigned char* tb;
    __device__ __forceinline__ void operator()(f32x4 (&acc)[2][2][4][2], const Unit& u, int wr, int wc, int fr, int fq) const {
        asm volatile("" : "+v"(fr), "+v"(fq));
        const int row0 = u.pm * BM + wr * 64 + fr, col0 = u.pn * BM + wc * 32 + 8 * fq;
        LAS f32x2* P = (LAS f32x2*)tb; LAS f32x2* S = (LAS f32x2*)(tb + 8192);
#pragma unroll
        for (int ai = 0; ai < 2; ++ai)
#pragma unroll
            for (int m = 0; m < 4; ++m) { const size_t off = (size_t)(row0 + ai * HALF + m * 16) * 1024 + col0; float sm = 0.f, sq = 0.f;
#pragma unroll
                for (int bj = 0; bj < 2; ++bj) { const u32x4 b = *(const u32x4*)(h + off + bj * HALF); const f32x4 a0 = acc[ai][bj][m][0] * sc, a1 = acc[ai][bj][m][1] * sc;
                    f32x4 z0, z1;
                    z0[0] = __builtin_bit_cast(float, b.x << 16) * alpha + a0[0]; z0[1] = __builtin_bit_cast(float, b.x & 0xffff0000u) * alpha + a0[1];
                    z0[2] = __builtin_bit_cast(float, b.y << 16) * alpha + a0[2]; z0[3] = __builtin_bit_cast(float, b.y & 0xffff0000u) * alpha + a0[3];
                    z1[0] = __builtin_bit_cast(float, b.z << 16) * alpha + a1[0]; z1[1] = __builtin_bit_cast(float, b.z & 0xffff0000u) * alpha + a1[1];
                    z1[2] = __builtin_bit_cast(float, b.w << 16) * alpha + a1[2]; z1[3] = __builtin_bit_cast(float, b.w & 0xffff0000u) * alpha + a1[3];
                    acc[ai][bj][m][0] = z0; acc[ai][bj][m][1] = z1;
                    sm += ((z0[0] + z0[1]) + (z0[2] + z0[3])) + ((z1[0] + z1[1]) + (z1[2] + z1[3]));
                    sq += ((z0[0] * z0[0] + z0[1] * z0[1]) + (z0[2] * z0[2] + z0[3] * z0[3])) + ((z1[0] * z1[0] + z1[1] * z1[1]) + (z1[2] * z1[2] + z1[3] * z1[3])); }
                sm += __shfl_xor(sm, 16); sm += __shfl_xor(sm, 32); sq += __shfl_xor(sq, 16); sq += __shfl_xor(sq, 32);
                if (fq == 0) P[(ai * HALF + wr * 64 + m * 16 + fr) * 4 + wc] = (f32x2){sm, sq};
                asm volatile("" ::: "memory"); }
        asm volatile("s_waitcnt lgkmcnt(0)" ::: "memory"); __builtin_amdgcn_s_barrier(); asm volatile("" ::: "memory");
        const int wid = wr * 4 + wc, lane = fq * 16 + fr, row = wid * 32 + (lane & 31);
        unsigned long long* slots = (unsigned long long*)xbuf + (size_t)(u.pm * BM + row) * 4;
        if (lane < 32) { const f32x2 a = P[row * 4 + 0], b = P[row * 4 + 1], c = P[row * 4 + 2], d = P[row * 4 + 3];
            const float ts = (a.x + b.x) + (c.x + d.x), tq = (a.y + b.y) + (c.y + d.y);
            __hip_atomic_store(slots + u.pn, ((unsigned long long)__builtin_bit_cast(unsigned, tq) << 32) | (unsigned long long)__builtin_bit_cast(unsigned, ts), __ATOMIC_RELAXED, __HIP_MEMORY_SCOPE_AGENT); }
        asm volatile("s_waitcnt vmcnt(0)" ::: "memory");
        if (lane == 0) (void)__hip_atomic_fetch_add(cnt + 16 * u.pm, 1u, __ATOMIC_RELAXED, __HIP_MEMORY_SCOPE_AGENT);
        if (wid == 0) { unsigned sp = 0u;
            while ((unsigned)__builtin_amdgcn_readfirstlane(__hip_atomic_load(cnt + 16 * u.pm, __ATOMIC_RELAXED, __HIP_MEMORY_SCOPE_AGENT)) < 32u) { __builtin_amdgcn_s_sleep(1);
                if ((++sp & 255u) == 0u) { if (__hip_atomic_load(tmo, __ATOMIC_RELAXED, __HIP_MEMORY_SCOPE_AGENT)) break; if (sp > (1u << 22)) { if (lane == 0) (void)__hip_atomic_fetch_add(tmo, 1u, __ATOMIC_RELAXED, __HIP_MEMORY_SCOPE_AGENT); break; } } }
            __builtin_amdgcn_fence(__ATOMIC_ACQUIRE, "agent"); }
        asm volatile("s_waitcnt vmcnt(0) lgkmcnt(0)" ::: "memory"); __builtin_amdgcn_s_barrier(); asm volatile("" ::: "memory");
        if (lane < 32) { float ts = 0.f, tq = 0.f;
#pragma unroll
            for (int t = 0; t < 4; ++t) { const unsigned long long w = __hip_atomic_load(slots + t, __ATOMIC_RELAXED, __HIP_MEMORY_SCOPE_AGENT); ts += __builtin_bit_cast(float, (unsigned)w); tq += __builtin_bit_cast(float, (unsigned)(w >> 32)); }
            const float mean = ts * (1.f / 1024.f), var = fmaxf(tq * (1.f / 1024.f) - mean * mean, 0.f);
            S[row] = (f32x2){mean, 1.f / sqrtf(var + LN_EPS)}; }
        asm volatile("s_waitcnt vmcnt(0) lgkmcnt(0)" ::: "memory"); __builtin_amdgcn_s_barrier(); asm volatile("" ::: "memory");
#pragma unroll
        for (int bj = 0; bj < 2; ++bj) { const f32x4 g0 = *(const f32x4*)(gain + col0 + bj * HALF), g1 = *(const f32x4*)(gain + col0 + bj * HALF + 4), b0 = *(const f32x4*)(bias + col0 + bj * HALF), b1 = *(const f32x4*)(bias + col0 + bj * HALF + 4);
#pragma unroll
            for (int ai = 0; ai < 2; ++ai)
#pragma unroll
                for (int m = 0; m < 4; ++m) { const int r = ai * HALF + wr * 64 + m * 16 + fr; const f32x2 sr = S[r]; const size_t off = (size_t)(u.pm * BM + r) * 1024 + col0 + bj * HALF;
                    const f32x4 y0 = (acc[ai][bj][m][0] - sr.x) * sr.y * g0 + b0, y1 = (acc[ai][bj][m][1] - sr.x) * sr.y * g1 + b1;
                    u32x4 w; w.x = cvt_pk_bf16(y0[0], y0[1]); w.y = cvt_pk_bf16(y0[2], y0[3]); w.z = cvt_pk_bf16(y1[0], y1[1]); w.w = cvt_pk_bf16(y1[2], y1[3]);
                    *(u32x4*)(h + off) = w;
                    if (HB8) { u32x2 w8; w8.x = pk4_fp8(y0[0], y0[1], y0[2], y0[3]); w8.y = pk4_fp8(y1[0], y1[1], y1[2], y1[3]); *(u32x2*)(h8 + off) = w8; }
                    asm volatile("" ::: "memory"); } }
    }
};

template <class Epi, class Sched, bool ALIGN_EPI = true, int FP8 = 0>
__device__ __forceinline__ void gemm_phase(LAS unsigned char* lds, const int wave_s, const Gemm g, const Sched& S, const Epi& E) {
    int tid = wave_s * 64 + (int)__builtin_amdgcn_mbcnt_hi(~0u, __builtin_amdgcn_mbcnt_lo(~0u, 0u)); asm volatile("" : "+v"(tid));
    const int wid = __builtin_amdgcn_readfirstlane(tid >> 6), lane = tid & 63, wr = wid >> 2, wc = wid & 3, fr = lane & 15, fq = lane >> 4;
    const int K = g.K, nt = K / BK;
    unsigned voffA[2], voffB[2];
#pragma unroll
    for (int i = 0; i < 2; ++i) { int R, C; stage_rc(tid * 16 + i * 8192, R, C); const int Rb = Epi::PERM ? ((R & ~31) + perm32(R & 31)) : R;
        voffA[i] = (unsigned)(R * g.rsA * K + C) * 2u; voffB[i] = (unsigned)(Rb * g.rsB * K + C) * 2u; }
    const unsigned kstep = (unsigned)(BK * 2);
    const unsigned hstepA = (unsigned)g.hstepA, hstepB = (unsigned)g.hstepB;
    const __amdgpu_buffer_rsrc_t rsrcA = __builtin_amdgcn_make_buffer_rsrc((void*)S.A0, 0, 0x7fffffff, 0x00020000), rsrcB = __builtin_amdgcn_make_buffer_rsrc((void*)S.B0, 0, 0x7fffffff, 0x00020000);
    const unsigned ldsw = (unsigned)wid * 1024u;
    const int aoff = lds_byte(wr * 64 + fr, fq * 8), boff = lds_byte(wc * 32 + fr, fq * 8);
    const int aoff8 = lds_byte(wr * 64 + fr, fq * 16), boff8 = lds_byte(wc * 32 + fr, fq * 16);
    unsigned bbase8_ = (unsigned)(4 * HTB + boff); asm volatile("" : "+v"(bbase8_));
    LAS unsigned char* const ldsB8 = lds + bbase8_;
#define PG8_SA(b, h) (((b) * 2 + (h)) * HTB)
#define PG8_SB(b, h) ((4 + (b) * 2 + (h)) * HTB)
#define PG8_STAGE(bufoff, gbase, voff) do { _Pragma("unroll") for (int _i = 0; _i < 2; ++_i) \
        __builtin_amdgcn_raw_ptr_buffer_load_lds(PG8_RS_##voff, (LAS unsigned*)(lds + (bufoff) + ldsw + _i * 8192), 16, (int)(voff)[_i], (int)(gbase), 0, 0); } while (0)
#define PG8_RS_voffA rsrcA
#define PG8_RS_voffB rsrcB
#define PG8_LD16(off) (*(const LAS bf16x8*)(lds + (off)))
#define PG8_CAT8(lo, hi) __builtin_shufflevector(__builtin_bit_cast(v4i_t, lo), __builtin_bit_cast(v4i_t, hi), 0, 1, 2, 3, 4, 5, 6, 7)
#define PG8_LDA(dst, b, h) do { if constexpr (FP8) { _Pragma("unroll") for (int m = 0; m < 4; ++m) dst##8[m] = PG8_CAT8(PG8_LD16(PG8_SA(b, h) + aoff + m * 2048), PG8_LD16(PG8_SA(b, h) + aoff + m * 2048 + 1024)); } \
        else { _Pragma("unroll") for (int m = 0; m < 4; ++m) _Pragma("unroll") for (int k = 0; k < 2; ++k) dst[m][k] = PG8_LD16(PG8_SA(b, h) + aoff + m * 2048 + k * 1024); } } while (0)
#define PG8_LDB(dst, b, h) do { if constexpr (FP8) { _Pragma("unroll") for (int n = 0; n < 2; ++n) dst##8[n] = PG8_CAT8(*(const LAS bf16x8*)(ldsB8 + ((b) * 2 + (h)) * HTB + n * 2048), *(const LAS bf16x8*)(ldsB8 + ((b) * 2 + (h)) * HTB + n * 2048 + 1024)); } \
        else { _Pragma("unroll") for (int n = 0; n < 2; ++n) _Pragma("unroll") for (int k = 0; k < 2; ++k) dst[n][k] = PG8_LD16(PG8_SB(b, h) + boff + n * 2048 + k * 1024); } } while (0)
#define PG8_MMA(ai, bj, At, Bt) do { __builtin_amdgcn_s_setprio(1); \
        if constexpr (FP8) { _Pragma("unroll") for (int m = 0; m < 4; ++m) _Pragma("unroll") for (int n = 0; n < 2; ++n) \
            acc[ai][bj][m][n] = __builtin_amdgcn_mfma_scale_f32_16x16x128_f8f6f4(Bt##8[n], At##8[m], acc[ai][bj][m][n], 0, 0, 0, 0, 0, 0); } \
        else { _Pragma("unroll") for (int m = 0; m < 4; ++m) _Pragma("unroll") for (int n = 0; n < 2; ++n) _Pragma("unroll") for (int k = 0; k < 2; ++k) \
            acc[ai][bj][m][n] = __builtin_amdgcn_mfma_f32_16x16x32_bf16(Bt[n][k], At[m][k], acc[ai][bj][m][n], 0, 0, 0); } \
        __builtin_amdgcn_s_setprio(0); } while (0)
#define PG8_WAIT_V(n) asm volatile("s_waitcnt vmcnt(" #n ")" ::: "memory")
#define PG8_WAIT_L(n) asm volatile("s_waitcnt lgkmcnt(" #n ")" ::: "memory")
#define PG8_BAR __builtin_amdgcn_s_barrier()
#define PG8_SCHED __builtin_amdgcn_sched_barrier(0)
    Unit cur, nxt; int ui = 0;
    if (!S.next(0, cur)) return;
    f32x4 acc[2][2][4][2];
#pragma unroll
    for (int a = 0; a < 2; ++a)
#pragma unroll
        for (int b = 0; b < 2; ++b)
#pragma unroll
            for (int m = 0; m < 4; ++m)
#pragma unroll
                for (int n = 0; n < 2; ++n) acc[a][b][m][n] = (f32x4){0.f, 0.f, 0.f, 0.f};
    bf16x8 At[4][2], B0[2][2], B1[2][2]; v8i_t At8[4], B08[2], B18[2];
    unsigned cA = cur.a, cB = cur.b;
    PG8_STAGE(PG8_SB(0, 0), cB, voffB); PG8_STAGE(PG8_SB(0, 1), cB + hstepB, voffB); PG8_STAGE(PG8_SA(0, 0), cA, voffA); PG8_STAGE(PG8_SA(0, 1), cA + hstepA, voffA);
    if (wr == 1) PG8_BAR;
    PG8_WAIT_V(2); PG8_BAR;
    PG8_STAGE(PG8_SB(1, 0), cB + kstep, voffB); PG8_STAGE(PG8_SA(1, 0), cA + kstep, voffA); PG8_STAGE(PG8_SB(1, 1), cB + hstepB + kstep, voffB);
    PG8_WAIT_V(6); PG8_BAR;
    for (;;) {
        const bool has_next = S.next(ui + 1, nxt);
        const unsigned nA = has_next ? nxt.a : cA, nB = has_next ? nxt.b : cB;
#pragma clang loop unroll(disable)
        for (int t = 0; t < nt; t += 2) {
            const bool last = (t == nt - 2);
            const unsigned a1 = cA + (unsigned)(t + 1) * kstep;
            const unsigned a2 = last ? nA : cA + (unsigned)(t + 2) * kstep, b2 = last ? nB : cB + (unsigned)(t + 2) * kstep;
            const unsigned a3 = a2 + kstep, b3 = b2 + kstep;
            PG8_LDB(B0, 0, 0); PG8_LDB(B1, 0, 1); PG8_SCHED; PG8_LDA(At, 0, 0); PG8_STAGE(PG8_SA(1, 1), a1 + hstepA, voffA);
            PG8_WAIT_V(8); PG8_WAIT_L(0); PG8_BAR; PG8_MMA(0, 0, At, B0); PG8_MMA(0, 1, At, B1); PG8_BAR; PG8_SCHED;
            PG8_LDA(At, 0, 1); PG8_STAGE(PG8_SB(0, 0), b2, voffB); PG8_STAGE(PG8_SB(0, 1), b2 + hstepB, voffB); PG8_STAGE(PG8_SA(0, 0), a2, voffA);
            PG8_WAIT_V(8); PG8_WAIT_L(0); PG8_BAR; PG8_MMA(1, 0, At, B0); PG8_MMA(1, 1, At, B1); PG8_BAR; PG8_SCHED;
            PG8_LDB(B0, 1, 0); PG8_LDB(B1, 1, 1); PG8_SCHED; PG8_LDA(At, 1, 0); PG8_STAGE(PG8_SA(0, 1), a2 + hstepA, voffA);
            PG8_WAIT_V(8); PG8_WAIT_L(0); PG8_BAR; PG8_MMA(0, 0, At, B0); PG8_MMA(0, 1, At, B1); PG8_BAR; PG8_SCHED;
            PG8_LDA(At, 1, 1); PG8_STAGE(PG8_SB(1, 0), b3, voffB); PG8_STAGE(PG8_SB(1, 1), b3 + hstepB, voffB); PG8_STAGE(PG8_SA(1, 0), a3, voffA);
            PG8_WAIT_V(8); PG8_WAIT_L(0); PG8_BAR; PG8_MMA(1, 0, At, B0); PG8_MMA(1, 1, At, B1); PG8_BAR; PG8_SCHED;
        }
        if constexpr (ALIGN_EPI) { if (wr == 0) PG8_BAR; }
        E(acc, cur, wr, wc, fr, fq);
        if (!has_next) break;
#pragma unroll
        for (int a = 0; a < 2; ++a)
#pragma unroll
            for (int b = 0; b < 2; ++b)
#pragma unroll
                for (int m = 0; m < 4; ++m)
#pragma unroll
                    for (int n = 0; n < 2; ++n) acc[a][b][m][n] = (f32x4){0.f, 0.f, 0.f, 0.f};
        cur = nxt; cA = nA; cB = nB; ++ui;
        if constexpr (ALIGN_EPI) { if (wr == 1) PG8_BAR; }
    }
    PG8_WAIT_V(0);
    if constexpr (!ALIGN_EPI) { if (wr == 0) PG8_BAR; }
    PG8_BAR;
#undef PG8_SA
#undef PG8_SB
#undef PG8_STAGE
#undef PG8_RS_voffA
#undef PG8_RS_voffB
#undef PG8_LDA
#undef PG8_LD16
#undef PG8_CAT8
#undef PG8_LDB
#undef PG8_MMA
#undef PG8_WAIT_V
#undef PG8_WAIT_L
#undef PG8_BAR
#undef PG8_SCHED
}
}

#define RLX_AGENT __ATOMIC_RELAXED, __HIP_MEMORY_SCOPE_AGENT
#define LDS_WAIT() asm volatile("s_waitcnt lgkmcnt(0)" ::: "memory")
#define VM_WAIT() asm volatile("s_waitcnt vmcnt(0)" ::: "memory")
__device__ __forceinline__ unsigned f2bf(float f) { unsigned u = __builtin_bit_cast(unsigned, f); return (u + 0x7fffu + ((u >> 16) & 1u)) >> 16; }
__device__ __forceinline__ unsigned pk2(float lo, float hi) { return pg8::cvt_pk_bf16(lo, hi); }
__device__ __forceinline__ float bflo(unsigned w) { return __builtin_bit_cast(float, w << 16); }
__device__ __forceinline__ float bfhi(unsigned w) { return __builtin_bit_cast(float, w & 0xffff0000u); }
__device__ __forceinline__ float wave_sum(float v) {
#pragma unroll
    for (int o = 1; o < 64; o <<= 1) v += __shfl_xor(v, o);
    return v;
}

#define XB_TMO      128
#define XB_XCNT(j)  (256  + 64 * (j))
#define XB_XSUB(j)  (1280 + 64 * (j))
#define XB_XGEN(j)  (2304 + 64 * (j))
#define XB_TOP      3328
#define XB_TOPGEN   3392
#define XCD_BAR_WORDS 3456
#define XB_SPIN_CAP (1u << 22)
__device__ __forceinline__ unsigned xb_ld(unsigned* p)              { return __hip_atomic_load(p, __ATOMIC_RELAXED, __HIP_MEMORY_SCOPE_AGENT); }
__device__ __forceinline__ unsigned xb_add(unsigned* p, unsigned v) { return __hip_atomic_fetch_add(p, v, __ATOMIC_RELAXED, __HIP_MEMORY_SCOPE_AGENT); }
__device__ __forceinline__ unsigned xb_xcc_id() { return (unsigned)__builtin_amdgcn_s_getreg((3 << 11) | 20) & 0xFu; }
#define XB_SPIN(cond, bar) do { unsigned _sp = 0; while (cond) { __builtin_amdgcn_s_sleep(1); \
    if ((++_sp & 255u) == 0u) { if (xb_ld(&(bar)[XB_TMO])) break; if (_sp > XB_SPIN_CAP) { atomicAdd(&(bar)[XB_TMO], 1u); break; } } } } while (0)
struct XcdBarrier { unsigned* bar; unsigned x; volatile LAS unsigned* st; };
__device__ __forceinline__ XcdBarrier xcd_barrier_post(unsigned* bar, volatile LAS unsigned* st) {
    XcdBarrier b; b.bar = bar; b.x = xb_xcc_id(); b.st = st;
    if (threadIdx.x == 0) (void)xb_add(&bar[XB_XCNT(b.x)], 1u);
    return b;
}
__device__ __forceinline__ void xcd_barrier_complete(unsigned* bar, unsigned x, unsigned& nloc, unsigned& nx) {
    const unsigned G = gridDim.x * gridDim.y * gridDim.z;
    unsigned sum, cnt, mine, sp = 0u;
    for (;;) {
        sum = 0u; cnt = 0u; mine = 0u;
#pragma unroll
        for (unsigned j = 0; j < 16; ++j) { const unsigned c = xb_ld(&bar[XB_XCNT(j)]); sum += c; cnt += (c > 0u) ? 1u : 0u; mine = (j == x) ? c : mine; }
        if (sum == G) break;
        __builtin_amdgcn_s_sleep(1);
        if ((++sp & 255u) == 0u) { if (xb_ld(&bar[XB_TMO])) break; if (sp > XB_SPIN_CAP) { atomicAdd(&bar[XB_TMO], 1u); break; } }
    }
    nloc = mine > 0u ? mine : 1u; nx = cnt > 0u ? cnt : 1u;
}
__device__ __forceinline__ void xcd_barrier(const XcdBarrier& b, const int tid) {
    asm volatile("s_waitcnt vmcnt(0)" ::: "memory");
    __syncthreads();
    if (tid == 0) {
        unsigned* bar = b.bar;
        __builtin_amdgcn_s_waitcnt(0);
        unsigned nloc = b.st[0], nx = b.st[1];
        if (nloc == 0u) { xcd_barrier_complete(bar, b.x, nloc, nx); b.st[0] = nloc; b.st[1] = nx; }
        const unsigned old = xb_add(&bar[XB_XSUB(b.x)], 1u);
        const unsigned gen = old / nloc;
        if (old + 1u == (gen + 1u) * nloc) {
            __builtin_amdgcn_fence(__ATOMIC_RELEASE, "agent");
            asm volatile("s_waitcnt vmcnt(0)" ::: "memory");
            const unsigned og = xb_add(&bar[XB_TOP], 1u);
            const unsigned tg = og / nx;
            if (og + 1u == (tg + 1u) * nx) xb_add(&bar[XB_TOPGEN], 1u);
            else XB_SPIN(xb_ld(&bar[XB_TOPGEN]) == tg, bar);
            __builtin_amdgcn_fence(__ATOMIC_ACQUIRE, "agent");
            xb_add(&bar[XB_XGEN(b.x)], 1u);
            asm volatile("s_waitcnt vmcnt(0)" ::: "memory");
        } else {
            XB_SPIN(xb_ld(&bar[XB_XGEN(b.x)]) == gen, bar);
            __builtin_amdgcn_fence(__ATOMIC_ACQUIRE, "agent");
            asm volatile("s_waitcnt vmcnt(0)" ::: "memory");
        }
    }
    __syncthreads();
}

constexpr int NWAVES = 8;
constexpr int RING_BYTES = 131072, MISC_OFF = RING_BYTES + 320, LNT_OFF = RING_BYTES + 2048  , LDS_BYTES = 147456;
struct Args { const float* in[24]; float* out; unsigned char* ws; int ph_lo, ph_hi; int chk, pad; };
struct Frame {
    LAS unsigned char* lds;
    gu32* ctl; unsigned char* ws; float* out;
    int tid, lane, wave, vcu, G;
    int chk, stage;
};

struct Job { const float* src; bf16* dst; int ld, K, N, mode, start; float scale; int fp8, pad; };
constexpr int NJOBS = 74;
__device__ __forceinline__ void make_job(const Args& a, int j, Job& J) {
    unsigned char* ws = a.ws; J.scale = 1.f; J.mode = 0; J.start = 0; J.fp8 = 0; J.pad = 0;
    if (j < 9) { const int g = j / 3, t = j % 3; J.src = a.in[4] + g * 3072 + t * 1024; J.ld = 9216; J.K = 1024; J.N = 1024;
        if (t == 2) J.dst = (bf16*)(ws + W_A_V + (size_t)g * 1024 * 1024); else J.dst = (bf16*)(ws + W_A_QK + (size_t)g * 2048 * 1024 + (size_t)t * 1024 * 1024);
        J.fp8 = 1; J.scale = (t == 0 ? QSCALE : 1.f) * WSCALE8; return; }
    j -= 9;
    if (j == 0) { J.src = a.in[5]; J.ld = 1024; J.K = 1024; J.N = 1024; J.dst = (bf16*)(ws + W_A_O); J.fp8 = 1; J.scale = WSCALE8; return; }
    if (j == 1) { J.src = a.in[6]; J.ld = 3072; J.K = 1024; J.N = 1024; J.dst = (bf16*)(ws + W_B_IN); return; }
    if (j == 9 || j == 10) { J.src = a.in[6] + 1024 * (j - 8); J.ld = 3072; J.K = 1024; J.N = 1024; J.dst = (bf16*)(ws + W_B_IN) + (size_t)1024 * 1024; J.mode = j - 8; return; }
    if (j == 2) { J.src = a.in[8]; J.ld = 1024; J.K = 1024; J.N = 1024; J.dst = (bf16*)(ws + W_B_O); return; }
    if (j == 3) { J.src = a.in[9]; J.ld = 3072; J.K = 1024; J.N = 1024; J.dst = (bf16*)(ws + W_C_QK); J.scale = QSCALE; return; }
    if (j == 4) { J.src = a.in[9] + 1024; J.ld = 3072; J.K = 1024; J.N = 1024; J.dst = (bf16*)(ws + W_C_QK) + (size_t)1024 * 1024; return; }
    if (j == 5) { J.src = a.in[9] + 2048; J.ld = 3072; J.K = 1024; J.N = 1024; J.dst = (bf16*)(ws + W_C_V); J.fp8 = 1; J.scale = WSCALE8; return; }
    if (j == 6) { J.src = a.in[10]; J.ld = 1024; J.K = 1024; J.N = 1024; J.dst = (bf16*)(ws + W_C_O); J.fp8 = 1; J.scale = WSCALE8; return; }
    if (j == 7) { J.src = a.in[11]; J.ld = 2048; J.K = 1024; J.N = 2048; J.dst = (bf16*)(ws + W_D_IN); return; }
    if (j == 8) { J.src = a.in[16]; J.ld = 1024; J.K = 1024; J.N = 1024; J.dst = (bf16*)(ws + W_D_O); return; }
    j -= 11;
    if (j < 6) { const int f = j / 3, t = j % 3;
        if (t < 2) { J.src = a.in[17 + t] + (size_t)f * 1024 * DFF; J.ld = DFF; J.K = 1024; J.N = DFF; J.dst = (bf16*)(ws + W_F_GU) + (size_t)f * 2 * DFF * 1024; J.mode = 1 + t;
            if (f == FFN_GU8) { J.fp8 = 1; J.scale = WSCALE8; } }
        else { J.src = a.in[19] + (size_t)f * DFF * 1024; J.ld = 1024; J.K = DFF; J.N = 1024; J.dst = (bf16*)(ws + W_F_D) + (size_t)f * 1024 * DFF; J.fp8 = 1; J.scale = WSCALE8D; }
        return; }
    j -= 6;
    { const int fe = j / 3, t = j % 3;
        if (t < 2) { J.src = a.in[21 + t] + (size_t)fe * 1024 * DFE; J.ld = DFE; J.K = 1024; J.N = DFE; J.dst = (bf16*)(ws + W_E_GU) + (size_t)fe * 2 * DFE * 1024; J.mode = 1 + t; J.fp8 = 1; J.scale = WSCALE8; }
        else { J.src = a.in[23] + (size_t)fe * DFE * 1024; J.ld = 1024; J.K = DFE; J.N = 1024; J.dst = (bf16*)(ws + W_E_D) + (size_t)fe * 1024 * DFE; J.fp8 = 1; J.scale = WSCALE8D; } }
}
__device__ __forceinline__ void transpose_item(const Job& J, int item, int lane) {
    const int nblk = J.N >> 6, kb = item / nblk, nb = item - kb * nblk, k0 = 64 * kb, n = 64 * nb + lane;
    const float* W = J.src + (size_t)k0 * J.ld + n;
    int r = n; if (J.mode) r = (n >> 7) * 256 + (n & 127) + (J.mode == 2 ? 128 : 0);
    const float sc = J.scale; const size_t ld = (size_t)J.ld;
    if (J.fp8) {
        unsigned char* dst8 = (unsigned char*)J.dst + (size_t)r * J.K + k0;
#pragma unroll
        for (int hf = 0; hf < 2; ++hf) {
            float v[32];
#pragma unroll
            for (int j = 0; j < 32; ++j) v[j] = W[(size_t)(32 * hf + j) * ld];
#pragma unroll
            for (int c = 0; c < 2; ++c) { u32x4 o; o.x = pk4_fp8(v[16 * c] * sc, v[16 * c + 1] * sc, v[16 * c + 2] * sc, v[16 * c + 3] * sc); o.y = pk4_fp8(v[16 * c + 4] * sc, v[16 * c + 5] * sc, v[16 * c + 6] * sc, v[16 * c + 7] * sc);
                o.z = pk4_fp8(v[16 * c + 8] * sc, v[16 * c + 9] * sc, v[16 * c + 10] * sc, v[16 * c + 11] * sc); o.w = pk4_fp8(v[16 * c + 12] * sc, v[16 * c + 13] * sc, v[16 * c + 14] * sc, v[16 * c + 15] * sc);
                *(u32x4*)(dst8 + 32 * hf + 16 * c) = o; }
        }
        return;
    }
    bf16* dst = J.dst + (size_t)r * J.K + k0;
#pragma unroll
    for (int hf = 0; hf < 2; ++hf) {
        float v[32];
#pragma unroll
        for (int j = 0; j < 32; ++j) v[j] = W[(size_t)(32 * hf + j) * ld];
#pragma unroll
        for (int c = 0; c < 4; ++c) { u32x4 o; o.x = pk2(v[8 * c] * sc, v[8 * c + 1] * sc); o.y = pk2(v[8 * c + 2] * sc, v[8 * c + 3] * sc); o.z = pk2(v[8 * c + 4] * sc, v[8 * c + 5] * sc); o.w = pk2(v[8 * c + 6] * sc, v[8 * c + 7] * sc);
            *(u32x4*)(dst + 32 * hf + 8 * c) = o; }
    }
}
__device__ __forceinline__ int t5_bucket(int d) {
    if (d < 16) return d;
    int b = 16 + (int)(log((double)d / 16.0) / log(128.0) * 16.0);
    return b < 16 ? 16 : (b > 31 ? 31 : b);
}
__device__ __forceinline__ void p_prologue(Frame& F, const Args& a) {
    unsigned char* gl_ = (unsigned char*)F.lds;
    Job* jobs = (Job*)(gl_ + 7 * 16384 + 8704);
    int* tot = (int*)(gl_ + 7 * 16384 + 8704 + NJOBS * sizeof(Job));
    static_assert(8704 + NJOBS * sizeof(Job) + 16 <= 16384, "job table fits");
    if (F.tid < NJOBS) { Job J; make_job(a, F.tid, J); jobs[F.tid] = J; }
    __syncthreads();
    if (F.tid == 0) { int s = 0; for (int j = 0; j < NJOBS; ++j) { jobs[j].start = s; s += (jobs[j].K / 64) * (jobs[j].N / 64); } tot[0] = s; }
    __syncthreads();
    const int total = tot[0];
    const int gw = F.vcu * NWAVES + F.wave, NGW = F.G * NWAVES;
    int jc = 0;
    for (int it = gw; it < total; it += NGW) {
        while (jc + 1 < NJOBS && jobs[jc + 1].start <= it) ++jc;
        const Job J = jobs[jc];
        transpose_item(J, it - J.start, F.lane);
    }
    { bf16* hb = (bf16*)(F.ws + WS_HB); const float* x = a.in[0]; unsigned char* hb8 = F.ws + WS_SCR + S_HB8;
      for (int m0 = 4 * gw; m0 < T; m0 += 4 * NGW) { f32x4 v[4][4];
#pragma unroll
          for (int k = 0; k < 4; ++k) { const f32x4* xr = (const f32x4*)(x + (size_t)(m0 + k) * D) + F.lane;
#pragma unroll
              for (int j = 0; j < 4; ++j) v[k][j] = xr[64 * j]; }
#pragma unroll
          for (int k = 0; k < 4; ++k) { unsigned long long* o8 = (unsigned long long*)(hb + (size_t)(m0 + k) * D) + F.lane;
#pragma unroll
              for (int j = 0; j < 4; ++j) o8[64 * j] = (unsigned long long)pk2(v[k][j].x, v[k][j].y) | ((unsigned long long)pk2(v[k][j].z, v[k][j].w) << 32);
              unsigned* o4 = (unsigned*)(hb8 + (size_t)(m0 + k) * D) + F.lane;
#pragma unroll
              for (int j = 0; j < 4; ++j) o4[64 * j] = pk4_fp8(v[k][j].x, v[k][j].y, v[k][j].z, v[k][j].w); } } }
    const int gt = blockIdx.x * 512 + F.tid, NGT = F.G * 512;
    const float* rel = a.in[1];
    float* btA = (float*)(F.ws + WS_BTABA); float* btC = (float*)(F.ws + WS_BTABC);
    for (int i = gt; i < 48 * 132; i += NGT) { const int gh = i / 132, dl = i % 132, g = gh >> 4, hh = gh & 15; const int dil = g == 0 ? 1 : (g == 1 ? 4 : 16);
        btA[i] = dl <= 128 ? rel[t5_bucket(dl * dil) * NH + hh] * LOG2E : 0.f; }
    for (int i = gt; i < 16 * 2048; i += NGT) { const int hh = i >> 11, dd = i & 2047; btC[i] = rel[t5_bucket(dd) * NH + hh] * LOG2E; }
    { bf16* wst = (bf16*)(F.ws + WS_WST); const float* wsrc = a.in[14];
      for (int i = gt; i < 8 * 128 * 128; i += NGT) { const int tt = (i >> 7) & 127, ss = i & 127; wst[i] = (bf16)f2bf(ss <= tt ? wsrc[i] : 0.f); } }
}

__device__ __forceinline__ void unpack8(const u32x4 a, float* x) { x[0] = bflo(a.x); x[1] = bfhi(a.x); x[2] = bflo(a.y); x[3] = bfhi(a.y); x[4] = bflo(a.z); x[5] = bfhi(a.z); x[6] = bflo(a.w); x[7] = bfhi(a.w); }
template <int MODE, bool ROUTE, bool FINAL, bool HB8 = false>
__device__ __forceinline__ void ln_phase(Frame& F, const float* gain, const float* bias, const float* wr) {
    constexpr int NBT = 2;
    const int gw = F.vcu * NWAVES + F.wave, NGW = F.G * NWAVES, lane = F.lane;
    bf16* hb = (bf16*)(F.ws + WS_HB); const bf16* zb = (const bf16*)F.out;
    float gv[16], bv[16];
#pragma unroll
    for (int k = 0; k < 2; ++k)
#pragma unroll
        for (int j = 0; j < 2; ++j) { const f32x4 g4 = *(const f32x4*)(gain + 512 * k + 8 * lane + 4 * j), b4 = *(const f32x4*)(bias + 512 * k + 8 * lane + 4 * j);
            gv[8 * k + 4 * j] = g4.x; gv[8 * k + 4 * j + 1] = g4.y; gv[8 * k + 4 * j + 2] = g4.z; gv[8 * k + 4 * j + 3] = g4.w;
            bv[8 * k + 4 * j] = b4.x; bv[8 * k + 4 * j + 1] = b4.y; bv[8 * k + 4 * j + 2] = b4.z; bv[8 * k + 4 * j + 3] = b4.w; }
    LAS float* wrT = (LAS float*)F.lds;
    if (ROUTE) { for (int i = F.tid; i < 8 * 1024; i += 512) { const int e = i >> 10, c = i & 1023; wrT[i] = wr[c * 8 + e]; } __syncthreads(); }
    const unsigned char* ys = F.ws + WS_SCR + S_XG;
    const int* slots = (const int*)(F.ws + WS_SLOTS); const float* gates = (const float*)(F.ws + WS_GATES);
    int* route = (int*)(F.ws + WS_ROUTE); float* gout = (float*)(F.ws + WS_GATES);
    for (int grp = gw; grp < T / 32; grp += NGW) {
        int cnt_e = 0;
        int my_e1 = 0, my_e2 = 0, my_r1 = 0, my_r2 = 0; float my_g1 = 0.f, my_g2 = 0.f;
        int sl0 = 0, sl1 = 0; float gg0 = 0.f, gg1 = 0.f;
        if (MODE == 2) { const int mm = grp * 32 + (lane & 31); sl0 = slots[2 * mm]; sl1 = slots[2 * mm + 1]; gg0 = gates[2 * mm]; gg1 = gates[2 * mm + 1]; }
        for (int i0 = 0; i0 < 32; i0 += NBT) {
            float v[NBT][16]; float st[NBT][2];
#pragma unroll
            for (int k = 0; k < NBT; ++k) { const int m = grp * 32 + i0 + k;
                if (MODE == 0) { const u32x4* zr = (const u32x4*)(zb + (size_t)m * D) + lane; unpack8(zr[0], v[k]); unpack8(zr[64], v[k] + 8); }
                else { const u32x4* hr = (const u32x4*)(hb + (size_t)m * D) + lane; unpack8(hr[0], v[k]); unpack8(hr[64], v[k] + 8);
#pragma unroll
                    for (int j = 0; j < 16; ++j) v[k][j] *= ALPHA;
                    if (MODE == 3) { const u32x4* yr = (const u32x4*)((const bf16*)(F.ws + WS_SCR + S_Y) + (size_t)m * D) + lane; float a[16]; unpack8(yr[0], a); unpack8(yr[64], a + 8);
#pragma unroll
                        for (int j = 0; j < 16; ++j) v[k][j] += a[j]; }
                    if (MODE == 2) { const int s0 = __builtin_amdgcn_readlane(sl0, i0 + k), s1 = __builtin_amdgcn_readlane(sl1, i0 + k);
                        const float g0 = __builtin_bit_cast(float, __builtin_amdgcn_readlane(__builtin_bit_cast(int, gg0), i0 + k)), g1 = __builtin_bit_cast(float, __builtin_amdgcn_readlane(__builtin_bit_cast(int, gg1), i0 + k));
                        const u32x2* y0 = (const u32x2*)(ys + (size_t)s0 * D) + lane; const u32x2* y1 = (const u32x2*)(ys + (size_t)s1 * D) + lane;
                        const u32x2 ya0 = y0[0], ya1 = y0[64], yb0 = y1[0], yb1 = y1[64];
                        float a[16], b[16];
#pragma unroll
                        for (int c = 0; c < 2; ++c) { const unsigned wa0 = c ? ya0.y : ya0.x, wa1 = c ? ya1.y : ya1.x, wb0 = c ? yb0.y : yb0.x, wb1 = c ? yb1.y : yb1.x;
                            f32x2 t;
                            t = __builtin_amdgcn_cvt_pk_f32_fp8((int)wa0, false); a[4 * c] = t.x; a[4 * c + 1] = t.y; t = __builtin_amdgcn_cvt_pk_f32_fp8((int)wa0, true); a[4 * c + 2] = t.x; a[4 * c + 3] = t.y;
                            t = __builtin_amdgcn_cvt_pk_f32_fp8((int)wa1, false); a[8 + 4 * c] = t.x; a[8 + 4 * c + 1] = t.y; t = __builtin_amdgcn_cvt_pk_f32_fp8((int)wa1, true); a[8 + 4 * c + 2] = t.x; a[8 + 4 * c + 3] = t.y;
                            t = __builtin_amdgcn_cvt_pk_f32_fp8((int)wb0, false); b[4 * c] = t.x; b[4 * c + 1] = t.y; t = __builtin_amdgcn_cvt_pk_f32_fp8((int)wb0, true); b[4 * c + 2] = t.x; b[4 * c + 3] = t.y;
                            t = __builtin_amdgcn_cvt_pk_f32_fp8((int)wb1, false); b[8 + 4 * c] = t.x; b[8 + 4 * c + 1] = t.y; t = __builtin_amdgcn_cvt_pk_f32_fp8((int)wb1, true); b[8 + 4 * c + 2] = t.x; b[8 + 4 * c + 3] = t.y; }
                        const float h0 = g0 * (1.f / YSCALE8), h1 = g1 * (1.f / YSCALE8);
#pragma unroll
                        for (int j = 0; j < 16; ++j) v[k][j] += h0 * a[j] + h1 * b[j]; } }
                float s = 0.f, q2 = 0.f;
#pragma unroll
                for (int j = 0; j < 16; ++j) { s += v[k][j]; q2 += v[k][j] * v[k][j]; }
                st[k][0] = s; st[k][1] = q2; }
#pragma unroll
            for (int o = 1; o < 64; o <<= 1) {
#pragma unroll
                for (int k = 0; k < NBT; ++k) { st[k][0] += __shfl_xor(st[k][0], o); st[k][1] += __shfl_xor(st[k][1], o); } }
#pragma unroll
            for (int k = 0; k < NBT; ++k) { const int m = grp * 32 + i0 + k;
                const float mean = st[k][0] * (1.f / D), var = fmaxf(st[k][1] * (1.f / D) - mean * mean, 0.f), rstd = 1.f / sqrtf(var + LN_EPS);
#pragma unroll
                for (int j = 0; j < 16; ++j) v[k][j] = (v[k][j] - mean) * rstd * gv[j] + bv[j];
                if (FINAL) { f32x4* orow = (f32x4*)(F.out + (size_t)m * D) + 2 * lane;
                    orow[0] = (f32x4){v[k][0], v[k][1], v[k][2], v[k][3]}; orow[1] = (f32x4){v[k][4], v[k][5], v[k][6], v[k][7]}; orow[128] = (f32x4){v[k][8], v[k][9], v[k][10], v[k][11]}; orow[129] = (f32x4){v[k][12], v[k][13], v[k][14], v[k][15]}; }
                else { u32x4* o = (u32x4*)(hb + (size_t)m * D) + lane; u32x4 a, b;
                    a.x = pk2(v[k][0], v[k][1]); a.y = pk2(v[k][2], v[k][3]); a.z = pk2(v[k][4], v[k][5]); a.w = pk2(v[k][6], v[k][7]); b.x = pk2(v[k][8], v[k][9]); b.y = pk2(v[k][10], v[k][11]); b.z = pk2(v[k][12], v[k][13]); b.w = pk2(v[k][14], v[k][15]);
                    o[0] = a; o[64] = b;
                    if (HB8) { u32x2* o8 = (u32x2*)(F.ws + WS_SCR + S_HB8 + (size_t)m * D) + lane; u32x2 c, d;
                        c.x = pk4_fp8(v[k][0], v[k][1], v[k][2], v[k][3]); c.y = pk4_fp8(v[k][4], v[k][5], v[k][6], v[k][7]); d.x = pk4_fp8(v[k][8], v[k][9], v[k][10], v[k][11]); d.y = pk4_fp8(v[k][12], v[k][13], v[k][14], v[k][15]);
                        o8[0] = c; o8[64] = d; } }
                if (ROUTE) {
                    float lg[8];
#pragma unroll
                    for (int e = 0; e < 8; ++e) { float p = 0.f;
#pragma unroll
                        for (int kk = 0; kk < 2; ++kk)
#pragma unroll
                            for (int j = 0; j < 2; ++j) { const f32x4 w4 = *(const LAS f32x4*)(wrT + e * 1024 + 512 * kk + 8 * lane + 4 * j); p += (v[k][8 * kk + 4 * j] * w4.x + v[k][8 * kk + 4 * j + 1] * w4.y) + (v[k][8 * kk + 4 * j + 2] * w4.z + v[k][8 * kk + 4 * j + 3] * w4.w); }
                        lg[e] = p; }
#pragma unroll
                    for (int o = 1; o < 64; o <<= 1) {
#pragma unroll
                        for (int e = 0; e < 8; ++e) lg[e] += __shfl_xor(lg[e], o); }
                    int e1 = 0; float v1 = lg[0];
#pragma unroll
                    for (int e = 1; e < 8; ++e) if (lg[e] > v1) { v1 = lg[e]; e1 = e; }
                    int e2 = -1; float v2 = -3.4e38f;
#pragma unroll
                    for (int e = 0; e < 8; ++e) if (e != e1 && lg[e] > v2) { v2 = lg[e]; e2 = e; }
                    const float g2 = 1.f / (1.f + __expf(v1 - v2)), g1 = 1.f - g2;
                    const int r1 = __shfl(cnt_e, e1); if (lane == e1) ++cnt_e;
                    const int r2 = __shfl(cnt_e, e2); if (lane == e2) ++cnt_e;
                    if (lane == i0 + k) { my_e1 = e1; my_e2 = e2; my_r1 = r1; my_r2 = r2; my_g1 = g1; my_g2 = g2; }
                }
            }
        }
        if (ROUTE) {
            if (lane < 8) ((int*)(F.ws + WS_WCNT))[grp * 8 + lane] = cnt_e;
            if (lane < 32) { const int m = grp * 32 + lane; int* r = route + 4 * m; r[0] = my_e1; r[1] = my_r1; r[2] = my_e2; r[3] = my_r2; gout[2 * m] = my_g1; gout[2 * m + 1] = my_g2; }
        }
    }
}

__device__ __forceinline__ f32x16 mfma32(bf16x8 a, bf16x8 b, f32x16 c) { return __builtin_amdgcn_mfma_f32_32x32x16_bf16(a, b, c, 0, 0, 0); }
__device__ __forceinline__ bf16x8 pack8(const f32x16& s, int b0) {
    u32x4 w; w.x = pg8::cvt_pk_bf16(s[b0], s[b0 + 1]); w.y = pg8::cvt_pk_bf16(s[b0 + 2], s[b0 + 3]); w.z = pg8::cvt_pk_bf16(s[b0 + 4], s[b0 + 5]); w.w = pg8::cvt_pk_bf16(s[b0 + 6], s[b0 + 7]);
    return __builtin_bit_cast(bf16x8, w);
}
__device__ __forceinline__ float max16(const f32x16& s) {
    float a = fmaxf(fmaxf(s[0], s[1]), fmaxf(s[2], s[3])), b = fmaxf(fmaxf(s[4], s[5]), fmaxf(s[6], s[7]));
    float c = fmaxf(fmaxf(s[8], s[9]), fmaxf(s[10], s[11])), d = fmaxf(fmaxf(s[12], s[13]), fmaxf(s[14], s[15]));
    return fmaxf(fmaxf(a, b), fmaxf(c, d));
}
__device__ __forceinline__ void softmax_pv(f32x16& s, float& m_run, float& l_run, f32x16& o0, f32x16& o1, const bf16* vt0, const bf16* vt1, int h) {
    float mx = max16(s); mx = fmaxf(mx, __shfl_xor(mx, 32));
    const float mn = fmaxf(m_run, mx), alpha = __builtin_amdgcn_exp2f(m_run - mn); m_run = mn;
    float ps = 0.f;
#pragma unroll
    for (int r = 0; r < 16; ++r) { const float p = __builtin_amdgcn_exp2f(s[r] - mn); s[r] = p; ps += p; }
    l_run = l_run * alpha + ps;
#pragma unroll
    for (int r = 0; r < 16; ++r) { o0[r] *= alpha; o1[r] *= alpha; }
    const bf16x8 p0 = pack8(s, 0), p1 = pack8(s, 8);
    const bf16x8 v00 = *(const bf16x8*)(vt0 + 8 * h), v01 = *(const bf16x8*)(vt0 + 16 + 8 * h), v10 = *(const bf16x8*)(vt1 + 8 * h), v11 = *(const bf16x8*)(vt1 + 16 + 8 * h);
    o0 = mfma32(v00, p0, o0); o0 = mfma32(v01, p1, o0);
    o1 = mfma32(v10, p0, o1); o1 = mfma32(v11, p1, o1);
}
__device__ __forceinline__ int kperm(int i) { return (i & 19) | ((i & 8) >> 1) | ((i & 4) << 1); }

__device__ __forceinline__ void dil_attn_phase(Frame& F) {
    LAS float* bt = (LAS float*)F.lds;
    { const float* btA = (const float*)(F.ws + WS_BTABA); for (int i = F.tid; i < 48 * 192; i += 512) { const int gh = i / 192, dl = i % 192 - 32; bt[i] = (dl >= 0 && dl <= 128) ? btA[gh * 132 + dl] : NEGB; } }
    __syncthreads();
    const int gw = F.vcu * NWAVES + F.wave, NGW = F.G * NWAVES, lane = F.lane, q = lane & 31, h = lane >> 5;
    const bf16* QK = (const bf16*)(F.ws + WS_SCR + S_QK); const bf16* VT = (const bf16*)(F.ws + WS_SCR + S_VT);
    bf16* OG = (bf16*)((unsigned char*)F.out + O_OG); float* LSE = (float*)((unsigned char*)F.out + O_LSE);
    constexpr int NTASK = 3 * 16 * 8 * 64;
    const int per = (NTASK + NGW - 1) / NGW;
    const int t_lo = gw * per, t_hi = (t_lo + per) < NTASK ? (t_lo + per) : NTASK;
    for (int task = t_lo; task < t_hi; ++task) {
        const int qt = task & 3, rn = (task >> 2) & 15, bl = (task >> 6) & 7, gh = task >> 9, g = gh >> 4, hh = gh & 15;
        const int nblk = 16 >> (2 * g); const bool has_prev = (rn & (nblk - 1)) != 0;
        const int n0 = bl * 2048 + rn * 128;
        const bf16* qrow = QK + ((size_t)g * TC + n0 + 32 * qt + q) * 2048 + hh * 64;
        bf16x8 qf[4];
#pragma unroll
        for (int d0 = 0; d0 < 4; ++d0) qf[d0] = *(const bf16x8*)(qrow + d0 * 16 + 8 * h);
        float m_run = NEGB, l_run = 0.f; f32x16 o0 = {}, o1 = {};
        const bf16* vbase0 = VT + ((size_t)g * 1024 + hh * 64 + q) * TC; const bf16* vbase1 = vbase0 + (size_t)32 * TC;
        const LAS float* btl = bt + gh * 192 + (q - 8 * h + 137);
#pragma unroll
        for (int t = 0; t < 5; ++t) {
            if (has_prev || qt + t > 3) {
                const int kr0 = n0 - 128 + 32 * qt + 32 * t;
                const bf16* krow = QK + ((size_t)g * TC + kr0 + kperm(q)) * 2048 + 1024 + hh * 64;
                f32x16 s;
#pragma unroll
                for (int r = 0; r < 16; ++r) s[r] = btl[-32 * t + 23 - 16 * (r >> 3) - (r & 7)];
#pragma unroll
                for (int d0 = 0; d0 < 4; ++d0) { const bf16x8 kf = *(const bf16x8*)(krow + d0 * 16 + 8 * h); s = mfma32(kf, qf[d0], s); }
                softmax_pv(s, m_run, l_run, o0, o1, vbase0 + kr0, vbase1 + kr0, h);
            }
        }
        const float l_tot = l_run + __shfl_xor(l_run, 32), inv = 1.f / l_tot;
        const size_t orow = (size_t)g * TC + n0 + 32 * qt + q;
        bf16* op = OG + orow * 1024 + hh * 64 + 4 * h;
#pragma unroll
        for (int gq = 0; gq < 4; ++gq) {
            u32x2 w0, w1; w0.x = pg8::cvt_pk_bf16(o0[4 * gq] * inv, o0[4 * gq + 1] * inv); w0.y = pg8::cvt_pk_bf16(o0[4 * gq + 2] * inv, o0[4 * gq + 3] * inv);
            w1.x = pg8::cvt_pk_bf16(o1[4 * gq] * inv, o1[4 * gq + 1] * inv); w1.y = pg8::cvt_pk_bf16(o1[4 * gq + 2] * inv, o1[4 * gq + 3] * inv);
            *(u32x2*)(op + 8 * gq) = w0; *(u32x2*)(op + 32 + 8 * gq) = w1; }
        if (h == 0) LSE[orow * 16 + hh] = m_run + __log2f(l_tot);
    }
}
__device__ __forceinline__ void dil_merge_phase(Frame& F, int ck) {
    const int gw = F.vcu * NWAVES + F.wave, NGW = F.G * NWAVES, lane = F.lane;
    const bf16* OG = (const bf16*)((unsigned char*)F.out + O_OG); const float* LSE = (const float*)((unsigned char*)F.out + O_LSE);
    unsigned char* att = F.ws + WS_SCR + S_ATT + (size_t)ck * TC * 1024;
    const int hh = lane >> 2;
    for (int tl0 = 2 * gw; tl0 < TC; tl0 += 2 * NGW) {
        size_t n[2][3]; float ls[2][3]; u32x4 x[2][3];
#pragma unroll
        for (int k = 0; k < 2; ++k) { const int tl = tl0 + k, bl = tl >> 11, tt = tl & 2047;
            n[k][0] = tl; n[k][1] = bl * 2048 + (tt & 3) * 512 + (tt >> 2); n[k][2] = bl * 2048 + (tt & 15) * 128 + (tt >> 4);
#pragma unroll
            for (int g = 0; g < 3; ++g) { ls[k][g] = LSE[((size_t)g * TC + n[k][g]) * 16 + hh]; x[k][g] = *(const u32x4*)((const unsigned char*)OG + ((size_t)g * TC + n[k][g]) * 1024 + 16 * lane); } }
#pragma unroll
        for (int k = 0; k < 2; ++k) {
            const float M = fmaxf(fmaxf(ls[k][0], ls[k][1]), ls[k][2]);
            float w[3]; float W = 0.f;
#pragma unroll
            for (int g = 0; g < 3; ++g) { w[g] = __builtin_amdgcn_exp2f(ls[k][g] - M); W += w[g]; }
            const float iw = 1.f / W;
            float acc[16];
#pragma unroll
            for (int j = 0; j < 16; ++j) acc[j] = 0.f;
#pragma unroll
            for (int g = 0; g < 3; ++g) { const float wg = w[g] * iw; float a[16];
#pragma unroll
                for (int c = 0; c < 4; ++c) { const f32x2 lo = __builtin_amdgcn_cvt_pk_f32_fp8((int)x[k][g][c], false), hi = __builtin_amdgcn_cvt_pk_f32_fp8((int)x[k][g][c], true); a[4 * c] = lo.x; a[4 * c + 1] = lo.y; a[4 * c + 2] = hi.x; a[4 * c + 3] = hi.y; }
#pragma unroll
                for (int j = 0; j < 16; ++j) acc[j] += wg * a[j]; }
            u32x4 y; y.x = pk4_fp8(acc[0], acc[1], acc[2], acc[3]); y.y = pk4_fp8(acc[4], acc[5], acc[6], acc[7]); y.z = pk4_fp8(acc[8], acc[9], acc[10], acc[11]); y.w = pk4_fp8(acc[12], acc[13], acc[14], acc[15]);
            *(u32x4*)(att + (size_t)(tl0 + k) * 1024 + 16 * lane) = y;
        }
    }
}

__device__ __forceinline__ void conv_phase(Frame& F, const float* cw) {
    const int gw = F.vcu * NWAVES + F.wave, NGW = F.G * NWAVES, lane = F.lane;
    const bf16* gbp = (const bf16*)(F.ws + WS_SCR + S_BCX); const bf16* up = (const bf16*)(F.ws + WS_SCR + S_BCX + (size_t)128 * MiB); bf16* p = (bf16*)(F.ws + WS_SCR + S_P);
    for (int item = gw; item < (T / 32) * 2; item += NGW) {
        const int half = item & 1, tb = item >> 1, t0 = tb * 32, c0 = half * 512 + lane * 8;
        float w0[8], w1[8], w2[8];
#pragma unroll
        for (int j = 0; j < 8; ++j) { w0[j] = cw[c0 + j]; w1[j] = cw[1024 + c0 + j]; w2[j] = cw[2048 + c0 + j]; }
        float u1[8], u2[8];
        const bool first = (t0 & 2047) == 0;
#pragma unroll
        for (int j = 0; j < 8; ++j) { u1[j] = 0.f; u2[j] = 0.f; }
        if (!first) { unpack8(*(const u32x4*)(up + (size_t)(t0 - 2) * 1024 + c0), u2); unpack8(*(const u32x4*)(up + (size_t)(t0 - 1) * 1024 + c0), u1); }
        for (int i = 0; i < 32; ++i) { const size_t r = (size_t)(t0 + i) * 1024;
            const u32x4 gb = *(const u32x4*)(gbp + r + c0), uu = *(const u32x4*)(up + r + c0);
            float u0[8], b[8]; unpack8(uu, u0); unpack8(gb, b);
            float o[8];
#pragma unroll
            for (int j = 0; j < 8; ++j) { o[j] = b[j] * (w0[j] * u2[j] + w1[j] * u1[j] + w2[j] * u0[j]); u2[j] = u1[j]; u1[j] = u0[j]; }
            u32x4 x; x.x = pk2(o[0], o[1]); x.y = pk2(o[2], o[3]); x.z = pk2(o[4], o[5]); x.w = pk2(o[6], o[7]);
            *(u32x4*)(p + (size_t)(t0 + i) * 1024 + c0) = x; }
    }
}

__device__ __forceinline__ void kmean_phase(Frame& F) {
    const int gw = F.vcu * NWAVES + F.wave, NGW = F.G * NWAVES, lane = F.lane;
    const bf16* QK = (const bf16*)(F.ws + WS_SCR + S_CQK); float* km = (float*)(F.ws + WS_KMEAN);
    const int kq = lane >> 3, dc = lane & 7;
    for (int u = gw; u < NB * NH * 8; u += NGW) { const int blk = u & 7, hh = (u >> 3) & 15, b = u >> 7;
        float a[8];
#pragma unroll
        for (int j = 0; j < 8; ++j) a[j] = 0.f;
        const bf16* kp = QK + ((size_t)b * SEQ + blk * 256 + kq) * 2048 + 1024 + hh * 64 + dc * 8;
#pragma unroll 8
        for (int i = 0; i < 32; ++i) { const u32x4 x = *(const u32x4*)(kp + (size_t)i * 8 * 2048);
            a[0] += bflo(x.x); a[1] += bfhi(x.x); a[2] += bflo(x.y); a[3] += bfhi(x.y); a[4] += bflo(x.z); a[5] += bfhi(x.z); a[6] += bflo(x.w); a[7] += bfhi(x.w); }
#pragma unroll
        for (int j = 0; j < 8; ++j) { a[j] += __shfl_xor(a[j], 8); a[j] += __shfl_xor(a[j], 16); a[j] += __shfl_xor(a[j], 32); }
        if (lane < 8) { float* o = km + (size_t)u * 64 + lane * 8;
#pragma unroll
            for (int j = 0; j < 8; ++j) o[j] = a[j] * (1.f / 256.f); }
    }
}
__device__ __forceinline__ void moba_unit(Frame& F, int b, int hh, int nb, LAS float* bt, int& cur_h) {
    const int lane = F.lane, q = lane & 31, h = lane >> 5, w = F.wave;
    const bf16* QK = (const bf16*)(F.ws + WS_SCR + S_CQK); const bf16* VT = (const bf16*)(F.ws + WS_SCR + S_CVT);
    bf16* att = (bf16*)(F.ws + WS_SCR + S_CATT); const float* km = (const float*)(F.ws + WS_KMEAN);
    if (hh != cur_h) { __syncthreads(); const float* btC = (const float*)(F.ws + WS_BTABC) + hh * 2048; for (int i = F.tid; i < 2048; i += 512) bt[i] = btC[i]; cur_h = hh; __syncthreads(); }
    const size_t tq = (size_t)b * SEQ + nb * 256 + 32 * w + q;
    const bf16* qrow = QK + tq * 2048 + hh * 64;
    bf16x8 qf[4];
#pragma unroll
    for (int d0 = 0; d0 < 4; ++d0) qf[d0] = *(const bf16x8*)(qrow + d0 * 16 + 8 * h);
    unsigned sel = 0;
    if (nb > 0) {
        float gsc[7];
#pragma unroll
        for (int m = 0; m < 7; ++m) { float s = 0.f;
            if (m < nb) { const float* kmp = km + (((size_t)b * NH + hh) * 8 + m) * 64;
#pragma unroll
                for (int d0 = 0; d0 < 4; ++d0) { const f32x4 k0 = *(const f32x4*)(kmp + d0 * 16 + 8 * h), k1 = *(const f32x4*)(kmp + d0 * 16 + 8 * h + 4); const u32x4 qq = __builtin_bit_cast(u32x4, qf[d0]);
                    s += bflo(qq.x) * k0.x + bfhi(qq.x) * k0.y + bflo(qq.y) * k0.z + bfhi(qq.y) * k0.w + bflo(qq.z) * k1.x + bfhi(qq.z) * k1.y + bflo(qq.w) * k1.z + bfhi(qq.w) * k1.w; }
                s += __shfl_xor(s, 32); }
            gsc[m] = m < nb ? s : -3.0e38f; }
        const int nsel = nb < 3 ? nb : 3;
#pragma unroll
        for (int r = 0; r < 3; ++r) { if (r < nsel) { int bi = -1; float bv = -3.4e38f;
#pragma unroll
                for (int m = 0; m < 7; ++m) if (!((sel >> m) & 1u) && gsc[m] > bv) { bv = gsc[m]; bi = m; }
                sel |= 1u << bi; } }
    }
#ifdef MK_SELFCHECK
    if (h == 0) ((unsigned*)(F.ws + WS_NEED + 3 * MiB))[tq * 16 + hh] = sel;
#endif
    float m_run = NEGB, l_run = 0.f; f32x16 o0 = {}, o1 = {};
    const bf16* vbase0 = VT + ((size_t)hh * 64 + q) * T + (size_t)b * SEQ; const bf16* vbase1 = vbase0 + (size_t)32 * T;
    const int qpos = nb * 256 + 32 * w + q;
    for (int m = 0; m < nb; ++m) {
        const bool mine = (sel >> m) & 1u;
        if (__ballot(mine) == 0ull) continue;
        for (int kt = 0; kt < 8; ++kt) {
            const int kr0 = m * 256 + 32 * kt;
            const bf16* krow = QK + ((size_t)b * SEQ + kr0 + kperm(q)) * 2048 + 1024 + hh * 64;
            f32x16 s = {};
#pragma unroll
            for (int d0 = 0; d0 < 4; ++d0) { const bf16x8 kf = *(const bf16x8*)(krow + d0 * 16 + 8 * h); s = mfma32(kf, qf[d0], s); }
#pragma unroll
            for (int r = 0; r < 16; ++r) { const int kap = 16 * (r >> 3) + 8 * h + (r & 7); const float bb = bt[qpos - kr0 - kap]; s[r] = mine ? s[r] + bb : NEGB; }
            softmax_pv(s, m_run, l_run, o0, o1, vbase0 + kr0, vbase1 + kr0, h);
        }
    }
    for (int kt = 0; kt <= w; ++kt) {
        const int kr0 = nb * 256 + 32 * kt;
        const bf16* krow = QK + ((size_t)b * SEQ + kr0 + kperm(q)) * 2048 + 1024 + hh * 64;
        f32x16 s = {};
#pragma unroll
        for (int d0 = 0; d0 < 4; ++d0) { const bf16x8 kf = *(const bf16x8*)(krow + d0 * 16 + 8 * h); s = mfma32(kf, qf[d0], s); }
#pragma unroll
        for (int r = 0; r < 16; ++r) { const int kap = 16 * (r >> 3) + 8 * h + (r & 7); const int dd = qpos - kr0 - kap; const float bb = bt[dd < 0 ? 0 : dd]; s[r] = dd >= 0 ? s[r] + bb : NEGB; }
        softmax_pv(s, m_run, l_run, o0, o1, vbase0 + kr0, vbase1 + kr0, h);
    }
    const float l_tot = l_run + __shfl_xor(l_run, 32), inv = 1.f / l_tot;
#ifdef MK_SELFCHECK
    if (h == 0) ((float*)(F.ws + WS_NEED + 7 * MiB))[tq * 16 + hh] = m_run + __log2f(l_tot);
#endif
    bf16* op = att + tq * 1024 + hh * 64 + 4 * h;
#pragma unroll
    for (int gq = 0; gq < 4; ++gq) {
        u32x2 w0, w1; w0.x = pg8::cvt_pk_bf16(o0[4 * gq] * inv, o0[4 * gq + 1] * inv); w0.y = pg8::cvt_pk_bf16(o0[4 * gq + 2] * inv, o0[4 * gq + 3] * inv);
        w1.x = pg8::cvt_pk_bf16(o1[4 * gq] * inv, o1[4 * gq + 1] * inv); w1.y = pg8::cvt_pk_bf16(o1[4 * gq + 2] * inv, o1[4 * gq + 3] * inv);
        *(u32x2*)(op + 8 * gq) = w0; *(u32x2*)(op + 32 + 8 * gq) = w1; }
}
__device__ __forceinline__ void moba_phase(Frame& F) {
    LAS float* bt = (LAS float*)F.lds; int cur_h = -1;
    const int NP = NB * NH * 4, per = (NP + F.G - 1) / F.G;
    const int lo = F.vcu * per, hi = (lo + per) < NP ? (lo + per) : NP;
    for (int pu = lo; pu < hi; ++pu) { const int j = pu & 3, hh = (pu >> 2) & 15, b = pu >> 6;
        moba_unit(F, b, hh, 7 - j, bt, cur_h); moba_unit(F, b, hh, j, bt, cur_h); }
}


constexpr int AKP = 72;
constexpr int ATILE = 64 * AKP * 2;
struct AttnSt { float m, l; f32x16 o0, o1; };
template <bool MASKED>
__device__ __forceinline__ void attn_tile(const LAS bf16* Kt, const LAS bf16* Vt, const LAS float* bl, const bf16x8 (&qf)[4], AttnSt& st, int q, int h, bool mine) {
    f32x16 s;
#pragma unroll
    for (int r = 0; r < 16; ++r) s[r] = bl[23 - 16 * (r >> 3) - (r & 7)];
    const LAS bf16* kr = Kt + kperm(q) * AKP + 8 * h;
#pragma unroll
    for (int d0 = 0; d0 < 4; ++d0) s = mfma32(*(const LAS bf16x8*)(kr + d0 * 16), qf[d0], s);
    float mx = max16(s); mx = fmaxf(mx, __shfl_xor(mx, 32));
    float mn = fmaxf(st.m, mx); if (MASKED) mn = mine ? mn : st.m;
    const float alpha = __builtin_amdgcn_exp2f(st.m - mn);
    float ps = 0.f;
#pragma unroll
    for (int r = 0; r < 16; ++r) { const float p = __builtin_amdgcn_exp2f(s[r] - mn); s[r] = p; ps += p; }
    bf16x8 p0 = pack8(s, 0), p1 = pack8(s, 8);
    if (MASKED) { if (!mine) { p0 = (bf16x8){0, 0, 0, 0, 0, 0, 0, 0}; p1 = p0; ps = 0.f; } }
    st.l = st.l * alpha + ps; st.m = mn;
    if (__ballot(alpha != 1.0f) != 0ull) {
#pragma unroll
        for (int r = 0; r < 16; ++r) { st.o0[r] *= alpha; st.o1[r] *= alpha; } }
    const LAS bf16* v0 = Vt + q * AKP + 8 * h; const LAS bf16* v1 = v0 + 32 * AKP;
    st.o0 = mfma32(*(const LAS bf16x8*)v0, p0, st.o0); st.o0 = mfma32(*(const LAS bf16x8*)(v0 + 16), p1, st.o0);
    st.o1 = mfma32(*(const LAS bf16x8*)v1, p0, st.o1); st.o1 = mfma32(*(const LAS bf16x8*)(v1 + 16), p1, st.o1);
}
__device__ __forceinline__ void attn_store(const AttnSt& st, bf16* op  , float inv) {
#pragma unroll
    for (int gq = 0; gq < 4; ++gq) {
        u32x2 w0, w1; w0.x = pg8::cvt_pk_bf16(st.o0[4 * gq] * inv, st.o0[4 * gq + 1] * inv); w0.y = pg8::cvt_pk_bf16(st.o0[4 * gq + 2] * inv, st.o0[4 * gq + 3] * inv);
        w1.x = pg8::cvt_pk_bf16(st.o1[4 * gq] * inv, st.o1[4 * gq + 1] * inv); w1.y = pg8::cvt_pk_bf16(st.o1[4 * gq + 2] * inv, st.o1[4 * gq + 3] * inv);
        *(u32x2*)(op + 8 * gq) = w0; *(u32x2*)(op + 32 + 8 * gq) = w1; }
}

__device__ __forceinline__ void attn_store8(const AttnSt& st, unsigned char* op  , float inv) {
#pragma unroll
    for (int gq = 0; gq < 4; ++gq) {
        *(unsigned*)(op + 8 * gq) = pk4_fp8(st.o0[4 * gq] * inv, st.o0[4 * gq + 1] * inv, st.o0[4 * gq + 2] * inv, st.o0[4 * gq + 3] * inv);
        *(unsigned*)(op + 32 + 8 * gq) = pk4_fp8(st.o1[4 * gq] * inv, st.o1[4 * gq + 1] * inv, st.o1[4 * gq + 2] * inv, st.o1[4 * gq + 3] * inv); }
}

__device__ __forceinline__ void dil_attn_phase2(Frame& F) {
    LAS float* bt = (LAS float*)F.lds;
    { const float* btA = (const float*)(F.ws + WS_BTABA); for (int i = F.tid; i < 48 * 192; i += 512) { const int gh = i / 192, dl = i % 192 - 32; bt[i] = (dl >= 0 && dl <= 128) ? btA[gh * 132 + dl] : NEGB; } }
    __syncthreads();
    constexpr int TBL = 48 * 192 * 4;
    const int lane = F.lane, q = lane & 31, h = lane >> 5, w = F.wave, uw = w >> 2, qt = w & 3, t = F.tid, tu = t >> 8, tt = t & 255, srow = tt >> 3, sch = tt & 7;
    const bf16* QK = (const bf16*)(F.ws + WS_SCR + S_QK); const bf16* VT = (const bf16*)(F.ws + WS_SCR + S_VT);
    bf16* OG = (bf16*)((unsigned char*)F.out + O_OG); float* LSE = (float*)((unsigned char*)F.out + O_LSE);
    for (int du = F.vcu; du < 3072; du += F.G) {
        const int g = du >> 10, rem = du & 1023, hh = rem >> 6, blp = (rem >> 4) & 3, rn = rem & 15, gh = g * 16 + hh;
        const int nblk = 16 >> (2 * g); const bool has_prev = (rn & (nblk - 1)) != 0;
        const int j0 = has_prev ? 0 : 2;
        const int n0s = (2 * blp + tu) * 2048 + rn * 128;
        const bf16* ksrc = QK + ((size_t)g * TC + n0s - 128 + srow) * 2048 + 1024 + hh * 64 + sch * 8;
        const bf16* vsrc = VT + ((size_t)g * 1024 + hh * 64 + srow) * TC + (n0s - 128) + sch * 8;
        const int sdst = srow * AKP + sch * 8;
        const int n0 = (2 * blp + uw) * 2048 + rn * 128;
        const bf16* qrow = QK + ((size_t)g * TC + n0 + 32 * qt + q) * 2048 + hh * 64;
        bf16x8 qf[4];
#pragma unroll
        for (int d0 = 0; d0 < 4; ++d0) qf[d0] = *(const bf16x8*)(qrow + d0 * 16 + 8 * h);
        AttnSt st; st.m = NEGB; st.l = 0.f; st.o0 = (f32x16){}; st.o1 = (f32x16){};
        u32x4 k0, k1, v0, v1;
        k0 = *(const u32x4*)(ksrc + (size_t)(64 * j0) * 2048); k1 = *(const u32x4*)(ksrc + (size_t)(64 * j0 + 32) * 2048);
        v0 = *(const u32x4*)(vsrc + 64 * j0); v1 = *(const u32x4*)(vsrc + (size_t)32 * TC + 64 * j0);
        { LAS bf16* kb = (LAS bf16*)(F.lds + TBL + (0 * 2 + tu) * 2 * ATILE); LAS bf16* vb = kb + 64 * AKP;
          *(LAS u32x4*)(kb + sdst) = k0; *(LAS u32x4*)(kb + 32 * AKP + sdst) = k1; *(LAS u32x4*)(vb + sdst) = v0; *(LAS u32x4*)(vb + 32 * AKP + sdst) = v1; }
        __syncthreads();
        int pb = 0;
        for (int j = j0; j < 4; ++j) {
            const bool more = j + 1 < 4;
            if (more) { k0 = *(const u32x4*)(ksrc + (size_t)(64 * (j + 1)) * 2048); k1 = *(const u32x4*)(ksrc + (size_t)(64 * (j + 1) + 32) * 2048);
                        v0 = *(const u32x4*)(vsrc + 64 * (j + 1)); v1 = *(const u32x4*)(vsrc + (size_t)32 * TC + 64 * (j + 1)); }
            const LAS bf16* kb = (const LAS bf16*)(F.lds + TBL + (pb * 2 + uw) * 2 * ATILE); const LAS bf16* vb = kb + 64 * AKP;
#pragma unroll
            for (int t2 = 0; t2 < 2; ++t2) { const int t32 = 2 * j + t2;
                if (t32 >= qt && t32 <= qt + 4) {
                    const LAS float* bl = bt + gh * 192 + 32 + (32 * qt + q + 128 - 32 * t32 - 8 * h - 23);
                    attn_tile<false>(kb + 32 * t2 * AKP, vb + 32 * t2, bl, qf, st, q, h, true); } }
            if (more) { LAS bf16* kn = (LAS bf16*)(F.lds + TBL + ((pb ^ 1) * 2 + tu) * 2 * ATILE); LAS bf16* vn = kn + 64 * AKP;
                *(LAS u32x4*)(kn + sdst) = k0; *(LAS u32x4*)(kn + 32 * AKP + sdst) = k1; *(LAS u32x4*)(vn + sdst) = v0; *(LAS u32x4*)(vn + 32 * AKP + sdst) = v1; }
            __syncthreads();
            pb ^= 1;
        }
        const float l_tot = st.l + __shfl_xor(st.l, 32), inv = 1.f / l_tot;
        const size_t orow = (size_t)g * TC + n0 + 32 * qt + q;
        attn_store(st, OG + orow * 1024 + hh * 64 + 4 * h, inv);
        if (h == 0) LSE[orow * 16 + hh] = st.m + __log2f(l_tot);
    }
}

__device__ __forceinline__ void moba_unit2(Frame& F, int b, int hh, int nb, LAS float* bt, int& cur_h) {
    constexpr int TBL = 8448;
    const int lane = F.lane, q = lane & 31, h = lane >> 5, w = F.wave, t = F.tid, srow = t >> 3, sch = t & 7;
    const bf16* QK = (const bf16*)(F.ws + WS_SCR + S_CQK); const bf16* VT = (const bf16*)(F.ws + WS_SCR + S_CVT);
    bf16* att = (bf16*)(F.ws + WS_SCR + S_CATT); const float* km = (const float*)(F.ws + WS_KMEAN);
    if (hh != cur_h) { __syncthreads(); const float* btC = (const float*)(F.ws + WS_BTABC) + hh * 2048; for (int i = t; i < 2048 + 32; i += 512) bt[i] = i < 32 ? NEGB : btC[i - 32]; cur_h = hh; __syncthreads(); }
    const size_t tq = (size_t)b * SEQ + nb * 256 + 32 * w + q;
    const bf16* qrow = QK + tq * 2048 + hh * 64;
    bf16x8 qf[4];
#pragma unroll
    for (int d0 = 0; d0 < 4; ++d0) qf[d0] = *(const bf16x8*)(qrow + d0 * 16 + 8 * h);
    unsigned sel = 0;
    if (nb > 0) {
        float gsc[7];
#pragma unroll
        for (int m = 0; m < 7; ++m) { float s = 0.f;
            if (m < nb) { const float* kmp = km + (((size_t)b * NH + hh) * 8 + m) * 64;
#pragma unroll
                for (int d0 = 0; d0 < 4; ++d0) { const f32x4 k0 = *(const f32x4*)(kmp + d0 * 16 + 8 * h), k1 = *(const f32x4*)(kmp + d0 * 16 + 8 * h + 4); const u32x4 qq = __builtin_bit_cast(u32x4, qf[d0]);
                    s += bflo(qq.x) * k0.x + bfhi(qq.x) * k0.y + bflo(qq.y) * k0.z + bfhi(qq.y) * k0.w + bflo(qq.z) * k1.x + bfhi(qq.z) * k1.y + bflo(qq.w) * k1.z + bfhi(qq.w) * k1.w; }
                s += __shfl_xor(s, 32); }
            gsc[m] = m < nb ? s : -3.0e38f; }
        const int nsel = nb < 3 ? nb : 3;
#pragma unroll
        for (int r = 0; r < 3; ++r) { if (r < nsel) { int bi = 0; float bv = -3.4e38f;
#pragma unroll
                for (int m = 0; m < 7; ++m) if (!((sel >> m) & 1u) && gsc[m] > bv) { bv = gsc[m]; bi = m; }
                sel |= 1u << bi; } }
    }
    AttnSt st; st.m = NEGB; st.l = 0.f; st.o0 = (f32x16){}; st.o1 = (f32x16){};
    const int qpos = nb * 256 + 32 * w + q, nsteps = 4 * nb + 4;
    const bf16* ksrc = QK + ((size_t)b * SEQ + srow) * 2048 + 1024 + hh * 64 + sch * 8;
    const bf16* vsrc = VT + ((size_t)hh * 64 + srow) * T + (size_t)b * SEQ + sch * 8;
    const int sdst = srow * AKP + sch * 8;
    u32x4 kreg = *(const u32x4*)ksrc, vreg = *(const u32x4*)vsrc;
    { LAS bf16* kb = (LAS bf16*)(F.lds + TBL); *(LAS u32x4*)(kb + sdst) = kreg; *(LAS u32x4*)(kb + 64 * AKP + sdst) = vreg; }
    __syncthreads();
    int pb = 0;
    for (int s = 0; s < nsteps; ++s) {
        const bool more = s + 1 < nsteps;
        if (more) { kreg = *(const u32x4*)(ksrc + (size_t)(64 * (s + 1)) * 2048); vreg = *(const u32x4*)(vsrc + 64 * (s + 1)); }
        const LAS bf16* kb = (const LAS bf16*)(F.lds + TBL + pb * 2 * ATILE); const LAS bf16* vb = kb + 64 * AKP;
        if (s < 4 * nb) {
            const bool mine = (sel >> (s >> 2)) & 1u;
            if (__ballot(mine) != 0ull) {
#pragma unroll
                for (int t2 = 0; t2 < 2; ++t2) { const LAS float* bl = bt + 32 + (qpos - 8 * h - (64 * s + 32 * t2) - 23);
                    attn_tile<true>(kb + 32 * t2 * AKP, vb + 32 * t2, bl, qf, st, q, h, mine); } }
        } else {
#pragma unroll
            for (int t2 = 0; t2 < 2; ++t2) { const int t32 = (s - 4 * nb) * 2 + t2;
                if (t32 <= w) { const LAS float* bl = bt + 32 + (qpos - 8 * h - (64 * s + 32 * t2) - 23);
                    attn_tile<false>(kb + 32 * t2 * AKP, vb + 32 * t2, bl, qf, st, q, h, true); } }
        }
        if (more) { LAS bf16* kn = (LAS bf16*)(F.lds + TBL + (pb ^ 1) * 2 * ATILE); *(LAS u32x4*)(kn + sdst) = kreg; *(LAS u32x4*)(kn + 64 * AKP + sdst) = vreg; }
        __syncthreads();
        pb ^= 1;
    }
    const float l_tot = st.l + __shfl_xor(st.l, 32), inv = 1.f / l_tot;
    attn_store(st, att + tq * 1024 + hh * 64 + 4 * h, inv);
}
__device__ __forceinline__ void moba_phase2(Frame& F) {
    LAS float* bt = (LAS float*)F.lds; int cur_h = -1;
    const int NP = NB * NH * 4, per = (NP + F.G - 1) / F.G;
    const int lo = F.vcu * per, hi = (lo + per) < NP ? (lo + per) : NP;
    for (int pu = lo; pu < hi; ++pu) { const int j = pu & 3, hh = (pu >> 2) & 15, b = pu >> 6;
        moba_unit2(F, b, hh, 7 - j, bt, cur_h); moba_unit2(F, b, hh, j, bt, cur_h); }
}


__device__ __forceinline__ float xhalf_max(float m) { auto rr = __builtin_amdgcn_permlane32_swap(__float_as_uint(m), __float_as_uint(m), false, false); return fmaxf(__uint_as_float(rr[0]), __uint_as_float(rr[1])); }
__device__ __forceinline__ float xhalf_sum(float m) { auto rr = __builtin_amdgcn_permlane32_swap(__float_as_uint(m), __float_as_uint(m), false, false); return __uint_as_float(rr[0]) + __uint_as_float(rr[1]); }
template <bool MASKED>
__device__ __forceinline__ void attn_tile2(const LAS bf16* Kt, const LAS bf16* Vt, const LAS float* bl0, const bf16x8 (&qf)[4], AttnSt& st, int q, int h, bool mine) {
    f32x16 s0, s1;
#pragma unroll
    for (int r = 0; r < 16; ++r) { s0[r] = bl0[23 - 16 * (r >> 3) - (r & 7)]; s1[r] = bl0[-32 + 23 - 16 * (r >> 3) - (r & 7)]; }
    const LAS bf16* kr = Kt + kperm(q) * AKP + 8 * h;
#pragma unroll
    for (int d0 = 0; d0 < 4; ++d0) { s0 = mfma32(*(const LAS bf16x8*)(kr + d0 * 16), qf[d0], s0); s1 = mfma32(*(const LAS bf16x8*)(kr + 32 * AKP + d0 * 16), qf[d0], s1); }
    const float mx = xhalf_max(fmaxf(max16(s0), max16(s1)));
    float mn = fmaxf(st.m, mx); if (MASKED) mn = mine ? mn : st.m;
    const float alpha = __builtin_amdgcn_exp2f(st.m - mn);
    float ps0 = 0.f, ps1 = 0.f;
#pragma unroll
    for (int r = 0; r < 16; ++r) { const float p = __builtin_amdgcn_exp2f(s0[r] - mn); s0[r] = p; ps0 += p; const float p2 = __builtin_amdgcn_exp2f(s1[r] - mn); s1[r] = p2; ps1 += p2; }
    bf16x8 p00 = pack8(s0, 0), p01 = pack8(s0, 8), p10 = pack8(s1, 0), p11 = pack8(s1, 8);
    float ps = ps0 + ps1;
    if (MASKED) { if (!mine) { p00 = (bf16x8){0, 0, 0, 0, 0, 0, 0, 0}; p01 = p00; p10 = p00; p11 = p00; ps = 0.f; } }
    st.l = st.l * alpha + ps; st.m = mn;
    if (__ballot(alpha != 1.0f) != 0ull) {
#pragma unroll
        for (int r = 0; r < 16; ++r) { st.o0[r] *= alpha; st.o1[r] *= alpha; } }
    const LAS bf16* v0 = Vt + q * AKP + 8 * h; const LAS bf16* v1 = v0 + 32 * AKP;
    st.o0 = mfma32(*(const LAS bf16x8*)v0, p00, st.o0); st.o1 = mfma32(*(const LAS bf16x8*)v1, p00, st.o1);
    st.o0 = mfma32(*(const LAS bf16x8*)(v0 + 16), p01, st.o0); st.o1 = mfma32(*(const LAS bf16x8*)(v1 + 16), p01, st.o1);
    st.o0 = mfma32(*(const LAS bf16x8*)(v0 + 32), p10, st.o0); st.o1 = mfma32(*(const LAS bf16x8*)(v1 + 32), p10, st.o1);
    st.o0 = mfma32(*(const LAS bf16x8*)(v0 + 48), p11, st.o0); st.o1 = mfma32(*(const LAS bf16x8*)(v1 + 48), p11, st.o1);
}

__device__ __forceinline__ void attn_tile2r(const LAS bf16* Kt, const LAS bf16* Vt, const LAS float* b0, const LAS float* b1, const bf16x8 (&qf)[4], AttnSt& st, int q, int h) {
    f32x16 s0, s1;
#pragma unroll
    for (int r = 0; r < 16; ++r) { s0[r] = b0[16 * (r >> 3) + (r & 7)]; s1[r] = b1[16 * (r >> 3) + (r & 7)]; }
    const LAS bf16* kr = Kt + kperm(q) * AKP + 8 * h;
#pragma unroll
    for (int d0 = 0; d0 < 4; ++d0) { s0 = mfma32(*(const LAS bf16x8*)(kr + d0 * 16), qf[d0], s0); s1 = mfma32(*(const LAS bf16x8*)(kr + 32 * AKP + d0 * 16), qf[d0], s1); }
    const float mx = xhalf_max(fmaxf(max16(s0), max16(s1)));
    const float mn = fmaxf(st.m, mx);
    const float alpha = __builtin_amdgcn_exp2f(st.m - mn);
    float ps0 = 0.f, ps1 = 0.f;
#pragma unroll
    for (int r = 0; r < 16; ++r) { const float p = __builtin_amdgcn_exp2f(s0[r] - mn); s0[r] = p; ps0 += p; const float p2 = __builtin_amdgcn_exp2f(s1[r] - mn); s1[r] = p2; ps1 += p2; }
    const bf16x8 p00 = pack8(s0, 0), p01 = pack8(s0, 8), p10 = pack8(s1, 0), p11 = pack8(s1, 8);
    st.l = st.l * alpha + (ps0 + ps1); st.m = mn;
    if (__ballot(alpha != 1.0f) != 0ull) {
#pragma unroll
        for (int r = 0; r < 16; ++r) { st.o0[r] *= alpha; st.o1[r] *= alpha; } }
    const LAS bf16* v0 = Vt + q * AKP + 8 * h; const LAS bf16* v1 = v0 + 32 * AKP;
    st.o0 = mfma32(*(const LAS bf16x8*)v0, p00, st.o0); st.o1 = mfma32(*(const LAS bf16x8*)v1, p00, st.o1);
    st.o0 = mfma32(*(const LAS bf16x8*)(v0 + 16), p01, st.o0); st.o1 = mfma32(*(const LAS bf16x8*)(v1 + 16), p01, st.o1);
    st.o0 = mfma32(*(const LAS bf16x8*)(v0 + 32), p10, st.o0); st.o1 = mfma32(*(const LAS bf16x8*)(v1 + 32), p10, st.o1);
    st.o0 = mfma32(*(const LAS bf16x8*)(v0 + 48), p11, st.o0); st.o1 = mfma32(*(const LAS bf16x8*)(v1 + 48), p11, st.o1);
}

__device__ __forceinline__ u32x4 f8x8_bf16(u32x2 v) {
    const f32x2 a = __builtin_amdgcn_cvt_pk_f32_fp8((int)v.x, false), b = __builtin_amdgcn_cvt_pk_f32_fp8((int)v.x, true), c = __builtin_amdgcn_cvt_pk_f32_fp8((int)v.y, false), d = __builtin_amdgcn_cvt_pk_f32_fp8((int)v.y, true);
    u32x4 r; r.x = pg8::cvt_pk_bf16(a.x, a.y); r.y = pg8::cvt_pk_bf16(b.x, b.y); r.z = pg8::cvt_pk_bf16(c.x, c.y); r.w = pg8::cvt_pk_bf16(d.x, d.y); return r;
}
__device__ __forceinline__ void dil_attn_phase3(Frame& F) {
    LAS float* bt = (LAS float*)F.lds;
    { const float* btA = (const float*)(F.ws + WS_BTABA); for (int i = F.tid; i < 48 * 192; i += 512) { const int gh = i / 192, dl = 159 - i % 192; bt[i] = (dl >= 0 && dl <= 128) ? btA[gh * 132 + dl] : NEGB; } }
    constexpr int TBL = 48 * 192 * 4;
    const int lane = F.lane, q = lane & 31, h = lane >> 5, w = F.wave, uw = w >> 2, qt = w & 3, t = F.tid, tu = t >> 8, tt = t & 255, srow = tt >> 3, sch = tt & 7;
    const unsigned char* QK = F.ws + WS_SCR + S_QK; const unsigned char* VT = F.ws + WS_SCR + S_VT;
    bf16* OG = (bf16*)((unsigned char*)F.out + O_OG); float* LSE = (float*)((unsigned char*)F.out + O_LSE);
    const int sdst = srow * AKP + sch * 8;
    int du = F.vcu;
    if (du >= 3072) { __syncthreads(); return; }
    int g = du >> 10, hh = (du >> 6) & 15, blp = (du >> 4) & 3, rn = du & 15;
    int j = ((rn & ((16 >> (2 * g)) - 1)) != 0) ? 0 : 2;
    u32x2 k0, k1, v0, v1; u32x2 qn[4]; bf16x8 qf[4];
#define DIL_LOADS(G_, HH_, BLP_, RN_, J_) do { const int n0s_ = (2 * (BLP_) + tu) * 2048 + (RN_) * 128 - 128 + 64 * (J_); \
        const unsigned char* ks_ = QK + ((size_t)(G_) * TC + n0s_ + srow) * 2048 + 1024 + (HH_) * 64 + sch * 8; \
        const unsigned char* vs_ = VT + ((size_t)(G_) * 1024 + (HH_) * 64 + srow) * TC + n0s_ + sch * 8; \
        k0 = *(const u32x2*)ks_; k1 = *(const u32x2*)(ks_ + (size_t)32 * 2048); v0 = *(const u32x2*)vs_; v1 = *(const u32x2*)(vs_ + (size_t)32 * TC); } while (0)
#define DIL_QLOADS(G_, HH_, BLP_, RN_) do { const unsigned char* qr_ = QK + ((size_t)(G_) * TC + (2 * (BLP_) + uw) * 2048 + (RN_) * 128 + 32 * qt + q) * 2048 + (HH_) * 64; \
        _Pragma("unroll") for (int d0 = 0; d0 < 4; ++d0) qn[d0] = *(const u32x2*)(qr_ + d0 * 16 + 8 * h); } while (0)
#define DIL_WRITE(PB_) do { LAS bf16* kb_ = (LAS bf16*)(F.lds + TBL + ((PB_) * 2 + tu) * 2 * ATILE); LAS bf16* vb_ = kb_ + 64 * AKP; \
        *(LAS u32x4*)(kb_ + sdst) = f8x8_bf16(k0); *(LAS u32x4*)(kb_ + 32 * AKP + sdst) = f8x8_bf16(k1); *(LAS u32x4*)(vb_ + sdst) = f8x8_bf16(v0); *(LAS u32x4*)(vb_ + 32 * AKP + sdst) = f8x8_bf16(v1); } while (0)
    DIL_LOADS(g, hh, blp, rn, j); DIL_QLOADS(g, hh, blp, rn);
    DIL_WRITE(0);
#pragma unroll
    for (int d0 = 0; d0 < 4; ++d0) qf[d0] = __builtin_bit_cast(bf16x8, f8x8_bf16(qn[d0]));
    __syncthreads();
    AttnSt st; st.m = NEGB; st.l = 0.f; st.o0 = (f32x16){}; st.o1 = (f32x16){};
    int pb = 0;
    for (;;) {
        const bool last = (j == 3);
        int ng = g, nhh = hh, nblp = blp, nrn = rn, nj = j + 1; bool more = true;
        if (last) { const int nd = du + F.G; more = nd < 3072; ng = nd >> 10; nhh = (nd >> 6) & 15; nblp = (nd >> 4) & 3; nrn = nd & 15; nj = ((nrn & ((16 >> (2 * ng)) - 1)) != 0) ? 0 : 2; }
        if (more) { DIL_LOADS(ng, nhh, nblp, nrn, nj); if (last) DIL_QLOADS(ng, nhh, nblp, nrn); }
        { const LAS bf16* kb = (const LAS bf16*)(F.lds + TBL + (pb * 2 + uw) * 2 * ATILE); const LAS bf16* vb = kb + 64 * AKP;
          const int gh = g * 16 + hh, ta = 2 * j, tb = 2 * j + 1;
          const bool a_on = ta >= qt && ta <= qt + 4, b_on = tb >= qt && tb <= qt + 4;
          const LAS float* row = bt + gh * 192;
          const LAS float* ba = row + (168 - (32 + (32 * qt + q + 128 - 32 * ta - 8 * h - 23)));
          if (a_on || b_on) attn_tile2r(kb, vb, a_on ? ba : row + 160, b_on ? ba + 32 : row + 160, qf, st, q, h); }
        if (more) DIL_WRITE(pb ^ 1);
        if (last) {
            const float l_tot = xhalf_sum(st.l), inv = 1.f / l_tot;
            const size_t orow = (size_t)g * TC + (2 * blp + uw) * 2048 + rn * 128 + 32 * qt + q;
            attn_store8(st, (unsigned char*)OG + orow * 1024 + hh * 64 + 4 * h, inv * ASCALE8);
            if (h == 0) LSE[orow * 16 + hh] = st.m + __log2f(l_tot);
            st.m = NEGB; st.l = 0.f; st.o0 = (f32x16){}; st.o1 = (f32x16){};
#pragma unroll
            for (int d0 = 0; d0 < 4; ++d0) qf[d0] = __builtin_bit_cast(bf16x8, f8x8_bf16(qn[d0]));
        }
        __syncthreads();
        pb ^= 1;
        if (!more) break;
        if (last) du += F.G;
        g = ng; hh = nhh; blp = nblp; rn = nrn; j = nj;
    }
#undef DIL_LOADS
#undef DIL_QLOADS
#undef DIL_WRITE
}

__device__ __forceinline__ void moba_phase3(Frame& F) {
    constexpr int TBL = 8448, KMO = TBL + 4 * ATILE;
    LAS float* bt = (LAS float*)F.lds; LAS float* kml = (LAS float*)(F.lds + KMO);
    const int lane = F.lane, q = lane & 31, h = lane >> 5, w = F.wave, t = F.tid, srow = t >> 3, sch = t & 7;
    const bf16* QK = (const bf16*)(F.ws + WS_SCR + S_CQK); const bf16* VT = (const bf16*)(F.ws + WS_SCR + S_CVT);
    bf16* att = (bf16*)(F.ws + WS_SCR + S_CATT); const float* km = (const float*)(F.ws + WS_KMEAN);
    const int NP = NB * NH * 4, per = (NP + F.G - 1) / F.G;
    const int lo = F.vcu * per, hi = (lo + per) < NP ? (lo + per) : NP;
    const int nunits = 2 * (hi - lo);
    if (nunits <= 0) return;
    const int sdst = srow * AKP + sch * 8;
    int u = 0, cur_bh = -1;
    u32x4 kreg, vreg; bf16x8 qn[4], qf[4];
#define MB_LOADS(B_, HH_, S_) do { const bf16* ks_ = QK + ((size_t)(B_) * SEQ + 64 * (S_) + srow) * 2048 + 1024 + (HH_) * 64 + sch * 8; \
        const bf16* vs_ = VT + ((size_t)(HH_) * 64 + srow) * T + (size_t)(B_) * SEQ + 64 * (S_) + sch * 8; kreg = *(const u32x4*)ks_; vreg = *(const u32x4*)vs_; } while (0)
#define MB_QLOADS(B_, HH_, NB_) do { const bf16* qr_ = QK + ((size_t)(B_) * SEQ + (NB_) * 256 + 32 * w + q) * 2048 + (HH_) * 64; \
        _Pragma("unroll") for (int d0 = 0; d0 < 4; ++d0) qn[d0] = *(const bf16x8*)(qr_ + d0 * 16 + 8 * h); } while (0)
#define MB_WRITE(PB_) do { LAS bf16* kb_ = (LAS bf16*)(F.lds + TBL + (PB_) * 2 * ATILE); *(LAS u32x4*)(kb_ + sdst) = kreg; *(LAS u32x4*)(kb_ + 64 * AKP + sdst) = vreg; } while (0)
    int pu = lo, jj = pu & 3, hh = (pu >> 2) & 15, b = pu >> 6, nb = 7 - jj, s = 0, pb = 0;
    MB_LOADS(b, hh, 0); MB_QLOADS(b, hh, nb); MB_WRITE(0);
    unsigned sel = 0; bool fresh = true;
    AttnSt st; st.m = NEGB; st.l = 0.f; st.o0 = (f32x16){}; st.o1 = (f32x16){};
    for (;;) {
        if (fresh) {
            if (b * 16 + hh != cur_bh) { __syncthreads(); const float* btC = (const float*)(F.ws + WS_BTABC) + hh * 2048;
                for (int i = t; i < 2048 + 32; i += 512) bt[2079 - i] = i < 32 ? NEGB : btC[i - 32];
                { const float* kmp = km + ((size_t)b * NH + hh) * 512; kml[t] = kmp[t]; }
                cur_bh = b * 16 + hh; }
#pragma unroll
            for (int d0 = 0; d0 < 4; ++d0) qf[d0] = qn[d0];
            __syncthreads();
            sel = 0;
            if (nb > 0) {
                float gsc[7];
#pragma unroll
                for (int m = 0; m < 7; ++m) { float sc = 0.f;
                    if (m < nb) {
#pragma unroll
                        for (int d0 = 0; d0 < 4; ++d0) { const f32x4 c0 = *(const LAS f32x4*)(kml + m * 64 + d0 * 16 + 8 * h), c1 = *(const LAS f32x4*)(kml + m * 64 + d0 * 16 + 8 * h + 4); const u32x4 qq = __builtin_bit_cast(u32x4, qf[d0]);
                            sc += bflo(qq.x) * c0.x + bfhi(qq.x) * c0.y + bflo(qq.y) * c0.z + bfhi(qq.y) * c0.w + bflo(qq.z) * c1.x + bfhi(qq.z) * c1.y + bflo(qq.w) * c1.z + bfhi(qq.w) * c1.w; }
                        sc = xhalf_sum(sc); }
                    gsc[m] = m < nb ? sc : -3.0e38f; }
                const int nsel = nb < 3 ? nb : 3;
#pragma unroll
                for (int r = 0; r < 3; ++r) { if (r < nsel) { int bi = 0; float bv = -3.4e38f;
#pragma unroll
                        for (int m = 0; m < 7; ++m) if (!((sel >> m) & 1u) && gsc[m] > bv) { bv = gsc[m]; bi = m; }
                        sel |= 1u << bi; } }
            }
            fresh = false;
        }
        const int nsteps = 4 * nb + 4;
        const bool last = (s + 1 == nsteps);
        int nb2 = nb, b2 = b, hh2 = hh, s2 = s + 1; bool more = true;
        if (last) { const int u2 = u + 1; more = u2 < nunits; const int pu2 = lo + (u2 >> 1), j2 = pu2 & 3; hh2 = (pu2 >> 2) & 15; b2 = pu2 >> 6; nb2 = (u2 & 1) ? j2 : 7 - j2; s2 = 0; }
        if (more) { MB_LOADS(b2, hh2, s2); if (last) MB_QLOADS(b2, hh2, nb2); }
        { const LAS bf16* kb = (const LAS bf16*)(F.lds + TBL + pb * 2 * ATILE); const LAS bf16* vb = kb + 64 * AKP;
          const int qpos = nb * 256 + 32 * w + q;
          const LAS float* ba = bt + (2056 - (32 + (qpos - 8 * h - 64 * s - 23)));
          const LAS float* negp = bt + 2048;
          bool act; const LAS float* p0; const LAS float* p1;
          if (s < 4 * nb) { const bool mine = (sel >> (s >> 2)) & 1u; act = __ballot(mine) != 0ull; p0 = mine ? ba : negp; p1 = mine ? ba + 32 : negp; }
          else { const int ta = (s - 4 * nb) * 2; act = ta <= w; p0 = ba; p1 = (ta + 1 <= w) ? ba + 32 : negp; }
          if (act) attn_tile2r(kb, vb, p0, p1, qf, st, q, h); }
        if (more) MB_WRITE(pb ^ 1);
        if (last) {
            const float l_tot = xhalf_sum(st.l), inv = 1.f / l_tot;
            const size_t tq = (size_t)b * SEQ + nb * 256 + 32 * w + q;
            attn_store8(st, (unsigned char*)att + tq * 1024 + hh * 64 + 4 * h, inv * ASCALE8);
            st.m = NEGB; st.l = 0.f; st.o0 = (f32x16){}; st.o1 = (f32x16){};
        }
        if (!last) __syncthreads();
        pb ^= 1;
        if (!more) break;
        if (last) { ++u; fresh = true; }
        nb = nb2; b = b2; hh = hh2; s = s2;
    }
#undef MB_LOADS
#undef MB_QLOADS
#undef MB_WRITE
}

__device__ __forceinline__ void gmlp_phase(Frame& F, const float* lng, const float* lnb, const float* bs) {
    const int lane = F.lane, w = F.wave, q = lane & 31, h = lane >> 5;
    const bf16* uv = (const bf16*)(F.ws + WS_SCR + S_UV); bf16* p = (bf16*)(F.ws + WS_SCR + S_P); const bf16* wst = (const bf16*)(F.ws + WS_WST);
    LAS float* stat = (LAS float*)F.lds;
    LAS bf16* vnT = (LAS bf16*)(F.lds + 1024);
    constexpr int VP = 136;
    for (int unit = F.vcu; unit < T / 128; unit += F.G) {
        const size_t t0 = (size_t)unit * 128;
        __syncthreads();
        for (int i = 0; i < 16; ++i) { const int r = w * 16 + i; const u32x4* vr = (const u32x4*)(uv + (t0 + r) * 2048 + 1024) + lane;
            const u32x4 a = vr[0], b = vr[64]; float x[16];
            x[0] = bflo(a.x); x[1] = bfhi(a.x); x[2] = bflo(a.y); x[3] = bfhi(a.y); x[4] = bflo(a.z); x[5] = bfhi(a.z); x[6] = bflo(a.w); x[7] = bfhi(a.w);
            x[8] = bflo(b.x); x[9] = bfhi(b.x); x[10] = bflo(b.y); x[11] = bfhi(b.y); x[12] = bflo(b.z); x[13] = bfhi(b.z); x[14] = bflo(b.w); x[15] = bfhi(b.w);
            float s = 0.f;
#pragma unroll
            for (int j = 0; j < 16; ++j) s += x[j];
            const float mean = wave_sum(s) * (1.f / 1024.f); float s2 = 0.f;
#pragma unroll
            for (int j = 0; j < 16; ++j) { const float d = x[j] - mean; s2 += d * d; }
            const float rstd = 1.f / sqrtf(wave_sum(s2) * (1.f / 1024.f) + LN_EPS);
            if (lane == 0) { stat[2 * r] = mean; stat[2 * r + 1] = rstd; } }
        __syncthreads();
        for (int gg = 0; gg < 8; ++gg) {
#pragma unroll
            for (int k = 0; k < 4; ++k) { const int id = F.tid + 512 * k, s = id >> 4, cc = (id & 15) * 8;
                const u32x4 a = *(const u32x4*)(uv + (t0 + s) * 2048 + 1024 + gg * 128 + cc); const float mean = stat[2 * s], rstd = stat[2 * s + 1];
                float x[8]; x[0] = bflo(a.x); x[1] = bfhi(a.x); x[2] = bflo(a.y); x[3] = bfhi(a.y); x[4] = bflo(a.z); x[5] = bfhi(a.z); x[6] = bflo(a.w); x[7] = bfhi(a.w);
#pragma unroll
                for (int j = 0; j < 8; ++j) { const int c = gg * 128 + cc + j; const float y = (x[j] - mean) * rstd * lng[c] + lnb[c]; vnT[(cc + j) * VP + s] = (bf16)f2bf(y); } }
            __syncthreads();
            const int cr = 32 * (w & 3), tc0 = 64 * (w >> 2);
            f32x16 acc0 = {}, acc1 = {};
#pragma unroll
            for (int ks = 0; ks < 8; ++ks) {
                const bf16x8 af = *(const LAS bf16x8*)(vnT + (cr + q) * VP + ks * 16 + 8 * h);
                const bf16x8 b0 = *(const bf16x8*)(wst + ((size_t)gg * 128 + tc0 + q) * 128 + ks * 16 + 8 * h);
                const bf16x8 b1 = *(const bf16x8*)(wst + ((size_t)gg * 128 + tc0 + 32 + q) * 128 + ks * 16 + 8 * h);
                acc0 = mfma32(af, b0, acc0); acc1 = mfma32(af, b1, acc1);
            }
#pragma unroll
            for (int tt = 0; tt < 2; ++tt) { const f32x16& ac = tt == 0 ? acc0 : acc1; const int tl = tc0 + 32 * tt + q; const float bsv = bs[gg * 128 + tl];
                const size_t rowu = (t0 + tl) * 2048, rowp = (t0 + tl) * 1024;
#pragma unroll
                for (int gq = 0; gq < 4; ++gq) { const int c = gg * 128 + cr + 8 * gq + 4 * h; const u32x2 uu = *(const u32x2*)(uv + rowu + c);
                    u32x2 o; o.x = pk2(bflo(uu.x) * (ac[4 * gq] + bsv), bfhi(uu.x) * (ac[4 * gq + 1] + bsv)); o.y = pk2(bflo(uu.y) * (ac[4 * gq + 2] + bsv), bfhi(uu.y) * (ac[4 * gq + 3] + bsv));
                    *(u32x2*)(p + rowp + c) = o; } }
            __syncthreads();
        }
    }
}

struct MoeSeg { int ts[9]; };
__device__ __forceinline__ MoeSeg moe_seg(Frame& F, int moe_l) {
    MoeSeg s; int acc = 0;
#pragma unroll
    for (int e = 0; e < 8; ++e) { s.ts[e] = acc; const unsigned c = __hip_atomic_load((unsigned*)(F.ctl + CW_ECNT + 64 * moe_l + e), RLX_AGENT); acc += (int)((c + 255u) >> 8); }
    s.ts[8] = acc; return s;
}
__device__ __forceinline__ void moe_gather_phase(Frame& F, int moe_l) {
    LAS int* P = (LAS int*)F.lds;
    LAS int* wtot = (LAS int*)(F.lds + 65536);
    LAS int* tot = wtot + 64;
    const int* wcnt = (const int*)(F.ws + WS_WCNT);
    int t = F.tid; asm volatile("" : "+v"(t));
    const int lane = F.lane;
    int loc[4][8], sum[8], inc[8];
#pragma unroll
    for (int k = 0; k < 4; ++k) { const u32x4 a = *(const u32x4*)(wcnt + (4 * t + k) * 8), b = *(const u32x4*)(wcnt + (4 * t + k) * 8 + 4);
        loc[k][0] = (int)a.x; loc[k][1] = (int)a.y; loc[k][2] = (int)a.z; loc[k][3] = (int)a.w; loc[k][4] = (int)b.x; loc[k][5] = (int)b.y; loc[k][6] = (int)b.z; loc[k][7] = (int)b.w; }
#pragma unroll
    for (int e = 0; e < 8; ++e) { sum[e] = (loc[0][e] + loc[1][e]) + (loc[2][e] + loc[3][e]); inc[e] = sum[e]; }
#pragma unroll
    for (int off = 1; off < 64; off <<= 1) {
#pragma unroll
        for (int e = 0; e < 8; ++e) { const int v = __shfl_up(inc[e], off); if (lane >= off) inc[e] += v; } }
    if (lane == 63) {
#pragma unroll
        for (int e = 0; e < 8; ++e) wtot[F.wave * 8 + e] = inc[e]; }
    __syncthreads();
    int run[8];
#pragma unroll
    for (int e = 0; e < 8; ++e) { int wb = 0; for (int w = 0; w < F.wave; ++w) wb += wtot[w * 8 + e]; run[e] = wb + inc[e] - sum[e]; }
#pragma unroll
    for (int k = 0; k < 4; ++k) {
#pragma unroll
        for (int e = 0; e < 8; ++e) { P[(4 * t + k) * 8 + e] = run[e]; run[e] += loc[k][e]; } }
    if (t == 511) {
#pragma unroll
        for (int e = 0; e < 8; ++e) tot[e] = run[e]; }
    __syncthreads();
    MoeSeg sg; { int acc = 0;
#pragma unroll
        for (int e = 0; e < 8; ++e) { sg.ts[e] = acc; acc += (tot[e] + 255) >> 8; } sg.ts[8] = acc; }
    if (blockIdx.x == 0 && t < 8) __hip_atomic_store((unsigned*)(F.ctl + CW_ECNT + 64 * moe_l + t), (unsigned)tot[t], RLX_AGENT);
    const int gw = F.vcu * NWAVES + F.wave, NGW = F.G * NWAVES;
    const bf16* hb = (const bf16*)(F.ws + WS_HB); unsigned char* xg8 = (unsigned char*)F.out;
    const int* route = (const int*)(F.ws + WS_ROUTE); int* slots = (int*)(F.ws + WS_SLOTS);
    for (int m0 = 4 * gw; m0 < T; m0 += 4 * NGW) {
        int s1[4], s2[4]; u32x4 a[4], b[4];
#pragma unroll
        for (int k = 0; k < 4; ++k) { const int m = m0 + k, grp = m >> 5;
            const int e1 = route[4 * m], p1 = route[4 * m + 1], e2 = route[4 * m + 2], p2 = route[4 * m + 3];
            int ts1 = 0, ts2 = 0;
#pragma unroll
            for (int e = 0; e < 8; ++e) { ts1 = e == e1 ? sg.ts[e] : ts1; ts2 = e == e2 ? sg.ts[e] : ts2; }
            s1[k] = ts1 * 256 + P[grp * 8 + e1] + p1; s2[k] = ts2 * 256 + P[grp * 8 + e2] + p2;
            const u32x4* src = (const u32x4*)(hb + (size_t)m * D) + lane; a[k] = src[0]; b[k] = src[64]; }
#pragma unroll
        for (int k = 0; k < 4; ++k) { const int m = m0 + k;
            float x[16]; unpack8(a[k], x); unpack8(b[k], x + 8);
            u32x2 lo, hi; lo.x = pk4_fp8(x[0], x[1], x[2], x[3]); lo.y = pk4_fp8(x[4], x[5], x[6], x[7]); hi.x = pk4_fp8(x[8], x[9], x[10], x[11]); hi.y = pk4_fp8(x[12], x[13], x[14], x[15]);
            unsigned char* d1 = xg8 + (size_t)s1[k] * D + 8 * lane; unsigned char* d2 = xg8 + (size_t)s2[k] * D + 8 * lane;
            *(u32x2*)d1 = lo; *(u32x2*)(d1 + 512) = hi; *(u32x2*)d2 = lo; *(u32x2*)(d2 + 512) = hi;
            if (lane == 0) { slots[2 * m] = s1[k]; slots[2 * m + 1] = s2[k]; } }
    }
}
struct MoeOrder {
    int nM, nN, G, c, tile0; MoeSeg sg; const char* A0; const char* B0; size_t aT, bE, bT; bool a_local;
    bool out_local;
    __device__ __forceinline__ bool next(int i, pg8::Unit& u) const {
        int pm, pn; if (!pg8::tile_of((long)i * G + c, nM, nN, pm, pn)) return false;
        if (a_local) pm = nM - 1 - pm;
        const int tile = tile0 + pm; int e = 0;
#pragma unroll
        for (int k = 1; k < 8; ++k) e += (tile >= sg.ts[k]) ? 1 : 0;
        u.pm = out_local ? pm : tile; u.pn = pn; u.a = (unsigned)((size_t)(a_local ? pm : tile) * aT); u.b = (unsigned)((size_t)e * bE + (size_t)pn * bT); return true;
    }
};


template <int GI> struct L0QKOrder { int G, c; const char* A0; const char* B0;
    __device__ __forceinline__ bool next(int i, pg8::Unit& u) const { if (!pg8::tile_of((long)i * G + c, 64, 8, u.pm, u.pn)) return false; const int pm = u.pm;
        const int tok = GI == 0 ? pm * 256 : (GI == 1 ? (pm >> 3) * 2048 + (pm & 1) * 1024 + ((pm >> 1) & 3) : (pm >> 3) * 2048 + (pm & 7) * 2);
        u.a = (unsigned)tok * 1024u; u.b = (unsigned)u.pn * 256u * 1024u; return true; } };
template <int GI> struct L0VtOrder { int G, c; const char* A0; const char* B0;
    __device__ __forceinline__ bool next(int i, pg8::Unit& u) const { if (!pg8::tile_of((long)i * G + c, 4, 64, u.pm, u.pn)) return false; const int pn = u.pn;
        const int tok = GI == 0 ? pn * 256 : (GI == 1 ? (pn >> 3) * 2048 + (pn & 1) * 1024 + ((pn >> 1) & 3) : (pn >> 3) * 2048 + (pn & 7) * 2);
        u.a = (unsigned)u.pm * 256u * 1024u; u.b = (unsigned)tok * 1024u; return true; } };
template <int GI> __device__ __forceinline__ void l0_gemms(Frame& F, int ck, int bx) {
    constexpr int rs = GI == 0 ? 1 : (GI == 1 ? 4 : 16);
    constexpr size_t hst = (GI == 0 ? (size_t)128 : (GI == 1 ? (size_t)512 : (size_t)1)) * 1024;
    const char* hbc = (const char*)(F.ws + WS_SCR + S_HB8) + (size_t)ck * TC * 1024;
    unsigned char* scr = F.ws + WS_SCR;
    { L0QKOrder<GI> S{F.G, bx, hbc, (const char*)(F.ws + W_A_QK) + (size_t)GI * 2048 * 1024};
      pg8::Gemm gm{512, rs, 1, hst, (size_t)128 * 1024};
      pg8::EpiF8 E{scr + S_QK + (size_t)GI * TC * 2048, 2048, 1.f / WSCALE8};
      pg8::gemm_phase<pg8::EpiF8, L0QKOrder<GI>, false, 1>(F.lds, F.wave, gm, S, E); }
    { L0VtOrder<GI> S{F.G, bx, (const char*)(F.ws + W_A_V) + (size_t)GI * 1024 * 1024, hbc};
      pg8::Gemm gm{512, 1, rs, (size_t)128 * 1024, hst};
      pg8::EpiF8 E{scr + S_VT + (size_t)GI * 1024 * TC, TC, 1.f / WSCALE8};
      pg8::gemm_phase<pg8::EpiF8, L0VtOrder<GI>, false, 1>(F.lds, F.wave, gm, S, E); }
}


#ifdef MK_SELFCHECK
__device__ __forceinline__ void selfcheck_buf(Frame& F, const void* ptr, size_t nbytes, int stage, int slot0) {
    if (!F.chk) return;
    const int gw = F.vcu * NWAVES + F.wave, NGW = F.G * NWAVES; unsigned* cks = (unsigned*)(F.ws + WS_NEED + 2 * MiB) + slot0;
    const int nch = (int)(nbytes >> 12);
    for (int c = gw; c < nch; c += NGW) { const u32x4* r = (const u32x4*)((const char*)ptr + ((size_t)c << 12)) + F.lane; unsigned x = 0;
#pragma unroll
        for (int j = 0; j < 4; ++j) { const u32x4 v = r[64 * j]; x ^= v.x * 3u + v.y * 5u + v.z * 7u + v.w * 11u + (unsigned)j; }
        x *= (unsigned)(2 * F.lane + 1);
#pragma unroll
        for (int o = 1; o < 64; o <<= 1) x ^= __shfl_xor(x, o);
        if (F.lane == 0) { if (F.chk == 1) cks[c] = x; else if (cks[c] != x) atomicMax((unsigned*)(F.ctl + 32), (unsigned)(1000 - stage)); } }
}
#endif

__global__ void __launch_bounds__(NWAVES * 64, 2) mk_fwd(Args args) {
    extern __shared__ __attribute__((aligned(16))) unsigned char lds[];
    Frame F;
    F.lds = (LAS unsigned char*)lds;
    F.tid = threadIdx.x; F.lane = F.tid & 63; F.wave = __builtin_amdgcn_readfirstlane(F.tid >> 6);
    F.G = gridDim.x; { const int bx = blockIdx.x; F.vcu = (F.G % 8 == 0) ? (bx % 8) * (F.G / 8) + bx / 8 : bx; }
    F.ws = args.ws; F.ctl = (gu32*)(args.ws + WS_CTL); F.out = args.out; F.chk = args.chk; F.stage = 0;
    volatile LAS unsigned* MISC = (volatile LAS unsigned*)(F.lds + MISC_OFF);
    for (int u = F.tid; u < (LDS_BYTES - RING_BYTES) / 4; u += NWAVES * 64) ((LAS unsigned*)(F.lds + RING_BYTES))[u] = 0u;
    __syncthreads();
    XcdBarrier bar; bar.bar = (unsigned*)(F.ctl + CW_BAR); bar.x = 0; bar.st = nullptr;
    if (!MK_MULTI) bar = xcd_barrier_post((unsigned*)(F.ctl + CW_BAR), MISC + 8);
    const int lo = args.ph_lo, hi = args.ph_hi;
    int ph = 0;
#define PHASE_BEGIN if (ph >= lo && ph < hi) { F.lane = (int)__builtin_amdgcn_mbcnt_hi(~0u, __builtin_amdgcn_mbcnt_lo(~0u, 0u)); asm volatile("" : "+v"(F.lane)); F.tid = F.wave * 64 + F.lane;
#define PHASE_END   if (!MK_MULTI && ph + 1 < hi) xcd_barrier(bar, F.tid); } ++ph;
    const int bx = (int)blockIdx.x;
#define scr (args.ws + WS_SCR)
#define hb ((const bf16*)(args.ws + WS_HB))
#define ln_g (args.in[2])
#define ln_b (args.in[3])

    PHASE_BEGIN p_prologue(F, args); if (MK_PROBE & 8) p_prologue(F, args); PHASE_END

    if (MK_ENABLE & 1) {
#define L0_CHUNK(ck) \
        PHASE_BEGIN \
        if ((ck) > 0) dil_merge_phase(F, (ck) - 1); \
        l0_gemms<0>(F, (ck), bx); l0_gemms<1>(F, (ck), bx); l0_gemms<2>(F, (ck), bx); \
        PHASE_END \
        PHASE_BEGIN dil_attn_phase3(F); if (MK_PROBE & 1) dil_attn_phase3(F); PHASE_END
        L0_CHUNK(0) L0_CHUNK(1) L0_CHUNK(2) L0_CHUNK(3)
#undef L0_CHUNK
        PHASE_BEGIN dil_merge_phase(F, 3); if (MK_PROBE & 4) { dil_merge_phase(F, 3); dil_merge_phase(F, 3); dil_merge_phase(F, 3); dil_merge_phase(F, 3); } PHASE_END
        PHASE_BEGIN
        { pg8::LinOrder S{T / 256, 4, F.G, bx, (const char*)(scr + S_ATT), (const char*)(F.ws + W_A_O), (size_t)256 * 1024, (size_t)256 * 1024};
          pg8::Gemm gm{512, 1, 1, (size_t)128 * 1024, (size_t)128 * 1024};
          pg8::EpiResLn<FFN_GU8 == 0> E{(bf16*)(F.ws + WS_HB), ln_g + 0 * 2048, ln_b + 0 * 2048, ALPHA, 1.f / (WSCALE8 * ASCALE8), (float*)scr, (unsigned*)(F.ctl + CW_LNC + 0 * 4096), (unsigned*)(F.ctl + CW_BAR) + XB_TMO, scr + S_HB8, F.lds + LNT_OFF};
          pg8::gemm_phase<pg8::EpiResLn<FFN_GU8 == 0>, pg8::LinOrder, true, 1>(F.lds, F.wave, gm, S, E); }
        PHASE_END
    } else {
        PHASE_BEGIN ln_phase<1, false, false>(F, ln_g + 0 * 2048, ln_b + 0 * 2048, nullptr); PHASE_END
    }
#define DENSE_FFN(f, lnidx, enbit) \
    if (MK_ENABLE & (enbit)) { \
        PHASE_BEGIN \
        if ((f) == FFN_GU8) { \
          pg8::LinOrder S{T / 256, 2 * DFF / 256, F.G, bx, (const char*)(scr + S_HB8), (const char*)(F.ws + W_F_GU) + (size_t)(f) * 2 * DFF * 2048, (size_t)256 * 1024, (size_t)256 * 1024}; \
          pg8::Gemm gm{512, 1, 1, (size_t)128 * 1024, (size_t)128 * 1024};     \
          pg8::EpiSwiglu8 E{(unsigned char*)(scr + S_HID), DFF, 1.f / WSCALE8}; \
          pg8::gemm_phase<pg8::EpiSwiglu8, pg8::LinOrder, true, 1>(F.lds, F.wave, gm, S, E); \
        } else { pg8::LinOrder S{T / 256, 2 * DFF / 256, F.G, bx, (const char*)hb, (const char*)(F.ws + W_F_GU) + (size_t)(f) * 2 * DFF * 2048, (size_t)256 * 2048, (size_t)256 * 2048}; \
          pg8::Gemm gm{1024, 1, 1, (size_t)128 * 2048, (size_t)128 * 2048}; \
          pg8::EpiSwiglu8 E{(unsigned char*)(scr + S_HID), DFF}; \
          pg8::gemm_phase(F.lds, F.wave, gm, S, E); } \
        PHASE_END \
        PHASE_BEGIN \
        { pg8::LinOrder S{T / 256, 4, F.G, bx, (const char*)(scr + S_HID), (const char*)(F.ws + W_F_D) + (size_t)(f) * 1024 * DFF * 2, (size_t)256 * DFF, (size_t)256 * DFF}; \
          pg8::Gemm gm{DFF / 2, 1, 1, (size_t)128 * DFF, (size_t)128 * DFF};     \
          pg8::EpiResLn<false> E{(bf16*)(F.ws + WS_HB), ln_g + (lnidx) * 1024, ln_b + (lnidx) * 1024, ALPHA, 1.f / WSCALE8D, (float*)(scr + S_Y), (unsigned*)(F.ctl + CW_LNC + (2 + (f)) * 4096), (unsigned*)(F.ctl + CW_BAR) + XB_TMO, nullptr, F.lds + LNT_OFF}; \
          pg8::gemm_phase<pg8::EpiResLn<false>, pg8::LinOrder, true, 1>(F.lds, F.wave, gm, S, E); }     \
        PHASE_END \
    } else { \
        PHASE_BEGIN ln_phase<1, false, false>(F, ln_g + (lnidx) * 1024, ln_b + (lnidx) * 1024, nullptr); PHASE_END \
    }
    DENSE_FFN(0, 1, 2)

    if (MK_ENABLE & 4) {
        PHASE_BEGIN
        { pg8::LinOrder S{T / 256, 4, F.G, bx, (const char*)hb, (const char*)(F.ws + W_B_IN), (size_t)256 * 2048, (size_t)256 * 2048};
          pg8::Gemm gm{1024, 1, 1, (size_t)128 * 2048, (size_t)128 * 2048};
          pg8::EpiBf16<0> E{(bf16*)(scr + S_BCX), 1024};
          pg8::gemm_phase(F.lds, F.wave, gm, S, E); }
        { pg8::LinOrder S{T / 256, 8, F.G, bx, (const char*)hb, (const char*)(F.ws + W_B_IN) + (size_t)1024 * 2048, (size_t)256 * 2048, (size_t)256 * 2048};
          pg8::Gemm gm{1024, 1, 1, (size_t)128 * 2048, (size_t)128 * 2048};
          pg8::EpiGlu<0> E{(bf16*)(scr + S_BCX + (size_t)128 * MiB), 1024};
          pg8::gemm_phase(F.lds, F.wave, gm, S, E); }
        PHASE_END
        PHASE_BEGIN conv_phase(F, args.in[7]); if (MK_PROBE & 4) conv_phase(F, args.in[7]); PHASE_END
        PHASE_BEGIN
        { pg8::LinOrder S{T / 256, 4, F.G, bx, (const char*)(scr + S_P), (const char*)(F.ws + W_B_O), (size_t)256 * 2048, (size_t)256 * 2048};
          pg8::Gemm gm{1024, 1, 1, (size_t)128 * 2048, (size_t)128 * 2048};
          pg8::EpiResBf16 E{hb, (bf16*)F.out, 1024, ALPHA};
          pg8::gemm_phase(F.lds, F.wave, gm, S, E); }
        PHASE_END
        PHASE_BEGIN ln_phase<0, true, false>(F, ln_g + 2 * 1024, ln_b + 2 * 1024, args.in[20]); PHASE_END
    } else {
        PHASE_BEGIN ln_phase<1, true, false>(F, ln_g + 2 * 1024, ln_b + 2 * 1024, args.in[20]); PHASE_END
    }
#define MOE_HID(ck) (scr + (size_t)130 * MiB + (size_t)((ck) & 1) * 168 * MiB)
#define MOE_G1(f, ck) \
        { const MoeSeg sg = moe_seg(F, (f)); int nM = sg.ts[8] - (ck) * MOE_CH_TILES; nM = nM > MOE_CH_TILES ? MOE_CH_TILES : (nM < 0 ? 0 : nM); \
          MoeOrder S{nM, 2 * DFE / 256, F.G, bx, (ck) * MOE_CH_TILES, sg, (const char*)F.out, (const char*)(F.ws + W_E_GU) + (size_t)(f) * 8 * 2 * DFE * 2048, (size_t)256 * 1024, (size_t)2 * DFE * 2048, (size_t)256 * 1024, false, true}; \
          pg8::Gemm gm{512, 1, 1, (size_t)128 * 1024, (size_t)128 * 1024};     \
          pg8::EpiSwiglu8 E{(unsigned char*)MOE_HID(ck), DFE, 1.f / WSCALE8}; \
          pg8::gemm_phase<pg8::EpiSwiglu8, MoeOrder, true, 0x7C>(F.lds, F.wave, gm, S, E); }
#define MOE_G2(f, ck) \
        { const MoeSeg sg = moe_seg(F, (f)); int nM = sg.ts[8] - (ck) * MOE_CH_TILES; nM = nM > MOE_CH_TILES ? MOE_CH_TILES : (nM < 0 ? 0 : nM); \
          MoeOrder S{nM, 4, F.G, bx, (ck) * MOE_CH_TILES, sg, (const char*)MOE_HID(ck), (const char*)(F.ws + W_E_D) + (size_t)(f) * 8 * 1024 * DFE * 2, (size_t)256 * DFE, (size_t)1024 * DFE * 2, (size_t)256 * DFE, true, false}; \
          pg8::Gemm gm{DFE / 2, 1, 1, (size_t)128 * DFE, (size_t)128 * DFE};     \
          pg8::EpiF8 E{scr + S_XG, 1024, YSCALE8 / WSCALE8D};     \
          pg8::gemm_phase<pg8::EpiF8, MoeOrder, true, 0x7B>(F.lds, F.wave, gm, S, E); }
#define MOE_FFN(f, lnidx, enbit, fin) \
    if (MK_ENABLE & (enbit)) { \
        PHASE_BEGIN moe_gather_phase(F, (f)); if (MK_PROBE & 4) moe_gather_phase(F, (f)); PHASE_END \
        PHASE_BEGIN MOE_G1(f, 0) PHASE_END \
        PHASE_BEGIN MOE_G2(f, 0) MOE_G1(f, 1) PHASE_END \
        PHASE_BEGIN MOE_G2(f, 1) MOE_G1(f, 2) PHASE_END \
        PHASE_BEGIN MOE_G2(f, 2) PHASE_END \
        PHASE_BEGIN ln_phase<2, false, fin, (f) == 0>(F, ln_g + (lnidx) * 1024, ln_b + (lnidx) * 1024, nullptr); PHASE_END \
    } else { \
        PHASE_BEGIN ln_phase<1, false, fin>(F, ln_g + (lnidx) * 1024, ln_b + (lnidx) * 1024, nullptr); PHASE_END \
    }
    MOE_FFN(0, 3, 8, false)

    if (MK_ENABLE & 16) {
        PHASE_BEGIN
        { pg8::LinOrder S{T / 256, 8, F.G, bx, (const char*)hb, (const char*)(F.ws + W_C_QK), (size_t)256 * 2048, (size_t)256 * 2048};
          pg8::Gemm gm{1024, 1, 1, (size_t)128 * 2048, (size_t)128 * 2048};
          pg8::EpiBf16<0> E{(bf16*)(scr + S_CQK), 2048};
          pg8::gemm_phase(F.lds, F.wave, gm, S, E); }
        { pg8::LinOrder S{4, T / 256, F.G, bx, (const char*)(F.ws + W_C_V), (const char*)(scr + S_HB8), (size_t)256 * 1024, (size_t)256 * 1024};
          pg8::Gemm gm{512, 1, 1, (size_t)128 * 1024, (size_t)128 * 1024};
          pg8::EpiBf16<0> E{(bf16*)(scr + S_CVT), T, 1.f / WSCALE8};
          pg8::gemm_phase<pg8::EpiBf16<0>, pg8::LinOrder, true, 1>(F.lds, F.wave, gm, S, E); }
        PHASE_END
#ifdef MK_SELFCHECK
        PHASE_BEGIN selfcheck_buf(F, scr + S_CQK, (size_t)256 * MiB, 40, 0); selfcheck_buf(F, scr + S_CVT, (size_t)128 * MiB, 41, 65536); PHASE_END
#endif
        PHASE_BEGIN kmean_phase(F); if (MK_PROBE & 4) kmean_phase(F); PHASE_END
#ifdef MK_SELFCHECK
        PHASE_BEGIN selfcheck_buf(F, F.ws + WS_KMEAN, (size_t)1 * MiB, 42, 65536 + 32768); PHASE_END
#endif
        PHASE_BEGIN moba_phase3(F); if (MK_PROBE & 2) moba_phase3(F); PHASE_END
#ifdef MK_SELFCHECK
        PHASE_BEGIN selfcheck_buf(F, F.ws + WS_NEED + 3 * MiB, (size_t)4 * MiB, 43, 65536 + 32768 + 256); selfcheck_buf(F, F.ws + WS_NEED + 7 * MiB, (size_t)4 * MiB, 44, 65536 + 32768 + 256 + 1024);
                    selfcheck_buf(F, scr + S_CATT, (size_t)128 * MiB, 45, 65536 + 32768 + 256 + 2048); PHASE_END
#endif
        PHASE_BEGIN
        { pg8::LinOrder S{T / 256, 4, F.G, bx, (const char*)(scr + S_CATT), (const char*)(F.ws + W_C_O), (size_t)256 * 1024, (size_t)256 * 1024};
          pg8::Gemm gm{512, 1, 1, (size_t)128 * 1024, (size_t)128 * 1024};
          pg8::EpiResLn<FFN_GU8 == 1> E{(bf16*)(F.ws + WS_HB), ln_g + 4 * 1024, ln_b + 4 * 1024, ALPHA, 1.f / (WSCALE8 * ASCALE8), (float*)scr, (unsigned*)(F.ctl + CW_LNC + 1 * 4096), (unsigned*)(F.ctl + CW_BAR) + XB_TMO, scr + S_HB8, F.lds + LNT_OFF};
          pg8::gemm_phase<pg8::EpiResLn<FFN_GU8 == 1>, pg8::LinOrder, true, 1>(F.lds, F.wave, gm, S, E); }
        PHASE_END
    } else {
        PHASE_BEGIN ln_phase<1, false, false>(F, ln_g + 4 * 1024, ln_b + 4 * 1024, nullptr); PHASE_END
    }
    DENSE_FFN(1, 5, 32)

    if (MK_ENABLE & 64) {
        PHASE_BEGIN
        { pg8::LinOrder S{T / 256, 8, F.G, bx, (const char*)hb, (const char*)(F.ws + W_D_IN), (size_t)256 * 2048, (size_t)256 * 2048};
          pg8::Gemm gm{1024, 1, 1, (size_t)128 * 2048, (size_t)128 * 2048};
          pg8::EpiBf16<1> E{(bf16*)(scr + S_UV), 2048};
          pg8::gemm_phase(F.lds, F.wave, gm, S, E); }
        PHASE_END
        PHASE_BEGIN gmlp_phase(F, args.in[12], args.in[13], args.in[15]); if (MK_PROBE & 4) gmlp_phase(F, args.in[12], args.in[13], args.in[15]); PHASE_END
        PHASE_BEGIN
        { pg8::LinOrder S{T / 256, 4, F.G, bx, (const char*)(scr + S_P), (const char*)(F.ws + W_D_O), (size_t)256 * 2048, (size_t)256 * 2048};
          pg8::Gemm gm{1024, 1, 1, (size_t)128 * 2048, (size_t)128 * 2048};
          pg8::EpiResBf16 E{hb, (bf16*)F.out, 1024, ALPHA};
          pg8::gemm_phase(F.lds, F.wave, gm, S, E); }
        PHASE_END
        PHASE_BEGIN ln_phase<0, true, false>(F, ln_g + 6 * 1024, ln_b + 6 * 1024, args.in[20] + 8192); PHASE_END
    } else {
        PHASE_BEGIN ln_phase<1, true, false>(F, ln_g + 6 * 1024, ln_b + 6 * 1024, args.in[20] + 8192); PHASE_END
    }
    MOE_FFN(1, 7, 128, true)
#ifdef MK_SELFCHECK
    PHASE_BEGIN
    { const unsigned fl = __hip_atomic_load((unsigned*)(F.ctl + 32), RLX_AGENT);
      if (fl != 0u) { const int code = 1000 - (int)fl; const float cval = (code >= 40 && code <= 45) ? (float)(20 + 2 * (code - 40)) : (float)(1u << (code / 10 + 1)); const int gw = F.vcu * NWAVES + F.wave, NGW = F.G * NWAVES;
          for (int m = gw; m < T; m += NGW) { f32x4* w = (f32x4*)(F.out + (size_t)m * D) + F.lane;
#pragma unroll
              for (int j = 0; j < 4; ++j) w[64 * j] = (f32x4){cval, cval, cval, cval}; } } }
    PHASE_END
#endif
#undef PHASE_BEGIN
#undef PHASE_END
#undef scr
#undef hb
#undef ln_g
#undef ln_b
}

static int count_phases() {
    int n = 1;
    n += (MK_ENABLE & 1) ? (8 + 1 + 1) : 1;
    n += (MK_ENABLE & 2) ? 2 : 1;
    n += (MK_ENABLE & 4) ? 4 : 1;
    n += (MK_ENABLE & 8) ? 6 : 1;
    n += (MK_ENABLE & 16) ? 4 : 1;
    n += (MK_ENABLE & 32) ? 2 : 1;
    n += (MK_ENABLE & 64) ? 4 : 1;
    n += (MK_ENABLE & 128) ? 6 : 1;
#ifdef MK_SELFCHECK
    n += 1 + 3;
#endif
    return n;
}
extern "C" void kernel_launch(void* const* d_in, const int* in_sizes, int n_in, void* d_out, int out_size, void* d_ws, size_t ws_size, hipStream_t stream) {
    static int grid = 0;
    if (grid == 0) {
        if (n_in != 24 || in_sizes[0] != T * D || out_size != T * D || ws_size < WS_NEED) { fprintf(stderr, "kernel_launch: unexpected shapes (n_in %d, in0 %d, out %d, ws %zu < %zu); nothing launched\n", n_in, n_in > 0 ? in_sizes[0] : -1, out_size, ws_size, (size_t)WS_NEED); grid = -1; return; }
        int dev = 0, cus = 0, per_cu = 0;
        if (hipGetDevice(&dev) != hipSuccess || hipDeviceGetAttribute(&cus, hipDeviceAttributeMultiprocessorCount, dev) != hipSuccess) { grid = -1; return; }
        if (hipFuncSetAttribute((const void*)mk_fwd, hipFuncAttributeMaxDynamicSharedMemorySize, LDS_BYTES) != hipSuccess) { fprintf(stderr, "kernel_launch: hipFuncSetAttribute failed\n"); grid = -1; return; }
        if (hipOccupancyMaxActiveBlocksPerMultiprocessor(&per_cu, (const void*)mk_fwd, NWAVES * 64, LDS_BYTES) != hipSuccess || per_cu < 1) fprintf(stderr, "kernel_launch: occupancy query reports %d\n", per_cu);
        (void)hipGetLastError();
        grid = cus;
    }
    if (grid < 0) return;
    (void)hipMemsetAsync((char*)d_ws + WS_CTL, 0, CTL_ZERO_BYTES, stream);
#ifdef SELF_POISON
    (void)hipMemsetAsync((char*)d_ws + CTL_ZERO_BYTES, 0xAA, WS_NEED - CTL_ZERO_BYTES, stream);
    (void)hipMemsetAsync(d_out, 0xAA, (size_t)T * D * 4, stream);
#endif
    Args a{};
    for (int i = 0; i < 24; ++i) a.in[i] = (const float*)d_in[i];
    a.out = (float*)d_out; a.ws = (unsigned char*)d_ws;
    const int nph = count_phases();
#if MK_MULTI
    for (int p = 0; p < nph; ++p) { a.ph_lo = p; a.ph_hi = p + 1; hipLaunchKernelGGL(mk_fwd, dim3(grid), dim3(NWAVES * 64), LDS_BYTES, stream, a); }
#else
    a.ph_lo = 0; a.ph_hi = nph;
#ifdef MK_SELFCHECK
    a.chk = 1;
    hipLaunchKernelGGL(mk_fwd, dim3(grid), dim3(NWAVES * 64), LDS_BYTES, stream, a);
    (void)hipMemsetAsync((char*)d_ws + WS_CTL, 0, CTL_ZERO_BYTES, stream);
    a.chk = 2;
#endif
    hipLaunchKernelGGL(mk_fwd, dim3(grid), dim3(NWAVES * 64), LDS_BYTES, stream, a);
#endif
    const hipError_t le = hipPeekAtLastError();
    if (le != hipSuccess) fprintf(stderr, "kernel_launch: launch failed: %s\n", hipGetErrorName(le));
}
```
